# Optimizing an MI355X kernel written in HIP

```python
import math
import jax, jax.numpy as jnp
from jax import lax
import numpy as np

D_MODEL = 1024
BATCH = 8
SEQ = 4096
DEPTH = 2

GRID_W = 64
CTX_LEN = 256

HEAD_DIM = 64
W_GROUP = D_MODEL // 4
MIX_WIDTH = 4 * W_GROUP
N_WA_HEADS = W_GROUP // HEAD_DIM
N_WA_KV = N_WA_HEADS // 2
N_NA_HEADS = W_GROUP // HEAD_DIM
KV_WA = N_WA_KV * HEAD_DIM
OFF_POOL = 3 * W_GROUP
OFF_WA_Q = 4 * W_GROUP
OFF_NA_Q = 5 * W_GROUP
OFF_KV = 6 * W_GROUP
IN_WIDTH = OFF_KV + 2 * KV_WA + 2 * W_GROUP

HY_ORDER = 2
HY_BANDS = 16
HY_EMB = 1 + 2 * HY_BANDS
HY_HIDDEN = 64
HY_DECAY_MIN = abs(math.log(1e-2) / 1.5)
HY_DECAY_MAX = abs(math.log(1e-2) / 0.3)

WA_WINDOW = 128
WA_BLOCK = 128

POOL_WINDOWS = (2, 4, 8, 16)
POOL_GROUP = W_GROUP // len(POOL_WINDOWS)

NA_ROWS = 8
NA_COLS = 16
NA_QCOLS = 16
NA_BAND = 2 * NA_COLS

ROPE_BASE = 10000.0

N_EXPERTS = 16
EXPERT_HIDDEN = 2 * D_MODEL
EC_CAPACITY = 2

NORM_EPS = 1e-6
NEG_INF = -1e30

kernel_name = 'hybrid_parallel_mixer_diffusion_block'


def _rmsnorm(x, g):
    x32 = x.astype(jnp.float32)
    y = x32 * lax.rsqrt(jnp.mean(x32 * x32, axis=-1, keepdims=True) + NORM_EPS)
    return (y * g.astype(jnp.float32)).astype(x.dtype)


def _modulate(h, shift, scale):
    return h * (1 + scale) + shift


def _short_conv(u, w, b):
    up = jnp.pad(u, ((0, 0), (1, 1), (0, 0)))
    return up[:, :-2] * w[0] + up[:, 1:-1] * w[1] + up[:, 2:] * w[2] + b


def _hyena_filters(L, w1, b1, w2, b2, w3, freq):
    f32 = jnp.float32
    pos = jnp.arange(L, dtype=f32)
    t = pos / max(L - 1, 1)
    bands = jnp.linspace(1e-4, HY_BANDS - 1, HY_BANDS, dtype=f32)
    ang = (2 * math.pi / L) * pos[:, None] * bands[None, :]
    feats = jnp.concatenate([t[:, None], jnp.cos(ang), -jnp.sin(ang)], axis=-1)
    fr = freq.astype(f32)
    h = jnp.sin(fr * (feats @ w1.astype(f32) + b1.astype(f32)))
    h = jnp.sin(fr * (h @ w2.astype(f32) + b2.astype(f32)))
    h = (h @ w3.astype(f32)).reshape(L, HY_ORDER, 2, W_GROUP)
    deltas = jnp.linspace(HY_DECAY_MIN, HY_DECAY_MAX, W_GROUP, dtype=f32)
    window = jnp.exp(-t[:, None] * deltas[None, :])
    return h * window[:, None, None, :]


def _two_sided(h_fwd, h_bwd):
    lag0 = h_fwd[:1] + h_bwd[:1]
    return jnp.concatenate([lag0, h_fwd[1:], jnp.zeros_like(h_fwd[:1]), h_bwd[:0:-1]], axis=0)


def _fft_conv(z, filt, skip):
    L = z.shape[1]
    zf = jnp.fft.rfft(z, n=2 * L, axis=1)
    ff = jnp.fft.rfft(filt, n=2 * L, axis=0)
    y = jnp.fft.irfft(zf * ff[None], n=2 * L, axis=1)[:, :L]
    return y + z * skip


def _hyena(u, conv_w, conv_b, w1, b1, w2, b2, w3, freq, skip):
    L = u.shape[1]
    uc = _short_conv(u, conv_w, conv_b).astype(jnp.float32)
    v, x1, x2 = jnp.split(uc, 3, axis=-1)
    h = _hyena_filters(L, w1, b1, w2, b2, w3, freq)
    sk = skip.astype(jnp.float32)
    z = x1 * _fft_conv(v, _two_sided(h[:, 0, 0], h[:, 0, 1]), sk[0])
    z = x2 * _fft_conv(z, _two_sided(h[:, 1, 0], h[:, 1, 1]), sk[1])
    return z.astype(u.dtype)


def _pool_mixer(u, w_grp, scale):
    B, L, C = u.shape
    u32 = u.astype(jnp.float32)
    cs = jnp.concatenate([jnp.zeros((B, 1, C), jnp.float32), jnp.cumsum(u32, axis=1)], axis=1)
    pos = np.arange(L)
    outs = []
    for g, win in enumerate(POOL_WINDOWS):
        lo = np.clip(pos - win // 2, 0, L)
        hi = np.clip(pos + win // 2, 0, L)
        sl = slice(g * POOL_GROUP, (g + 1) * POOL_GROUP)
        mean = (cs[:, hi, sl] - cs[:, lo, sl]) / (hi - lo).astype(np.float32)[None, :, None]
        outs.append((mean - u32[:, :, sl]).astype(u.dtype) @ w_grp[g])
    return jnp.concatenate(outs, axis=-1) * scale


def _axial_rope(x, rows, cols):
    quarter = HEAD_DIM // 4
    half = HEAD_DIM // 2
    inv = ROPE_BASE ** (-jnp.arange(quarter, dtype=jnp.float32) / quarter)

    def rot(xh, p):
        ang = p.astype(jnp.float32)[:, None] * inv[None, :]
        cos = jnp.cos(ang)[None, :, None, :].astype(x.dtype)
        sin = jnp.sin(ang)[None, :, None, :].astype(x.dtype)
        a, b = xh[..., :quarter], xh[..., quarter:]
        return jnp.concatenate([a * cos - b * sin, a * sin + b * cos], axis=-1)

    return jnp.concatenate([rot(x[..., :half], rows), rot(x[..., half:], cols)], axis=-1)


def _window_attn(q, k, v, kc, vc, sink):
    f32 = jnp.float32
    B, S, HQ, hd = q.shape
    HKV = k.shape[2]
    G = HQ // HKV
    Lc = kc.shape[1]
    nb = S // WA_BLOCK
    nbw = 3 * WA_BLOCK
    qb = q.reshape(B, nb, WA_BLOCK, HKV, G, hd)

    def band(t):
        tp = jnp.pad(t, ((0, 0), (WA_BLOCK, WA_BLOCK), (0, 0), (0, 0))).reshape(B, nb + 2, WA_BLOCK, HKV, hd)
        return jnp.concatenate([tp[:, :-2], tp[:, 1:-1], tp[:, 2:]], axis=2)

    kb, vb = band(k), band(v)
    scl = hd ** -0.5
    qpos = np.arange(nb)[:, None, None] * WA_BLOCK + np.arange(WA_BLOCK)[None, :, None]
    kpos = np.arange(nb)[:, None, None] * WA_BLOCK - WA_BLOCK + np.arange(nbw)[None, None, :]
    valid = (np.abs(qpos - kpos) <= WA_WINDOW) & (kpos >= 0) & (kpos < S)
    s_loc = jnp.where(valid, jnp.einsum('bnqkgd,bnjkd->bkgnqj', qb, kb).astype(f32) * scl, NEG_INF)
    s_ctx = jnp.einsum('bnqkgd,bckd->bkgnqc', qb, kc).astype(f32) * scl
    s_snk = jnp.broadcast_to(sink.astype(f32).reshape(HKV, G)[None, :, :, None, None, None],
                             (B, HKV, G, nb, WA_BLOCK, 1))
    p = jax.nn.softmax(jnp.concatenate([s_loc, s_ctx, s_snk], axis=-1), axis=-1).astype(v.dtype)
    out = (jnp.einsum('bkgnqj,bnjkd->bnqkgd', p[..., :nbw], vb)
           + jnp.einsum('bkgnqc,bckd->bnqkgd', p[..., nbw:nbw + Lc], vc))
    return out.reshape(B, S, HQ * hd)


def _ctx_attn(q, k, v, sink):
    B, L, HQ, hd = q.shape
    HKV = k.shape[2]
    G = HQ // HKV
    qg = q.reshape(B, L, HKV, G, hd)
    s = jnp.einsum('bqkgd,bjkd->bkgqj', qg, k).astype(jnp.float32) * hd ** -0.5
    if sink is not None:
        snk = jnp.broadcast_to(sink.astype(jnp.float32).reshape(HKV, G)[None, :, :, None, None], (B, HKV, G, L, 1))
        s = jnp.concatenate([s, snk], axis=-1)
    p = jax.nn.softmax(s, axis=-1)[..., :L].astype(v.dtype)
    return jnp.einsum('bkgqj,bjkd->bqkgd', p, v).reshape(B, L, HQ * hd)


def _neighbourhood_attn(q, k, v, kc, vc, rpb):
    f32 = jnp.float32
    B, S, H, hd = q.shape
    rows = S // GRID_W
    wr = min(NA_ROWS, rows)
    ncb = GRID_W // NA_QCOLS
    nk = wr * NA_BAND
    r = np.arange(rows)
    ri = np.clip(r - wr // 2, 0, rows - wr)[:, None] + np.arange(wr)[None, :]
    ci = (np.clip(np.arange(ncb) * NA_QCOLS - NA_COLS // 2, 0, GRID_W - NA_BAND)[:, None]
          + np.arange(NA_BAND)[None, :])
    qcol = np.arange(GRID_W).reshape(ncb, NA_QCOLS)
    ws = np.clip(qcol - NA_COLS // 2, 0, GRID_W - NA_COLS)
    col_ok = (ci[:, None, :] >= ws[:, :, None]) & (ci[:, None, :] < ws[:, :, None] + NA_COLS)
    mask = np.broadcast_to(col_ok[:, :, None, :], (ncb, NA_QCOLS, wr, NA_BAND)).reshape(ncb, NA_QCOLS, nk)
    dr = ri - r[:, None] + NA_ROWS - 1
    dc = np.clip(ci[:, None, :] - qcol[:, :, None] + NA_COLS - 1, 0, 2 * NA_COLS - 2)
    bias = rpb.astype(f32)[:, dr[:, None, None, :, None], dc[None, :, :, None, :]]
    bias = bias.reshape(H, rows, ncb, NA_QCOLS, nk)
    qg = q.reshape(B, rows, ncb, NA_QCOLS, H, hd)

    def gather(t):
        tg = t.reshape(B, rows, GRID_W, H, hd)
        return tg[:, ri[:, None, :, None], ci[None, :, None, :]].reshape(B, rows, ncb, nk, H, hd)

    kg, vg = gather(k), gather(v)
    scl = hd ** -0.5
    s_loc = jnp.where(mask, jnp.einsum('brnqhd,brnjhd->bhrnqj', qg, kg).astype(f32) * scl + bias[None], NEG_INF)
    s_ctx = jnp.einsum('brnqhd,bchd->bhrnqc', qg, kc).astype(f32) * scl
    p = jax.nn.softmax(jnp.concatenate([s_loc, s_ctx], axis=-1), axis=-1).astype(v.dtype)
    out = (jnp.einsum('bhrnqj,brnjhd->brnqhd', p[..., :nk], vg)
           + jnp.einsum('bhrnqc,bchd->brnqhd', p[..., nk:], vc))
    return out.reshape(B, S, H * hd)


def _expert_choice_ffn(h, router_w, w_gate, w_up, w_down):
    B, L, D = h.shape
    cap = EC_CAPACITY * L // N_EXPERTS
    aff = jax.nn.softmax((h @ router_w).astype(jnp.float32), axis=-1)
    g, idx = lax.top_k(jnp.swapaxes(aff, 1, 2), cap)
    bidx = jnp.arange(B)[:, None, None]
    xg = h[bidx, idx]
    a = jnp.einsum('becd,edf->becf', xg, w_gate)
    u = jnp.einsum('becd,edf->becf', xg, w_up)
    o = jnp.einsum('becf,efd->becd', jax.nn.silu(a) * u, w_down) * g[..., None].astype(h.dtype)
    return jnp.zeros_like(h).at[bidx, idx].add(o)


def _split_kv(p, B, L):
    wk = p[..., :KV_WA].reshape(B, L, N_WA_KV, HEAD_DIM)
    wv = p[..., KV_WA:2 * KV_WA].reshape(B, L, N_WA_KV, HEAD_DIM)
    nk = p[..., 2 * KV_WA:2 * KV_WA + W_GROUP].reshape(B, L, N_NA_HEADS, HEAD_DIM)
    nv = p[..., 2 * KV_WA + W_GROUP:].reshape(B, L, N_NA_HEADS, HEAD_DIM)
    return wk, wv, nk, nv


def _layer(x, ctx, c, c_ctx, ada_w, ada_b, g1, g2, w_in, hy_conv_w, hy_conv_b, hy_w1, hy_b1, hy_w2, hy_b2,
           hy_w3, hy_freq, hy_skip, wa_sink, pool_w, pool_scale, na_rpb, w_out, router_w, exp_w_gate,
           exp_w_up, exp_w_down, update_ctx):
    D = D_MODEL
    B, S, _ = x.shape
    Lc = ctx.shape[1]
    hy = (hy_conv_w, hy_conv_b, hy_w1, hy_b1, hy_w2, hy_b2, hy_w3, hy_freq, hy_skip)
    mod = jax.nn.silu(c) @ ada_w + ada_b
    sh1, sc1, gt1, sh2, sc2, gt2 = jnp.split(mod[:, None, :], 6, axis=-1)
    n_cm = 6 if update_ctx else 2
    mod_c = (jax.nn.silu(c_ctx) @ ada_w[:, :n_cm * D] + ada_b[:n_cm * D]).reshape(n_cm, D)

    hx = _modulate(_rmsnorm(x, g1), sh1, sc1)
    hc = _modulate(_rmsnorm(ctx, g1), mod_c[0], mod_c[1])
    px = hx @ w_in
    if update_ctx:
        pc = hc @ w_in
        pc_kv = pc[..., OFF_KV:]
    else:
        pc_kv = hc @ w_in[:, OFF_KV:]
    kc_wa, vc_wa, kc_na, vc_na = _split_kv(pc_kv, B, Lc)
    k_wa, v_wa, k_na, v_na = _split_kv(px[..., OFF_KV:], B, S)

    pos = jnp.arange(S)
    rows, cols = pos // GRID_W, pos % GRID_W
    q_wa = _axial_rope(px[..., OFF_WA_Q:OFF_NA_Q].reshape(B, S, N_WA_HEADS, HEAD_DIM), rows, cols)
    k_wa = _axial_rope(k_wa, rows, cols)
    q_na = px[..., OFF_NA_Q:OFF_KV].reshape(B, S, N_NA_HEADS, HEAD_DIM)

    y = jnp.concatenate([
        _hyena(px[..., :OFF_POOL], *hy),
        _window_attn(q_wa, k_wa, v_wa, kc_wa, vc_wa, wa_sink),
        _pool_mixer(px[..., OFF_POOL:OFF_WA_Q], pool_w, pool_scale),
        _neighbourhood_attn(q_na, k_na, v_na, kc_na, vc_na, na_rpb),
    ], axis=-1)
    x = x + gt1 * (y @ w_out)
    x = x + gt2 * _expert_choice_ffn(_modulate(_rmsnorm(x, g2), sh2, sc2), router_w, exp_w_gate, exp_w_up, exp_w_down)

    if update_ctx:
        qc_wa = pc[..., OFF_WA_Q:OFF_NA_Q].reshape(B, Lc, N_WA_HEADS, HEAD_DIM)
        qc_na = pc[..., OFF_NA_Q:OFF_KV].reshape(B, Lc, N_NA_HEADS, HEAD_DIM)
        yc = jnp.concatenate([
            _hyena(pc[..., :OFF_POOL], *hy),
            _ctx_attn(qc_wa, kc_wa, vc_wa, wa_sink),
            _pool_mixer(pc[..., OFF_POOL:OFF_WA_Q], pool_w, pool_scale),
            _ctx_attn(qc_na, kc_na, vc_na, None),
        ], axis=-1)
        ctx = ctx + mod_c[2] * (yc @ w_out)
        ctx = ctx + mod_c[5] * _expert_choice_ffn(_modulate(_rmsnorm(ctx, g2), mod_c[3], mod_c[4]),
                                                  router_w, exp_w_gate, exp_w_up, exp_w_down)
    return x, ctx


def setup_inputs(seed: int = 0) -> dict:
    key = jax.random.key(seed)
    ks = jax.random.split(key, 28)
    D, NL, W, F, E = D_MODEL, DEPTH, W_GROUP, EXPERT_HIDDEN, N_EXPERTS

    def nrm(k, shape, s):
        return jax.random.normal(k, shape, jnp.float32) * s

    return {
        'x': nrm(ks[0], (BATCH, SEQ, D), 1.0),
        'c': nrm(ks[1], (BATCH, D), 1.0),
        'ctx': nrm(ks[2], (BATCH, CTX_LEN, D), 1.0),
        'c_ctx': nrm(ks[3], (D,), 1.0),
        'ada_w': nrm(ks[4], (NL, D, 6 * D), 0.5 * D ** -0.5),
        'ada_b': nrm(ks[5], (NL, 6 * D), 0.02),
        'norm1_g': 1.0 + nrm(ks[6], (NL, D), 0.05),
        'norm2_g': 1.0 + nrm(ks[7], (NL, D), 0.05),
        'w_in': nrm(ks[8], (NL, D, IN_WIDTH), D ** -0.5),
        'hy_conv_w': nrm(ks[9], (NL, 3, 3 * W), 3 ** -0.5),
        'hy_conv_b': nrm(ks[10], (NL, 3 * W), 0.02),
        'hy_w1': nrm(ks[11], (NL, HY_EMB, HY_HIDDEN), HY_EMB ** -0.5),
        'hy_b1': nrm(ks[12], (NL, HY_HIDDEN), 0.1),
        'hy_w2': nrm(ks[13], (NL, HY_HIDDEN, HY_HIDDEN), HY_HIDDEN ** -0.5),
        'hy_b2': nrm(ks[14], (NL, HY_HIDDEN), 0.1),
        'hy_w3': nrm(ks[15], (NL, HY_HIDDEN, HY_ORDER * 2 * W), 0.01),
        'hy_freq': 1.0 + nrm(ks[16], (NL, HY_HIDDEN), 0.1),
        'hy_skip': nrm(ks[17], (NL, HY_ORDER, W), 0.5),
        'wa_sink': nrm(ks[18], (NL, N_WA_HEADS), 0.5),
        'pool_w': nrm(ks[19], (NL, len(POOL_WINDOWS), POOL_GROUP, POOL_GROUP), POOL_GROUP ** -0.5),
        'pool_scale': 1.0 + nrm(ks[20], (NL, W), 0.1),
        'na_rpb': nrm(ks[21], (NL, N_NA_HEADS, 2 * NA_ROWS - 1, 2 * NA_COLS - 1), 0.2),
        'w_out': nrm(ks[22], (NL, MIX_WIDTH, D), MIX_WIDTH ** -0.5),
        'router_w': nrm(ks[23], (NL, D, E), D ** -0.5),
        'exp_w_gate': nrm(ks[24], (NL, E, D, F), D ** -0.5),
        'exp_w_up': nrm(ks[25], (NL, E, D, F), D ** -0.5),
        'exp_w_down': nrm(ks[26], (NL, E, F, D), F ** -0.5),
        'final_norm_g': 1.0 + nrm(ks[27], (D,), 0.05),
    }


def reference(x, c, ctx, c_ctx, ada_w, ada_b, norm1_g, norm2_g, w_in, hy_conv_w, hy_conv_b, hy_w1, hy_b1,
              hy_w2, hy_b2, hy_w3, hy_freq, hy_skip, wa_sink, pool_w, pool_scale, na_rpb, w_out, router_w,
              exp_w_gate, exp_w_up, exp_w_down, final_norm_g):
    for l in range(DEPTH):
        x, ctx = _layer(x, ctx, c, c_ctx, ada_w[l], ada_b[l], norm1_g[l], norm2_g[l], w_in[l],
                        hy_conv_w[l], hy_conv_b[l], hy_w1[l], hy_b1[l], hy_w2[l], hy_b2[l], hy_w3[l],
                        hy_freq[l], hy_skip[l], wa_sink[l], pool_w[l], pool_scale[l], na_rpb[l], w_out[l],
                        router_w[l], exp_w_gate[l], exp_w_up[l], exp_w_down[l],
                        update_ctx=(l < DEPTH - 1))
    return _rmsnorm(x, final_norm_g)
```

```cpp
#include <hip/hip_runtime.h>
#include <hip/hip_cooperative_groups.h>
#include <cstdio>
#include <cstdint>
namespace cg = cooperative_groups;
namespace pg8 {
#define PG8_LAS __attribute__((address_space(3)))
typedef unsigned short bf16_t;
typedef short bf16x8 __attribute__((ext_vector_type(8)));
typedef float f32x4 __attribute__((ext_vector_type(4)));
typedef unsigned u32x4 __attribute__((ext_vector_type(4)));
constexpr int BM = 256, BK = 64, HALF = 128, HTB = HALF * BK * 2  , STAGE_BYTES = 8 * HTB, NXCD = 8, WGM = 8;

__host__ __device__ __forceinline__ int lds_byte(int r, int c) { const int st = (r >> 4) * 2 + (c >> 5), rr = r & 15, cc = c & 31, ob = rr * 64 + cc * 2; return st * 1024 + (ob ^ (((ob >> 9) & 1) << 5)); }
__host__ __device__ __forceinline__ void stage_rc(int b, int& R, int& C) { const int st = b / 1024, sb = b % 1024, swz = sb ^ (((sb >> 9) & 1) << 5); R = (st >> 1) * 16 + swz / 64; C = (st & 1) * 32 + (swz % 64) / 2; }
__host__ __device__ __forceinline__ int perm32(int rho) { const int n = rho >> 4, i = rho & 15; return 8 * (i >> 2) + 4 * n + (i & 3); }

struct Unit { int pm, pn; };
struct Gemm { const bf16_t* A; const bf16_t* Bt; int M, N, K; };

struct StaticOrder {
    int nM, nN, nwg, G, c;
    __host__ __device__ void init(int M, int N, int G_, int c_) { nM = M / BM; nN = N / BM; nwg = nM * nN; G = G_; c = c_; }
    __host__ __device__ bool next(int i, Unit& u) const {
        const long L = (long)i * G + c; if (L >= nwg) return false;
        int wgid = (int)L; { const int q = nwg / NXCD, r = nwg % NXCD, xcd = wgid % NXCD, off = wgid / NXCD; wgid = (xcd < r ? xcd * (q + 1) : r * (q + 1) + (xcd - r) * q) + off; }
        const int nig = WGM * nN, gid = wgid / nig, fm = gid * WGM, gsz = (nM - fm) < WGM ? (nM - fm) : WGM;
        u.pm = fm + ((wgid % nig) % gsz); u.pn = (wgid % nig) / gsz; return true;
    }
    __device__ __forceinline__ void a_ready(const Unit&) const {}
    __device__ __forceinline__ void done(const Unit&) const {}
};

__device__ __forceinline__ unsigned cvt_pk_bf16(float lo, float hi) { unsigned r; asm volatile("v_cvt_pk_bf16_f32 %0, %1, %2" : "=v"(r) : "v"(lo), "v"(hi)); return r; }
typedef float f32x2 __attribute__((ext_vector_type(2)));
__device__ __forceinline__ f32x2 gelu_pk(f32x2 v) {
    const f32x2 av = __builtin_elementwise_abs(v), d = av * 0.2316418882f + 1.0f;
    f32x2 t; t.x = __builtin_amdgcn_rcpf(d.x); t.y = __builtin_amdgcn_rcpf(d.y);
    f32x2 q = t * 0.5307027145f + (-0.7265760135f); q = q * t + 0.7107068705f; q = q * t + (-0.142248368f); q = q * t + 0.127414796f; q = q * t;
    const f32x2 s = (v * v) * (-0.72134752044f);
    f32x2 e; e.x = __builtin_amdgcn_exp2f(s.x); e.y = __builtin_amdgcn_exp2f(s.y);
    const f32x2 m = v * (q * e), r = v - m;
    f32x2 o; o.x = v.x < 0.f ? m.x : r.x; o.y = v.y < 0.f ? m.y : r.y; return o;
}


struct GroupOrder {
    int nMl, nNl, strideM, nper, nwg, G, c;
    __device__ void init(int ng, int nMl_, int nNl_, int strideM_, int G_, int c_) { nMl = nMl_; nNl = nNl_; strideM = strideM_; nper = nMl_ * nNl_; nwg = ng * nper; G = G_; c = c_; }
    __device__ bool next(int i, Unit& u) const {
        const long L = (long)i * G + c; if (L >= nwg) return false;
        int wgid = (int)L; { const int q = nwg / NXCD, r = nwg % NXCD, xcd = wgid % NXCD, off = wgid / NXCD; wgid = (xcd < r ? xcd * (q + 1) : r * (q + 1) + (xcd - r) * q) + off; }
        const int e = wgid / nper, id = wgid % nper;
        const int nig = WGM * nNl, gid = id / nig, fm = gid * WGM, gsz = (nMl - fm) < WGM ? (nMl - fm) : WGM;
        u.pm = e * strideM + fm + ((id % nig) % gsz); u.pn = e * nNl + (id % nig) / gsz; return true;
    }
    __device__ __forceinline__ void a_ready(const Unit&) const {}
    __device__ __forceinline__ void done(const Unit&) const {}
};

constexpr int TXR = 32768;
struct EpiIn {
    static constexpr bool PERM = true, AFTER_DRAIN = false;
    bf16_t* PX; const float* rope;
    __device__ __forceinline__ void operator()(const f32x4 (&acc)[2][2][4][2], const Unit& u, int wr, int wc, int fr, int fq) const {
        const int row0 = u.pm * BM + wr * 64 + fr; const int col0 = u.pn * BM + wc * 32 + 8 * fq;
        const bool latent = u.pm < (TXR / BM);
#pragma unroll
        for (int ai = 0; ai < 2; ++ai)
#pragma unroll
            for (int m = 0; m < 4; ++m) { const int row = row0 + ai * HALF + m * 16; bf16_t* rowp = PX + (size_t)row * 2304 + col0;
#pragma unroll
                for (int bj = 0; bj < 2; ++bj) { f32x4 v0 = acc[ai][bj][m][0], v1 = acc[ai][bj][m][1];
                    const bool dorope = latent && (u.pn == 4 || (u.pn == 6 && bj == 0));
                    if (dorope) {
                        const int t = row & 4095; const int pos = (wc & 1) ? (t & 63) : (t >> 6);
                        const f32x4* rp = (const f32x4*)(rope + (pos * 16 + 8 * (fq & 1)) * 2);
                        const f32x4 r0 = rp[0], r1 = rp[1], r2 = rp[2], r3 = rp[3];
                        f32x4 p0, p1;
#pragma unroll
                        for (int j = 0; j < 4; ++j) { p0[j] = __shfl_xor(v0[j], 32); p1[j] = __shfl_xor(v1[j], 32); }
                        const float c0[4] = {r0[0], r0[2], r1[0], r1[2]}, s0[4] = {r0[1], r0[3], r1[1], r1[3]};
                        const float c1[4] = {r2[0], r2[2], r3[0], r3[2]}, s1[4] = {r2[1], r2[3], r3[1], r3[3]};
                        const bool lo = fq < 2;
#pragma unroll
                        for (int j = 0; j < 4; ++j) {
                            v0[j] = lo ? (v0[j] * c0[j] - p0[j] * s0[j]) : (p0[j] * s0[j] + v0[j] * c0[j]);
                            v1[j] = lo ? (v1[j] * c1[j] - p1[j] * s1[j]) : (p1[j] * s1[j] + v1[j] * c1[j]); }
                    }
                    u32x4 w; w.x = cvt_pk_bf16(v0[0], v0[1]); w.y = cvt_pk_bf16(v0[2], v0[3]); w.z = cvt_pk_bf16(v1[0], v1[1]); w.w = cvt_pk_bf16(v1[2], v1[3]);
                    *(u32x4*)(rowp + bj * HALF) = w; } }
    }
};
struct EpiOut {
    static constexpr bool PERM = false, AFTER_DRAIN = false;
    const float* xold_x; const float* xold_c; float* dst_x; float* dst_c; const float* mod;
    __device__ __forceinline__ void operator()(const f32x4 (&acc)[2][2][4][2], const Unit& u, int wr, int wc, int fr, int fq) const {
        const int row0 = u.pm * BM + wr * 64 + fr, col0 = u.pn * BM + wc * 32 + 4 * fq;
        const bool latent = u.pm < (TXR / BM);
#pragma unroll
        for (int ai = 0; ai < 2; ++ai)
#pragma unroll
            for (int m = 0; m < 4; ++m) { const int row = row0 + ai * HALF + m * 16;
                const int mrow = latent ? (row >> 12) : 8; const float* gp = mod + mrow * 6144 + 2 * 1024 + col0;
                const size_t off = latent ? (size_t)row * 1024 + col0 : (size_t)(row - TXR) * 1024 + col0;
                const float* xo = (latent ? xold_x : xold_c) + off; float* xd = (latent ? dst_x : dst_c) + off;
#pragma unroll
                for (int bj = 0; bj < 2; ++bj)
#pragma unroll
                    for (int n = 0; n < 2; ++n) { const f32x4 g = *(const f32x4*)(gp + bj * HALF + n * 16), xv = *(const f32x4*)(xo + bj * HALF + n * 16);
                        *(f32x4*)(xd + bj * HALF + n * 16) = xv + g * acc[ai][bj][m][n]; } }
    }
};
struct EpiGU {
    static constexpr bool PERM = true, AFTER_DRAIN = false;
    bf16_t* ACT;
    __device__ __forceinline__ void operator()(const f32x4 (&acc)[2][2][4][2], const Unit& u, int wr, int wc, int fr, int fq) const {
        const int row0 = u.pm * BM + wr * 64 + fr; const int col0 = (u.pn & 15) * 128 + wc * 32 + 8 * fq;
#pragma unroll
        for (int ai = 0; ai < 2; ++ai)
#pragma unroll
            for (int m = 0; m < 4; ++m) { bf16_t* rowp = ACT + (size_t)(row0 + ai * HALF + m * 16) * 2048 + col0;
                f32x4 h[2];
#pragma unroll
                for (int n = 0; n < 2; ++n)
#pragma unroll
                    for (int j = 0; j < 4; ++j) { const float g = acc[ai][0][m][n][j], up = acc[ai][1][m][n][j]; h[n][j] = g / (1.0f + __expf(-g)) * up; }
                u32x4 w; w.x = cvt_pk_bf16(h[0][0], h[0][1]); w.y = cvt_pk_bf16(h[0][2], h[0][3]); w.z = cvt_pk_bf16(h[1][0], h[1][1]); w.w = cvt_pk_bf16(h[1][2], h[1][3]);
                *(u32x4*)rowp = w; }
    }
};
struct EpiDown {
    static constexpr bool PERM = true, AFTER_DRAIN = false;
    bf16_t* OB; const float* gate;
    __device__ __forceinline__ void operator()(const f32x4 (&acc)[2][2][4][2], const Unit& u, int wr, int wc, int fr, int fq) const {
        const int row0 = u.pm * BM + wr * 64 + fr; const int col0 = (u.pn & 3) * BM + wc * 32 + 8 * fq;
#pragma unroll
        for (int ai = 0; ai < 2; ++ai)
#pragma unroll
            for (int m = 0; m < 4; ++m) { const int row = row0 + ai * HALF + m * 16; const float g = gate[row]; bf16_t* rowp = OB + (size_t)row * 1024 + col0;
#pragma unroll
                for (int bj = 0; bj < 2; ++bj) { const f32x4 v0 = acc[ai][bj][m][0] * g, v1 = acc[ai][bj][m][1] * g;
                    u32x4 w; w.x = cvt_pk_bf16(v0[0], v0[1]); w.y = cvt_pk_bf16(v0[2], v0[3]); w.z = cvt_pk_bf16(v1[0], v1[1]); w.w = cvt_pk_bf16(v1[2], v1[3]);
                    *(u32x4*)(rowp + bj * HALF) = w; } }
    }
};

template <class Epi, class Sched, bool ALIGN_EPI = false, bool SP2 = false>
__device__ __forceinline__ void gemm_phase(PG8_LAS unsigned char* lds, const Gemm g, const Sched& S, const Epi& E) {
    int tid_ = threadIdx.x; asm volatile("" : "+v"(tid_));
    const int tid = tid_, wid = __builtin_amdgcn_readfirstlane(tid >> 6), lane = tid & 63, wr = wid >> 2, wc = wid & 3, fr = lane & 15, fq = lane >> 4;
    const int K = g.K, nt = K / BK;
    unsigned voffA[2], voffB[2];
#pragma unroll
    for (int i = 0; i < 2; ++i) { int R, C; stage_rc(tid * 16 + i * 8192, R, C); const int Rb = Epi::PERM ? ((R & ~31) + perm32(R & 31)) : R;
        voffA[i] = (unsigned)(R * K + C) * 2u; voffB[i] = (unsigned)(Rb * K + C) * 2u; }
    const size_t kstep = (size_t)(BK * 2);
    const size_t hstep = (size_t)HALF * K * 2;
    const size_t tstep = 2 * hstep;
    const unsigned ldsw = (unsigned)wid * 1024u;
    const int aoff = lds_byte(wr * 64 + fr, fq * 8), boff = lds_byte(wc * 32 + fr, fq * 8);
#define PG8_SA(b, h) (((b) * 2 + (h)) * HTB)
#define PG8_SB(b, h) ((4 + (b) * 2 + (h)) * HTB)
#define PG8_STAGE(bufoff, gbase, voff) do { _Pragma("unroll") for (int _i = 0; _i < 2; ++_i) \
        __builtin_amdgcn_global_load_lds((const unsigned*)((const char*)(gbase) + (voff)[_i]), (PG8_LAS unsigned*)(lds + (bufoff) + ldsw + _i * 8192), 16, 0, 0); } while (0)
#define PG8_LDA(dst, b, h) do { _Pragma("unroll") for (int m = 0; m < 4; ++m) _Pragma("unroll") for (int k = 0; k < 2; ++k) dst[m][k] = *(const PG8_LAS bf16x8*)(lds + PG8_SA(b, h) + aoff + m * 2048 + k * 1024); } while (0)
#define PG8_LDB(dst, b, h) do { _Pragma("unroll") for (int n = 0; n < 2; ++n) _Pragma("unroll") for (int k = 0; k < 2; ++k) dst[n][k] = *(const PG8_LAS bf16x8*)(lds + PG8_SB(b, h) + boff + n * 2048 + k * 1024); } while (0)
#define PG8_MMA(ai, bj, At, Bt) do { __builtin_amdgcn_s_setprio(1); _Pragma("unroll") for (int m = 0; m < 4; ++m) _Pragma("unroll") for (int n = 0; n < 2; ++n) _Pragma("unroll") for (int k = 0; k < 2; ++k) \
        acc[ai][bj][m][n] = __builtin_amdgcn_mfma_f32_16x16x32_bf16(Bt[n][k], At[m][k], acc[ai][bj][m][n], 0, 0, 0); __builtin_amdgcn_s_setprio(0); } while (0)
#define PG8_WAIT_V(n) asm volatile("s_waitcnt vmcnt(" #n ")" ::: "memory")
#define PG8_WAIT_L(n) asm volatile("s_waitcnt lgkmcnt(" #n ")" ::: "memory")
#define PG8_BAR __builtin_amdgcn_s_barrier()
#define PG8_SCHED __builtin_amdgcn_sched_barrier(0)
    Unit cur, nxt; int ui = 0;
    if (!S.next(0, cur)) return;
    f32x4 acc[2][2][4][2];
#pragma unroll
    for (int a = 0; a < 2; ++a)
#pragma unroll
        for (int b = 0; b < 2; ++b)
#pragma unroll
            for (int m = 0; m < 4; ++m)
#pragma unroll
                for (int n = 0; n < 2; ++n) acc[a][b][m][n] = (f32x4){0.f, 0.f, 0.f, 0.f};
    bf16x8 At[4][2], B0[2][2], B1[2][2];
    const char* cA = (const char*)g.A + (size_t)cur.pm * tstep; const char* cB = (const char*)g.Bt + (size_t)cur.pn * tstep;
    S.a_ready(cur);
    if constexpr (SP2) {
        PG8_STAGE(PG8_SB(0, 0), cB, voffB); PG8_STAGE(PG8_SB(0, 1), cB + hstep, voffB); PG8_STAGE(PG8_SA(0, 0), cA, voffA); PG8_STAGE(PG8_SA(0, 1), cA + hstep, voffA);
        if (wr == 1) PG8_BAR;
        PG8_WAIT_V(2); PG8_BAR;
        PG8_STAGE(PG8_SB(1, 0), cB + kstep, voffB); PG8_STAGE(PG8_SA(1, 0), cA + kstep, voffA); PG8_STAGE(PG8_SB(1, 1), cB + hstep + kstep, voffB);
        PG8_WAIT_V(6); PG8_BAR;
    } else {
        PG8_STAGE(PG8_SB(0, 0), cB, voffB); PG8_STAGE(PG8_SA(0, 0), cA, voffA); PG8_STAGE(PG8_SB(0, 1), cB + hstep, voffB); PG8_STAGE(PG8_SA(0, 1), cA + hstep, voffA);
        if (wr == 1) PG8_BAR;
        PG8_WAIT_V(4); PG8_BAR;
        PG8_STAGE(PG8_SB(1, 0), cB + kstep, voffB); PG8_STAGE(PG8_SA(1, 0), cA + kstep, voffA); PG8_STAGE(PG8_SB(1, 1), cB + hstep + kstep, voffB);
        PG8_WAIT_V(6); PG8_BAR;
    }
    for (;;) {
        const bool has_next = S.next(ui + 1, nxt);
        const char* nA = has_next ? (const char*)g.A + (size_t)nxt.pm * tstep : cA; const char* nB = has_next ? (const char*)g.Bt + (size_t)nxt.pn * tstep : cB;
        for (int t = 0; t < nt; t += 2) {
            const bool last = (t == nt - 2);
            const char* a1 = cA + (size_t)(t + 1) * kstep;
            const char* a2 = last ? nA : cA + (size_t)(t + 2) * kstep; const char* b2 = last ? nB : cB + (size_t)(t + 2) * kstep;
            const char* a3 = a2 + kstep; const char* b3 = b2 + kstep;
            if (last && has_next) S.a_ready(nxt);
            if constexpr (SP2) {
            PG8_LDB(B0, 0, 0); PG8_LDB(B1, 0, 1); PG8_SCHED; PG8_LDA(At, 0, 0); PG8_STAGE(PG8_SA(1, 1), a1 + hstep, voffA);
            PG8_WAIT_V(8); PG8_WAIT_L(0); PG8_BAR; PG8_MMA(0, 0, At, B0); PG8_MMA(0, 1, At, B1); PG8_BAR; PG8_SCHED;
            PG8_LDA(At, 0, 1); PG8_STAGE(PG8_SB(0, 0), b2, voffB); PG8_STAGE(PG8_SB(0, 1), b2 + hstep, voffB); PG8_STAGE(PG8_SA(0, 0), a2, voffA);
            PG8_WAIT_V(8); PG8_WAIT_L(0); PG8_BAR; PG8_MMA(1, 0, At, B0); PG8_MMA(1, 1, At, B1); PG8_BAR; PG8_SCHED;
            PG8_LDB(B0, 1, 0); PG8_LDB(B1, 1, 1); PG8_SCHED; PG8_LDA(At, 1, 0); PG8_STAGE(PG8_SA(0, 1), a2 + hstep, voffA);
            PG8_WAIT_V(8); PG8_WAIT_L(0); PG8_BAR; PG8_MMA(0, 0, At, B0); PG8_MMA(0, 1, At, B1); PG8_BAR; PG8_SCHED;
            PG8_LDA(At, 1, 1); PG8_STAGE(PG8_SB(1, 0), b3, voffB); PG8_STAGE(PG8_SB(1, 1), b3 + hstep, voffB); PG8_STAGE(PG8_SA(1, 0), a3, voffA);
            PG8_WAIT_V(8); PG8_WAIT_L(0); PG8_BAR; PG8_MMA(1, 0, At, B0); PG8_MMA(1, 1, At, B1); PG8_BAR; PG8_SCHED;
            } else {
            PG8_LDB(B0, 0, 0); PG8_SCHED; PG8_LDA(At, 0, 0); PG8_STAGE(PG8_SA(1, 1), a1 + hstep, voffA);
            PG8_WAIT_L(8); PG8_BAR; PG8_WAIT_L(0); PG8_MMA(0, 0, At, B0); PG8_BAR; PG8_SCHED;
            PG8_LDB(B1, 0, 1); PG8_STAGE(PG8_SB(0, 0), b2, voffB);
            PG8_BAR; PG8_WAIT_L(0); PG8_MMA(0, 1, At, B1); PG8_BAR;
            PG8_LDA(At, 0, 1); PG8_STAGE(PG8_SA(0, 0), a2, voffA);
            PG8_BAR; PG8_WAIT_L(0); PG8_MMA(1, 0, At, B0); PG8_BAR; PG8_SCHED;
            PG8_STAGE(PG8_SB(0, 1), b2 + hstep, voffB);
            PG8_WAIT_V(6); PG8_BAR; PG8_MMA(1, 1, At, B1); PG8_BAR;
            PG8_LDB(B0, 1, 0); PG8_SCHED; PG8_LDA(At, 1, 0); PG8_STAGE(PG8_SA(0, 1), a2 + hstep, voffA);
            PG8_WAIT_L(8); PG8_BAR; PG8_WAIT_L(0); PG8_MMA(0, 0, At, B0); PG8_BAR; PG8_SCHED;
            PG8_LDB(B1, 1, 1); PG8_STAGE(PG8_SB(1, 0), b3, voffB);
            PG8_BAR; PG8_WAIT_L(0); PG8_MMA(0, 1, At, B1); PG8_BAR;
            PG8_LDA(At, 1, 1); PG8_STAGE(PG8_SA(1, 0), a3, voffA);
            PG8_BAR; PG8_WAIT_L(0); PG8_MMA(1, 0, At, B0); PG8_BAR; PG8_SCHED;
            PG8_STAGE(PG8_SB(1, 1), b3 + hstep, voffB);
            PG8_WAIT_V(6); PG8_BAR; PG8_MMA(1, 1, At, B1); PG8_BAR;
            }
        }
        if constexpr (ALIGN_EPI) { if (wr == 0) PG8_BAR; }
        if constexpr (!Epi::AFTER_DRAIN) { E(acc, cur, wr, wc, fr, fq); S.done(cur); }
        if (!has_next) break;
#pragma unroll
        for (int a = 0; a < 2; ++a)
#pragma unroll
            for (int b = 0; b < 2; ++b)
#pragma unroll
                for (int m = 0; m < 4; ++m)
#pragma unroll
                    for (int n = 0; n < 2; ++n) acc[a][b][m][n] = (f32x4){0.f, 0.f, 0.f, 0.f};
        cur = nxt; cA = nA; cB = nB; ++ui;
        if constexpr (ALIGN_EPI) { if (wr == 1) PG8_BAR; }
    }
    PG8_WAIT_V(0);
    if constexpr (!ALIGN_EPI) { if (wr == 0) PG8_BAR; }
    PG8_BAR;
    if constexpr (Epi::AFTER_DRAIN) { E.fused(acc, cur, wr, wc, fr, fq, lds, wid, lane); S.done(cur); }
#undef PG8_SA
#undef PG8_SB
#undef PG8_STAGE
#undef PG8_LDA
#undef PG8_LDB
#undef PG8_MMA
#undef PG8_WAIT_V
#undef PG8_WAIT_L
#undef PG8_BAR
#undef PG8_SCHED
}
}

#define LAS __attribute__((address_space(3)))
typedef unsigned short bf16_t;
typedef float f32x4 __attribute__((ext_vector_type(4)));
typedef unsigned u32x4 __attribute__((ext_vector_type(4)));
typedef unsigned u32x2 __attribute__((ext_vector_type(2)));
typedef __bf16 bf16x2_t __attribute__((ext_vector_type(2)));
constexpr int NWAVES = 8, NTHR = 512;
constexpr int D = 1024, NB = 8, SEQ = 4096, LCTX = 256, TX = NB * SEQ, TC = NB * LCTX, TT = TX + TC, INW = 2304, NE = 16, FF = 2048;
constexpr int CAPX = 512, CAPC = 32, SLOTS = NB * CAPX + NB * CAPC;
constexpr float LOG2E = 1.4426950408889634f;
constexpr int LDS_BYTES = 147456;
enum { I_X = 0, I_C, I_CTX, I_CCTX, I_ADAW, I_ADAB, I_N1G, I_N2G, I_WIN, I_HCW, I_HCB, I_HW1, I_HB1, I_HW2, I_HB2, I_HW3, I_HFREQ, I_HSKIP, I_SINK, I_POOLW, I_POOLS, I_RPB, I_WOUT, I_ROUTER, I_WG, I_WU, I_WD, I_FNG, N_IN };
constexpr size_t MiB = 1u << 20;
constexpr size_t WS_MOD = 1 * MiB;
constexpr size_t WS_ROPE = 2 * MiB;
constexpr size_t WS_WIN_T = 3 * MiB;
constexpr size_t WS_WOUT_T = 13 * MiB;
constexpr size_t WS_HC = 17 * MiB;
constexpr size_t WS_HCC = 51 * MiB;
constexpr size_t WS_AFFT = 53 * MiB;
constexpr size_t WS_ROWMAP = 56 * MiB;
constexpr size_t WS_GATE = 57 * MiB;
constexpr size_t WS_INV = 58 * MiB;
constexpr size_t WS_CRES = 61 * MiB;
constexpr size_t WS_HX = 69 * MiB;
constexpr size_t WS_WGU_T = 137 * MiB;
constexpr size_t WS_WD_T = 393 * MiB;
constexpr size_t WS_R = 521 * MiB;
constexpr size_t WS_ACT = WS_R;
constexpr size_t WS_XG = WS_R + 272 * MiB;
constexpr size_t WS_PX = WS_R;
constexpr size_t WS_Y = WS_R + 153 * MiB;
constexpr size_t WS_UC = WS_XG;
constexpr size_t WS_Z1 = WS_XG + 102 * MiB;
constexpr size_t WS_END = WS_R + 408 * MiB;
static_assert(WS_END <= 1024 * MiB, "workspace map");

struct Args { const float* in[N_IN]; float* out; unsigned char* ws; };

__device__ __forceinline__ float bf2f(unsigned short v) { return __uint_as_float(((unsigned)v) << 16); }
__device__ __forceinline__ unsigned f2bf(float f) { unsigned u = __float_as_uint(f); return (u + 0x7fffu + ((u >> 16) & 1u)) >> 16; }
__device__ __forceinline__ unsigned pk2(float lo, float hi) { return f2bf(lo) | (f2bf(hi) << 16); }
__device__ __forceinline__ float bflo(unsigned w) { return __uint_as_float(w << 16); }
__device__ __forceinline__ float bfhi(unsigned w) { return __uint_as_float(w & 0xffff0000u); }
__device__ __forceinline__ float dot2bf(unsigned a, unsigned b, float acc) { return __builtin_amdgcn_fdot2_f32_bf16(__builtin_bit_cast(bf16x2_t, a), __builtin_bit_cast(bf16x2_t, b), acc, false); }
__device__ __forceinline__ float wave_sum(float v) {
#pragma unroll
    for (int o = 1; o < 64; o <<= 1) v += __shfl_xor(v, o);
    return v;
}
#define LDS_WAIT() asm volatile("s_waitcnt lgkmcnt(0)" ::: "memory")

__device__ __forceinline__ void tr_item(const float* W, int K, int N, bf16_t* WT, int Kt, int item, int mode, LAS float* scr, int lane) {
    const int nblk = N / 32, kb = item / nblk, nb = item % nblk, k0 = 64 * kb, n0 = 32 * nb;
#pragma unroll 8
    for (int i = 0; i < 32; ++i) { const int kk = 2 * i + (lane >> 5); scr[kk * 33 + (lane & 31)] = W[(size_t)(k0 + kk) * N + n0 + (lane & 31)]; }
    LDS_WAIT();
    const int c = lane & 7;
    const int drow0 = (mode == 0) ? n0 : ((n0 >> 7) * 256 + (n0 & 127) + (mode == 2 ? 128 : 0));
#pragma unroll
    for (int j = 0; j < 4; ++j) { const int n = (lane >> 3) + 8 * j; const LAS float* s = scr + (8 * c) * 33 + n;
        u32x4 o; o.x = pk2(s[0 * 33], s[1 * 33]); o.y = pk2(s[2 * 33], s[3 * 33]); o.z = pk2(s[4 * 33], s[5 * 33]); o.w = pk2(s[6 * 33], s[7 * 33]);
        *(u32x4*)(WT + (size_t)(drow0 + n) * Kt + k0 + 8 * c) = o; }
    LDS_WAIT();
}

__device__ __forceinline__ void filter_pos(const Args& a, int l, int L, int p, float* HCdst, int lane) {
    const float* w1 = a.in[I_HW1] + l * 33 * 64; const float* b1 = a.in[I_HB1] + l * 64; const float* w2 = a.in[I_HW2] + l * 64 * 64; const float* b2 = a.in[I_HB2] + l * 64;
    const float* w3 = a.in[I_HW3] + l * 64 * 1024; const float* fr = a.in[I_HFREQ] + l * 64;
    const float tn = (float)p / (float)(L - 1);
    float fv = 0.f;
    if (lane == 0) fv = tn;
    else if (lane <= 32) { const int bi = (lane - 1) & 15; const float band = 1e-4f + (float)bi * ((15.0f - 1e-4f) / 15.0f);
        const float ang = ((float)(6.283185307179586 / (double)L) * (float)p) * band; fv = (lane <= 16) ? cosf(ang) : -sinf(ang); }
    float a1 = b1[lane];
    for (int i = 0; i < 33; ++i) a1 += __shfl(fv, i) * w1[i * 64 + lane];
    const float frq = fr[lane];
    const float h1 = sinf(frq * a1);
    float a2 = b2[lane];
    for (int i = 0; i < 64; ++i) a2 += __shfl(h1, i) * w2[i * 64 + lane];
    const float h2 = sinf(frq * a2);
    float o[16];
#pragma unroll
    for (int q = 0; q < 16; ++q) o[q] = 0.f;
    for (int i = 0; i < 64; ++i) { const float hv = __shfl(h2, i);
#pragma unroll
        for (int q = 0; q < 16; ++q) o[q] += hv * w3[i * 1024 + q * 64 + lane]; }
    const float dmin = 3.0701134573253945f, dmax = 15.350567286626972f;
#pragma unroll
    for (int ord = 0; ord < 2; ++ord)
#pragma unroll
        for (int cs = 0; cs < 4; ++cs) { const int c = cs * 64 + lane; const float delta = dmin + (float)c * ((dmax - dmin) / 255.0f); const float win = expf(-tn * delta);
            const float vf = o[ord * 8 + cs] * win, vb = o[ord * 8 + 4 + cs] * win;
            float* base = HCdst + (size_t)ord * (2 * L - 1) * 256;
            if (p == 0) base[(size_t)(L - 1) * 256 + c] = vf + vb;
            else { base[(size_t)(L - 1 + p) * 256 + c] = vf; base[(size_t)(L - 1 - p) * 256 + c] = vb; } }
}

__device__ __forceinline__ void phase_prologue(const Args& a, unsigned char* ldsg, int vcu, int G) {
    LAS unsigned char* lds = (LAS unsigned char*)ldsg;
    int tid_ = threadIdx.x; asm volatile("" : "+v"(tid_));
    const int tid = tid_, lane = tid & 63, wave = __builtin_amdgcn_readfirstlane(tid >> 6);
    unsigned char* ws = a.ws;
    LAS float* sc = (LAS float*)lds; LAS float* red = (LAS float*)(lds + 36864);
    for (int i = tid; i < 9 * 1024; i += NTHR) { const float v = (i < 8192) ? a.in[I_C][i] : a.in[I_CCTX][i - 8192]; sc[i] = v / (1.0f + expf(-v)); }
    __syncthreads();
    float* MOD = (float*)(ws + WS_MOD);
    for (int item = vcu; item < 2 * 96; item += G) {
        const int l = item / 96, n0 = (item % 96) * 64, col = tid & 63, kg = tid >> 6;
        float acc[9];
#pragma unroll
        for (int r = 0; r < 9; ++r) acc[r] = 0.f;
        const float* w = a.in[I_ADAW] + (size_t)l * 1024 * 6144 + n0 + col;
#pragma unroll 4
        for (int k = kg * 128; k < kg * 128 + 128; ++k) { const float wv = w[(size_t)k * 6144];
#pragma unroll
            for (int r = 0; r < 9; ++r) acc[r] += sc[r * 1024 + k] * wv; }
#pragma unroll
        for (int r = 0; r < 9; ++r) red[(kg * 9 + r) * 64 + col] = acc[r];
        __syncthreads();
        for (int o = tid; o < 9 * 64; o += NTHR) { const int r = o >> 6, cc = o & 63; float s = 0.f;
#pragma unroll
            for (int g2 = 0; g2 < 8; ++g2) s += red[(g2 * 9 + r) * 64 + cc];
            MOD[(size_t)(l * 9 + r) * 6144 + n0 + cc] = s + a.in[I_ADAB][l * 6144 + n0 + cc]; }
        __syncthreads();
    }
    if (vcu == 0) { float* ROPE = (float*)(ws + WS_ROPE);
        for (int i = tid; i < 1024; i += NTHR) { const int pos = i >> 4, fi = i & 15; const float inv = powf(10000.0f, -(float)fi / 16.0f); const float ang = (float)pos * inv;
            ROPE[2 * i] = cosf(ang); ROPE[2 * i + 1] = sinf(ang); } }
    const int gw = vcu * NWAVES + wave, NGW = G * NWAVES;
    for (int it = gw; it < 8448; it += NGW) {
        if (it < 4096) filter_pos(a, 0, 4096, it, (float*)(ws + WS_HC), lane);
        else if (it < 8192) filter_pos(a, 1, 4096, it - 4096, (float*)(ws + WS_HC) + (size_t)2 * 8191 * 256, lane);
        else filter_pos(a, 0, 256, it - 8192, (float*)(ws + WS_HCC), lane);
    }
    LAS float* scr = (LAS float*)(lds + 65536 + wave * 8448);
    constexpr int IT_IN = 16 * 72, IT_OUT = 16 * 32, IT_E = 1024, IT_LAYER = IT_IN + IT_OUT + 3 * 16 * IT_E;
    for (int it = gw; it < 2 * IT_LAYER; it += NGW) {
        const int l = it / IT_LAYER; int r = it % IT_LAYER;
        if (r < IT_IN) { tr_item(a.in[I_WIN] + (size_t)l * 1024 * 2304, 1024, 2304, (bf16_t*)(ws + WS_WIN_T) + (size_t)l * 2304 * 1024, 1024, r, 0, scr, lane); continue; } r -= IT_IN;
        if (r < IT_OUT) { tr_item(a.in[I_WOUT] + (size_t)l * 1024 * 1024, 1024, 1024, (bf16_t*)(ws + WS_WOUT_T) + (size_t)l * 1024 * 1024, 1024, r, 0, scr, lane); continue; } r -= IT_OUT;
        const int which = r / (16 * IT_E), e = (r / IT_E) & 15, ri = r % IT_E; const size_t le = (size_t)l * 16 + e;
        if (which == 0) tr_item(a.in[I_WG] + le * 1024 * 2048, 1024, 2048, (bf16_t*)(ws + WS_WGU_T) + le * 4096 * 1024, 1024, ri, 1, scr, lane);
        else if (which == 1) tr_item(a.in[I_WU] + le * 1024 * 2048, 1024, 2048, (bf16_t*)(ws + WS_WGU_T) + le * 4096 * 1024, 1024, ri, 2, scr, lane);
        else tr_item(a.in[I_WD] + le * 2048 * 1024, 2048, 1024, (bf16_t*)(ws + WS_WD_T) + le * 1024 * 2048, 2048, ri, 0, scr, lane);
    }
}

__device__ __forceinline__ void phase_norm(const Args& a, unsigned char* ldsg, int vcu, int G, int l, const float* srcx, const float* srcc, const float* gain, int shift_idx, int nrows, bool router) {
    int tid_ = threadIdx.x; asm volatile("" : "+v"(tid_));
    const int tid = tid_, lane = tid & 63, wave = __builtin_amdgcn_readfirstlane(tid >> 6);
    unsigned char* ws = a.ws; const float* MOD = (const float*)(ws + WS_MOD) + (size_t)l * 9 * 6144; bf16_t* HX = (bf16_t*)(ws + WS_HX);
    LAS float* rw = (LAS float*)(LAS unsigned char*)ldsg;
    if (router) { const float* rsrc = a.in[I_ROUTER] + (size_t)l * 1024 * 16; for (int i = tid; i < 1024 * 16; i += NTHR) rw[(i & 15) * 1024 + (i >> 4)] = rsrc[i]; __syncthreads(); }
    const int gw = vcu * NWAVES + wave, NGW = G * NWAVES;
    for (int row = gw; row < nrows; row += NGW) {
        const bool lat = row < TX; const float* xr = lat ? srcx + (size_t)row * D : srcc + (size_t)(row - TX) * D; const int mrow = lat ? (row >> 12) : 8;
        const float* shp = MOD + mrow * 6144 + shift_idx * 1024; const float* scp = shp + 1024;
        f32x4 v[4]; float ss = 0.f;
#pragma unroll
        for (int j = 0; j < 4; ++j) { v[j] = *(const f32x4*)(xr + 256 * j + 4 * lane); ss += (v[j][0] * v[j][0] + v[j][1] * v[j][1]) + (v[j][2] * v[j][2] + v[j][3] * v[j][3]); }
        const float rstd = 1.0f / sqrtf(wave_sum(ss) * (1.0f / D) + 1e-6f);
#pragma unroll
        for (int j = 0; j < 4; ++j) { const f32x4 gg = *(const f32x4*)(gain + 256 * j + 4 * lane), sh = *(const f32x4*)(shp + 256 * j + 4 * lane), sc = *(const f32x4*)(scp + 256 * j + 4 * lane);
            v[j] = (v[j] * rstd * gg) * (1.0f + sc) + sh;
            u32x2 o; o.x = pk2(v[j][0], v[j][1]); o.y = pk2(v[j][2], v[j][3]); *(u32x2*)(HX + (size_t)row * D + 256 * j + 4 * lane) = o; }
        if (router) {
            float mylog = -1e30f;
#pragma unroll 1
            for (int e = 0; e < 16; ++e) { float p = 0.f;
#pragma unroll
                for (int j = 0; j < 4; ++j) { const f32x4 wv = *(const LAS f32x4*)(rw + e * 1024 + 256 * j + 4 * lane);
                    p += (v[j][0] * wv[0] + v[j][1] * wv[1]) + (v[j][2] * wv[2] + v[j][3] * wv[3]); }
                p = wave_sum(p); mylog = (lane == e) ? p : mylog; }
            float mx = mylog;
#pragma unroll
            for (int o = 1; o < 16; o <<= 1) mx = fmaxf(mx, __shfl_xor(mx, o));
            const float mine = (lane < 16) ? expf(mylog - mx) : 0.f; float den = mine;
#pragma unroll
            for (int o = 1; o < 16; o <<= 1) den += __shfl_xor(den, o);
            if (lane < 16) { ((float*)(ws + WS_AFFT))[(size_t)lane * TT + row] = mine / den; ((int*)(ws + WS_INV))[(size_t)row * 16 + lane] = -1; }
        }
    }
}

#define PIN16(o, b) asm volatile("" : "+v"(o[b]), "+v"(o[b + 1]), "+v"(o[b + 2]), "+v"(o[b + 3]), "+v"(o[b + 4]), "+v"(o[b + 5]), "+v"(o[b + 6]), "+v"(o[b + 7]), "+v"(o[b + 8]), "+v"(o[b + 9]), "+v"(o[b + 10]), "+v"(o[b + 11]), "+v"(o[b + 12]), "+v"(o[b + 13]), "+v"(o[b + 14]), "+v"(o[b + 15]) :: "memory")
__device__ __forceinline__ void att_chunk(const bf16_t* PX, LAS unsigned char* stg, int kcol, int vcol, int row0, const float (&bias)[8], const unsigned (&q)[32], float& m, float& lsum, float (&o)[64], int lane) {
    { const bf16_t* rp = PX + (size_t)(row0 + (lane >> 3)) * INW + (lane & 7) * 8;
      const u32x4 kv = *(const u32x4*)(rp + kcol), vv = *(const u32x4*)(rp + vcol);
      *(LAS u32x4*)(stg + lane * 16) = kv; *(LAS u32x4*)(stg + 1024 + lane * 16) = vv; }
    LDS_WAIT();
    float s[8];
#pragma unroll
    for (int kk = 0; kk < 8; ++kk) { const LAS u32x4* kp = (const LAS u32x4*)(stg + kk * 128); float d0 = 0.f, d1 = 0.f;
#pragma unroll
        for (int i = 0; i < 8; ++i) { const u32x4 kv = kp[i]; d0 = dot2bf(kv.x, q[4 * i], d0); d1 = dot2bf(kv.y, q[4 * i + 1], d1); d0 = dot2bf(kv.z, q[4 * i + 2], d0); d1 = dot2bf(kv.w, q[4 * i + 3], d1); }
        s[kk] = (bias[kk] > -1e29f) ? (d0 + d1) * (0.125f * LOG2E) + bias[kk] : -1e30f;
        asm volatile("" : "+v"(s[kk]) :: "memory"); }
    float cm = s[0];
#pragma unroll
    for (int kk = 1; kk < 8; ++kk) cm = fmaxf(cm, s[kk]);
    const float mnew = fmaxf(m, cm), corr = __builtin_amdgcn_exp2f(m - mnew);
    lsum *= corr;
#pragma unroll
    for (int d = 0; d < 64; ++d) o[d] *= corr;
    m = mnew;
#pragma unroll
    for (int kk = 0; kk < 8; ++kk) { const float p = (s[kk] > -1e29f) ? __builtin_amdgcn_exp2f(s[kk] - mnew) : 0.f; lsum += p;
        const LAS u32x4* vp = (const LAS u32x4*)(stg + 1024 + kk * 128);
#pragma unroll
        for (int i = 0; i < 8; ++i) { const u32x4 vv = vp[i];
            o[8 * i + 0] += p * bflo(vv.x); o[8 * i + 1] += p * bfhi(vv.x); o[8 * i + 2] += p * bflo(vv.y); o[8 * i + 3] += p * bfhi(vv.y);
            o[8 * i + 4] += p * bflo(vv.z); o[8 * i + 5] += p * bfhi(vv.z); o[8 * i + 6] += p * bflo(vv.w); o[8 * i + 7] += p * bfhi(vv.w); }
        PIN16(o, 0); PIN16(o, 16); PIN16(o, 32); PIN16(o, 48); }
}
template <int MODE>
__device__ __forceinline__ void attn_wave(const Args& a, LAS unsigned char* stg, int l, int item, int lane) {
    const bf16_t* PX = (const bf16_t*)(a.ws + WS_PX); bf16_t* Y = (bf16_t*)(a.ws + WS_Y);
    int b, h, qrow, qcol, kcol, vcol, ycol, t = 0, r = 0, hb = 0;
    if (MODE == 0) { b = item >> 8; h = (item >> 6) & 3; hb = item & 63; t = hb * 64 + lane; qrow = b * 4096 + t; qcol = 1024 + h * 64; kcol = 1536 + (h >> 1) * 64; vcol = 1664 + (h >> 1) * 64; ycol = 256 + h * 64; }
    else if (MODE == 1) { b = item >> 8; h = (item >> 6) & 3; r = item & 63; t = r * 64 + lane; qrow = b * 4096 + t; qcol = 1280 + h * 64; kcol = 1792 + h * 64; vcol = 2048 + h * 64; ycol = 768 + h * 64; }
    else if (MODE == 2) { b = item >> 4; h = (item >> 2) & 3; qrow = TX + b * 256 + (item & 3) * 64 + lane; qcol = 1024 + h * 64; kcol = 1536 + (h >> 1) * 64; vcol = 1664 + (h >> 1) * 64; ycol = 256 + h * 64; }
    else { b = item >> 4; h = (item >> 2) & 3; qrow = TX + b * 256 + (item & 3) * 64 + lane; qcol = 1280 + h * 64; kcol = 1792 + h * 64; vcol = 2048 + h * 64; ycol = 768 + h * 64; }
    unsigned q[32];
    { const u32x4* qp = (const u32x4*)(PX + (size_t)qrow * INW + qcol);
#pragma unroll
      for (int i = 0; i < 8; ++i) { const u32x4 v = qp[i]; q[4 * i] = v.x; q[4 * i + 1] = v.y; q[4 * i + 2] = v.z; q[4 * i + 3] = v.w; } }
    float m = -1e30f, lsum = 0.f; float o[64];
#pragma unroll
    for (int d = 0; d < 64; ++d) o[d] = 0.f;
    float bias[8];
    if (MODE == 0) {
        const int klo = (hb * 64 - 128) > 0 ? (hb * 64 - 128) : 0, khi = (hb * 64 + 191) < 4095 ? (hb * 64 + 191) : 4095;
        for (int j0 = klo; j0 <= khi; j0 += 8) {
#pragma unroll
            for (int kk = 0; kk < 8; ++kk) { const int kp = j0 + kk; const int dd = t - kp; bias[kk] = (dd <= 128 && dd >= -128) ? 0.f : -1e30f; }
            att_chunk(PX, stg, kcol, vcol, b * 4096 + j0, bias, q, m, lsum, o, lane); }
    }
    if (MODE == 1) {
        const int r0 = (r - 4) < 0 ? 0 : ((r - 4) > 56 ? 56 : (r - 4)); const int c = lane; const int wsc = (c - 8) < 0 ? 0 : ((c - 8) > 48 ? 48 : (c - 8));
        const float* rpb = a.in[I_RPB] + (size_t)(l * 4 + h) * 15 * 31;
        for (int kr = 0; kr < 8; ++kr) { const int rk = r0 + kr;
            for (int ck0 = 0; ck0 < 64; ck0 += 8) {
#pragma unroll
                for (int kk = 0; kk < 8; ++kk) { const int ck = ck0 + kk; const bool ok = (ck >= wsc) && (ck < wsc + 16);
                    const int bi = ok ? ((rk - r + 7) * 31 + (ck - c + 15)) : 0; bias[kk] = ok ? rpb[bi] * LOG2E : -1e30f; }
                att_chunk(PX, stg, kcol, vcol, b * 4096 + rk * 64 + ck0, bias, q, m, lsum, o, lane); } }
    }
    for (int j0 = 0; j0 < 256; j0 += 8) {
#pragma unroll
        for (int kk = 0; kk < 8; ++kk) bias[kk] = 0.f;
        att_chunk(PX, stg, kcol, vcol, TX + b * 256 + j0, bias, q, m, lsum, o, lane); }
    if (MODE == 0 || MODE == 2) lsum += __builtin_amdgcn_exp2f(a.in[I_SINK][l * 4 + h] * LOG2E - m);
    const float inv = 1.0f / lsum;
    u32x4* yp = (u32x4*)(Y + (size_t)qrow * D + ycol);
#pragma unroll
    for (int i = 0; i < 8; ++i) { u32x4 w; w.x = pk2(o[8 * i] * inv, o[8 * i + 1] * inv); w.y = pk2(o[8 * i + 2] * inv, o[8 * i + 3] * inv); w.z = pk2(o[8 * i + 4] * inv, o[8 * i + 5] * inv); w.w = pk2(o[8 * i + 6] * inv, o[8 * i + 7] * inv); yp[i] = w; }
}

__device__ __forceinline__ void phase_mix1(const Args& a, unsigned char* ldsg, int vcu, int G, int l) {
    LAS unsigned char* lds = (LAS unsigned char*)ldsg;
    int tid_ = threadIdx.x; asm volatile("" : "+v"(tid_));
    const int tid = tid_, lane = tid & 63, wave = __builtin_amdgcn_readfirstlane(tid >> 6);
    unsigned char* ws = a.ws; const bf16_t* PX = (const bf16_t*)(ws + WS_PX); bf16_t* Y = (bf16_t*)(ws + WS_Y); float* UC = (float*)(ws + WS_UC);
    const bool upd = (l == 0); const int nrows = upd ? TT : TX;
    const int gw = vcu * NWAVES + wave, NGW = G * NWAVES;
    LAS float* pw = (LAS float*)lds; LAS float* dv = (LAS float*)(lds + 65536 + wave * 1024);
    { const float* src = a.in[I_POOLW] + (size_t)l * 4 * 64 * 64; for (int i = tid; i < 4 * 64 * 64; i += NTHR) pw[i] = src[i]; }
    __syncthreads();
    const float* cw = a.in[I_HCW] + (size_t)l * 3 * 768; const float* cb = a.in[I_HCB] + (size_t)l * 768; const float* pscale = a.in[I_POOLS] + (size_t)l * 256;
    for (int row = gw; row < nrows; row += NGW) {
        const bool lat = row < TX; const int tpos = lat ? (row & 4095) : ((row - TX) & 255); const int Ls = lat ? 4096 : 256;
        const bf16_t* pr = PX + (size_t)row * INW;
#pragma unroll
        for (int j = 0; j < 3; ++j) { const int c = 256 * j + 4 * lane;
            const u32x2 cur = *(const u32x2*)(pr + c); u32x2 prv = {0u, 0u}, nxt = {0u, 0u};
            if (tpos > 0) prv = *(const u32x2*)(pr - INW + c);
            if (tpos < Ls - 1) nxt = *(const u32x2*)(pr + INW + c);
            const f32x4 w0 = *(const f32x4*)(cw + c), w1 = *(const f32x4*)(cw + 768 + c), w2 = *(const f32x4*)(cw + 1536 + c), bb = *(const f32x4*)(cb + c);
            f32x4 o; o[0] = bflo(prv.x) * w0[0] + bflo(cur.x) * w1[0] + bflo(nxt.x) * w2[0] + bb[0]; o[1] = bfhi(prv.x) * w0[1] + bfhi(cur.x) * w1[1] + bfhi(nxt.x) * w2[1] + bb[1];
            o[2] = bflo(prv.y) * w0[2] + bflo(cur.y) * w1[2] + bflo(nxt.y) * w2[2] + bb[2]; o[3] = bfhi(prv.y) * w0[3] + bfhi(cur.y) * w1[3] + bfhi(nxt.y) * w2[3] + bb[3];
            *(f32x4*)(UC + (size_t)row * 768 + c) = o; }
        { const int g = lane >> 4, hw = 1 << g;
          const int c = 768 + 4 * lane; float s0 = 0.f, s1 = 0.f, s2 = 0.f, s3 = 0.f; int cnt = 0;
#pragma unroll
          for (int off = -8; off < 8; ++off) { const int tp = tpos + off; const bool in = (off >= -hw) && (off < hw) && (tp >= 0) && (tp < Ls);
              if (in) { const u32x2 v = *(const u32x2*)(pr + (ptrdiff_t)off * INW + c); s0 += bflo(v.x); s1 += bfhi(v.x); s2 += bflo(v.y); s3 += bfhi(v.y); cnt++; } }
          const u32x2 u0 = *(const u32x2*)(pr + c); const float ic = 1.0f / (float)cnt;
          f32x4 dd; dd[0] = s0 * ic - bflo(u0.x); dd[1] = s1 * ic - bfhi(u0.x); dd[2] = s2 * ic - bflo(u0.y); dd[3] = s3 * ic - bfhi(u0.y);
          *(LAS f32x4*)(dv + 4 * lane) = dd;
          LDS_WAIT();
          const int j0 = 4 * (lane & 15); f32x4 acc = {0.f, 0.f, 0.f, 0.f};
          const LAS float* dg = dv + g * 64; const LAS float* wg = pw + g * 4096 + j0;
#pragma unroll 8
          for (int i = 0; i < 64; ++i) { const float di = dg[i]; const f32x4 wv = *(const LAS f32x4*)(wg + i * 64); acc += wv * di; }
          const f32x4 sc = *(const f32x4*)(pscale + g * 64 + j0); acc *= sc;
          u32x2 ov; ov.x = pk2(acc[0], acc[1]); ov.y = pk2(acc[2], acc[3]);
          *(u32x2*)(Y + (size_t)row * D + 512 + g * 64 + j0) = ov;
          LDS_WAIT(); }
    }
    LAS unsigned char* stg = lds + 81920 + wave * 2048;
    const int n_att = 2048 + 2048 + (upd ? 256 : 0);
    for (int it = gw; it < n_att; it += NGW) {
        if (it < 2048) attn_wave<0>(a, stg, l, it, lane);
        else if (it < 4096) attn_wave<1>(a, stg, l, it - 2048, lane);
        else if (it < 4224) attn_wave<2>(a, stg, l, it - 4096, lane);
        else attn_wave<3>(a, stg, l, it - 4224, lane);
    }
}

__device__ __forceinline__ void phase_conv(const Args& a, int vcu, int G, int l, int ord, const float* IN, int in_ld, const float* UCm, int mul_col, float* outf, bf16_t* outy) {
    int tid_ = threadIdx.x; asm volatile("" : "+v"(tid_));
    const int tid = tid_, lane = tid & 63, wave = __builtin_amdgcn_readfirstlane(tid >> 6);
    const bool upd = (l == 0); const int nitems = 1024 + (upd ? 64 : 0);
    const float* skip = a.in[I_HSKIP] + (size_t)(l * 2 + ord) * 256;
    for (int item = vcu; item < nitems; item += G) {
        int b, cch, tch, L, rowbase; const float* H;
        if (item < 1024) { b = item >> 7; cch = (item >> 5) & 3; tch = item & 31; L = 4096; rowbase = b * 4096; H = (const float*)(a.ws + WS_HC) + (size_t)(l * 2 + ord) * 8191 * 256; }
        else { const int it = item - 1024; b = it >> 3; cch = (it >> 1) & 3; tch = it & 1; L = 256; rowbase = TX + b * 256; H = (const float*)(a.ws + WS_HCC) + (size_t)ord * 511 * 256; }
        const int c = cch * 64 + lane, t0 = tch * 128 + wave * 16;
        float acc[16], w[16];
#pragma unroll
        for (int i = 0; i < 16; ++i) { acc[i] = 0.f; w[i] = H[(size_t)(t0 + L - 1 + i) * 256 + c]; }
        const float* inp = IN + (size_t)rowbase * in_ld + c;
        for (int s0 = 0; s0 < L; s0 += 16) {
#pragma unroll
            for (int u = 0; u < 16; ++u) { const int s = s0 + u; const float v = inp[(size_t)s * in_ld];
#pragma unroll
                for (int i = 0; i < 16; ++i) acc[i] += v * w[(i - u + 16) & 15];
                int ni = t0 + L - 2 - s; ni = ni < 0 ? 0 : ni;
                w[(15 - u) & 15] = H[(size_t)ni * 256 + c]; }
        }
        const float sk = skip[c];
#pragma unroll
        for (int i = 0; i < 16; ++i) { const size_t row = (size_t)rowbase + t0 + i; const float r = UCm[row * 768 + mul_col + c] * (acc[i] + inp[(size_t)(t0 + i) * in_ld] * sk);
            if (outf) outf[row * 256 + c] = r; else outy[row * D + c] = (bf16_t)f2bf(r); }
    }
}

__device__ __forceinline__ void phase_select(const Args& a, unsigned char* ldsg, int vcu, int G, bool with_ctx) {
    LAS float* vals = (LAS float*)(LAS unsigned char*)ldsg;
    int tid_ = threadIdx.x; asm volatile("" : "+v"(tid_));
    const int tid = tid_; unsigned char* ws = a.ws;
    const float* AFFT = (const float*)(ws + WS_AFFT); int* ROWMAP = (int*)(ws + WS_ROWMAP); float* GATE = (float*)(ws + WS_GATE); int* INV = (int*)(ws + WS_INV);
    const int nitems = 1024 + (with_ctx ? 128 : 0);
    for (int item = vcu; item < nitems; item += G) {
        int e, ch, base, Ls, cap, slot0;
        if (item < 1024) { const int b = item >> 7; e = (item >> 3) & 15; ch = item & 7; base = b * 4096; Ls = 4096; cap = CAPX; slot0 = b * CAPX; }
        else { const int it = item - 1024; const int b = it >> 4; e = it & 15; ch = 0; base = TX + b * 256; Ls = 256; cap = CAPC; slot0 = NB * CAPX + b * CAPC; }
        for (int i = tid; i < Ls; i += NTHR) vals[i] = AFFT[(size_t)e * TT + base + i];
        __syncthreads();
        const int i = ch * NTHR + tid;
        if (i < Ls) { const float av = vals[i]; int cnt = 0;
            for (int j4 = 0; j4 < Ls; j4 += 4) { const f32x4 v = *(const LAS f32x4*)(vals + j4);
#pragma unroll
                for (int q = 0; q < 4; ++q) cnt += ((v[q] > av) || (v[q] == av && (j4 + q) < i)) ? 1 : 0; }
            if (cnt < cap) { const int slot = e * SLOTS + slot0 + cnt; ROWMAP[slot] = base + i; GATE[slot] = av; INV[(size_t)(base + i) * 16 + e] = slot; } }
        __syncthreads();
    }
}
__device__ __forceinline__ void phase_gather(const Args& a, int vcu, int G, bool with_ctx) {
    int tid_ = threadIdx.x; asm volatile("" : "+v"(tid_));
    const int tid = tid_, lane = tid & 63, wave = __builtin_amdgcn_readfirstlane(tid >> 6); unsigned char* ws = a.ws;
    const int* ROWMAP = (const int*)(ws + WS_ROWMAP); const bf16_t* HX = (const bf16_t*)(ws + WS_HX); bf16_t* XG = (bf16_t*)(ws + WS_XG);
    const int per = with_ctx ? SLOTS : NB * CAPX; const int gw = vcu * NWAVES + wave, NGW = G * NWAVES;
    for (int it = gw; it < NE * per; it += NGW) { const int e = it / per, s = it % per; const int slot = e * SLOTS + s; const int src = ROWMAP[slot];
        const u32x4* sp = (const u32x4*)(HX + (size_t)src * D) + 2 * lane; u32x4* dp = (u32x4*)(XG + (size_t)slot * D) + 2 * lane;
        const u32x4 v0 = sp[0], v1 = sp[1]; dp[0] = v0; dp[1] = v1; }
}
__device__ __forceinline__ void phase_combine(const Args& a, int vcu, int G, int l, bool with_ctx, bool final_norm) {
    int tid_ = threadIdx.x; asm volatile("" : "+v"(tid_));
    const int tid = tid_, lane = tid & 63, wave = __builtin_amdgcn_readfirstlane(tid >> 6); unsigned char* ws = a.ws;
    const int* INV = (const int*)(ws + WS_INV); const bf16_t* OB = (const bf16_t*)(ws + WS_XG); const float* MOD = (const float*)(ws + WS_MOD) + (size_t)l * 9 * 6144;
    float* CRES = (float*)(ws + WS_CRES); const float* fng = a.in[I_FNG];
    const int nrows = with_ctx ? TT : TX; const int gw = vcu * NWAVES + wave, NGW = G * NWAVES;
    for (int row = gw; row < nrows; row += NGW) {
        const bool lat = row < TX; float* xr = lat ? a.out + (size_t)row * D : CRES + (size_t)(row - TX) * D; const int mrow = lat ? (row >> 12) : 8;
        const int myinv = (lane < 16) ? INV[(size_t)row * 16 + lane] : -1;
        f32x4 acc[4];
#pragma unroll
        for (int j = 0; j < 4; ++j) acc[j] = (f32x4){0.f, 0.f, 0.f, 0.f};
        for (int e = 0; e < 16; ++e) { const int s = __shfl(myinv, e);
            if (s >= 0) { const bf16_t* orow = OB + (size_t)s * D;
#pragma unroll
                for (int j = 0; j < 4; ++j) { const u32x2 v = *(const u32x2*)(orow + 256 * j + 4 * lane); acc[j][0] += bflo(v.x); acc[j][1] += bfhi(v.x); acc[j][2] += bflo(v.y); acc[j][3] += bfhi(v.y); } } }
        const float* gp = MOD + mrow * 6144 + 5 * 1024; f32x4 v[4]; float ss = 0.f;
#pragma unroll
        for (int j = 0; j < 4; ++j) { const f32x4 g = *(const f32x4*)(gp + 256 * j + 4 * lane); v[j] = *(const f32x4*)(xr + 256 * j + 4 * lane) + g * acc[j];
            ss += (v[j][0] * v[j][0] + v[j][1] * v[j][1]) + (v[j][2] * v[j][2] + v[j][3] * v[j][3]); }
        if (final_norm) { const float rstd = 1.0f / sqrtf(wave_sum(ss) * (1.0f / D) + 1e-6f);
#pragma unroll
            for (int j = 0; j < 4; ++j) { const f32x4 g = *(const f32x4*)(fng + 256 * j + 4 * lane); v[j] = v[j] * rstd * g; } }
#pragma unroll
        for (int j = 0; j < 4; ++j) *(f32x4*)(xr + 256 * j + 4 * lane) = v[j];
    }
}

__global__ void __launch_bounds__(NTHR, 2) fwd_kernel(Args a) {
    extern __shared__ __attribute__((aligned(16))) unsigned char lds[];
    cg::grid_group grid = cg::this_grid();
    const int G = gridDim.x, bx = blockIdx.x; const int vcu = (G % 8 == 0) ? (bx % 8) * (G / 8) + bx / 8 : bx;
    unsigned char* ws = a.ws;
    PG8_LAS unsigned char* glds = (PG8_LAS unsigned char*)lds;
    phase_prologue(a, lds, vcu, G);
    grid.sync();
    for (int l = 0; l < 2; ++l) {
        const bool upd = (l == 0);
        const float* srcx = upd ? a.in[I_X] : a.out; const float* srcc = upd ? a.in[I_CTX] : (const float*)(ws + WS_CRES);
        phase_norm(a, lds, vcu, G, l, srcx, srcc, a.in[I_N1G] + l * D, 0, TT, false);
        grid.sync();
        { pg8::Gemm g{(const pg8::bf16_t*)(ws + WS_HX), (const pg8::bf16_t*)(ws + WS_WIN_T) + (size_t)l * INW * D, TT, INW, D};
          pg8::GroupOrder S; S.init(1, TT / 256, INW / 256, 0, G, bx);
          pg8::EpiIn E{(pg8::bf16_t*)(ws + WS_PX), (const float*)(ws + WS_ROPE)};
          pg8::gemm_phase<pg8::EpiIn, pg8::GroupOrder, true, true>(glds, g, S, E); }
        grid.sync();
        phase_mix1(a, lds, vcu, G, l);
        grid.sync();
        phase_conv(a, vcu, G, l, 0, (const float*)(ws + WS_UC), 768, (const float*)(ws + WS_UC), 256, (float*)(ws + WS_Z1), nullptr);
        grid.sync();
        phase_conv(a, vcu, G, l, 1, (const float*)(ws + WS_Z1), 256, (const float*)(ws + WS_UC), 512, nullptr, (bf16_t*)(ws + WS_Y));
        grid.sync();
        { pg8::Gemm g{(const pg8::bf16_t*)(ws + WS_Y), (const pg8::bf16_t*)(ws + WS_WOUT_T) + (size_t)l * D * D, TT, D, D};
          pg8::GroupOrder S; S.init(1, (upd ? TT : TX) / 256, D / 256, 0, G, bx);
          pg8::EpiOut E{srcx, srcc, a.out, (float*)(ws + WS_CRES), (const float*)(ws + WS_MOD) + (size_t)l * 9 * 6144};
          pg8::gemm_phase<pg8::EpiOut, pg8::GroupOrder, true, true>(glds, g, S, E); }
        grid.sync();
        phase_norm(a, lds, vcu, G, l, a.out, (const float*)(ws + WS_CRES), a.in[I_N2G] + l * D, 3, upd ? TT : TX, true);
        grid.sync();
        phase_select(a, lds, vcu, G, upd);
        grid.sync();
        phase_gather(a, vcu, G, upd);
        grid.sync();
        { pg8::Gemm g{(const pg8::bf16_t*)(ws + WS_XG), (const pg8::bf16_t*)(ws + WS_WGU_T) + (size_t)l * NE * 4096 * D, NE * SLOTS, NE * 4096, D};
          pg8::GroupOrder S; S.init(NE, upd ? 17 : 16, 16, 17, G, bx);
          pg8::EpiGU E{(pg8::bf16_t*)(ws + WS_ACT)};
          pg8::gemm_phase<pg8::EpiGU, pg8::GroupOrder, true, true>(glds, g, S, E); }
        grid.sync();
        { pg8::Gemm g{(const pg8::bf16_t*)(ws + WS_ACT), (const pg8::bf16_t*)(ws + WS_WD_T) + (size_t)l * NE * D * FF, NE * SLOTS, NE * D, FF};
          pg8::GroupOrder S; S.init(NE, upd ? 17 : 16, 4, 17, G, bx);
          pg8::EpiDown E{(pg8::bf16_t*)(ws + WS_XG), (const float*)(ws + WS_GATE)};
          pg8::gemm_phase<pg8::EpiDown, pg8::GroupOrder, true, true>(glds, g, S, E); }
        grid.sync();
        phase_combine(a, vcu, G, l, upd, !upd);
        if (upd) grid.sync();
    }
}

extern "C" void kernel_launch(void* const* d_in, const int* in_sizes, int n_in, void* d_out, int out_size, void* d_ws, size_t ws_size, hipStream_t stream) {
    static int grid = 0;
    if (grid == 0) {
        int dev = 0, cus = 0, per_cu = 0;
        hipGetDevice(&dev); hipDeviceGetAttribute(&cus, hipDeviceAttributeMultiprocessorCount, dev);
        if (hipFuncSetAttribute((const void*)fwd_kernel, hipFuncAttributeMaxDynamicSharedMemorySize, LDS_BYTES) != hipSuccess) { fprintf(stderr, "kernel_launch: hipFuncSetAttribute failed\n"); grid = -1; return; }
        if (hipOccupancyMaxActiveBlocksPerMultiprocessor(&per_cu, (const void*)fwd_kernel, NTHR, LDS_BYTES) != hipSuccess || per_cu < 1) { fprintf(stderr, "kernel_launch: occupancy query failed (%d)\n", per_cu); grid = -1; return; }
        grid = cus * 1;
        if (n_in != N_IN || ws_size < WS_END) { fprintf(stderr, "kernel_launch: unexpected n_in %d / ws %zu\n", n_in, ws_size); grid = -1; return; }
    }
    if (grid < 0) return;
    Args a{};
    for (int i = 0; i < N_IN; ++i) a.in[i] = (const float*)d_in[i];
    a.out = (float*)d_out; a.ws = (unsigned char*)d_ws;
    void* args[] = {&a};
    hipError_t e = hipLaunchCooperativeKernel((const void*)fwd_kernel, dim3(grid), dim3(NTHR), args, LDS_BYTES, stream);
    if (e != hipSuccess) fprintf(stderr, "cooperative launch failed: %s (grid %d)\n", hipGetErrorString(e), grid);
}
```

```cpp
#include <hip/hip_runtime.h>
#include <hip/hip_cooperative_groups.h>
#include <cstdio>
#include <cstdint>
namespace cg = cooperative_groups;
namespace pg8 {
#define PG8_LAS __attribute__((address_space(3)))
typedef unsigned short bf16_t;
typedef short bf16x8 __attribute__((ext_vector_type(8)));
typedef float f32x4 __attribute__((ext_vector_type(4)));
typedef unsigned u32x4 __attribute__((ext_vector_type(4)));
constexpr int BM = 256, BK = 64, HALF = 128, HTB = HALF * BK * 2  , STAGE_BYTES = 8 * HTB, NXCD = 8, WGM = 8;

__host__ __device__ __forceinline__ int lds_byte(int r, int c) { const int st = (r >> 4) * 2 + (c >> 5), rr = r & 15, cc = c & 31, ob = rr * 64 + cc * 2; return st * 1024 + (ob ^ (((ob >> 9) & 1) << 5)); }
__host__ __device__ __forceinline__ void stage_rc(int b, int& R, int& C) { const int st = b / 1024, sb = b % 1024, swz = sb ^ (((sb >> 9) & 1) << 5); R = (st >> 1) * 16 + swz / 64; C = (st & 1) * 32 + (swz % 64) / 2; }
__host__ __device__ __forceinline__ int perm32(int rho) { const int n = rho >> 4, i = rho & 15; return 8 * (i >> 2) + 4 * n + (i & 3); }

struct Unit { int pm, pn; };
struct Gemm { const bf16_t* A; const bf16_t* Bt; int M, N, K; };

struct StaticOrder {
    int nM, nN, nwg, G, c;
    __host__ __device__ void init(int M, int N, int G_, int c_) { nM = M / BM; nN = N / BM; nwg = nM * nN; G = G_; c = c_; }
    __host__ __device__ bool next(int i, Unit& u) const {
        const long L = (long)i * G + c; if (L >= nwg) return false;
        int wgid = (int)L; { const int q = nwg / NXCD, r = nwg % NXCD, xcd = wgid % NXCD, off = wgid / NXCD; wgid = (xcd < r ? xcd * (q + 1) : r * (q + 1) + (xcd - r) * q) + off; }
        const int nig = WGM * nN, gid = wgid / nig, fm = gid * WGM, gsz = (nM - fm) < WGM ? (nM - fm) : WGM;
        u.pm = fm + ((wgid % nig) % gsz); u.pn = (wgid % nig) / gsz; return true;
    }
    __device__ __forceinline__ void a_ready(const Unit&) const {}
    __device__ __forceinline__ void done(const Unit&) const {}
};

__device__ __forceinline__ unsigned cvt_pk_bf16(float lo, float hi) { unsigned r; asm volatile("v_cvt_pk_bf16_f32 %0, %1, %2" : "=v"(r) : "v"(lo), "v"(hi)); return r; }
typedef float f32x2 __attribute__((ext_vector_type(2)));
__device__ __forceinline__ f32x2 gelu_pk(f32x2 v) {
    const f32x2 av = __builtin_elementwise_abs(v), d = av * 0.2316418882f + 1.0f;
    f32x2 t; t.x = __builtin_amdgcn_rcpf(d.x); t.y = __builtin_amdgcn_rcpf(d.y);
    f32x2 q = t * 0.5307027145f + (-0.7265760135f); q = q * t + 0.7107068705f; q = q * t + (-0.142248368f); q = q * t + 0.127414796f; q = q * t;
    const f32x2 s = (v * v) * (-0.72134752044f);
    f32x2 e; e.x = __builtin_amdgcn_exp2f(s.x); e.y = __builtin_amdgcn_exp2f(s.y);
    const f32x2 m = v * (q * e), r = v - m;
    f32x2 o; o.x = v.x < 0.f ? m.x : r.x; o.y = v.y < 0.f ? m.y : r.y; return o;
}


struct GroupOrder {
    int nMl, nNl, strideM, nper, nwg, G, c;
    __device__ void init(int ng, int nMl_, int nNl_, int strideM_, int G_, int c_) { nMl = nMl_; nNl = nNl_; strideM = strideM_; nper = nMl_ * nNl_; nwg = ng * nper; G = G_; c = c_; }
    __device__ bool next(int i, Unit& u) const {
        const long L = (long)i * G + c; if (L >= nwg) return false;
        int wgid = (int)L; { const int q = nwg / NXCD, r = nwg % NXCD, xcd = wgid % NXCD, off = wgid / NXCD; wgid = (xcd < r ? xcd * (q + 1) : r * (q + 1) + (xcd - r) * q) + off; }
        const int e = wgid / nper, id = wgid % nper;
        const int nig = WGM * nNl, gid = id / nig, fm = gid * WGM, gsz = (nMl - fm) < WGM ? (nMl - fm) : WGM;
        u.pm = e * strideM + fm + ((id % nig) % gsz); u.pn = e * nNl + (id % nig) / gsz; return true;
    }
    __device__ __forceinline__ void a_ready(const Unit&) const {}
    __device__ __forceinline__ void done(const Unit&) const {}
};

constexpr int TXR = 32768;
struct EpiIn {
    static constexpr bool PERM = true, AFTER_DRAIN = false;
    bf16_t* PX; const float* rope; bf16_t* UT; PG8_LAS unsigned char* stgbase;
    __device__ __forceinline__ void operator()(const f32x4 (&acc)[2][2][4][2], const Unit& u, int wr, int wc, int fr, int fq) const {
        const int row0 = u.pm * BM + wr * 64 + fr; const int col0 = u.pn * BM + wc * 32 + 8 * fq;
        const bool latent = u.pm < (TXR / BM);
        if (latent && u.pn < 3) {
            PG8_LAS unsigned char* stg = stgbase + (wr * 4 + wc) * 2304; const int lane = fq * 16 + fr;
            const int b = u.pm >> 4, trow0 = (u.pm & 15) * BM; const int col = lane >> 1, half = lane & 1;
#pragma unroll
            for (int ai = 0; ai < 2; ++ai)
#pragma unroll
                for (int bj = 0; bj < 2; ++bj)
#pragma unroll
                    for (int mh = 0; mh < 2; ++mh) {
#pragma unroll
                        for (int mm = 0; mm < 2; ++mm)
#pragma unroll
                            for (int n = 0; n < 2; ++n) { const f32x4 v = acc[ai][bj][2 * mh + mm][n]; const unsigned w0 = cvt_pk_bf16(v[0], v[1]), w1 = cvt_pk_bf16(v[2], v[3]);
                                PG8_LAS unsigned char* p = stg + (8 * fq + 4 * n) * 72 + (16 * mm + fr) * 2;
                                *(PG8_LAS unsigned short*)(p) = (unsigned short)w0; *(PG8_LAS unsigned short*)(p + 72) = (unsigned short)(w0 >> 16);
                                *(PG8_LAS unsigned short*)(p + 144) = (unsigned short)w1; *(PG8_LAS unsigned short*)(p + 216) = (unsigned short)(w1 >> 16); }
                        asm volatile("s_waitcnt lgkmcnt(0)" ::: "memory");
                        typedef unsigned u32x2v __attribute__((ext_vector_type(2)));
                        const PG8_LAS unsigned char* rp = stg + col * 72 + half * 32;
                        const u32x2v a0 = *(const PG8_LAS u32x2v*)(rp), a1 = *(const PG8_LAS u32x2v*)(rp + 8), a2 = *(const PG8_LAS u32x2v*)(rp + 16), a3 = *(const PG8_LAS u32x2v*)(rp + 24);
                        const int ch = u.pn * BM + bj * HALF + wc * 32 + col; const int t0 = trow0 + ai * HALF + wr * 64 + mh * 32 + half * 16;
                        u32x4* gp = (u32x4*)(UT + ((size_t)(b * 768 + ch)) * 4096 + t0);
                        gp[0] = (u32x4){a0.x, a0.y, a1.x, a1.y}; gp[1] = (u32x4){a2.x, a2.y, a3.x, a3.y};
                        asm volatile("s_waitcnt lgkmcnt(0)" ::: "memory"); }
            return;
        }
#pragma unroll
        for (int ai = 0; ai < 2; ++ai)
#pragma unroll
            for (int m = 0; m < 4; ++m) { const int row = row0 + ai * HALF + m * 16; bf16_t* rowp = PX + (size_t)row * 2304 + col0;
#pragma unroll
                for (int bj = 0; bj < 2; ++bj) { f32x4 v0 = acc[ai][bj][m][0], v1 = acc[ai][bj][m][1];
                    const bool dorope = latent && (u.pn == 4 || (u.pn == 6 && bj == 0));
                    if (dorope) {
                        const int t = row & 4095; const int pos = (wc & 1) ? (t & 63) : (t >> 6);
                        const f32x4* rp = (const f32x4*)(rope + (pos * 16 + 8 * (fq & 1)) * 2);
                        const f32x4 r0 = rp[0], r1 = rp[1], r2 = rp[2], r3 = rp[3];
                        f32x4 p0, p1;
#pragma unroll
                        for (int j = 0; j < 4; ++j) { p0[j] = __shfl_xor(v0[j], 32); p1[j] = __shfl_xor(v1[j], 32); }
                        const float c0[4] = {r0[0], r0[2], r1[0], r1[2]}, s0[4] = {r0[1], r0[3], r1[1], r1[3]};
                        const float c1[4] = {r2[0], r2[2], r3[0], r3[2]}, s1[4] = {r2[1], r2[3], r3[1], r3[3]};
                        const bool lo = fq < 2;
#pragma unroll
                        for (int j = 0; j < 4; ++j) {
                            v0[j] = lo ? (v0[j] * c0[j] - p0[j] * s0[j]) : (p0[j] * s0[j] + v0[j] * c0[j]);
                            v1[j] = lo ? (v1[j] * c1[j] - p1[j] * s1[j]) : (p1[j] * s1[j] + v1[j] * c1[j]); }
                    }
                    u32x4 w; w.x = cvt_pk_bf16(v0[0], v0[1]); w.y = cvt_pk_bf16(v0[2], v0[3]); w.z = cvt_pk_bf16(v1[0], v1[1]); w.w = cvt_pk_bf16(v1[2], v1[3]);
                    *(u32x4*)(rowp + bj * HALF) = w; } }
    }
};
struct EpiOut {
    static constexpr bool PERM = false, AFTER_DRAIN = false;
    const float* xold_x; const float* xold_c; float* dst_x; float* dst_c; const float* mod;
    __device__ __forceinline__ void operator()(const f32x4 (&acc)[2][2][4][2], const Unit& u, int wr, int wc, int fr, int fq) const {
        const int row0 = u.pm * BM + wr * 64 + fr, col0 = u.pn * BM + wc * 32 + 4 * fq;
        const bool latent = u.pm < (TXR / BM);
#pragma unroll
        for (int ai = 0; ai < 2; ++ai)
#pragma unroll
            for (int m = 0; m < 4; ++m) { const int row = row0 + ai * HALF + m * 16;
                const int mrow = latent ? (row >> 12) : 8; const float* gp = mod + mrow * 6144 + 2 * 1024 + col0;
                const size_t off = latent ? (size_t)row * 1024 + col0 : (size_t)(row - TXR) * 1024 + col0;
                const float* xo = (latent ? xold_x : xold_c) + off; float* xd = (latent ? dst_x : dst_c) + off;
#pragma unroll
                for (int bj = 0; bj < 2; ++bj)
#pragma unroll
                    for (int n = 0; n < 2; ++n) { const f32x4 g = *(const f32x4*)(gp + bj * HALF + n * 16), xv = *(const f32x4*)(xo + bj * HALF + n * 16);
                        *(f32x4*)(xd + bj * HALF + n * 16) = xv + g * acc[ai][bj][m][n]; } }
    }
};
struct EpiGU {
    static constexpr bool PERM = true, AFTER_DRAIN = false;
    bf16_t* ACT;
    __device__ __forceinline__ void operator()(const f32x4 (&acc)[2][2][4][2], const Unit& u, int wr, int wc, int fr, int fq) const {
        const int row0 = u.pm * BM + wr * 64 + fr; const int col0 = (u.pn & 15) * 128 + wc * 32 + 8 * fq;
#pragma unroll
        for (int ai = 0; ai < 2; ++ai)
#pragma unroll
            for (int m = 0; m < 4; ++m) { bf16_t* rowp = ACT + (size_t)(row0 + ai * HALF + m * 16) * 2048 + col0;
                f32x4 h[2];
#pragma unroll
                for (int n = 0; n < 2; ++n)
#pragma unroll
                    for (int j = 0; j < 4; ++j) { const float g = acc[ai][0][m][n][j], up = acc[ai][1][m][n][j]; h[n][j] = g / (1.0f + __expf(-g)) * up; }
                u32x4 w; w.x = cvt_pk_bf16(h[0][0], h[0][1]); w.y = cvt_pk_bf16(h[0][2], h[0][3]); w.z = cvt_pk_bf16(h[1][0], h[1][1]); w.w = cvt_pk_bf16(h[1][2], h[1][3]);
                *(u32x4*)rowp = w; }
    }
};
struct EpiDown {
    static constexpr bool PERM = true, AFTER_DRAIN = false;
    bf16_t* OB; const float* gate;
    __device__ __forceinline__ void operator()(const f32x4 (&acc)[2][2][4][2], const Unit& u, int wr, int wc, int fr, int fq) const {
        const int row0 = u.pm * BM + wr * 64 + fr; const int col0 = (u.pn & 3) * BM + wc * 32 + 8 * fq;
#pragma unroll
        for (int ai = 0; ai < 2; ++ai)
#pragma unroll
            for (int m = 0; m < 4; ++m) { const int row = row0 + ai * HALF + m * 16; const float g = gate[row]; bf16_t* rowp = OB + (size_t)row * 1024 + col0;
#pragma unroll
                for (int bj = 0; bj < 2; ++bj) { const f32x4 v0 = acc[ai][bj][m][0] * g, v1 = acc[ai][bj][m][1] * g;
                    u32x4 w; w.x = cvt_pk_bf16(v0[0], v0[1]); w.y = cvt_pk_bf16(v0[2], v0[3]); w.z = cvt_pk_bf16(v1[0], v1[1]); w.w = cvt_pk_bf16(v1[2], v1[3]);
                    *(u32x4*)(rowp + bj * HALF) = w; } }
    }
};

template <class Epi, class Sched, bool ALIGN_EPI = false, bool SP2 = false>
__device__ __forceinline__ void gemm_phase(PG8_LAS unsigned char* lds, const Gemm g, const Sched& S, const Epi& E) {
    int tid_ = threadIdx.x; asm volatile("" : "+v"(tid_));
    const int tid = tid_, wid = __builtin_amdgcn_readfirstlane(tid >> 6), lane = tid & 63, wr = wid >> 2, wc = wid & 3, fr = lane & 15, fq = lane >> 4;
    const int K = g.K, nt = K / BK;
    unsigned voffA[2], voffB[2];
#pragma unroll
    for (int i = 0; i < 2; ++i) { int R, C; stage_rc(tid * 16 + i * 8192, R, C); const int Rb = Epi::PERM ? ((R & ~31) + perm32(R & 31)) : R;
        voffA[i] = (unsigned)(R * K + C) * 2u; voffB[i] = (unsigned)(Rb * K + C) * 2u; }
    const size_t kstep = (size_t)(BK * 2);
    const size_t hstep = (size_t)HALF * K * 2;
    const size_t tstep = 2 * hstep;
    const unsigned ldsw = (unsigned)wid * 1024u;
    const int aoff = lds_byte(wr * 64 + fr, fq * 8), boff = lds_byte(wc * 32 + fr, fq * 8);
#define PG8_SA(b, h) (((b) * 2 + (h)) * HTB)
#define PG8_SB(b, h) ((4 + (b) * 2 + (h)) * HTB)
#define PG8_STAGE(bufoff, gbase, voff) do { _Pragma("unroll") for (int _i = 0; _i < 2; ++_i) \
        __builtin_amdgcn_global_load_lds((const unsigned*)((const char*)(gbase) + (voff)[_i]), (PG8_LAS unsigned*)(lds + (bufoff) + ldsw + _i * 8192), 16, 0, 0); } while (0)
#define PG8_LDA(dst, b, h) do { _Pragma("unroll") for (int m = 0; m < 4; ++m) _Pragma("unroll") for (int k = 0; k < 2; ++k) dst[m][k] = *(const PG8_LAS bf16x8*)(lds + PG8_SA(b, h) + aoff + m * 2048 + k * 1024); } while (0)
#define PG8_LDB(dst, b, h) do { _Pragma("unroll") for (int n = 0; n < 2; ++n) _Pragma("unroll") for (int k = 0; k < 2; ++k) dst[n][k] = *(const PG8_LAS bf16x8*)(lds + PG8_SB(b, h) + boff + n * 2048 + k * 1024); } while (0)
#define PG8_MMA(ai, bj, At, Bt) do { __builtin_amdgcn_s_setprio(1); _Pragma("unroll") for (int m = 0; m < 4; ++m) _Pragma("unroll") for (int n = 0; n < 2; ++n) _Pragma("unroll") for (int k = 0; k < 2; ++k) \
        acc[ai][bj][m][n] = __builtin_amdgcn_mfma_f32_16x16x32_bf16(Bt[n][k], At[m][k], acc[ai][bj][m][n], 0, 0, 0); __builtin_amdgcn_s_setprio(0); } while (0)
#define PG8_WAIT_V(n) asm volatile("s_waitcnt vmcnt(" #n ")" ::: "memory")
#define PG8_WAIT_L(n) asm volatile("s_waitcnt lgkmcnt(" #n ")" ::: "memory")
#define PG8_BAR __builtin_amdgcn_s_barrier()
#define PG8_SCHED __builtin_amdgcn_sched_barrier(0)
    Unit cur, nxt; int ui = 0;
    if (!S.next(0, cur)) return;
    f32x4 acc[2][2][4][2];
#pragma unroll
    for (int a = 0; a < 2; ++a)
#pragma unroll
        for (int b = 0; b < 2; ++b)
#pragma unroll
            for (int m = 0; m < 4; ++m)
#pragma unroll
                for (int n = 0; n < 2; ++n) acc[a][b][m][n] = (f32x4){0.f, 0.f, 0.f, 0.f};
    bf16x8 At[4][2], B0[2][2], B1[2][2];
    const char* cA = (const char*)g.A + (size_t)cur.pm * tstep; const char* cB = (const char*)g.Bt + (size_t)cur.pn * tstep;
    S.a_ready(cur);
    if constexpr (SP2) {
        PG8_STAGE(PG8_SB(0, 0), cB, voffB); PG8_STAGE(PG8_SB(0, 1), cB + hstep, voffB); PG8_STAGE(PG8_SA(0, 0), cA, voffA); PG8_STAGE(PG8_SA(0, 1), cA + hstep, voffA);
        if (wr == 1) PG8_BAR;
        PG8_WAIT_V(2); PG8_BAR;
        PG8_STAGE(PG8_SB(1, 0), cB + kstep, voffB); PG8_STAGE(PG8_SA(1, 0), cA + kstep, voffA); PG8_STAGE(PG8_SB(1, 1), cB + hstep + kstep, voffB);
        PG8_WAIT_V(6); PG8_BAR;
    } else {
        PG8_STAGE(PG8_SB(0, 0), cB, voffB); PG8_STAGE(PG8_SA(0, 0), cA, voffA); PG8_STAGE(PG8_SB(0, 1), cB + hstep, voffB); PG8_STAGE(PG8_SA(0, 1), cA + hstep, voffA);
        if (wr == 1) PG8_BAR;
        PG8_WAIT_V(4); PG8_BAR;
        PG8_STAGE(PG8_SB(1, 0), cB + kstep, voffB); PG8_STAGE(PG8_SA(1, 0), cA + kstep, voffA); PG8_STAGE(PG8_SB(1, 1), cB + hstep + kstep, voffB);
        PG8_WAIT_V(6); PG8_BAR;
    }
    for (;;) {
        const bool has_next = S.next(ui + 1, nxt);
        const char* nA = has_next ? (const char*)g.A + (size_t)nxt.pm * tstep : cA; const char* nB = has_next ? (const char*)g.Bt + (size_t)nxt.pn * tstep : cB;
        for (int t = 0; t < nt; t += 2) {
            const bool last = (t == nt - 2);
            const char* a1 = cA + (size_t)(t + 1) * kstep;
            const char* a2 = last ? nA : cA + (size_t)(t + 2) * kstep; const char* b2 = last ? nB : cB + (size_t)(t + 2) * kstep;
            const char* a3 = a2 + kstep; const char* b3 = b2 + kstep;
            if (last && has_next) S.a_ready(nxt);
            if constexpr (SP2) {
            PG8_LDB(B0, 0, 0); PG8_LDB(B1, 0, 1); PG8_SCHED; PG8_LDA(At, 0, 0); PG8_STAGE(PG8_SA(1, 1), a1 + hstep, voffA);
            PG8_WAIT_V(8); PG8_WAIT_L(0); PG8_BAR; PG8_MMA(0, 0, At, B0); PG8_MMA(0, 1, At, B1); PG8_BAR; PG8_SCHED;
            PG8_LDA(At, 0, 1); PG8_STAGE(PG8_SB(0, 0), b2, voffB); PG8_STAGE(PG8_SB(0, 1), b2 + hstep, voffB); PG8_STAGE(PG8_SA(0, 0), a2, voffA);
            PG8_WAIT_V(8); PG8_WAIT_L(0); PG8_BAR; PG8_MMA(1, 0, At, B0); PG8_MMA(1, 1, At, B1); PG8_BAR; PG8_SCHED;
            PG8_LDB(B0, 1, 0); PG8_LDB(B1, 1, 1); PG8_SCHED; PG8_LDA(At, 1, 0); PG8_STAGE(PG8_SA(0, 1), a2 + hstep, voffA);
            PG8_WAIT_V(8); PG8_WAIT_L(0); PG8_BAR; PG8_MMA(0, 0, At, B0); PG8_MMA(0, 1, At, B1); PG8_BAR; PG8_SCHED;
            PG8_LDA(At, 1, 1); PG8_STAGE(PG8_SB(1, 0), b3, voffB); PG8_STAGE(PG8_SB(1, 1), b3 + hstep, voffB); PG8_STAGE(PG8_SA(1, 0), a3, voffA);
            PG8_WAIT_V(8); PG8_WAIT_L(0); PG8_BAR; PG8_MMA(1, 0, At, B0); PG8_MMA(1, 1, At, B1); PG8_BAR; PG8_SCHED;
            } else {
            PG8_LDB(B0, 0, 0); PG8_SCHED; PG8_LDA(At, 0, 0); PG8_STAGE(PG8_SA(1, 1), a1 + hstep, voffA);
            PG8_WAIT_L(8); PG8_BAR; PG8_WAIT_L(0); PG8_MMA(0, 0, At, B0); PG8_BAR; PG8_SCHED;
            PG8_LDB(B1, 0, 1); PG8_STAGE(PG8_SB(0, 0), b2, voffB);
            PG8_BAR; PG8_WAIT_L(0); PG8_MMA(0, 1, At, B1); PG8_BAR;
            PG8_LDA(At, 0, 1); PG8_STAGE(PG8_SA(0, 0), a2, voffA);
            PG8_BAR; PG8_WAIT_L(0); PG8_MMA(1, 0, At, B0); PG8_BAR; PG8_SCHED;
            PG8_STAGE(PG8_SB(0, 1), b2 + hstep, voffB);
            PG8_WAIT_V(6); PG8_BAR; PG8_MMA(1, 1, At, B1); PG8_BAR;
            PG8_LDB(B0, 1, 0); PG8_SCHED; PG8_LDA(At, 1, 0); PG8_STAGE(PG8_SA(0, 1), a2 + hstep, voffA);
            PG8_WAIT_L(8); PG8_BAR; PG8_WAIT_L(0); PG8_MMA(0, 0, At, B0); PG8_BAR; PG8_SCHED;
            PG8_LDB(B1, 1, 1); PG8_STAGE(PG8_SB(1, 0), b3, voffB);
            PG8_BAR; PG8_WAIT_L(0); PG8_MMA(0, 1, At, B1); PG8_BAR;
            PG8_LDA(At, 1, 1); PG8_STAGE(PG8_SA(1, 0), a3, voffA);
            PG8_BAR; PG8_WAIT_L(0); PG8_MMA(1, 0, At, B0); PG8_BAR; PG8_SCHED;
            PG8_STAGE(PG8_SB(1, 1), b3 + hstep, voffB);
            PG8_WAIT_V(6); PG8_BAR; PG8_MMA(1, 1, At, B1); PG8_BAR;
            }
        }
        if constexpr (ALIGN_EPI) { if (wr == 0) PG8_BAR; }
        if constexpr (!Epi::AFTER_DRAIN) { E(acc, cur, wr, wc, fr, fq); S.done(cur); }
        if (!has_next) break;
#pragma unroll
        for (int a = 0; a < 2; ++a)
#pragma unroll
            for (int b = 0; b < 2; ++b)
#pragma unroll
                for (int m = 0; m < 4; ++m)
#pragma unroll
                    for (int n = 0; n < 2; ++n) acc[a][b][m][n] = (f32x4){0.f, 0.f, 0.f, 0.f};
        cur = nxt; cA = nA; cB = nB; ++ui;
        if constexpr (ALIGN_EPI) { if (wr == 1) PG8_BAR; }
    }
    PG8_WAIT_V(0);
    if constexpr (!ALIGN_EPI) { if (wr == 0) PG8_BAR; }
    PG8_BAR;
    if constexpr (Epi::AFTER_DRAIN) { E.fused(acc, cur, wr, wc, fr, fq, lds, wid, lane); S.done(cur); }
#undef PG8_SA
#undef PG8_SB
#undef PG8_STAGE
#undef PG8_LDA
#undef PG8_LDB
#undef PG8_MMA
#undef PG8_WAIT_V
#undef PG8_WAIT_L
#undef PG8_BAR
#undef PG8_SCHED
}
}

#define LAS __attribute__((address_space(3)))
typedef unsigned short bf16_t;
typedef float f32x4 __attribute__((ext_vector_type(4)));
typedef unsigned u32x4 __attribute__((ext_vector_type(4)));
typedef unsigned u32x2 __attribute__((ext_vector_type(2)));
typedef __bf16 bf16x2_t __attribute__((ext_vector_type(2)));
constexpr int NWAVES = 8, NTHR = 512;
constexpr int D = 1024, NB = 8, SEQ = 4096, LCTX = 256, TX = NB * SEQ, TC = NB * LCTX, TT = TX + TC, INW = 2304, NE = 16, FF = 2048;
constexpr int CAPX = 512, CAPC = 32, SLOTS = NB * CAPX + NB * CAPC;
constexpr float LOG2E = 1.4426950408889634f;
constexpr int LDS_BYTES = 155648;
enum { I_X = 0, I_C, I_CTX, I_CCTX, I_ADAW, I_ADAB, I_N1G, I_N2G, I_WIN, I_HCW, I_HCB, I_HW1, I_HB1, I_HW2, I_HB2, I_HW3, I_HFREQ, I_HSKIP, I_SINK, I_POOLW, I_POOLS, I_RPB, I_WOUT, I_ROUTER, I_WG, I_WU, I_WD, I_FNG, N_IN };
constexpr size_t MiB = 1u << 20;
constexpr size_t WS_MOD = 1 * MiB;
constexpr size_t WS_ROPE = 2 * MiB;
constexpr size_t WS_TW8 = 2 * MiB + 65536;
constexpr size_t WS_WIN_T = 3 * MiB;
constexpr size_t WS_WOUT_T = 13 * MiB;
constexpr size_t WS_HC = 17 * MiB;
constexpr size_t WS_HCC = 51 * MiB;
constexpr size_t WS_AFFT = 53 * MiB;
constexpr size_t WS_ROWMAP = 56 * MiB;
constexpr size_t WS_GATE = 57 * MiB;
constexpr size_t WS_INV = 58 * MiB;
constexpr size_t WS_CRES = 61 * MiB;
constexpr size_t WS_HX = 69 * MiB;
constexpr size_t WS_WGU_T = 137 * MiB;
constexpr size_t WS_WD_T = 393 * MiB;
constexpr size_t WS_R = 521 * MiB;
constexpr size_t WS_ACT = WS_R;
constexpr size_t WS_XG = WS_R + 272 * MiB;
constexpr size_t WS_PX = WS_R;
constexpr size_t WS_Y = WS_R + 153 * MiB;
constexpr size_t WS_UT = WS_XG;
constexpr size_t WS_HS = WS_R + 408 * MiB;
constexpr size_t WS_END = WS_HS + 64 * MiB;
static_assert(WS_END <= 1024 * MiB, "workspace map");

struct Args { const float* in[N_IN]; float* out; unsigned char* ws; };

__device__ __forceinline__ float bf2f(unsigned short v) { return __uint_as_float(((unsigned)v) << 16); }
__device__ __forceinline__ unsigned f2bf(float f) { unsigned u = __float_as_uint(f); return (u + 0x7fffu + ((u >> 16) & 1u)) >> 16; }
__device__ __forceinline__ unsigned pk2(float lo, float hi) { return f2bf(lo) | (f2bf(hi) << 16); }
__device__ __forceinline__ float bflo(unsigned w) { return __uint_as_float(w << 16); }
__device__ __forceinline__ float bfhi(unsigned w) { return __uint_as_float(w & 0xffff0000u); }
__device__ __forceinline__ float dot2bf(unsigned a, unsigned b, float acc) { return __builtin_amdgcn_fdot2_f32_bf16(__builtin_bit_cast(bf16x2_t, a), __builtin_bit_cast(bf16x2_t, b), acc, false); }
__device__ __forceinline__ float wave_sum(float v) {
#pragma unroll
    for (int o = 1; o < 64; o <<= 1) v += __shfl_xor(v, o);
    return v;
}
#define LDS_WAIT() asm volatile("s_waitcnt lgkmcnt(0)" ::: "memory")

__device__ __forceinline__ void tr_item(const float* W, int K, int N, bf16_t* WT, int Kt, int item, int mode, LAS float* scr, int lane) {
    const int nblk = N / 32, kb = item / nblk, nb = item % nblk, k0 = 64 * kb, n0 = 32 * nb;
#pragma unroll 8
    for (int i = 0; i < 32; ++i) { const int kk = 2 * i + (lane >> 5); scr[kk * 33 + (lane & 31)] = W[(size_t)(k0 + kk) * N + n0 + (lane & 31)]; }
    LDS_WAIT();
    const int c = lane & 7;
    const int drow0 = (mode == 0) ? n0 : ((n0 >> 7) * 256 + (n0 & 127) + (mode == 2 ? 128 : 0));
#pragma unroll
    for (int j = 0; j < 4; ++j) { const int n = (lane >> 3) + 8 * j; const LAS float* s = scr + (8 * c) * 33 + n;
        u32x4 o; o.x = pk2(s[0 * 33], s[1 * 33]); o.y = pk2(s[2 * 33], s[3 * 33]); o.z = pk2(s[4 * 33], s[5 * 33]); o.w = pk2(s[6 * 33], s[7 * 33]);
        *(u32x4*)(WT + (size_t)(drow0 + n) * Kt + k0 + 8 * c) = o; }
    LDS_WAIT();
}

__device__ __forceinline__ void filter_pos(const Args& a, int l, int L, int p, float* HCdst, int lane) {
    const float* w1 = a.in[I_HW1] + l * 33 * 64; const float* b1 = a.in[I_HB1] + l * 64; const float* w2 = a.in[I_HW2] + l * 64 * 64; const float* b2 = a.in[I_HB2] + l * 64;
    const float* w3 = a.in[I_HW3] + l * 64 * 1024; const float* fr = a.in[I_HFREQ] + l * 64;
    const float tn = (float)p / (float)(L - 1);
    float fv = 0.f;
    if (lane == 0) fv = tn;
    else if (lane <= 32) { const int bi = (lane - 1) & 15; const float band = 1e-4f + (float)bi * ((15.0f - 1e-4f) / 15.0f);
        const float ang = ((float)(6.283185307179586 / (double)L) * (float)p) * band; fv = (lane <= 16) ? cosf(ang) : -sinf(ang); }
    float a1 = b1[lane];
    for (int i = 0; i < 33; ++i) a1 += __shfl(fv, i) * w1[i * 64 + lane];
    const float frq = fr[lane];
    const float h1 = sinf(frq * a1);
    float a2 = b2[lane];
    for (int i = 0; i < 64; ++i) a2 += __shfl(h1, i) * w2[i * 64 + lane];
    const float h2 = sinf(frq * a2);
    float o[16];
#pragma unroll
    for (int q = 0; q < 16; ++q) o[q] = 0.f;
    for (int i = 0; i < 64; ++i) { const float hv = __shfl(h2, i);
#pragma unroll
        for (int q = 0; q < 16; ++q) o[q] += hv * w3[i * 1024 + q * 64 + lane]; }
    const float dmin = 3.0701134573253945f, dmax = 15.350567286626972f;
#pragma unroll
    for (int ord = 0; ord < 2; ++ord)
#pragma unroll
        for (int cs = 0; cs < 4; ++cs) { const int c = cs * 64 + lane; const float delta = dmin + (float)c * ((dmax - dmin) / 255.0f); const float win = expf(-tn * delta);
            const float vf = o[ord * 8 + cs] * win, vb = o[ord * 8 + 4 + cs] * win;
            float* base = HCdst + (size_t)ord * (2 * L - 1) * 256;
            if (p == 0) base[(size_t)(L - 1) * 256 + c] = vf + vb;
            else { base[(size_t)(L - 1 + p) * 256 + c] = vf; base[(size_t)(L - 1 - p) * 256 + c] = vb; } }
}

__device__ __forceinline__ void phase_prologue(const Args& a, unsigned char* ldsg, int vcu, int G) {
    LAS unsigned char* lds = (LAS unsigned char*)ldsg;
    int tid_ = threadIdx.x; asm volatile("" : "+v"(tid_));
    const int tid = tid_, lane = tid & 63, wave = __builtin_amdgcn_readfirstlane(tid >> 6);
    unsigned char* ws = a.ws;
    LAS float* sc = (LAS float*)lds; LAS float* red = (LAS float*)(lds + 36864);
    for (int i = tid; i < 9 * 1024; i += NTHR) { const float v = (i < 8192) ? a.in[I_C][i] : a.in[I_CCTX][i - 8192]; sc[i] = v / (1.0f + expf(-v)); }
    __syncthreads();
    float* MOD = (float*)(ws + WS_MOD);
    for (int item = vcu; item < 2 * 96; item += G) {
        const int l = item / 96, n0 = (item % 96) * 64, col = tid & 63, kg = tid >> 6;
        float acc[9];
#pragma unroll
        for (int r = 0; r < 9; ++r) acc[r] = 0.f;
        const float* w = a.in[I_ADAW] + (size_t)l * 1024 * 6144 + n0 + col;
#pragma unroll 4
        for (int k = kg * 128; k < kg * 128 + 128; ++k) { const float wv = w[(size_t)k * 6144];
#pragma unroll
            for (int r = 0; r < 9; ++r) acc[r] += sc[r * 1024 + k] * wv; }
#pragma unroll
        for (int r = 0; r < 9; ++r) red[(kg * 9 + r) * 64 + col] = acc[r];
        __syncthreads();
        for (int o = tid; o < 9 * 64; o += NTHR) { const int r = o >> 6, cc = o & 63; float s = 0.f;
#pragma unroll
            for (int g2 = 0; g2 < 8; ++g2) s += red[(g2 * 9 + r) * 64 + cc];
            MOD[(size_t)(l * 9 + r) * 6144 + n0 + cc] = s + a.in[I_ADAB][l * 6144 + n0 + cc]; }
        __syncthreads();
    }
    if (vcu == 0) { float* ROPE = (float*)(ws + WS_ROPE);
        for (int i = tid; i < 1024; i += NTHR) { const int pos = i >> 4, fi = i & 15; const float inv = powf(10000.0f, -(float)fi / 16.0f); const float ang = (float)pos * inv;
            ROPE[2 * i] = cosf(ang); ROPE[2 * i + 1] = sinf(ang); } }
    if (vcu == 1 % G) { float* TW8 = (float*)(ws + WS_TW8);
        for (int i = tid; i < 8192; i += NTHR) { float sn, cs; sincospif(-(float)i * (1.0f / 4096.0f), &sn, &cs); TW8[2 * i] = cs; TW8[2 * i + 1] = sn; } }
    const int gw = vcu * NWAVES + wave, NGW = G * NWAVES;
    for (int it = gw; it < 8448; it += NGW) {
        if (it < 4096) filter_pos(a, 0, 4096, it, (float*)(ws + WS_HC), lane);
        else if (it < 8192) filter_pos(a, 1, 4096, it - 4096, (float*)(ws + WS_HC) + (size_t)2 * 8191 * 256, lane);
        else filter_pos(a, 0, 256, it - 8192, (float*)(ws + WS_HCC) + 256, lane);
    }
    LAS float* scr = (LAS float*)(lds + 65536 + wave * 8448);
    constexpr int IT_IN = 16 * 72, IT_OUT = 16 * 32, IT_E = 1024, IT_LAYER = IT_IN + IT_OUT + 3 * 16 * IT_E;
    for (int it = gw; it < 2 * IT_LAYER; it += NGW) {
        const int l = it / IT_LAYER; int r = it % IT_LAYER;
        if (r < IT_IN) { tr_item(a.in[I_WIN] + (size_t)l * 1024 * 2304, 1024, 2304, (bf16_t*)(ws + WS_WIN_T) + (size_t)l * 2304 * 1024, 1024, r, 0, scr, lane); continue; } r -= IT_IN;
        if (r < IT_OUT) { tr_item(a.in[I_WOUT] + (size_t)l * 1024 * 1024, 1024, 1024, (bf16_t*)(ws + WS_WOUT_T) + (size_t)l * 1024 * 1024, 1024, r, 0, scr, lane); continue; } r -= IT_OUT;
        const int which = r / (16 * IT_E), e = (r / IT_E) & 15, ri = r % IT_E; const size_t le = (size_t)l * 16 + e;
        if (which == 0) tr_item(a.in[I_WG] + le * 1024 * 2048, 1024, 2048, (bf16_t*)(ws + WS_WGU_T) + le * 4096 * 1024, 1024, ri, 1, scr, lane);
        else if (which == 1) tr_item(a.in[I_WU] + le * 1024 * 2048, 1024, 2048, (bf16_t*)(ws + WS_WGU_T) + le * 4096 * 1024, 1024, ri, 2, scr, lane);
        else tr_item(a.in[I_WD] + le * 2048 * 1024, 2048, 1024, (bf16_t*)(ws + WS_WD_T) + le * 1024 * 2048, 2048, ri, 0, scr, lane);
    }
}

__device__ __forceinline__ void phase_norm(const Args& a, unsigned char* ldsg, int vcu, int G, int l, const float* srcx, const float* srcc, const float* gain, int shift_idx, int nrows, bool router) {
    int tid_ = threadIdx.x; asm volatile("" : "+v"(tid_));
    const int tid = tid_, lane = tid & 63, wave = __builtin_amdgcn_readfirstlane(tid >> 6);
    unsigned char* ws = a.ws; const float* MOD = (const float*)(ws + WS_MOD) + (size_t)l * 9 * 6144; bf16_t* HX = (bf16_t*)(ws + WS_HX);
    LAS float* rw = (LAS float*)(LAS unsigned char*)ldsg;
    if (router) { const float* rsrc = a.in[I_ROUTER] + (size_t)l * 1024 * 16; for (int i = tid; i < 1024 * 16; i += NTHR) rw[(i & 15) * 1024 + (i >> 4)] = rsrc[i]; __syncthreads(); }
    const int gw = vcu * NWAVES + wave, NGW = G * NWAVES;
    for (int row = gw; row < nrows; row += NGW) {
        const bool lat = row < TX; const float* xr = lat ? srcx + (size_t)row * D : srcc + (size_t)(row - TX) * D; const int mrow = lat ? (row >> 12) : 8;
        const float* shp = MOD + mrow * 6144 + shift_idx * 1024; const float* scp = shp + 1024;
        f32x4 v[4]; float ss = 0.f;
#pragma unroll
        for (int j = 0; j < 4; ++j) { v[j] = *(const f32x4*)(xr + 256 * j + 4 * lane); ss += (v[j][0] * v[j][0] + v[j][1] * v[j][1]) + (v[j][2] * v[j][2] + v[j][3] * v[j][3]); }
        const float rstd = 1.0f / sqrtf(wave_sum(ss) * (1.0f / D) + 1e-6f);
#pragma unroll
        for (int j = 0; j < 4; ++j) { const f32x4 gg = *(const f32x4*)(gain + 256 * j + 4 * lane), sh = *(const f32x4*)(shp + 256 * j + 4 * lane), sc = *(const f32x4*)(scp + 256 * j + 4 * lane);
            v[j] = (v[j] * rstd * gg) * (1.0f + sc) + sh;
            u32x2 o; o.x = pk2(v[j][0], v[j][1]); o.y = pk2(v[j][2], v[j][3]); *(u32x2*)(HX + (size_t)row * D + 256 * j + 4 * lane) = o; }
        if (router) {
            float mylog = -1e30f;
#pragma unroll 1
            for (int e = 0; e < 16; ++e) { float p = 0.f;
#pragma unroll
                for (int j = 0; j < 4; ++j) { const f32x4 wv = *(const LAS f32x4*)(rw + e * 1024 + 256 * j + 4 * lane);
                    p += (v[j][0] * wv[0] + v[j][1] * wv[1]) + (v[j][2] * wv[2] + v[j][3] * wv[3]); }
                p = wave_sum(p); mylog = (lane == e) ? p : mylog; }
            float mx = mylog;
#pragma unroll
            for (int o = 1; o < 16; o <<= 1) mx = fmaxf(mx, __shfl_xor(mx, o));
            const float mine = (lane < 16) ? expf(mylog - mx) : 0.f; float den = mine;
#pragma unroll
            for (int o = 1; o < 16; o <<= 1) den += __shfl_xor(den, o);
            if (lane < 16) { ((float*)(ws + WS_AFFT))[(size_t)lane * TT + row] = mine / den; ((int*)(ws + WS_INV))[(size_t)row * 16 + lane] = -1; }
        }
    }
}

typedef float f32x2 __attribute__((ext_vector_type(2)));
__device__ __forceinline__ f32x2 cmul(f32x2 a, f32x2 b) { return (f32x2){a.x * b.x - a.y * b.y, a.x * b.y + a.y * b.x}; }
__device__ __forceinline__ void dft16(f32x2 (&v)[16]) {
    constexpr float WC[8] = {1.0f, 0.92387953251128674f, 0.70710678118654752f, 0.38268343236508977f, 0.0f, -0.38268343236508977f, -0.70710678118654752f, -0.92387953251128674f};
    constexpr float WS[8] = {0.0f, -0.38268343236508977f, -0.70710678118654752f, -0.92387953251128674f, -1.0f, -0.92387953251128674f, -0.70710678118654752f, -0.38268343236508977f};
#pragma unroll
    for (int s = 8; s >= 1; s >>= 1)
#pragma unroll
        for (int i = 0; i < 16; ++i) if ((i & s) == 0) { const int k = (i & (s - 1)) * (8 / s); const f32x2 u = v[i], t = v[i + s]; v[i] = u + t; const f32x2 d = u - t;
            v[i + s] = (k == 0) ? d : ((k == 4) ? (f32x2){d.y, -d.x} : (f32x2){d.x * WC[k] - d.y * WS[k], d.x * WS[k] + d.y * WC[k]}); }
}
__device__ __forceinline__ constexpr int bitrev4(int i) { return ((i & 1) << 3) | ((i & 2) << 1) | ((i & 4) >> 1) | ((i & 8) >> 3); }
template <int NS, int MODE>
__device__ __forceinline__ void fft_pass(LAS f32x2* Z, const LAS f32x2* TW, int tid, const f32x2* H) {
    const int f = tid >> 8, j = tid & 255, base = f * 4096, k = j & (NS - 1);
    f32x2 v[16];
#pragma unroll
    for (int r = 0; r < 16; ++r) { const int idx = base + j + 256 * r; v[r] = Z[idx + (idx >> 4)]; }
    if (MODE == 1) {
#pragma unroll
        for (int r = 0; r < 16; ++r) { const f32x2 p = cmul(v[r], H[base + j + 256 * r]); v[r] = (f32x2){p.y, p.x}; } }
    if (NS > 1) { constexpr int step = 8192 / (NS * 16);
#pragma unroll
        for (int r = 1; r < 16; ++r) v[r] = cmul(v[r], TW[r * k * step]); }
    dft16(v);
    __syncthreads();
    const int j0 = base + (j / NS) * NS * 16 + k;
#pragma unroll
    for (int rr = 0; rr < 16; ++rr) { const int idx = j0 + rr * NS; Z[idx + (idx >> 4)] = v[bitrev4(rr)]; }
    __syncthreads();
}
__device__ __forceinline__ void load_uc(const bf16_t* UT, const float* cw, const float* cb, int ch, int b, int tid, float (&out)[8]) {
    const bf16_t* p = UT + ((size_t)(b * 768 + ch)) * 4096 + 8 * tid;
    const u32x4 w = *(const u32x4*)p; float u[10];
    u[1] = bflo(w.x); u[2] = bfhi(w.x); u[3] = bflo(w.y); u[4] = bfhi(w.y); u[5] = bflo(w.z); u[6] = bfhi(w.z); u[7] = bflo(w.w); u[8] = bfhi(w.w);
    u[0] = (tid > 0) ? bf2f(p[-1]) : 0.f; u[9] = (tid < 511) ? bf2f(p[8]) : 0.f;
    const float w0 = cw[ch], w1 = cw[768 + ch], w2 = cw[1536 + ch], bb = cb[ch];
#pragma unroll
    for (int i = 0; i < 8; ++i) out[i] = u[i] * w0 + u[i + 1] * w1 + u[i + 2] * w2 + bb;
}
__device__ __forceinline__ void hy_fill(LAS f32x2* Z, const LAS f32x2* TW, int tid, const float (&va)[8], const float (&vb)[8]) {
#pragma unroll
    for (int i = 0; i < 8; ++i) { const int t = 8 * tid + i; const f32x2 z = {va[i], vb[i]}; Z[t + (t >> 4)] = z; const int t2 = 4096 + t; Z[t2 + (t2 >> 4)] = cmul(z, TW[t]); }
    __syncthreads();
}
__device__ __forceinline__ void hy_conv(LAS f32x2* Z, const LAS f32x2* TW, int tid, const f32x2* H) {
    fft_pass<1, 0>(Z, TW, tid, nullptr); fft_pass<16, 0>(Z, TW, tid, nullptr); fft_pass<256, 0>(Z, TW, tid, nullptr);
    fft_pass<1, 1>(Z, TW, tid, H); fft_pass<16, 0>(Z, TW, tid, nullptr); fft_pass<256, 0>(Z, TW, tid, nullptr);
}
__device__ __forceinline__ f32x2 hy_out(const LAS f32x2* Z, const LAS f32x2* TW, int t) {
    const f32x2 se = Z[t + (t >> 4)]; const int t2 = 4096 + t; const f32x2 so = Z[t2 + (t2 >> 4)]; const f32x2 tw = TW[t];
    const f32x2 So = {so.y, so.x};
    return (f32x2){se.y + (So.x * tw.x + So.y * tw.y), se.x + (So.y * tw.x - So.x * tw.y)};
}
__device__ __forceinline__ void hyena_item(const Args& a, LAS unsigned char* lds, int l, int c, int bp, int tid) {
    asm volatile("" : "+v"(tid));
    LAS f32x2* Z = (LAS f32x2*)lds; const LAS f32x2* TW = (const LAS f32x2*)(lds + 69632);
    const bf16_t* UT = (const bf16_t*)(a.ws + WS_UT); bf16_t* Y = (bf16_t*)(a.ws + WS_Y);
    const float* cw = a.in[I_HCW] + (size_t)l * 3 * 768; const float* cb = a.in[I_HCB] + (size_t)l * 768; const float* skip = a.in[I_HSKIP] + (size_t)l * 2 * 256;
    const f32x2* HS = (const f32x2*)(a.ws + WS_HS) + ((size_t)(l * 2) * 256 + c) * 8192;
    const int b0 = 2 * bp, b1 = 2 * bp + 1;
    float va[8], vb[8], xa[8], xb[8];
    load_uc(UT, cw, cb, c, b0, tid, va); load_uc(UT, cw, cb, c, b1, tid, vb);
    hy_fill(Z, TW, tid, va, vb);
    hy_conv(Z, TW, tid, HS);
    load_uc(UT, cw, cb, 256 + c, b0, tid, xa); load_uc(UT, cw, cb, 256 + c, b1, tid, xb);
    { const float sk = skip[c];
#pragma unroll
      for (int i = 0; i < 8; ++i) { const f32x2 y = hy_out(Z, TW, 8 * tid + i); va[i] = xa[i] * (y.x + va[i] * sk); vb[i] = xb[i] * (y.y + vb[i] * sk); } }
    __syncthreads();
    hy_fill(Z, TW, tid, va, vb);
    hy_conv(Z, TW, tid, HS + (size_t)256 * 8192);
    load_uc(UT, cw, cb, 512 + c, b0, tid, xa); load_uc(UT, cw, cb, 512 + c, b1, tid, xb);
    { const float sk = skip[256 + c];
#pragma unroll
      for (int i = 0; i < 8; ++i) { const int t = 8 * tid + i; const f32x2 y = hy_out(Z, TW, t);
          Y[((size_t)b0 * 4096 + t) * D + c] = (bf16_t)f2bf(xa[i] * (y.x + va[i] * sk)); Y[((size_t)b1 * 4096 + t) * D + c] = (bf16_t)f2bf(xb[i] * (y.y + vb[i] * sk)); } }
    __syncthreads();
}
__device__ __forceinline__ void spectrum_item(const Args& a, LAS unsigned char* lds, int item, int tid) {
    asm volatile("" : "+v"(tid));
    LAS f32x2* Z = (LAS f32x2*)lds; const LAS f32x2* TW = (const LAS f32x2*)(lds + 69632);
    const int c = item & 255, lo = item >> 8;
    const float* HC = (const float*)(a.ws + WS_HC) + (size_t)lo * 8191 * 256 + c;
#pragma unroll
    for (int i = 0; i < 8; ++i) { const int t = 8 * tid + i; const float hl = HC[(size_t)(4095 + t) * 256], hh = (t == 0) ? 0.f : HC[(size_t)(t - 1) * 256];
        Z[t + (t >> 4)] = (f32x2){hl + hh, 0.f}; const int t2 = 4096 + t; const f32x2 tw = TW[t]; const float dd = hl - hh; Z[t2 + (t2 >> 4)] = (f32x2){dd * tw.x, dd * tw.y}; }
    __syncthreads();
    fft_pass<1, 0>(Z, TW, tid, nullptr); fft_pass<16, 0>(Z, TW, tid, nullptr); fft_pass<256, 0>(Z, TW, tid, nullptr);
    f32x2* HS = (f32x2*)(a.ws + WS_HS) + (size_t)item * 8192;
#pragma unroll
    for (int i = 0; i < 16; ++i) { const int idx = tid + 512 * i; HS[idx] = Z[idx + (idx >> 4)] * (1.0f / 8192.0f); }
    __syncthreads();
}
__device__ __forceinline__ void load_tw(const Args& a, LAS unsigned char* lds, int tid) {
    LAS f32x2* TW = (LAS f32x2*)(lds + 69632); const f32x2* src = (const f32x2*)(a.ws + WS_TW8);
    for (int i = tid; i < 8192; i += NTHR) TW[i] = src[i];
    __syncthreads();
}
__device__ __forceinline__ float ctx_uc(const bf16_t* PXc, const float* cw, const float* cb, int ch, int t) {
    const float u1 = bf2f(PXc[(size_t)t * INW + ch]); const float u0 = (t > 0) ? bf2f(PXc[(size_t)(t - 1) * INW + ch]) : 0.f; const float u2 = (t < 255) ? bf2f(PXc[(size_t)(t + 1) * INW + ch]) : 0.f;
    return u0 * cw[ch] + u1 * cw[768 + ch] + u2 * cw[1536 + ch] + cb[ch];
}
__device__ __forceinline__ void ctx_conv16(const LAS float* IN, const float* H, int c, int lane, int t0, float (&acc)[16]) {
    float w[16];
    const float* hp = H + (size_t)(t0 + 255) * 256 + c;
#pragma unroll
    for (int i = 0; i < 16; ++i) { acc[i] = 0.f; w[i] = hp[i * 256]; }
    const LAS float* ip = IN + lane;
#pragma unroll 1
    for (int s0 = 0; s0 < 256; s0 += 16) {
#pragma unroll
        for (int u = 0; u < 16; ++u) { const float v = ip[u * 64];
#pragma unroll
            for (int i = 0; i < 16; ++i) acc[i] += v * w[(i - u + 16) & 15];
            w[(15 - u) & 15] = hp[-(u + 1) * 256]; }
        hp -= 16 * 256; ip += 16 * 64; }
}
__device__ __forceinline__ void ctx_hyena_item(const Args& a, LAS unsigned char* lds, int l, int item, int tid) {
    asm volatile("" : "+v"(tid));
    const int lane = tid & 63, wave = tid >> 6, b = item >> 2, c = (item & 3) * 64 + lane;
    LAS float* V = (LAS float*)lds; LAS float* Z1 = (LAS float*)(lds + 65536);
    const bf16_t* PXc = (const bf16_t*)(a.ws + WS_PX) + (size_t)(TX + b * 256) * INW; bf16_t* Y = (bf16_t*)(a.ws + WS_Y) + (size_t)(TX + b * 256) * D;
    const float* cw = a.in[I_HCW] + (size_t)l * 3 * 768; const float* cb = a.in[I_HCB] + (size_t)l * 768; const float* skip = a.in[I_HSKIP] + (size_t)l * 2 * 256;
    const float* H0 = (const float*)(a.ws + WS_HCC) + 256, *H1 = H0 + (size_t)511 * 256;
#pragma unroll 2
    for (int i = 0; i < 32; ++i) { const int t = wave * 32 + i; V[t * 64 + lane] = ctx_uc(PXc, cw, cb, c, t); }
    __syncthreads();
    float acc[16];
#pragma unroll 1
    for (int g = 0; g < 2; ++g) { const int t0 = wave * 32 + g * 16; ctx_conv16(V, H0, c, lane, t0, acc); const float sk = skip[c];
#pragma unroll
        for (int i = 0; i < 16; ++i) { const int t = t0 + i; Z1[t * 64 + lane] = ctx_uc(PXc, cw, cb, 256 + c, t) * (acc[i] + V[t * 64 + lane] * sk); } }
    __syncthreads();
#pragma unroll 1
    for (int g = 0; g < 2; ++g) { const int t0 = wave * 32 + g * 16; ctx_conv16(Z1, H1, c, lane, t0, acc); const float sk = skip[256 + c];
#pragma unroll
        for (int i = 0; i < 16; ++i) { const int t = t0 + i; Y[(size_t)t * D + c] = (bf16_t)f2bf(ctx_uc(PXc, cw, cb, 512 + c, t) * (acc[i] + Z1[t * 64 + lane] * sk)); } }
    __syncthreads();
}

#define PIN16(o, b) asm volatile("" : "+v"(o[b]), "+v"(o[b + 1]), "+v"(o[b + 2]), "+v"(o[b + 3]), "+v"(o[b + 4]), "+v"(o[b + 5]), "+v"(o[b + 6]), "+v"(o[b + 7]), "+v"(o[b + 8]), "+v"(o[b + 9]), "+v"(o[b + 10]), "+v"(o[b + 11]), "+v"(o[b + 12]), "+v"(o[b + 13]), "+v"(o[b + 14]), "+v"(o[b + 15]) :: "memory")
__device__ __forceinline__ void att_chunk(const bf16_t* PX, LAS unsigned char* stg, int kcol, int vcol, int row0, const float (&bias)[8], const unsigned (&q)[32], float& m, float& lsum, float (&o)[64], int lane) {
    { const bf16_t* rp = PX + (size_t)(row0 + (lane >> 3)) * INW + (lane & 7) * 8;
      const u32x4 kv = *(const u32x4*)(rp + kcol), vv = *(const u32x4*)(rp + vcol);
      *(LAS u32x4*)(stg + lane * 16) = kv; *(LAS u32x4*)(stg + 1024 + lane * 16) = vv; }
    LDS_WAIT();
    float s[8];
#pragma unroll
    for (int kk = 0; kk < 8; ++kk) { const LAS u32x4* kp = (const LAS u32x4*)(stg + kk * 128); float d0 = 0.f, d1 = 0.f;
#pragma unroll
        for (int i = 0; i < 8; ++i) { const u32x4 kv = kp[i]; d0 = dot2bf(kv.x, q[4 * i], d0); d1 = dot2bf(kv.y, q[4 * i + 1], d1); d0 = dot2bf(kv.z, q[4 * i + 2], d0); d1 = dot2bf(kv.w, q[4 * i + 3], d1); }
        s[kk] = (bias[kk] > -1e29f) ? (d0 + d1) * (0.125f * LOG2E) + bias[kk] : -1e30f;
        asm volatile("" : "+v"(s[kk]) :: "memory"); }
    float cm = s[0];
#pragma unroll
    for (int kk = 1; kk < 8; ++kk) cm = fmaxf(cm, s[kk]);
    const float mnew = fmaxf(m, cm), corr = __builtin_amdgcn_exp2f(m - mnew);
    lsum *= corr;
#pragma unroll
    for (int d = 0; d < 64; ++d) o[d] *= corr;
    m = mnew;
#pragma unroll
    for (int kk = 0; kk < 8; ++kk) { const float p = (s[kk] > -1e29f) ? __builtin_amdgcn_exp2f(s[kk] - mnew) : 0.f; lsum += p;
        const LAS u32x4* vp = (const LAS u32x4*)(stg + 1024 + kk * 128);
#pragma unroll
        for (int i = 0; i < 8; ++i) { const u32x4 vv = vp[i];
            o[8 * i + 0] += p * bflo(vv.x); o[8 * i + 1] += p * bfhi(vv.x); o[8 * i + 2] += p * bflo(vv.y); o[8 * i + 3] += p * bfhi(vv.y);
            o[8 * i + 4] += p * bflo(vv.z); o[8 * i + 5] += p * bfhi(vv.z); o[8 * i + 6] += p * bflo(vv.w); o[8 * i + 7] += p * bfhi(vv.w); }
        PIN16(o, 0); PIN16(o, 16); PIN16(o, 32); PIN16(o, 48); }
}
template <int MODE>
__device__ __forceinline__ void attn_wave(const Args& a, LAS unsigned char* stg, int l, int item, int lane) {
    const bf16_t* PX = (const bf16_t*)(a.ws + WS_PX); bf16_t* Y = (bf16_t*)(a.ws + WS_Y);
    int b, h, qrow, qcol, kcol, vcol, ycol, t = 0, r = 0, hb = 0;
    if (MODE == 0) { b = item >> 8; h = (item >> 6) & 3; hb = item & 63; t = hb * 64 + lane; qrow = b * 4096 + t; qcol = 1024 + h * 64; kcol = 1536 + (h >> 1) * 64; vcol = 1664 + (h >> 1) * 64; ycol = 256 + h * 64; }
    else if (MODE == 1) { b = item >> 8; h = (item >> 6) & 3; r = item & 63; t = r * 64 + lane; qrow = b * 4096 + t; qcol = 1280 + h * 64; kcol = 1792 + h * 64; vcol = 2048 + h * 64; ycol = 768 + h * 64; }
    else if (MODE == 2) { b = item >> 4; h = (item >> 2) & 3; qrow = TX + b * 256 + (item & 3) * 64 + lane; qcol = 1024 + h * 64; kcol = 1536 + (h >> 1) * 64; vcol = 1664 + (h >> 1) * 64; ycol = 256 + h * 64; }
    else { b = item >> 4; h = (item >> 2) & 3; qrow = TX + b * 256 + (item & 3) * 64 + lane; qcol = 1280 + h * 64; kcol = 1792 + h * 64; vcol = 2048 + h * 64; ycol = 768 + h * 64; }
    unsigned q[32];
    { const u32x4* qp = (const u32x4*)(PX + (size_t)qrow * INW + qcol);
#pragma unroll
      for (int i = 0; i < 8; ++i) { const u32x4 v = qp[i]; q[4 * i] = v.x; q[4 * i + 1] = v.y; q[4 * i + 2] = v.z; q[4 * i + 3] = v.w; } }
    float m = -1e30f, lsum = 0.f; float o[64];
#pragma unroll
    for (int d = 0; d < 64; ++d) o[d] = 0.f;
    float bias[8];
    if (MODE == 0) {
        const int klo = (hb * 64 - 128) > 0 ? (hb * 64 - 128) : 0, khi = (hb * 64 + 191) < 4095 ? (hb * 64 + 191) : 4095;
        for (int j0 = klo; j0 <= khi; j0 += 8) {
#pragma unroll
            for (int kk = 0; kk < 8; ++kk) { const int kp = j0 + kk; const int dd = t - kp; bias[kk] = (dd <= 128 && dd >= -128) ? 0.f : -1e30f; }
            att_chunk(PX, stg, kcol, vcol, b * 4096 + j0, bias, q, m, lsum, o, lane); }
    }
    if (MODE == 1) {
        const int r0 = (r - 4) < 0 ? 0 : ((r - 4) > 56 ? 56 : (r - 4)); const int c = lane; const int wsc = (c - 8) < 0 ? 0 : ((c - 8) > 48 ? 48 : (c - 8));
        const float* rpb = a.in[I_RPB] + (size_t)(l * 4 + h) * 15 * 31;
        for (int kr = 0; kr < 8; ++kr) { const int rk = r0 + kr;
            for (int ck0 = 0; ck0 < 64; ck0 += 8) {
#pragma unroll
                for (int kk = 0; kk < 8; ++kk) { const int ck = ck0 + kk; const bool ok = (ck >= wsc) && (ck < wsc + 16);
                    const int bi = ok ? ((rk - r + 7) * 31 + (ck - c + 15)) : 0; bias[kk] = ok ? rpb[bi] * LOG2E : -1e30f; }
                att_chunk(PX, stg, kcol, vcol, b * 4096 + rk * 64 + ck0, bias, q, m, lsum, o, lane); } }
    }
    for (int j0 = 0; j0 < 256; j0 += 8) {
#pragma unroll
        for (int kk = 0; kk < 8; ++kk) bias[kk] = 0.f;
        att_chunk(PX, stg, kcol, vcol, TX + b * 256 + j0, bias, q, m, lsum, o, lane); }
    if (MODE == 0 || MODE == 2) lsum += __builtin_amdgcn_exp2f(a.in[I_SINK][l * 4 + h] * LOG2E - m);
    const float inv = 1.0f / lsum;
    u32x4* yp = (u32x4*)(Y + (size_t)qrow * D + ycol);
#pragma unroll
    for (int i = 0; i < 8; ++i) { u32x4 w; w.x = pk2(o[8 * i] * inv, o[8 * i + 1] * inv); w.y = pk2(o[8 * i + 2] * inv, o[8 * i + 3] * inv); w.z = pk2(o[8 * i + 4] * inv, o[8 * i + 5] * inv); w.w = pk2(o[8 * i + 6] * inv, o[8 * i + 7] * inv); yp[i] = w; }
}

__device__ __forceinline__ void phase_mix1(const Args& a, unsigned char* ldsg, int vcu, int G, int l) {
    LAS unsigned char* lds = (LAS unsigned char*)ldsg;
    int tid_ = threadIdx.x; asm volatile("" : "+v"(tid_));
    const int tid = tid_, lane = tid & 63, wave = __builtin_amdgcn_readfirstlane(tid >> 6);
    unsigned char* ws = a.ws; const bf16_t* PX = (const bf16_t*)(ws + WS_PX); bf16_t* Y = (bf16_t*)(ws + WS_Y);
    const bool upd = (l == 0); const int nrows = upd ? TT : TX;
    const int gw = vcu * NWAVES + wave, NGW = G * NWAVES;
    load_tw(a, lds, tid);
    for (int it = vcu; it < 1024; it += G) hyena_item(a, lds, l, it >> 2, it & 3, tid);
    if (upd) for (int it = vcu; it < 32; it += G) ctx_hyena_item(a, lds, l, it, tid);
    __syncthreads();
    LAS float* pw = (LAS float*)lds; LAS float* dv = (LAS float*)(lds + 65536 + wave * 1024);
    { const float* src = a.in[I_POOLW] + (size_t)l * 4 * 64 * 64; for (int i = tid; i < 4 * 64 * 64; i += NTHR) pw[i] = src[i]; }
    __syncthreads();
    const float* pscale = a.in[I_POOLS] + (size_t)l * 256;
    for (int row = gw; row < nrows; row += NGW) {
        const bool lat = row < TX; const int tpos = lat ? (row & 4095) : ((row - TX) & 255); const int Ls = lat ? 4096 : 256;
        const bf16_t* pr = PX + (size_t)row * INW;
        { const int g = lane >> 4, hw = 1 << g;
          const int c = 768 + 4 * lane; float s0 = 0.f, s1 = 0.f, s2 = 0.f, s3 = 0.f; int cnt = 0;
#pragma unroll
          for (int off = -8; off < 8; ++off) { const int tp = tpos + off; const bool in = (off >= -hw) && (off < hw) && (tp >= 0) && (tp < Ls);
              if (in) { const u32x2 v = *(const u32x2*)(pr + (ptrdiff_t)off * INW + c); s0 += bflo(v.x); s1 += bfhi(v.x); s2 += bflo(v.y); s3 += bfhi(v.y); cnt++; } }
          const u32x2 u0 = *(const u32x2*)(pr + c); const float ic = 1.0f / (float)cnt;
          f32x4 dd; dd[0] = s0 * ic - bflo(u0.x); dd[1] = s1 * ic - bfhi(u0.x); dd[2] = s2 * ic - bflo(u0.y); dd[3] = s3 * ic - bfhi(u0.y);
          *(LAS f32x4*)(dv + 4 * lane) = dd;
          LDS_WAIT();
          const int j0 = 4 * (lane & 15); f32x4 acc = {0.f, 0.f, 0.f, 0.f};
          const LAS float* dg = dv + g * 64; const LAS float* wg = pw + g * 4096 + j0;
#pragma unroll 8
          for (int i = 0; i < 64; ++i) { const float di = dg[i]; const f32x4 wv = *(const LAS f32x4*)(wg + i * 64); acc += wv * di; }
          const f32x4 sc = *(const f32x4*)(pscale + g * 64 + j0); acc *= sc;
          u32x2 ov; ov.x = pk2(acc[0], acc[1]); ov.y = pk2(acc[2], acc[3]);
          *(u32x2*)(Y + (size_t)row * D + 512 + g * 64 + j0) = ov;
          LDS_WAIT(); }
    }
    LAS unsigned char* stg = lds + 81920 + wave * 2048;
    const int n_att = 2048 + 2048 + (upd ? 256 : 0);
    for (int it = gw; it < n_att; it += NGW) {
        if (it < 2048) attn_wave<0>(a, stg, l, it, lane);
        else if (it < 4096) attn_wave<1>(a, stg, l, it - 2048, lane);
        else if (it < 4224) attn_wave<2>(a, stg, l, it - 4096, lane);
        else attn_wave<3>(a, stg, l, it - 4224, lane);
    }
}

__device__ __forceinline__ void phase_select(const Args& a, unsigned char* ldsg, int vcu, int G, bool with_ctx) {
    LAS float* vals = (LAS float*)(LAS unsigned char*)ldsg;
    int tid_ = threadIdx.x; asm volatile("" : "+v"(tid_));
    const int tid = tid_; unsigned char* ws = a.ws;
    const float* AFFT = (const float*)(ws + WS_AFFT); int* ROWMAP = (int*)(ws + WS_ROWMAP); float* GATE = (float*)(ws + WS_GATE); int* INV = (int*)(ws + WS_INV);
    const int nitems = 1024 + (with_ctx ? 128 : 0);
    for (int item = vcu; item < nitems; item += G) {
        int e, ch, base, Ls, cap, slot0;
        if (item < 1024) { const int b = item >> 7; e = (item >> 3) & 15; ch = item & 7; base = b * 4096; Ls = 4096; cap = CAPX; slot0 = b * CAPX; }
        else { const int it = item - 1024; const int b = it >> 4; e = it & 15; ch = 0; base = TX + b * 256; Ls = 256; cap = CAPC; slot0 = NB * CAPX + b * CAPC; }
        for (int i = tid; i < Ls; i += NTHR) vals[i] = AFFT[(size_t)e * TT + base + i];
        __syncthreads();
        const int i = ch * NTHR + tid;
        if (i < Ls) { const float av = vals[i]; int cnt = 0;
            for (int j4 = 0; j4 < Ls; j4 += 4) { const f32x4 v = *(const LAS f32x4*)(vals + j4);
#pragma unroll
                for (int q = 0; q < 4; ++q) cnt += ((v[q] > av) || (v[q] == av && (j4 + q) < i)) ? 1 : 0; }
            if (cnt < cap) { const int slot = e * SLOTS + slot0 + cnt; ROWMAP[slot] = base + i; GATE[slot] = av; INV[(size_t)(base + i) * 16 + e] = slot; } }
        __syncthreads();
    }
}
__device__ __forceinline__ void phase_gather(const Args& a, int vcu, int G, bool with_ctx) {
    int tid_ = threadIdx.x; asm volatile("" : "+v"(tid_));
    const int tid = tid_, lane = tid & 63, wave = __builtin_amdgcn_readfirstlane(tid >> 6); unsigned char* ws = a.ws;
    const int* ROWMAP = (const int*)(ws + WS_ROWMAP); const bf16_t* HX = (const bf16_t*)(ws + WS_HX); bf16_t* XG = (bf16_t*)(ws + WS_XG);
    const int per = with_ctx ? SLOTS : NB * CAPX; const int gw = vcu * NWAVES + wave, NGW = G * NWAVES;
    for (int it = gw; it < NE * per; it += NGW) { const int e = it / per, s = it % per; const int slot = e * SLOTS + s; const int src = ROWMAP[slot];
        const u32x4* sp = (const u32x4*)(HX + (size_t)src * D) + 2 * lane; u32x4* dp = (u32x4*)(XG + (size_t)slot * D) + 2 * lane;
        const u32x4 v0 = sp[0], v1 = sp[1]; dp[0] = v0; dp[1] = v1; }
}
__device__ __forceinline__ void phase_combine(const Args& a, int vcu, int G, int l, bool with_ctx, bool final_norm) {
    int tid_ = threadIdx.x; asm volatile("" : "+v"(tid_));
    const int tid = tid_, lane = tid & 63, wave = __builtin_amdgcn_readfirstlane(tid >> 6); unsigned char* ws = a.ws;
    const int* INV = (const int*)(ws + WS_INV); const bf16_t* OB = (const bf16_t*)(ws + WS_XG); const float* MOD = (const float*)(ws + WS_MOD) + (size_t)l * 9 * 6144;
    float* CRES = (float*)(ws + WS_CRES); const float* fng = a.in[I_FNG];
    const int nrows = with_ctx ? TT : TX; const int gw = vcu * NWAVES + wave, NGW = G * NWAVES;
    for (int row = gw; row < nrows; row += NGW) {
        const bool lat = row < TX; float* xr = lat ? a.out + (size_t)row * D : CRES + (size_t)(row - TX) * D; const int mrow = lat ? (row >> 12) : 8;
        const int myinv = (lane < 16) ? INV[(size_t)row * 16 + lane] : -1;
        f32x4 acc[4];
#pragma unroll
        for (int j = 0; j < 4; ++j) acc[j] = (f32x4){0.f, 0.f, 0.f, 0.f};
        for (int e = 0; e < 16; ++e) { const int s = __shfl(myinv, e);
            if (s >= 0) { const bf16_t* orow = OB + (size_t)s * D;
#pragma unroll
                for (int j = 0; j < 4; ++j) { const u32x2 v = *(const u32x2*)(orow + 256 * j + 4 * lane); acc[j][0] += bflo(v.x); acc[j][1] += bfhi(v.x); acc[j][2] += bflo(v.y); acc[j][3] += bfhi(v.y); } } }
        const float* gp = MOD + mrow * 6144 + 5 * 1024; f32x4 v[4]; float ss = 0.f;
#pragma unroll
        for (int j = 0; j < 4; ++j) { const f32x4 g = *(const f32x4*)(gp + 256 * j + 4 * lane); v[j] = *(const f32x4*)(xr + 256 * j + 4 * lane) + g * acc[j];
            ss += (v[j][0] * v[j][0] + v[j][1] * v[j][1]) + (v[j][2] * v[j][2] + v[j][3] * v[j][3]); }
        if (final_norm) { const float rstd = 1.0f / sqrtf(wave_sum(ss) * (1.0f / D) + 1e-6f);
#pragma unroll
            for (int j = 0; j < 4; ++j) { const f32x4 g = *(const f32x4*)(fng + 256 * j + 4 * lane); v[j] = v[j] * rstd * g; } }
#pragma unroll
        for (int j = 0; j < 4; ++j) *(f32x4*)(xr + 256 * j + 4 * lane) = v[j];
    }
}

__global__ void __launch_bounds__(NTHR, 2) fwd_kernel(Args a) {
    extern __shared__ __attribute__((aligned(16))) unsigned char lds[];
    cg::grid_group grid = cg::this_grid();
    const int G = gridDim.x, bx = blockIdx.x; const int vcu = (G % 8 == 0) ? (bx % 8) * (G / 8) + bx / 8 : bx;
    unsigned char* ws = a.ws;
    PG8_LAS unsigned char* glds = (PG8_LAS unsigned char*)lds;
    phase_prologue(a, lds, vcu, G);
    grid.sync();
    for (int l = 0; l < 2; ++l) {
        const bool upd = (l == 0);
        const float* srcx = upd ? a.in[I_X] : a.out; const float* srcc = upd ? a.in[I_CTX] : (const float*)(ws + WS_CRES);
        phase_norm(a, lds, vcu, G, l, srcx, srcc, a.in[I_N1G] + l * D, 0, TT, false);
        if (upd) { load_tw(a, (LAS unsigned char*)lds, threadIdx.x); for (int it = vcu; it < 1024; it += G) spectrum_item(a, (LAS unsigned char*)lds, it, threadIdx.x); }
        grid.sync();
        { pg8::Gemm g{(const pg8::bf16_t*)(ws + WS_HX), (const pg8::bf16_t*)(ws + WS_WIN_T) + (size_t)l * INW * D, TT, INW, D};
          pg8::GroupOrder S; S.init(1, TT / 256, INW / 256, 0, G, bx);
          pg8::EpiIn E{(pg8::bf16_t*)(ws + WS_PX), (const float*)(ws + WS_ROPE), (pg8::bf16_t*)(ws + WS_UT), glds + 131072};
          pg8::gemm_phase<pg8::EpiIn, pg8::GroupOrder, true, true>(glds, g, S, E); }
        grid.sync();
        phase_mix1(a, lds, vcu, G, l);
        grid.sync();
        { pg8::Gemm g{(const pg8::bf16_t*)(ws + WS_Y), (const pg8::bf16_t*)(ws + WS_WOUT_T) + (size_t)l * D * D, TT, D, D};
          pg8::GroupOrder S; S.init(1, (upd ? TT : TX) / 256, D / 256, 0, G, bx);
          pg8::EpiOut E{srcx, srcc, a.out, (float*)(ws + WS_CRES), (const float*)(ws + WS_MOD) + (size_t)l * 9 * 6144};
          pg8::gemm_phase<pg8::EpiOut, pg8::GroupOrder, true, true>(glds, g, S, E); }
        grid.sync();
        phase_norm(a, lds, vcu, G, l, a.out, (const float*)(ws + WS_CRES), a.in[I_N2G] + l * D, 3, upd ? TT : TX, true);
        grid.sync();
        phase_select(a, lds, vcu, G, upd);
        grid.sync();
        phase_gather(a, vcu, G, upd);
        grid.sync();
        { pg8::Gemm g{(const pg8::bf16_t*)(ws + WS_XG), (const pg8::bf16_t*)(ws + WS_WGU_T) + (size_t)l * NE * 4096 * D, NE * SLOTS, NE * 4096, D};
          pg8::GroupOrder S; S.init(NE, upd ? 17 : 16, 16, 17, G, bx);
          pg8::EpiGU E{(pg8::bf16_t*)(ws + WS_ACT)};
          pg8::gemm_phase<pg8::EpiGU, pg8::GroupOrder, true, true>(glds, g, S, E); }
        grid.sync();
        { pg8::Gemm g{(const pg8::bf16_t*)(ws + WS_ACT), (const pg8::bf16_t*)(ws + WS_WD_T) + (size_t)l * NE * D * FF, NE * SLOTS, NE * D, FF};
          pg8::GroupOrder S; S.init(NE, upd ? 17 : 16, 4, 17, G, bx);
          pg8::EpiDown E{(pg8::bf16_t*)(ws + WS_XG), (const float*)(ws + WS_GATE)};
          pg8::gemm_phase<pg8::EpiDown, pg8::GroupOrder, true, true>(glds, g, S, E); }
        grid.sync();
        phase_combine(a, vcu, G, l, upd, !upd);
        if (upd) grid.sync();
    }
}

extern "C" void kernel_launch(void* const* d_in, const int* in_sizes, int n_in, void* d_out, int out_size, void* d_ws, size_t ws_size, hipStream_t stream) {
    static int grid = 0;
    if (grid == 0) {
        int dev = 0, cus = 0, per_cu = 0;
        hipGetDevice(&dev); hipDeviceGetAttribute(&cus, hipDeviceAttributeMultiprocessorCount, dev);
        if (hipFuncSetAttribute((const void*)fwd_kernel, hipFuncAttributeMaxDynamicSharedMemorySize, LDS_BYTES) != hipSuccess) { fprintf(stderr, "kernel_launch: hipFuncSetAttribute failed\n"); grid = -1; return; }
        if (hipOccupancyMaxActiveBlocksPerMultiprocessor(&per_cu, (const void*)fwd_kernel, NTHR, LDS_BYTES) != hipSuccess || per_cu < 1) { fprintf(stderr, "kernel_launch: occupancy query failed (%d)\n", per_cu); grid = -1; return; }
        grid = cus * 1;
        if (n_in != N_IN || ws_size < WS_END) { fprintf(stderr, "kernel_launch: unexpected n_in %d / ws %zu\n", n_in, ws_size); grid = -1; return; }
    }
    if (grid < 0) return;
    Args a{};
    for (int i = 0; i < N_IN; ++i) a.in[i] = (const float*)d_in[i];
    a.out = (float*)d_out; a.ws = (unsigned char*)d_ws;
    void* args[] = {&a};
    hipError_t e = hipLaunchCooperativeKernel((const void*)fwd_kernel, dim3(grid), dim3(NTHR), args, LDS_BYTES, stream);
    if (e != hipSuccess) fprintf(stderr, "cooperative launch failed: %s (grid %d)\n", hipGetErrorString(e), grid);
}
```

```cpp
#include <hip/hip_runtime.h>
#include <hip/hip_cooperative_groups.h>
#include <cstdio>
#include <cstdint>
namespace cg = cooperative_groups;
namespace pg8 {
#define PG8_LAS __attribute__((address_space(3)))
typedef unsigned short bf16_t;
typedef short bf16x8 __attribute__((ext_vector_type(8)));
typedef float f32x4 __attribute__((ext_vector_type(4)));
typedef unsigned u32x4 __attribute__((ext_vector_type(4)));
constexpr int BM = 256, BK = 64, HALF = 128, HTB = HALF * BK * 2  , STAGE_BYTES = 8 * HTB, NXCD = 8, WGM = 8;

__host__ __device__ __forceinline__ int lds_byte(int r, int c) { const int st = (r >> 4) * 2 + (c >> 5), rr = r & 15, cc = c & 31, ob = rr * 64 + cc * 2; return st * 1024 + (ob ^ (((ob >> 9) & 1) << 5)); }
__host__ __device__ __forceinline__ void stage_rc(int b, int& R, int& C) { const int st = b / 1024, sb = b % 1024, swz = sb ^ (((sb >> 9) & 1) << 5); R = (st >> 1) * 16 + swz / 64; C = (st & 1) * 32 + (swz % 64) / 2; }
__host__ __device__ __forceinline__ int perm32(int rho) { const int n = rho >> 4, i = rho & 15; return 8 * (i >> 2) + 4 * n + (i & 3); }

struct Unit { int pm, pn; };
struct Gemm { const bf16_t* A; const bf16_t* Bt; int M, N, K; };

struct StaticOrder {
    int nM, nN, nwg, G, c;
    __host__ __device__ void init(int M, int N, int G_, int c_) { nM = M / BM; nN = N / BM; nwg = nM * nN; G = G_; c = c_; }
    __host__ __device__ bool next(int i, Unit& u) const {
        const long L = (long)i * G + c; if (L >= nwg) return false;
        int wgid = (int)L; { const int q = nwg / NXCD, r = nwg % NXCD, xcd = wgid % NXCD, off = wgid / NXCD; wgid = (xcd < r ? xcd * (q + 1) : r * (q + 1) + (xcd - r) * q) + off; }
        const int nig = WGM * nN, gid = wgid / nig, fm = gid * WGM, gsz = (nM - fm) < WGM ? (nM - fm) : WGM;
        u.pm = fm + ((wgid % nig) % gsz); u.pn = (wgid % nig) / gsz; return true;
    }
    __device__ __forceinline__ void a_ready(const Unit&) const {}
    __device__ __forceinline__ void done(const Unit&) const {}
};

__device__ __forceinline__ unsigned cvt_pk_bf16(float lo, float hi) { unsigned r; asm volatile("v_cvt_pk_bf16_f32 %0, %1, %2" : "=v"(r) : "v"(lo), "v"(hi)); return r; }
typedef float f32x2 __attribute__((ext_vector_type(2)));
__device__ __forceinline__ f32x2 gelu_pk(f32x2 v) {
    const f32x2 av = __builtin_elementwise_abs(v), d = av * 0.2316418882f + 1.0f;
    f32x2 t; t.x = __builtin_amdgcn_rcpf(d.x); t.y = __builtin_amdgcn_rcpf(d.y);
    f32x2 q = t * 0.5307027145f + (-0.7265760135f); q = q * t + 0.7107068705f; q = q * t + (-0.142248368f); q = q * t + 0.127414796f; q = q * t;
    const f32x2 s = (v * v) * (-0.72134752044f);
    f32x2 e; e.x = __builtin_amdgcn_exp2f(s.x); e.y = __builtin_amdgcn_exp2f(s.y);
    const f32x2 m = v * (q * e), r = v - m;
    f32x2 o; o.x = v.x < 0.f ? m.x : r.x; o.y = v.y < 0.f ? m.y : r.y; return o;
}


struct GroupOrder {
    int nMl, nNl, strideM, nper, nwg, G, c;
    __device__ void init(int ng, int nMl_, int nNl_, int strideM_, int G_, int c_) { nMl = nMl_; nNl = nNl_; strideM = strideM_; nper = nMl_ * nNl_; nwg = ng * nper; G = G_; c = c_; }
    __device__ bool next(int i, Unit& u) const {
        const long L = (long)i * G + c; if (L >= nwg) return false;
        int wgid = (int)L; { const int q = nwg / NXCD, r = nwg % NXCD, xcd = wgid % NXCD, off = wgid / NXCD; wgid = (xcd < r ? xcd * (q + 1) : r * (q + 1) + (xcd - r) * q) + off; }
        const int e = wgid / nper, id = wgid % nper;
        const int nig = WGM * nNl, gid = id / nig, fm = gid * WGM, gsz = (nMl - fm) < WGM ? (nMl - fm) : WGM;
        u.pm = e * strideM + fm + ((id % nig) % gsz); u.pn = e * nNl + (id % nig) / gsz; return true;
    }
    __device__ __forceinline__ void a_ready(const Unit&) const {}
    __device__ __forceinline__ void done(const Unit&) const {}
};

constexpr int TXR = 32768;
struct EpiIn {
    static constexpr bool PERM = true, AFTER_DRAIN = false;
    bf16_t* PX; const float* rope; bf16_t* UT; PG8_LAS unsigned char* stgbase;
    __device__ __forceinline__ void operator()(const f32x4 (&acc)[2][2][4][2], const Unit& u, int wr, int wc, int fr, int fq) const {
        const int row0 = u.pm * BM + wr * 64 + fr; const int col0 = u.pn * BM + wc * 32 + 8 * fq;
        const bool latent = u.pm < (TXR / BM);
        if (latent && u.pn < 3) {
            PG8_LAS unsigned char* stg = stgbase + (wr * 4 + wc) * 2304; const int lane = fq * 16 + fr;
            const int b = u.pm >> 4, trow0 = (u.pm & 15) * BM; const int col = lane >> 1, half = lane & 1;
#pragma unroll
            for (int ai = 0; ai < 2; ++ai)
#pragma unroll
                for (int bj = 0; bj < 2; ++bj)
#pragma unroll
                    for (int mh = 0; mh < 2; ++mh) {
#pragma unroll
                        for (int mm = 0; mm < 2; ++mm)
#pragma unroll
                            for (int n = 0; n < 2; ++n) { const f32x4 v = acc[ai][bj][2 * mh + mm][n]; const unsigned w0 = cvt_pk_bf16(v[0], v[1]), w1 = cvt_pk_bf16(v[2], v[3]);
                                PG8_LAS unsigned char* p = stg + (8 * fq + 4 * n) * 72 + (16 * mm + fr) * 2;
                                *(PG8_LAS unsigned short*)(p) = (unsigned short)w0; *(PG8_LAS unsigned short*)(p + 72) = (unsigned short)(w0 >> 16);
                                *(PG8_LAS unsigned short*)(p + 144) = (unsigned short)w1; *(PG8_LAS unsigned short*)(p + 216) = (unsigned short)(w1 >> 16); }
                        asm volatile("s_waitcnt lgkmcnt(0)" ::: "memory");
                        typedef unsigned u32x2v __attribute__((ext_vector_type(2)));
                        const PG8_LAS unsigned char* rp = stg + col * 72 + half * 32;
                        const u32x2v a0 = *(const PG8_LAS u32x2v*)(rp), a1 = *(const PG8_LAS u32x2v*)(rp + 8), a2 = *(const PG8_LAS u32x2v*)(rp + 16), a3 = *(const PG8_LAS u32x2v*)(rp + 24);
                        const int ch = u.pn * BM + bj * HALF + wc * 32 + col; const int t0 = trow0 + ai * HALF + wr * 64 + mh * 32 + half * 16;
                        u32x4* gp = (u32x4*)(UT + ((size_t)(b * 768 + ch)) * 4096 + t0);
                        gp[0] = (u32x4){a0.x, a0.y, a1.x, a1.y}; gp[1] = (u32x4){a2.x, a2.y, a3.x, a3.y};
                        asm volatile("s_waitcnt lgkmcnt(0)" ::: "memory"); }
            return;
        }
#pragma unroll
        for (int ai = 0; ai < 2; ++ai)
#pragma unroll
            for (int m = 0; m < 4; ++m) { const int row = row0 + ai * HALF + m * 16; bf16_t* rowp = PX + (size_t)row * 2304 + col0;
#pragma unroll
                for (int bj = 0; bj < 2; ++bj) { f32x4 v0 = acc[ai][bj][m][0], v1 = acc[ai][bj][m][1];
                    const bool dorope = latent && (u.pn == 4 || (u.pn == 6 && bj == 0));
                    if (dorope) {
                        const int t = row & 4095; const int pos = (wc & 1) ? (t & 63) : (t >> 6);
                        const f32x4* rp = (const f32x4*)(rope + (pos * 16 + 8 * (fq & 1)) * 2);
                        const f32x4 r0 = rp[0], r1 = rp[1], r2 = rp[2], r3 = rp[3];
                        f32x4 p0, p1;
#pragma unroll
                        for (int j = 0; j < 4; ++j) { p0[j] = __shfl_xor(v0[j], 32); p1[j] = __shfl_xor(v1[j], 32); }
                        const float c0[4] = {r0[0], r0[2], r1[0], r1[2]}, s0[4] = {r0[1], r0[3], r1[1], r1[3]};
                        const float c1[4] = {r2[0], r2[2], r3[0], r3[2]}, s1[4] = {r2[1], r2[3], r3[1], r3[3]};
                        const bool lo = fq < 2;
#pragma unroll
                        for (int j = 0; j < 4; ++j) {
                            v0[j] = lo ? (v0[j] * c0[j] - p0[j] * s0[j]) : (p0[j] * s0[j] + v0[j] * c0[j]);
                            v1[j] = lo ? (v1[j] * c1[j] - p1[j] * s1[j]) : (p1[j] * s1[j] + v1[j] * c1[j]); }
                    }
                    u32x4 w; w.x = cvt_pk_bf16(v0[0], v0[1]); w.y = cvt_pk_bf16(v0[2], v0[3]); w.z = cvt_pk_bf16(v1[0], v1[1]); w.w = cvt_pk_bf16(v1[2], v1[3]);
                    *(u32x4*)(rowp + bj * HALF) = w; } }
    }
};
struct EpiOut {
    static constexpr bool PERM = false, AFTER_DRAIN = false;
    const float* xold_x; const float* xold_c; float* dst_x; float* dst_c; const float* mod;
    __device__ __forceinline__ void operator()(const f32x4 (&acc)[2][2][4][2], const Unit& u, int wr, int wc, int fr, int fq) const {
        const int row0 = u.pm * BM + wr * 64 + fr, col0 = u.pn * BM + wc * 32 + 4 * fq;
        const bool latent = u.pm < (TXR / BM);
#pragma unroll
        for (int ai = 0; ai < 2; ++ai)
#pragma unroll
            for (int m = 0; m < 4; ++m) { const int row = row0 + ai * HALF + m * 16;
                const int mrow = latent ? (row >> 12) : 8; const float* gp = mod + mrow * 6144 + 2 * 1024 + col0;
                const size_t off = latent ? (size_t)row * 1024 + col0 : (size_t)(row - TXR) * 1024 + col0;
                const float* xo = (latent ? xold_x : xold_c) + off; float* xd = (latent ? dst_x : dst_c) + off;
#pragma unroll
                for (int bj = 0; bj < 2; ++bj)
#pragma unroll
                    for (int n = 0; n < 2; ++n) { const f32x4 g = *(const f32x4*)(gp + bj * HALF + n * 16), xv = *(const f32x4*)(xo + bj * HALF + n * 16);
                        *(f32x4*)(xd + bj * HALF + n * 16) = xv + g * acc[ai][bj][m][n]; } }
    }
};
struct EpiGU {
    static constexpr bool PERM = true, AFTER_DRAIN = false;
    bf16_t* ACT;
    __device__ __forceinline__ void operator()(const f32x4 (&acc)[2][2][4][2], const Unit& u, int wr, int wc, int fr, int fq) const {
        const int row0 = u.pm * BM + wr * 64 + fr; const int col0 = (u.pn & 15) * 128 + wc * 32 + 8 * fq;
#pragma unroll
        for (int ai = 0; ai < 2; ++ai)
#pragma unroll
            for (int m = 0; m < 4; ++m) { bf16_t* rowp = ACT + (size_t)(row0 + ai * HALF + m * 16) * 2048 + col0;
                f32x4 h[2];
#pragma unroll
                for (int n = 0; n < 2; ++n)
#pragma unroll
                    for (int j = 0; j < 4; ++j) { const float g = acc[ai][0][m][n][j], up = acc[ai][1][m][n][j]; h[n][j] = g / (1.0f + __expf(-g)) * up; }
                u32x4 w; w.x = cvt_pk_bf16(h[0][0], h[0][1]); w.y = cvt_pk_bf16(h[0][2], h[0][3]); w.z = cvt_pk_bf16(h[1][0], h[1][1]); w.w = cvt_pk_bf16(h[1][2], h[1][3]);
                *(u32x4*)rowp = w; }
    }
};
struct EpiDown {
    static constexpr bool PERM = true, AFTER_DRAIN = false;
    bf16_t* OB; const float* gate;
    __device__ __forceinline__ void operator()(const f32x4 (&acc)[2][2][4][2], const Unit& u, int wr, int wc, int fr, int fq) const {
        const int row0 = u.pm * BM + wr * 64 + fr; const int col0 = (u.pn & 3) * BM + wc * 32 + 8 * fq;
#pragma unroll
        for (int ai = 0; ai < 2; ++ai)
#pragma unroll
            for (int m = 0; m < 4; ++m) { const int row = row0 + ai * HALF + m * 16; const float g = gate[row]; bf16_t* rowp = OB + (size_t)row * 1024 + col0;
#pragma unroll
                for (int bj = 0; bj < 2; ++bj) { const f32x4 v0 = acc[ai][bj][m][0] * g, v1 = acc[ai][bj][m][1] * g;
                    u32x4 w; w.x = cvt_pk_bf16(v0[0], v0[1]); w.y = cvt_pk_bf16(v0[2], v0[3]); w.z = cvt_pk_bf16(v1[0], v1[1]); w.w = cvt_pk_bf16(v1[2], v1[3]);
                    *(u32x4*)(rowp + bj * HALF) = w; } }
    }
};

template <class Epi, class Sched, bool ALIGN_EPI = false, bool SP2 = false>
__device__ __forceinline__ void gemm_phase(PG8_LAS unsigned char* lds, const Gemm g, const Sched& S, const Epi& E) {
    int tid_ = threadIdx.x; asm volatile("" : "+v"(tid_));
    const int tid = tid_, wid = __builtin_amdgcn_readfirstlane(tid >> 6), lane = tid & 63, wr = wid >> 2, wc = wid & 3, fr = lane & 15, fq = lane >> 4;
    const int K = g.K, nt = K / BK;
    unsigned voffA[2], voffB[2];
#pragma unroll
    for (int i = 0; i < 2; ++i) { int R, C; stage_rc(tid * 16 + i * 8192, R, C); const int Rb = Epi::PERM ? ((R & ~31) + perm32(R & 31)) : R;
        voffA[i] = (unsigned)(R * K + C) * 2u; voffB[i] = (unsigned)(Rb * K + C) * 2u; }
    const size_t kstep = (size_t)(BK * 2);
    const size_t hstep = (size_t)HALF * K * 2;
    const size_t tstep = 2 * hstep;
    const unsigned ldsw = (unsigned)wid * 1024u;
    const int aoff = lds_byte(wr * 64 + fr, fq * 8), boff = lds_byte(wc * 32 + fr, fq * 8);
#define PG8_SA(b, h) (((b) * 2 + (h)) * HTB)
#define PG8_SB(b, h) ((4 + (b) * 2 + (h)) * HTB)
#define PG8_STAGE(bufoff, gbase, voff) do { _Pragma("unroll") for (int _i = 0; _i < 2; ++_i) \
        __builtin_amdgcn_global_load_lds((const unsigned*)((const char*)(gbase) + (voff)[_i]), (PG8_LAS unsigned*)(lds + (bufoff) + ldsw + _i * 8192), 16, 0, 0); } while (0)
#define PG8_LDA(dst, b, h) do { _Pragma("unroll") for (int m = 0; m < 4; ++m) _Pragma("unroll") for (int k = 0; k < 2; ++k) dst[m][k] = *(const PG8_LAS bf16x8*)(lds + PG8_SA(b, h) + aoff + m * 2048 + k * 1024); } while (0)
#define PG8_LDB(dst, b, h) do { _Pragma("unroll") for (int n = 0; n < 2; ++n) _Pragma("unroll") for (int k = 0; k < 2; ++k) dst[n][k] = *(const PG8_LAS bf16x8*)(lds + PG8_SB(b, h) + boff + n * 2048 + k * 1024); } while (0)
#define PG8_MMA(ai, bj, At, Bt) do { __builtin_amdgcn_s_setprio(1); _Pragma("unroll") for (int m = 0; m < 4; ++m) _Pragma("unroll") for (int n = 0; n < 2; ++n) _Pragma("unroll") for (int k = 0; k < 2; ++k) \
        acc[ai][bj][m][n] = __builtin_amdgcn_mfma_f32_16x16x32_bf16(Bt[n][k], At[m][k], acc[ai][bj][m][n], 0, 0, 0); __builtin_amdgcn_s_setprio(0); } while (0)
#define PG8_WAIT_V(n) asm volatile("s_waitcnt vmcnt(" #n ")" ::: "memory")
#define PG8_WAIT_L(n) asm volatile("s_waitcnt lgkmcnt(" #n ")" ::: "memory")
#define PG8_BAR __builtin_amdgcn_s_barrier()
#define PG8_SCHED __builtin_amdgcn_sched_barrier(0)
    Unit cur, nxt; int ui = 0;
    if (!S.next(0, cur)) return;
    f32x4 acc[2][2][4][2];
#pragma unroll
    for (int a = 0; a < 2; ++a)
#pragma unroll
        for (int b = 0; b < 2; ++b)
#pragma unroll
            for (int m = 0; m < 4; ++m)
#pragma unroll
                for (int n = 0; n < 2; ++n) acc[a][b][m][n] = (f32x4){0.f, 0.f, 0.f, 0.f};
    bf16x8 At[4][2], B0[2][2], B1[2][2];
    const char* cA = (const char*)g.A + (size_t)cur.pm * tstep; const char* cB = (const char*)g.Bt + (size_t)cur.pn * tstep;
    S.a_ready(cur);
    if constexpr (SP2) {
        PG8_STAGE(PG8_SB(0, 0), cB, voffB); PG8_STAGE(PG8_SB(0, 1), cB + hstep, voffB); PG8_STAGE(PG8_SA(0, 0), cA, voffA); PG8_STAGE(PG8_SA(0, 1), cA + hstep, voffA);
        if (wr == 1) PG8_BAR;
        PG8_WAIT_V(2); PG8_BAR;
        PG8_STAGE(PG8_SB(1, 0), cB + kstep, voffB); PG8_STAGE(PG8_SA(1, 0), cA + kstep, voffA); PG8_STAGE(PG8_SB(1, 1), cB + hstep + kstep, voffB);
        PG8_WAIT_V(6); PG8_BAR;
    } else {
        PG8_STAGE(PG8_SB(0, 0), cB, voffB); PG8_STAGE(PG8_SA(0, 0), cA, voffA); PG8_STAGE(PG8_SB(0, 1), cB + hstep, voffB); PG8_STAGE(PG8_SA(0, 1), cA + hstep, voffA);
        if (wr == 1) PG8_BAR;
        PG8_WAIT_V(4); PG8_BAR;
        PG8_STAGE(PG8_SB(1, 0), cB + kstep, voffB); PG8_STAGE(PG8_SA(1, 0), cA + kstep, voffA); PG8_STAGE(PG8_SB(1, 1), cB + hstep + kstep, voffB);
        PG8_WAIT_V(6); PG8_BAR;
    }
    for (;;) {
        const bool has_next = S.next(ui + 1, nxt);
        const char* nA = has_next ? (const char*)g.A + (size_t)nxt.pm * tstep : cA; const char* nB = has_next ? (const char*)g.Bt + (size_t)nxt.pn * tstep : cB;
        for (int t = 0; t < nt; t += 2) {
            const bool last = (t == nt - 2);
            const char* a1 = cA + (size_t)(t + 1) * kstep;
            const char* a2 = last ? nA : cA + (size_t)(t + 2) * kstep; const char* b2 = last ? nB : cB + (size_t)(t + 2) * kstep;
            const char* a3 = a2 + kstep; const char* b3 = b2 + kstep;
            if (last && has_next) S.a_ready(nxt);
            if constexpr (SP2) {
            PG8_LDB(B0, 0, 0); PG8_LDB(B1, 0, 1); PG8_SCHED; PG8_LDA(At, 0, 0); PG8_STAGE(PG8_SA(1, 1), a1 + hstep, voffA);
            PG8_WAIT_V(8); PG8_WAIT_L(0); PG8_BAR; PG8_MMA(0, 0, At, B0); PG8_MMA(0, 1, At, B1); PG8_BAR; PG8_SCHED;
            PG8_LDA(At, 0, 1); PG8_STAGE(PG8_SB(0, 0), b2, voffB); PG8_STAGE(PG8_SB(0, 1), b2 + hstep, voffB); PG8_STAGE(PG8_SA(0, 0), a2, voffA);
            PG8_WAIT_V(8); PG8_WAIT_L(0); PG8_BAR; PG8_MMA(1, 0, At, B0); PG8_MMA(1, 1, At, B1); PG8_BAR; PG8_SCHED;
            PG8_LDB(B0, 1, 0); PG8_LDB(B1, 1, 1); PG8_SCHED; PG8_LDA(At, 1, 0); PG8_STAGE(PG8_SA(0, 1), a2 + hstep, voffA);
            PG8_WAIT_V(8); PG8_WAIT_L(0); PG8_BAR; PG8_MMA(0, 0, At, B0); PG8_MMA(0, 1, At, B1); PG8_BAR; PG8_SCHED;
            PG8_LDA(At, 1, 1); PG8_STAGE(PG8_SB(1, 0), b3, voffB); PG8_STAGE(PG8_SB(1, 1), b3 + hstep, voffB); PG8_STAGE(PG8_SA(1, 0), a3, voffA);
            PG8_WAIT_V(8); PG8_WAIT_L(0); PG8_BAR; PG8_MMA(1, 0, At, B0); PG8_MMA(1, 1, At, B1); PG8_BAR; PG8_SCHED;
            } else {
            PG8_LDB(B0, 0, 0); PG8_SCHED; PG8_LDA(At, 0, 0); PG8_STAGE(PG8_SA(1, 1), a1 + hstep, voffA);
            PG8_WAIT_L(8); PG8_BAR; PG8_WAIT_L(0); PG8_MMA(0, 0, At, B0); PG8_BAR; PG8_SCHED;
            PG8_LDB(B1, 0, 1); PG8_STAGE(PG8_SB(0, 0), b2, voffB);
            PG8_BAR; PG8_WAIT_L(0); PG8_MMA(0, 1, At, B1); PG8_BAR;
            PG8_LDA(At, 0, 1); PG8_STAGE(PG8_SA(0, 0), a2, voffA);
            PG8_BAR; PG8_WAIT_L(0); PG8_MMA(1, 0, At, B0); PG8_BAR; PG8_SCHED;
            PG8_STAGE(PG8_SB(0, 1), b2 + hstep, voffB);
            PG8_WAIT_V(6); PG8_BAR; PG8_MMA(1, 1, At, B1); PG8_BAR;
            PG8_LDB(B0, 1, 0); PG8_SCHED; PG8_LDA(At, 1, 0); PG8_STAGE(PG8_SA(0, 1), a2 + hstep, voffA);
            PG8_WAIT_L(8); PG8_BAR; PG8_WAIT_L(0); PG8_MMA(0, 0, At, B0); PG8_BAR; PG8_SCHED;
            PG8_LDB(B1, 1, 1); PG8_STAGE(PG8_SB(1, 0), b3, voffB);
            PG8_BAR; PG8_WAIT_L(0); PG8_MMA(0, 1, At, B1); PG8_BAR;
            PG8_LDA(At, 1, 1); PG8_STAGE(PG8_SA(1, 0), a3, voffA);
            PG8_BAR; PG8_WAIT_L(0); PG8_MMA(1, 0, At, B0); PG8_BAR; PG8_SCHED;
            PG8_STAGE(PG8_SB(1, 1), b3 + hstep, voffB);
            PG8_WAIT_V(6); PG8_BAR; PG8_MMA(1, 1, At, B1); PG8_BAR;
            }
        }
        if constexpr (ALIGN_EPI) { if (wr == 0) PG8_BAR; }
        if constexpr (!Epi::AFTER_DRAIN) { E(acc, cur, wr, wc, fr, fq); S.done(cur); }
        if (!has_next) break;
#pragma unroll
        for (int a = 0; a < 2; ++a)
#pragma unroll
            for (int b = 0; b < 2; ++b)
#pragma unroll
                for (int m = 0; m < 4; ++m)
#pragma unroll
                    for (int n = 0; n < 2; ++n) acc[a][b][m][n] = (f32x4){0.f, 0.f, 0.f, 0.f};
        cur = nxt; cA = nA; cB = nB; ++ui;
        if constexpr (ALIGN_EPI) { if (wr == 1) PG8_BAR; }
    }
    PG8_WAIT_V(0);
    if constexpr (!ALIGN_EPI) { if (wr == 0) PG8_BAR; }
    PG8_BAR;
    if constexpr (Epi::AFTER_DRAIN) { E.fused(acc, cur, wr, wc, fr, fq, lds, wid, lane); S.done(cur); }
#undef PG8_SA
#undef PG8_SB
#undef PG8_STAGE
#undef PG8_LDA
#undef PG8_LDB
#undef PG8_MMA
#undef PG8_WAIT_V
#undef PG8_WAIT_L
#undef PG8_BAR
#undef PG8_SCHED
}
}

#define LAS __attribute__((address_space(3)))
typedef unsigned short bf16_t;
typedef float f32x4 __attribute__((ext_vector_type(4)));
typedef unsigned u32x4 __attribute__((ext_vector_type(4)));
typedef unsigned u32x2 __attribute__((ext_vector_type(2)));
typedef __bf16 bf16x2_t __attribute__((ext_vector_type(2)));
constexpr int NWAVES = 8, NTHR = 512;
constexpr int D = 1024, NB = 8, SEQ = 4096, LCTX = 256, TX = NB * SEQ, TC = NB * LCTX, TT = TX + TC, INW = 2304, NE = 16, FF = 2048;
constexpr int CAPX = 512, CAPC = 32, SLOTS = NB * CAPX + NB * CAPC;
constexpr float LOG2E = 1.4426950408889634f;
constexpr int LDS_BYTES = 155648;
enum { I_X = 0, I_C, I_CTX, I_CCTX, I_ADAW, I_ADAB, I_N1G, I_N2G, I_WIN, I_HCW, I_HCB, I_HW1, I_HB1, I_HW2, I_HB2, I_HW3, I_HFREQ, I_HSKIP, I_SINK, I_POOLW, I_POOLS, I_RPB, I_WOUT, I_ROUTER, I_WG, I_WU, I_WD, I_FNG, N_IN };
constexpr size_t MiB = 1u << 20;
constexpr size_t WS_MOD = 1 * MiB;
constexpr size_t WS_ROPE = 2 * MiB;
constexpr size_t WS_TW8 = 2 * MiB + 65536;
constexpr size_t WS_WIN_T = 3 * MiB;
constexpr size_t WS_WOUT_T = 13 * MiB;
constexpr size_t WS_HC = 17 * MiB;
constexpr size_t WS_HCC = 51 * MiB;
constexpr size_t WS_AFFT = 53 * MiB;
constexpr size_t WS_ROWMAP = 56 * MiB;
constexpr size_t WS_GATE = 57 * MiB;
constexpr size_t WS_INV = 58 * MiB;
constexpr size_t WS_CRES = 61 * MiB;
constexpr size_t WS_HX = 69 * MiB;
constexpr size_t WS_WGU_T = 137 * MiB;
constexpr size_t WS_WD_T = 393 * MiB;
constexpr size_t WS_R = 521 * MiB;
constexpr size_t WS_ACT = WS_R;
constexpr size_t WS_XG = WS_R + 272 * MiB;
constexpr size_t WS_PX = WS_R;
constexpr size_t WS_Y = WS_R + 153 * MiB;
constexpr size_t WS_UT = WS_XG;
constexpr size_t WS_HS = WS_R + 408 * MiB;
constexpr size_t WS_END = WS_HS + 64 * MiB;
static_assert(WS_END <= 1024 * MiB, "workspace map");

struct Args { const float* in[N_IN]; float* out; unsigned char* ws; };

__device__ __forceinline__ float bf2f(unsigned short v) { return __uint_as_float(((unsigned)v) << 16); }
__device__ __forceinline__ unsigned f2bf(float f) { unsigned u = __float_as_uint(f); return (u + 0x7fffu + ((u >> 16) & 1u)) >> 16; }
__device__ __forceinline__ unsigned pk2(float lo, float hi) { return f2bf(lo) | (f2bf(hi) << 16); }
__device__ __forceinline__ float bflo(unsigned w) { return __uint_as_float(w << 16); }
__device__ __forceinline__ float bfhi(unsigned w) { return __uint_as_float(w & 0xffff0000u); }
__device__ __forceinline__ float dot2bf(unsigned a, unsigned b, float acc) { return __builtin_amdgcn_fdot2_f32_bf16(__builtin_bit_cast(bf16x2_t, a), __builtin_bit_cast(bf16x2_t, b), acc, false); }
__device__ __forceinline__ float wave_sum(float v) {
#pragma unroll
    for (int o = 1; o < 64; o <<= 1) v += __shfl_xor(v, o);
    return v;
}
#define LDS_WAIT() asm volatile("s_waitcnt lgkmcnt(0)" ::: "memory")

__device__ __forceinline__ void tr_item(const float* W, int K, int N, bf16_t* WT, int Kt, int item, int mode, LAS float* scr, int lane) {
    const int nblk = N / 32, kb = item / nblk, nb = item % nblk, k0 = 64 * kb, n0 = 32 * nb;
#pragma unroll 8
    for (int i = 0; i < 32; ++i) { const int kk = 2 * i + (lane >> 5); scr[kk * 33 + (lane & 31)] = W[(size_t)(k0 + kk) * N + n0 + (lane & 31)]; }
    LDS_WAIT();
    const int c = lane & 7;
    const int drow0 = (mode == 0) ? n0 : ((n0 >> 7) * 256 + (n0 & 127) + (mode == 2 ? 128 : 0));
#pragma unroll
    for (int j = 0; j < 4; ++j) { const int n = (lane >> 3) + 8 * j; const LAS float* s = scr + (8 * c) * 33 + n;
        u32x4 o; o.x = pk2(s[0 * 33], s[1 * 33]); o.y = pk2(s[2 * 33], s[3 * 33]); o.z = pk2(s[4 * 33], s[5 * 33]); o.w = pk2(s[6 * 33], s[7 * 33]);
        *(u32x4*)(WT + (size_t)(drow0 + n) * Kt + k0 + 8 * c) = o; }
    LDS_WAIT();
}

__device__ __forceinline__ void filter_pos(const Args& a, int l, int L, int p, float* HCdst, int lane) {
    const float* w1 = a.in[I_HW1] + l * 33 * 64; const float* b1 = a.in[I_HB1] + l * 64; const float* w2 = a.in[I_HW2] + l * 64 * 64; const float* b2 = a.in[I_HB2] + l * 64;
    const float* w3 = a.in[I_HW3] + l * 64 * 1024; const float* fr = a.in[I_HFREQ] + l * 64;
    const float tn = (float)p / (float)(L - 1);
    float fv = 0.f;
    if (lane == 0) fv = tn;
    else if (lane <= 32) { const int bi = (lane - 1) & 15; const float band = 1e-4f + (float)bi * ((15.0f - 1e-4f) / 15.0f);
        const float ang = ((float)(6.283185307179586 / (double)L) * (float)p) * band; fv = (lane <= 16) ? cosf(ang) : -sinf(ang); }
    float a1 = b1[lane];
    for (int i = 0; i < 33; ++i) a1 += __shfl(fv, i) * w1[i * 64 + lane];
    const float frq = fr[lane];
    const float h1 = sinf(frq * a1);
    float a2 = b2[lane];
    for (int i = 0; i < 64; ++i) a2 += __shfl(h1, i) * w2[i * 64 + lane];
    const float h2 = sinf(frq * a2);
    float o[16];
#pragma unroll
    for (int q = 0; q < 16; ++q) o[q] = 0.f;
    for (int i = 0; i < 64; ++i) { const float hv = __shfl(h2, i);
#pragma unroll
        for (int q = 0; q < 16; ++q) o[q] += hv * w3[i * 1024 + q * 64 + lane]; }
    const float dmin = 3.0701134573253945f, dmax = 15.350567286626972f;
#pragma unroll
    for (int ord = 0; ord < 2; ++ord)
#pragma unroll
        for (int cs = 0; cs < 4; ++cs) { const int c = cs * 64 + lane; const float delta = dmin + (float)c * ((dmax - dmin) / 255.0f); const float win = expf(-tn * delta);
            const float vf = o[ord * 8 + cs] * win, vb = o[ord * 8 + 4 + cs] * win;
            float* base = HCdst + (size_t)ord * (2 * L - 1) * 256;
            if (p == 0) base[(size_t)(L - 1) * 256 + c] = vf + vb;
            else { base[(size_t)(L - 1 + p) * 256 + c] = vf; base[(size_t)(L - 1 - p) * 256 + c] = vb; } }
}

__device__ __forceinline__ void phase_prologue(const Args& a, unsigned char* ldsg, int vcu, int G) {
    LAS unsigned char* lds = (LAS unsigned char*)ldsg;
    int tid_ = threadIdx.x; asm volatile("" : "+v"(tid_));
    const int tid = tid_, lane = tid & 63, wave = __builtin_amdgcn_readfirstlane(tid >> 6);
    unsigned char* ws = a.ws;
    LAS float* sc = (LAS float*)lds; LAS float* red = (LAS float*)(lds + 36864);
    for (int i = tid; i < 9 * 1024; i += NTHR) { const float v = (i < 8192) ? a.in[I_C][i] : a.in[I_CCTX][i - 8192]; sc[i] = v / (1.0f + expf(-v)); }
    __syncthreads();
    float* MOD = (float*)(ws + WS_MOD);
    for (int item = vcu; item < 2 * 96; item += G) {
        const int l = item / 96, n0 = (item % 96) * 64, col = tid & 63, kg = tid >> 6;
        float acc[9];
#pragma unroll
        for (int r = 0; r < 9; ++r) acc[r] = 0.f;
        const float* w = a.in[I_ADAW] + (size_t)l * 1024 * 6144 + n0 + col;
#pragma unroll 4
        for (int k = kg * 128; k < kg * 128 + 128; ++k) { const float wv = w[(size_t)k * 6144];
#pragma unroll
            for (int r = 0; r < 9; ++r) acc[r] += sc[r * 1024 + k] * wv; }
#pragma unroll
        for (int r = 0; r < 9; ++r) red[(kg * 9 + r) * 64 + col] = acc[r];
        __syncthreads();
        for (int o = tid; o < 9 * 64; o += NTHR) { const int r = o >> 6, cc = o & 63; float s = 0.f;
#pragma unroll
            for (int g2 = 0; g2 < 8; ++g2) s += red[(g2 * 9 + r) * 64 + cc];
            MOD[(size_t)(l * 9 + r) * 6144 + n0 + cc] = s + a.in[I_ADAB][l * 6144 + n0 + cc]; }
        __syncthreads();
    }
    if (vcu == 0) { float* ROPE = (float*)(ws + WS_ROPE);
        for (int i = tid; i < 1024; i += NTHR) { const int pos = i >> 4, fi = i & 15; const float inv = powf(10000.0f, -(float)fi / 16.0f); const float ang = (float)pos * inv;
            ROPE[2 * i] = cosf(ang); ROPE[2 * i + 1] = sinf(ang); } }
    if (vcu == 1 % G) { float* TW8 = (float*)(ws + WS_TW8);
        for (int i = tid; i < 8192; i += NTHR) { float sn, cs; sincospif(-(float)i * (1.0f / 4096.0f), &sn, &cs); TW8[2 * i] = cs; TW8[2 * i + 1] = sn; } }
    const int gw = vcu * NWAVES + wave, NGW = G * NWAVES;
    for (int it = gw; it < 8448; it += NGW) {
        if (it < 4096) filter_pos(a, 0, 4096, it, (float*)(ws + WS_HC), lane);
        else if (it < 8192) filter_pos(a, 1, 4096, it - 4096, (float*)(ws + WS_HC) + (size_t)2 * 8191 * 256, lane);
        else filter_pos(a, 0, 256, it - 8192, (float*)(ws + WS_HCC) + 256, lane);
    }
    LAS float* scr = (LAS float*)(lds + 65536 + wave * 8448);
    constexpr int IT_IN = 16 * 72, IT_OUT = 16 * 32, IT_E = 1024, IT_LAYER = IT_IN + IT_OUT + 3 * 16 * IT_E;
    for (int it = gw; it < 2 * IT_LAYER; it += NGW) {
        const int l = it / IT_LAYER; int r = it % IT_LAYER;
        if (r < IT_IN) { tr_item(a.in[I_WIN] + (size_t)l * 1024 * 2304, 1024, 2304, (bf16_t*)(ws + WS_WIN_T) + (size_t)l * 2304 * 1024, 1024, r, 0, scr, lane); continue; } r -= IT_IN;
        if (r < IT_OUT) { tr_item(a.in[I_WOUT] + (size_t)l * 1024 * 1024, 1024, 1024, (bf16_t*)(ws + WS_WOUT_T) + (size_t)l * 1024 * 1024, 1024, r, 0, scr, lane); continue; } r -= IT_OUT;
        const int which = r / (16 * IT_E), e = (r / IT_E) & 15, ri = r % IT_E; const size_t le = (size_t)l * 16 + e;
        if (which == 0) tr_item(a.in[I_WG] + le * 1024 * 2048, 1024, 2048, (bf16_t*)(ws + WS_WGU_T) + le * 4096 * 1024, 1024, ri, 1, scr, lane);
        else if (which == 1) tr_item(a.in[I_WU] + le * 1024 * 2048, 1024, 2048, (bf16_t*)(ws + WS_WGU_T) + le * 4096 * 1024, 1024, ri, 2, scr, lane);
        else tr_item(a.in[I_WD] + le * 2048 * 1024, 2048, 1024, (bf16_t*)(ws + WS_WD_T) + le * 1024 * 2048, 2048, ri, 0, scr, lane);
    }
}

__device__ __forceinline__ void phase_norm(const Args& a, unsigned char* ldsg, int vcu, int G, int l, const float* srcx, const float* srcc, const float* gain, int shift_idx, int nrows, bool router) {
    int tid_ = threadIdx.x; asm volatile("" : "+v"(tid_));
    const int tid = tid_, lane = tid & 63, wave = __builtin_amdgcn_readfirstlane(tid >> 6);
    unsigned char* ws = a.ws; const float* MOD = (const float*)(ws + WS_MOD) + (size_t)l * 9 * 6144; bf16_t* HX = (bf16_t*)(ws + WS_HX);
    LAS float* rw = (LAS float*)(LAS unsigned char*)ldsg;
    if (router) { const float* rsrc = a.in[I_ROUTER] + (size_t)l * 1024 * 16; for (int i = tid; i < 1024 * 16; i += NTHR) rw[(i & 15) * 1024 + (i >> 4)] = rsrc[i]; __syncthreads(); }
    const int gw = vcu * NWAVES + wave, NGW = G * NWAVES;
    for (int row = gw; row < nrows; row += NGW) {
        const bool lat = row < TX; const float* xr = lat ? srcx + (size_t)row * D : srcc + (size_t)(row - TX) * D; const int mrow = lat ? (row >> 12) : 8;
        const float* shp = MOD + mrow * 6144 + shift_idx * 1024; const float* scp = shp + 1024;
        f32x4 v[4]; float ss = 0.f;
#pragma unroll
        for (int j = 0; j < 4; ++j) { v[j] = *(const f32x4*)(xr + 256 * j + 4 * lane); ss += (v[j][0] * v[j][0] + v[j][1] * v[j][1]) + (v[j][2] * v[j][2] + v[j][3] * v[j][3]); }
        const float rstd = 1.0f / sqrtf(wave_sum(ss) * (1.0f / D) + 1e-6f);
#pragma unroll
        for (int j = 0; j < 4; ++j) { const f32x4 gg = *(const f32x4*)(gain + 256 * j + 4 * lane), sh = *(const f32x4*)(shp + 256 * j + 4 * lane), sc = *(const f32x4*)(scp + 256 * j + 4 * lane);
            v[j] = (v[j] * rstd * gg) * (1.0f + sc) + sh;
            u32x2 o; o.x = pk2(v[j][0], v[j][1]); o.y = pk2(v[j][2], v[j][3]); *(u32x2*)(HX + (size_t)row * D + 256 * j + 4 * lane) = o; }
        if (router) {
            float mylog = -1e30f;
#pragma unroll 1
            for (int e = 0; e < 16; ++e) { float p = 0.f;
#pragma unroll
                for (int j = 0; j < 4; ++j) { const f32x4 wv = *(const LAS f32x4*)(rw + e * 1024 + 256 * j + 4 * lane);
                    p += (v[j][0] * wv[0] + v[j][1] * wv[1]) + (v[j][2] * wv[2] + v[j][3] * wv[3]); }
                p = wave_sum(p); mylog = (lane == e) ? p : mylog; }
            float mx = mylog;
#pragma unroll
            for (int o = 1; o < 16; o <<= 1) mx = fmaxf(mx, __shfl_xor(mx, o));
            const float mine = (lane < 16) ? expf(mylog - mx) : 0.f; float den = mine;
#pragma unroll
            for (int o = 1; o < 16; o <<= 1) den += __shfl_xor(den, o);
            if (lane < 16) { ((float*)(ws + WS_AFFT))[(size_t)lane * TT + row] = mine / den; ((int*)(ws + WS_INV))[(size_t)row * 16 + lane] = -1; }
        }
    }
}

typedef float f32x2 __attribute__((ext_vector_type(2)));
__device__ __forceinline__ f32x2 cmul(f32x2 a, f32x2 b) { return (f32x2){a.x * b.x - a.y * b.y, a.x * b.y + a.y * b.x}; }
__device__ __forceinline__ void dft16(f32x2 (&v)[16]) {
    constexpr float WC[8] = {1.0f, 0.92387953251128674f, 0.70710678118654752f, 0.38268343236508977f, 0.0f, -0.38268343236508977f, -0.70710678118654752f, -0.92387953251128674f};
    constexpr float WS[8] = {0.0f, -0.38268343236508977f, -0.70710678118654752f, -0.92387953251128674f, -1.0f, -0.92387953251128674f, -0.70710678118654752f, -0.38268343236508977f};
#pragma unroll
    for (int s = 8; s >= 1; s >>= 1)
#pragma unroll
        for (int i = 0; i < 16; ++i) if ((i & s) == 0) { const int k = (i & (s - 1)) * (8 / s); const f32x2 u = v[i], t = v[i + s]; v[i] = u + t; const f32x2 d = u - t;
            v[i + s] = (k == 0) ? d : ((k == 4) ? (f32x2){d.y, -d.x} : (f32x2){d.x * WC[k] - d.y * WS[k], d.x * WS[k] + d.y * WC[k]}); }
}
__device__ __forceinline__ constexpr int bitrev4(int i) { return ((i & 1) << 3) | ((i & 2) << 1) | ((i & 4) >> 1) | ((i & 8) >> 3); }
template <int NS, int MODE>
__device__ __forceinline__ void fft_pass(LAS f32x2* Z, const LAS f32x2* TW, int tid, const f32x2* H) {
    const int f = tid >> 8, j = tid & 255, base = f * 4096, k = j & (NS - 1);
    f32x2 v[16];
#pragma unroll
    for (int r = 0; r < 16; ++r) { const int idx = base + j + 256 * r; v[r] = Z[idx + (idx >> 4)]; }
    if (MODE == 1) {
#pragma unroll
        for (int r = 0; r < 16; ++r) { const f32x2 p = cmul(v[r], H[base + j + 256 * r]); v[r] = (f32x2){p.y, p.x}; } }
    if (NS > 1) { constexpr int step = 8192 / (NS * 16);
#pragma unroll
        for (int r = 1; r < 16; ++r) v[r] = cmul(v[r], TW[r * k * step]); }
    dft16(v);
    __syncthreads();
    const int j0 = base + (j / NS) * NS * 16 + k;
#pragma unroll
    for (int rr = 0; rr < 16; ++rr) { const int idx = j0 + rr * NS; Z[idx + (idx >> 4)] = v[bitrev4(rr)]; }
    __syncthreads();
}
__device__ __forceinline__ void load_uc(const bf16_t* UT, const float* cw, const float* cb, int ch, int b, int tid, float (&out)[8]) {
    const bf16_t* p = UT + ((size_t)(b * 768 + ch)) * 4096 + 8 * tid;
    const u32x4 w = *(const u32x4*)p; float u[10];
    u[1] = bflo(w.x); u[2] = bfhi(w.x); u[3] = bflo(w.y); u[4] = bfhi(w.y); u[5] = bflo(w.z); u[6] = bfhi(w.z); u[7] = bflo(w.w); u[8] = bfhi(w.w);
    u[0] = (tid > 0) ? bf2f(p[-1]) : 0.f; u[9] = (tid < 511) ? bf2f(p[8]) : 0.f;
    const float w0 = cw[ch], w1 = cw[768 + ch], w2 = cw[1536 + ch], bb = cb[ch];
#pragma unroll
    for (int i = 0; i < 8; ++i) out[i] = u[i] * w0 + u[i + 1] * w1 + u[i + 2] * w2 + bb;
}
__device__ __forceinline__ void hy_fill(LAS f32x2* Z, const LAS f32x2* TW, int tid, const float (&va)[8], const float (&vb)[8]) {
#pragma unroll
    for (int i = 0; i < 8; ++i) { const int t = 8 * tid + i; const f32x2 z = {va[i], vb[i]}; Z[t + (t >> 4)] = z; const int t2 = 4096 + t; Z[t2 + (t2 >> 4)] = cmul(z, TW[t]); }
    __syncthreads();
}
__device__ __forceinline__ void hy_conv(LAS f32x2* Z, const LAS f32x2* TW, int tid, const f32x2* H) {
    fft_pass<1, 0>(Z, TW, tid, nullptr); fft_pass<16, 0>(Z, TW, tid, nullptr); fft_pass<256, 0>(Z, TW, tid, nullptr);
    fft_pass<1, 1>(Z, TW, tid, H); fft_pass<16, 0>(Z, TW, tid, nullptr); fft_pass<256, 0>(Z, TW, tid, nullptr);
}
__device__ __forceinline__ f32x2 hy_out(const LAS f32x2* Z, const LAS f32x2* TW, int t) {
    const f32x2 se = Z[t + (t >> 4)]; const int t2 = 4096 + t; const f32x2 so = Z[t2 + (t2 >> 4)]; const f32x2 tw = TW[t];
    const f32x2 So = {so.y, so.x};
    return (f32x2){se.y + (So.x * tw.x + So.y * tw.y), se.x + (So.y * tw.x - So.x * tw.y)};
}
__device__ __forceinline__ void hyena_item(const Args& a, LAS unsigned char* lds, int l, int c, int bp, int tid) {
    asm volatile("" : "+v"(tid));
    LAS f32x2* Z = (LAS f32x2*)lds; const LAS f32x2* TW = (const LAS f32x2*)(lds + 69632);
    const bf16_t* UT = (const bf16_t*)(a.ws + WS_UT); bf16_t* Y = (bf16_t*)(a.ws + WS_Y);
    const float* cw = a.in[I_HCW] + (size_t)l * 3 * 768; const float* cb = a.in[I_HCB] + (size_t)l * 768; const float* skip = a.in[I_HSKIP] + (size_t)l * 2 * 256;
    const f32x2* HS = (const f32x2*)(a.ws + WS_HS) + ((size_t)(l * 2) * 256 + c) * 8192;
    const int b0 = 2 * bp, b1 = 2 * bp + 1;
    float va[8], vb[8], xa[8], xb[8];
    load_uc(UT, cw, cb, c, b0, tid, va); load_uc(UT, cw, cb, c, b1, tid, vb);
    hy_fill(Z, TW, tid, va, vb);
    hy_conv(Z, TW, tid, HS);
    load_uc(UT, cw, cb, 256 + c, b0, tid, xa); load_uc(UT, cw, cb, 256 + c, b1, tid, xb);
    { const float sk = skip[c];
#pragma unroll
      for (int i = 0; i < 8; ++i) { const f32x2 y = hy_out(Z, TW, 8 * tid + i); va[i] = xa[i] * (y.x + va[i] * sk); vb[i] = xb[i] * (y.y + vb[i] * sk); } }
    __syncthreads();
    hy_fill(Z, TW, tid, va, vb);
    hy_conv(Z, TW, tid, HS + (size_t)256 * 8192);
    load_uc(UT, cw, cb, 512 + c, b0, tid, xa); load_uc(UT, cw, cb, 512 + c, b1, tid, xb);
    { const float sk = skip[256 + c];
#pragma unroll
      for (int i = 0; i < 8; ++i) { const int t = 8 * tid + i; const f32x2 y = hy_out(Z, TW, t);
          Y[((size_t)b0 * 4096 + t) * D + c] = (bf16_t)f2bf(xa[i] * (y.x + va[i] * sk)); Y[((size_t)b1 * 4096 + t) * D + c] = (bf16_t)f2bf(xb[i] * (y.y + vb[i] * sk)); } }
    __syncthreads();
}
__device__ __forceinline__ void spectrum_item(const Args& a, LAS unsigned char* lds, int item, int tid) {
    asm volatile("" : "+v"(tid));
    LAS f32x2* Z = (LAS f32x2*)lds; const LAS f32x2* TW = (const LAS f32x2*)(lds + 69632);
    const int c = item & 255, lo = item >> 8;
    const float* HC = (const float*)(a.ws + WS_HC) + (size_t)lo * 8191 * 256 + c;
#pragma unroll
    for (int i = 0; i < 8; ++i) { const int t = 8 * tid + i; const float hl = HC[(size_t)(4095 + t) * 256], hh = (t == 0) ? 0.f : HC[(size_t)(t - 1) * 256];
        Z[t + (t >> 4)] = (f32x2){hl + hh, 0.f}; const int t2 = 4096 + t; const f32x2 tw = TW[t]; const float dd = hl - hh; Z[t2 + (t2 >> 4)] = (f32x2){dd * tw.x, dd * tw.y}; }
    __syncthreads();
    fft_pass<1, 0>(Z, TW, tid, nullptr); fft_pass<16, 0>(Z, TW, tid, nullptr); fft_pass<256, 0>(Z, TW, tid, nullptr);
    f32x2* HS = (f32x2*)(a.ws + WS_HS) + (size_t)item * 8192;
#pragma unroll
    for (int i = 0; i < 16; ++i) { const int idx = tid + 512 * i; HS[idx] = Z[idx + (idx >> 4)] * (1.0f / 8192.0f); }
    __syncthreads();
}
__device__ __forceinline__ void load_tw(const Args& a, LAS unsigned char* lds, int tid) {
    LAS f32x2* TW = (LAS f32x2*)(lds + 69632); const f32x2* src = (const f32x2*)(a.ws + WS_TW8);
    for (int i = tid; i < 8192; i += NTHR) TW[i] = src[i];
    __syncthreads();
}
__device__ __forceinline__ float ctx_uc(const bf16_t* PXc, const float* cw, const float* cb, int ch, int t) {
    const float u1 = bf2f(PXc[(size_t)t * INW + ch]); const float u0 = (t > 0) ? bf2f(PXc[(size_t)(t - 1) * INW + ch]) : 0.f; const float u2 = (t < 255) ? bf2f(PXc[(size_t)(t + 1) * INW + ch]) : 0.f;
    return u0 * cw[ch] + u1 * cw[768 + ch] + u2 * cw[1536 + ch] + cb[ch];
}
__device__ __forceinline__ void ctx_conv16(const LAS float* IN, const float* H, int c, int lane, int t0, float (&acc)[16]) {
    float w[16];
    const float* hp = H + (size_t)(t0 + 255) * 256 + c;
#pragma unroll
    for (int i = 0; i < 16; ++i) { acc[i] = 0.f; w[i] = hp[i * 256]; }
    const LAS float* ip = IN + lane;
#pragma unroll 1
    for (int s0 = 0; s0 < 256; s0 += 16) {
#pragma unroll
        for (int u = 0; u < 16; ++u) { const float v = ip[u * 64];
#pragma unroll
            for (int i = 0; i < 16; ++i) acc[i] += v * w[(i - u + 16) & 15];
            w[(15 - u) & 15] = hp[-(u + 1) * 256]; }
        hp -= 16 * 256; ip += 16 * 64; }
}
__device__ __forceinline__ void ctx_hyena_item(const Args& a, LAS unsigned char* lds, int l, int item, int tid) {
    asm volatile("" : "+v"(tid));
    const int lane = tid & 63, wave = tid >> 6, b = item >> 2, c = (item & 3) * 64 + lane;
    LAS float* V = (LAS float*)lds; LAS float* Z1 = (LAS float*)(lds + 65536);
    const bf16_t* PXc = (const bf16_t*)(a.ws + WS_PX) + (size_t)(TX + b * 256) * INW; bf16_t* Y = (bf16_t*)(a.ws + WS_Y) + (size_t)(TX + b * 256) * D;
    const float* cw = a.in[I_HCW] + (size_t)l * 3 * 768; const float* cb = a.in[I_HCB] + (size_t)l * 768; const float* skip = a.in[I_HSKIP] + (size_t)l * 2 * 256;
    const float* H0 = (const float*)(a.ws + WS_HCC) + 256, *H1 = H0 + (size_t)511 * 256;
#pragma unroll 2
    for (int i = 0; i < 32; ++i) { const int t = wave * 32 + i; V[t * 64 + lane] = ctx_uc(PXc, cw, cb, c, t); }
    __syncthreads();
    float acc[16];
#pragma unroll 1
    for (int g = 0; g < 2; ++g) { const int t0 = wave * 32 + g * 16; ctx_conv16(V, H0, c, lane, t0, acc); const float sk = skip[c];
#pragma unroll
        for (int i = 0; i < 16; ++i) { const int t = t0 + i; Z1[t * 64 + lane] = ctx_uc(PXc, cw, cb, 256 + c, t) * (acc[i] + V[t * 64 + lane] * sk); } }
    __syncthreads();
#pragma unroll 1
    for (int g = 0; g < 2; ++g) { const int t0 = wave * 32 + g * 16; ctx_conv16(Z1, H1, c, lane, t0, acc); const float sk = skip[256 + c];
#pragma unroll
        for (int i = 0; i < 16; ++i) { const int t = t0 + i; Y[(size_t)t * D + c] = (bf16_t)f2bf(ctx_uc(PXc, cw, cb, 512 + c, t) * (acc[i] + Z1[t * 64 + lane] * sk)); } }
    __syncthreads();
}

typedef short bf16x8_t __attribute__((ext_vector_type(8)));
typedef short s16x4_t __attribute__((ext_vector_type(4)));
typedef float f32x16 __attribute__((ext_vector_type(16)));
__device__ __forceinline__ int crow(int r, int hi) { return (r & 3) + 8 * (r >> 2) + 4 * hi; }
__device__ __forceinline__ unsigned cvtpk(float lo, float hi) { f32x2 v = {lo, hi}; bf16x2_t b = __builtin_convertvector(v, bf16x2_t); return __builtin_bit_cast(unsigned, b); }
__device__ __forceinline__ s16x4_t vtr(const LAS unsigned char* p) { return __builtin_bit_cast(s16x4_t, __builtin_amdgcn_ds_read_tr16_b64_v4i16((LAS s16x4_t*)p)); }
constexpr int AT_K = 0, AT_V = 16384, AT_WSF = 32768, AT_OST = 34816, AT_RPB = 67584, AT_END = 69632;
template <int KIND>
__device__ __forceinline__ void attn_unit(const Args& a, LAS unsigned char* lds, int l, int u, int tid) {
    asm volatile("" : "+v"(tid));
    const int lane = tid & 63, wid = __builtin_amdgcn_readfirstlane(tid >> 6), r32 = lane & 31, hi = lane >> 5;
    const bf16_t* PX = (const bf16_t*)(a.ws + WS_PX); bf16_t* Y = (bf16_t*)(a.ws + WS_Y);
    int b, qcol, kcol, vcol, ycol, qrow0, nloc = 0, lo = 0; bool sink = false; int hsink = 0;
    int qpos0 = 0, blk = 0, rq = 0, cbase = 0, rq4 = 0;
    if (KIND == 0) { b = u >> 6; const int kvh = (u >> 5) & 1; blk = u & 31; const int h = 2 * kvh + (wid >> 2); qpos0 = blk * 128 + 32 * (wid & 3); qrow0 = b * 4096 + qpos0;
        qcol = 1024 + h * 64; kcol = 1536 + kvh * 64; vcol = 1664 + kvh * 64; ycol = 256 + h * 64; lo = (blk == 0) ? 2 : 0; nloc = ((blk == 31) ? 3 : 5) - lo + 1; sink = true; hsink = h; }
    else if (KIND == 1) { b = u >> 6; const int h = (u >> 4) & 3; rq4 = u & 15; rq = 4 * rq4 + (wid >> 1); cbase = 32 * (wid & 1); qrow0 = b * 4096 + rq * 64 + cbase;
        qcol = 1280 + h * 64; kcol = 1792 + h * 64; vcol = 2048 + h * 64; ycol = 768 + h * 64;
        const int ra = 4 * rq4 - 4, rb = 4 * rq4 + 3 - 4; lo = ra < 0 ? 0 : (ra > 56 ? 56 : ra); const int hi_r = (rb < 0 ? 0 : (rb > 56 ? 56 : rb)) + 7; nloc = hi_r - lo + 1;
        LAS float* rpbL = (LAS float*)(lds + AT_RPB); const float* src = a.in[I_RPB] + (size_t)(l * 4 + h) * 465;
        for (int i = tid; i < 465; i += NTHR) rpbL[i] = src[i] * LOG2E; }
    else { b = u >> 3; const int h = (u >> 1) & 3; qrow0 = TX + b * 256 + 32 * wid;
        if ((u & 1) == 0) { qcol = 1024 + h * 64; kcol = 1536 + (h >> 1) * 64; vcol = 1664 + (h >> 1) * 64; ycol = 256 + h * 64; sink = true; hsink = h; }
        else { qcol = 1280 + h * 64; kcol = 1792 + h * 64; vcol = 2048 + h * 64; ycol = 768 + h * 64; } }
    const int NT = nloc + 4;
    bf16x8_t qr[4];
    { const bf16_t* qp = PX + (size_t)(qrow0 + r32) * INW + qcol + hi * 8;
#pragma unroll
      for (int d0 = 0; d0 < 4; ++d0) qr[d0] = *(const bf16x8_t*)(qp + d0 * 16); }
    const int krow = 8 * wid + (lane & 7), kchunk = lane >> 3; const int vrow = 16 * (wid & 3) + (lane >> 2), vcoff = (wid >> 2) * 32 + (lane & 3) * 8;
    const int kdst = AT_K + kchunk * 1024 + krow * 16, vdst = AT_V + wid * 1024 + lane * 16;
    auto tile_row0 = [&](int t) -> int { if (t < nloc) { if (KIND == 0) return b * 4096 + blk * 128 - 128 + 64 * (lo + t); else return b * 4096 + (lo + t) * 64; } return TX + b * 256 + 64 * (t - nloc); };
    u32x4 gk, gv;
    { const int R0 = tile_row0(0); gk = *(const u32x4*)(PX + (size_t)(R0 + krow) * INW + kcol + kchunk * 8); gv = *(const u32x4*)(PX + (size_t)(R0 + vrow) * INW + vcol + vcoff); }
    *(LAS u32x4*)(lds + kdst) = gk; *(LAS u32x4*)(lds + vdst) = gv;
    float mhat = -1e30f, l_reg = 0.f; f32x16 o[2];
#pragma unroll
    for (int r = 0; r < 16; ++r) { o[0][r] = 0.f; o[1][r] = 0.f; }
    LAS float* wsf = (LAS float*)(lds + AT_WSF) + wid * 64;
    const LAS unsigned char* vb0 = lds + AT_V + ((lane >> 4) & 1) * 32 + (lane & 3) * 8 + (4 * hi + ((lane & 15) >> 2)) * 64;
    const LAS unsigned char* kb0 = lds + AT_K + hi * 1024 + r32 * 16;
    __syncthreads();
    for (int t = 0; t < NT; ++t) {
        const int bufo = (t & 1) * 8192;
        if (t + 1 < NT) { const int R0 = tile_row0(t + 1); gk = *(const u32x4*)(PX + (size_t)(R0 + krow) * INW + kcol + kchunk * 8); gv = *(const u32x4*)(PX + (size_t)(R0 + vrow) * INW + vcol + vcoff); }
        bool need = true; bool full = true; int ts = 0, rk = 0;
        if (t < nloc) {
            if (KIND == 0) { ts = blk * 128 - 128 + 64 * (lo + t); need = (ts + 63 >= qpos0 - 128) && (ts <= qpos0 + 31 + 128); full = (qpos0 + 31 - ts <= 128) && (ts + 63 - qpos0 <= 128); }
            if (KIND == 1) { rk = lo + t; const int r0 = (rq - 4) < 0 ? 0 : ((rq - 4) > 56 ? 56 : (rq - 4)); need = (rk >= r0) && (rk <= r0 + 7); full = false; }
        }
        if (need) {
            f32x16 p0, p1;
#pragma unroll
            for (int r = 0; r < 16; ++r) { p0[r] = 0.f; p1[r] = 0.f; }
            const LAS unsigned char* kb = kb0 + bufo;
#pragma unroll
            for (int d0 = 0; d0 < 4; ++d0) { const bf16x8_t k0 = *(const LAS bf16x8_t*)(kb + d0 * 2048), k1 = *(const LAS bf16x8_t*)(kb + d0 * 2048 + 512);
                p0 = __builtin_amdgcn_mfma_f32_32x32x16_bf16(k0, qr[d0], p0, 0, 0, 0); p1 = __builtin_amdgcn_mfma_f32_32x32x16_bf16(k1, qr[d0], p1, 0, 0, 0); }
            constexpr float C2 = 0.125f * LOG2E;
#pragma unroll
            for (int r = 0; r < 16; ++r) { p0[r] *= C2; p1[r] *= C2; }
            if (!full) {
                if (KIND == 0) { const int tq = qpos0 + r32;
#pragma unroll
                    for (int r = 0; r < 16; ++r) { const int k0 = ts + crow(r, hi), d0 = tq - k0, d1 = d0 - 32; if (d0 > 128 || d0 < -128) p0[r] = -1e30f; if (d1 > 128 || d1 < -128) p1[r] = -1e30f; } }
                if (KIND == 1) { const int c = cbase + r32; const int wsc = (c - 8) < 0 ? 0 : ((c - 8) > 48 ? 48 : (c - 8)); const LAS float* rp = (const LAS float*)(lds + AT_RPB) + (rk - rq + 7) * 31 + 15 - c;
#pragma unroll
                    for (int r = 0; r < 16; ++r) { const int c0 = crow(r, hi), c1 = c0 + 32; const bool ok0 = (c0 >= wsc) && (c0 < wsc + 16), ok1 = (c1 >= wsc) && (c1 < wsc + 16);
                        p0[r] = ok0 ? p0[r] + rp[ok0 ? c0 : c] : -1e30f; p1[r] = ok1 ? p1[r] + rp[ok1 ? c1 : c] : -1e30f; } }
            }
            float rm = fmaxf(p0[0], p1[0]);
#pragma unroll
            for (int r = 1; r < 16; ++r) rm = fmaxf(rm, fmaxf(p0[r], p1[r]));
            { auto rr = __builtin_amdgcn_permlane32_swap(__float_as_uint(rm), __float_as_uint(rm), false, false); rm = fmaxf(__uint_as_float(rr[0]), __uint_as_float(rr[1])); }
            const float mnew = fmaxf(mhat, rm); const float f = __builtin_amdgcn_exp2f(mhat - mnew); const bool grew = mnew > mhat; mhat = mnew;
            float sacc = 0.f;
#pragma unroll
            for (int r = 0; r < 16; ++r) { p0[r] = (p0[r] > -1e29f) ? __builtin_amdgcn_exp2f(p0[r] - mnew) : 0.f; p1[r] = (p1[r] > -1e29f) ? __builtin_amdgcn_exp2f(p1[r] - mnew) : 0.f; sacc += p0[r] + p1[r]; }
            l_reg = l_reg * f + sacc;
            if (__any(grew)) { if (hi == 0) wsf[r32] = f; LDS_WAIT();
#pragma unroll
                for (int r = 0; r < 16; ++r) { const float fr_ = wsf[crow(r, hi)]; o[0][r] *= fr_; o[1][r] *= fr_; }
                LDS_WAIT(); }
            u32x4 pw0, pw1, pw2, pw3;
            pw0 = (u32x4){cvtpk(p0[0], p0[1]), cvtpk(p0[2], p0[3]), cvtpk(p0[4], p0[5]), cvtpk(p0[6], p0[7])}; pw1 = (u32x4){cvtpk(p0[8], p0[9]), cvtpk(p0[10], p0[11]), cvtpk(p0[12], p0[13]), cvtpk(p0[14], p0[15])};
            pw2 = (u32x4){cvtpk(p1[0], p1[1]), cvtpk(p1[2], p1[3]), cvtpk(p1[4], p1[5]), cvtpk(p1[6], p1[7])}; pw3 = (u32x4){cvtpk(p1[8], p1[9]), cvtpk(p1[10], p1[11]), cvtpk(p1[12], p1[13]), cvtpk(p1[14], p1[15])};
            const LAS unsigned char* vb = vb0 + bufo;
#pragma unroll
            for (int d0 = 0; d0 < 2; ++d0) {
#pragma unroll
                for (int ks = 0; ks < 4; ++ks) { const s16x4_t vl = vtr(vb + d0 * 4096 + ks * 1024), vh = vtr(vb + d0 * 4096 + ks * 1024 + 512);
                    const bf16x8_t vf = (bf16x8_t){vl[0], vl[1], vl[2], vl[3], vh[0], vh[1], vh[2], vh[3]};
                    const bf16x8_t pa = __builtin_bit_cast(bf16x8_t, ks == 0 ? pw0 : (ks == 1 ? pw1 : (ks == 2 ? pw2 : pw3)));
                    o[d0] = __builtin_amdgcn_mfma_f32_32x32x16_bf16(pa, vf, o[d0], 0, 0, 0); } }
        }
        if (t + 1 < NT) { const int nb = ((t + 1) & 1) * 8192; *(LAS u32x4*)(lds + kdst + nb) = gk; *(LAS u32x4*)(lds + vdst + nb) = gv; }
        __syncthreads();
    }
    { auto rr = __builtin_amdgcn_permlane32_swap(__float_as_uint(l_reg), __float_as_uint(l_reg), false, false); l_reg = __uint_as_float(rr[0]) + __uint_as_float(rr[1]); }
    if (sink) l_reg += __builtin_amdgcn_exp2f(a.in[I_SINK][l * 4 + hsink] * LOG2E - mhat);
    if (hi == 0) wsf[32 + r32] = 1.0f / l_reg;
    LDS_WAIT();
    LAS bf16_t* stg = (LAS bf16_t*)(lds + AT_OST) + wid * 2048;
#pragma unroll
    for (int r = 0; r < 16; ++r) { const int orow = crow(r, hi); const float il = wsf[32 + orow];
        stg[orow * 64 + r32] = (bf16_t)f2bf(o[0][r] * il); stg[orow * 64 + 32 + r32] = (bf16_t)f2bf(o[1][r] * il); }
    LDS_WAIT();
#pragma unroll
    for (int i = 0; i < 4; ++i) { const int row = i * 8 + (lane >> 3), ch = lane & 7; const u32x4 v = *(const LAS u32x4*)(stg + row * 64 + ch * 8);
        *(u32x4*)(Y + (size_t)(qrow0 + row) * D + ycol + ch * 8) = v; }
    __syncthreads();
}

__device__ __forceinline__ void phase_mix1(const Args& a, unsigned char* ldsg, int vcu, int G, int l) {
    LAS unsigned char* lds = (LAS unsigned char*)ldsg;
    int tid_ = threadIdx.x; asm volatile("" : "+v"(tid_));
    const int tid = tid_, lane = tid & 63, wave = __builtin_amdgcn_readfirstlane(tid >> 6);
    unsigned char* ws = a.ws; const bf16_t* PX = (const bf16_t*)(ws + WS_PX); bf16_t* Y = (bf16_t*)(ws + WS_Y);
    const bool upd = (l == 0); const int nrows = upd ? TT : TX;
    const int gw = vcu * NWAVES + wave, NGW = G * NWAVES;
    load_tw(a, lds, tid);
    for (int it = vcu; it < 1024; it += G) hyena_item(a, lds, l, it >> 2, it & 3, tid);
    if (upd) for (int it = vcu; it < 32; it += G) ctx_hyena_item(a, lds, l, it, tid);
    __syncthreads();
    LAS float* pw = (LAS float*)(lds + 73728); LAS float* dv = (LAS float*)(lds + 139264 + wave * 1024);
    { const float* src = a.in[I_POOLW] + (size_t)l * 4 * 64 * 64; for (int i = tid; i < 4 * 64 * 64; i += NTHR) pw[i] = src[i]; }
    __syncthreads();
    const float* pscale = a.in[I_POOLS] + (size_t)l * 256;
    for (int row = gw; row < nrows; row += NGW) {
        const bool lat = row < TX; const int tpos = lat ? (row & 4095) : ((row - TX) & 255); const int Ls = lat ? 4096 : 256;
        const bf16_t* pr = PX + (size_t)row * INW;
        { const int g = lane >> 4, hw = 1 << g;
          const int c = 768 + 4 * lane; float s0 = 0.f, s1 = 0.f, s2 = 0.f, s3 = 0.f; int cnt = 0;
#pragma unroll
          for (int off = -8; off < 8; ++off) { const int tp = tpos + off; const bool in = (off >= -hw) && (off < hw) && (tp >= 0) && (tp < Ls);
              if (in) { const u32x2 v = *(const u32x2*)(pr + (ptrdiff_t)off * INW + c); s0 += bflo(v.x); s1 += bfhi(v.x); s2 += bflo(v.y); s3 += bfhi(v.y); cnt++; } }
          const u32x2 u0 = *(const u32x2*)(pr + c); const float ic = 1.0f / (float)cnt;
          f32x4 dd; dd[0] = s0 * ic - bflo(u0.x); dd[1] = s1 * ic - bfhi(u0.x); dd[2] = s2 * ic - bflo(u0.y); dd[3] = s3 * ic - bfhi(u0.y);
          *(LAS f32x4*)(dv + 4 * lane) = dd;
          LDS_WAIT();
          const int j0 = 4 * (lane & 15); f32x4 acc = {0.f, 0.f, 0.f, 0.f};
          const LAS float* dg = dv + g * 64; const LAS float* wg = pw + g * 4096 + j0;
#pragma unroll 8
          for (int i = 0; i < 64; ++i) { const float di = dg[i]; const f32x4 wv = *(const LAS f32x4*)(wg + i * 64); acc += wv * di; }
          const f32x4 sc = *(const f32x4*)(pscale + g * 64 + j0); acc *= sc;
          u32x2 ov; ov.x = pk2(acc[0], acc[1]); ov.y = pk2(acc[2], acc[3]);
          *(u32x2*)(Y + (size_t)row * D + 512 + g * 64 + j0) = ov;
          LDS_WAIT(); }
    }
    __syncthreads();
    for (int u = vcu; u < 512; u += G) attn_unit<0>(a, lds, l, u, tid);
    for (int u = vcu; u < 512; u += G) attn_unit<1>(a, lds, l, u, tid);
    if (upd) for (int u = vcu; u < 64; u += G) attn_unit<2>(a, lds, l, u, tid);
}

__device__ __forceinline__ void phase_select(const Args& a, unsigned char* ldsg, int vcu, int G, bool with_ctx) {
    LAS float* vals = (LAS float*)(LAS unsigned char*)ldsg;
    int tid_ = threadIdx.x; asm volatile("" : "+v"(tid_));
    const int tid = tid_; unsigned char* ws = a.ws;
    const float* AFFT = (const float*)(ws + WS_AFFT); int* ROWMAP = (int*)(ws + WS_ROWMAP); float* GATE = (float*)(ws + WS_GATE); int* INV = (int*)(ws + WS_INV);
    const int nitems = 1024 + (with_ctx ? 128 : 0);
    for (int item = vcu; item < nitems; item += G) {
        int e, ch, base, Ls, cap, slot0;
        if (item < 1024) { const int b = item >> 7; e = (item >> 3) & 15; ch = item & 7; base = b * 4096; Ls = 4096; cap = CAPX; slot0 = b * CAPX; }
        else { const int it = item - 1024; const int b = it >> 4; e = it & 15; ch = 0; base = TX + b * 256; Ls = 256; cap = CAPC; slot0 = NB * CAPX + b * CAPC; }
        for (int i = tid; i < Ls; i += NTHR) vals[i] = AFFT[(size_t)e * TT + base + i];
        __syncthreads();
        const int i = ch * NTHR + tid;
        if (i < Ls) { const float av = vals[i]; int cnt = 0;
            for (int j4 = 0; j4 < Ls; j4 += 4) { const f32x4 v = *(const LAS f32x4*)(vals + j4);
#pragma unroll
                for (int q = 0; q < 4; ++q) cnt += ((v[q] > av) || (v[q] == av && (j4 + q) < i)) ? 1 : 0; }
            if (cnt < cap) { const int slot = e * SLOTS + slot0 + cnt; ROWMAP[slot] = base + i; GATE[slot] = av; INV[(size_t)(base + i) * 16 + e] = slot; } }
        __syncthreads();
    }
}
__device__ __forceinline__ void phase_gather(const Args& a, int vcu, int G, bool with_ctx) {
    int tid_ = threadIdx.x; asm volatile("" : "+v"(tid_));
    const int tid = tid_, lane = tid & 63, wave = __builtin_amdgcn_readfirstlane(tid >> 6); unsigned char* ws = a.ws;
    const int* ROWMAP = (const int*)(ws + WS_ROWMAP); const bf16_t* HX = (const bf16_t*)(ws + WS_HX); bf16_t* XG = (bf16_t*)(ws + WS_XG);
    const int per = with_ctx ? SLOTS : NB * CAPX; const int gw = vcu * NWAVES + wave, NGW = G * NWAVES;
    for (int it = gw; it < NE * per; it += NGW) { const int e = it / per, s = it % per; const int slot = e * SLOTS + s; const int src = ROWMAP[slot];
        const u32x4* sp = (const u32x4*)(HX + (size_t)src * D) + 2 * lane; u32x4* dp = (u32x4*)(XG + (size_t)slot * D) + 2 * lane;
        const u32x4 v0 = sp[0], v1 = sp[1]; dp[0] = v0; dp[1] = v1; }
}
__device__ __forceinline__ void phase_combine(const Args& a, int vcu, int G, int l, bool with_ctx, bool final_norm) {
    int tid_ = threadIdx.x; asm volatile("" : "+v"(tid_));
    const int tid = tid_, lane = tid & 63, wave = __builtin_amdgcn_readfirstlane(tid >> 6); unsigned char* ws = a.ws;
    const int* INV = (const int*)(ws + WS_INV); const bf16_t* OB = (const bf16_t*)(ws + WS_XG); const float* MOD = (const float*)(ws + WS_MOD) + (size_t)l * 9 * 6144;
    float* CRES = (float*)(ws + WS_CRES); const float* fng = a.in[I_FNG];
    const int nrows = with_ctx ? TT : TX; const int gw = vcu * NWAVES + wave, NGW = G * NWAVES;
    for (int row = gw; row < nrows; row += NGW) {
        const bool lat = row < TX; float* xr = lat ? a.out + (size_t)row * D : CRES + (size_t)(row - TX) * D; const int mrow = lat ? (row >> 12) : 8;
        const int myinv = (lane < 16) ? INV[(size_t)row * 16 + lane] : -1;
        f32x4 acc[4];
#pragma unroll
        for (int j = 0; j < 4; ++j) acc[j] = (f32x4){0.f, 0.f, 0.f, 0.f};
        for (int e = 0; e < 16; ++e) { const int s = __shfl(myinv, e);
            if (s >= 0) { const bf16_t* orow = OB + (size_t)s * D;
#pragma unroll
                for (int j = 0; j < 4; ++j) { const u32x2 v = *(const u32x2*)(orow + 256 * j + 4 * lane); acc[j][0] += bflo(v.x); acc[j][1] += bfhi(v.x); acc[j][2] += bflo(v.y); acc[j][3] += bfhi(v.y); } } }
        const float* gp = MOD + mrow * 6144 + 5 * 1024; f32x4 v[4]; float ss = 0.f;
#pragma unroll
        for (int j = 0; j < 4; ++j) { const f32x4 g = *(const f32x4*)(gp + 256 * j + 4 * lane); v[j] = *(const f32x4*)(xr + 256 * j + 4 * lane) + g * acc[j];
            ss += (v[j][0] * v[j][0] + v[j][1] * v[j][1]) + (v[j][2] * v[j][2] + v[j][3] * v[j][3]); }
        if (final_norm) { const float rstd = 1.0f / sqrtf(wave_sum(ss) * (1.0f / D) + 1e-6f);
#pragma unroll
            for (int j = 0; j < 4; ++j) { const f32x4 g = *(const f32x4*)(fng + 256 * j + 4 * lane); v[j] = v[j] * rstd * g; } }
#pragma unroll
        for (int j = 0; j < 4; ++j) *(f32x4*)(xr + 256 * j + 4 * lane) = v[j];
    }
}

__global__ void __launch_bounds__(NTHR, 2) fwd_kernel(Args a) {
    extern __shared__ __attribute__((aligned(16))) unsigned char lds[];
    cg::grid_group grid = cg::this_grid();
    const int G = gridDim.x, bx = blockIdx.x; const int vcu = (G % 8 == 0) ? (bx % 8) * (G / 8) + bx / 8 : bx;
    unsigned char* ws = a.ws;
    PG8_LAS unsigned char* glds = (PG8_LAS unsigned char*)lds;
    phase_prologue(a, lds, vcu, G);
    grid.sync();
    for (int l = 0; l < 2; ++l) {
        const bool upd = (l == 0);
        const float* srcx = upd ? a.in[I_X] : a.out; const float* srcc = upd ? a.in[I_CTX] : (const float*)(ws + WS_CRES);
        phase_norm(a, lds, vcu, G, l, srcx, srcc, a.in[I_N1G] + l * D, 0, TT, false);
        if (upd) { load_tw(a, (LAS unsigned char*)lds, threadIdx.x); for (int it = vcu; it < 1024; it += G) spectrum_item(a, (LAS unsigned char*)lds, it, threadIdx.x); }
        grid.sync();
        { pg8::Gemm g{(const pg8::bf16_t*)(ws + WS_HX), (const pg8::bf16_t*)(ws + WS_WIN_T) + (size_t)l * INW * D, TT, INW, D};
          pg8::GroupOrder S; S.init(1, TT / 256, INW / 256, 0, G, bx);
          pg8::EpiIn E{(pg8::bf16_t*)(ws + WS_PX), (const float*)(ws + WS_ROPE), (pg8::bf16_t*)(ws + WS_UT), glds + 131072};
          pg8::gemm_phase<pg8::EpiIn, pg8::GroupOrder, true, true>(glds, g, S, E); }
        grid.sync();
        phase_mix1(a, lds, vcu, G, l);
        grid.sync();
        { pg8::Gemm g{(const pg8::bf16_t*)(ws + WS_Y), (const pg8::bf16_t*)(ws + WS_WOUT_T) + (size_t)l * D * D, TT, D, D};
          pg8::GroupOrder S; S.init(1, (upd ? TT : TX) / 256, D / 256, 0, G, bx);
          pg8::EpiOut E{srcx, srcc, a.out, (float*)(ws + WS_CRES), (const float*)(ws + WS_MOD) + (size_t)l * 9 * 6144};
          pg8::gemm_phase<pg8::EpiOut, pg8::GroupOrder, true, true>(glds, g, S, E); }
        grid.sync();
        phase_norm(a, lds, vcu, G, l, a.out, (const float*)(ws + WS_CRES), a.in[I_N2G] + l * D, 3, upd ? TT : TX, true);
        grid.sync();
        phase_select(a, lds, vcu, G, upd);
        grid.sync();
        phase_gather(a, vcu, G, upd);
        grid.sync();
        { pg8::Gemm g{(const pg8::bf16_t*)(ws + WS_XG), (const pg8::bf16_t*)(ws + WS_WGU_T) + (size_t)l * NE * 4096 * D, NE * SLOTS, NE * 4096, D};
          pg8::GroupOrder S; S.init(NE, upd ? 17 : 16, 16, 17, G, bx);
          pg8::EpiGU E{(pg8::bf16_t*)(ws + WS_ACT)};
          pg8::gemm_phase<pg8::EpiGU, pg8::GroupOrder, true, true>(glds, g, S, E); }
        grid.sync();
        { pg8::Gemm g{(const pg8::bf16_t*)(ws + WS_ACT), (const pg8::bf16_t*)(ws + WS_WD_T) + (size_t)l * NE * D * FF, NE * SLOTS, NE * D, FF};
          pg8::GroupOrder S; S.init(NE, upd ? 17 : 16, 4, 17, G, bx);
          pg8::EpiDown E{(pg8::bf16_t*)(ws + WS_XG), (const float*)(ws + WS_GATE)};
          pg8::gemm_phase<pg8::EpiDown, pg8::GroupOrder, true, true>(glds, g, S, E); }
        grid.sync();
        phase_combine(a, vcu, G, l, upd, !upd);
        if (upd) grid.sync();
    }
}

extern "C" void kernel_launch(void* const* d_in, const int* in_sizes, int n_in, void* d_out, int out_size, void* d_ws, size_t ws_size, hipStream_t stream) {
    static int grid = 0;
    if (grid == 0) {
        int dev = 0, cus = 0, per_cu = 0;
        hipGetDevice(&dev); hipDeviceGetAttribute(&cus, hipDeviceAttributeMultiprocessorCount, dev);
        if (hipFuncSetAttribute((const void*)fwd_kernel, hipFuncAttributeMaxDynamicSharedMemorySize, LDS_BYTES) != hipSuccess) { fprintf(stderr, "kernel_launch: hipFuncSetAttribute failed\n"); grid = -1; return; }
        if (hipOccupancyMaxActiveBlocksPerMultiprocessor(&per_cu, (const void*)fwd_kernel, NTHR, LDS_BYTES) != hipSuccess || per_cu < 1) { fprintf(stderr, "kernel_launch: occupancy query failed (%d)\n", per_cu); grid = -1; return; }
        grid = cus * 1;
        if (n_in != N_IN || ws_size < WS_END) { fprintf(stderr, "kernel_launch: unexpected n_in %d / ws %zu\n", n_in, ws_size); grid = -1; return; }
    }
    if (grid < 0) return;
    Args a{};
    for (int i = 0; i < N_IN; ++i) a.in[i] = (const float*)d_in[i];
    a.out = (float*)d_out; a.ws = (unsigned char*)d_ws;
    void* args[] = {&a};
    hipError_t e = hipLaunchCooperativeKernel((const void*)fwd_kernel, dim3(grid), dim3(NTHR), args, LDS_BYTES, stream);
    if (e != hipSuccess) fprintf(stderr, "cooperative launch failed: %s (grid %d)\n", hipGetErrorString(e), grid);
}
```

```cpp
#define AMP_PHASE -1
#include <hip/hip_runtime.h>
#include <hip/hip_cooperative_groups.h>
#include <cstdio>
#include <cstdint>
namespace cg = cooperative_groups;
namespace pg8 {
#define PG8_LAS __attribute__((address_space(3)))
typedef unsigned short bf16_t;
typedef short bf16x8 __attribute__((ext_vector_type(8)));
typedef float f32x4 __attribute__((ext_vector_type(4)));
typedef unsigned u32x4 __attribute__((ext_vector_type(4)));
constexpr int BM = 256, BK = 64, HALF = 128, HTB = HALF * BK * 2  , STAGE_BYTES = 8 * HTB, NXCD = 8, WGM = 8;

__host__ __device__ __forceinline__ int lds_byte(int r, int c) { const int st = (r >> 4) * 2 + (c >> 5), rr = r & 15, cc = c & 31, ob = rr * 64 + cc * 2; return st * 1024 + (ob ^ (((ob >> 9) & 1) << 5)); }
__host__ __device__ __forceinline__ void stage_rc(int b, int& R, int& C) { const int st = b / 1024, sb = b % 1024, swz = sb ^ (((sb >> 9) & 1) << 5); R = (st >> 1) * 16 + swz / 64; C = (st & 1) * 32 + (swz % 64) / 2; }
__host__ __device__ __forceinline__ int perm32(int rho) { const int n = rho >> 4, i = rho & 15; return 8 * (i >> 2) + 4 * n + (i & 3); }

struct Unit { int pm, pn; };
struct Gemm { const bf16_t* A; const bf16_t* Bt; int M, N, K; };

struct StaticOrder {
    int nM, nN, nwg, G, c;
    __host__ __device__ void init(int M, int N, int G_, int c_) { nM = M / BM; nN = N / BM; nwg = nM * nN; G = G_; c = c_; }
    __host__ __device__ bool next(int i, Unit& u) const {
        const long L = (long)i * G + c; if (L >= nwg) return false;
        int wgid = (int)L; { const int q = nwg / NXCD, r = nwg % NXCD, xcd = wgid % NXCD, off = wgid / NXCD; wgid = (xcd < r ? xcd * (q + 1) : r * (q + 1) + (xcd - r) * q) + off; }
        const int nig = WGM * nN, gid = wgid / nig, fm = gid * WGM, gsz = (nM - fm) < WGM ? (nM - fm) : WGM;
        u.pm = fm + ((wgid % nig) % gsz); u.pn = (wgid % nig) / gsz; return true;
    }
    __device__ __forceinline__ void a_ready(const Unit&) const {}
    __device__ __forceinline__ void done(const Unit&) const {}
};

__device__ __forceinline__ unsigned cvt_pk_bf16(float lo, float hi) { unsigned r; asm volatile("v_cvt_pk_bf16_f32 %0, %1, %2" : "=v"(r) : "v"(lo), "v"(hi)); return r; }
typedef float f32x2 __attribute__((ext_vector_type(2)));
__device__ __forceinline__ f32x2 gelu_pk(f32x2 v) {
    const f32x2 av = __builtin_elementwise_abs(v), d = av * 0.2316418882f + 1.0f;
    f32x2 t; t.x = __builtin_amdgcn_rcpf(d.x); t.y = __builtin_amdgcn_rcpf(d.y);
    f32x2 q = t * 0.5307027145f + (-0.7265760135f); q = q * t + 0.7107068705f; q = q * t + (-0.142248368f); q = q * t + 0.127414796f; q = q * t;
    const f32x2 s = (v * v) * (-0.72134752044f);
    f32x2 e; e.x = __builtin_amdgcn_exp2f(s.x); e.y = __builtin_amdgcn_exp2f(s.y);
    const f32x2 m = v * (q * e), r = v - m;
    f32x2 o; o.x = v.x < 0.f ? m.x : r.x; o.y = v.y < 0.f ? m.y : r.y; return o;
}


struct GroupOrder {
    int nMl, nNl, strideM, nper, nwg, G, c;
    __device__ void init(int ng, int nMl_, int nNl_, int strideM_, int G_, int c_) { nMl = nMl_; nNl = nNl_; strideM = strideM_; nper = nMl_ * nNl_; nwg = ng * nper; G = G_; c = c_; }
    __device__ bool next(int i, Unit& u) const {
        const long L = (long)i * G + c; if (L >= nwg) return false;
        int wgid = (int)L; { const int q = nwg / NXCD, r = nwg % NXCD, xcd = wgid % NXCD, off = wgid / NXCD; wgid = (xcd < r ? xcd * (q + 1) : r * (q + 1) + (xcd - r) * q) + off; }
        const int e = wgid / nper, id = wgid % nper;
        const int nig = WGM * nNl, gid = id / nig, fm = gid * WGM, gsz = (nMl - fm) < WGM ? (nMl - fm) : WGM;
        u.pm = e * strideM + fm + ((id % nig) % gsz); u.pn = e * nNl + (id % nig) / gsz; return true;
    }
    __device__ __forceinline__ void a_ready(const Unit&) const {}
    __device__ __forceinline__ void done(const Unit&) const {}
};

constexpr int TXR = 32768;
struct EpiIn {
    static constexpr bool PERM = true, AFTER_DRAIN = false;
    bf16_t* PX; const float* rope; bf16_t* UT; PG8_LAS unsigned char* stgbase;
    __device__ __forceinline__ void operator()(const f32x4 (&acc)[2][2][4][2], const Unit& u, int wr, int wc, int fr, int fq) const {
        const int row0 = u.pm * BM + wr * 64 + fr; const int col0 = u.pn * BM + wc * 32 + 8 * fq;
        const bool latent = u.pm < (TXR / BM);
        if (latent && u.pn < 3) {
            PG8_LAS unsigned char* stg = stgbase + (wr * 4 + wc) * 2304; const int lane = fq * 16 + fr;
            const int b = u.pm >> 4, trow0 = (u.pm & 15) * BM; const int col = lane >> 1, half = lane & 1;
#pragma unroll
            for (int ai = 0; ai < 2; ++ai)
#pragma unroll
                for (int bj = 0; bj < 2; ++bj)
#pragma unroll
                    for (int mh = 0; mh < 2; ++mh) {
#pragma unroll
                        for (int mm = 0; mm < 2; ++mm)
#pragma unroll
                            for (int n = 0; n < 2; ++n) { const f32x4 v = acc[ai][bj][2 * mh + mm][n]; const unsigned w0 = cvt_pk_bf16(v[0], v[1]), w1 = cvt_pk_bf16(v[2], v[3]);
                                PG8_LAS unsigned char* p = stg + (8 * fq + 4 * n) * 72 + (16 * mm + fr) * 2;
                                *(PG8_LAS unsigned short*)(p) = (unsigned short)w0; *(PG8_LAS unsigned short*)(p + 72) = (unsigned short)(w0 >> 16);
                                *(PG8_LAS unsigned short*)(p + 144) = (unsigned short)w1; *(PG8_LAS unsigned short*)(p + 216) = (unsigned short)(w1 >> 16); }
                        asm volatile("s_waitcnt lgkmcnt(0)" ::: "memory");
                        typedef unsigned u32x2v __attribute__((ext_vector_type(2)));
                        const PG8_LAS unsigned char* rp = stg + col * 72 + half * 32;
                        const u32x2v a0 = *(const PG8_LAS u32x2v*)(rp), a1 = *(const PG8_LAS u32x2v*)(rp + 8), a2 = *(const PG8_LAS u32x2v*)(rp + 16), a3 = *(const PG8_LAS u32x2v*)(rp + 24);
                        const int ch = u.pn * BM + bj * HALF + wc * 32 + col; const int t0 = trow0 + ai * HALF + wr * 64 + mh * 32 + half * 16;
                        u32x4* gp = (u32x4*)(UT + ((size_t)(b * 768 + ch)) * 4096 + t0);
                        gp[0] = (u32x4){a0.x, a0.y, a1.x, a1.y}; gp[1] = (u32x4){a2.x, a2.y, a3.x, a3.y};
                        asm volatile("s_waitcnt lgkmcnt(0)" ::: "memory"); }
            return;
        }
#pragma unroll
        for (int ai = 0; ai < 2; ++ai)
#pragma unroll
            for (int m = 0; m < 4; ++m) { const int row = row0 + ai * HALF + m * 16; bf16_t* rowp = PX + (size_t)row * 2304 + col0;
#pragma unroll
                for (int bj = 0; bj < 2; ++bj) { f32x4 v0 = acc[ai][bj][m][0], v1 = acc[ai][bj][m][1];
                    const bool dorope = latent && (u.pn == 4 || (u.pn == 6 && bj == 0));
                    if (dorope) {
                        const int t = row & 4095; const int pos = (wc & 1) ? (t & 63) : (t >> 6);
                        const f32x4* rp = (const f32x4*)(rope + (pos * 16 + 8 * (fq & 1)) * 2);
                        const f32x4 r0 = rp[0], r1 = rp[1], r2 = rp[2], r3 = rp[3];
                        f32x4 p0, p1;
#pragma unroll
                        for (int j = 0; j < 4; ++j) { p0[j] = __shfl_xor(v0[j], 32); p1[j] = __shfl_xor(v1[j], 32); }
                        const float c0[4] = {r0[0], r0[2], r1[0], r1[2]}, s0[4] = {r0[1], r0[3], r1[1], r1[3]};
                        const float c1[4] = {r2[0], r2[2], r3[0], r3[2]}, s1[4] = {r2[1], r2[3], r3[1], r3[3]};
                        const bool lo = fq < 2;
#pragma unroll
                        for (int j = 0; j < 4; ++j) {
                            v0[j] = lo ? (v0[j] * c0[j] - p0[j] * s0[j]) : (p0[j] * s0[j] + v0[j] * c0[j]);
                            v1[j] = lo ? (v1[j] * c1[j] - p1[j] * s1[j]) : (p1[j] * s1[j] + v1[j] * c1[j]); }
                    }
                    u32x4 w; w.x = cvt_pk_bf16(v0[0], v0[1]); w.y = cvt_pk_bf16(v0[2], v0[3]); w.z = cvt_pk_bf16(v1[0], v1[1]); w.w = cvt_pk_bf16(v1[2], v1[3]);
                    *(u32x4*)(rowp + bj * HALF) = w; } }
    }
};
struct EpiOut {
    static constexpr bool PERM = false, AFTER_DRAIN = false;
    const float* xold_x; const float* xold_c; float* dst_x; float* dst_c; const float* mod;
    __device__ __forceinline__ void operator()(const f32x4 (&acc)[2][2][4][2], const Unit& u, int wr, int wc, int fr, int fq) const {
        const int row0 = u.pm * BM + wr * 64 + fr, col0 = u.pn * BM + wc * 32 + 4 * fq;
        const bool latent = u.pm < (TXR / BM);
#pragma unroll
        for (int ai = 0; ai < 2; ++ai)
#pragma unroll
            for (int m = 0; m < 4; ++m) { const int row = row0 + ai * HALF + m * 16;
                const int mrow = latent ? (row >> 12) : 8; const float* gp = mod + mrow * 6144 + 2 * 1024 + col0;
                const size_t off = latent ? (size_t)row * 1024 + col0 : (size_t)(row - TXR) * 1024 + col0;
                const float* xo = (latent ? xold_x : xold_c) + off; float* xd = (latent ? dst_x : dst_c) + off;
#pragma unroll
                for (int bj = 0; bj < 2; ++bj)
#pragma unroll
                    for (int n = 0; n < 2; ++n) { const f32x4 g = *(const f32x4*)(gp + bj * HALF + n * 16), xv = *(const f32x4*)(xo + bj * HALF + n * 16);
                        *(f32x4*)(xd + bj * HALF + n * 16) = xv + g * acc[ai][bj][m][n]; } }
    }
};
struct EpiGU {
    static constexpr bool PERM = true, AFTER_DRAIN = false;
    bf16_t* ACT;
    __device__ __forceinline__ void operator()(const f32x4 (&acc)[2][2][4][2], const Unit& u, int wr, int wc, int fr, int fq) const {
        const int row0 = u.pm * BM + wr * 64 + fr; const int col0 = (u.pn & 15) * 128 + wc * 32 + 8 * fq;
#pragma unroll
        for (int ai = 0; ai < 2; ++ai)
#pragma unroll
            for (int m = 0; m < 4; ++m) { bf16_t* rowp = ACT + (size_t)(row0 + ai * HALF + m * 16) * 2048 + col0;
                f32x4 h[2];
#pragma unroll
                for (int n = 0; n < 2; ++n)
#pragma unroll
                    for (int j = 0; j < 4; ++j) { const float g = acc[ai][0][m][n][j], up = acc[ai][1][m][n][j]; h[n][j] = g / (1.0f + __expf(-g)) * up; }
                u32x4 w; w.x = cvt_pk_bf16(h[0][0], h[0][1]); w.y = cvt_pk_bf16(h[0][2], h[0][3]); w.z = cvt_pk_bf16(h[1][0], h[1][1]); w.w = cvt_pk_bf16(h[1][2], h[1][3]);
                *(u32x4*)rowp = w; }
    }
};
struct EpiDown {
    static constexpr bool PERM = true, AFTER_DRAIN = false;
    bf16_t* OB; const float* gate;
    __device__ __forceinline__ void operator()(const f32x4 (&acc)[2][2][4][2], const Unit& u, int wr, int wc, int fr, int fq) const {
        const int row0 = u.pm * BM + wr * 64 + fr; const int col0 = (u.pn & 3) * BM + wc * 32 + 8 * fq;
#pragma unroll
        for (int ai = 0; ai < 2; ++ai)
#pragma unroll
            for (int m = 0; m < 4; ++m) { const int row = row0 + ai * HALF + m * 16; const float g = gate[row]; bf16_t* rowp = OB + (size_t)row * 1024 + col0;
#pragma unroll
                for (int bj = 0; bj < 2; ++bj) { const f32x4 v0 = acc[ai][bj][m][0] * g, v1 = acc[ai][bj][m][1] * g;
                    u32x4 w; w.x = cvt_pk_bf16(v0[0], v0[1]); w.y = cvt_pk_bf16(v0[2], v0[3]); w.z = cvt_pk_bf16(v1[0], v1[1]); w.w = cvt_pk_bf16(v1[2], v1[3]);
                    *(u32x4*)(rowp + bj * HALF) = w; } }
    }
};

template <class Epi, class Sched, bool ALIGN_EPI = false, bool SP2 = false>
__device__ __forceinline__ void gemm_phase(PG8_LAS unsigned char* lds, const Gemm g, const Sched& S, const Epi& E) {
    int tid_ = threadIdx.x; asm volatile("" : "+v"(tid_));
    const int tid = tid_, wid = __builtin_amdgcn_readfirstlane(tid >> 6), lane = tid & 63, wr = wid >> 2, wc = wid & 3, fr = lane & 15, fq = lane >> 4;
    const int K = g.K, nt = K / BK;
    unsigned voffA[2], voffB[2];
#pragma unroll
    for (int i = 0; i < 2; ++i) { int R, C; stage_rc(tid * 16 + i * 8192, R, C); const int Rb = Epi::PERM ? ((R & ~31) + perm32(R & 31)) : R;
        voffA[i] = (unsigned)(R * K + C) * 2u; voffB[i] = (unsigned)(Rb * K + C) * 2u; }
    const size_t kstep = (size_t)(BK * 2);
    const size_t hstep = (size_t)HALF * K * 2;
    const size_t tstep = 2 * hstep;
    const unsigned ldsw = (unsigned)wid * 1024u;
    const int aoff = lds_byte(wr * 64 + fr, fq * 8), boff = lds_byte(wc * 32 + fr, fq * 8);
#define PG8_SA(b, h) (((b) * 2 + (h)) * HTB)
#define PG8_SB(b, h) ((4 + (b) * 2 + (h)) * HTB)
#define PG8_STAGE(bufoff, gbase, voff) do { _Pragma("unroll") for (int _i = 0; _i < 2; ++_i) \
        __builtin_amdgcn_global_load_lds((const unsigned*)((const char*)(gbase) + (voff)[_i]), (PG8_LAS unsigned*)(lds + (bufoff) + ldsw + _i * 8192), 16, 0, 0); } while (0)
#define PG8_LDA(dst, b, h) do { _Pragma("unroll") for (int m = 0; m < 4; ++m) _Pragma("unroll") for (int k = 0; k < 2; ++k) dst[m][k] = *(const PG8_LAS bf16x8*)(lds + PG8_SA(b, h) + aoff + m * 2048 + k * 1024); } while (0)
#define PG8_LDB(dst, b, h) do { _Pragma("unroll") for (int n = 0; n < 2; ++n) _Pragma("unroll") for (int k = 0; k < 2; ++k) dst[n][k] = *(const PG8_LAS bf16x8*)(lds + PG8_SB(b, h) + boff + n * 2048 + k * 1024); } while (0)
#define PG8_MMA(ai, bj, At, Bt) do { __builtin_amdgcn_s_setprio(1); _Pragma("unroll") for (int m = 0; m < 4; ++m) _Pragma("unroll") for (int n = 0; n < 2; ++n) _Pragma("unroll") for (int k = 0; k < 2; ++k) \
        acc[ai][bj][m][n] = __builtin_amdgcn_mfma_f32_16x16x32_bf16(Bt[n][k], At[m][k], acc[ai][bj][m][n], 0, 0, 0); __builtin_amdgcn_s_setprio(0); } while (0)
#define PG8_WAIT_V(n) asm volatile("s_waitcnt vmcnt(" #n ")" ::: "memory")
#define PG8_WAIT_L(n) asm volatile("s_waitcnt lgkmcnt(" #n ")" ::: "memory")
#define PG8_BAR __builtin_amdgcn_s_barrier()
#define PG8_SCHED __builtin_amdgcn_sched_barrier(0)
    Unit cur, nxt; int ui = 0;
    if (!S.next(0, cur)) return;
    f32x4 acc[2][2][4][2];
#pragma unroll
    for (int a = 0; a < 2; ++a)
#pragma unroll
        for (int b = 0; b < 2; ++b)
#pragma unroll
            for (int m = 0; m < 4; ++m)
#pragma unroll
                for (int n = 0; n < 2; ++n) acc[a][b][m][n] = (f32x4){0.f, 0.f, 0.f, 0.f};
    bf16x8 At[4][2], B0[2][2], B1[2][2];
    const char* cA = (const char*)g.A + (size_t)cur.pm * tstep; const char* cB = (const char*)g.Bt + (size_t)cur.pn * tstep;
    S.a_ready(cur);
    if constexpr (SP2) {
        PG8_STAGE(PG8_SB(0, 0), cB, voffB); PG8_STAGE(PG8_SB(0, 1), cB + hstep, voffB); PG8_STAGE(PG8_SA(0, 0), cA, voffA); PG8_STAGE(PG8_SA(0, 1), cA + hstep, voffA);
        if (wr == 1) PG8_BAR;
        PG8_WAIT_V(2); PG8_BAR;
        PG8_STAGE(PG8_SB(1, 0), cB + kstep, voffB); PG8_STAGE(PG8_SA(1, 0), cA + kstep, voffA); PG8_STAGE(PG8_SB(1, 1), cB + hstep + kstep, voffB);
        PG8_WAIT_V(6); PG8_BAR;
    } else {
        PG8_STAGE(PG8_SB(0, 0), cB, voffB); PG8_STAGE(PG8_SA(0, 0), cA, voffA); PG8_STAGE(PG8_SB(0, 1), cB + hstep, voffB); PG8_STAGE(PG8_SA(0, 1), cA + hstep, voffA);
        if (wr == 1) PG8_BAR;
        PG8_WAIT_V(4); PG8_BAR;
        PG8_STAGE(PG8_SB(1, 0), cB + kstep, voffB); PG8_STAGE(PG8_SA(1, 0), cA + kstep, voffA); PG8_STAGE(PG8_SB(1, 1), cB + hstep + kstep, voffB);
        PG8_WAIT_V(6); PG8_BAR;
    }
    for (;;) {
        const bool has_next = S.next(ui + 1, nxt);
        const char* nA = has_next ? (const char*)g.A + (size_t)nxt.pm * tstep : cA; const char* nB = has_next ? (const char*)g.Bt + (size_t)nxt.pn * tstep : cB;
        for (int t = 0; t < nt; t += 2) {
            const bool last = (t == nt - 2);
            const char* a1 = cA + (size_t)(t + 1) * kstep;
            const char* a2 = last ? nA : cA + (size_t)(t + 2) * kstep; const char* b2 = last ? nB : cB + (size_t)(t + 2) * kstep;
            const char* a3 = a2 + kstep; const char* b3 = b2 + kstep;
            if (last && has_next) S.a_ready(nxt);
            if constexpr (SP2) {
            PG8_LDB(B0, 0, 0); PG8_LDB(B1, 0, 1); PG8_SCHED; PG8_LDA(At, 0, 0); PG8_STAGE(PG8_SA(1, 1), a1 + hstep, voffA);
            PG8_WAIT_V(8); PG8_WAIT_L(0); PG8_BAR; PG8_MMA(0, 0, At, B0); PG8_MMA(0, 1, At, B1); PG8_BAR; PG8_SCHED;
            PG8_LDA(At, 0, 1); PG8_STAGE(PG8_SB(0, 0), b2, voffB); PG8_STAGE(PG8_SB(0, 1), b2 + hstep, voffB); PG8_STAGE(PG8_SA(0, 0), a2, voffA);
            PG8_WAIT_V(8); PG8_WAIT_L(0); PG8_BAR; PG8_MMA(1, 0, At, B0); PG8_MMA(1, 1, At, B1); PG8_BAR; PG8_SCHED;
            PG8_LDB(B0, 1, 0); PG8_LDB(B1, 1, 1); PG8_SCHED; PG8_LDA(At, 1, 0); PG8_STAGE(PG8_SA(0, 1), a2 + hstep, voffA);
            PG8_WAIT_V(8); PG8_WAIT_L(0); PG8_BAR; PG8_MMA(0, 0, At, B0); PG8_MMA(0, 1, At, B1); PG8_BAR; PG8_SCHED;
            PG8_LDA(At, 1, 1); PG8_STAGE(PG8_SB(1, 0), b3, voffB); PG8_STAGE(PG8_SB(1, 1), b3 + hstep, voffB); PG8_STAGE(PG8_SA(1, 0), a3, voffA);
            PG8_WAIT_V(8); PG8_WAIT_L(0); PG8_BAR; PG8_MMA(1, 0, At, B0); PG8_MMA(1, 1, At, B1); PG8_BAR; PG8_SCHED;
            } else {
            PG8_LDB(B0, 0, 0); PG8_SCHED; PG8_LDA(At, 0, 0); PG8_STAGE(PG8_SA(1, 1), a1 + hstep, voffA);
            PG8_WAIT_L(8); PG8_BAR; PG8_WAIT_L(0); PG8_MMA(0, 0, At, B0); PG8_BAR; PG8_SCHED;
            PG8_LDB(B1, 0, 1); PG8_STAGE(PG8_SB(0, 0), b2, voffB);
            PG8_BAR; PG8_WAIT_L(0); PG8_MMA(0, 1, At, B1); PG8_BAR;
            PG8_LDA(At, 0, 1); PG8_STAGE(PG8_SA(0, 0), a2, voffA);
            PG8_BAR; PG8_WAIT_L(0); PG8_MMA(1, 0, At, B0); PG8_BAR; PG8_SCHED;
            PG8_STAGE(PG8_SB(0, 1), b2 + hstep, voffB);
            PG8_WAIT_V(6); PG8_BAR; PG8_MMA(1, 1, At, B1); PG8_BAR;
            PG8_LDB(B0, 1, 0); PG8_SCHED; PG8_LDA(At, 1, 0); PG8_STAGE(PG8_SA(0, 1), a2 + hstep, voffA);
            PG8_WAIT_L(8); PG8_BAR; PG8_WAIT_L(0); PG8_MMA(0, 0, At, B0); PG8_BAR; PG8_SCHED;
            PG8_LDB(B1, 1, 1); PG8_STAGE(PG8_SB(1, 0), b3, voffB);
            PG8_BAR; PG8_WAIT_L(0); PG8_MMA(0, 1, At, B1); PG8_BAR;
            PG8_LDA(At, 1, 1); PG8_STAGE(PG8_SA(1, 0), a3, voffA);
            PG8_BAR; PG8_WAIT_L(0); PG8_MMA(1, 0, At, B0); PG8_BAR; PG8_SCHED;
            PG8_STAGE(PG8_SB(1, 1), b3 + hstep, voffB);
            PG8_WAIT_V(6); PG8_BAR; PG8_MMA(1, 1, At, B1); PG8_BAR;
            }
        }
        if constexpr (ALIGN_EPI) { if (wr == 0) PG8_BAR; }
        if constexpr (!Epi::AFTER_DRAIN) { E(acc, cur, wr, wc, fr, fq); S.done(cur); }
        if (!has_next) break;
#pragma unroll
        for (int a = 0; a < 2; ++a)
#pragma unroll
            for (int b = 0; b < 2; ++b)
#pragma unroll
                for (int m = 0; m < 4; ++m)
#pragma unroll
                    for (int n = 0; n < 2; ++n) acc[a][b][m][n] = (f32x4){0.f, 0.f, 0.f, 0.f};
        cur = nxt; cA = nA; cB = nB; ++ui;
        if constexpr (ALIGN_EPI) { if (wr == 1) PG8_BAR; }
    }
    PG8_WAIT_V(0);
    if constexpr (!ALIGN_EPI) { if (wr == 0) PG8_BAR; }
    PG8_BAR;
    if constexpr (Epi::AFTER_DRAIN) { E.fused(acc, cur, wr, wc, fr, fq, lds, wid, lane); S.done(cur); }
#undef PG8_SA
#undef PG8_SB
#undef PG8_STAGE
#undef PG8_LDA
#undef PG8_LDB
#undef PG8_MMA
#undef PG8_WAIT_V
#undef PG8_WAIT_L
#undef PG8_BAR
#undef PG8_SCHED
}
}

#define LAS __attribute__((address_space(3)))
typedef unsigned short bf16_t;
typedef float f32x4 __attribute__((ext_vector_type(4)));
typedef unsigned u32x4 __attribute__((ext_vector_type(4)));
typedef unsigned u32x2 __attribute__((ext_vector_type(2)));
typedef __bf16 bf16x2_t __attribute__((ext_vector_type(2)));
constexpr int NWAVES = 8, NTHR = 512;
constexpr int D = 1024, NB = 8, SEQ = 4096, LCTX = 256, TX = NB * SEQ, TC = NB * LCTX, TT = TX + TC, INW = 2304, NE = 16, FF = 2048;
constexpr int CAPX = 512, CAPC = 32, SLOTS = NB * CAPX + NB * CAPC;
constexpr float LOG2E = 1.4426950408889634f;
constexpr int LDS_BYTES = 155648;
enum { I_X = 0, I_C, I_CTX, I_CCTX, I_ADAW, I_ADAB, I_N1G, I_N2G, I_WIN, I_HCW, I_HCB, I_HW1, I_HB1, I_HW2, I_HB2, I_HW3, I_HFREQ, I_HSKIP, I_SINK, I_POOLW, I_POOLS, I_RPB, I_WOUT, I_ROUTER, I_WG, I_WU, I_WD, I_FNG, N_IN };
constexpr size_t MiB = 1u << 20;
constexpr size_t WS_CTL = 0;
constexpr size_t WS_MOD = 1 * MiB;
constexpr size_t WS_ROPE = 2 * MiB;
constexpr size_t WS_TW8 = 2 * MiB + 65536;
constexpr size_t WS_WIN_T = 3 * MiB;
constexpr size_t WS_WOUT_T = 13 * MiB;
constexpr size_t WS_HC = 17 * MiB;
constexpr size_t WS_HCC = 51 * MiB;
constexpr size_t WS_AFFT = 53 * MiB;
constexpr size_t WS_ROWMAP = 56 * MiB;
constexpr size_t WS_GATE = 57 * MiB;
constexpr size_t WS_INV = 58 * MiB;
constexpr size_t WS_CRES = 61 * MiB;
constexpr size_t WS_HX = 69 * MiB;
constexpr size_t WS_WGU_T = 137 * MiB;
constexpr size_t WS_WD_T = 393 * MiB;
constexpr size_t WS_R = 521 * MiB;
constexpr size_t WS_ACT = WS_R;
constexpr size_t WS_XG = WS_R + 272 * MiB;
constexpr size_t WS_PX = WS_R;
constexpr size_t WS_Y = WS_R + 153 * MiB;
constexpr size_t WS_UT = WS_XG;
constexpr size_t WS_HS = WS_R + 408 * MiB;
constexpr size_t WS_END = WS_HS + 64 * MiB;
static_assert(WS_END <= 1024 * MiB, "workspace map");

struct Args { const float* in[N_IN]; float* out; unsigned char* ws; };

__device__ __forceinline__ float bf2f(unsigned short v) { return __uint_as_float(((unsigned)v) << 16); }
__device__ __forceinline__ unsigned f2bf(float f) { unsigned u = __float_as_uint(f); return (u + 0x7fffu + ((u >> 16) & 1u)) >> 16; }
__device__ __forceinline__ unsigned pk2(float lo, float hi) { return f2bf(lo) | (f2bf(hi) << 16); }
__device__ __forceinline__ float bflo(unsigned w) { return __uint_as_float(w << 16); }
__device__ __forceinline__ float bfhi(unsigned w) { return __uint_as_float(w & 0xffff0000u); }
__device__ __forceinline__ float dot2bf(unsigned a, unsigned b, float acc) { return __builtin_amdgcn_fdot2_f32_bf16(__builtin_bit_cast(bf16x2_t, a), __builtin_bit_cast(bf16x2_t, b), acc, false); }
__device__ __forceinline__ float wave_sum(float v) {
#pragma unroll
    for (int o = 1; o < 64; o <<= 1) v += __shfl_xor(v, o);
    return v;
}
#define LDS_WAIT() asm volatile("s_waitcnt lgkmcnt(0)" ::: "memory")

__device__ __forceinline__ void tr_item(const float* W, int K, int N, bf16_t* WT, int Kt, int item, int mode, LAS float* scr, int lane) {
    const int nblk = N / 32, kb = item / nblk, nb = item % nblk, k0 = 64 * kb, n0 = 32 * nb;
#pragma unroll 8
    for (int i = 0; i < 32; ++i) { const int kk = 2 * i + (lane >> 5); scr[kk * 33 + (lane & 31)] = W[(size_t)(k0 + kk) * N + n0 + (lane & 31)]; }
    LDS_WAIT();
    const int c = lane & 7;
    const int drow0 = (mode == 0) ? n0 : ((n0 >> 7) * 256 + (n0 & 127) + (mode == 2 ? 128 : 0));
#pragma unroll
    for (int j = 0; j < 4; ++j) { const int n = (lane >> 3) + 8 * j; const LAS float* s = scr + (8 * c) * 33 + n;
        u32x4 o; o.x = pk2(s[0 * 33], s[1 * 33]); o.y = pk2(s[2 * 33], s[3 * 33]); o.z = pk2(s[4 * 33], s[5 * 33]); o.w = pk2(s[6 * 33], s[7 * 33]);
        *(u32x4*)(WT + (size_t)(drow0 + n) * Kt + k0 + 8 * c) = o; }
    LDS_WAIT();
}

__device__ __forceinline__ void filter_pos(const Args& a, int l, int L, int p, float* HCdst, int lane) {
    const float* w1 = a.in[I_HW1] + l * 33 * 64; const float* b1 = a.in[I_HB1] + l * 64; const float* w2 = a.in[I_HW2] + l * 64 * 64; const float* b2 = a.in[I_HB2] + l * 64;
    const float* w3 = a.in[I_HW3] + l * 64 * 1024; const float* fr = a.in[I_HFREQ] + l * 64;
    const float tn = (float)p / (float)(L - 1);
    float fv = 0.f;
    if (lane == 0) fv = tn;
    else if (lane <= 32) { const int bi = (lane - 1) & 15; const float band = 1e-4f + (float)bi * ((15.0f - 1e-4f) / 15.0f);
        const float ang = ((float)(6.283185307179586 / (double)L) * (float)p) * band; fv = (lane <= 16) ? cosf(ang) : -sinf(ang); }
    float a1 = b1[lane];
    for (int i = 0; i < 33; ++i) a1 += __shfl(fv, i) * w1[i * 64 + lane];
    const float frq = fr[lane];
    const float h1 = sinf(frq * a1);
    float a2 = b2[lane];
    for (int i = 0; i < 64; ++i) a2 += __shfl(h1, i) * w2[i * 64 + lane];
    const float h2 = sinf(frq * a2);
    float o[16];
#pragma unroll
    for (int q = 0; q < 16; ++q) o[q] = 0.f;
    for (int i = 0; i < 64; ++i) { const float hv = __shfl(h2, i);
#pragma unroll
        for (int q = 0; q < 16; ++q) o[q] += hv * w3[i * 1024 + q * 64 + lane]; }
    const float dmin = 3.0701134573253945f, dmax = 15.350567286626972f;
#pragma unroll
    for (int ord = 0; ord < 2; ++ord)
#pragma unroll
        for (int cs = 0; cs < 4; ++cs) { const int c = cs * 64 + lane; const float delta = dmin + (float)c * ((dmax - dmin) / 255.0f); const float win = expf(-tn * delta);
            const float vf = o[ord * 8 + cs] * win, vb = o[ord * 8 + 4 + cs] * win;
            float* base = HCdst + (size_t)ord * (2 * L - 1) * 256;
            if (p == 0) base[(size_t)(L - 1) * 256 + c] = vf + vb;
            else { base[(size_t)(L - 1 + p) * 256 + c] = vf; base[(size_t)(L - 1 - p) * 256 + c] = vb; } }
}

__device__ __forceinline__ void phase_prologue(const Args& a, unsigned char* ldsg, int vcu, int G) {
    LAS unsigned char* lds = (LAS unsigned char*)ldsg;
    int tid_ = threadIdx.x; asm volatile("" : "+v"(tid_));
    const int tid = tid_, lane = tid & 63, wave = __builtin_amdgcn_readfirstlane(tid >> 6);
    unsigned char* ws = a.ws;
    LAS float* sc = (LAS float*)lds; LAS float* red = (LAS float*)(lds + 36864);
    for (int i = tid; i < 9 * 1024; i += NTHR) { const float v = (i < 8192) ? a.in[I_C][i] : a.in[I_CCTX][i - 8192]; sc[i] = v / (1.0f + expf(-v)); }
    __syncthreads();
    float* MOD = (float*)(ws + WS_MOD);
    for (int item = vcu; item < 2 * 96; item += G) {
        const int l = item / 96, n0 = (item % 96) * 64, col = tid & 63, kg = tid >> 6;
        float acc[9];
#pragma unroll
        for (int r = 0; r < 9; ++r) acc[r] = 0.f;
        const float* w = a.in[I_ADAW] + (size_t)l * 1024 * 6144 + n0 + col;
#pragma unroll 4
        for (int k = kg * 128; k < kg * 128 + 128; ++k) { const float wv = w[(size_t)k * 6144];
#pragma unroll
            for (int r = 0; r < 9; ++r) acc[r] += sc[r * 1024 + k] * wv; }
#pragma unroll
        for (int r = 0; r < 9; ++r) red[(kg * 9 + r) * 64 + col] = acc[r];
        __syncthreads();
        for (int o = tid; o < 9 * 64; o += NTHR) { const int r = o >> 6, cc = o & 63; float s = 0.f;
#pragma unroll
            for (int g2 = 0; g2 < 8; ++g2) s += red[(g2 * 9 + r) * 64 + cc];
            MOD[(size_t)(l * 9 + r) * 6144 + n0 + cc] = s + a.in[I_ADAB][l * 6144 + n0 + cc]; }
        __syncthreads();
    }
    if (vcu == 0) { float* ROPE = (float*)(ws + WS_ROPE);
        for (int i = tid; i < 1024; i += NTHR) { const int pos = i >> 4, fi = i & 15; const float inv = powf(10000.0f, -(float)fi / 16.0f); const float ang = (float)pos * inv;
            ROPE[2 * i] = cosf(ang); ROPE[2 * i + 1] = sinf(ang); } }
    if (vcu == 1 % G) { float* TW8 = (float*)(ws + WS_TW8);
        for (int i = tid; i < 8192; i += NTHR) { float sn, cs; sincospif(-(float)i * (1.0f / 4096.0f), &sn, &cs); TW8[2 * i] = cs; TW8[2 * i + 1] = sn; } }
    const int gw = vcu * NWAVES + wave, NGW = G * NWAVES;
    for (int it = gw; it < 8448; it += NGW) {
        if (it < 4096) filter_pos(a, 0, 4096, it, (float*)(ws + WS_HC), lane);
        else if (it < 8192) filter_pos(a, 1, 4096, it - 4096, (float*)(ws + WS_HC) + (size_t)2 * 8191 * 256, lane);
        else filter_pos(a, 0, 256, it - 8192, (float*)(ws + WS_HCC) + 256, lane);
    }
    LAS float* scr = (LAS float*)(lds + 65536 + wave * 8448);
    constexpr int IT_IN = 16 * 72, IT_OUT = 16 * 32, IT_E = 1024, IT_LAYER = IT_IN + IT_OUT + 3 * 16 * IT_E;
    for (int it = gw; it < 2 * IT_LAYER; it += NGW) {
        const int l = it / IT_LAYER; int r = it % IT_LAYER;
        if (r < IT_IN) { tr_item(a.in[I_WIN] + (size_t)l * 1024 * 2304, 1024, 2304, (bf16_t*)(ws + WS_WIN_T) + (size_t)l * 2304 * 1024, 1024, r, 0, scr, lane); continue; } r -= IT_IN;
        if (r < IT_OUT) { tr_item(a.in[I_WOUT] + (size_t)l * 1024 * 1024, 1024, 1024, (bf16_t*)(ws + WS_WOUT_T) + (size_t)l * 1024 * 1024, 1024, r, 0, scr, lane); continue; } r -= IT_OUT;
        const int which = r / (16 * IT_E), e = (r / IT_E) & 15, ri = r % IT_E; const size_t le = (size_t)l * 16 + e;
        if (which == 0) tr_item(a.in[I_WG] + le * 1024 * 2048, 1024, 2048, (bf16_t*)(ws + WS_WGU_T) + le * 4096 * 1024, 1024, ri, 1, scr, lane);
        else if (which == 1) tr_item(a.in[I_WU] + le * 1024 * 2048, 1024, 2048, (bf16_t*)(ws + WS_WGU_T) + le * 4096 * 1024, 1024, ri, 2, scr, lane);
        else tr_item(a.in[I_WD] + le * 2048 * 1024, 2048, 1024, (bf16_t*)(ws + WS_WD_T) + le * 1024 * 2048, 2048, ri, 0, scr, lane);
    }
}

__device__ __forceinline__ void phase_norm(const Args& a, unsigned char* ldsg, int vcu, int G, int l, const float* srcx, const float* srcc, const float* gain, int shift_idx, int nrows, bool router) {
    int tid_ = threadIdx.x; asm volatile("" : "+v"(tid_));
    const int tid = tid_, lane = tid & 63, wave = __builtin_amdgcn_readfirstlane(tid >> 6);
    unsigned char* ws = a.ws; const float* MOD = (const float*)(ws + WS_MOD) + (size_t)l * 9 * 6144; bf16_t* HX = (bf16_t*)(ws + WS_HX);
    LAS float* rw = (LAS float*)(LAS unsigned char*)ldsg;
    if (router) { const float* rsrc = a.in[I_ROUTER] + (size_t)l * 1024 * 16; for (int i = tid; i < 1024 * 16; i += NTHR) rw[(i & 15) * 1024 + (i >> 4)] = rsrc[i]; __syncthreads(); }
    const int gw = vcu * NWAVES + wave, NGW = G * NWAVES;
    for (int row = gw; row < nrows; row += NGW) {
        const bool lat = row < TX; const float* xr = lat ? srcx + (size_t)row * D : srcc + (size_t)(row - TX) * D; const int mrow = lat ? (row >> 12) : 8;
        const float* shp = MOD + mrow * 6144 + shift_idx * 1024; const float* scp = shp + 1024;
        f32x4 v[4]; float ss = 0.f;
#pragma unroll
        for (int j = 0; j < 4; ++j) { v[j] = *(const f32x4*)(xr + 256 * j + 4 * lane); ss += (v[j][0] * v[j][0] + v[j][1] * v[j][1]) + (v[j][2] * v[j][2] + v[j][3] * v[j][3]); }
        const float rstd = 1.0f / sqrtf(wave_sum(ss) * (1.0f / D) + 1e-6f);
#pragma unroll
        for (int j = 0; j < 4; ++j) { const f32x4 gg = *(const f32x4*)(gain + 256 * j + 4 * lane), sh = *(const f32x4*)(shp + 256 * j + 4 * lane), sc = *(const f32x4*)(scp + 256 * j + 4 * lane);
            v[j] = (v[j] * rstd * gg) * (1.0f + sc) + sh;
            u32x2 o; o.x = pk2(v[j][0], v[j][1]); o.y = pk2(v[j][2], v[j][3]); *(u32x2*)(HX + (size_t)row * D + 256 * j + 4 * lane) = o; }
        if (router) {
            float mylog = -1e30f;
#pragma unroll 1
            for (int e = 0; e < 16; ++e) { float p = 0.f;
#pragma unroll
                for (int j = 0; j < 4; ++j) { const f32x4 wv = *(const LAS f32x4*)(rw + e * 1024 + 256 * j + 4 * lane);
                    p += (v[j][0] * wv[0] + v[j][1] * wv[1]) + (v[j][2] * wv[2] + v[j][3] * wv[3]); }
                p = wave_sum(p); mylog = (lane == e) ? p : mylog; }
            float mx = mylog;
#pragma unroll
            for (int o = 1; o < 16; o <<= 1) mx = fmaxf(mx, __shfl_xor(mx, o));
            const float mine = (lane < 16) ? expf(mylog - mx) : 0.f; float den = mine;
#pragma unroll
            for (int o = 1; o < 16; o <<= 1) den += __shfl_xor(den, o);
            if (lane < 16) { ((float*)(ws + WS_AFFT))[(size_t)lane * TT + row] = mine / den; ((int*)(ws + WS_INV))[(size_t)row * 16 + lane] = -1; }
        }
    }
}

#define XB_TMO      128
#define XB_XCNT(j)  (256  + 64 * (j))
#define XB_XSUB(j)  (1280 + 64 * (j))
#define XB_XGEN(j)  (2304 + 64 * (j))
#define XB_TOP      3328
#define XB_TOPGEN   3392
#define XCD_BAR_WORDS 3456
#define XB_SPIN_CAP (1u << 18)

__device__ __forceinline__ unsigned xb_ld(unsigned* p)              { return __hip_atomic_load(p, __ATOMIC_RELAXED, __HIP_MEMORY_SCOPE_AGENT); }
__device__ __forceinline__ unsigned xb_add(unsigned* p, unsigned v) { return __hip_atomic_fetch_add(p, v, __ATOMIC_RELAXED, __HIP_MEMORY_SCOPE_AGENT); }
__device__ __forceinline__ unsigned xb_xcc_id() { return (unsigned)__builtin_amdgcn_s_getreg((3 << 11) | 20) & 0xFu; }
#define XB_SPIN(cond, bar) do { unsigned _sp = 0; while (cond) { __builtin_amdgcn_s_sleep(1); \
    if ((++_sp & 255u) == 0u) { if (xb_ld(&(bar)[XB_TMO])) break; if (_sp > XB_SPIN_CAP) { atomicAdd(&(bar)[XB_TMO], 1u); break; } } } } while (0)

struct XcdBarrier {
    unsigned* bar; unsigned x;
    volatile LAS unsigned* st;
};

__device__ __forceinline__ XcdBarrier xcd_barrier_post(unsigned* bar, volatile LAS unsigned* st) {
    XcdBarrier b; b.bar = bar; b.x = xb_xcc_id(); b.st = st;
    if (threadIdx.x == 0) (void)xb_add(&bar[XB_XCNT(b.x)], 1u);
    return b;
}
__device__ __forceinline__ void xcd_barrier_complete(unsigned* bar, unsigned x, unsigned& nloc, unsigned& nx) {
    const unsigned G = gridDim.x * gridDim.y * gridDim.z;
    unsigned sum, cnt, mine, sp = 0u;
    for (;;) {
        sum = 0u; cnt = 0u; mine = 0u;
#pragma unroll
        for (unsigned j = 0; j < 16; ++j) { const unsigned c = xb_ld(&bar[XB_XCNT(j)]); sum += c; cnt += (c > 0u) ? 1u : 0u; mine = (j == x) ? c : mine; }
        if (sum == G) break;
        __builtin_amdgcn_s_sleep(1);
        if ((++sp & 255u) == 0u) { if (xb_ld(&bar[XB_TMO])) break; if (sp > XB_SPIN_CAP) { atomicAdd(&bar[XB_TMO], 1u); break; } }
    }
    nloc = mine > 0u ? mine : 1u; nx = cnt > 0u ? cnt : 1u;
}

__device__ __forceinline__ void xcd_barrier(const XcdBarrier& b) {
    asm volatile("s_waitcnt vmcnt(0)" ::: "memory");
    __syncthreads();
    if (threadIdx.x == 0) {
        unsigned* bar = b.bar;
        __builtin_amdgcn_s_waitcnt(0);
        unsigned nloc = b.st[0], nx = b.st[1];
        if (nloc == 0u) { xcd_barrier_complete(bar, b.x, nloc, nx); b.st[0] = nloc; b.st[1] = nx; }
        const unsigned old = xb_add(&bar[XB_XSUB(b.x)], 1u);
        const unsigned gen = old / nloc;
        if (old + 1u == (gen + 1u) * nloc) {
            __builtin_amdgcn_fence(__ATOMIC_RELEASE, "agent");
            asm volatile("s_waitcnt vmcnt(0)" ::: "memory");
            const unsigned og = xb_add(&bar[XB_TOP], 1u);
            const unsigned tg = og / nx;
            if (og + 1u == (tg + 1u) * nx) xb_add(&bar[XB_TOPGEN], 1u);
            else XB_SPIN(xb_ld(&bar[XB_TOPGEN]) == tg, bar);
            __builtin_amdgcn_fence(__ATOMIC_ACQUIRE, "agent");
            xb_add(&bar[XB_XGEN(b.x)], 1u);
            asm volatile("s_waitcnt vmcnt(0)" ::: "memory");
        } else {
            XB_SPIN(xb_ld(&bar[XB_XGEN(b.x)]) == gen, bar);
            __builtin_amdgcn_fence(__ATOMIC_ACQUIRE, "agent");
            asm volatile("s_waitcnt vmcnt(0)" ::: "memory");
        }
    }
    __syncthreads();
}


typedef float f32x2 __attribute__((ext_vector_type(2)));
__device__ __forceinline__ f32x2 cmul(f32x2 a, f32x2 b) { return (f32x2){a.x * b.x - a.y * b.y, a.x * b.y + a.y * b.x}; }
__device__ __forceinline__ void dft16(f32x2 (&v)[16]) {
    constexpr float WC[8] = {1.0f, 0.92387953251128674f, 0.70710678118654752f, 0.38268343236508977f, 0.0f, -0.38268343236508977f, -0.70710678118654752f, -0.92387953251128674f};
    constexpr float WS[8] = {0.0f, -0.38268343236508977f, -0.70710678118654752f, -0.92387953251128674f, -1.0f, -0.92387953251128674f, -0.70710678118654752f, -0.38268343236508977f};
#pragma unroll
    for (int s = 8; s >= 1; s >>= 1)
#pragma unroll
        for (int i = 0; i < 16; ++i) if ((i & s) == 0) { const int k = (i & (s - 1)) * (8 / s); const f32x2 u = v[i], t = v[i + s]; v[i] = u + t; const f32x2 d = u - t;
            v[i + s] = (k == 0) ? d : ((k == 4) ? (f32x2){d.y, -d.x} : (f32x2){d.x * WC[k] - d.y * WS[k], d.x * WS[k] + d.y * WC[k]}); }
}
__device__ __forceinline__ constexpr int bitrev4(int i) { return ((i & 1) << 3) | ((i & 2) << 1) | ((i & 4) >> 1) | ((i & 8) >> 3); }
template <int NS, int MODE>
__device__ __forceinline__ void fft_pass(LAS f32x2* Z, const LAS f32x2* TW, int tid, const f32x2* H) {
    const int f = tid >> 8, j = tid & 255, base = f * 4096, k = j & (NS - 1);
    f32x2 v[16];
#pragma unroll
    for (int r = 0; r < 16; ++r) { const int idx = base + j + 256 * r; v[r] = Z[idx + (idx >> 4)]; }
    if (MODE == 1) {
#pragma unroll
        for (int r = 0; r < 16; ++r) { const f32x2 p = cmul(v[r], H[base + j + 256 * r]); v[r] = (f32x2){p.y, p.x}; } }
    if (NS > 1) { constexpr int step = 8192 / (NS * 16);
#pragma unroll
        for (int r = 1; r < 16; ++r) v[r] = cmul(v[r], TW[r * k * step]); }
    dft16(v);
    __syncthreads();
    const int j0 = base + (j / NS) * NS * 16 + k;
#pragma unroll
    for (int rr = 0; rr < 16; ++rr) { const int idx = j0 + rr * NS; Z[idx + (idx >> 4)] = v[bitrev4(rr)]; }
    __syncthreads();
}
__device__ __forceinline__ void load_uc(const bf16_t* UT, const float* cw, const float* cb, int ch, int b, int tid, float (&out)[8]) {
    const bf16_t* p = UT + ((size_t)(b * 768 + ch)) * 4096 + 8 * tid;
    const u32x4 w = *(const u32x4*)p; float u[10];
    u[1] = bflo(w.x); u[2] = bfhi(w.x); u[3] = bflo(w.y); u[4] = bfhi(w.y); u[5] = bflo(w.z); u[6] = bfhi(w.z); u[7] = bflo(w.w); u[8] = bfhi(w.w);
    u[0] = (tid > 0) ? bf2f(p[-1]) : 0.f; u[9] = (tid < 511) ? bf2f(p[8]) : 0.f;
    const float w0 = cw[ch], w1 = cw[768 + ch], w2 = cw[1536 + ch], bb = cb[ch];
#pragma unroll
    for (int i = 0; i < 8; ++i) out[i] = u[i] * w0 + u[i + 1] * w1 + u[i + 2] * w2 + bb;
}
__device__ __forceinline__ void hy_fill(LAS f32x2* Z, const LAS f32x2* TW, int tid, const float (&va)[8], const float (&vb)[8]) {
#pragma unroll
    for (int i = 0; i < 8; ++i) { const int t = 8 * tid + i; const f32x2 z = {va[i], vb[i]}; Z[t + (t >> 4)] = z; const int t2 = 4096 + t; Z[t2 + (t2 >> 4)] = cmul(z, TW[t]); }
    __syncthreads();
}
__device__ __forceinline__ void hy_conv(LAS f32x2* Z, const LAS f32x2* TW, int tid, const f32x2* H) {
    fft_pass<1, 0>(Z, TW, tid, nullptr); fft_pass<16, 0>(Z, TW, tid, nullptr); fft_pass<256, 0>(Z, TW, tid, nullptr);
    fft_pass<1, 1>(Z, TW, tid, H); fft_pass<16, 0>(Z, TW, tid, nullptr); fft_pass<256, 0>(Z, TW, tid, nullptr);
}
__device__ __forceinline__ f32x2 hy_out(const LAS f32x2* Z, const LAS f32x2* TW, int t) {
    const f32x2 se = Z[t + (t >> 4)]; const int t2 = 4096 + t; const f32x2 so = Z[t2 + (t2 >> 4)]; const f32x2 tw = TW[t];
    const f32x2 So = {so.y, so.x};
    return (f32x2){se.y + (So.x * tw.x + So.y * tw.y), se.x + (So.y * tw.x - So.x * tw.y)};
}
__device__ __forceinline__ void hyena_item(const Args& a, LAS unsigned char* lds, int l, int c, int bp, int tid) {
    asm volatile("" : "+v"(tid));
    LAS f32x2* Z = (LAS f32x2*)lds; const LAS f32x2* TW = (const LAS f32x2*)(lds + 69632);
    const bf16_t* UT = (const bf16_t*)(a.ws + WS_UT); bf16_t* Y = (bf16_t*)(a.ws + WS_Y);
    const float* cw = a.in[I_HCW] + (size_t)l * 3 * 768; const float* cb = a.in[I_HCB] + (size_t)l * 768; const float* skip = a.in[I_HSKIP] + (size_t)l * 2 * 256;
    const f32x2* HS = (const f32x2*)(a.ws + WS_HS) + ((size_t)(l * 2) * 256 + c) * 8192;
    const int b0 = 2 * bp, b1 = 2 * bp + 1;
    float va[8], vb[8], xa[8], xb[8];
    load_uc(UT, cw, cb, c, b0, tid, va); load_uc(UT, cw, cb, c, b1, tid, vb);
    hy_fill(Z, TW, tid, va, vb);
    hy_conv(Z, TW, tid, HS);
    load_uc(UT, cw, cb, 256 + c, b0, tid, xa); load_uc(UT, cw, cb, 256 + c, b1, tid, xb);
    { const float sk = skip[c];
#pragma unroll
      for (int i = 0; i < 8; ++i) { const f32x2 y = hy_out(Z, TW, 8 * tid + i); va[i] = xa[i] * (y.x + va[i] * sk); vb[i] = xb[i] * (y.y + vb[i] * sk); } }
    __syncthreads();
    hy_fill(Z, TW, tid, va, vb);
    hy_conv(Z, TW, tid, HS + (size_t)256 * 8192);
    load_uc(UT, cw, cb, 512 + c, b0, tid, xa); load_uc(UT, cw, cb, 512 + c, b1, tid, xb);
    { const float sk = skip[256 + c];
#pragma unroll
      for (int i = 0; i < 8; ++i) { const int t = 8 * tid + i; const f32x2 y = hy_out(Z, TW, t);
          Y[((size_t)b0 * 4096 + t) * D + c] = (bf16_t)f2bf(xa[i] * (y.x + va[i] * sk)); Y[((size_t)b1 * 4096 + t) * D + c] = (bf16_t)f2bf(xb[i] * (y.y + vb[i] * sk)); } }
    __syncthreads();
}
__device__ __forceinline__ void spectrum_item(const Args& a, LAS unsigned char* lds, int item, int tid) {
    asm volatile("" : "+v"(tid));
    LAS f32x2* Z = (LAS f32x2*)lds; const LAS f32x2* TW = (const LAS f32x2*)(lds + 69632);
    const int c = item & 255, lo = item >> 8;
    const float* HC = (const float*)(a.ws + WS_HC) + (size_t)lo * 8191 * 256 + c;
#pragma unroll
    for (int i = 0; i < 8; ++i) { const int t = 8 * tid + i; const float hl = HC[(size_t)(4095 + t) * 256], hh = (t == 0) ? 0.f : HC[(size_t)(t - 1) * 256];
        Z[t + (t >> 4)] = (f32x2){hl + hh, 0.f}; const int t2 = 4096 + t; const f32x2 tw = TW[t]; const float dd = hl - hh; Z[t2 + (t2 >> 4)] = (f32x2){dd * tw.x, dd * tw.y}; }
    __syncthreads();
    fft_pass<1, 0>(Z, TW, tid, nullptr); fft_pass<16, 0>(Z, TW, tid, nullptr); fft_pass<256, 0>(Z, TW, tid, nullptr);
    f32x2* HS = (f32x2*)(a.ws + WS_HS) + (size_t)item * 8192;
#pragma unroll
    for (int i = 0; i < 16; ++i) { const int idx = tid + 512 * i; HS[idx] = Z[idx + (idx >> 4)] * (1.0f / 8192.0f); }
    __syncthreads();
}
__device__ __forceinline__ void load_tw(const Args& a, LAS unsigned char* lds, int tid) {
    LAS f32x2* TW = (LAS f32x2*)(lds + 69632); const f32x2* src = (const f32x2*)(a.ws + WS_TW8);
    for (int i = tid; i < 8192; i += NTHR) TW[i] = src[i];
    __syncthreads();
}
__device__ __forceinline__ float ctx_uc(const bf16_t* PXc, const float* cw, const float* cb, int ch, int t) {
    const float u1 = bf2f(PXc[(size_t)t * INW + ch]); const float u0 = (t > 0) ? bf2f(PXc[(size_t)(t - 1) * INW + ch]) : 0.f; const float u2 = (t < 255) ? bf2f(PXc[(size_t)(t + 1) * INW + ch]) : 0.f;
    return u0 * cw[ch] + u1 * cw[768 + ch] + u2 * cw[1536 + ch] + cb[ch];
}
__device__ __forceinline__ void ctx_conv16(const LAS float* IN, const float* H, int c, int lane, int t0, float (&acc)[16]) {
    float w[16];
    const float* hp = H + (size_t)(t0 + 255) * 256 + c;
#pragma unroll
    for (int i = 0; i < 16; ++i) { acc[i] = 0.f; w[i] = hp[i * 256]; }
    const LAS float* ip = IN + lane;
#pragma unroll 1
    for (int s0 = 0; s0 < 256; s0 += 16) {
#pragma unroll
        for (int u = 0; u < 16; ++u) { const float v = ip[u * 64];
#pragma unroll
            for (int i = 0; i < 16; ++i) acc[i] += v * w[(i - u + 16) & 15];
            w[(15 - u) & 15] = hp[-(u + 1) * 256]; }
        hp -= 16 * 256; ip += 16 * 64; }
}
__device__ __forceinline__ void ctx_hyena_item(const Args& a, LAS unsigned char* lds, int l, int item, int tid) {
    asm volatile("" : "+v"(tid));
    const int lane = tid & 63, wave = tid >> 6, b = item >> 2, c = (item & 3) * 64 + lane;
    LAS float* V = (LAS float*)lds; LAS float* Z1 = (LAS float*)(lds + 65536);
    const bf16_t* PXc = (const bf16_t*)(a.ws + WS_PX) + (size_t)(TX + b * 256) * INW; bf16_t* Y = (bf16_t*)(a.ws + WS_Y) + (size_t)(TX + b * 256) * D;
    const float* cw = a.in[I_HCW] + (size_t)l * 3 * 768; const float* cb = a.in[I_HCB] + (size_t)l * 768; const float* skip = a.in[I_HSKIP] + (size_t)l * 2 * 256;
    const float* H0 = (const float*)(a.ws + WS_HCC) + 256, *H1 = H0 + (size_t)511 * 256;
#pragma unroll 2
    for (int i = 0; i < 32; ++i) { const int t = wave * 32 + i; V[t * 64 + lane] = ctx_uc(PXc, cw, cb, c, t); }
    __syncthreads();
    float acc[16];
#pragma unroll 1
    for (int g = 0; g < 2; ++g) { const int t0 = wave * 32 + g * 16; ctx_conv16(V, H0, c, lane, t0, acc); const float sk = skip[c];
#pragma unroll
        for (int i = 0; i < 16; ++i) { const int t = t0 + i; Z1[t * 64 + lane] = ctx_uc(PXc, cw, cb, 256 + c, t) * (acc[i] + V[t * 64 + lane] * sk); } }
    __syncthreads();
#pragma unroll 1
    for (int g = 0; g < 2; ++g) { const int t0 = wave * 32 + g * 16; ctx_conv16(Z1, H1, c, lane, t0, acc); const float sk = skip[256 + c];
#pragma unroll
        for (int i = 0; i < 16; ++i) { const int t = t0 + i; Y[(size_t)t * D + c] = (bf16_t)f2bf(ctx_uc(PXc, cw, cb, 512 + c, t) * (acc[i] + Z1[t * 64 + lane] * sk)); } }
    __syncthreads();
}

typedef short bf16x8_t __attribute__((ext_vector_type(8)));
typedef short s16x4_t __attribute__((ext_vector_type(4)));
typedef float f32x16 __attribute__((ext_vector_type(16)));
__device__ __forceinline__ int crow(int r, int hi) { return (r & 3) + 8 * (r >> 2) + 4 * hi; }
__device__ __forceinline__ unsigned cvtpk(float lo, float hi) { f32x2 v = {lo, hi}; bf16x2_t b = __builtin_convertvector(v, bf16x2_t); return __builtin_bit_cast(unsigned, b); }
__device__ __forceinline__ s16x4_t vtr(const LAS unsigned char* p) { return __builtin_bit_cast(s16x4_t, __builtin_amdgcn_ds_read_tr16_b64_v4i16((LAS s16x4_t*)p)); }
constexpr int AT_K = 0, AT_V = 16384, AT_WSF = 32768, AT_OST = 34816, AT_RPB = 67584, AT_END = 69632;
template <int KIND>
__device__ __forceinline__ void attn_unit(const Args& a, LAS unsigned char* lds, int l, int u, int tid) {
    asm volatile("" : "+v"(tid));
    const int lane = tid & 63, wid = __builtin_amdgcn_readfirstlane(tid >> 6), r32 = lane & 31, hi = lane >> 5;
    const bf16_t* PX = (const bf16_t*)(a.ws + WS_PX); bf16_t* Y = (bf16_t*)(a.ws + WS_Y);
    int b, qcol, kcol, vcol, ycol, qrow0, nloc = 0, lo = 0; bool sink = false; int hsink = 0;
    int qpos0 = 0, blk = 0, rq = 0, cbase = 0, rq4 = 0;
    if (KIND == 0) { b = u >> 6; const int kvh = (u >> 5) & 1; blk = u & 31; const int h = 2 * kvh + (wid >> 2); qpos0 = blk * 128 + 32 * (wid & 3); qrow0 = b * 4096 + qpos0;
        qcol = 1024 + h * 64; kcol = 1536 + kvh * 64; vcol = 1664 + kvh * 64; ycol = 256 + h * 64; lo = (blk == 0) ? 2 : 0; nloc = ((blk == 31) ? 3 : 5) - lo + 1; sink = true; hsink = h; }
    else if (KIND == 1) { b = u >> 6; const int h = (u >> 4) & 3; rq4 = u & 15; rq = 4 * rq4 + (wid >> 1); cbase = 32 * (wid & 1); qrow0 = b * 4096 + rq * 64 + cbase;
        qcol = 1280 + h * 64; kcol = 1792 + h * 64; vcol = 2048 + h * 64; ycol = 768 + h * 64;
        const int ra = 4 * rq4 - 4, rb = 4 * rq4 + 3 - 4; lo = ra < 0 ? 0 : (ra > 56 ? 56 : ra); const int hi_r = (rb < 0 ? 0 : (rb > 56 ? 56 : rb)) + 7; nloc = hi_r - lo + 1;
        LAS float* rpbL = (LAS float*)(lds + AT_RPB); const float* src = a.in[I_RPB] + (size_t)(l * 4 + h) * 465;
        for (int i = tid; i < 465; i += NTHR) rpbL[i] = src[i] * LOG2E; }
    else { b = u >> 3; const int h = (u >> 1) & 3; qrow0 = TX + b * 256 + 32 * wid;
        if ((u & 1) == 0) { qcol = 1024 + h * 64; kcol = 1536 + (h >> 1) * 64; vcol = 1664 + (h >> 1) * 64; ycol = 256 + h * 64; sink = true; hsink = h; }
        else { qcol = 1280 + h * 64; kcol = 1792 + h * 64; vcol = 2048 + h * 64; ycol = 768 + h * 64; } }
    const int NT = nloc + 4;
    bf16x8_t qr[4];
    { const bf16_t* qp = PX + (size_t)(qrow0 + r32) * INW + qcol + hi * 8;
#pragma unroll
      for (int d0 = 0; d0 < 4; ++d0) qr[d0] = *(const bf16x8_t*)(qp + d0 * 16); }
    const int krow = 8 * wid + (lane & 7), kchunk = lane >> 3; const int vrow = 16 * (wid & 3) + (lane >> 2), vcoff = (wid >> 2) * 32 + (lane & 3) * 8;
    const int kdst = AT_K + kchunk * 1024 + krow * 16, vdst = AT_V + wid * 1024 + lane * 16;
    auto tile_row0 = [&](int t) -> int { if (t < nloc) { if (KIND == 0) return b * 4096 + blk * 128 - 128 + 64 * (lo + t); else return b * 4096 + (lo + t) * 64; } return TX + b * 256 + 64 * (t - nloc); };
    u32x4 gk, gv;
    { const int R0 = tile_row0(0); gk = *(const u32x4*)(PX + (size_t)(R0 + krow) * INW + kcol + kchunk * 8); gv = *(const u32x4*)(PX + (size_t)(R0 + vrow) * INW + vcol + vcoff); }
    *(LAS u32x4*)(lds + kdst) = gk; *(LAS u32x4*)(lds + vdst) = gv;
    float mhat = -1e30f, l_reg = 0.f; f32x16 o[2];
#pragma unroll
    for (int r = 0; r < 16; ++r) { o[0][r] = 0.f; o[1][r] = 0.f; }
    LAS float* wsf = (LAS float*)(lds + AT_WSF) + wid * 64;
    const LAS unsigned char* vb0 = lds + AT_V + ((lane >> 4) & 1) * 32 + (lane & 3) * 8 + (4 * hi + ((lane & 15) >> 2)) * 64;
    const LAS unsigned char* kb0 = lds + AT_K + hi * 1024 + r32 * 16;
    __syncthreads();
    for (int t = 0; t < NT; ++t) {
        const int bufo = (t & 1) * 8192;
        if (t + 1 < NT) { const int R0 = tile_row0(t + 1); gk = *(const u32x4*)(PX + (size_t)(R0 + krow) * INW + kcol + kchunk * 8); gv = *(const u32x4*)(PX + (size_t)(R0 + vrow) * INW + vcol + vcoff); }
        bool need = true; bool full = true; int ts = 0, rk = 0;
        if (t < nloc) {
            if (KIND == 0) { ts = blk * 128 - 128 + 64 * (lo + t); need = (ts + 63 >= qpos0 - 128) && (ts <= qpos0 + 31 + 128); full = (qpos0 + 31 - ts <= 128) && (ts + 63 - qpos0 <= 128); }
            if (KIND == 1) { rk = lo + t; const int r0 = (rq - 4) < 0 ? 0 : ((rq - 4) > 56 ? 56 : (rq - 4)); need = (rk >= r0) && (rk <= r0 + 7); full = false; }
        }
        if (need) {
            f32x16 p0, p1;
#pragma unroll
            for (int r = 0; r < 16; ++r) { p0[r] = 0.f; p1[r] = 0.f; }
            const LAS unsigned char* kb = kb0 + bufo;
#pragma unroll
            for (int d0 = 0; d0 < 4; ++d0) { const bf16x8_t k0 = *(const LAS bf16x8_t*)(kb + d0 * 2048), k1 = *(const LAS bf16x8_t*)(kb + d0 * 2048 + 512);
                p0 = __builtin_amdgcn_mfma_f32_32x32x16_bf16(k0, qr[d0], p0, 0, 0, 0); p1 = __builtin_amdgcn_mfma_f32_32x32x16_bf16(k1, qr[d0], p1, 0, 0, 0); }
            constexpr float C2 = 0.125f * LOG2E;
#pragma unroll
            for (int r = 0; r < 16; ++r) { p0[r] *= C2; p1[r] *= C2; }
            if (!full) {
                if (KIND == 0) { const int tq = qpos0 + r32;
#pragma unroll
                    for (int r = 0; r < 16; ++r) { const int k0 = ts + crow(r, hi), d0 = tq - k0, d1 = d0 - 32; if (d0 > 128 || d0 < -128) p0[r] = -1e30f; if (d1 > 128 || d1 < -128) p1[r] = -1e30f; } }
                if (KIND == 1) { const int c = cbase + r32; const int wsc = (c - 8) < 0 ? 0 : ((c - 8) > 48 ? 48 : (c - 8)); const LAS float* rp = (const LAS float*)(lds + AT_RPB) + (rk - rq + 7) * 31 + 15 - c;
#pragma unroll
                    for (int r = 0; r < 16; ++r) { const int c0 = crow(r, hi), c1 = c0 + 32; const bool ok0 = (c0 >= wsc) && (c0 < wsc + 16), ok1 = (c1 >= wsc) && (c1 < wsc + 16);
                        p0[r] = ok0 ? p0[r] + rp[ok0 ? c0 : c] : -1e30f; p1[r] = ok1 ? p1[r] + rp[ok1 ? c1 : c] : -1e30f; } }
            }
            float rm = fmaxf(p0[0], p1[0]);
#pragma unroll
            for (int r = 1; r < 16; ++r) rm = fmaxf(rm, fmaxf(p0[r], p1[r]));
            { auto rr = __builtin_amdgcn_permlane32_swap(__float_as_uint(rm), __float_as_uint(rm), false, false); rm = fmaxf(__uint_as_float(rr[0]), __uint_as_float(rr[1])); }
            const float mnew = fmaxf(mhat, rm); const float f = __builtin_amdgcn_exp2f(mhat - mnew); const bool grew = mnew > mhat; mhat = mnew;
            float sacc = 0.f;
#pragma unroll
            for (int r = 0; r < 16; ++r) { p0[r] = (p0[r] > -1e29f) ? __builtin_amdgcn_exp2f(p0[r] - mnew) : 0.f; p1[r] = (p1[r] > -1e29f) ? __builtin_amdgcn_exp2f(p1[r] - mnew) : 0.f; sacc += p0[r] + p1[r]; }
            l_reg = l_reg * f + sacc;
            if (__any(grew)) { if (hi == 0) wsf[r32] = f; LDS_WAIT();
#pragma unroll
                for (int r = 0; r < 16; ++r) { const float fr_ = wsf[crow(r, hi)]; o[0][r] *= fr_; o[1][r] *= fr_; }
                LDS_WAIT(); }
            u32x4 pw0, pw1, pw2, pw3;
            pw0 = (u32x4){cvtpk(p0[0], p0[1]), cvtpk(p0[2], p0[3]), cvtpk(p0[4], p0[5]), cvtpk(p0[6], p0[7])}; pw1 = (u32x4){cvtpk(p0[8], p0[9]), cvtpk(p0[10], p0[11]), cvtpk(p0[12], p0[13]), cvtpk(p0[14], p0[15])};
            pw2 = (u32x4){cvtpk(p1[0], p1[1]), cvtpk(p1[2], p1[3]), cvtpk(p1[4], p1[5]), cvtpk(p1[6], p1[7])}; pw3 = (u32x4){cvtpk(p1[8], p1[9]), cvtpk(p1[10], p1[11]), cvtpk(p1[12], p1[13]), cvtpk(p1[14], p1[15])};
            const LAS unsigned char* vb = vb0 + bufo;
#pragma unroll
            for (int d0 = 0; d0 < 2; ++d0) {
#pragma unroll
                for (int ks = 0; ks < 4; ++ks) { const s16x4_t vl = vtr(vb + d0 * 4096 + ks * 1024), vh = vtr(vb + d0 * 4096 + ks * 1024 + 512);
                    const bf16x8_t vf = (bf16x8_t){vl[0], vl[1], vl[2], vl[3], vh[0], vh[1], vh[2], vh[3]};
                    const bf16x8_t pa = __builtin_bit_cast(bf16x8_t, ks == 0 ? pw0 : (ks == 1 ? pw1 : (ks == 2 ? pw2 : pw3)));
                    o[d0] = __builtin_amdgcn_mfma_f32_32x32x16_bf16(pa, vf, o[d0], 0, 0, 0); } }
        }
        if (t + 1 < NT) { const int nb = ((t + 1) & 1) * 8192; *(LAS u32x4*)(lds + kdst + nb) = gk; *(LAS u32x4*)(lds + vdst + nb) = gv; }
        __syncthreads();
    }
    { auto rr = __builtin_amdgcn_permlane32_swap(__float_as_uint(l_reg), __float_as_uint(l_reg), false, false); l_reg = __uint_as_float(rr[0]) + __uint_as_float(rr[1]); }
    if (sink) l_reg += __builtin_amdgcn_exp2f(a.in[I_SINK][l * 4 + hsink] * LOG2E - mhat);
    if (hi == 0) wsf[32 + r32] = 1.0f / l_reg;
    LDS_WAIT();
    LAS bf16_t* stg = (LAS bf16_t*)(lds + AT_OST) + wid * 2048;
#pragma unroll
    for (int r = 0; r < 16; ++r) { const int orow = crow(r, hi); const float il = wsf[32 + orow];
        stg[orow * 64 + r32] = (bf16_t)f2bf(o[0][r] * il); stg[orow * 64 + 32 + r32] = (bf16_t)f2bf(o[1][r] * il); }
    LDS_WAIT();
#pragma unroll
    for (int i = 0; i < 4; ++i) { const int row = i * 8 + (lane >> 3), ch = lane & 7; const u32x4 v = *(const LAS u32x4*)(stg + row * 64 + ch * 8);
        *(u32x4*)(Y + (size_t)(qrow0 + row) * D + ycol + ch * 8) = v; }
    __syncthreads();
}
#ifndef AMP_PHASE
#define AMP_PHASE -1
#endif
__device__ __forceinline__ unsigned long long amp_now() { asm volatile("s_waitcnt vmcnt(0) lgkmcnt(0)" ::: "memory"); __builtin_amdgcn_sched_barrier(0); const unsigned long long t = __builtin_amdgcn_s_memrealtime(); asm volatile("s_waitcnt lgkmcnt(0)" ::: "memory"); __builtin_amdgcn_sched_barrier(0); return t; }
#define AMP_BEGIN(id) unsigned long long amp_t0_ = 0; if ((id) == AMP_PHASE) { __syncthreads(); amp_t0_ = amp_now(); }
#define AMP_END(id) if ((id) == AMP_PHASE) { __syncthreads(); const unsigned long long t1_ = amp_now(); const unsigned long long d_ = t1_ - amp_t0_; while (amp_now() - t1_ < d_) __builtin_amdgcn_s_sleep(8); __syncthreads(); }

__device__ __forceinline__ void phase_mix1(const Args& a, unsigned char* ldsg, int vcu, int G, int l) {
    LAS unsigned char* lds = (LAS unsigned char*)ldsg;
    int tid_ = threadIdx.x; asm volatile("" : "+v"(tid_));
    const int tid = tid_, lane = tid & 63, wave = __builtin_amdgcn_readfirstlane(tid >> 6);
    unsigned char* ws = a.ws; const bf16_t* PX = (const bf16_t*)(ws + WS_PX); bf16_t* Y = (bf16_t*)(ws + WS_Y);
    const bool upd = (l == 0); const int nrows = upd ? TT : TX;
    const int gw = vcu * NWAVES + wave, NGW = G * NWAVES;
    { AMP_BEGIN(31) load_tw(a, lds, tid);
    for (int it = vcu; it < 1024; it += G) hyena_item(a, lds, l, it >> 2, it & 3, tid);
    if (upd) for (int it = vcu; it < 32; it += G) ctx_hyena_item(a, lds, l, it, tid);
    __syncthreads(); AMP_END(31) }
    { AMP_BEGIN(32)
    LAS float* pw = (LAS float*)(lds + 73728); LAS float* dv = (LAS float*)(lds + 139264 + wave * 1024);
    { const float* src = a.in[I_POOLW] + (size_t)l * 4 * 64 * 64; for (int i = tid; i < 4 * 64 * 64; i += NTHR) pw[i] = src[i]; }
    __syncthreads();
    const float* pscale = a.in[I_POOLS] + (size_t)l * 256;
    for (int row = gw; row < nrows; row += NGW) {
        const bool lat = row < TX; const int tpos = lat ? (row & 4095) : ((row - TX) & 255); const int Ls = lat ? 4096 : 256;
        const bf16_t* pr = PX + (size_t)row * INW;
        { const int g = lane >> 4, hw = 1 << g;
          const int c = 768 + 4 * lane; float s0 = 0.f, s1 = 0.f, s2 = 0.f, s3 = 0.f; int cnt = 0;
#pragma unroll
          for (int off = -8; off < 8; ++off) { const int tp = tpos + off; const bool in = (off >= -hw) && (off < hw) && (tp >= 0) && (tp < Ls);
              if (in) { const u32x2 v = *(const u32x2*)(pr + (ptrdiff_t)off * INW + c); s0 += bflo(v.x); s1 += bfhi(v.x); s2 += bflo(v.y); s3 += bfhi(v.y); cnt++; } }
          const u32x2 u0 = *(const u32x2*)(pr + c); const float ic = 1.0f / (float)cnt;
          f32x4 dd; dd[0] = s0 * ic - bflo(u0.x); dd[1] = s1 * ic - bfhi(u0.x); dd[2] = s2 * ic - bflo(u0.y); dd[3] = s3 * ic - bfhi(u0.y);
          *(LAS f32x4*)(dv + 4 * lane) = dd;
          LDS_WAIT();
          const int j0 = 4 * (lane & 15); f32x4 acc = {0.f, 0.f, 0.f, 0.f};
          const LAS float* dg = dv + g * 64; const LAS float* wg = pw + g * 4096 + j0;
#pragma unroll 8
          for (int i = 0; i < 64; ++i) { const float di = dg[i]; const f32x4 wv = *(const LAS f32x4*)(wg + i * 64); acc += wv * di; }
          const f32x4 sc = *(const f32x4*)(pscale + g * 64 + j0); acc *= sc;
          u32x2 ov; ov.x = pk2(acc[0], acc[1]); ov.y = pk2(acc[2], acc[3]);
          *(u32x2*)(Y + (size_t)row * D + 512 + g * 64 + j0) = ov;
          LDS_WAIT(); }
    }
    __syncthreads(); AMP_END(32) }
    { AMP_BEGIN(33)
    for (int u = vcu; u < 512; u += G) attn_unit<0>(a, lds, l, u, tid);
    for (int u = vcu; u < 512; u += G) attn_unit<1>(a, lds, l, u, tid);
    if (upd) for (int u = vcu; u < 64; u += G) attn_unit<2>(a, lds, l, u, tid);
    AMP_END(33) }
}

__device__ __forceinline__ void phase_select(const Args& a, unsigned char* ldsg, int vcu, int G, bool with_ctx) {
    LAS unsigned long long* arr = (LAS unsigned long long*)(LAS unsigned char*)ldsg;
    int tid_ = threadIdx.x; asm volatile("" : "+v"(tid_));
    const int tid = tid_; unsigned char* ws = a.ws;
    const float* AFFT = (const float*)(ws + WS_AFFT); int* ROWMAP = (int*)(ws + WS_ROWMAP); float* GATE = (float*)(ws + WS_GATE); int* INV = (int*)(ws + WS_INV);
    const int nitems = 128 + (with_ctx ? 128 : 0);
    for (int item = vcu; item < nitems; item += G) {
        int e, base, Ls, cap, slot0;
        if (item < 128) { const int b = item >> 4; e = item & 15; base = b * 4096; Ls = 4096; cap = CAPX; slot0 = b * CAPX; }
        else { const int it = item - 128; const int b = it >> 4; e = it & 15; base = TX + b * 256; Ls = 256; cap = CAPC; slot0 = NB * CAPX + b * CAPC; }
        for (int i = tid; i < Ls; i += NTHR) arr[i] = ((unsigned long long)__float_as_uint(AFFT[(size_t)e * TT + base + i]) << 32) | (unsigned)(Ls - 1 - i);
        __syncthreads();
        const int npairs = Ls >> 1;
        for (int k = 2; k <= Ls; k <<= 1)
            for (int j = k >> 1; j > 0; j >>= 1) {
                for (int p = tid; p < npairs; p += NTHR) { const int i = ((p & ~(j - 1)) << 1) | (p & (j - 1)), ix = i | j;
                    const unsigned long long x = arr[i], y = arr[ix]; const bool desc = ((i & k) == 0);
                    if (desc ? (x < y) : (x > y)) { arr[i] = y; arr[ix] = x; } }
                __syncthreads(); }
        for (int s = tid; s < cap; s += NTHR) { const unsigned long long v = arr[s]; const int idx = Ls - 1 - (int)(unsigned)(v & 0xffffffffull); const int slot = e * SLOTS + slot0 + s;
            ROWMAP[slot] = base + idx; GATE[slot] = __uint_as_float((unsigned)(v >> 32)); INV[(size_t)(base + idx) * 16 + e] = slot; }
        __syncthreads();
    }
}
__device__ __forceinline__ void phase_gather(const Args& a, int vcu, int G, bool with_ctx) {
    int tid_ = threadIdx.x; asm volatile("" : "+v"(tid_));
    const int tid = tid_, lane = tid & 63, wave = __builtin_amdgcn_readfirstlane(tid >> 6); unsigned char* ws = a.ws;
    const int* ROWMAP = (const int*)(ws + WS_ROWMAP); const bf16_t* HX = (const bf16_t*)(ws + WS_HX); bf16_t* XG = (bf16_t*)(ws + WS_XG);
    const int per = with_ctx ? SLOTS : NB * CAPX; const int gw = vcu * NWAVES + wave, NGW = G * NWAVES;
    for (int it = gw; it < NE * per; it += NGW) { const int e = it / per, s = it % per; const int slot = e * SLOTS + s; const int src = ROWMAP[slot];
        const u32x4* sp = (const u32x4*)(HX + (size_t)src * D) + 2 * lane; u32x4* dp = (u32x4*)(XG + (size_t)slot * D) + 2 * lane;
        const u32x4 v0 = sp[0], v1 = sp[1]; dp[0] = v0; dp[1] = v1; }
}
__device__ __forceinline__ void phase_combine(const Args& a, int vcu, int G, int l, bool with_ctx, bool final_norm) {
    int tid_ = threadIdx.x; asm volatile("" : "+v"(tid_));
    const int tid = tid_, lane = tid & 63, wave = __builtin_amdgcn_readfirstlane(tid >> 6); unsigned char* ws = a.ws;
    const int* INV = (const int*)(ws + WS_INV); const bf16_t* OB = (const bf16_t*)(ws + WS_XG); const float* MOD = (const float*)(ws + WS_MOD) + (size_t)l * 9 * 6144;
    float* CRES = (float*)(ws + WS_CRES); const float* fng = a.in[I_FNG];
    const int nrows = with_ctx ? TT : TX; const int gw = vcu * NWAVES + wave, NGW = G * NWAVES;
    for (int row = gw; row < nrows; row += NGW) {
        const bool lat = row < TX; float* xr = lat ? a.out + (size_t)row * D : CRES + (size_t)(row - TX) * D; const int mrow = lat ? (row >> 12) : 8;
        const int myinv = (lane < 16) ? INV[(size_t)row * 16 + lane] : -1;
        f32x4 acc[4];
#pragma unroll
        for (int j = 0; j < 4; ++j) acc[j] = (f32x4){0.f, 0.f, 0.f, 0.f};
        for (int e = 0; e < 16; ++e) { const int s = __shfl(myinv, e);
            if (s >= 0) { const bf16_t* orow = OB + (size_t)s * D;
#pragma unroll
                for (int j = 0; j < 4; ++j) { const u32x2 v = *(const u32x2*)(orow + 256 * j + 4 * lane); acc[j][0] += bflo(v.x); acc[j][1] += bfhi(v.x); acc[j][2] += bflo(v.y); acc[j][3] += bfhi(v.y); } } }
        const float* gp = MOD + mrow * 6144 + 5 * 1024; f32x4 v[4]; float ss = 0.f;
#pragma unroll
        for (int j = 0; j < 4; ++j) { const f32x4 g = *(const f32x4*)(gp + 256 * j + 4 * lane); v[j] = *(const f32x4*)(xr + 256 * j + 4 * lane) + g * acc[j];
            ss += (v[j][0] * v[j][0] + v[j][1] * v[j][1]) + (v[j][2] * v[j][2] + v[j][3] * v[j][3]); }
        if (final_norm) { const float rstd = 1.0f / sqrtf(wave_sum(ss) * (1.0f / D) + 1e-6f);
#pragma unroll
            for (int j = 0; j < 4; ++j) { const f32x4 g = *(const f32x4*)(fng + 256 * j + 4 * lane); v[j] = v[j] * rstd * g; } }
#pragma unroll
        for (int j = 0; j < 4; ++j) *(f32x4*)(xr + 256 * j + 4 * lane) = v[j];
    }
}

__global__ void __launch_bounds__(NTHR, 2) fwd_kernel(Args a) {
    extern __shared__ __attribute__((aligned(16))) unsigned char lds[];
    cg::grid_group grid = cg::this_grid();
    const int G = gridDim.x, bx = blockIdx.x; const int vcu = (G % 8 == 0) ? (bx % 8) * (G / 8) + bx / 8 : bx;
    unsigned char* ws = a.ws;
    PG8_LAS unsigned char* glds = (PG8_LAS unsigned char*)lds;
    volatile LAS unsigned* bst = (volatile LAS unsigned*)((LAS unsigned char*)lds + LDS_BYTES - 16);
    if (threadIdx.x < 4) bst[threadIdx.x] = 0u;
    __syncthreads();
    XcdBarrier bar = xcd_barrier_post((unsigned*)(ws + WS_CTL), bst);
    { AMP_BEGIN(0) phase_prologue(a, lds, vcu, G); AMP_END(0) }
    grid.sync();
    for (int l = 0; l < 2; ++l) {
        const bool upd = (l == 0);
        const float* srcx = upd ? a.in[I_X] : a.out; const float* srcc = upd ? a.in[I_CTX] : (const float*)(ws + WS_CRES);
        { AMP_BEGIN(1) phase_norm(a, lds, vcu, G, l, srcx, srcc, a.in[I_N1G] + l * D, 0, TT, false); AMP_END(1) }
        { AMP_BEGIN(11) if (upd) { load_tw(a, (LAS unsigned char*)lds, threadIdx.x); for (int it = vcu; it < 1024; it += G) spectrum_item(a, (LAS unsigned char*)lds, it, threadIdx.x); } AMP_END(11) }
        xcd_barrier(bar);
        { AMP_BEGIN(2) pg8::Gemm g{(const pg8::bf16_t*)(ws + WS_HX), (const pg8::bf16_t*)(ws + WS_WIN_T) + (size_t)l * INW * D, TT, INW, D};
          pg8::GroupOrder S; S.init(1, TT / 256, INW / 256, 0, G, bx);
          pg8::EpiIn E{(pg8::bf16_t*)(ws + WS_PX), (const float*)(ws + WS_ROPE), (pg8::bf16_t*)(ws + WS_UT), glds + 131072};
          pg8::gemm_phase<pg8::EpiIn, pg8::GroupOrder, true, true>(glds, g, S, E); AMP_END(2) }
        xcd_barrier(bar);
        { AMP_BEGIN(3) phase_mix1(a, lds, vcu, G, l); AMP_END(3) }
        xcd_barrier(bar);
        { AMP_BEGIN(4) pg8::Gemm g{(const pg8::bf16_t*)(ws + WS_Y), (const pg8::bf16_t*)(ws + WS_WOUT_T) + (size_t)l * D * D, TT, D, D};
          pg8::GroupOrder S; S.init(1, (upd ? TT : TX) / 256, D / 256, 0, G, bx);
          pg8::EpiOut E{srcx, srcc, a.out, (float*)(ws + WS_CRES), (const float*)(ws + WS_MOD) + (size_t)l * 9 * 6144};
          pg8::gemm_phase<pg8::EpiOut, pg8::GroupOrder, true, true>(glds, g, S, E); AMP_END(4) }
        xcd_barrier(bar);
        { AMP_BEGIN(5) phase_norm(a, lds, vcu, G, l, a.out, (const float*)(ws + WS_CRES), a.in[I_N2G] + l * D, 3, upd ? TT : TX, true); AMP_END(5) }
        xcd_barrier(bar);
        { AMP_BEGIN(6) phase_select(a, lds, vcu, G, upd); AMP_END(6) }
        xcd_barrier(bar);
        { AMP_BEGIN(7) phase_gather(a, vcu, G, upd); AMP_END(7) }
        xcd_barrier(bar);
        { AMP_BEGIN(8) pg8::Gemm g{(const pg8::bf16_t*)(ws + WS_XG), (const pg8::bf16_t*)(ws + WS_WGU_T) + (size_t)l * NE * 4096 * D, NE * SLOTS, NE * 4096, D};
          pg8::GroupOrder S; S.init(NE, upd ? 17 : 16, 16, 17, G, bx);
          pg8::EpiGU E{(pg8::bf16_t*)(ws + WS_ACT)};
          pg8::gemm_phase<pg8::EpiGU, pg8::GroupOrder, true, true>(glds, g, S, E); AMP_END(8) }
        xcd_barrier(bar);
        { AMP_BEGIN(9) pg8::Gemm g{(const pg8::bf16_t*)(ws + WS_ACT), (const pg8::bf16_t*)(ws + WS_WD_T) + (size_t)l * NE * D * FF, NE * SLOTS, NE * D, FF};
          pg8::GroupOrder S; S.init(NE, upd ? 17 : 16, 4, 17, G, bx);
          pg8::EpiDown E{(pg8::bf16_t*)(ws + WS_XG), (const float*)(ws + WS_GATE)};
          pg8::gemm_phase<pg8::EpiDown, pg8::GroupOrder, true, true>(glds, g, S, E); AMP_END(9) }
        xcd_barrier(bar);
        { AMP_BEGIN(10) phase_combine(a, vcu, G, l, upd, !upd); AMP_END(10) }
        if (upd) xcd_barrier(bar);
    }
}

extern "C" void kernel_launch(void* const* d_in, const int* in_sizes, int n_in, void* d_out, int out_size, void* d_ws, size_t ws_size, hipStream_t stream) {
    static int grid = 0;
    if (grid == 0) {
        int dev = 0, cus = 0, per_cu = 0;
        hipGetDevice(&dev); hipDeviceGetAttribute(&cus, hipDeviceAttributeMultiprocessorCount, dev);
        if (hipFuncSetAttribute((const void*)fwd_kernel, hipFuncAttributeMaxDynamicSharedMemorySize, LDS_BYTES) != hipSuccess) { fprintf(stderr, "kernel_launch: hipFuncSetAttribute failed\n"); grid = -1; return; }
        if (hipOccupancyMaxActiveBlocksPerMultiprocessor(&per_cu, (const void*)fwd_kernel, NTHR, LDS_BYTES) != hipSuccess || per_cu < 1) { fprintf(stderr, "kernel_launch: occupancy query failed (%d)\n", per_cu); grid = -1; return; }
        grid = cus * 1;
        if (n_in != N_IN || ws_size < WS_END) { fprintf(stderr, "kernel_launch: unexpected n_in %d / ws %zu\n", n_in, ws_size); grid = -1; return; }
    }
    if (grid < 0) return;
    if (hipMemsetAsync((char*)d_ws + WS_CTL, 0, 65536, stream) != hipSuccess) { fprintf(stderr, "kernel_launch: memset failed\n"); return; }
    Args a{};
    for (int i = 0; i < N_IN; ++i) a.in[i] = (const float*)d_in[i];
    a.out = (float*)d_out; a.ws = (unsigned char*)d_ws;
    void* args[] = {&a};
    hipError_t e = hipLaunchCooperativeKernel((const void*)fwd_kernel, dim3(grid), dim3(NTHR), args, LDS_BYTES, stream);
    if (e != hipSuccess) fprintf(stderr, "cooperative launch failed: %s (grid %d)\n", hipGetErrorString(e), grid);
}
```

```cpp
#define AMP_PHASE -1
#include <hip/hip_runtime.h>
#include <hip/hip_cooperative_groups.h>
#include <cstdio>
#include <cstdint>
namespace cg = cooperative_groups;
namespace pg8 {
#define PG8_LAS __attribute__((address_space(3)))
typedef unsigned short bf16_t;
typedef short bf16x8 __attribute__((ext_vector_type(8)));
typedef float f32x4 __attribute__((ext_vector_type(4)));
typedef unsigned u32x4 __attribute__((ext_vector_type(4)));
constexpr int BM = 256, BK = 64, HALF = 128, HTB = HALF * BK * 2  , STAGE_BYTES = 8 * HTB, NXCD = 8, WGM = 8;

__host__ __device__ __forceinline__ int lds_byte(int r, int c) { const int st = (r >> 4) * 2 + (c >> 5), rr = r & 15, cc = c & 31, ob = rr * 64 + cc * 2; return st * 1024 + (ob ^ (((ob >> 9) & 1) << 5)); }
__host__ __device__ __forceinline__ void stage_rc(int b, int& R, int& C) { const int st = b / 1024, sb = b % 1024, swz = sb ^ (((sb >> 9) & 1) << 5); R = (st >> 1) * 16 + swz / 64; C = (st & 1) * 32 + (swz % 64) / 2; }
__host__ __device__ __forceinline__ int perm32(int rho) { const int n = rho >> 4, i = rho & 15; return 8 * (i >> 2) + 4 * n + (i & 3); }

struct Unit { int pm, pn; };
struct Gemm { const bf16_t* A; const bf16_t* Bt; int M, N, K; };

struct StaticOrder {
    int nM, nN, nwg, G, c;
    __host__ __device__ void init(int M, int N, int G_, int c_) { nM = M / BM; nN = N / BM; nwg = nM * nN; G = G_; c = c_; }
    __host__ __device__ bool next(int i, Unit& u) const {
        const long L = (long)i * G + c; if (L >= nwg) return false;
        int wgid = (int)L; { const int q = nwg / NXCD, r = nwg % NXCD, xcd = wgid % NXCD, off = wgid / NXCD; wgid = (xcd < r ? xcd * (q + 1) : r * (q + 1) + (xcd - r) * q) + off; }
        const int nig = WGM * nN, gid = wgid / nig, fm = gid * WGM, gsz = (nM - fm) < WGM ? (nM - fm) : WGM;
        u.pm = fm + ((wgid % nig) % gsz); u.pn = (wgid % nig) / gsz; return true;
    }
    __device__ __forceinline__ void a_ready(const Unit&) const {}
    __device__ __forceinline__ void done(const Unit&) const {}
};

__device__ __forceinline__ unsigned cvt_pk_bf16(float lo, float hi) { unsigned r; asm volatile("v_cvt_pk_bf16_f32 %0, %1, %2" : "=v"(r) : "v"(lo), "v"(hi)); return r; }
typedef float f32x2 __attribute__((ext_vector_type(2)));
__device__ __forceinline__ f32x2 gelu_pk(f32x2 v) {
    const f32x2 av = __builtin_elementwise_abs(v), d = av * 0.2316418882f + 1.0f;
    f32x2 t; t.x = __builtin_amdgcn_rcpf(d.x); t.y = __builtin_amdgcn_rcpf(d.y);
    f32x2 q = t * 0.5307027145f + (-0.7265760135f); q = q * t + 0.7107068705f; q = q * t + (-0.142248368f); q = q * t + 0.127414796f; q = q * t;
    const f32x2 s = (v * v) * (-0.72134752044f);
    f32x2 e; e.x = __builtin_amdgcn_exp2f(s.x); e.y = __builtin_amdgcn_exp2f(s.y);
    const f32x2 m = v * (q * e), r = v - m;
    f32x2 o; o.x = v.x < 0.f ? m.x : r.x; o.y = v.y < 0.f ? m.y : r.y; return o;
}


struct GroupOrder {
    int nMl, nNl, strideM, nper, nwg, G, c;
    __device__ void init(int ng, int nMl_, int nNl_, int strideM_, int G_, int c_) { nMl = nMl_; nNl = nNl_; strideM = strideM_; nper = nMl_ * nNl_; nwg = ng * nper; G = G_; c = c_; }
    __device__ bool next(int i, Unit& u) const {
        const long L = (long)i * G + c; if (L >= nwg) return false;
        int wgid = (int)L; { const int q = nwg / NXCD, r = nwg % NXCD, xcd = wgid % NXCD, off = wgid / NXCD; wgid = (xcd < r ? xcd * (q + 1) : r * (q + 1) + (xcd - r) * q) + off; }
        const int e = wgid / nper, id = wgid % nper;
        const int nig = WGM * nNl, gid = id / nig, fm = gid * WGM, gsz = (nMl - fm) < WGM ? (nMl - fm) : WGM;
        u.pm = e * strideM + fm + ((id % nig) % gsz); u.pn = e * nNl + (id % nig) / gsz; return true;
    }
    __device__ __forceinline__ void a_ready(const Unit&) const {}
    __device__ __forceinline__ void done(const Unit&) const {}
};

constexpr int TXR = 32768;
struct EpiIn {
    static constexpr bool PERM = true, AFTER_DRAIN = false;
    bf16_t* PX; const float* rope; bf16_t* UT; PG8_LAS unsigned char* stgbase;
    __device__ __forceinline__ void operator()(const f32x4 (&acc)[2][2][4][2], const Unit& u, int wr, int wc, int fr, int fq) const {
        const int row0 = u.pm * BM + wr * 64 + fr; const int col0 = u.pn * BM + wc * 32 + 8 * fq;
        const bool latent = u.pm < (TXR / BM);
        if (latent && u.pn < 3) {
            PG8_LAS unsigned char* stg = stgbase + (wr * 4 + wc) * 2304; const int lane = fq * 16 + fr;
            const int b = u.pm >> 4, trow0 = (u.pm & 15) * BM; const int col = lane >> 1, half = lane & 1;
#pragma unroll
            for (int ai = 0; ai < 2; ++ai)
#pragma unroll
                for (int bj = 0; bj < 2; ++bj)
#pragma unroll
                    for (int mh = 0; mh < 2; ++mh) {
#pragma unroll
                        for (int mm = 0; mm < 2; ++mm)
#pragma unroll
                            for (int n = 0; n < 2; ++n) { const f32x4 v = acc[ai][bj][2 * mh + mm][n]; const unsigned w0 = cvt_pk_bf16(v[0], v[1]), w1 = cvt_pk_bf16(v[2], v[3]);
                                PG8_LAS unsigned char* p = stg + (8 * fq + 4 * n) * 72 + (16 * mm + fr) * 2;
                                *(PG8_LAS unsigned short*)(p) = (unsigned short)w0; *(PG8_LAS unsigned short*)(p + 72) = (unsigned short)(w0 >> 16);
                                *(PG8_LAS unsigned short*)(p + 144) = (unsigned short)w1; *(PG8_LAS unsigned short*)(p + 216) = (unsigned short)(w1 >> 16); }
                        asm volatile("s_waitcnt lgkmcnt(0)" ::: "memory");
                        typedef unsigned u32x2v __attribute__((ext_vector_type(2)));
                        const PG8_LAS unsigned char* rp = stg + col * 72 + half * 32;
                        const u32x2v a0 = *(const PG8_LAS u32x2v*)(rp), a1 = *(const PG8_LAS u32x2v*)(rp + 8), a2 = *(const PG8_LAS u32x2v*)(rp + 16), a3 = *(const PG8_LAS u32x2v*)(rp + 24);
                        const int ch = u.pn * BM + bj * HALF + wc * 32 + col; const int t0 = trow0 + ai * HALF + wr * 64 + mh * 32 + half * 16;
                        u32x4* gp = (u32x4*)(UT + ((size_t)(b * 768 + ch)) * 4096 + t0);
                        gp[0] = (u32x4){a0.x, a0.y, a1.x, a1.y}; gp[1] = (u32x4){a2.x, a2.y, a3.x, a3.y};
                        asm volatile("s_waitcnt lgkmcnt(0)" ::: "memory"); }
            return;
        }
#pragma unroll
        for (int ai = 0; ai < 2; ++ai)
#pragma unroll
            for (int m = 0; m < 4; ++m) { const int row = row0 + ai * HALF + m * 16; bf16_t* rowp = PX + (size_t)row * 2304 + col0;
#pragma unroll
                for (int bj = 0; bj < 2; ++bj) { f32x4 v0 = acc[ai][bj][m][0], v1 = acc[ai][bj][m][1];
                    const bool dorope = latent && (u.pn == 4 || (u.pn == 6 && bj == 0));
                    if (dorope) {
                        const int t = row & 4095; const int pos = (wc & 1) ? (t & 63) : (t >> 6);
                        const f32x4* rp = (const f32x4*)(rope + (pos * 16 + 8 * (fq & 1)) * 2);
                        const f32x4 r0 = rp[0], r1 = rp[1], r2 = rp[2], r3 = rp[3];
                        f32x4 p0, p1;
#pragma unroll
                        for (int j = 0; j < 4; ++j) { p0[j] = __shfl_xor(v0[j], 32); p1[j] = __shfl_xor(v1[j], 32); }
                        const float c0[4] = {r0[0], r0[2], r1[0], r1[2]}, s0[4] = {r0[1], r0[3], r1[1], r1[3]};
                        const float c1[4] = {r2[0], r2[2], r3[0], r3[2]}, s1[4] = {r2[1], r2[3], r3[1], r3[3]};
                        const bool lo = fq < 2;
#pragma unroll
                        for (int j = 0; j < 4; ++j) {
                            v0[j] = lo ? (v0[j] * c0[j] - p0[j] * s0[j]) : (p0[j] * s0[j] + v0[j] * c0[j]);
                            v1[j] = lo ? (v1[j] * c1[j] - p1[j] * s1[j]) : (p1[j] * s1[j] + v1[j] * c1[j]); }
                    }
                    u32x4 w; w.x = cvt_pk_bf16(v0[0], v0[1]); w.y = cvt_pk_bf16(v0[2], v0[3]); w.z = cvt_pk_bf16(v1[0], v1[1]); w.w = cvt_pk_bf16(v1[2], v1[3]);
                    *(u32x4*)(rowp + bj * HALF) = w; } }
    }
};
struct EpiOut {
    static constexpr bool PERM = false, AFTER_DRAIN = false;
    const float* xold_x; const float* xold_c; float* dst_x; float* dst_c; const float* mod;
    __device__ __forceinline__ void operator()(const f32x4 (&acc)[2][2][4][2], const Unit& u, int wr, int wc, int fr, int fq) const {
        const int row0 = u.pm * BM + wr * 64 + fr, col0 = u.pn * BM + wc * 32 + 4 * fq;
        const bool latent = u.pm < (TXR / BM);
#pragma unroll
        for (int ai = 0; ai < 2; ++ai)
#pragma unroll
            for (int m = 0; m < 4; ++m) { const int row = row0 + ai * HALF + m * 16;
                const int mrow = latent ? (row >> 12) : 8; const float* gp = mod + mrow * 6144 + 2 * 1024 + col0;
                const size_t off = latent ? (size_t)row * 1024 + col0 : (size_t)(row - TXR) * 1024 + col0;
                const float* xo = (latent ? xold_x : xold_c) + off; float* xd = (latent ? dst_x : dst_c) + off;
#pragma unroll
                for (int bj = 0; bj < 2; ++bj)
#pragma unroll
                    for (int n = 0; n < 2; ++n) { const f32x4 g = *(const f32x4*)(gp + bj * HALF + n * 16), xv = *(const f32x4*)(xo + bj * HALF + n * 16);
                        *(f32x4*)(xd + bj * HALF + n * 16) = xv + g * acc[ai][bj][m][n]; } }
    }
};
struct EpiGU {
    static constexpr bool PERM = true, AFTER_DRAIN = false;
    bf16_t* ACT;
    __device__ __forceinline__ void operator()(const f32x4 (&acc)[2][2][4][2], const Unit& u, int wr, int wc, int fr, int fq) const {
        const int row0 = u.pm * BM + wr * 64 + fr; const int col0 = (u.pn & 15) * 128 + wc * 32 + 8 * fq;
#pragma unroll
        for (int ai = 0; ai < 2; ++ai)
#pragma unroll
            for (int m = 0; m < 4; ++m) { bf16_t* rowp = ACT + (size_t)(row0 + ai * HALF + m * 16) * 2048 + col0;
                f32x4 h[2];
#pragma unroll
                for (int n = 0; n < 2; ++n)
#pragma unroll
                    for (int j = 0; j < 4; ++j) { const float g = acc[ai][0][m][n][j], up = acc[ai][1][m][n][j]; h[n][j] = g / (1.0f + __expf(-g)) * up; }
                u32x4 w; w.x = cvt_pk_bf16(h[0][0], h[0][1]); w.y = cvt_pk_bf16(h[0][2], h[0][3]); w.z = cvt_pk_bf16(h[1][0], h[1][1]); w.w = cvt_pk_bf16(h[1][2], h[1][3]);
                *(u32x4*)rowp = w; }
    }
};
struct EpiDown {
    static constexpr bool PERM = true, AFTER_DRAIN = false;
    bf16_t* OB; const float* gate;
    __device__ __forceinline__ void operator()(const f32x4 (&acc)[2][2][4][2], const Unit& u, int wr, int wc, int fr, int fq) const {
        const int row0 = u.pm * BM + wr * 64 + fr; const int col0 = (u.pn & 3) * BM + wc * 32 + 8 * fq;
#pragma unroll
        for (int ai = 0; ai < 2; ++ai)
#pragma unroll
            for (int m = 0; m < 4; ++m) { const int row = row0 + ai * HALF + m * 16; const float g = gate[row]; bf16_t* rowp = OB + (size_t)row * 1024 + col0;
#pragma unroll
                for (int bj = 0; bj < 2; ++bj) { const f32x4 v0 = acc[ai][bj][m][0] * g, v1 = acc[ai][bj][m][1] * g;
                    u32x4 w; w.x = cvt_pk_bf16(v0[0], v0[1]); w.y = cvt_pk_bf16(v0[2], v0[3]); w.z = cvt_pk_bf16(v1[0], v1[1]); w.w = cvt_pk_bf16(v1[2], v1[3]);
                    *(u32x4*)(rowp + bj * HALF) = w; } }
    }
};

template <class Epi, class Sched, bool ALIGN_EPI = false, bool SP2 = false>
__device__ __forceinline__ void gemm_phase(PG8_LAS unsigned char* lds, const Gemm g, const Sched& S, const Epi& E) {
    int tid_ = threadIdx.x; asm volatile("" : "+v"(tid_));
    const int tid = tid_, wid = __builtin_amdgcn_readfirstlane(tid >> 6), lane = tid & 63, wr = wid >> 2, wc = wid & 3, fr = lane & 15, fq = lane >> 4;
    const int K = g.K, nt = K / BK;
    unsigned voffA[2], voffB[2];
#pragma unroll
    for (int i = 0; i < 2; ++i) { int R, C; stage_rc(tid * 16 + i * 8192, R, C); const int Rb = Epi::PERM ? ((R & ~31) + perm32(R & 31)) : R;
        voffA[i] = (unsigned)(R * K + C) * 2u; voffB[i] = (unsigned)(Rb * K + C) * 2u; }
    const size_t kstep = (size_t)(BK * 2);
    const size_t hstep = (size_t)HALF * K * 2;
    const size_t tstep = 2 * hstep;
    const unsigned ldsw = (unsigned)wid * 1024u;
    const int aoff = lds_byte(wr * 64 + fr, fq * 8), boff = lds_byte(wc * 32 + fr, fq * 8);
#define PG8_SA(b, h) (((b) * 2 + (h)) * HTB)
#define PG8_SB(b, h) ((4 + (b) * 2 + (h)) * HTB)
#define PG8_STAGE(bufoff, gbase, voff) do { _Pragma("unroll") for (int _i = 0; _i < 2; ++_i) \
        __builtin_amdgcn_global_load_lds((const unsigned*)((const char*)(gbase) + (voff)[_i]), (PG8_LAS unsigned*)(lds + (bufoff) + ldsw + _i * 8192), 16, 0, 0); } while (0)
#define PG8_LDA(dst, b, h) do { _Pragma("unroll") for (int m = 0; m < 4; ++m) _Pragma("unroll") for (int k = 0; k < 2; ++k) dst[m][k] = *(const PG8_LAS bf16x8*)(lds + PG8_SA(b, h) + aoff + m * 2048 + k * 1024); } while (0)
#define PG8_LDB(dst, b, h) do { _Pragma("unroll") for (int n = 0; n < 2; ++n) _Pragma("unroll") for (int k = 0; k < 2; ++k) dst[n][k] = *(const PG8_LAS bf16x8*)(lds + PG8_SB(b, h) + boff + n * 2048 + k * 1024); } while (0)
#define PG8_MMA(ai, bj, At, Bt) do { __builtin_amdgcn_s_setprio(1); _Pragma("unroll") for (int m = 0; m < 4; ++m) _Pragma("unroll") for (int n = 0; n < 2; ++n) _Pragma("unroll") for (int k = 0; k < 2; ++k) \
        acc[ai][bj][m][n] = __builtin_amdgcn_mfma_f32_16x16x32_bf16(Bt[n][k], At[m][k], acc[ai][bj][m][n], 0, 0, 0); __builtin_amdgcn_s_setprio(0); } while (0)
#define PG8_WAIT_V(n) asm volatile("s_waitcnt vmcnt(" #n ")" ::: "memory")
#define PG8_WAIT_L(n) asm volatile("s_waitcnt lgkmcnt(" #n ")" ::: "memory")
#define PG8_BAR __builtin_amdgcn_s_barrier()
#define PG8_SCHED __builtin_amdgcn_sched_barrier(0)
    Unit cur, nxt; int ui = 0;
    if (!S.next(0, cur)) return;
    f32x4 acc[2][2][4][2];
#pragma unroll
    for (int a = 0; a < 2; ++a)
#pragma unroll
        for (int b = 0; b < 2; ++b)
#pragma unroll
            for (int m = 0; m < 4; ++m)
#pragma unroll
                for (int n = 0; n < 2; ++n) acc[a][b][m][n] = (f32x4){0.f, 0.f, 0.f, 0.f};
    bf16x8 At[4][2], B0[2][2], B1[2][2];
    const char* cA = (const char*)g.A + (size_t)cur.pm * tstep; const char* cB = (const char*)g.Bt + (size_t)cur.pn * tstep;
    S.a_ready(cur);
    if constexpr (SP2) {
        PG8_STAGE(PG8_SB(0, 0), cB, voffB); PG8_STAGE(PG8_SB(0, 1), cB + hstep, voffB); PG8_STAGE(PG8_SA(0, 0), cA, voffA); PG8_STAGE(PG8_SA(0, 1), cA + hstep, voffA);
        if (wr == 1) PG8_BAR;
        PG8_WAIT_V(2); PG8_BAR;
        PG8_STAGE(PG8_SB(1, 0), cB + kstep, voffB); PG8_STAGE(PG8_SA(1, 0), cA + kstep, voffA); PG8_STAGE(PG8_SB(1, 1), cB + hstep + kstep, voffB);
        PG8_WAIT_V(6); PG8_BAR;
    } else {
        PG8_STAGE(PG8_SB(0, 0), cB, voffB); PG8_STAGE(PG8_SA(0, 0), cA, voffA); PG8_STAGE(PG8_SB(0, 1), cB + hstep, voffB); PG8_STAGE(PG8_SA(0, 1), cA + hstep, voffA);
        if (wr == 1) PG8_BAR;
        PG8_WAIT_V(4); PG8_BAR;
        PG8_STAGE(PG8_SB(1, 0), cB + kstep, voffB); PG8_STAGE(PG8_SA(1, 0), cA + kstep, voffA); PG8_STAGE(PG8_SB(1, 1), cB + hstep + kstep, voffB);
        PG8_WAIT_V(6); PG8_BAR;
    }
    for (;;) {
        const bool has_next = S.next(ui + 1, nxt);
        const char* nA = has_next ? (const char*)g.A + (size_t)nxt.pm * tstep : cA; const char* nB = has_next ? (const char*)g.Bt + (size_t)nxt.pn * tstep : cB;
        for (int t = 0; t < nt; t += 2) {
            const bool last = (t == nt - 2);
            const char* a1 = cA + (size_t)(t + 1) * kstep;
            const char* a2 = last ? nA : cA + (size_t)(t + 2) * kstep; const char* b2 = last ? nB : cB + (size_t)(t + 2) * kstep;
            const char* a3 = a2 + kstep; const char* b3 = b2 + kstep;
            if (last && has_next) S.a_ready(nxt);
            if constexpr (SP2) {
            PG8_LDB(B0, 0, 0); PG8_LDB(B1, 0, 1); PG8_SCHED; PG8_LDA(At, 0, 0); PG8_STAGE(PG8_SA(1, 1), a1 + hstep, voffA);
            PG8_WAIT_V(8); PG8_WAIT_L(0); PG8_BAR; PG8_MMA(0, 0, At, B0); PG8_MMA(0, 1, At, B1); PG8_BAR; PG8_SCHED;
            PG8_LDA(At, 0, 1); PG8_STAGE(PG8_SB(0, 0), b2, voffB); PG8_STAGE(PG8_SB(0, 1), b2 + hstep, voffB); PG8_STAGE(PG8_SA(0, 0), a2, voffA);
            PG8_WAIT_V(8); PG8_WAIT_L(0); PG8_BAR; PG8_MMA(1, 0, At, B0); PG8_MMA(1, 1, At, B1); PG8_BAR; PG8_SCHED;
            PG8_LDB(B0, 1, 0); PG8_LDB(B1, 1, 1); PG8_SCHED; PG8_LDA(At, 1, 0); PG8_STAGE(PG8_SA(0, 1), a2 + hstep, voffA);
            PG8_WAIT_V(8); PG8_WAIT_L(0); PG8_BAR; PG8_MMA(0, 0, At, B0); PG8_MMA(0, 1, At, B1); PG8_BAR; PG8_SCHED;
            PG8_LDA(At, 1, 1); PG8_STAGE(PG8_SB(1, 0), b3, voffB); PG8_STAGE(PG8_SB(1, 1), b3 + hstep, voffB); PG8_STAGE(PG8_SA(1, 0), a3, voffA);
            PG8_WAIT_V(8); PG8_WAIT_L(0); PG8_BAR; PG8_MMA(1, 0, At, B0); PG8_MMA(1, 1, At, B1); PG8_BAR; PG8_SCHED;
            } else {
            PG8_LDB(B0, 0, 0); PG8_SCHED; PG8_LDA(At, 0, 0); PG8_STAGE(PG8_SA(1, 1), a1 + hstep, voffA);
            PG8_WAIT_L(8); PG8_BAR; PG8_WAIT_L(0); PG8_MMA(0, 0, At, B0); PG8_BAR; PG8_SCHED;
            PG8_LDB(B1, 0, 1); PG8_STAGE(PG8_SB(0, 0), b2, voffB);
            PG8_BAR; PG8_WAIT_L(0); PG8_MMA(0, 1, At, B1); PG8_BAR;
            PG8_LDA(At, 0, 1); PG8_STAGE(PG8_SA(0, 0), a2, voffA);
            PG8_BAR; PG8_WAIT_L(0); PG8_MMA(1, 0, At, B0); PG8_BAR; PG8_SCHED;
            PG8_STAGE(PG8_SB(0, 1), b2 + hstep, voffB);
            PG8_WAIT_V(6); PG8_BAR; PG8_MMA(1, 1, At, B1); PG8_BAR;
            PG8_LDB(B0, 1, 0); PG8_SCHED; PG8_LDA(At, 1, 0); PG8_STAGE(PG8_SA(0, 1), a2 + hstep, voffA);
            PG8_WAIT_L(8); PG8_BAR; PG8_WAIT_L(0); PG8_MMA(0, 0, At, B0); PG8_BAR; PG8_SCHED;
            PG8_LDB(B1, 1, 1); PG8_STAGE(PG8_SB(1, 0), b3, voffB);
            PG8_BAR; PG8_WAIT_L(0); PG8_MMA(0, 1, At, B1); PG8_BAR;
            PG8_LDA(At, 1, 1); PG8_STAGE(PG8_SA(1, 0), a3, voffA);
            PG8_BAR; PG8_WAIT_L(0); PG8_MMA(1, 0, At, B0); PG8_BAR; PG8_SCHED;
            PG8_STAGE(PG8_SB(1, 1), b3 + hstep, voffB);
            PG8_WAIT_V(6); PG8_BAR; PG8_MMA(1, 1, At, B1); PG8_BAR;
            }
        }
        if constexpr (ALIGN_EPI) { if (wr == 0) PG8_BAR; }
        if constexpr (!Epi::AFTER_DRAIN) { E(acc, cur, wr, wc, fr, fq); S.done(cur); }
        if (!has_next) break;
#pragma unroll
        for (int a = 0; a < 2; ++a)
#pragma unroll
            for (int b = 0; b < 2; ++b)
#pragma unroll
                for (int m = 0; m < 4; ++m)
#pragma unroll
                    for (int n = 0; n < 2; ++n) acc[a][b][m][n] = (f32x4){0.f, 0.f, 0.f, 0.f};
        cur = nxt; cA = nA; cB = nB; ++ui;
        if constexpr (ALIGN_EPI) { if (wr == 1) PG8_BAR; }
    }
    PG8_WAIT_V(0);
    if constexpr (!ALIGN_EPI) { if (wr == 0) PG8_BAR; }
    PG8_BAR;
    if constexpr (Epi::AFTER_DRAIN) { E.fused(acc, cur, wr, wc, fr, fq, lds, wid, lane); S.done(cur); }
#undef PG8_SA
#undef PG8_SB
#undef PG8_STAGE
#undef PG8_LDA
#undef PG8_LDB
#undef PG8_MMA
#undef PG8_WAIT_V
#undef PG8_WAIT_L
#undef PG8_BAR
#undef PG8_SCHED
}
}

#define LAS __attribute__((address_space(3)))
typedef unsigned short bf16_t;
typedef float f32x4 __attribute__((ext_vector_type(4)));
typedef unsigned u32x4 __attribute__((ext_vector_type(4)));
typedef unsigned u32x2 __attribute__((ext_vector_type(2)));
typedef __bf16 bf16x2_t __attribute__((ext_vector_type(2)));
constexpr int NWAVES = 8, NTHR = 512;
constexpr int D = 1024, NB = 8, SEQ = 4096, LCTX = 256, TX = NB * SEQ, TC = NB * LCTX, TT = TX + TC, INW = 2304, NE = 16, FF = 2048;
constexpr int CAPX = 512, CAPC = 32, SLOTS = NB * CAPX + NB * CAPC;
constexpr float LOG2E = 1.4426950408889634f;
constexpr int LDS_BYTES = 155648;
enum { I_X = 0, I_C, I_CTX, I_CCTX, I_ADAW, I_ADAB, I_N1G, I_N2G, I_WIN, I_HCW, I_HCB, I_HW1, I_HB1, I_HW2, I_HB2, I_HW3, I_HFREQ, I_HSKIP, I_SINK, I_POOLW, I_POOLS, I_RPB, I_WOUT, I_ROUTER, I_WG, I_WU, I_WD, I_FNG, N_IN };
constexpr size_t MiB = 1u << 20;
constexpr size_t WS_CTL = 0;
constexpr size_t WS_MOD = 1 * MiB;
constexpr size_t WS_ROPE = 2 * MiB;
constexpr size_t WS_TW8 = 2 * MiB + 65536;
constexpr size_t WS_WIN_T = 3 * MiB;
constexpr size_t WS_WOUT_T = 13 * MiB;
constexpr size_t WS_HC = 17 * MiB;
constexpr size_t WS_HCC = 51 * MiB;
constexpr size_t WS_AFFT = 53 * MiB;
constexpr size_t WS_ROWMAP = 56 * MiB;
constexpr size_t WS_GATE = 57 * MiB;
constexpr size_t WS_INV = 58 * MiB;
constexpr size_t WS_CRES = 61 * MiB;
constexpr size_t WS_HX = 69 * MiB;
constexpr size_t WS_WGU_T = 137 * MiB;
constexpr size_t WS_WD_T = 393 * MiB;
constexpr size_t WS_R = 521 * MiB;
constexpr size_t WS_ACT = WS_R;
constexpr size_t WS_XG = WS_R + 272 * MiB;
constexpr size_t WS_PX = WS_R;
constexpr size_t WS_Y = WS_R + 153 * MiB;
constexpr size_t WS_UT = WS_XG;
constexpr size_t WS_HS = WS_R + 408 * MiB;
constexpr size_t WS_END = WS_HS + 64 * MiB;
static_assert(WS_END <= 1024 * MiB, "workspace map");

struct Args { const float* in[N_IN]; float* out; unsigned char* ws; };

__device__ __forceinline__ float bf2f(unsigned short v) { return __uint_as_float(((unsigned)v) << 16); }
__device__ __forceinline__ unsigned f2bf(float f) { unsigned u = __float_as_uint(f); return (u + 0x7fffu + ((u >> 16) & 1u)) >> 16; }
__device__ __forceinline__ unsigned pk2(float lo, float hi) { return f2bf(lo) | (f2bf(hi) << 16); }
__device__ __forceinline__ float bflo(unsigned w) { return __uint_as_float(w << 16); }
__device__ __forceinline__ float bfhi(unsigned w) { return __uint_as_float(w & 0xffff0000u); }
__device__ __forceinline__ float dot2bf(unsigned a, unsigned b, float acc) { return __builtin_amdgcn_fdot2_f32_bf16(__builtin_bit_cast(bf16x2_t, a), __builtin_bit_cast(bf16x2_t, b), acc, false); }
__device__ __forceinline__ float wave_sum(float v) {
#pragma unroll
    for (int o = 1; o < 64; o <<= 1) v += __shfl_xor(v, o);
    return v;
}
#define LDS_WAIT() asm volatile("s_waitcnt lgkmcnt(0)" ::: "memory")

#ifndef AMP_PHASE
#define AMP_PHASE -1
#endif
__device__ __forceinline__ unsigned long long amp_now() { asm volatile("s_waitcnt vmcnt(0) lgkmcnt(0)" ::: "memory"); __builtin_amdgcn_sched_barrier(0); const unsigned long long t = __builtin_amdgcn_s_memrealtime(); asm volatile("s_waitcnt lgkmcnt(0)" ::: "memory"); __builtin_amdgcn_sched_barrier(0); return t; }
#define AMP_BEGIN(id) unsigned long long amp_t0_ = 0; if ((id) == AMP_PHASE) { __syncthreads(); amp_t0_ = amp_now(); }
#define AMP_END(id) if ((id) == AMP_PHASE) { __syncthreads(); const unsigned long long t1_ = amp_now(); const unsigned long long d_ = t1_ - amp_t0_; while (amp_now() - t1_ < d_) __builtin_amdgcn_s_sleep(8); __syncthreads(); }
__device__ __forceinline__ void tr_item(const float* W, int K, int N, bf16_t* WT, int Kt, int item, int mode, LAS float* scr, int lane) {
    const int nblk = N / 32, kb = item / nblk, nb = item % nblk, k0 = 64 * kb, n0 = 32 * nb;
    const int r8 = lane >> 3, c4 = lane & 7; f32x4 v[8];
    const float* wp = W + (size_t)(k0 + r8) * N + n0 + 4 * c4;
#pragma unroll
    for (int i = 0; i < 8; ++i) v[i] = *(const f32x4*)(wp + (size_t)(8 * i) * N);
#pragma unroll
    for (int i = 0; i < 8; ++i) { LAS float* d = scr + (r8 + 8 * i) * 33 + 4 * c4; d[0] = v[i][0]; d[1] = v[i][1]; d[2] = v[i][2]; d[3] = v[i][3]; }
    LDS_WAIT();
    const int c = lane & 7;
    const int drow0 = (mode == 0) ? n0 : ((n0 >> 7) * 256 + (n0 & 127) + (mode == 2 ? 128 : 0));
#pragma unroll
    for (int j = 0; j < 4; ++j) { const int n = (lane >> 3) + 8 * j; const LAS float* sp = scr + (8 * c) * 33 + n;
        u32x4 o; o.x = pk2(sp[0 * 33], sp[1 * 33]); o.y = pk2(sp[2 * 33], sp[3 * 33]); o.z = pk2(sp[4 * 33], sp[5 * 33]); o.w = pk2(sp[6 * 33], sp[7 * 33]);
        *(u32x4*)(WT + (size_t)(drow0 + n) * Kt + k0 + 8 * c) = o; }
    LDS_WAIT();
}

__device__ __forceinline__ void filter_item(const Args& a, LAS unsigned char* lds, int item, int tid) {
    asm volatile("" : "+v"(tid));
    const int lane = tid & 63, wave = tid >> 6;
    int l, L, p0; float* HCdst;
    if (item < 128) { l = 0; L = 4096; p0 = item * 32; HCdst = (float*)(a.ws + WS_HC); }
    else if (item < 256) { l = 1; L = 4096; p0 = (item - 128) * 32; HCdst = (float*)(a.ws + WS_HC) + (size_t)2 * 8191 * 256; }
    else { l = 0; L = 256; p0 = (item - 256) * 32; HCdst = (float*)(a.ws + WS_HCC) + 256; }
    LAS float* w1s = (LAS float*)lds; LAS float* w2s = w1s + 33 * 64; LAS float* b1s = w2s + 64 * 64; LAS float* b2s = b1s + 64; LAS float* frs = b2s + 64; LAS float* h2s = frs + 64; LAS float* ex = h2s + 32 * 64;
    { const float* w1 = a.in[I_HW1] + l * 33 * 64; const float* w2 = a.in[I_HW2] + l * 64 * 64;
      for (int i = tid; i < 33 * 64; i += NTHR) w1s[i] = w1[i];
      for (int i = tid; i < 64 * 64; i += NTHR) w2s[i] = w2[i];
      if (tid < 64) { b1s[tid] = a.in[I_HB1][l * 64 + tid]; b2s[tid] = a.in[I_HB2][l * 64 + tid]; frs[tid] = a.in[I_HFREQ][l * 64 + tid]; } }
    __syncthreads();
    const float frq = frs[lane];
#pragma unroll 1
    for (int q = 0; q < 4; ++q) { const int pp = wave * 4 + q, p = p0 + pp; const float tn = (float)p / (float)(L - 1);
        float fv = 0.f;
        if (lane == 0) fv = tn;
        else if (lane <= 32) { const int bi = (lane - 1) & 15; const float band = 1e-4f + (float)bi * ((15.0f - 1e-4f) / 15.0f);
            const float ang = ((float)(6.283185307179586 / (double)L) * (float)p) * band; fv = (lane <= 16) ? cosf(ang) : -sinf(ang); }
        float a1 = b1s[lane];
#pragma unroll
        for (int i = 0; i < 33; ++i) a1 += __shfl(fv, i) * w1s[i * 64 + lane];
        const float h1 = sinf(frq * a1);
        float a2 = b2s[lane];
#pragma unroll 16
        for (int i = 0; i < 64; ++i) a2 += __shfl(h1, i) * w2s[i * 64 + lane];
        h2s[pp * 64 + lane] = sinf(frq * a2); }
    __syncthreads();
    const float* w3 = a.in[I_HW3] + (size_t)l * 64 * 1024 + tid;
    float acc0[32], acc1[32];
#pragma unroll
    for (int pp = 0; pp < 32; ++pp) { acc0[pp] = 0.f; acc1[pp] = 0.f; }
#pragma unroll 4
    for (int i = 0; i < 64; ++i) { const float wa = w3[i * 1024], wb = w3[i * 1024 + 512];
#pragma unroll
        for (int pp = 0; pp < 32; ++pp) { const float h = h2s[pp * 64 + i]; acc0[pp] += h * wa; acc1[pp] += h * wb; } }
    const int c = tid & 255, dir = tid >> 8; const float dmin = 3.0701134573253945f, dmax = 15.350567286626972f; const float delta = dmin + (float)c * ((dmax - dmin) / 255.0f);
    float* base0 = HCdst; float* base1 = HCdst + (size_t)(2 * L - 1) * 256;
#pragma unroll
    for (int pp = 0; pp < 32; ++pp) { const int p = p0 + pp; const float tn = (float)p / (float)(L - 1); const float win = expf(-tn * delta); const float v0 = acc0[pp] * win, v1 = acc1[pp] * win;
        if (p == 0) { ex[tid] = v0; ex[512 + tid] = v1; }
        else { const size_t idx = (size_t)(dir == 0 ? (L - 1 + p) : (L - 1 - p)) * 256 + c; base0[idx] = v0; base1[idx] = v1; } }
    __syncthreads();
    if (p0 == 0 && tid < 256) { const size_t idx = (size_t)(L - 1) * 256 + tid; base0[idx] = ex[tid] + ex[tid + 256]; base1[idx] = ex[512 + tid] + ex[512 + tid + 256]; }
    __syncthreads();
}

__device__ __forceinline__ void phase_prologue(const Args& a, unsigned char* ldsg, int vcu, int G) {
    LAS unsigned char* lds = (LAS unsigned char*)ldsg;
    int tid_ = threadIdx.x; asm volatile("" : "+v"(tid_));
    const int tid = tid_, lane = tid & 63, wave = __builtin_amdgcn_readfirstlane(tid >> 6);
    unsigned char* ws = a.ws;
    LAS float* sc = (LAS float*)lds; LAS float* red = (LAS float*)(lds + 36864);
    for (int i = tid; i < 9 * 1024; i += NTHR) { const float v = (i < 8192) ? a.in[I_C][i] : a.in[I_CCTX][i - 8192]; sc[i] = v / (1.0f + expf(-v)); }
    __syncthreads();
    { AMP_BEGIN(41)
    float* MOD = (float*)(ws + WS_MOD);
    for (int item = vcu; item < 2 * 96; item += G) {
        const int l = item / 96, n0 = (item % 96) * 64, col = tid & 63, kg = tid >> 6;
        float acc[9];
#pragma unroll
        for (int r = 0; r < 9; ++r) acc[r] = 0.f;
        const float* w = a.in[I_ADAW] + (size_t)l * 1024 * 6144 + n0 + col;
#pragma unroll 4
        for (int k = kg * 128; k < kg * 128 + 128; ++k) { const float wv = w[(size_t)k * 6144];
#pragma unroll
            for (int r = 0; r < 9; ++r) acc[r] += sc[r * 1024 + k] * wv; }
#pragma unroll
        for (int r = 0; r < 9; ++r) red[(kg * 9 + r) * 64 + col] = acc[r];
        __syncthreads();
        for (int o = tid; o < 9 * 64; o += NTHR) { const int r = o >> 6, cc = o & 63; float s = 0.f;
#pragma unroll
            for (int g2 = 0; g2 < 8; ++g2) s += red[(g2 * 9 + r) * 64 + cc];
            MOD[(size_t)(l * 9 + r) * 6144 + n0 + cc] = s + a.in[I_ADAB][l * 6144 + n0 + cc]; }
        __syncthreads();
    }
    AMP_END(41) }
    if (vcu == 0) { float* ROPE = (float*)(ws + WS_ROPE);
        for (int i = tid; i < 1024; i += NTHR) { const int pos = i >> 4, fi = i & 15; const float inv = powf(10000.0f, -(float)fi / 16.0f); const float ang = (float)pos * inv;
            ROPE[2 * i] = cosf(ang); ROPE[2 * i + 1] = sinf(ang); } }
    if (vcu == 1 % G) { float* TW8 = (float*)(ws + WS_TW8);
        for (int i = tid; i < 8192; i += NTHR) { float sn, cs; sincospif(-(float)i * (1.0f / 4096.0f), &sn, &cs); TW8[2 * i] = cs; TW8[2 * i + 1] = sn; } }
    const int gw = vcu * NWAVES + wave, NGW = G * NWAVES;
    { AMP_BEGIN(42)
    for (int it = vcu; it < 264; it += G) filter_item(a, lds, it, tid);
    AMP_END(42) }
    { AMP_BEGIN(43)
    LAS float* scr = (LAS float*)(lds + 65536 + wave * 8448);
    constexpr int IT_IN = 16 * 72, IT_OUT = 16 * 32, IT_E = 1024, IT_LAYER = IT_IN + IT_OUT + 3 * 16 * IT_E;
    for (int it = gw; it < 2 * IT_LAYER; it += NGW) {
        const int l = it / IT_LAYER; int r = it % IT_LAYER;
        if (r < IT_IN) { tr_item(a.in[I_WIN] + (size_t)l * 1024 * 2304, 1024, 2304, (bf16_t*)(ws + WS_WIN_T) + (size_t)l * 2304 * 1024, 1024, r, 0, scr, lane); continue; } r -= IT_IN;
        if (r < IT_OUT) { tr_item(a.in[I_WOUT] + (size_t)l * 1024 * 1024, 1024, 1024, (bf16_t*)(ws + WS_WOUT_T) + (size_t)l * 1024 * 1024, 1024, r, 0, scr, lane); continue; } r -= IT_OUT;
        const int which = r / (16 * IT_E), e = (r / IT_E) & 15, ri = r % IT_E; const size_t le = (size_t)l * 16 + e;
        if (which == 0) tr_item(a.in[I_WG] + le * 1024 * 2048, 1024, 2048, (bf16_t*)(ws + WS_WGU_T) + le * 4096 * 1024, 1024, ri, 1, scr, lane);
        else if (which == 1) tr_item(a.in[I_WU] + le * 1024 * 2048, 1024, 2048, (bf16_t*)(ws + WS_WGU_T) + le * 4096 * 1024, 1024, ri, 2, scr, lane);
        else tr_item(a.in[I_WD] + le * 2048 * 1024, 2048, 1024, (bf16_t*)(ws + WS_WD_T) + le * 1024 * 2048, 2048, ri, 0, scr, lane);
    }
    AMP_END(43) }
}

__device__ __forceinline__ void phase_norm(const Args& a, unsigned char* ldsg, int vcu, int G, int l, const float* srcx, const float* srcc, const float* gain, int shift_idx, int nrows, bool router) {
    int tid_ = threadIdx.x; asm volatile("" : "+v"(tid_));
    const int tid = tid_, lane = tid & 63, wave = __builtin_amdgcn_readfirstlane(tid >> 6);
    unsigned char* ws = a.ws; const float* MOD = (const float*)(ws + WS_MOD) + (size_t)l * 9 * 6144; bf16_t* HX = (bf16_t*)(ws + WS_HX);
    LAS float* rw = (LAS float*)(LAS unsigned char*)ldsg;
    if (router) { const float* rsrc = a.in[I_ROUTER] + (size_t)l * 1024 * 16; for (int i = tid; i < 1024 * 16; i += NTHR) rw[(i & 15) * 1024 + (i >> 4)] = rsrc[i]; __syncthreads(); }
    const int gw = vcu * NWAVES + wave, NGW = G * NWAVES;
    for (int row = gw; row < nrows; row += NGW) {
        const bool lat = row < TX; const float* xr = lat ? srcx + (size_t)row * D : srcc + (size_t)(row - TX) * D; const int mrow = lat ? (row >> 12) : 8;
        const float* shp = MOD + mrow * 6144 + shift_idx * 1024; const float* scp = shp + 1024;
        f32x4 v[4]; float ss = 0.f;
#pragma unroll
        for (int j = 0; j < 4; ++j) { v[j] = *(const f32x4*)(xr + 256 * j + 4 * lane); ss += (v[j][0] * v[j][0] + v[j][1] * v[j][1]) + (v[j][2] * v[j][2] + v[j][3] * v[j][3]); }
        const float rstd = 1.0f / sqrtf(wave_sum(ss) * (1.0f / D) + 1e-6f);
#pragma unroll
        for (int j = 0; j < 4; ++j) { const f32x4 gg = *(const f32x4*)(gain + 256 * j + 4 * lane), sh = *(const f32x4*)(shp + 256 * j + 4 * lane), sc = *(const f32x4*)(scp + 256 * j + 4 * lane);
            v[j] = (v[j] * rstd * gg) * (1.0f + sc) + sh;
            u32x2 o; o.x = pk2(v[j][0], v[j][1]); o.y = pk2(v[j][2], v[j][3]); *(u32x2*)(HX + (size_t)row * D + 256 * j + 4 * lane) = o; }
        if (router) {
            float mylog = -1e30f;
#pragma unroll 1
            for (int e = 0; e < 16; ++e) { float p = 0.f;
#pragma unroll
                for (int j = 0; j < 4; ++j) { const f32x4 wv = *(const LAS f32x4*)(rw + e * 1024 + 256 * j + 4 * lane);
                    p += (v[j][0] * wv[0] + v[j][1] * wv[1]) + (v[j][2] * wv[2] + v[j][3] * wv[3]); }
                p = wave_sum(p); mylog = (lane == e) ? p : mylog; }
            float mx = mylog;
#pragma unroll
            for (int o = 1; o < 16; o <<= 1) mx = fmaxf(mx, __shfl_xor(mx, o));
            const float mine = (lane < 16) ? expf(mylog - mx) : 0.f; float den = mine;
#pragma unroll
            for (int o = 1; o < 16; o <<= 1) den += __shfl_xor(den, o);
            if (lane < 16) { ((float*)(ws + WS_AFFT))[(size_t)lane * TT + row] = mine / den; ((int*)(ws + WS_INV))[(size_t)row * 16 + lane] = -1; }
        }
    }
}

#define XB_TMO      128
#define XB_XCNT(j)  (256  + 64 * (j))
#define XB_XSUB(j)  (1280 + 64 * (j))
#define XB_XGEN(j)  (2304 + 64 * (j))
#define XB_TOP      3328
#define XB_TOPGEN   3392
#define XCD_BAR_WORDS 3456
#define XB_SPIN_CAP (1u << 18)

__device__ __forceinline__ unsigned xb_ld(unsigned* p)              { return __hip_atomic_load(p, __ATOMIC_RELAXED, __HIP_MEMORY_SCOPE_AGENT); }
__device__ __forceinline__ unsigned xb_add(unsigned* p, unsigned v) { return __hip_atomic_fetch_add(p, v, __ATOMIC_RELAXED, __HIP_MEMORY_SCOPE_AGENT); }
__device__ __forceinline__ unsigned xb_xcc_id() { return (unsigned)__builtin_amdgcn_s_getreg((3 << 11) | 20) & 0xFu; }
#define XB_SPIN(cond, bar) do { unsigned _sp = 0; while (cond) { __builtin_amdgcn_s_sleep(1); \
    if ((++_sp & 255u) == 0u) { if (xb_ld(&(bar)[XB_TMO])) break; if (_sp > XB_SPIN_CAP) { atomicAdd(&(bar)[XB_TMO], 1u); break; } } } } while (0)

struct XcdBarrier {
    unsigned* bar; unsigned x;
    volatile LAS unsigned* st;
};

__device__ __forceinline__ XcdBarrier xcd_barrier_post(unsigned* bar, volatile LAS unsigned* st) {
    XcdBarrier b; b.bar = bar; b.x = xb_xcc_id(); b.st = st;
    if (threadIdx.x == 0) (void)xb_add(&bar[XB_XCNT(b.x)], 1u);
    return b;
}
__device__ __forceinline__ void xcd_barrier_complete(unsigned* bar, unsigned x, unsigned& nloc, unsigned& nx) {
    const unsigned G = gridDim.x * gridDim.y * gridDim.z;
    unsigned sum, cnt, mine, sp = 0u;
    for (;;) {
        sum = 0u; cnt = 0u; mine = 0u;
#pragma unroll
        for (unsigned j = 0; j < 16; ++j) { const unsigned c = xb_ld(&bar[XB_XCNT(j)]); sum += c; cnt += (c > 0u) ? 1u : 0u; mine = (j == x) ? c : mine; }
        if (sum == G) break;
        __builtin_amdgcn_s_sleep(1);
        if ((++sp & 255u) == 0u) { if (xb_ld(&bar[XB_TMO])) break; if (sp > XB_SPIN_CAP) { atomicAdd(&bar[XB_TMO], 1u); break; } }
    }
    nloc = mine > 0u ? mine : 1u; nx = cnt > 0u ? cnt : 1u;
}

__device__ __forceinline__ void xcd_barrier(const XcdBarrier& b) {
    asm volatile("s_waitcnt vmcnt(0)" ::: "memory");
    __syncthreads();
    if (threadIdx.x == 0) {
        unsigned* bar = b.bar;
        __builtin_amdgcn_s_waitcnt(0);
        unsigned nloc = b.st[0], nx = b.st[1];
        if (nloc == 0u) { xcd_barrier_complete(bar, b.x, nloc, nx); b.st[0] = nloc; b.st[1] = nx; }
        const unsigned old = xb_add(&bar[XB_XSUB(b.x)], 1u);
        const unsigned gen = old / nloc;
        if (old + 1u == (gen + 1u) * nloc) {
            __builtin_amdgcn_fence(__ATOMIC_RELEASE, "agent");
            asm volatile("s_waitcnt vmcnt(0)" ::: "memory");
            const unsigned og = xb_add(&bar[XB_TOP], 1u);
            const unsigned tg = og / nx;
            if (og + 1u == (tg + 1u) * nx) xb_add(&bar[XB_TOPGEN], 1u);
            else XB_SPIN(xb_ld(&bar[XB_TOPGEN]) == tg, bar);
            __builtin_amdgcn_fence(__ATOMIC_ACQUIRE, "agent");
            xb_add(&bar[XB_XGEN(b.x)], 1u);
            asm volatile("s_waitcnt vmcnt(0)" ::: "memory");
        } else {
            XB_SPIN(xb_ld(&bar[XB_XGEN(b.x)]) == gen, bar);
            __builtin_amdgcn_fence(__ATOMIC_ACQUIRE, "agent");
            asm volatile("s_waitcnt vmcnt(0)" ::: "memory");
        }
    }
    __syncthreads();
}


typedef float f32x2 __attribute__((ext_vector_type(2)));
__device__ __forceinline__ f32x2 cmul(f32x2 a, f32x2 b) { return (f32x2){a.x * b.x - a.y * b.y, a.x * b.y + a.y * b.x}; }
__device__ __forceinline__ void dft16(f32x2 (&v)[16]) {
    constexpr float WC[8] = {1.0f, 0.92387953251128674f, 0.70710678118654752f, 0.38268343236508977f, 0.0f, -0.38268343236508977f, -0.70710678118654752f, -0.92387953251128674f};
    constexpr float WS[8] = {0.0f, -0.38268343236508977f, -0.70710678118654752f, -0.92387953251128674f, -1.0f, -0.92387953251128674f, -0.70710678118654752f, -0.38268343236508977f};
#pragma unroll
    for (int s = 8; s >= 1; s >>= 1)
#pragma unroll
        for (int i = 0; i < 16; ++i) if ((i & s) == 0) { const int k = (i & (s - 1)) * (8 / s); const f32x2 u = v[i], t = v[i + s]; v[i] = u + t; const f32x2 d = u - t;
            v[i + s] = (k == 0) ? d : ((k == 4) ? (f32x2){d.y, -d.x} : (f32x2){d.x * WC[k] - d.y * WS[k], d.x * WS[k] + d.y * WC[k]}); }
}
__device__ __forceinline__ constexpr int bitrev4(int i) { return ((i & 1) << 3) | ((i & 2) << 1) | ((i & 4) >> 1) | ((i & 8) >> 3); }
template <int NS, int MODE>
__device__ __forceinline__ void fft_pass(LAS f32x2* Z, const LAS f32x2* TW, int tid, const f32x2* H) {
    const int f = tid >> 8, j = tid & 255, base = f * 4096, k = j & (NS - 1);
    f32x2 v[16];
#pragma unroll
    for (int r = 0; r < 16; ++r) { const int idx = base + j + 256 * r; v[r] = Z[idx + (idx >> 4)]; }
    if (MODE == 1) {
#pragma unroll
        for (int r = 0; r < 16; ++r) { const f32x2 p = cmul(v[r], H[r]); v[r] = (f32x2){p.y, p.x}; } }
    if (NS > 1) { const LAS f32x2* tp = (NS == 16) ? (TW + 8192 + k) : (TW + 4096 + k);
#pragma unroll
        for (int r = 1; r < 16; ++r) v[r] = cmul(v[r], tp[r * NS]); }
    dft16(v);
    __syncthreads();
    const int j0 = base + (j / NS) * NS * 16 + k;
#pragma unroll
    for (int rr = 0; rr < 16; ++rr) { const int idx = j0 + rr * NS; Z[idx + (idx >> 4)] = v[bitrev4(rr)]; }
    __syncthreads();
}
__device__ __forceinline__ void load_uc(const bf16_t* UT, const float* cw, const float* cb, int ch, int b, int tid, float (&out)[8]) {
    const bf16_t* p = UT + ((size_t)(b * 768 + ch)) * 4096 + 8 * tid;
    const u32x4 w = *(const u32x4*)p; float u[10];
    u[1] = bflo(w.x); u[2] = bfhi(w.x); u[3] = bflo(w.y); u[4] = bfhi(w.y); u[5] = bflo(w.z); u[6] = bfhi(w.z); u[7] = bflo(w.w); u[8] = bfhi(w.w);
    u[0] = (tid > 0) ? bf2f(p[-1]) : 0.f; u[9] = (tid < 511) ? bf2f(p[8]) : 0.f;
    const float w0 = cw[ch], w1 = cw[768 + ch], w2 = cw[1536 + ch], bb = cb[ch];
#pragma unroll
    for (int i = 0; i < 8; ++i) out[i] = u[i] * w0 + u[i + 1] * w1 + u[i + 2] * w2 + bb;
}
__device__ __forceinline__ void hy_fill(LAS f32x2* Z, const LAS f32x2* TW, int tid, const float (&va)[8], const float (&vb)[8]) {
#pragma unroll
    for (int i = 0; i < 8; ++i) { const int t = 8 * tid + i; const f32x2 z = {va[i], vb[i]}; Z[t + (t >> 4)] = z; const int t2 = 4096 + t; Z[t2 + (t2 >> 4)] = cmul(z, TW[t]); }
    __syncthreads();
}
__device__ __forceinline__ void hy_conv(LAS f32x2* Z, const LAS f32x2* TW, int tid, const f32x2* Hg) {
    f32x2 H[16];
    { const int f = tid >> 8, j = tid & 255, base = f * 4096;
#pragma unroll
      for (int r = 0; r < 16; ++r) H[r] = Hg[base + j + 256 * r]; }
    fft_pass<1, 0>(Z, TW, tid, nullptr); fft_pass<16, 0>(Z, TW, tid, nullptr); fft_pass<256, 0>(Z, TW, tid, nullptr);
    fft_pass<1, 1>(Z, TW, tid, H); fft_pass<16, 0>(Z, TW, tid, nullptr); fft_pass<256, 0>(Z, TW, tid, nullptr);
}
__device__ __forceinline__ f32x2 hy_out(const LAS f32x2* Z, const LAS f32x2* TW, int t) {
    const f32x2 se = Z[t + (t >> 4)]; const int t2 = 4096 + t; const f32x2 so = Z[t2 + (t2 >> 4)]; const f32x2 tw = TW[t];
    const f32x2 So = {so.y, so.x};
    return (f32x2){se.y + (So.x * tw.x + So.y * tw.y), se.x + (So.y * tw.x - So.x * tw.y)};
}
__device__ __forceinline__ void hyena_item(const Args& a, LAS unsigned char* lds, int l, int c, int bp, int tid) {
    asm volatile("" : "+v"(tid));
    LAS f32x2* Z = (LAS f32x2*)lds; const LAS f32x2* TW = (const LAS f32x2*)(lds + 69632);
    const bf16_t* UT = (const bf16_t*)(a.ws + WS_UT); bf16_t* Y = (bf16_t*)(a.ws + WS_Y);
    const float* cw = a.in[I_HCW] + (size_t)l * 3 * 768; const float* cb = a.in[I_HCB] + (size_t)l * 768; const float* skip = a.in[I_HSKIP] + (size_t)l * 2 * 256;
    const f32x2* HS = (const f32x2*)(a.ws + WS_HS) + ((size_t)(l * 2) * 256 + c) * 8192;
    const int b0 = 2 * bp, b1 = 2 * bp + 1;
    float va[8], vb[8], xa[8], xb[8];
    load_uc(UT, cw, cb, c, b0, tid, va); load_uc(UT, cw, cb, c, b1, tid, vb);
    hy_fill(Z, TW, tid, va, vb);
    hy_conv(Z, TW, tid, HS);
    load_uc(UT, cw, cb, 256 + c, b0, tid, xa); load_uc(UT, cw, cb, 256 + c, b1, tid, xb);
    { const float sk = skip[c];
#pragma unroll
      for (int i = 0; i < 8; ++i) { const f32x2 y = hy_out(Z, TW, 8 * tid + i); va[i] = xa[i] * (y.x + va[i] * sk); vb[i] = xb[i] * (y.y + vb[i] * sk); } }
    __syncthreads();
    hy_fill(Z, TW, tid, va, vb);
    hy_conv(Z, TW, tid, HS + (size_t)256 * 8192);
    load_uc(UT, cw, cb, 512 + c, b0, tid, xa); load_uc(UT, cw, cb, 512 + c, b1, tid, xb);
    { const float sk = skip[256 + c];
#pragma unroll
      for (int i = 0; i < 8; ++i) { const int t = 8 * tid + i; const f32x2 y = hy_out(Z, TW, t);
          Y[((size_t)b0 * 4096 + t) * D + c] = (bf16_t)f2bf(xa[i] * (y.x + va[i] * sk)); Y[((size_t)b1 * 4096 + t) * D + c] = (bf16_t)f2bf(xb[i] * (y.y + vb[i] * sk)); } }
    __syncthreads();
}
__device__ __forceinline__ void spectrum_item(const Args& a, LAS unsigned char* lds, int item, int tid) {
    asm volatile("" : "+v"(tid));
    LAS f32x2* Z = (LAS f32x2*)lds; const LAS f32x2* TW = (const LAS f32x2*)(lds + 69632);
    const int c = item & 255, lo = item >> 8;
    const float* HC = (const float*)(a.ws + WS_HC) + (size_t)lo * 8191 * 256 + c;
#pragma unroll
    for (int i = 0; i < 8; ++i) { const int t = 8 * tid + i; const float hl = HC[(size_t)(4095 + t) * 256], hh = (t == 0) ? 0.f : HC[(size_t)(t - 1) * 256];
        Z[t + (t >> 4)] = (f32x2){hl + hh, 0.f}; const int t2 = 4096 + t; const f32x2 tw = TW[t]; const float dd = hl - hh; Z[t2 + (t2 >> 4)] = (f32x2){dd * tw.x, dd * tw.y}; }
    __syncthreads();
    fft_pass<1, 0>(Z, TW, tid, nullptr); fft_pass<16, 0>(Z, TW, tid, nullptr); fft_pass<256, 0>(Z, TW, tid, nullptr);
    f32x2* HS = (f32x2*)(a.ws + WS_HS) + (size_t)item * 8192;
#pragma unroll
    for (int i = 0; i < 16; ++i) { const int idx = tid + 512 * i; HS[idx] = Z[idx + (idx >> 4)] * (1.0f / 8192.0f); }
    __syncthreads();
}
__device__ __forceinline__ void load_tw(const Args& a, LAS unsigned char* lds, int tid) {
    asm volatile("" : "+v"(tid));
    LAS f32x2* TW = (LAS f32x2*)(lds + 69632); const f32x2* src = (const f32x2*)(a.ws + WS_TW8);
    for (int i = tid; i < 4096; i += NTHR) { TW[i] = src[i]; const int r = i >> 8, k = i & 255; TW[4096 + i] = src[r * k * 2]; }
    if (tid < 256) { const int r = tid >> 4, k = tid & 15; TW[8192 + tid] = src[r * k * 32]; }
    __syncthreads();
}
__device__ __forceinline__ float ctx_uc(const bf16_t* PXc, const float* cw, const float* cb, int ch, int t) {
    const float u1 = bf2f(PXc[(size_t)t * INW + ch]); const float u0 = (t > 0) ? bf2f(PXc[(size_t)(t - 1) * INW + ch]) : 0.f; const float u2 = (t < 255) ? bf2f(PXc[(size_t)(t + 1) * INW + ch]) : 0.f;
    return u0 * cw[ch] + u1 * cw[768 + ch] + u2 * cw[1536 + ch] + cb[ch];
}
__device__ __forceinline__ void ctx_conv16(const LAS float* IN, const float* H, int c, int lane, int t0, float (&acc)[16]) {
    float w[16];
    const float* hp = H + (size_t)(t0 + 255) * 256 + c;
#pragma unroll
    for (int i = 0; i < 16; ++i) { acc[i] = 0.f; w[i] = hp[i * 256]; }
    const LAS float* ip = IN + lane;
#pragma unroll 1
    for (int s0 = 0; s0 < 256; s0 += 16) {
#pragma unroll
        for (int u = 0; u < 16; ++u) { const float v = ip[u * 64];
#pragma unroll
            for (int i = 0; i < 16; ++i) acc[i] += v * w[(i - u + 16) & 15];
            w[(15 - u) & 15] = hp[-(u + 1) * 256]; }
        hp -= 16 * 256; ip += 16 * 64; }
}
__device__ __forceinline__ void ctx_hyena_item(const Args& a, LAS unsigned char* lds, int l, int item, int tid) {
    asm volatile("" : "+v"(tid));
    const int lane = tid & 63, wave = tid >> 6, b = item >> 2, c = (item & 3) * 64 + lane;
    LAS float* V = (LAS float*)lds; LAS float* Z1 = (LAS float*)(lds + 65536);
    const bf16_t* PXc = (const bf16_t*)(a.ws + WS_PX) + (size_t)(TX + b * 256) * INW; bf16_t* Y = (bf16_t*)(a.ws + WS_Y) + (size_t)(TX + b * 256) * D;
    const float* cw = a.in[I_HCW] + (size_t)l * 3 * 768; const float* cb = a.in[I_HCB] + (size_t)l * 768; const float* skip = a.in[I_HSKIP] + (size_t)l * 2 * 256;
    const float* H0 = (const float*)(a.ws + WS_HCC) + 256, *H1 = H0 + (size_t)511 * 256;
#pragma unroll 2
    for (int i = 0; i < 32; ++i) { const int t = wave * 32 + i; V[t * 64 + lane] = ctx_uc(PXc, cw, cb, c, t); }
    __syncthreads();
    float acc[16];
#pragma unroll 1
    for (int g = 0; g < 2; ++g) { const int t0 = wave * 32 + g * 16; ctx_conv16(V, H0, c, lane, t0, acc); const float sk = skip[c];
#pragma unroll
        for (int i = 0; i < 16; ++i) { const int t = t0 + i; Z1[t * 64 + lane] = ctx_uc(PXc, cw, cb, 256 + c, t) * (acc[i] + V[t * 64 + lane] * sk); } }
    __syncthreads();
#pragma unroll 1
    for (int g = 0; g < 2; ++g) { const int t0 = wave * 32 + g * 16; ctx_conv16(Z1, H1, c, lane, t0, acc); const float sk = skip[256 + c];
#pragma unroll
        for (int i = 0; i < 16; ++i) { const int t = t0 + i; Y[(size_t)t * D + c] = (bf16_t)f2bf(ctx_uc(PXc, cw, cb, 512 + c, t) * (acc[i] + Z1[t * 64 + lane] * sk)); } }
    __syncthreads();
}

typedef short bf16x8_t __attribute__((ext_vector_type(8)));
typedef short s16x4_t __attribute__((ext_vector_type(4)));
typedef float f32x16 __attribute__((ext_vector_type(16)));
__device__ __forceinline__ int crow(int r, int hi) { return (r & 3) + 8 * (r >> 2) + 4 * hi; }
__device__ __forceinline__ unsigned cvtpk(float lo, float hi) { f32x2 v = {lo, hi}; bf16x2_t b = __builtin_convertvector(v, bf16x2_t); return __builtin_bit_cast(unsigned, b); }
__device__ __forceinline__ s16x4_t vtr(const LAS unsigned char* p) { return __builtin_bit_cast(s16x4_t, __builtin_amdgcn_ds_read_tr16_b64_v4i16((LAS s16x4_t*)p)); }
constexpr int AT_K = 0, AT_V = 16384, AT_WSF = 32768, AT_OST = 34816, AT_RPB = 67584, AT_END = 69632;
template <int KIND>
__device__ __forceinline__ void attn_unit(const Args& a, LAS unsigned char* lds, int l, int u, int tid) {
    asm volatile("" : "+v"(tid));
    const int lane = tid & 63, wid = __builtin_amdgcn_readfirstlane(tid >> 6), r32 = lane & 31, hi = lane >> 5;
    const bf16_t* PX = (const bf16_t*)(a.ws + WS_PX); bf16_t* Y = (bf16_t*)(a.ws + WS_Y);
    int b, qcol, kcol, vcol, ycol, qrow0, nloc = 0, lo = 0; bool sink = false; int hsink = 0;
    int qpos0 = 0, blk = 0, rq = 0, cbase = 0, rq4 = 0;
    if (KIND == 0) { b = u >> 6; const int kvh = (u >> 5) & 1; blk = u & 31; const int h = 2 * kvh + (wid >> 2); qpos0 = blk * 128 + 32 * (wid & 3); qrow0 = b * 4096 + qpos0;
        qcol = 1024 + h * 64; kcol = 1536 + kvh * 64; vcol = 1664 + kvh * 64; ycol = 256 + h * 64; lo = (blk == 0) ? 2 : 0; nloc = ((blk == 31) ? 3 : 5) - lo + 1; sink = true; hsink = h; }
    else if (KIND == 1) { b = u >> 6; const int h = (u >> 4) & 3; rq4 = u & 15; rq = 4 * rq4 + (wid >> 1); cbase = 32 * (wid & 1); qrow0 = b * 4096 + rq * 64 + cbase;
        qcol = 1280 + h * 64; kcol = 1792 + h * 64; vcol = 2048 + h * 64; ycol = 768 + h * 64;
        const int ra = 4 * rq4 - 4, rb = 4 * rq4 + 3 - 4; lo = ra < 0 ? 0 : (ra > 56 ? 56 : ra); const int hi_r = (rb < 0 ? 0 : (rb > 56 ? 56 : rb)) + 7; nloc = hi_r - lo + 1;
        LAS float* rpbL = (LAS float*)(lds + AT_RPB); const float* src = a.in[I_RPB] + (size_t)(l * 4 + h) * 465;
        for (int i = tid; i < 465; i += NTHR) rpbL[i] = src[i] * LOG2E; }
    else { b = u >> 3; const int h = (u >> 1) & 3; qrow0 = TX + b * 256 + 32 * wid;
        if ((u & 1) == 0) { qcol = 1024 + h * 64; kcol = 1536 + (h >> 1) * 64; vcol = 1664 + (h >> 1) * 64; ycol = 256 + h * 64; sink = true; hsink = h; }
        else { qcol = 1280 + h * 64; kcol = 1792 + h * 64; vcol = 2048 + h * 64; ycol = 768 + h * 64; } }
    const int NT = nloc + 4;
    bf16x8_t qr[4];
    { const bf16_t* qp = PX + (size_t)(qrow0 + r32) * INW + qcol + hi * 8;
#pragma unroll
      for (int d0 = 0; d0 < 4; ++d0) qr[d0] = *(const bf16x8_t*)(qp + d0 * 16); }
    const int krow = 8 * wid + (lane & 7), kchunk = lane >> 3; const int vrow = 16 * (wid & 3) + (lane >> 2), vcoff = (wid >> 2) * 32 + (lane & 3) * 8;
    const int kdst = AT_K + kchunk * 1024 + krow * 16, vdst = AT_V + wid * 1024 + lane * 16;
    auto tile_row0 = [&](int t) -> int { if (t < nloc) { if (KIND == 0) return b * 4096 + blk * 128 - 128 + 64 * (lo + t); else return b * 4096 + (lo + t) * 64; } return TX + b * 256 + 64 * (t - nloc); };
    u32x4 gk, gv;
    { const int R0 = tile_row0(0); gk = *(const u32x4*)(PX + (size_t)(R0 + krow) * INW + kcol + kchunk * 8); gv = *(const u32x4*)(PX + (size_t)(R0 + vrow) * INW + vcol + vcoff); }
    *(LAS u32x4*)(lds + kdst) = gk; *(LAS u32x4*)(lds + vdst) = gv;
    float mhat = -1e30f, l_reg = 0.f; f32x16 o[2];
#pragma unroll
    for (int r = 0; r < 16; ++r) { o[0][r] = 0.f; o[1][r] = 0.f; }
    LAS float* wsf = (LAS float*)(lds + AT_WSF) + wid * 64;
    const LAS unsigned char* vb0 = lds + AT_V + ((lane >> 4) & 1) * 32 + (lane & 3) * 8 + (4 * hi + ((lane & 15) >> 2)) * 64;
    const LAS unsigned char* kb0 = lds + AT_K + hi * 1024 + r32 * 16;
    __syncthreads();
    for (int t = 0; t < NT; ++t) {
        const int bufo = (t & 1) * 8192;
        if (t + 1 < NT) { const int R0 = tile_row0(t + 1); gk = *(const u32x4*)(PX + (size_t)(R0 + krow) * INW + kcol + kchunk * 8); gv = *(const u32x4*)(PX + (size_t)(R0 + vrow) * INW + vcol + vcoff); }
        bool need = true; bool full = true; int ts = 0, rk = 0;
        if (t < nloc) {
            if (KIND == 0) { ts = blk * 128 - 128 + 64 * (lo + t); need = (ts + 63 >= qpos0 - 128) && (ts <= qpos0 + 31 + 128); full = (qpos0 + 31 - ts <= 128) && (ts + 63 - qpos0 <= 128); }
            if (KIND == 1) { rk = lo + t; const int r0 = (rq - 4) < 0 ? 0 : ((rq - 4) > 56 ? 56 : (rq - 4)); need = (rk >= r0) && (rk <= r0 + 7); full = false; }
        }
        if (need) {
            f32x16 p0, p1;
#pragma unroll
            for (int r = 0; r < 16; ++r) { p0[r] = 0.f; p1[r] = 0.f; }
            const LAS unsigned char* kb = kb0 + bufo;
#pragma unroll
            for (int d0 = 0; d0 < 4; ++d0) { const bf16x8_t k0 = *(const LAS bf16x8_t*)(kb + d0 * 2048), k1 = *(const LAS bf16x8_t*)(kb + d0 * 2048 + 512);
                p0 = __builtin_amdgcn_mfma_f32_32x32x16_bf16(k0, qr[d0], p0, 0, 0, 0); p1 = __builtin_amdgcn_mfma_f32_32x32x16_bf16(k1, qr[d0], p1, 0, 0, 0); }
            constexpr float C2 = 0.125f * LOG2E;
#pragma unroll
            for (int r = 0; r < 16; ++r) { p0[r] *= C2; p1[r] *= C2; }
            if (!full) {
                if (KIND == 0) { const int tq = qpos0 + r32;
#pragma unroll
                    for (int r = 0; r < 16; ++r) { const int k0 = ts + crow(r, hi), d0 = tq - k0, d1 = d0 - 32; if (d0 > 128 || d0 < -128) p0[r] = -1e30f; if (d1 > 128 || d1 < -128) p1[r] = -1e30f; } }
                if (KIND == 1) { const int c = cbase + r32; const int wsc = (c - 8) < 0 ? 0 : ((c - 8) > 48 ? 48 : (c - 8)); const LAS float* rp = (const LAS float*)(lds + AT_RPB) + (rk - rq + 7) * 31 + 15 - c;
#pragma unroll
                    for (int r = 0; r < 16; ++r) { const int c0 = crow(r, hi), c1 = c0 + 32; const bool ok0 = (c0 >= wsc) && (c0 < wsc + 16), ok1 = (c1 >= wsc) && (c1 < wsc + 16);
                        p0[r] = ok0 ? p0[r] + rp[ok0 ? c0 : c] : -1e30f; p1[r] = ok1 ? p1[r] + rp[ok1 ? c1 : c] : -1e30f; } }
            }
            float rm = fmaxf(p0[0], p1[0]);
#pragma unroll
            for (int r = 1; r < 16; ++r) rm = fmaxf(rm, fmaxf(p0[r], p1[r]));
            { auto rr = __builtin_amdgcn_permlane32_swap(__float_as_uint(rm), __float_as_uint(rm), false, false); rm = fmaxf(__uint_as_float(rr[0]), __uint_as_float(rr[1])); }
            const float mnew = fmaxf(mhat, rm); const float f = __builtin_amdgcn_exp2f(mhat - mnew); const bool grew = mnew > mhat; mhat = mnew;
            float sacc = 0.f;
#pragma unroll
            for (int r = 0; r < 16; ++r) { p0[r] = (p0[r] > -1e29f) ? __builtin_amdgcn_exp2f(p0[r] - mnew) : 0.f; p1[r] = (p1[r] > -1e29f) ? __builtin_amdgcn_exp2f(p1[r] - mnew) : 0.f; sacc += p0[r] + p1[r]; }
            l_reg = l_reg * f + sacc;
            if (__any(grew)) { if (hi == 0) wsf[r32] = f; LDS_WAIT();
#pragma unroll
                for (int r = 0; r < 16; ++r) { const float fr_ = wsf[crow(r, hi)]; o[0][r] *= fr_; o[1][r] *= fr_; }
                LDS_WAIT(); }
            u32x4 pw0, pw1, pw2, pw3;
            pw0 = (u32x4){cvtpk(p0[0], p0[1]), cvtpk(p0[2], p0[3]), cvtpk(p0[4], p0[5]), cvtpk(p0[6], p0[7])}; pw1 = (u32x4){cvtpk(p0[8], p0[9]), cvtpk(p0[10], p0[11]), cvtpk(p0[12], p0[13]), cvtpk(p0[14], p0[15])};
            pw2 = (u32x4){cvtpk(p1[0], p1[1]), cvtpk(p1[2], p1[3]), cvtpk(p1[4], p1[5]), cvtpk(p1[6], p1[7])}; pw3 = (u32x4){cvtpk(p1[8], p1[9]), cvtpk(p1[10], p1[11]), cvtpk(p1[12], p1[13]), cvtpk(p1[14], p1[15])};
            const LAS unsigned char* vb = vb0 + bufo;
#pragma unroll
            for (int d0 = 0; d0 < 2; ++d0) {
#pragma unroll
                for (int ks = 0; ks < 4; ++ks) { const s16x4_t vl = vtr(vb + d0 * 4096 + ks * 1024), vh = vtr(vb + d0 * 4096 + ks * 1024 + 512);
                    const bf16x8_t vf = (bf16x8_t){vl[0], vl[1], vl[2], vl[3], vh[0], vh[1], vh[2], vh[3]};
                    const bf16x8_t pa = __builtin_bit_cast(bf16x8_t, ks == 0 ? pw0 : (ks == 1 ? pw1 : (ks == 2 ? pw2 : pw3)));
                    o[d0] = __builtin_amdgcn_mfma_f32_32x32x16_bf16(pa, vf, o[d0], 0, 0, 0); } }
        }
        if (t + 1 < NT) { const int nb = ((t + 1) & 1) * 8192; *(LAS u32x4*)(lds + kdst + nb) = gk; *(LAS u32x4*)(lds + vdst + nb) = gv; }
        __syncthreads();
    }
    { auto rr = __builtin_amdgcn_permlane32_swap(__float_as_uint(l_reg), __float_as_uint(l_reg), false, false); l_reg = __uint_as_float(rr[0]) + __uint_as_float(rr[1]); }
    if (sink) l_reg += __builtin_amdgcn_exp2f(a.in[I_SINK][l * 4 + hsink] * LOG2E - mhat);
    if (hi == 0) wsf[32 + r32] = 1.0f / l_reg;
    LDS_WAIT();
    LAS bf16_t* stg = (LAS bf16_t*)(lds + AT_OST) + wid * 2048;
#pragma unroll
    for (int r = 0; r < 16; ++r) { const int orow = crow(r, hi); const float il = wsf[32 + orow];
        stg[orow * 64 + r32] = (bf16_t)f2bf(o[0][r] * il); stg[orow * 64 + 32 + r32] = (bf16_t)f2bf(o[1][r] * il); }
    LDS_WAIT();
#pragma unroll
    for (int i = 0; i < 4; ++i) { const int row = i * 8 + (lane >> 3), ch = lane & 7; const u32x4 v = *(const LAS u32x4*)(stg + row * 64 + ch * 8);
        *(u32x4*)(Y + (size_t)(qrow0 + row) * D + ycol + ch * 8) = v; }
    __syncthreads();
}

__device__ __forceinline__ void phase_mix1(const Args& a, unsigned char* ldsg, int vcu, int G, int l) {
    LAS unsigned char* lds = (LAS unsigned char*)ldsg;
    int tid_ = threadIdx.x; asm volatile("" : "+v"(tid_));
    const int tid = tid_, lane = tid & 63, wave = __builtin_amdgcn_readfirstlane(tid >> 6);
    unsigned char* ws = a.ws; const bf16_t* PX = (const bf16_t*)(ws + WS_PX); bf16_t* Y = (bf16_t*)(ws + WS_Y);
    const bool upd = (l == 0); const int nrows = upd ? TT : TX;
    const int gw = vcu * NWAVES + wave, NGW = G * NWAVES;
    { AMP_BEGIN(31) load_tw(a, lds, tid);
    for (int it = vcu; it < 1024; it += G) hyena_item(a, lds, l, it >> 2, it & 3, tid);
    if (upd) for (int it = vcu; it < 32; it += G) ctx_hyena_item(a, lds, l, it, tid);
    __syncthreads(); AMP_END(31) }
    { AMP_BEGIN(32)
    LAS float* pw = (LAS float*)(lds + 73728); LAS float* dv = (LAS float*)(lds + 139264 + wave * 1024);
    { const float* src = a.in[I_POOLW] + (size_t)l * 4 * 64 * 64; for (int i = tid; i < 4 * 64 * 64; i += NTHR) pw[i] = src[i]; }
    __syncthreads();
    const float* pscale = a.in[I_POOLS] + (size_t)l * 256;
    for (int row = gw; row < nrows; row += NGW) {
        const bool lat = row < TX; const int tpos = lat ? (row & 4095) : ((row - TX) & 255); const int Ls = lat ? 4096 : 256;
        const bf16_t* pr = PX + (size_t)row * INW;
        { const int g = lane >> 4, hw = 1 << g;
          const int c = 768 + 4 * lane; float s0 = 0.f, s1 = 0.f, s2 = 0.f, s3 = 0.f; int cnt = 0;
          u32x2 wv[16];
#pragma unroll
          for (int off = -8; off < 8; ++off) { const int tp = tpos + off; const bool inr = (tp >= 0) && (tp < Ls); wv[off + 8] = *(const u32x2*)(pr + (ptrdiff_t)(inr ? off : 0) * INW + c); }
#pragma unroll
          for (int off = -8; off < 8; ++off) { const int tp = tpos + off; const bool in = (off >= -hw) && (off < hw) && (tp >= 0) && (tp < Ls); const u32x2 v = wv[off + 8];
              s0 += in ? bflo(v.x) : 0.f; s1 += in ? bfhi(v.x) : 0.f; s2 += in ? bflo(v.y) : 0.f; s3 += in ? bfhi(v.y) : 0.f; cnt += in ? 1 : 0; }
          const u32x2 u0 = wv[8]; const float ic = 1.0f / (float)cnt;
          f32x4 dd; dd[0] = s0 * ic - bflo(u0.x); dd[1] = s1 * ic - bfhi(u0.x); dd[2] = s2 * ic - bflo(u0.y); dd[3] = s3 * ic - bfhi(u0.y);
          *(LAS f32x4*)(dv + 4 * lane) = dd;
          LDS_WAIT();
          const int j0 = 4 * (lane & 15); f32x4 acc = {0.f, 0.f, 0.f, 0.f};
          const LAS float* dg = dv + g * 64; const LAS float* wg = pw + g * 4096 + j0;
#pragma unroll 8
          for (int i = 0; i < 64; ++i) { const float di = dg[i]; const f32x4 wv = *(const LAS f32x4*)(wg + i * 64); acc += wv * di; }
          const f32x4 sc = *(const f32x4*)(pscale + g * 64 + j0); acc *= sc;
          u32x2 ov; ov.x = pk2(acc[0], acc[1]); ov.y = pk2(acc[2], acc[3]);
          *(u32x2*)(Y + (size_t)row * D + 512 + g * 64 + j0) = ov;
          LDS_WAIT(); }
    }
    __syncthreads(); AMP_END(32) }
    { AMP_BEGIN(33)
    for (int u = vcu; u < 512; u += G) attn_unit<0>(a, lds, l, u, tid);
    for (int u = vcu; u < 512; u += G) attn_unit<1>(a, lds, l, u, tid);
    if (upd) for (int u = vcu; u < 64; u += G) attn_unit<2>(a, lds, l, u, tid);
    AMP_END(33) }
}

__device__ __forceinline__ void phase_select(const Args& a, unsigned char* ldsg, int vcu, int G, bool with_ctx) {
    LAS unsigned long long* arr = (LAS unsigned long long*)(LAS unsigned char*)ldsg;
    int tid_ = threadIdx.x; asm volatile("" : "+v"(tid_));
    const int tid = tid_; unsigned char* ws = a.ws;
    const float* AFFT = (const float*)(ws + WS_AFFT); int* ROWMAP = (int*)(ws + WS_ROWMAP); float* GATE = (float*)(ws + WS_GATE); int* INV = (int*)(ws + WS_INV);
    const int nitems = 128 + (with_ctx ? 128 : 0);
    for (int item = vcu; item < nitems; item += G) {
        int e, base, Ls, cap, slot0;
        if (item < 128) { const int b = item >> 4; e = item & 15; base = b * 4096; Ls = 4096; cap = CAPX; slot0 = b * CAPX; }
        else { const int it = item - 128; const int b = it >> 4; e = it & 15; base = TX + b * 256; Ls = 256; cap = CAPC; slot0 = NB * CAPX + b * CAPC; }
        for (int i = tid; i < Ls; i += NTHR) arr[i] = ((unsigned long long)__float_as_uint(AFFT[(size_t)e * TT + base + i]) << 32) | (unsigned)(Ls - 1 - i);
        __syncthreads();
        const int npairs = Ls >> 1;
        for (int k = 2; k <= Ls; k <<= 1)
            for (int j = k >> 1; j > 0; j >>= 1) {
                for (int p = tid; p < npairs; p += NTHR) { const int i = ((p & ~(j - 1)) << 1) | (p & (j - 1)), ix = i | j;
                    const unsigned long long x = arr[i], y = arr[ix]; const bool desc = ((i & k) == 0);
                    if (desc ? (x < y) : (x > y)) { arr[i] = y; arr[ix] = x; } }
                __syncthreads(); }
        for (int s = tid; s < cap; s += NTHR) { const unsigned long long v = arr[s]; const int idx = Ls - 1 - (int)(unsigned)(v & 0xffffffffull); const int slot = e * SLOTS + slot0 + s;
            ROWMAP[slot] = base + idx; GATE[slot] = __uint_as_float((unsigned)(v >> 32)); INV[(size_t)(base + idx) * 16 + e] = slot; }
        __syncthreads();
    }
}
__device__ __forceinline__ void phase_gather(const Args& a, int vcu, int G, bool with_ctx) {
    int tid_ = threadIdx.x; asm volatile("" : "+v"(tid_));
    const int tid = tid_, lane = tid & 63, wave = __builtin_amdgcn_readfirstlane(tid >> 6); unsigned char* ws = a.ws;
    const int* ROWMAP = (const int*)(ws + WS_ROWMAP); const bf16_t* HX = (const bf16_t*)(ws + WS_HX); bf16_t* XG = (bf16_t*)(ws + WS_XG);
    const int per = with_ctx ? SLOTS : NB * CAPX; const int gw = vcu * NWAVES + wave, NGW = G * NWAVES;
    for (int it = gw; it < NE * per; it += NGW) { const int e = it / per, s = it % per; const int slot = e * SLOTS + s; const int src = ROWMAP[slot];
        const u32x4* sp = (const u32x4*)(HX + (size_t)src * D) + 2 * lane; u32x4* dp = (u32x4*)(XG + (size_t)slot * D) + 2 * lane;
        const u32x4 v0 = sp[0], v1 = sp[1]; dp[0] = v0; dp[1] = v1; }
}
__device__ __forceinline__ void phase_combine(const Args& a, int vcu, int G, int l, bool with_ctx, bool final_norm, bool next_norm) {
    int tid_ = threadIdx.x; asm volatile("" : "+v"(tid_));
    const int tid = tid_, lane = tid & 63, wave = __builtin_amdgcn_readfirstlane(tid >> 6); unsigned char* ws = a.ws;
    const int* INV = (const int*)(ws + WS_INV); const bf16_t* OB = (const bf16_t*)(ws + WS_XG); const float* MOD = (const float*)(ws + WS_MOD) + (size_t)l * 9 * 6144;
    const float* MODN = (const float*)(ws + WS_MOD) + (size_t)(l + 1) * 9 * 6144; const float* gainn = a.in[I_N1G] + (l + 1) * D; bf16_t* HX = (bf16_t*)(ws + WS_HX);
    float* CRES = (float*)(ws + WS_CRES); const float* fng = a.in[I_FNG];
    const int nrows = with_ctx ? TT : TX; const int gw = vcu * NWAVES + wave, NGW = G * NWAVES;
    for (int rowa = gw; rowa < nrows; rowa += 2 * NGW) {
        int myinv[2]; f32x4 xv[2][4]; f32x4 acc[2][4];
#pragma unroll
        for (int u = 0; u < 2; ++u) { const int row = rowa + u * NGW; const bool ok = row < nrows; const int rr = ok ? row : rowa;
            myinv[u] = (lane < 16 && ok) ? INV[(size_t)rr * 16 + lane] : -1;
            const float* xr = (rr < TX) ? a.out + (size_t)rr * D : CRES + (size_t)(rr - TX) * D;
#pragma unroll
            for (int j = 0; j < 4; ++j) { xv[u][j] = *(const f32x4*)(xr + 256 * j + 4 * lane); acc[u][j] = (f32x4){0.f, 0.f, 0.f, 0.f}; } }
#pragma unroll
        for (int u = 0; u < 2; ++u)
            for (int e = 0; e < 16; ++e) { const int s = __shfl(myinv[u], e);
                if (s >= 0) { const bf16_t* orow = OB + (size_t)s * D;
#pragma unroll
                    for (int j = 0; j < 4; ++j) { const u32x2 v = *(const u32x2*)(orow + 256 * j + 4 * lane); acc[u][j][0] += bflo(v.x); acc[u][j][1] += bfhi(v.x); acc[u][j][2] += bflo(v.y); acc[u][j][3] += bfhi(v.y); } } }
#pragma unroll
        for (int u = 0; u < 2; ++u) { const int row = rowa + u * NGW; if (row < nrows) {
            const bool lat = row < TX; float* xr = lat ? a.out + (size_t)row * D : CRES + (size_t)(row - TX) * D; const int mrow = lat ? (row >> 12) : 8;
            const float* gp = MOD + mrow * 6144 + 5 * 1024; f32x4 v[4]; float ss = 0.f;
#pragma unroll
            for (int j = 0; j < 4; ++j) { const f32x4 g = *(const f32x4*)(gp + 256 * j + 4 * lane); v[j] = xv[u][j] + g * acc[u][j];
                ss += (v[j][0] * v[j][0] + v[j][1] * v[j][1]) + (v[j][2] * v[j][2] + v[j][3] * v[j][3]); }
            if (final_norm) { const float rstd = 1.0f / sqrtf(wave_sum(ss) * (1.0f / D) + 1e-6f);
#pragma unroll
                for (int j = 0; j < 4; ++j) { const f32x4 g = *(const f32x4*)(fng + 256 * j + 4 * lane); *(f32x4*)(xr + 256 * j + 4 * lane) = v[j] * rstd * g; } }
            else {
#pragma unroll
                for (int j = 0; j < 4; ++j) *(f32x4*)(xr + 256 * j + 4 * lane) = v[j];
                if (next_norm) { const float rstd = 1.0f / sqrtf(wave_sum(ss) * (1.0f / D) + 1e-6f); const float* shp = MODN + mrow * 6144; const float* scp = shp + 1024;
#pragma unroll
                    for (int j = 0; j < 4; ++j) { const f32x4 gg = *(const f32x4*)(gainn + 256 * j + 4 * lane), sh = *(const f32x4*)(shp + 256 * j + 4 * lane), sc = *(const f32x4*)(scp + 256 * j + 4 * lane);
                        const f32x4 hv = (v[j] * rstd * gg) * (1.0f + sc) + sh; u32x2 o; o.x = pk2(hv[0], hv[1]); o.y = pk2(hv[2], hv[3]); *(u32x2*)(HX + (size_t)row * D + 256 * j + 4 * lane) = o; } } } } }
    }
}

#define XBAR() do { xcd_barrier(bar); if (AMP_PHASE == 99) xcd_barrier(bar); } while (0)
__global__ void __launch_bounds__(NTHR, 2) fwd_kernel(Args a) {
    extern __shared__ __attribute__((aligned(16))) unsigned char lds[];
    cg::grid_group grid = cg::this_grid();
    const int G = gridDim.x, bx = blockIdx.x; const int vcu = (G % 8 == 0) ? (bx % 8) * (G / 8) + bx / 8 : bx;
    unsigned char* ws = a.ws;
    PG8_LAS unsigned char* glds = (PG8_LAS unsigned char*)lds;
    volatile LAS unsigned* bst = (volatile LAS unsigned*)((LAS unsigned char*)lds + LDS_BYTES - 16);
    if (threadIdx.x < 4) bst[threadIdx.x] = 0u;
    __syncthreads();
    XcdBarrier bar = xcd_barrier_post((unsigned*)(ws + WS_CTL), bst);
    { AMP_BEGIN(0) phase_prologue(a, lds, vcu, G); AMP_END(0) }
    grid.sync();
    for (int l = 0; l < 2; ++l) {
        const bool upd = (l == 0);
        const float* srcx = upd ? a.in[I_X] : a.out; const float* srcc = upd ? a.in[I_CTX] : (const float*)(ws + WS_CRES);
        if (upd) {
            { AMP_BEGIN(1) phase_norm(a, lds, vcu, G, l, srcx, srcc, a.in[I_N1G] + l * D, 0, TT, false); AMP_END(1) }
            { AMP_BEGIN(11) load_tw(a, (LAS unsigned char*)lds, threadIdx.x); for (int it = vcu; it < 1024; it += G) spectrum_item(a, (LAS unsigned char*)lds, it, threadIdx.x); AMP_END(11) }
            XBAR();
        }
        { AMP_BEGIN(2) pg8::Gemm g{(const pg8::bf16_t*)(ws + WS_HX), (const pg8::bf16_t*)(ws + WS_WIN_T) + (size_t)l * INW * D, TT, INW, D};
          pg8::GroupOrder S; S.init(1, TT / 256, INW / 256, 0, G, bx);
          pg8::EpiIn E{(pg8::bf16_t*)(ws + WS_PX), (const float*)(ws + WS_ROPE), (pg8::bf16_t*)(ws + WS_UT), glds + 131072};
          pg8::gemm_phase<pg8::EpiIn, pg8::GroupOrder, true, true>(glds, g, S, E); AMP_END(2) }
        XBAR();
        { AMP_BEGIN(3) phase_mix1(a, lds, vcu, G, l); AMP_END(3) }
        XBAR();
        { AMP_BEGIN(4) pg8::Gemm g{(const pg8::bf16_t*)(ws + WS_Y), (const pg8::bf16_t*)(ws + WS_WOUT_T) + (size_t)l * D * D, TT, D, D};
          pg8::GroupOrder S; S.init(1, (upd ? TT : TX) / 256, D / 256, 0, G, bx);
          pg8::EpiOut E{srcx, srcc, a.out, (float*)(ws + WS_CRES), (const float*)(ws + WS_MOD) + (size_t)l * 9 * 6144};
          pg8::gemm_phase<pg8::EpiOut, pg8::GroupOrder, true, true>(glds, g, S, E); AMP_END(4) }
        XBAR();
        { AMP_BEGIN(5) phase_norm(a, lds, vcu, G, l, a.out, (const float*)(ws + WS_CRES), a.in[I_N2G] + l * D, 3, upd ? TT : TX, true); AMP_END(5) }
        XBAR();
        { AMP_BEGIN(6) phase_select(a, lds, vcu, G, upd); AMP_END(6) }
        XBAR();
        { AMP_BEGIN(7) phase_gather(a, vcu, G, upd); AMP_END(7) }
        XBAR();
        { AMP_BEGIN(8) pg8::Gemm g{(const pg8::bf16_t*)(ws + WS_XG), (const pg8::bf16_t*)(ws + WS_WGU_T) + (size_t)l * NE * 4096 * D, NE * SLOTS, NE * 4096, D};
          pg8::GroupOrder S; S.init(NE, upd ? 17 : 16, 16, 17, G, bx);
          pg8::EpiGU E{(pg8::bf16_t*)(ws + WS_ACT)};
          pg8::gemm_phase<pg8::EpiGU, pg8::GroupOrder, true, true>(glds, g, S, E); AMP_END(8) }
        XBAR();
        { AMP_BEGIN(9) pg8::Gemm g{(const pg8::bf16_t*)(ws + WS_ACT), (const pg8::bf16_t*)(ws + WS_WD_T) + (size_t)l * NE * D * FF, NE * SLOTS, NE * D, FF};
          pg8::GroupOrder S; S.init(NE, upd ? 17 : 16, 4, 17, G, bx);
          pg8::EpiDown E{(pg8::bf16_t*)(ws + WS_XG), (const float*)(ws + WS_GATE)};
          pg8::gemm_phase<pg8::EpiDown, pg8::GroupOrder, true, true>(glds, g, S, E); AMP_END(9) }
        XBAR();
        { AMP_BEGIN(10) phase_combine(a, vcu, G, l, upd, !upd, upd); AMP_END(10) }
        if (upd) XBAR();
    }
}

extern "C" void kernel_launch(void* const* d_in, const int* in_sizes, int n_in, void* d_out, int out_size, void* d_ws, size_t ws_size, hipStream_t stream) {
    static int grid = 0;
    if (grid == 0) {
        int dev = 0, cus = 0, per_cu = 0;
        hipGetDevice(&dev); hipDeviceGetAttribute(&cus, hipDeviceAttributeMultiprocessorCount, dev);
        if (hipFuncSetAttribute((const void*)fwd_kernel, hipFuncAttributeMaxDynamicSharedMemorySize, LDS_BYTES) != hipSuccess) { fprintf(stderr, "kernel_launch: hipFuncSetAttribute failed\n"); grid = -1; return; }
        if (hipOccupancyMaxActiveBlocksPerMultiprocessor(&per_cu, (const void*)fwd_kernel, NTHR, LDS_BYTES) != hipSuccess || per_cu < 1) { fprintf(stderr, "kernel_launch: occupancy query failed (%d)\n", per_cu); grid = -1; return; }
        grid = cus * 1;
        if (n_in != N_IN || ws_size < WS_END) { fprintf(stderr, "kernel_launch: unexpected n_in %d / ws %zu\n", n_in, ws_size); grid = -1; return; }
    }
    if (grid < 0) return;
    if (hipMemsetAsync((char*)d_ws + WS_CTL, 0, 65536, stream) != hipSuccess) { fprintf(stderr, "kernel_launch: memset failed\n"); return; }
    Args a{};
    for (int i = 0; i < N_IN; ++i) a.in[i] = (const float*)d_in[i];
    a.out = (float*)d_out; a.ws = (unsigned char*)d_ws;
    void* args[] = {&a};
    hipError_t e = hipLaunchCooperativeKernel((const void*)fwd_kernel, dim3(grid), dim3(NTHR), args, LDS_BYTES, stream);
    if (e != hipSuccess) fprintf(stderr, "cooperative launch failed: %s (grid %d)\n", hipGetErrorString(e), grid);
}
```

```cpp
#define AMP_PHASE -1
#include <hip/hip_runtime.h>
#include <hip/hip_cooperative_groups.h>
#include <cstdio>
#include <cstdint>
namespace cg = cooperative_groups;
namespace pg8 {
#define PG8_LAS __attribute__((address_space(3)))
typedef unsigned short bf16_t;
typedef short bf16x8 __attribute__((ext_vector_type(8)));
typedef float f32x4 __attribute__((ext_vector_type(4)));
typedef unsigned u32x4 __attribute__((ext_vector_type(4)));
typedef int v4i_t __attribute__((ext_vector_type(4)));
typedef int v8i_t __attribute__((ext_vector_type(8)));
constexpr int BM = 256, BK = 64, HALF = 128, HTB = HALF * BK * 2  , STAGE_BYTES = 8 * HTB, NXCD = 8, WGM = 8;

__host__ __device__ __forceinline__ int lds_byte(int r, int c) { const int st = (r >> 4) * 2 + (c >> 5), rr = r & 15, cc = c & 31, ob = rr * 64 + cc * 2; return st * 1024 + (ob ^ (((ob >> 9) & 1) << 5)); }
__host__ __device__ __forceinline__ void stage_rc(int b, int& R, int& C) { const int st = b / 1024, sb = b % 1024, swz = sb ^ (((sb >> 9) & 1) << 5); R = (st >> 1) * 16 + swz / 64; C = (st & 1) * 32 + (swz % 64) / 2; }
__host__ __device__ __forceinline__ int perm32(int rho) { const int n = rho >> 4, i = rho & 15; return 8 * (i >> 2) + 4 * n + (i & 3); }

struct Unit { int pm, pn; };
struct Gemm { const bf16_t* A; const bf16_t* Bt; int M, N, K; };

struct StaticOrder {
    int nM, nN, nwg, G, c;
    __host__ __device__ void init(int M, int N, int G_, int c_) { nM = M / BM; nN = N / BM; nwg = nM * nN; G = G_; c = c_; }
    __host__ __device__ bool next(int i, Unit& u) const {
        const long L = (long)i * G + c; if (L >= nwg) return false;
        int wgid = (int)L; { const int q = nwg / NXCD, r = nwg % NXCD, xcd = wgid % NXCD, off = wgid / NXCD; wgid = (xcd < r ? xcd * (q + 1) : r * (q + 1) + (xcd - r) * q) + off; }
        const int nig = WGM * nN, gid = wgid / nig, fm = gid * WGM, gsz = (nM - fm) < WGM ? (nM - fm) : WGM;
        u.pm = fm + ((wgid % nig) % gsz); u.pn = (wgid % nig) / gsz; return true;
    }
    __device__ __forceinline__ void a_ready(const Unit&) const {}
    __device__ __forceinline__ void done(const Unit&) const {}
};

__device__ __forceinline__ unsigned cvt_pk_bf16(float lo, float hi) { unsigned r; asm volatile("v_cvt_pk_bf16_f32 %0, %1, %2" : "=v"(r) : "v"(lo), "v"(hi)); return r; }
typedef float f32x2 __attribute__((ext_vector_type(2)));
__device__ __forceinline__ f32x2 gelu_pk(f32x2 v) {
    const f32x2 av = __builtin_elementwise_abs(v), d = av * 0.2316418882f + 1.0f;
    f32x2 t; t.x = __builtin_amdgcn_rcpf(d.x); t.y = __builtin_amdgcn_rcpf(d.y);
    f32x2 q = t * 0.5307027145f + (-0.7265760135f); q = q * t + 0.7107068705f; q = q * t + (-0.142248368f); q = q * t + 0.127414796f; q = q * t;
    const f32x2 s = (v * v) * (-0.72134752044f);
    f32x2 e; e.x = __builtin_amdgcn_exp2f(s.x); e.y = __builtin_amdgcn_exp2f(s.y);
    const f32x2 m = v * (q * e), r = v - m;
    f32x2 o; o.x = v.x < 0.f ? m.x : r.x; o.y = v.y < 0.f ? m.y : r.y; return o;
}


struct GroupOrder {
    int nMl, nNl, strideM, nper, nwg, G, c;
    __device__ void init(int ng, int nMl_, int nNl_, int strideM_, int G_, int c_) { nMl = nMl_; nNl = nNl_; strideM = strideM_; nper = nMl_ * nNl_; nwg = ng * nper; G = G_; c = c_; }
    __device__ bool next(int i, Unit& u) const {
        const long L = (long)i * G + c; if (L >= nwg) return false;
        int wgid = (int)L; { const int q = nwg / NXCD, r = nwg % NXCD, xcd = wgid % NXCD, off = wgid / NXCD; wgid = (xcd < r ? xcd * (q + 1) : r * (q + 1) + (xcd - r) * q) + off; }
        const int e = wgid / nper, id = wgid % nper;
        const int nig = WGM * nNl, gid = id / nig, fm = gid * WGM, gsz = (nMl - fm) < WGM ? (nMl - fm) : WGM;
        u.pm = e * strideM + fm + ((id % nig) % gsz); u.pn = e * nNl + (id % nig) / gsz; return true;
    }
    __device__ __forceinline__ void a_ready(const Unit&) const {}
    __device__ __forceinline__ void done(const Unit&) const {}
};

constexpr int TXR = 32768;
struct EpiIn {
    static constexpr bool PERM = true, AFTER_DRAIN = false;
    bf16_t* PX; const float* rope; bf16_t* UT; PG8_LAS unsigned char* stgbase;
    __device__ __forceinline__ void operator()(const f32x4 (&acc)[2][2][4][2], const Unit& u, int wr, int wc, int fr, int fq) const {
        const int row0 = u.pm * BM + wr * 64 + fr; const int col0 = u.pn * BM + wc * 32 + 8 * fq;
        const bool latent = u.pm < (TXR / BM);
        if (latent && u.pn < 3) {
            PG8_LAS unsigned char* stg = stgbase + (wr * 4 + wc) * 2304; const int lane = fq * 16 + fr;
            const int b = u.pm >> 4, trow0 = (u.pm & 15) * BM; const int col = lane >> 1, half = lane & 1;
#pragma unroll
            for (int ai = 0; ai < 2; ++ai)
#pragma unroll
                for (int bj = 0; bj < 2; ++bj)
#pragma unroll
                    for (int mh = 0; mh < 2; ++mh) {
#pragma unroll
                        for (int mm = 0; mm < 2; ++mm)
#pragma unroll
                            for (int n = 0; n < 2; ++n) { const f32x4 v = acc[ai][bj][2 * mh + mm][n]; const unsigned w0 = cvt_pk_bf16(v[0], v[1]), w1 = cvt_pk_bf16(v[2], v[3]);
                                PG8_LAS unsigned char* p = stg + (8 * fq + 4 * n) * 72 + (16 * mm + fr) * 2;
                                *(PG8_LAS unsigned short*)(p) = (unsigned short)w0; *(PG8_LAS unsigned short*)(p + 72) = (unsigned short)(w0 >> 16);
                                *(PG8_LAS unsigned short*)(p + 144) = (unsigned short)w1; *(PG8_LAS unsigned short*)(p + 216) = (unsigned short)(w1 >> 16); }
                        asm volatile("s_waitcnt lgkmcnt(0)" ::: "memory");
                        typedef unsigned u32x2v __attribute__((ext_vector_type(2)));
                        const PG8_LAS unsigned char* rp = stg + col * 72 + half * 32;
                        const u32x2v a0 = *(const PG8_LAS u32x2v*)(rp), a1 = *(const PG8_LAS u32x2v*)(rp + 8), a2 = *(const PG8_LAS u32x2v*)(rp + 16), a3 = *(const PG8_LAS u32x2v*)(rp + 24);
                        const int ch = u.pn * BM + bj * HALF + wc * 32 + col; const int t0 = trow0 + ai * HALF + wr * 64 + mh * 32 + half * 16;
                        u32x4* gp = (u32x4*)(UT + ((size_t)(b * 768 + ch)) * 4096 + t0);
                        gp[0] = (u32x4){a0.x, a0.y, a1.x, a1.y}; gp[1] = (u32x4){a2.x, a2.y, a3.x, a3.y};
                        asm volatile("s_waitcnt lgkmcnt(0)" ::: "memory"); }
            return;
        }
#pragma unroll
        for (int ai = 0; ai < 2; ++ai)
#pragma unroll
            for (int m = 0; m < 4; ++m) { const int row = row0 + ai * HALF + m * 16; bf16_t* rowp = PX + (size_t)row * 2304 + col0;
#pragma unroll
                for (int bj = 0; bj < 2; ++bj) { f32x4 v0 = acc[ai][bj][m][0], v1 = acc[ai][bj][m][1];
                    const bool dorope = latent && (u.pn == 4 || (u.pn == 6 && bj == 0));
                    if (dorope) {
                        const int t = row & 4095; const int pos = (wc & 1) ? (t & 63) : (t >> 6);
                        const f32x4* rp = (const f32x4*)(rope + (pos * 16 + 8 * (fq & 1)) * 2);
                        const f32x4 r0 = rp[0], r1 = rp[1], r2 = rp[2], r3 = rp[3];
                        f32x4 p0, p1;
#pragma unroll
                        for (int j = 0; j < 4; ++j) { p0[j] = __shfl_xor(v0[j], 32); p1[j] = __shfl_xor(v1[j], 32); }
                        const float c0[4] = {r0[0], r0[2], r1[0], r1[2]}, s0[4] = {r0[1], r0[3], r1[1], r1[3]};
                        const float c1[4] = {r2[0], r2[2], r3[0], r3[2]}, s1[4] = {r2[1], r2[3], r3[1], r3[3]};
                        const bool lo = fq < 2;
#pragma unroll
                        for (int j = 0; j < 4; ++j) {
                            v0[j] = lo ? (v0[j] * c0[j] - p0[j] * s0[j]) : (p0[j] * s0[j] + v0[j] * c0[j]);
                            v1[j] = lo ? (v1[j] * c1[j] - p1[j] * s1[j]) : (p1[j] * s1[j] + v1[j] * c1[j]); }
                    }
                    u32x4 w; w.x = cvt_pk_bf16(v0[0], v0[1]); w.y = cvt_pk_bf16(v0[2], v0[3]); w.z = cvt_pk_bf16(v1[0], v1[1]); w.w = cvt_pk_bf16(v1[2], v1[3]);
                    *(u32x4*)(rowp + bj * HALF) = w; } }
    }
};
struct EpiOut {
    static constexpr bool PERM = false, AFTER_DRAIN = false;
    const float* xold_x; const float* xold_c; float* dst_x; float* dst_c; const float* mod;
    __device__ __forceinline__ void operator()(const f32x4 (&acc)[2][2][4][2], const Unit& u, int wr, int wc, int fr, int fq) const {
        const int row0 = u.pm * BM + wr * 64 + fr, col0 = u.pn * BM + wc * 32 + 4 * fq;
        const bool latent = u.pm < (TXR / BM);
#pragma unroll
        for (int ai = 0; ai < 2; ++ai)
#pragma unroll
            for (int m = 0; m < 4; ++m) { const int row = row0 + ai * HALF + m * 16;
                const int mrow = latent ? (row >> 12) : 8; const float* gp = mod + mrow * 6144 + 2 * 1024 + col0;
                const size_t off = latent ? (size_t)row * 1024 + col0 : (size_t)(row - TXR) * 1024 + col0;
                const float* xo = (latent ? xold_x : xold_c) + off; float* xd = (latent ? dst_x : dst_c) + off;
#pragma unroll
                for (int bj = 0; bj < 2; ++bj)
#pragma unroll
                    for (int n = 0; n < 2; ++n) { const f32x4 g = *(const f32x4*)(gp + bj * HALF + n * 16), xv = *(const f32x4*)(xo + bj * HALF + n * 16);
                        *(f32x4*)(xd + bj * HALF + n * 16) = xv + g * acc[ai][bj][m][n]; } }
    }
};
struct EpiGU {
    static constexpr bool PERM = true, AFTER_DRAIN = false;
    unsigned char* ACT; const float* wsc;
    __device__ __forceinline__ void operator()(const f32x4 (&acc)[2][2][4][2], const Unit& u, int wr, int wc, int fr, int fq) const {
        const int row0 = u.pm * BM + wr * 64 + fr; const int col0 = (u.pn & 15) * 128 + wc * 32 + 8 * fq; const int e = u.pn >> 4; const float sg = wsc[e], su = wsc[16 + e];
#pragma unroll
        for (int ai = 0; ai < 2; ++ai)
#pragma unroll
            for (int m = 0; m < 4; ++m) { unsigned char* rowp = ACT + (size_t)(row0 + ai * HALF + m * 16) * 2048 + col0;
                float h[8];
#pragma unroll
                for (int n = 0; n < 2; ++n)
#pragma unroll
                    for (int j = 0; j < 4; ++j) { const float g = acc[ai][0][m][n][j] * sg, up = acc[ai][1][m][n][j] * su; const float v = g / (1.0f + __expf(-g)) * up; h[4 * n + j] = fminf(fmaxf(v, -448.0f), 448.0f); }
                int p0 = 0, p1 = 0;
                p0 = __builtin_amdgcn_cvt_pk_fp8_f32(h[0], h[1], p0, false); p0 = __builtin_amdgcn_cvt_pk_fp8_f32(h[2], h[3], p0, true);
                p1 = __builtin_amdgcn_cvt_pk_fp8_f32(h[4], h[5], p1, false); p1 = __builtin_amdgcn_cvt_pk_fp8_f32(h[6], h[7], p1, true);
                typedef int i32x2v __attribute__((ext_vector_type(2)));
                *(i32x2v*)rowp = (i32x2v){p0, p1}; }
    }
};
struct EpiDown {
    static constexpr bool PERM = true, AFTER_DRAIN = false;
    bf16_t* OB; const float* gate; const float* wsc;
    __device__ __forceinline__ void operator()(const f32x4 (&acc)[2][2][4][2], const Unit& u, int wr, int wc, int fr, int fq) const {
        const int row0 = u.pm * BM + wr * 64 + fr; const int col0 = (u.pn & 3) * BM + wc * 32 + 8 * fq;
#pragma unroll
        for (int ai = 0; ai < 2; ++ai)
#pragma unroll
            for (int m = 0; m < 4; ++m) { const int row = row0 + ai * HALF + m * 16; const float g = gate[row] * wsc[u.pn >> 2]; bf16_t* rowp = OB + (size_t)row * 1024 + col0;
#pragma unroll
                for (int bj = 0; bj < 2; ++bj) { const f32x4 v0 = acc[ai][bj][m][0] * g, v1 = acc[ai][bj][m][1] * g;
                    u32x4 w; w.x = cvt_pk_bf16(v0[0], v0[1]); w.y = cvt_pk_bf16(v0[2], v0[3]); w.z = cvt_pk_bf16(v1[0], v1[1]); w.w = cvt_pk_bf16(v1[2], v1[3]);
                    *(u32x4*)(rowp + bj * HALF) = w; } }
    }
};

template <class Epi, class Sched, bool ALIGN_EPI = false, bool SP2 = false, bool FP8 = false>
__device__ __forceinline__ void gemm_phase(PG8_LAS unsigned char* lds, const Gemm g, const Sched& S, const Epi& E) {
    int tid_ = threadIdx.x; asm volatile("" : "+v"(tid_));
    const int tid = tid_, wid = __builtin_amdgcn_readfirstlane(tid >> 6), lane = tid & 63, wr = wid >> 2, wc = wid & 3, fr = lane & 15, fq = lane >> 4;
    const int K = g.K, KB = FP8 ? K : 2 * K  , nt = KB / (BK * 2);
    unsigned voffA[2], voffB[2];
#pragma unroll
    for (int i = 0; i < 2; ++i) { int R, C; stage_rc(tid * 16 + i * 8192, R, C); const int Rb = Epi::PERM ? ((R & ~31) + perm32(R & 31)) : R;
        voffA[i] = (unsigned)(R * KB + C * 2); voffB[i] = (unsigned)(Rb * KB + C * 2); }
    const size_t kstep = (size_t)(BK * 2);
    const size_t hstep = (size_t)HALF * KB;
    const size_t tstep = 2 * hstep;
    const unsigned ldsw = (unsigned)wid * 1024u;
    const int aoff = lds_byte(wr * 64 + fr, fq * 8), boff = lds_byte(wc * 32 + fr, fq * 8);
#define PG8_SA(b, h) (((b) * 2 + (h)) * HTB)
#define PG8_SB(b, h) ((4 + (b) * 2 + (h)) * HTB)
#define PG8_STAGE(bufoff, gbase, voff) do { _Pragma("unroll") for (int _i = 0; _i < 2; ++_i) \
        __builtin_amdgcn_global_load_lds((const unsigned*)((const char*)(gbase) + (voff)[_i]), (PG8_LAS unsigned*)(lds + (bufoff) + ldsw + _i * 8192), 16, 0, 0); } while (0)
#define PG8_LDA(dst, b, h) do { _Pragma("unroll") for (int m = 0; m < 4; ++m) { if constexpr (FP8) { dst##8[m].lo = *(const PG8_LAS v4i_t*)(lds + PG8_SA(b, h) + aoff + m * 2048); dst##8[m].hi = *(const PG8_LAS v4i_t*)(lds + PG8_SA(b, h) + aoff + m * 2048 + 1024); } \
        else { _Pragma("unroll") for (int k = 0; k < 2; ++k) dst[m][k] = *(const PG8_LAS bf16x8*)(lds + PG8_SA(b, h) + aoff + m * 2048 + k * 1024); } } } while (0)
#define PG8_LDB(dst, b, h) do { _Pragma("unroll") for (int n = 0; n < 2; ++n) { if constexpr (FP8) { dst##8[n].lo = *(const PG8_LAS v4i_t*)(lds + PG8_SB(b, h) + boff + n * 2048); dst##8[n].hi = *(const PG8_LAS v4i_t*)(lds + PG8_SB(b, h) + boff + n * 2048 + 1024); } \
        else { _Pragma("unroll") for (int k = 0; k < 2; ++k) dst[n][k] = *(const PG8_LAS bf16x8*)(lds + PG8_SB(b, h) + boff + n * 2048 + k * 1024); } } } while (0)
#define PG8_CAT8(x0, x1) __builtin_shufflevector(__builtin_bit_cast(v4i_t, x0), __builtin_bit_cast(v4i_t, x1), 0, 1, 2, 3, 4, 5, 6, 7)
#define PG8_MMA(ai, bj, At, Bt) do { __builtin_amdgcn_s_setprio(1); if constexpr (FP8) asm volatile("s_nop 1" ::: "memory"); _Pragma("unroll") for (int m = 0; m < 4; ++m) _Pragma("unroll") for (int n = 0; n < 2; ++n) { \
        if constexpr (FP8) asm volatile("v_mfma_scale_f32_16x16x128_f8f6f4 %0, %1, %2, %0, %3, %3 op_sel_hi:[0,0,0]" : "+v"(acc[ai][bj][m][n]) : "v"(Bt##8[n]), "v"(At##8[m]), "v"(one_scale)); \
        else { _Pragma("unroll") for (int k = 0; k < 2; ++k) acc[ai][bj][m][n] = __builtin_amdgcn_mfma_f32_16x16x32_bf16(Bt[n][k], At[m][k], acc[ai][bj][m][n], 0, 0, 0); } } if constexpr (FP8) asm volatile("s_nop 15\n\ts_nop 3" ::: "memory"); __builtin_amdgcn_s_setprio(0); } while (0)
#define PG8_WAIT_V(n) asm volatile("s_waitcnt vmcnt(" #n ")" ::: "memory")
#define PG8_WAIT_L(n) asm volatile("s_waitcnt lgkmcnt(" #n ")" ::: "memory")
#define PG8_BAR __builtin_amdgcn_s_barrier()
#define PG8_SCHED __builtin_amdgcn_sched_barrier(0)
    Unit cur, nxt; int ui = 0;
    if (!S.next(0, cur)) return;
    f32x4 acc[2][2][4][2];
#pragma unroll
    for (int a = 0; a < 2; ++a)
#pragma unroll
        for (int b = 0; b < 2; ++b)
#pragma unroll
            for (int m = 0; m < 4; ++m)
#pragma unroll
                for (int n = 0; n < 2; ++n) acc[a][b][m][n] = (f32x4){0.f, 0.f, 0.f, 0.f};
    bf16x8 At[4][2], B0[2][2], B1[2][2];
    v8i_t At8[4], B08[2], B18[2];
    int one_scale = 0x7f7f7f7f; asm volatile("" : "+v"(one_scale));
    const char* cA = (const char*)g.A + (size_t)cur.pm * tstep; const char* cB = (const char*)g.Bt + (size_t)cur.pn * tstep;
    S.a_ready(cur);
    if constexpr (SP2) {
        PG8_STAGE(PG8_SB(0, 0), cB, voffB); PG8_STAGE(PG8_SB(0, 1), cB + hstep, voffB); PG8_STAGE(PG8_SA(0, 0), cA, voffA); PG8_STAGE(PG8_SA(0, 1), cA + hstep, voffA);
        if (wr == 1) PG8_BAR;
        PG8_WAIT_V(2); PG8_BAR;
        PG8_STAGE(PG8_SB(1, 0), cB + kstep, voffB); PG8_STAGE(PG8_SA(1, 0), cA + kstep, voffA); PG8_STAGE(PG8_SB(1, 1), cB + hstep + kstep, voffB);
        PG8_WAIT_V(6); PG8_BAR;
    } else {
        PG8_STAGE(PG8_SB(0, 0), cB, voffB); PG8_STAGE(PG8_SA(0, 0), cA, voffA); PG8_STAGE(PG8_SB(0, 1), cB + hstep, voffB); PG8_STAGE(PG8_SA(0, 1), cA + hstep, voffA);
        if (wr == 1) PG8_BAR;
        PG8_WAIT_V(4); PG8_BAR;
        PG8_STAGE(PG8_SB(1, 0), cB + kstep, voffB); PG8_STAGE(PG8_SA(1, 0), cA + kstep, voffA); PG8_STAGE(PG8_SB(1, 1), cB + hstep + kstep, voffB);
        PG8_WAIT_V(6); PG8_BAR;
    }
    for (;;) {
        const bool has_next = S.next(ui + 1, nxt);
        const char* nA = has_next ? (const char*)g.A + (size_t)nxt.pm * tstep : cA; const char* nB = has_next ? (const char*)g.Bt + (size_t)nxt.pn * tstep : cB;
#pragma nounroll
        for (int t = 0; t < nt; t += 2) {
            const bool last = (t == nt - 2);
            const char* a1 = cA + (size_t)(t + 1) * kstep;
            const char* a2 = last ? nA : cA + (size_t)(t + 2) * kstep; const char* b2 = last ? nB : cB + (size_t)(t + 2) * kstep;
            const char* a3 = a2 + kstep; const char* b3 = b2 + kstep;
            if (last && has_next) S.a_ready(nxt);
            if constexpr (SP2) {
            PG8_LDB(B0, 0, 0); PG8_LDB(B1, 0, 1); PG8_SCHED; PG8_LDA(At, 0, 0); PG8_STAGE(PG8_SA(1, 1), a1 + hstep, voffA);
            PG8_WAIT_V(8); PG8_WAIT_L(0); PG8_BAR; PG8_MMA(0, 0, At, B0); PG8_MMA(0, 1, At, B1); PG8_BAR; PG8_SCHED;
            PG8_LDA(At, 0, 1); PG8_STAGE(PG8_SB(0, 0), b2, voffB); PG8_STAGE(PG8_SB(0, 1), b2 + hstep, voffB); PG8_STAGE(PG8_SA(0, 0), a2, voffA);
            PG8_WAIT_V(8); PG8_WAIT_L(0); PG8_BAR; PG8_MMA(1, 0, At, B0); PG8_MMA(1, 1, At, B1); PG8_BAR; PG8_SCHED;
            PG8_LDB(B0, 1, 0); PG8_LDB(B1, 1, 1); PG8_SCHED; PG8_LDA(At, 1, 0); PG8_STAGE(PG8_SA(0, 1), a2 + hstep, voffA);
            PG8_WAIT_V(8); PG8_WAIT_L(0); PG8_BAR; PG8_MMA(0, 0, At, B0); PG8_MMA(0, 1, At, B1); PG8_BAR; PG8_SCHED;
            PG8_LDA(At, 1, 1); PG8_STAGE(PG8_SB(1, 0), b3, voffB); PG8_STAGE(PG8_SB(1, 1), b3 + hstep, voffB); PG8_STAGE(PG8_SA(1, 0), a3, voffA);
            PG8_WAIT_V(8); PG8_WAIT_L(0); PG8_BAR; PG8_MMA(1, 0, At, B0); PG8_MMA(1, 1, At, B1); PG8_BAR; PG8_SCHED;
            } else {
            PG8_LDB(B0, 0, 0); PG8_SCHED; PG8_LDA(At, 0, 0); PG8_STAGE(PG8_SA(1, 1), a1 + hstep, voffA);
            PG8_WAIT_L(8); PG8_BAR; PG8_WAIT_L(0); PG8_MMA(0, 0, At, B0); PG8_BAR; PG8_SCHED;
            PG8_LDB(B1, 0, 1); PG8_STAGE(PG8_SB(0, 0), b2, voffB);
            PG8_BAR; PG8_WAIT_L(0); PG8_MMA(0, 1, At, B1); PG8_BAR;
            PG8_LDA(At, 0, 1); PG8_STAGE(PG8_SA(0, 0), a2, voffA);
            PG8_BAR; PG8_WAIT_L(0); PG8_MMA(1, 0, At, B0); PG8_BAR; PG8_SCHED;
            PG8_STAGE(PG8_SB(0, 1), b2 + hstep, voffB);
            PG8_WAIT_V(6); PG8_BAR; PG8_MMA(1, 1, At, B1); PG8_BAR;
            PG8_LDB(B0, 1, 0); PG8_SCHED; PG8_LDA(At, 1, 0); PG8_STAGE(PG8_SA(0, 1), a2 + hstep, voffA);
            PG8_WAIT_L(8); PG8_BAR; PG8_WAIT_L(0); PG8_MMA(0, 0, At, B0); PG8_BAR; PG8_SCHED;
            PG8_LDB(B1, 1, 1); PG8_STAGE(PG8_SB(1, 0), b3, voffB);
            PG8_BAR; PG8_WAIT_L(0); PG8_MMA(0, 1, At, B1); PG8_BAR;
            PG8_LDA(At, 1, 1); PG8_STAGE(PG8_SA(1, 0), a3, voffA);
            PG8_BAR; PG8_WAIT_L(0); PG8_MMA(1, 0, At, B0); PG8_BAR; PG8_SCHED;
            PG8_STAGE(PG8_SB(1, 1), b3 + hstep, voffB);
            PG8_WAIT_V(6); PG8_BAR; PG8_MMA(1, 1, At, B1); PG8_BAR;
            }
        }
        if constexpr (ALIGN_EPI) { if (wr == 0) PG8_BAR; }
        if constexpr (!Epi::AFTER_DRAIN) { E(acc, cur, wr, wc, fr, fq); S.done(cur); }
        if (!has_next) break;
#pragma unroll
        for (int a = 0; a < 2; ++a)
#pragma unroll
            for (int b = 0; b < 2; ++b)
#pragma unroll
                for (int m = 0; m < 4; ++m)
#pragma unroll
                    for (int n = 0; n < 2; ++n) acc[a][b][m][n] = (f32x4){0.f, 0.f, 0.f, 0.f};
        cur = nxt; cA = nA; cB = nB; ++ui;
        if constexpr (ALIGN_EPI) { if (wr == 1) PG8_BAR; }
    }
    PG8_WAIT_V(0);
    if constexpr (!ALIGN_EPI) { if (wr == 0) PG8_BAR; }
    PG8_BAR;
    if constexpr (Epi::AFTER_DRAIN) { E.fused(acc, cur, wr, wc, fr, fq, lds, wid, lane); S.done(cur); }
#undef PG8_SA
#undef PG8_SB
#undef PG8_STAGE
#undef PG8_LDA
#undef PG8_LDB
#undef PG8_MMA
#undef PG8_CAT8
#undef PG8_WAIT_V
#undef PG8_WAIT_L
#undef PG8_BAR
#undef PG8_SCHED
}
template <class Epi, class Sched, bool FP8 = false>
__device__ __forceinline__ void gemm_phase_gather(PG8_LAS unsigned char* lds, const Gemm g, const int* rowmap, PG8_LAS int* idxs, const Sched& S, const Epi& E) {
    constexpr bool ALIGN_EPI = true, SP2 = true;
    int tid_ = threadIdx.x; asm volatile("" : "+v"(tid_));
    const int tid = tid_, wid = __builtin_amdgcn_readfirstlane(tid >> 6), lane = tid & 63, wr = wid >> 2, wc = wid & 3, fr = lane & 15, fq = lane >> 4;
    const int K = g.K, KB = FP8 ? K : 2 * K  , nt = KB / (BK * 2);
    unsigned voffB[2]; int RA[2], CA[2];
#pragma unroll
    for (int i = 0; i < 2; ++i) { int R, C; stage_rc(tid * 16 + i * 8192, R, C); const int Rb = Epi::PERM ? ((R & ~31) + perm32(R & 31)) : R;
        RA[i] = R; CA[i] = C * 2; voffB[i] = (unsigned)(Rb * KB + C * 2); }
    const size_t kstep = (size_t)(BK * 2);
    const size_t hstep = (size_t)HALF * KB;
    const size_t tstep = 2 * hstep;
    const unsigned ldsw = (unsigned)wid * 1024u;
    const int aoff = lds_byte(wr * 64 + fr, fq * 8), boff = lds_byte(wc * 32 + fr, fq * 8);
#define PG8_SA(b, h) (((b) * 2 + (h)) * HTB)
#define PG8_SB(b, h) ((4 + (b) * 2 + (h)) * HTB)
#define PG8_STAGE(bufoff, gbase, voff) do { _Pragma("unroll") for (int _i = 0; _i < 2; ++_i) \
        __builtin_amdgcn_global_load_lds((const unsigned*)((const char*)(gbase) + (voff)[_i]), (PG8_LAS unsigned*)(lds + (bufoff) + ldsw + _i * 8192), 16, 0, 0); } while (0)
#define PG8_STAGE_AG(bufoff, P, h, koff) do { _Pragma("unroll") for (int _i = 0; _i < 2; ++_i) \
        __builtin_amdgcn_global_load_lds((const unsigned*)((P)[h][_i] + (koff)), (PG8_LAS unsigned*)(lds + (bufoff) + ldsw + _i * 8192), 16, 0, 0); } while (0)
#define PG8_ROWPTR(P, u) do { _Pragma("unroll") for (int _h = 0; _h < 2; ++_h) _Pragma("unroll") for (int _i = 0; _i < 2; ++_i) \
        (P)[_h][_i] = (const char*)g.A + (size_t)idxs[(u) * BM + _h * HALF + RA[_i]] * (size_t)KB + CA[_i]; } while (0)
#define PG8_LDA(dst, b, h) do { _Pragma("unroll") for (int m = 0; m < 4; ++m) { if constexpr (FP8) { dst##8[m].lo = *(const PG8_LAS v4i_t*)(lds + PG8_SA(b, h) + aoff + m * 2048); dst##8[m].hi = *(const PG8_LAS v4i_t*)(lds + PG8_SA(b, h) + aoff + m * 2048 + 1024); } \
        else { _Pragma("unroll") for (int k = 0; k < 2; ++k) dst[m][k] = *(const PG8_LAS bf16x8*)(lds + PG8_SA(b, h) + aoff + m * 2048 + k * 1024); } } } while (0)
#define PG8_LDB(dst, b, h) do { _Pragma("unroll") for (int n = 0; n < 2; ++n) { if constexpr (FP8) { dst##8[n].lo = *(const PG8_LAS v4i_t*)(lds + PG8_SB(b, h) + boff + n * 2048); dst##8[n].hi = *(const PG8_LAS v4i_t*)(lds + PG8_SB(b, h) + boff + n * 2048 + 1024); } \
        else { _Pragma("unroll") for (int k = 0; k < 2; ++k) dst[n][k] = *(const PG8_LAS bf16x8*)(lds + PG8_SB(b, h) + boff + n * 2048 + k * 1024); } } } while (0)
#define PG8_CAT8(x0, x1) __builtin_shufflevector(__builtin_bit_cast(v4i_t, x0), __builtin_bit_cast(v4i_t, x1), 0, 1, 2, 3, 4, 5, 6, 7)
#define PG8_MMA(ai, bj, At, Bt) do { __builtin_amdgcn_s_setprio(1); if constexpr (FP8) asm volatile("s_nop 1" ::: "memory"); _Pragma("unroll") for (int m = 0; m < 4; ++m) _Pragma("unroll") for (int n = 0; n < 2; ++n) { \
        if constexpr (FP8) asm volatile("v_mfma_scale_f32_16x16x128_f8f6f4 %0, %1, %2, %0, %3, %3 op_sel_hi:[0,0,0]" : "+v"(acc[ai][bj][m][n]) : "v"(Bt##8[n]), "v"(At##8[m]), "v"(one_scale)); \
        else { _Pragma("unroll") for (int k = 0; k < 2; ++k) acc[ai][bj][m][n] = __builtin_amdgcn_mfma_f32_16x16x32_bf16(Bt[n][k], At[m][k], acc[ai][bj][m][n], 0, 0, 0); } } if constexpr (FP8) asm volatile("s_nop 15\n\ts_nop 3" ::: "memory"); __builtin_amdgcn_s_setprio(0); } while (0)
#define PG8_WAIT_V(n) asm volatile("s_waitcnt vmcnt(" #n ")" ::: "memory")
#define PG8_WAIT_L(n) asm volatile("s_waitcnt lgkmcnt(" #n ")" ::: "memory")
#define PG8_BAR __builtin_amdgcn_s_barrier()
#define PG8_SCHED __builtin_amdgcn_sched_barrier(0)
    Unit cur, nxt; int ui = 0;
    if (!S.next(0, cur)) return;
    f32x4 acc[2][2][4][2];
#pragma unroll
    for (int a = 0; a < 2; ++a)
#pragma unroll
        for (int b = 0; b < 2; ++b)
#pragma unroll
            for (int m = 0; m < 4; ++m)
#pragma unroll
                for (int n = 0; n < 2; ++n) acc[a][b][m][n] = (f32x4){0.f, 0.f, 0.f, 0.f};
    bf16x8 At[4][2], B0[2][2], B1[2][2];
    v8i_t At8[4], B08[2], B18[2];
    int one_scale = 0x7f7f7f7f; asm volatile("" : "+v"(one_scale));
    const char* cB = (const char*)g.Bt + (size_t)cur.pn * tstep;
    const char* cP[2][2]; const char* nP[2][2];
    { Unit uu; for (int i = 0; S.next(i, uu); ++i) if (tid < BM) idxs[i * BM + tid] = rowmap[uu.pm * BM + tid]; }
    asm volatile("s_waitcnt vmcnt(0) lgkmcnt(0)" ::: "memory"); __builtin_amdgcn_s_barrier(); asm volatile("" ::: "memory");
    PG8_ROWPTR(cP, 0);
    S.a_ready(cur);
    if constexpr (SP2) {
        PG8_STAGE(PG8_SB(0, 0), cB, voffB); PG8_STAGE(PG8_SB(0, 1), cB + hstep, voffB); PG8_STAGE_AG(PG8_SA(0, 0), cP, 0, 0); PG8_STAGE_AG(PG8_SA(0, 1), cP, 1, 0);
        if (wr == 1) PG8_BAR;
        PG8_WAIT_V(2); PG8_BAR;
        PG8_STAGE(PG8_SB(1, 0), cB + kstep, voffB); PG8_STAGE_AG(PG8_SA(1, 0), cP, 0, kstep); PG8_STAGE(PG8_SB(1, 1), cB + hstep + kstep, voffB);
        PG8_WAIT_V(6); PG8_BAR;
    }
    for (;;) {
        const bool has_next = S.next(ui + 1, nxt);
        const char* nB = has_next ? (const char*)g.Bt + (size_t)nxt.pn * tstep : cB;
        if (has_next) { PG8_ROWPTR(nP, ui + 1); } else { _Pragma("unroll") for (int _h = 0; _h < 2; ++_h) _Pragma("unroll") for (int _i = 0; _i < 2; ++_i) nP[_h][_i] = cP[_h][_i]; }
#pragma nounroll
        for (int t = 0; t < nt; t += 2) {
            const bool last = (t == nt - 2);
            const size_t k1 = (size_t)(t + 1) * kstep, k2 = last ? 0 : (size_t)(t + 2) * kstep, k3 = k2 + kstep;
            const char* sP[2][2];
            _Pragma("unroll") for (int _h = 0; _h < 2; ++_h) _Pragma("unroll") for (int _i = 0; _i < 2; ++_i) sP[_h][_i] = last ? nP[_h][_i] : cP[_h][_i];
            const char* b2 = last ? nB : cB + (size_t)(t + 2) * kstep; const char* b3 = b2 + kstep;
            if (last && has_next) S.a_ready(nxt);
            if constexpr (SP2) {
            PG8_LDB(B0, 0, 0); PG8_LDB(B1, 0, 1); PG8_SCHED; PG8_LDA(At, 0, 0); PG8_STAGE_AG(PG8_SA(1, 1), cP, 1, k1);
            PG8_WAIT_V(8); PG8_WAIT_L(0); PG8_BAR; PG8_MMA(0, 0, At, B0); PG8_MMA(0, 1, At, B1); PG8_BAR; PG8_SCHED;
            PG8_LDA(At, 0, 1); PG8_STAGE(PG8_SB(0, 0), b2, voffB); PG8_STAGE(PG8_SB(0, 1), b2 + hstep, voffB); PG8_STAGE_AG(PG8_SA(0, 0), sP, 0, k2);
            PG8_WAIT_V(8); PG8_WAIT_L(0); PG8_BAR; PG8_MMA(1, 0, At, B0); PG8_MMA(1, 1, At, B1); PG8_BAR; PG8_SCHED;
            PG8_LDB(B0, 1, 0); PG8_LDB(B1, 1, 1); PG8_SCHED; PG8_LDA(At, 1, 0); PG8_STAGE_AG(PG8_SA(0, 1), sP, 1, k2);
            PG8_WAIT_V(8); PG8_WAIT_L(0); PG8_BAR; PG8_MMA(0, 0, At, B0); PG8_MMA(0, 1, At, B1); PG8_BAR; PG8_SCHED;
            PG8_LDA(At, 1, 1); PG8_STAGE(PG8_SB(1, 0), b3, voffB); PG8_STAGE(PG8_SB(1, 1), b3 + hstep, voffB); PG8_STAGE_AG(PG8_SA(1, 0), sP, 0, k3);
            PG8_WAIT_V(8); PG8_WAIT_L(0); PG8_BAR; PG8_MMA(1, 0, At, B0); PG8_MMA(1, 1, At, B1); PG8_BAR; PG8_SCHED;
            }
        }
        if constexpr (ALIGN_EPI) { if (wr == 0) PG8_BAR; }
        if constexpr (!Epi::AFTER_DRAIN) { E(acc, cur, wr, wc, fr, fq); S.done(cur); }
        if (!has_next) break;
#pragma unroll
        for (int a = 0; a < 2; ++a)
#pragma unroll
            for (int b = 0; b < 2; ++b)
#pragma unroll
                for (int m = 0; m < 4; ++m)
#pragma unroll
                    for (int n = 0; n < 2; ++n) acc[a][b][m][n] = (f32x4){0.f, 0.f, 0.f, 0.f};
        cur = nxt; cB = nB; ++ui;
        _Pragma("unroll") for (int _h = 0; _h < 2; ++_h) _Pragma("unroll") for (int _i = 0; _i < 2; ++_i) cP[_h][_i] = nP[_h][_i];
        if constexpr (ALIGN_EPI) { if (wr == 1) PG8_BAR; }
    }
    PG8_WAIT_V(0);
    if constexpr (!ALIGN_EPI) { if (wr == 0) PG8_BAR; }
    PG8_BAR;
    if constexpr (Epi::AFTER_DRAIN) { E.fused(acc, cur, wr, wc, fr, fq, lds, wid, lane); S.done(cur); }
#undef PG8_SA
#undef PG8_SB
#undef PG8_STAGE
#undef PG8_STAGE_AG
#undef PG8_ROWPTR
#undef PG8_LDA
#undef PG8_LDB
#undef PG8_MMA
#undef PG8_CAT8
#undef PG8_WAIT_V
#undef PG8_WAIT_L
#undef PG8_BAR
#undef PG8_SCHED
}

}

#define LAS __attribute__((address_space(3)))
typedef unsigned short bf16_t;
typedef float f32x4 __attribute__((ext_vector_type(4)));
typedef unsigned u32x4 __attribute__((ext_vector_type(4)));
typedef unsigned u32x2 __attribute__((ext_vector_type(2)));
typedef __bf16 bf16x2_t __attribute__((ext_vector_type(2)));
constexpr int NWAVES = 8, NTHR = 512;
constexpr int D = 1024, NB = 8, SEQ = 4096, LCTX = 256, TX = NB * SEQ, TC = NB * LCTX, TT = TX + TC, INW = 2304, NE = 16, FF = 2048;
constexpr int CAPX = 512, CAPC = 32, SLOTS = NB * CAPX + NB * CAPC;
constexpr float LOG2E = 1.4426950408889634f;
constexpr int LDS_BYTES = 155648;
enum { I_X = 0, I_C, I_CTX, I_CCTX, I_ADAW, I_ADAB, I_N1G, I_N2G, I_WIN, I_HCW, I_HCB, I_HW1, I_HB1, I_HW2, I_HB2, I_HW3, I_HFREQ, I_HSKIP, I_SINK, I_POOLW, I_POOLS, I_RPB, I_WOUT, I_ROUTER, I_WG, I_WU, I_WD, I_FNG, N_IN };
constexpr size_t MiB = 1u << 20;
constexpr size_t WS_CTL = 0;
constexpr size_t WS_MOD = 1 * MiB;
constexpr size_t WS_WSC = 1 * MiB + 512 * 1024;
constexpr size_t WS_ROPE = 2 * MiB;
constexpr size_t WS_TW8 = 2 * MiB + 65536;
constexpr size_t WS_WIN_T = 3 * MiB;
constexpr size_t WS_WOUT_T = 13 * MiB;
constexpr size_t WS_HC = 17 * MiB;
constexpr size_t WS_HCC = 51 * MiB;
constexpr size_t WS_AFFT = 53 * MiB;
constexpr size_t WS_ROWMAP = 56 * MiB;
constexpr size_t WS_GATE = 57 * MiB;
constexpr size_t WS_INV = 58 * MiB;
constexpr size_t WS_CRES = 61 * MiB;
constexpr size_t WS_HX = 69 * MiB;
constexpr size_t WS_WGU_T = 137 * MiB;
constexpr size_t WS_WD_T = 393 * MiB;
constexpr size_t WS_R = 521 * MiB;
constexpr size_t WS_ACT = WS_R;
constexpr size_t WS_XG = WS_R + 272 * MiB;
constexpr size_t WS_PX = WS_R;
constexpr size_t WS_Y = WS_R + 153 * MiB;
constexpr size_t WS_YT = WS_XG + 48 * MiB;
constexpr size_t WS_UT = WS_XG;
constexpr size_t WS_HS = WS_R + 408 * MiB;
constexpr size_t WS_END = WS_HS + 64 * MiB;
static_assert(WS_END <= 1024 * MiB, "workspace map");

struct Args { const float* in[N_IN]; float* out; unsigned char* ws; };

__device__ __forceinline__ float bf2f(unsigned short v) { return __uint_as_float(((unsigned)v) << 16); }
__device__ __forceinline__ unsigned f2bf(float f) { unsigned u = __float_as_uint(f); return (u + 0x7fffu + ((u >> 16) & 1u)) >> 16; }
__device__ __forceinline__ unsigned pk2(float lo, float hi) { return f2bf(lo) | (f2bf(hi) << 16); }
__device__ __forceinline__ float bflo(unsigned w) { return __uint_as_float(w << 16); }
__device__ __forceinline__ float bfhi(unsigned w) { return __uint_as_float(w & 0xffff0000u); }
__device__ __forceinline__ float dot2bf(unsigned a, unsigned b, float acc) { return __builtin_amdgcn_fdot2_f32_bf16(__builtin_bit_cast(bf16x2_t, a), __builtin_bit_cast(bf16x2_t, b), acc, false); }
__device__ __forceinline__ float wave_sum(float v) {
#pragma unroll
    for (int o = 1; o < 64; o <<= 1) v += __shfl_xor(v, o);
    return v;
}
#define LDS_WAIT() asm volatile("s_waitcnt lgkmcnt(0)" ::: "memory")

#ifndef AMP_PHASE
#define AMP_PHASE -1
#endif
__device__ __forceinline__ unsigned long long amp_now() { asm volatile("s_waitcnt vmcnt(0) lgkmcnt(0)" ::: "memory"); __builtin_amdgcn_sched_barrier(0); const unsigned long long t = __builtin_amdgcn_s_memrealtime(); asm volatile("s_waitcnt lgkmcnt(0)" ::: "memory"); __builtin_amdgcn_sched_barrier(0); return t; }
#define AMP_BEGIN(id) unsigned long long amp_t0_ = 0; if ((id) == AMP_PHASE) { __syncthreads(); amp_t0_ = amp_now(); }
#define AMP_END(id) if ((id) == AMP_PHASE) { __syncthreads(); const unsigned long long t1_ = amp_now(); const unsigned long long d_ = t1_ - amp_t0_; while (amp_now() - t1_ < d_) __builtin_amdgcn_s_sleep(8); __syncthreads(); }
__device__ __forceinline__ void tr_item(const float* W, int K, int N, bf16_t* WT, int Kt, int item, int mode, LAS float* scr, int lane) {
    const int nblk = N / 32, kb = item / nblk, nb = item % nblk, k0 = 64 * kb, n0 = 32 * nb;
    const int r8 = lane >> 3, c4 = lane & 7; f32x4 v[8];
    const float* wp = W + (size_t)(k0 + r8) * N + n0 + 4 * c4;
#pragma unroll
    for (int i = 0; i < 8; ++i) v[i] = *(const f32x4*)(wp + (size_t)(8 * i) * N);
#pragma unroll
    for (int i = 0; i < 8; ++i) { LAS float* d = scr + (r8 + 8 * i) * 33 + 4 * c4; d[0] = v[i][0]; d[1] = v[i][1]; d[2] = v[i][2]; d[3] = v[i][3]; }
    LDS_WAIT();
    const int c = lane & 7;
    const int drow0 = (mode == 0) ? n0 : ((n0 >> 7) * 256 + (n0 & 127) + (mode == 2 ? 128 : 0));
#pragma unroll
    for (int j = 0; j < 4; ++j) { const int n = (lane >> 3) + 8 * j; const LAS float* sp = scr + (8 * c) * 33 + n;
        u32x4 o; o.x = pk2(sp[0 * 33], sp[1 * 33]); o.y = pk2(sp[2 * 33], sp[3 * 33]); o.z = pk2(sp[4 * 33], sp[5 * 33]); o.w = pk2(sp[6 * 33], sp[7 * 33]);
        *(u32x4*)(WT + (size_t)(drow0 + n) * Kt + k0 + 8 * c) = o; }
    LDS_WAIT();
}

__device__ __forceinline__ void tr_item_fp8(const float* W, int K, int N, unsigned char* WT, int Kt, int item, int mode, LAS float* scr, int lane, float* wsc_out) {
    const int nblk = N / 32, kb = item / nblk, nb = item % nblk, k0 = 64 * kb, n0 = 32 * nb;
    const int r8 = lane >> 3, c4 = lane & 7; f32x4 v[8];
    const f32x4 sv = *(const f32x4*)(W + 4 * lane);
    const float* wp = W + (size_t)(k0 + r8) * N + n0 + 4 * c4;
#pragma unroll
    for (int i = 0; i < 8; ++i) v[i] = *(const f32x4*)(wp + (size_t)(8 * i) * N);
    float sm = fmaxf(fmaxf(fabsf(sv[0]), fabsf(sv[1])), fmaxf(fabsf(sv[2]), fabsf(sv[3])));
#pragma unroll
    for (int o = 1; o < 64; o <<= 1) sm = fmaxf(sm, __shfl_xor(sm, o));
    int E = 0; (void)frexpf(fmaxf(sm, 1e-30f), &E); const float mul = ldexpf(1.0f, 5 - E);
    if (item == 0 && lane == 0) *wsc_out = ldexpf(1.0f, E - 5);
#pragma unroll
    for (int i = 0; i < 8; ++i) { LAS float* d = scr + (r8 + 8 * i) * 33 + 4 * c4; d[0] = v[i][0] * mul; d[1] = v[i][1] * mul; d[2] = v[i][2] * mul; d[3] = v[i][3] * mul; }
    LDS_WAIT();
    const int c = lane & 7;
    const int drow0 = (mode == 0) ? n0 : ((n0 >> 7) * 256 + (n0 & 127) + (mode == 2 ? 128 : 0));
#pragma unroll
    for (int j = 0; j < 4; ++j) { const int n = (lane >> 3) + 8 * j; const LAS float* sp = scr + (8 * c) * 33 + n;
        int p0 = 0, p1 = 0;
        p0 = __builtin_amdgcn_cvt_pk_fp8_f32(sp[0 * 33], sp[1 * 33], p0, false); p0 = __builtin_amdgcn_cvt_pk_fp8_f32(sp[2 * 33], sp[3 * 33], p0, true);
        p1 = __builtin_amdgcn_cvt_pk_fp8_f32(sp[4 * 33], sp[5 * 33], p1, false); p1 = __builtin_amdgcn_cvt_pk_fp8_f32(sp[6 * 33], sp[7 * 33], p1, true);
        typedef int i32x2v __attribute__((ext_vector_type(2)));
        *(i32x2v*)(WT + (size_t)(drow0 + n) * Kt + k0 + 8 * c) = (i32x2v){p0, p1}; }
    LDS_WAIT();
}

__device__ __forceinline__ void filter_item(const Args& a, LAS unsigned char* lds, int item, int tid) {
    asm volatile("" : "+v"(tid));
    const int lane = tid & 63, wave = tid >> 6;
    int l, L, p0; float* HCdst;
    if (item < 128) { l = 0; L = 4096; p0 = item * 32; HCdst = (float*)(a.ws + WS_HC); }
    else if (item < 256) { l = 1; L = 4096; p0 = (item - 128) * 32; HCdst = (float*)(a.ws + WS_HC) + (size_t)2 * 8191 * 256; }
    else { l = 0; L = 256; p0 = (item - 256) * 32; HCdst = (float*)(a.ws + WS_HCC) + 256; }
    LAS float* w1s = (LAS float*)lds; LAS float* w2s = w1s + 33 * 64; LAS float* b1s = w2s + 64 * 64; LAS float* b2s = b1s + 64; LAS float* frs = b2s + 64; LAS float* h2s = frs + 64; LAS float* ex = h2s + 32 * 64;
    { const float* w1 = a.in[I_HW1] + l * 33 * 64; const float* w2 = a.in[I_HW2] + l * 64 * 64;
      for (int i = tid; i < 33 * 64; i += NTHR) w1s[i] = w1[i];
      for (int i = tid; i < 64 * 64; i += NTHR) w2s[i] = w2[i];
      if (tid < 64) { b1s[tid] = a.in[I_HB1][l * 64 + tid]; b2s[tid] = a.in[I_HB2][l * 64 + tid]; frs[tid] = a.in[I_HFREQ][l * 64 + tid]; } }
    __syncthreads();
    const float frq = frs[lane];
#pragma unroll 1
    for (int q = 0; q < 4; ++q) { const int pp = wave * 4 + q, p = p0 + pp; const float tn = (float)p / (float)(L - 1);
        float fv = 0.f;
        if (lane == 0) fv = tn;
        else if (lane <= 32) { const int bi = (lane - 1) & 15; const float band = 1e-4f + (float)bi * ((15.0f - 1e-4f) / 15.0f);
            const float ang = ((float)(6.283185307179586 / (double)L) * (float)p) * band; fv = (lane <= 16) ? cosf(ang) : -sinf(ang); }
        float a1 = b1s[lane];
#pragma unroll
        for (int i = 0; i < 33; ++i) a1 += __shfl(fv, i) * w1s[i * 64 + lane];
        const float h1 = sinf(frq * a1);
        float a2 = b2s[lane];
#pragma unroll 16
        for (int i = 0; i < 64; ++i) a2 += __shfl(h1, i) * w2s[i * 64 + lane];
        h2s[pp * 64 + lane] = sinf(frq * a2); }
    __syncthreads();
    const float* w3 = a.in[I_HW3] + (size_t)l * 64 * 1024 + tid;
    float acc0[32], acc1[32];
#pragma unroll
    for (int pp = 0; pp < 32; ++pp) { acc0[pp] = 0.f; acc1[pp] = 0.f; }
#pragma unroll 4
    for (int i = 0; i < 64; ++i) { const float wa = w3[i * 1024], wb = w3[i * 1024 + 512];
#pragma unroll
        for (int pp = 0; pp < 32; ++pp) { const float h = h2s[pp * 64 + i]; acc0[pp] += h * wa; acc1[pp] += h * wb; } }
    const int c = tid & 255, dir = tid >> 8; const float dmin = 3.0701134573253945f, dmax = 15.350567286626972f; const float delta = dmin + (float)c * ((dmax - dmin) / 255.0f);
    float* base0 = HCdst; float* base1 = HCdst + (size_t)(2 * L - 1) * 256;
#pragma unroll
    for (int pp = 0; pp < 32; ++pp) { const int p = p0 + pp; const float tn = (float)p / (float)(L - 1); const float win = expf(-tn * delta); const float v0 = acc0[pp] * win, v1 = acc1[pp] * win;
        if (p == 0) { ex[tid] = v0; ex[512 + tid] = v1; }
        else { const size_t idx = (size_t)(dir == 0 ? (L - 1 + p) : (L - 1 - p)) * 256 + c; base0[idx] = v0; base1[idx] = v1; } }
    __syncthreads();
    if (p0 == 0 && tid < 256) { const size_t idx = (size_t)(L - 1) * 256 + tid; base0[idx] = ex[tid] + ex[tid + 256]; base1[idx] = ex[512 + tid] + ex[512 + tid + 256]; }
    __syncthreads();
}


typedef int v8i_t __attribute__((ext_vector_type(8)));
__device__ __forceinline__ float st_A(int i, int k) { return (float)(((i * 7 + k * 3) % 5) - 2); }
__device__ __forceinline__ float st_B(int k, int j) { return (float)(((k * 5 + j * 11 + (k >> 4)) % 5) - 2); }
__device__ __forceinline__ void fp8_selftest(unsigned* poison, int lane) {
    const int fr = lane & 15, fq = lane >> 4; v8i_t av, bv;
#pragma unroll
    for (int w = 0; w < 8; ++w) { int pa = 0, pb = 0;
#pragma unroll
        for (int q = 0; q < 4; ++q) { }
        const int kb = (w < 4) ? (16 * fq + 4 * w) : (64 + 16 * fq + 4 * (w - 4));
        pa = __builtin_amdgcn_cvt_pk_fp8_f32(st_A(fr, kb), st_A(fr, kb + 1), pa, false); pa = __builtin_amdgcn_cvt_pk_fp8_f32(st_A(fr, kb + 2), st_A(fr, kb + 3), pa, true);
        pb = __builtin_amdgcn_cvt_pk_fp8_f32(st_B(kb, fr), st_B(kb + 1, fr), pb, false); pb = __builtin_amdgcn_cvt_pk_fp8_f32(st_B(kb + 2, fr), st_B(kb + 3, fr), pb, true);
        av[w] = pa; bv[w] = pb; }
    f32x4 acc = {0.f, 0.f, 0.f, 0.f};
    acc = __builtin_amdgcn_mfma_scale_f32_16x16x128_f8f6f4(av, bv, acc, 0, 0, 0, 0x7f7f7f7f, 0, 0x7f7f7f7f);
    bool bad = false;
#pragma unroll
    for (int r = 0; r < 4; ++r) { float ref = 0.f; for (int k = 0; k < 128; ++k) ref += st_A(4 * fq + r, k) * st_B(k, fr); bad |= (acc[r] != ref); }
    if (__any(bad) && lane == 0) __hip_atomic_store(poison, 1u, __ATOMIC_RELAXED, __HIP_MEMORY_SCOPE_AGENT);
}

__device__ __forceinline__ void phase_prologue(const Args& a, unsigned char* ldsg, int vcu, int G) {
    LAS unsigned char* lds = (LAS unsigned char*)ldsg;
    int tid_ = threadIdx.x; asm volatile("" : "+v"(tid_));
    const int tid = tid_, lane = tid & 63, wave = __builtin_amdgcn_readfirstlane(tid >> 6);
    unsigned char* ws = a.ws;
    if (vcu == 2 % G && wave == 0) fp8_selftest((unsigned*)(ws + WS_CTL) + 12288, lane);
    LAS float* sc = (LAS float*)lds; LAS float* red = (LAS float*)(lds + 36864);
    for (int i = tid; i < 9 * 1024; i += NTHR) { const float v = (i < 8192) ? a.in[I_C][i] : a.in[I_CCTX][i - 8192]; sc[i] = v / (1.0f + expf(-v)); }
    __syncthreads();
    { AMP_BEGIN(41)
    float* MOD = (float*)(ws + WS_MOD);
    for (int item = vcu; item < 2 * 96; item += G) {
        const int l = item / 96, n0 = (item % 96) * 64, col = tid & 63, kg = tid >> 6;
        float acc[9];
#pragma unroll
        for (int r = 0; r < 9; ++r) acc[r] = 0.f;
        const float* w = a.in[I_ADAW] + (size_t)l * 1024 * 6144 + n0 + col;
#pragma unroll 4
        for (int k = kg * 128; k < kg * 128 + 128; ++k) { const float wv = w[(size_t)k * 6144];
#pragma unroll
            for (int r = 0; r < 9; ++r) acc[r] += sc[r * 1024 + k] * wv; }
#pragma unroll
        for (int r = 0; r < 9; ++r) red[(kg * 9 + r) * 64 + col] = acc[r];
        __syncthreads();
        for (int o = tid; o < 9 * 64; o += NTHR) { const int r = o >> 6, cc = o & 63; float s = 0.f;
#pragma unroll
            for (int g2 = 0; g2 < 8; ++g2) s += red[(g2 * 9 + r) * 64 + cc];
            MOD[(size_t)(l * 9 + r) * 6144 + n0 + cc] = s + a.in[I_ADAB][l * 6144 + n0 + cc]; }
        __syncthreads();
    }
    AMP_END(41) }
    if (vcu == 0) { float* ROPE = (float*)(ws + WS_ROPE);
        for (int i = tid; i < 1024; i += NTHR) { const int pos = i >> 4, fi = i & 15; const float inv = powf(10000.0f, -(float)fi / 16.0f); const float ang = (float)pos * inv;
            ROPE[2 * i] = cosf(ang); ROPE[2 * i + 1] = sinf(ang); } }
    if (vcu == 1 % G) { float* TW8 = (float*)(ws + WS_TW8);
        for (int i = tid; i < 8192; i += NTHR) { float sn, cs; sincospif(-(float)i * (1.0f / 4096.0f), &sn, &cs); TW8[2 * i] = cs; TW8[2 * i + 1] = sn; } }
    const int gw = vcu * NWAVES + wave, NGW = G * NWAVES;
    { AMP_BEGIN(42)
    for (int it = vcu; it < 264; it += G) filter_item(a, lds, it, tid);
    AMP_END(42) }
    { AMP_BEGIN(43)
    LAS float* scr = (LAS float*)(lds + 65536 + wave * 8448);
    constexpr int IT_IN = 16 * 72, IT_OUT = 16 * 32, IT_E = 1024, IT_LAYER = IT_IN + IT_OUT + 3 * 16 * IT_E;
    for (int it = gw; it < 2 * IT_LAYER; it += NGW) {
        const int l = it / IT_LAYER; int r = it % IT_LAYER;
        if (r < IT_IN) { tr_item(a.in[I_WIN] + (size_t)l * 1024 * 2304, 1024, 2304, (bf16_t*)(ws + WS_WIN_T) + (size_t)l * 2304 * 1024, 1024, r, 0, scr, lane); continue; } r -= IT_IN;
        if (r < IT_OUT) { tr_item(a.in[I_WOUT] + (size_t)l * 1024 * 1024, 1024, 1024, (bf16_t*)(ws + WS_WOUT_T) + (size_t)l * 1024 * 1024, 1024, r, 0, scr, lane); continue; } r -= IT_OUT;
        const int which = r / (16 * IT_E), e = (r / IT_E) & 15, ri = r % IT_E; const size_t le = (size_t)l * 16 + e;
        float* wsc = (float*)(ws + WS_WSC) + (l * 3 + which) * 16 + e;
        if (which == 0) tr_item_fp8(a.in[I_WG] + le * 1024 * 2048, 1024, 2048, (unsigned char*)(ws + WS_WGU_T) + le * 4096 * 1024, 1024, ri, 1, scr, lane, wsc);
        else if (which == 1) tr_item_fp8(a.in[I_WU] + le * 1024 * 2048, 1024, 2048, (unsigned char*)(ws + WS_WGU_T) + le * 4096 * 1024, 1024, ri, 2, scr, lane, wsc);
        else tr_item_fp8(a.in[I_WD] + le * 2048 * 1024, 2048, 1024, (unsigned char*)(ws + WS_WD_T) + le * 1024 * 2048, 2048, ri, 0, scr, lane, wsc);
    }
    AMP_END(43) }
}

__device__ __forceinline__ void phase_norm(const Args& a, unsigned char* ldsg, int vcu, int G, int l, const float* srcx, const float* srcc, const float* gain, int shift_idx, int nrows, bool router) {
    int tid_ = threadIdx.x; asm volatile("" : "+v"(tid_));
    const int tid = tid_, lane = tid & 63, wave = __builtin_amdgcn_readfirstlane(tid >> 6);
    unsigned char* ws = a.ws; const float* MOD = (const float*)(ws + WS_MOD) + (size_t)l * 9 * 6144; bf16_t* HX = (bf16_t*)(ws + WS_HX);
    LAS float* rw = (LAS float*)(LAS unsigned char*)ldsg;
    if (router) { const float* rsrc = a.in[I_ROUTER] + (size_t)l * 1024 * 16; for (int i = tid; i < 1024 * 16; i += NTHR) rw[(i & 15) * 1024 + (i >> 4)] = rsrc[i]; __syncthreads(); }
    const int gw = vcu * NWAVES + wave, NGW = G * NWAVES;
    for (int row = gw; row < nrows; row += NGW) {
        const bool lat = row < TX; const float* xr = lat ? srcx + (size_t)row * D : srcc + (size_t)(row - TX) * D; const int mrow = lat ? (row >> 12) : 8;
        const float* shp = MOD + mrow * 6144 + shift_idx * 1024; const float* scp = shp + 1024;
        f32x4 v[4]; float ss = 0.f;
#pragma unroll
        for (int j = 0; j < 4; ++j) { v[j] = *(const f32x4*)(xr + 256 * j + 4 * lane); ss += (v[j][0] * v[j][0] + v[j][1] * v[j][1]) + (v[j][2] * v[j][2] + v[j][3] * v[j][3]); }
        const float rstd = 1.0f / sqrtf(wave_sum(ss) * (1.0f / D) + 1e-6f);
#pragma unroll
        for (int j = 0; j < 4; ++j) { const f32x4 gg = *(const f32x4*)(gain + 256 * j + 4 * lane), sh = *(const f32x4*)(shp + 256 * j + 4 * lane), sc = *(const f32x4*)(scp + 256 * j + 4 * lane);
            v[j] = (v[j] * rstd * gg) * (1.0f + sc) + sh;
            if (router) { int p = 0; p = __builtin_amdgcn_cvt_pk_fp8_f32(fminf(fmaxf(v[j][0], -448.f), 448.f), fminf(fmaxf(v[j][1], -448.f), 448.f), p, false); p = __builtin_amdgcn_cvt_pk_fp8_f32(fminf(fmaxf(v[j][2], -448.f), 448.f), fminf(fmaxf(v[j][3], -448.f), 448.f), p, true);
                *(int*)((unsigned char*)HX + (size_t)row * D + 256 * j + 4 * lane) = p; }
            else { u32x2 o; o.x = pk2(v[j][0], v[j][1]); o.y = pk2(v[j][2], v[j][3]); *(u32x2*)(HX + (size_t)row * D + 256 * j + 4 * lane) = o; } }
        if (router) {
            float pl[16];
#pragma unroll
            for (int e = 0; e < 16; ++e) { float p = 0.f;
#pragma unroll
                for (int j = 0; j < 4; ++j) { const f32x4 wv = *(const LAS f32x4*)(rw + e * 1024 + 256 * j + 4 * lane);
                    p += (v[j][0] * wv[0] + v[j][1] * wv[1]) + (v[j][2] * wv[2] + v[j][3] * wv[3]); }
                pl[e] = p; asm volatile("" : "+v"(pl[e])); }
            float q8[8], q4[4], q2[2], q1;
            { const bool up = (lane & 8) != 0;
#pragma unroll
              for (int e = 0; e < 8; ++e) { const float keep = up ? pl[e + 8] : pl[e], give = up ? pl[e] : pl[e + 8]; q8[e] = keep + __shfl_xor(give, 8); } }
            { const bool up = (lane & 4) != 0;
#pragma unroll
              for (int e = 0; e < 4; ++e) { const float keep = up ? q8[e + 4] : q8[e], give = up ? q8[e] : q8[e + 4]; q4[e] = keep + __shfl_xor(give, 4); } }
            { const bool up = (lane & 2) != 0;
#pragma unroll
              for (int e = 0; e < 2; ++e) { const float keep = up ? q4[e + 2] : q4[e], give = up ? q4[e] : q4[e + 2]; q2[e] = keep + __shfl_xor(give, 2); } }
            { const bool up = (lane & 1) != 0; const float keep = up ? q2[1] : q2[0], give = up ? q2[0] : q2[1]; q1 = keep + __shfl_xor(give, 1); }
            q1 += __shfl_xor(q1, 16); q1 += __shfl_xor(q1, 32);
            const float mylog = (lane < 16) ? q1 : -1e30f;
            float mx = mylog;
#pragma unroll
            for (int o = 1; o < 16; o <<= 1) mx = fmaxf(mx, __shfl_xor(mx, o));
            const float mine = (lane < 16) ? expf(mylog - mx) : 0.f; float den = mine;
#pragma unroll
            for (int o = 1; o < 16; o <<= 1) den += __shfl_xor(den, o);
            if (lane < 16) { ((float*)(ws + WS_AFFT))[(size_t)lane * TT + row] = mine / den; ((int*)(ws + WS_INV))[(size_t)row * 16 + lane] = -1; }
        }
    }
}

#define XB_TMO      128
#define XB_XCNT(j)  (256  + 64 * (j))
#define XB_XSUB(j)  (1280 + 64 * (j))
#define XB_XGEN(j)  (2304 + 64 * (j))
#define XB_TOP      3328
#define XB_TOPGEN   3392
#define XCD_BAR_WORDS 3456
#define XB_SPIN_CAP (1u << 18)

__device__ __forceinline__ unsigned xb_ld(unsigned* p)              { return __hip_atomic_load(p, __ATOMIC_RELAXED, __HIP_MEMORY_SCOPE_AGENT); }
__device__ __forceinline__ unsigned xb_add(unsigned* p, unsigned v) { return __hip_atomic_fetch_add(p, v, __ATOMIC_RELAXED, __HIP_MEMORY_SCOPE_AGENT); }
__device__ __forceinline__ unsigned xb_xcc_id() { return (unsigned)__builtin_amdgcn_s_getreg((3 << 11) | 20) & 0xFu; }
#define XB_SPIN(cond, bar) do { unsigned _sp = 0; while (cond) { __builtin_amdgcn_s_sleep(1); \
    if ((++_sp & 255u) == 0u) { if (xb_ld(&(bar)[XB_TMO])) break; if (_sp > XB_SPIN_CAP) { atomicAdd(&(bar)[XB_TMO], 1u); break; } } } } while (0)

struct XcdBarrier {
    unsigned* bar; unsigned x;
    volatile LAS unsigned* st;
};

__device__ __forceinline__ XcdBarrier xcd_barrier_post(unsigned* bar, volatile LAS unsigned* st) {
    XcdBarrier b; b.bar = bar; b.x = xb_xcc_id(); b.st = st;
    if (threadIdx.x == 0) (void)xb_add(&bar[XB_XCNT(b.x)], 1u);
    return b;
}
__device__ __forceinline__ void xcd_barrier_complete(unsigned* bar, unsigned x, unsigned& nloc, unsigned& nx) {
    const unsigned G = gridDim.x * gridDim.y * gridDim.z;
    unsigned sum, cnt, mine, sp = 0u;
    for (;;) {
        sum = 0u; cnt = 0u; mine = 0u;
#pragma unroll
        for (unsigned j = 0; j < 16; ++j) { const unsigned c = xb_ld(&bar[XB_XCNT(j)]); sum += c; cnt += (c > 0u) ? 1u : 0u; mine = (j == x) ? c : mine; }
        if (sum == G) break;
        __builtin_amdgcn_s_sleep(1);
        if ((++sp & 255u) == 0u) { if (xb_ld(&bar[XB_TMO])) break; if (sp > XB_SPIN_CAP) { atomicAdd(&bar[XB_TMO], 1u); break; } }
    }
    nloc = mine > 0u ? mine : 1u; nx = cnt > 0u ? cnt : 1u;
}

__device__ __forceinline__ void xcd_barrier(const XcdBarrier& b) {
    asm volatile("s_waitcnt vmcnt(0)" ::: "memory");
    __syncthreads();
    if (threadIdx.x == 0) {
        unsigned* bar = b.bar;
        __builtin_amdgcn_s_waitcnt(0);
        unsigned nloc = b.st[0], nx = b.st[1];
        if (nloc == 0u) { xcd_barrier_complete(bar, b.x, nloc, nx); b.st[0] = nloc; b.st[1] = nx; }
        const unsigned old = xb_add(&bar[XB_XSUB(b.x)], 1u);
        const unsigned gen = old / nloc;
        if (old + 1u == (gen + 1u) * nloc) {
            __builtin_amdgcn_fence(__ATOMIC_RELEASE, "agent");
            asm volatile("s_waitcnt vmcnt(0)" ::: "memory");
            const unsigned og = xb_add(&bar[XB_TOP], 1u);
            const unsigned tg = og / nx;
            if (og + 1u == (tg + 1u) * nx) xb_add(&bar[XB_TOPGEN], 1u);
            else XB_SPIN(xb_ld(&bar[XB_TOPGEN]) == tg, bar);
            __builtin_amdgcn_fence(__ATOMIC_ACQUIRE, "agent");
            xb_add(&bar[XB_XGEN(b.x)], 1u);
            asm volatile("s_waitcnt vmcnt(0)" ::: "memory");
        } else {
            XB_SPIN(xb_ld(&bar[XB_XGEN(b.x)]) == gen, bar);
            __builtin_amdgcn_fence(__ATOMIC_ACQUIRE, "agent");
            asm volatile("s_waitcnt vmcnt(0)" ::: "memory");
        }
    }
    __syncthreads();
}


typedef float f32x2 __attribute__((ext_vector_type(2)));
__device__ __forceinline__ f32x2 cmul(f32x2 a, f32x2 b) { return (f32x2){a.x * b.x - a.y * b.y, a.x * b.y + a.y * b.x}; }
__device__ __forceinline__ void dft16(f32x2 (&v)[16]) {
    constexpr float WC[8] = {1.0f, 0.92387953251128674f, 0.70710678118654752f, 0.38268343236508977f, 0.0f, -0.38268343236508977f, -0.70710678118654752f, -0.92387953251128674f};
    constexpr float WS[8] = {0.0f, -0.38268343236508977f, -0.70710678118654752f, -0.92387953251128674f, -1.0f, -0.92387953251128674f, -0.70710678118654752f, -0.38268343236508977f};
#pragma unroll
    for (int s = 8; s >= 1; s >>= 1)
#pragma unroll
        for (int i = 0; i < 16; ++i) if ((i & s) == 0) { const int k = (i & (s - 1)) * (8 / s); const f32x2 u = v[i], t = v[i + s]; v[i] = u + t; const f32x2 d = u - t;
            v[i + s] = (k == 0) ? d : ((k == 4) ? (f32x2){d.y, -d.x} : (f32x2){d.x * WC[k] - d.y * WS[k], d.x * WS[k] + d.y * WC[k]}); }
}
__device__ __forceinline__ constexpr int bitrev4(int i) { return ((i & 1) << 3) | ((i & 2) << 1) | ((i & 4) >> 1) | ((i & 8) >> 3); }
template <int NS, int MODE>
__device__ __forceinline__ void fft_pass(LAS f32x2* Z, const LAS f32x2* TW, int tid, const f32x2* H) {
    const int f = tid >> 8, j = tid & 255, base = f * 4096, k = j & (NS - 1);
    f32x2 v[16];
#pragma unroll
    for (int r = 0; r < 16; ++r) { const int idx = base + j + 256 * r; v[r] = Z[idx + (idx >> 4)]; }
    if (MODE == 1) {
#pragma unroll
        for (int r = 0; r < 16; ++r) { const f32x2 p = cmul(v[r], H[r]); v[r] = (f32x2){p.y, p.x}; } }
    if (NS > 1) { const LAS f32x2* tp = (NS == 16) ? (TW + 8192 + k) : (TW + 4096 + k);
#pragma unroll
        for (int r = 1; r < 16; ++r) v[r] = cmul(v[r], tp[r * NS]); }
    dft16(v);
    if (NS != 256) __syncthreads();
    const int j0 = base + (j / NS) * NS * 16 + k;
#pragma unroll
    for (int rr = 0; rr < 16; ++rr) { const int idx = j0 + rr * NS; Z[idx + (idx >> 4)] = v[bitrev4(rr)]; }
    __syncthreads();
}
__device__ __forceinline__ void load_uc(const bf16_t* UT, const float* cw, const float* cb, int ch, int b, int tid, float (&out)[8]) {
    const bf16_t* p = UT + ((size_t)(b * 768 + ch)) * 4096 + 8 * tid;
    const u32x4 w = *(const u32x4*)p; float u[10];
    u[1] = bflo(w.x); u[2] = bfhi(w.x); u[3] = bflo(w.y); u[4] = bfhi(w.y); u[5] = bflo(w.z); u[6] = bfhi(w.z); u[7] = bflo(w.w); u[8] = bfhi(w.w);
    u[0] = (tid > 0) ? bf2f(p[-1]) : 0.f; u[9] = (tid < 511) ? bf2f(p[8]) : 0.f;
    const float w0 = cw[ch], w1 = cw[768 + ch], w2 = cw[1536 + ch], bb = cb[ch];
#pragma unroll
    for (int i = 0; i < 8; ++i) out[i] = u[i] * w0 + u[i + 1] * w1 + u[i + 2] * w2 + bb;
}
__device__ __forceinline__ void hy_fill(LAS f32x2* Z, const LAS f32x2* TW, int tid, const float (&va)[8], const float (&vb)[8]) {
#pragma unroll
    for (int i = 0; i < 8; ++i) { const int t = 8 * tid + i; const f32x2 z = {va[i], vb[i]}; Z[t + (t >> 4)] = z; const int t2 = 4096 + t; Z[t2 + (t2 >> 4)] = cmul(z, TW[t]); }
    __syncthreads();
}
__device__ __forceinline__ void hy_conv(LAS f32x2* Z, const LAS f32x2* TW, int tid, const f32x2* Hg) {
    f32x2 H[16];
    { const int f = tid >> 8, j = tid & 255, base = f * 4096;
#pragma unroll
      for (int r = 0; r < 16; ++r) H[r] = Hg[base + j + 256 * r]; }
    fft_pass<1, 0>(Z, TW, tid, nullptr); fft_pass<16, 0>(Z, TW, tid, nullptr); fft_pass<256, 0>(Z, TW, tid, nullptr);
    fft_pass<1, 1>(Z, TW, tid, H); fft_pass<16, 0>(Z, TW, tid, nullptr); fft_pass<256, 0>(Z, TW, tid, nullptr);
}
__device__ __forceinline__ f32x2 hy_out(const LAS f32x2* Z, const LAS f32x2* TW, int t) {
    const f32x2 se = Z[t + (t >> 4)]; const int t2 = 4096 + t; const f32x2 so = Z[t2 + (t2 >> 4)]; const f32x2 tw = TW[t];
    const f32x2 So = {so.y, so.x};
    return (f32x2){se.y + (So.x * tw.x + So.y * tw.y), se.x + (So.y * tw.x - So.x * tw.y)};
}
__device__ __forceinline__ void hyena_item(const Args& a, LAS unsigned char* lds, int l, int c, int bp, int tid) {
    asm volatile("" : "+v"(tid));
    LAS f32x2* Z = (LAS f32x2*)lds; const LAS f32x2* TW = (const LAS f32x2*)(lds + 69632);
    const bf16_t* UT = (const bf16_t*)(a.ws + WS_UT); bf16_t* YT = (bf16_t*)(a.ws + WS_YT);
    const float* cw = a.in[I_HCW] + (size_t)l * 3 * 768; const float* cb = a.in[I_HCB] + (size_t)l * 768; const float* skip = a.in[I_HSKIP] + (size_t)l * 2 * 256;
    const f32x2* HS = (const f32x2*)(a.ws + WS_HS) + ((size_t)(l * 2) * 256 + c) * 8192;
    const int b0 = 2 * bp, b1 = 2 * bp + 1;
    float va[8], vb[8], xa[8], xb[8];
    load_uc(UT, cw, cb, c, b0, tid, va); load_uc(UT, cw, cb, c, b1, tid, vb);
    hy_fill(Z, TW, tid, va, vb);
    hy_conv(Z, TW, tid, HS);
    load_uc(UT, cw, cb, 256 + c, b0, tid, xa); load_uc(UT, cw, cb, 256 + c, b1, tid, xb);
    { const float sk = skip[c];
#pragma unroll
      for (int i = 0; i < 8; ++i) { const f32x2 y = hy_out(Z, TW, 8 * tid + i); va[i] = xa[i] * (y.x + va[i] * sk); vb[i] = xb[i] * (y.y + vb[i] * sk); } }
    __syncthreads();
    hy_fill(Z, TW, tid, va, vb);
    hy_conv(Z, TW, tid, HS + (size_t)256 * 8192);
    load_uc(UT, cw, cb, 512 + c, b0, tid, xa); load_uc(UT, cw, cb, 512 + c, b1, tid, xb);
    { const float sk = skip[256 + c];
      float oa[8], ob[8];
#pragma unroll
      for (int i = 0; i < 8; ++i) { const f32x2 y = hy_out(Z, TW, 8 * tid + i); oa[i] = xa[i] * (y.x + va[i] * sk); ob[i] = xb[i] * (y.y + vb[i] * sk); }
      u32x4 wa, wb; wa.x = pk2(oa[0], oa[1]); wa.y = pk2(oa[2], oa[3]); wa.z = pk2(oa[4], oa[5]); wa.w = pk2(oa[6], oa[7]); wb.x = pk2(ob[0], ob[1]); wb.y = pk2(ob[2], ob[3]); wb.z = pk2(ob[4], ob[5]); wb.w = pk2(ob[6], ob[7]);
      *(u32x4*)(YT + ((size_t)(b0 * 256 + c)) * 4096 + 8 * tid) = wa; *(u32x4*)(YT + ((size_t)(b1 * 256 + c)) * 4096 + 8 * tid) = wb; }
    __syncthreads();
}
__device__ __forceinline__ void spectrum_item(const Args& a, LAS unsigned char* lds, int item, int tid) {
    asm volatile("" : "+v"(tid));
    LAS f32x2* Z = (LAS f32x2*)lds; const LAS f32x2* TW = (const LAS f32x2*)(lds + 69632);
    const int c = item & 255, lo = item >> 8;
    const float* HC = (const float*)(a.ws + WS_HC) + (size_t)lo * 8191 * 256 + c;
#pragma unroll
    for (int i = 0; i < 8; ++i) { const int t = 8 * tid + i; const float hl = HC[(size_t)(4095 + t) * 256], hh = (t == 0) ? 0.f : HC[(size_t)(t - 1) * 256];
        Z[t + (t >> 4)] = (f32x2){hl + hh, 0.f}; const int t2 = 4096 + t; const f32x2 tw = TW[t]; const float dd = hl - hh; Z[t2 + (t2 >> 4)] = (f32x2){dd * tw.x, dd * tw.y}; }
    __syncthreads();
    fft_pass<1, 0>(Z, TW, tid, nullptr); fft_pass<16, 0>(Z, TW, tid, nullptr); fft_pass<256, 0>(Z, TW, tid, nullptr);
    f32x2* HS = (f32x2*)(a.ws + WS_HS) + (size_t)item * 8192;
#pragma unroll
    for (int i = 0; i < 16; ++i) { const int idx = tid + 512 * i; HS[idx] = Z[idx + (idx >> 4)] * (1.0f / 8192.0f); }
    __syncthreads();
}
__device__ __forceinline__ void load_tw(const Args& a, LAS unsigned char* lds, int tid) {
    asm volatile("" : "+v"(tid));
    LAS f32x2* TW = (LAS f32x2*)(lds + 69632); const f32x2* src = (const f32x2*)(a.ws + WS_TW8);
    for (int i = tid; i < 4096; i += NTHR) { TW[i] = src[i]; const int r = i >> 8, k = i & 255; TW[4096 + i] = src[r * k * 2]; }
    if (tid < 256) { const int r = tid >> 4, k = tid & 15; TW[8192 + tid] = src[r * k * 32]; }
    __syncthreads();
}
__device__ __forceinline__ float ctx_uc(const bf16_t* PXc, const float* cw, const float* cb, int ch, int t) {
    const float u1 = bf2f(PXc[(size_t)t * INW + ch]); const float u0 = (t > 0) ? bf2f(PXc[(size_t)(t - 1) * INW + ch]) : 0.f; const float u2 = (t < 255) ? bf2f(PXc[(size_t)(t + 1) * INW + ch]) : 0.f;
    return u0 * cw[ch] + u1 * cw[768 + ch] + u2 * cw[1536 + ch] + cb[ch];
}
__device__ __forceinline__ void ctx_conv16(const LAS float* IN, const float* H, int c, int lane, int t0, float (&acc)[16]) {
    float w[16];
    const float* hp = H + (size_t)(t0 + 255) * 256 + c;
#pragma unroll
    for (int i = 0; i < 16; ++i) { acc[i] = 0.f; w[i] = hp[i * 256]; }
    const LAS float* ip = IN + lane;
#pragma unroll 1
    for (int s0 = 0; s0 < 256; s0 += 16) {
#pragma unroll
        for (int u = 0; u < 16; ++u) { const float v = ip[u * 64];
#pragma unroll
            for (int i = 0; i < 16; ++i) acc[i] += v * w[(i - u + 16) & 15];
            w[(15 - u) & 15] = hp[-(u + 1) * 256]; }
        hp -= 16 * 256; ip += 16 * 64; }
}
__device__ __forceinline__ void ctx_hyena_item(const Args& a, LAS unsigned char* lds, int l, int item, int tid) {
    asm volatile("" : "+v"(tid));
    const int lane = tid & 63, wave = tid >> 6, b = item >> 2, c = (item & 3) * 64 + lane;
    LAS float* V = (LAS float*)lds; LAS float* Z1 = (LAS float*)(lds + 65536);
    const bf16_t* PXc = (const bf16_t*)(a.ws + WS_PX) + (size_t)(TX + b * 256) * INW; bf16_t* Y = (bf16_t*)(a.ws + WS_Y) + (size_t)(TX + b * 256) * D;
    const float* cw = a.in[I_HCW] + (size_t)l * 3 * 768; const float* cb = a.in[I_HCB] + (size_t)l * 768; const float* skip = a.in[I_HSKIP] + (size_t)l * 2 * 256;
    const float* H0 = (const float*)(a.ws + WS_HCC) + 256, *H1 = H0 + (size_t)511 * 256;
#pragma unroll 2
    for (int i = 0; i < 32; ++i) { const int t = wave * 32 + i; V[t * 64 + lane] = ctx_uc(PXc, cw, cb, c, t); }
    __syncthreads();
    float acc[16];
#pragma unroll 1
    for (int g = 0; g < 2; ++g) { const int t0 = wave * 32 + g * 16; ctx_conv16(V, H0, c, lane, t0, acc); const float sk = skip[c];
#pragma unroll
        for (int i = 0; i < 16; ++i) { const int t = t0 + i; Z1[t * 64 + lane] = ctx_uc(PXc, cw, cb, 256 + c, t) * (acc[i] + V[t * 64 + lane] * sk); } }
    __syncthreads();
#pragma unroll 1
    for (int g = 0; g < 2; ++g) { const int t0 = wave * 32 + g * 16; ctx_conv16(Z1, H1, c, lane, t0, acc); const float sk = skip[256 + c];
#pragma unroll
        for (int i = 0; i < 16; ++i) { const int t = t0 + i; Y[(size_t)t * D + c] = (bf16_t)f2bf(ctx_uc(PXc, cw, cb, 512 + c, t) * (acc[i] + Z1[t * 64 + lane] * sk)); } }
    __syncthreads();
}

__device__ __forceinline__ void ytr_item(const Args& a, LAS unsigned char* tile, int item, int lane) {
    const int b = item >> 8, tt = (item >> 2) & 63, ct = item & 3;
    const bf16_t* src = (const bf16_t*)(a.ws + WS_YT) + ((size_t)(b * 256 + ct * 64)) * 4096 + tt * 64; bf16_t* Y = (bf16_t*)(a.ws + WS_Y) + ((size_t)b * 4096 + tt * 64) * D + ct * 64;
    u32x4 v[8];
#pragma unroll
    for (int i = 0; i < 8; ++i) v[i] = *(const u32x4*)(src + (size_t)((lane >> 3) + 8 * i) * 4096 + (lane & 7) * 8);
#pragma unroll
    for (int i = 0; i < 8; ++i) *(LAS u32x4*)(tile + ((lane >> 3) + 8 * i) * 144 + (lane & 7) * 16) = v[i];
    LDS_WAIT();
    const LAS unsigned short* tp = (const LAS unsigned short*)(tile + lane * 2);
#pragma unroll
    for (int q = 0; q < 8; ++q) { u32x4 o;
        o.x = (unsigned)tp[(8 * q + 0) * 72] | ((unsigned)tp[(8 * q + 1) * 72] << 16); o.y = (unsigned)tp[(8 * q + 2) * 72] | ((unsigned)tp[(8 * q + 3) * 72] << 16);
        o.z = (unsigned)tp[(8 * q + 4) * 72] | ((unsigned)tp[(8 * q + 5) * 72] << 16); o.w = (unsigned)tp[(8 * q + 6) * 72] | ((unsigned)tp[(8 * q + 7) * 72] << 16);
        *(u32x4*)(Y + (size_t)lane * D + 8 * q) = o; }
    LDS_WAIT();
}
__device__ __forceinline__ void event_arrive(unsigned* ctr) {
    asm volatile("s_waitcnt vmcnt(0)" ::: "memory"); __syncthreads();
    if (threadIdx.x == 0) { __builtin_amdgcn_fence(__ATOMIC_RELEASE, "agent"); asm volatile("s_waitcnt vmcnt(0)" ::: "memory"); __hip_atomic_fetch_add(ctr, 1u, __ATOMIC_RELAXED, __HIP_MEMORY_SCOPE_AGENT); }
}
__device__ __forceinline__ void event_wait(unsigned* ctr, unsigned want) {
    if (threadIdx.x == 0) { unsigned sp = 0;
        while (__hip_atomic_load(ctr, __ATOMIC_RELAXED, __HIP_MEMORY_SCOPE_AGENT) < want) { __builtin_amdgcn_s_sleep(2); if (++sp > (1u << 22)) break; }
        __builtin_amdgcn_fence(__ATOMIC_ACQUIRE, "agent"); asm volatile("s_waitcnt vmcnt(0)" ::: "memory"); }
    __syncthreads();
}

typedef short bf16x8_t __attribute__((ext_vector_type(8)));
typedef short s16x4_t __attribute__((ext_vector_type(4)));
typedef float f32x16 __attribute__((ext_vector_type(16)));
__device__ __forceinline__ int crow(int r, int hi) { return (r & 3) + 8 * (r >> 2) + 4 * hi; }
__device__ __forceinline__ unsigned cvtpk(float lo, float hi) { f32x2 v = {lo, hi}; bf16x2_t b = __builtin_convertvector(v, bf16x2_t); return __builtin_bit_cast(unsigned, b); }
__device__ __forceinline__ s16x4_t vtr(const LAS unsigned char* p) { return __builtin_bit_cast(s16x4_t, __builtin_amdgcn_ds_read_tr16_b64_v4i16((LAS s16x4_t*)p)); }
constexpr int AT_K = 0, AT_V = 16384, AT_WSF = 32768, AT_OST = 34816, AT_RPB = 67584, AT_END = 69632;
template <int KIND>
__device__ __forceinline__ void attn_unit(const Args& a, LAS unsigned char* lds, int l, int u, int tid) {
    asm volatile("" : "+v"(tid));
    const int lane = tid & 63, wid = __builtin_amdgcn_readfirstlane(tid >> 6), r32 = lane & 31, hi = lane >> 5;
    const bf16_t* PX = (const bf16_t*)(a.ws + WS_PX); bf16_t* Y = (bf16_t*)(a.ws + WS_Y);
    int b, qcol, kcol, vcol, ycol, qrow0, nloc = 0, lo = 0; bool sink = false; int hsink = 0;
    int qpos0 = 0, blk = 0, rq = 0, cbase = 0, rq4 = 0;
    if (KIND == 0) { b = u >> 6; const int kvh = (u >> 5) & 1; blk = u & 31; const int h = 2 * kvh + (wid >> 2); qpos0 = blk * 128 + 32 * (wid & 3); qrow0 = b * 4096 + qpos0;
        qcol = 1024 + h * 64; kcol = 1536 + kvh * 64; vcol = 1664 + kvh * 64; ycol = 256 + h * 64; lo = (blk == 0) ? 2 : 0; nloc = ((blk == 31) ? 3 : 5) - lo + 1; sink = true; hsink = h; }
    else if (KIND == 1) { b = u >> 6; const int h = (u >> 4) & 3; rq4 = u & 15; rq = 4 * rq4 + (wid >> 1); cbase = 32 * (wid & 1); qrow0 = b * 4096 + rq * 64 + cbase;
        qcol = 1280 + h * 64; kcol = 1792 + h * 64; vcol = 2048 + h * 64; ycol = 768 + h * 64;
        const int ra = 4 * rq4 - 4, rb = 4 * rq4 + 3 - 4; lo = ra < 0 ? 0 : (ra > 56 ? 56 : ra); const int hi_r = (rb < 0 ? 0 : (rb > 56 ? 56 : rb)) + 7; nloc = hi_r - lo + 1;
        LAS float* rpbL = (LAS float*)(lds + AT_RPB); const float* src = a.in[I_RPB] + (size_t)(l * 4 + h) * 465;
        for (int i = tid; i < 465; i += NTHR) rpbL[i] = src[i] * LOG2E; }
    else { b = u >> 3; const int h = (u >> 1) & 3; qrow0 = TX + b * 256 + 32 * wid;
        if ((u & 1) == 0) { qcol = 1024 + h * 64; kcol = 1536 + (h >> 1) * 64; vcol = 1664 + (h >> 1) * 64; ycol = 256 + h * 64; sink = true; hsink = h; }
        else { qcol = 1280 + h * 64; kcol = 1792 + h * 64; vcol = 2048 + h * 64; ycol = 768 + h * 64; } }
    const int NT = nloc + 4;
    bf16x8_t qr[4];
    { const bf16_t* qp = PX + (size_t)(qrow0 + r32) * INW + qcol + hi * 8;
#pragma unroll
      for (int d0 = 0; d0 < 4; ++d0) qr[d0] = *(const bf16x8_t*)(qp + d0 * 16); }
    const int krow = 8 * wid + (lane & 7), kchunk = lane >> 3; const int vrow = 16 * (wid & 3) + (lane >> 2), vcoff = (wid >> 2) * 32 + (lane & 3) * 8;
    const int kdst = AT_K + kchunk * 1024 + krow * 16, vdst = AT_V + wid * 1024 + lane * 16;
    auto tile_row0 = [&](int t) -> int { if (t < nloc) { if (KIND == 0) return b * 4096 + blk * 128 - 128 + 64 * (lo + t); else return b * 4096 + (lo + t) * 64; } return TX + b * 256 + 64 * (t - nloc); };
    u32x4 gk0, gv0, gk1, gv1;
#define AT_LOAD(GK, GV, t_) do { const int R0_ = tile_row0(t_); GK = *(const u32x4*)(PX + (size_t)(R0_ + krow) * INW + kcol + kchunk * 8); GV = *(const u32x4*)(PX + (size_t)(R0_ + vrow) * INW + vcol + vcoff); } while (0)
    AT_LOAD(gk0, gv0, 0);
    if (NT > 1) AT_LOAD(gk1, gv1, 1); else { gk1 = gk0; gv1 = gv0; }
    *(LAS u32x4*)(lds + kdst) = gk0; *(LAS u32x4*)(lds + vdst) = gv0;
    float mhat = -1e30f, l_reg = 0.f; f32x16 o[2];
#pragma unroll
    for (int r = 0; r < 16; ++r) { o[0][r] = 0.f; o[1][r] = 0.f; }
    LAS float* wsf = (LAS float*)(lds + AT_WSF) + wid * 64;
    const LAS unsigned char* vb0 = lds + AT_V + ((lane >> 4) & 1) * 32 + (lane & 3) * 8 + (4 * hi + ((lane & 15) >> 2)) * 64;
    const LAS unsigned char* kb0 = lds + AT_K + hi * 1024 + r32 * 16;
    __syncthreads();
    auto step = [&](int t, u32x4& gkw, u32x4& gvw, u32x4& gkl, u32x4& gvl) __attribute__((always_inline)) {
        const int bufo = (t & 1) * 8192;
        if (t + 2 < NT) AT_LOAD(gkl, gvl, t + 2);
        bool need = true; bool full = true; int ts = 0, rk = 0;
        if (t < nloc) {
            if (KIND == 0) { ts = blk * 128 - 128 + 64 * (lo + t); need = (ts + 63 >= qpos0 - 128) && (ts <= qpos0 + 31 + 128); full = (qpos0 + 31 - ts <= 128) && (ts + 63 - qpos0 <= 128); }
            if (KIND == 1) { rk = lo + t; const int r0 = (rq - 4) < 0 ? 0 : ((rq - 4) > 56 ? 56 : (rq - 4)); need = (rk >= r0) && (rk <= r0 + 7); full = false; }
        }
        if (need) {
            f32x16 p0, p1;
#pragma unroll
            for (int r = 0; r < 16; ++r) { p0[r] = 0.f; p1[r] = 0.f; }
            const LAS unsigned char* kb = kb0 + bufo;
#pragma unroll
            for (int d0 = 0; d0 < 4; ++d0) { const bf16x8_t k0 = *(const LAS bf16x8_t*)(kb + d0 * 2048), k1 = *(const LAS bf16x8_t*)(kb + d0 * 2048 + 512);
                p0 = __builtin_amdgcn_mfma_f32_32x32x16_bf16(k0, qr[d0], p0, 0, 0, 0); p1 = __builtin_amdgcn_mfma_f32_32x32x16_bf16(k1, qr[d0], p1, 0, 0, 0); }
            constexpr float C2 = 0.125f * LOG2E;
#pragma unroll
            for (int r = 0; r < 16; ++r) { p0[r] *= C2; p1[r] *= C2; }
            if (!full) {
                if (KIND == 0) { const int tq = qpos0 + r32;
#pragma unroll
                    for (int r = 0; r < 16; ++r) { const int k0 = ts + crow(r, hi), d0 = tq - k0, d1 = d0 - 32; if (d0 > 128 || d0 < -128) p0[r] = -1e30f; if (d1 > 128 || d1 < -128) p1[r] = -1e30f; } }
                if (KIND == 1) { const int c = cbase + r32; const int wsc = (c - 8) < 0 ? 0 : ((c - 8) > 48 ? 48 : (c - 8)); const LAS float* rp = (const LAS float*)(lds + AT_RPB) + (rk - rq + 7) * 31 + 15 - c;
#pragma unroll
                    for (int r = 0; r < 16; ++r) { const int c0 = crow(r, hi), c1 = c0 + 32; const bool ok0 = (c0 >= wsc) && (c0 < wsc + 16), ok1 = (c1 >= wsc) && (c1 < wsc + 16);
                        p0[r] = ok0 ? p0[r] + rp[ok0 ? c0 : c] : -1e30f; p1[r] = ok1 ? p1[r] + rp[ok1 ? c1 : c] : -1e30f; } }
            }
            float rm = fmaxf(p0[0], p1[0]);
#pragma unroll
            for (int r = 1; r < 16; ++r) rm = fmaxf(rm, fmaxf(p0[r], p1[r]));
            { auto rr = __builtin_amdgcn_permlane32_swap(__float_as_uint(rm), __float_as_uint(rm), false, false); rm = fmaxf(__uint_as_float(rr[0]), __uint_as_float(rr[1])); }
            const float mnew = fmaxf(mhat, rm); const float f = __builtin_amdgcn_exp2f(mhat - mnew); const bool grew = mnew > mhat; mhat = mnew;
            float sacc = 0.f;
#pragma unroll
            for (int r = 0; r < 16; ++r) { p0[r] = (p0[r] > -1e29f) ? __builtin_amdgcn_exp2f(p0[r] - mnew) : 0.f; p1[r] = (p1[r] > -1e29f) ? __builtin_amdgcn_exp2f(p1[r] - mnew) : 0.f; sacc += p0[r] + p1[r]; }
            l_reg = l_reg * f + sacc;
            if (__any(grew)) { if (hi == 0) wsf[r32] = f; LDS_WAIT();
#pragma unroll
                for (int r = 0; r < 16; ++r) { const float fr_ = wsf[crow(r, hi)]; o[0][r] *= fr_; o[1][r] *= fr_; }
                LDS_WAIT(); }
            u32x4 pw0, pw1, pw2, pw3;
            pw0 = (u32x4){cvtpk(p0[0], p0[1]), cvtpk(p0[2], p0[3]), cvtpk(p0[4], p0[5]), cvtpk(p0[6], p0[7])}; pw1 = (u32x4){cvtpk(p0[8], p0[9]), cvtpk(p0[10], p0[11]), cvtpk(p0[12], p0[13]), cvtpk(p0[14], p0[15])};
            pw2 = (u32x4){cvtpk(p1[0], p1[1]), cvtpk(p1[2], p1[3]), cvtpk(p1[4], p1[5]), cvtpk(p1[6], p1[7])}; pw3 = (u32x4){cvtpk(p1[8], p1[9]), cvtpk(p1[10], p1[11]), cvtpk(p1[12], p1[13]), cvtpk(p1[14], p1[15])};
            const LAS unsigned char* vb = vb0 + bufo;
#pragma unroll
            for (int d0 = 0; d0 < 2; ++d0) {
#pragma unroll
                for (int ks = 0; ks < 4; ++ks) { const s16x4_t vl = vtr(vb + d0 * 4096 + ks * 1024), vh = vtr(vb + d0 * 4096 + ks * 1024 + 512);
                    const bf16x8_t vf = (bf16x8_t){vl[0], vl[1], vl[2], vl[3], vh[0], vh[1], vh[2], vh[3]};
                    const bf16x8_t pa = __builtin_bit_cast(bf16x8_t, ks == 0 ? pw0 : (ks == 1 ? pw1 : (ks == 2 ? pw2 : pw3)));
                    o[d0] = __builtin_amdgcn_mfma_f32_32x32x16_bf16(pa, vf, o[d0], 0, 0, 0); } }
        }
        if (t + 1 < NT) { const int nb = ((t + 1) & 1) * 8192; *(LAS u32x4*)(lds + kdst + nb) = gkw; *(LAS u32x4*)(lds + vdst + nb) = gvw; }
        __syncthreads();
    };
    for (int t = 0; t < NT; t += 2) { step(t, gk1, gv1, gk0, gv0); if (t + 1 < NT) step(t + 1, gk0, gv0, gk1, gv1); }
#undef AT_LOAD
    { auto rr = __builtin_amdgcn_permlane32_swap(__float_as_uint(l_reg), __float_as_uint(l_reg), false, false); l_reg = __uint_as_float(rr[0]) + __uint_as_float(rr[1]); }
    if (sink) l_reg += __builtin_amdgcn_exp2f(a.in[I_SINK][l * 4 + hsink] * LOG2E - mhat);
    if (hi == 0) wsf[32 + r32] = 1.0f / l_reg;
    LDS_WAIT();
    LAS bf16_t* stg = (LAS bf16_t*)(lds + AT_OST) + wid * 2048;
#pragma unroll
    for (int r = 0; r < 16; ++r) { const int orow = crow(r, hi); const float il = wsf[32 + orow];
        stg[orow * 64 + r32] = (bf16_t)f2bf(o[0][r] * il); stg[orow * 64 + 32 + r32] = (bf16_t)f2bf(o[1][r] * il); }
    LDS_WAIT();
#pragma unroll
    for (int i = 0; i < 4; ++i) { const int row = i * 8 + (lane >> 3), ch = lane & 7; const u32x4 v = *(const LAS u32x4*)(stg + row * 64 + ch * 8);
        *(u32x4*)(Y + (size_t)(qrow0 + row) * D + ycol + ch * 8) = v; }
    __syncthreads();
}

__device__ __forceinline__ void phase_mix1(const Args& a, unsigned char* ldsg, int vcu, int G, int l) {
    LAS unsigned char* lds = (LAS unsigned char*)ldsg;
    int tid_ = threadIdx.x; asm volatile("" : "+v"(tid_));
    const int tid = tid_, lane = tid & 63, wave = __builtin_amdgcn_readfirstlane(tid >> 6);
    unsigned char* ws = a.ws; const bf16_t* PX = (const bf16_t*)(ws + WS_PX); bf16_t* Y = (bf16_t*)(ws + WS_Y);
    const bool upd = (l == 0); const int nrows = upd ? TT : TX;
    const int gw = vcu * NWAVES + wave, NGW = G * NWAVES;
    { AMP_BEGIN(31) load_tw(a, lds, tid);
    for (int it = vcu; it < 1024; it += G) hyena_item(a, lds, l, it >> 2, it & 3, tid);
    if (upd) for (int it = vcu; it < 32; it += G) ctx_hyena_item(a, lds, l, it, tid);
    event_arrive((unsigned*)(ws + WS_CTL) + 8192 + 64 * l); AMP_END(31) }
    { AMP_BEGIN(32)
    LAS float* pw = (LAS float*)(lds + 73728); LAS float* dv = (LAS float*)(lds + 139264 + wave * 1024);
    { const float* src = a.in[I_POOLW] + (size_t)l * 4 * 64 * 64; for (int i = tid; i < 4 * 64 * 64; i += NTHR) pw[i] = src[i]; }
    __syncthreads();
    const float* pscale = a.in[I_POOLS] + (size_t)l * 256;
    for (int row = gw; row < nrows; row += NGW) {
        const bool lat = row < TX; const int tpos = lat ? (row & 4095) : ((row - TX) & 255); const int Ls = lat ? 4096 : 256;
        const bf16_t* pr = PX + (size_t)row * INW;
        { const int g = lane >> 4, hw = 1 << g;
          const int c = 768 + 4 * lane; float s0 = 0.f, s1 = 0.f, s2 = 0.f, s3 = 0.f; int cnt = 0;
          u32x2 wv[16];
#pragma unroll
          for (int off = -8; off < 8; ++off) { const int tp = tpos + off; const bool inr = (tp >= 0) && (tp < Ls); wv[off + 8] = *(const u32x2*)(pr + (ptrdiff_t)(inr ? off : 0) * INW + c); }
#pragma unroll
          for (int off = -8; off < 8; ++off) { const int tp = tpos + off; const bool in = (off >= -hw) && (off < hw) && (tp >= 0) && (tp < Ls); const u32x2 v = wv[off + 8];
              s0 += in ? bflo(v.x) : 0.f; s1 += in ? bfhi(v.x) : 0.f; s2 += in ? bflo(v.y) : 0.f; s3 += in ? bfhi(v.y) : 0.f; cnt += in ? 1 : 0; }
          const u32x2 u0 = wv[8]; const float ic = 1.0f / (float)cnt;
          f32x4 dd; dd[0] = s0 * ic - bflo(u0.x); dd[1] = s1 * ic - bfhi(u0.x); dd[2] = s2 * ic - bflo(u0.y); dd[3] = s3 * ic - bfhi(u0.y);
          *(LAS f32x4*)(dv + 4 * lane) = dd;
          LDS_WAIT();
          const int j0 = 4 * (lane & 15); f32x4 acc = {0.f, 0.f, 0.f, 0.f};
          const LAS float* dg = dv + g * 64; const LAS float* wg = pw + g * 4096 + j0;
#pragma unroll 8
          for (int i = 0; i < 64; ++i) { const float di = dg[i]; const f32x4 wv = *(const LAS f32x4*)(wg + i * 64); acc += wv * di; }
          const f32x4 sc = *(const f32x4*)(pscale + g * 64 + j0); acc *= sc;
          u32x2 ov; ov.x = pk2(acc[0], acc[1]); ov.y = pk2(acc[2], acc[3]);
          *(u32x2*)(Y + (size_t)row * D + 512 + g * 64 + j0) = ov;
          LDS_WAIT(); }
    }
    __syncthreads(); AMP_END(32) }
    { AMP_BEGIN(33)
    for (int u = vcu; u < 512; u += G) attn_unit<0>(a, lds, l, u, tid);
    for (int u = vcu; u < 512; u += G) attn_unit<1>(a, lds, l, u, tid);
    if (upd) for (int u = vcu; u < 64; u += G) attn_unit<2>(a, lds, l, u, tid);
    AMP_END(33) }
    { AMP_BEGIN(34) event_wait((unsigned*)(ws + WS_CTL) + 8192 + 64 * l, (unsigned)G);
      for (int it = gw; it < 2048; it += NGW) ytr_item(a, lds + wave * 9216, it, lane); AMP_END(34) }
}

__device__ __forceinline__ void phase_select(const Args& a, unsigned char* ldsg, int vcu, int G, bool with_ctx) {
    LAS unsigned long long* arr = (LAS unsigned long long*)(LAS unsigned char*)ldsg;
    int tid_ = threadIdx.x; asm volatile("" : "+v"(tid_));
    const int tid = tid_; unsigned char* ws = a.ws;
    const float* AFFT = (const float*)(ws + WS_AFFT); int* ROWMAP = (int*)(ws + WS_ROWMAP); float* GATE = (float*)(ws + WS_GATE); int* INV = (int*)(ws + WS_INV);
    const int nitems = 128 + (with_ctx ? 128 : 0);
    for (int item = vcu; item < nitems; item += G) {
        int e, base, Ls, cap, slot0;
        if (item < 128) { const int b = item >> 4; e = item & 15; base = b * 4096; Ls = 4096; cap = CAPX; slot0 = b * CAPX; }
        else { const int it = item - 128; const int b = it >> 4; e = it & 15; base = TX + b * 256; Ls = 256; cap = CAPC; slot0 = NB * CAPX + b * CAPC; }
        for (int i = tid; i < Ls; i += NTHR) arr[i] = ((unsigned long long)__float_as_uint(AFFT[(size_t)e * TT + base + i]) << 32) | (unsigned)(Ls - 1 - i);
        __syncthreads();
        const int npairs = Ls >> 1;
        for (int k = 2; k <= Ls; k <<= 1)
            for (int j = k >> 1; j > 0; j >>= 1) {
                for (int p = tid; p < npairs; p += NTHR) { const int i = ((p & ~(j - 1)) << 1) | (p & (j - 1)), ix = i | j;
                    const unsigned long long x = arr[i], y = arr[ix]; const bool desc = ((i & k) == 0);
                    if (desc ? (x < y) : (x > y)) { arr[i] = y; arr[ix] = x; } }
                __syncthreads(); }
        for (int s = tid; s < cap; s += NTHR) { const unsigned long long v = arr[s]; const int idx = Ls - 1 - (int)(unsigned)(v & 0xffffffffull); const int slot = e * SLOTS + slot0 + s;
            ROWMAP[slot] = base + idx; GATE[slot] = __uint_as_float((unsigned)(v >> 32)); INV[(size_t)(base + idx) * 16 + e] = slot; }
        __syncthreads();
    }
}
__device__ __forceinline__ void phase_gather(const Args& a, int vcu, int G, bool with_ctx) {
    int tid_ = threadIdx.x; asm volatile("" : "+v"(tid_));
    const int tid = tid_, lane = tid & 63, wave = __builtin_amdgcn_readfirstlane(tid >> 6); unsigned char* ws = a.ws;
    const int* ROWMAP = (const int*)(ws + WS_ROWMAP); const bf16_t* HX = (const bf16_t*)(ws + WS_HX); bf16_t* XG = (bf16_t*)(ws + WS_XG);
    const int per = with_ctx ? SLOTS : NB * CAPX; const int gw = vcu * NWAVES + wave, NGW = G * NWAVES;
    for (int it = gw; it < NE * per; it += NGW) { const int e = it / per, s = it % per; const int slot = e * SLOTS + s; const int src = ROWMAP[slot];
        const u32x4* sp = (const u32x4*)(HX + (size_t)src * D) + 2 * lane; u32x4* dp = (u32x4*)(XG + (size_t)slot * D) + 2 * lane;
        const u32x4 v0 = sp[0], v1 = sp[1]; dp[0] = v0; dp[1] = v1; }
}
__device__ __forceinline__ void phase_combine(const Args& a, int vcu, int G, int l, bool with_ctx, bool final_norm, bool next_norm) {
    int tid_ = threadIdx.x; asm volatile("" : "+v"(tid_));
    const int tid = tid_, lane = tid & 63, wave = __builtin_amdgcn_readfirstlane(tid >> 6); unsigned char* ws = a.ws;
    const int* INV = (const int*)(ws + WS_INV); const bf16_t* OB = (const bf16_t*)(ws + WS_XG); const float* MOD = (const float*)(ws + WS_MOD) + (size_t)l * 9 * 6144;
    const float* MODN = (const float*)(ws + WS_MOD) + (size_t)(l + 1) * 9 * 6144; const float* gainn = a.in[I_N1G] + (l + 1) * D; bf16_t* HX = (bf16_t*)(ws + WS_HX);
    float* CRES = (float*)(ws + WS_CRES); const float* fng = a.in[I_FNG];
    const int nrows = with_ctx ? TT : TX; const int gw = vcu * NWAVES + wave, NGW = G * NWAVES;
    const float pz = (final_norm && __hip_atomic_load((unsigned*)(ws + WS_CTL) + 12288, __ATOMIC_RELAXED, __HIP_MEMORY_SCOPE_AGENT) != 0u) ? __builtin_nanf("") : 0.f;
    for (int rowa = gw; rowa < nrows; rowa += 2 * NGW) {
        int myinv[2]; f32x4 xv[2][4]; f32x4 acc[2][4];
#pragma unroll
        for (int u = 0; u < 2; ++u) { const int row = rowa + u * NGW; const bool ok = row < nrows; const int rr = ok ? row : rowa;
            myinv[u] = (lane < 16 && ok) ? INV[(size_t)rr * 16 + lane] : -1;
            const float* xr = (rr < TX) ? a.out + (size_t)rr * D : CRES + (size_t)(rr - TX) * D;
#pragma unroll
            for (int j = 0; j < 4; ++j) { xv[u][j] = *(const f32x4*)(xr + 256 * j + 4 * lane); acc[u][j] = (f32x4){0.f, 0.f, 0.f, 0.f}; } }
#pragma unroll
        for (int u = 0; u < 2; ++u)
            for (int e = 0; e < 16; ++e) { const int s = __shfl(myinv[u], e);
                if (s >= 0) { const bf16_t* orow = OB + (size_t)s * D;
#pragma unroll
                    for (int j = 0; j < 4; ++j) { const u32x2 v = *(const u32x2*)(orow + 256 * j + 4 * lane); acc[u][j][0] += bflo(v.x); acc[u][j][1] += bfhi(v.x); acc[u][j][2] += bflo(v.y); acc[u][j][3] += bfhi(v.y); } } }
#pragma unroll
        for (int u = 0; u < 2; ++u) { const int row = rowa + u * NGW; if (row < nrows) {
            const bool lat = row < TX; float* xr = lat ? a.out + (size_t)row * D : CRES + (size_t)(row - TX) * D; const int mrow = lat ? (row >> 12) : 8;
            const float* gp = MOD + mrow * 6144 + 5 * 1024; f32x4 v[4]; float ss = 0.f;
#pragma unroll
            for (int j = 0; j < 4; ++j) { const f32x4 g = *(const f32x4*)(gp + 256 * j + 4 * lane); v[j] = xv[u][j] + g * acc[u][j];
                ss += (v[j][0] * v[j][0] + v[j][1] * v[j][1]) + (v[j][2] * v[j][2] + v[j][3] * v[j][3]); }
            if (final_norm) { const float rstd = 1.0f / sqrtf(wave_sum(ss) * (1.0f / D) + 1e-6f);
#pragma unroll
                for (int j = 0; j < 4; ++j) { const f32x4 g = *(const f32x4*)(fng + 256 * j + 4 * lane); *(f32x4*)(xr + 256 * j + 4 * lane) = v[j] * rstd * g + pz; } }
            else {
#pragma unroll
                for (int j = 0; j < 4; ++j) *(f32x4*)(xr + 256 * j + 4 * lane) = v[j];
                if (next_norm) { const float rstd = 1.0f / sqrtf(wave_sum(ss) * (1.0f / D) + 1e-6f); const float* shp = MODN + mrow * 6144; const float* scp = shp + 1024;
#pragma unroll
                    for (int j = 0; j < 4; ++j) { const f32x4 gg = *(const f32x4*)(gainn + 256 * j + 4 * lane), sh = *(const f32x4*)(shp + 256 * j + 4 * lane), sc = *(const f32x4*)(scp + 256 * j + 4 * lane);
                        const f32x4 hv = (v[j] * rstd * gg) * (1.0f + sc) + sh; u32x2 o; o.x = pk2(hv[0], hv[1]); o.y = pk2(hv[2], hv[3]); *(u32x2*)(HX + (size_t)row * D + 256 * j + 4 * lane) = o; } } } } }
    }
}

#define XBAR() do { xcd_barrier(bar); if (AMP_PHASE == 99) xcd_barrier(bar); } while (0)

__global__ void __launch_bounds__(NTHR, 2) fwd_kernel(Args a) {
    extern __shared__ __attribute__((aligned(16))) unsigned char lds[];
    cg::grid_group grid = cg::this_grid();
    const int G = gridDim.x, bx = blockIdx.x; const int vcu = (G % 8 == 0) ? (bx % 8) * (G / 8) + bx / 8 : bx;
    unsigned char* ws = a.ws;
    PG8_LAS unsigned char* glds = (PG8_LAS unsigned char*)lds;
    volatile LAS unsigned* bst = (volatile LAS unsigned*)((LAS unsigned char*)lds + LDS_BYTES - 16);
    if (threadIdx.x < 4) bst[threadIdx.x] = 0u;
    __syncthreads();
    XcdBarrier bar = xcd_barrier_post((unsigned*)(ws + WS_CTL), bst);
    { AMP_BEGIN(0) phase_prologue(a, lds, vcu, G); AMP_END(0) }
    grid.sync();
    for (int l = 0; l < 2; ++l) {
        const bool upd = (l == 0);
        const float* srcx = upd ? a.in[I_X] : a.out; const float* srcc = upd ? a.in[I_CTX] : (const float*)(ws + WS_CRES);
        if (upd) {
            { AMP_BEGIN(1) phase_norm(a, lds, vcu, G, l, srcx, srcc, a.in[I_N1G] + l * D, 0, TT, false); AMP_END(1) }
            { AMP_BEGIN(11) load_tw(a, (LAS unsigned char*)lds, threadIdx.x); for (int it = vcu; it < 1024; it += G) spectrum_item(a, (LAS unsigned char*)lds, it, threadIdx.x); AMP_END(11) }
            XBAR();
        }
        { AMP_BEGIN(2) pg8::Gemm g{(const pg8::bf16_t*)(ws + WS_HX), (const pg8::bf16_t*)(ws + WS_WIN_T) + (size_t)l * INW * D, TT, INW, D};
          pg8::GroupOrder S; S.init(1, TT / 256, INW / 256, 0, G, bx);
          pg8::EpiIn E{(pg8::bf16_t*)(ws + WS_PX), (const float*)(ws + WS_ROPE), (pg8::bf16_t*)(ws + WS_UT), glds + 131072};
          pg8::gemm_phase<pg8::EpiIn, pg8::GroupOrder, true, true>(glds, g, S, E); AMP_END(2) }
        XBAR();
        { AMP_BEGIN(3) phase_mix1(a, lds, vcu, G, l); AMP_END(3) }
        XBAR();
        { AMP_BEGIN(4) pg8::Gemm g{(const pg8::bf16_t*)(ws + WS_Y), (const pg8::bf16_t*)(ws + WS_WOUT_T) + (size_t)l * D * D, TT, D, D};
          pg8::GroupOrder S; S.init(1, (upd ? TT : TX) / 256, D / 256, 0, G, bx);
          pg8::EpiOut E{srcx, srcc, a.out, (float*)(ws + WS_CRES), (const float*)(ws + WS_MOD) + (size_t)l * 9 * 6144};
          pg8::gemm_phase<pg8::EpiOut, pg8::GroupOrder, true, true>(glds, g, S, E); AMP_END(4) }
        XBAR();
        { AMP_BEGIN(5) phase_norm(a, lds, vcu, G, l, a.out, (const float*)(ws + WS_CRES), a.in[I_N2G] + l * D, 3, upd ? TT : TX, true); AMP_END(5) }
        XBAR();
        { AMP_BEGIN(6) phase_select(a, lds, vcu, G, upd); AMP_END(6) }
        XBAR();
        { AMP_BEGIN(8) pg8::Gemm g{(const pg8::bf16_t*)(ws + WS_HX), (const pg8::bf16_t*)(ws + WS_WGU_T + (size_t)l * NE * 4096 * D), NE * SLOTS, NE * 4096, D};
          pg8::GroupOrder S; S.init(NE, upd ? 17 : 16, 16, 17, G, bx);
          pg8::EpiGU E{(unsigned char*)(ws + WS_ACT), (const float*)(ws + WS_WSC) + l * 48};
          pg8::gemm_phase_gather<pg8::EpiGU, pg8::GroupOrder, true>(glds, g, (const int*)(ws + WS_ROWMAP), (PG8_LAS int*)(glds + 131072), S, E); AMP_END(8) }
        XBAR();
        { AMP_BEGIN(9) pg8::Gemm g{(const pg8::bf16_t*)(ws + WS_ACT), (const pg8::bf16_t*)(ws + WS_WD_T + (size_t)l * NE * D * FF), NE * SLOTS, NE * D, FF};
          pg8::GroupOrder S; S.init(NE, upd ? 17 : 16, 4, 17, G, bx);
          pg8::EpiDown E{(pg8::bf16_t*)(ws + WS_XG), (const float*)(ws + WS_GATE), (const float*)(ws + WS_WSC) + l * 48 + 32};
          pg8::gemm_phase<pg8::EpiDown, pg8::GroupOrder, true, true, true>(glds, g, S, E); AMP_END(9) }
        XBAR();
        { AMP_BEGIN(10) phase_combine(a, vcu, G, l, upd, !upd, upd); AMP_END(10) }
        if (upd) XBAR();
    }
}

extern "C" void kernel_launch(void* const* d_in, const int* in_sizes, int n_in, void* d_out, int out_size, void* d_ws, size_t ws_size, hipStream_t stream) {
    static int grid = 0;
    if (grid == 0) {
        int dev = 0, cus = 0, per_cu = 0;
        hipGetDevice(&dev); hipDeviceGetAttribute(&cus, hipDeviceAttributeMultiprocessorCount, dev);
        if (hipFuncSetAttribute((const void*)fwd_kernel, hipFuncAttributeMaxDynamicSharedMemorySize, LDS_BYTES) != hipSuccess) { fprintf(stderr, "kernel_launch: hipFuncSetAttribute failed\n"); grid = -1; return; }
        if (hipOccupancyMaxActiveBlocksPerMultiprocessor(&per_cu, (const void*)fwd_kernel, NTHR, LDS_BYTES) != hipSuccess || per_cu < 1) { fprintf(stderr, "kernel_launch: occupancy query failed (%d)\n", per_cu); grid = -1; return; }
        grid = cus * 1;
        if (n_in != N_IN || ws_size < WS_END) { fprintf(stderr, "kernel_launch: unexpected n_in %d / ws %zu\n", n_in, ws_size); grid = -1; return; }
    }
    if (grid < 0) return;
    if (hipMemsetAsync((char*)d_ws + WS_CTL, 0, 65536, stream) != hipSuccess) { fprintf(stderr, "kernel_launch: memset failed\n"); return; }
    Args a{};
    for (int i = 0; i < N_IN; ++i) a.in[i] = (const float*)d_in[i];
    a.out = (float*)d_out; a.ws = (unsigned char*)d_ws;
    void* args[] = {&a};
    hipError_t e = hipLaunchCooperativeKernel((const void*)fwd_kernel, dim3(grid), dim3(NTHR), args, LDS_BYTES, stream);
    if (e != hipSuccess) fprintf(stderr, "cooperative launch failed: %s (grid %d)\n", hipGetErrorString(e), grid);
}
```

```cpp
#define AMP_PHASE -1
#include <hip/hip_runtime.h>
#include <hip/hip_cooperative_groups.h>
#include <cstdio>
#include <cstdint>
namespace cg = cooperative_groups;
namespace pg8 {
#define PG8_LAS __attribute__((address_space(3)))
typedef unsigned short bf16_t;
typedef short bf16x8 __attribute__((ext_vector_type(8)));
typedef float f32x4 __attribute__((ext_vector_type(4)));
typedef unsigned u32x4 __attribute__((ext_vector_type(4)));
typedef int v4i_t __attribute__((ext_vector_type(4)));
typedef int v8i_t __attribute__((ext_vector_type(8)));
constexpr int BM = 256, BK = 64, HALF = 128, HTB = HALF * BK * 2  , STAGE_BYTES = 8 * HTB, NXCD = 8, WGM = 8;

__host__ __device__ __forceinline__ int lds_byte(int r, int c) { const int st = (r >> 4) * 2 + (c >> 5), rr = r & 15, cc = c & 31, ob = rr * 64 + cc * 2; return st * 1024 + (ob ^ (((ob >> 9) & 1) << 5)); }
__host__ __device__ __forceinline__ void stage_rc(int b, int& R, int& C) { const int st = b / 1024, sb = b % 1024, swz = sb ^ (((sb >> 9) & 1) << 5); R = (st >> 1) * 16 + swz / 64; C = (st & 1) * 32 + (swz % 64) / 2; }
__host__ __device__ __forceinline__ int perm32(int rho) { const int n = rho >> 4, i = rho & 15; return 8 * (i >> 2) + 4 * n + (i & 3); }

struct Unit { int pm, pn; };
struct Gemm { const bf16_t* A; const bf16_t* Bt; int M, N, K; };

struct StaticOrder {
    int nM, nN, nwg, G, c;
    __host__ __device__ void init(int M, int N, int G_, int c_) { nM = M / BM; nN = N / BM; nwg = nM * nN; G = G_; c = c_; }
    __host__ __device__ bool next(int i, Unit& u) const {
        const long L = (long)i * G + c; if (L >= nwg) return false;
        int wgid = (int)L; { const int q = nwg / NXCD, r = nwg % NXCD, xcd = wgid % NXCD, off = wgid / NXCD; wgid = (xcd < r ? xcd * (q + 1) : r * (q + 1) + (xcd - r) * q) + off; }
        const int nig = WGM * nN, gid = wgid / nig, fm = gid * WGM, gsz = (nM - fm) < WGM ? (nM - fm) : WGM;
        u.pm = fm + ((wgid % nig) % gsz); u.pn = (wgid % nig) / gsz; return true;
    }
    __device__ __forceinline__ void a_ready(const Unit&) const {}
    __device__ __forceinline__ void done(const Unit&) const {}
};

__device__ __forceinline__ unsigned cvt_pk_bf16(float lo, float hi) { unsigned r; asm volatile("v_cvt_pk_bf16_f32 %0, %1, %2" : "=v"(r) : "v"(lo), "v"(hi)); return r; }
typedef float f32x2 __attribute__((ext_vector_type(2)));
__device__ __forceinline__ f32x2 gelu_pk(f32x2 v) {
    const f32x2 av = __builtin_elementwise_abs(v), d = av * 0.2316418882f + 1.0f;
    f32x2 t; t.x = __builtin_amdgcn_rcpf(d.x); t.y = __builtin_amdgcn_rcpf(d.y);
    f32x2 q = t * 0.5307027145f + (-0.7265760135f); q = q * t + 0.7107068705f; q = q * t + (-0.142248368f); q = q * t + 0.127414796f; q = q * t;
    const f32x2 s = (v * v) * (-0.72134752044f);
    f32x2 e; e.x = __builtin_amdgcn_exp2f(s.x); e.y = __builtin_amdgcn_exp2f(s.y);
    const f32x2 m = v * (q * e), r = v - m;
    f32x2 o; o.x = v.x < 0.f ? m.x : r.x; o.y = v.y < 0.f ? m.y : r.y; return o;
}


struct GroupOrder {
    int nMl, nNl, strideM, nper, nwg, G, c;
    __device__ void init(int ng, int nMl_, int nNl_, int strideM_, int G_, int c_) { nMl = nMl_; nNl = nNl_; strideM = strideM_; nper = nMl_ * nNl_; nwg = ng * nper; G = G_; c = c_; }
    __device__ bool next(int i, Unit& u) const {
        const long L = (long)i * G + c; if (L >= nwg) return false;
        int wgid = (int)L; { const int q = nwg / NXCD, r = nwg % NXCD, xcd = wgid % NXCD, off = wgid / NXCD; wgid = (xcd < r ? xcd * (q + 1) : r * (q + 1) + (xcd - r) * q) + off; }
        const int e = wgid / nper, id = wgid % nper;
        const int nig = WGM * nNl, gid = id / nig, fm = gid * WGM, gsz = (nMl - fm) < WGM ? (nMl - fm) : WGM;
        u.pm = e * strideM + fm + ((id % nig) % gsz); u.pn = e * nNl + (id % nig) / gsz; return true;
    }
    __device__ __forceinline__ void a_ready(const Unit&) const {}
    __device__ __forceinline__ void done(const Unit&) const {}
};

constexpr int TXR = 32768;
struct EpiIn {
    static constexpr bool PERM = true, AFTER_DRAIN = false;
    bf16_t* PX; const PG8_LAS float* rope; bf16_t* UT; PG8_LAS unsigned char* stgbase;
    __device__ __forceinline__ void operator()(const f32x4 (&acc)[2][2][4][2], const Unit& u, int ui, int wr, int wc, int fr, int fq) const {
        const int row0 = u.pm * BM + wr * 64 + fr; const int col0 = u.pn * BM + wc * 32 + 8 * fq;
        const bool latent = u.pm < (TXR / BM);
        if (latent && u.pn < 3) {
            PG8_LAS unsigned char* stg = stgbase + (wr * 4 + wc) * 2304; const int lane = fq * 16 + fr;
            const int b = u.pm >> 4, trow0 = (u.pm & 15) * BM; const int col = lane >> 1, half = lane & 1;
#pragma unroll
            for (int ai = 0; ai < 2; ++ai)
#pragma unroll
                for (int bj = 0; bj < 2; ++bj)
#pragma unroll
                    for (int mh = 0; mh < 2; ++mh) {
#pragma unroll
                        for (int mm = 0; mm < 2; ++mm)
#pragma unroll
                            for (int n = 0; n < 2; ++n) { const f32x4 v = acc[ai][bj][2 * mh + mm][n]; const unsigned w0 = cvt_pk_bf16(v[0], v[1]), w1 = cvt_pk_bf16(v[2], v[3]);
                                PG8_LAS unsigned char* p = stg + (8 * fq + 4 * n) * 72 + (16 * mm + fr) * 2;
                                *(PG8_LAS unsigned short*)(p) = (unsigned short)w0; *(PG8_LAS unsigned short*)(p + 72) = (unsigned short)(w0 >> 16);
                                *(PG8_LAS unsigned short*)(p + 144) = (unsigned short)w1; *(PG8_LAS unsigned short*)(p + 216) = (unsigned short)(w1 >> 16); }
                        asm volatile("s_waitcnt lgkmcnt(0)" ::: "memory");
                        typedef unsigned u32x2v __attribute__((ext_vector_type(2)));
                        const PG8_LAS unsigned char* rp = stg + col * 72 + half * 32;
                        const u32x2v a0 = *(const PG8_LAS u32x2v*)(rp), a1 = *(const PG8_LAS u32x2v*)(rp + 8), a2 = *(const PG8_LAS u32x2v*)(rp + 16), a3 = *(const PG8_LAS u32x2v*)(rp + 24);
                        const int ch = u.pn * BM + bj * HALF + wc * 32 + col; const int t0 = trow0 + ai * HALF + wr * 64 + mh * 32 + half * 16;
                        u32x4* gp = (u32x4*)(UT + ((size_t)(b * 768 + ch)) * 4096 + t0);
                        gp[0] = (u32x4){a0.x, a0.y, a1.x, a1.y}; gp[1] = (u32x4){a2.x, a2.y, a3.x, a3.y};
                        asm volatile("s_waitcnt lgkmcnt(0)" ::: "memory"); }
            return;
        }
#pragma unroll
        for (int ai = 0; ai < 2; ++ai)
#pragma unroll
            for (int m = 0; m < 4; ++m) { const int row = row0 + ai * HALF + m * 16; bf16_t* rowp = PX + (size_t)row * 2304 + col0;
#pragma unroll
                for (int bj = 0; bj < 2; ++bj) { f32x4 v0 = acc[ai][bj][m][0], v1 = acc[ai][bj][m][1];
                    const bool dorope = latent && (u.pn == 4 || (u.pn == 6 && bj == 0));
                    if (dorope) {
                        const int t = row & 4095; const int pos = (wc & 1) ? (t & 63) : (t >> 6);
                        const PG8_LAS f32x4* rp = (const PG8_LAS f32x4*)(rope + (pos * 16 + 8 * (fq & 1)) * 2);
                        const f32x4 r0 = rp[0], r1 = rp[1], r2 = rp[2], r3 = rp[3];
                        f32x4 p0, p1;
#pragma unroll
                        for (int j = 0; j < 4; ++j) { p0[j] = __shfl_xor(v0[j], 32); p1[j] = __shfl_xor(v1[j], 32); }
                        const float c0[4] = {r0[0], r0[2], r1[0], r1[2]}, s0[4] = {r0[1], r0[3], r1[1], r1[3]};
                        const float c1[4] = {r2[0], r2[2], r3[0], r3[2]}, s1[4] = {r2[1], r2[3], r3[1], r3[3]};
                        const bool lo = fq < 2;
#pragma unroll
                        for (int j = 0; j < 4; ++j) {
                            v0[j] = lo ? (v0[j] * c0[j] - p0[j] * s0[j]) : (p0[j] * s0[j] + v0[j] * c0[j]);
                            v1[j] = lo ? (v1[j] * c1[j] - p1[j] * s1[j]) : (p1[j] * s1[j] + v1[j] * c1[j]); }
                    }
                    u32x4 w; w.x = cvt_pk_bf16(v0[0], v0[1]); w.y = cvt_pk_bf16(v0[2], v0[3]); w.z = cvt_pk_bf16(v1[0], v1[1]); w.w = cvt_pk_bf16(v1[2], v1[3]);
                    *(u32x4*)(rowp + bj * HALF) = w; } }
    }
};
struct EpiOut {
    static constexpr bool PERM = true, AFTER_DRAIN = false;
    const float* xf_x; const float* xf_c; bf16_t* XB; const float* mod; int from_f32;
    __device__ __forceinline__ void operator()(const f32x4 (&acc)[2][2][4][2], const Unit& u, int ui, int wr, int wc, int fr, int fq) const {
        const int row0 = u.pm * BM + wr * 64 + fr, col0 = u.pn * BM + wc * 32 + 8 * fq;
        const bool latent = u.pm < (TXR / BM);
#pragma unroll
        for (int ai = 0; ai < 2; ++ai)
#pragma unroll
            for (int m = 0; m < 4; ++m) { const int row = row0 + ai * HALF + m * 16;
                const int mrow = latent ? (row >> 12) : 8; const float* gp = mod + mrow * 6144 + 2 * 1024 + col0;
                bf16_t* xb = XB + (size_t)row * 1024 + col0;
#pragma unroll
                for (int bj = 0; bj < 2; ++bj) { const f32x4 g0 = *(const f32x4*)(gp + bj * HALF), g1 = *(const f32x4*)(gp + bj * HALF + 4); f32x4 x0, x1;
                    if (from_f32) { const float* xo = (latent ? xf_x + (size_t)row * 1024 : xf_c + (size_t)(row - TXR) * 1024) + col0 + bj * HALF; x0 = *(const f32x4*)xo; x1 = *(const f32x4*)(xo + 4); }
                    else { const u32x4 w = *(const u32x4*)(xb + bj * HALF); x0 = (f32x4){__uint_as_float(w.x << 16), __uint_as_float(w.x & 0xffff0000u), __uint_as_float(w.y << 16), __uint_as_float(w.y & 0xffff0000u)};
                        x1 = (f32x4){__uint_as_float(w.z << 16), __uint_as_float(w.z & 0xffff0000u), __uint_as_float(w.w << 16), __uint_as_float(w.w & 0xffff0000u)}; }
                    const f32x4 v0 = x0 + g0 * acc[ai][bj][m][0], v1 = x1 + g1 * acc[ai][bj][m][1];
                    u32x4 o; o.x = cvt_pk_bf16(v0[0], v0[1]); o.y = cvt_pk_bf16(v0[2], v0[3]); o.z = cvt_pk_bf16(v1[0], v1[1]); o.w = cvt_pk_bf16(v1[2], v1[3]);
                    *(u32x4*)(xb + bj * HALF) = o; } }
    }
};
struct EpiGU {
    static constexpr bool PERM = true, AFTER_DRAIN = false;
    unsigned char* ACT; const PG8_LAS float* wsc;
    __device__ __forceinline__ void operator()(const f32x4 (&acc)[2][2][4][2], const Unit& u, int ui, int wr, int wc, int fr, int fq) const {
        const int row0 = u.pm * BM + wr * 64 + fr; const int col0 = (u.pn & 15) * 128 + wc * 32 + 8 * fq; const int e = u.pn >> 4; const float sg = wsc[e], su = wsc[16 + e];
#pragma unroll
        for (int ai = 0; ai < 2; ++ai)
#pragma unroll
            for (int m = 0; m < 4; ++m) { unsigned char* rowp = ACT + (size_t)(row0 + ai * HALF + m * 16) * 2048 + col0;
                float h[8];
#pragma unroll
                for (int n = 0; n < 2; ++n)
#pragma unroll
                    for (int j = 0; j < 4; ++j) { const float g = acc[ai][0][m][n][j] * sg, up = acc[ai][1][m][n][j] * su; const float v = g * __builtin_amdgcn_rcpf(1.0f + __builtin_amdgcn_exp2f(g * -1.4426950408889634f)) * up; h[4 * n + j] = fminf(fmaxf(v, -448.0f), 448.0f); }
                int p0 = 0, p1 = 0;
                p0 = __builtin_amdgcn_cvt_pk_fp8_f32(h[0], h[1], p0, false); p0 = __builtin_amdgcn_cvt_pk_fp8_f32(h[2], h[3], p0, true);
                p1 = __builtin_amdgcn_cvt_pk_fp8_f32(h[4], h[5], p1, false); p1 = __builtin_amdgcn_cvt_pk_fp8_f32(h[6], h[7], p1, true);
                typedef int i32x2v __attribute__((ext_vector_type(2)));
                *(i32x2v*)rowp = (i32x2v){p0, p1}; }
    }
};
struct EpiDown {
    static constexpr bool PERM = true, AFTER_DRAIN = false;
    bf16_t* OB; const PG8_LAS float* gl;
    __device__ __forceinline__ void operator()(const f32x4 (&acc)[2][2][4][2], const Unit& u, int ui, int wr, int wc, int fr, int fq) const {
        const int row0 = u.pm * BM + wr * 64 + fr; const int col0 = (u.pn & 3) * BM + wc * 32 + 8 * fq;
#pragma unroll
        for (int ai = 0; ai < 2; ++ai)
#pragma unroll
            for (int m = 0; m < 4; ++m) { const int row = row0 + ai * HALF + m * 16; const float g = gl[ui * BM + ai * HALF + wr * 64 + m * 16 + fr]; bf16_t* rowp = OB + (size_t)row * 1024 + col0;
#pragma unroll
                for (int bj = 0; bj < 2; ++bj) { const f32x4 v0 = acc[ai][bj][m][0] * g, v1 = acc[ai][bj][m][1] * g;
                    u32x4 w; w.x = cvt_pk_bf16(v0[0], v0[1]); w.y = cvt_pk_bf16(v0[2], v0[3]); w.z = cvt_pk_bf16(v1[0], v1[1]); w.w = cvt_pk_bf16(v1[2], v1[3]);
                    *(u32x4*)(rowp + bj * HALF) = w; } }
    }
};

template <class Epi, class Sched, bool ALIGN_EPI = false, bool SP2 = false, bool FP8 = false>
__device__ __forceinline__ void gemm_phase(PG8_LAS unsigned char* lds, const Gemm g, const Sched& S, const Epi& E) {
    int tid_ = threadIdx.x; asm volatile("" : "+v"(tid_));
    const int tid = tid_, wid = __builtin_amdgcn_readfirstlane(tid >> 6), lane = tid & 63, wr = wid >> 2, wc = wid & 3, fr = lane & 15, fq = lane >> 4;
    const int K = g.K, KB = FP8 ? K : 2 * K  , nt = KB / (BK * 2);
    unsigned voffA[2], voffB[2];
#pragma unroll
    for (int i = 0; i < 2; ++i) { int R, C; stage_rc(tid * 16 + i * 8192, R, C); const int Rb = Epi::PERM ? ((R & ~31) + perm32(R & 31)) : R;
        voffA[i] = (unsigned)(R * KB + C * 2); voffB[i] = (unsigned)(Rb * KB + C * 2); }
    const size_t kstep = (size_t)(BK * 2);
    const size_t hstep = (size_t)HALF * KB;
    const size_t tstep = 2 * hstep;
    const unsigned ldsw = (unsigned)wid * 1024u;
    const int aoff = lds_byte(wr * 64 + fr, fq * 8), boff = lds_byte(wc * 32 + fr, fq * 8);
#define PG8_SA(b, h) (((b) * 2 + (h)) * HTB)
#define PG8_SB(b, h) ((4 + (b) * 2 + (h)) * HTB)
#define PG8_STAGE(bufoff, gbase, voff) do { _Pragma("unroll") for (int _i = 0; _i < 2; ++_i) \
        __builtin_amdgcn_global_load_lds((const unsigned*)((const char*)(gbase) + (voff)[_i]), (PG8_LAS unsigned*)(lds + (bufoff) + ldsw + _i * 8192), 16, 0, 0); } while (0)
#define PG8_LDA(dst, b, h) do { _Pragma("unroll") for (int m = 0; m < 4; ++m) { if constexpr (FP8) { dst##8[m].lo = *(const PG8_LAS v4i_t*)(lds + PG8_SA(b, h) + aoff + m * 2048); dst##8[m].hi = *(const PG8_LAS v4i_t*)(lds + PG8_SA(b, h) + aoff + m * 2048 + 1024); } \
        else { _Pragma("unroll") for (int k = 0; k < 2; ++k) dst[m][k] = *(const PG8_LAS bf16x8*)(lds + PG8_SA(b, h) + aoff + m * 2048 + k * 1024); } } } while (0)
#define PG8_LDB(dst, b, h) do { _Pragma("unroll") for (int n = 0; n < 2; ++n) { if constexpr (FP8) { dst##8[n].lo = *(const PG8_LAS v4i_t*)(lds + PG8_SB(b, h) + boff + n * 2048); dst##8[n].hi = *(const PG8_LAS v4i_t*)(lds + PG8_SB(b, h) + boff + n * 2048 + 1024); } \
        else { _Pragma("unroll") for (int k = 0; k < 2; ++k) dst[n][k] = *(const PG8_LAS bf16x8*)(lds + PG8_SB(b, h) + boff + n * 2048 + k * 1024); } } } while (0)
#define PG8_CAT8(x0, x1) __builtin_shufflevector(__builtin_bit_cast(v4i_t, x0), __builtin_bit_cast(v4i_t, x1), 0, 1, 2, 3, 4, 5, 6, 7)
#define PG8_MMA(ai, bj, At, Bt) do { __builtin_amdgcn_s_setprio(1); if constexpr (FP8) asm volatile("s_nop 1" ::: "memory"); _Pragma("unroll") for (int m = 0; m < 4; ++m) _Pragma("unroll") for (int n = 0; n < 2; ++n) { \
        if constexpr (FP8) asm volatile("v_mfma_scale_f32_16x16x128_f8f6f4 %0, %1, %2, %0, %3, %3 op_sel_hi:[0,0,0]" : "+v"(acc[ai][bj][m][n]) : "v"(Bt##8[n]), "v"(At##8[m]), "v"(one_scale)); \
        else { _Pragma("unroll") for (int k = 0; k < 2; ++k) acc[ai][bj][m][n] = __builtin_amdgcn_mfma_f32_16x16x32_bf16(Bt[n][k], At[m][k], acc[ai][bj][m][n], 0, 0, 0); } } if constexpr (FP8) asm volatile("s_nop 15\n\ts_nop 3" ::: "memory"); __builtin_amdgcn_s_setprio(0); } while (0)
#define PG8_WAIT_V(n) asm volatile("s_waitcnt vmcnt(" #n ")" ::: "memory")
#define PG8_WAIT_L(n) asm volatile("s_waitcnt lgkmcnt(" #n ")" ::: "memory")
#define PG8_BAR __builtin_amdgcn_s_barrier()
#define PG8_SCHED __builtin_amdgcn_sched_barrier(0)
    Unit cur, nxt; int ui = 0;
    if (!S.next(0, cur)) return;
    f32x4 acc[2][2][4][2];
#pragma unroll
    for (int a = 0; a < 2; ++a)
#pragma unroll
        for (int b = 0; b < 2; ++b)
#pragma unroll
            for (int m = 0; m < 4; ++m)
#pragma unroll
                for (int n = 0; n < 2; ++n) acc[a][b][m][n] = (f32x4){0.f, 0.f, 0.f, 0.f};
    bf16x8 At[4][2], B0[2][2], B1[2][2];
    v8i_t At8[4], B08[2], B18[2];
    int one_scale = 0x7f7f7f7f; asm volatile("" : "+v"(one_scale));
    const char* cA = (const char*)g.A + (size_t)cur.pm * tstep; const char* cB = (const char*)g.Bt + (size_t)cur.pn * tstep;
    S.a_ready(cur);
    if constexpr (SP2) {
        PG8_STAGE(PG8_SB(0, 0), cB, voffB); PG8_STAGE(PG8_SB(0, 1), cB + hstep, voffB); PG8_STAGE(PG8_SA(0, 0), cA, voffA); PG8_STAGE(PG8_SA(0, 1), cA + hstep, voffA);
        if (wr == 1) PG8_BAR;
        PG8_WAIT_V(2); PG8_BAR;
        PG8_STAGE(PG8_SB(1, 0), cB + kstep, voffB); PG8_STAGE(PG8_SA(1, 0), cA + kstep, voffA); PG8_STAGE(PG8_SB(1, 1), cB + hstep + kstep, voffB);
        PG8_WAIT_V(6); PG8_BAR;
    } else {
        PG8_STAGE(PG8_SB(0, 0), cB, voffB); PG8_STAGE(PG8_SA(0, 0), cA, voffA); PG8_STAGE(PG8_SB(0, 1), cB + hstep, voffB); PG8_STAGE(PG8_SA(0, 1), cA + hstep, voffA);
        if (wr == 1) PG8_BAR;
        PG8_WAIT_V(4); PG8_BAR;
        PG8_STAGE(PG8_SB(1, 0), cB + kstep, voffB); PG8_STAGE(PG8_SA(1, 0), cA + kstep, voffA); PG8_STAGE(PG8_SB(1, 1), cB + hstep + kstep, voffB);
        PG8_WAIT_V(6); PG8_BAR;
    }
    for (;;) {
        const bool has_next = S.next(ui + 1, nxt);
        const char* nA = has_next ? (const char*)g.A + (size_t)nxt.pm * tstep : cA; const char* nB = has_next ? (const char*)g.Bt + (size_t)nxt.pn * tstep : cB;
#pragma nounroll
        for (int t = 0; t < nt; t += 2) {
            const bool last = (t == nt - 2);
            const char* a1 = cA + (size_t)(t + 1) * kstep;
            const char* a2 = last ? nA : cA + (size_t)(t + 2) * kstep; const char* b2 = last ? nB : cB + (size_t)(t + 2) * kstep;
            const char* a3 = a2 + kstep; const char* b3 = b2 + kstep;
            if (last && has_next) S.a_ready(nxt);
            if constexpr (SP2) {
            PG8_LDB(B0, 0, 0); PG8_LDB(B1, 0, 1); PG8_SCHED; PG8_LDA(At, 0, 0); PG8_STAGE(PG8_SA(1, 1), a1 + hstep, voffA);
            PG8_WAIT_V(8); PG8_WAIT_L(0); PG8_BAR; PG8_MMA(0, 0, At, B0); PG8_MMA(0, 1, At, B1); PG8_BAR; PG8_SCHED;
            PG8_LDA(At, 0, 1); PG8_STAGE(PG8_SB(0, 0), b2, voffB); PG8_STAGE(PG8_SB(0, 1), b2 + hstep, voffB); PG8_STAGE(PG8_SA(0, 0), a2, voffA);
            PG8_WAIT_V(8); PG8_WAIT_L(0); PG8_BAR; PG8_MMA(1, 0, At, B0); PG8_MMA(1, 1, At, B1); PG8_BAR; PG8_SCHED;
            PG8_LDB(B0, 1, 0); PG8_LDB(B1, 1, 1); PG8_SCHED; PG8_LDA(At, 1, 0); PG8_STAGE(PG8_SA(0, 1), a2 + hstep, voffA);
            PG8_WAIT_V(8); PG8_WAIT_L(0); PG8_BAR; PG8_MMA(0, 0, At, B0); PG8_MMA(0, 1, At, B1); PG8_BAR; PG8_SCHED;
            PG8_LDA(At, 1, 1); PG8_STAGE(PG8_SB(1, 0), b3, voffB); PG8_STAGE(PG8_SB(1, 1), b3 + hstep, voffB); PG8_STAGE(PG8_SA(1, 0), a3, voffA);
            PG8_WAIT_V(8); PG8_WAIT_L(0); PG8_BAR; PG8_MMA(1, 0, At, B0); PG8_MMA(1, 1, At, B1); PG8_BAR; PG8_SCHED;
            } else {
            PG8_LDB(B0, 0, 0); PG8_SCHED; PG8_LDA(At, 0, 0); PG8_STAGE(PG8_SA(1, 1), a1 + hstep, voffA);
            PG8_WAIT_L(8); PG8_BAR; PG8_WAIT_L(0); PG8_MMA(0, 0, At, B0); PG8_BAR; PG8_SCHED;
            PG8_LDB(B1, 0, 1); PG8_STAGE(PG8_SB(0, 0), b2, voffB);
            PG8_BAR; PG8_WAIT_L(0); PG8_MMA(0, 1, At, B1); PG8_BAR;
            PG8_LDA(At, 0, 1); PG8_STAGE(PG8_SA(0, 0), a2, voffA);
            PG8_BAR; PG8_WAIT_L(0); PG8_MMA(1, 0, At, B0); PG8_BAR; PG8_SCHED;
            PG8_STAGE(PG8_SB(0, 1), b2 + hstep, voffB);
            PG8_WAIT_V(6); PG8_BAR; PG8_MMA(1, 1, At, B1); PG8_BAR;
            PG8_LDB(B0, 1, 0); PG8_SCHED; PG8_LDA(At, 1, 0); PG8_STAGE(PG8_SA(0, 1), a2 + hstep, voffA);
            PG8_WAIT_L(8); PG8_BAR; PG8_WAIT_L(0); PG8_MMA(0, 0, At, B0); PG8_BAR; PG8_SCHED;
            PG8_LDB(B1, 1, 1); PG8_STAGE(PG8_SB(1, 0), b3, voffB);
            PG8_BAR; PG8_WAIT_L(0); PG8_MMA(0, 1, At, B1); PG8_BAR;
            PG8_LDA(At, 1, 1); PG8_STAGE(PG8_SA(1, 0), a3, voffA);
            PG8_BAR; PG8_WAIT_L(0); PG8_MMA(1, 0, At, B0); PG8_BAR; PG8_SCHED;
            PG8_STAGE(PG8_SB(1, 1), b3 + hstep, voffB);
            PG8_WAIT_V(6); PG8_BAR; PG8_MMA(1, 1, At, B1); PG8_BAR;
            }
        }
        if constexpr (ALIGN_EPI) { if (wr == 0) PG8_BAR; }
        if constexpr (!Epi::AFTER_DRAIN) { E(acc, cur, ui, wr, wc, fr, fq); S.done(cur); }
        if (!has_next) break;
#pragma unroll
        for (int a = 0; a < 2; ++a)
#pragma unroll
            for (int b = 0; b < 2; ++b)
#pragma unroll
                for (int m = 0; m < 4; ++m)
#pragma unroll
                    for (int n = 0; n < 2; ++n) acc[a][b][m][n] = (f32x4){0.f, 0.f, 0.f, 0.f};
        cur = nxt; cA = nA; cB = nB; ++ui;
        if constexpr (ALIGN_EPI) { if (wr == 1) PG8_BAR; }
    }
    PG8_WAIT_V(0);
    if constexpr (!ALIGN_EPI) { if (wr == 0) PG8_BAR; }
    PG8_BAR;
    if constexpr (Epi::AFTER_DRAIN) { E.fused(acc, cur, wr, wc, fr, fq, lds, wid, lane); S.done(cur); }
#undef PG8_SA
#undef PG8_SB
#undef PG8_STAGE
#undef PG8_LDA
#undef PG8_LDB
#undef PG8_MMA
#undef PG8_CAT8
#undef PG8_WAIT_V
#undef PG8_WAIT_L
#undef PG8_BAR
#undef PG8_SCHED
}
template <class Epi, class Sched, bool FP8 = false>
__device__ __forceinline__ void gemm_phase_gather(PG8_LAS unsigned char* lds, const Gemm g, const int* rowmap, PG8_LAS int* idxs, const Sched& S, const Epi& E) {
    constexpr bool ALIGN_EPI = true, SP2 = true;
    int tid_ = threadIdx.x; asm volatile("" : "+v"(tid_));
    const int tid = tid_, wid = __builtin_amdgcn_readfirstlane(tid >> 6), lane = tid & 63, wr = wid >> 2, wc = wid & 3, fr = lane & 15, fq = lane >> 4;
    const int K = g.K, KB = FP8 ? K : 2 * K  , nt = KB / (BK * 2);
    unsigned voffB[2]; int RA[2], CA[2];
#pragma unroll
    for (int i = 0; i < 2; ++i) { int R, C; stage_rc(tid * 16 + i * 8192, R, C); const int Rb = Epi::PERM ? ((R & ~31) + perm32(R & 31)) : R;
        RA[i] = R; CA[i] = C * 2; voffB[i] = (unsigned)(Rb * KB + C * 2); }
    const size_t kstep = (size_t)(BK * 2);
    const size_t hstep = (size_t)HALF * KB;
    const size_t tstep = 2 * hstep;
    const unsigned ldsw = (unsigned)wid * 1024u;
    const int aoff = lds_byte(wr * 64 + fr, fq * 8), boff = lds_byte(wc * 32 + fr, fq * 8);
#define PG8_SA(b, h) (((b) * 2 + (h)) * HTB)
#define PG8_SB(b, h) ((4 + (b) * 2 + (h)) * HTB)
#define PG8_STAGE(bufoff, gbase, voff) do { _Pragma("unroll") for (int _i = 0; _i < 2; ++_i) \
        __builtin_amdgcn_global_load_lds((const unsigned*)((const char*)(gbase) + (voff)[_i]), (PG8_LAS unsigned*)(lds + (bufoff) + ldsw + _i * 8192), 16, 0, 0); } while (0)
#define PG8_STAGE_AG(bufoff, P, h, koff) do { _Pragma("unroll") for (int _i = 0; _i < 2; ++_i) \
        __builtin_amdgcn_global_load_lds((const unsigned*)((P)[h][_i] + (koff)), (PG8_LAS unsigned*)(lds + (bufoff) + ldsw + _i * 8192), 16, 0, 0); } while (0)
#define PG8_ROWPTR(P, u) do { _Pragma("unroll") for (int _h = 0; _h < 2; ++_h) _Pragma("unroll") for (int _i = 0; _i < 2; ++_i) \
        (P)[_h][_i] = (const char*)g.A + (size_t)idxs[(u) * BM + _h * HALF + RA[_i]] * (size_t)KB + CA[_i]; } while (0)
#define PG8_LDA(dst, b, h) do { _Pragma("unroll") for (int m = 0; m < 4; ++m) { if constexpr (FP8) { dst##8[m].lo = *(const PG8_LAS v4i_t*)(lds + PG8_SA(b, h) + aoff + m * 2048); dst##8[m].hi = *(const PG8_LAS v4i_t*)(lds + PG8_SA(b, h) + aoff + m * 2048 + 1024); } \
        else { _Pragma("unroll") for (int k = 0; k < 2; ++k) dst[m][k] = *(const PG8_LAS bf16x8*)(lds + PG8_SA(b, h) + aoff + m * 2048 + k * 1024); } } } while (0)
#define PG8_LDB(dst, b, h) do { _Pragma("unroll") for (int n = 0; n < 2; ++n) { if constexpr (FP8) { dst##8[n].lo = *(const PG8_LAS v4i_t*)(lds + PG8_SB(b, h) + boff + n * 2048); dst##8[n].hi = *(const PG8_LAS v4i_t*)(lds + PG8_SB(b, h) + boff + n * 2048 + 1024); } \
        else { _Pragma("unroll") for (int k = 0; k < 2; ++k) dst[n][k] = *(const PG8_LAS bf16x8*)(lds + PG8_SB(b, h) + boff + n * 2048 + k * 1024); } } } while (0)
#define PG8_CAT8(x0, x1) __builtin_shufflevector(__builtin_bit_cast(v4i_t, x0), __builtin_bit_cast(v4i_t, x1), 0, 1, 2, 3, 4, 5, 6, 7)
#define PG8_MMA(ai, bj, At, Bt) do { __builtin_amdgcn_s_setprio(1); if constexpr (FP8) asm volatile("s_nop 1" ::: "memory"); _Pragma("unroll") for (int m = 0; m < 4; ++m) _Pragma("unroll") for (int n = 0; n < 2; ++n) { \
        if constexpr (FP8) asm volatile("v_mfma_scale_f32_16x16x128_f8f6f4 %0, %1, %2, %0, %3, %3 op_sel_hi:[0,0,0]" : "+v"(acc[ai][bj][m][n]) : "v"(Bt##8[n]), "v"(At##8[m]), "v"(one_scale)); \
        else { _Pragma("unroll") for (int k = 0; k < 2; ++k) acc[ai][bj][m][n] = __builtin_amdgcn_mfma_f32_16x16x32_bf16(Bt[n][k], At[m][k], acc[ai][bj][m][n], 0, 0, 0); } } if constexpr (FP8) asm volatile("s_nop 15\n\ts_nop 3" ::: "memory"); __builtin_amdgcn_s_setprio(0); } while (0)
#define PG8_WAIT_V(n) asm volatile("s_waitcnt vmcnt(" #n ")" ::: "memory")
#define PG8_WAIT_L(n) asm volatile("s_waitcnt lgkmcnt(" #n ")" ::: "memory")
#define PG8_BAR __builtin_amdgcn_s_barrier()
#define PG8_SCHED __builtin_amdgcn_sched_barrier(0)
    Unit cur, nxt; int ui = 0;
    if (!S.next(0, cur)) return;
    f32x4 acc[2][2][4][2];
#pragma unroll
    for (int a = 0; a < 2; ++a)
#pragma unroll
        for (int b = 0; b < 2; ++b)
#pragma unroll
            for (int m = 0; m < 4; ++m)
#pragma unroll
                for (int n = 0; n < 2; ++n) acc[a][b][m][n] = (f32x4){0.f, 0.f, 0.f, 0.f};
    bf16x8 At[4][2], B0[2][2], B1[2][2];
    v8i_t At8[4], B08[2], B18[2];
    int one_scale = 0x7f7f7f7f; asm volatile("" : "+v"(one_scale));
    const char* cB = (const char*)g.Bt + (size_t)cur.pn * tstep;
    const char* cP[2][2]; const char* nP[2][2];
    { Unit uu; for (int i = 0; S.next(i, uu); ++i) if (tid < BM) idxs[i * BM + tid] = rowmap[uu.pm * BM + tid]; }
    asm volatile("s_waitcnt vmcnt(0) lgkmcnt(0)" ::: "memory"); __builtin_amdgcn_s_barrier(); asm volatile("" ::: "memory");
    PG8_ROWPTR(cP, 0);
    S.a_ready(cur);
    if constexpr (SP2) {
        PG8_STAGE(PG8_SB(0, 0), cB, voffB); PG8_STAGE(PG8_SB(0, 1), cB + hstep, voffB); PG8_STAGE_AG(PG8_SA(0, 0), cP, 0, 0); PG8_STAGE_AG(PG8_SA(0, 1), cP, 1, 0);
        if (wr == 1) PG8_BAR;
        PG8_WAIT_V(2); PG8_BAR;
        PG8_STAGE(PG8_SB(1, 0), cB + kstep, voffB); PG8_STAGE_AG(PG8_SA(1, 0), cP, 0, kstep); PG8_STAGE(PG8_SB(1, 1), cB + hstep + kstep, voffB);
        PG8_WAIT_V(6); PG8_BAR;
    }
    for (;;) {
        const bool has_next = S.next(ui + 1, nxt);
        const char* nB = has_next ? (const char*)g.Bt + (size_t)nxt.pn * tstep : cB;
        if (has_next) { PG8_ROWPTR(nP, ui + 1); } else { _Pragma("unroll") for (int _h = 0; _h < 2; ++_h) _Pragma("unroll") for (int _i = 0; _i < 2; ++_i) nP[_h][_i] = cP[_h][_i]; }
#pragma nounroll
        for (int t = 0; t < nt; t += 2) {
            const bool last = (t == nt - 2);
            const size_t k1 = (size_t)(t + 1) * kstep, k2 = last ? 0 : (size_t)(t + 2) * kstep, k3 = k2 + kstep;
            const char* sP[2][2];
            _Pragma("unroll") for (int _h = 0; _h < 2; ++_h) _Pragma("unroll") for (int _i = 0; _i < 2; ++_i) sP[_h][_i] = last ? nP[_h][_i] : cP[_h][_i];
            const char* b2 = last ? nB : cB + (size_t)(t + 2) * kstep; const char* b3 = b2 + kstep;
            if (last && has_next) S.a_ready(nxt);
            if constexpr (SP2) {
            PG8_LDB(B0, 0, 0); PG8_LDB(B1, 0, 1); PG8_SCHED; PG8_LDA(At, 0, 0); PG8_STAGE_AG(PG8_SA(1, 1), cP, 1, k1);
            PG8_WAIT_V(8); PG8_WAIT_L(0); PG8_BAR; PG8_MMA(0, 0, At, B0); PG8_MMA(0, 1, At, B1); PG8_BAR; PG8_SCHED;
            PG8_LDA(At, 0, 1); PG8_STAGE(PG8_SB(0, 0), b2, voffB); PG8_STAGE(PG8_SB(0, 1), b2 + hstep, voffB); PG8_STAGE_AG(PG8_SA(0, 0), sP, 0, k2);
            PG8_WAIT_V(8); PG8_WAIT_L(0); PG8_BAR; PG8_MMA(1, 0, At, B0); PG8_MMA(1, 1, At, B1); PG8_BAR; PG8_SCHED;
            PG8_LDB(B0, 1, 0); PG8_LDB(B1, 1, 1); PG8_SCHED; PG8_LDA(At, 1, 0); PG8_STAGE_AG(PG8_SA(0, 1), sP, 1, k2);
            PG8_WAIT_V(8); PG8_WAIT_L(0); PG8_BAR; PG8_MMA(0, 0, At, B0); PG8_MMA(0, 1, At, B1); PG8_BAR; PG8_SCHED;
            PG8_LDA(At, 1, 1); PG8_STAGE(PG8_SB(1, 0), b3, voffB); PG8_STAGE(PG8_SB(1, 1), b3 + hstep, voffB); PG8_STAGE_AG(PG8_SA(1, 0), sP, 0, k3);
            PG8_WAIT_V(8); PG8_WAIT_L(0); PG8_BAR; PG8_MMA(1, 0, At, B0); PG8_MMA(1, 1, At, B1); PG8_BAR; PG8_SCHED;
            }
        }
        if constexpr (ALIGN_EPI) { if (wr == 0) PG8_BAR; }
        if constexpr (!Epi::AFTER_DRAIN) { E(acc, cur, ui, wr, wc, fr, fq); S.done(cur); }
        if (!has_next) break;
#pragma unroll
        for (int a = 0; a < 2; ++a)
#pragma unroll
            for (int b = 0; b < 2; ++b)
#pragma unroll
                for (int m = 0; m < 4; ++m)
#pragma unroll
                    for (int n = 0; n < 2; ++n) acc[a][b][m][n] = (f32x4){0.f, 0.f, 0.f, 0.f};
        cur = nxt; cB = nB; ++ui;
        _Pragma("unroll") for (int _h = 0; _h < 2; ++_h) _Pragma("unroll") for (int _i = 0; _i < 2; ++_i) cP[_h][_i] = nP[_h][_i];
        if constexpr (ALIGN_EPI) { if (wr == 1) PG8_BAR; }
    }
    PG8_WAIT_V(0);
    if constexpr (!ALIGN_EPI) { if (wr == 0) PG8_BAR; }
    PG8_BAR;
    if constexpr (Epi::AFTER_DRAIN) { E.fused(acc, cur, wr, wc, fr, fq, lds, wid, lane); S.done(cur); }
#undef PG8_SA
#undef PG8_SB
#undef PG8_STAGE
#undef PG8_STAGE_AG
#undef PG8_ROWPTR
#undef PG8_LDA
#undef PG8_LDB
#undef PG8_MMA
#undef PG8_CAT8
#undef PG8_WAIT_V
#undef PG8_WAIT_L
#undef PG8_BAR
#undef PG8_SCHED
}

}

#define LAS __attribute__((address_space(3)))
typedef unsigned short bf16_t;
typedef float f32x4 __attribute__((ext_vector_type(4)));
typedef unsigned u32x4 __attribute__((ext_vector_type(4)));
typedef unsigned u32x2 __attribute__((ext_vector_type(2)));
typedef __bf16 bf16x2_t __attribute__((ext_vector_type(2)));
constexpr int NWAVES = 8, NTHR = 512;
constexpr int D = 1024, NB = 8, SEQ = 4096, LCTX = 256, TX = NB * SEQ, TC = NB * LCTX, TT = TX + TC, INW = 2304, NE = 16, FF = 2048;
constexpr int CAPX = 512, CAPC = 32, SLOTS = NB * CAPX + NB * CAPC;
constexpr float LOG2E = 1.4426950408889634f;
constexpr int LDS_BYTES = 163840;
enum { I_X = 0, I_C, I_CTX, I_CCTX, I_ADAW, I_ADAB, I_N1G, I_N2G, I_WIN, I_HCW, I_HCB, I_HW1, I_HB1, I_HW2, I_HB2, I_HW3, I_HFREQ, I_HSKIP, I_SINK, I_POOLW, I_POOLS, I_RPB, I_WOUT, I_ROUTER, I_WG, I_WU, I_WD, I_FNG, N_IN };
constexpr size_t MiB = 1u << 20;
constexpr size_t WS_CTL = 0;
constexpr size_t WS_MOD = 1 * MiB;
constexpr size_t WS_WSC = 1 * MiB + 512 * 1024;
constexpr size_t WS_ROPE = 2 * MiB;
constexpr size_t WS_TW8 = 2 * MiB + 65536;
constexpr size_t WS_WIN_T = 3 * MiB;
constexpr size_t WS_WOUT_T = 13 * MiB;
constexpr size_t WS_HC = 17 * MiB;
constexpr size_t WS_HCC = 51 * MiB;
constexpr size_t WS_AFFT = 53 * MiB;
constexpr size_t WS_ROWMAP = 56 * MiB;
constexpr size_t WS_GATE = 57 * MiB;
constexpr size_t WS_INV = 58 * MiB;
constexpr size_t WS_CRES = 61 * MiB;
constexpr size_t WS_HX = 69 * MiB;
constexpr size_t WS_WGU_T = 137 * MiB;
constexpr size_t WS_XB = 265 * MiB;
constexpr size_t WS_WD_T = 393 * MiB;
constexpr size_t WS_R = 521 * MiB;
constexpr size_t WS_ACT = WS_R;
constexpr size_t WS_XG = WS_R + 272 * MiB;
constexpr size_t WS_PX = WS_R;
constexpr size_t WS_Y = WS_R + 153 * MiB;
constexpr size_t WS_YT = WS_XG + 48 * MiB;
constexpr size_t WS_UT = WS_XG;
constexpr size_t WS_HS = WS_R + 408 * MiB;
constexpr size_t WS_END = WS_HS + 64 * MiB;
static_assert(WS_END <= 1024 * MiB, "workspace map");

struct Args { const float* in[N_IN]; float* out; unsigned char* ws; };

__device__ __forceinline__ float bf2f(unsigned short v) { return __uint_as_float(((unsigned)v) << 16); }
__device__ __forceinline__ unsigned f2bf(float f) { unsigned u = __float_as_uint(f); return (u + 0x7fffu + ((u >> 16) & 1u)) >> 16; }
__device__ __forceinline__ unsigned pk2(float lo, float hi) { return f2bf(lo) | (f2bf(hi) << 16); }
__device__ __forceinline__ float bflo(unsigned w) { return __uint_as_float(w << 16); }
__device__ __forceinline__ float bfhi(unsigned w) { return __uint_as_float(w & 0xffff0000u); }
__device__ __forceinline__ float dot2bf(unsigned a, unsigned b, float acc) { return __builtin_amdgcn_fdot2_f32_bf16(__builtin_bit_cast(bf16x2_t, a), __builtin_bit_cast(bf16x2_t, b), acc, false); }
__device__ __forceinline__ float wave_sum(float v) {
#pragma unroll
    for (int o = 1; o < 64; o <<= 1) v += __shfl_xor(v, o);
    return v;
}
#define LDS_WAIT() asm volatile("s_waitcnt lgkmcnt(0)" ::: "memory")

#ifndef AMP_PHASE
#define AMP_PHASE -1
#endif
__device__ __forceinline__ unsigned long long amp_now() { asm volatile("s_waitcnt vmcnt(0) lgkmcnt(0)" ::: "memory"); __builtin_amdgcn_sched_barrier(0); const unsigned long long t = __builtin_amdgcn_s_memrealtime(); asm volatile("s_waitcnt lgkmcnt(0)" ::: "memory"); __builtin_amdgcn_sched_barrier(0); return t; }
#define AMP_BEGIN(id) unsigned long long amp_t0_ = 0; if ((id) == AMP_PHASE) { __syncthreads(); amp_t0_ = amp_now(); }
#define AMP_END(id) if ((id) == AMP_PHASE) { __syncthreads(); const unsigned long long t1_ = amp_now(); const unsigned long long d_ = t1_ - amp_t0_; while (amp_now() - t1_ < d_) __builtin_amdgcn_s_sleep(8); __syncthreads(); }
__device__ __forceinline__ void tr_item(const float* W, int K, int N, bf16_t* WT, int Kt, int item, int mode, LAS float* scr, int lane) {
    const int nblk = N / 32, kb = item / nblk, nb = item % nblk, k0 = 64 * kb, n0 = 32 * nb;
    const int r8 = lane >> 3, c4 = lane & 7; f32x4 v[8];
    const float* wp = W + (size_t)(k0 + r8) * N + n0 + 4 * c4;
#pragma unroll
    for (int i = 0; i < 8; ++i) v[i] = *(const f32x4*)(wp + (size_t)(8 * i) * N);
#pragma unroll
    for (int i = 0; i < 8; ++i) { LAS float* d = scr + (r8 + 8 * i) * 33 + 4 * c4; d[0] = v[i][0]; d[1] = v[i][1]; d[2] = v[i][2]; d[3] = v[i][3]; }
    LDS_WAIT();
    const int c = lane & 7;
    const int drow0 = (mode == 0) ? n0 : ((n0 >> 7) * 256 + (n0 & 127) + (mode == 2 ? 128 : 0));
#pragma unroll
    for (int j = 0; j < 4; ++j) { const int n = (lane >> 3) + 8 * j; const LAS float* sp = scr + (8 * c) * 33 + n;
        u32x4 o; o.x = pk2(sp[0 * 33], sp[1 * 33]); o.y = pk2(sp[2 * 33], sp[3 * 33]); o.z = pk2(sp[4 * 33], sp[5 * 33]); o.w = pk2(sp[6 * 33], sp[7 * 33]);
        *(u32x4*)(WT + (size_t)(drow0 + n) * Kt + k0 + 8 * c) = o; }
    LDS_WAIT();
}

__device__ __forceinline__ void tr_item_fp8(const float* W, int K, int N, unsigned char* WT, int Kt, int item, int mode, LAS float* scr, int lane, float* wsc_out) {
    const int nblk = N / 32, kb = item / nblk, nb = item % nblk, k0 = 64 * kb, n0 = 32 * nb;
    const int r8 = lane >> 3, c4 = lane & 7; f32x4 v[8];
    const f32x4 sv = *(const f32x4*)(W + 4 * lane);
    const float* wp = W + (size_t)(k0 + r8) * N + n0 + 4 * c4;
#pragma unroll
    for (int i = 0; i < 8; ++i) v[i] = *(const f32x4*)(wp + (size_t)(8 * i) * N);
    float sm = fmaxf(fmaxf(fabsf(sv[0]), fabsf(sv[1])), fmaxf(fabsf(sv[2]), fabsf(sv[3])));
#pragma unroll
    for (int o = 1; o < 64; o <<= 1) sm = fmaxf(sm, __shfl_xor(sm, o));
    int E = 0; (void)frexpf(fmaxf(sm, 1e-30f), &E); const float mul = ldexpf(1.0f, 5 - E);
    if (item == 0 && lane == 0) *wsc_out = ldexpf(1.0f, E - 5);
#pragma unroll
    for (int i = 0; i < 8; ++i) { LAS float* d = scr + (r8 + 8 * i) * 33 + 4 * c4; d[0] = v[i][0] * mul; d[1] = v[i][1] * mul; d[2] = v[i][2] * mul; d[3] = v[i][3] * mul; }
    LDS_WAIT();
    const int c = lane & 7;
    const int drow0 = (mode == 0) ? n0 : ((n0 >> 7) * 256 + (n0 & 127) + (mode == 2 ? 128 : 0));
#pragma unroll
    for (int j = 0; j < 4; ++j) { const int n = (lane >> 3) + 8 * j; const LAS float* sp = scr + (8 * c) * 33 + n;
        int p0 = 0, p1 = 0;
        p0 = __builtin_amdgcn_cvt_pk_fp8_f32(sp[0 * 33], sp[1 * 33], p0, false); p0 = __builtin_amdgcn_cvt_pk_fp8_f32(sp[2 * 33], sp[3 * 33], p0, true);
        p1 = __builtin_amdgcn_cvt_pk_fp8_f32(sp[4 * 33], sp[5 * 33], p1, false); p1 = __builtin_amdgcn_cvt_pk_fp8_f32(sp[6 * 33], sp[7 * 33], p1, true);
        typedef int i32x2v __attribute__((ext_vector_type(2)));
        *(i32x2v*)(WT + (size_t)(drow0 + n) * Kt + k0 + 8 * c) = (i32x2v){p0, p1}; }
    LDS_WAIT();
}

__device__ __forceinline__ void filter_item(const Args& a, LAS unsigned char* lds, int item, int tid) {
    asm volatile("" : "+v"(tid));
    const int lane = tid & 63, wave = tid >> 6;
    int l, L, p0; float* HCdst;
    if (item < 128) { l = 0; L = 4096; p0 = item * 32; HCdst = (float*)(a.ws + WS_HC); }
    else if (item < 256) { l = 1; L = 4096; p0 = (item - 128) * 32; HCdst = (float*)(a.ws + WS_HC) + (size_t)2 * 8191 * 256; }
    else { l = 0; L = 256; p0 = (item - 256) * 32; HCdst = (float*)(a.ws + WS_HCC) + 256; }
    LAS float* w1s = (LAS float*)lds; LAS float* w2s = w1s + 33 * 64; LAS float* b1s = w2s + 64 * 64; LAS float* b2s = b1s + 64; LAS float* frs = b2s + 64; LAS float* h2s = frs + 64; LAS float* ex = h2s + 32 * 64;
    { const float* w1 = a.in[I_HW1] + l * 33 * 64; const float* w2 = a.in[I_HW2] + l * 64 * 64;
      for (int i = tid; i < 33 * 64; i += NTHR) w1s[i] = w1[i];
      for (int i = tid; i < 64 * 64; i += NTHR) w2s[i] = w2[i];
      if (tid < 64) { b1s[tid] = a.in[I_HB1][l * 64 + tid]; b2s[tid] = a.in[I_HB2][l * 64 + tid]; frs[tid] = a.in[I_HFREQ][l * 64 + tid]; } }
    __syncthreads();
    const float frq = frs[lane];
#pragma unroll 1
    for (int q = 0; q < 4; ++q) { const int pp = wave * 4 + q, p = p0 + pp; const float tn = (float)p / (float)(L - 1);
        float fv = 0.f;
        if (lane == 0) fv = tn;
        else if (lane <= 32) { const int bi = (lane - 1) & 15; const float band = 1e-4f + (float)bi * ((15.0f - 1e-4f) / 15.0f);
            const float ang = ((float)(6.283185307179586 / (double)L) * (float)p) * band; fv = (lane <= 16) ? cosf(ang) : -sinf(ang); }
        float a1 = b1s[lane];
#pragma unroll
        for (int i = 0; i < 33; ++i) a1 += __shfl(fv, i) * w1s[i * 64 + lane];
        const float h1 = sinf(frq * a1);
        float a2 = b2s[lane];
#pragma unroll 16
        for (int i = 0; i < 64; ++i) a2 += __shfl(h1, i) * w2s[i * 64 + lane];
        h2s[pp * 64 + lane] = sinf(frq * a2); }
    __syncthreads();
    const float* w3 = a.in[I_HW3] + (size_t)l * 64 * 1024 + tid;
    float acc0[32], acc1[32];
#pragma unroll
    for (int pp = 0; pp < 32; ++pp) { acc0[pp] = 0.f; acc1[pp] = 0.f; }
#pragma unroll 4
    for (int i = 0; i < 64; ++i) { const float wa = w3[i * 1024], wb = w3[i * 1024 + 512];
#pragma unroll
        for (int pp = 0; pp < 32; ++pp) { const float h = h2s[pp * 64 + i]; acc0[pp] += h * wa; acc1[pp] += h * wb; } }
    const int c = tid & 255, dir = tid >> 8; const float dmin = 3.0701134573253945f, dmax = 15.350567286626972f; const float delta = dmin + (float)c * ((dmax - dmin) / 255.0f);
    float* base0 = HCdst; float* base1 = HCdst + (size_t)(2 * L - 1) * 256;
#pragma unroll
    for (int pp = 0; pp < 32; ++pp) { const int p = p0 + pp; const float tn = (float)p / (float)(L - 1); const float win = expf(-tn * delta); const float v0 = acc0[pp] * win, v1 = acc1[pp] * win;
        if (p == 0) { ex[tid] = v0; ex[512 + tid] = v1; }
        else { const size_t idx = (size_t)(dir == 0 ? (L - 1 + p) : (L - 1 - p)) * 256 + c; base0[idx] = v0; base1[idx] = v1; } }
    __syncthreads();
    if (p0 == 0 && tid < 256) { const size_t idx = (size_t)(L - 1) * 256 + tid; base0[idx] = ex[tid] + ex[tid + 256]; base1[idx] = ex[512 + tid] + ex[512 + tid + 256]; }
    __syncthreads();
}


typedef int v8i_t __attribute__((ext_vector_type(8)));
__device__ __forceinline__ float st_A(int i, int k) { return (float)(((i * 7 + k * 3) % 5) - 2); }
__device__ __forceinline__ float st_B(int k, int j) { return (float)(((k * 5 + j * 11 + (k >> 4)) % 5) - 2); }
__device__ __forceinline__ void fp8_selftest(unsigned* poison, int lane) {
    const int fr = lane & 15, fq = lane >> 4; v8i_t av, bv;
#pragma unroll
    for (int w = 0; w < 8; ++w) { int pa = 0, pb = 0;
#pragma unroll
        for (int q = 0; q < 4; ++q) { }
        const int kb = (w < 4) ? (16 * fq + 4 * w) : (64 + 16 * fq + 4 * (w - 4));
        pa = __builtin_amdgcn_cvt_pk_fp8_f32(st_A(fr, kb), st_A(fr, kb + 1), pa, false); pa = __builtin_amdgcn_cvt_pk_fp8_f32(st_A(fr, kb + 2), st_A(fr, kb + 3), pa, true);
        pb = __builtin_amdgcn_cvt_pk_fp8_f32(st_B(kb, fr), st_B(kb + 1, fr), pb, false); pb = __builtin_amdgcn_cvt_pk_fp8_f32(st_B(kb + 2, fr), st_B(kb + 3, fr), pb, true);
        av[w] = pa; bv[w] = pb; }
    f32x4 acc = {0.f, 0.f, 0.f, 0.f};
    acc = __builtin_amdgcn_mfma_scale_f32_16x16x128_f8f6f4(av, bv, acc, 0, 0, 0, 0x7f7f7f7f, 0, 0x7f7f7f7f);
    bool bad = false;
#pragma unroll
    for (int r = 0; r < 4; ++r) { float ref = 0.f; for (int k = 0; k < 128; ++k) ref += st_A(4 * fq + r, k) * st_B(k, fr); bad |= (acc[r] != ref); }
    if (__any(bad) && lane == 0) __hip_atomic_store(poison, 1u, __ATOMIC_RELAXED, __HIP_MEMORY_SCOPE_AGENT);
}

__device__ __forceinline__ void phase_prologue(const Args& a, unsigned char* ldsg, int vcu, int G) {
    LAS unsigned char* lds = (LAS unsigned char*)ldsg;
    int tid_ = threadIdx.x; asm volatile("" : "+v"(tid_));
    const int tid = tid_, lane = tid & 63, wave = __builtin_amdgcn_readfirstlane(tid >> 6);
    unsigned char* ws = a.ws;
    if (vcu == 2 % G && wave == 0) fp8_selftest((unsigned*)(ws + WS_CTL) + 12288, lane);
    LAS float* sc = (LAS float*)lds; LAS float* red = (LAS float*)(lds + 36864);
    for (int i = tid; i < 9 * 1024; i += NTHR) { const float v = (i < 8192) ? a.in[I_C][i] : a.in[I_CCTX][i - 8192]; sc[i] = v / (1.0f + expf(-v)); }
    __syncthreads();
    { AMP_BEGIN(41)
    float* MOD = (float*)(ws + WS_MOD);
    for (int item = vcu; item < 2 * 96; item += G) {
        const int l = item / 96, n0 = (item % 96) * 64, col = tid & 63, kg = tid >> 6;
        float acc[9];
#pragma unroll
        for (int r = 0; r < 9; ++r) acc[r] = 0.f;
        const float* w = a.in[I_ADAW] + (size_t)l * 1024 * 6144 + n0 + col;
#pragma unroll 4
        for (int k = kg * 128; k < kg * 128 + 128; ++k) { const float wv = w[(size_t)k * 6144];
#pragma unroll
            for (int r = 0; r < 9; ++r) acc[r] += sc[r * 1024 + k] * wv; }
#pragma unroll
        for (int r = 0; r < 9; ++r) red[(kg * 9 + r) * 64 + col] = acc[r];
        __syncthreads();
        for (int o = tid; o < 9 * 64; o += NTHR) { const int r = o >> 6, cc = o & 63; float s = 0.f;
#pragma unroll
            for (int g2 = 0; g2 < 8; ++g2) s += red[(g2 * 9 + r) * 64 + cc];
            MOD[(size_t)(l * 9 + r) * 6144 + n0 + cc] = s + a.in[I_ADAB][l * 6144 + n0 + cc]; }
        __syncthreads();
    }
    AMP_END(41) }
    if (vcu == 0) { float* ROPE = (float*)(ws + WS_ROPE);
        for (int i = tid; i < 1024; i += NTHR) { const int pos = i >> 4, fi = i & 15; const float inv = powf(10000.0f, -(float)fi / 16.0f); const float ang = (float)pos * inv;
            ROPE[2 * i] = cosf(ang); ROPE[2 * i + 1] = sinf(ang); } }
    if (vcu == 1 % G) { float* TW8 = (float*)(ws + WS_TW8);
        for (int i = tid; i < 8192; i += NTHR) { float sn, cs; sincospif(-(float)i * (1.0f / 4096.0f), &sn, &cs); TW8[2 * i] = cs; TW8[2 * i + 1] = sn; } }
    const int gw = vcu * NWAVES + wave, NGW = G * NWAVES;
    { AMP_BEGIN(42)
    for (int it = vcu; it < 264; it += G) filter_item(a, lds, it, tid);
    AMP_END(42) }
    { AMP_BEGIN(43)
    LAS float* scr = (LAS float*)(lds + 65536 + wave * 8448);
    constexpr int IT_IN = 16 * 72, IT_OUT = 16 * 32, IT_E = 1024, IT_LAYER = IT_IN + IT_OUT + 3 * 16 * IT_E;
    for (int it = gw; it < 2 * IT_LAYER; it += NGW) {
        const int l = it / IT_LAYER; int r = it % IT_LAYER;
        if (r < IT_IN) { tr_item(a.in[I_WIN] + (size_t)l * 1024 * 2304, 1024, 2304, (bf16_t*)(ws + WS_WIN_T) + (size_t)l * 2304 * 1024, 1024, r, 0, scr, lane); continue; } r -= IT_IN;
        if (r < IT_OUT) { tr_item(a.in[I_WOUT] + (size_t)l * 1024 * 1024, 1024, 1024, (bf16_t*)(ws + WS_WOUT_T) + (size_t)l * 1024 * 1024, 1024, r, 0, scr, lane); continue; } r -= IT_OUT;
        const int which = r / (16 * IT_E), e = (r / IT_E) & 15, ri = r % IT_E; const size_t le = (size_t)l * 16 + e;
        float* wsc = (float*)(ws + WS_WSC) + (l * 3 + which) * 16 + e;
        if (which == 0) tr_item_fp8(a.in[I_WG] + le * 1024 * 2048, 1024, 2048, (unsigned char*)(ws + WS_WGU_T) + le * 4096 * 1024, 1024, ri, 1, scr, lane, wsc);
        else if (which == 1) tr_item_fp8(a.in[I_WU] + le * 1024 * 2048, 1024, 2048, (unsigned char*)(ws + WS_WGU_T) + le * 4096 * 1024, 1024, ri, 2, scr, lane, wsc);
        else tr_item_fp8(a.in[I_WD] + le * 2048 * 1024, 2048, 1024, (unsigned char*)(ws + WS_WD_T) + le * 1024 * 2048, 2048, ri, 0, scr, lane, wsc);
    }
    AMP_END(43) }
}

__device__ __forceinline__ void phase_norm(const Args& a, unsigned char* ldsg, int vcu, int G, int l, const float* srcx, const float* srcc, const bf16_t* srcb, const float* gain, int shift_idx, int nrows, bool router) {
    int tid_ = threadIdx.x; asm volatile("" : "+v"(tid_));
    const int tid = tid_, lane = tid & 63, wave = __builtin_amdgcn_readfirstlane(tid >> 6);
    unsigned char* ws = a.ws; const float* MOD = (const float*)(ws + WS_MOD) + (size_t)l * 9 * 6144; bf16_t* HX = (bf16_t*)(ws + WS_HX);
    LAS float* rw = (LAS float*)(LAS unsigned char*)ldsg;
    if (router) { const float* rsrc = a.in[I_ROUTER] + (size_t)l * 1024 * 16; for (int i = tid; i < 1024 * 16; i += NTHR) rw[(i & 15) * 1024 + (i >> 4)] = rsrc[i]; __syncthreads(); }
    const int gw = vcu * NWAVES + wave, NGW = G * NWAVES;
    for (int rowa = gw; rowa < nrows; rowa += 2 * NGW) {
        f32x4 vv[2][4];
#pragma unroll
        for (int u = 0; u < 2; ++u) { const int rr = (rowa + u * NGW < nrows) ? rowa + u * NGW : rowa;
            if (srcb) { const bf16_t* xr = srcb + (size_t)rr * D;
#pragma unroll
                for (int j = 0; j < 4; ++j) { const u32x2 w = *(const u32x2*)(xr + 256 * j + 4 * lane); vv[u][j] = (f32x4){bflo(w.x), bfhi(w.x), bflo(w.y), bfhi(w.y)}; } }
            else { const float* xr = (rr < TX) ? srcx + (size_t)rr * D : srcc + (size_t)(rr - TX) * D;
#pragma unroll
                for (int j = 0; j < 4; ++j) vv[u][j] = *(const f32x4*)(xr + 256 * j + 4 * lane); } }
#pragma unroll
        for (int u = 0; u < 2; ++u) { const int row = rowa + u * NGW; if (row < nrows) {
        const bool lat = row < TX; const int mrow = lat ? (row >> 12) : 8;
        const float* shp = MOD + mrow * 6144 + shift_idx * 1024; const float* scp = shp + 1024;
        f32x4 v[4]; float ss = 0.f;
#pragma unroll
        for (int j = 0; j < 4; ++j) { v[j] = vv[u][j]; ss += (v[j][0] * v[j][0] + v[j][1] * v[j][1]) + (v[j][2] * v[j][2] + v[j][3] * v[j][3]); }
        const float rstd = 1.0f / sqrtf(wave_sum(ss) * (1.0f / D) + 1e-6f);
#pragma unroll
        for (int j = 0; j < 4; ++j) { const f32x4 gg = *(const f32x4*)(gain + 256 * j + 4 * lane), sh = *(const f32x4*)(shp + 256 * j + 4 * lane), sc = *(const f32x4*)(scp + 256 * j + 4 * lane);
            v[j] = (v[j] * rstd * gg) * (1.0f + sc) + sh;
            if (router) { int p = 0; p = __builtin_amdgcn_cvt_pk_fp8_f32(fminf(fmaxf(v[j][0], -448.f), 448.f), fminf(fmaxf(v[j][1], -448.f), 448.f), p, false); p = __builtin_amdgcn_cvt_pk_fp8_f32(fminf(fmaxf(v[j][2], -448.f), 448.f), fminf(fmaxf(v[j][3], -448.f), 448.f), p, true);
                *(int*)((unsigned char*)HX + (size_t)row * D + 256 * j + 4 * lane) = p; }
            else { u32x2 o; o.x = pk2(v[j][0], v[j][1]); o.y = pk2(v[j][2], v[j][3]); *(u32x2*)(HX + (size_t)row * D + 256 * j + 4 * lane) = o; } }
        if (router) {
            float pl[16];
#pragma unroll
            for (int e = 0; e < 16; ++e) { float p = 0.f;
#pragma unroll
                for (int j = 0; j < 4; ++j) { const f32x4 wv = *(const LAS f32x4*)(rw + e * 1024 + 256 * j + 4 * lane);
                    p += (v[j][0] * wv[0] + v[j][1] * wv[1]) + (v[j][2] * wv[2] + v[j][3] * wv[3]); }
                pl[e] = p; asm volatile("" : "+v"(pl[e])); }
            float q8[8], q4[4], q2[2], q1;
            { const bool up = (lane & 8) != 0;
#pragma unroll
              for (int e = 0; e < 8; ++e) { const float keep = up ? pl[e + 8] : pl[e], give = up ? pl[e] : pl[e + 8]; q8[e] = keep + __shfl_xor(give, 8); } }
            { const bool up = (lane & 4) != 0;
#pragma unroll
              for (int e = 0; e < 4; ++e) { const float keep = up ? q8[e + 4] : q8[e], give = up ? q8[e] : q8[e + 4]; q4[e] = keep + __shfl_xor(give, 4); } }
            { const bool up = (lane & 2) != 0;
#pragma unroll
              for (int e = 0; e < 2; ++e) { const float keep = up ? q4[e + 2] : q4[e], give = up ? q4[e] : q4[e + 2]; q2[e] = keep + __shfl_xor(give, 2); } }
            { const bool up = (lane & 1) != 0; const float keep = up ? q2[1] : q2[0], give = up ? q2[0] : q2[1]; q1 = keep + __shfl_xor(give, 1); }
            q1 += __shfl_xor(q1, 16); q1 += __shfl_xor(q1, 32);
            const float mylog = (lane < 16) ? q1 : -1e30f;
            float mx = mylog;
#pragma unroll
            for (int o = 1; o < 16; o <<= 1) mx = fmaxf(mx, __shfl_xor(mx, o));
            const float mine = (lane < 16) ? expf(mylog - mx) : 0.f; float den = mine;
#pragma unroll
            for (int o = 1; o < 16; o <<= 1) den += __shfl_xor(den, o);
            if (lane < 16) { ((float*)(ws + WS_AFFT))[(size_t)lane * TT + row] = mine / den; ((int*)(ws + WS_INV))[(size_t)row * 16 + lane] = -1; }
        }
    } }
    }
}

#define XB_TMO      128
#define XB_XCNT(j)  (256  + 64 * (j))
#define XB_XSUB(j)  (1280 + 64 * (j))
#define XB_XGEN(j)  (2304 + 64 * (j))
#define XB_TOP      3328
#define XB_TOPGEN   3392
#define XCD_BAR_WORDS 3456
#define XB_SPIN_CAP (1u << 18)

__device__ __forceinline__ unsigned xb_ld(unsigned* p)              { return __hip_atomic_load(p, __ATOMIC_RELAXED, __HIP_MEMORY_SCOPE_AGENT); }
__device__ __forceinline__ unsigned xb_add(unsigned* p, unsigned v) { return __hip_atomic_fetch_add(p, v, __ATOMIC_RELAXED, __HIP_MEMORY_SCOPE_AGENT); }
__device__ __forceinline__ unsigned xb_xcc_id() { return (unsigned)__builtin_amdgcn_s_getreg((3 << 11) | 20) & 0xFu; }
#define XB_SPIN(cond, bar) do { unsigned _sp = 0; while (cond) { __builtin_amdgcn_s_sleep(1); \
    if ((++_sp & 255u) == 0u) { if (xb_ld(&(bar)[XB_TMO])) break; if (_sp > XB_SPIN_CAP) { atomicAdd(&(bar)[XB_TMO], 1u); break; } } } } while (0)

struct XcdBarrier {
    unsigned* bar; unsigned x;
    volatile LAS unsigned* st;
};

__device__ __forceinline__ XcdBarrier xcd_barrier_post(unsigned* bar, volatile LAS unsigned* st) {
    XcdBarrier b; b.bar = bar; b.x = xb_xcc_id(); b.st = st;
    if (threadIdx.x == 0) (void)xb_add(&bar[XB_XCNT(b.x)], 1u);
    return b;
}
__device__ __forceinline__ void xcd_barrier_complete(unsigned* bar, unsigned x, unsigned& nloc, unsigned& nx) {
    const unsigned G = gridDim.x * gridDim.y * gridDim.z;
    unsigned sum, cnt, mine, sp = 0u;
    for (;;) {
        sum = 0u; cnt = 0u; mine = 0u;
#pragma unroll
        for (unsigned j = 0; j < 16; ++j) { const unsigned c = xb_ld(&bar[XB_XCNT(j)]); sum += c; cnt += (c > 0u) ? 1u : 0u; mine = (j == x) ? c : mine; }
        if (sum == G) break;
        __builtin_amdgcn_s_sleep(1);
        if ((++sp & 255u) == 0u) { if (xb_ld(&bar[XB_TMO])) break; if (sp > XB_SPIN_CAP) { atomicAdd(&bar[XB_TMO], 1u); break; } }
    }
    nloc = mine > 0u ? mine : 1u; nx = cnt > 0u ? cnt : 1u;
}

__device__ __forceinline__ void xcd_barrier(const XcdBarrier& b) {
    asm volatile("s_waitcnt vmcnt(0)" ::: "memory");
    __syncthreads();
    if (threadIdx.x == 0) {
        unsigned* bar = b.bar;
        __builtin_amdgcn_s_waitcnt(0);
        unsigned nloc = b.st[0], nx = b.st[1];
        if (nloc == 0u) { xcd_barrier_complete(bar, b.x, nloc, nx); b.st[0] = nloc; b.st[1] = nx; }
        const unsigned old = xb_add(&bar[XB_XSUB(b.x)], 1u);
        const unsigned gen = old / nloc;
        if (old + 1u == (gen + 1u) * nloc) {
            __builtin_amdgcn_fence(__ATOMIC_RELEASE, "agent");
            asm volatile("s_waitcnt vmcnt(0)" ::: "memory");
            const unsigned og = xb_add(&bar[XB_TOP], 1u);
            const unsigned tg = og / nx;
            if (og + 1u == (tg + 1u) * nx) xb_add(&bar[XB_TOPGEN], 1u);
            else XB_SPIN(xb_ld(&bar[XB_TOPGEN]) == tg, bar);
            __builtin_amdgcn_fence(__ATOMIC_ACQUIRE, "agent");
            xb_add(&bar[XB_XGEN(b.x)], 1u);
            asm volatile("s_waitcnt vmcnt(0)" ::: "memory");
        } else {
            XB_SPIN(xb_ld(&bar[XB_XGEN(b.x)]) == gen, bar);
            __builtin_amdgcn_fence(__ATOMIC_ACQUIRE, "agent");
            asm volatile("s_waitcnt vmcnt(0)" ::: "memory");
        }
    }
    __syncthreads();
}


typedef float f32x2 __attribute__((ext_vector_type(2)));
__device__ __forceinline__ f32x2 cmul(f32x2 a, f32x2 b) { return (f32x2){a.x * b.x - a.y * b.y, a.x * b.y + a.y * b.x}; }
__device__ __forceinline__ void dft16(f32x2 (&v)[16]) {
    constexpr float WC[8] = {1.0f, 0.92387953251128674f, 0.70710678118654752f, 0.38268343236508977f, 0.0f, -0.38268343236508977f, -0.70710678118654752f, -0.92387953251128674f};
    constexpr float WS[8] = {0.0f, -0.38268343236508977f, -0.70710678118654752f, -0.92387953251128674f, -1.0f, -0.92387953251128674f, -0.70710678118654752f, -0.38268343236508977f};
#pragma unroll
    for (int s = 8; s >= 1; s >>= 1)
#pragma unroll
        for (int i = 0; i < 16; ++i) if ((i & s) == 0) { const int k = (i & (s - 1)) * (8 / s); const f32x2 u = v[i], t = v[i + s]; v[i] = u + t; const f32x2 d = u - t;
            v[i + s] = (k == 0) ? d : ((k == 4) ? (f32x2){d.y, -d.x} : (f32x2){d.x * WC[k] - d.y * WS[k], d.x * WS[k] + d.y * WC[k]}); }
}
__device__ __forceinline__ constexpr int bitrev4(int i) { return ((i & 1) << 3) | ((i & 2) << 1) | ((i & 4) >> 1) | ((i & 8) >> 3); }
template <int NS, int MODE>
__device__ __forceinline__ void fft_pass(LAS f32x2* Z, const LAS f32x2* TW, int tid, const f32x2* H) {
    const int f = tid >> 8, j = tid & 255, base = f * 4096, k = j & (NS - 1);
    f32x2 v[16];
#pragma unroll
    for (int r = 0; r < 16; ++r) { const int idx = base + j + 256 * r; v[r] = Z[idx + (idx >> 4)]; }
    if (MODE == 1) {
#pragma unroll
        for (int r = 0; r < 16; ++r) { const f32x2 p = cmul(v[r], H[r]); v[r] = (f32x2){p.y, p.x}; } }
    if (NS > 1) { const LAS f32x2* tp = (NS == 16) ? (TW + 8192 + k) : (TW + 4096 + k);
#pragma unroll
        for (int r = 1; r < 16; ++r) v[r] = cmul(v[r], tp[r * NS]); }
    dft16(v);
    if (NS != 256) __syncthreads();
    const int j0 = base + (j / NS) * NS * 16 + k;
#pragma unroll
    for (int rr = 0; rr < 16; ++rr) { const int idx = j0 + rr * NS; Z[idx + (idx >> 4)] = v[bitrev4(rr)]; }
    __syncthreads();
}
__device__ __forceinline__ void load_uc(const bf16_t* UT, const float* cw, const float* cb, int ch, int b, int tid, float (&out)[8]) {
    const bf16_t* p = UT + ((size_t)(b * 768 + ch)) * 4096 + 8 * tid;
    const u32x4 w = *(const u32x4*)p; float u[10];
    u[1] = bflo(w.x); u[2] = bfhi(w.x); u[3] = bflo(w.y); u[4] = bfhi(w.y); u[5] = bflo(w.z); u[6] = bfhi(w.z); u[7] = bflo(w.w); u[8] = bfhi(w.w);
    u[0] = (tid > 0) ? bf2f(p[-1]) : 0.f; u[9] = (tid < 511) ? bf2f(p[8]) : 0.f;
    const float w0 = cw[ch], w1 = cw[768 + ch], w2 = cw[1536 + ch], bb = cb[ch];
#pragma unroll
    for (int i = 0; i < 8; ++i) out[i] = u[i] * w0 + u[i + 1] * w1 + u[i + 2] * w2 + bb;
}
__device__ __forceinline__ void hy_fill(LAS f32x2* Z, const LAS f32x2* TW, int tid, const float (&va)[8], const float (&vb)[8]) {
#pragma unroll
    for (int i = 0; i < 8; ++i) { const int t = 8 * tid + i; const f32x2 z = {va[i], vb[i]}; Z[t + (t >> 4)] = z; const int t2 = 4096 + t; Z[t2 + (t2 >> 4)] = cmul(z, TW[t]); }
    __syncthreads();
}
__device__ __forceinline__ void hy_conv(LAS f32x2* Z, const LAS f32x2* TW, int tid, const f32x2* Hg) {
    f32x2 H[16];
    { const int f = tid >> 8, j = tid & 255, base = f * 4096;
#pragma unroll
      for (int r = 0; r < 16; ++r) H[r] = Hg[base + j + 256 * r]; }
    fft_pass<1, 0>(Z, TW, tid, nullptr); fft_pass<16, 0>(Z, TW, tid, nullptr); fft_pass<256, 0>(Z, TW, tid, nullptr);
    fft_pass<1, 1>(Z, TW, tid, H); fft_pass<16, 0>(Z, TW, tid, nullptr); fft_pass<256, 0>(Z, TW, tid, nullptr);
}
__device__ __forceinline__ f32x2 hy_out(const LAS f32x2* Z, const LAS f32x2* TW, int t) {
    const f32x2 se = Z[t + (t >> 4)]; const int t2 = 4096 + t; const f32x2 so = Z[t2 + (t2 >> 4)]; const f32x2 tw = TW[t];
    const f32x2 So = {so.y, so.x};
    return (f32x2){se.y + (So.x * tw.x + So.y * tw.y), se.x + (So.y * tw.x - So.x * tw.y)};
}
__device__ __forceinline__ void hyena_item(const Args& a, LAS unsigned char* lds, int l, int c, int bp, int tid) {
    asm volatile("" : "+v"(tid));
    LAS f32x2* Z = (LAS f32x2*)lds; const LAS f32x2* TW = (const LAS f32x2*)(lds + 69632);
    const bf16_t* UT = (const bf16_t*)(a.ws + WS_UT); bf16_t* YT = (bf16_t*)(a.ws + WS_YT);
    const float* cw = a.in[I_HCW] + (size_t)l * 3 * 768; const float* cb = a.in[I_HCB] + (size_t)l * 768; const float* skip = a.in[I_HSKIP] + (size_t)l * 2 * 256;
    const f32x2* HS = (const f32x2*)(a.ws + WS_HS) + ((size_t)(l * 2) * 256 + c) * 8192;
    const int b0 = 2 * bp, b1 = 2 * bp + 1;
    float va[8], vb[8], xa[8], xb[8];
    load_uc(UT, cw, cb, c, b0, tid, va); load_uc(UT, cw, cb, c, b1, tid, vb);
    hy_fill(Z, TW, tid, va, vb);
    hy_conv(Z, TW, tid, HS);
    load_uc(UT, cw, cb, 256 + c, b0, tid, xa); load_uc(UT, cw, cb, 256 + c, b1, tid, xb);
    { const float sk = skip[c];
#pragma unroll
      for (int i = 0; i < 8; ++i) { const f32x2 y = hy_out(Z, TW, 8 * tid + i); va[i] = xa[i] * (y.x + va[i] * sk); vb[i] = xb[i] * (y.y + vb[i] * sk); } }
    __syncthreads();
    hy_fill(Z, TW, tid, va, vb);
    hy_conv(Z, TW, tid, HS + (size_t)256 * 8192);
    load_uc(UT, cw, cb, 512 + c, b0, tid, xa); load_uc(UT, cw, cb, 512 + c, b1, tid, xb);
    { const float sk = skip[256 + c];
      float oa[8], ob[8];
#pragma unroll
      for (int i = 0; i < 8; ++i) { const f32x2 y = hy_out(Z, TW, 8 * tid + i); oa[i] = xa[i] * (y.x + va[i] * sk); ob[i] = xb[i] * (y.y + vb[i] * sk); }
      u32x4 wa, wb; wa.x = pk2(oa[0], oa[1]); wa.y = pk2(oa[2], oa[3]); wa.z = pk2(oa[4], oa[5]); wa.w = pk2(oa[6], oa[7]); wb.x = pk2(ob[0], ob[1]); wb.y = pk2(ob[2], ob[3]); wb.z = pk2(ob[4], ob[5]); wb.w = pk2(ob[6], ob[7]);
      *(u32x4*)(YT + ((size_t)(b0 * 256 + c)) * 4096 + 8 * tid) = wa; *(u32x4*)(YT + ((size_t)(b1 * 256 + c)) * 4096 + 8 * tid) = wb; }
    __syncthreads();
}
__device__ __forceinline__ void spectrum_item(const Args& a, LAS unsigned char* lds, int item, int tid) {
    asm volatile("" : "+v"(tid));
    LAS f32x2* Z = (LAS f32x2*)lds; const LAS f32x2* TW = (const LAS f32x2*)(lds + 69632);
    const int c = item & 255, lo = item >> 8;
    const float* HC = (const float*)(a.ws + WS_HC) + (size_t)lo * 8191 * 256 + c;
#pragma unroll
    for (int i = 0; i < 8; ++i) { const int t = 8 * tid + i; const float hl = HC[(size_t)(4095 + t) * 256], hh = (t == 0) ? 0.f : HC[(size_t)(t - 1) * 256];
        Z[t + (t >> 4)] = (f32x2){hl + hh, 0.f}; const int t2 = 4096 + t; const f32x2 tw = TW[t]; const float dd = hl - hh; Z[t2 + (t2 >> 4)] = (f32x2){dd * tw.x, dd * tw.y}; }
    __syncthreads();
    fft_pass<1, 0>(Z, TW, tid, nullptr); fft_pass<16, 0>(Z, TW, tid, nullptr); fft_pass<256, 0>(Z, TW, tid, nullptr);
    f32x2* HS = (f32x2*)(a.ws + WS_HS) + (size_t)item * 8192;
#pragma unroll
    for (int i = 0; i < 16; ++i) { const int idx = tid + 512 * i; HS[idx] = Z[idx + (idx >> 4)] * (1.0f / 8192.0f); }
    __syncthreads();
}
__device__ __forceinline__ void load_tw(const Args& a, LAS unsigned char* lds, int tid) {
    asm volatile("" : "+v"(tid));
    LAS f32x2* TW = (LAS f32x2*)(lds + 69632); const f32x2* src = (const f32x2*)(a.ws + WS_TW8);
    for (int i = tid; i < 4096; i += NTHR) { TW[i] = src[i]; const int r = i >> 8, k = i & 255; TW[4096 + i] = src[r * k * 2]; }
    if (tid < 256) { const int r = tid >> 4, k = tid & 15; TW[8192 + tid] = src[r * k * 32]; }
    __syncthreads();
}
__device__ __forceinline__ float ctx_uc(const bf16_t* PXc, const float* cw, const float* cb, int ch, int t) {
    const float u1 = bf2f(PXc[(size_t)t * INW + ch]); const float u0 = (t > 0) ? bf2f(PXc[(size_t)(t - 1) * INW + ch]) : 0.f; const float u2 = (t < 255) ? bf2f(PXc[(size_t)(t + 1) * INW + ch]) : 0.f;
    return u0 * cw[ch] + u1 * cw[768 + ch] + u2 * cw[1536 + ch] + cb[ch];
}
__device__ __forceinline__ void ctx_conv16(const LAS float* IN, const float* H, int c, int lane, int t0, float (&acc)[16]) {
    float w[16];
    const float* hp = H + (size_t)(t0 + 255) * 256 + c;
#pragma unroll
    for (int i = 0; i < 16; ++i) { acc[i] = 0.f; w[i] = hp[i * 256]; }
    const LAS float* ip = IN + lane;
#pragma unroll 1
    for (int s0 = 0; s0 < 256; s0 += 16) {
#pragma unroll
        for (int u = 0; u < 16; ++u) { const float v = ip[u * 64];
#pragma unroll
            for (int i = 0; i < 16; ++i) acc[i] += v * w[(i - u + 16) & 15];
            w[(15 - u) & 15] = hp[-(u + 1) * 256]; }
        hp -= 16 * 256; ip += 16 * 64; }
}
__device__ __forceinline__ void ctx_hyena_item(const Args& a, LAS unsigned char* lds, int l, int item, int tid) {
    asm volatile("" : "+v"(tid));
    const int lane = tid & 63, wave = tid >> 6, b = item >> 2, c = (item & 3) * 64 + lane;
    LAS float* V = (LAS float*)lds; LAS float* Z1 = (LAS float*)(lds + 65536);
    const bf16_t* PXc = (const bf16_t*)(a.ws + WS_PX) + (size_t)(TX + b * 256) * INW; bf16_t* Y = (bf16_t*)(a.ws + WS_Y) + (size_t)(TX + b * 256) * D;
    const float* cw = a.in[I_HCW] + (size_t)l * 3 * 768; const float* cb = a.in[I_HCB] + (size_t)l * 768; const float* skip = a.in[I_HSKIP] + (size_t)l * 2 * 256;
    const float* H0 = (const float*)(a.ws + WS_HCC) + 256, *H1 = H0 + (size_t)511 * 256;
#pragma unroll 2
    for (int i = 0; i < 32; ++i) { const int t = wave * 32 + i; V[t * 64 + lane] = ctx_uc(PXc, cw, cb, c, t); }
    __syncthreads();
    float acc[16];
#pragma unroll 1
    for (int g = 0; g < 2; ++g) { const int t0 = wave * 32 + g * 16; ctx_conv16(V, H0, c, lane, t0, acc); const float sk = skip[c];
#pragma unroll
        for (int i = 0; i < 16; ++i) { const int t = t0 + i; Z1[t * 64 + lane] = ctx_uc(PXc, cw, cb, 256 + c, t) * (acc[i] + V[t * 64 + lane] * sk); } }
    __syncthreads();
#pragma unroll 1
    for (int g = 0; g < 2; ++g) { const int t0 = wave * 32 + g * 16; ctx_conv16(Z1, H1, c, lane, t0, acc); const float sk = skip[256 + c];
#pragma unroll
        for (int i = 0; i < 16; ++i) { const int t = t0 + i; Y[(size_t)t * D + c] = (bf16_t)f2bf(ctx_uc(PXc, cw, cb, 512 + c, t) * (acc[i] + Z1[t * 64 + lane] * sk)); } }
    __syncthreads();
}

__device__ __forceinline__ void ytr_item(const Args& a, LAS unsigned char* tile, int item, int lane) {
    const int b = item >> 8, tt = (item >> 2) & 63, ct = item & 3;
    const bf16_t* src = (const bf16_t*)(a.ws + WS_YT) + ((size_t)(b * 256 + ct * 64)) * 4096 + tt * 64; bf16_t* Y = (bf16_t*)(a.ws + WS_Y) + ((size_t)b * 4096 + tt * 64) * D + ct * 64;
    u32x4 v[8];
#pragma unroll
    for (int i = 0; i < 8; ++i) v[i] = *(const u32x4*)(src + (size_t)((lane >> 3) + 8 * i) * 4096 + (lane & 7) * 8);
#pragma unroll
    for (int i = 0; i < 8; ++i) *(LAS u32x4*)(tile + ((lane >> 3) + 8 * i) * 144 + (lane & 7) * 16) = v[i];
    LDS_WAIT();
    const LAS unsigned short* tp = (const LAS unsigned short*)(tile + lane * 2);
#pragma unroll
    for (int q = 0; q < 8; ++q) { u32x4 o;
        o.x = (unsigned)tp[(8 * q + 0) * 72] | ((unsigned)tp[(8 * q + 1) * 72] << 16); o.y = (unsigned)tp[(8 * q + 2) * 72] | ((unsigned)tp[(8 * q + 3) * 72] << 16);
        o.z = (unsigned)tp[(8 * q + 4) * 72] | ((unsigned)tp[(8 * q + 5) * 72] << 16); o.w = (unsigned)tp[(8 * q + 6) * 72] | ((unsigned)tp[(8 * q + 7) * 72] << 16);
        *(u32x4*)(Y + (size_t)lane * D + 8 * q) = o; }
    LDS_WAIT();
}
__device__ __forceinline__ void event_arrive(unsigned* ctr) {
    asm volatile("s_waitcnt vmcnt(0)" ::: "memory"); __syncthreads();
    if (threadIdx.x == 0) { __builtin_amdgcn_fence(__ATOMIC_RELEASE, "agent"); asm volatile("s_waitcnt vmcnt(0)" ::: "memory"); __hip_atomic_fetch_add(ctr, 1u, __ATOMIC_RELAXED, __HIP_MEMORY_SCOPE_AGENT); }
}
__device__ __forceinline__ void event_wait(unsigned* ctr, unsigned want) {
    if (threadIdx.x == 0) { unsigned sp = 0;
        while (__hip_atomic_load(ctr, __ATOMIC_RELAXED, __HIP_MEMORY_SCOPE_AGENT) < want) { __builtin_amdgcn_s_sleep(2); if (++sp > (1u << 22)) break; }
        __builtin_amdgcn_fence(__ATOMIC_ACQUIRE, "agent"); asm volatile("s_waitcnt vmcnt(0)" ::: "memory"); }
    __syncthreads();
}

typedef short bf16x8_t __attribute__((ext_vector_type(8)));
typedef short s16x4_t __attribute__((ext_vector_type(4)));
typedef float f32x16 __attribute__((ext_vector_type(16)));
__device__ __forceinline__ int crow(int r, int hi) { return (r & 3) + 8 * (r >> 2) + 4 * hi; }
__device__ __forceinline__ unsigned cvtpk(float lo, float hi) { f32x2 v = {lo, hi}; bf16x2_t b = __builtin_convertvector(v, bf16x2_t); return __builtin_bit_cast(unsigned, b); }
__device__ __forceinline__ s16x4_t vtr(const LAS unsigned char* p) { return __builtin_bit_cast(s16x4_t, __builtin_amdgcn_ds_read_tr16_b64_v4i16((LAS s16x4_t*)p)); }
constexpr int AT_K = 0, AT_V = 16384, AT_WSF = 32768, AT_OST = 34816, AT_RPB = 67584, AT_END = 69632;
template <int KIND>
__device__ __forceinline__ void attn_unit(const Args& a, LAS unsigned char* lds, int l, int u, int tid) {
    asm volatile("" : "+v"(tid));
    const int lane = tid & 63, wid = __builtin_amdgcn_readfirstlane(tid >> 6), r32 = lane & 31, hi = lane >> 5;
    const bf16_t* PX = (const bf16_t*)(a.ws + WS_PX); bf16_t* Y = (bf16_t*)(a.ws + WS_Y);
    int b, qcol, kcol, vcol, ycol, qrow0, nloc = 0, lo = 0; bool sink = false; int hsink = 0;
    int qpos0 = 0, blk = 0, rq = 0, cbase = 0, rq4 = 0;
    if (KIND == 0) { b = u >> 6; const int kvh = (u >> 5) & 1; blk = u & 31; const int h = 2 * kvh + (wid >> 2); qpos0 = blk * 128 + 32 * (wid & 3); qrow0 = b * 4096 + qpos0;
        qcol = 1024 + h * 64; kcol = 1536 + kvh * 64; vcol = 1664 + kvh * 64; ycol = 256 + h * 64; lo = (blk == 0) ? 2 : 0; nloc = ((blk == 31) ? 3 : 5) - lo + 1; sink = true; hsink = h; }
    else if (KIND == 1) { b = u >> 6; const int h = (u >> 4) & 3; rq4 = u & 15; rq = 4 * rq4 + (wid >> 1); cbase = 32 * (wid & 1); qrow0 = b * 4096 + rq * 64 + cbase;
        qcol = 1280 + h * 64; kcol = 1792 + h * 64; vcol = 2048 + h * 64; ycol = 768 + h * 64;
        const int ra = 4 * rq4 - 4, rb = 4 * rq4 + 3 - 4; lo = ra < 0 ? 0 : (ra > 56 ? 56 : ra); const int hi_r = (rb < 0 ? 0 : (rb > 56 ? 56 : rb)) + 7; nloc = hi_r - lo + 1;
        LAS float* rpbL = (LAS float*)(lds + AT_RPB); const float* src = a.in[I_RPB] + (size_t)(l * 4 + h) * 465;
        for (int i = tid; i < 465; i += NTHR) rpbL[i] = src[i] * LOG2E; }
    else { b = u >> 3; const int h = (u >> 1) & 3; qrow0 = TX + b * 256 + 32 * wid;
        if ((u & 1) == 0) { qcol = 1024 + h * 64; kcol = 1536 + (h >> 1) * 64; vcol = 1664 + (h >> 1) * 64; ycol = 256 + h * 64; sink = true; hsink = h; }
        else { qcol = 1280 + h * 64; kcol = 1792 + h * 64; vcol = 2048 + h * 64; ycol = 768 + h * 64; } }
    const int NT = nloc + 4;
    bf16x8_t qr[4];
    { const bf16_t* qp = PX + (size_t)(qrow0 + r32) * INW + qcol + hi * 8;
#pragma unroll
      for (int d0 = 0; d0 < 4; ++d0) qr[d0] = *(const bf16x8_t*)(qp + d0 * 16); }
    const int krow = 8 * wid + (lane & 7), kchunk = lane >> 3; const int vrow = 16 * (wid & 3) + (lane >> 2), vcoff = (wid >> 2) * 32 + (lane & 3) * 8;
    const int kdst = AT_K + kchunk * 1024 + krow * 16, vdst = AT_V + wid * 1024 + lane * 16;
    auto tile_row0 = [&](int t) -> int { if (t < nloc) { if (KIND == 0) return b * 4096 + blk * 128 - 128 + 64 * (lo + t); else return b * 4096 + (lo + t) * 64; } return TX + b * 256 + 64 * (t - nloc); };
    u32x4 gk0, gv0, gk1, gv1;
#define AT_LOAD(GK, GV, t_) do { const int R0_ = tile_row0(t_); GK = *(const u32x4*)(PX + (size_t)(R0_ + krow) * INW + kcol + kchunk * 8); GV = *(const u32x4*)(PX + (size_t)(R0_ + vrow) * INW + vcol + vcoff); } while (0)
    AT_LOAD(gk0, gv0, 0);
    if (NT > 1) AT_LOAD(gk1, gv1, 1); else { gk1 = gk0; gv1 = gv0; }
    *(LAS u32x4*)(lds + kdst) = gk0; *(LAS u32x4*)(lds + vdst) = gv0;
    float mhat = -1e30f, l_reg = 0.f; f32x16 o[2];
#pragma unroll
    for (int r = 0; r < 16; ++r) { o[0][r] = 0.f; o[1][r] = 0.f; }
    LAS float* wsf = (LAS float*)(lds + AT_WSF) + wid * 64;
    const LAS unsigned char* vb0 = lds + AT_V + ((lane >> 4) & 1) * 32 + (lane & 3) * 8 + (4 * hi + ((lane & 15) >> 2)) * 64;
    const LAS unsigned char* kb0 = lds + AT_K + hi * 1024 + r32 * 16;
    __syncthreads();
    auto step = [&](int t, u32x4& gkw, u32x4& gvw, u32x4& gkl, u32x4& gvl) __attribute__((always_inline)) {
        const int bufo = (t & 1) * 8192;
        if (t + 2 < NT) AT_LOAD(gkl, gvl, t + 2);
        bool need = true; bool full = true; int ts = 0, rk = 0;
        if (t < nloc) {
            if (KIND == 0) { ts = blk * 128 - 128 + 64 * (lo + t); need = (ts + 63 >= qpos0 - 128) && (ts <= qpos0 + 31 + 128); full = (qpos0 + 31 - ts <= 128) && (ts + 63 - qpos0 <= 128); }
            if (KIND == 1) { rk = lo + t; const int r0 = (rq - 4) < 0 ? 0 : ((rq - 4) > 56 ? 56 : (rq - 4)); need = (rk >= r0) && (rk <= r0 + 7); full = false; }
        }
        if (need) {
            f32x16 p0, p1;
#pragma unroll
            for (int r = 0; r < 16; ++r) { p0[r] = 0.f; p1[r] = 0.f; }
            const LAS unsigned char* kb = kb0 + bufo;
#pragma unroll
            for (int d0 = 0; d0 < 4; ++d0) { const bf16x8_t k0 = *(const LAS bf16x8_t*)(kb + d0 * 2048), k1 = *(const LAS bf16x8_t*)(kb + d0 * 2048 + 512);
                p0 = __builtin_amdgcn_mfma_f32_32x32x16_bf16(k0, qr[d0], p0, 0, 0, 0); p1 = __builtin_amdgcn_mfma_f32_32x32x16_bf16(k1, qr[d0], p1, 0, 0, 0); }
            constexpr float C2 = 0.125f * LOG2E;
#pragma unroll
            for (int r = 0; r < 16; ++r) { p0[r] *= C2; p1[r] *= C2; }
            if (!full) {
                if (KIND == 0) { const int tq = qpos0 + r32;
#pragma unroll
                    for (int r = 0; r < 16; ++r) { const int k0 = ts + crow(r, hi), d0 = tq - k0, d1 = d0 - 32; if (d0 > 128 || d0 < -128) p0[r] = -1e30f; if (d1 > 128 || d1 < -128) p1[r] = -1e30f; } }
                if (KIND == 1) { const int c = cbase + r32; const int wsc = (c - 8) < 0 ? 0 : ((c - 8) > 48 ? 48 : (c - 8)); const LAS float* rp = (const LAS float*)(lds + AT_RPB) + (rk - rq + 7) * 31 + 15 - c;
#pragma unroll
                    for (int r = 0; r < 16; ++r) { const int c0 = crow(r, hi), c1 = c0 + 32; const bool ok0 = (c0 >= wsc) && (c0 < wsc + 16), ok1 = (c1 >= wsc) && (c1 < wsc + 16);
                        p0[r] = ok0 ? p0[r] + rp[ok0 ? c0 : c] : -1e30f; p1[r] = ok1 ? p1[r] + rp[ok1 ? c1 : c] : -1e30f; } }
            }
            float rm = fmaxf(p0[0], p1[0]);
#pragma unroll
            for (int r = 1; r < 16; ++r) rm = fmaxf(rm, fmaxf(p0[r], p1[r]));
            { auto rr = __builtin_amdgcn_permlane32_swap(__float_as_uint(rm), __float_as_uint(rm), false, false); rm = fmaxf(__uint_as_float(rr[0]), __uint_as_float(rr[1])); }
            const float mnew = fmaxf(mhat, rm); const float f = __builtin_amdgcn_exp2f(mhat - mnew); const bool grew = mnew > mhat; mhat = mnew;
            float sacc = 0.f;
#pragma unroll
            for (int r = 0; r < 16; ++r) { p0[r] = (p0[r] > -1e29f) ? __builtin_amdgcn_exp2f(p0[r] - mnew) : 0.f; p1[r] = (p1[r] > -1e29f) ? __builtin_amdgcn_exp2f(p1[r] - mnew) : 0.f; sacc += p0[r] + p1[r]; }
            l_reg = l_reg * f + sacc;
            if (__any(grew)) { if (hi == 0) wsf[r32] = f; LDS_WAIT();
#pragma unroll
                for (int r = 0; r < 16; ++r) { const float fr_ = wsf[crow(r, hi)]; o[0][r] *= fr_; o[1][r] *= fr_; }
                LDS_WAIT(); }
            u32x4 pw0, pw1, pw2, pw3;
            pw0 = (u32x4){cvtpk(p0[0], p0[1]), cvtpk(p0[2], p0[3]), cvtpk(p0[4], p0[5]), cvtpk(p0[6], p0[7])}; pw1 = (u32x4){cvtpk(p0[8], p0[9]), cvtpk(p0[10], p0[11]), cvtpk(p0[12], p0[13]), cvtpk(p0[14], p0[15])};
            pw2 = (u32x4){cvtpk(p1[0], p1[1]), cvtpk(p1[2], p1[3]), cvtpk(p1[4], p1[5]), cvtpk(p1[6], p1[7])}; pw3 = (u32x4){cvtpk(p1[8], p1[9]), cvtpk(p1[10], p1[11]), cvtpk(p1[12], p1[13]), cvtpk(p1[14], p1[15])};
            const LAS unsigned char* vb = vb0 + bufo;
#pragma unroll
            for (int d0 = 0; d0 < 2; ++d0) {
#pragma unroll
                for (int ks = 0; ks < 4; ++ks) { const s16x4_t vl = vtr(vb + d0 * 4096 + ks * 1024), vh = vtr(vb + d0 * 4096 + ks * 1024 + 512);
                    const bf16x8_t vf = (bf16x8_t){vl[0], vl[1], vl[2], vl[3], vh[0], vh[1], vh[2], vh[3]};
                    const bf16x8_t pa = __builtin_bit_cast(bf16x8_t, ks == 0 ? pw0 : (ks == 1 ? pw1 : (ks == 2 ? pw2 : pw3)));
                    o[d0] = __builtin_amdgcn_mfma_f32_32x32x16_bf16(pa, vf, o[d0], 0, 0, 0); } }
        }
        if (t + 1 < NT) { const int nb = ((t + 1) & 1) * 8192; *(LAS u32x4*)(lds + kdst + nb) = gkw; *(LAS u32x4*)(lds + vdst + nb) = gvw; }
        __syncthreads();
    };
    for (int t = 0; t < NT; t += 2) { step(t, gk1, gv1, gk0, gv0); if (t + 1 < NT) step(t + 1, gk0, gv0, gk1, gv1); }
#undef AT_LOAD
    { auto rr = __builtin_amdgcn_permlane32_swap(__float_as_uint(l_reg), __float_as_uint(l_reg), false, false); l_reg = __uint_as_float(rr[0]) + __uint_as_float(rr[1]); }
    if (sink) l_reg += __builtin_amdgcn_exp2f(a.in[I_SINK][l * 4 + hsink] * LOG2E - mhat);
    if (hi == 0) wsf[32 + r32] = 1.0f / l_reg;
    LDS_WAIT();
    LAS bf16_t* stg = (LAS bf16_t*)(lds + AT_OST) + wid * 2048;
#pragma unroll
    for (int r = 0; r < 16; ++r) { const int orow = crow(r, hi); const float il = wsf[32 + orow];
        stg[orow * 64 + r32] = (bf16_t)f2bf(o[0][r] * il); stg[orow * 64 + 32 + r32] = (bf16_t)f2bf(o[1][r] * il); }
    LDS_WAIT();
#pragma unroll
    for (int i = 0; i < 4; ++i) { const int row = i * 8 + (lane >> 3), ch = lane & 7; const u32x4 v = *(const LAS u32x4*)(stg + row * 64 + ch * 8);
        *(u32x4*)(Y + (size_t)(qrow0 + row) * D + ycol + ch * 8) = v; }
    __syncthreads();
}

__device__ __forceinline__ void phase_mix1(const Args& a, unsigned char* ldsg, int vcu, int G, int l) {
    LAS unsigned char* lds = (LAS unsigned char*)ldsg;
    int tid_ = threadIdx.x; asm volatile("" : "+v"(tid_));
    const int tid = tid_, lane = tid & 63, wave = __builtin_amdgcn_readfirstlane(tid >> 6);
    unsigned char* ws = a.ws; const bf16_t* PX = (const bf16_t*)(ws + WS_PX); bf16_t* Y = (bf16_t*)(ws + WS_Y);
    const bool upd = (l == 0); const int nrows = upd ? TT : TX;
    const int gw = vcu * NWAVES + wave, NGW = G * NWAVES;
    { AMP_BEGIN(31) load_tw(a, lds, tid);
    for (int it = vcu; it < 1024; it += G) hyena_item(a, lds, l, it >> 2, it & 3, tid);
    if (upd) for (int it = vcu; it < 32; it += G) ctx_hyena_item(a, lds, l, it, tid);
    event_arrive((unsigned*)(ws + WS_CTL) + 8192 + 64 * l); AMP_END(31) }
    { AMP_BEGIN(32)
    LAS float* pw = (LAS float*)(lds + 73728); LAS float* dv = (LAS float*)(lds + 139264 + wave * 1024);
    { const float* src = a.in[I_POOLW] + (size_t)l * 4 * 64 * 64; for (int i = tid; i < 4 * 64 * 64; i += NTHR) pw[i] = src[i]; }
    __syncthreads();
    const float* pscale = a.in[I_POOLS] + (size_t)l * 256;
    for (int row = gw; row < nrows; row += NGW) {
        const bool lat = row < TX; const int tpos = lat ? (row & 4095) : ((row - TX) & 255); const int Ls = lat ? 4096 : 256;
        const bf16_t* pr = PX + (size_t)row * INW;
        { const int g = lane >> 4, hw = 1 << g;
          const int c = 768 + 4 * lane; float s0 = 0.f, s1 = 0.f, s2 = 0.f, s3 = 0.f; int cnt = 0;
          u32x2 wv[16];
#pragma unroll
          for (int off = -8; off < 8; ++off) { const int tp = tpos + off; const bool inr = (tp >= 0) && (tp < Ls); wv[off + 8] = *(const u32x2*)(pr + (ptrdiff_t)(inr ? off : 0) * INW + c); }
#pragma unroll
          for (int off = -8; off < 8; ++off) { const int tp = tpos + off; const bool in = (off >= -hw) && (off < hw) && (tp >= 0) && (tp < Ls); const u32x2 v = wv[off + 8];
              s0 += in ? bflo(v.x) : 0.f; s1 += in ? bfhi(v.x) : 0.f; s2 += in ? bflo(v.y) : 0.f; s3 += in ? bfhi(v.y) : 0.f; cnt += in ? 1 : 0; }
          const u32x2 u0 = wv[8]; const float ic = 1.0f / (float)cnt;
          f32x4 dd; dd[0] = s0 * ic - bflo(u0.x); dd[1] = s1 * ic - bfhi(u0.x); dd[2] = s2 * ic - bflo(u0.y); dd[3] = s3 * ic - bfhi(u0.y);
          *(LAS f32x4*)(dv + 4 * lane) = dd;
          LDS_WAIT();
          const int j0 = 4 * (lane & 15); f32x4 acc = {0.f, 0.f, 0.f, 0.f};
          const LAS float* dg = dv + g * 64; const LAS float* wg = pw + g * 4096 + j0;
#pragma unroll 8
          for (int i = 0; i < 64; ++i) { const float di = dg[i]; const f32x4 wv = *(const LAS f32x4*)(wg + i * 64); acc += wv * di; }
          const f32x4 sc = *(const f32x4*)(pscale + g * 64 + j0); acc *= sc;
          u32x2 ov; ov.x = pk2(acc[0], acc[1]); ov.y = pk2(acc[2], acc[3]);
          *(u32x2*)(Y + (size_t)row * D + 512 + g * 64 + j0) = ov;
          LDS_WAIT(); }
    }
    __syncthreads(); AMP_END(32) }
    { AMP_BEGIN(33)
    for (int u = vcu; u < 512; u += G) attn_unit<0>(a, lds, l, u, tid);
    for (int u = vcu; u < 512; u += G) attn_unit<1>(a, lds, l, u, tid);
    if (upd) for (int u = vcu; u < 64; u += G) attn_unit<2>(a, lds, l, u, tid);
    AMP_END(33) }
    { AMP_BEGIN(34) event_wait((unsigned*)(ws + WS_CTL) + 8192 + 64 * l, (unsigned)G);
      for (int it = gw; it < 2048; it += NGW) ytr_item(a, lds + wave * 9216, it, lane); AMP_END(34) }
}

__device__ __forceinline__ void phase_select(const Args& a, unsigned char* ldsg, int vcu, int G, bool with_ctx) {
    LAS unsigned long long* arr = (LAS unsigned long long*)(LAS unsigned char*)ldsg;
    int tid_ = threadIdx.x; asm volatile("" : "+v"(tid_));
    const int tid = tid_; unsigned char* ws = a.ws;
    const float* AFFT = (const float*)(ws + WS_AFFT); int* ROWMAP = (int*)(ws + WS_ROWMAP); float* GATE = (float*)(ws + WS_GATE); int* INV = (int*)(ws + WS_INV);
    const int nitems = 128 + (with_ctx ? 128 : 0);
    for (int item = vcu; item < nitems; item += G) {
        int e, base, Ls, cap, slot0;
        if (item < 128) { const int b = item >> 4; e = item & 15; base = b * 4096; Ls = 4096; cap = CAPX; slot0 = b * CAPX; }
        else { const int it = item - 128; const int b = it >> 4; e = it & 15; base = TX + b * 256; Ls = 256; cap = CAPC; slot0 = NB * CAPX + b * CAPC; }
        for (int i = tid; i < Ls; i += NTHR) arr[i] = ((unsigned long long)__float_as_uint(AFFT[(size_t)e * TT + base + i]) << 32) | (unsigned)(Ls - 1 - i);
        __syncthreads();
        const int npairs = Ls >> 1;
        for (int k = 2; k <= Ls; k <<= 1)
            for (int j = k >> 1; j > 0; j >>= 1) {
                for (int p = tid; p < npairs; p += NTHR) { const int i = ((p & ~(j - 1)) << 1) | (p & (j - 1)), ix = i | j;
                    const unsigned long long x = arr[i], y = arr[ix]; const bool desc = ((i & k) == 0);
                    if (desc ? (x < y) : (x > y)) { arr[i] = y; arr[ix] = x; } }
                __syncthreads(); }
        for (int s = tid; s < cap; s += NTHR) { const unsigned long long v = arr[s]; const int idx = Ls - 1 - (int)(unsigned)(v & 0xffffffffull); const int slot = e * SLOTS + slot0 + s;
            ROWMAP[slot] = base + idx; GATE[slot] = __uint_as_float((unsigned)(v >> 32)); INV[(size_t)(base + idx) * 16 + e] = slot; }
        __syncthreads();
    }
}
__device__ __forceinline__ void phase_gather(const Args& a, int vcu, int G, bool with_ctx) {
    int tid_ = threadIdx.x; asm volatile("" : "+v"(tid_));
    const int tid = tid_, lane = tid & 63, wave = __builtin_amdgcn_readfirstlane(tid >> 6); unsigned char* ws = a.ws;
    const int* ROWMAP = (const int*)(ws + WS_ROWMAP); const bf16_t* HX = (const bf16_t*)(ws + WS_HX); bf16_t* XG = (bf16_t*)(ws + WS_XG);
    const int per = with_ctx ? SLOTS : NB * CAPX; const int gw = vcu * NWAVES + wave, NGW = G * NWAVES;
    for (int it = gw; it < NE * per; it += NGW) { const int e = it / per, s = it % per; const int slot = e * SLOTS + s; const int src = ROWMAP[slot];
        const u32x4* sp = (const u32x4*)(HX + (size_t)src * D) + 2 * lane; u32x4* dp = (u32x4*)(XG + (size_t)slot * D) + 2 * lane;
        const u32x4 v0 = sp[0], v1 = sp[1]; dp[0] = v0; dp[1] = v1; }
}
__device__ __forceinline__ void phase_combine(const Args& a, int vcu, int G, int l, bool with_ctx, bool final_norm, bool next_norm) {
    int tid_ = threadIdx.x; asm volatile("" : "+v"(tid_));
    const int tid = tid_, lane = tid & 63, wave = __builtin_amdgcn_readfirstlane(tid >> 6); unsigned char* ws = a.ws;
    const int* INV = (const int*)(ws + WS_INV); const bf16_t* OB = (const bf16_t*)(ws + WS_XG); const float* MOD = (const float*)(ws + WS_MOD) + (size_t)l * 9 * 6144;
    const float* MODN = (const float*)(ws + WS_MOD) + (size_t)(l + 1) * 9 * 6144; const float* gainn = a.in[I_N1G] + (l + 1) * D; bf16_t* HX = (bf16_t*)(ws + WS_HX);
    bf16_t* XB = (bf16_t*)(ws + WS_XB); const float* fng = a.in[I_FNG];
    const int nrows = with_ctx ? TT : TX; const int gw = vcu * NWAVES + wave, NGW = G * NWAVES;
    const float pz = (final_norm && __hip_atomic_load((unsigned*)(ws + WS_CTL) + 12288, __ATOMIC_RELAXED, __HIP_MEMORY_SCOPE_AGENT) != 0u) ? __builtin_nanf("") : 0.f;
    for (int rowa = gw; rowa < nrows; rowa += 2 * NGW) {
        int myinv[2]; f32x4 xv[2][4]; f32x4 acc[2][4];
#pragma unroll
        for (int u = 0; u < 2; ++u) { const int row = rowa + u * NGW; const bool ok = row < nrows; const int rr = ok ? row : rowa;
            myinv[u] = (lane < 16 && ok) ? INV[(size_t)rr * 16 + lane] : -1;
            const bf16_t* xr = XB + (size_t)rr * D;
#pragma unroll
            for (int j = 0; j < 4; ++j) { const u32x2 w = *(const u32x2*)(xr + 256 * j + 4 * lane); xv[u][j] = (f32x4){bflo(w.x), bfhi(w.x), bflo(w.y), bfhi(w.y)}; acc[u][j] = (f32x4){0.f, 0.f, 0.f, 0.f}; } }
#pragma unroll
        for (int u = 0; u < 2; ++u)
            for (int e = 0; e < 16; ++e) { const int s = __shfl(myinv[u], e);
                if (s >= 0) { const bf16_t* orow = OB + (size_t)s * D;
#pragma unroll
                    for (int j = 0; j < 4; ++j) { const u32x2 v = *(const u32x2*)(orow + 256 * j + 4 * lane); acc[u][j][0] += bflo(v.x); acc[u][j][1] += bfhi(v.x); acc[u][j][2] += bflo(v.y); acc[u][j][3] += bfhi(v.y); } } }
#pragma unroll
        for (int u = 0; u < 2; ++u) { const int row = rowa + u * NGW; if (row < nrows) {
            const bool lat = row < TX; float* xr = a.out + (size_t)row * D; bf16_t* xbr = XB + (size_t)row * D; const int mrow = lat ? (row >> 12) : 8;
            const float* gp = MOD + mrow * 6144 + 5 * 1024; f32x4 v[4]; float ss = 0.f;
#pragma unroll
            for (int j = 0; j < 4; ++j) { const f32x4 g = *(const f32x4*)(gp + 256 * j + 4 * lane); v[j] = xv[u][j] + g * acc[u][j];
                ss += (v[j][0] * v[j][0] + v[j][1] * v[j][1]) + (v[j][2] * v[j][2] + v[j][3] * v[j][3]); }
            if (final_norm) { const float rstd = 1.0f / sqrtf(wave_sum(ss) * (1.0f / D) + 1e-6f);
#pragma unroll
                for (int j = 0; j < 4; ++j) { const f32x4 g = *(const f32x4*)(fng + 256 * j + 4 * lane); *(f32x4*)(xr + 256 * j + 4 * lane) = v[j] * rstd * g + pz; } }
            else {
#pragma unroll
                for (int j = 0; j < 4; ++j) { u32x2 o; o.x = pk2(v[j][0], v[j][1]); o.y = pk2(v[j][2], v[j][3]); *(u32x2*)(xbr + 256 * j + 4 * lane) = o; }
                if (next_norm) { const float rstd = 1.0f / sqrtf(wave_sum(ss) * (1.0f / D) + 1e-6f); const float* shp = MODN + mrow * 6144; const float* scp = shp + 1024;
#pragma unroll
                    for (int j = 0; j < 4; ++j) { const f32x4 gg = *(const f32x4*)(gainn + 256 * j + 4 * lane), sh = *(const f32x4*)(shp + 256 * j + 4 * lane), sc = *(const f32x4*)(scp + 256 * j + 4 * lane);
                        const f32x4 hv = (v[j] * rstd * gg) * (1.0f + sc) + sh; u32x2 o; o.x = pk2(hv[0], hv[1]); o.y = pk2(hv[2], hv[3]); *(u32x2*)(HX + (size_t)row * D + 256 * j + 4 * lane) = o; } } } } }
    }
}

#define XBAR() do { xcd_barrier(bar); if (AMP_PHASE == 99) xcd_barrier(bar); } while (0)

__global__ void __launch_bounds__(NTHR, 2) fwd_kernel(Args a) {
    extern __shared__ __attribute__((aligned(16))) unsigned char lds[];
    cg::grid_group grid = cg::this_grid();
    const int G = gridDim.x, bx = blockIdx.x; const int vcu = (G % 8 == 0) ? (bx % 8) * (G / 8) + bx / 8 : bx;
    unsigned char* ws = a.ws;
    PG8_LAS unsigned char* glds = (PG8_LAS unsigned char*)lds;
    volatile LAS unsigned* bst = (volatile LAS unsigned*)((LAS unsigned char*)lds + LDS_BYTES - 16);
    if (threadIdx.x < 4) bst[threadIdx.x] = 0u;
    __syncthreads();
    XcdBarrier bar = xcd_barrier_post((unsigned*)(ws + WS_CTL), bst);
    { AMP_BEGIN(0) phase_prologue(a, lds, vcu, G); AMP_END(0) }
    grid.sync();
    for (int l = 0; l < 2; ++l) {
        const bool upd = (l == 0);
        const float* srcx = a.in[I_X]; const float* srcc = a.in[I_CTX];
        if (upd) {
            { AMP_BEGIN(1) phase_norm(a, lds, vcu, G, l, srcx, srcc, nullptr, a.in[I_N1G] + l * D, 0, TT, false); AMP_END(1) }
            { AMP_BEGIN(11) load_tw(a, (LAS unsigned char*)lds, threadIdx.x); for (int it = vcu; it < 1024; it += G) spectrum_item(a, (LAS unsigned char*)lds, it, threadIdx.x); AMP_END(11) }
            XBAR();
        }
        { AMP_BEGIN(2) pg8::Gemm g{(const pg8::bf16_t*)(ws + WS_HX), (const pg8::bf16_t*)(ws + WS_WIN_T) + (size_t)l * INW * D, TT, INW, D};
          pg8::GroupOrder S; S.init(1, TT / 256, INW / 256, 0, G, bx);
          { PG8_LAS float* rl = (PG8_LAS float*)(glds + 131072 + 20480); const float* rs = (const float*)(ws + WS_ROPE); int tx = threadIdx.x; asm volatile("" : "+v"(tx)); for (int i = tx; i < 2048; i += NTHR) rl[i] = rs[i]; __syncthreads(); }
          pg8::EpiIn E{(pg8::bf16_t*)(ws + WS_PX), (const PG8_LAS float*)(glds + 131072 + 20480), (pg8::bf16_t*)(ws + WS_UT), glds + 131072};
          pg8::gemm_phase<pg8::EpiIn, pg8::GroupOrder, true, true>(glds, g, S, E); AMP_END(2) }
        XBAR();
        { AMP_BEGIN(3) phase_mix1(a, lds, vcu, G, l); AMP_END(3) }
        XBAR();
        { AMP_BEGIN(4) pg8::Gemm g{(const pg8::bf16_t*)(ws + WS_Y), (const pg8::bf16_t*)(ws + WS_WOUT_T) + (size_t)l * D * D, TT, D, D};
          pg8::GroupOrder S; S.init(1, (upd ? TT : TX) / 256, D / 256, 0, G, bx);
          pg8::EpiOut E{a.in[I_X], a.in[I_CTX], (pg8::bf16_t*)(ws + WS_XB), (const float*)(ws + WS_MOD) + (size_t)l * 9 * 6144, upd ? 1 : 0};
          pg8::gemm_phase<pg8::EpiOut, pg8::GroupOrder, true, true>(glds, g, S, E); AMP_END(4) }
        XBAR();
        { AMP_BEGIN(5) phase_norm(a, lds, vcu, G, l, nullptr, nullptr, (const bf16_t*)(ws + WS_XB), a.in[I_N2G] + l * D, 3, upd ? TT : TX, true); AMP_END(5) }
        XBAR();
        { AMP_BEGIN(6) phase_select(a, lds, vcu, G, upd); AMP_END(6) }
        XBAR();
        { AMP_BEGIN(8) pg8::Gemm g{(const pg8::bf16_t*)(ws + WS_HX), (const pg8::bf16_t*)(ws + WS_WGU_T + (size_t)l * NE * 4096 * D), NE * SLOTS, NE * 4096, D};
          pg8::GroupOrder S; S.init(NE, upd ? 17 : 16, 16, 17, G, bx);
          { PG8_LAS float* sl = (PG8_LAS float*)(glds + 131072 + 17408); const float* ss = (const float*)(ws + WS_WSC) + l * 48; int tx = threadIdx.x; asm volatile("" : "+v"(tx)); if (tx < 32) sl[tx] = ss[tx]; __syncthreads(); }
          pg8::EpiGU E{(unsigned char*)(ws + WS_ACT), (const PG8_LAS float*)(glds + 131072 + 17408)};
          pg8::gemm_phase_gather<pg8::EpiGU, pg8::GroupOrder, true>(glds, g, (const int*)(ws + WS_ROWMAP), (PG8_LAS int*)(glds + 131072), S, E); AMP_END(8) }
        XBAR();
        { AMP_BEGIN(9) pg8::Gemm g{(const pg8::bf16_t*)(ws + WS_ACT), (const pg8::bf16_t*)(ws + WS_WD_T + (size_t)l * NE * D * FF), NE * SLOTS, NE * D, FF};
          pg8::GroupOrder S; S.init(NE, upd ? 17 : 16, 4, 17, G, bx);
          { PG8_LAS float* gl = (PG8_LAS float*)(glds + 131072); const float* gs = (const float*)(ws + WS_GATE); const float* ss = (const float*)(ws + WS_WSC) + l * 48 + 32; pg8::Unit uu; int tx = threadIdx.x; asm volatile("" : "+v"(tx));
            for (int i = 0; S.next(i, uu); ++i) if (tx < 256) gl[i * 256 + tx] = gs[uu.pm * 256 + tx] * ss[uu.pn >> 2];
            __syncthreads(); }
          pg8::EpiDown E{(pg8::bf16_t*)(ws + WS_XG), (const PG8_LAS float*)(glds + 131072)};
          pg8::gemm_phase<pg8::EpiDown, pg8::GroupOrder, true, true, true>(glds, g, S, E); AMP_END(9) }
        XBAR();
        { AMP_BEGIN(10) phase_combine(a, vcu, G, l, upd, !upd, upd); AMP_END(10) }
        if (upd) XBAR();
    }
}

extern "C" void kernel_launch(void* const* d_in, const int* in_sizes, int n_in, void* d_out, int out_size, void* d_ws, size_t ws_size, hipStream_t stream) {
    static int grid = 0;
    if (grid == 0) {
        int dev = 0, cus = 0, per_cu = 0;
        hipGetDevice(&dev); hipDeviceGetAttribute(&cus, hipDeviceAttributeMultiprocessorCount, dev);
        if (hipFuncSetAttribute((const void*)fwd_kernel, hipFuncAttributeMaxDynamicSharedMemorySize, LDS_BYTES) != hipSuccess) { fprintf(stderr, "kernel_launch: hipFuncSetAttribute failed\n"); grid = -1; return; }
        if (hipOccupancyMaxActiveBlocksPerMultiprocessor(&per_cu, (const void*)fwd_kernel, NTHR, LDS_BYTES) != hipSuccess || per_cu < 1) { fprintf(stderr, "kernel_launch: occupancy query failed (%d)\n", per_cu); grid = -1; return; }
        grid = cus * 1;
        if (n_in != N_IN || ws_size < WS_END) { fprintf(stderr, "kernel_launch: unexpected n_in %d / ws %zu\n", n_in, ws_size); grid = -1; return; }
    }
    if (grid < 0) return;
    if (hipMemsetAsync((char*)d_ws + WS_CTL, 0, 65536, stream) != hipSuccess) { fprintf(stderr, "kernel_launch: memset failed\n"); return; }
    Args a{};
    for (int i = 0; i < N_IN; ++i) a.in[i] = (const float*)d_in[i];
    a.out = (float*)d_out; a.ws = (unsigned char*)d_ws;
    void* args[] = {&a};
    hipError_t e = hipLaunchCooperativeKernel((const void*)fwd_kernel, dim3(grid), dim3(NTHR), args, LDS_BYTES, stream);
    if (e != hipSuccess) fprintf(stderr, "cooperative launch failed: %s (grid %d)\n", hipGetErrorString(e), grid);
}
```

```cpp
#define AMP_PHASE -1
#include <hip/hip_runtime.h>
#include <hip/hip_cooperative_groups.h>
#include <cstdio>
#include <cstdint>
namespace cg = cooperative_groups;
namespace pg8 {
#define PG8_LAS __attribute__((address_space(3)))
typedef unsigned short bf16_t;
typedef short bf16x8 __attribute__((ext_vector_type(8)));
typedef float f32x4 __attribute__((ext_vector_type(4)));
typedef unsigned u32x4 __attribute__((ext_vector_type(4)));
typedef int v4i_t __attribute__((ext_vector_type(4)));
typedef int v8i_t __attribute__((ext_vector_type(8)));
constexpr int BM = 256, BK = 64, HALF = 128, HTB = HALF * BK * 2  , STAGE_BYTES = 8 * HTB, NXCD = 8, WGM = 8;

__host__ __device__ __forceinline__ int lds_byte(int r, int c) { const int st = (r >> 4) * 2 + (c >> 5), rr = r & 15, cc = c & 31, ob = rr * 64 + cc * 2; return st * 1024 + (ob ^ (((ob >> 9) & 1) << 5)); }
__host__ __device__ __forceinline__ void stage_rc(int b, int& R, int& C) { const int st = b / 1024, sb = b % 1024, swz = sb ^ (((sb >> 9) & 1) << 5); R = (st >> 1) * 16 + swz / 64; C = (st & 1) * 32 + (swz % 64) / 2; }
__host__ __device__ __forceinline__ int perm32(int rho) { const int n = rho >> 4, i = rho & 15; return 8 * (i >> 2) + 4 * n + (i & 3); }

struct Unit { int pm, pn; };
struct Gemm { const bf16_t* A; const bf16_t* Bt; int M, N, K; };

struct StaticOrder {
    int nM, nN, nwg, G, c;
    __host__ __device__ void init(int M, int N, int G_, int c_) { nM = M / BM; nN = N / BM; nwg = nM * nN; G = G_; c = c_; }
    __host__ __device__ bool next(int i, Unit& u) const {
        const long L = (long)i * G + c; if (L >= nwg) return false;
        int wgid = (int)L; { const int q = nwg / NXCD, r = nwg % NXCD, xcd = wgid % NXCD, off = wgid / NXCD; wgid = (xcd < r ? xcd * (q + 1) : r * (q + 1) + (xcd - r) * q) + off; }
        const int nig = WGM * nN, gid = wgid / nig, fm = gid * WGM, gsz = (nM - fm) < WGM ? (nM - fm) : WGM;
        u.pm = fm + ((wgid % nig) % gsz); u.pn = (wgid % nig) / gsz; return true;
    }
    __device__ __forceinline__ void a_ready(const Unit&) const {}
    __device__ __forceinline__ void done(const Unit&) const {}
};

__device__ __forceinline__ unsigned cvt_pk_bf16(float lo, float hi) { unsigned r; asm volatile("v_cvt_pk_bf16_f32 %0, %1, %2" : "=v"(r) : "v"(lo), "v"(hi)); return r; }
typedef float f32x2 __attribute__((ext_vector_type(2)));
__device__ __forceinline__ f32x2 gelu_pk(f32x2 v) {
    const f32x2 av = __builtin_elementwise_abs(v), d = av * 0.2316418882f + 1.0f;
    f32x2 t; t.x = __builtin_amdgcn_rcpf(d.x); t.y = __builtin_amdgcn_rcpf(d.y);
    f32x2 q = t * 0.5307027145f + (-0.7265760135f); q = q * t + 0.7107068705f; q = q * t + (-0.142248368f); q = q * t + 0.127414796f; q = q * t;
    const f32x2 s = (v * v) * (-0.72134752044f);
    f32x2 e; e.x = __builtin_amdgcn_exp2f(s.x); e.y = __builtin_amdgcn_exp2f(s.y);
    const f32x2 m = v * (q * e), r = v - m;
    f32x2 o; o.x = v.x < 0.f ? m.x : r.x; o.y = v.y < 0.f ? m.y : r.y; return o;
}


struct GroupOrder {
    int nMl, nNl, strideM, nper, nwg, G, c;
    __device__ __forceinline__ void init(int ng, int nMl_, int nNl_, int strideM_, int G_, int c_) { nMl = nMl_; nNl = nNl_; strideM = strideM_; nper = nMl_ * nNl_; nwg = ng * nper; G = G_; c = c_; }
    __device__ __forceinline__ bool next(int i, Unit& u) const {
        const long L = (long)i * G + c; if (L >= nwg) return false;
        int wgid = (int)L; { const int q = nwg / NXCD, r = nwg % NXCD, xcd = wgid % NXCD, off = wgid / NXCD; wgid = (xcd < r ? xcd * (q + 1) : r * (q + 1) + (xcd - r) * q) + off; }
        const int e = wgid / nper, id = wgid % nper;
        const int nig = WGM * nNl, gid = id / nig, fm = gid * WGM, gsz = (nMl - fm) < WGM ? (nMl - fm) : WGM;
        u.pm = e * strideM + fm + ((id % nig) % gsz); u.pn = e * nNl + (id % nig) / gsz; return true;
    }
    __device__ __forceinline__ void a_ready(const Unit&) const {}
    __device__ __forceinline__ void done(const Unit&) const {}
};

constexpr int TXR = 32768;
struct EpiIn {
    static constexpr bool PERM = true, AFTER_DRAIN = false;
    bf16_t* PX; const PG8_LAS float* rope; bf16_t* UT; PG8_LAS unsigned char* stgbase; float wsc;
    __device__ __forceinline__ void operator()(const f32x4 (&acc)[2][2][4][2], const Unit& u, int ui, int wr, int wc, int fr, int fq) const {
        const int row0 = u.pm * BM + wr * 64 + fr; const int col0 = u.pn * BM + wc * 32 + 8 * fq;
        const bool latent = u.pm < (TXR / BM);
        if (latent && u.pn < 3) {
            PG8_LAS unsigned char* stg = stgbase + (wr * 4 + wc) * 2304; const int lane = fq * 16 + fr;
            const int b = u.pm >> 4, trow0 = (u.pm & 15) * BM; const int col = lane >> 1, half = lane & 1;
#pragma unroll
            for (int ai = 0; ai < 2; ++ai)
#pragma unroll
                for (int bj = 0; bj < 2; ++bj)
#pragma unroll
                    for (int mh = 0; mh < 2; ++mh) {
#pragma unroll
                        for (int mm = 0; mm < 2; ++mm)
#pragma unroll
                            for (int n = 0; n < 2; ++n) { const f32x4 v = acc[ai][bj][2 * mh + mm][n] * wsc; const unsigned w0 = cvt_pk_bf16(v[0], v[1]), w1 = cvt_pk_bf16(v[2], v[3]);
                                PG8_LAS unsigned char* p = stg + (8 * fq + 4 * n) * 72 + (16 * mm + fr) * 2;
                                *(PG8_LAS unsigned short*)(p) = (unsigned short)w0; *(PG8_LAS unsigned short*)(p + 72) = (unsigned short)(w0 >> 16);
                                *(PG8_LAS unsigned short*)(p + 144) = (unsigned short)w1; *(PG8_LAS unsigned short*)(p + 216) = (unsigned short)(w1 >> 16); }
                        asm volatile("s_waitcnt lgkmcnt(0)" ::: "memory");
                        typedef unsigned u32x2v __attribute__((ext_vector_type(2)));
                        const PG8_LAS unsigned char* rp = stg + col * 72 + half * 32;
                        const u32x2v a0 = *(const PG8_LAS u32x2v*)(rp), a1 = *(const PG8_LAS u32x2v*)(rp + 8), a2 = *(const PG8_LAS u32x2v*)(rp + 16), a3 = *(const PG8_LAS u32x2v*)(rp + 24);
                        const int ch = u.pn * BM + bj * HALF + wc * 32 + col; const int t0 = trow0 + ai * HALF + wr * 64 + mh * 32 + half * 16;
                        u32x4* gp = (u32x4*)(UT + ((size_t)(b * 768 + ch)) * 4096 + t0);
                        gp[0] = (u32x4){a0.x, a0.y, a1.x, a1.y}; gp[1] = (u32x4){a2.x, a2.y, a3.x, a3.y};
                        asm volatile("s_waitcnt lgkmcnt(0)" ::: "memory"); }
            return;
        }
#pragma unroll
        for (int ai = 0; ai < 2; ++ai)
#pragma unroll
            for (int m = 0; m < 4; ++m) { const int row = row0 + ai * HALF + m * 16; bf16_t* rowp = PX + (size_t)row * 2304 + col0;
#pragma unroll
                for (int bj = 0; bj < 2; ++bj) { f32x4 v0 = acc[ai][bj][m][0] * wsc, v1 = acc[ai][bj][m][1] * wsc;
                    const bool dorope = latent && (u.pn == 4 || (u.pn == 6 && bj == 0));
                    if (dorope) {
                        const int t = row & 4095; const int pos = (wc & 1) ? (t & 63) : (t >> 6);
                        const PG8_LAS f32x4* rp = (const PG8_LAS f32x4*)(rope + (pos * 16 + 8 * (fq & 1)) * 2);
                        const f32x4 r0 = rp[0], r1 = rp[1], r2 = rp[2], r3 = rp[3];
                        f32x4 p0, p1;
#pragma unroll
                        for (int j = 0; j < 4; ++j) { p0[j] = __shfl_xor(v0[j], 32); p1[j] = __shfl_xor(v1[j], 32); }
                        const float c0[4] = {r0[0], r0[2], r1[0], r1[2]}, s0[4] = {r0[1], r0[3], r1[1], r1[3]};
                        const float c1[4] = {r2[0], r2[2], r3[0], r3[2]}, s1[4] = {r2[1], r2[3], r3[1], r3[3]};
                        const bool lo = fq < 2;
#pragma unroll
                        for (int j = 0; j < 4; ++j) {
                            v0[j] = lo ? (v0[j] * c0[j] - p0[j] * s0[j]) : (p0[j] * s0[j] + v0[j] * c0[j]);
                            v1[j] = lo ? (v1[j] * c1[j] - p1[j] * s1[j]) : (p1[j] * s1[j] + v1[j] * c1[j]); }
                    }
                    u32x4 w; w.x = cvt_pk_bf16(v0[0], v0[1]); w.y = cvt_pk_bf16(v0[2], v0[3]); w.z = cvt_pk_bf16(v1[0], v1[1]); w.w = cvt_pk_bf16(v1[2], v1[3]);
                    *(u32x4*)(rowp + bj * HALF) = w; } }
    }
};
struct EpiOut {
    static constexpr bool PERM = true, AFTER_DRAIN = false;
    const float* xf_x; const float* xf_c; bf16_t* XB; const float* mod; int from_f32;
    __device__ __forceinline__ void operator()(const f32x4 (&acc)[2][2][4][2], const Unit& u, int ui, int wr, int wc, int fr, int fq) const {
        const int row0 = u.pm * BM + wr * 64 + fr, col0 = u.pn * BM + wc * 32 + 8 * fq;
        const bool latent = u.pm < (TXR / BM);
#pragma unroll
        for (int ai = 0; ai < 2; ++ai)
#pragma unroll
            for (int m = 0; m < 4; ++m) { const int row = row0 + ai * HALF + m * 16;
                const int mrow = latent ? (row >> 12) : 8; const float* gp = mod + mrow * 6144 + 2 * 1024 + col0;
                bf16_t* xb = XB + (size_t)row * 1024 + col0;
#pragma unroll
                for (int bj = 0; bj < 2; ++bj) { const f32x4 g0 = *(const f32x4*)(gp + bj * HALF), g1 = *(const f32x4*)(gp + bj * HALF + 4); f32x4 x0, x1;
                    if (from_f32) { const float* xo = (latent ? xf_x + (size_t)row * 1024 : xf_c + (size_t)(row - TXR) * 1024) + col0 + bj * HALF; x0 = *(const f32x4*)xo; x1 = *(const f32x4*)(xo + 4); }
                    else { const u32x4 w = *(const u32x4*)(xb + bj * HALF); x0 = (f32x4){__uint_as_float(w.x << 16), __uint_as_float(w.x & 0xffff0000u), __uint_as_float(w.y << 16), __uint_as_float(w.y & 0xffff0000u)};
                        x1 = (f32x4){__uint_as_float(w.z << 16), __uint_as_float(w.z & 0xffff0000u), __uint_as_float(w.w << 16), __uint_as_float(w.w & 0xffff0000u)}; }
                    const f32x4 v0 = x0 + g0 * acc[ai][bj][m][0], v1 = x1 + g1 * acc[ai][bj][m][1];
                    u32x4 o; o.x = cvt_pk_bf16(v0[0], v0[1]); o.y = cvt_pk_bf16(v0[2], v0[3]); o.z = cvt_pk_bf16(v1[0], v1[1]); o.w = cvt_pk_bf16(v1[2], v1[3]);
                    *(u32x4*)(xb + bj * HALF) = o; } }
    }
};
struct EpiGU {
    static constexpr bool PERM = true, AFTER_DRAIN = false;
    unsigned char* ACT; const PG8_LAS float* wsc;
    __device__ __forceinline__ void operator()(const f32x4 (&acc)[2][2][4][2], const Unit& u, int ui, int wr, int wc, int fr, int fq) const {
        const int row0 = u.pm * BM + wr * 64 + fr; const int col0 = (u.pn & 15) * 128 + wc * 32 + 8 * fq; const int e = u.pn >> 4; const float sg = wsc[e], su = wsc[16 + e];
#pragma unroll
        for (int ai = 0; ai < 2; ++ai)
#pragma unroll
            for (int m = 0; m < 4; ++m) { unsigned char* rowp = ACT + (size_t)(row0 + ai * HALF + m * 16) * 2048 + col0;
                float h[8];
#pragma unroll
                for (int n = 0; n < 2; ++n)
#pragma unroll
                    for (int j = 0; j < 4; ++j) { const float g = acc[ai][0][m][n][j] * sg, up = acc[ai][1][m][n][j] * su; const float v = g * __builtin_amdgcn_rcpf(1.0f + __builtin_amdgcn_exp2f(g * -1.4426950408889634f)) * up; h[4 * n + j] = fminf(fmaxf(v, -448.0f), 448.0f); }
                int p0 = 0, p1 = 0;
                p0 = __builtin_amdgcn_cvt_pk_fp8_f32(h[0], h[1], p0, false); p0 = __builtin_amdgcn_cvt_pk_fp8_f32(h[2], h[3], p0, true);
                p1 = __builtin_amdgcn_cvt_pk_fp8_f32(h[4], h[5], p1, false); p1 = __builtin_amdgcn_cvt_pk_fp8_f32(h[6], h[7], p1, true);
                typedef int i32x2v __attribute__((ext_vector_type(2)));
                *(i32x2v*)rowp = (i32x2v){p0, p1}; }
    }
};
struct EpiDown {
    static constexpr bool PERM = true, AFTER_DRAIN = false;
    bf16_t* OB; const PG8_LAS float* gl;
    __device__ __forceinline__ void operator()(const f32x4 (&acc)[2][2][4][2], const Unit& u, int ui, int wr, int wc, int fr, int fq) const {
        const int row0 = u.pm * BM + wr * 64 + fr; const int col0 = (u.pn & 3) * BM + wc * 32 + 8 * fq;
#pragma unroll
        for (int ai = 0; ai < 2; ++ai)
#pragma unroll
            for (int m = 0; m < 4; ++m) { const int row = row0 + ai * HALF + m * 16; const float g = gl[ui * BM + ai * HALF + wr * 64 + m * 16 + fr]; bf16_t* rowp = OB + (size_t)row * 1024 + col0;
#pragma unroll
                for (int bj = 0; bj < 2; ++bj) { const f32x4 v0 = acc[ai][bj][m][0] * g, v1 = acc[ai][bj][m][1] * g;
                    u32x4 w; w.x = cvt_pk_bf16(v0[0], v0[1]); w.y = cvt_pk_bf16(v0[2], v0[3]); w.z = cvt_pk_bf16(v1[0], v1[1]); w.w = cvt_pk_bf16(v1[2], v1[3]);
                    *(u32x4*)(rowp + bj * HALF) = w; } }
    }
};

template <class Epi, class Sched, bool ALIGN_EPI = false, bool SP2 = false, bool FP8 = false>
__device__ __forceinline__ void gemm_phase(PG8_LAS unsigned char* lds, const Gemm g, const Sched& S, const Epi& E) {
    int tid_ = threadIdx.x; asm volatile("" : "+v"(tid_));
    const int tid = tid_, wid = __builtin_amdgcn_readfirstlane(tid >> 6), lane = tid & 63, wr = wid >> 2, wc = wid & 3, fr = lane & 15, fq = lane >> 4;
    const int K = g.K, KB = FP8 ? K : 2 * K  , nt = KB / (BK * 2);
    unsigned voffA[2], voffB[2];
#pragma unroll
    for (int i = 0; i < 2; ++i) { int R, C; stage_rc(tid * 16 + i * 8192, R, C); const int Rb = Epi::PERM ? ((R & ~31) + perm32(R & 31)) : R;
        voffA[i] = (unsigned)(R * KB + C * 2); voffB[i] = (unsigned)(Rb * KB + C * 2); }
    const size_t kstep = (size_t)(BK * 2);
    const size_t hstep = (size_t)HALF * KB;
    const size_t tstep = 2 * hstep;
    const unsigned ldsw = (unsigned)wid * 1024u;
    const int aoff = lds_byte(wr * 64 + fr, fq * 8), boff = lds_byte(wc * 32 + fr, fq * 8);
#define PG8_SA(b, h) (((b) * 2 + (h)) * HTB)
#define PG8_SB(b, h) ((4 + (b) * 2 + (h)) * HTB)
#define PG8_STAGE(bufoff, gbase, voff) do { _Pragma("unroll") for (int _i = 0; _i < 2; ++_i) \
        __builtin_amdgcn_global_load_lds((const unsigned*)((const char*)(gbase) + (voff)[_i]), (PG8_LAS unsigned*)(lds + (bufoff) + ldsw + _i * 8192), 16, 0, 0); } while (0)
#define PG8_LDA(dst, b, h) do { _Pragma("unroll") for (int m = 0; m < 4; ++m) { if constexpr (FP8) { dst##8[m].lo = *(const PG8_LAS v4i_t*)(lds + PG8_SA(b, h) + aoff + m * 2048); dst##8[m].hi = *(const PG8_LAS v4i_t*)(lds + PG8_SA(b, h) + aoff + m * 2048 + 1024); } \
        else { _Pragma("unroll") for (int k = 0; k < 2; ++k) dst[m][k] = *(const PG8_LAS bf16x8*)(lds + PG8_SA(b, h) + aoff + m * 2048 + k * 1024); } } } while (0)
#define PG8_LDB(dst, b, h) do { _Pragma("unroll") for (int n = 0; n < 2; ++n) { if constexpr (FP8) { dst##8[n].lo = *(const PG8_LAS v4i_t*)(lds + PG8_SB(b, h) + boff + n * 2048); dst##8[n].hi = *(const PG8_LAS v4i_t*)(lds + PG8_SB(b, h) + boff + n * 2048 + 1024); } \
        else { _Pragma("unroll") for (int k = 0; k < 2; ++k) dst[n][k] = *(const PG8_LAS bf16x8*)(lds + PG8_SB(b, h) + boff + n * 2048 + k * 1024); } } } while (0)
#define PG8_CAT8(x0, x1) __builtin_shufflevector(__builtin_bit_cast(v4i_t, x0), __builtin_bit_cast(v4i_t, x1), 0, 1, 2, 3, 4, 5, 6, 7)
#define PG8_MMA(ai, bj, At, Bt) do { __builtin_amdgcn_s_setprio(1); if constexpr (FP8) asm volatile("s_nop 1" ::: "memory"); _Pragma("unroll") for (int m = 0; m < 4; ++m) _Pragma("unroll") for (int n = 0; n < 2; ++n) { \
        if constexpr (FP8) asm volatile("v_mfma_scale_f32_16x16x128_f8f6f4 %0, %1, %2, %0, %3, %3 op_sel_hi:[0,0,0]" : "+v"(acc[ai][bj][m][n]) : "v"(Bt##8[n]), "v"(At##8[m]), "v"(one_scale)); \
        else { _Pragma("unroll") for (int k = 0; k < 2; ++k) acc[ai][bj][m][n] = __builtin_amdgcn_mfma_f32_16x16x32_bf16(Bt[n][k], At[m][k], acc[ai][bj][m][n], 0, 0, 0); } } if constexpr (FP8) asm volatile("s_nop 15\n\ts_nop 3" ::: "memory"); __builtin_amdgcn_s_setprio(0); } while (0)
#define PG8_WAIT_V(n) asm volatile("s_waitcnt vmcnt(" #n ")" ::: "memory")
#define PG8_WAIT_L(n) asm volatile("s_waitcnt lgkmcnt(" #n ")" ::: "memory")
#define PG8_BAR __builtin_amdgcn_s_barrier()
#define PG8_SCHED __builtin_amdgcn_sched_barrier(0)
    Unit cur, nxt; int ui = 0;
    if (!S.next(0, cur)) return;
    f32x4 acc[2][2][4][2];
#pragma unroll
    for (int a = 0; a < 2; ++a)
#pragma unroll
        for (int b = 0; b < 2; ++b)
#pragma unroll
            for (int m = 0; m < 4; ++m)
#pragma unroll
                for (int n = 0; n < 2; ++n) acc[a][b][m][n] = (f32x4){0.f, 0.f, 0.f, 0.f};
    bf16x8 At[4][2], B0[2][2], B1[2][2];
    v8i_t At8[4], B08[2], B18[2];
    int one_scale = 0x7f7f7f7f; asm volatile("" : "+v"(one_scale));
    const char* cA = (const char*)g.A + (size_t)cur.pm * tstep; const char* cB = (const char*)g.Bt + (size_t)cur.pn * tstep;
    S.a_ready(cur);
    if constexpr (SP2) {
        PG8_STAGE(PG8_SB(0, 0), cB, voffB); PG8_STAGE(PG8_SB(0, 1), cB + hstep, voffB); PG8_STAGE(PG8_SA(0, 0), cA, voffA); PG8_STAGE(PG8_SA(0, 1), cA + hstep, voffA);
        if (wr == 1) PG8_BAR;
        PG8_WAIT_V(2); PG8_BAR;
        PG8_STAGE(PG8_SB(1, 0), cB + kstep, voffB); PG8_STAGE(PG8_SA(1, 0), cA + kstep, voffA); PG8_STAGE(PG8_SB(1, 1), cB + hstep + kstep, voffB);
        PG8_WAIT_V(6); PG8_BAR;
    } else {
        PG8_STAGE(PG8_SB(0, 0), cB, voffB); PG8_STAGE(PG8_SA(0, 0), cA, voffA); PG8_STAGE(PG8_SB(0, 1), cB + hstep, voffB); PG8_STAGE(PG8_SA(0, 1), cA + hstep, voffA);
        if (wr == 1) PG8_BAR;
        PG8_WAIT_V(4); PG8_BAR;
        PG8_STAGE(PG8_SB(1, 0), cB + kstep, voffB); PG8_STAGE(PG8_SA(1, 0), cA + kstep, voffA); PG8_STAGE(PG8_SB(1, 1), cB + hstep + kstep, voffB);
        PG8_WAIT_V(6); PG8_BAR;
    }
    for (;;) {
        const bool has_next = S.next(ui + 1, nxt);
        const char* nA = has_next ? (const char*)g.A + (size_t)nxt.pm * tstep : cA; const char* nB = has_next ? (const char*)g.Bt + (size_t)nxt.pn * tstep : cB;
#pragma nounroll
        for (int t = 0; t < nt; t += 2) {
            const bool last = (t == nt - 2);
            const char* a1 = cA + (size_t)(t + 1) * kstep;
            const char* a2 = last ? nA : cA + (size_t)(t + 2) * kstep; const char* b2 = last ? nB : cB + (size_t)(t + 2) * kstep;
            const char* a3 = a2 + kstep; const char* b3 = b2 + kstep;
            if (last && has_next) S.a_ready(nxt);
            if constexpr (SP2) {
            PG8_LDB(B0, 0, 0); PG8_LDB(B1, 0, 1); PG8_SCHED; PG8_LDA(At, 0, 0); PG8_STAGE(PG8_SA(1, 1), a1 + hstep, voffA);
            PG8_WAIT_V(8); PG8_WAIT_L(0); PG8_BAR; PG8_MMA(0, 0, At, B0); PG8_MMA(0, 1, At, B1); PG8_BAR; PG8_SCHED;
            PG8_LDA(At, 0, 1); PG8_STAGE(PG8_SB(0, 0), b2, voffB); PG8_STAGE(PG8_SB(0, 1), b2 + hstep, voffB); PG8_STAGE(PG8_SA(0, 0), a2, voffA);
            PG8_WAIT_V(8); PG8_WAIT_L(0); PG8_BAR; PG8_MMA(1, 0, At, B0); PG8_MMA(1, 1, At, B1); PG8_BAR; PG8_SCHED;
            PG8_LDB(B0, 1, 0); PG8_LDB(B1, 1, 1); PG8_SCHED; PG8_LDA(At, 1, 0); PG8_STAGE(PG8_SA(0, 1), a2 + hstep, voffA);
            PG8_WAIT_V(8); PG8_WAIT_L(0); PG8_BAR; PG8_MMA(0, 0, At, B0); PG8_MMA(0, 1, At, B1); PG8_BAR; PG8_SCHED;
            PG8_LDA(At, 1, 1); PG8_STAGE(PG8_SB(1, 0), b3, voffB); PG8_STAGE(PG8_SB(1, 1), b3 + hstep, voffB); PG8_STAGE(PG8_SA(1, 0), a3, voffA);
            PG8_WAIT_V(8); PG8_WAIT_L(0); PG8_BAR; PG8_MMA(1, 0, At, B0); PG8_MMA(1, 1, At, B1); PG8_BAR; PG8_SCHED;
            } else {
            PG8_LDB(B0, 0, 0); PG8_SCHED; PG8_LDA(At, 0, 0); PG8_STAGE(PG8_SA(1, 1), a1 + hstep, voffA);
            PG8_WAIT_L(8); PG8_BAR; PG8_WAIT_L(0); PG8_MMA(0, 0, At, B0); PG8_BAR; PG8_SCHED;
            PG8_LDB(B1, 0, 1); PG8_STAGE(PG8_SB(0, 0), b2, voffB);
            PG8_BAR; PG8_WAIT_L(0); PG8_MMA(0, 1, At, B1); PG8_BAR;
            PG8_LDA(At, 0, 1); PG8_STAGE(PG8_SA(0, 0), a2, voffA);
            PG8_BAR; PG8_WAIT_L(0); PG8_MMA(1, 0, At, B0); PG8_BAR; PG8_SCHED;
            PG8_STAGE(PG8_SB(0, 1), b2 + hstep, voffB);
            PG8_WAIT_V(6); PG8_BAR; PG8_MMA(1, 1, At, B1); PG8_BAR;
            PG8_LDB(B0, 1, 0); PG8_SCHED; PG8_LDA(At, 1, 0); PG8_STAGE(PG8_SA(0, 1), a2 + hstep, voffA);
            PG8_WAIT_L(8); PG8_BAR; PG8_WAIT_L(0); PG8_MMA(0, 0, At, B0); PG8_BAR; PG8_SCHED;
            PG8_LDB(B1, 1, 1); PG8_STAGE(PG8_SB(1, 0), b3, voffB);
            PG8_BAR; PG8_WAIT_L(0); PG8_MMA(0, 1, At, B1); PG8_BAR;
            PG8_LDA(At, 1, 1); PG8_STAGE(PG8_SA(1, 0), a3, voffA);
            PG8_BAR; PG8_WAIT_L(0); PG8_MMA(1, 0, At, B0); PG8_BAR; PG8_SCHED;
            PG8_STAGE(PG8_SB(1, 1), b3 + hstep, voffB);
            PG8_WAIT_V(6); PG8_BAR; PG8_MMA(1, 1, At, B1); PG8_BAR;
            }
        }
        if constexpr (ALIGN_EPI) { if (wr == 0) PG8_BAR; }
        if constexpr (!Epi::AFTER_DRAIN) { E(acc, cur, ui, wr, wc, fr, fq); S.done(cur); }
        if (!has_next) break;
#pragma unroll
        for (int a = 0; a < 2; ++a)
#pragma unroll
            for (int b = 0; b < 2; ++b)
#pragma unroll
                for (int m = 0; m < 4; ++m)
#pragma unroll
                    for (int n = 0; n < 2; ++n) acc[a][b][m][n] = (f32x4){0.f, 0.f, 0.f, 0.f};
        cur = nxt; cA = nA; cB = nB; ++ui;
        if constexpr (ALIGN_EPI) { if (wr == 1) PG8_BAR; }
    }
    PG8_WAIT_V(0);
    if constexpr (!ALIGN_EPI) { if (wr == 0) PG8_BAR; }
    PG8_BAR;
    if constexpr (Epi::AFTER_DRAIN) { E.fused(acc, cur, wr, wc, fr, fq, lds, wid, lane); S.done(cur); }
#undef PG8_SA
#undef PG8_SB
#undef PG8_STAGE
#undef PG8_LDA
#undef PG8_LDB
#undef PG8_MMA
#undef PG8_CAT8
#undef PG8_WAIT_V
#undef PG8_WAIT_L
#undef PG8_BAR
#undef PG8_SCHED
}
template <class Epi, class Sched, bool FP8 = false>
__device__ __forceinline__ void gemm_phase_gather(PG8_LAS unsigned char* lds, const Gemm g, const int* rowmap, PG8_LAS int* idxs, const Sched& S, const Epi& E) {
    constexpr bool ALIGN_EPI = true, SP2 = true;
    int tid_ = threadIdx.x; asm volatile("" : "+v"(tid_));
    const int tid = tid_, wid = __builtin_amdgcn_readfirstlane(tid >> 6), lane = tid & 63, wr = wid >> 2, wc = wid & 3, fr = lane & 15, fq = lane >> 4;
    const int K = g.K, KB = FP8 ? K : 2 * K  , nt = KB / (BK * 2);
    unsigned voffB[2]; int RA[2], CA[2];
#pragma unroll
    for (int i = 0; i < 2; ++i) { int R, C; stage_rc(tid * 16 + i * 8192, R, C); const int Rb = Epi::PERM ? ((R & ~31) + perm32(R & 31)) : R;
        RA[i] = R; CA[i] = C * 2; voffB[i] = (unsigned)(Rb * KB + C * 2); }
    const size_t kstep = (size_t)(BK * 2);
    const size_t hstep = (size_t)HALF * KB;
    const size_t tstep = 2 * hstep;
    const unsigned ldsw = (unsigned)wid * 1024u;
    const int aoff = lds_byte(wr * 64 + fr, fq * 8), boff = lds_byte(wc * 32 + fr, fq * 8);
#define PG8_SA(b, h) (((b) * 2 + (h)) * HTB)
#define PG8_SB(b, h) ((4 + (b) * 2 + (h)) * HTB)
#define PG8_STAGE(bufoff, gbase, voff) do { _Pragma("unroll") for (int _i = 0; _i < 2; ++_i) \
        __builtin_amdgcn_global_load_lds((const unsigned*)((const char*)(gbase) + (voff)[_i]), (PG8_LAS unsigned*)(lds + (bufoff) + ldsw + _i * 8192), 16, 0, 0); } while (0)
#define PG8_STAGE_AG(bufoff, P, h, koff) do { _Pragma("unroll") for (int _i = 0; _i < 2; ++_i) \
        __builtin_amdgcn_global_load_lds((const unsigned*)((const char*)g.A + (size_t)((P)[h][_i] + (unsigned)(koff))), (PG8_LAS unsigned*)(lds + (bufoff) + ldsw + _i * 8192), 16, 0, 0); } while (0)
#define PG8_ROWPTR(P, u) do { _Pragma("unroll") for (int _h = 0; _h < 2; ++_h) _Pragma("unroll") for (int _i = 0; _i < 2; ++_i) \
        (P)[_h][_i] = (unsigned)idxs[(u) * BM + _h * HALF + RA[_i]] * (unsigned)KB + (unsigned)CA[_i]; } while (0)
#define PG8_LDA(dst, b, h) do { _Pragma("unroll") for (int m = 0; m < 4; ++m) { if constexpr (FP8) { dst##8[m].lo = *(const PG8_LAS v4i_t*)(lds + PG8_SA(b, h) + aoff + m * 2048); dst##8[m].hi = *(const PG8_LAS v4i_t*)(lds + PG8_SA(b, h) + aoff + m * 2048 + 1024); } \
        else { _Pragma("unroll") for (int k = 0; k < 2; ++k) dst[m][k] = *(const PG8_LAS bf16x8*)(lds + PG8_SA(b, h) + aoff + m * 2048 + k * 1024); } } } while (0)
#define PG8_LDB(dst, b, h) do { _Pragma("unroll") for (int n = 0; n < 2; ++n) { if constexpr (FP8) { dst##8[n].lo = *(const PG8_LAS v4i_t*)(lds + PG8_SB(b, h) + boff + n * 2048); dst##8[n].hi = *(const PG8_LAS v4i_t*)(lds + PG8_SB(b, h) + boff + n * 2048 + 1024); } \
        else { _Pragma("unroll") for (int k = 0; k < 2; ++k) dst[n][k] = *(const PG8_LAS bf16x8*)(lds + PG8_SB(b, h) + boff + n * 2048 + k * 1024); } } } while (0)
#define PG8_CAT8(x0, x1) __builtin_shufflevector(__builtin_bit_cast(v4i_t, x0), __builtin_bit_cast(v4i_t, x1), 0, 1, 2, 3, 4, 5, 6, 7)
#define PG8_MMA(ai, bj, At, Bt) do { __builtin_amdgcn_s_setprio(1); if constexpr (FP8) asm volatile("s_nop 1" ::: "memory"); _Pragma("unroll") for (int m = 0; m < 4; ++m) _Pragma("unroll") for (int n = 0; n < 2; ++n) { \
        if constexpr (FP8) asm volatile("v_mfma_scale_f32_16x16x128_f8f6f4 %0, %1, %2, %0, %3, %3 op_sel_hi:[0,0,0]" : "+v"(acc[ai][bj][m][n]) : "v"(Bt##8[n]), "v"(At##8[m]), "v"(one_scale)); \
        else { _Pragma("unroll") for (int k = 0; k < 2; ++k) acc[ai][bj][m][n] = __builtin_amdgcn_mfma_f32_16x16x32_bf16(Bt[n][k], At[m][k], acc[ai][bj][m][n], 0, 0, 0); } } if constexpr (FP8) asm volatile("s_nop 15\n\ts_nop 3" ::: "memory"); __builtin_amdgcn_s_setprio(0); } while (0)
#define PG8_WAIT_V(n) asm volatile("s_waitcnt vmcnt(" #n ")" ::: "memory")
#define PG8_WAIT_L(n) asm volatile("s_waitcnt lgkmcnt(" #n ")" ::: "memory")
#define PG8_BAR __builtin_amdgcn_s_barrier()
#define PG8_SCHED __builtin_amdgcn_sched_barrier(0)
    Unit cur, nxt; int ui = 0;
    if (!S.next(0, cur)) return;
    f32x4 acc[2][2][4][2];
#pragma unroll
    for (int a = 0; a < 2; ++a)
#pragma unroll
        for (int b = 0; b < 2; ++b)
#pragma unroll
            for (int m = 0; m < 4; ++m)
#pragma unroll
                for (int n = 0; n < 2; ++n) acc[a][b][m][n] = (f32x4){0.f, 0.f, 0.f, 0.f};
    bf16x8 At[4][2], B0[2][2], B1[2][2];
    v8i_t At8[4], B08[2], B18[2];
    int one_scale = 0x7f7f7f7f; asm volatile("" : "+v"(one_scale));
    const char* cB = (const char*)g.Bt + (size_t)cur.pn * tstep;
    unsigned cP[2][2], nP[2][2];
    { Unit uu; for (int i = 0; S.next(i, uu); ++i) if (tid < BM) idxs[i * BM + tid] = rowmap[uu.pm * BM + tid]; }
    asm volatile("s_waitcnt vmcnt(0) lgkmcnt(0)" ::: "memory"); __builtin_amdgcn_s_barrier(); asm volatile("" ::: "memory");
    PG8_ROWPTR(cP, 0);
    S.a_ready(cur);
    if constexpr (SP2) {
        PG8_STAGE(PG8_SB(0, 0), cB, voffB); PG8_STAGE(PG8_SB(0, 1), cB + hstep, voffB); PG8_STAGE_AG(PG8_SA(0, 0), cP, 0, 0); PG8_STAGE_AG(PG8_SA(0, 1), cP, 1, 0);
        if (wr == 1) PG8_BAR;
        PG8_WAIT_V(2); PG8_BAR;
        PG8_STAGE(PG8_SB(1, 0), cB + kstep, voffB); PG8_STAGE_AG(PG8_SA(1, 0), cP, 0, kstep); PG8_STAGE(PG8_SB(1, 1), cB + hstep + kstep, voffB);
        PG8_WAIT_V(6); PG8_BAR;
    }
    for (;;) {
        const bool has_next = S.next(ui + 1, nxt);
        const char* nB = has_next ? (const char*)g.Bt + (size_t)nxt.pn * tstep : cB;
        if (has_next) { PG8_ROWPTR(nP, ui + 1); } else { _Pragma("unroll") for (int _h = 0; _h < 2; ++_h) _Pragma("unroll") for (int _i = 0; _i < 2; ++_i) nP[_h][_i] = cP[_h][_i]; }
#pragma nounroll
        for (int t = 0; t < nt; t += 2) {
            const bool last = (t == nt - 2);
            const size_t k1 = (size_t)(t + 1) * kstep, k2 = last ? 0 : (size_t)(t + 2) * kstep, k3 = k2 + kstep;
            unsigned sP[2][2];
            _Pragma("unroll") for (int _h = 0; _h < 2; ++_h) _Pragma("unroll") for (int _i = 0; _i < 2; ++_i) sP[_h][_i] = last ? nP[_h][_i] : cP[_h][_i];
            const char* b2 = last ? nB : cB + (size_t)(t + 2) * kstep; const char* b3 = b2 + kstep;
            if (last && has_next) S.a_ready(nxt);
            if constexpr (SP2) {
            PG8_LDB(B0, 0, 0); PG8_LDB(B1, 0, 1); PG8_SCHED; PG8_LDA(At, 0, 0); PG8_STAGE_AG(PG8_SA(1, 1), cP, 1, k1);
            PG8_WAIT_V(8); PG8_WAIT_L(0); PG8_BAR; PG8_MMA(0, 0, At, B0); PG8_MMA(0, 1, At, B1); PG8_BAR; PG8_SCHED;
            PG8_LDA(At, 0, 1); PG8_STAGE(PG8_SB(0, 0), b2, voffB); PG8_STAGE(PG8_SB(0, 1), b2 + hstep, voffB); PG8_STAGE_AG(PG8_SA(0, 0), sP, 0, k2);
            PG8_WAIT_V(8); PG8_WAIT_L(0); PG8_BAR; PG8_MMA(1, 0, At, B0); PG8_MMA(1, 1, At, B1); PG8_BAR; PG8_SCHED;
            PG8_LDB(B0, 1, 0); PG8_LDB(B1, 1, 1); PG8_SCHED; PG8_LDA(At, 1, 0); PG8_STAGE_AG(PG8_SA(0, 1), sP, 1, k2);
            PG8_WAIT_V(8); PG8_WAIT_L(0); PG8_BAR; PG8_MMA(0, 0, At, B0); PG8_MMA(0, 1, At, B1); PG8_BAR; PG8_SCHED;
            PG8_LDA(At, 1, 1); PG8_STAGE(PG8_SB(1, 0), b3, voffB); PG8_STAGE(PG8_SB(1, 1), b3 + hstep, voffB); PG8_STAGE_AG(PG8_SA(1, 0), sP, 0, k3);
            PG8_WAIT_V(8); PG8_WAIT_L(0); PG8_BAR; PG8_MMA(1, 0, At, B0); PG8_MMA(1, 1, At, B1); PG8_BAR; PG8_SCHED;
            }
        }
        if constexpr (ALIGN_EPI) { if (wr == 0) PG8_BAR; }
        if constexpr (!Epi::AFTER_DRAIN) { E(acc, cur, ui, wr, wc, fr, fq); S.done(cur); }
        if (!has_next) break;
#pragma unroll
        for (int a = 0; a < 2; ++a)
#pragma unroll
            for (int b = 0; b < 2; ++b)
#pragma unroll
                for (int m = 0; m < 4; ++m)
#pragma unroll
                    for (int n = 0; n < 2; ++n) acc[a][b][m][n] = (f32x4){0.f, 0.f, 0.f, 0.f};
        cur = nxt; cB = nB; ++ui;
        _Pragma("unroll") for (int _h = 0; _h < 2; ++_h) _Pragma("unroll") for (int _i = 0; _i < 2; ++_i) cP[_h][_i] = nP[_h][_i];
        if constexpr (ALIGN_EPI) { if (wr == 1) PG8_BAR; }
    }
    PG8_WAIT_V(0);
    if constexpr (!ALIGN_EPI) { if (wr == 0) PG8_BAR; }
    PG8_BAR;
    if constexpr (Epi::AFTER_DRAIN) { E.fused(acc, cur, wr, wc, fr, fq, lds, wid, lane); S.done(cur); }
#undef PG8_SA
#undef PG8_SB
#undef PG8_STAGE
#undef PG8_STAGE_AG
#undef PG8_ROWPTR
#undef PG8_LDA
#undef PG8_LDB
#undef PG8_MMA
#undef PG8_CAT8
#undef PG8_WAIT_V
#undef PG8_WAIT_L
#undef PG8_BAR
#undef PG8_SCHED
}

}

#define LAS __attribute__((address_space(3)))
typedef unsigned short bf16_t;
typedef float f32x4 __attribute__((ext_vector_type(4)));
typedef unsigned u32x4 __attribute__((ext_vector_type(4)));
typedef unsigned u32x2 __attribute__((ext_vector_type(2)));
typedef __bf16 bf16x2_t __attribute__((ext_vector_type(2)));
constexpr int NWAVES = 8, NTHR = 512;
constexpr int D = 1024, NB = 8, SEQ = 4096, LCTX = 256, TX = NB * SEQ, TC = NB * LCTX, TT = TX + TC, INW = 2304, NE = 16, FF = 2048;
constexpr int CAPX = 512, CAPC = 32, SLOTS = NB * CAPX + NB * CAPC;
constexpr float LOG2E = 1.4426950408889634f;
constexpr int LDS_BYTES = 163840;
enum { I_X = 0, I_C, I_CTX, I_CCTX, I_ADAW, I_ADAB, I_N1G, I_N2G, I_WIN, I_HCW, I_HCB, I_HW1, I_HB1, I_HW2, I_HB2, I_HW3, I_HFREQ, I_HSKIP, I_SINK, I_POOLW, I_POOLS, I_RPB, I_WOUT, I_ROUTER, I_WG, I_WU, I_WD, I_FNG, N_IN };
constexpr size_t MiB = 1u << 20;
constexpr size_t WS_CTL = 0;
constexpr size_t WS_MOD = 1 * MiB;
constexpr size_t WS_WSC = 1 * MiB + 512 * 1024;
constexpr size_t WS_ROPE = 2 * MiB;
constexpr size_t WS_TW8 = 2 * MiB + 65536;
constexpr size_t WS_WIN_T = 3 * MiB;
constexpr size_t WS_WOUT_T = 13 * MiB;
constexpr size_t WS_HC = 17 * MiB;
constexpr size_t WS_HCC = 51 * MiB;
constexpr size_t WS_AFFT = 53 * MiB;
constexpr size_t WS_ROWMAP = 56 * MiB;
constexpr size_t WS_GATE = 57 * MiB;
constexpr size_t WS_INV = 58 * MiB;
constexpr size_t WS_CRES = 61 * MiB;
constexpr size_t WS_HX = 69 * MiB;
constexpr size_t WS_WGU_T = 137 * MiB;
constexpr size_t WS_XB = 265 * MiB;
constexpr size_t WS_WD_T = 393 * MiB;
constexpr size_t WS_R = 521 * MiB;
constexpr size_t WS_ACT = WS_R;
constexpr size_t WS_XG = WS_R + 272 * MiB;
constexpr size_t WS_PX = WS_R;
constexpr size_t WS_Y = WS_R + 153 * MiB;
constexpr size_t WS_YT = WS_XG + 48 * MiB;
constexpr size_t WS_UT = WS_XG;
constexpr size_t WS_HS = WS_R + 408 * MiB;
constexpr size_t WS_END = WS_HS + 64 * MiB;
static_assert(WS_END <= 1024 * MiB, "workspace map");

struct Args { const float* in[N_IN]; float* out; unsigned char* ws; };

__device__ __forceinline__ float bf2f(unsigned short v) { return __uint_as_float(((unsigned)v) << 16); }
__device__ __forceinline__ unsigned f2bf(float f) { unsigned u = __float_as_uint(f); return (u + 0x7fffu + ((u >> 16) & 1u)) >> 16; }
__device__ __forceinline__ unsigned pk2(float lo, float hi) { return f2bf(lo) | (f2bf(hi) << 16); }
__device__ __forceinline__ float bflo(unsigned w) { return __uint_as_float(w << 16); }
__device__ __forceinline__ float bfhi(unsigned w) { return __uint_as_float(w & 0xffff0000u); }
__device__ __forceinline__ float dot2bf(unsigned a, unsigned b, float acc) { return __builtin_amdgcn_fdot2_f32_bf16(__builtin_bit_cast(bf16x2_t, a), __builtin_bit_cast(bf16x2_t, b), acc, false); }
__device__ __forceinline__ float wave_sum(float v) {
#pragma unroll
    for (int o = 1; o < 64; o <<= 1) v += __shfl_xor(v, o);
    return v;
}
#define LDS_WAIT() asm volatile("s_waitcnt lgkmcnt(0)" ::: "memory")

#ifndef AMP_PHASE
#define AMP_PHASE -1
#endif
__device__ __forceinline__ unsigned long long amp_now() { asm volatile("s_waitcnt vmcnt(0) lgkmcnt(0)" ::: "memory"); __builtin_amdgcn_sched_barrier(0); const unsigned long long t = __builtin_amdgcn_s_memrealtime(); asm volatile("s_waitcnt lgkmcnt(0)" ::: "memory"); __builtin_amdgcn_sched_barrier(0); return t; }
#define AMP_BEGIN(id) unsigned long long amp_t0_ = 0; if ((id) == AMP_PHASE) { __syncthreads(); amp_t0_ = amp_now(); }
#define AMP_END(id) if ((id) == AMP_PHASE) { __syncthreads(); const unsigned long long t1_ = amp_now(); const unsigned long long d_ = t1_ - amp_t0_; while (amp_now() - t1_ < d_) __builtin_amdgcn_s_sleep(8); __syncthreads(); }
__device__ __forceinline__ void tr_item(const float* W, int K, int N, bf16_t* WT, int Kt, int item, int mode, LAS float* scr, int lane) {
    const int nblk = N / 32, kb = item / nblk, nb = item % nblk, k0 = 64 * kb, n0 = 32 * nb;
    const int r8 = lane >> 3, c4 = lane & 7; f32x4 v[8];
    const float* wp = W + (size_t)(k0 + r8) * N + n0 + 4 * c4;
#pragma unroll
    for (int i = 0; i < 8; ++i) v[i] = *(const f32x4*)(wp + (size_t)(8 * i) * N);
#pragma unroll
    for (int i = 0; i < 8; ++i) { LAS float* d = scr + (r8 + 8 * i) * 33 + 4 * c4; d[0] = v[i][0]; d[1] = v[i][1]; d[2] = v[i][2]; d[3] = v[i][3]; }
    LDS_WAIT();
    const int c = lane & 7;
    const int drow0 = (mode == 0) ? n0 : ((n0 >> 7) * 256 + (n0 & 127) + (mode == 2 ? 128 : 0));
#pragma unroll
    for (int j = 0; j < 4; ++j) { const int n = (lane >> 3) + 8 * j; const LAS float* sp = scr + (8 * c) * 33 + n;
        u32x4 o; o.x = pk2(sp[0 * 33], sp[1 * 33]); o.y = pk2(sp[2 * 33], sp[3 * 33]); o.z = pk2(sp[4 * 33], sp[5 * 33]); o.w = pk2(sp[6 * 33], sp[7 * 33]);
        *(u32x4*)(WT + (size_t)(drow0 + n) * Kt + k0 + 8 * c) = o; }
    LDS_WAIT();
}

__device__ __forceinline__ void tr_item_fp8(const float* W, int K, int N, unsigned char* WT, int Kt, int item, int mode, LAS float* scr, int lane, float* wsc_out) {
    const int nblk = N / 32, kb = item / nblk, nb = item % nblk, k0 = 64 * kb, n0 = 32 * nb;
    const int r8 = lane >> 3, c4 = lane & 7; f32x4 v[8];
    const f32x4 sv = *(const f32x4*)(W + 4 * lane);
    const float* wp = W + (size_t)(k0 + r8) * N + n0 + 4 * c4;
#pragma unroll
    for (int i = 0; i < 8; ++i) v[i] = *(const f32x4*)(wp + (size_t)(8 * i) * N);
    float sm = fmaxf(fmaxf(fabsf(sv[0]), fabsf(sv[1])), fmaxf(fabsf(sv[2]), fabsf(sv[3])));
#pragma unroll
    for (int o = 1; o < 64; o <<= 1) sm = fmaxf(sm, __shfl_xor(sm, o));
    int E = 0; (void)frexpf(fmaxf(sm, 1e-30f), &E); const float mul = ldexpf(1.0f, 5 - E);
    if (item == 0 && lane == 0) *wsc_out = ldexpf(1.0f, E - 5);
#pragma unroll
    for (int i = 0; i < 8; ++i) { LAS float* d = scr + (r8 + 8 * i) * 33 + 4 * c4; d[0] = v[i][0] * mul; d[1] = v[i][1] * mul; d[2] = v[i][2] * mul; d[3] = v[i][3] * mul; }
    LDS_WAIT();
    const int c = lane & 7;
    const int drow0 = (mode == 0) ? n0 : ((n0 >> 7) * 256 + (n0 & 127) + (mode == 2 ? 128 : 0));
#pragma unroll
    for (int j = 0; j < 4; ++j) { const int n = (lane >> 3) + 8 * j; const LAS float* sp = scr + (8 * c) * 33 + n;
        int p0 = 0, p1 = 0;
        p0 = __builtin_amdgcn_cvt_pk_fp8_f32(sp[0 * 33], sp[1 * 33], p0, false); p0 = __builtin_amdgcn_cvt_pk_fp8_f32(sp[2 * 33], sp[3 * 33], p0, true);
        p1 = __builtin_amdgcn_cvt_pk_fp8_f32(sp[4 * 33], sp[5 * 33], p1, false); p1 = __builtin_amdgcn_cvt_pk_fp8_f32(sp[6 * 33], sp[7 * 33], p1, true);
        typedef int i32x2v __attribute__((ext_vector_type(2)));
        *(i32x2v*)(WT + (size_t)(drow0 + n) * Kt + k0 + 8 * c) = (i32x2v){p0, p1}; }
    LDS_WAIT();
}

__device__ __forceinline__ void filter_item(const Args& a, LAS unsigned char* lds, int item, int tid) {
    asm volatile("" : "+v"(tid));
    const int lane = tid & 63, wave = tid >> 6;
    int l, L, p0; float* HCdst;
    if (item < 128) { l = 0; L = 4096; p0 = item * 32; HCdst = (float*)(a.ws + WS_HC); }
    else if (item < 256) { l = 1; L = 4096; p0 = (item - 128) * 32; HCdst = (float*)(a.ws + WS_HC) + (size_t)2 * 8191 * 256; }
    else { l = 0; L = 256; p0 = (item - 256) * 32; HCdst = (float*)(a.ws + WS_HCC) + 256; }
    LAS float* w1s = (LAS float*)lds; LAS float* w2s = w1s + 33 * 64; LAS float* b1s = w2s + 64 * 64; LAS float* b2s = b1s + 64; LAS float* frs = b2s + 64; LAS float* h2s = frs + 64; LAS float* ex = h2s + 32 * 64;
    { const float* w1 = a.in[I_HW1] + l * 33 * 64; const float* w2 = a.in[I_HW2] + l * 64 * 64;
      for (int i = tid; i < 33 * 64; i += NTHR) w1s[i] = w1[i];
      for (int i = tid; i < 64 * 64; i += NTHR) w2s[i] = w2[i];
      if (tid < 64) { b1s[tid] = a.in[I_HB1][l * 64 + tid]; b2s[tid] = a.in[I_HB2][l * 64 + tid]; frs[tid] = a.in[I_HFREQ][l * 64 + tid]; } }
    __syncthreads();
    const float frq = frs[lane];
#pragma unroll 1
    for (int q = 0; q < 4; ++q) { const int pp = wave * 4 + q, p = p0 + pp; const float tn = (float)p / (float)(L - 1);
        float fv = 0.f;
        if (lane == 0) fv = tn;
        else if (lane <= 32) { const int bi = (lane - 1) & 15; const float band = 1e-4f + (float)bi * ((15.0f - 1e-4f) / 15.0f);
            const float ang = ((float)(6.283185307179586 / (double)L) * (float)p) * band; fv = (lane <= 16) ? cosf(ang) : -sinf(ang); }
        float a1 = b1s[lane];
#pragma unroll
        for (int i = 0; i < 33; ++i) a1 += __shfl(fv, i) * w1s[i * 64 + lane];
        const float h1 = sinf(frq * a1);
        float a2 = b2s[lane];
#pragma unroll 16
        for (int i = 0; i < 64; ++i) a2 += __shfl(h1, i) * w2s[i * 64 + lane];
        h2s[pp * 64 + lane] = sinf(frq * a2); }
    __syncthreads();
    const float* w3 = a.in[I_HW3] + (size_t)l * 64 * 1024 + tid;
    float acc0[32], acc1[32];
#pragma unroll
    for (int pp = 0; pp < 32; ++pp) { acc0[pp] = 0.f; acc1[pp] = 0.f; }
#pragma unroll 4
    for (int i = 0; i < 64; ++i) { const float wa = w3[i * 1024], wb = w3[i * 1024 + 512];
#pragma unroll
        for (int pp = 0; pp < 32; ++pp) { const float h = h2s[pp * 64 + i]; acc0[pp] += h * wa; acc1[pp] += h * wb; } }
    const int c = tid & 255, dir = tid >> 8; const float dmin = 3.0701134573253945f, dmax = 15.350567286626972f; const float delta = dmin + (float)c * ((dmax - dmin) / 255.0f);
    float* base0 = HCdst; float* base1 = HCdst + (size_t)(2 * L - 1) * 256;
#pragma unroll
    for (int pp = 0; pp < 32; ++pp) { const int p = p0 + pp; const float tn = (float)p / (float)(L - 1); const float win = expf(-tn * delta); const float v0 = acc0[pp] * win, v1 = acc1[pp] * win;
        if (p == 0) { ex[tid] = v0; ex[512 + tid] = v1; }
        else { const size_t idx = (size_t)(dir == 0 ? (L - 1 + p) : (L - 1 - p)) * 256 + c; base0[idx] = v0; base1[idx] = v1; } }
    __syncthreads();
    if (p0 == 0 && tid < 256) { const size_t idx = (size_t)(L - 1) * 256 + tid; base0[idx] = ex[tid] + ex[tid + 256]; base1[idx] = ex[512 + tid] + ex[512 + tid + 256]; }
    __syncthreads();
}


typedef int v8i_t __attribute__((ext_vector_type(8)));
__device__ __forceinline__ float st_A(int i, int k) { return (float)(((i * 7 + k * 3) % 5) - 2); }
__device__ __forceinline__ float st_B(int k, int j) { return (float)(((k * 5 + j * 11 + (k >> 4)) % 5) - 2); }
__device__ __forceinline__ void fp8_selftest(unsigned* poison, int lane) {
    const int fr = lane & 15, fq = lane >> 4; v8i_t av, bv;
#pragma unroll
    for (int w = 0; w < 8; ++w) { int pa = 0, pb = 0;
#pragma unroll
        for (int q = 0; q < 4; ++q) { }
        const int kb = (w < 4) ? (16 * fq + 4 * w) : (64 + 16 * fq + 4 * (w - 4));
        pa = __builtin_amdgcn_cvt_pk_fp8_f32(st_A(fr, kb), st_A(fr, kb + 1), pa, false); pa = __builtin_amdgcn_cvt_pk_fp8_f32(st_A(fr, kb + 2), st_A(fr, kb + 3), pa, true);
        pb = __builtin_amdgcn_cvt_pk_fp8_f32(st_B(kb, fr), st_B(kb + 1, fr), pb, false); pb = __builtin_amdgcn_cvt_pk_fp8_f32(st_B(kb + 2, fr), st_B(kb + 3, fr), pb, true);
        av[w] = pa; bv[w] = pb; }
    f32x4 acc = {0.f, 0.f, 0.f, 0.f};
    acc = __builtin_amdgcn_mfma_scale_f32_16x16x128_f8f6f4(av, bv, acc, 0, 0, 0, 0x7f7f7f7f, 0, 0x7f7f7f7f);
    bool bad = false;
#pragma unroll
    for (int r = 0; r < 4; ++r) { float ref = 0.f; for (int k = 0; k < 128; ++k) ref += st_A(4 * fq + r, k) * st_B(k, fr); bad |= (acc[r] != ref); }
    if (__any(bad) && lane == 0) __hip_atomic_store(poison, 1u, __ATOMIC_RELAXED, __HIP_MEMORY_SCOPE_AGENT);
}

__device__ __forceinline__ void phase_prologue(const Args& a, unsigned char* ldsg, int vcu, int G) {
    LAS unsigned char* lds = (LAS unsigned char*)ldsg;
    int tid_ = threadIdx.x; asm volatile("" : "+v"(tid_));
    const int tid = tid_, lane = tid & 63, wave = __builtin_amdgcn_readfirstlane(tid >> 6);
    unsigned char* ws = a.ws; asm volatile("" : "+s"(ws));
    if (vcu == 2 % G && wave == 0) fp8_selftest((unsigned*)(ws + WS_CTL) + 12288, lane);
    LAS float* sc = (LAS float*)lds; LAS float* red = (LAS float*)(lds + 36864);
    for (int i = tid; i < 9 * 1024; i += NTHR) { const float v = (i < 8192) ? a.in[I_C][i] : a.in[I_CCTX][i - 8192]; sc[i] = v / (1.0f + expf(-v)); }
    __syncthreads();
    { AMP_BEGIN(41)
    float* MOD = (float*)(ws + WS_MOD);
    for (int item = vcu; item < 2 * 96; item += G) {
        const int l = item / 96, n0 = (item % 96) * 64, col = tid & 63, kg = tid >> 6;
        float acc[9];
#pragma unroll
        for (int r = 0; r < 9; ++r) acc[r] = 0.f;
        const float* w = a.in[I_ADAW] + (size_t)l * 1024 * 6144 + n0 + col;
#pragma unroll 4
        for (int k = kg * 128; k < kg * 128 + 128; ++k) { const float wv = w[(size_t)k * 6144];
#pragma unroll
            for (int r = 0; r < 9; ++r) acc[r] += sc[r * 1024 + k] * wv; }
#pragma unroll
        for (int r = 0; r < 9; ++r) red[(kg * 9 + r) * 64 + col] = acc[r];
        __syncthreads();
        for (int o = tid; o < 9 * 64; o += NTHR) { const int r = o >> 6, cc = o & 63; float s = 0.f;
#pragma unroll
            for (int g2 = 0; g2 < 8; ++g2) s += red[(g2 * 9 + r) * 64 + cc];
            MOD[(size_t)(l * 9 + r) * 6144 + n0 + cc] = s + a.in[I_ADAB][l * 6144 + n0 + cc]; }
        __syncthreads();
    }
    AMP_END(41) }
    if (vcu == 0) { float* ROPE = (float*)(ws + WS_ROPE);
        for (int i = tid; i < 1024; i += NTHR) { const int pos = i >> 4, fi = i & 15; const float inv = powf(10000.0f, -(float)fi / 16.0f); const float ang = (float)pos * inv;
            ROPE[2 * i] = cosf(ang); ROPE[2 * i + 1] = sinf(ang); } }
    if (vcu == 1 % G) { float* TW8 = (float*)(ws + WS_TW8);
        for (int i = tid; i < 8192; i += NTHR) { float sn, cs; sincospif(-(float)i * (1.0f / 4096.0f), &sn, &cs); TW8[2 * i] = cs; TW8[2 * i + 1] = sn; } }
    const int gw = vcu * NWAVES + wave, NGW = G * NWAVES;
    { AMP_BEGIN(42)
    for (int it = vcu; it < 264; it += G) filter_item(a, lds, it, tid);
    AMP_END(42) }
    { AMP_BEGIN(43)
    LAS float* scr = (LAS float*)(lds + 65536 + wave * 8448);
    constexpr int IT_IN = 16 * 72, IT_OUT = 16 * 32, IT_E = 1024, IT_LAYER = IT_IN + IT_OUT + 3 * 16 * IT_E;
    for (int it = gw; it < 2 * IT_LAYER; it += NGW) {
        const int l = it / IT_LAYER; int r = it % IT_LAYER;
        if (r < IT_IN) { tr_item(a.in[I_WIN] + (size_t)l * 1024 * 2304, 1024, 2304, (bf16_t*)(ws + WS_WIN_T) + (size_t)l * 2304 * 1024, 1024, r, 0, scr, lane); continue; } r -= IT_IN;
        if (r < IT_OUT) { tr_item(a.in[I_WOUT] + (size_t)l * 1024 * 1024, 1024, 1024, (bf16_t*)(ws + WS_WOUT_T) + (size_t)l * 1024 * 1024, 1024, r, 0, scr, lane); continue; } r -= IT_OUT;
        const int which = r / (16 * IT_E), e = (r / IT_E) & 15, ri = r % IT_E; const size_t le = (size_t)l * 16 + e;
        float* wsc = (float*)(ws + WS_WSC) + (l * 3 + which) * 16 + e;
        if (which == 0) tr_item_fp8(a.in[I_WG] + le * 1024 * 2048, 1024, 2048, (unsigned char*)(ws + WS_WGU_T) + le * 4096 * 1024, 1024, ri, 1, scr, lane, wsc);
        else if (which == 1) tr_item_fp8(a.in[I_WU] + le * 1024 * 2048, 1024, 2048, (unsigned char*)(ws + WS_WGU_T) + le * 4096 * 1024, 1024, ri, 2, scr, lane, wsc);
        else tr_item_fp8(a.in[I_WD] + le * 2048 * 1024, 2048, 1024, (unsigned char*)(ws + WS_WD_T) + le * 1024 * 2048, 2048, ri, 0, scr, lane, wsc);
    }
    AMP_END(43) }
}

__device__ __forceinline__ void phase_norm(const Args& a, unsigned char* ldsg, int vcu, int G, int l, const float* srcx, const float* srcc, const bf16_t* srcb, const float* gain, int shift_idx, int nrows, bool router) {
    int tid_ = threadIdx.x; asm volatile("" : "+v"(tid_));
    const int tid = tid_, lane = tid & 63, wave = __builtin_amdgcn_readfirstlane(tid >> 6);
    unsigned char* ws = a.ws; asm volatile("" : "+s"(ws)); const float* MOD = (const float*)(ws + WS_MOD) + (size_t)l * 9 * 6144; bf16_t* HX = (bf16_t*)(ws + WS_HX);
    LAS float* rw = (LAS float*)(LAS unsigned char*)ldsg;
    if (router) { const float* rsrc = a.in[I_ROUTER] + (size_t)l * 1024 * 16; for (int i = tid; i < 1024 * 16; i += NTHR) rw[(i & 15) * 1024 + (i >> 4)] = rsrc[i]; __syncthreads(); }
    const int gw = vcu * NWAVES + wave, NGW = G * NWAVES;
    for (int rowa = gw; rowa < nrows; rowa += 2 * NGW) {
        f32x4 vv[2][4];
#pragma unroll
        for (int u = 0; u < 2; ++u) { const int rr = (rowa + u * NGW < nrows) ? rowa + u * NGW : rowa;
            if (srcb) { const bf16_t* xr = srcb + (size_t)rr * D;
#pragma unroll
                for (int j = 0; j < 4; ++j) { const u32x2 w = *(const u32x2*)(xr + 256 * j + 4 * lane); vv[u][j] = (f32x4){bflo(w.x), bfhi(w.x), bflo(w.y), bfhi(w.y)}; } }
            else { const float* xr = (rr < TX) ? srcx + (size_t)rr * D : srcc + (size_t)(rr - TX) * D;
#pragma unroll
                for (int j = 0; j < 4; ++j) vv[u][j] = *(const f32x4*)(xr + 256 * j + 4 * lane); } }
        f32x4 hv[2][4];
#pragma unroll
        for (int u = 0; u < 2; ++u) { const int row = rowa + u * NGW; if (row < nrows) {
        const bool lat = row < TX; const int mrow = lat ? (row >> 12) : 8;
        const float* shp = MOD + mrow * 6144 + shift_idx * 1024; const float* scp = shp + 1024;
        f32x4 v[4]; float ss = 0.f;
#pragma unroll
        for (int j = 0; j < 4; ++j) { v[j] = vv[u][j]; ss += (v[j][0] * v[j][0] + v[j][1] * v[j][1]) + (v[j][2] * v[j][2] + v[j][3] * v[j][3]); }
        const float rstd = 1.0f / sqrtf(wave_sum(ss) * (1.0f / D) + 1e-6f);
#pragma unroll
        for (int j = 0; j < 4; ++j) { const f32x4 gg = *(const f32x4*)(gain + 256 * j + 4 * lane), sh = *(const f32x4*)(shp + 256 * j + 4 * lane), sc = *(const f32x4*)(scp + 256 * j + 4 * lane);
            v[j] = (v[j] * rstd * gg) * (1.0f + sc) + sh;
            if (router) { int p = 0; p = __builtin_amdgcn_cvt_pk_fp8_f32(fminf(fmaxf(v[j][0], -448.f), 448.f), fminf(fmaxf(v[j][1], -448.f), 448.f), p, false); p = __builtin_amdgcn_cvt_pk_fp8_f32(fminf(fmaxf(v[j][2], -448.f), 448.f), fminf(fmaxf(v[j][3], -448.f), 448.f), p, true);
                *(int*)((unsigned char*)HX + (size_t)row * D + 256 * j + 4 * lane) = p; }
            else { u32x2 o; o.x = pk2(v[j][0], v[j][1]); o.y = pk2(v[j][2], v[j][3]); *(u32x2*)(HX + (size_t)row * D + 256 * j + 4 * lane) = o; } }
#pragma unroll
        for (int j = 0; j < 4; ++j) hv[u][j] = v[j];
        } }
        float plr[2][16];
        if (router) {
#pragma unroll
            for (int e = 0; e < 16; ++e) { float p0 = 0.f, p1 = 0.f;
#pragma unroll
                for (int j = 0; j < 4; ++j) { const f32x4 wv = *(const LAS f32x4*)(rw + e * 1024 + 256 * j + 4 * lane);
                    p0 += (hv[0][j][0] * wv[0] + hv[0][j][1] * wv[1]) + (hv[0][j][2] * wv[2] + hv[0][j][3] * wv[3]);
                    p1 += (hv[1][j][0] * wv[0] + hv[1][j][1] * wv[1]) + (hv[1][j][2] * wv[2] + hv[1][j][3] * wv[3]); }
                plr[0][e] = p0; plr[1][e] = p1; asm volatile("" : "+v"(plr[0][e]), "+v"(plr[1][e])); } }
#pragma unroll
        for (int u = 0; u < 2; ++u) { const int row = rowa + u * NGW; if (row < nrows) {
        if (router) {
            float pl[16];
#pragma unroll
            for (int e = 0; e < 16; ++e) pl[e] = plr[u][e];
            float q8[8], q4[4], q2[2], q1;
            { const bool up = (lane & 8) != 0;
#pragma unroll
              for (int e = 0; e < 8; ++e) { const float keep = up ? pl[e + 8] : pl[e], give = up ? pl[e] : pl[e + 8]; q8[e] = keep + __shfl_xor(give, 8); } }
            { const bool up = (lane & 4) != 0;
#pragma unroll
              for (int e = 0; e < 4; ++e) { const float keep = up ? q8[e + 4] : q8[e], give = up ? q8[e] : q8[e + 4]; q4[e] = keep + __shfl_xor(give, 4); } }
            { const bool up = (lane & 2) != 0;
#pragma unroll
              for (int e = 0; e < 2; ++e) { const float keep = up ? q4[e + 2] : q4[e], give = up ? q4[e] : q4[e + 2]; q2[e] = keep + __shfl_xor(give, 2); } }
            { const bool up = (lane & 1) != 0; const float keep = up ? q2[1] : q2[0], give = up ? q2[0] : q2[1]; q1 = keep + __shfl_xor(give, 1); }
            q1 += __shfl_xor(q1, 16); q1 += __shfl_xor(q1, 32);
            const float mylog = (lane < 16) ? q1 : -1e30f;
            float mx = mylog;
#pragma unroll
            for (int o = 1; o < 16; o <<= 1) mx = fmaxf(mx, __shfl_xor(mx, o));
            const float mine = (lane < 16) ? expf(mylog - mx) : 0.f; float den = mine;
#pragma unroll
            for (int o = 1; o < 16; o <<= 1) den += __shfl_xor(den, o);
            if (lane < 16) { ((float*)(ws + WS_AFFT))[(size_t)lane * TT + row] = mine / den; ((int*)(ws + WS_INV))[(size_t)row * 16 + lane] = -1; }
        }
    } }
    }
}

#define XB_TMO      128
#define XB_XCNT(j)  (256  + 64 * (j))
#define XB_XSUB(j)  (1280 + 64 * (j))
#define XB_XGEN(j)  (2304 + 64 * (j))
#define XB_TOP      3328
#define XB_TOPGEN   3392
#define XCD_BAR_WORDS 3456
#define XB_SPIN_CAP (1u << 18)

__device__ __forceinline__ unsigned xb_ld(unsigned* p)              { return __hip_atomic_load(p, __ATOMIC_RELAXED, __HIP_MEMORY_SCOPE_AGENT); }
__device__ __forceinline__ unsigned xb_add(unsigned* p, unsigned v) { return __hip_atomic_fetch_add(p, v, __ATOMIC_RELAXED, __HIP_MEMORY_SCOPE_AGENT); }
__device__ __forceinline__ unsigned xb_xcc_id() { return (unsigned)__builtin_amdgcn_s_getreg((3 << 11) | 20) & 0xFu; }
#define XB_SPIN(cond, bar) do { unsigned _sp = 0; while (cond) { __builtin_amdgcn_s_sleep(1); \
    if ((++_sp & 255u) == 0u) { if (xb_ld(&(bar)[XB_TMO])) break; if (_sp > XB_SPIN_CAP) { atomicAdd(&(bar)[XB_TMO], 1u); break; } } } } while (0)

struct XcdBarrier {
    unsigned* bar; unsigned x;
    volatile LAS unsigned* st;
};

__device__ __forceinline__ XcdBarrier xcd_barrier_post(unsigned* bar, volatile LAS unsigned* st) {
    XcdBarrier b; b.bar = bar; b.x = xb_xcc_id(); b.st = st;
    if (threadIdx.x == 0) (void)xb_add(&bar[XB_XCNT(b.x)], 1u);
    return b;
}
__device__ __forceinline__ void xcd_barrier_complete(unsigned* bar, unsigned x, unsigned& nloc, unsigned& nx) {
    const unsigned G = gridDim.x * gridDim.y * gridDim.z;
    unsigned sum, cnt, mine, sp = 0u;
    for (;;) {
        sum = 0u; cnt = 0u; mine = 0u;
#pragma unroll
        for (unsigned j = 0; j < 16; ++j) { const unsigned c = xb_ld(&bar[XB_XCNT(j)]); sum += c; cnt += (c > 0u) ? 1u : 0u; mine = (j == x) ? c : mine; }
        if (sum == G) break;
        __builtin_amdgcn_s_sleep(1);
        if ((++sp & 255u) == 0u) { if (xb_ld(&bar[XB_TMO])) break; if (sp > XB_SPIN_CAP) { atomicAdd(&bar[XB_TMO], 1u); break; } }
    }
    nloc = mine > 0u ? mine : 1u; nx = cnt > 0u ? cnt : 1u;
}

__device__ __forceinline__ void xcd_barrier(const XcdBarrier& b) {
    asm volatile("s_waitcnt vmcnt(0)" ::: "memory");
    __syncthreads();
    if (threadIdx.x == 0) {
        unsigned* bar = b.bar;
        __builtin_amdgcn_s_waitcnt(0);
        unsigned nloc = b.st[0], nx = b.st[1];
        if (nloc == 0u) { xcd_barrier_complete(bar, b.x, nloc, nx); b.st[0] = nloc; b.st[1] = nx; }
        const unsigned old = xb_add(&bar[XB_XSUB(b.x)], 1u);
        const unsigned gen = old / nloc;
        if (old + 1u == (gen + 1u) * nloc) {
            __builtin_amdgcn_fence(__ATOMIC_RELEASE, "agent");
            asm volatile("s_waitcnt vmcnt(0)" ::: "memory");
            const unsigned og = xb_add(&bar[XB_TOP], 1u);
            const unsigned tg = og / nx;
            if (og + 1u == (tg + 1u) * nx) xb_add(&bar[XB_TOPGEN], 1u);
            else XB_SPIN(xb_ld(&bar[XB_TOPGEN]) == tg, bar);
            __builtin_amdgcn_fence(__ATOMIC_ACQUIRE, "agent");
            xb_add(&bar[XB_XGEN(b.x)], 1u);
            asm volatile("s_waitcnt vmcnt(0)" ::: "memory");
        } else {
            XB_SPIN(xb_ld(&bar[XB_XGEN(b.x)]) == gen, bar);
            __builtin_amdgcn_fence(__ATOMIC_ACQUIRE, "agent");
            asm volatile("s_waitcnt vmcnt(0)" ::: "memory");
        }
    }
    __syncthreads();
}


typedef float f32x2 __attribute__((ext_vector_type(2)));
__device__ __forceinline__ f32x2 cmul(f32x2 a, f32x2 b) { return (f32x2){a.x * b.x - a.y * b.y, a.x * b.y + a.y * b.x}; }
__device__ __forceinline__ void dft16(f32x2 (&v)[16]) {
    constexpr float WC[8] = {1.0f, 0.92387953251128674f, 0.70710678118654752f, 0.38268343236508977f, 0.0f, -0.38268343236508977f, -0.70710678118654752f, -0.92387953251128674f};
    constexpr float WS[8] = {0.0f, -0.38268343236508977f, -0.70710678118654752f, -0.92387953251128674f, -1.0f, -0.92387953251128674f, -0.70710678118654752f, -0.38268343236508977f};
#pragma unroll
    for (int s = 8; s >= 1; s >>= 1)
#pragma unroll
        for (int i = 0; i < 16; ++i) if ((i & s) == 0) { const int k = (i & (s - 1)) * (8 / s); const f32x2 u = v[i], t = v[i + s]; v[i] = u + t; const f32x2 d = u - t;
            v[i + s] = (k == 0) ? d : ((k == 4) ? (f32x2){d.y, -d.x} : (f32x2){d.x * WC[k] - d.y * WS[k], d.x * WS[k] + d.y * WC[k]}); }
}
__device__ __forceinline__ constexpr int bitrev4(int i) { return ((i & 1) << 3) | ((i & 2) << 1) | ((i & 4) >> 1) | ((i & 8) >> 3); }
template <int NS, int MODE>
__device__ __forceinline__ void fft_pass(LAS f32x2* Z, const LAS f32x2* TW, int tid, const f32x2* H) {
    const int f = tid >> 8, j = tid & 255, base = f * 4096, k = j & (NS - 1);
    f32x2 v[16];
#pragma unroll
    for (int r = 0; r < 16; ++r) { const int idx = base + j + 256 * r; v[r] = Z[idx + (idx >> 4)]; }
    if (MODE == 1) {
#pragma unroll
        for (int r = 0; r < 16; ++r) { const f32x2 p = cmul(v[r], H[r]); v[r] = (f32x2){p.y, p.x}; } }
    if (NS > 1) { const LAS f32x2* tp = (NS == 16) ? (TW + 8192 + k) : (TW + 4096 + k);
#pragma unroll
        for (int r = 1; r < 16; ++r) v[r] = cmul(v[r], tp[r * NS]); }
    dft16(v);
    if (NS != 256) __syncthreads();
    const int j0 = base + (j / NS) * NS * 16 + k;
#pragma unroll
    for (int rr = 0; rr < 16; ++rr) { const int idx = j0 + rr * NS; Z[idx + (idx >> 4)] = v[bitrev4(rr)]; }
    __syncthreads();
}
__device__ __forceinline__ void load_uc(const bf16_t* UT, const float* cw, const float* cb, int ch, int b, int tid, float (&out)[8]) {
    const bf16_t* p = UT + ((size_t)(b * 768 + ch)) * 4096 + 8 * tid;
    const u32x4 w = *(const u32x4*)p; float u[10];
    u[1] = bflo(w.x); u[2] = bfhi(w.x); u[3] = bflo(w.y); u[4] = bfhi(w.y); u[5] = bflo(w.z); u[6] = bfhi(w.z); u[7] = bflo(w.w); u[8] = bfhi(w.w);
    u[0] = (tid > 0) ? bf2f(p[-1]) : 0.f; u[9] = (tid < 511) ? bf2f(p[8]) : 0.f;
    const float w0 = cw[ch], w1 = cw[768 + ch], w2 = cw[1536 + ch], bb = cb[ch];
#pragma unroll
    for (int i = 0; i < 8; ++i) out[i] = u[i] * w0 + u[i + 1] * w1 + u[i + 2] * w2 + bb;
}
__device__ __forceinline__ void hy_fill(LAS f32x2* Z, const LAS f32x2* TW, int tid, const float (&va)[8], const float (&vb)[8]) {
#pragma unroll
    for (int i = 0; i < 8; ++i) { const int t = 8 * tid + i; const f32x2 z = {va[i], vb[i]}; Z[t + (t >> 4)] = z; const int t2 = 4096 + t; Z[t2 + (t2 >> 4)] = cmul(z, TW[t]); }
    __syncthreads();
}
__device__ __forceinline__ void hy_conv(LAS f32x2* Z, const LAS f32x2* TW, int tid, const f32x2* Hg) {
    f32x2 H[16];
    { const int f = tid >> 8, j = tid & 255, base = f * 4096;
#pragma unroll
      for (int r = 0; r < 16; ++r) H[r] = Hg[base + j + 256 * r]; }
    fft_pass<1, 0>(Z, TW, tid, nullptr); fft_pass<16, 0>(Z, TW, tid, nullptr); fft_pass<256, 0>(Z, TW, tid, nullptr);
    fft_pass<1, 1>(Z, TW, tid, H); fft_pass<16, 0>(Z, TW, tid, nullptr); fft_pass<256, 0>(Z, TW, tid, nullptr);
}
__device__ __forceinline__ f32x2 hy_out(const LAS f32x2* Z, const LAS f32x2* TW, int t) {
    const f32x2 se = Z[t + (t >> 4)]; const int t2 = 4096 + t; const f32x2 so = Z[t2 + (t2 >> 4)]; const f32x2 tw = TW[t];
    const f32x2 So = {so.y, so.x};
    return (f32x2){se.y + (So.x * tw.x + So.y * tw.y), se.x + (So.y * tw.x - So.x * tw.y)};
}
__device__ __forceinline__ void hyena_item(const Args& a, LAS unsigned char* lds, int l, int c, int bp, int tid) {
    asm volatile("" : "+v"(tid));
    LAS f32x2* Z = (LAS f32x2*)lds; const LAS f32x2* TW = (const LAS f32x2*)(lds + 69632);
    const bf16_t* UT = (const bf16_t*)(a.ws + WS_UT); bf16_t* YT = (bf16_t*)(a.ws + WS_YT);
    const float* cw = a.in[I_HCW] + (size_t)l * 3 * 768; const float* cb = a.in[I_HCB] + (size_t)l * 768; const float* skip = a.in[I_HSKIP] + (size_t)l * 2 * 256;
    const f32x2* HS = (const f32x2*)(a.ws + WS_HS) + ((size_t)(l * 2) * 256 + c) * 8192;
    const int b0 = 2 * bp, b1 = 2 * bp + 1;
    float va[8], vb[8], xa[8], xb[8];
    load_uc(UT, cw, cb, c, b0, tid, va); load_uc(UT, cw, cb, c, b1, tid, vb);
    hy_fill(Z, TW, tid, va, vb);
    hy_conv(Z, TW, tid, HS);
    load_uc(UT, cw, cb, 256 + c, b0, tid, xa); load_uc(UT, cw, cb, 256 + c, b1, tid, xb);
    { const float sk = skip[c];
#pragma unroll
      for (int i = 0; i < 8; ++i) { const f32x2 y = hy_out(Z, TW, 8 * tid + i); va[i] = xa[i] * (y.x + va[i] * sk); vb[i] = xb[i] * (y.y + vb[i] * sk); } }
    __syncthreads();
    hy_fill(Z, TW, tid, va, vb);
    hy_conv(Z, TW, tid, HS + (size_t)256 * 8192);
    load_uc(UT, cw, cb, 512 + c, b0, tid, xa); load_uc(UT, cw, cb, 512 + c, b1, tid, xb);
    { const float sk = skip[256 + c];
      float oa[8], ob[8];
#pragma unroll
      for (int i = 0; i < 8; ++i) { const f32x2 y = hy_out(Z, TW, 8 * tid + i); oa[i] = xa[i] * (y.x + va[i] * sk); ob[i] = xb[i] * (y.y + vb[i] * sk); }
      u32x4 wa, wb; wa.x = pk2(oa[0], oa[1]); wa.y = pk2(oa[2], oa[3]); wa.z = pk2(oa[4], oa[5]); wa.w = pk2(oa[6], oa[7]); wb.x = pk2(ob[0], ob[1]); wb.y = pk2(ob[2], ob[3]); wb.z = pk2(ob[4], ob[5]); wb.w = pk2(ob[6], ob[7]);
      *(u32x4*)(YT + ((size_t)(b0 * 256 + c)) * 4096 + 8 * tid) = wa; *(u32x4*)(YT + ((size_t)(b1 * 256 + c)) * 4096 + 8 * tid) = wb; }
    __syncthreads();
}
__device__ __forceinline__ void spectrum_item(const Args& a, LAS unsigned char* lds, int item, int tid) {
    asm volatile("" : "+v"(tid));
    LAS f32x2* Z = (LAS f32x2*)lds; const LAS f32x2* TW = (const LAS f32x2*)(lds + 69632);
    const int c = item & 255, lo = item >> 8;
    const float* HC = (const float*)(a.ws + WS_HC) + (size_t)lo * 8191 * 256 + c;
#pragma unroll
    for (int i = 0; i < 8; ++i) { const int t = 8 * tid + i; const float hl = HC[(size_t)(4095 + t) * 256], hh = (t == 0) ? 0.f : HC[(size_t)(t - 1) * 256];
        Z[t + (t >> 4)] = (f32x2){hl + hh, 0.f}; const int t2 = 4096 + t; const f32x2 tw = TW[t]; const float dd = hl - hh; Z[t2 + (t2 >> 4)] = (f32x2){dd * tw.x, dd * tw.y}; }
    __syncthreads();
    fft_pass<1, 0>(Z, TW, tid, nullptr); fft_pass<16, 0>(Z, TW, tid, nullptr); fft_pass<256, 0>(Z, TW, tid, nullptr);
    f32x2* HS = (f32x2*)(a.ws + WS_HS) + (size_t)item * 8192;
#pragma unroll
    for (int i = 0; i < 16; ++i) { const int idx = tid + 512 * i; HS[idx] = Z[idx + (idx >> 4)] * (1.0f / 8192.0f); }
    __syncthreads();
}
__device__ __forceinline__ void load_tw(const Args& a, LAS unsigned char* lds, int tid) {
    asm volatile("" : "+v"(tid));
    LAS f32x2* TW = (LAS f32x2*)(lds + 69632); const f32x2* src = (const f32x2*)(a.ws + WS_TW8);
    for (int i = tid; i < 4096; i += NTHR) { TW[i] = src[i]; const int r = i >> 8, k = i & 255; TW[4096 + i] = src[r * k * 2]; }
    if (tid < 256) { const int r = tid >> 4, k = tid & 15; TW[8192 + tid] = src[r * k * 32]; }
    __syncthreads();
}
__device__ __forceinline__ float ctx_uc(const bf16_t* PXc, const float* cw, const float* cb, int ch, int t) {
    const float u1 = bf2f(PXc[(size_t)t * INW + ch]); const float u0 = (t > 0) ? bf2f(PXc[(size_t)(t - 1) * INW + ch]) : 0.f; const float u2 = (t < 255) ? bf2f(PXc[(size_t)(t + 1) * INW + ch]) : 0.f;
    return u0 * cw[ch] + u1 * cw[768 + ch] + u2 * cw[1536 + ch] + cb[ch];
}
__device__ __forceinline__ void ctx_conv16(const LAS float* IN, const float* H, int c, int lane, int t0, float (&acc)[16]) {
    float w[16];
    const float* hp = H + (size_t)(t0 + 255) * 256 + c;
#pragma unroll
    for (int i = 0; i < 16; ++i) { acc[i] = 0.f; w[i] = hp[i * 256]; }
    const LAS float* ip = IN + lane;
#pragma unroll 1
    for (int s0 = 0; s0 < 256; s0 += 16) {
#pragma unroll
        for (int u = 0; u < 16; ++u) { const float v = ip[u * 64];
#pragma unroll
            for (int i = 0; i < 16; ++i) acc[i] += v * w[(i - u + 16) & 15];
            w[(15 - u) & 15] = hp[-(u + 1) * 256]; }
        hp -= 16 * 256; ip += 16 * 64; }
}
__device__ __forceinline__ void ctx_hyena_item(const Args& a, LAS unsigned char* lds, int l, int item, int tid) {
    asm volatile("" : "+v"(tid));
    const int lane = tid & 63, wave = tid >> 6, b = item >> 2, c = (item & 3) * 64 + lane;
    LAS float* V = (LAS float*)lds; LAS float* Z1 = (LAS float*)(lds + 65536);
    const bf16_t* PXc = (const bf16_t*)(a.ws + WS_PX) + (size_t)(TX + b * 256) * INW; bf16_t* Y = (bf16_t*)(a.ws + WS_Y) + (size_t)(TX + b * 256) * D;
    const float* cw = a.in[I_HCW] + (size_t)l * 3 * 768; const float* cb = a.in[I_HCB] + (size_t)l * 768; const float* skip = a.in[I_HSKIP] + (size_t)l * 2 * 256;
    const float* H0 = (const float*)(a.ws + WS_HCC) + 256, *H1 = H0 + (size_t)511 * 256;
#pragma unroll 2
    for (int i = 0; i < 32; ++i) { const int t = wave * 32 + i; V[t * 64 + lane] = ctx_uc(PXc, cw, cb, c, t); }
    __syncthreads();
    float acc[16];
#pragma unroll 1
    for (int g = 0; g < 2; ++g) { const int t0 = wave * 32 + g * 16; ctx_conv16(V, H0, c, lane, t0, acc); const float sk = skip[c];
#pragma unroll
        for (int i = 0; i < 16; ++i) { const int t = t0 + i; Z1[t * 64 + lane] = ctx_uc(PXc, cw, cb, 256 + c, t) * (acc[i] + V[t * 64 + lane] * sk); } }
    __syncthreads();
#pragma unroll 1
    for (int g = 0; g < 2; ++g) { const int t0 = wave * 32 + g * 16; ctx_conv16(Z1, H1, c, lane, t0, acc); const float sk = skip[256 + c];
#pragma unroll
        for (int i = 0; i < 16; ++i) { const int t = t0 + i; Y[(size_t)t * D + c] = (bf16_t)f2bf(ctx_uc(PXc, cw, cb, 512 + c, t) * (acc[i] + Z1[t * 64 + lane] * sk)); } }
    __syncthreads();
}

__device__ __forceinline__ void ytr_item(const Args& a, LAS unsigned char* tile, int item, int lane) {
    const int b = item >> 8, tt = (item >> 2) & 63, ct = item & 3;
    const bf16_t* src = (const bf16_t*)(a.ws + WS_YT) + ((size_t)(b * 256 + ct * 64)) * 4096 + tt * 64; bf16_t* Y = (bf16_t*)(a.ws + WS_Y) + ((size_t)b * 4096 + tt * 64) * D + ct * 64;
    u32x4 v[8];
#pragma unroll
    for (int i = 0; i < 8; ++i) v[i] = *(const u32x4*)(src + (size_t)((lane >> 3) + 8 * i) * 4096 + (lane & 7) * 8);
#pragma unroll
    for (int i = 0; i < 8; ++i) *(LAS u32x4*)(tile + ((lane >> 3) + 8 * i) * 144 + (lane & 7) * 16) = v[i];
    LDS_WAIT();
    const LAS unsigned short* tp = (const LAS unsigned short*)(tile + lane * 2);
#pragma unroll
    for (int q = 0; q < 8; ++q) { u32x4 o;
        o.x = (unsigned)tp[(8 * q + 0) * 72] | ((unsigned)tp[(8 * q + 1) * 72] << 16); o.y = (unsigned)tp[(8 * q + 2) * 72] | ((unsigned)tp[(8 * q + 3) * 72] << 16);
        o.z = (unsigned)tp[(8 * q + 4) * 72] | ((unsigned)tp[(8 * q + 5) * 72] << 16); o.w = (unsigned)tp[(8 * q + 6) * 72] | ((unsigned)tp[(8 * q + 7) * 72] << 16);
        *(u32x4*)(Y + (size_t)lane * D + 8 * q) = o; }
    LDS_WAIT();
}
__device__ __forceinline__ void event_arrive(unsigned* ctr) {
    asm volatile("s_waitcnt vmcnt(0)" ::: "memory"); __syncthreads();
    if (threadIdx.x == 0) { __builtin_amdgcn_fence(__ATOMIC_RELEASE, "agent"); asm volatile("s_waitcnt vmcnt(0)" ::: "memory"); __hip_atomic_fetch_add(ctr, 1u, __ATOMIC_RELAXED, __HIP_MEMORY_SCOPE_AGENT); }
}
__device__ __forceinline__ void event_wait(unsigned* ctr, unsigned want) {
    if (threadIdx.x == 0) { unsigned sp = 0;
        while (__hip_atomic_load(ctr, __ATOMIC_RELAXED, __HIP_MEMORY_SCOPE_AGENT) < want) { __builtin_amdgcn_s_sleep(2); if (++sp > (1u << 22)) break; }
        __builtin_amdgcn_fence(__ATOMIC_ACQUIRE, "agent"); asm volatile("s_waitcnt vmcnt(0)" ::: "memory"); }
    __syncthreads();
}

typedef short bf16x8_t __attribute__((ext_vector_type(8)));
typedef short s16x4_t __attribute__((ext_vector_type(4)));
typedef float f32x16 __attribute__((ext_vector_type(16)));
__device__ __forceinline__ int crow(int r, int hi) { return (r & 3) + 8 * (r >> 2) + 4 * hi; }
__device__ __forceinline__ unsigned cvtpk(float lo, float hi) { f32x2 v = {lo, hi}; bf16x2_t b = __builtin_convertvector(v, bf16x2_t); return __builtin_bit_cast(unsigned, b); }
__device__ __forceinline__ s16x4_t vtr(const LAS unsigned char* p) { return __builtin_bit_cast(s16x4_t, __builtin_amdgcn_ds_read_tr16_b64_v4i16((LAS s16x4_t*)p)); }
constexpr int AT_K = 0, AT_V = 16384, AT_WSF = 32768, AT_OST = 34816, AT_RPB = 67584, AT_END = 69632;
template <int KIND>
__device__ __forceinline__ void attn_unit(const Args& a, LAS unsigned char* lds, int l, int u, int tid) {
    asm volatile("" : "+v"(tid));
    const int lane = tid & 63, wid = __builtin_amdgcn_readfirstlane(tid >> 6), r32 = lane & 31, hi = lane >> 5;
    const bf16_t* PX = (const bf16_t*)(a.ws + WS_PX); bf16_t* Y = (bf16_t*)(a.ws + WS_Y);
    int b, qcol, kcol, vcol, ycol, qrow0, nloc = 0, lo = 0; bool sink = false; int hsink = 0;
    int qpos0 = 0, blk = 0, rq = 0, cbase = 0, rq4 = 0;
    if (KIND == 0) { b = u >> 6; const int kvh = (u >> 5) & 1; blk = u & 31; const int h = 2 * kvh + (wid >> 2); qpos0 = blk * 128 + 32 * (wid & 3); qrow0 = b * 4096 + qpos0;
        qcol = 1024 + h * 64; kcol = 1536 + kvh * 64; vcol = 1664 + kvh * 64; ycol = 256 + h * 64; lo = (blk == 0) ? 2 : 0; nloc = ((blk == 31) ? 3 : 5) - lo + 1; sink = true; hsink = h; }
    else if (KIND == 1) { b = u >> 6; const int h = (u >> 4) & 3; rq4 = u & 15; rq = 4 * rq4 + (wid >> 1); cbase = 32 * (wid & 1); qrow0 = b * 4096 + rq * 64 + cbase;
        qcol = 1280 + h * 64; kcol = 1792 + h * 64; vcol = 2048 + h * 64; ycol = 768 + h * 64;
        const int ra = 4 * rq4 - 4, rb = 4 * rq4 + 3 - 4; lo = ra < 0 ? 0 : (ra > 56 ? 56 : ra); const int hi_r = (rb < 0 ? 0 : (rb > 56 ? 56 : rb)) + 7; nloc = hi_r - lo + 1;
        LAS float* rpbL = (LAS float*)(lds + AT_RPB); const float* src = a.in[I_RPB] + (size_t)(l * 4 + h) * 465;
        for (int i = tid; i < 465; i += NTHR) rpbL[i] = src[i] * LOG2E; }
    else { b = u >> 3; const int h = (u >> 1) & 3; qrow0 = TX + b * 256 + 32 * wid;
        if ((u & 1) == 0) { qcol = 1024 + h * 64; kcol = 1536 + (h >> 1) * 64; vcol = 1664 + (h >> 1) * 64; ycol = 256 + h * 64; sink = true; hsink = h; }
        else { qcol = 1280 + h * 64; kcol = 1792 + h * 64; vcol = 2048 + h * 64; ycol = 768 + h * 64; } }
    const int NT = nloc + 4;
    bf16x8_t qr[4];
    { const bf16_t* qp = PX + (size_t)(qrow0 + r32) * INW + qcol + hi * 8;
#pragma unroll
      for (int d0 = 0; d0 < 4; ++d0) qr[d0] = *(const bf16x8_t*)(qp + d0 * 16); }
    const int krow = 8 * wid + (lane & 7), kchunk = lane >> 3; const int vrow = 16 * (wid & 3) + (lane >> 2), vcoff = (wid >> 2) * 32 + (lane & 3) * 8;
    const int kdst = AT_K + kchunk * 1024 + krow * 16, vdst = AT_V + wid * 1024 + lane * 16;
    auto tile_row0 = [&](int t) -> int { if (t < nloc) { if (KIND == 0) return b * 4096 + blk * 128 - 128 + 64 * (lo + t); else return b * 4096 + (lo + t) * 64; } return TX + b * 256 + 64 * (t - nloc); };
    u32x4 gk0, gv0, gk1, gv1;
#define AT_LOAD(GK, GV, t_) do { const int R0_ = tile_row0(t_); GK = *(const u32x4*)(PX + (size_t)(R0_ + krow) * INW + kcol + kchunk * 8); GV = *(const u32x4*)(PX + (size_t)(R0_ + vrow) * INW + vcol + vcoff); } while (0)
    AT_LOAD(gk0, gv0, 0);
    if (NT > 1) AT_LOAD(gk1, gv1, 1); else { gk1 = gk0; gv1 = gv0; }
    *(LAS u32x4*)(lds + kdst) = gk0; *(LAS u32x4*)(lds + vdst) = gv0;
    float mhat = -1e30f, l_reg = 0.f; f32x16 o[2];
#pragma unroll
    for (int r = 0; r < 16; ++r) { o[0][r] = 0.f; o[1][r] = 0.f; }
    LAS float* wsf = (LAS float*)(lds + AT_WSF) + wid * 64;
    const LAS unsigned char* vb0 = lds + AT_V + ((lane >> 4) & 1) * 32 + (lane & 3) * 8 + (4 * hi + ((lane & 15) >> 2)) * 64;
    const LAS unsigned char* kb0 = lds + AT_K + hi * 1024 + r32 * 16;
    __syncthreads();
    auto step = [&](int t, u32x4& gkw, u32x4& gvw, u32x4& gkl, u32x4& gvl) __attribute__((always_inline)) {
        const int bufo = (t & 1) * 8192;
        if (t + 2 < NT) AT_LOAD(gkl, gvl, t + 2);
        bool need = true; bool full = true; int ts = 0, rk = 0;
        if (t < nloc) {
            if (KIND == 0) { ts = blk * 128 - 128 + 64 * (lo + t); need = (ts + 63 >= qpos0 - 128) && (ts <= qpos0 + 31 + 128); full = (qpos0 + 31 - ts <= 128) && (ts + 63 - qpos0 <= 128); }
            if (KIND == 1) { rk = lo + t; const int r0 = (rq - 4) < 0 ? 0 : ((rq - 4) > 56 ? 56 : (rq - 4)); need = (rk >= r0) && (rk <= r0 + 7); full = false; }
        }
        if (need) {
            f32x16 p0, p1;
#pragma unroll
            for (int r = 0; r < 16; ++r) { p0[r] = 0.f; p1[r] = 0.f; }
            const LAS unsigned char* kb = kb0 + bufo;
#pragma unroll
            for (int d0 = 0; d0 < 4; ++d0) { const bf16x8_t k0 = *(const LAS bf16x8_t*)(kb + d0 * 2048), k1 = *(const LAS bf16x8_t*)(kb + d0 * 2048 + 512);
                p0 = __builtin_amdgcn_mfma_f32_32x32x16_bf16(k0, qr[d0], p0, 0, 0, 0); p1 = __builtin_amdgcn_mfma_f32_32x32x16_bf16(k1, qr[d0], p1, 0, 0, 0); }
            constexpr float C2 = 0.125f * LOG2E;
#pragma unroll
            for (int r = 0; r < 16; ++r) { p0[r] *= C2; p1[r] *= C2; }
            if (!full) {
                if (KIND == 0) { const int tq = qpos0 + r32;
#pragma unroll
                    for (int r = 0; r < 16; ++r) { const int k0 = ts + crow(r, hi), d0 = tq - k0, d1 = d0 - 32; if (d0 > 128 || d0 < -128) p0[r] = -1e30f; if (d1 > 128 || d1 < -128) p1[r] = -1e30f; } }
                if (KIND == 1) { const int c = cbase + r32; const int wsc = (c - 8) < 0 ? 0 : ((c - 8) > 48 ? 48 : (c - 8)); const LAS float* rp = (const LAS float*)(lds + AT_RPB) + (rk - rq + 7) * 31 + 15 - c;
#pragma unroll
                    for (int r = 0; r < 16; ++r) { const int c0 = crow(r, hi), c1 = c0 + 32; const bool ok0 = (c0 >= wsc) && (c0 < wsc + 16), ok1 = (c1 >= wsc) && (c1 < wsc + 16);
                        p0[r] = ok0 ? p0[r] + rp[ok0 ? c0 : c] : -1e30f; p1[r] = ok1 ? p1[r] + rp[ok1 ? c1 : c] : -1e30f; } }
            }
            float rm = fmaxf(p0[0], p1[0]);
#pragma unroll
            for (int r = 1; r < 16; ++r) rm = fmaxf(rm, fmaxf(p0[r], p1[r]));
            { auto rr = __builtin_amdgcn_permlane32_swap(__float_as_uint(rm), __float_as_uint(rm), false, false); rm = fmaxf(__uint_as_float(rr[0]), __uint_as_float(rr[1])); }
            const float mnew = fmaxf(mhat, rm); const float f = __builtin_amdgcn_exp2f(mhat - mnew); const bool grew = mnew > mhat; mhat = mnew;
            float sacc = 0.f;
#pragma unroll
            for (int r = 0; r < 16; ++r) { p0[r] = (p0[r] > -1e29f) ? __builtin_amdgcn_exp2f(p0[r] - mnew) : 0.f; p1[r] = (p1[r] > -1e29f) ? __builtin_amdgcn_exp2f(p1[r] - mnew) : 0.f; sacc += p0[r] + p1[r]; }
            l_reg = l_reg * f + sacc;
            if (__any(grew)) { if (hi == 0) wsf[r32] = f; LDS_WAIT();
#pragma unroll
                for (int r = 0; r < 16; ++r) { const float fr_ = wsf[crow(r, hi)]; o[0][r] *= fr_; o[1][r] *= fr_; }
                LDS_WAIT(); }
            u32x4 pw0, pw1, pw2, pw3;
            pw0 = (u32x4){cvtpk(p0[0], p0[1]), cvtpk(p0[2], p0[3]), cvtpk(p0[4], p0[5]), cvtpk(p0[6], p0[7])}; pw1 = (u32x4){cvtpk(p0[8], p0[9]), cvtpk(p0[10], p0[11]), cvtpk(p0[12], p0[13]), cvtpk(p0[14], p0[15])};
            pw2 = (u32x4){cvtpk(p1[0], p1[1]), cvtpk(p1[2], p1[3]), cvtpk(p1[4], p1[5]), cvtpk(p1[6], p1[7])}; pw3 = (u32x4){cvtpk(p1[8], p1[9]), cvtpk(p1[10], p1[11]), cvtpk(p1[12], p1[13]), cvtpk(p1[14], p1[15])};
            const LAS unsigned char* vb = vb0 + bufo;
#pragma unroll
            for (int d0 = 0; d0 < 2; ++d0) {
#pragma unroll
                for (int ks = 0; ks < 4; ++ks) { const s16x4_t vl = vtr(vb + d0 * 4096 + ks * 1024), vh = vtr(vb + d0 * 4096 + ks * 1024 + 512);
                    const bf16x8_t vf = (bf16x8_t){vl[0], vl[1], vl[2], vl[3], vh[0], vh[1], vh[2], vh[3]};
                    const bf16x8_t pa = __builtin_bit_cast(bf16x8_t, ks == 0 ? pw0 : (ks == 1 ? pw1 : (ks == 2 ? pw2 : pw3)));
                    o[d0] = __builtin_amdgcn_mfma_f32_32x32x16_bf16(pa, vf, o[d0], 0, 0, 0); } }
        }
        if (t + 1 < NT) { const int nb = ((t + 1) & 1) * 8192; *(LAS u32x4*)(lds + kdst + nb) = gkw; *(LAS u32x4*)(lds + vdst + nb) = gvw; }
        __syncthreads();
    };
    for (int t = 0; t < NT; t += 2) { step(t, gk1, gv1, gk0, gv0); if (t + 1 < NT) step(t + 1, gk0, gv0, gk1, gv1); }
#undef AT_LOAD
    { auto rr = __builtin_amdgcn_permlane32_swap(__float_as_uint(l_reg), __float_as_uint(l_reg), false, false); l_reg = __uint_as_float(rr[0]) + __uint_as_float(rr[1]); }
    if (sink) l_reg += __builtin_amdgcn_exp2f(a.in[I_SINK][l * 4 + hsink] * LOG2E - mhat);
    if (hi == 0) wsf[32 + r32] = 1.0f / l_reg;
    LDS_WAIT();
    LAS bf16_t* stg = (LAS bf16_t*)(lds + AT_OST) + wid * 2048;
#pragma unroll
    for (int r = 0; r < 16; ++r) { const int orow = crow(r, hi); const float il = wsf[32 + orow];
        stg[orow * 64 + r32] = (bf16_t)f2bf(o[0][r] * il); stg[orow * 64 + 32 + r32] = (bf16_t)f2bf(o[1][r] * il); }
    LDS_WAIT();
#pragma unroll
    for (int i = 0; i < 4; ++i) { const int row = i * 8 + (lane >> 3), ch = lane & 7; const u32x4 v = *(const LAS u32x4*)(stg + row * 64 + ch * 8);
        *(u32x4*)(Y + (size_t)(qrow0 + row) * D + ycol + ch * 8) = v; }
    __syncthreads();
}

__device__ __forceinline__ void phase_mix1(const Args& a, unsigned char* ldsg, int vcu, int G, int l) {
    LAS unsigned char* lds = (LAS unsigned char*)ldsg;
    int tid_ = threadIdx.x; asm volatile("" : "+v"(tid_));
    const int tid = tid_, lane = tid & 63, wave = __builtin_amdgcn_readfirstlane(tid >> 6);
    unsigned char* ws = a.ws; asm volatile("" : "+s"(ws)); const bf16_t* PX = (const bf16_t*)(ws + WS_PX); bf16_t* Y = (bf16_t*)(ws + WS_Y);
    const bool upd = (l == 0); const int nrows = upd ? TT : TX;
    const int gw = vcu * NWAVES + wave, NGW = G * NWAVES;
    { AMP_BEGIN(31) load_tw(a, lds, tid);
    for (int it = vcu; it < 1024; it += G) hyena_item(a, lds, l, it >> 2, it & 3, tid);
    if (upd) for (int it = vcu; it < 32; it += G) ctx_hyena_item(a, lds, l, it, tid);
    event_arrive((unsigned*)(ws + WS_CTL) + 8192 + 64 * l); AMP_END(31) }
    { AMP_BEGIN(32)
    LAS float* pw = (LAS float*)(lds + 73728); LAS float* dv = (LAS float*)(lds + 139264 + wave * 1024);
    { const float* src = a.in[I_POOLW] + (size_t)l * 4 * 64 * 64; for (int i = tid; i < 4 * 64 * 64; i += NTHR) pw[i] = src[i]; }
    __syncthreads();
    const float* pscale = a.in[I_POOLS] + (size_t)l * 256;
    for (int row = gw; row < nrows; row += NGW) {
        const bool lat = row < TX; const int tpos = lat ? (row & 4095) : ((row - TX) & 255); const int Ls = lat ? 4096 : 256;
        const bf16_t* pr = PX + (size_t)row * INW;
        { const int g = lane >> 4, hw = 1 << g;
          const int c = 768 + 4 * lane; float s0 = 0.f, s1 = 0.f, s2 = 0.f, s3 = 0.f; int cnt = 0;
          u32x2 wv[16];
#pragma unroll
          for (int off = -8; off < 8; ++off) { const int tp = tpos + off; const bool inr = (tp >= 0) && (tp < Ls); wv[off + 8] = *(const u32x2*)(pr + (ptrdiff_t)(inr ? off : 0) * INW + c); }
#pragma unroll
          for (int off = -8; off < 8; ++off) { const int tp = tpos + off; const bool in = (off >= -hw) && (off < hw) && (tp >= 0) && (tp < Ls); const u32x2 v = wv[off + 8];
              s0 += in ? bflo(v.x) : 0.f; s1 += in ? bfhi(v.x) : 0.f; s2 += in ? bflo(v.y) : 0.f; s3 += in ? bfhi(v.y) : 0.f; cnt += in ? 1 : 0; }
          const u32x2 u0 = wv[8]; const float ic = 1.0f / (float)cnt;
          f32x4 dd; dd[0] = s0 * ic - bflo(u0.x); dd[1] = s1 * ic - bfhi(u0.x); dd[2] = s2 * ic - bflo(u0.y); dd[3] = s3 * ic - bfhi(u0.y);
          *(LAS f32x4*)(dv + 4 * lane) = dd;
          LDS_WAIT();
          const int j0 = 4 * (lane & 15); f32x4 acc = {0.f, 0.f, 0.f, 0.f};
          const LAS float* dg = dv + g * 64; const LAS float* wg = pw + g * 4096 + j0;
#pragma unroll 8
          for (int i = 0; i < 64; ++i) { const float di = dg[i]; const f32x4 wv = *(const LAS f32x4*)(wg + i * 64); acc += wv * di; }
          const f32x4 sc = *(const f32x4*)(pscale + g * 64 + j0); acc *= sc;
          u32x2 ov; ov.x = pk2(acc[0], acc[1]); ov.y = pk2(acc[2], acc[3]);
          *(u32x2*)(Y + (size_t)row * D + 512 + g * 64 + j0) = ov;
          LDS_WAIT(); }
    }
    __syncthreads(); AMP_END(32) }
    { AMP_BEGIN(33)
    for (int u = vcu; u < 512; u += G) attn_unit<0>(a, lds, l, u, tid);
    for (int u = vcu; u < 512; u += G) attn_unit<1>(a, lds, l, u, tid);
    if (upd) for (int u = vcu; u < 64; u += G) attn_unit<2>(a, lds, l, u, tid);
    AMP_END(33) }
    { AMP_BEGIN(34) event_wait((unsigned*)(ws + WS_CTL) + 8192 + 64 * l, (unsigned)G);
      for (int it = gw; it < 2048; it += NGW) ytr_item(a, lds + wave * 9216, it, lane); AMP_END(34) }
}

__device__ __forceinline__ void phase_select(const Args& a, unsigned char* ldsg, int vcu, int G, bool with_ctx) {
    LAS unsigned* keys = (LAS unsigned*)(LAS unsigned char*)ldsg;
    LAS unsigned* hist = keys + 4096;
    LAS unsigned* ctl = hist + 256;
    int tid_ = threadIdx.x; asm volatile("" : "+v"(tid_));
    const int tid = tid_, lane = tid & 63; unsigned char* ws = a.ws; asm volatile("" : "+s"(ws));
    const float* AFFT = (const float*)(ws + WS_AFFT); int* ROWMAP = (int*)(ws + WS_ROWMAP); float* GATE = (float*)(ws + WS_GATE); int* INV = (int*)(ws + WS_INV);
    const int nitems = 128 + (with_ctx ? 128 : 0);
    for (int item = vcu; item < nitems; item += G) {
        int e, base, Ls, cap, slot0;
        if (item < 128) { const int b = item >> 4; e = item & 15; base = b * 4096; Ls = 4096; cap = CAPX; slot0 = b * CAPX; }
        else { const int it = item - 128; const int b = it >> 4; e = it & 15; base = TX + b * 256; Ls = 256; cap = CAPC; slot0 = NB * CAPX + b * CAPC; }
        unsigned k[8];
#pragma unroll
        for (int i = 0; i < 8; ++i) { const int idx = tid + NTHR * i; k[i] = (idx < Ls) ? __float_as_uint(AFFT[(size_t)e * TT + base + idx]) : 0u; if (idx < Ls) keys[idx] = k[i]; }
        if (tid == 0) { ctl[0] = 0u; ctl[1] = (unsigned)cap; ctl[2] = 0u; ctl[3] = 0u; }
        unsigned prefix = 0u;
#pragma unroll 1
        for (int p = 0; p < 4; ++p) { const int shift = 24 - 8 * p;
            if (tid < 256) hist[tid] = 0u;
            __syncthreads();
#pragma unroll
            for (int i = 0; i < 8; ++i) { const int idx = tid + NTHR * i; const bool cand = (idx < Ls) && (p == 0 || (k[i] >> (shift + 8)) == prefix);
                if (cand) atomicAdd((unsigned*)&hist[(k[i] >> shift) & 255u], 1u); }
            __syncthreads();
            if (tid < 64) {
                const unsigned need = ctl[1];
                const unsigned c0 = hist[255 - 4 * lane], c1 = hist[254 - 4 * lane], c2 = hist[253 - 4 * lane], c3 = hist[252 - 4 * lane];
                const unsigned s = c0 + c1 + c2 + c3; unsigned inc = s;
#pragma unroll
                for (int o = 1; o < 64; o <<= 1) { const unsigned v = __shfl_up(inc, o); if (lane >= o) inc += v; }
                const unsigned exc = inc - s;
                if (exc < need && inc >= need) { unsigned above = exc; int d;
                    if (above + c0 >= need) d = 255 - 4 * lane; else { above += c0; if (above + c1 >= need) d = 254 - 4 * lane; else { above += c1; if (above + c2 >= need) d = 253 - 4 * lane; else { above += c2; d = 252 - 4 * lane; } } }
                    ctl[0] = (prefix << 8) | (unsigned)d; ctl[1] = need - above; } }
            __syncthreads();
            prefix = ctl[0]; }
        const unsigned T = prefix; const unsigned need = ctl[1];
        int eqc = 0;
#pragma unroll
        for (int i = 0; i < 8; ++i) { const int idx = tid + NTHR * i; eqc += ((idx < Ls) && k[i] == T) ? 1 : 0; }
        if (eqc) atomicAdd((unsigned*)&ctl[3], (unsigned)eqc);
        __syncthreads();
        const bool all_eq = (ctl[3] == need);
#pragma unroll
        for (int i = 0; i < 8; ++i) { const int idx = tid + NTHR * i;
            if (idx < Ls && (k[i] > T || (all_eq && k[i] == T))) { const int s = (int)atomicAdd((unsigned*)&ctl[2], 1u); const int slot = e * SLOTS + slot0 + s;
                ROWMAP[slot] = base + idx; GATE[slot] = __uint_as_float(k[i]); INV[(size_t)(base + idx) * 16 + e] = slot; } }
        __syncthreads();
        if (!all_eq && tid == 0) {
            int s = (int)ctl[2]; unsigned left = need;
            for (int idx = 0; idx < Ls && left; ++idx) if (keys[idx] == T) { const int slot = e * SLOTS + slot0 + s; ROWMAP[slot] = base + idx; GATE[slot] = __uint_as_float(T); INV[(size_t)(base + idx) * 16 + e] = slot; ++s; --left; } }
        __syncthreads();
    }
}
__device__ __forceinline__ void phase_gather(const Args& a, int vcu, int G, bool with_ctx) {
    int tid_ = threadIdx.x; asm volatile("" : "+v"(tid_));
    const int tid = tid_, lane = tid & 63, wave = __builtin_amdgcn_readfirstlane(tid >> 6); unsigned char* ws = a.ws; asm volatile("" : "+s"(ws));
    const int* ROWMAP = (const int*)(ws + WS_ROWMAP); const bf16_t* HX = (const bf16_t*)(ws + WS_HX); bf16_t* XG = (bf16_t*)(ws + WS_XG);
    const int per = with_ctx ? SLOTS : NB * CAPX; const int gw = vcu * NWAVES + wave, NGW = G * NWAVES;
    for (int it = gw; it < NE * per; it += NGW) { const int e = it / per, s = it % per; const int slot = e * SLOTS + s; const int src = ROWMAP[slot];
        const u32x4* sp = (const u32x4*)(HX + (size_t)src * D) + 2 * lane; u32x4* dp = (u32x4*)(XG + (size_t)slot * D) + 2 * lane;
        const u32x4 v0 = sp[0], v1 = sp[1]; dp[0] = v0; dp[1] = v1; }
}
__device__ __forceinline__ void phase_combine(const Args& a, int vcu, int G, int l, bool with_ctx, bool final_norm, bool next_norm) {
    int tid_ = threadIdx.x; asm volatile("" : "+v"(tid_));
    const int tid = tid_, lane = tid & 63, wave = __builtin_amdgcn_readfirstlane(tid >> 6); unsigned char* ws = a.ws; asm volatile("" : "+s"(ws));
    const int* INV = (const int*)(ws + WS_INV); const bf16_t* OB = (const bf16_t*)(ws + WS_XG); const float* MOD = (const float*)(ws + WS_MOD) + (size_t)l * 9 * 6144;
    const float* MODN = (const float*)(ws + WS_MOD) + (size_t)(l + 1) * 9 * 6144; const float* gainn = a.in[I_N1G] + (l + 1) * D; bf16_t* HX = (bf16_t*)(ws + WS_HX);
    bf16_t* XB = (bf16_t*)(ws + WS_XB); const float* fng = a.in[I_FNG];
    const int nrows = with_ctx ? TT : TX; const int gw = vcu * NWAVES + wave, NGW = G * NWAVES;
    const float pz = (final_norm && __hip_atomic_load((unsigned*)(ws + WS_CTL) + 12288, __ATOMIC_RELAXED, __HIP_MEMORY_SCOPE_AGENT) != 0u) ? __builtin_nanf("") : 0.f;
    for (int rowa = gw; rowa < nrows; rowa += 2 * NGW) {
        int myinv[2]; f32x4 xv[2][4]; f32x4 acc[2][4];
#pragma unroll
        for (int u = 0; u < 2; ++u) { const int row = rowa + u * NGW; const bool ok = row < nrows; const int rr = ok ? row : rowa;
            myinv[u] = (lane < 16 && ok) ? INV[(size_t)rr * 16 + lane] : -1;
            const bf16_t* xr = XB + (size_t)rr * D;
#pragma unroll
            for (int j = 0; j < 4; ++j) { const u32x2 w = *(const u32x2*)(xr + 256 * j + 4 * lane); xv[u][j] = (f32x4){bflo(w.x), bfhi(w.x), bflo(w.y), bfhi(w.y)}; acc[u][j] = (f32x4){0.f, 0.f, 0.f, 0.f}; } }
#pragma unroll
        for (int u = 0; u < 2; ++u) {
            unsigned long long mask = __ballot(myinv[u] >= 0) & 0xffffull;
            while (mask) { int sl[4];
#pragma unroll
                for (int q = 0; q < 4; ++q) { if (mask) { const int e = __builtin_ctzll(mask); mask &= mask - 1; sl[q] = __shfl(myinv[u], e); } else sl[q] = -1; }
                u32x2 w[4][4];
#pragma unroll
                for (int q = 0; q < 4; ++q) { const bf16_t* orow = OB + (size_t)(sl[q] >= 0 ? sl[q] : 0) * D;
#pragma unroll
                    for (int j = 0; j < 4; ++j) w[q][j] = *(const u32x2*)(orow + 256 * j + 4 * lane); }
#pragma unroll
                for (int q = 0; q < 4; ++q) { const float m = (sl[q] >= 0) ? 1.0f : 0.0f;
#pragma unroll
                    for (int j = 0; j < 4; ++j) { acc[u][j][0] += m * bflo(w[q][j].x); acc[u][j][1] += m * bfhi(w[q][j].x); acc[u][j][2] += m * bflo(w[q][j].y); acc[u][j][3] += m * bfhi(w[q][j].y); } } } }
#pragma unroll
        for (int u = 0; u < 2; ++u) { const int row = rowa + u * NGW; if (row < nrows) {
            const bool lat = row < TX; float* xr = a.out + (size_t)row * D; bf16_t* xbr = XB + (size_t)row * D; const int mrow = lat ? (row >> 12) : 8;
            const float* gp = MOD + mrow * 6144 + 5 * 1024; f32x4 v[4]; float ss = 0.f;
#pragma unroll
            for (int j = 0; j < 4; ++j) { const f32x4 g = *(const f32x4*)(gp + 256 * j + 4 * lane); v[j] = xv[u][j] + g * acc[u][j];
                ss += (v[j][0] * v[j][0] + v[j][1] * v[j][1]) + (v[j][2] * v[j][2] + v[j][3] * v[j][3]); }
            if (final_norm) { const float rstd = 1.0f / sqrtf(wave_sum(ss) * (1.0f / D) + 1e-6f);
#pragma unroll
                for (int j = 0; j < 4; ++j) { const f32x4 g = *(const f32x4*)(fng + 256 * j + 4 * lane); *(f32x4*)(xr + 256 * j + 4 * lane) = v[j] * rstd * g + pz; } }
            else {
#pragma unroll
                for (int j = 0; j < 4; ++j) { u32x2 o; o.x = pk2(v[j][0], v[j][1]); o.y = pk2(v[j][2], v[j][3]); *(u32x2*)(xbr + 256 * j + 4 * lane) = o; }
                if (next_norm) { const float rstd = 1.0f / sqrtf(wave_sum(ss) * (1.0f / D) + 1e-6f); const float* shp = MODN + mrow * 6144; const float* scp = shp + 1024;
#pragma unroll
                    for (int j = 0; j < 4; ++j) { const f32x4 gg = *(const f32x4*)(gainn + 256 * j + 4 * lane), sh = *(const f32x4*)(shp + 256 * j + 4 * lane), sc = *(const f32x4*)(scp + 256 * j + 4 * lane);
                        const f32x4 hv = (v[j] * rstd * gg) * (1.0f + sc) + sh; u32x2 o; o.x = pk2(hv[0], hv[1]); o.y = pk2(hv[2], hv[3]); *(u32x2*)(HX + (size_t)row * D + 256 * j + 4 * lane) = o; } } } } }
    }
}

#define XBAR() do { xcd_barrier(bar); if (AMP_PHASE == 99) xcd_barrier(bar); } while (0)

__global__ void __launch_bounds__(NTHR, 2) fwd_kernel(Args a) {
    extern __shared__ __attribute__((aligned(16))) unsigned char lds[];
    cg::grid_group grid = cg::this_grid();
    const int G = gridDim.x, bx = blockIdx.x; const int vcu = (G % 8 == 0) ? (bx % 8) * (G / 8) + bx / 8 : bx;
    unsigned char* ws = a.ws;
    PG8_LAS unsigned char* glds = (PG8_LAS unsigned char*)lds;
    volatile LAS unsigned* bst = (volatile LAS unsigned*)((LAS unsigned char*)lds + LDS_BYTES - 16);
    if (threadIdx.x < 4) bst[threadIdx.x] = 0u;
    __syncthreads();
    XcdBarrier bar = xcd_barrier_post((unsigned*)(ws + WS_CTL), bst);
    { AMP_BEGIN(0) phase_prologue(a, lds, vcu, G); AMP_END(0) }
    grid.sync();
    for (int l = 0; l < 2; ++l) {
        const bool upd = (l == 0);
        asm volatile("" : "+s"(ws));
        const float* srcx = a.in[I_X]; const float* srcc = a.in[I_CTX];
        if (upd) {
            { AMP_BEGIN(1) phase_norm(a, lds, vcu, G, l, srcx, srcc, nullptr, a.in[I_N1G] + l * D, 0, TT, false); AMP_END(1) }
            { AMP_BEGIN(11) load_tw(a, (LAS unsigned char*)lds, threadIdx.x); for (int it = vcu; it < 1024; it += G) spectrum_item(a, (LAS unsigned char*)lds, it, threadIdx.x); AMP_END(11) }
            XBAR();
        }
        { AMP_BEGIN(2) pg8::Gemm g{(const pg8::bf16_t*)(ws + WS_HX), (const pg8::bf16_t*)(ws + WS_WIN_T) + (size_t)l * INW * D, TT, INW, D};
          pg8::GroupOrder S; S.init(1, TT / 256, INW / 256, 0, G, bx);
          { PG8_LAS float* rl = (PG8_LAS float*)(glds + 131072 + 20480); const float* rs = (const float*)(ws + WS_ROPE); int tx = threadIdx.x; asm volatile("" : "+v"(tx)); for (int i = tx; i < 2048; i += NTHR) rl[i] = rs[i]; __syncthreads(); }
          pg8::EpiIn E{(pg8::bf16_t*)(ws + WS_PX), (const PG8_LAS float*)(glds + 131072 + 20480), (pg8::bf16_t*)(ws + WS_UT), glds + 131072, 1.0f};
          pg8::gemm_phase<pg8::EpiIn, pg8::GroupOrder, true, true>(glds, g, S, E); AMP_END(2) }
        XBAR();
        { AMP_BEGIN(3) phase_mix1(a, lds, vcu, G, l); AMP_END(3) }
        XBAR();
        { AMP_BEGIN(4) pg8::Gemm g{(const pg8::bf16_t*)(ws + WS_Y), (const pg8::bf16_t*)(ws + WS_WOUT_T) + (size_t)l * D * D, TT, D, D};
          pg8::GroupOrder S; S.init(1, (upd ? TT : TX) / 256, D / 256, 0, G, bx);
          pg8::EpiOut E{a.in[I_X], a.in[I_CTX], (pg8::bf16_t*)(ws + WS_XB), (const float*)(ws + WS_MOD) + (size_t)l * 9 * 6144, upd ? 1 : 0};
          pg8::gemm_phase<pg8::EpiOut, pg8::GroupOrder, true, true>(glds, g, S, E); AMP_END(4) }
        XBAR();
        { AMP_BEGIN(5) phase_norm(a, lds, vcu, G, l, nullptr, nullptr, (const bf16_t*)(ws + WS_XB), a.in[I_N2G] + l * D, 3, upd ? TT : TX, true); AMP_END(5) }
        XBAR();
        { AMP_BEGIN(6) phase_select(a, lds, vcu, G, upd); AMP_END(6) }
        XBAR();
        { AMP_BEGIN(8) pg8::Gemm g{(const pg8::bf16_t*)(ws + WS_HX), (const pg8::bf16_t*)(ws + WS_WGU_T + (size_t)l * NE * 4096 * D), NE * SLOTS, NE * 4096, D};
          pg8::GroupOrder S; S.init(NE, upd ? 17 : 16, 16, 17, G, bx);
          { PG8_LAS float* sl = (PG8_LAS float*)(glds + 131072 + 17408); const float* ss = (const float*)(ws + WS_WSC) + l * 48; int tx = threadIdx.x; asm volatile("" : "+v"(tx)); if (tx < 32) sl[tx] = ss[tx]; __syncthreads(); }
          pg8::EpiGU E{(unsigned char*)(ws + WS_ACT), (const PG8_LAS float*)(glds + 131072 + 17408)};
          pg8::gemm_phase_gather<pg8::EpiGU, pg8::GroupOrder, true>(glds, g, (const int*)(ws + WS_ROWMAP), (PG8_LAS int*)(glds + 131072), S, E); AMP_END(8) }
        XBAR();
        { AMP_BEGIN(9) pg8::Gemm g{(const pg8::bf16_t*)(ws + WS_ACT), (const pg8::bf16_t*)(ws + WS_WD_T + (size_t)l * NE * D * FF), NE * SLOTS, NE * D, FF};
          pg8::GroupOrder S; S.init(NE, upd ? 17 : 16, 4, 17, G, bx);
          { PG8_LAS float* gl = (PG8_LAS float*)(glds + 131072); const float* gs = (const float*)(ws + WS_GATE); const float* ss = (const float*)(ws + WS_WSC) + l * 48 + 32; pg8::Unit uu; int tx = threadIdx.x; asm volatile("" : "+v"(tx));
            for (int i = 0; S.next(i, uu); ++i) if (tx < 256) gl[i * 256 + tx] = gs[uu.pm * 256 + tx] * ss[uu.pn >> 2];
            __syncthreads(); }
          pg8::EpiDown E{(pg8::bf16_t*)(ws + WS_XG), (const PG8_LAS float*)(glds + 131072)};
          pg8::gemm_phase<pg8::EpiDown, pg8::GroupOrder, true, true, true>(glds, g, S, E); AMP_END(9) }
        XBAR();
        { AMP_BEGIN(10) phase_combine(a, vcu, G, l, upd, !upd, upd); AMP_END(10) }
        if (upd) XBAR();
    }
}

extern "C" void kernel_launch(void* const* d_in, const int* in_sizes, int n_in, void* d_out, int out_size, void* d_ws, size_t ws_size, hipStream_t stream) {
    static int grid = 0;
    if (grid == 0) {
        int dev = 0, cus = 0, per_cu = 0;
        hipGetDevice(&dev); hipDeviceGetAttribute(&cus, hipDeviceAttributeMultiprocessorCount, dev);
        if (hipFuncSetAttribute((const void*)fwd_kernel, hipFuncAttributeMaxDynamicSharedMemorySize, LDS_BYTES) != hipSuccess) { fprintf(stderr, "kernel_launch: hipFuncSetAttribute failed\n"); grid = -1; return; }
        if (hipOccupancyMaxActiveBlocksPerMultiprocessor(&per_cu, (const void*)fwd_kernel, NTHR, LDS_BYTES) != hipSuccess || per_cu < 1) { fprintf(stderr, "kernel_launch: occupancy query failed (%d)\n", per_cu); grid = -1; return; }
        grid = cus * 1;
        if (n_in != N_IN || ws_size < WS_END) { fprintf(stderr, "kernel_launch: unexpected n_in %d / ws %zu\n", n_in, ws_size); grid = -1; return; }
    }
    if (grid < 0) return;
    if (hipMemsetAsync((char*)d_ws + WS_CTL, 0, 65536, stream) != hipSuccess) { fprintf(stderr, "kernel_launch: memset failed\n"); return; }
    Args a{};
    for (int i = 0; i < N_IN; ++i) a.in[i] = (const float*)d_in[i];
    a.out = (float*)d_out; a.ws = (unsigned char*)d_ws;
    void* args[] = {&a};
    hipError_t e = hipLaunchCooperativeKernel((const void*)fwd_kernel, dim3(grid), dim3(NTHR), args, LDS_BYTES, stream);
    if (e != hipSuccess) fprintf(stderr, "cooperative launch failed: %s (grid %d)\n", hipGetErrorString(e), grid);
}
```

```cpp
#define AMP_PHASE -1
#include <hip/hip_runtime.h>
#include <hip/hip_cooperative_groups.h>
#include <cstdio>
#include <cstdint>
#ifndef AMP_PHASE
#define AMP_PHASE -1
#endif
namespace cg = cooperative_groups;
namespace pg8 {
#define PG8_LAS __attribute__((address_space(3)))
typedef unsigned short bf16_t;
typedef short bf16x8 __attribute__((ext_vector_type(8)));
typedef float f32x4 __attribute__((ext_vector_type(4)));
typedef unsigned u32x4 __attribute__((ext_vector_type(4)));
typedef int v4i_t __attribute__((ext_vector_type(4)));
typedef int v8i_t __attribute__((ext_vector_type(8)));
constexpr int BM = 256, BK = 64, HALF = 128, HTB = HALF * BK * 2  , STAGE_BYTES = 8 * HTB, NXCD = 8, WGM = 8;

__host__ __device__ __forceinline__ int lds_byte(int r, int c) { const int st = (r >> 4) * 2 + (c >> 5), rr = r & 15, cc = c & 31, ob = rr * 64 + cc * 2; return st * 1024 + (ob ^ (((ob >> 9) & 1) << 5)); }
__host__ __device__ __forceinline__ void stage_rc(int b, int& R, int& C) { const int st = b / 1024, sb = b % 1024, swz = sb ^ (((sb >> 9) & 1) << 5); R = (st >> 1) * 16 + swz / 64; C = (st & 1) * 32 + (swz % 64) / 2; }
__host__ __device__ __forceinline__ int perm32(int rho) { const int n = rho >> 4, i = rho & 15; return 8 * (i >> 2) + 4 * n + (i & 3); }

struct Unit { int pm, pn; };
struct Gemm { const bf16_t* A; const bf16_t* Bt; int M, N, K; };

struct StaticOrder {
    int nM, nN, nwg, G, c;
    __host__ __device__ void init(int M, int N, int G_, int c_) { nM = M / BM; nN = N / BM; nwg = nM * nN; G = G_; c = c_; }
    __host__ __device__ bool next(int i, Unit& u) const {
        const long L = (long)i * G + c; if (L >= nwg) return false;
        int wgid = (int)L; { const int q = nwg / NXCD, r = nwg % NXCD, xcd = wgid % NXCD, off = wgid / NXCD; wgid = (xcd < r ? xcd * (q + 1) : r * (q + 1) + (xcd - r) * q) + off; }
        const int nig = WGM * nN, gid = wgid / nig, fm = gid * WGM, gsz = (nM - fm) < WGM ? (nM - fm) : WGM;
        u.pm = fm + ((wgid % nig) % gsz); u.pn = (wgid % nig) / gsz; return true;
    }
    __device__ __forceinline__ void a_ready(const Unit&) const {}
    __device__ __forceinline__ void done(const Unit&) const {}
};

__device__ __forceinline__ unsigned cvt_pk_bf16(float lo, float hi) { unsigned r; asm volatile("v_cvt_pk_bf16_f32 %0, %1, %2" : "=v"(r) : "v"(lo), "v"(hi)); return r; }
typedef float f32x2 __attribute__((ext_vector_type(2)));
__device__ __forceinline__ f32x2 gelu_pk(f32x2 v) {
    const f32x2 av = __builtin_elementwise_abs(v), d = av * 0.2316418882f + 1.0f;
    f32x2 t; t.x = __builtin_amdgcn_rcpf(d.x); t.y = __builtin_amdgcn_rcpf(d.y);
    f32x2 q = t * 0.5307027145f + (-0.7265760135f); q = q * t + 0.7107068705f; q = q * t + (-0.142248368f); q = q * t + 0.127414796f; q = q * t;
    const f32x2 s = (v * v) * (-0.72134752044f);
    f32x2 e; e.x = __builtin_amdgcn_exp2f(s.x); e.y = __builtin_amdgcn_exp2f(s.y);
    const f32x2 m = v * (q * e), r = v - m;
    f32x2 o; o.x = v.x < 0.f ? m.x : r.x; o.y = v.y < 0.f ? m.y : r.y; return o;
}


struct GroupOrder {
    int nMl, nNl, strideM, nper, nwg, G, c;
    __device__ __forceinline__ void init(int ng, int nMl_, int nNl_, int strideM_, int G_, int c_) { nMl = nMl_; nNl = nNl_; strideM = strideM_; nper = nMl_ * nNl_; nwg = ng * nper; G = G_; c = c_; }
    __device__ __forceinline__ bool next(int i, Unit& u) const {
        const long L = (long)i * G + c; if (L >= nwg) return false;
        int wgid = (int)L; { const int q = nwg / NXCD, r = nwg % NXCD, xcd = wgid % NXCD, off = wgid / NXCD; wgid = (xcd < r ? xcd * (q + 1) : r * (q + 1) + (xcd - r) * q) + off; }
        const int e = wgid / nper, id = wgid % nper;
        const int nig = WGM * nNl, gid = id / nig, fm = gid * WGM, gsz = (nMl - fm) < WGM ? (nMl - fm) : WGM;
        u.pm = e * strideM + fm + ((id % nig) % gsz); u.pn = e * nNl + (id % nig) / gsz; return true;
    }
    __device__ __forceinline__ void a_ready(const Unit&) const {}
    __device__ __forceinline__ void done(const Unit&) const {}
};

constexpr int TXR = 32768;
struct EpiIn {
    static constexpr bool PERM = true, AFTER_DRAIN = false;
    bf16_t* PX; const PG8_LAS float* rope; bf16_t* UT; PG8_LAS unsigned char* stgbase; float wsc;
    __device__ __forceinline__ void operator()(const f32x4 (&acc)[2][2][4][2], const Unit& u, int ui, int wr, int wc, int fr, int fq) const {
        const int row0 = u.pm * BM + wr * 64 + fr; const int col0 = u.pn * BM + wc * 32 + 8 * fq;
        const bool latent = u.pm < (TXR / BM);
        if (latent && u.pn < 3) {
            PG8_LAS unsigned char* stg = stgbase + (wr * 4 + wc) * 2304; const int lane = fq * 16 + fr;
            const int b = u.pm >> 4, trow0 = (u.pm & 15) * BM; const int col = lane >> 1, half = lane & 1;
#pragma unroll
            for (int ai = 0; ai < 2; ++ai)
#pragma unroll
                for (int bj = 0; bj < 2; ++bj)
#pragma unroll
                    for (int mh = 0; mh < 2; ++mh) {
#pragma unroll
                        for (int mm = 0; mm < 2; ++mm)
#pragma unroll
                            for (int n = 0; n < 2; ++n) { const f32x4 v = acc[ai][bj][2 * mh + mm][n] * wsc; const unsigned w0 = cvt_pk_bf16(v[0], v[1]), w1 = cvt_pk_bf16(v[2], v[3]);
                                PG8_LAS unsigned char* p = stg + (8 * fq + 4 * n) * 72 + (16 * mm + fr) * 2;
                                *(PG8_LAS unsigned short*)(p) = (unsigned short)w0; *(PG8_LAS unsigned short*)(p + 72) = (unsigned short)(w0 >> 16);
                                *(PG8_LAS unsigned short*)(p + 144) = (unsigned short)w1; *(PG8_LAS unsigned short*)(p + 216) = (unsigned short)(w1 >> 16); }
                        asm volatile("s_waitcnt lgkmcnt(0)" ::: "memory");
                        typedef unsigned u32x2v __attribute__((ext_vector_type(2)));
                        const PG8_LAS unsigned char* rp = stg + col * 72 + half * 32;
                        const u32x2v a0 = *(const PG8_LAS u32x2v*)(rp), a1 = *(const PG8_LAS u32x2v*)(rp + 8), a2 = *(const PG8_LAS u32x2v*)(rp + 16), a3 = *(const PG8_LAS u32x2v*)(rp + 24);
                        const int ch = u.pn * BM + bj * HALF + wc * 32 + col; const int t0 = trow0 + ai * HALF + wr * 64 + mh * 32 + half * 16;
                        u32x4* gp = (u32x4*)(UT + ((size_t)(b * 768 + ch)) * 4096 + t0);
                        gp[0] = (u32x4){a0.x, a0.y, a1.x, a1.y}; gp[1] = (u32x4){a2.x, a2.y, a3.x, a3.y};
                        asm volatile("s_waitcnt lgkmcnt(0)" ::: "memory"); }
            return;
        }
#pragma unroll
        for (int ai = 0; ai < 2; ++ai)
#pragma unroll
            for (int m = 0; m < 4; ++m) { const int row = row0 + ai * HALF + m * 16; bf16_t* rowp = PX + (size_t)row * 2304 + col0;
#pragma unroll
                for (int bj = 0; bj < 2; ++bj) { f32x4 v0 = acc[ai][bj][m][0] * wsc, v1 = acc[ai][bj][m][1] * wsc;
                    const bool dorope = latent && (u.pn == 4 || (u.pn == 6 && bj == 0));
                    if (dorope) {
                        const int t = row & 4095; const int pos = (wc & 1) ? (t & 63) : (t >> 6);
                        const PG8_LAS f32x4* rp = (const PG8_LAS f32x4*)(rope + (pos * 16 + 8 * (fq & 1)) * 2);
                        const f32x4 r0 = rp[0], r1 = rp[1], r2 = rp[2], r3 = rp[3];
                        f32x4 p0, p1;
#pragma unroll
                        for (int j = 0; j < 4; ++j) { p0[j] = __shfl_xor(v0[j], 32); p1[j] = __shfl_xor(v1[j], 32); }
                        const float c0[4] = {r0[0], r0[2], r1[0], r1[2]}, s0[4] = {r0[1], r0[3], r1[1], r1[3]};
                        const float c1[4] = {r2[0], r2[2], r3[0], r3[2]}, s1[4] = {r2[1], r2[3], r3[1], r3[3]};
                        const bool lo = fq < 2;
#pragma unroll
                        for (int j = 0; j < 4; ++j) {
                            v0[j] = lo ? (v0[j] * c0[j] - p0[j] * s0[j]) : (p0[j] * s0[j] + v0[j] * c0[j]);
                            v1[j] = lo ? (v1[j] * c1[j] - p1[j] * s1[j]) : (p1[j] * s1[j] + v1[j] * c1[j]); }
                    }
                    u32x4 w; w.x = cvt_pk_bf16(v0[0], v0[1]); w.y = cvt_pk_bf16(v0[2], v0[3]); w.z = cvt_pk_bf16(v1[0], v1[1]); w.w = cvt_pk_bf16(v1[2], v1[3]);
                    *(u32x4*)(rowp + bj * HALF) = w; } }
    }
};
struct EpiOut {
    static constexpr bool PERM = true, AFTER_DRAIN = false;
    const float* xf_x; const float* xf_c; bf16_t* XB; const float* mod; int from_f32;
    __device__ __forceinline__ void operator()(const f32x4 (&acc)[2][2][4][2], const Unit& u, int ui, int wr, int wc, int fr, int fq) const {
        const int row0 = u.pm * BM + wr * 64 + fr, col0 = u.pn * BM + wc * 32 + 8 * fq;
        const bool latent = u.pm < (TXR / BM);
#pragma unroll
        for (int ai = 0; ai < 2; ++ai)
#pragma unroll
            for (int m = 0; m < 4; ++m) { const int row = row0 + ai * HALF + m * 16;
                const int mrow = latent ? (row >> 12) : 8; const float* gp = mod + mrow * 6144 + 2 * 1024 + col0;
                bf16_t* xb = XB + (size_t)row * 1024 + col0;
#pragma unroll
                for (int bj = 0; bj < 2; ++bj) { const f32x4 g0 = *(const f32x4*)(gp + bj * HALF), g1 = *(const f32x4*)(gp + bj * HALF + 4); f32x4 x0, x1;
                    if (from_f32) { const float* xo = (latent ? xf_x + (size_t)row * 1024 : xf_c + (size_t)(row - TXR) * 1024) + col0 + bj * HALF; x0 = *(const f32x4*)xo; x1 = *(const f32x4*)(xo + 4); }
                    else { const u32x4 w = *(const u32x4*)(xb + bj * HALF); x0 = (f32x4){__uint_as_float(w.x << 16), __uint_as_float(w.x & 0xffff0000u), __uint_as_float(w.y << 16), __uint_as_float(w.y & 0xffff0000u)};
                        x1 = (f32x4){__uint_as_float(w.z << 16), __uint_as_float(w.z & 0xffff0000u), __uint_as_float(w.w << 16), __uint_as_float(w.w & 0xffff0000u)}; }
                    const f32x4 v0 = x0 + g0 * acc[ai][bj][m][0], v1 = x1 + g1 * acc[ai][bj][m][1];
                    u32x4 o; o.x = cvt_pk_bf16(v0[0], v0[1]); o.y = cvt_pk_bf16(v0[2], v0[3]); o.z = cvt_pk_bf16(v1[0], v1[1]); o.w = cvt_pk_bf16(v1[2], v1[3]);
                    *(u32x4*)(xb + bj * HALF) = o; } }
    }
};
struct EpiGU {
    static constexpr bool PERM = true, AFTER_DRAIN = false;
    unsigned char* ACT; const PG8_LAS float* wsc;
    __device__ __forceinline__ void operator()(const f32x4 (&acc)[2][2][4][2], const Unit& u, int ui, int wr, int wc, int fr, int fq) const {
        const int row0 = u.pm * BM + wr * 64 + fr; const int col0 = (u.pn & 15) * 128 + wc * 32 + 8 * fq; const int e = u.pn >> 4; const float sg = wsc[e], su = wsc[16 + e]; const float nsl = -1.4426950408889634f * sg, sgu = sg * su;
#pragma unroll
        for (int ai = 0; ai < 2; ++ai)
#pragma unroll
            for (int m = 0; m < 4; ++m) { unsigned char* rowp = ACT + (size_t)(row0 + ai * HALF + m * 16) * 2048 + col0;
                float h[8];
#pragma unroll
                for (int n = 0; n < 2; ++n)
#pragma unroll
                    for (int j = 0; j < 4; ++j) { const float ag = acc[ai][0][m][n][j], au = acc[ai][1][m][n][j]; const float r = __builtin_amdgcn_rcpf(1.0f + __builtin_amdgcn_exp2f(ag * nsl)); h[4 * n + j] = __builtin_amdgcn_fmed3f((ag * au) * sgu * r, -448.0f, 448.0f); }
                int p0 = 0, p1 = 0;
                p0 = __builtin_amdgcn_cvt_pk_fp8_f32(h[0], h[1], p0, false); p0 = __builtin_amdgcn_cvt_pk_fp8_f32(h[2], h[3], p0, true);
                p1 = __builtin_amdgcn_cvt_pk_fp8_f32(h[4], h[5], p1, false); p1 = __builtin_amdgcn_cvt_pk_fp8_f32(h[6], h[7], p1, true);
                typedef int i32x2v __attribute__((ext_vector_type(2)));
                *(i32x2v*)rowp = (i32x2v){p0, p1}; }
    }
};
struct EpiDown {
    static constexpr bool PERM = true, AFTER_DRAIN = false;
    bf16_t* OB; const PG8_LAS float* gl;
    __device__ __forceinline__ void operator()(const f32x4 (&acc)[2][2][4][2], const Unit& u, int ui, int wr, int wc, int fr, int fq) const {
        const int row0 = u.pm * BM + wr * 64 + fr; const int col0 = (u.pn & 3) * BM + wc * 32 + 8 * fq;
#pragma unroll
        for (int ai = 0; ai < 2; ++ai)
#pragma unroll
            for (int m = 0; m < 4; ++m) { const int row = row0 + ai * HALF + m * 16; const float g = gl[ui * BM + ai * HALF + wr * 64 + m * 16 + fr]; bf16_t* rowp = OB + (size_t)row * 1024 + col0;
#pragma unroll
                for (int bj = 0; bj < 2; ++bj) { const f32x4 v0 = acc[ai][bj][m][0] * g, v1 = acc[ai][bj][m][1] * g;
                    u32x4 w; w.x = cvt_pk_bf16(v0[0], v0[1]); w.y = cvt_pk_bf16(v0[2], v0[3]); w.z = cvt_pk_bf16(v1[0], v1[1]); w.w = cvt_pk_bf16(v1[2], v1[3]);
                    *(u32x4*)(rowp + bj * HALF) = w; } }
    }
};

template <class Epi, class Sched, bool ALIGN_EPI = false, bool SP2 = false, bool FP8 = false>
__device__ __forceinline__ void gemm_phase(PG8_LAS unsigned char* lds, const Gemm g, const Sched& S, const Epi& E) {
    int tid_ = threadIdx.x; asm volatile("" : "+v"(tid_));
    const int tid = tid_, wid = __builtin_amdgcn_readfirstlane(tid >> 6), lane = tid & 63, wr = wid >> 2, wc = wid & 3, fr = lane & 15, fq = lane >> 4;
    const int K = g.K, KB = FP8 ? K : 2 * K  , nt = KB / (BK * 2);
    unsigned voffA[2], voffB[2];
#pragma unroll
    for (int i = 0; i < 2; ++i) { int R, C; stage_rc(tid * 16 + i * 8192, R, C); const int Rb = Epi::PERM ? ((R & ~31) + perm32(R & 31)) : R;
        voffA[i] = (unsigned)(R * KB + C * 2); voffB[i] = (unsigned)(Rb * KB + C * 2); }
    const size_t kstep = (size_t)(BK * 2);
    const size_t hstep = (size_t)HALF * KB;
    const size_t tstep = 2 * hstep;
    const unsigned ldsw = (unsigned)wid * 1024u;
    const int aoff = lds_byte(wr * 64 + fr, fq * 8), boff = lds_byte(wc * 32 + fr, fq * 8);
#define PG8_SA(b, h) (((b) * 2 + (h)) * HTB)
#define PG8_SB(b, h) ((4 + (b) * 2 + (h)) * HTB)
#define PG8_STAGE(bufoff, gbase, voff) do { _Pragma("unroll") for (int _i = 0; _i < 2; ++_i) \
        __builtin_amdgcn_global_load_lds((const unsigned*)((const char*)(gbase) + (voff)[_i]), (PG8_LAS unsigned*)(lds + (bufoff) + ldsw + _i * 8192), 16, 0, 0); } while (0)
#define PG8_LDA(dst, b, h) do { _Pragma("unroll") for (int m = 0; m < 4; ++m) { if constexpr (FP8) { dst##8[m].lo = *(const PG8_LAS v4i_t*)(lds + PG8_SA(b, h) + aoff + m * 2048); dst##8[m].hi = *(const PG8_LAS v4i_t*)(lds + PG8_SA(b, h) + aoff + m * 2048 + 1024); } \
        else { _Pragma("unroll") for (int k = 0; k < 2; ++k) dst[m][k] = *(const PG8_LAS bf16x8*)(lds + PG8_SA(b, h) + aoff + m * 2048 + k * 1024); } } } while (0)
#define PG8_LDB(dst, b, h) do { _Pragma("unroll") for (int n = 0; n < 2; ++n) { if constexpr (FP8) { dst##8[n].lo = *(const PG8_LAS v4i_t*)(lds + PG8_SB(b, h) + boff + n * 2048); dst##8[n].hi = *(const PG8_LAS v4i_t*)(lds + PG8_SB(b, h) + boff + n * 2048 + 1024); } \
        else { _Pragma("unroll") for (int k = 0; k < 2; ++k) dst[n][k] = *(const PG8_LAS bf16x8*)(lds + PG8_SB(b, h) + boff + n * 2048 + k * 1024); } } } while (0)
#define PG8_CAT8(x0, x1) __builtin_shufflevector(__builtin_bit_cast(v4i_t, x0), __builtin_bit_cast(v4i_t, x1), 0, 1, 2, 3, 4, 5, 6, 7)
#define PG8_MMA(ai, bj, At, Bt) do { __builtin_amdgcn_s_setprio(1); if constexpr (FP8) asm volatile("s_nop 1" ::: "memory"); _Pragma("unroll") for (int m = 0; m < 4; ++m) _Pragma("unroll") for (int n = 0; n < 2; ++n) { \
        if constexpr (FP8) asm volatile("v_mfma_scale_f32_16x16x128_f8f6f4 %0, %1, %2, %0, %3, %3 op_sel_hi:[0,0,0]" : "+v"(acc[ai][bj][m][n]) : "v"(Bt##8[n]), "v"(At##8[m]), "v"(one_scale)); \
        else { _Pragma("unroll") for (int k = 0; k < 2; ++k) acc[ai][bj][m][n] = __builtin_amdgcn_mfma_f32_16x16x32_bf16(Bt[n][k], At[m][k], acc[ai][bj][m][n], 0, 0, 0); } } if constexpr (FP8) asm volatile("s_nop 15\n\ts_nop 3" ::: "memory"); __builtin_amdgcn_s_setprio(0); } while (0)
#define PG8_WAIT_V(n) asm volatile("s_waitcnt vmcnt(" #n ")" ::: "memory")
#define PG8_WAIT_L(n) asm volatile("s_waitcnt lgkmcnt(" #n ")" ::: "memory")
#define PG8_BAR __builtin_amdgcn_s_barrier()
#define PG8_SCHED __builtin_amdgcn_sched_barrier(0)
    Unit cur, nxt; int ui = 0;
    if (!S.next(0, cur)) return;
    f32x4 acc[2][2][4][2];
#pragma unroll
    for (int a = 0; a < 2; ++a)
#pragma unroll
        for (int b = 0; b < 2; ++b)
#pragma unroll
            for (int m = 0; m < 4; ++m)
#pragma unroll
                for (int n = 0; n < 2; ++n) acc[a][b][m][n] = (f32x4){0.f, 0.f, 0.f, 0.f};
    bf16x8 At[4][2], B0[2][2], B1[2][2];
    v8i_t At8[4], B08[2], B18[2];
    int one_scale = 0x7f7f7f7f; asm volatile("" : "+v"(one_scale));
    const char* cA = (const char*)g.A + (size_t)cur.pm * tstep; const char* cB = (const char*)g.Bt + (size_t)cur.pn * tstep;
    S.a_ready(cur);
    if constexpr (SP2) {
        PG8_STAGE(PG8_SB(0, 0), cB, voffB); PG8_STAGE(PG8_SB(0, 1), cB + hstep, voffB); PG8_STAGE(PG8_SA(0, 0), cA, voffA); PG8_STAGE(PG8_SA(0, 1), cA + hstep, voffA);
        if (wr == 1) PG8_BAR;
        PG8_WAIT_V(2); PG8_BAR;
        PG8_STAGE(PG8_SB(1, 0), cB + kstep, voffB); PG8_STAGE(PG8_SA(1, 0), cA + kstep, voffA); PG8_STAGE(PG8_SB(1, 1), cB + hstep + kstep, voffB);
        PG8_WAIT_V(6); PG8_BAR;
    } else {
        PG8_STAGE(PG8_SB(0, 0), cB, voffB); PG8_STAGE(PG8_SA(0, 0), cA, voffA); PG8_STAGE(PG8_SB(0, 1), cB + hstep, voffB); PG8_STAGE(PG8_SA(0, 1), cA + hstep, voffA);
        if (wr == 1) PG8_BAR;
        PG8_WAIT_V(4); PG8_BAR;
        PG8_STAGE(PG8_SB(1, 0), cB + kstep, voffB); PG8_STAGE(PG8_SA(1, 0), cA + kstep, voffA); PG8_STAGE(PG8_SB(1, 1), cB + hstep + kstep, voffB);
        PG8_WAIT_V(6); PG8_BAR;
    }
    for (;;) {
        const bool has_next = S.next(ui + 1, nxt);
        const char* nA = has_next ? (const char*)g.A + (size_t)nxt.pm * tstep : cA; const char* nB = has_next ? (const char*)g.Bt + (size_t)nxt.pn * tstep : cB;
#pragma nounroll
        for (int t = 0; t < nt; t += 2) {
            const bool last = (t == nt - 2);
            const char* a1 = cA + (size_t)(t + 1) * kstep;
            const char* a2 = last ? nA : cA + (size_t)(t + 2) * kstep; const char* b2 = last ? nB : cB + (size_t)(t + 2) * kstep;
            const char* a3 = a2 + kstep; const char* b3 = b2 + kstep;
            if (last && has_next) S.a_ready(nxt);
            if constexpr (SP2) {
            PG8_LDB(B0, 0, 0); PG8_LDB(B1, 0, 1); PG8_SCHED; PG8_LDA(At, 0, 0); PG8_STAGE(PG8_SA(1, 1), a1 + hstep, voffA);
            PG8_WAIT_V(8); PG8_WAIT_L(0); PG8_BAR; PG8_MMA(0, 0, At, B0); PG8_MMA(0, 1, At, B1); PG8_BAR; PG8_SCHED;
            PG8_LDA(At, 0, 1); PG8_STAGE(PG8_SB(0, 0), b2, voffB); PG8_STAGE(PG8_SB(0, 1), b2 + hstep, voffB); PG8_STAGE(PG8_SA(0, 0), a2, voffA);
            PG8_WAIT_V(8); PG8_WAIT_L(0); PG8_BAR; PG8_MMA(1, 0, At, B0); PG8_MMA(1, 1, At, B1); PG8_BAR; PG8_SCHED;
            PG8_LDB(B0, 1, 0); PG8_LDB(B1, 1, 1); PG8_SCHED; PG8_LDA(At, 1, 0); PG8_STAGE(PG8_SA(0, 1), a2 + hstep, voffA);
            PG8_WAIT_V(8); PG8_WAIT_L(0); PG8_BAR; PG8_MMA(0, 0, At, B0); PG8_MMA(0, 1, At, B1); PG8_BAR; PG8_SCHED;
            PG8_LDA(At, 1, 1); PG8_STAGE(PG8_SB(1, 0), b3, voffB); PG8_STAGE(PG8_SB(1, 1), b3 + hstep, voffB); PG8_STAGE(PG8_SA(1, 0), a3, voffA);
            PG8_WAIT_V(8); PG8_WAIT_L(0); PG8_BAR; PG8_MMA(1, 0, At, B0); PG8_MMA(1, 1, At, B1); PG8_BAR; PG8_SCHED;
            } else {
            PG8_LDB(B0, 0, 0); PG8_SCHED; PG8_LDA(At, 0, 0); PG8_STAGE(PG8_SA(1, 1), a1 + hstep, voffA);
            PG8_WAIT_L(8); PG8_BAR; PG8_WAIT_L(0); PG8_MMA(0, 0, At, B0); PG8_BAR; PG8_SCHED;
            PG8_LDB(B1, 0, 1); PG8_STAGE(PG8_SB(0, 0), b2, voffB);
            PG8_BAR; PG8_WAIT_L(0); PG8_MMA(0, 1, At, B1); PG8_BAR;
            PG8_LDA(At, 0, 1); PG8_STAGE(PG8_SA(0, 0), a2, voffA);
            PG8_BAR; PG8_WAIT_L(0); PG8_MMA(1, 0, At, B0); PG8_BAR; PG8_SCHED;
            PG8_STAGE(PG8_SB(0, 1), b2 + hstep, voffB);
            PG8_WAIT_V(6); PG8_BAR; PG8_MMA(1, 1, At, B1); PG8_BAR;
            PG8_LDB(B0, 1, 0); PG8_SCHED; PG8_LDA(At, 1, 0); PG8_STAGE(PG8_SA(0, 1), a2 + hstep, voffA);
            PG8_WAIT_L(8); PG8_BAR; PG8_WAIT_L(0); PG8_MMA(0, 0, At, B0); PG8_BAR; PG8_SCHED;
            PG8_LDB(B1, 1, 1); PG8_STAGE(PG8_SB(1, 0), b3, voffB);
            PG8_BAR; PG8_WAIT_L(0); PG8_MMA(0, 1, At, B1); PG8_BAR;
            PG8_LDA(At, 1, 1); PG8_STAGE(PG8_SA(1, 0), a3, voffA);
            PG8_BAR; PG8_WAIT_L(0); PG8_MMA(1, 0, At, B0); PG8_BAR; PG8_SCHED;
            PG8_STAGE(PG8_SB(1, 1), b3 + hstep, voffB);
            PG8_WAIT_V(6); PG8_BAR; PG8_MMA(1, 1, At, B1); PG8_BAR;
            }
        }
        if constexpr (ALIGN_EPI) { if (wr == 0) PG8_BAR; }
        if constexpr (!Epi::AFTER_DRAIN) { E(acc, cur, ui, wr, wc, fr, fq); S.done(cur); }
        if (!has_next) break;
#pragma unroll
        for (int a = 0; a < 2; ++a)
#pragma unroll
            for (int b = 0; b < 2; ++b)
#pragma unroll
                for (int m = 0; m < 4; ++m)
#pragma unroll
                    for (int n = 0; n < 2; ++n) acc[a][b][m][n] = (f32x4){0.f, 0.f, 0.f, 0.f};
        cur = nxt; cA = nA; cB = nB; ++ui;
        if constexpr (ALIGN_EPI) { if (wr == 1) PG8_BAR; }
    }
    PG8_WAIT_V(0);
    if constexpr (!ALIGN_EPI) { if (wr == 0) PG8_BAR; }
    PG8_BAR;
    if constexpr (Epi::AFTER_DRAIN) { E.fused(acc, cur, wr, wc, fr, fq, lds, wid, lane); S.done(cur); }
#undef PG8_SA
#undef PG8_SB
#undef PG8_STAGE
#undef PG8_LDA
#undef PG8_LDB
#undef PG8_MMA
#undef PG8_CAT8
#undef PG8_WAIT_V
#undef PG8_WAIT_L
#undef PG8_BAR
#undef PG8_SCHED
}
template <class Epi, class Sched, bool FP8 = false>
__device__ __forceinline__ void gemm_phase_gather(PG8_LAS unsigned char* lds, const Gemm g, const int* rowmap, PG8_LAS int* idxs, const Sched& S, const Epi& E) {
    constexpr bool ALIGN_EPI = true, SP2 = true;
    int tid_ = threadIdx.x; asm volatile("" : "+v"(tid_));
    const int tid = tid_, wid = __builtin_amdgcn_readfirstlane(tid >> 6), lane = tid & 63, wr = wid >> 2, wc = wid & 3, fr = lane & 15, fq = lane >> 4;
    const int K = g.K, KB = FP8 ? K : 2 * K  , nt = KB / (BK * 2);
    unsigned voffB[2]; int RA[2], CA[2];
#pragma unroll
    for (int i = 0; i < 2; ++i) { int R, C; stage_rc(tid * 16 + i * 8192, R, C); const int Rb = Epi::PERM ? ((R & ~31) + perm32(R & 31)) : R;
        RA[i] = R; CA[i] = C * 2; voffB[i] = (unsigned)(Rb * KB + C * 2); }
    const size_t kstep = (size_t)(BK * 2);
    const size_t hstep = (size_t)HALF * KB;
    const size_t tstep = 2 * hstep;
    const unsigned ldsw = (unsigned)wid * 1024u;
    const int aoff = lds_byte(wr * 64 + fr, fq * 8), boff = lds_byte(wc * 32 + fr, fq * 8);
#define PG8_SA(b, h) (((b) * 2 + (h)) * HTB)
#define PG8_SB(b, h) ((4 + (b) * 2 + (h)) * HTB)
#define PG8_STAGE(bufoff, gbase, voff) do { _Pragma("unroll") for (int _i = 0; _i < 2; ++_i) \
        __builtin_amdgcn_global_load_lds((const unsigned*)((const char*)(gbase) + (voff)[_i]), (PG8_LAS unsigned*)(lds + (bufoff) + ldsw + _i * 8192), 16, 0, 0); } while (0)
#define PG8_STAGE_AG(bufoff, P, h, koff) do { _Pragma("unroll") for (int _i = 0; _i < 2; ++_i) \
        __builtin_amdgcn_global_load_lds((const unsigned*)((const char*)g.A + (size_t)((P)[h][_i] + (unsigned)(koff))), (PG8_LAS unsigned*)(lds + (bufoff) + ldsw + _i * 8192), 16, 0, 0); } while (0)
#define PG8_ROWPTR(P, u) do { _Pragma("unroll") for (int _h = 0; _h < 2; ++_h) _Pragma("unroll") for (int _i = 0; _i < 2; ++_i) \
        (P)[_h][_i] = (unsigned)idxs[(u) * BM + _h * HALF + RA[_i]] * (unsigned)KB + (unsigned)CA[_i]; } while (0)
#define PG8_LDA(dst, b, h) do { _Pragma("unroll") for (int m = 0; m < 4; ++m) { if constexpr (FP8) { dst##8[m].lo = *(const PG8_LAS v4i_t*)(lds + PG8_SA(b, h) + aoff + m * 2048); dst##8[m].hi = *(const PG8_LAS v4i_t*)(lds + PG8_SA(b, h) + aoff + m * 2048 + 1024); } \
        else { _Pragma("unroll") for (int k = 0; k < 2; ++k) dst[m][k] = *(const PG8_LAS bf16x8*)(lds + PG8_SA(b, h) + aoff + m * 2048 + k * 1024); } } } while (0)
#define PG8_LDB(dst, b, h) do { _Pragma("unroll") for (int n = 0; n < 2; ++n) { if constexpr (FP8) { dst##8[n].lo = *(const PG8_LAS v4i_t*)(lds + PG8_SB(b, h) + boff + n * 2048); dst##8[n].hi = *(const PG8_LAS v4i_t*)(lds + PG8_SB(b, h) + boff + n * 2048 + 1024); } \
        else { _Pragma("unroll") for (int k = 0; k < 2; ++k) dst[n][k] = *(const PG8_LAS bf16x8*)(lds + PG8_SB(b, h) + boff + n * 2048 + k * 1024); } } } while (0)
#define PG8_CAT8(x0, x1) __builtin_shufflevector(__builtin_bit_cast(v4i_t, x0), __builtin_bit_cast(v4i_t, x1), 0, 1, 2, 3, 4, 5, 6, 7)
#define PG8_MMA(ai, bj, At, Bt) do { __builtin_amdgcn_s_setprio(1); if constexpr (FP8) asm volatile("s_nop 1" ::: "memory"); _Pragma("unroll") for (int m = 0; m < 4; ++m) _Pragma("unroll") for (int n = 0; n < 2; ++n) { \
        if constexpr (FP8) asm volatile("v_mfma_scale_f32_16x16x128_f8f6f4 %0, %1, %2, %0, %3, %3 op_sel_hi:[0,0,0]" : "+v"(acc[ai][bj][m][n]) : "v"(Bt##8[n]), "v"(At##8[m]), "v"(one_scale)); \
        else { _Pragma("unroll") for (int k = 0; k < 2; ++k) acc[ai][bj][m][n] = __builtin_amdgcn_mfma_f32_16x16x32_bf16(Bt[n][k], At[m][k], acc[ai][bj][m][n], 0, 0, 0); } } if constexpr (FP8) asm volatile("s_nop 15\n\ts_nop 3" ::: "memory"); __builtin_amdgcn_s_setprio(0); } while (0)
#define PG8_WAIT_V(n) asm volatile("s_waitcnt vmcnt(" #n ")" ::: "memory")
#define PG8_WAIT_L(n) asm volatile("s_waitcnt lgkmcnt(" #n ")" ::: "memory")
#define PG8_BAR __builtin_amdgcn_s_barrier()
#define PG8_SCHED __builtin_amdgcn_sched_barrier(0)
    Unit cur, nxt; int ui = 0;
    if (!S.next(0, cur)) return;
    f32x4 acc[2][2][4][2];
#pragma unroll
    for (int a = 0; a < 2; ++a)
#pragma unroll
        for (int b = 0; b < 2; ++b)
#pragma unroll
            for (int m = 0; m < 4; ++m)
#pragma unroll
                for (int n = 0; n < 2; ++n) acc[a][b][m][n] = (f32x4){0.f, 0.f, 0.f, 0.f};
    bf16x8 At[4][2], B0[2][2], B1[2][2];
    v8i_t At8[4], B08[2], B18[2];
    int one_scale = 0x7f7f7f7f; asm volatile("" : "+v"(one_scale));
    const char* cB = (const char*)g.Bt + (size_t)cur.pn * tstep;
    unsigned cP[2][2], nP[2][2];
    { Unit uu; for (int i = 0; S.next(i, uu); ++i) if (tid < BM) idxs[i * BM + tid] = rowmap[uu.pm * BM + tid]; }
    asm volatile("s_waitcnt vmcnt(0) lgkmcnt(0)" ::: "memory"); __builtin_amdgcn_s_barrier(); asm volatile("" ::: "memory");
    PG8_ROWPTR(cP, 0);
    S.a_ready(cur);
    if constexpr (SP2) {
        PG8_STAGE(PG8_SB(0, 0), cB, voffB); PG8_STAGE(PG8_SB(0, 1), cB + hstep, voffB); PG8_STAGE_AG(PG8_SA(0, 0), cP, 0, 0); PG8_STAGE_AG(PG8_SA(0, 1), cP, 1, 0);
        if (wr == 1) PG8_BAR;
        PG8_WAIT_V(2); PG8_BAR;
        PG8_STAGE(PG8_SB(1, 0), cB + kstep, voffB); PG8_STAGE_AG(PG8_SA(1, 0), cP, 0, kstep); PG8_STAGE(PG8_SB(1, 1), cB + hstep + kstep, voffB);
        PG8_WAIT_V(6); PG8_BAR;
    }
    for (;;) {
        const bool has_next = S.next(ui + 1, nxt);
        const char* nB = has_next ? (const char*)g.Bt + (size_t)nxt.pn * tstep : cB;
        if (has_next) { PG8_ROWPTR(nP, ui + 1); } else { _Pragma("unroll") for (int _h = 0; _h < 2; ++_h) _Pragma("unroll") for (int _i = 0; _i < 2; ++_i) nP[_h][_i] = cP[_h][_i]; }
#pragma nounroll
        for (int t = 0; t < nt; t += 2) {
            const bool last = (t == nt - 2);
            const size_t k1 = (size_t)(t + 1) * kstep, k2 = last ? 0 : (size_t)(t + 2) * kstep, k3 = k2 + kstep;
            unsigned sP[2][2];
            _Pragma("unroll") for (int _h = 0; _h < 2; ++_h) _Pragma("unroll") for (int _i = 0; _i < 2; ++_i) sP[_h][_i] = last ? nP[_h][_i] : cP[_h][_i];
            const char* b2 = last ? nB : cB + (size_t)(t + 2) * kstep; const char* b3 = b2 + kstep;
            if (last && has_next) S.a_ready(nxt);
            if constexpr (SP2) {
            PG8_LDB(B0, 0, 0); PG8_LDB(B1, 0, 1); PG8_SCHED; PG8_LDA(At, 0, 0); PG8_STAGE_AG(PG8_SA(1, 1), cP, 1, k1);
            PG8_WAIT_V(8); PG8_WAIT_L(0); PG8_BAR; PG8_MMA(0, 0, At, B0); PG8_MMA(0, 1, At, B1); PG8_BAR; PG8_SCHED;
            PG8_LDA(At, 0, 1); PG8_STAGE(PG8_SB(0, 0), b2, voffB); PG8_STAGE(PG8_SB(0, 1), b2 + hstep, voffB); PG8_STAGE_AG(PG8_SA(0, 0), sP, 0, k2);
            PG8_WAIT_V(8); PG8_WAIT_L(0); PG8_BAR; PG8_MMA(1, 0, At, B0); PG8_MMA(1, 1, At, B1); PG8_BAR; PG8_SCHED;
            PG8_LDB(B0, 1, 0); PG8_LDB(B1, 1, 1); PG8_SCHED; PG8_LDA(At, 1, 0); PG8_STAGE_AG(PG8_SA(0, 1), sP, 1, k2);
            PG8_WAIT_V(8); PG8_WAIT_L(0); PG8_BAR; PG8_MMA(0, 0, At, B0); PG8_MMA(0, 1, At, B1); PG8_BAR; PG8_SCHED;
            PG8_LDA(At, 1, 1); PG8_STAGE(PG8_SB(1, 0), b3, voffB); PG8_STAGE(PG8_SB(1, 1), b3 + hstep, voffB); PG8_STAGE_AG(PG8_SA(1, 0), sP, 0, k3);
            PG8_WAIT_V(8); PG8_WAIT_L(0); PG8_BAR; PG8_MMA(1, 0, At, B0); PG8_MMA(1, 1, At, B1); PG8_BAR; PG8_SCHED;
            }
        }
        if constexpr (ALIGN_EPI) { if (wr == 0) PG8_BAR; }
        if constexpr (!Epi::AFTER_DRAIN) { E(acc, cur, ui, wr, wc, fr, fq); if (AMP_PHASE == 81) { asm volatile("" ::: "memory"); E(acc, cur, ui, wr, wc, fr, fq); } S.done(cur); }
        if (!has_next) break;
#pragma unroll
        for (int a = 0; a < 2; ++a)
#pragma unroll
            for (int b = 0; b < 2; ++b)
#pragma unroll
                for (int m = 0; m < 4; ++m)
#pragma unroll
                    for (int n = 0; n < 2; ++n) acc[a][b][m][n] = (f32x4){0.f, 0.f, 0.f, 0.f};
        cur = nxt; cB = nB; ++ui;
        _Pragma("unroll") for (int _h = 0; _h < 2; ++_h) _Pragma("unroll") for (int _i = 0; _i < 2; ++_i) cP[_h][_i] = nP[_h][_i];
        if constexpr (ALIGN_EPI) { if (wr == 1) PG8_BAR; }
    }
    PG8_WAIT_V(0);
    if constexpr (!ALIGN_EPI) { if (wr == 0) PG8_BAR; }
    PG8_BAR;
    if constexpr (Epi::AFTER_DRAIN) { E.fused(acc, cur, wr, wc, fr, fq, lds, wid, lane); S.done(cur); }
#undef PG8_SA
#undef PG8_SB
#undef PG8_STAGE
#undef PG8_STAGE_AG
#undef PG8_ROWPTR
#undef PG8_LDA
#undef PG8_LDB
#undef PG8_MMA
#undef PG8_CAT8
#undef PG8_WAIT_V
#undef PG8_WAIT_L
#undef PG8_BAR
#undef PG8_SCHED
}

}

#define LAS __attribute__((address_space(3)))
typedef unsigned short bf16_t;
typedef float f32x4 __attribute__((ext_vector_type(4)));
typedef unsigned u32x4 __attribute__((ext_vector_type(4)));
typedef unsigned u32x2 __attribute__((ext_vector_type(2)));
typedef __bf16 bf16x2_t __attribute__((ext_vector_type(2)));
constexpr int NWAVES = 8, NTHR = 512;
constexpr int D = 1024, NB = 8, SEQ = 4096, LCTX = 256, TX = NB * SEQ, TC = NB * LCTX, TT = TX + TC, INW = 2304, NE = 16, FF = 2048;
constexpr int CAPX = 512, CAPC = 32, SLOTS = NB * CAPX + NB * CAPC;
constexpr float LOG2E = 1.4426950408889634f;
constexpr int LDS_BYTES = 163840;
enum { I_X = 0, I_C, I_CTX, I_CCTX, I_ADAW, I_ADAB, I_N1G, I_N2G, I_WIN, I_HCW, I_HCB, I_HW1, I_HB1, I_HW2, I_HB2, I_HW3, I_HFREQ, I_HSKIP, I_SINK, I_POOLW, I_POOLS, I_RPB, I_WOUT, I_ROUTER, I_WG, I_WU, I_WD, I_FNG, N_IN };
constexpr size_t MiB = 1u << 20;
constexpr size_t WS_CTL = 0;
constexpr size_t WS_MOD = 1 * MiB;
constexpr size_t WS_WSC = 1 * MiB + 512 * 1024;
constexpr size_t WS_ROPE = 2 * MiB;
constexpr size_t WS_TW8 = 2 * MiB + 65536;
constexpr size_t WS_WIN_T = 3 * MiB;
constexpr size_t WS_WOUT_T = 13 * MiB;
constexpr size_t WS_HC = 17 * MiB;
constexpr size_t WS_HCC = 51 * MiB;
constexpr size_t WS_AFFT = 53 * MiB;
constexpr size_t WS_ROWMAP = 56 * MiB;
constexpr size_t WS_GATE = 57 * MiB;
constexpr size_t WS_INV = 58 * MiB;
constexpr size_t WS_CRES = 61 * MiB;
constexpr size_t WS_HX = 69 * MiB;
constexpr size_t WS_WGU_T = 137 * MiB;
constexpr size_t WS_XB = 265 * MiB;
constexpr size_t WS_WD_T = 393 * MiB;
constexpr size_t WS_R = 521 * MiB;
constexpr size_t WS_ACT = WS_R;
constexpr size_t WS_XG = WS_R + 272 * MiB;
constexpr size_t WS_PX = WS_R;
constexpr size_t WS_Y = WS_R + 153 * MiB;
constexpr size_t WS_YT = WS_XG + 48 * MiB;
constexpr size_t WS_UT = WS_XG;
constexpr size_t WS_HS = WS_R + 408 * MiB;
constexpr size_t WS_END = WS_HS + 64 * MiB;
static_assert(WS_END <= 1024 * MiB, "workspace map");

struct Args { const float* in[N_IN]; float* out; unsigned char* ws; };

__device__ __forceinline__ float bf2f(unsigned short v) { return __uint_as_float(((unsigned)v) << 16); }
__device__ __forceinline__ unsigned f2bf(float f) { unsigned u = __float_as_uint(f); return (u + 0x7fffu + ((u >> 16) & 1u)) >> 16; }
__device__ __forceinline__ unsigned pk2(float lo, float hi) { return f2bf(lo) | (f2bf(hi) << 16); }
__device__ __forceinline__ float bflo(unsigned w) { return __uint_as_float(w << 16); }
__device__ __forceinline__ float bfhi(unsigned w) { return __uint_as_float(w & 0xffff0000u); }
__device__ __forceinline__ float dot2bf(unsigned a, unsigned b, float acc) { return __builtin_amdgcn_fdot2_f32_bf16(__builtin_bit_cast(bf16x2_t, a), __builtin_bit_cast(bf16x2_t, b), acc, false); }
__device__ __forceinline__ float wave_sum(float v) {
#pragma unroll
    for (int o = 1; o < 64; o <<= 1) v += __shfl_xor(v, o);
    return v;
}
#define LDS_WAIT() asm volatile("s_waitcnt lgkmcnt(0)" ::: "memory")

#ifndef AMP_PHASE
#define AMP_PHASE -1
#endif
__device__ __forceinline__ unsigned long long amp_now() { asm volatile("s_waitcnt vmcnt(0) lgkmcnt(0)" ::: "memory"); __builtin_amdgcn_sched_barrier(0); const unsigned long long t = __builtin_amdgcn_s_memrealtime(); asm volatile("s_waitcnt lgkmcnt(0)" ::: "memory"); __builtin_amdgcn_sched_barrier(0); return t; }
#define AMP_BEGIN(id) unsigned long long amp_t0_ = 0; if ((id) == AMP_PHASE) { __syncthreads(); amp_t0_ = amp_now(); }
#define AMP_END(id) if ((id) == AMP_PHASE) { __syncthreads(); const unsigned long long t1_ = amp_now(); const unsigned long long d_ = t1_ - amp_t0_; while (amp_now() - t1_ < d_) __builtin_amdgcn_s_sleep(8); __syncthreads(); }
__device__ __forceinline__ void tr_item(const float* W, int K, int N, bf16_t* WT, int Kt, int item, int mode, LAS float* scr, int lane) {
    const int nblk = N / 32, kb = item / nblk, nb = item % nblk, k0 = 64 * kb, n0 = 32 * nb;
    const int r8 = lane >> 3, c4 = lane & 7; f32x4 v[8];
    const float* wp = W + (size_t)(k0 + r8) * N + n0 + 4 * c4;
#pragma unroll
    for (int i = 0; i < 8; ++i) v[i] = *(const f32x4*)(wp + (size_t)(8 * i) * N);
#pragma unroll
    for (int i = 0; i < 8; ++i) { LAS float* d = scr + (r8 + 8 * i) * 33 + 4 * c4; d[0] = v[i][0]; d[1] = v[i][1]; d[2] = v[i][2]; d[3] = v[i][3]; }
    LDS_WAIT();
    const int c = lane & 7;
    const int drow0 = (mode == 0) ? n0 : ((n0 >> 7) * 256 + (n0 & 127) + (mode == 2 ? 128 : 0));
#pragma unroll
    for (int j = 0; j < 4; ++j) { const int n = (lane >> 3) + 8 * j; const LAS float* sp = scr + (8 * c) * 33 + n;
        u32x4 o; o.x = pk2(sp[0 * 33], sp[1 * 33]); o.y = pk2(sp[2 * 33], sp[3 * 33]); o.z = pk2(sp[4 * 33], sp[5 * 33]); o.w = pk2(sp[6 * 33], sp[7 * 33]);
        *(u32x4*)(WT + (size_t)(drow0 + n) * Kt + k0 + 8 * c) = o; }
    LDS_WAIT();
}

__device__ __forceinline__ void tr_item_fp8(const float* W, int K, int N, unsigned char* WT, int Kt, int item, int mode, LAS float* scr, int lane, float* wsc_out) {
    const int nblk = N / 32, kb = item / nblk, nb = item % nblk, k0 = 64 * kb, n0 = 32 * nb;
    const int r8 = lane >> 3, c4 = lane & 7; f32x4 v[8];
    const f32x4 sv = *(const f32x4*)(W + 4 * lane);
    const float* wp = W + (size_t)(k0 + r8) * N + n0 + 4 * c4;
#pragma unroll
    for (int i = 0; i < 8; ++i) v[i] = *(const f32x4*)(wp + (size_t)(8 * i) * N);
    float sm = fmaxf(fmaxf(fabsf(sv[0]), fabsf(sv[1])), fmaxf(fabsf(sv[2]), fabsf(sv[3])));
#pragma unroll
    for (int o = 1; o < 64; o <<= 1) sm = fmaxf(sm, __shfl_xor(sm, o));
    int E = 0; (void)frexpf(fmaxf(sm, 1e-30f), &E); const float mul = ldexpf(1.0f, 5 - E);
    if (item == 0 && lane == 0) *wsc_out = ldexpf(1.0f, E - 5);
#pragma unroll
    for (int i = 0; i < 8; ++i) { LAS float* d = scr + (r8 + 8 * i) * 33 + 4 * c4; d[0] = v[i][0] * mul; d[1] = v[i][1] * mul; d[2] = v[i][2] * mul; d[3] = v[i][3] * mul; }
    LDS_WAIT();
    const int c = lane & 7;
    const int drow0 = (mode == 0) ? n0 : ((n0 >> 7) * 256 + (n0 & 127) + (mode == 2 ? 128 : 0));
#pragma unroll
    for (int j = 0; j < 4; ++j) { const int n = (lane >> 3) + 8 * j; const LAS float* sp = scr + (8 * c) * 33 + n;
        int p0 = 0, p1 = 0;
        p0 = __builtin_amdgcn_cvt_pk_fp8_f32(sp[0 * 33], sp[1 * 33], p0, false); p0 = __builtin_amdgcn_cvt_pk_fp8_f32(sp[2 * 33], sp[3 * 33], p0, true);
        p1 = __builtin_amdgcn_cvt_pk_fp8_f32(sp[4 * 33], sp[5 * 33], p1, false); p1 = __builtin_amdgcn_cvt_pk_fp8_f32(sp[6 * 33], sp[7 * 33], p1, true);
        typedef int i32x2v __attribute__((ext_vector_type(2)));
        *(i32x2v*)(WT + (size_t)(drow0 + n) * Kt + k0 + 8 * c) = (i32x2v){p0, p1}; }
    LDS_WAIT();
}

__device__ __forceinline__ void filter_item(const Args& a, LAS unsigned char* lds, int item, int tid) {
    asm volatile("" : "+v"(tid));
    const int lane = tid & 63, wave = tid >> 6;
    int l, L, p0; float* HCdst;
    if (item < 128) { l = 0; L = 4096; p0 = item * 32; HCdst = (float*)(a.ws + WS_HC); }
    else if (item < 256) { l = 1; L = 4096; p0 = (item - 128) * 32; HCdst = (float*)(a.ws + WS_HC) + (size_t)2 * 8191 * 256; }
    else { l = 0; L = 256; p0 = (item - 256) * 32; HCdst = (float*)(a.ws + WS_HCC) + 256; }
    LAS float* w1s = (LAS float*)lds; LAS float* w2s = w1s + 33 * 64; LAS float* b1s = w2s + 64 * 64; LAS float* b2s = b1s + 64; LAS float* frs = b2s + 64; LAS float* h2s = frs + 64; LAS float* ex = h2s + 32 * 64;
    { const float* w1 = a.in[I_HW1] + l * 33 * 64; const float* w2 = a.in[I_HW2] + l * 64 * 64;
      for (int i = tid; i < 33 * 64; i += NTHR) w1s[i] = w1[i];
      for (int i = tid; i < 64 * 64; i += NTHR) w2s[i] = w2[i];
      if (tid < 64) { b1s[tid] = a.in[I_HB1][l * 64 + tid]; b2s[tid] = a.in[I_HB2][l * 64 + tid]; frs[tid] = a.in[I_HFREQ][l * 64 + tid]; } }
    __syncthreads();
    const float frq = frs[lane];
#pragma unroll 1
    for (int q = 0; q < 4; ++q) { const int pp = wave * 4 + q, p = p0 + pp; const float tn = (float)p / (float)(L - 1);
        float fv = 0.f;
        if (lane == 0) fv = tn;
        else if (lane <= 32) { const int bi = (lane - 1) & 15; const float band = 1e-4f + (float)bi * ((15.0f - 1e-4f) / 15.0f);
            const float ang = ((float)(6.283185307179586 / (double)L) * (float)p) * band; fv = (lane <= 16) ? cosf(ang) : -sinf(ang); }
        float a1 = b1s[lane];
#pragma unroll
        for (int i = 0; i < 33; ++i) a1 += __shfl(fv, i) * w1s[i * 64 + lane];
        const float h1 = sinf(frq * a1);
        float a2 = b2s[lane];
#pragma unroll 16
        for (int i = 0; i < 64; ++i) a2 += __shfl(h1, i) * w2s[i * 64 + lane];
        h2s[pp * 64 + lane] = sinf(frq * a2); }
    __syncthreads();
    const float* w3 = a.in[I_HW3] + (size_t)l * 64 * 1024 + tid;
    float acc0[32], acc1[32];
#pragma unroll
    for (int pp = 0; pp < 32; ++pp) { acc0[pp] = 0.f; acc1[pp] = 0.f; }
#pragma unroll 4
    for (int i = 0; i < 64; ++i) { const float wa = w3[i * 1024], wb = w3[i * 1024 + 512];
#pragma unroll
        for (int pp = 0; pp < 32; ++pp) { const float h = h2s[pp * 64 + i]; acc0[pp] += h * wa; acc1[pp] += h * wb; } }
    const int c = tid & 255, dir = tid >> 8; const float dmin = 3.0701134573253945f, dmax = 15.350567286626972f; const float delta = dmin + (float)c * ((dmax - dmin) / 255.0f);
    float* base0 = HCdst; float* base1 = HCdst + (size_t)(2 * L - 1) * 256;
#pragma unroll
    for (int pp = 0; pp < 32; ++pp) { const int p = p0 + pp; const float tn = (float)p / (float)(L - 1); const float win = expf(-tn * delta); const float v0 = acc0[pp] * win, v1 = acc1[pp] * win;
        if (p == 0) { ex[tid] = v0; ex[512 + tid] = v1; }
        else { const size_t idx = (size_t)(dir == 0 ? (L - 1 + p) : (L - 1 - p)) * 256 + c; base0[idx] = v0; base1[idx] = v1; } }
    __syncthreads();
    if (p0 == 0 && tid < 256) { const size_t idx = (size_t)(L - 1) * 256 + tid; base0[idx] = ex[tid] + ex[tid + 256]; base1[idx] = ex[512 + tid] + ex[512 + tid + 256]; }
    __syncthreads();
}


typedef int v8i_t __attribute__((ext_vector_type(8)));
__device__ __forceinline__ float st_A(int i, int k) { return (float)(((i * 7 + k * 3) % 5) - 2); }
__device__ __forceinline__ float st_B(int k, int j) { return (float)(((k * 5 + j * 11 + (k >> 4)) % 5) - 2); }
__device__ __forceinline__ void fp8_selftest(unsigned* poison, int lane) {
    const int fr = lane & 15, fq = lane >> 4; v8i_t av, bv;
#pragma unroll
    for (int w = 0; w < 8; ++w) { int pa = 0, pb = 0;
#pragma unroll
        for (int q = 0; q < 4; ++q) { }
        const int kb = (w < 4) ? (16 * fq + 4 * w) : (64 + 16 * fq + 4 * (w - 4));
        pa = __builtin_amdgcn_cvt_pk_fp8_f32(st_A(fr, kb), st_A(fr, kb + 1), pa, false); pa = __builtin_amdgcn_cvt_pk_fp8_f32(st_A(fr, kb + 2), st_A(fr, kb + 3), pa, true);
        pb = __builtin_amdgcn_cvt_pk_fp8_f32(st_B(kb, fr), st_B(kb + 1, fr), pb, false); pb = __builtin_amdgcn_cvt_pk_fp8_f32(st_B(kb + 2, fr), st_B(kb + 3, fr), pb, true);
        av[w] = pa; bv[w] = pb; }
    f32x4 acc = {0.f, 0.f, 0.f, 0.f};
    acc = __builtin_amdgcn_mfma_scale_f32_16x16x128_f8f6f4(av, bv, acc, 0, 0, 0, 0x7f7f7f7f, 0, 0x7f7f7f7f);
    bool bad = false;
#pragma unroll
    for (int r = 0; r < 4; ++r) { float ref = 0.f; for (int k = 0; k < 128; ++k) ref += st_A(4 * fq + r, k) * st_B(k, fr); bad |= (acc[r] != ref); }
    { const float v = (float)(lane * 3 + 1);
      const float r5 = __builtin_bit_cast(float, __builtin_amdgcn_update_dpp(0, __builtin_bit_cast(int, v), 0x150 + 5, 0xf, 0xf, false));
      const float r12 = __builtin_bit_cast(float, __builtin_amdgcn_update_dpp(0, __builtin_bit_cast(int, v), 0x150 + 12, 0xf, 0xf, false));
      bad |= (r5 != (float)(((lane & 48) + 5) * 3 + 1)) || (r12 != (float)(((lane & 48) + 12) * 3 + 1)); }
    if (__any(bad) && lane == 0) __hip_atomic_store(poison, 1u, __ATOMIC_RELAXED, __HIP_MEMORY_SCOPE_AGENT);
}

__device__ __forceinline__ void phase_prologue(const Args& a, unsigned char* ldsg, int vcu, int G) {
    LAS unsigned char* lds = (LAS unsigned char*)ldsg;
    int tid_ = threadIdx.x; asm volatile("" : "+v"(tid_));
    const int tid = tid_, lane = tid & 63, wave = __builtin_amdgcn_readfirstlane(tid >> 6);
    unsigned char* ws = a.ws; asm volatile("" : "+s"(ws));
    if (vcu == 2 % G && wave == 0) fp8_selftest((unsigned*)(ws + WS_CTL) + 12288, lane);
    LAS float* sc = (LAS float*)lds; LAS float* red = (LAS float*)(lds + 36864);
    for (int i = tid; i < 9 * 1024; i += NTHR) { const float v = (i < 8192) ? a.in[I_C][i] : a.in[I_CCTX][i - 8192]; sc[i] = v / (1.0f + expf(-v)); }
    __syncthreads();
    { AMP_BEGIN(41)
    float* MOD = (float*)(ws + WS_MOD);
    for (int item = vcu; item < 2 * 96; item += G) {
        const int l = item / 96, n0 = (item % 96) * 64, col = tid & 63, kg = tid >> 6;
        float acc[9];
#pragma unroll
        for (int r = 0; r < 9; ++r) acc[r] = 0.f;
        const float* w = a.in[I_ADAW] + (size_t)l * 1024 * 6144 + n0 + col;
#pragma unroll 4
        for (int k = kg * 128; k < kg * 128 + 128; ++k) { const float wv = w[(size_t)k * 6144];
#pragma unroll
            for (int r = 0; r < 9; ++r) acc[r] += sc[r * 1024 + k] * wv; }
#pragma unroll
        for (int r = 0; r < 9; ++r) red[(kg * 9 + r) * 64 + col] = acc[r];
        __syncthreads();
        for (int o = tid; o < 9 * 64; o += NTHR) { const int r = o >> 6, cc = o & 63; float s = 0.f;
#pragma unroll
            for (int g2 = 0; g2 < 8; ++g2) s += red[(g2 * 9 + r) * 64 + cc];
            MOD[(size_t)(l * 9 + r) * 6144 + n0 + cc] = s + a.in[I_ADAB][l * 6144 + n0 + cc]; }
        __syncthreads();
    }
    AMP_END(41) }
    if (vcu == 0) { float* ROPE = (float*)(ws + WS_ROPE);
        for (int i = tid; i < 1024; i += NTHR) { const int pos = i >> 4, fi = i & 15; const float inv = powf(10000.0f, -(float)fi / 16.0f); const float ang = (float)pos * inv;
            ROPE[2 * i] = cosf(ang); ROPE[2 * i + 1] = sinf(ang); } }
    if (vcu == 1 % G) { float* TW8 = (float*)(ws + WS_TW8);
        for (int i = tid; i < 8192; i += NTHR) { float sn, cs; sincospif(-(float)i * (1.0f / 4096.0f), &sn, &cs); TW8[2 * i] = cs; TW8[2 * i + 1] = sn; } }
    const int gw = vcu * NWAVES + wave, NGW = G * NWAVES;
    { AMP_BEGIN(42)
    for (int it = vcu; it < 264; it += G) filter_item(a, lds, it, tid);
    AMP_END(42) }
    { AMP_BEGIN(43)
    LAS float* scr = (LAS float*)(lds + 65536 + wave * 8448);
    constexpr int IT_IN = 16 * 72, IT_OUT = 16 * 32, IT_E = 1024, IT_LAYER = IT_IN + IT_OUT + 3 * 16 * IT_E;
    for (int it = gw; it < 2 * IT_LAYER; it += NGW) {
        const int l = it / IT_LAYER; int r = it % IT_LAYER;
        if (r < IT_IN) { tr_item(a.in[I_WIN] + (size_t)l * 1024 * 2304, 1024, 2304, (bf16_t*)(ws + WS_WIN_T) + (size_t)l * 2304 * 1024, 1024, r, 0, scr, lane); continue; } r -= IT_IN;
        if (r < IT_OUT) { tr_item(a.in[I_WOUT] + (size_t)l * 1024 * 1024, 1024, 1024, (bf16_t*)(ws + WS_WOUT_T) + (size_t)l * 1024 * 1024, 1024, r, 0, scr, lane); continue; } r -= IT_OUT;
        const int which = r / (16 * IT_E), e = (r / IT_E) & 15, ri = r % IT_E; const size_t le = (size_t)l * 16 + e;
        float* wsc = (float*)(ws + WS_WSC) + (l * 3 + which) * 16 + e;
        if (which == 0) tr_item_fp8(a.in[I_WG] + le * 1024 * 2048, 1024, 2048, (unsigned char*)(ws + WS_WGU_T) + le * 4096 * 1024, 1024, ri, 1, scr, lane, wsc);
        else if (which == 1) tr_item_fp8(a.in[I_WU] + le * 1024 * 2048, 1024, 2048, (unsigned char*)(ws + WS_WGU_T) + le * 4096 * 1024, 1024, ri, 2, scr, lane, wsc);
        else tr_item_fp8(a.in[I_WD] + le * 2048 * 1024, 2048, 1024, (unsigned char*)(ws + WS_WD_T) + le * 1024 * 2048, 2048, ri, 0, scr, lane, wsc);
    }
    AMP_END(43) }
}

__device__ __forceinline__ void phase_norm(const Args& a, unsigned char* ldsg, int vcu, int G, int l, const float* srcx, const float* srcc, const bf16_t* srcb, const float* gain, int shift_idx, int nrows, bool router) {
    int tid_ = threadIdx.x; asm volatile("" : "+v"(tid_));
    const int tid = tid_, lane = tid & 63, wave = __builtin_amdgcn_readfirstlane(tid >> 6);
    unsigned char* ws = a.ws; asm volatile("" : "+s"(ws)); const float* MOD = (const float*)(ws + WS_MOD) + (size_t)l * 9 * 6144; bf16_t* HX = (bf16_t*)(ws + WS_HX);
    LAS float* rw = (LAS float*)(LAS unsigned char*)ldsg;
    if (router) { const float* rsrc = a.in[I_ROUTER] + (size_t)l * 1024 * 16; for (int i = tid; i < 1024 * 16; i += NTHR) rw[(i & 15) * 1024 + (i >> 4)] = rsrc[i]; __syncthreads(); }
    const int gw = vcu * NWAVES + wave, NGW = G * NWAVES;
    for (int rowa = gw; rowa < nrows; rowa += 2 * NGW) {
        f32x4 vv[2][4];
#pragma unroll
        for (int u = 0; u < 2; ++u) { const int rr = (rowa + u * NGW < nrows) ? rowa + u * NGW : rowa;
            if (srcb) { const bf16_t* xr = srcb + (size_t)rr * D;
#pragma unroll
                for (int j = 0; j < 4; ++j) { const u32x2 w = *(const u32x2*)(xr + 256 * j + 4 * lane); vv[u][j] = (f32x4){bflo(w.x), bfhi(w.x), bflo(w.y), bfhi(w.y)}; } }
            else { const float* xr = (rr < TX) ? srcx + (size_t)rr * D : srcc + (size_t)(rr - TX) * D;
#pragma unroll
                for (int j = 0; j < 4; ++j) vv[u][j] = *(const f32x4*)(xr + 256 * j + 4 * lane); } }
        f32x4 hv[2][4];
#pragma unroll
        for (int u = 0; u < 2; ++u) { const int row = rowa + u * NGW; if (row < nrows) {
        const bool lat = row < TX; const int mrow = lat ? (row >> 12) : 8;
        const float* shp = MOD + mrow * 6144 + shift_idx * 1024; const float* scp = shp + 1024;
        f32x4 v[4]; float ss = 0.f;
#pragma unroll
        for (int j = 0; j < 4; ++j) { v[j] = vv[u][j]; ss += (v[j][0] * v[j][0] + v[j][1] * v[j][1]) + (v[j][2] * v[j][2] + v[j][3] * v[j][3]); }
        const float rstd = 1.0f / sqrtf(wave_sum(ss) * (1.0f / D) + 1e-6f);
#pragma unroll
        for (int j = 0; j < 4; ++j) { const f32x4 gg = *(const f32x4*)(gain + 256 * j + 4 * lane), sh = *(const f32x4*)(shp + 256 * j + 4 * lane), sc = *(const f32x4*)(scp + 256 * j + 4 * lane);
            v[j] = (v[j] * rstd * gg) * (1.0f + sc) + sh;
            if (router) { int p = 0; p = __builtin_amdgcn_cvt_pk_fp8_f32(fminf(fmaxf(v[j][0], -448.f), 448.f), fminf(fmaxf(v[j][1], -448.f), 448.f), p, false); p = __builtin_amdgcn_cvt_pk_fp8_f32(fminf(fmaxf(v[j][2], -448.f), 448.f), fminf(fmaxf(v[j][3], -448.f), 448.f), p, true);
                *(int*)((unsigned char*)HX + (size_t)row * D + 256 * j + 4 * lane) = p; }
            else { u32x2 o; o.x = pk2(v[j][0], v[j][1]); o.y = pk2(v[j][2], v[j][3]); *(u32x2*)(HX + (size_t)row * D + 256 * j + 4 * lane) = o; } }
#pragma unroll
        for (int j = 0; j < 4; ++j) hv[u][j] = v[j];
        } }
        float plr[2][16];
        if (router) {
#pragma unroll
            for (int e = 0; e < 16; ++e) { float p0 = 0.f, p1 = 0.f;
#pragma unroll
                for (int j = 0; j < 4; ++j) { const f32x4 wv = *(const LAS f32x4*)(rw + e * 1024 + 256 * j + 4 * lane);
                    p0 += (hv[0][j][0] * wv[0] + hv[0][j][1] * wv[1]) + (hv[0][j][2] * wv[2] + hv[0][j][3] * wv[3]);
                    p1 += (hv[1][j][0] * wv[0] + hv[1][j][1] * wv[1]) + (hv[1][j][2] * wv[2] + hv[1][j][3] * wv[3]); }
                plr[0][e] = p0; plr[1][e] = p1; asm volatile("" : "+v"(plr[0][e]), "+v"(plr[1][e])); } }
#pragma unroll
        for (int u = 0; u < 2; ++u) { const int row = rowa + u * NGW; if (row < nrows) {
        if (router) {
            float pl[16];
#pragma unroll
            for (int e = 0; e < 16; ++e) pl[e] = plr[u][e];
            float q8[8], q4[4], q2[2], q1;
            { const bool up = (lane & 8) != 0;
#pragma unroll
              for (int e = 0; e < 8; ++e) { const float keep = up ? pl[e + 8] : pl[e], give = up ? pl[e] : pl[e + 8]; q8[e] = keep + __shfl_xor(give, 8); } }
            { const bool up = (lane & 4) != 0;
#pragma unroll
              for (int e = 0; e < 4; ++e) { const float keep = up ? q8[e + 4] : q8[e], give = up ? q8[e] : q8[e + 4]; q4[e] = keep + __shfl_xor(give, 4); } }
            { const bool up = (lane & 2) != 0;
#pragma unroll
              for (int e = 0; e < 2; ++e) { const float keep = up ? q4[e + 2] : q4[e], give = up ? q4[e] : q4[e + 2]; q2[e] = keep + __shfl_xor(give, 2); } }
            { const bool up = (lane & 1) != 0; const float keep = up ? q2[1] : q2[0], give = up ? q2[0] : q2[1]; q1 = keep + __shfl_xor(give, 1); }
            q1 += __shfl_xor(q1, 16); q1 += __shfl_xor(q1, 32);
            const float mylog = (lane < 16) ? q1 : -1e30f;
            float mx = mylog;
#pragma unroll
            for (int o = 1; o < 16; o <<= 1) mx = fmaxf(mx, __shfl_xor(mx, o));
            const float mine = (lane < 16) ? expf(mylog - mx) : 0.f; float den = mine;
#pragma unroll
            for (int o = 1; o < 16; o <<= 1) den += __shfl_xor(den, o);
            if (lane < 16) { ((float*)(ws + WS_AFFT))[(size_t)lane * TT + row] = mine / den; ((int*)(ws + WS_INV))[(size_t)row * 16 + lane] = -1; }
        }
    } }
    }
}

#define XB_TMO      128
#define XB_XCNT(j)  (256  + 64 * (j))
#define XB_XSUB(j)  (1280 + 64 * (j))
#define XB_XGEN(j)  (2304 + 64 * (j))
#define XB_TOP      3328
#define XB_TOPGEN   3392
#define XCD_BAR_WORDS 3456
#define XB_SPIN_CAP (1u << 18)

__device__ __forceinline__ unsigned xb_ld(unsigned* p)              { return __hip_atomic_load(p, __ATOMIC_RELAXED, __HIP_MEMORY_SCOPE_AGENT); }
__device__ __forceinline__ unsigned xb_add(unsigned* p, unsigned v) { return __hip_atomic_fetch_add(p, v, __ATOMIC_RELAXED, __HIP_MEMORY_SCOPE_AGENT); }
__device__ __forceinline__ unsigned xb_xcc_id() { return (unsigned)__builtin_amdgcn_s_getreg((3 << 11) | 20) & 0xFu; }
#define XB_SPIN(cond, bar) do { unsigned _sp = 0; while (cond) { __builtin_amdgcn_s_sleep(1); \
    if ((++_sp & 255u) == 0u) { if (xb_ld(&(bar)[XB_TMO])) break; if (_sp > XB_SPIN_CAP) { atomicAdd(&(bar)[XB_TMO], 1u); break; } } } } while (0)

struct XcdBarrier {
    unsigned* bar; unsigned x;
    volatile LAS unsigned* st;
};

__device__ __forceinline__ XcdBarrier xcd_barrier_post(unsigned* bar, volatile LAS unsigned* st) {
    XcdBarrier b; b.bar = bar; b.x = xb_xcc_id(); b.st = st;
    if (threadIdx.x == 0) (void)xb_add(&bar[XB_XCNT(b.x)], 1u);
    return b;
}
__device__ __forceinline__ void xcd_barrier_complete(unsigned* bar, unsigned x, unsigned& nloc, unsigned& nx) {
    const unsigned G = gridDim.x * gridDim.y * gridDim.z;
    unsigned sum, cnt, mine, sp = 0u;
    for (;;) {
        sum = 0u; cnt = 0u; mine = 0u;
#pragma unroll
        for (unsigned j = 0; j < 16; ++j) { const unsigned c = xb_ld(&bar[XB_XCNT(j)]); sum += c; cnt += (c > 0u) ? 1u : 0u; mine = (j == x) ? c : mine; }
        if (sum == G) break;
        __builtin_amdgcn_s_sleep(1);
        if ((++sp & 255u) == 0u) { if (xb_ld(&bar[XB_TMO])) break; if (sp > XB_SPIN_CAP) { atomicAdd(&bar[XB_TMO], 1u); break; } }
    }
    nloc = mine > 0u ? mine : 1u; nx = cnt > 0u ? cnt : 1u;
}

__device__ __forceinline__ void xcd_barrier(const XcdBarrier& b) {
    asm volatile("s_waitcnt vmcnt(0)" ::: "memory");
    __syncthreads();
    if (threadIdx.x == 0) {
        unsigned* bar = b.bar;
        __builtin_amdgcn_s_waitcnt(0);
        unsigned nloc = b.st[0], nx = b.st[1];
        if (nloc == 0u) { xcd_barrier_complete(bar, b.x, nloc, nx); b.st[0] = nloc; b.st[1] = nx; }
        const unsigned old = xb_add(&bar[XB_XSUB(b.x)], 1u);
        const unsigned gen = old / nloc;
        if (old + 1u == (gen + 1u) * nloc) {
            __builtin_amdgcn_fence(__ATOMIC_RELEASE, "agent");
            asm volatile("s_waitcnt vmcnt(0)" ::: "memory");
            const unsigned og = xb_add(&bar[XB_TOP], 1u);
            const unsigned tg = og / nx;
            if (og + 1u == (tg + 1u) * nx) xb_add(&bar[XB_TOPGEN], 1u);
            else XB_SPIN(xb_ld(&bar[XB_TOPGEN]) == tg, bar);
            __builtin_amdgcn_fence(__ATOMIC_ACQUIRE, "agent");
            xb_add(&bar[XB_XGEN(b.x)], 1u);
            asm volatile("s_waitcnt vmcnt(0)" ::: "memory");
        } else {
            XB_SPIN(xb_ld(&bar[XB_XGEN(b.x)]) == gen, bar);
            __builtin_amdgcn_fence(__ATOMIC_ACQUIRE, "agent");
            asm volatile("s_waitcnt vmcnt(0)" ::: "memory");
        }
    }
    __syncthreads();
}


typedef float f32x2 __attribute__((ext_vector_type(2)));
__device__ __forceinline__ f32x2 cmul(f32x2 a, f32x2 b) { return (f32x2){a.x * b.x - a.y * b.y, a.x * b.y + a.y * b.x}; }
__device__ __forceinline__ void dft16(f32x2 (&v)[16]) {
    constexpr float WC[8] = {1.0f, 0.92387953251128674f, 0.70710678118654752f, 0.38268343236508977f, 0.0f, -0.38268343236508977f, -0.70710678118654752f, -0.92387953251128674f};
    constexpr float WS[8] = {0.0f, -0.38268343236508977f, -0.70710678118654752f, -0.92387953251128674f, -1.0f, -0.92387953251128674f, -0.70710678118654752f, -0.38268343236508977f};
#pragma unroll
    for (int s = 8; s >= 1; s >>= 1)
#pragma unroll
        for (int i = 0; i < 16; ++i) if ((i & s) == 0) { const int k = (i & (s - 1)) * (8 / s); const f32x2 u = v[i], t = v[i + s]; v[i] = u + t; const f32x2 d = u - t;
            v[i + s] = (k == 0) ? d : ((k == 4) ? (f32x2){d.y, -d.x} : (f32x2){d.x * WC[k] - d.y * WS[k], d.x * WS[k] + d.y * WC[k]}); }
}
__device__ __forceinline__ constexpr int bitrev4(int i) { return ((i & 1) << 3) | ((i & 2) << 1) | ((i & 4) >> 1) | ((i & 8) >> 3); }
template <int NS, int MODE>
__device__ __forceinline__ void fft_pass(LAS f32x2* Z, const LAS f32x2* TW, int tid, const f32x2* H) {
    const int f = tid >> 8, j = tid & 255, base = f * 4096, k = j & (NS - 1);
    f32x2 v[16];
#pragma unroll
    for (int r = 0; r < 16; ++r) { const int idx = base + j + 256 * r; v[r] = Z[idx + (idx >> 4)]; }
    if (MODE == 1) {
#pragma unroll
        for (int r = 0; r < 16; ++r) { const f32x2 p = cmul(v[r], H[r]); v[r] = (f32x2){p.y, p.x}; } }
    if (NS > 1) { const LAS f32x2* tp = (NS == 16) ? (TW + 8192 + k) : (TW + 4096 + k);
#pragma unroll
        for (int r = 1; r < 16; ++r) v[r] = cmul(v[r], tp[r * NS]); }
    dft16(v);
    if (NS != 256) __syncthreads();
    const int j0 = base + (j / NS) * NS * 16 + k;
#pragma unroll
    for (int rr = 0; rr < 16; ++rr) { const int idx = j0 + rr * NS; Z[idx + (idx >> 4)] = v[bitrev4(rr)]; }
    __syncthreads();
}
__device__ __forceinline__ void load_uc(const bf16_t* UT, const float* cw, const float* cb, int ch, int b, int tid, float (&out)[8]) {
    const bf16_t* p = UT + ((size_t)(b * 768 + ch)) * 4096 + 8 * tid;
    const u32x4 w = *(const u32x4*)p; float u[10];
    u[1] = bflo(w.x); u[2] = bfhi(w.x); u[3] = bflo(w.y); u[4] = bfhi(w.y); u[5] = bflo(w.z); u[6] = bfhi(w.z); u[7] = bflo(w.w); u[8] = bfhi(w.w);
    u[0] = (tid > 0) ? bf2f(p[-1]) : 0.f; u[9] = (tid < 511) ? bf2f(p[8]) : 0.f;
    const float w0 = cw[ch], w1 = cw[768 + ch], w2 = cw[1536 + ch], bb = cb[ch];
#pragma unroll
    for (int i = 0; i < 8; ++i) out[i] = u[i] * w0 + u[i + 1] * w1 + u[i + 2] * w2 + bb;
}
__device__ __forceinline__ void hy_fill(LAS f32x2* Z, const LAS f32x2* TW, int tid, const float (&va)[8], const float (&vb)[8]) {
#pragma unroll
    for (int i = 0; i < 8; ++i) { const int t = 8 * tid + i; const f32x2 z = {va[i], vb[i]}; Z[t + (t >> 4)] = z; const int t2 = 4096 + t; Z[t2 + (t2 >> 4)] = cmul(z, TW[t]); }
    __syncthreads();
}
__device__ __forceinline__ void hy_conv(LAS f32x2* Z, const LAS f32x2* TW, int tid, const f32x2* Hg) {
    f32x2 H[16];
    { const int f = tid >> 8, j = tid & 255, base = f * 4096;
#pragma unroll
      for (int r = 0; r < 16; ++r) H[r] = Hg[base + j + 256 * r]; }
    fft_pass<1, 0>(Z, TW, tid, nullptr); fft_pass<16, 0>(Z, TW, tid, nullptr); fft_pass<256, 0>(Z, TW, tid, nullptr);
    fft_pass<1, 1>(Z, TW, tid, H); fft_pass<16, 0>(Z, TW, tid, nullptr); fft_pass<256, 0>(Z, TW, tid, nullptr);
}
__device__ __forceinline__ f32x2 hy_out(const LAS f32x2* Z, const LAS f32x2* TW, int t) {
    const f32x2 se = Z[t + (t >> 4)]; const int t2 = 4096 + t; const f32x2 so = Z[t2 + (t2 >> 4)]; const f32x2 tw = TW[t];
    const f32x2 So = {so.y, so.x};
    return (f32x2){se.y + (So.x * tw.x + So.y * tw.y), se.x + (So.y * tw.x - So.x * tw.y)};
}
__device__ __forceinline__ void hyena_item(const Args& a, LAS unsigned char* lds, int l, int c, int bp, int tid) {
    asm volatile("" : "+v"(tid));
    LAS f32x2* Z = (LAS f32x2*)lds; const LAS f32x2* TW = (const LAS f32x2*)(lds + 69632);
    const bf16_t* UT = (const bf16_t*)(a.ws + WS_UT); bf16_t* YT = (bf16_t*)(a.ws + WS_YT);
    const float* cw = a.in[I_HCW] + (size_t)l * 3 * 768; const float* cb = a.in[I_HCB] + (size_t)l * 768; const float* skip = a.in[I_HSKIP] + (size_t)l * 2 * 256;
    const f32x2* HS = (const f32x2*)(a.ws + WS_HS) + ((size_t)(l * 2) * 256 + c) * 8192;
    const int b0 = 2 * bp, b1 = 2 * bp + 1;
    float va[8], vb[8], xa[8], xb[8];
    load_uc(UT, cw, cb, c, b0, tid, va); load_uc(UT, cw, cb, c, b1, tid, vb);
    hy_fill(Z, TW, tid, va, vb);
    hy_conv(Z, TW, tid, HS);
    load_uc(UT, cw, cb, 256 + c, b0, tid, xa); load_uc(UT, cw, cb, 256 + c, b1, tid, xb);
    { const float sk = skip[c];
#pragma unroll
      for (int i = 0; i < 8; ++i) { const f32x2 y = hy_out(Z, TW, 8 * tid + i); va[i] = xa[i] * (y.x + va[i] * sk); vb[i] = xb[i] * (y.y + vb[i] * sk); } }
    __syncthreads();
    hy_fill(Z, TW, tid, va, vb);
    hy_conv(Z, TW, tid, HS + (size_t)256 * 8192);
    load_uc(UT, cw, cb, 512 + c, b0, tid, xa); load_uc(UT, cw, cb, 512 + c, b1, tid, xb);
    { const float sk = skip[256 + c];
      float oa[8], ob[8];
#pragma unroll
      for (int i = 0; i < 8; ++i) { const f32x2 y = hy_out(Z, TW, 8 * tid + i); oa[i] = xa[i] * (y.x + va[i] * sk); ob[i] = xb[i] * (y.y + vb[i] * sk); }
      u32x4 wa, wb; wa.x = pk2(oa[0], oa[1]); wa.y = pk2(oa[2], oa[3]); wa.z = pk2(oa[4], oa[5]); wa.w = pk2(oa[6], oa[7]); wb.x = pk2(ob[0], ob[1]); wb.y = pk2(ob[2], ob[3]); wb.z = pk2(ob[4], ob[5]); wb.w = pk2(ob[6], ob[7]);
      *(u32x4*)(YT + ((size_t)(b0 * 256 + c)) * 4096 + 8 * tid) = wa; *(u32x4*)(YT + ((size_t)(b1 * 256 + c)) * 4096 + 8 * tid) = wb; }
    __syncthreads();
}
__device__ __forceinline__ void spectrum_item(const Args& a, LAS unsigned char* lds, int item, int tid) {
    asm volatile("" : "+v"(tid));
    LAS f32x2* Z = (LAS f32x2*)lds; const LAS f32x2* TW = (const LAS f32x2*)(lds + 69632);
    const int c = item & 255, lo = item >> 8;
    const float* HC = (const float*)(a.ws + WS_HC) + (size_t)lo * 8191 * 256 + c;
#pragma unroll
    for (int i = 0; i < 8; ++i) { const int t = 8 * tid + i; const float hl = HC[(size_t)(4095 + t) * 256], hh = (t == 0) ? 0.f : HC[(size_t)(t - 1) * 256];
        Z[t + (t >> 4)] = (f32x2){hl + hh, 0.f}; const int t2 = 4096 + t; const f32x2 tw = TW[t]; const float dd = hl - hh; Z[t2 + (t2 >> 4)] = (f32x2){dd * tw.x, dd * tw.y}; }
    __syncthreads();
    fft_pass<1, 0>(Z, TW, tid, nullptr); fft_pass<16, 0>(Z, TW, tid, nullptr); fft_pass<256, 0>(Z, TW, tid, nullptr);
    f32x2* HS = (f32x2*)(a.ws + WS_HS) + (size_t)item * 8192;
#pragma unroll
    for (int i = 0; i < 16; ++i) { const int idx = tid + 512 * i; HS[idx] = Z[idx + (idx >> 4)] * (1.0f / 8192.0f); }
    __syncthreads();
}
__device__ __forceinline__ void load_tw(const Args& a, LAS unsigned char* lds, int tid) {
    asm volatile("" : "+v"(tid));
    LAS f32x2* TW = (LAS f32x2*)(lds + 69632); const f32x2* src = (const f32x2*)(a.ws + WS_TW8);
    for (int i = tid; i < 4096; i += NTHR) { TW[i] = src[i]; const int r = i >> 8, k = i & 255; TW[4096 + i] = src[r * k * 2]; }
    if (tid < 256) { const int r = tid >> 4, k = tid & 15; TW[8192 + tid] = src[r * k * 32]; }
    __syncthreads();
}
__device__ __forceinline__ float ctx_uc(const bf16_t* PXc, const float* cw, const float* cb, int ch, int t) {
    const float u1 = bf2f(PXc[(size_t)t * INW + ch]); const float u0 = (t > 0) ? bf2f(PXc[(size_t)(t - 1) * INW + ch]) : 0.f; const float u2 = (t < 255) ? bf2f(PXc[(size_t)(t + 1) * INW + ch]) : 0.f;
    return u0 * cw[ch] + u1 * cw[768 + ch] + u2 * cw[1536 + ch] + cb[ch];
}
__device__ __forceinline__ void ctx_conv16(const LAS float* IN, const float* H, int c, int lane, int t0, float (&acc)[16]) {
    float w[16];
    const float* hp = H + (size_t)(t0 + 255) * 256 + c;
#pragma unroll
    for (int i = 0; i < 16; ++i) { acc[i] = 0.f; w[i] = hp[i * 256]; }
    const LAS float* ip = IN + lane;
#pragma unroll 1
    for (int s0 = 0; s0 < 256; s0 += 16) {
#pragma unroll
        for (int u = 0; u < 16; ++u) { const float v = ip[u * 64];
#pragma unroll
            for (int i = 0; i < 16; ++i) acc[i] += v * w[(i - u + 16) & 15];
            w[(15 - u) & 15] = hp[-(u + 1) * 256]; }
        hp -= 16 * 256; ip += 16 * 64; }
}
__device__ __forceinline__ void ctx_hyena_item(const Args& a, LAS unsigned char* lds, int l, int item, int tid) {
    asm volatile("" : "+v"(tid));
    const int lane = tid & 63, wave = tid >> 6, b = item >> 2, c = (item & 3) * 64 + lane;
    LAS float* V = (LAS float*)lds; LAS float* Z1 = (LAS float*)(lds + 65536);
    const bf16_t* PXc = (const bf16_t*)(a.ws + WS_PX) + (size_t)(TX + b * 256) * INW; bf16_t* Y = (bf16_t*)(a.ws + WS_Y) + (size_t)(TX + b * 256) * D;
    const float* cw = a.in[I_HCW] + (size_t)l * 3 * 768; const float* cb = a.in[I_HCB] + (size_t)l * 768; const float* skip = a.in[I_HSKIP] + (size_t)l * 2 * 256;
    const float* H0 = (const float*)(a.ws + WS_HCC) + 256, *H1 = H0 + (size_t)511 * 256;
#pragma unroll 2
    for (int i = 0; i < 32; ++i) { const int t = wave * 32 + i; V[t * 64 + lane] = ctx_uc(PXc, cw, cb, c, t); }
    __syncthreads();
    float acc[16];
#pragma unroll 1
    for (int g = 0; g < 2; ++g) { const int t0 = wave * 32 + g * 16; ctx_conv16(V, H0, c, lane, t0, acc); const float sk = skip[c];
#pragma unroll
        for (int i = 0; i < 16; ++i) { const int t = t0 + i; Z1[t * 64 + lane] = ctx_uc(PXc, cw, cb, 256 + c, t) * (acc[i] + V[t * 64 + lane] * sk); } }
    __syncthreads();
#pragma unroll 1
    for (int g = 0; g < 2; ++g) { const int t0 = wave * 32 + g * 16; ctx_conv16(Z1, H1, c, lane, t0, acc); const float sk = skip[256 + c];
#pragma unroll
        for (int i = 0; i < 16; ++i) { const int t = t0 + i; Y[(size_t)t * D + c] = (bf16_t)f2bf(ctx_uc(PXc, cw, cb, 512 + c, t) * (acc[i] + Z1[t * 64 + lane] * sk)); } }
    __syncthreads();
}

__device__ __forceinline__ void ytr_item(const Args& a, LAS unsigned char* tile, int item, int lane) {
    const int b = item >> 8, tt = (item >> 2) & 63, ct = item & 3;
    const bf16_t* src = (const bf16_t*)(a.ws + WS_YT) + ((size_t)(b * 256 + ct * 64)) * 4096 + tt * 64; bf16_t* Y = (bf16_t*)(a.ws + WS_Y) + ((size_t)b * 4096 + tt * 64) * D + ct * 64;
    u32x4 v[8];
#pragma unroll
    for (int i = 0; i < 8; ++i) v[i] = *(const u32x4*)(src + (size_t)((lane >> 3) + 8 * i) * 4096 + (lane & 7) * 8);
#pragma unroll
    for (int i = 0; i < 8; ++i) *(LAS u32x4*)(tile + ((lane >> 3) + 8 * i) * 144 + (lane & 7) * 16) = v[i];
    LDS_WAIT();
    const LAS unsigned short* tp = (const LAS unsigned short*)(tile + lane * 2);
#pragma unroll
    for (int q = 0; q < 8; ++q) { u32x4 o;
        o.x = (unsigned)tp[(8 * q + 0) * 72] | ((unsigned)tp[(8 * q + 1) * 72] << 16); o.y = (unsigned)tp[(8 * q + 2) * 72] | ((unsigned)tp[(8 * q + 3) * 72] << 16);
        o.z = (unsigned)tp[(8 * q + 4) * 72] | ((unsigned)tp[(8 * q + 5) * 72] << 16); o.w = (unsigned)tp[(8 * q + 6) * 72] | ((unsigned)tp[(8 * q + 7) * 72] << 16);
        *(u32x4*)(Y + (size_t)lane * D + 8 * q) = o; }
    LDS_WAIT();
}
__device__ __forceinline__ void event_arrive(unsigned* ctr) {
    asm volatile("s_waitcnt vmcnt(0)" ::: "memory"); __syncthreads();
    if (threadIdx.x == 0) { __builtin_amdgcn_fence(__ATOMIC_RELEASE, "agent"); asm volatile("s_waitcnt vmcnt(0)" ::: "memory"); __hip_atomic_fetch_add(ctr, 1u, __ATOMIC_RELAXED, __HIP_MEMORY_SCOPE_AGENT); }
}
__device__ __forceinline__ void event_wait(unsigned* ctr, unsigned want) {
    if (threadIdx.x == 0) { unsigned sp = 0;
        while (__hip_atomic_load(ctr, __ATOMIC_RELAXED, __HIP_MEMORY_SCOPE_AGENT) < want) { __builtin_amdgcn_s_sleep(2); if (++sp > (1u << 22)) break; }
        __builtin_amdgcn_fence(__ATOMIC_ACQUIRE, "agent"); asm volatile("s_waitcnt vmcnt(0)" ::: "memory"); }
    __syncthreads();
}

typedef short bf16x8_t __attribute__((ext_vector_type(8)));
typedef short s16x4_t __attribute__((ext_vector_type(4)));
typedef float f32x16 __attribute__((ext_vector_type(16)));
__device__ __forceinline__ int crow(int r, int hi) { return (r & 3) + 8 * (r >> 2) + 4 * hi; }
__device__ __forceinline__ unsigned cvtpk(float lo, float hi) { f32x2 v = {lo, hi}; bf16x2_t b = __builtin_convertvector(v, bf16x2_t); return __builtin_bit_cast(unsigned, b); }
__device__ __forceinline__ s16x4_t vtr(const LAS unsigned char* p) { return __builtin_bit_cast(s16x4_t, __builtin_amdgcn_ds_read_tr16_b64_v4i16((LAS s16x4_t*)p)); }
constexpr int AT_K = 0, AT_V = 16384, AT_WSF = 32768, AT_OST = 34816, AT_RPB = 67584, AT_END = 69632;
template <int KIND>
__device__ __forceinline__ void attn_unit(const Args& a, LAS unsigned char* lds, int l, int u, int tid) {
    asm volatile("" : "+v"(tid));
    const int lane = tid & 63, wid = __builtin_amdgcn_readfirstlane(tid >> 6), r32 = lane & 31, hi = lane >> 5;
    const bf16_t* PX = (const bf16_t*)(a.ws + WS_PX); bf16_t* Y = (bf16_t*)(a.ws + WS_Y);
    int b, qcol, kcol, vcol, ycol, qrow0, nloc = 0, lo = 0; bool sink = false; int hsink = 0;
    int qpos0 = 0, blk = 0, rq = 0, cbase = 0, rq4 = 0;
    if (KIND == 0) { b = u >> 6; const int kvh = (u >> 5) & 1; blk = u & 31; const int h = 2 * kvh + (wid >> 2); qpos0 = blk * 128 + 32 * (wid & 3); qrow0 = b * 4096 + qpos0;
        qcol = 1024 + h * 64; kcol = 1536 + kvh * 64; vcol = 1664 + kvh * 64; ycol = 256 + h * 64; lo = (blk == 0) ? 2 : 0; nloc = ((blk == 31) ? 3 : 5) - lo + 1; sink = true; hsink = h; }
    else if (KIND == 1) { b = u >> 6; const int h = (u >> 4) & 3; rq4 = u & 15; rq = 4 * rq4 + (wid >> 1); cbase = 32 * (wid & 1); qrow0 = b * 4096 + rq * 64 + cbase;
        qcol = 1280 + h * 64; kcol = 1792 + h * 64; vcol = 2048 + h * 64; ycol = 768 + h * 64;
        const int ra = 4 * rq4 - 4, rb = 4 * rq4 + 3 - 4; lo = ra < 0 ? 0 : (ra > 56 ? 56 : ra); const int hi_r = (rb < 0 ? 0 : (rb > 56 ? 56 : rb)) + 7; nloc = hi_r - lo + 1;
        LAS float* rpbL = (LAS float*)(lds + AT_RPB); const float* src = a.in[I_RPB] + (size_t)(l * 4 + h) * 465;
        for (int i = tid; i < 465; i += NTHR) rpbL[i] = src[i] * 8.0f; }
    else { b = u >> 3; const int h = (u >> 1) & 3; qrow0 = TX + b * 256 + 32 * wid;
        if ((u & 1) == 0) { qcol = 1024 + h * 64; kcol = 1536 + (h >> 1) * 64; vcol = 1664 + (h >> 1) * 64; ycol = 256 + h * 64; sink = true; hsink = h; }
        else { qcol = 1280 + h * 64; kcol = 1792 + h * 64; vcol = 2048 + h * 64; ycol = 768 + h * 64; } }
    const int NT = nloc + 4;
    bf16x8_t qr[4];
    { const bf16_t* qp = PX + (size_t)(qrow0 + r32) * INW + qcol + hi * 8;
#pragma unroll
      for (int d0 = 0; d0 < 4; ++d0) qr[d0] = *(const bf16x8_t*)(qp + d0 * 16); }
    const int krow = 8 * wid + (lane & 7), kchunk = lane >> 3; const int vrow = 16 * (wid & 3) + (lane >> 2), vcoff = (wid >> 2) * 32 + (lane & 3) * 8;
    const int kdst = AT_K + kchunk * 1024 + krow * 16, vdst = AT_V + wid * 1024 + lane * 16;
    auto tile_row0 = [&](int t) -> int { if (t < nloc) { if (KIND == 0) return b * 4096 + blk * 128 - 128 + 64 * (lo + t); else return b * 4096 + (lo + t) * 64; } return TX + b * 256 + 64 * (t - nloc); };
    u32x4 gk0, gv0, gk1, gv1;
#define AT_LOAD(GK, GV, t_) do { const int R0_ = tile_row0(t_); GK = *(const u32x4*)(PX + (size_t)(R0_ + krow) * INW + kcol + kchunk * 8); GV = *(const u32x4*)(PX + (size_t)(R0_ + vrow) * INW + vcol + vcoff); } while (0)
    AT_LOAD(gk0, gv0, 0);
    if (NT > 1) AT_LOAD(gk1, gv1, 1); else { gk1 = gk0; gv1 = gv0; }
    *(LAS u32x4*)(lds + kdst) = gk0; *(LAS u32x4*)(lds + vdst) = gv0;
    float mhat = -1e30f, l_reg = 0.f; f32x16 o[2];
#pragma unroll
    for (int r = 0; r < 16; ++r) { o[0][r] = 0.f; o[1][r] = 0.f; }
    LAS float* wsf = (LAS float*)(lds + AT_WSF) + wid * 64;
    const LAS unsigned char* vb0 = lds + AT_V + ((lane >> 4) & 1) * 32 + (lane & 3) * 8 + (4 * hi + ((lane & 15) >> 2)) * 64;
    const LAS unsigned char* kb0 = lds + AT_K + hi * 1024 + r32 * 16;
    __syncthreads();
    auto step = [&](int t, u32x4& gkw, u32x4& gvw, u32x4& gkl, u32x4& gvl) __attribute__((always_inline)) {
        const int bufo = (t & 1) * 8192;
        if (t + 2 < NT) AT_LOAD(gkl, gvl, t + 2);
        bool need = true; bool full = true; int ts = 0, rk = 0;
        if (t < nloc) {
            if (KIND == 0) { ts = blk * 128 - 128 + 64 * (lo + t); need = (ts + 63 >= qpos0 - 128) && (ts <= qpos0 + 31 + 128); full = (qpos0 + 31 - ts <= 128) && (ts + 63 - qpos0 <= 128); }
            if (KIND == 1) { rk = lo + t; const int r0 = (rq - 4) < 0 ? 0 : ((rq - 4) > 56 ? 56 : (rq - 4)); need = (rk >= r0) && (rk <= r0 + 7); full = false; }
        }
        if (need) {
            f32x16 p0, p1;
#pragma unroll
            for (int r = 0; r < 16; ++r) { p0[r] = 0.f; p1[r] = 0.f; }
            const LAS unsigned char* kb = kb0 + bufo;
#pragma unroll
            for (int d0 = 0; d0 < 4; ++d0) { const bf16x8_t k0 = *(const LAS bf16x8_t*)(kb + d0 * 2048), k1 = *(const LAS bf16x8_t*)(kb + d0 * 2048 + 512);
                p0 = __builtin_amdgcn_mfma_f32_32x32x16_bf16(k0, qr[d0], p0, 0, 0, 0); p1 = __builtin_amdgcn_mfma_f32_32x32x16_bf16(k1, qr[d0], p1, 0, 0, 0); }
            constexpr float C2 = 0.125f * LOG2E;
            if (!full) {
                if (KIND == 0) { const int tq = qpos0 + r32;
#pragma unroll
                    for (int r = 0; r < 16; ++r) { const int k0 = ts + crow(r, hi), d0 = tq - k0, d1 = d0 - 32; p0[r] = (d0 > 128 || d0 < -128) ? -INFINITY : p0[r]; p1[r] = (d1 > 128 || d1 < -128) ? -INFINITY : p1[r]; } }
                if (KIND == 1) { const int c = cbase + r32; const int wsc = (c - 8) < 0 ? 0 : ((c - 8) > 48 ? 48 : (c - 8)); const LAS float* rp = (const LAS float*)(lds + AT_RPB) + (rk - rq + 7) * 31 + 15 - c;
                    float b0[16], b1[16];
#pragma unroll
                    for (int r = 0; r < 16; ++r) { const int c0 = crow(r, hi), c1 = c0 + 32; const int i0 = c0 < wsc ? wsc : (c0 > wsc + 15 ? wsc + 15 : c0), i1 = c1 < wsc ? wsc : (c1 > wsc + 15 ? wsc + 15 : c1); b0[r] = rp[i0]; b1[r] = rp[i1]; }
#pragma unroll
                    for (int r = 0; r < 16; ++r) { const int c0 = crow(r, hi), c1 = c0 + 32; const bool ok0 = (c0 >= wsc) && (c0 < wsc + 16), ok1 = (c1 >= wsc) && (c1 < wsc + 16);
                        p0[r] = ok0 ? p0[r] + b0[r] : -INFINITY; p1[r] = ok1 ? p1[r] + b1[r] : -INFINITY; } }
            }
            float rm = fmaxf(p0[0], p1[0]);
#pragma unroll
            for (int r = 1; r < 16; ++r) rm = fmaxf(rm, fmaxf(p0[r], p1[r]));
            { auto rr = __builtin_amdgcn_permlane32_swap(__float_as_uint(rm), __float_as_uint(rm), false, false); rm = fmaxf(__uint_as_float(rr[0]), __uint_as_float(rr[1])); }
            const float mnew = fmaxf(mhat, rm); const float f = __builtin_amdgcn_exp2f((mhat - mnew) * C2); const bool grew = mnew > mhat; mhat = mnew;
            const float nm = -mnew * C2; float sacc = 0.f;
#pragma unroll
            for (int r = 0; r < 16; ++r) { p0[r] = __builtin_amdgcn_exp2f(fmaf(p0[r], C2, nm)); p1[r] = __builtin_amdgcn_exp2f(fmaf(p1[r], C2, nm)); sacc += p0[r] + p1[r]; }
            l_reg = l_reg * f + sacc;
            if (__any(grew)) { if (hi == 0) wsf[r32] = f; LDS_WAIT();
#pragma unroll
                for (int r = 0; r < 16; ++r) { const float fr_ = wsf[crow(r, hi)]; o[0][r] *= fr_; o[1][r] *= fr_; }
                LDS_WAIT(); }
            u32x4 pw0, pw1, pw2, pw3;
            pw0 = (u32x4){cvtpk(p0[0], p0[1]), cvtpk(p0[2], p0[3]), cvtpk(p0[4], p0[5]), cvtpk(p0[6], p0[7])}; pw1 = (u32x4){cvtpk(p0[8], p0[9]), cvtpk(p0[10], p0[11]), cvtpk(p0[12], p0[13]), cvtpk(p0[14], p0[15])};
            pw2 = (u32x4){cvtpk(p1[0], p1[1]), cvtpk(p1[2], p1[3]), cvtpk(p1[4], p1[5]), cvtpk(p1[6], p1[7])}; pw3 = (u32x4){cvtpk(p1[8], p1[9]), cvtpk(p1[10], p1[11]), cvtpk(p1[12], p1[13]), cvtpk(p1[14], p1[15])};
            const LAS unsigned char* vb = vb0 + bufo;
#pragma unroll
            for (int d0 = 0; d0 < 2; ++d0) {
#pragma unroll
                for (int ks = 0; ks < 4; ++ks) { const s16x4_t vl = vtr(vb + d0 * 4096 + ks * 1024), vh = vtr(vb + d0 * 4096 + ks * 1024 + 512);
                    const bf16x8_t vf = (bf16x8_t){vl[0], vl[1], vl[2], vl[3], vh[0], vh[1], vh[2], vh[3]};
                    const bf16x8_t pa = __builtin_bit_cast(bf16x8_t, ks == 0 ? pw0 : (ks == 1 ? pw1 : (ks == 2 ? pw2 : pw3)));
                    o[d0] = __builtin_amdgcn_mfma_f32_32x32x16_bf16(pa, vf, o[d0], 0, 0, 0); } }
        }
        if (t + 1 < NT) { const int nb = ((t + 1) & 1) * 8192; *(LAS u32x4*)(lds + kdst + nb) = gkw; *(LAS u32x4*)(lds + vdst + nb) = gvw; }
        __syncthreads();
    };
    for (int t = 0; t < NT; t += 2) { step(t, gk1, gv1, gk0, gv0); if (t + 1 < NT) step(t + 1, gk0, gv0, gk1, gv1); }
#undef AT_LOAD
    { auto rr = __builtin_amdgcn_permlane32_swap(__float_as_uint(l_reg), __float_as_uint(l_reg), false, false); l_reg = __uint_as_float(rr[0]) + __uint_as_float(rr[1]); }
    if (sink) l_reg += __builtin_amdgcn_exp2f(a.in[I_SINK][l * 4 + hsink] * LOG2E - mhat * (0.125f * LOG2E));
    if (hi == 0) wsf[32 + r32] = 1.0f / l_reg;
    LDS_WAIT();
    LAS bf16_t* stg = (LAS bf16_t*)(lds + AT_OST) + wid * 2048;
#pragma unroll
    for (int r = 0; r < 16; ++r) { const int orow = crow(r, hi); const float il = wsf[32 + orow];
        stg[orow * 64 + r32] = (bf16_t)f2bf(o[0][r] * il); stg[orow * 64 + 32 + r32] = (bf16_t)f2bf(o[1][r] * il); }
    LDS_WAIT();
#pragma unroll
    for (int i = 0; i < 4; ++i) { const int row = i * 8 + (lane >> 3), ch = lane & 7; const u32x4 v = *(const LAS u32x4*)(stg + row * 64 + ch * 8);
        *(u32x4*)(Y + (size_t)(qrow0 + row) * D + ycol + ch * 8) = v; }
    __syncthreads();
}


template <int HW>
__device__ __forceinline__ void pool_tile(const bf16_t* PX, bf16_t* Y, const float* pscale, int tile, int g, int lane, const bf16x8_t (&wf)[4][2]) {
    const int tk = lane & 15, oc = lane >> 4; const int row = tile * 16 + tk; const bool lat = row < TX; const int tpos = lat ? (row & 4095) : ((row - TX) & 255); const int Ls = lat ? 4096 : 256;
    const bf16_t* pr = PX + (size_t)row * INW + 768 + g * 64 + 8 * oc;
    u32x4 w0[2 * HW], w1[2 * HW];
#pragma unroll
    for (int i = 0; i < 2 * HW; ++i) { const int off = i - HW; const int tp = tpos + off; const bool inr = (tp >= 0) && (tp < Ls); const bf16_t* p = pr + (ptrdiff_t)(inr ? off : 0) * INW; w0[i] = *(const u32x4*)p; w1[i] = *(const u32x4*)(p + 32); }
    float s0[8], s1[8]; int cnt = 0;
#pragma unroll
    for (int j = 0; j < 8; ++j) { s0[j] = 0.f; s1[j] = 0.f; }
#pragma unroll
    for (int i = 0; i < 2 * HW; ++i) { const int tp = tpos + i - HW; const bool in = (tp >= 0) && (tp < Ls); const float m = in ? 1.0f : 0.0f; cnt += in ? 1 : 0;
        s0[0] += m * bflo(w0[i].x); s0[1] += m * bfhi(w0[i].x); s0[2] += m * bflo(w0[i].y); s0[3] += m * bfhi(w0[i].y); s0[4] += m * bflo(w0[i].z); s0[5] += m * bfhi(w0[i].z); s0[6] += m * bflo(w0[i].w); s0[7] += m * bfhi(w0[i].w);
        s1[0] += m * bflo(w1[i].x); s1[1] += m * bfhi(w1[i].x); s1[2] += m * bflo(w1[i].y); s1[3] += m * bfhi(w1[i].y); s1[4] += m * bflo(w1[i].z); s1[5] += m * bfhi(w1[i].z); s1[6] += m * bflo(w1[i].w); s1[7] += m * bfhi(w1[i].w); }
    const float ic = 1.0f / (float)cnt; const u32x4 c0 = w0[HW], c1 = w1[HW];
    const float u0[8] = {bflo(c0.x), bfhi(c0.x), bflo(c0.y), bfhi(c0.y), bflo(c0.z), bfhi(c0.z), bflo(c0.w), bfhi(c0.w)}, u1[8] = {bflo(c1.x), bfhi(c1.x), bflo(c1.y), bfhi(c1.y), bflo(c1.z), bfhi(c1.z), bflo(c1.w), bfhi(c1.w)};
    u32x4 d0, d1;
    d0.x = cvtpk(s0[0] * ic - u0[0], s0[1] * ic - u0[1]); d0.y = cvtpk(s0[2] * ic - u0[2], s0[3] * ic - u0[3]); d0.z = cvtpk(s0[4] * ic - u0[4], s0[5] * ic - u0[5]); d0.w = cvtpk(s0[6] * ic - u0[6], s0[7] * ic - u0[7]);
    d1.x = cvtpk(s1[0] * ic - u1[0], s1[1] * ic - u1[1]); d1.y = cvtpk(s1[2] * ic - u1[2], s1[3] * ic - u1[3]); d1.z = cvtpk(s1[4] * ic - u1[4], s1[5] * ic - u1[5]); d1.w = cvtpk(s1[6] * ic - u1[6], s1[7] * ic - u1[7]);
    const bf16x8_t b0 = __builtin_bit_cast(bf16x8_t, d0), b1 = __builtin_bit_cast(bf16x8_t, d1);
    bf16_t* yr = Y + (size_t)row * D + 512 + g * 64 + 4 * oc;
#pragma unroll
    for (int nt = 0; nt < 4; ++nt) { f32x4 acc = {0.f, 0.f, 0.f, 0.f};
        acc = __builtin_amdgcn_mfma_f32_16x16x32_bf16(wf[nt][0], b0, acc, 0, 0, 0); acc = __builtin_amdgcn_mfma_f32_16x16x32_bf16(wf[nt][1], b1, acc, 0, 0, 0);
        const f32x4 sc = *(const f32x4*)(pscale + g * 64 + 16 * nt + 4 * oc); acc *= sc;
        u32x2 ov; ov.x = cvtpk(acc[0], acc[1]); ov.y = cvtpk(acc[2], acc[3]); *(u32x2*)(yr + 16 * nt) = ov; }
}
__device__ __forceinline__ void phase_mix1(const Args& a, unsigned char* ldsg, int vcu, int G, int l) {
    LAS unsigned char* lds = (LAS unsigned char*)ldsg;
    int tid_ = threadIdx.x; asm volatile("" : "+v"(tid_));
    const int tid = tid_, lane = tid & 63, wave = __builtin_amdgcn_readfirstlane(tid >> 6);
    unsigned char* ws = a.ws; asm volatile("" : "+s"(ws)); const bf16_t* PX = (const bf16_t*)(ws + WS_PX); bf16_t* Y = (bf16_t*)(ws + WS_Y);
    const bool upd = (l == 0); const int nrows = upd ? TT : TX;
    const int gw = vcu * NWAVES + wave, NGW = G * NWAVES;
    { AMP_BEGIN(31) load_tw(a, lds, tid);
    for (int it = vcu; it < 1024; it += G) hyena_item(a, lds, l, it >> 2, it & 3, tid);
    if (upd) for (int it = vcu; it < 32; it += G) ctx_hyena_item(a, lds, l, it, tid);
    event_arrive((unsigned*)(ws + WS_CTL) + 8192 + 64 * l); AMP_END(31) }
    { AMP_BEGIN(32)
    { const int g = gw & 3; const float* pwg = a.in[I_POOLW] + (size_t)(l * 4 + g) * 4096; const float* pscale = a.in[I_POOLS] + (size_t)l * 256;
      bf16x8_t wf[4][2];
#pragma unroll
      for (int nt = 0; nt < 4; ++nt)
#pragma unroll
          for (int ks = 0; ks < 2; ++ks) { const float* wp = pwg + (size_t)(32 * ks + 8 * (lane >> 4)) * 64 + 16 * nt + (lane & 15); u32x4 w;
              w.x = cvtpk(wp[0], wp[64]); w.y = cvtpk(wp[128], wp[192]); w.z = cvtpk(wp[256], wp[320]); w.w = cvtpk(wp[384], wp[448]); wf[nt][ks] = __builtin_bit_cast(bf16x8_t, w); }
      const int ntiles = nrows / 16;
      for (int it = gw; it < ntiles * 4; it += NGW) { const int tile = it >> 2;
          if (g == 0) pool_tile<1>(PX, Y, pscale, tile, g, lane, wf); else if (g == 1) pool_tile<2>(PX, Y, pscale, tile, g, lane, wf); else if (g == 2) pool_tile<4>(PX, Y, pscale, tile, g, lane, wf); else pool_tile<8>(PX, Y, pscale, tile, g, lane, wf); } }
    __syncthreads(); AMP_END(32) }
    { AMP_BEGIN(33)
    for (int u = vcu; u < 512; u += G) attn_unit<0>(a, lds, l, u, tid);
    for (int u = vcu; u < 512; u += G) attn_unit<1>(a, lds, l, u, tid);
    if (upd) for (int u = vcu; u < 64; u += G) attn_unit<2>(a, lds, l, u, tid);
    AMP_END(33) }
    { AMP_BEGIN(34) event_wait((unsigned*)(ws + WS_CTL) + 8192 + 64 * l, (unsigned)G);
      for (int it = gw; it < 2048; it += NGW) ytr_item(a, lds + wave * 9216, it, lane); AMP_END(34) }
}

__device__ __forceinline__ void phase_select(const Args& a, unsigned char* ldsg, int vcu, int G, bool with_ctx) {
    LAS unsigned* keys = (LAS unsigned*)(LAS unsigned char*)ldsg;
    LAS unsigned* hist = keys + 4096;
    LAS unsigned* ctl = hist + 256;
    int tid_ = threadIdx.x; asm volatile("" : "+v"(tid_));
    const int tid = tid_, lane = tid & 63; unsigned char* ws = a.ws; asm volatile("" : "+s"(ws));
    const float* AFFT = (const float*)(ws + WS_AFFT); int* ROWMAP = (int*)(ws + WS_ROWMAP); float* GATE = (float*)(ws + WS_GATE); int* INV = (int*)(ws + WS_INV);
    const int nitems = 128 + (with_ctx ? 128 : 0);
    for (int item = vcu; item < nitems; item += G) {
        int e, base, Ls, cap, slot0;
        if (item < 128) { const int b = item >> 4; e = item & 15; base = b * 4096; Ls = 4096; cap = CAPX; slot0 = b * CAPX; }
        else { const int it = item - 128; const int b = it >> 4; e = it & 15; base = TX + b * 256; Ls = 256; cap = CAPC; slot0 = NB * CAPX + b * CAPC; }
        unsigned k[8];
#pragma unroll
        for (int i = 0; i < 8; ++i) { const int idx = tid + NTHR * i; k[i] = (idx < Ls) ? __float_as_uint(AFFT[(size_t)e * TT + base + idx]) : 0u; if (idx < Ls) keys[idx] = k[i]; }
        if (tid == 0) { ctl[0] = 0u; ctl[1] = (unsigned)cap; ctl[2] = 0u; ctl[3] = 0u; }
        unsigned prefix = 0u;
#pragma unroll 1
        for (int p = 0; p < 4; ++p) { const int shift = 24 - 8 * p;
            if (tid < 256) hist[tid] = 0u;
            __syncthreads();
#pragma unroll
            for (int i = 0; i < 8; ++i) { const int idx = tid + NTHR * i; const bool cand = (idx < Ls) && (p == 0 || (k[i] >> (shift + 8)) == prefix);
                if (cand) atomicAdd((unsigned*)&hist[(k[i] >> shift) & 255u], 1u); }
            __syncthreads();
            if (tid < 64) {
                const unsigned need = ctl[1];
                const unsigned c0 = hist[255 - 4 * lane], c1 = hist[254 - 4 * lane], c2 = hist[253 - 4 * lane], c3 = hist[252 - 4 * lane];
                const unsigned s = c0 + c1 + c2 + c3; unsigned inc = s;
#pragma unroll
                for (int o = 1; o < 64; o <<= 1) { const unsigned v = __shfl_up(inc, o); if (lane >= o) inc += v; }
                const unsigned exc = inc - s;
                if (exc < need && inc >= need) { unsigned above = exc; int d;
                    if (above + c0 >= need) d = 255 - 4 * lane; else { above += c0; if (above + c1 >= need) d = 254 - 4 * lane; else { above += c1; if (above + c2 >= need) d = 253 - 4 * lane; else { above += c2; d = 252 - 4 * lane; } } }
                    ctl[0] = (prefix << 8) | (unsigned)d; ctl[1] = need - above; } }
            __syncthreads();
            prefix = ctl[0]; }
        const unsigned T = prefix; const unsigned need = ctl[1];
        int eqc = 0;
#pragma unroll
        for (int i = 0; i < 8; ++i) { const int idx = tid + NTHR * i; eqc += ((idx < Ls) && k[i] == T) ? 1 : 0; }
        if (eqc) atomicAdd((unsigned*)&ctl[3], (unsigned)eqc);
        __syncthreads();
        const bool all_eq = (ctl[3] == need);
#pragma unroll
        for (int i = 0; i < 8; ++i) { const int idx = tid + NTHR * i;
            if (idx < Ls && (k[i] > T || (all_eq && k[i] == T))) { const int s = (int)atomicAdd((unsigned*)&ctl[2], 1u); const int slot = e * SLOTS + slot0 + s;
                ROWMAP[slot] = base + idx; GATE[slot] = __uint_as_float(k[i]); INV[(size_t)(base + idx) * 16 + e] = slot; } }
        __syncthreads();
        if (!all_eq && tid == 0) {
            int s = (int)ctl[2]; unsigned left = need;
            for (int idx = 0; idx < Ls && left; ++idx) if (keys[idx] == T) { const int slot = e * SLOTS + slot0 + s; ROWMAP[slot] = base + idx; GATE[slot] = __uint_as_float(T); INV[(size_t)(base + idx) * 16 + e] = slot; ++s; --left; } }
        __syncthreads();
    }
}
__device__ __forceinline__ void phase_gather(const Args& a, int vcu, int G, bool with_ctx) {
    int tid_ = threadIdx.x; asm volatile("" : "+v"(tid_));
    const int tid = tid_, lane = tid & 63, wave = __builtin_amdgcn_readfirstlane(tid >> 6); unsigned char* ws = a.ws; asm volatile("" : "+s"(ws));
    const int* ROWMAP = (const int*)(ws + WS_ROWMAP); const bf16_t* HX = (const bf16_t*)(ws + WS_HX); bf16_t* XG = (bf16_t*)(ws + WS_XG);
    const int per = with_ctx ? SLOTS : NB * CAPX; const int gw = vcu * NWAVES + wave, NGW = G * NWAVES;
    for (int it = gw; it < NE * per; it += NGW) { const int e = it / per, s = it % per; const int slot = e * SLOTS + s; const int src = ROWMAP[slot];
        const u32x4* sp = (const u32x4*)(HX + (size_t)src * D) + 2 * lane; u32x4* dp = (u32x4*)(XG + (size_t)slot * D) + 2 * lane;
        const u32x4 v0 = sp[0], v1 = sp[1]; dp[0] = v0; dp[1] = v1; }
}
__device__ __forceinline__ void phase_combine(const Args& a, int vcu, int G, int l, bool with_ctx, bool final_norm, bool next_norm) {
    int tid_ = threadIdx.x; asm volatile("" : "+v"(tid_));
    const int tid = tid_, lane = tid & 63, wave = __builtin_amdgcn_readfirstlane(tid >> 6); unsigned char* ws = a.ws; asm volatile("" : "+s"(ws));
    const int* INV = (const int*)(ws + WS_INV); const bf16_t* OB = (const bf16_t*)(ws + WS_XG); const float* MOD = (const float*)(ws + WS_MOD) + (size_t)l * 9 * 6144;
    const float* MODN = (const float*)(ws + WS_MOD) + (size_t)(l + 1) * 9 * 6144; const float* gainn = a.in[I_N1G] + (l + 1) * D; bf16_t* HX = (bf16_t*)(ws + WS_HX);
    bf16_t* XB = (bf16_t*)(ws + WS_XB); const float* fng = a.in[I_FNG];
    const int nrows = with_ctx ? TT : TX; const int gw = vcu * NWAVES + wave, NGW = G * NWAVES;
    const float pz = (final_norm && __hip_atomic_load((unsigned*)(ws + WS_CTL) + 12288, __ATOMIC_RELAXED, __HIP_MEMORY_SCOPE_AGENT) != 0u) ? __builtin_nanf("") : 0.f;
    for (int rowa = gw; rowa < nrows; rowa += 2 * NGW) {
        int myinv[2]; f32x4 xv[2][4]; f32x4 acc[2][4];
#pragma unroll
        for (int u = 0; u < 2; ++u) { const int row = rowa + u * NGW; const bool ok = row < nrows; const int rr = ok ? row : rowa;
            myinv[u] = (lane < 16 && ok) ? INV[(size_t)rr * 16 + lane] : -1;
            const bf16_t* xr = XB + (size_t)rr * D;
#pragma unroll
            for (int j = 0; j < 4; ++j) { const u32x2 w = *(const u32x2*)(xr + 256 * j + 4 * lane); xv[u][j] = (f32x4){bflo(w.x), bfhi(w.x), bflo(w.y), bfhi(w.y)}; acc[u][j] = (f32x4){0.f, 0.f, 0.f, 0.f}; } }
#pragma unroll
        for (int u = 0; u < 2; ++u) {
            unsigned long long mask = __ballot(myinv[u] >= 0) & 0xffffull;
            while (mask) { int sl[4];
#pragma unroll
                for (int q = 0; q < 4; ++q) { if (mask) { const int e = __builtin_ctzll(mask); mask &= mask - 1; sl[q] = __shfl(myinv[u], e); } else sl[q] = -1; }
                u32x2 w[4][4];
#pragma unroll
                for (int q = 0; q < 4; ++q) { const bf16_t* orow = OB + (size_t)(sl[q] >= 0 ? sl[q] : 0) * D;
#pragma unroll
                    for (int j = 0; j < 4; ++j) w[q][j] = *(const u32x2*)(orow + 256 * j + 4 * lane); }
#pragma unroll
                for (int q = 0; q < 4; ++q) { const float m = (sl[q] >= 0) ? 1.0f : 0.0f;
#pragma unroll
                    for (int j = 0; j < 4; ++j) { acc[u][j][0] += m * bflo(w[q][j].x); acc[u][j][1] += m * bfhi(w[q][j].x); acc[u][j][2] += m * bflo(w[q][j].y); acc[u][j][3] += m * bfhi(w[q][j].y); } } } }
#pragma unroll
        for (int u = 0; u < 2; ++u) { const int row = rowa + u * NGW; if (row < nrows) {
            const bool lat = row < TX; float* xr = a.out + (size_t)row * D; bf16_t* xbr = XB + (size_t)row * D; const int mrow = lat ? (row >> 12) : 8;
            const float* gp = MOD + mrow * 6144 + 5 * 1024; f32x4 v[4]; float ss = 0.f;
#pragma unroll
            for (int j = 0; j < 4; ++j) { const f32x4 g = *(const f32x4*)(gp + 256 * j + 4 * lane); v[j] = xv[u][j] + g * acc[u][j];
                ss += (v[j][0] * v[j][0] + v[j][1] * v[j][1]) + (v[j][2] * v[j][2] + v[j][3] * v[j][3]); }
            if (final_norm) { const float rstd = 1.0f / sqrtf(wave_sum(ss) * (1.0f / D) + 1e-6f);
#pragma unroll
                for (int j = 0; j < 4; ++j) { const f32x4 g = *(const f32x4*)(fng + 256 * j + 4 * lane); *(f32x4*)(xr + 256 * j + 4 * lane) = v[j] * rstd * g + pz; } }
            else {
#pragma unroll
                for (int j = 0; j < 4; ++j) { u32x2 o; o.x = pk2(v[j][0], v[j][1]); o.y = pk2(v[j][2], v[j][3]); *(u32x2*)(xbr + 256 * j + 4 * lane) = o; }
                if (next_norm) { const float rstd = 1.0f / sqrtf(wave_sum(ss) * (1.0f / D) + 1e-6f); const float* shp = MODN + mrow * 6144; const float* scp = shp + 1024;
#pragma unroll
                    for (int j = 0; j < 4; ++j) { const f32x4 gg = *(const f32x4*)(gainn + 256 * j + 4 * lane), sh = *(const f32x4*)(shp + 256 * j + 4 * lane), sc = *(const f32x4*)(scp + 256 * j + 4 * lane);
                        const f32x4 hv = (v[j] * rstd * gg) * (1.0f + sc) + sh; u32x2 o; o.x = pk2(hv[0], hv[1]); o.y = pk2(hv[2], hv[3]); *(u32x2*)(HX + (size_t)row * D + 256 * j + 4 * lane) = o; } } } } }
    }
}

#define XBAR() do { xcd_barrier(bar); if (AMP_PHASE == 99) xcd_barrier(bar); } while (0)

__global__ void __launch_bounds__(NTHR, 2) fwd_kernel(Args a) {
    extern __shared__ __attribute__((aligned(16))) unsigned char lds[];
    cg::grid_group grid = cg::this_grid();
    const int G = gridDim.x, bx = blockIdx.x; const int vcu = (G % 8 == 0) ? (bx % 8) * (G / 8) + bx / 8 : bx;
    unsigned char* ws = a.ws;
    PG8_LAS unsigned char* glds = (PG8_LAS unsigned char*)lds;
    volatile LAS unsigned* bst = (volatile LAS unsigned*)((LAS unsigned char*)lds + LDS_BYTES - 16);
    if (threadIdx.x < 4) bst[threadIdx.x] = 0u;
    __syncthreads();
    XcdBarrier bar = xcd_barrier_post((unsigned*)(ws + WS_CTL), bst);
    { AMP_BEGIN(0) phase_prologue(a, lds, vcu, G); AMP_END(0) }
    grid.sync();
    for (int l = 0; l < 2; ++l) {
        const bool upd = (l == 0);
        asm volatile("" : "+s"(ws));
        const float* srcx = a.in[I_X]; const float* srcc = a.in[I_CTX];
        if (upd) {
            { AMP_BEGIN(1) phase_norm(a, lds, vcu, G, l, srcx, srcc, nullptr, a.in[I_N1G] + l * D, 0, TT, false); AMP_END(1) }
            { AMP_BEGIN(11) load_tw(a, (LAS unsigned char*)lds, threadIdx.x); for (int it = vcu; it < 1024; it += G) spectrum_item(a, (LAS unsigned char*)lds, it, threadIdx.x); AMP_END(11) }
            XBAR();
        }
        { AMP_BEGIN(2) pg8::Gemm g{(const pg8::bf16_t*)(ws + WS_HX), (const pg8::bf16_t*)(ws + WS_WIN_T) + (size_t)l * INW * D, TT, INW, D};
          pg8::GroupOrder S; S.init(1, TT / 256, INW / 256, 0, G, bx);
          { PG8_LAS float* rl = (PG8_LAS float*)(glds + 131072 + 20480); const float* rs = (const float*)(ws + WS_ROPE); int tx = threadIdx.x; asm volatile("" : "+v"(tx)); for (int i = tx; i < 2048; i += NTHR) rl[i] = rs[i]; __syncthreads(); }
          pg8::EpiIn E{(pg8::bf16_t*)(ws + WS_PX), (const PG8_LAS float*)(glds + 131072 + 20480), (pg8::bf16_t*)(ws + WS_UT), glds + 131072, 1.0f};
          pg8::gemm_phase<pg8::EpiIn, pg8::GroupOrder, true, true>(glds, g, S, E); AMP_END(2) }
        XBAR();
        { AMP_BEGIN(3) phase_mix1(a, lds, vcu, G, l); AMP_END(3) }
        XBAR();
        { AMP_BEGIN(4) pg8::Gemm g{(const pg8::bf16_t*)(ws + WS_Y), (const pg8::bf16_t*)(ws + WS_WOUT_T) + (size_t)l * D * D, TT, D, D};
          pg8::GroupOrder S; S.init(1, (upd ? TT : TX) / 256, D / 256, 0, G, bx);
          pg8::EpiOut E{a.in[I_X], a.in[I_CTX], (pg8::bf16_t*)(ws + WS_XB), (const float*)(ws + WS_MOD) + (size_t)l * 9 * 6144, upd ? 1 : 0};
          pg8::gemm_phase<pg8::EpiOut, pg8::GroupOrder, true, true>(glds, g, S, E); AMP_END(4) }
        XBAR();
        { AMP_BEGIN(5) phase_norm(a, lds, vcu, G, l, nullptr, nullptr, (const bf16_t*)(ws + WS_XB), a.in[I_N2G] + l * D, 3, upd ? TT : TX, true); AMP_END(5) }
        XBAR();
        { AMP_BEGIN(6) phase_select(a, lds, vcu, G, upd); AMP_END(6) }
        XBAR();
        { AMP_BEGIN(8) pg8::Gemm g{(const pg8::bf16_t*)(ws + WS_HX), (const pg8::bf16_t*)(ws + WS_WGU_T + (size_t)l * NE * 4096 * D), NE * SLOTS, NE * 4096, D};
          pg8::GroupOrder S; S.init(NE, upd ? 17 : 16, 16, 17, G, bx);
          { PG8_LAS float* sl = (PG8_LAS float*)(glds + 131072 + 17408); const float* ss = (const float*)(ws + WS_WSC) + l * 48; int tx = threadIdx.x; asm volatile("" : "+v"(tx)); if (tx < 32) sl[tx] = ss[tx]; __syncthreads(); }
          pg8::EpiGU E{(unsigned char*)(ws + WS_ACT), (const PG8_LAS float*)(glds + 131072 + 17408)};
          pg8::gemm_phase_gather<pg8::EpiGU, pg8::GroupOrder, true>(glds, g, (const int*)(ws + WS_ROWMAP), (PG8_LAS int*)(glds + 131072), S, E); AMP_END(8) }
        XBAR();
        { AMP_BEGIN(9) pg8::Gemm g{(const pg8::bf16_t*)(ws + WS_ACT), (const pg8::bf16_t*)(ws + WS_WD_T + (size_t)l * NE * D * FF), NE * SLOTS, NE * D, FF};
          pg8::GroupOrder S; S.init(NE, upd ? 17 : 16, 4, 17, G, bx);
          { PG8_LAS float* gl = (PG8_LAS float*)(glds + 131072); const float* gs = (const float*)(ws + WS_GATE); const float* ss = (const float*)(ws + WS_WSC) + l * 48 + 32; pg8::Unit uu; int tx = threadIdx.x; asm volatile("" : "+v"(tx));
            for (int i = 0; S.next(i, uu); ++i) if (tx < 256) gl[i * 256 + tx] = gs[uu.pm * 256 + tx] * ss[uu.pn >> 2];
            __syncthreads(); }
          pg8::EpiDown E{(pg8::bf16_t*)(ws + WS_XG), (const PG8_LAS float*)(glds + 131072)};
          pg8::gemm_phase<pg8::EpiDown, pg8::GroupOrder, true, true, true>(glds, g, S, E); AMP_END(9) }
        XBAR();
        { AMP_BEGIN(10) phase_combine(a, vcu, G, l, upd, !upd, upd); AMP_END(10) }
        if (upd) XBAR();
    }
}

extern "C" void kernel_launch(void* const* d_in, const int* in_sizes, int n_in, void* d_out, int out_size, void* d_ws, size_t ws_size, hipStream_t stream) {
    static int grid = 0;
    if (grid == 0) {
        int dev = 0, cus = 0, per_cu = 0;
        hipGetDevice(&dev); hipDeviceGetAttribute(&cus, hipDeviceAttributeMultiprocessorCount, dev);
        if (hipFuncSetAttribute((const void*)fwd_kernel, hipFuncAttributeMaxDynamicSharedMemorySize, LDS_BYTES) != hipSuccess) { fprintf(stderr, "kernel_launch: hipFuncSetAttribute failed\n"); grid = -1; return; }
        if (hipOccupancyMaxActiveBlocksPerMultiprocessor(&per_cu, (const void*)fwd_kernel, NTHR, LDS_BYTES) != hipSuccess || per_cu < 1) { fprintf(stderr, "kernel_launch: occupancy query failed (%d)\n", per_cu); grid = -1; return; }
        grid = cus * 1;
        if (n_in != N_IN || ws_size < WS_END) { fprintf(stderr, "kernel_launch: unexpected n_in %d / ws %zu\n", n_in, ws_size); grid = -1; return; }
    }
    if (grid < 0) return;
    if (hipMemsetAsync((char*)d_ws + WS_CTL, 0, 65536, stream) != hipSuccess) { fprintf(stderr, "kernel_launch: memset failed\n"); return; }
    Args a{};
    for (int i = 0; i < N_IN; ++i) a.in[i] = (const float*)d_in[i];
    a.out = (float*)d_out; a.ws = (unsigned char*)d_ws;
    void* args[] = {&a};
    hipError_t e = hipLaunchCooperativeKernel((const void*)fwd_kernel, dim3(grid), dim3(NTHR), args, LDS_BYTES, stream);
    if (e != hipSuccess) fprintf(stderr, "cooperative launch failed: %s (grid %d)\n", hipGetErrorString(e), grid);
}
```

```cpp
#define AMP_PHASE -1
#include <hip/hip_runtime.h>
#include <hip/hip_cooperative_groups.h>
#include <cstdio>
#include <cstdint>
#ifndef AMP_PHASE
#define AMP_PHASE -1
#endif
namespace cg = cooperative_groups;
namespace pg8 {
#define PG8_LAS __attribute__((address_space(3)))
typedef unsigned short bf16_t;
typedef short bf16x8 __attribute__((ext_vector_type(8)));
typedef float f32x4 __attribute__((ext_vector_type(4)));
typedef unsigned u32x4 __attribute__((ext_vector_type(4)));
typedef int v4i_t __attribute__((ext_vector_type(4)));
typedef int v8i_t __attribute__((ext_vector_type(8)));
constexpr int BM = 256, BK = 64, HALF = 128, HTB = HALF * BK * 2  , STAGE_BYTES = 8 * HTB, NXCD = 8, WGM = 8;

__host__ __device__ __forceinline__ int lds_byte(int r, int c) { const int st = (r >> 4) * 2 + (c >> 5), rr = r & 15, cc = c & 31, ob = rr * 64 + cc * 2; return st * 1024 + (ob ^ (((ob >> 9) & 1) << 5)); }
__host__ __device__ __forceinline__ void stage_rc(int b, int& R, int& C) { const int st = b / 1024, sb = b % 1024, swz = sb ^ (((sb >> 9) & 1) << 5); R = (st >> 1) * 16 + swz / 64; C = (st & 1) * 32 + (swz % 64) / 2; }
__host__ __device__ __forceinline__ int perm32(int rho) { const int n = rho >> 4, i = rho & 15; return 8 * (i >> 2) + 4 * n + (i & 3); }

struct Unit { int pm, pn; };
struct Gemm { const bf16_t* A; const bf16_t* Bt; int M, N, K; };

struct StaticOrder {
    int nM, nN, nwg, G, c;
    __host__ __device__ void init(int M, int N, int G_, int c_) { nM = M / BM; nN = N / BM; nwg = nM * nN; G = G_; c = c_; }
    __host__ __device__ bool next(int i, Unit& u) const {
        const long L = (long)i * G + c; if (L >= nwg) return false;
        int wgid = (int)L; { const int q = nwg / NXCD, r = nwg % NXCD, xcd = wgid % NXCD, off = wgid / NXCD; wgid = (xcd < r ? xcd * (q + 1) : r * (q + 1) + (xcd - r) * q) + off; }
        const int nig = WGM * nN, gid = wgid / nig, fm = gid * WGM, gsz = (nM - fm) < WGM ? (nM - fm) : WGM;
        u.pm = fm + ((wgid % nig) % gsz); u.pn = (wgid % nig) / gsz; return true;
    }
    __device__ __forceinline__ void a_ready(const Unit&) const {}
    __device__ __forceinline__ void done(const Unit&) const {}
};

__device__ __forceinline__ unsigned cvt_pk_bf16(float lo, float hi) { unsigned r; asm volatile("v_cvt_pk_bf16_f32 %0, %1, %2" : "=v"(r) : "v"(lo), "v"(hi)); return r; }
typedef float f32x2 __attribute__((ext_vector_type(2)));
__device__ __forceinline__ f32x2 gelu_pk(f32x2 v) {
    const f32x2 av = __builtin_elementwise_abs(v), d = av * 0.2316418882f + 1.0f;
    f32x2 t; t.x = __builtin_amdgcn_rcpf(d.x); t.y = __builtin_amdgcn_rcpf(d.y);
    f32x2 q = t * 0.5307027145f + (-0.7265760135f); q = q * t + 0.7107068705f; q = q * t + (-0.142248368f); q = q * t + 0.127414796f; q = q * t;
    const f32x2 s = (v * v) * (-0.72134752044f);
    f32x2 e; e.x = __builtin_amdgcn_exp2f(s.x); e.y = __builtin_amdgcn_exp2f(s.y);
    const f32x2 m = v * (q * e), r = v - m;
    f32x2 o; o.x = v.x < 0.f ? m.x : r.x; o.y = v.y < 0.f ? m.y : r.y; return o;
}


struct GroupOrder {
    int nMl, nNl, strideM, nper, nwg, G, c;
    __device__ __forceinline__ void init(int ng, int nMl_, int nNl_, int strideM_, int G_, int c_) { nMl = nMl_; nNl = nNl_; strideM = strideM_; nper = nMl_ * nNl_; nwg = ng * nper; G = G_; c = c_; }
    __device__ __forceinline__ bool next(int i, Unit& u) const {
        const long L = (long)i * G + c; if (L >= nwg) return false;
        int wgid = (int)L; { const int q = nwg / NXCD, r = nwg % NXCD, xcd = wgid % NXCD, off = wgid / NXCD; wgid = (xcd < r ? xcd * (q + 1) : r * (q + 1) + (xcd - r) * q) + off; }
        const int e = wgid / nper, id = wgid % nper;
        const int nig = WGM * nNl, gid = id / nig, fm = gid * WGM, gsz = (nMl - fm) < WGM ? (nMl - fm) : WGM;
        u.pm = e * strideM + fm + ((id % nig) % gsz); u.pn = e * nNl + (id % nig) / gsz; return true;
    }
    __device__ __forceinline__ void a_ready(const Unit&) const {}
    __device__ __forceinline__ void done(const Unit&) const {}
};

constexpr int TXR = 32768;
struct EpiIn {
    static constexpr bool PERM = true, AFTER_DRAIN = false;
    bf16_t* PX; const PG8_LAS float* rope; bf16_t* UT; PG8_LAS unsigned char* stgbase; float wsc;
    __device__ __forceinline__ void operator()(const f32x4 (&acc)[2][2][4][2], const Unit& u, int ui, int wr, int wc, int fr, int fq) const {
        const int row0 = u.pm * BM + wr * 64 + fr; const int col0 = u.pn * BM + wc * 32 + 8 * fq;
        const bool latent = u.pm < (TXR / BM);
        if (latent && u.pn < 3) {
            PG8_LAS unsigned char* stg = stgbase + (wr * 4 + wc) * 2304; const int lane = fq * 16 + fr;
            const int b = u.pm >> 4, trow0 = (u.pm & 15) * BM; const int col = lane >> 1, half = lane & 1;
#pragma unroll
            for (int ai = 0; ai < 2; ++ai)
#pragma unroll
                for (int bj = 0; bj < 2; ++bj)
#pragma unroll
                    for (int mh = 0; mh < 2; ++mh) {
#pragma unroll
                        for (int mm = 0; mm < 2; ++mm)
#pragma unroll
                            for (int n = 0; n < 2; ++n) { const f32x4 v = acc[ai][bj][2 * mh + mm][n] * wsc; const unsigned w0 = cvt_pk_bf16(v[0], v[1]), w1 = cvt_pk_bf16(v[2], v[3]);
                                PG8_LAS unsigned char* p = stg + (8 * fq + 4 * n) * 72 + (16 * mm + fr) * 2;
                                *(PG8_LAS unsigned short*)(p) = (unsigned short)w0; *(PG8_LAS unsigned short*)(p + 72) = (unsigned short)(w0 >> 16);
                                *(PG8_LAS unsigned short*)(p + 144) = (unsigned short)w1; *(PG8_LAS unsigned short*)(p + 216) = (unsigned short)(w1 >> 16); }
                        asm volatile("s_waitcnt lgkmcnt(0)" ::: "memory");
                        typedef unsigned u32x2v __attribute__((ext_vector_type(2)));
                        const PG8_LAS unsigned char* rp = stg + col * 72 + half * 32;
                        const u32x2v a0 = *(const PG8_LAS u32x2v*)(rp), a1 = *(const PG8_LAS u32x2v*)(rp + 8), a2 = *(const PG8_LAS u32x2v*)(rp + 16), a3 = *(const PG8_LAS u32x2v*)(rp + 24);
                        const int ch = u.pn * BM + bj * HALF + wc * 32 + col; const int t0 = trow0 + ai * HALF + wr * 64 + mh * 32 + half * 16;
                        u32x4* gp = (u32x4*)(UT + ((size_t)(b * 768 + ch)) * 4096 + t0);
                        gp[0] = (u32x4){a0.x, a0.y, a1.x, a1.y}; gp[1] = (u32x4){a2.x, a2.y, a3.x, a3.y};
                        asm volatile("s_waitcnt lgkmcnt(0)" ::: "memory"); }
            return;
        }
#pragma unroll
        for (int ai = 0; ai < 2; ++ai)
#pragma unroll
            for (int m = 0; m < 4; ++m) { const int row = row0 + ai * HALF + m * 16; bf16_t* rowp = PX + (size_t)row * 2304 + col0;
#pragma unroll
                for (int bj = 0; bj < 2; ++bj) { f32x4 v0 = acc[ai][bj][m][0] * wsc, v1 = acc[ai][bj][m][1] * wsc;
                    const bool dorope = latent && (u.pn == 4 || (u.pn == 6 && bj == 0));
                    if (dorope) {
                        const int t = row & 4095; const int pos = (wc & 1) ? (t & 63) : (t >> 6);
                        const PG8_LAS f32x4* rp = (const PG8_LAS f32x4*)(rope + (pos * 16 + 8 * (fq & 1)) * 2);
                        const f32x4 r0 = rp[0], r1 = rp[1], r2 = rp[2], r3 = rp[3];
                        f32x4 p0, p1;
#pragma unroll
                        for (int j = 0; j < 4; ++j) { auto r0_ = __builtin_amdgcn_permlane32_swap(__float_as_uint(v0[j]), __float_as_uint(v0[j]), false, false); auto r1_ = __builtin_amdgcn_permlane32_swap(__float_as_uint(v1[j]), __float_as_uint(v1[j]), false, false);
                            p0[j] = __uint_as_float(fq < 2 ? r0_[1] : r0_[0]); p1[j] = __uint_as_float(fq < 2 ? r1_[1] : r1_[0]); }
                        const float c0[4] = {r0[0], r0[2], r1[0], r1[2]}, s0[4] = {r0[1], r0[3], r1[1], r1[3]};
                        const float c1[4] = {r2[0], r2[2], r3[0], r3[2]}, s1[4] = {r2[1], r2[3], r3[1], r3[3]};
                        const bool lo = fq < 2;
#pragma unroll
                        for (int j = 0; j < 4; ++j) {
                            v0[j] = lo ? (v0[j] * c0[j] - p0[j] * s0[j]) : (p0[j] * s0[j] + v0[j] * c0[j]);
                            v1[j] = lo ? (v1[j] * c1[j] - p1[j] * s1[j]) : (p1[j] * s1[j] + v1[j] * c1[j]); }
                    }
                    u32x4 w; w.x = cvt_pk_bf16(v0[0], v0[1]); w.y = cvt_pk_bf16(v0[2], v0[3]); w.z = cvt_pk_bf16(v1[0], v1[1]); w.w = cvt_pk_bf16(v1[2], v1[3]);
                    *(u32x4*)(rowp + bj * HALF) = w; } }
    }
};
struct EpiOut {
    static constexpr bool PERM = true, AFTER_DRAIN = false;
    const float* xf_x; const float* xf_c; bf16_t* XB; const float* mod; int from_f32;
    __device__ __forceinline__ void operator()(const f32x4 (&acc)[2][2][4][2], const Unit& u, int ui, int wr, int wc, int fr, int fq) const {
        const int row0 = u.pm * BM + wr * 64 + fr, col0 = u.pn * BM + wc * 32 + 8 * fq;
        const bool latent = u.pm < (TXR / BM);
#pragma unroll
        for (int ai = 0; ai < 2; ++ai)
#pragma unroll
            for (int m = 0; m < 4; ++m) { const int row = row0 + ai * HALF + m * 16;
                const int mrow = latent ? (row >> 12) : 8; const float* gp = mod + mrow * 6144 + 2 * 1024 + col0;
                bf16_t* xb = XB + (size_t)row * 1024 + col0;
#pragma unroll
                for (int bj = 0; bj < 2; ++bj) { const f32x4 g0 = *(const f32x4*)(gp + bj * HALF), g1 = *(const f32x4*)(gp + bj * HALF + 4); f32x4 x0, x1;
                    if (from_f32) { const float* xo = (latent ? xf_x + (size_t)row * 1024 : xf_c + (size_t)(row - TXR) * 1024) + col0 + bj * HALF; x0 = *(const f32x4*)xo; x1 = *(const f32x4*)(xo + 4); }
                    else { const u32x4 w = *(const u32x4*)(xb + bj * HALF); x0 = (f32x4){__uint_as_float(w.x << 16), __uint_as_float(w.x & 0xffff0000u), __uint_as_float(w.y << 16), __uint_as_float(w.y & 0xffff0000u)};
                        x1 = (f32x4){__uint_as_float(w.z << 16), __uint_as_float(w.z & 0xffff0000u), __uint_as_float(w.w << 16), __uint_as_float(w.w & 0xffff0000u)}; }
                    const f32x4 v0 = x0 + g0 * acc[ai][bj][m][0], v1 = x1 + g1 * acc[ai][bj][m][1];
                    u32x4 o; o.x = cvt_pk_bf16(v0[0], v0[1]); o.y = cvt_pk_bf16(v0[2], v0[3]); o.z = cvt_pk_bf16(v1[0], v1[1]); o.w = cvt_pk_bf16(v1[2], v1[3]);
                    *(u32x4*)(xb + bj * HALF) = o; } }
    }
};
struct EpiGU {
    static constexpr bool PERM = true, AFTER_DRAIN = false;
    unsigned char* ACT; const PG8_LAS float* wsc;
    __device__ __forceinline__ void operator()(const f32x4 (&acc)[2][2][4][2], const Unit& u, int ui, int wr, int wc, int fr, int fq) const {
        const int row0 = u.pm * BM + wr * 64 + fr; const int col0 = (u.pn & 15) * 128 + wc * 32 + 8 * fq; const int e = u.pn >> 4; const float sg = wsc[e], su = wsc[16 + e]; const float nsl = -1.4426950408889634f * sg, sgu = sg * su;
#pragma unroll
        for (int ai = 0; ai < 2; ++ai)
#pragma unroll
            for (int m = 0; m < 4; ++m) { unsigned char* rowp = ACT + (size_t)(row0 + ai * HALF + m * 16) * 2048 + col0;
                float h[8];
#pragma unroll
                for (int n = 0; n < 2; ++n)
#pragma unroll
                    for (int j = 0; j < 4; ++j) { const float ag = acc[ai][0][m][n][j], au = acc[ai][1][m][n][j]; const float r = __builtin_amdgcn_rcpf(1.0f + __builtin_amdgcn_exp2f(ag * nsl)); h[4 * n + j] = __builtin_amdgcn_fmed3f((ag * au) * sgu * r, -448.0f, 448.0f); }
                int p0 = 0, p1 = 0;
                p0 = __builtin_amdgcn_cvt_pk_fp8_f32(h[0], h[1], p0, false); p0 = __builtin_amdgcn_cvt_pk_fp8_f32(h[2], h[3], p0, true);
                p1 = __builtin_amdgcn_cvt_pk_fp8_f32(h[4], h[5], p1, false); p1 = __builtin_amdgcn_cvt_pk_fp8_f32(h[6], h[7], p1, true);
                typedef int i32x2v __attribute__((ext_vector_type(2)));
                *(i32x2v*)rowp = (i32x2v){p0, p1}; }
    }
};
struct EpiDown {
    static constexpr bool PERM = true, AFTER_DRAIN = false;
    bf16_t* OB; const PG8_LAS float* gl;
    __device__ __forceinline__ void operator()(const f32x4 (&acc)[2][2][4][2], const Unit& u, int ui, int wr, int wc, int fr, int fq) const {
        const int row0 = u.pm * BM + wr * 64 + fr; const int col0 = (u.pn & 3) * BM + wc * 32 + 8 * fq;
#pragma unroll
        for (int ai = 0; ai < 2; ++ai)
#pragma unroll
            for (int m = 0; m < 4; ++m) { const int row = row0 + ai * HALF + m * 16; const float g = gl[ui * BM + ai * HALF + wr * 64 + m * 16 + fr]; bf16_t* rowp = OB + (size_t)row * 1024 + col0;
#pragma unroll
                for (int bj = 0; bj < 2; ++bj) { const f32x4 v0 = acc[ai][bj][m][0] * g, v1 = acc[ai][bj][m][1] * g;
                    u32x4 w; w.x = cvt_pk_bf16(v0[0], v0[1]); w.y = cvt_pk_bf16(v0[2], v0[3]); w.z = cvt_pk_bf16(v1[0], v1[1]); w.w = cvt_pk_bf16(v1[2], v1[3]);
                    *(u32x4*)(rowp + bj * HALF) = w; } }
    }
};

template <class Epi, class Sched, bool ALIGN_EPI = false, bool SP2 = false, bool FP8 = false>
__device__ __forceinline__ void gemm_phase(PG8_LAS unsigned char* lds, const Gemm g, const Sched& S, const Epi& E) {
    int tid_ = threadIdx.x; asm volatile("" : "+v"(tid_));
    const int tid = tid_, wid = __builtin_amdgcn_readfirstlane(tid >> 6), lane = tid & 63, wr = wid >> 2, wc = wid & 3, fr = lane & 15, fq = lane >> 4;
    const int K = g.K, KB = FP8 ? K : 2 * K  , nt = KB / (BK * 2);
    unsigned voffA[2], voffB[2];
#pragma unroll
    for (int i = 0; i < 2; ++i) { int R, C; stage_rc(tid * 16 + i * 8192, R, C); const int Rb = Epi::PERM ? ((R & ~31) + perm32(R & 31)) : R;
        voffA[i] = (unsigned)(R * KB + C * 2); voffB[i] = (unsigned)(Rb * KB + C * 2); }
    const size_t kstep = (size_t)(BK * 2);
    const size_t hstep = (size_t)HALF * KB;
    const size_t tstep = 2 * hstep;
    const unsigned ldsw = (unsigned)wid * 1024u;
    const int aoff = lds_byte(wr * 64 + fr, fq * 8), boff = lds_byte(wc * 32 + fr, fq * 8);
#define PG8_SA(b, h) (((b) * 2 + (h)) * HTB)
#define PG8_SB(b, h) ((4 + (b) * 2 + (h)) * HTB)
#define PG8_STAGE(bufoff, gbase, voff) do { _Pragma("unroll") for (int _i = 0; _i < 2; ++_i) \
        __builtin_amdgcn_global_load_lds((const unsigned*)((const char*)(gbase) + (voff)[_i]), (PG8_LAS unsigned*)(lds + (bufoff) + ldsw + _i * 8192), 16, 0, 0); } while (0)
#define PG8_LDA(dst, b, h) do { _Pragma("unroll") for (int m = 0; m < 4; ++m) { if constexpr (FP8) { dst##8[m].lo = *(const PG8_LAS v4i_t*)(lds + PG8_SA(b, h) + aoff + m * 2048); dst##8[m].hi = *(const PG8_LAS v4i_t*)(lds + PG8_SA(b, h) + aoff + m * 2048 + 1024); } \
        else { _Pragma("unroll") for (int k = 0; k < 2; ++k) dst[m][k] = *(const PG8_LAS bf16x8*)(lds + PG8_SA(b, h) + aoff + m * 2048 + k * 1024); } } } while (0)
#define PG8_LDB(dst, b, h) do { _Pragma("unroll") for (int n = 0; n < 2; ++n) { if constexpr (FP8) { dst##8[n].lo = *(const PG8_LAS v4i_t*)(lds + PG8_SB(b, h) + boff + n * 2048); dst##8[n].hi = *(const PG8_LAS v4i_t*)(lds + PG8_SB(b, h) + boff + n * 2048 + 1024); } \
        else { _Pragma("unroll") for (int k = 0; k < 2; ++k) dst[n][k] = *(const PG8_LAS bf16x8*)(lds + PG8_SB(b, h) + boff + n * 2048 + k * 1024); } } } while (0)
#define PG8_CAT8(x0, x1) __builtin_shufflevector(__builtin_bit_cast(v4i_t, x0), __builtin_bit_cast(v4i_t, x1), 0, 1, 2, 3, 4, 5, 6, 7)
#define PG8_MMA(ai, bj, At, Bt) do { __builtin_amdgcn_s_setprio(1); if constexpr (FP8) asm volatile("s_nop 1" ::: "memory"); _Pragma("unroll") for (int m = 0; m < 4; ++m) _Pragma("unroll") for (int n = 0; n < 2; ++n) { \
        if constexpr (FP8) asm volatile("v_mfma_scale_f32_16x16x128_f8f6f4 %0, %1, %2, %0, %3, %3 op_sel_hi:[0,0,0]" : "+v"(acc[ai][bj][m][n]) : "v"(Bt##8[n]), "v"(At##8[m]), "v"(one_scale)); \
        else { _Pragma("unroll") for (int k = 0; k < 2; ++k) acc[ai][bj][m][n] = __builtin_amdgcn_mfma_f32_16x16x32_bf16(Bt[n][k], At[m][k], acc[ai][bj][m][n], 0, 0, 0); } } if constexpr (FP8) asm volatile("s_nop 15\n\ts_nop 3" ::: "memory"); __builtin_amdgcn_s_setprio(0); } while (0)
#define PG8_WAIT_V(n) asm volatile("s_waitcnt vmcnt(" #n ")" ::: "memory")
#define PG8_WAIT_L(n) asm volatile("s_waitcnt lgkmcnt(" #n ")" ::: "memory")
#define PG8_BAR __builtin_amdgcn_s_barrier()
#define PG8_SCHED __builtin_amdgcn_sched_barrier(0)
    Unit cur, nxt; int ui = 0;
    if (!S.next(0, cur)) return;
    f32x4 acc[2][2][4][2];
#pragma unroll
    for (int a = 0; a < 2; ++a)
#pragma unroll
        for (int b = 0; b < 2; ++b)
#pragma unroll
            for (int m = 0; m < 4; ++m)
#pragma unroll
                for (int n = 0; n < 2; ++n) acc[a][b][m][n] = (f32x4){0.f, 0.f, 0.f, 0.f};
    bf16x8 At[4][2], B0[2][2], B1[2][2];
    v8i_t At8[4], B08[2], B18[2];
    int one_scale = 0x7f7f7f7f; asm volatile("" : "+v"(one_scale));
    const char* cA = (const char*)g.A + (size_t)cur.pm * tstep; const char* cB = (const char*)g.Bt + (size_t)cur.pn * tstep;
    S.a_ready(cur);
    if constexpr (SP2) {
        PG8_STAGE(PG8_SB(0, 0), cB, voffB); PG8_STAGE(PG8_SB(0, 1), cB + hstep, voffB); PG8_STAGE(PG8_SA(0, 0), cA, voffA); PG8_STAGE(PG8_SA(0, 1), cA + hstep, voffA);
        if (wr == 1) PG8_BAR;
        PG8_WAIT_V(2); PG8_BAR;
        PG8_STAGE(PG8_SB(1, 0), cB + kstep, voffB); PG8_STAGE(PG8_SA(1, 0), cA + kstep, voffA); PG8_STAGE(PG8_SB(1, 1), cB + hstep + kstep, voffB);
        PG8_WAIT_V(6); PG8_BAR;
    } else {
        PG8_STAGE(PG8_SB(0, 0), cB, voffB); PG8_STAGE(PG8_SA(0, 0), cA, voffA); PG8_STAGE(PG8_SB(0, 1), cB + hstep, voffB); PG8_STAGE(PG8_SA(0, 1), cA + hstep, voffA);
        if (wr == 1) PG8_BAR;
        PG8_WAIT_V(4); PG8_BAR;
        PG8_STAGE(PG8_SB(1, 0), cB + kstep, voffB); PG8_STAGE(PG8_SA(1, 0), cA + kstep, voffA); PG8_STAGE(PG8_SB(1, 1), cB + hstep + kstep, voffB);
        PG8_WAIT_V(6); PG8_BAR;
    }
    for (;;) {
        const bool has_next = S.next(ui + 1, nxt);
        const char* nA = has_next ? (const char*)g.A + (size_t)nxt.pm * tstep : cA; const char* nB = has_next ? (const char*)g.Bt + (size_t)nxt.pn * tstep : cB;
#pragma nounroll
        for (int t = 0; t < nt; t += 2) {
            const bool last = (t == nt - 2);
            const char* a1 = cA + (size_t)(t + 1) * kstep;
            const char* a2 = last ? nA : cA + (size_t)(t + 2) * kstep; const char* b2 = last ? nB : cB + (size_t)(t + 2) * kstep;
            const char* a3 = a2 + kstep; const char* b3 = b2 + kstep;
            if (last && has_next) S.a_ready(nxt);
            if constexpr (SP2) {
            PG8_LDB(B0, 0, 0); PG8_LDB(B1, 0, 1); PG8_SCHED; PG8_LDA(At, 0, 0); PG8_STAGE(PG8_SA(1, 1), a1 + hstep, voffA);
            PG8_WAIT_V(8); PG8_WAIT_L(0); PG8_BAR; PG8_MMA(0, 0, At, B0); PG8_MMA(0, 1, At, B1); PG8_BAR; PG8_SCHED;
            PG8_LDA(At, 0, 1); PG8_STAGE(PG8_SB(0, 0), b2, voffB); PG8_STAGE(PG8_SB(0, 1), b2 + hstep, voffB); PG8_STAGE(PG8_SA(0, 0), a2, voffA);
            PG8_WAIT_V(8); PG8_WAIT_L(0); PG8_BAR; PG8_MMA(1, 0, At, B0); PG8_MMA(1, 1, At, B1); PG8_BAR; PG8_SCHED;
            PG8_LDB(B0, 1, 0); PG8_LDB(B1, 1, 1); PG8_SCHED; PG8_LDA(At, 1, 0); PG8_STAGE(PG8_SA(0, 1), a2 + hstep, voffA);
            PG8_WAIT_V(8); PG8_WAIT_L(0); PG8_BAR; PG8_MMA(0, 0, At, B0); PG8_MMA(0, 1, At, B1); PG8_BAR; PG8_SCHED;
            PG8_LDA(At, 1, 1); PG8_STAGE(PG8_SB(1, 0), b3, voffB); PG8_STAGE(PG8_SB(1, 1), b3 + hstep, voffB); PG8_STAGE(PG8_SA(1, 0), a3, voffA);
            PG8_WAIT_V(8); PG8_WAIT_L(0); PG8_BAR; PG8_MMA(1, 0, At, B0); PG8_MMA(1, 1, At, B1); PG8_BAR; PG8_SCHED;
            } else {
            PG8_LDB(B0, 0, 0); PG8_SCHED; PG8_LDA(At, 0, 0); PG8_STAGE(PG8_SA(1, 1), a1 + hstep, voffA);
            PG8_WAIT_L(8); PG8_BAR; PG8_WAIT_L(0); PG8_MMA(0, 0, At, B0); PG8_BAR; PG8_SCHED;
            PG8_LDB(B1, 0, 1); PG8_STAGE(PG8_SB(0, 0), b2, voffB);
            PG8_BAR; PG8_WAIT_L(0); PG8_MMA(0, 1, At, B1); PG8_BAR;
            PG8_LDA(At, 0, 1); PG8_STAGE(PG8_SA(0, 0), a2, voffA);
            PG8_BAR; PG8_WAIT_L(0); PG8_MMA(1, 0, At, B0); PG8_BAR; PG8_SCHED;
            PG8_STAGE(PG8_SB(0, 1), b2 + hstep, voffB);
            PG8_WAIT_V(6); PG8_BAR; PG8_MMA(1, 1, At, B1); PG8_BAR;
            PG8_LDB(B0, 1, 0); PG8_SCHED; PG8_LDA(At, 1, 0); PG8_STAGE(PG8_SA(0, 1), a2 + hstep, voffA);
            PG8_WAIT_L(8); PG8_BAR; PG8_WAIT_L(0); PG8_MMA(0, 0, At, B0); PG8_BAR; PG8_SCHED;
            PG8_LDB(B1, 1, 1); PG8_STAGE(PG8_SB(1, 0), b3, voffB);
            PG8_BAR; PG8_WAIT_L(0); PG8_MMA(0, 1, At, B1); PG8_BAR;
            PG8_LDA(At, 1, 1); PG8_STAGE(PG8_SA(1, 0), a3, voffA);
            PG8_BAR; PG8_WAIT_L(0); PG8_MMA(1, 0, At, B0); PG8_BAR; PG8_SCHED;
            PG8_STAGE(PG8_SB(1, 1), b3 + hstep, voffB);
            PG8_WAIT_V(6); PG8_BAR; PG8_MMA(1, 1, At, B1); PG8_BAR;
            }
        }
        if constexpr (ALIGN_EPI) { if (wr == 0) PG8_BAR; }
        if constexpr (!Epi::AFTER_DRAIN) { E(acc, cur, ui, wr, wc, fr, fq); S.done(cur); }
        if (!has_next) break;
#pragma unroll
        for (int a = 0; a < 2; ++a)
#pragma unroll
            for (int b = 0; b < 2; ++b)
#pragma unroll
                for (int m = 0; m < 4; ++m)
#pragma unroll
                    for (int n = 0; n < 2; ++n) acc[a][b][m][n] = (f32x4){0.f, 0.f, 0.f, 0.f};
        cur = nxt; cA = nA; cB = nB; ++ui;
        if constexpr (ALIGN_EPI) { if (wr == 1) PG8_BAR; }
    }
    PG8_WAIT_V(0);
    if constexpr (!ALIGN_EPI) { if (wr == 0) PG8_BAR; }
    PG8_BAR;
    if constexpr (Epi::AFTER_DRAIN) { E.fused(acc, cur, wr, wc, fr, fq, lds, wid, lane); S.done(cur); }
#undef PG8_SA
#undef PG8_SB
#undef PG8_STAGE
#undef PG8_LDA
#undef PG8_LDB
#undef PG8_MMA
#undef PG8_CAT8
#undef PG8_WAIT_V
#undef PG8_WAIT_L
#undef PG8_BAR
#undef PG8_SCHED
}
template <class Epi, class Sched, bool FP8 = false>
__device__ __forceinline__ void gemm_phase_gather(PG8_LAS unsigned char* lds, const Gemm g, const int* rowmap, PG8_LAS int* idxs, const Sched& S, const Epi& E) {
    constexpr bool ALIGN_EPI = true, SP2 = true;
    int tid_ = threadIdx.x; asm volatile("" : "+v"(tid_));
    const int tid = tid_, wid = __builtin_amdgcn_readfirstlane(tid >> 6), lane = tid & 63, wr = wid >> 2, wc = wid & 3, fr = lane & 15, fq = lane >> 4;
    const int K = g.K, KB = FP8 ? K : 2 * K  , nt = KB / (BK * 2);
    unsigned voffB[2]; int RA[2], CA[2];
#pragma unroll
    for (int i = 0; i < 2; ++i) { int R, C; stage_rc(tid * 16 + i * 8192, R, C); const int Rb = Epi::PERM ? ((R & ~31) + perm32(R & 31)) : R;
        RA[i] = R; CA[i] = C * 2; voffB[i] = (unsigned)(Rb * KB + C * 2); }
    const size_t kstep = (size_t)(BK * 2);
    const size_t hstep = (size_t)HALF * KB;
    const size_t tstep = 2 * hstep;
    const unsigned ldsw = (unsigned)wid * 1024u;
    const int aoff = lds_byte(wr * 64 + fr, fq * 8), boff = lds_byte(wc * 32 + fr, fq * 8);
#define PG8_SA(b, h) (((b) * 2 + (h)) * HTB)
#define PG8_SB(b, h) ((4 + (b) * 2 + (h)) * HTB)
#define PG8_STAGE(bufoff, gbase, voff) do { _Pragma("unroll") for (int _i = 0; _i < 2; ++_i) \
        __builtin_amdgcn_global_load_lds((const unsigned*)((const char*)(gbase) + (voff)[_i]), (PG8_LAS unsigned*)(lds + (bufoff) + ldsw + _i * 8192), 16, 0, 0); } while (0)
#define PG8_STAGE_AG(bufoff, P, h, koff) do { _Pragma("unroll") for (int _i = 0; _i < 2; ++_i) \
        __builtin_amdgcn_global_load_lds((const unsigned*)((const char*)g.A + (size_t)((P)[h][_i] + (unsigned)(koff))), (PG8_LAS unsigned*)(lds + (bufoff) + ldsw + _i * 8192), 16, 0, 0); } while (0)
#define PG8_ROWPTR(P, u) do { _Pragma("unroll") for (int _h = 0; _h < 2; ++_h) _Pragma("unroll") for (int _i = 0; _i < 2; ++_i) \
        (P)[_h][_i] = (unsigned)idxs[(u) * BM + _h * HALF + RA[_i]] * (unsigned)KB + (unsigned)CA[_i]; } while (0)
#define PG8_LDA(dst, b, h) do { _Pragma("unroll") for (int m = 0; m < 4; ++m) { if constexpr (FP8) { dst##8[m].lo = *(const PG8_LAS v4i_t*)(lds + PG8_SA(b, h) + aoff + m * 2048); dst##8[m].hi = *(const PG8_LAS v4i_t*)(lds + PG8_SA(b, h) + aoff + m * 2048 + 1024); } \
        else { _Pragma("unroll") for (int k = 0; k < 2; ++k) dst[m][k] = *(const PG8_LAS bf16x8*)(lds + PG8_SA(b, h) + aoff + m * 2048 + k * 1024); } } } while (0)
#define PG8_LDB(dst, b, h) do { _Pragma("unroll") for (int n = 0; n < 2; ++n) { if constexpr (FP8) { dst##8[n].lo = *(const PG8_LAS v4i_t*)(lds + PG8_SB(b, h) + boff + n * 2048); dst##8[n].hi = *(const PG8_LAS v4i_t*)(lds + PG8_SB(b, h) + boff + n * 2048 + 1024); } \
        else { _Pragma("unroll") for (int k = 0; k < 2; ++k) dst[n][k] = *(const PG8_LAS bf16x8*)(lds + PG8_SB(b, h) + boff + n * 2048 + k * 1024); } } } while (0)
#define PG8_CAT8(x0, x1) __builtin_shufflevector(__builtin_bit_cast(v4i_t, x0), __builtin_bit_cast(v4i_t, x1), 0, 1, 2, 3, 4, 5, 6, 7)
#define PG8_MMA(ai, bj, At, Bt) do { __builtin_amdgcn_s_setprio(1); if constexpr (FP8) asm volatile("s_nop 1" ::: "memory"); _Pragma("unroll") for (int m = 0; m < 4; ++m) _Pragma("unroll") for (int n = 0; n < 2; ++n) { \
        if constexpr (FP8) asm volatile("v_mfma_scale_f32_16x16x128_f8f6f4 %0, %1, %2, %0, %3, %3 op_sel_hi:[0,0,0]" : "+v"(acc[ai][bj][m][n]) : "v"(Bt##8[n]), "v"(At##8[m]), "v"(one_scale)); \
        else { _Pragma("unroll") for (int k = 0; k < 2; ++k) acc[ai][bj][m][n] = __builtin_amdgcn_mfma_f32_16x16x32_bf16(Bt[n][k], At[m][k], acc[ai][bj][m][n], 0, 0, 0); } } if constexpr (FP8) asm volatile("s_nop 15\n\ts_nop 3" ::: "memory"); __builtin_amdgcn_s_setprio(0); } while (0)
#define PG8_WAIT_V(n) asm volatile("s_waitcnt vmcnt(" #n ")" ::: "memory")
#define PG8_WAIT_L(n) asm volatile("s_waitcnt lgkmcnt(" #n ")" ::: "memory")
#define PG8_BAR __builtin_amdgcn_s_barrier()
#define PG8_SCHED __builtin_amdgcn_sched_barrier(0)
    Unit cur, nxt; int ui = 0;
    if (!S.next(0, cur)) return;
    f32x4 acc[2][2][4][2];
#pragma unroll
    for (int a = 0; a < 2; ++a)
#pragma unroll
        for (int b = 0; b < 2; ++b)
#pragma unroll
            for (int m = 0; m < 4; ++m)
#pragma unroll
                for (int n = 0; n < 2; ++n) acc[a][b][m][n] = (f32x4){0.f, 0.f, 0.f, 0.f};
    bf16x8 At[4][2], B0[2][2], B1[2][2];
    v8i_t At8[4], B08[2], B18[2];
    int one_scale = 0x7f7f7f7f; asm volatile("" : "+v"(one_scale));
    const char* cB = (const char*)g.Bt + (size_t)cur.pn * tstep;
    unsigned cP[2][2], nP[2][2];
    { Unit uu; for (int i = 0; S.next(i, uu); ++i) if (tid < BM) idxs[i * BM + tid] = rowmap[uu.pm * BM + tid]; }
    asm volatile("s_waitcnt vmcnt(0) lgkmcnt(0)" ::: "memory"); __builtin_amdgcn_s_barrier(); asm volatile("" ::: "memory");
    PG8_ROWPTR(cP, 0);
    S.a_ready(cur);
    if constexpr (SP2) {
        PG8_STAGE(PG8_SB(0, 0), cB, voffB); PG8_STAGE(PG8_SB(0, 1), cB + hstep, voffB); PG8_STAGE_AG(PG8_SA(0, 0), cP, 0, 0); PG8_STAGE_AG(PG8_SA(0, 1), cP, 1, 0);
        if (wr == 1) PG8_BAR;
        PG8_WAIT_V(2); PG8_BAR;
        PG8_STAGE(PG8_SB(1, 0), cB + kstep, voffB); PG8_STAGE_AG(PG8_SA(1, 0), cP, 0, kstep); PG8_STAGE(PG8_SB(1, 1), cB + hstep + kstep, voffB);
        PG8_WAIT_V(6); PG8_BAR;
    }
    for (;;) {
        const bool has_next = S.next(ui + 1, nxt);
        const char* nB = has_next ? (const char*)g.Bt + (size_t)nxt.pn * tstep : cB;
        if (has_next) { PG8_ROWPTR(nP, ui + 1); } else { _Pragma("unroll") for (int _h = 0; _h < 2; ++_h) _Pragma("unroll") for (int _i = 0; _i < 2; ++_i) nP[_h][_i] = cP[_h][_i]; }
#pragma nounroll
        for (int t = 0; t < nt; t += 2) {
            const bool last = (t == nt - 2);
            const size_t k1 = (size_t)(t + 1) * kstep, k2 = last ? 0 : (size_t)(t + 2) * kstep, k3 = k2 + kstep;
            unsigned sP[2][2];
            _Pragma("unroll") for (int _h = 0; _h < 2; ++_h) _Pragma("unroll") for (int _i = 0; _i < 2; ++_i) sP[_h][_i] = last ? nP[_h][_i] : cP[_h][_i];
            const char* b2 = last ? nB : cB + (size_t)(t + 2) * kstep; const char* b3 = b2 + kstep;
            if (last && has_next) S.a_ready(nxt);
            if constexpr (SP2) {
            PG8_LDB(B0, 0, 0); PG8_LDB(B1, 0, 1); PG8_SCHED; PG8_LDA(At, 0, 0); PG8_STAGE_AG(PG8_SA(1, 1), cP, 1, k1);
            PG8_WAIT_V(8); PG8_WAIT_L(0); PG8_BAR; PG8_MMA(0, 0, At, B0); PG8_MMA(0, 1, At, B1); PG8_BAR; PG8_SCHED;
            PG8_LDA(At, 0, 1); PG8_STAGE(PG8_SB(0, 0), b2, voffB); PG8_STAGE(PG8_SB(0, 1), b2 + hstep, voffB); PG8_STAGE_AG(PG8_SA(0, 0), sP, 0, k2);
            PG8_WAIT_V(8); PG8_WAIT_L(0); PG8_BAR; PG8_MMA(1, 0, At, B0); PG8_MMA(1, 1, At, B1); PG8_BAR; PG8_SCHED;
            PG8_LDB(B0, 1, 0); PG8_LDB(B1, 1, 1); PG8_SCHED; PG8_LDA(At, 1, 0); PG8_STAGE_AG(PG8_SA(0, 1), sP, 1, k2);
            PG8_WAIT_V(8); PG8_WAIT_L(0); PG8_BAR; PG8_MMA(0, 0, At, B0); PG8_MMA(0, 1, At, B1); PG8_BAR; PG8_SCHED;
            PG8_LDA(At, 1, 1); PG8_STAGE(PG8_SB(1, 0), b3, voffB); PG8_STAGE(PG8_SB(1, 1), b3 + hstep, voffB); PG8_STAGE_AG(PG8_SA(1, 0), sP, 0, k3);
            PG8_WAIT_V(8); PG8_WAIT_L(0); PG8_BAR; PG8_MMA(1, 0, At, B0); PG8_MMA(1, 1, At, B1); PG8_BAR; PG8_SCHED;
            }
        }
        if constexpr (ALIGN_EPI) { if (wr == 0) PG8_BAR; }
        if constexpr (!Epi::AFTER_DRAIN) { E(acc, cur, ui, wr, wc, fr, fq); if (AMP_PHASE == 81) { asm volatile("" ::: "memory"); E(acc, cur, ui, wr, wc, fr, fq); } S.done(cur); }
        if (!has_next) break;
#pragma unroll
        for (int a = 0; a < 2; ++a)
#pragma unroll
            for (int b = 0; b < 2; ++b)
#pragma unroll
                for (int m = 0; m < 4; ++m)
#pragma unroll
                    for (int n = 0; n < 2; ++n) acc[a][b][m][n] = (f32x4){0.f, 0.f, 0.f, 0.f};
        cur = nxt; cB = nB; ++ui;
        _Pragma("unroll") for (int _h = 0; _h < 2; ++_h) _Pragma("unroll") for (int _i = 0; _i < 2; ++_i) cP[_h][_i] = nP[_h][_i];
        if constexpr (ALIGN_EPI) { if (wr == 1) PG8_BAR; }
    }
    PG8_WAIT_V(0);
    if constexpr (!ALIGN_EPI) { if (wr == 0) PG8_BAR; }
    PG8_BAR;
    if constexpr (Epi::AFTER_DRAIN) { E.fused(acc, cur, wr, wc, fr, fq, lds, wid, lane); S.done(cur); }
#undef PG8_SA
#undef PG8_SB
#undef PG8_STAGE
#undef PG8_STAGE_AG
#undef PG8_ROWPTR
#undef PG8_LDA
#undef PG8_LDB
#undef PG8_MMA
#undef PG8_CAT8
#undef PG8_WAIT_V
#undef PG8_WAIT_L
#undef PG8_BAR
#undef PG8_SCHED
}

}

#define LAS __attribute__((address_space(3)))
typedef unsigned short bf16_t;
typedef float f32x4 __attribute__((ext_vector_type(4)));
typedef unsigned u32x4 __attribute__((ext_vector_type(4)));
typedef unsigned u32x2 __attribute__((ext_vector_type(2)));
typedef __bf16 bf16x2_t __attribute__((ext_vector_type(2)));
constexpr int NWAVES = 8, NTHR = 512;
constexpr int D = 1024, NB = 8, SEQ = 4096, LCTX = 256, TX = NB * SEQ, TC = NB * LCTX, TT = TX + TC, INW = 2304, NE = 16, FF = 2048;
constexpr int CAPX = 512, CAPC = 32, SLOTS = NB * CAPX + NB * CAPC;
constexpr float LOG2E = 1.4426950408889634f;
constexpr int LDS_BYTES = 163840;
enum { I_X = 0, I_C, I_CTX, I_CCTX, I_ADAW, I_ADAB, I_N1G, I_N2G, I_WIN, I_HCW, I_HCB, I_HW1, I_HB1, I_HW2, I_HB2, I_HW3, I_HFREQ, I_HSKIP, I_SINK, I_POOLW, I_POOLS, I_RPB, I_WOUT, I_ROUTER, I_WG, I_WU, I_WD, I_FNG, N_IN };
constexpr size_t MiB = 1u << 20;
constexpr size_t WS_CTL = 0;
constexpr size_t WS_MOD = 1 * MiB;
constexpr size_t WS_WSC = 1 * MiB + 512 * 1024;
constexpr size_t WS_ROPE = 2 * MiB;
constexpr size_t WS_TW8 = 2 * MiB + 65536;
constexpr size_t WS_WIN_T = 3 * MiB;
constexpr size_t WS_WOUT_T = 13 * MiB;
constexpr size_t WS_HC = 17 * MiB;
constexpr size_t WS_HCC = 51 * MiB;
constexpr size_t WS_AFFT = 53 * MiB;
constexpr size_t WS_ROWMAP = 56 * MiB;
constexpr size_t WS_GATE = 57 * MiB;
constexpr size_t WS_INV = 58 * MiB;
constexpr size_t WS_CRES = 61 * MiB;
constexpr size_t WS_HX = 69 * MiB;
constexpr size_t WS_WGU_T = 137 * MiB;
constexpr size_t WS_XB = 265 * MiB;
constexpr size_t WS_WD_T = 393 * MiB;
constexpr size_t WS_R = 521 * MiB;
constexpr size_t WS_ACT = WS_R;
constexpr size_t WS_XG = WS_R + 272 * MiB;
constexpr size_t WS_PX = WS_R;
constexpr size_t WS_Y = WS_R + 153 * MiB;
constexpr size_t WS_YT = WS_XG + 48 * MiB;
constexpr size_t WS_UT = WS_XG;
constexpr size_t WS_HS = WS_R + 408 * MiB;
constexpr size_t WS_END = WS_HS + 64 * MiB;
static_assert(WS_END <= 1024 * MiB, "workspace map");

struct Args { const float* in[N_IN]; float* out; unsigned char* ws; };

__device__ __forceinline__ float bf2f(unsigned short v) { return __uint_as_float(((unsigned)v) << 16); }
__device__ __forceinline__ unsigned f2bf(float f) { unsigned u = __float_as_uint(f); return (u + 0x7fffu + ((u >> 16) & 1u)) >> 16; }
__device__ __forceinline__ unsigned pk2(float lo, float hi) { return f2bf(lo) | (f2bf(hi) << 16); }
__device__ __forceinline__ float bflo(unsigned w) { return __uint_as_float(w << 16); }
__device__ __forceinline__ float bfhi(unsigned w) { return __uint_as_float(w & 0xffff0000u); }
__device__ __forceinline__ float dot2bf(unsigned a, unsigned b, float acc) { return __builtin_amdgcn_fdot2_f32_bf16(__builtin_bit_cast(bf16x2_t, a), __builtin_bit_cast(bf16x2_t, b), acc, false); }
template <int O> __device__ __forceinline__ float xshfl(float v) {
    if constexpr (O == 32) { auto rr = __builtin_amdgcn_permlane32_swap(__float_as_uint(v), __float_as_uint(v), false, false);
        const bool lowhalf = __builtin_amdgcn_mbcnt_lo(~0u, 0u) == __builtin_amdgcn_mbcnt_hi(~0u, __builtin_amdgcn_mbcnt_lo(~0u, 0u));
        return lowhalf ? __uint_as_float(rr[1]) : __uint_as_float(rr[0]); }
    else return __builtin_bit_cast(float, __builtin_amdgcn_ds_swizzle(__builtin_bit_cast(int, v), (O << 10) | 0x1f));
}
__device__ __forceinline__ float xsum32(float v) { auto rr = __builtin_amdgcn_permlane32_swap(__float_as_uint(v), __float_as_uint(v), false, false); return __uint_as_float(rr[0]) + __uint_as_float(rr[1]); }
__device__ __forceinline__ float xmax32(float v) { auto rr = __builtin_amdgcn_permlane32_swap(__float_as_uint(v), __float_as_uint(v), false, false); return fmaxf(__uint_as_float(rr[0]), __uint_as_float(rr[1])); }
__device__ __forceinline__ float wave_sum(float v) { v += xshfl<1>(v); v += xshfl<2>(v); v += xshfl<4>(v); v += xshfl<8>(v); v += xshfl<16>(v); return xsum32(v); }
__device__ __forceinline__ float wave_max_(float v) { v = fmaxf(v, xshfl<1>(v)); v = fmaxf(v, xshfl<2>(v)); v = fmaxf(v, xshfl<4>(v)); v = fmaxf(v, xshfl<8>(v)); v = fmaxf(v, xshfl<16>(v)); return xmax32(v); }
#define LDS_WAIT() asm volatile("s_waitcnt lgkmcnt(0)" ::: "memory")

#ifndef AMP_PHASE
#define AMP_PHASE -1
#endif
__device__ __forceinline__ unsigned long long amp_now() { asm volatile("s_waitcnt vmcnt(0) lgkmcnt(0)" ::: "memory"); __builtin_amdgcn_sched_barrier(0); const unsigned long long t = __builtin_amdgcn_s_memrealtime(); asm volatile("s_waitcnt lgkmcnt(0)" ::: "memory"); __builtin_amdgcn_sched_barrier(0); return t; }
#define AMP_BEGIN(id) unsigned long long amp_t0_ = 0; if ((id) == AMP_PHASE) { __syncthreads(); amp_t0_ = amp_now(); }
#define AMP_END(id) if ((id) == AMP_PHASE) { __syncthreads(); const unsigned long long t1_ = amp_now(); const unsigned long long d_ = t1_ - amp_t0_; while (amp_now() - t1_ < d_) __builtin_amdgcn_s_sleep(8); __syncthreads(); }
__device__ __forceinline__ void tr_item(const float* W, int K, int N, bf16_t* WT, int Kt, int item, int mode, LAS float* scr, int lane) {
    const int nblk = N / 32, kb = item / nblk, nb = item % nblk, k0 = 64 * kb, n0 = 32 * nb;
    const int r8 = lane >> 3, c4 = lane & 7; f32x4 v[8];
    const float* wp = W + (size_t)(k0 + r8) * N + n0 + 4 * c4;
#pragma unroll
    for (int i = 0; i < 8; ++i) v[i] = *(const f32x4*)(wp + (size_t)(8 * i) * N);
#pragma unroll
    for (int i = 0; i < 8; ++i) { LAS float* d = scr + (r8 + 8 * i) * 33 + 4 * c4; d[0] = v[i][0]; d[1] = v[i][1]; d[2] = v[i][2]; d[3] = v[i][3]; }
    LDS_WAIT();
    const int c = lane & 7;
    const int drow0 = (mode == 0) ? n0 : ((n0 >> 7) * 256 + (n0 & 127) + (mode == 2 ? 128 : 0));
#pragma unroll
    for (int j = 0; j < 4; ++j) { const int n = (lane >> 3) + 8 * j; const LAS float* sp = scr + (8 * c) * 33 + n;
        u32x4 o; o.x = pk2(sp[0 * 33], sp[1 * 33]); o.y = pk2(sp[2 * 33], sp[3 * 33]); o.z = pk2(sp[4 * 33], sp[5 * 33]); o.w = pk2(sp[6 * 33], sp[7 * 33]);
        *(u32x4*)(WT + (size_t)(drow0 + n) * Kt + k0 + 8 * c) = o; }
    LDS_WAIT();
}

__device__ __forceinline__ void tr_item_fp8(const float* W, int K, int N, unsigned char* WT, int Kt, int item, int mode, LAS float* scr, int lane, float* wsc_out) {
    const int nblk = N / 32, kb = item / nblk, nb = item % nblk, k0 = 64 * kb, n0 = 32 * nb;
    const int r8 = lane >> 3, c4 = lane & 7; f32x4 v[8];
    const f32x4 sv = *(const f32x4*)(W + 4 * lane);
    const float* wp = W + (size_t)(k0 + r8) * N + n0 + 4 * c4;
#pragma unroll
    for (int i = 0; i < 8; ++i) v[i] = *(const f32x4*)(wp + (size_t)(8 * i) * N);
    float sm = fmaxf(fmaxf(fabsf(sv[0]), fabsf(sv[1])), fmaxf(fabsf(sv[2]), fabsf(sv[3])));
#pragma unroll
    for (int o = 1; o < 64; o <<= 1) sm = fmaxf(sm, __shfl_xor(sm, o));
    int E = 0; (void)frexpf(fmaxf(sm, 1e-30f), &E); const float mul = ldexpf(1.0f, 5 - E);
    if (item == 0 && lane == 0) *wsc_out = ldexpf(1.0f, E - 5);
#pragma unroll
    for (int i = 0; i < 8; ++i) { LAS float* d = scr + (r8 + 8 * i) * 33 + 4 * c4; d[0] = v[i][0] * mul; d[1] = v[i][1] * mul; d[2] = v[i][2] * mul; d[3] = v[i][3] * mul; }
    LDS_WAIT();
    const int c = lane & 7;
    const int drow0 = (mode == 0) ? n0 : ((n0 >> 7) * 256 + (n0 & 127) + (mode == 2 ? 128 : 0));
#pragma unroll
    for (int j = 0; j < 4; ++j) { const int n = (lane >> 3) + 8 * j; const LAS float* sp = scr + (8 * c) * 33 + n;
        int p0 = 0, p1 = 0;
        p0 = __builtin_amdgcn_cvt_pk_fp8_f32(sp[0 * 33], sp[1 * 33], p0, false); p0 = __builtin_amdgcn_cvt_pk_fp8_f32(sp[2 * 33], sp[3 * 33], p0, true);
        p1 = __builtin_amdgcn_cvt_pk_fp8_f32(sp[4 * 33], sp[5 * 33], p1, false); p1 = __builtin_amdgcn_cvt_pk_fp8_f32(sp[6 * 33], sp[7 * 33], p1, true);
        typedef int i32x2v __attribute__((ext_vector_type(2)));
        *(i32x2v*)(WT + (size_t)(drow0 + n) * Kt + k0 + 8 * c) = (i32x2v){p0, p1}; }
    LDS_WAIT();
}

struct CvtStream { int it, end, live; f32x4 v0, v1, v2, v3, v4, v5, v6, v7; };
constexpr int CVT_ITEMS = 2 * 3 * 16 * 1024;
__device__ __forceinline__ void cvt_decode(const Args& a, int r, const float*& W, int& K, int& N, unsigned char*& WT, int& Kt, int& mode, int& ri, float*& wsc) {
    const int l = r / 49152, rr = r % 49152, which = rr >> 14, e = (rr >> 10) & 15; ri = rr & 1023; const size_t le = (size_t)l * 16 + e;
    wsc = (float*)(a.ws + WS_WSC) + (l * 3 + which) * 16 + e;
    if (which == 0) { W = a.in[I_WG] + le * 1024 * 2048; K = 1024; N = 2048; WT = (unsigned char*)(a.ws + WS_WGU_T) + le * 4096 * 1024; Kt = 1024; mode = 1; }
    else if (which == 1) { W = a.in[I_WU] + le * 1024 * 2048; K = 1024; N = 2048; WT = (unsigned char*)(a.ws + WS_WGU_T) + le * 4096 * 1024; Kt = 1024; mode = 2; }
    else { W = a.in[I_WD] + le * 2048 * 1024; K = 2048; N = 1024; WT = (unsigned char*)(a.ws + WS_WD_T) + le * 1024 * 2048; Kt = 2048; mode = 0; }
}
__device__ __forceinline__ void cvt_issue(const Args& a, CvtStream& c, int lane) {
    c.live = 0; if (c.it >= c.end) return;
    const float* W; int K, N, Kt, mode, ri; unsigned char* WT; float* wsc; cvt_decode(a, c.it, W, K, N, WT, Kt, mode, ri, wsc);
    const int nblk = N / 32, kb = ri / nblk, nb = ri % nblk, k0 = 64 * kb, n0 = 32 * nb; const int r8 = lane >> 3, c4 = lane & 7;
    const float* wp = W + (size_t)(k0 + r8) * N + n0 + 4 * c4; const size_t st = (size_t)8 * N;
    c.v0 = *(const f32x4*)(wp); c.v1 = *(const f32x4*)(wp + st); c.v2 = *(const f32x4*)(wp + 2 * st); c.v3 = *(const f32x4*)(wp + 3 * st);
    c.v4 = *(const f32x4*)(wp + 4 * st); c.v5 = *(const f32x4*)(wp + 5 * st); c.v6 = *(const f32x4*)(wp + 6 * st); c.v7 = *(const f32x4*)(wp + 7 * st);
    c.live = 1;
}
__device__ __forceinline__ void cvt_finish(const Args& a, CvtStream& c, LAS float* scr, int lane, int stride) {
    if (!c.live) return;
    const float* W; int K, N, Kt, mode, ri; unsigned char* WT; float* wsc; cvt_decode(a, c.it, W, K, N, WT, Kt, mode, ri, wsc);
    const int nblk = N / 32, kb = ri / nblk, nb = ri % nblk, k0 = 64 * kb, n0 = 32 * nb; const int r8 = lane >> 3, c4 = lane & 7;
    const float mul = 1.0f / *wsc;
    LAS float* d = scr + r8 * 33 + 4 * c4;
#define CVT_PUT(i, v) { d[(8 * (i)) * 33 + 0] = v[0] * mul; d[(8 * (i)) * 33 + 1] = v[1] * mul; d[(8 * (i)) * 33 + 2] = v[2] * mul; d[(8 * (i)) * 33 + 3] = v[3] * mul; }
    CVT_PUT(0, c.v0) CVT_PUT(1, c.v1) CVT_PUT(2, c.v2) CVT_PUT(3, c.v3) CVT_PUT(4, c.v4) CVT_PUT(5, c.v5) CVT_PUT(6, c.v6) CVT_PUT(7, c.v7)
#undef CVT_PUT
    LDS_WAIT();
    const int cc = lane & 7;
    const int drow0 = (mode == 0) ? n0 : ((n0 >> 7) * 256 + (n0 & 127) + (mode == 2 ? 128 : 0));
#pragma unroll
    for (int j = 0; j < 4; ++j) { const int n = (lane >> 3) + 8 * j; const LAS float* sp = scr + (8 * cc) * 33 + n;
        int p0 = 0, p1 = 0;
        p0 = __builtin_amdgcn_cvt_pk_fp8_f32(sp[0 * 33], sp[1 * 33], p0, false); p0 = __builtin_amdgcn_cvt_pk_fp8_f32(sp[2 * 33], sp[3 * 33], p0, true);
        p1 = __builtin_amdgcn_cvt_pk_fp8_f32(sp[4 * 33], sp[5 * 33], p1, false); p1 = __builtin_amdgcn_cvt_pk_fp8_f32(sp[6 * 33], sp[7 * 33], p1, true);
        typedef int i32x2v __attribute__((ext_vector_type(2)));
        *(i32x2v*)(WT + (size_t)(drow0 + n) * Kt + k0 + 8 * cc) = (i32x2v){p0, p1}; }
    LDS_WAIT();
    c.it += stride; c.live = 0;
}

__device__ __forceinline__ void filter_item(const Args& a, LAS unsigned char* lds, int item, int tid) {
    asm volatile("" : "+v"(tid));
    const int lane = tid & 63, wave = tid >> 6;
    int l, L, p0; float* HCdst;
    if (item < 128) { l = 0; L = 4096; p0 = item * 32; HCdst = (float*)(a.ws + WS_HC); }
    else if (item < 256) { l = 1; L = 4096; p0 = (item - 128) * 32; HCdst = (float*)(a.ws + WS_HC) + (size_t)2 * 8191 * 256; }
    else { l = 0; L = 256; p0 = (item - 256) * 32; HCdst = (float*)(a.ws + WS_HCC) + 256; }
    LAS float* w1s = (LAS float*)lds; LAS float* w2s = w1s + 33 * 64; LAS float* b1s = w2s + 64 * 64; LAS float* b2s = b1s + 64; LAS float* frs = b2s + 64; LAS float* h2s = frs + 64; LAS float* ex = h2s + 32 * 64;
    { const float* w1 = a.in[I_HW1] + l * 33 * 64; const float* w2 = a.in[I_HW2] + l * 64 * 64;
      for (int i = tid; i < 33 * 64; i += NTHR) w1s[i] = w1[i];
      for (int i = tid; i < 64 * 64; i += NTHR) w2s[i] = w2[i];
      if (tid < 64) { b1s[tid] = a.in[I_HB1][l * 64 + tid]; b2s[tid] = a.in[I_HB2][l * 64 + tid]; frs[tid] = a.in[I_HFREQ][l * 64 + tid]; } }
    __syncthreads();
    const float frq = frs[lane];
#pragma unroll 1
    for (int q = 0; q < 4; ++q) { const int pp = wave * 4 + q, p = p0 + pp; const float tn = (float)p / (float)(L - 1);
        float fv = 0.f;
        if (lane == 0) fv = tn;
        else if (lane <= 32) { const int bi = (lane - 1) & 15; const float band = 1e-4f + (float)bi * ((15.0f - 1e-4f) / 15.0f);
            const float ang = ((float)(6.283185307179586 / (double)L) * (float)p) * band; fv = (lane <= 16) ? cosf(ang) : -sinf(ang); }
        float a1 = b1s[lane];
#pragma unroll
        for (int i = 0; i < 33; ++i) a1 += __builtin_bit_cast(float, __builtin_amdgcn_readlane(__builtin_bit_cast(int, fv), i)) * w1s[i * 64 + lane];
        const float h1 = sinf(frq * a1);
        float a2 = b2s[lane];
#pragma unroll 16
        for (int i = 0; i < 64; ++i) a2 += __builtin_bit_cast(float, __builtin_amdgcn_readlane(__builtin_bit_cast(int, h1), i)) * w2s[i * 64 + lane];
        h2s[lane * 32 + pp] = sinf(frq * a2); }
    __syncthreads();
    const float* w3 = a.in[I_HW3] + (size_t)l * 64 * 1024 + tid;
    float acc0[32], acc1[32];
#pragma unroll
    for (int pp = 0; pp < 32; ++pp) { acc0[pp] = 0.f; acc1[pp] = 0.f; }
#pragma unroll 4
    for (int i = 0; i < 64; ++i) { const float wa = w3[i * 1024], wb = w3[i * 1024 + 512];
#pragma unroll
        for (int q = 0; q < 8; ++q) { const f32x4 h = *(const LAS f32x4*)(h2s + i * 32 + 4 * q);
#pragma unroll
            for (int r = 0; r < 4; ++r) { acc0[4 * q + r] += h[r] * wa; acc1[4 * q + r] += h[r] * wb; } } }
    const int c = tid & 255, dir = tid >> 8; const float dmin = 3.0701134573253945f, dmax = 15.350567286626972f; const float delta = dmin + (float)c * ((dmax - dmin) / 255.0f);
    float* base0 = HCdst; float* base1 = HCdst + (size_t)(2 * L - 1) * 256;
#pragma unroll
    for (int pp = 0; pp < 32; ++pp) { const int p = p0 + pp; const float tn = (float)p / (float)(L - 1); const float win = expf(-tn * delta); const float v0 = acc0[pp] * win, v1 = acc1[pp] * win;
        if (p == 0) { ex[tid] = v0; ex[512 + tid] = v1; }
        else { const size_t idx = (size_t)(dir == 0 ? (L - 1 + p) : (L - 1 - p)) * 256 + c; base0[idx] = v0; base1[idx] = v1; } }
    __syncthreads();
    if (p0 == 0 && tid < 256) { const size_t idx = (size_t)(L - 1) * 256 + tid; base0[idx] = ex[tid] + ex[tid + 256]; base1[idx] = ex[512 + tid] + ex[512 + tid + 256]; }
    __syncthreads();
}


typedef int v8i_t __attribute__((ext_vector_type(8)));
__device__ __forceinline__ float st_A(int i, int k) { return (float)(((i * 7 + k * 3) % 5) - 2); }
__device__ __forceinline__ float st_B(int k, int j) { return (float)(((k * 5 + j * 11 + (k >> 4)) % 5) - 2); }
__device__ __forceinline__ void fp8_selftest(unsigned* poison, int lane) {
    const int fr = lane & 15, fq = lane >> 4; v8i_t av, bv;
#pragma unroll
    for (int w = 0; w < 8; ++w) { int pa = 0, pb = 0;
#pragma unroll
        for (int q = 0; q < 4; ++q) { }
        const int kb = (w < 4) ? (16 * fq + 4 * w) : (64 + 16 * fq + 4 * (w - 4));
        pa = __builtin_amdgcn_cvt_pk_fp8_f32(st_A(fr, kb), st_A(fr, kb + 1), pa, false); pa = __builtin_amdgcn_cvt_pk_fp8_f32(st_A(fr, kb + 2), st_A(fr, kb + 3), pa, true);
        pb = __builtin_amdgcn_cvt_pk_fp8_f32(st_B(kb, fr), st_B(kb + 1, fr), pb, false); pb = __builtin_amdgcn_cvt_pk_fp8_f32(st_B(kb + 2, fr), st_B(kb + 3, fr), pb, true);
        av[w] = pa; bv[w] = pb; }
    f32x4 acc = {0.f, 0.f, 0.f, 0.f};
    acc = __builtin_amdgcn_mfma_scale_f32_16x16x128_f8f6f4(av, bv, acc, 0, 0, 0, 0x7f7f7f7f, 0, 0x7f7f7f7f);
    bool bad = false;
#pragma unroll
    for (int r = 0; r < 4; ++r) { float ref = 0.f; for (int k = 0; k < 128; ++k) ref += st_A(4 * fq + r, k) * st_B(k, fr); bad |= (acc[r] != ref); }
    { const float v = (float)(lane * 3 + 1);
      const float r5 = __builtin_bit_cast(float, __builtin_amdgcn_update_dpp(0, __builtin_bit_cast(int, v), 0x150 + 5, 0xf, 0xf, false));
      const float r12 = __builtin_bit_cast(float, __builtin_amdgcn_update_dpp(0, __builtin_bit_cast(int, v), 0x150 + 12, 0xf, 0xf, false));
      bad |= (r5 != (float)(((lane & 48) + 5) * 3 + 1)) || (r12 != (float)(((lane & 48) + 12) * 3 + 1)); }
    if (__any(bad) && lane == 0) __hip_atomic_store(poison, 1u, __ATOMIC_RELAXED, __HIP_MEMORY_SCOPE_AGENT);
}

__device__ __forceinline__ void phase_prologue(const Args& a, unsigned char* ldsg, int vcu, int G) {
    LAS unsigned char* lds = (LAS unsigned char*)ldsg;
    int tid_ = threadIdx.x; asm volatile("" : "+v"(tid_));
    const int tid = tid_, lane = tid & 63, wave = __builtin_amdgcn_readfirstlane(tid >> 6);
    unsigned char* ws = a.ws;
    if (vcu == 2 % G && wave == 0) fp8_selftest((unsigned*)(ws + WS_CTL) + 12288, lane);
    LAS float* sc = (LAS float*)lds; LAS float* red = (LAS float*)(lds + 36864);
    for (int i = tid; i < 9 * 1024; i += NTHR) { const float v = (i < 8192) ? a.in[I_C][i] : a.in[I_CCTX][i - 8192]; sc[i] = v / (1.0f + expf(-v)); }
    __syncthreads();
    { AMP_BEGIN(41)
    float* MOD = (float*)(ws + WS_MOD);
    for (int item = vcu; item < 2 * 96; item += G) {
        const int l = item / 96, n0 = (item % 96) * 64, col = tid & 63, kg = tid >> 6;
        float acc[9];
#pragma unroll
        for (int r = 0; r < 9; ++r) acc[r] = 0.f;
        const float* w = a.in[I_ADAW] + (size_t)l * 1024 * 6144 + n0 + col;
#pragma unroll 4
        for (int k = kg * 128; k < kg * 128 + 128; ++k) { const float wv = w[(size_t)k * 6144];
#pragma unroll
            for (int r = 0; r < 9; ++r) acc[r] += sc[r * 1024 + k] * wv; }
#pragma unroll
        for (int r = 0; r < 9; ++r) red[(kg * 9 + r) * 64 + col] = acc[r];
        __syncthreads();
        for (int o = tid; o < 9 * 64; o += NTHR) { const int r = o >> 6, cc = o & 63; float s = 0.f;
#pragma unroll
            for (int g2 = 0; g2 < 8; ++g2) s += red[(g2 * 9 + r) * 64 + cc];
            MOD[(size_t)(l * 9 + r) * 6144 + n0 + cc] = s + a.in[I_ADAB][l * 6144 + n0 + cc]; }
        __syncthreads();
    }
    AMP_END(41) }
    if (vcu == 0) { float* ROPE = (float*)(ws + WS_ROPE);
        for (int i = tid; i < 1024; i += NTHR) { const int pos = i >> 4, fi = i & 15; const float inv = powf(10000.0f, -(float)fi / 16.0f); const float ang = (float)pos * inv;
            ROPE[2 * i] = cosf(ang); ROPE[2 * i + 1] = sinf(ang); } }
    if (vcu == 1 % G) { float* TW8 = (float*)(ws + WS_TW8);
        for (int i = tid; i < 8192; i += NTHR) { float sn, cs; sincospif(-(float)i * (1.0f / 4096.0f), &sn, &cs); TW8[2 * i] = cs; TW8[2 * i + 1] = sn; } }
    const int gw = vcu * NWAVES + wave, NGW = G * NWAVES;
    { AMP_BEGIN(42)
    for (int it = vcu; it < 264; it += G) filter_item(a, lds, it, tid);
    AMP_END(42) }
    { AMP_BEGIN(43)
    LAS float* scr = (LAS float*)(lds + 65536 + wave * 8448);
    for (int m = gw; m < 96; m += NGW) { const int l = m / 48, which = (m % 48) / 16, e = m & 15; const size_t le = (size_t)l * 16 + e; int lane_ = lane; asm volatile("" : "+v"(lane_));
        const float* W = (which == 0) ? a.in[I_WG] + le * 1024 * 2048 : ((which == 1) ? a.in[I_WU] + le * 1024 * 2048 : a.in[I_WD] + le * 2048 * 1024);
        const f32x4 sv = *(const f32x4*)(W + 4 * lane_); float sm = fmaxf(fmaxf(fabsf(sv[0]), fabsf(sv[1])), fmaxf(fabsf(sv[2]), fabsf(sv[3])));
        sm = wave_max_(sm);
        int E = 0; (void)frexpf(fmaxf(sm, 1e-30f), &E); if (lane_ == 0) ((float*)(ws + WS_WSC))[m] = ldexpf(1.0f, E - 5); }
    constexpr int IT_IN = 16 * 72, IT_OUT = 16 * 32, IT_LAYER = IT_IN + IT_OUT;
    for (int it = gw; it < 2 * IT_LAYER; it += NGW) {
        const int l = it / IT_LAYER; int r = it % IT_LAYER;
        if (r < IT_IN) { tr_item(a.in[I_WIN] + (size_t)l * 1024 * 2304, 1024, 2304, (bf16_t*)(ws + WS_WIN_T) + (size_t)l * 2304 * 1024, 1024, r, 0, scr, lane); continue; } r -= IT_IN;
        tr_item(a.in[I_WOUT] + (size_t)l * 1024 * 1024, 1024, 1024, (bf16_t*)(ws + WS_WOUT_T) + (size_t)l * 1024 * 1024, 1024, r, 0, scr, lane);
    }
    AMP_END(43) }
}

__device__ __forceinline__ void phase_norm(const Args& a, unsigned char* ldsg, int vcu, int G, int l, const float* srcx, const float* srcc, const bf16_t* srcb, const float* gain, int shift_idx, int nrows, bool router) {
    int tid_ = threadIdx.x; asm volatile("" : "+v"(tid_));
    const int tid = tid_, lane = tid & 63, wave = __builtin_amdgcn_readfirstlane(tid >> 6);
    unsigned char* ws = a.ws; asm volatile("" : "+s"(ws)); const float* MOD = (const float*)(ws + WS_MOD) + (size_t)l * 9 * 6144; bf16_t* HX = (bf16_t*)(ws + WS_HX);
    LAS float* rw = (LAS float*)(LAS unsigned char*)ldsg;
    if (router) { const float* rsrc = a.in[I_ROUTER] + (size_t)l * 1024 * 16; for (int i = tid; i < 1024 * 16; i += NTHR) rw[(i & 15) * 1024 + (i >> 4)] = rsrc[i]; __syncthreads(); }
    const int gw = vcu * NWAVES + wave, NGW = G * NWAVES;
    for (int rowa = gw; rowa < nrows; rowa += 2 * NGW) {
        f32x4 vv[2][4];
#pragma unroll
        for (int u = 0; u < 2; ++u) { const int rr = (rowa + u * NGW < nrows) ? rowa + u * NGW : rowa;
            if (srcb) { const bf16_t* xr = srcb + (size_t)rr * D;
#pragma unroll
                for (int j = 0; j < 4; ++j) { const u32x2 w = *(const u32x2*)(xr + 256 * j + 4 * lane); vv[u][j] = (f32x4){bflo(w.x), bfhi(w.x), bflo(w.y), bfhi(w.y)}; } }
            else { const float* xr = (rr < TX) ? srcx + (size_t)rr * D : srcc + (size_t)(rr - TX) * D;
#pragma unroll
                for (int j = 0; j < 4; ++j) vv[u][j] = *(const f32x4*)(xr + 256 * j + 4 * lane); } }
        f32x4 hv[2][4];
#pragma unroll
        for (int u = 0; u < 2; ++u) { const int row = rowa + u * NGW; if (row < nrows) {
        const bool lat = row < TX; const int mrow = lat ? (row >> 12) : 8;
        const float* shp = MOD + mrow * 6144 + shift_idx * 1024; const float* scp = shp + 1024;
        f32x4 v[4]; float ss = 0.f;
#pragma unroll
        for (int j = 0; j < 4; ++j) { v[j] = vv[u][j]; ss += (v[j][0] * v[j][0] + v[j][1] * v[j][1]) + (v[j][2] * v[j][2] + v[j][3] * v[j][3]); }
        const float rstd = 1.0f / sqrtf(wave_sum(ss) * (1.0f / D) + 1e-6f);
#pragma unroll
        for (int j = 0; j < 4; ++j) { const f32x4 gg = *(const f32x4*)(gain + 256 * j + 4 * lane), sh = *(const f32x4*)(shp + 256 * j + 4 * lane), sc = *(const f32x4*)(scp + 256 * j + 4 * lane);
            v[j] = (v[j] * rstd * gg) * (1.0f + sc) + sh;
            if (router) { int p = 0; p = __builtin_amdgcn_cvt_pk_fp8_f32(fminf(fmaxf(v[j][0], -448.f), 448.f), fminf(fmaxf(v[j][1], -448.f), 448.f), p, false); p = __builtin_amdgcn_cvt_pk_fp8_f32(fminf(fmaxf(v[j][2], -448.f), 448.f), fminf(fmaxf(v[j][3], -448.f), 448.f), p, true);
                *(int*)((unsigned char*)HX + (size_t)row * D + 256 * j + 4 * lane) = p; }
            else { u32x2 o; o.x = pk2(v[j][0], v[j][1]); o.y = pk2(v[j][2], v[j][3]); *(u32x2*)(HX + (size_t)row * D + 256 * j + 4 * lane) = o; } }
#pragma unroll
        for (int j = 0; j < 4; ++j) hv[u][j] = v[j];
        } }
        float plr[2][16];
        if (router) {
#pragma unroll
            for (int e = 0; e < 16; ++e) { float p0 = 0.f, p1 = 0.f;
#pragma unroll
                for (int j = 0; j < 4; ++j) { const f32x4 wv = *(const LAS f32x4*)(rw + e * 1024 + 256 * j + 4 * lane);
                    p0 += (hv[0][j][0] * wv[0] + hv[0][j][1] * wv[1]) + (hv[0][j][2] * wv[2] + hv[0][j][3] * wv[3]);
                    p1 += (hv[1][j][0] * wv[0] + hv[1][j][1] * wv[1]) + (hv[1][j][2] * wv[2] + hv[1][j][3] * wv[3]); }
                plr[0][e] = p0; plr[1][e] = p1; asm volatile("" : "+v"(plr[0][e]), "+v"(plr[1][e])); } }
#pragma unroll
        for (int u = 0; u < 2; ++u) { const int row = rowa + u * NGW; if (row < nrows) {
        if (router) {
            float pl[16];
#pragma unroll
            for (int e = 0; e < 16; ++e) pl[e] = plr[u][e];
            float q8[8], q4[4], q2[2], q1;
            { const bool up = (lane & 8) != 0;
#pragma unroll
              for (int e = 0; e < 8; ++e) { const float keep = up ? pl[e + 8] : pl[e], give = up ? pl[e] : pl[e + 8]; q8[e] = keep + xshfl<8>(give); } }
            { const bool up = (lane & 4) != 0;
#pragma unroll
              for (int e = 0; e < 4; ++e) { const float keep = up ? q8[e + 4] : q8[e], give = up ? q8[e] : q8[e + 4]; q4[e] = keep + xshfl<4>(give); } }
            { const bool up = (lane & 2) != 0;
#pragma unroll
              for (int e = 0; e < 2; ++e) { const float keep = up ? q4[e + 2] : q4[e], give = up ? q4[e] : q4[e + 2]; q2[e] = keep + xshfl<2>(give); } }
            { const bool up = (lane & 1) != 0; const float keep = up ? q2[1] : q2[0], give = up ? q2[0] : q2[1]; q1 = keep + xshfl<1>(give); }
            q1 += xshfl<16>(q1); q1 = xsum32(q1);
            const float mylog = (lane < 16) ? q1 : -1e30f;
            float mx = mylog;
            mx = fmaxf(mx, xshfl<1>(mx)); mx = fmaxf(mx, xshfl<2>(mx)); mx = fmaxf(mx, xshfl<4>(mx)); mx = fmaxf(mx, xshfl<8>(mx));
            const float mine = (lane < 16) ? expf(mylog - mx) : 0.f; float den = mine;
            den += xshfl<1>(den); den += xshfl<2>(den); den += xshfl<4>(den); den += xshfl<8>(den);
            if (lane < 16) { ((float*)(ws + WS_AFFT))[(size_t)lane * TT + row] = mine / den; ((int*)(ws + WS_INV))[(size_t)row * 16 + lane] = -1; }
        }
    } }
    }
}

#define XB_TMO      128
#define XB_XCNT(j)  (256  + 64 * (j))
#define XB_XSUB(j)  (1280 + 64 * (j))
#define XB_XGEN(j)  (2304 + 64 * (j))
#define XB_TOP      3328
#define XB_TOPGEN   3392
#define XCD_BAR_WORDS 3456
#define XB_SPIN_CAP (1u << 18)

__device__ __forceinline__ unsigned xb_ld(unsigned* p)              { return __hip_atomic_load(p, __ATOMIC_RELAXED, __HIP_MEMORY_SCOPE_AGENT); }
__device__ __forceinline__ unsigned xb_add(unsigned* p, unsigned v) { return __hip_atomic_fetch_add(p, v, __ATOMIC_RELAXED, __HIP_MEMORY_SCOPE_AGENT); }
__device__ __forceinline__ unsigned xb_xcc_id() { return (unsigned)__builtin_amdgcn_s_getreg((3 << 11) | 20) & 0xFu; }
#define XB_SPIN(cond, bar) do { unsigned _sp = 0; while (cond) { __builtin_amdgcn_s_sleep(1); \
    if ((++_sp & 255u) == 0u) { if (xb_ld(&(bar)[XB_TMO])) break; if (_sp > XB_SPIN_CAP) { atomicAdd(&(bar)[XB_TMO], 1u); break; } } } } while (0)

struct XcdBarrier {
    unsigned* bar; unsigned x;
    volatile LAS unsigned* st;
};

__device__ __forceinline__ XcdBarrier xcd_barrier_post(unsigned* bar, volatile LAS unsigned* st) {
    XcdBarrier b; b.bar = bar; b.x = xb_xcc_id(); b.st = st;
    if (threadIdx.x == 0) (void)xb_add(&bar[XB_XCNT(b.x)], 1u);
    return b;
}
__device__ __forceinline__ void xcd_barrier_complete(unsigned* bar, unsigned x, unsigned& nloc, unsigned& nx) {
    const unsigned G = gridDim.x * gridDim.y * gridDim.z;
    unsigned sum, cnt, mine, sp = 0u;
    for (;;) {
        sum = 0u; cnt = 0u; mine = 0u;
#pragma unroll
        for (unsigned j = 0; j < 16; ++j) { const unsigned c = xb_ld(&bar[XB_XCNT(j)]); sum += c; cnt += (c > 0u) ? 1u : 0u; mine = (j == x) ? c : mine; }
        if (sum == G) break;
        __builtin_amdgcn_s_sleep(1);
        if ((++sp & 255u) == 0u) { if (xb_ld(&bar[XB_TMO])) break; if (sp > XB_SPIN_CAP) { atomicAdd(&bar[XB_TMO], 1u); break; } }
    }
    nloc = mine > 0u ? mine : 1u; nx = cnt > 0u ? cnt : 1u;
}

__device__ __forceinline__ void xcd_barrier(const XcdBarrier& b) {
    asm volatile("s_waitcnt vmcnt(0)" ::: "memory");
    __syncthreads();
    if (threadIdx.x == 0) {
        unsigned* bar = b.bar;
        __builtin_amdgcn_s_waitcnt(0);
        unsigned nloc = b.st[0], nx = b.st[1];
        if (nloc == 0u) { xcd_barrier_complete(bar, b.x, nloc, nx); b.st[0] = nloc; b.st[1] = nx; }
        const unsigned old = xb_add(&bar[XB_XSUB(b.x)], 1u);
        const unsigned gen = old / nloc;
        if (old + 1u == (gen + 1u) * nloc) {
            __builtin_amdgcn_fence(__ATOMIC_RELEASE, "agent");
            asm volatile("s_waitcnt vmcnt(0)" ::: "memory");
            const unsigned og = xb_add(&bar[XB_TOP], 1u);
            const unsigned tg = og / nx;
            if (og + 1u == (tg + 1u) * nx) xb_add(&bar[XB_TOPGEN], 1u);
            else XB_SPIN(xb_ld(&bar[XB_TOPGEN]) == tg, bar);
            __builtin_amdgcn_fence(__ATOMIC_ACQUIRE, "agent");
            xb_add(&bar[XB_XGEN(b.x)], 1u);
            asm volatile("s_waitcnt vmcnt(0)" ::: "memory");
        } else {
            XB_SPIN(xb_ld(&bar[XB_XGEN(b.x)]) == gen, bar);
            __builtin_amdgcn_fence(__ATOMIC_ACQUIRE, "agent");
            asm volatile("s_waitcnt vmcnt(0)" ::: "memory");
        }
    }
    __syncthreads();
}


typedef float f32x2 __attribute__((ext_vector_type(2)));
__device__ __forceinline__ f32x2 cmul(f32x2 a, f32x2 b) { return (f32x2){a.x * b.x - a.y * b.y, a.x * b.y + a.y * b.x}; }
__device__ __forceinline__ void dft16(f32x2 (&v)[16]) {
    constexpr float WC[8] = {1.0f, 0.92387953251128674f, 0.70710678118654752f, 0.38268343236508977f, 0.0f, -0.38268343236508977f, -0.70710678118654752f, -0.92387953251128674f};
    constexpr float WS[8] = {0.0f, -0.38268343236508977f, -0.70710678118654752f, -0.92387953251128674f, -1.0f, -0.92387953251128674f, -0.70710678118654752f, -0.38268343236508977f};
#pragma unroll
    for (int s = 8; s >= 1; s >>= 1)
#pragma unroll
        for (int i = 0; i < 16; ++i) if ((i & s) == 0) { const int k = (i & (s - 1)) * (8 / s); const f32x2 u = v[i], t = v[i + s]; v[i] = u + t; const f32x2 d = u - t;
            v[i + s] = (k == 0) ? d : ((k == 4) ? (f32x2){d.y, -d.x} : (f32x2){d.x * WC[k] - d.y * WS[k], d.x * WS[k] + d.y * WC[k]}); }
}
__device__ __forceinline__ constexpr int bitrev4(int i) { return ((i & 1) << 3) | ((i & 2) << 1) | ((i & 4) >> 1) | ((i & 8) >> 3); }
template <int NS, int MODE>
__device__ __forceinline__ void fft_pass(LAS f32x2* Z, const LAS f32x2* TW, int tid, const f32x2* H) {
    const int f = tid >> 8, j = tid & 255, base = f * 4096, k = j & (NS - 1);
    f32x2 v[16];
#pragma unroll
    for (int r = 0; r < 16; ++r) { const int idx = base + j + 256 * r; v[r] = Z[idx + (idx >> 4)]; }
    if (MODE == 1) {
#pragma unroll
        for (int r = 0; r < 16; ++r) { const f32x2 p = cmul(v[r], H[r]); v[r] = (f32x2){p.y, p.x}; } }
    if (NS > 1) { const LAS f32x2* tp = (NS == 16) ? (TW + 8192 + k) : (TW + 4096 + k);
#pragma unroll
        for (int r = 1; r < 16; ++r) v[r] = cmul(v[r], tp[r * NS]); }
    dft16(v);
    if (NS != 256) __syncthreads();
    const int j0 = base + (j / NS) * NS * 16 + k;
#pragma unroll
    for (int rr = 0; rr < 16; ++rr) { const int idx = j0 + rr * NS; Z[idx + (idx >> 4)] = v[bitrev4(rr)]; }
    __syncthreads();
}
__device__ __forceinline__ void load_uc(const bf16_t* UT, const float* cw, const float* cb, int ch, int b, int tid, float (&out)[8]) {
    const bf16_t* p = UT + ((size_t)(b * 768 + ch)) * 4096 + 8 * tid;
    const u32x4 w = *(const u32x4*)p; float u[10];
    u[1] = bflo(w.x); u[2] = bfhi(w.x); u[3] = bflo(w.y); u[4] = bfhi(w.y); u[5] = bflo(w.z); u[6] = bfhi(w.z); u[7] = bflo(w.w); u[8] = bfhi(w.w);
    u[0] = (tid > 0) ? bf2f(p[-1]) : 0.f; u[9] = (tid < 511) ? bf2f(p[8]) : 0.f;
    const float w0 = cw[ch], w1 = cw[768 + ch], w2 = cw[1536 + ch], bb = cb[ch];
#pragma unroll
    for (int i = 0; i < 8; ++i) out[i] = u[i] * w0 + u[i + 1] * w1 + u[i + 2] * w2 + bb;
}
__device__ __forceinline__ void hy_fill(LAS f32x2* Z, const LAS f32x2* TW, int tid, const float (&va)[8], const float (&vb)[8]) {
#pragma unroll
    for (int i = 0; i < 8; ++i) { const int t = 8 * tid + i; const f32x2 z = {va[i], vb[i]}; Z[t + (t >> 4)] = z; const int t2 = 4096 + t; Z[t2 + (t2 >> 4)] = cmul(z, TW[t]); }
    __syncthreads();
}
__device__ __forceinline__ void hy_conv(LAS f32x2* Z, const LAS f32x2* TW, int tid, const f32x2* Hg) {
    f32x2 H[16];
    { const int f = tid >> 8, j = tid & 255, base = f * 4096;
#pragma unroll
      for (int r = 0; r < 16; ++r) H[r] = Hg[base + j + 256 * r]; }
    fft_pass<1, 0>(Z, TW, tid, nullptr); fft_pass<16, 0>(Z, TW, tid, nullptr); fft_pass<256, 0>(Z, TW, tid, nullptr);
    fft_pass<1, 1>(Z, TW, tid, H); fft_pass<16, 0>(Z, TW, tid, nullptr); fft_pass<256, 0>(Z, TW, tid, nullptr);
}
__device__ __forceinline__ f32x2 hy_out(const LAS f32x2* Z, const LAS f32x2* TW, int t) {
    const f32x2 se = Z[t + (t >> 4)]; const int t2 = 4096 + t; const f32x2 so = Z[t2 + (t2 >> 4)]; const f32x2 tw = TW[t];
    const f32x2 So = {so.y, so.x};
    return (f32x2){se.y + (So.x * tw.x + So.y * tw.y), se.x + (So.y * tw.x - So.x * tw.y)};
}
__device__ __forceinline__ void hyena_item(const Args& a, LAS unsigned char* lds, int l, int c, int bp, int tid) {
    asm volatile("" : "+v"(tid));
    LAS f32x2* Z = (LAS f32x2*)lds; const LAS f32x2* TW = (const LAS f32x2*)(lds + 69632);
    const bf16_t* UT = (const bf16_t*)(a.ws + WS_UT); bf16_t* YT = (bf16_t*)(a.ws + WS_YT);
    const float* cw = a.in[I_HCW] + (size_t)l * 3 * 768; const float* cb = a.in[I_HCB] + (size_t)l * 768; const float* skip = a.in[I_HSKIP] + (size_t)l * 2 * 256;
    const f32x2* HS = (const f32x2*)(a.ws + WS_HS) + ((size_t)(l * 2) * 256 + c) * 8192;
    const int b0 = 2 * bp, b1 = 2 * bp + 1;
    float va[8], vb[8], xa[8], xb[8];
    load_uc(UT, cw, cb, c, b0, tid, va); load_uc(UT, cw, cb, c, b1, tid, vb);
    hy_fill(Z, TW, tid, va, vb);
    hy_conv(Z, TW, tid, HS);
    load_uc(UT, cw, cb, 256 + c, b0, tid, xa); load_uc(UT, cw, cb, 256 + c, b1, tid, xb);
    { const float sk = skip[c];
#pragma unroll
      for (int i = 0; i < 8; ++i) { const f32x2 y = hy_out(Z, TW, 8 * tid + i); va[i] = xa[i] * (y.x + va[i] * sk); vb[i] = xb[i] * (y.y + vb[i] * sk); } }
    __syncthreads();
    hy_fill(Z, TW, tid, va, vb);
    hy_conv(Z, TW, tid, HS + (size_t)256 * 8192);
    load_uc(UT, cw, cb, 512 + c, b0, tid, xa); load_uc(UT, cw, cb, 512 + c, b1, tid, xb);
    { const float sk = skip[256 + c];
      float oa[8], ob[8];
#pragma unroll
      for (int i = 0; i < 8; ++i) { const f32x2 y = hy_out(Z, TW, 8 * tid + i); oa[i] = xa[i] * (y.x + va[i] * sk); ob[i] = xb[i] * (y.y + vb[i] * sk); }
      u32x4 wa, wb; wa.x = pk2(oa[0], oa[1]); wa.y = pk2(oa[2], oa[3]); wa.z = pk2(oa[4], oa[5]); wa.w = pk2(oa[6], oa[7]); wb.x = pk2(ob[0], ob[1]); wb.y = pk2(ob[2], ob[3]); wb.z = pk2(ob[4], ob[5]); wb.w = pk2(ob[6], ob[7]);
      *(u32x4*)(YT + ((size_t)(b0 * 256 + c)) * 4096 + 8 * tid) = wa; *(u32x4*)(YT + ((size_t)(b1 * 256 + c)) * 4096 + 8 * tid) = wb; }
    __syncthreads();
}
__device__ __forceinline__ void spectrum_item(const Args& a, LAS unsigned char* lds, int item, int tid) {
    asm volatile("" : "+v"(tid));
    LAS f32x2* Z = (LAS f32x2*)lds; const LAS f32x2* TW = (const LAS f32x2*)(lds + 69632);
    const int c = item & 255, lo = item >> 8;
    const float* HC = (const float*)(a.ws + WS_HC) + (size_t)lo * 8191 * 256 + c;
#pragma unroll
    for (int i = 0; i < 8; ++i) { const int t = 8 * tid + i; const float hl = HC[(size_t)(4095 + t) * 256], hh = (t == 0) ? 0.f : HC[(size_t)(t - 1) * 256];
        Z[t + (t >> 4)] = (f32x2){hl + hh, 0.f}; const int t2 = 4096 + t; const f32x2 tw = TW[t]; const float dd = hl - hh; Z[t2 + (t2 >> 4)] = (f32x2){dd * tw.x, dd * tw.y}; }
    __syncthreads();
    fft_pass<1, 0>(Z, TW, tid, nullptr); fft_pass<16, 0>(Z, TW, tid, nullptr); fft_pass<256, 0>(Z, TW, tid, nullptr);
    f32x2* HS = (f32x2*)(a.ws + WS_HS) + (size_t)item * 8192;
#pragma unroll
    for (int i = 0; i < 16; ++i) { const int idx = tid + 512 * i; HS[idx] = Z[idx + (idx >> 4)] * (1.0f / 8192.0f); }
    __syncthreads();
}
__device__ __forceinline__ void load_tw(const Args& a, LAS unsigned char* lds, int tid) {
    asm volatile("" : "+v"(tid));
    LAS f32x2* TW = (LAS f32x2*)(lds + 69632); const f32x2* src = (const f32x2*)(a.ws + WS_TW8);
    for (int i = tid; i < 4096; i += NTHR) { TW[i] = src[i]; const int r = i >> 8, k = i & 255; TW[4096 + i] = src[r * k * 2]; }
    if (tid < 256) { const int r = tid >> 4, k = tid & 15; TW[8192 + tid] = src[r * k * 32]; }
    __syncthreads();
}
__device__ __forceinline__ float ctx_uc(const bf16_t* PXc, const float* cw, const float* cb, int ch, int t) {
    const float u1 = bf2f(PXc[(size_t)t * INW + ch]); const float u0 = (t > 0) ? bf2f(PXc[(size_t)(t - 1) * INW + ch]) : 0.f; const float u2 = (t < 255) ? bf2f(PXc[(size_t)(t + 1) * INW + ch]) : 0.f;
    return u0 * cw[ch] + u1 * cw[768 + ch] + u2 * cw[1536 + ch] + cb[ch];
}
__device__ __forceinline__ void ctx_conv16(const LAS float* IN, const float* H, int c, int lane, int t0, float (&acc)[16]) {
    float w[16];
    const float* hp = H + (size_t)(t0 + 255) * 256 + c;
#pragma unroll
    for (int i = 0; i < 16; ++i) { acc[i] = 0.f; w[i] = hp[i * 256]; }
    const LAS float* ip = IN + lane;
#pragma unroll 1
    for (int s0 = 0; s0 < 256; s0 += 16) {
#pragma unroll
        for (int u = 0; u < 16; ++u) { const float v = ip[u * 64];
#pragma unroll
            for (int i = 0; i < 16; ++i) acc[i] += v * w[(i - u + 16) & 15];
            w[(15 - u) & 15] = hp[-(u + 1) * 256]; }
        hp -= 16 * 256; ip += 16 * 64; }
}
__device__ __forceinline__ void ctx_hyena_item(const Args& a, LAS unsigned char* lds, int l, int item, int tid) {
    asm volatile("" : "+v"(tid));
    const int lane = tid & 63, wave = tid >> 6, b = item >> 2, c = (item & 3) * 64 + lane;
    LAS float* V = (LAS float*)lds; LAS float* Z1 = (LAS float*)(lds + 65536);
    const bf16_t* PXc = (const bf16_t*)(a.ws + WS_PX) + (size_t)(TX + b * 256) * INW; bf16_t* Y = (bf16_t*)(a.ws + WS_Y) + (size_t)(TX + b * 256) * D;
    const float* cw = a.in[I_HCW] + (size_t)l * 3 * 768; const float* cb = a.in[I_HCB] + (size_t)l * 768; const float* skip = a.in[I_HSKIP] + (size_t)l * 2 * 256;
    const float* H0 = (const float*)(a.ws + WS_HCC) + 256, *H1 = H0 + (size_t)511 * 256;
#pragma unroll 2
    for (int i = 0; i < 32; ++i) { const int t = wave * 32 + i; V[t * 64 + lane] = ctx_uc(PXc, cw, cb, c, t); }
    __syncthreads();
    float acc[16];
#pragma unroll 1
    for (int g = 0; g < 2; ++g) { const int t0 = wave * 32 + g * 16; ctx_conv16(V, H0, c, lane, t0, acc); const float sk = skip[c];
#pragma unroll
        for (int i = 0; i < 16; ++i) { const int t = t0 + i; Z1[t * 64 + lane] = ctx_uc(PXc, cw, cb, 256 + c, t) * (acc[i] + V[t * 64 + lane] * sk); } }
    __syncthreads();
#pragma unroll 1
    for (int g = 0; g < 2; ++g) { const int t0 = wave * 32 + g * 16; ctx_conv16(Z1, H1, c, lane, t0, acc); const float sk = skip[256 + c];
#pragma unroll
        for (int i = 0; i < 16; ++i) { const int t = t0 + i; Y[(size_t)t * D + c] = (bf16_t)f2bf(ctx_uc(PXc, cw, cb, 512 + c, t) * (acc[i] + Z1[t * 64 + lane] * sk)); } }
    __syncthreads();
}

__device__ __forceinline__ void ytr_item(const Args& a, LAS unsigned char* tile, int item, int lane) {
    const int b = item >> 8, tt = (item >> 2) & 63, ct = item & 3;
    const bf16_t* src = (const bf16_t*)(a.ws + WS_YT) + ((size_t)(b * 256 + ct * 64)) * 4096 + tt * 64; bf16_t* Y = (bf16_t*)(a.ws + WS_Y) + ((size_t)b * 4096 + tt * 64) * D + ct * 64;
    u32x4 v[8];
#pragma unroll
    for (int i = 0; i < 8; ++i) v[i] = *(const u32x4*)(src + (size_t)((lane >> 3) + 8 * i) * 4096 + (lane & 7) * 8);
#pragma unroll
    for (int i = 0; i < 8; ++i) *(LAS u32x4*)(tile + ((lane >> 3) + 8 * i) * 144 + (lane & 7) * 16) = v[i];
    LDS_WAIT();
    const LAS unsigned short* tp = (const LAS unsigned short*)(tile + lane * 2);
#pragma unroll
    for (int q = 0; q < 8; ++q) { u32x4 o;
        o.x = (unsigned)tp[(8 * q + 0) * 72] | ((unsigned)tp[(8 * q + 1) * 72] << 16); o.y = (unsigned)tp[(8 * q + 2) * 72] | ((unsigned)tp[(8 * q + 3) * 72] << 16);
        o.z = (unsigned)tp[(8 * q + 4) * 72] | ((unsigned)tp[(8 * q + 5) * 72] << 16); o.w = (unsigned)tp[(8 * q + 6) * 72] | ((unsigned)tp[(8 * q + 7) * 72] << 16);
        *(u32x4*)(Y + (size_t)lane * D + 8 * q) = o; }
    LDS_WAIT();
}
__device__ __forceinline__ void event_arrive(unsigned* ctr) {
    asm volatile("s_waitcnt vmcnt(0)" ::: "memory"); __syncthreads();
    if (threadIdx.x == 0) { __builtin_amdgcn_fence(__ATOMIC_RELEASE, "agent"); asm volatile("s_waitcnt vmcnt(0)" ::: "memory"); __hip_atomic_fetch_add(ctr, 1u, __ATOMIC_RELAXED, __HIP_MEMORY_SCOPE_AGENT); }
}
__device__ __forceinline__ void event_wait(unsigned* ctr, unsigned want) {
    if (threadIdx.x == 0) { unsigned sp = 0;
        while (__hip_atomic_load(ctr, __ATOMIC_RELAXED, __HIP_MEMORY_SCOPE_AGENT) < want) { __builtin_amdgcn_s_sleep(2); if (++sp > (1u << 22)) break; }
        __builtin_amdgcn_fence(__ATOMIC_ACQUIRE, "agent"); asm volatile("s_waitcnt vmcnt(0)" ::: "memory"); }
    __syncthreads();
}

typedef short bf16x8_t __attribute__((ext_vector_type(8)));
typedef short s16x4_t __attribute__((ext_vector_type(4)));
typedef float f32x16 __attribute__((ext_vector_type(16)));
__device__ __forceinline__ int crow(int r, int hi) { return (r & 3) + 8 * (r >> 2) + 4 * hi; }
__device__ __forceinline__ unsigned cvtpk(float lo, float hi) { f32x2 v = {lo, hi}; bf16x2_t b = __builtin_convertvector(v, bf16x2_t); return __builtin_bit_cast(unsigned, b); }
__device__ __forceinline__ s16x4_t vtr(const LAS unsigned char* p) { return __builtin_bit_cast(s16x4_t, __builtin_amdgcn_ds_read_tr16_b64_v4i16((LAS s16x4_t*)p)); }
constexpr int AT_K = 0, AT_V = 16384, AT_WSF = 32768, AT_OST = 34816, AT_RPB = 67584, AT_END = 69632;
template <int KIND>
__device__ __forceinline__ void attn_unit(const Args& a, LAS unsigned char* lds, int l, int u, int wave_, CvtStream& cs, int cstride) {
    int lane = (int)__builtin_amdgcn_mbcnt_hi(~0u, __builtin_amdgcn_mbcnt_lo(~0u, 0u)); asm volatile("" : "+v"(lane));
    const int wid = wave_, tid = wave_ * 64 + lane, r32 = lane & 31, hi = lane >> 5;
    const bf16_t* PX = (const bf16_t*)(a.ws + WS_PX); bf16_t* Y = (bf16_t*)(a.ws + WS_Y);
    int b, qcol, kcol, vcol, ycol, qrow0, nloc = 0, lo = 0; bool sink = false; int hsink = 0;
    int qpos0 = 0, blk = 0, rq = 0, cbase = 0, rq4 = 0;
    if (KIND == 0) { b = u >> 6; const int kvh = (u >> 5) & 1; blk = u & 31; const int h = 2 * kvh + (wid >> 2); qpos0 = blk * 128 + 32 * (wid & 3); qrow0 = b * 4096 + qpos0;
        qcol = 1024 + h * 64; kcol = 1536 + kvh * 64; vcol = 1664 + kvh * 64; ycol = 256 + h * 64; lo = (blk == 0) ? 2 : 0; nloc = ((blk == 31) ? 3 : 5) - lo + 1; sink = true; hsink = h; }
    else if (KIND == 1) { b = u >> 6; const int h = (u >> 4) & 3; rq4 = u & 15; rq = 4 * rq4 + (wid >> 1); cbase = 32 * (wid & 1); qrow0 = b * 4096 + rq * 64 + cbase;
        qcol = 1280 + h * 64; kcol = 1792 + h * 64; vcol = 2048 + h * 64; ycol = 768 + h * 64;
        const int ra = 4 * rq4 - 4, rb = 4 * rq4 + 3 - 4; lo = ra < 0 ? 0 : (ra > 56 ? 56 : ra); const int hi_r = (rb < 0 ? 0 : (rb > 56 ? 56 : rb)) + 7; nloc = hi_r - lo + 1;
        LAS float* rpbL = (LAS float*)(lds + AT_RPB); const float* src = a.in[I_RPB] + (size_t)(l * 4 + h) * 465;
        for (int i = tid; i < 465; i += NTHR) rpbL[i] = src[i] * 8.0f; }
    else { b = u >> 3; const int h = (u >> 1) & 3; qrow0 = TX + b * 256 + 32 * wid;
        if ((u & 1) == 0) { qcol = 1024 + h * 64; kcol = 1536 + (h >> 1) * 64; vcol = 1664 + (h >> 1) * 64; ycol = 256 + h * 64; sink = true; hsink = h; }
        else { qcol = 1280 + h * 64; kcol = 1792 + h * 64; vcol = 2048 + h * 64; ycol = 768 + h * 64; } }
    const int NT = nloc + 4;
    bf16x8_t qr[4];
    { const bf16_t* qp = PX + (size_t)(qrow0 + r32) * INW + qcol + hi * 8;
#pragma unroll
      for (int d0 = 0; d0 < 4; ++d0) qr[d0] = *(const bf16x8_t*)(qp + d0 * 16); }
    const int krow = 8 * wid + (lane & 7), kchunk = lane >> 3; const int vrow = 16 * (wid & 3) + (lane >> 2), vcoff = (wid >> 2) * 32 + (lane & 3) * 8;
    const int kdst = AT_K + kchunk * 1024 + krow * 16, vdst = AT_V + wid * 1024 + lane * 16;
    auto tile_row0 = [&](int t) -> int { if (t < nloc) { if (KIND == 0) return b * 4096 + blk * 128 - 128 + 64 * (lo + t); else return b * 4096 + (lo + t) * 64; } return TX + b * 256 + 64 * (t - nloc); };
    u32x4 gk0, gv0, gk1, gv1;
#define AT_LOAD(GK, GV, t_) do { const int R0_ = tile_row0(t_); GK = *(const u32x4*)(PX + (size_t)(R0_ + krow) * INW + kcol + kchunk * 8); GV = *(const u32x4*)(PX + (size_t)(R0_ + vrow) * INW + vcol + vcoff); } while (0)
    AT_LOAD(gk0, gv0, 0);
    if (NT > 1) AT_LOAD(gk1, gv1, 1); else { gk1 = gk0; gv1 = gv0; }
    *(LAS u32x4*)(lds + kdst) = gk0; *(LAS u32x4*)(lds + vdst) = gv0;
    float mhat = -1e30f, l_reg = 0.f; f32x16 o[2];
#pragma unroll
    for (int r = 0; r < 16; ++r) { o[0][r] = 0.f; o[1][r] = 0.f; }
    LAS float* wsf = (LAS float*)(lds + AT_WSF) + wid * 64;
    const LAS unsigned char* vb0 = lds + AT_V + ((lane >> 4) & 1) * 32 + (lane & 3) * 8 + (4 * hi + ((lane & 15) >> 2)) * 64;
    const LAS unsigned char* kb0 = lds + AT_K + hi * 1024 + r32 * 16;
    __syncthreads();
    auto step = [&](int t, u32x4& gkw, u32x4& gvw, u32x4& gkl, u32x4& gvl) __attribute__((always_inline)) {
        const int bufo = (t & 1) * 8192;
        cvt_issue(a, cs, lane);
        if (t + 2 < NT) AT_LOAD(gkl, gvl, t + 2);
        bool need = true; bool full = true; int ts = 0, rk = 0;
        if (t < nloc) {
            if (KIND == 0) { ts = blk * 128 - 128 + 64 * (lo + t); need = (ts + 63 >= qpos0 - 128) && (ts <= qpos0 + 31 + 128); full = (qpos0 + 31 - ts <= 128) && (ts + 63 - qpos0 <= 128); }
            if (KIND == 1) { rk = lo + t; const int r0 = (rq - 4) < 0 ? 0 : ((rq - 4) > 56 ? 56 : (rq - 4)); need = (rk >= r0) && (rk <= r0 + 7); full = false; }
        }
        if (need) {
            f32x16 p0, p1;
#pragma unroll
            for (int r = 0; r < 16; ++r) { p0[r] = 0.f; p1[r] = 0.f; }
            const LAS unsigned char* kb = kb0 + bufo;
#pragma unroll
            for (int d0 = 0; d0 < 4; ++d0) { const bf16x8_t k0 = *(const LAS bf16x8_t*)(kb + d0 * 2048), k1 = *(const LAS bf16x8_t*)(kb + d0 * 2048 + 512);
                p0 = __builtin_amdgcn_mfma_f32_32x32x16_bf16(k0, qr[d0], p0, 0, 0, 0); p1 = __builtin_amdgcn_mfma_f32_32x32x16_bf16(k1, qr[d0], p1, 0, 0, 0); }
            constexpr float C2 = 0.125f * LOG2E;
            if (!full) {
                if (KIND == 0) { const int tq = qpos0 + r32;
#pragma unroll
                    for (int r = 0; r < 16; ++r) { const int k0 = ts + crow(r, hi), d0 = tq - k0, d1 = d0 - 32; p0[r] = (d0 > 128 || d0 < -128) ? -INFINITY : p0[r]; p1[r] = (d1 > 128 || d1 < -128) ? -INFINITY : p1[r]; } }
                if (KIND == 1) { const int c = cbase + r32; const int wsc = (c - 8) < 0 ? 0 : ((c - 8) > 48 ? 48 : (c - 8)); const LAS float* rp = (const LAS float*)(lds + AT_RPB) + (rk - rq + 7) * 31 + 15 - c;
                    { float b0[16];
#pragma unroll
                      for (int r = 0; r < 16; ++r) { const int c0 = crow(r, hi); const int i0 = c0 < wsc ? wsc : (c0 > wsc + 15 ? wsc + 15 : c0); b0[r] = rp[i0]; }
#pragma unroll
                      for (int r = 0; r < 16; ++r) { const int c0 = crow(r, hi); const bool ok0 = (c0 >= wsc) && (c0 < wsc + 16); p0[r] = ok0 ? p0[r] + b0[r] : -INFINITY; } }
                    asm volatile("" : "+v"(p0) :: "memory");
                    { float b1[16];
#pragma unroll
                      for (int r = 0; r < 16; ++r) { const int c1 = crow(r, hi) + 32; const int i1 = c1 < wsc ? wsc : (c1 > wsc + 15 ? wsc + 15 : c1); b1[r] = rp[i1]; }
#pragma unroll
                      for (int r = 0; r < 16; ++r) { const int c1 = crow(r, hi) + 32; const bool ok1 = (c1 >= wsc) && (c1 < wsc + 16); p1[r] = ok1 ? p1[r] + b1[r] : -INFINITY; } } }
            }
            float rm = fmaxf(p0[0], p1[0]);
#pragma unroll
            for (int r = 1; r < 16; ++r) rm = fmaxf(rm, fmaxf(p0[r], p1[r]));
            { auto rr = __builtin_amdgcn_permlane32_swap(__float_as_uint(rm), __float_as_uint(rm), false, false); rm = fmaxf(__uint_as_float(rr[0]), __uint_as_float(rr[1])); }
            const float mnew = fmaxf(mhat, rm); const float f = __builtin_amdgcn_exp2f((mhat - mnew) * C2); const bool grew = mnew > mhat; mhat = mnew;
            const float nm = -mnew * C2; float sacc = 0.f;
#pragma unroll
            for (int r = 0; r < 16; ++r) { p0[r] = __builtin_amdgcn_exp2f(fmaf(p0[r], C2, nm)); p1[r] = __builtin_amdgcn_exp2f(fmaf(p1[r], C2, nm)); sacc += p0[r] + p1[r]; }
            l_reg = l_reg * f + sacc;
            if (__any(grew)) { if (hi == 0) wsf[r32] = f; LDS_WAIT();
#pragma unroll
                for (int r = 0; r < 16; ++r) { const float fr_ = wsf[crow(r, hi)]; o[0][r] *= fr_; o[1][r] *= fr_; }
                LDS_WAIT(); }
            u32x4 pw0, pw1, pw2, pw3;
            pw0 = (u32x4){cvtpk(p0[0], p0[1]), cvtpk(p0[2], p0[3]), cvtpk(p0[4], p0[5]), cvtpk(p0[6], p0[7])}; pw1 = (u32x4){cvtpk(p0[8], p0[9]), cvtpk(p0[10], p0[11]), cvtpk(p0[12], p0[13]), cvtpk(p0[14], p0[15])};
            pw2 = (u32x4){cvtpk(p1[0], p1[1]), cvtpk(p1[2], p1[3]), cvtpk(p1[4], p1[5]), cvtpk(p1[6], p1[7])}; pw3 = (u32x4){cvtpk(p1[8], p1[9]), cvtpk(p1[10], p1[11]), cvtpk(p1[12], p1[13]), cvtpk(p1[14], p1[15])};
            const LAS unsigned char* vb = vb0 + bufo;
#pragma unroll
            for (int d0 = 0; d0 < 2; ++d0) {
#pragma unroll
                for (int ks = 0; ks < 4; ++ks) { const s16x4_t vl = vtr(vb + d0 * 4096 + ks * 1024), vh = vtr(vb + d0 * 4096 + ks * 1024 + 512);
                    const bf16x8_t vf = (bf16x8_t){vl[0], vl[1], vl[2], vl[3], vh[0], vh[1], vh[2], vh[3]};
                    const bf16x8_t pa = __builtin_bit_cast(bf16x8_t, ks == 0 ? pw0 : (ks == 1 ? pw1 : (ks == 2 ? pw2 : pw3)));
                    o[d0] = __builtin_amdgcn_mfma_f32_32x32x16_bf16(pa, vf, o[d0], 0, 0, 0); } }
        }
        cvt_finish(a, cs, (LAS float*)(lds + 73728) + wid * 2112, lane, cstride);
        if (t + 1 < NT) { const int nb = ((t + 1) & 1) * 8192; *(LAS u32x4*)(lds + kdst + nb) = gkw; *(LAS u32x4*)(lds + vdst + nb) = gvw; }
        __syncthreads();
    };
    for (int t = 0; t < NT; t += 2) { step(t, gk1, gv1, gk0, gv0); if (t + 1 < NT) step(t + 1, gk0, gv0, gk1, gv1); }
#undef AT_LOAD
    { auto rr = __builtin_amdgcn_permlane32_swap(__float_as_uint(l_reg), __float_as_uint(l_reg), false, false); l_reg = __uint_as_float(rr[0]) + __uint_as_float(rr[1]); }
    if (sink) l_reg += __builtin_amdgcn_exp2f(a.in[I_SINK][l * 4 + hsink] * LOG2E - mhat * (0.125f * LOG2E));
    if (hi == 0) wsf[32 + r32] = 1.0f / l_reg;
    LDS_WAIT();
    LAS bf16_t* stg = (LAS bf16_t*)(lds + AT_OST) + wid * 2048;
#pragma unroll
    for (int r = 0; r < 16; ++r) { const int orow = crow(r, hi); const float il = wsf[32 + orow];
        stg[orow * 64 + r32] = (bf16_t)f2bf(o[0][r] * il); stg[orow * 64 + 32 + r32] = (bf16_t)f2bf(o[1][r] * il); }
    LDS_WAIT();
#pragma unroll
    for (int i = 0; i < 4; ++i) { const int row = i * 8 + (lane >> 3), ch = lane & 7; const u32x4 v = *(const LAS u32x4*)(stg + row * 64 + ch * 8);
        *(u32x4*)(Y + (size_t)(qrow0 + row) * D + ycol + ch * 8) = v; }
    __syncthreads();
}


template <int HW>
__device__ __forceinline__ void pool_tile(const bf16_t* PX, bf16_t* Y, const float* pscale, int tile, int g, int lane, const bf16x8_t (&wf)[4][2]) {
    const int tk = lane & 15, oc = lane >> 4; const int row = tile * 16 + tk; const bool lat = row < TX; const int tpos = lat ? (row & 4095) : ((row - TX) & 255); const int Ls = lat ? 4096 : 256;
    const bf16_t* pr = PX + (size_t)row * INW + 768 + g * 64 + 8 * oc;
    u32x4 w0[2 * HW], w1[2 * HW];
#pragma unroll
    for (int i = 0; i < 2 * HW; ++i) { const int off = i - HW; const int tp = tpos + off; const bool inr = (tp >= 0) && (tp < Ls); const bf16_t* p = pr + (ptrdiff_t)(inr ? off : 0) * INW; w0[i] = *(const u32x4*)p; w1[i] = *(const u32x4*)(p + 32); }
    float s0[8], s1[8]; int cnt = 0;
#pragma unroll
    for (int j = 0; j < 8; ++j) { s0[j] = 0.f; s1[j] = 0.f; }
#pragma unroll
    for (int i = 0; i < 2 * HW; ++i) { const int tp = tpos + i - HW; const bool in = (tp >= 0) && (tp < Ls); const float m = in ? 1.0f : 0.0f; cnt += in ? 1 : 0;
        s0[0] += m * bflo(w0[i].x); s0[1] += m * bfhi(w0[i].x); s0[2] += m * bflo(w0[i].y); s0[3] += m * bfhi(w0[i].y); s0[4] += m * bflo(w0[i].z); s0[5] += m * bfhi(w0[i].z); s0[6] += m * bflo(w0[i].w); s0[7] += m * bfhi(w0[i].w);
        s1[0] += m * bflo(w1[i].x); s1[1] += m * bfhi(w1[i].x); s1[2] += m * bflo(w1[i].y); s1[3] += m * bfhi(w1[i].y); s1[4] += m * bflo(w1[i].z); s1[5] += m * bfhi(w1[i].z); s1[6] += m * bflo(w1[i].w); s1[7] += m * bfhi(w1[i].w); }
    const float ic = 1.0f / (float)cnt; const u32x4 c0 = w0[HW], c1 = w1[HW];
    const float u0[8] = {bflo(c0.x), bfhi(c0.x), bflo(c0.y), bfhi(c0.y), bflo(c0.z), bfhi(c0.z), bflo(c0.w), bfhi(c0.w)}, u1[8] = {bflo(c1.x), bfhi(c1.x), bflo(c1.y), bfhi(c1.y), bflo(c1.z), bfhi(c1.z), bflo(c1.w), bfhi(c1.w)};
    u32x4 d0, d1;
    d0.x = cvtpk(s0[0] * ic - u0[0], s0[1] * ic - u0[1]); d0.y = cvtpk(s0[2] * ic - u0[2], s0[3] * ic - u0[3]); d0.z = cvtpk(s0[4] * ic - u0[4], s0[5] * ic - u0[5]); d0.w = cvtpk(s0[6] * ic - u0[6], s0[7] * ic - u0[7]);
    d1.x = cvtpk(s1[0] * ic - u1[0], s1[1] * ic - u1[1]); d1.y = cvtpk(s1[2] * ic - u1[2], s1[3] * ic - u1[3]); d1.z = cvtpk(s1[4] * ic - u1[4], s1[5] * ic - u1[5]); d1.w = cvtpk(s1[6] * ic - u1[6], s1[7] * ic - u1[7]);
    const bf16x8_t b0 = __builtin_bit_cast(bf16x8_t, d0), b1 = __builtin_bit_cast(bf16x8_t, d1);
    bf16_t* yr = Y + (size_t)row * D + 512 + g * 64 + 4 * oc;
#pragma unroll
    for (int nt = 0; nt < 4; ++nt) { f32x4 acc = {0.f, 0.f, 0.f, 0.f};
        acc = __builtin_amdgcn_mfma_f32_16x16x32_bf16(wf[nt][0], b0, acc, 0, 0, 0); acc = __builtin_amdgcn_mfma_f32_16x16x32_bf16(wf[nt][1], b1, acc, 0, 0, 0);
        const f32x4 sc = *(const f32x4*)(pscale + g * 64 + 16 * nt + 4 * oc); acc *= sc;
        u32x2 ov; ov.x = cvtpk(acc[0], acc[1]); ov.y = cvtpk(acc[2], acc[3]); *(u32x2*)(yr + 16 * nt) = ov; }
}
__device__ __forceinline__ void phase_mix1(const Args& a, unsigned char* ldsg, int vcu, int G, int l) {
    LAS unsigned char* lds = (LAS unsigned char*)ldsg;
    int tid_ = threadIdx.x; asm volatile("" : "+v"(tid_));
    const int tid = tid_, lane = tid & 63, wave = __builtin_amdgcn_readfirstlane(tid >> 6);
    unsigned char* ws = a.ws; asm volatile("" : "+s"(ws)); const bf16_t* PX = (const bf16_t*)(ws + WS_PX); bf16_t* Y = (bf16_t*)(ws + WS_Y);
    const bool upd = (l == 0); const int nrows = upd ? TT : TX;
    const int gw = vcu * NWAVES + wave, NGW = G * NWAVES;
    { AMP_BEGIN(31) load_tw(a, lds, tid);
    for (int it = vcu; it < 1024; it += G) hyena_item(a, lds, l, it >> 2, it & 3, tid);
    if (upd) for (int it = vcu; it < 32; it += G) ctx_hyena_item(a, lds, l, it, tid);
    event_arrive((unsigned*)(ws + WS_CTL) + 8192 + 64 * l); AMP_END(31) }
    { AMP_BEGIN(32)
    { const int g = gw & 3; const float* pwg = a.in[I_POOLW] + (size_t)(l * 4 + g) * 4096; const float* pscale = a.in[I_POOLS] + (size_t)l * 256;
      bf16x8_t wf[4][2];
#pragma unroll
      for (int nt = 0; nt < 4; ++nt)
#pragma unroll
          for (int ks = 0; ks < 2; ++ks) { const float* wp = pwg + (size_t)(32 * ks + 8 * (lane >> 4)) * 64 + 16 * nt + (lane & 15); u32x4 w;
              w.x = cvtpk(wp[0], wp[64]); w.y = cvtpk(wp[128], wp[192]); w.z = cvtpk(wp[256], wp[320]); w.w = cvtpk(wp[384], wp[448]); wf[nt][ks] = __builtin_bit_cast(bf16x8_t, w); }
      const int ntiles = nrows / 16;
      for (int it = gw; it < ntiles * 4; it += NGW) { const int tile = it >> 2;
          if (g == 0) pool_tile<1>(PX, Y, pscale, tile, g, lane, wf); else if (g == 1) pool_tile<2>(PX, Y, pscale, tile, g, lane, wf); else if (g == 2) pool_tile<4>(PX, Y, pscale, tile, g, lane, wf); else pool_tile<8>(PX, Y, pscale, tile, g, lane, wf); } }
    __syncthreads(); AMP_END(32) }
    { AMP_BEGIN(33)
    CvtStream cs; cs.it = upd ? gw : CVT_ITEMS; cs.end = CVT_ITEMS; cs.live = 0;
    for (int u = vcu; u < 512; u += G) attn_unit<0>(a, lds, l, u, wave, cs, NGW);
    for (int u = vcu; u < 512; u += G) attn_unit<1>(a, lds, l, u, wave, cs, NGW);
    if (upd) for (int u = vcu; u < 64; u += G) attn_unit<2>(a, lds, l, u, wave, cs, NGW);
    int lane2 = (int)__builtin_amdgcn_mbcnt_hi(~0u, __builtin_amdgcn_mbcnt_lo(~0u, 0u)); asm volatile("" : "+v"(lane2));
    while (cs.it < cs.end) { cvt_issue(a, cs, lane2); cvt_finish(a, cs, (LAS float*)(lds + 73728) + wave * 2112, lane2, NGW); }
    AMP_END(33) }
    { AMP_BEGIN(34) event_wait((unsigned*)(ws + WS_CTL) + 8192 + 64 * l, (unsigned)G);
      int lane3 = (int)__builtin_amdgcn_mbcnt_hi(~0u, __builtin_amdgcn_mbcnt_lo(~0u, 0u)); asm volatile("" : "+v"(lane3));
      for (int it = gw; it < 2048; it += NGW) ytr_item(a, lds + wave * 9216, it, lane3); AMP_END(34) }
}

__device__ __forceinline__ void phase_select(const Args& a, unsigned char* ldsg, int vcu, int G, bool with_ctx) {
    LAS unsigned* keys = (LAS unsigned*)(LAS unsigned char*)ldsg;
    LAS unsigned* hist = keys + 4096;
    LAS unsigned* ctl = hist + 256 + 64;
    int tid_ = threadIdx.x; asm volatile("" : "+v"(tid_));
    const int tid = tid_, lane = tid & 63; unsigned char* ws = a.ws; asm volatile("" : "+s"(ws));
    const float* AFFT = (const float*)(ws + WS_AFFT); int* ROWMAP = (int*)(ws + WS_ROWMAP); float* GATE = (float*)(ws + WS_GATE); int* INV = (int*)(ws + WS_INV);
    const int nitems = 128 + (with_ctx ? 128 : 0);
    for (int item = vcu; item < nitems; item += G) {
        int e, base, Ls, cap, slot0;
        if (item < 128) { const int b = item >> 4; e = item & 15; base = b * 4096; Ls = 4096; cap = CAPX; slot0 = b * CAPX; }
        else { const int it = item - 128; const int b = it >> 4; e = it & 15; base = TX + b * 256; Ls = 256; cap = CAPC; slot0 = NB * CAPX + b * CAPC; }
        unsigned k[8];
#pragma unroll
        for (int i = 0; i < 8; ++i) { const int idx = tid + NTHR * i; k[i] = (idx < Ls) ? __float_as_uint(AFFT[(size_t)e * TT + base + idx]) : 0u; if (idx < Ls) keys[idx] = k[i]; }
        if (tid == 0) { ctl[0] = 0u; ctl[1] = (unsigned)cap; ctl[2] = 0u; ctl[3] = 0u; }
        unsigned prefix = 0u;
#pragma unroll 1
        for (int p = 0; p < 4; ++p) { const int shift = 24 - 8 * p;
            if (tid < 256) hist[tid] = 0u;
            __syncthreads();
#pragma unroll
            for (int i = 0; i < 8; ++i) { const int idx = tid + NTHR * i; const bool cand = (idx < Ls) && (p == 0 || (k[i] >> (shift + 8)) == prefix);
                if (cand) atomicAdd((unsigned*)&hist[(k[i] >> shift) & 255u], 1u); }
            __syncthreads();
            if (tid < 64) {
                const unsigned need = ctl[1];
                const unsigned c0 = hist[255 - 4 * lane], c1 = hist[254 - 4 * lane], c2 = hist[253 - 4 * lane], c3 = hist[252 - 4 * lane];
                const unsigned s = c0 + c1 + c2 + c3;
                hist[256 + lane] = s; LDS_WAIT();
                unsigned inc = 0u;
                for (int q = 0; q < 64; ++q) { const unsigned v = hist[256 + q]; inc += (q <= lane) ? v : 0u; }
                const unsigned exc = inc - s;
                if (exc < need && inc >= need) { unsigned above = exc; int d;
                    if (above + c0 >= need) d = 255 - 4 * lane; else { above += c0; if (above + c1 >= need) d = 254 - 4 * lane; else { above += c1; if (above + c2 >= need) d = 253 - 4 * lane; else { above += c2; d = 252 - 4 * lane; } } }
                    ctl[0] = (prefix << 8) | (unsigned)d; ctl[1] = need - above; } }
            __syncthreads();
            prefix = ctl[0]; }
        const unsigned T = prefix; const unsigned need = ctl[1];
        int eqc = 0;
#pragma unroll
        for (int i = 0; i < 8; ++i) { const int idx = tid + NTHR * i; eqc += ((idx < Ls) && k[i] == T) ? 1 : 0; }
        if (eqc) atomicAdd((unsigned*)&ctl[3], (unsigned)eqc);
        __syncthreads();
        const bool all_eq = (ctl[3] == need);
#pragma unroll
        for (int i = 0; i < 8; ++i) { const int idx = tid + NTHR * i;
            if (idx < Ls && (k[i] > T || (all_eq && k[i] == T))) { const int s = (int)atomicAdd((unsigned*)&ctl[2], 1u); const int slot = e * SLOTS + slot0 + s;
                ROWMAP[slot] = base + idx; GATE[slot] = __uint_as_float(k[i]); INV[(size_t)(base + idx) * 16 + e] = slot; } }
        __syncthreads();
        if (!all_eq && tid == 0) {
            int s = (int)ctl[2]; unsigned left = need;
            for (int idx = 0; idx < Ls && left; ++idx) if (keys[idx] == T) { const int slot = e * SLOTS + slot0 + s; ROWMAP[slot] = base + idx; GATE[slot] = __uint_as_float(T); INV[(size_t)(base + idx) * 16 + e] = slot; ++s; --left; } }
        __syncthreads();
    }
}
__device__ __forceinline__ void phase_gather(const Args& a, int vcu, int G, bool with_ctx) {
    int tid_ = threadIdx.x; asm volatile("" : "+v"(tid_));
    const int tid = tid_, lane = tid & 63, wave = __builtin_amdgcn_readfirstlane(tid >> 6); unsigned char* ws = a.ws; asm volatile("" : "+s"(ws));
    const int* ROWMAP = (const int*)(ws + WS_ROWMAP); const bf16_t* HX = (const bf16_t*)(ws + WS_HX); bf16_t* XG = (bf16_t*)(ws + WS_XG);
    const int per = with_ctx ? SLOTS : NB * CAPX; const int gw = vcu * NWAVES + wave, NGW = G * NWAVES;
    for (int it = gw; it < NE * per; it += NGW) { const int e = it / per, s = it % per; const int slot = e * SLOTS + s; const int src = ROWMAP[slot];
        const u32x4* sp = (const u32x4*)(HX + (size_t)src * D) + 2 * lane; u32x4* dp = (u32x4*)(XG + (size_t)slot * D) + 2 * lane;
        const u32x4 v0 = sp[0], v1 = sp[1]; dp[0] = v0; dp[1] = v1; }
}
__device__ __forceinline__ void phase_combine(const Args& a, int vcu, int G, int l, bool with_ctx, bool final_norm, bool next_norm) {
    int tid_ = threadIdx.x; asm volatile("" : "+v"(tid_));
    const int tid = tid_, lane = tid & 63, wave = __builtin_amdgcn_readfirstlane(tid >> 6); unsigned char* ws = a.ws; asm volatile("" : "+s"(ws));
    const int* INV = (const int*)(ws + WS_INV); const bf16_t* OB = (const bf16_t*)(ws + WS_XG); const float* MOD = (const float*)(ws + WS_MOD) + (size_t)l * 9 * 6144;
    const float* MODN = (const float*)(ws + WS_MOD) + (size_t)(l + 1) * 9 * 6144; const float* gainn = a.in[I_N1G] + (l + 1) * D; bf16_t* HX = (bf16_t*)(ws + WS_HX);
    bf16_t* XB = (bf16_t*)(ws + WS_XB); const float* fng = a.in[I_FNG];
    const int nrows = with_ctx ? TT : TX; const int gw = vcu * NWAVES + wave, NGW = G * NWAVES;
    const float pz = (final_norm && __hip_atomic_load((unsigned*)(ws + WS_CTL) + 12288, __ATOMIC_RELAXED, __HIP_MEMORY_SCOPE_AGENT) != 0u) ? __builtin_nanf("") : 0.f;
    for (int rowa = gw; rowa < nrows; rowa += 2 * NGW) {
        int myinv[2]; f32x4 xv[2][4]; f32x4 acc[2][4];
#pragma unroll
        for (int u = 0; u < 2; ++u) { const int row = rowa + u * NGW; const bool ok = row < nrows; const int rr = ok ? row : rowa;
            myinv[u] = (lane < 16 && ok) ? INV[(size_t)rr * 16 + lane] : -1;
            const bf16_t* xr = XB + (size_t)rr * D;
#pragma unroll
            for (int j = 0; j < 4; ++j) { const u32x2 w = *(const u32x2*)(xr + 256 * j + 4 * lane); xv[u][j] = (f32x4){bflo(w.x), bfhi(w.x), bflo(w.y), bfhi(w.y)}; acc[u][j] = (f32x4){0.f, 0.f, 0.f, 0.f}; } }
#pragma unroll
        for (int u = 0; u < 2; ++u) {
            unsigned long long mask = __ballot(myinv[u] >= 0) & 0xffffull;
            while (mask) { int sl[4];
#pragma unroll
                for (int q = 0; q < 4; ++q) { if (mask) { const int e = __builtin_ctzll(mask); mask &= mask - 1; sl[q] = __builtin_amdgcn_readlane(myinv[u], e); } else sl[q] = -1; }
                u32x2 w[4][4];
#pragma unroll
                for (int q = 0; q < 4; ++q) { const bf16_t* orow = OB + (size_t)(sl[q] >= 0 ? sl[q] : 0) * D;
#pragma unroll
                    for (int j = 0; j < 4; ++j) w[q][j] = *(const u32x2*)(orow + 256 * j + 4 * lane); }
#pragma unroll
                for (int q = 0; q < 4; ++q) { const float m = (sl[q] >= 0) ? 1.0f : 0.0f;
#pragma unroll
                    for (int j = 0; j < 4; ++j) { acc[u][j][0] += m * bflo(w[q][j].x); acc[u][j][1] += m * bfhi(w[q][j].x); acc[u][j][2] += m * bflo(w[q][j].y); acc[u][j][3] += m * bfhi(w[q][j].y); } } } }
#pragma unroll
        for (int u = 0; u < 2; ++u) { const int row = rowa + u * NGW; if (row < nrows) {
            const bool lat = row < TX; float* xr = a.out + (size_t)row * D; bf16_t* xbr = XB + (size_t)row * D; const int mrow = lat ? (row >> 12) : 8;
            const float* gp = MOD + mrow * 6144 + 5 * 1024; f32x4 v[4]; float ss = 0.f;
#pragma unroll
            for (int j = 0; j < 4; ++j) { const f32x4 g = *(const f32x4*)(gp + 256 * j + 4 * lane); v[j] = xv[u][j] + g * acc[u][j];
                ss += (v[j][0] * v[j][0] + v[j][1] * v[j][1]) + (v[j][2] * v[j][2] + v[j][3] * v[j][3]); }
            if (final_norm) { const float rstd = 1.0f / sqrtf(wave_sum(ss) * (1.0f / D) + 1e-6f);
#pragma unroll
                for (int j = 0; j < 4; ++j) { const f32x4 g = *(const f32x4*)(fng + 256 * j + 4 * lane); *(f32x4*)(xr + 256 * j + 4 * lane) = v[j] * rstd * g + pz; } }
            else {
#pragma unroll
                for (int j = 0; j < 4; ++j) { u32x2 o; o.x = pk2(v[j][0], v[j][1]); o.y = pk2(v[j][2], v[j][3]); *(u32x2*)(xbr + 256 * j + 4 * lane) = o; }
                if (next_norm) { const float rstd = 1.0f / sqrtf(wave_sum(ss) * (1.0f / D) + 1e-6f); const float* shp = MODN + mrow * 6144; const float* scp = shp + 1024;
#pragma unroll
                    for (int j = 0; j < 4; ++j) { const f32x4 gg = *(const f32x4*)(gainn + 256 * j + 4 * lane), sh = *(const f32x4*)(shp + 256 * j + 4 * lane), sc = *(const f32x4*)(scp + 256 * j + 4 * lane);
                        const f32x4 hv = (v[j] * rstd * gg) * (1.0f + sc) + sh; u32x2 o; o.x = pk2(hv[0], hv[1]); o.y = pk2(hv[2], hv[3]); *(u32x2*)(HX + (size_t)row * D + 256 * j + 4 * lane) = o; } } } } }
    }
}

#define XBAR() do { xcd_barrier(bar); if (AMP_PHASE == 99) xcd_barrier(bar); } while (0)

__global__ void __launch_bounds__(NTHR, 2) fwd_kernel(Args a) {
    extern __shared__ __attribute__((aligned(16))) unsigned char lds[];
    cg::grid_group grid = cg::this_grid();
    const int G = gridDim.x, bx = blockIdx.x; const int vcu = (G % 8 == 0) ? (bx % 8) * (G / 8) + bx / 8 : bx;
    unsigned char* ws = a.ws;
    PG8_LAS unsigned char* glds = (PG8_LAS unsigned char*)lds;
    volatile LAS unsigned* bst = (volatile LAS unsigned*)((LAS unsigned char*)lds + LDS_BYTES - 16);
    if (threadIdx.x < 4) bst[threadIdx.x] = 0u;
    __syncthreads();
    XcdBarrier bar = xcd_barrier_post((unsigned*)(ws + WS_CTL), bst);
    { AMP_BEGIN(0) phase_prologue(a, lds, vcu, G); AMP_END(0) }
    grid.sync();
    for (int l = 0; l < 2; ++l) {
        const bool upd = (l == 0);
        asm volatile("" : "+s"(ws));
        const float* srcx = a.in[I_X]; const float* srcc = a.in[I_CTX];
        if (upd) {
            { AMP_BEGIN(1) phase_norm(a, lds, vcu, G, l, srcx, srcc, nullptr, a.in[I_N1G] + l * D, 0, TT, false); AMP_END(1) }
            { AMP_BEGIN(11) load_tw(a, (LAS unsigned char*)lds, threadIdx.x); for (int it = vcu; it < 1024; it += G) spectrum_item(a, (LAS unsigned char*)lds, it, threadIdx.x); AMP_END(11) }
            XBAR();
        }
        { AMP_BEGIN(2) pg8::Gemm g{(const pg8::bf16_t*)(ws + WS_HX), (const pg8::bf16_t*)(ws + WS_WIN_T) + (size_t)l * INW * D, TT, INW, D};
          pg8::GroupOrder S; S.init(1, TT / 256, INW / 256, 0, G, bx);
          { PG8_LAS float* rl = (PG8_LAS float*)(glds + 131072 + 20480); const float* rs = (const float*)(ws + WS_ROPE); int tx = threadIdx.x; asm volatile("" : "+v"(tx)); for (int i = tx; i < 2048; i += NTHR) rl[i] = rs[i]; __syncthreads(); }
          pg8::EpiIn E{(pg8::bf16_t*)(ws + WS_PX), (const PG8_LAS float*)(glds + 131072 + 20480), (pg8::bf16_t*)(ws + WS_UT), glds + 131072, 1.0f};
          pg8::gemm_phase<pg8::EpiIn, pg8::GroupOrder, true, true>(glds, g, S, E); AMP_END(2) }
        XBAR();
        { AMP_BEGIN(3) phase_mix1(a, lds, vcu, G, l); AMP_END(3) }
        XBAR();
        { AMP_BEGIN(4) pg8::Gemm g{(const pg8::bf16_t*)(ws + WS_Y), (const pg8::bf16_t*)(ws + WS_WOUT_T) + (size_t)l * D * D, TT, D, D};
          pg8::GroupOrder S; S.init(1, (upd ? TT : TX) / 256, D / 256, 0, G, bx);
          pg8::EpiOut E{a.in[I_X], a.in[I_CTX], (pg8::bf16_t*)(ws + WS_XB), (const float*)(ws + WS_MOD) + (size_t)l * 9 * 6144, upd ? 1 : 0};
          pg8::gemm_phase<pg8::EpiOut, pg8::GroupOrder, true, true>(glds, g, S, E); AMP_END(4) }
        XBAR();
        { AMP_BEGIN(5) phase_norm(a, lds, vcu, G, l, nullptr, nullptr, (const bf16_t*)(ws + WS_XB), a.in[I_N2G] + l * D, 3, upd ? TT : TX, true); AMP_END(5) }
        XBAR();
        { AMP_BEGIN(6) phase_select(a, lds, vcu, G, upd); AMP_END(6) }
        XBAR();
        { AMP_BEGIN(8) pg8::Gemm g{(const pg8::bf16_t*)(ws + WS_HX), (const pg8::bf16_t*)(ws + WS_WGU_T + (size_t)l * NE * 4096 * D), NE * SLOTS, NE * 4096, D};
          pg8::GroupOrder S; S.init(NE, upd ? 17 : 16, 16, 17, G, bx);
          { PG8_LAS float* sl = (PG8_LAS float*)(glds + 131072 + 17408); const float* ss = (const float*)(ws + WS_WSC) + l * 48; int tx = threadIdx.x; asm volatile("" : "+v"(tx)); if (tx < 32) sl[tx] = ss[tx]; __syncthreads(); }
          pg8::EpiGU E{(unsigned char*)(ws + WS_ACT), (const PG8_LAS float*)(glds + 131072 + 17408)};
          pg8::gemm_phase_gather<pg8::EpiGU, pg8::GroupOrder, true>(glds, g, (const int*)(ws + WS_ROWMAP), (PG8_LAS int*)(glds + 131072), S, E); AMP_END(8) }
        XBAR();
        { AMP_BEGIN(9) pg8::Gemm g{(const pg8::bf16_t*)(ws + WS_ACT), (const pg8::bf16_t*)(ws + WS_WD_T + (size_t)l * NE * D * FF), NE * SLOTS, NE * D, FF};
          pg8::GroupOrder S; S.init(NE, upd ? 17 : 16, 4, 17, G, bx);
          { PG8_LAS float* gl = (PG8_LAS float*)(glds + 131072); const float* gs = (const float*)(ws + WS_GATE); const float* ss = (const float*)(ws + WS_WSC) + l * 48 + 32; pg8::Unit uu; int tx = threadIdx.x; asm volatile("" : "+v"(tx));
            for (int i = 0; S.next(i, uu); ++i) if (tx < 256) gl[i * 256 + tx] = gs[uu.pm * 256 + tx] * ss[uu.pn >> 2];
            __syncthreads(); }
          pg8::EpiDown E{(pg8::bf16_t*)(ws + WS_XG), (const PG8_LAS float*)(glds + 131072)};
          pg8::gemm_phase<pg8::EpiDown, pg8::GroupOrder, true, true, true>(glds, g, S, E); AMP_END(9) }
        XBAR();
        { AMP_BEGIN(10) phase_combine(a, vcu, G, l, upd, !upd, upd); AMP_END(10) }
        if (upd) XBAR();
    }
}

extern "C" void kernel_launch(void* const* d_in, const int* in_sizes, int n_in, void* d_out, int out_size, void* d_ws, size_t ws_size, hipStream_t stream) {
    static int grid = 0;
    if (grid == 0) {
        int dev = 0, cus = 0, per_cu = 0;
        hipGetDevice(&dev); hipDeviceGetAttribute(&cus, hipDeviceAttributeMultiprocessorCount, dev);
        if (hipFuncSetAttribute((const void*)fwd_kernel, hipFuncAttributeMaxDynamicSharedMemorySize, LDS_BYTES) != hipSuccess) { fprintf(stderr, "kernel_launch: hipFuncSetAttribute failed\n"); grid = -1; return; }
        if (hipOccupancyMaxActiveBlocksPerMultiprocessor(&per_cu, (const void*)fwd_kernel, NTHR, LDS_BYTES) != hipSuccess || per_cu < 1) { fprintf(stderr, "kernel_launch: occupancy query failed (%d)\n", per_cu); grid = -1; return; }
        grid = cus * 1;
        if (n_in != N_IN || ws_size < WS_END) { fprintf(stderr, "kernel_launch: unexpected n_in %d / ws %zu\n", n_in, ws_size); grid = -1; return; }
    }
    if (grid < 0) return;
    if (hipMemsetAsync((char*)d_ws + WS_CTL, 0, 65536, stream) != hipSuccess) { fprintf(stderr, "kernel_launch: memset failed\n"); return; }
    Args a{};
    for (int i = 0; i < N_IN; ++i) a.in[i] = (const float*)d_in[i];
    a.out = (float*)d_out; a.ws = (unsigned char*)d_ws;
    void* args[] = {&a};
    hipError_t e = hipLaunchCooperativeKernel((const void*)fwd_kernel, dim3(grid), dim3(NTHR), args, LDS_BYTES, stream);
    if (e != hipSuccess) fprintf(stderr, "cooperative launch failed: %s (grid %d)\n", hipGetErrorString(e), grid);
}
```

```cpp
#define AMP_PHASE -1
#include <hip/hip_runtime.h>
#include <hip/hip_cooperative_groups.h>
#include <cstdio>
#include <cstdint>
#ifndef AMP_PHASE
#define AMP_PHASE -1
#endif
namespace cg = cooperative_groups;
namespace pg8 {
#define PG8_LAS __attribute__((address_space(3)))
typedef unsigned short bf16_t;
typedef short bf16x8 __attribute__((ext_vector_type(8)));
typedef float f32x4 __attribute__((ext_vector_type(4)));
typedef unsigned u32x4 __attribute__((ext_vector_type(4)));
typedef int v4i_t __attribute__((ext_vector_type(4)));
typedef int v8i_t __attribute__((ext_vector_type(8)));
constexpr int BM = 256, BK = 64, HALF = 128, HTB = HALF * BK * 2  , STAGE_BYTES = 8 * HTB, NXCD = 8, WGM = 8;

__host__ __device__ __forceinline__ int lds_byte(int r, int c) { const int st = (r >> 4) * 2 + (c >> 5), rr = r & 15, cc = c & 31, ob = rr * 64 + cc * 2; return st * 1024 + (ob ^ (((ob >> 9) & 1) << 5)); }
__host__ __device__ __forceinline__ void stage_rc(int b, int& R, int& C) { const int st = b / 1024, sb = b % 1024, swz = sb ^ (((sb >> 9) & 1) << 5); R = (st >> 1) * 16 + swz / 64; C = (st & 1) * 32 + (swz % 64) / 2; }
__host__ __device__ __forceinline__ int perm32(int rho) { const int n = rho >> 4, i = rho & 15; return 8 * (i >> 2) + 4 * n + (i & 3); }

struct Unit { int pm, pn; };
struct Gemm { const bf16_t* A; const bf16_t* Bt; int M, N, K; };

struct StaticOrder {
    int nM, nN, nwg, G, c;
    __host__ __device__ void init(int M, int N, int G_, int c_) { nM = M / BM; nN = N / BM; nwg = nM * nN; G = G_; c = c_; }
    __host__ __device__ bool next(int i, Unit& u) const {
        const long L = (long)i * G + c; if (L >= nwg) return false;
        int wgid = (int)L; { const int q = nwg / NXCD, r = nwg % NXCD, xcd = wgid % NXCD, off = wgid / NXCD; wgid = (xcd < r ? xcd * (q + 1) : r * (q + 1) + (xcd - r) * q) + off; }
        const int nig = WGM * nN, gid = wgid / nig, fm = gid * WGM, gsz = (nM - fm) < WGM ? (nM - fm) : WGM;
        u.pm = fm + ((wgid % nig) % gsz); u.pn = (wgid % nig) / gsz; return true;
    }
    __device__ __forceinline__ void a_ready(const Unit&) const {}
    __device__ __forceinline__ void done(const Unit&) const {}
};

__device__ __forceinline__ unsigned cvt_pk_bf16(float lo, float hi) { unsigned r; asm volatile("v_cvt_pk_bf16_f32 %0, %1, %2" : "=v"(r) : "v"(lo), "v"(hi)); return r; }
typedef float f32x2 __attribute__((ext_vector_type(2)));
__device__ __forceinline__ f32x2 gelu_pk(f32x2 v) {
    const f32x2 av = __builtin_elementwise_abs(v), d = av * 0.2316418882f + 1.0f;
    f32x2 t; t.x = __builtin_amdgcn_rcpf(d.x); t.y = __builtin_amdgcn_rcpf(d.y);
    f32x2 q = t * 0.5307027145f + (-0.7265760135f); q = q * t + 0.7107068705f; q = q * t + (-0.142248368f); q = q * t + 0.127414796f; q = q * t;
    const f32x2 s = (v * v) * (-0.72134752044f);
    f32x2 e; e.x = __builtin_amdgcn_exp2f(s.x); e.y = __builtin_amdgcn_exp2f(s.y);
    const f32x2 m = v * (q * e), r = v - m;
    f32x2 o; o.x = v.x < 0.f ? m.x : r.x; o.y = v.y < 0.f ? m.y : r.y; return o;
}


struct GroupOrder {
    int nMl, nNl, strideM, nper, nwg, G, c;
    __device__ __forceinline__ void init(int ng, int nMl_, int nNl_, int strideM_, int G_, int c_) { nMl = nMl_; nNl = nNl_; strideM = strideM_; nper = nMl_ * nNl_; nwg = ng * nper; G = G_; c = c_; }
    __device__ __forceinline__ bool next(int i, Unit& u) const {
        const long L = (long)i * G + c; if (L >= nwg) return false;
        int wgid = (int)L; { const int q = nwg / NXCD, r = nwg % NXCD, xcd = wgid % NXCD, off = wgid / NXCD; wgid = (xcd < r ? xcd * (q + 1) : r * (q + 1) + (xcd - r) * q) + off; }
        const int e = wgid / nper, id = wgid % nper;
        const int nig = WGM * nNl, gid = id / nig, fm = gid * WGM, gsz = (nMl - fm) < WGM ? (nMl - fm) : WGM;
        u.pm = e * strideM + fm + ((id % nig) % gsz); u.pn = e * nNl + (id % nig) / gsz; return true;
    }
    __device__ __forceinline__ void a_ready(const Unit&) const {}
    __device__ __forceinline__ void done(const Unit&) const {}
};

constexpr int TXR = 32768;
struct EpiIn {
    static constexpr bool PERM = true, AFTER_DRAIN = false;
    bf16_t* PX; const PG8_LAS float* rope; bf16_t* UT; PG8_LAS unsigned char* stgbase; float wsc;
    __device__ __forceinline__ void operator()(const f32x4 (&acc)[2][2][4][2], const Unit& u, int ui, int wr, int wc, int fr, int fq) const {
        const int row0 = u.pm * BM + wr * 64 + fr; const int col0 = u.pn * BM + wc * 32 + 8 * fq;
        const bool latent = u.pm < (TXR / BM);
        if (latent && u.pn < 3) {
            PG8_LAS unsigned char* stg = stgbase + (wr * 4 + wc) * 2304; const int lane = fq * 16 + fr;
            const int b = u.pm >> 4, trow0 = (u.pm & 15) * BM; const int col = lane >> 1, half = lane & 1;
#pragma unroll
            for (int ai = 0; ai < 2; ++ai)
#pragma unroll
                for (int bj = 0; bj < 2; ++bj)
#pragma unroll
                    for (int mh = 0; mh < 2; ++mh) {
#pragma unroll
                        for (int mm = 0; mm < 2; ++mm)
#pragma unroll
                            for (int n = 0; n < 2; ++n) { const f32x4 v = acc[ai][bj][2 * mh + mm][n] * wsc; const unsigned w0 = cvt_pk_bf16(v[0], v[1]), w1 = cvt_pk_bf16(v[2], v[3]);
                                PG8_LAS unsigned char* p = stg + (8 * fq + 4 * n) * 72 + (16 * mm + fr) * 2;
                                *(PG8_LAS unsigned short*)(p) = (unsigned short)w0; *(PG8_LAS unsigned short*)(p + 72) = (unsigned short)(w0 >> 16);
                                *(PG8_LAS unsigned short*)(p + 144) = (unsigned short)w1; *(PG8_LAS unsigned short*)(p + 216) = (unsigned short)(w1 >> 16); }
                        asm volatile("s_waitcnt lgkmcnt(0)" ::: "memory");
                        typedef unsigned u32x2v __attribute__((ext_vector_type(2)));
                        const PG8_LAS unsigned char* rp = stg + col * 72 + half * 32;
                        const u32x2v a0 = *(const PG8_LAS u32x2v*)(rp), a1 = *(const PG8_LAS u32x2v*)(rp + 8), a2 = *(const PG8_LAS u32x2v*)(rp + 16), a3 = *(const PG8_LAS u32x2v*)(rp + 24);
                        const int ch = u.pn * BM + bj * HALF + wc * 32 + col; const int t0 = trow0 + ai * HALF + wr * 64 + mh * 32 + half * 16;
                        u32x4* gp = (u32x4*)(UT + ((size_t)(b * 768 + ch)) * 4096 + t0);
                        gp[0] = (u32x4){a0.x, a0.y, a1.x, a1.y}; gp[1] = (u32x4){a2.x, a2.y, a3.x, a3.y};
                        asm volatile("s_waitcnt lgkmcnt(0)" ::: "memory"); }
            return;
        }
#pragma unroll
        for (int ai = 0; ai < 2; ++ai)
#pragma unroll
            for (int m = 0; m < 4; ++m) { const int row = row0 + ai * HALF + m * 16; bf16_t* rowp = PX + (size_t)row * 2304 + col0;
#pragma unroll
                for (int bj = 0; bj < 2; ++bj) { f32x4 v0 = acc[ai][bj][m][0] * wsc, v1 = acc[ai][bj][m][1] * wsc;
                    const bool dorope = latent && (u.pn == 4 || (u.pn == 6 && bj == 0));
                    if (dorope) {
                        const int t = row & 4095; const int pos = (wc & 1) ? (t & 63) : (t >> 6);
                        const PG8_LAS f32x4* rp = (const PG8_LAS f32x4*)(rope + (pos * 16 + 8 * (fq & 1)) * 2);
                        const f32x4 r0 = rp[0], r1 = rp[1], r2 = rp[2], r3 = rp[3];
                        f32x4 p0, p1;
#pragma unroll
                        for (int j = 0; j < 4; ++j) { auto r0_ = __builtin_amdgcn_permlane32_swap(__float_as_uint(v0[j]), __float_as_uint(v0[j]), false, false); auto r1_ = __builtin_amdgcn_permlane32_swap(__float_as_uint(v1[j]), __float_as_uint(v1[j]), false, false);
                            p0[j] = __uint_as_float(fq < 2 ? r0_[1] : r0_[0]); p1[j] = __uint_as_float(fq < 2 ? r1_[1] : r1_[0]); }
                        const float c0[4] = {r0[0], r0[2], r1[0], r1[2]}, s0[4] = {r0[1], r0[3], r1[1], r1[3]};
                        const float c1[4] = {r2[0], r2[2], r3[0], r3[2]}, s1[4] = {r2[1], r2[3], r3[1], r3[3]};
                        const bool lo = fq < 2;
#pragma unroll
                        for (int j = 0; j < 4; ++j) {
                            v0[j] = lo ? (v0[j] * c0[j] - p0[j] * s0[j]) : (p0[j] * s0[j] + v0[j] * c0[j]);
                            v1[j] = lo ? (v1[j] * c1[j] - p1[j] * s1[j]) : (p1[j] * s1[j] + v1[j] * c1[j]); }
                    }
                    u32x4 w; w.x = cvt_pk_bf16(v0[0], v0[1]); w.y = cvt_pk_bf16(v0[2], v0[3]); w.z = cvt_pk_bf16(v1[0], v1[1]); w.w = cvt_pk_bf16(v1[2], v1[3]);
                    *(u32x4*)(rowp + bj * HALF) = w; } }
    }
};
struct EpiOut {
    static constexpr bool PERM = true, AFTER_DRAIN = false;
    const float* xf_x; const float* xf_c; bf16_t* XB; const float* mod; int from_f32;
    __device__ __forceinline__ void operator()(const f32x4 (&acc)[2][2][4][2], const Unit& u, int ui, int wr, int wc, int fr, int fq) const {
        const int row0 = u.pm * BM + wr * 64 + fr, col0 = u.pn * BM + wc * 32 + 8 * fq;
        const bool latent = u.pm < (TXR / BM);
#pragma unroll
        for (int ai = 0; ai < 2; ++ai)
#pragma unroll
            for (int m = 0; m < 4; ++m) { const int row = row0 + ai * HALF + m * 16;
                const int mrow = latent ? (row >> 12) : 8; const float* gp = mod + mrow * 6144 + 2 * 1024 + col0;
                bf16_t* xb = XB + (size_t)row * 1024 + col0;
#pragma unroll
                for (int bj = 0; bj < 2; ++bj) { const f32x4 g0 = *(const f32x4*)(gp + bj * HALF), g1 = *(const f32x4*)(gp + bj * HALF + 4); f32x4 x0, x1;
                    if (from_f32) { const float* xo = (latent ? xf_x + (size_t)row * 1024 : xf_c + (size_t)(row - TXR) * 1024) + col0 + bj * HALF; x0 = *(const f32x4*)xo; x1 = *(const f32x4*)(xo + 4); }
                    else { const u32x4 w = *(const u32x4*)(xb + bj * HALF); x0 = (f32x4){__uint_as_float(w.x << 16), __uint_as_float(w.x & 0xffff0000u), __uint_as_float(w.y << 16), __uint_as_float(w.y & 0xffff0000u)};
                        x1 = (f32x4){__uint_as_float(w.z << 16), __uint_as_float(w.z & 0xffff0000u), __uint_as_float(w.w << 16), __uint_as_float(w.w & 0xffff0000u)}; }
                    const f32x4 v0 = x0 + g0 * acc[ai][bj][m][0], v1 = x1 + g1 * acc[ai][bj][m][1];
                    u32x4 o; o.x = cvt_pk_bf16(v0[0], v0[1]); o.y = cvt_pk_bf16(v0[2], v0[3]); o.z = cvt_pk_bf16(v1[0], v1[1]); o.w = cvt_pk_bf16(v1[2], v1[3]);
                    *(u32x4*)(xb + bj * HALF) = o; } }
    }
};
struct EpiGU {
    static constexpr bool PERM = true, AFTER_DRAIN = false;
    unsigned char* ACT; const PG8_LAS float* wsc;
    __device__ __forceinline__ void operator()(const f32x4 (&acc)[2][2][4][2], const Unit& u, int ui, int wr, int wc, int fr, int fq) const {
        const int row0 = u.pm * BM + wr * 64 + fr; const int col0 = (u.pn & 15) * 128 + wc * 32 + 8 * fq; const int e = u.pn >> 4; const float sg = wsc[e], su = wsc[16 + e]; const float nsl = -1.4426950408889634f * sg, sgu = sg * su;
#pragma unroll
        for (int ai = 0; ai < 2; ++ai)
#pragma unroll
            for (int m = 0; m < 4; ++m) { unsigned char* rowp = ACT + (size_t)(row0 + ai * HALF + m * 16) * 2048 + col0;
                float h[8];
#pragma unroll
                for (int n = 0; n < 2; ++n)
#pragma unroll
                    for (int j = 0; j < 4; ++j) { const float ag = acc[ai][0][m][n][j], au = acc[ai][1][m][n][j]; const float r = __builtin_amdgcn_rcpf(1.0f + __builtin_amdgcn_exp2f(ag * nsl)); h[4 * n + j] = __builtin_amdgcn_fmed3f((ag * au) * sgu * r, -448.0f, 448.0f); }
                int p0 = 0, p1 = 0;
                p0 = __builtin_amdgcn_cvt_pk_fp8_f32(h[0], h[1], p0, false); p0 = __builtin_amdgcn_cvt_pk_fp8_f32(h[2], h[3], p0, true);
                p1 = __builtin_amdgcn_cvt_pk_fp8_f32(h[4], h[5], p1, false); p1 = __builtin_amdgcn_cvt_pk_fp8_f32(h[6], h[7], p1, true);
                typedef int i32x2v __attribute__((ext_vector_type(2)));
                *(i32x2v*)rowp = (i32x2v){p0, p1}; }
    }
};
struct EpiDown {
    static constexpr bool PERM = true, AFTER_DRAIN = false;
    bf16_t* OB; const PG8_LAS float* gl;
    __device__ __forceinline__ void operator()(const f32x4 (&acc)[2][2][4][2], const Unit& u, int ui, int wr, int wc, int fr, int fq) const {
        const int row0 = u.pm * BM + wr * 64 + fr; const int col0 = (u.pn & 3) * BM + wc * 32 + 8 * fq;
#pragma unroll
        for (int ai = 0; ai < 2; ++ai)
#pragma unroll
            for (int m = 0; m < 4; ++m) { const int row = row0 + ai * HALF + m * 16; const float g = gl[ui * BM + ai * HALF + wr * 64 + m * 16 + fr]; bf16_t* rowp = OB + (size_t)row * 1024 + col0;
#pragma unroll
                for (int bj = 0; bj < 2; ++bj) { const f32x4 v0 = acc[ai][bj][m][0] * g, v1 = acc[ai][bj][m][1] * g;
                    u32x4 w; w.x = cvt_pk_bf16(v0[0], v0[1]); w.y = cvt_pk_bf16(v0[2], v0[3]); w.z = cvt_pk_bf16(v1[0], v1[1]); w.w = cvt_pk_bf16(v1[2], v1[3]);
                    *(u32x4*)(rowp + bj * HALF) = w; } }
    }
};

template <class Epi, class Sched, bool ALIGN_EPI = false, bool SP2 = false, bool FP8 = false>
__device__ __forceinline__ void gemm_phase(PG8_LAS unsigned char* lds, const Gemm g, const Sched& S, const Epi& E) {
    int tid_ = threadIdx.x; asm volatile("" : "+v"(tid_));
    const int tid = tid_, wid = __builtin_amdgcn_readfirstlane(tid >> 6), lane = tid & 63, wr = wid >> 2, wc = wid & 3, fr = lane & 15, fq = lane >> 4;
    const int K = g.K, KB = FP8 ? K : 2 * K  , nt = KB / (BK * 2);
    unsigned voffA[2], voffB[2];
#pragma unroll
    for (int i = 0; i < 2; ++i) { int R, C; stage_rc(tid * 16 + i * 8192, R, C); const int Rb = Epi::PERM ? ((R & ~31) + perm32(R & 31)) : R;
        voffA[i] = (unsigned)(R * KB + C * 2); voffB[i] = (unsigned)(Rb * KB + C * 2); }
    const size_t kstep = (size_t)(BK * 2);
    const size_t hstep = (size_t)HALF * KB;
    const size_t tstep = 2 * hstep;
    const unsigned ldsw = (unsigned)wid * 1024u;
    const int aoff = lds_byte(wr * 64 + fr, fq * 8), boff = lds_byte(wc * 32 + fr, fq * 8);
#define PG8_SA(b, h) (((b) * 2 + (h)) * HTB)
#define PG8_SB(b, h) ((4 + (b) * 2 + (h)) * HTB)
#define PG8_STAGE(bufoff, gbase, voff) do { _Pragma("unroll") for (int _i = 0; _i < 2; ++_i) \
        __builtin_amdgcn_global_load_lds((const unsigned*)((const char*)(gbase) + (voff)[_i]), (PG8_LAS unsigned*)(lds + (bufoff) + ldsw + _i * 8192), 16, 0, 0); } while (0)
#define PG8_LDA(dst, b, h) do { _Pragma("unroll") for (int m = 0; m < 4; ++m) { if constexpr (FP8) { dst##8[m].lo = *(const PG8_LAS v4i_t*)(lds + PG8_SA(b, h) + aoff + m * 2048); dst##8[m].hi = *(const PG8_LAS v4i_t*)(lds + PG8_SA(b, h) + aoff + m * 2048 + 1024); } \
        else { _Pragma("unroll") for (int k = 0; k < 2; ++k) dst[m][k] = *(const PG8_LAS bf16x8*)(lds + PG8_SA(b, h) + aoff + m * 2048 + k * 1024); } } } while (0)
#define PG8_LDB(dst, b, h) do { _Pragma("unroll") for (int n = 0; n < 2; ++n) { if constexpr (FP8) { dst##8[n].lo = *(const PG8_LAS v4i_t*)(lds + PG8_SB(b, h) + boff + n * 2048); dst##8[n].hi = *(const PG8_LAS v4i_t*)(lds + PG8_SB(b, h) + boff + n * 2048 + 1024); } \
        else { _Pragma("unroll") for (int k = 0; k < 2; ++k) dst[n][k] = *(const PG8_LAS bf16x8*)(lds + PG8_SB(b, h) + boff + n * 2048 + k * 1024); } } } while (0)
#define PG8_CAT8(x0, x1) __builtin_shufflevector(__builtin_bit_cast(v4i_t, x0), __builtin_bit_cast(v4i_t, x1), 0, 1, 2, 3, 4, 5, 6, 7)
#define PG8_MMA(ai, bj, At, Bt) do { __builtin_amdgcn_s_setprio(1); if constexpr (FP8) asm volatile("s_nop 1" ::: "memory"); _Pragma("unroll") for (int m = 0; m < 4; ++m) _Pragma("unroll") for (int n = 0; n < 2; ++n) { \
        if constexpr (FP8) { asm volatile("v_mfma_scale_f32_16x16x128_f8f6f4 %0, %1, %2, %0, %3, %3 op_sel_hi:[0,0,0]" : "+v"(acc[ai][bj][m][n]) : "v"(Bt##8[n]), "v"(At##8[m]), "v"(one_scale)); } \
        else { _Pragma("unroll") for (int k = 0; k < 2; ++k) acc[ai][bj][m][n] = __builtin_amdgcn_mfma_f32_16x16x32_bf16(Bt[n][k], At[m][k], acc[ai][bj][m][n], 0, 0, 0); } } if constexpr (FP8) asm volatile("s_nop 15\n\ts_nop 3" ::: "memory"); __builtin_amdgcn_s_setprio(0); } while (0)
#define PG8_WAIT_V(n) asm volatile("s_waitcnt vmcnt(" #n ")" ::: "memory")
#define PG8_WAIT_L(n) asm volatile("s_waitcnt lgkmcnt(" #n ")" ::: "memory")
#define PG8_BAR __builtin_amdgcn_s_barrier()
#define PG8_SCHED __builtin_amdgcn_sched_barrier(0)
    Unit cur, nxt; int ui = 0;
    if (!S.next(0, cur)) return;
    f32x4 acc[2][2][4][2];
#pragma unroll
    for (int a = 0; a < 2; ++a)
#pragma unroll
        for (int b = 0; b < 2; ++b)
#pragma unroll
            for (int m = 0; m < 4; ++m)
#pragma unroll
                for (int n = 0; n < 2; ++n) acc[a][b][m][n] = (f32x4){0.f, 0.f, 0.f, 0.f};
    bf16x8 At[4][2], B0[2][2], B1[2][2];
    v8i_t At8[4], B08[2], B18[2];
    int one_scale = 0x7f7f7f7f; asm volatile("" : "+v"(one_scale));
    const char* cA = (const char*)g.A + (size_t)cur.pm * tstep; const char* cB = (const char*)g.Bt + (size_t)cur.pn * tstep;
    S.a_ready(cur);
    if constexpr (SP2) {
        PG8_STAGE(PG8_SB(0, 0), cB, voffB); PG8_STAGE(PG8_SB(0, 1), cB + hstep, voffB); PG8_STAGE(PG8_SA(0, 0), cA, voffA); PG8_STAGE(PG8_SA(0, 1), cA + hstep, voffA);
        if (wr == 1) PG8_BAR;
        PG8_WAIT_V(2); PG8_BAR;
        PG8_STAGE(PG8_SB(1, 0), cB + kstep, voffB); PG8_STAGE(PG8_SA(1, 0), cA + kstep, voffA); PG8_STAGE(PG8_SB(1, 1), cB + hstep + kstep, voffB);
        PG8_WAIT_V(6); PG8_BAR;
    } else {
        PG8_STAGE(PG8_SB(0, 0), cB, voffB); PG8_STAGE(PG8_SA(0, 0), cA, voffA); PG8_STAGE(PG8_SB(0, 1), cB + hstep, voffB); PG8_STAGE(PG8_SA(0, 1), cA + hstep, voffA);
        if (wr == 1) PG8_BAR;
        PG8_WAIT_V(4); PG8_BAR;
        PG8_STAGE(PG8_SB(1, 0), cB + kstep, voffB); PG8_STAGE(PG8_SA(1, 0), cA + kstep, voffA); PG8_STAGE(PG8_SB(1, 1), cB + hstep + kstep, voffB);
        PG8_WAIT_V(6); PG8_BAR;
    }
    for (;;) {
        const bool has_next = S.next(ui + 1, nxt);
        const char* nA = has_next ? (const char*)g.A + (size_t)nxt.pm * tstep : cA; const char* nB = has_next ? (const char*)g.Bt + (size_t)nxt.pn * tstep : cB;
#pragma nounroll
        for (int t = 0; t < nt; t += 2) {
            const bool last = (t == nt - 2);
            const char* a1 = cA + (size_t)(t + 1) * kstep;
            const char* a2 = last ? nA : cA + (size_t)(t + 2) * kstep; const char* b2 = last ? nB : cB + (size_t)(t + 2) * kstep;
            const char* a3 = a2 + kstep; const char* b3 = b2 + kstep;
            if (last && has_next) S.a_ready(nxt);
            if constexpr (SP2) {
            PG8_LDB(B0, 0, 0); PG8_LDB(B1, 0, 1); PG8_SCHED; PG8_LDA(At, 0, 0); PG8_STAGE(PG8_SA(1, 1), a1 + hstep, voffA);
            PG8_WAIT_V(8); PG8_WAIT_L(0); PG8_BAR; PG8_MMA(0, 0, At, B0); PG8_MMA(0, 1, At, B1); PG8_BAR; PG8_SCHED;
            PG8_LDA(At, 0, 1); PG8_STAGE(PG8_SB(0, 0), b2, voffB); PG8_STAGE(PG8_SB(0, 1), b2 + hstep, voffB); PG8_STAGE(PG8_SA(0, 0), a2, voffA);
            PG8_WAIT_V(8); PG8_WAIT_L(0); PG8_BAR; PG8_MMA(1, 0, At, B0); PG8_MMA(1, 1, At, B1); PG8_BAR; PG8_SCHED;
            PG8_LDB(B0, 1, 0); PG8_LDB(B1, 1, 1); PG8_SCHED; PG8_LDA(At, 1, 0); PG8_STAGE(PG8_SA(0, 1), a2 + hstep, voffA);
            PG8_WAIT_V(8); PG8_WAIT_L(0); PG8_BAR; PG8_MMA(0, 0, At, B0); PG8_MMA(0, 1, At, B1); PG8_BAR; PG8_SCHED;
            PG8_LDA(At, 1, 1); PG8_STAGE(PG8_SB(1, 0), b3, voffB); PG8_STAGE(PG8_SB(1, 1), b3 + hstep, voffB); PG8_STAGE(PG8_SA(1, 0), a3, voffA);
            PG8_WAIT_V(8); PG8_WAIT_L(0); PG8_BAR; PG8_MMA(1, 0, At, B0); PG8_MMA(1, 1, At, B1); PG8_BAR; PG8_SCHED;
            } else {
            PG8_LDB(B0, 0, 0); PG8_SCHED; PG8_LDA(At, 0, 0); PG8_STAGE(PG8_SA(1, 1), a1 + hstep, voffA);
            PG8_WAIT_L(8); PG8_BAR; PG8_WAIT_L(0); PG8_MMA(0, 0, At, B0); PG8_BAR; PG8_SCHED;
            PG8_LDB(B1, 0, 1); PG8_STAGE(PG8_SB(0, 0), b2, voffB);
            PG8_BAR; PG8_WAIT_L(0); PG8_MMA(0, 1, At, B1); PG8_BAR;
            PG8_LDA(At, 0, 1); PG8_STAGE(PG8_SA(0, 0), a2, voffA);
            PG8_BAR; PG8_WAIT_L(0); PG8_MMA(1, 0, At, B0); PG8_BAR; PG8_SCHED;
            PG8_STAGE(PG8_SB(0, 1), b2 + hstep, voffB);
            PG8_WAIT_V(6); PG8_BAR; PG8_MMA(1, 1, At, B1); PG8_BAR;
            PG8_LDB(B0, 1, 0); PG8_SCHED; PG8_LDA(At, 1, 0); PG8_STAGE(PG8_SA(0, 1), a2 + hstep, voffA);
            PG8_WAIT_L(8); PG8_BAR; PG8_WAIT_L(0); PG8_MMA(0, 0, At, B0); PG8_BAR; PG8_SCHED;
            PG8_LDB(B1, 1, 1); PG8_STAGE(PG8_SB(1, 0), b3, voffB);
            PG8_BAR; PG8_WAIT_L(0); PG8_MMA(0, 1, At, B1); PG8_BAR;
            PG8_LDA(At, 1, 1); PG8_STAGE(PG8_SA(1, 0), a3, voffA);
            PG8_BAR; PG8_WAIT_L(0); PG8_MMA(1, 0, At, B0); PG8_BAR; PG8_SCHED;
            PG8_STAGE(PG8_SB(1, 1), b3 + hstep, voffB);
            PG8_WAIT_V(6); PG8_BAR; PG8_MMA(1, 1, At, B1); PG8_BAR;
            }
        }
        if constexpr (ALIGN_EPI) { if (wr == 0) PG8_BAR; }
        if constexpr (!Epi::AFTER_DRAIN) { E(acc, cur, ui, wr, wc, fr, fq); S.done(cur); }
        if (!has_next) break;
#pragma unroll
        for (int a = 0; a < 2; ++a)
#pragma unroll
            for (int b = 0; b < 2; ++b)
#pragma unroll
                for (int m = 0; m < 4; ++m)
#pragma unroll
                    for (int n = 0; n < 2; ++n) acc[a][b][m][n] = (f32x4){0.f, 0.f, 0.f, 0.f};
        cur = nxt; cA = nA; cB = nB; ++ui;
        if constexpr (ALIGN_EPI) { if (wr == 1) PG8_BAR; }
    }
    PG8_WAIT_V(0);
    if constexpr (!ALIGN_EPI) { if (wr == 0) PG8_BAR; }
    PG8_BAR;
    if constexpr (Epi::AFTER_DRAIN) { E.fused(acc, cur, wr, wc, fr, fq, lds, wid, lane); S.done(cur); }
#undef PG8_SA
#undef PG8_SB
#undef PG8_STAGE
#undef PG8_LDA
#undef PG8_LDB
#undef PG8_MMA
#undef PG8_CAT8
#undef PG8_WAIT_V
#undef PG8_WAIT_L
#undef PG8_BAR
#undef PG8_SCHED
}
template <class Epi, class Sched, bool FP8 = false>
__device__ __forceinline__ void gemm_phase_gather(PG8_LAS unsigned char* lds, const Gemm g, const int* rowmap, PG8_LAS int* idxs, const Sched& S, const Epi& E) {
    constexpr bool ALIGN_EPI = true, SP2 = true;
    int tid_ = threadIdx.x; asm volatile("" : "+v"(tid_));
    const int tid = tid_, wid = __builtin_amdgcn_readfirstlane(tid >> 6), lane = tid & 63, wr = wid >> 2, wc = wid & 3, fr = lane & 15, fq = lane >> 4;
    const int K = g.K, KB = FP8 ? K : 2 * K  , nt = KB / (BK * 2);
    unsigned voffB[2]; int RA[2], CA[2];
#pragma unroll
    for (int i = 0; i < 2; ++i) { int R, C; stage_rc(tid * 16 + i * 8192, R, C); const int Rb = Epi::PERM ? ((R & ~31) + perm32(R & 31)) : R;
        RA[i] = R; CA[i] = C * 2; voffB[i] = (unsigned)(Rb * KB + C * 2); }
    const size_t kstep = (size_t)(BK * 2);
    const size_t hstep = (size_t)HALF * KB;
    const size_t tstep = 2 * hstep;
    const unsigned ldsw = (unsigned)wid * 1024u;
    const int aoff = lds_byte(wr * 64 + fr, fq * 8), boff = lds_byte(wc * 32 + fr, fq * 8);
#define PG8_SA(b, h) (((b) * 2 + (h)) * HTB)
#define PG8_SB(b, h) ((4 + (b) * 2 + (h)) * HTB)
#define PG8_STAGE(bufoff, gbase, voff) do { _Pragma("unroll") for (int _i = 0; _i < 2; ++_i) \
        __builtin_amdgcn_global_load_lds((const unsigned*)((const char*)(gbase) + (voff)[_i]), (PG8_LAS unsigned*)(lds + (bufoff) + ldsw + _i * 8192), 16, 0, 0); } while (0)
#define PG8_STAGE_AG(bufoff, P, h, koff) do { _Pragma("unroll") for (int _i = 0; _i < 2; ++_i) \
        __builtin_amdgcn_global_load_lds((const unsigned*)((const char*)g.A + (size_t)((P)[h][_i] + (unsigned)(koff))), (PG8_LAS unsigned*)(lds + (bufoff) + ldsw + _i * 8192), 16, 0, 0); } while (0)
#define PG8_ROWPTR(P, u) do { _Pragma("unroll") for (int _h = 0; _h < 2; ++_h) _Pragma("unroll") for (int _i = 0; _i < 2; ++_i) \
        (P)[_h][_i] = (unsigned)idxs[(u) * BM + _h * HALF + RA[_i]] * (unsigned)KB + (unsigned)CA[_i]; } while (0)
#define PG8_LDA(dst, b, h) do { _Pragma("unroll") for (int m = 0; m < 4; ++m) { if constexpr (FP8) { dst##8[m].lo = *(const PG8_LAS v4i_t*)(lds + PG8_SA(b, h) + aoff + m * 2048); dst##8[m].hi = *(const PG8_LAS v4i_t*)(lds + PG8_SA(b, h) + aoff + m * 2048 + 1024); } \
        else { _Pragma("unroll") for (int k = 0; k < 2; ++k) dst[m][k] = *(const PG8_LAS bf16x8*)(lds + PG8_SA(b, h) + aoff + m * 2048 + k * 1024); } } } while (0)
#define PG8_LDB(dst, b, h) do { _Pragma("unroll") for (int n = 0; n < 2; ++n) { if constexpr (FP8) { dst##8[n].lo = *(const PG8_LAS v4i_t*)(lds + PG8_SB(b, h) + boff + n * 2048); dst##8[n].hi = *(const PG8_LAS v4i_t*)(lds + PG8_SB(b, h) + boff + n * 2048 + 1024); } \
        else { _Pragma("unroll") for (int k = 0; k < 2; ++k) dst[n][k] = *(const PG8_LAS bf16x8*)(lds + PG8_SB(b, h) + boff + n * 2048 + k * 1024); } } } while (0)
#define PG8_CAT8(x0, x1) __builtin_shufflevector(__builtin_bit_cast(v4i_t, x0), __builtin_bit_cast(v4i_t, x1), 0, 1, 2, 3, 4, 5, 6, 7)
#define PG8_MMA(ai, bj, At, Bt) do { __builtin_amdgcn_s_setprio(1); if constexpr (FP8) asm volatile("s_nop 1" ::: "memory"); _Pragma("unroll") for (int m = 0; m < 4; ++m) _Pragma("unroll") for (int n = 0; n < 2; ++n) { \
        if constexpr (FP8) { asm volatile("v_mfma_scale_f32_16x16x128_f8f6f4 %0, %1, %2, %0, %3, %3 op_sel_hi:[0,0,0]" : "+v"(acc[ai][bj][m][n]) : "v"(Bt##8[n]), "v"(At##8[m]), "v"(one_scale)); } \
        else { _Pragma("unroll") for (int k = 0; k < 2; ++k) acc[ai][bj][m][n] = __builtin_amdgcn_mfma_f32_16x16x32_bf16(Bt[n][k], At[m][k], acc[ai][bj][m][n], 0, 0, 0); } } if constexpr (FP8) asm volatile("s_nop 15\n\ts_nop 3" ::: "memory"); __builtin_amdgcn_s_setprio(0); } while (0)
#define PG8_WAIT_V(n) asm volatile("s_waitcnt vmcnt(" #n ")" ::: "memory")
#define PG8_WAIT_L(n) asm volatile("s_waitcnt lgkmcnt(" #n ")" ::: "memory")
#define PG8_BAR __builtin_amdgcn_s_barrier()
#define PG8_SCHED __builtin_amdgcn_sched_barrier(0)
    Unit cur, nxt; int ui = 0;
    if (!S.next(0, cur)) return;
    f32x4 acc[2][2][4][2];
#pragma unroll
    for (int a = 0; a < 2; ++a)
#pragma unroll
        for (int b = 0; b < 2; ++b)
#pragma unroll
            for (int m = 0; m < 4; ++m)
#pragma unroll
                for (int n = 0; n < 2; ++n) acc[a][b][m][n] = (f32x4){0.f, 0.f, 0.f, 0.f};
    bf16x8 At[4][2], B0[2][2], B1[2][2];
    v8i_t At8[4], B08[2], B18[2];
    int one_scale = 0x7f7f7f7f; asm volatile("" : "+v"(one_scale));
    const char* cB = (const char*)g.Bt + (size_t)cur.pn * tstep;
    unsigned cP[2][2], nP[2][2];
    { Unit uu; for (int i = 0; S.next(i, uu); ++i) if (tid < BM) idxs[i * BM + tid] = rowmap[uu.pm * BM + tid]; }
    asm volatile("s_waitcnt vmcnt(0) lgkmcnt(0)" ::: "memory"); __builtin_amdgcn_s_barrier(); asm volatile("" ::: "memory");
    PG8_ROWPTR(cP, 0);
    S.a_ready(cur);
    if constexpr (SP2) {
        PG8_STAGE(PG8_SB(0, 0), cB, voffB); PG8_STAGE(PG8_SB(0, 1), cB + hstep, voffB); PG8_STAGE_AG(PG8_SA(0, 0), cP, 0, 0); PG8_STAGE_AG(PG8_SA(0, 1), cP, 1, 0);
        if (wr == 1) PG8_BAR;
        PG8_WAIT_V(2); PG8_BAR;
        PG8_STAGE(PG8_SB(1, 0), cB + kstep, voffB); PG8_STAGE_AG(PG8_SA(1, 0), cP, 0, kstep); PG8_STAGE(PG8_SB(1, 1), cB + hstep + kstep, voffB);
        PG8_WAIT_V(6); PG8_BAR;
    }
    for (;;) {
        const bool has_next = S.next(ui + 1, nxt);
        const char* nB = has_next ? (const char*)g.Bt + (size_t)nxt.pn * tstep : cB;
        if (has_next) { PG8_ROWPTR(nP, ui + 1); } else { _Pragma("unroll") for (int _h = 0; _h < 2; ++_h) _Pragma("unroll") for (int _i = 0; _i < 2; ++_i) nP[_h][_i] = cP[_h][_i]; }
#pragma nounroll
        for (int t = 0; t < nt; t += 2) {
            const bool last = (t == nt - 2);
            const size_t k1 = (size_t)(t + 1) * kstep, k2 = last ? 0 : (size_t)(t + 2) * kstep, k3 = k2 + kstep;
            unsigned sP[2][2];
            _Pragma("unroll") for (int _h = 0; _h < 2; ++_h) _Pragma("unroll") for (int _i = 0; _i < 2; ++_i) sP[_h][_i] = last ? nP[_h][_i] : cP[_h][_i];
            const char* b2 = last ? nB : cB + (size_t)(t + 2) * kstep; const char* b3 = b2 + kstep;
            if (last && has_next) S.a_ready(nxt);
            if constexpr (SP2) {
            PG8_LDB(B0, 0, 0); PG8_LDB(B1, 0, 1); PG8_SCHED; PG8_LDA(At, 0, 0); PG8_STAGE_AG(PG8_SA(1, 1), cP, 1, k1);
            PG8_WAIT_V(8); PG8_WAIT_L(0); PG8_BAR; PG8_MMA(0, 0, At, B0); PG8_MMA(0, 1, At, B1); PG8_BAR; PG8_SCHED;
            PG8_LDA(At, 0, 1); PG8_STAGE(PG8_SB(0, 0), b2, voffB); PG8_STAGE(PG8_SB(0, 1), b2 + hstep, voffB); PG8_STAGE_AG(PG8_SA(0, 0), sP, 0, k2);
            PG8_WAIT_V(8); PG8_WAIT_L(0); PG8_BAR; PG8_MMA(1, 0, At, B0); PG8_MMA(1, 1, At, B1); PG8_BAR; PG8_SCHED;
            PG8_LDB(B0, 1, 0); PG8_LDB(B1, 1, 1); PG8_SCHED; PG8_LDA(At, 1, 0); PG8_STAGE_AG(PG8_SA(0, 1), sP, 1, k2);
            PG8_WAIT_V(8); PG8_WAIT_L(0); PG8_BAR; PG8_MMA(0, 0, At, B0); PG8_MMA(0, 1, At, B1); PG8_BAR; PG8_SCHED;
            PG8_LDA(At, 1, 1); PG8_STAGE(PG8_SB(1, 0), b3, voffB); PG8_STAGE(PG8_SB(1, 1), b3 + hstep, voffB); PG8_STAGE_AG(PG8_SA(1, 0), sP, 0, k3);
            PG8_WAIT_V(8); PG8_WAIT_L(0); PG8_BAR; PG8_MMA(1, 0, At, B0); PG8_MMA(1, 1, At, B1); PG8_BAR; PG8_SCHED;
            }
        }
        if constexpr (ALIGN_EPI) { if (wr == 0) PG8_BAR; }
        if constexpr (!Epi::AFTER_DRAIN) { E(acc, cur, ui, wr, wc, fr, fq); if (AMP_PHASE == 81) { asm volatile("" ::: "memory"); E(acc, cur, ui, wr, wc, fr, fq); } S.done(cur); }
        if (!has_next) break;
#pragma unroll
        for (int a = 0; a < 2; ++a)
#pragma unroll
            for (int b = 0; b < 2; ++b)
#pragma unroll
                for (int m = 0; m < 4; ++m)
#pragma unroll
                    for (int n = 0; n < 2; ++n) acc[a][b][m][n] = (f32x4){0.f, 0.f, 0.f, 0.f};
        cur = nxt; cB = nB; ++ui;
        _Pragma("unroll") for (int _h = 0; _h < 2; ++_h) _Pragma("unroll") for (int _i = 0; _i < 2; ++_i) cP[_h][_i] = nP[_h][_i];
        if constexpr (ALIGN_EPI) { if (wr == 1) PG8_BAR; }
    }
    PG8_WAIT_V(0);
    if constexpr (!ALIGN_EPI) { if (wr == 0) PG8_BAR; }
    PG8_BAR;
    if constexpr (Epi::AFTER_DRAIN) { E.fused(acc, cur, wr, wc, fr, fq, lds, wid, lane); S.done(cur); }
#undef PG8_SA
#undef PG8_SB
#undef PG8_STAGE
#undef PG8_STAGE_AG
#undef PG8_ROWPTR
#undef PG8_LDA
#undef PG8_LDB
#undef PG8_MMA
#undef PG8_CAT8
#undef PG8_WAIT_V
#undef PG8_WAIT_L
#undef PG8_BAR
#undef PG8_SCHED
}

}

#define LAS __attribute__((address_space(3)))
typedef unsigned short bf16_t;
typedef float f32x4 __attribute__((ext_vector_type(4)));
typedef unsigned u32x4 __attribute__((ext_vector_type(4)));
typedef unsigned u32x2 __attribute__((ext_vector_type(2)));
typedef __bf16 bf16x2_t __attribute__((ext_vector_type(2)));
constexpr int NWAVES = 8, NTHR = 512;
constexpr int D = 1024, NB = 8, SEQ = 4096, LCTX = 256, TX = NB * SEQ, TC = NB * LCTX, TT = TX + TC, INW = 2304, NE = 16, FF = 2048;
constexpr int CAPX = 512, CAPC = 32, SLOTS = NB * CAPX + NB * CAPC;
constexpr float LOG2E = 1.4426950408889634f;
constexpr int LDS_BYTES = 163840;
enum { I_X = 0, I_C, I_CTX, I_CCTX, I_ADAW, I_ADAB, I_N1G, I_N2G, I_WIN, I_HCW, I_HCB, I_HW1, I_HB1, I_HW2, I_HB2, I_HW3, I_HFREQ, I_HSKIP, I_SINK, I_POOLW, I_POOLS, I_RPB, I_WOUT, I_ROUTER, I_WG, I_WU, I_WD, I_FNG, N_IN };
constexpr size_t MiB = 1u << 20;
constexpr size_t WS_CTL = 0;
constexpr size_t WS_MOD = 1 * MiB;
constexpr size_t WS_WSC = 1 * MiB + 512 * 1024;
constexpr size_t WS_ROPE = 2 * MiB;
constexpr size_t WS_TW8 = 2 * MiB + 65536;
constexpr size_t WS_WIN_T = 3 * MiB;
constexpr size_t WS_WOUT_T = 13 * MiB;
constexpr size_t WS_HC = 17 * MiB;
constexpr size_t WS_HCC = 51 * MiB;
constexpr size_t WS_AFFT = 53 * MiB;
constexpr size_t WS_ROWMAP = 56 * MiB;
constexpr size_t WS_GATE = 57 * MiB;
constexpr size_t WS_INV = 58 * MiB;
constexpr size_t WS_CRES = 61 * MiB;
constexpr size_t WS_HX = 69 * MiB;
constexpr size_t WS_WGU_T = 137 * MiB;
constexpr size_t WS_XB = 265 * MiB;
constexpr size_t WS_WD_T = 393 * MiB;
constexpr size_t WS_R = 521 * MiB;
constexpr size_t WS_ACT = WS_R;
constexpr size_t WS_XG = WS_R + 272 * MiB;
constexpr size_t WS_PX = WS_R;
constexpr size_t WS_Y = WS_R + 153 * MiB;
constexpr size_t WS_YT = WS_XG + 48 * MiB;
constexpr size_t WS_UT = WS_XG;
constexpr size_t WS_HS = WS_R + 408 * MiB;
constexpr size_t WS_END = WS_HS + 64 * MiB;
static_assert(WS_END <= 1024 * MiB, "workspace map");

struct Args { const float* in[N_IN]; float* out; unsigned char* ws; };

__device__ __forceinline__ float bf2f(unsigned short v) { return __uint_as_float(((unsigned)v) << 16); }
__device__ __forceinline__ unsigned f2bf(float f) { unsigned u = __float_as_uint(f); return (u + 0x7fffu + ((u >> 16) & 1u)) >> 16; }
__device__ __forceinline__ unsigned pk2(float lo, float hi) { return f2bf(lo) | (f2bf(hi) << 16); }
__device__ __forceinline__ float bflo(unsigned w) { return __uint_as_float(w << 16); }
__device__ __forceinline__ float bfhi(unsigned w) { return __uint_as_float(w & 0xffff0000u); }
__device__ __forceinline__ float dot2bf(unsigned a, unsigned b, float acc) { return __builtin_amdgcn_fdot2_f32_bf16(__builtin_bit_cast(bf16x2_t, a), __builtin_bit_cast(bf16x2_t, b), acc, false); }
template <int O> __device__ __forceinline__ float xshfl(float v) {
    if constexpr (O == 32) { auto rr = __builtin_amdgcn_permlane32_swap(__float_as_uint(v), __float_as_uint(v), false, false);
        const bool lowhalf = __builtin_amdgcn_mbcnt_lo(~0u, 0u) == __builtin_amdgcn_mbcnt_hi(~0u, __builtin_amdgcn_mbcnt_lo(~0u, 0u));
        return lowhalf ? __uint_as_float(rr[1]) : __uint_as_float(rr[0]); }
    else return __builtin_bit_cast(float, __builtin_amdgcn_ds_swizzle(__builtin_bit_cast(int, v), (O << 10) | 0x1f));
}
__device__ __forceinline__ float xsum32(float v) { auto rr = __builtin_amdgcn_permlane32_swap(__float_as_uint(v), __float_as_uint(v), false, false); return __uint_as_float(rr[0]) + __uint_as_float(rr[1]); }
__device__ __forceinline__ float xmax32(float v) { auto rr = __builtin_amdgcn_permlane32_swap(__float_as_uint(v), __float_as_uint(v), false, false); return fmaxf(__uint_as_float(rr[0]), __uint_as_float(rr[1])); }
__device__ __forceinline__ float wave_sum(float v) { v += xshfl<1>(v); v += xshfl<2>(v); v += xshfl<4>(v); v += xshfl<8>(v); v += xshfl<16>(v); return xsum32(v); }
__device__ __forceinline__ float wave_max_(float v) { v = fmaxf(v, xshfl<1>(v)); v = fmaxf(v, xshfl<2>(v)); v = fmaxf(v, xshfl<4>(v)); v = fmaxf(v, xshfl<8>(v)); v = fmaxf(v, xshfl<16>(v)); return xmax32(v); }
#define LDS_WAIT() asm volatile("s_waitcnt lgkmcnt(0)" ::: "memory")

#ifndef AMP_PHASE
#define AMP_PHASE -1
#endif
__device__ __forceinline__ unsigned long long amp_now() { asm volatile("s_waitcnt vmcnt(0) lgkmcnt(0)" ::: "memory"); __builtin_amdgcn_sched_barrier(0); const unsigned long long t = __builtin_amdgcn_s_memrealtime(); asm volatile("s_waitcnt lgkmcnt(0)" ::: "memory"); __builtin_amdgcn_sched_barrier(0); return t; }
#define AMP_BEGIN(id) unsigned long long amp_t0_ = 0; if ((id) == AMP_PHASE) { __syncthreads(); amp_t0_ = amp_now(); }
#define AMP_END(id) if ((id) == AMP_PHASE) { __syncthreads(); const unsigned long long t1_ = amp_now(); const unsigned long long d_ = t1_ - amp_t0_; while (amp_now() - t1_ < d_) __builtin_amdgcn_s_sleep(8); __syncthreads(); }
__device__ __forceinline__ void tr_item(const float* W, int K, int N, bf16_t* WT, int Kt, int item, int mode, LAS float* scr, int lane) {
    const int nblk = N / 32, kb = item / nblk, nb = item % nblk, k0 = 64 * kb, n0 = 32 * nb;
    const int r8 = lane >> 3, c4 = lane & 7; f32x4 v[8];
    const float* wp = W + (size_t)(k0 + r8) * N + n0 + 4 * c4;
#pragma unroll
    for (int i = 0; i < 8; ++i) v[i] = *(const f32x4*)(wp + (size_t)(8 * i) * N);
#pragma unroll
    for (int i = 0; i < 8; ++i) { LAS float* d = scr + (r8 + 8 * i) * 33 + 4 * c4; d[0] = v[i][0]; d[1] = v[i][1]; d[2] = v[i][2]; d[3] = v[i][3]; }
    LDS_WAIT();
    const int c = lane & 7;
    const int drow0 = (mode == 0) ? n0 : ((n0 >> 7) * 256 + (n0 & 127) + (mode == 2 ? 128 : 0));
#pragma unroll
    for (int j = 0; j < 4; ++j) { const int n = (lane >> 3) + 8 * j; const LAS float* sp = scr + (8 * c) * 33 + n;
        u32x4 o; o.x = pk2(sp[0 * 33], sp[1 * 33]); o.y = pk2(sp[2 * 33], sp[3 * 33]); o.z = pk2(sp[4 * 33], sp[5 * 33]); o.w = pk2(sp[6 * 33], sp[7 * 33]);
        *(u32x4*)(WT + (size_t)(drow0 + n) * Kt + k0 + 8 * c) = o; }
    LDS_WAIT();
}

__device__ __forceinline__ void tr_item_fp8(const float* W, int K, int N, unsigned char* WT, int Kt, int item, int mode, LAS float* scr, int lane, float* wsc_out) {
    const int nblk = N / 32, kb = item / nblk, nb = item % nblk, k0 = 64 * kb, n0 = 32 * nb;
    const int r8 = lane >> 3, c4 = lane & 7; f32x4 v[8];
    const f32x4 sv = *(const f32x4*)(W + 4 * lane);
    const float* wp = W + (size_t)(k0 + r8) * N + n0 + 4 * c4;
#pragma unroll
    for (int i = 0; i < 8; ++i) v[i] = *(const f32x4*)(wp + (size_t)(8 * i) * N);
    float sm = fmaxf(fmaxf(fabsf(sv[0]), fabsf(sv[1])), fmaxf(fabsf(sv[2]), fabsf(sv[3])));
#pragma unroll
    for (int o = 1; o < 64; o <<= 1) sm = fmaxf(sm, __shfl_xor(sm, o));
    int E = 0; (void)frexpf(fmaxf(sm, 1e-30f), &E); const float mul = ldexpf(1.0f, 5 - E);
    if (item == 0 && lane == 0) *wsc_out = ldexpf(1.0f, E - 5);
#pragma unroll
    for (int i = 0; i < 8; ++i) { LAS float* d = scr + (r8 + 8 * i) * 33 + 4 * c4; d[0] = v[i][0] * mul; d[1] = v[i][1] * mul; d[2] = v[i][2] * mul; d[3] = v[i][3] * mul; }
    LDS_WAIT();
    const int c = lane & 7;
    const int drow0 = (mode == 0) ? n0 : ((n0 >> 7) * 256 + (n0 & 127) + (mode == 2 ? 128 : 0));
#pragma unroll
    for (int j = 0; j < 4; ++j) { const int n = (lane >> 3) + 8 * j; const LAS float* sp = scr + (8 * c) * 33 + n;
        int p0 = 0, p1 = 0;
        p0 = __builtin_amdgcn_cvt_pk_fp8_f32(sp[0 * 33], sp[1 * 33], p0, false); p0 = __builtin_amdgcn_cvt_pk_fp8_f32(sp[2 * 33], sp[3 * 33], p0, true);
        p1 = __builtin_amdgcn_cvt_pk_fp8_f32(sp[4 * 33], sp[5 * 33], p1, false); p1 = __builtin_amdgcn_cvt_pk_fp8_f32(sp[6 * 33], sp[7 * 33], p1, true);
        typedef int i32x2v __attribute__((ext_vector_type(2)));
        *(i32x2v*)(WT + (size_t)(drow0 + n) * Kt + k0 + 8 * c) = (i32x2v){p0, p1}; }
    LDS_WAIT();
}

struct CvtStream { int it, end, live; f32x4 v0, v1, v2, v3, v4, v5, v6, v7; };
constexpr int CVT_ITEMS = 2 * 3 * 16 * 1024;
__device__ __forceinline__ void cvt_decode(const Args& a, int r, const float*& W, int& K, int& N, unsigned char*& WT, int& Kt, int& mode, int& ri, float*& wsc) {
    const int l = r / 49152, rr = r % 49152, which = rr >> 14, e = (rr >> 10) & 15; ri = rr & 1023; const size_t le = (size_t)l * 16 + e;
    wsc = (float*)(a.ws + WS_WSC) + (l * 3 + which) * 16 + e;
    if (which == 0) { W = a.in[I_WG] + le * 1024 * 2048; K = 1024; N = 2048; WT = (unsigned char*)(a.ws + WS_WGU_T) + le * 4096 * 1024; Kt = 1024; mode = 1; }
    else if (which == 1) { W = a.in[I_WU] + le * 1024 * 2048; K = 1024; N = 2048; WT = (unsigned char*)(a.ws + WS_WGU_T) + le * 4096 * 1024; Kt = 1024; mode = 2; }
    else { W = a.in[I_WD] + le * 2048 * 1024; K = 2048; N = 1024; WT = (unsigned char*)(a.ws + WS_WD_T) + le * 1024 * 2048; Kt = 2048; mode = 0; }
}
__device__ __forceinline__ void cvt_issue(const Args& a, CvtStream& c, int lane) {
    c.live = 0; if (c.it >= c.end) return;
    const float* W; int K, N, Kt, mode, ri; unsigned char* WT; float* wsc; cvt_decode(a, c.it, W, K, N, WT, Kt, mode, ri, wsc);
    const int nblk = N / 32, kb = ri / nblk, nb = ri % nblk, k0 = 64 * kb, n0 = 32 * nb; const int r8 = lane >> 3, c4 = lane & 7;
    const float* wp = W + (size_t)(k0 + r8) * N + n0 + 4 * c4; const size_t st = (size_t)8 * N;
    c.v0 = *(const f32x4*)(wp); c.v1 = *(const f32x4*)(wp + st); c.v2 = *(const f32x4*)(wp + 2 * st); c.v3 = *(const f32x4*)(wp + 3 * st);
    c.v4 = *(const f32x4*)(wp + 4 * st); c.v5 = *(const f32x4*)(wp + 5 * st); c.v6 = *(const f32x4*)(wp + 6 * st); c.v7 = *(const f32x4*)(wp + 7 * st);
    c.live = 1;
}
__device__ __forceinline__ void cvt_finish(const Args& a, CvtStream& c, LAS float* scr, int lane, int stride) {
    if (!c.live) return;
    const float* W; int K, N, Kt, mode, ri; unsigned char* WT; float* wsc; cvt_decode(a, c.it, W, K, N, WT, Kt, mode, ri, wsc);
    const int nblk = N / 32, kb = ri / nblk, nb = ri % nblk, k0 = 64 * kb, n0 = 32 * nb; const int r8 = lane >> 3, c4 = lane & 7;
    const float mul = 1.0f / *wsc;
    LAS float* d = scr + r8 * 33 + 4 * c4;
#define CVT_PUT(i, v) { d[(8 * (i)) * 33 + 0] = v[0] * mul; d[(8 * (i)) * 33 + 1] = v[1] * mul; d[(8 * (i)) * 33 + 2] = v[2] * mul; d[(8 * (i)) * 33 + 3] = v[3] * mul; }
    CVT_PUT(0, c.v0) CVT_PUT(1, c.v1) CVT_PUT(2, c.v2) CVT_PUT(3, c.v3) CVT_PUT(4, c.v4) CVT_PUT(5, c.v5) CVT_PUT(6, c.v6) CVT_PUT(7, c.v7)
#undef CVT_PUT
    LDS_WAIT();
    const int cc = lane & 7;
    const int drow0 = (mode == 0) ? n0 : ((n0 >> 7) * 256 + (n0 & 127) + (mode == 2 ? 128 : 0));
#pragma unroll
    for (int j = 0; j < 4; ++j) { const int n = (lane >> 3) + 8 * j; const LAS float* sp = scr + (8 * cc) * 33 + n;
        int p0 = 0, p1 = 0;
        p0 = __builtin_amdgcn_cvt_pk_fp8_f32(sp[0 * 33], sp[1 * 33], p0, false); p0 = __builtin_amdgcn_cvt_pk_fp8_f32(sp[2 * 33], sp[3 * 33], p0, true);
        p1 = __builtin_amdgcn_cvt_pk_fp8_f32(sp[4 * 33], sp[5 * 33], p1, false); p1 = __builtin_amdgcn_cvt_pk_fp8_f32(sp[6 * 33], sp[7 * 33], p1, true);
        typedef int i32x2v __attribute__((ext_vector_type(2)));
        *(i32x2v*)(WT + (size_t)(drow0 + n) * Kt + k0 + 8 * cc) = (i32x2v){p0, p1}; }
    LDS_WAIT();
    c.it += stride; c.live = 0;
}

__device__ __forceinline__ void filter_item(const Args& a, LAS unsigned char* lds, int item, int tid) {
    asm volatile("" : "+v"(tid));
    const int lane = tid & 63, wave = tid >> 6;
    int l, L, p0; float* HCdst;
    if (item < 128) { l = 0; L = 4096; p0 = item * 32; HCdst = (float*)(a.ws + WS_HC); }
    else if (item < 256) { l = 1; L = 4096; p0 = (item - 128) * 32; HCdst = (float*)(a.ws + WS_HC) + (size_t)2 * 256 * 8192; }
    else { l = 0; L = 256; p0 = (item - 256) * 32; HCdst = (float*)(a.ws + WS_HCC) + 256; }
    LAS float* w1s = (LAS float*)lds; LAS float* w2s = w1s + 33 * 64; LAS float* b1s = w2s + 64 * 64; LAS float* b2s = b1s + 64; LAS float* frs = b2s + 64; LAS float* h2s = frs + 64; LAS float* ex = h2s + 32 * 64;
    { const float* w1 = a.in[I_HW1] + l * 33 * 64; const float* w2 = a.in[I_HW2] + l * 64 * 64;
      for (int i = tid; i < 33 * 64; i += NTHR) w1s[i] = w1[i];
      for (int i = tid; i < 64 * 64; i += NTHR) w2s[i] = w2[i];
      if (tid < 64) { b1s[tid] = a.in[I_HB1][l * 64 + tid]; b2s[tid] = a.in[I_HB2][l * 64 + tid]; frs[tid] = a.in[I_HFREQ][l * 64 + tid]; } }
    __syncthreads();
    const float frq = frs[lane];
#pragma unroll 1
    for (int q = 0; q < 4; ++q) { const int pp = wave * 4 + q, p = p0 + pp; const float tn = (float)p / (float)(L - 1);
        float fv = 0.f;
        if (lane == 0) fv = tn;
        else if (lane <= 32) { const int bi = (lane - 1) & 15; const float band = 1e-4f + (float)bi * ((15.0f - 1e-4f) / 15.0f);
            const float ang = ((float)(6.283185307179586 / (double)L) * (float)p) * band; fv = (lane <= 16) ? cosf(ang) : -sinf(ang); }
        float a1 = b1s[lane];
#pragma unroll
        for (int i = 0; i < 33; ++i) a1 += __builtin_bit_cast(float, __builtin_amdgcn_readlane(__builtin_bit_cast(int, fv), i)) * w1s[i * 64 + lane];
        const float h1 = sinf(frq * a1);
        float a2 = b2s[lane];
#pragma unroll 16
        for (int i = 0; i < 64; ++i) a2 += __builtin_bit_cast(float, __builtin_amdgcn_readlane(__builtin_bit_cast(int, h1), i)) * w2s[i * 64 + lane];
        h2s[lane * 32 + pp] = sinf(frq * a2); }
    __syncthreads();
    const float* w3 = a.in[I_HW3] + (size_t)l * 64 * 1024 + tid;
    float acc0[32], acc1[32];
#pragma unroll
    for (int pp = 0; pp < 32; ++pp) { acc0[pp] = 0.f; acc1[pp] = 0.f; }
#pragma unroll 4
    for (int i = 0; i < 64; ++i) { const float wa = w3[i * 1024], wb = w3[i * 1024 + 512];
#pragma unroll
        for (int q = 0; q < 8; ++q) { const f32x4 h = *(const LAS f32x4*)(h2s + i * 32 + 4 * q);
#pragma unroll
            for (int r = 0; r < 4; ++r) { acc0[4 * q + r] += h[r] * wa; acc1[4 * q + r] += h[r] * wb; } } }
    const int c = tid & 255, dir = tid >> 8; const float dmin = 3.0701134573253945f, dmax = 15.350567286626972f; const float delta = dmin + (float)c * ((dmax - dmin) / 255.0f);
    float* base0 = HCdst; float* base1 = HCdst + (size_t)(2 * L - 1) * 256;
    const bool tr = (L == 4096);
#pragma unroll
    for (int pp = 0; pp < 32; ++pp) { const int p = p0 + pp; const float tn = (float)p / (float)(L - 1); const float win = expf(-tn * delta); const float v0 = acc0[pp] * win, v1 = acc1[pp] * win;
        if (p == 0) { ex[tid] = v0; ex[512 + tid] = v1; }
        else { const int li = dir == 0 ? (L - 1 + p) : (L - 1 - p); const size_t idx = tr ? ((size_t)c * 8192 + li) : ((size_t)li * 256 + c); const size_t o1 = tr ? (size_t)256 * 8192 : (size_t)(2 * L - 1) * 256; base0[idx] = v0; base0[idx + o1] = v1; } }
    __syncthreads();
    if (p0 == 0 && tid < 256) { const size_t idx = tr ? ((size_t)tid * 8192 + (L - 1)) : ((size_t)(L - 1) * 256 + tid); const size_t o1 = tr ? (size_t)256 * 8192 : (size_t)(2 * L - 1) * 256; base0[idx] = ex[tid] + ex[tid + 256]; base0[idx + o1] = ex[512 + tid] + ex[512 + tid + 256]; }
    __syncthreads();
}


typedef int v8i_t __attribute__((ext_vector_type(8)));
__device__ __forceinline__ float st_A(int i, int k) { return (float)(((i * 7 + k * 3) % 5) - 2); }
__device__ __forceinline__ float st_B(int k, int j) { return (float)(((k * 5 + j * 11 + (k >> 4)) % 5) - 2); }
__device__ __forceinline__ void fp8_selftest(unsigned* poison, int lane) {
    const int fr = lane & 15, fq = lane >> 4; v8i_t av, bv;
#pragma unroll
    for (int w = 0; w < 8; ++w) { int pa = 0, pb = 0;
#pragma unroll
        for (int q = 0; q < 4; ++q) { }
        const int kb = (w < 4) ? (16 * fq + 4 * w) : (64 + 16 * fq + 4 * (w - 4));
        pa = __builtin_amdgcn_cvt_pk_fp8_f32(st_A(fr, kb), st_A(fr, kb + 1), pa, false); pa = __builtin_amdgcn_cvt_pk_fp8_f32(st_A(fr, kb + 2), st_A(fr, kb + 3), pa, true);
        pb = __builtin_amdgcn_cvt_pk_fp8_f32(st_B(kb, fr), st_B(kb + 1, fr), pb, false); pb = __builtin_amdgcn_cvt_pk_fp8_f32(st_B(kb + 2, fr), st_B(kb + 3, fr), pb, true);
        av[w] = pa; bv[w] = pb; }
    f32x4 acc = {0.f, 0.f, 0.f, 0.f};
    acc = __builtin_amdgcn_mfma_scale_f32_16x16x128_f8f6f4(av, bv, acc, 0, 0, 0, 0x7f7f7f7f, 0, 0x7f7f7f7f);
    bool bad = false;
#pragma unroll
    for (int r = 0; r < 4; ++r) { float ref = 0.f; for (int k = 0; k < 128; ++k) ref += st_A(4 * fq + r, k) * st_B(k, fr); bad |= (acc[r] != ref); }
    { const float v = (float)(lane * 3 + 1);
      const float r5 = __builtin_bit_cast(float, __builtin_amdgcn_update_dpp(0, __builtin_bit_cast(int, v), 0x150 + 5, 0xf, 0xf, false));
      const float r12 = __builtin_bit_cast(float, __builtin_amdgcn_update_dpp(0, __builtin_bit_cast(int, v), 0x150 + 12, 0xf, 0xf, false));
      bad |= (r5 != (float)(((lane & 48) + 5) * 3 + 1)) || (r12 != (float)(((lane & 48) + 12) * 3 + 1)); }
    if (__any(bad) && lane == 0) __hip_atomic_store(poison, 1u, __ATOMIC_RELAXED, __HIP_MEMORY_SCOPE_AGENT);
}

__device__ __forceinline__ void phase_prologue(const Args& a, unsigned char* ldsg, int vcu, int G) {
    LAS unsigned char* lds = (LAS unsigned char*)ldsg;
    int tid_ = threadIdx.x; asm volatile("" : "+v"(tid_));
    const int tid = tid_, lane = tid & 63, wave = __builtin_amdgcn_readfirstlane(tid >> 6);
    unsigned char* ws = a.ws;
    if (vcu == 2 % G && wave == 0) fp8_selftest((unsigned*)(ws + WS_CTL) + 12288, lane);
    LAS float* sc = (LAS float*)lds; LAS float* red = (LAS float*)(lds + 36864);
    for (int i = tid; i < 9 * 1024; i += NTHR) { const float v = (i < 8192) ? a.in[I_C][i] : a.in[I_CCTX][i - 8192]; sc[i] = v / (1.0f + expf(-v)); }
    __syncthreads();
    { AMP_BEGIN(41)
    float* MOD = (float*)(ws + WS_MOD);
    for (int item = vcu; item < 2 * 96; item += G) {
        const int l = item / 96, n0 = (item % 96) * 64, col = tid & 63, kg = tid >> 6;
        float acc[9];
#pragma unroll
        for (int r = 0; r < 9; ++r) acc[r] = 0.f;
        const float* w = a.in[I_ADAW] + (size_t)l * 1024 * 6144 + n0 + col;
#pragma unroll 4
        for (int k = kg * 128; k < kg * 128 + 128; ++k) { const float wv = w[(size_t)k * 6144];
#pragma unroll
            for (int r = 0; r < 9; ++r) acc[r] += sc[r * 1024 + k] * wv; }
#pragma unroll
        for (int r = 0; r < 9; ++r) red[(kg * 9 + r) * 64 + col] = acc[r];
        __syncthreads();
        for (int o = tid; o < 9 * 64; o += NTHR) { const int r = o >> 6, cc = o & 63; float s = 0.f;
#pragma unroll
            for (int g2 = 0; g2 < 8; ++g2) s += red[(g2 * 9 + r) * 64 + cc];
            MOD[(size_t)(l * 9 + r) * 6144 + n0 + cc] = s + a.in[I_ADAB][l * 6144 + n0 + cc]; }
        __syncthreads();
    }
    AMP_END(41) }
    if (vcu == 0) { float* ROPE = (float*)(ws + WS_ROPE);
        for (int i = tid; i < 1024; i += NTHR) { const int pos = i >> 4, fi = i & 15; const float inv = powf(10000.0f, -(float)fi / 16.0f); const float ang = (float)pos * inv;
            ROPE[2 * i] = cosf(ang); ROPE[2 * i + 1] = sinf(ang); } }
    if (vcu == 1 % G) { float* TW8 = (float*)(ws + WS_TW8);
        for (int i = tid; i < 8192; i += NTHR) { float sn, cs; sincospif(-(float)i * (1.0f / 4096.0f), &sn, &cs); TW8[2 * i] = cs; TW8[2 * i + 1] = sn; } }
    const int gw = vcu * NWAVES + wave, NGW = G * NWAVES;
    { AMP_BEGIN(42)
    for (int it = vcu; it < 264; it += G) filter_item(a, lds, it, tid);
    AMP_END(42) }
    { AMP_BEGIN(43)
    LAS float* scr = (LAS float*)(lds + 65536 + wave * 8448);
    for (int m = gw; m < 96; m += NGW) { const int l = m / 48, which = (m % 48) / 16, e = m & 15; const size_t le = (size_t)l * 16 + e; int lane_ = lane; asm volatile("" : "+v"(lane_));
        const float* W = (which == 0) ? a.in[I_WG] + le * 1024 * 2048 : ((which == 1) ? a.in[I_WU] + le * 1024 * 2048 : a.in[I_WD] + le * 2048 * 1024);
        const f32x4 sv = *(const f32x4*)(W + 4 * lane_); float sm = fmaxf(fmaxf(fabsf(sv[0]), fabsf(sv[1])), fmaxf(fabsf(sv[2]), fabsf(sv[3])));
        sm = wave_max_(sm);
        int E = 0; (void)frexpf(fmaxf(sm, 1e-30f), &E); if (lane_ == 0) ((float*)(ws + WS_WSC))[m] = ldexpf(1.0f, E - 5); }
    constexpr int IT_IN = 16 * 72, IT_OUT = 16 * 32, IT_LAYER = IT_IN + IT_OUT;
    for (int it = gw; it < 2 * IT_LAYER; it += NGW) {
        const int l = it / IT_LAYER; int r = it % IT_LAYER;
        if (r < IT_IN) { tr_item(a.in[I_WIN] + (size_t)l * 1024 * 2304, 1024, 2304, (bf16_t*)(ws + WS_WIN_T) + (size_t)l * 2304 * 1024, 1024, r, 0, scr, lane); continue; } r -= IT_IN;
        tr_item(a.in[I_WOUT] + (size_t)l * 1024 * 1024, 1024, 1024, (bf16_t*)(ws + WS_WOUT_T) + (size_t)l * 1024 * 1024, 1024, r, 0, scr, lane);
    }
    AMP_END(43) }
}

__device__ __forceinline__ void phase_norm(const Args& a, unsigned char* ldsg, int vcu, int G, int l, const float* srcx, const float* srcc, const bf16_t* srcb, const float* gain, int shift_idx, int nrows, bool router) {
    int tid_ = threadIdx.x; asm volatile("" : "+v"(tid_));
    const int tid = tid_, lane = tid & 63, wave = __builtin_amdgcn_readfirstlane(tid >> 6);
    unsigned char* ws = a.ws; asm volatile("" : "+s"(ws)); const float* MOD = (const float*)(ws + WS_MOD) + (size_t)l * 9 * 6144; bf16_t* HX = (bf16_t*)(ws + WS_HX);
    LAS float* rw = (LAS float*)(LAS unsigned char*)ldsg;
    if (router) { const float* rsrc = a.in[I_ROUTER] + (size_t)l * 1024 * 16; for (int i = tid; i < 1024 * 16; i += NTHR) rw[(i & 15) * 1024 + (i >> 4)] = rsrc[i]; __syncthreads(); }
    const int gw = vcu * NWAVES + wave, NGW = G * NWAVES;
    for (int rowa = gw; rowa < nrows; rowa += 2 * NGW) {
        f32x4 vv[2][4];
#pragma unroll
        for (int u = 0; u < 2; ++u) { const int rr = (rowa + u * NGW < nrows) ? rowa + u * NGW : rowa;
            if (srcb) { const bf16_t* xr = srcb + (size_t)rr * D;
#pragma unroll
                for (int j = 0; j < 4; ++j) { const u32x2 w = *(const u32x2*)(xr + 256 * j + 4 * lane); vv[u][j] = (f32x4){bflo(w.x), bfhi(w.x), bflo(w.y), bfhi(w.y)}; } }
            else { const float* xr = (rr < TX) ? srcx + (size_t)rr * D : srcc + (size_t)(rr - TX) * D;
#pragma unroll
                for (int j = 0; j < 4; ++j) vv[u][j] = *(const f32x4*)(xr + 256 * j + 4 * lane); } }
        f32x4 hv[2][4];
#pragma unroll
        for (int u = 0; u < 2; ++u) { const int row = rowa + u * NGW; if (row < nrows) {
        const bool lat = row < TX; const int mrow = lat ? (row >> 12) : 8;
        const float* shp = MOD + mrow * 6144 + shift_idx * 1024; const float* scp = shp + 1024;
        f32x4 v[4]; float ss = 0.f;
#pragma unroll
        for (int j = 0; j < 4; ++j) { v[j] = vv[u][j]; ss += (v[j][0] * v[j][0] + v[j][1] * v[j][1]) + (v[j][2] * v[j][2] + v[j][3] * v[j][3]); }
        const float rstd = 1.0f / sqrtf(wave_sum(ss) * (1.0f / D) + 1e-6f);
#pragma unroll
        for (int j = 0; j < 4; ++j) { const f32x4 gg = *(const f32x4*)(gain + 256 * j + 4 * lane), sh = *(const f32x4*)(shp + 256 * j + 4 * lane), sc = *(const f32x4*)(scp + 256 * j + 4 * lane);
            v[j] = (v[j] * rstd * gg) * (1.0f + sc) + sh;
            if (router) { int p = 0; p = __builtin_amdgcn_cvt_pk_fp8_f32(fminf(fmaxf(v[j][0], -448.f), 448.f), fminf(fmaxf(v[j][1], -448.f), 448.f), p, false); p = __builtin_amdgcn_cvt_pk_fp8_f32(fminf(fmaxf(v[j][2], -448.f), 448.f), fminf(fmaxf(v[j][3], -448.f), 448.f), p, true);
                *(int*)((unsigned char*)HX + (size_t)row * D + 256 * j + 4 * lane) = p; }
            else { u32x2 o; o.x = pk2(v[j][0], v[j][1]); o.y = pk2(v[j][2], v[j][3]); *(u32x2*)(HX + (size_t)row * D + 256 * j + 4 * lane) = o; } }
#pragma unroll
        for (int j = 0; j < 4; ++j) hv[u][j] = v[j];
        } }
        float plr[2][16];
        if (router) {
#pragma unroll
            for (int e = 0; e < 16; ++e) { float p0 = 0.f, p1 = 0.f;
#pragma unroll
                for (int j = 0; j < 4; ++j) { const f32x4 wv = *(const LAS f32x4*)(rw + e * 1024 + 256 * j + 4 * lane);
                    p0 += (hv[0][j][0] * wv[0] + hv[0][j][1] * wv[1]) + (hv[0][j][2] * wv[2] + hv[0][j][3] * wv[3]);
                    p1 += (hv[1][j][0] * wv[0] + hv[1][j][1] * wv[1]) + (hv[1][j][2] * wv[2] + hv[1][j][3] * wv[3]); }
                plr[0][e] = p0; plr[1][e] = p1; asm volatile("" : "+v"(plr[0][e]), "+v"(plr[1][e])); } }
#pragma unroll
        for (int u = 0; u < 2; ++u) { const int row = rowa + u * NGW; if (row < nrows) {
        if (router) {
            float pl[16];
#pragma unroll
            for (int e = 0; e < 16; ++e) pl[e] = plr[u][e];
            float q8[8], q4[4], q2[2], q1;
            { const bool up = (lane & 8) != 0;
#pragma unroll
              for (int e = 0; e < 8; ++e) { const float keep = up ? pl[e + 8] : pl[e], give = up ? pl[e] : pl[e + 8]; q8[e] = keep + xshfl<8>(give); } }
            { const bool up = (lane & 4) != 0;
#pragma unroll
              for (int e = 0; e < 4; ++e) { const float keep = up ? q8[e + 4] : q8[e], give = up ? q8[e] : q8[e + 4]; q4[e] = keep + xshfl<4>(give); } }
            { const bool up = (lane & 2) != 0;
#pragma unroll
              for (int e = 0; e < 2; ++e) { const float keep = up ? q4[e + 2] : q4[e], give = up ? q4[e] : q4[e + 2]; q2[e] = keep + xshfl<2>(give); } }
            { const bool up = (lane & 1) != 0; const float keep = up ? q2[1] : q2[0], give = up ? q2[0] : q2[1]; q1 = keep + xshfl<1>(give); }
            q1 += xshfl<16>(q1); q1 = xsum32(q1);
            const float mylog = (lane < 16) ? q1 : -1e30f;
            float mx = mylog;
            mx = fmaxf(mx, xshfl<1>(mx)); mx = fmaxf(mx, xshfl<2>(mx)); mx = fmaxf(mx, xshfl<4>(mx)); mx = fmaxf(mx, xshfl<8>(mx));
            const float mine = (lane < 16) ? expf(mylog - mx) : 0.f; float den = mine;
            den += xshfl<1>(den); den += xshfl<2>(den); den += xshfl<4>(den); den += xshfl<8>(den);
            if (lane < 16) { ((float*)(ws + WS_AFFT))[(size_t)lane * TT + row] = mine / den; ((int*)(ws + WS_INV))[(size_t)row * 16 + lane] = -1; }
        }
    } }
    }
}

#define XB_TMO      128
#define XB_XCNT(j)  (256  + 64 * (j))
#define XB_XSUB(j)  (1280 + 64 * (j))
#define XB_XGEN(j)  (2304 + 64 * (j))
#define XB_TOP      3328
#define XB_TOPGEN   3392
#define XCD_BAR_WORDS 3456
#define XB_SPIN_CAP (1u << 18)

__device__ __forceinline__ unsigned xb_ld(unsigned* p)              { return __hip_atomic_load(p, __ATOMIC_RELAXED, __HIP_MEMORY_SCOPE_AGENT); }
__device__ __forceinline__ unsigned xb_add(unsigned* p, unsigned v) { return __hip_atomic_fetch_add(p, v, __ATOMIC_RELAXED, __HIP_MEMORY_SCOPE_AGENT); }
__device__ __forceinline__ unsigned xb_xcc_id() { return (unsigned)__builtin_amdgcn_s_getreg((3 << 11) | 20) & 0xFu; }
#define XB_SPIN(cond, bar) do { unsigned _sp = 0; while (cond) { __builtin_amdgcn_s_sleep(1); \
    if ((++_sp & 255u) == 0u) { if (xb_ld(&(bar)[XB_TMO])) break; if (_sp > XB_SPIN_CAP) { atomicAdd(&(bar)[XB_TMO], 1u); break; } } } } while (0)

struct XcdBarrier {
    unsigned* bar; unsigned x;
    volatile LAS unsigned* st;
};

__device__ __forceinline__ XcdBarrier xcd_barrier_post(unsigned* bar, volatile LAS unsigned* st) {
    XcdBarrier b; b.bar = bar; b.x = xb_xcc_id(); b.st = st;
    if (threadIdx.x == 0) (void)xb_add(&bar[XB_XCNT(b.x)], 1u);
    return b;
}
__device__ __forceinline__ void xcd_barrier_complete(unsigned* bar, unsigned x, unsigned& nloc, unsigned& nx) {
    const unsigned G = gridDim.x * gridDim.y * gridDim.z;
    unsigned sum, cnt, mine, sp = 0u;
    for (;;) {
        sum = 0u; cnt = 0u; mine = 0u;
#pragma unroll
        for (unsigned j = 0; j < 16; ++j) { const unsigned c = xb_ld(&bar[XB_XCNT(j)]); sum += c; cnt += (c > 0u) ? 1u : 0u; mine = (j == x) ? c : mine; }
        if (sum == G) break;
        __builtin_amdgcn_s_sleep(1);
        if ((++sp & 255u) == 0u) { if (xb_ld(&bar[XB_TMO])) break; if (sp > XB_SPIN_CAP) { atomicAdd(&bar[XB_TMO], 1u); break; } }
    }
    nloc = mine > 0u ? mine : 1u; nx = cnt > 0u ? cnt : 1u;
}

__device__ __forceinline__ void xcd_barrier(const XcdBarrier& b) {
    asm volatile("s_waitcnt vmcnt(0)" ::: "memory");
    __syncthreads();
    if (threadIdx.x == 0) {
        unsigned* bar = b.bar;
        __builtin_amdgcn_s_waitcnt(0);
        unsigned nloc = b.st[0], nx = b.st[1];
        if (nloc == 0u) { xcd_barrier_complete(bar, b.x, nloc, nx); b.st[0] = nloc; b.st[1] = nx; }
        const unsigned old = xb_add(&bar[XB_XSUB(b.x)], 1u);
        const unsigned gen = old / nloc;
        if (old + 1u == (gen + 1u) * nloc) {
            __builtin_amdgcn_fence(__ATOMIC_RELEASE, "agent");
            asm volatile("s_waitcnt vmcnt(0)" ::: "memory");
            const unsigned og = xb_add(&bar[XB_TOP], 1u);
            const unsigned tg = og / nx;
            if (og + 1u == (tg + 1u) * nx) xb_add(&bar[XB_TOPGEN], 1u);
            else XB_SPIN(xb_ld(&bar[XB_TOPGEN]) == tg, bar);
            __builtin_amdgcn_fence(__ATOMIC_ACQUIRE, "agent");
            xb_add(&bar[XB_XGEN(b.x)], 1u);
            asm volatile("s_waitcnt vmcnt(0)" ::: "memory");
        } else {
            XB_SPIN(xb_ld(&bar[XB_XGEN(b.x)]) == gen, bar);
            __builtin_amdgcn_fence(__ATOMIC_ACQUIRE, "agent");
            asm volatile("s_waitcnt vmcnt(0)" ::: "memory");
        }
    }
    __syncthreads();
}


typedef float f32x2 __attribute__((ext_vector_type(2)));
__device__ __forceinline__ f32x2 cmul(f32x2 a, f32x2 b) { return (f32x2){a.x * b.x - a.y * b.y, a.x * b.y + a.y * b.x}; }
__device__ __forceinline__ void dft16(f32x2 (&v)[16]) {
    constexpr float WC[8] = {1.0f, 0.92387953251128674f, 0.70710678118654752f, 0.38268343236508977f, 0.0f, -0.38268343236508977f, -0.70710678118654752f, -0.92387953251128674f};
    constexpr float WS[8] = {0.0f, -0.38268343236508977f, -0.70710678118654752f, -0.92387953251128674f, -1.0f, -0.92387953251128674f, -0.70710678118654752f, -0.38268343236508977f};
#pragma unroll
    for (int s = 8; s >= 1; s >>= 1)
#pragma unroll
        for (int i = 0; i < 16; ++i) if ((i & s) == 0) { const int k = (i & (s - 1)) * (8 / s); const f32x2 u = v[i], t = v[i + s]; v[i] = u + t; const f32x2 d = u - t;
            v[i + s] = (k == 0) ? d : ((k == 4) ? (f32x2){d.y, -d.x} : (f32x2){d.x * WC[k] - d.y * WS[k], d.x * WS[k] + d.y * WC[k]}); }
}
__device__ __forceinline__ constexpr int bitrev4(int i) { return ((i & 1) << 3) | ((i & 2) << 1) | ((i & 4) >> 1) | ((i & 8) >> 3); }
template <int NS, int MODE>
__device__ __forceinline__ void fft_pass(LAS f32x2* Z, const LAS f32x2* TW, int tid, const f32x2* H) {
    const int f = tid >> 8, j = tid & 255, base = f * 4096, k = j & (NS - 1);
    f32x2 v[16];
#pragma unroll
    for (int r = 0; r < 16; ++r) { const int idx = base + j + 256 * r; v[r] = Z[idx + (idx >> 4)]; }
    if (MODE == 1) {
#pragma unroll
        for (int r = 0; r < 16; ++r) { const f32x2 p = cmul(v[r], H[r]); v[r] = (f32x2){p.y, p.x}; } }
    if (NS > 1) { const LAS f32x2* tp = (NS == 16) ? (TW + 8192 + k) : (TW + 4096 + k);
#pragma unroll
        for (int r = 1; r < 16; ++r) v[r] = cmul(v[r], tp[r * NS]); }
    dft16(v);
    if (NS != 256) __syncthreads();
    const int j0 = base + (j / NS) * NS * 16 + k;
#pragma unroll
    for (int rr = 0; rr < 16; ++rr) { const int idx = j0 + rr * NS; Z[idx + (idx >> 4)] = v[bitrev4(rr)]; }
    __syncthreads();
}
__device__ __forceinline__ void load_uc(const bf16_t* UT, const float* cw, const float* cb, int ch, int b, int tid, float (&out)[8]) {
    const bf16_t* p = UT + ((size_t)(b * 768 + ch)) * 4096 + 8 * tid;
    const u32x4 w = *(const u32x4*)p; float u[10];
    u[1] = bflo(w.x); u[2] = bfhi(w.x); u[3] = bflo(w.y); u[4] = bfhi(w.y); u[5] = bflo(w.z); u[6] = bfhi(w.z); u[7] = bflo(w.w); u[8] = bfhi(w.w);
    u[0] = (tid > 0) ? bf2f(p[-1]) : 0.f; u[9] = (tid < 511) ? bf2f(p[8]) : 0.f;
    const float w0 = cw[ch], w1 = cw[768 + ch], w2 = cw[1536 + ch], bb = cb[ch];
#pragma unroll
    for (int i = 0; i < 8; ++i) out[i] = u[i] * w0 + u[i + 1] * w1 + u[i + 2] * w2 + bb;
}
__device__ __forceinline__ void hy_fill(LAS f32x2* Z, const LAS f32x2* TW, int tid, const float (&va)[8], const float (&vb)[8]) {
#pragma unroll
    for (int i = 0; i < 8; ++i) { const int t = 8 * tid + i; const f32x2 z = {va[i], vb[i]}; Z[t + (t >> 4)] = z; const int t2 = 4096 + t; Z[t2 + (t2 >> 4)] = cmul(z, TW[t]); }
    __syncthreads();
}
__device__ __forceinline__ void hy_conv(LAS f32x2* Z, const LAS f32x2* TW, int tid, const f32x2* Hg) {
    f32x2 H[16];
    { const int f = tid >> 8, j = tid & 255, base = f * 4096;
#pragma unroll
      for (int r = 0; r < 16; ++r) H[r] = Hg[base + j + 256 * r]; }
    fft_pass<1, 0>(Z, TW, tid, nullptr); fft_pass<16, 0>(Z, TW, tid, nullptr); fft_pass<256, 0>(Z, TW, tid, nullptr);
    fft_pass<1, 1>(Z, TW, tid, H); fft_pass<16, 0>(Z, TW, tid, nullptr); fft_pass<256, 0>(Z, TW, tid, nullptr);
}
__device__ __forceinline__ f32x2 hy_out(const LAS f32x2* Z, const LAS f32x2* TW, int t) {
    const f32x2 se = Z[t + (t >> 4)]; const int t2 = 4096 + t; const f32x2 so = Z[t2 + (t2 >> 4)]; const f32x2 tw = TW[t];
    const f32x2 So = {so.y, so.x};
    return (f32x2){se.y + (So.x * tw.x + So.y * tw.y), se.x + (So.y * tw.x - So.x * tw.y)};
}
__device__ __forceinline__ void hyena_item(const Args& a, LAS unsigned char* lds, int l, int c, int bp, int tid) {
    asm volatile("" : "+v"(tid));
    LAS f32x2* Z = (LAS f32x2*)lds; const LAS f32x2* TW = (const LAS f32x2*)(lds + 69632);
    const bf16_t* UT = (const bf16_t*)(a.ws + WS_UT); bf16_t* YT = (bf16_t*)(a.ws + WS_YT);
    const float* cw = a.in[I_HCW] + (size_t)l * 3 * 768; const float* cb = a.in[I_HCB] + (size_t)l * 768; const float* skip = a.in[I_HSKIP] + (size_t)l * 2 * 256;
    const f32x2* HS = (const f32x2*)(a.ws + WS_HS) + ((size_t)(l * 2) * 256 + c) * 8192;
    const int b0 = 2 * bp, b1 = 2 * bp + 1;
    float va[8], vb[8], xa[8], xb[8];
    load_uc(UT, cw, cb, c, b0, tid, va); load_uc(UT, cw, cb, c, b1, tid, vb);
    hy_fill(Z, TW, tid, va, vb);
    hy_conv(Z, TW, tid, HS);
    load_uc(UT, cw, cb, 256 + c, b0, tid, xa); load_uc(UT, cw, cb, 256 + c, b1, tid, xb);
    { const float sk = skip[c];
#pragma unroll
      for (int i = 0; i < 8; ++i) { const f32x2 y = hy_out(Z, TW, 8 * tid + i); va[i] = xa[i] * (y.x + va[i] * sk); vb[i] = xb[i] * (y.y + vb[i] * sk); } }
    __syncthreads();
    hy_fill(Z, TW, tid, va, vb);
    hy_conv(Z, TW, tid, HS + (size_t)256 * 8192);
    load_uc(UT, cw, cb, 512 + c, b0, tid, xa); load_uc(UT, cw, cb, 512 + c, b1, tid, xb);
    { const float sk = skip[256 + c];
      float oa[8], ob[8];
#pragma unroll
      for (int i = 0; i < 8; ++i) { const f32x2 y = hy_out(Z, TW, 8 * tid + i); oa[i] = xa[i] * (y.x + va[i] * sk); ob[i] = xb[i] * (y.y + vb[i] * sk); }
      u32x4 wa, wb; wa.x = pk2(oa[0], oa[1]); wa.y = pk2(oa[2], oa[3]); wa.z = pk2(oa[4], oa[5]); wa.w = pk2(oa[6], oa[7]); wb.x = pk2(ob[0], ob[1]); wb.y = pk2(ob[2], ob[3]); wb.z = pk2(ob[4], ob[5]); wb.w = pk2(ob[6], ob[7]);
      *(u32x4*)(YT + ((size_t)(b0 * 256 + c)) * 4096 + 8 * tid) = wa; *(u32x4*)(YT + ((size_t)(b1 * 256 + c)) * 4096 + 8 * tid) = wb; }
    __syncthreads();
}
__device__ __forceinline__ void spectrum_item(const Args& a, LAS unsigned char* lds, int item, int tid) {
    asm volatile("" : "+v"(tid));
    LAS f32x2* Z = (LAS f32x2*)lds; const LAS f32x2* TW = (const LAS f32x2*)(lds + 69632);
    const int c = item & 255, lo = item >> 8;
    const float* HC = (const float*)(a.ws + WS_HC) + ((size_t)lo * 256 + c) * 8192;
    { const f32x4 hl0 = *(const f32x4*)(HC + 4095 + 8 * tid), hl1 = *(const f32x4*)(HC + 4095 + 8 * tid + 4);
      float hlv[8] = {hl0[0], hl0[1], hl0[2], hl0[3], hl1[0], hl1[1], hl1[2], hl1[3]}; float hhv[8];
#pragma unroll
      for (int i = 0; i < 8; ++i) { const int t = 8 * tid + i; hhv[i] = (t == 0) ? 0.f : HC[t - 1]; }
#pragma unroll
      for (int i = 0; i < 8; ++i) { const int t = 8 * tid + i; const float hl = hlv[i], hh = hhv[i];
        Z[t + (t >> 4)] = (f32x2){hl + hh, 0.f}; const int t2 = 4096 + t; const f32x2 tw = TW[t]; const float dd = hl - hh; Z[t2 + (t2 >> 4)] = (f32x2){dd * tw.x, dd * tw.y}; } }
    __syncthreads();
    fft_pass<1, 0>(Z, TW, tid, nullptr); fft_pass<16, 0>(Z, TW, tid, nullptr); fft_pass<256, 0>(Z, TW, tid, nullptr);
    f32x2* HS = (f32x2*)(a.ws + WS_HS) + (size_t)item * 8192;
#pragma unroll
    for (int i = 0; i < 16; ++i) { const int idx = tid + 512 * i; HS[idx] = Z[idx + (idx >> 4)] * (1.0f / 8192.0f); }
    __syncthreads();
}
__device__ __forceinline__ void load_tw(const Args& a, LAS unsigned char* lds, int tid) {
    asm volatile("" : "+v"(tid));
    LAS f32x2* TW = (LAS f32x2*)(lds + 69632); const f32x2* src = (const f32x2*)(a.ws + WS_TW8);
    for (int i = tid; i < 4096; i += NTHR) { TW[i] = src[i]; const int r = i >> 8, k = i & 255; TW[4096 + i] = src[r * k * 2]; }
    if (tid < 256) { const int r = tid >> 4, k = tid & 15; TW[8192 + tid] = src[r * k * 32]; }
    __syncthreads();
}
__device__ __forceinline__ float ctx_uc(const bf16_t* PXc, const float* cw, const float* cb, int ch, int t) {
    const float u1 = bf2f(PXc[(size_t)t * INW + ch]); const float u0 = (t > 0) ? bf2f(PXc[(size_t)(t - 1) * INW + ch]) : 0.f; const float u2 = (t < 255) ? bf2f(PXc[(size_t)(t + 1) * INW + ch]) : 0.f;
    return u0 * cw[ch] + u1 * cw[768 + ch] + u2 * cw[1536 + ch] + cb[ch];
}
__device__ __forceinline__ void ctx_conv16(const LAS float* IN, const float* H, int c, int lane, int t0, float (&acc)[16]) {
    float w[16];
    const float* hp = H + (size_t)(t0 + 255) * 256 + c;
#pragma unroll
    for (int i = 0; i < 16; ++i) { acc[i] = 0.f; w[i] = hp[i * 256]; }
    const LAS float* ip = IN + lane;
#pragma unroll 1
    for (int s0 = 0; s0 < 256; s0 += 16) {
#pragma unroll
        for (int u = 0; u < 16; ++u) { const float v = ip[u * 64];
#pragma unroll
            for (int i = 0; i < 16; ++i) acc[i] += v * w[(i - u + 16) & 15];
            w[(15 - u) & 15] = hp[-(u + 1) * 256]; }
        hp -= 16 * 256; ip += 16 * 64; }
}
__device__ __forceinline__ void ctx_hyena_item(const Args& a, LAS unsigned char* lds, int l, int item, int tid) {
    asm volatile("" : "+v"(tid));
    const int lane = tid & 63, wave = tid >> 6, b = item >> 2, c = (item & 3) * 64 + lane;
    LAS float* V = (LAS float*)lds; LAS float* Z1 = (LAS float*)(lds + 65536);
    const bf16_t* PXc = (const bf16_t*)(a.ws + WS_PX) + (size_t)(TX + b * 256) * INW; bf16_t* Y = (bf16_t*)(a.ws + WS_Y) + (size_t)(TX + b * 256) * D;
    const float* cw = a.in[I_HCW] + (size_t)l * 3 * 768; const float* cb = a.in[I_HCB] + (size_t)l * 768; const float* skip = a.in[I_HSKIP] + (size_t)l * 2 * 256;
    const float* H0 = (const float*)(a.ws + WS_HCC) + 256, *H1 = H0 + (size_t)511 * 256;
#pragma unroll 2
    for (int i = 0; i < 32; ++i) { const int t = wave * 32 + i; V[t * 64 + lane] = ctx_uc(PXc, cw, cb, c, t); }
    __syncthreads();
    float acc[16];
#pragma unroll 1
    for (int g = 0; g < 2; ++g) { const int t0 = wave * 32 + g * 16; ctx_conv16(V, H0, c, lane, t0, acc); const float sk = skip[c];
#pragma unroll
        for (int i = 0; i < 16; ++i) { const int t = t0 + i; Z1[t * 64 + lane] = ctx_uc(PXc, cw, cb, 256 + c, t) * (acc[i] + V[t * 64 + lane] * sk); } }
    __syncthreads();
#pragma unroll 1
    for (int g = 0; g < 2; ++g) { const int t0 = wave * 32 + g * 16; ctx_conv16(Z1, H1, c, lane, t0, acc); const float sk = skip[256 + c];
#pragma unroll
        for (int i = 0; i < 16; ++i) { const int t = t0 + i; Y[(size_t)t * D + c] = (bf16_t)f2bf(ctx_uc(PXc, cw, cb, 512 + c, t) * (acc[i] + Z1[t * 64 + lane] * sk)); } }
    __syncthreads();
}

__device__ __forceinline__ void ytr_item(const Args& a, LAS unsigned char* tile, int item, int lane) {
    const int b = item >> 8, tt = (item >> 2) & 63, ct = item & 3;
    const bf16_t* src = (const bf16_t*)(a.ws + WS_YT) + ((size_t)(b * 256 + ct * 64)) * 4096 + tt * 64; bf16_t* Y = (bf16_t*)(a.ws + WS_Y) + ((size_t)b * 4096 + tt * 64) * D + ct * 64;
    u32x4 v[8];
#pragma unroll
    for (int i = 0; i < 8; ++i) v[i] = *(const u32x4*)(src + (size_t)((lane >> 3) + 8 * i) * 4096 + (lane & 7) * 8);
#pragma unroll
    for (int i = 0; i < 8; ++i) *(LAS u32x4*)(tile + ((lane >> 3) + 8 * i) * 144 + (lane & 7) * 16) = v[i];
    LDS_WAIT();
    const LAS unsigned short* tp = (const LAS unsigned short*)(tile + lane * 2);
#pragma unroll
    for (int q = 0; q < 8; ++q) { u32x4 o;
        o.x = (unsigned)tp[(8 * q + 0) * 72] | ((unsigned)tp[(8 * q + 1) * 72] << 16); o.y = (unsigned)tp[(8 * q + 2) * 72] | ((unsigned)tp[(8 * q + 3) * 72] << 16);
        o.z = (unsigned)tp[(8 * q + 4) * 72] | ((unsigned)tp[(8 * q + 5) * 72] << 16); o.w = (unsigned)tp[(8 * q + 6) * 72] | ((unsigned)tp[(8 * q + 7) * 72] << 16);
        *(u32x4*)(Y + (size_t)lane * D + 8 * q) = o; }
    LDS_WAIT();
}
__device__ __forceinline__ void event_arrive(unsigned* ctr) {
    asm volatile("s_waitcnt vmcnt(0)" ::: "memory"); __syncthreads();
    if (threadIdx.x == 0) { __builtin_amdgcn_fence(__ATOMIC_RELEASE, "agent"); asm volatile("s_waitcnt vmcnt(0)" ::: "memory"); __hip_atomic_fetch_add(ctr, 1u, __ATOMIC_RELAXED, __HIP_MEMORY_SCOPE_AGENT); }
}
__device__ __forceinline__ void event_wait(unsigned* ctr, unsigned want) {
    if (threadIdx.x == 0) { unsigned sp = 0;
        while (__hip_atomic_load(ctr, __ATOMIC_RELAXED, __HIP_MEMORY_SCOPE_AGENT) < want) { __builtin_amdgcn_s_sleep(2); if (++sp > (1u << 22)) break; }
        __builtin_amdgcn_fence(__ATOMIC_ACQUIRE, "agent"); asm volatile("s_waitcnt vmcnt(0)" ::: "memory"); }
    __syncthreads();
}

typedef short bf16x8_t __attribute__((ext_vector_type(8)));
typedef short s16x4_t __attribute__((ext_vector_type(4)));
typedef float f32x16 __attribute__((ext_vector_type(16)));
__device__ __forceinline__ int crow(int r, int hi) { return (r & 3) + 8 * (r >> 2) + 4 * hi; }
__device__ __forceinline__ unsigned cvtpk(float lo, float hi) { f32x2 v = {lo, hi}; bf16x2_t b = __builtin_convertvector(v, bf16x2_t); return __builtin_bit_cast(unsigned, b); }
__device__ __forceinline__ s16x4_t vtr(const LAS unsigned char* p) { return __builtin_bit_cast(s16x4_t, __builtin_amdgcn_ds_read_tr16_b64_v4i16((LAS s16x4_t*)p)); }
constexpr int AT_K = 0, AT_V = 16384, AT_WSF = 32768, AT_OST = 34816, AT_RPB = 67584, AT_END = 69632;
template <int KIND>
__device__ __forceinline__ void attn_unit(const Args& a, LAS unsigned char* lds, int l, int u, int wave_, CvtStream& cs, int cstride) {
    int lane = (int)__builtin_amdgcn_mbcnt_hi(~0u, __builtin_amdgcn_mbcnt_lo(~0u, 0u)); asm volatile("" : "+v"(lane));
    const int wid = wave_, tid = wave_ * 64 + lane, r32 = lane & 31, hi = lane >> 5;
    const bf16_t* PX = (const bf16_t*)(a.ws + WS_PX); bf16_t* Y = (bf16_t*)(a.ws + WS_Y);
    int b, qcol, kcol, vcol, ycol, qrow0, nloc = 0, lo = 0; bool sink = false; int hsink = 0;
    int qpos0 = 0, blk = 0, rq = 0, cbase = 0, rq4 = 0;
    if (KIND == 0) { b = u >> 6; const int kvh = (u >> 5) & 1; blk = u & 31; const int h = 2 * kvh + (wid >> 2); qpos0 = blk * 128 + 32 * (wid & 3); qrow0 = b * 4096 + qpos0;
        qcol = 1024 + h * 64; kcol = 1536 + kvh * 64; vcol = 1664 + kvh * 64; ycol = 256 + h * 64; lo = (blk == 0) ? 2 : 0; nloc = ((blk == 31) ? 3 : 5) - lo + 1; sink = true; hsink = h; }
    else if (KIND == 1) { b = u >> 6; const int h = (u >> 4) & 3; rq4 = u & 15; rq = 4 * rq4 + (wid >> 1); cbase = 32 * (wid & 1); qrow0 = b * 4096 + rq * 64 + cbase;
        qcol = 1280 + h * 64; kcol = 1792 + h * 64; vcol = 2048 + h * 64; ycol = 768 + h * 64;
        const int ra = 4 * rq4 - 4, rb = 4 * rq4 + 3 - 4; lo = ra < 0 ? 0 : (ra > 56 ? 56 : ra); const int hi_r = (rb < 0 ? 0 : (rb > 56 ? 56 : rb)) + 7; nloc = hi_r - lo + 1;
        LAS float* rpbL = (LAS float*)(lds + AT_RPB); const float* src = a.in[I_RPB] + (size_t)(l * 4 + h) * 465;
        for (int i = tid; i < 465; i += NTHR) rpbL[i] = src[i] * 8.0f; }
    else { b = u >> 3; const int h = (u >> 1) & 3; qrow0 = TX + b * 256 + 32 * wid;
        if ((u & 1) == 0) { qcol = 1024 + h * 64; kcol = 1536 + (h >> 1) * 64; vcol = 1664 + (h >> 1) * 64; ycol = 256 + h * 64; sink = true; hsink = h; }
        else { qcol = 1280 + h * 64; kcol = 1792 + h * 64; vcol = 2048 + h * 64; ycol = 768 + h * 64; } }
    const int NT = nloc + 4;
    bf16x8_t qr[4];
    { const bf16_t* qp = PX + (size_t)(qrow0 + r32) * INW + qcol + hi * 8;
#pragma unroll
      for (int d0 = 0; d0 < 4; ++d0) qr[d0] = *(const bf16x8_t*)(qp + d0 * 16); }
    const int krow = 8 * wid + (lane & 7), kchunk = lane >> 3; const int vrow = 16 * (wid & 3) + (lane >> 2), vcoff = (wid >> 2) * 32 + (lane & 3) * 8;
    const int kdst = AT_K + kchunk * 1024 + krow * 16, vdst = AT_V + wid * 1024 + lane * 16;
    auto tile_row0 = [&](int t) -> int { if (t < nloc) { if (KIND == 0) return b * 4096 + blk * 128 - 128 + 64 * (lo + t); else return b * 4096 + (lo + t) * 64; } return TX + b * 256 + 64 * (t - nloc); };
    u32x4 gk0, gv0, gk1, gv1;
#define AT_LOAD(GK, GV, t_) do { const int R0_ = tile_row0(t_); GK = *(const u32x4*)(PX + (size_t)(R0_ + krow) * INW + kcol + kchunk * 8); GV = *(const u32x4*)(PX + (size_t)(R0_ + vrow) * INW + vcol + vcoff); } while (0)
    AT_LOAD(gk0, gv0, 0);
    if (NT > 1) AT_LOAD(gk1, gv1, 1); else { gk1 = gk0; gv1 = gv0; }
    *(LAS u32x4*)(lds + kdst) = gk0; *(LAS u32x4*)(lds + vdst) = gv0;
    float mhat = -1e30f, l_reg = 0.f; f32x16 o[2];
#pragma unroll
    for (int r = 0; r < 16; ++r) { o[0][r] = 0.f; o[1][r] = 0.f; }
    LAS float* wsf = (LAS float*)(lds + AT_WSF) + wid * 64;
    const LAS unsigned char* vb0 = lds + AT_V + ((lane >> 4) & 1) * 32 + (lane & 3) * 8 + (4 * hi + ((lane & 15) >> 2)) * 64;
    const LAS unsigned char* kb0 = lds + AT_K + hi * 1024 + r32 * 16;
    __syncthreads();
    auto step = [&](int t, u32x4& gkw, u32x4& gvw, u32x4& gkl, u32x4& gvl) __attribute__((always_inline)) {
        const int bufo = (t & 1) * 8192;
        cvt_issue(a, cs, lane);
        if (t + 2 < NT) AT_LOAD(gkl, gvl, t + 2);
        bool need = true; bool full = true; int ts = 0, rk = 0;
        if (t < nloc) {
            if (KIND == 0) { ts = blk * 128 - 128 + 64 * (lo + t); need = (ts + 63 >= qpos0 - 128) && (ts <= qpos0 + 31 + 128); full = (qpos0 + 31 - ts <= 128) && (ts + 63 - qpos0 <= 128); }
            if (KIND == 1) { rk = lo + t; const int r0 = (rq - 4) < 0 ? 0 : ((rq - 4) > 56 ? 56 : (rq - 4)); need = (rk >= r0) && (rk <= r0 + 7); full = false; }
        }
        if (need) {
            f32x16 p0, p1;
#pragma unroll
            for (int r = 0; r < 16; ++r) { p0[r] = 0.f; p1[r] = 0.f; }
            const LAS unsigned char* kb = kb0 + bufo;
#pragma unroll
            for (int d0 = 0; d0 < 4; ++d0) { const bf16x8_t k0 = *(const LAS bf16x8_t*)(kb + d0 * 2048), k1 = *(const LAS bf16x8_t*)(kb + d0 * 2048 + 512);
                p0 = __builtin_amdgcn_mfma_f32_32x32x16_bf16(k0, qr[d0], p0, 0, 0, 0); p1 = __builtin_amdgcn_mfma_f32_32x32x16_bf16(k1, qr[d0], p1, 0, 0, 0); }
            constexpr float C2 = 0.125f * LOG2E;
            if (!full) {
                if (KIND == 0) { const int tq = qpos0 + r32;
#pragma unroll
                    for (int r = 0; r < 16; ++r) { const int k0 = ts + crow(r, hi), d0 = tq - k0, d1 = d0 - 32; p0[r] = (d0 > 128 || d0 < -128) ? -INFINITY : p0[r]; p1[r] = (d1 > 128 || d1 < -128) ? -INFINITY : p1[r]; } }
                if (KIND == 1) { const int c = cbase + r32; const int wsc = (c - 8) < 0 ? 0 : ((c - 8) > 48 ? 48 : (c - 8)); const LAS float* rp = (const LAS float*)(lds + AT_RPB) + (rk - rq + 7) * 31 + 15 - c;
                    { float b0[16];
#pragma unroll
                      for (int r = 0; r < 16; ++r) { const int c0 = crow(r, hi); const int i0 = c0 < wsc ? wsc : (c0 > wsc + 15 ? wsc + 15 : c0); b0[r] = rp[i0]; }
#pragma unroll
                      for (int r = 0; r < 16; ++r) { const int c0 = crow(r, hi); const bool ok0 = (c0 >= wsc) && (c0 < wsc + 16); p0[r] = ok0 ? p0[r] + b0[r] : -INFINITY; } }
                    asm volatile("" : "+v"(p0) :: "memory");
                    { float b1[16];
#pragma unroll
                      for (int r = 0; r < 16; ++r) { const int c1 = crow(r, hi) + 32; const int i1 = c1 < wsc ? wsc : (c1 > wsc + 15 ? wsc + 15 : c1); b1[r] = rp[i1]; }
#pragma unroll
                      for (int r = 0; r < 16; ++r) { const int c1 = crow(r, hi) + 32; const bool ok1 = (c1 >= wsc) && (c1 < wsc + 16); p1[r] = ok1 ? p1[r] + b1[r] : -INFINITY; } } }
            }
            float rm = fmaxf(p0[0], p1[0]);
#pragma unroll
            for (int r = 1; r < 16; ++r) rm = fmaxf(rm, fmaxf(p0[r], p1[r]));
            { auto rr = __builtin_amdgcn_permlane32_swap(__float_as_uint(rm), __float_as_uint(rm), false, false); rm = fmaxf(__uint_as_float(rr[0]), __uint_as_float(rr[1])); }
            const float mnew = fmaxf(mhat, rm); const float f = __builtin_amdgcn_exp2f((mhat - mnew) * C2); const bool grew = mnew > mhat; mhat = mnew;
            const float nm = -mnew * C2; float sacc = 0.f;
#pragma unroll
            for (int r = 0; r < 16; ++r) { p0[r] = __builtin_amdgcn_exp2f(fmaf(p0[r], C2, nm)); p1[r] = __builtin_amdgcn_exp2f(fmaf(p1[r], C2, nm)); sacc += p0[r] + p1[r]; }
            l_reg = l_reg * f + sacc;
            if (__any(grew)) { if (hi == 0) wsf[r32] = f; LDS_WAIT();
#pragma unroll
                for (int r = 0; r < 16; ++r) { const float fr_ = wsf[crow(r, hi)]; o[0][r] *= fr_; o[1][r] *= fr_; }
                LDS_WAIT(); }
            u32x4 pw0, pw1, pw2, pw3;
            pw0 = (u32x4){cvtpk(p0[0], p0[1]), cvtpk(p0[2], p0[3]), cvtpk(p0[4], p0[5]), cvtpk(p0[6], p0[7])}; pw1 = (u32x4){cvtpk(p0[8], p0[9]), cvtpk(p0[10], p0[11]), cvtpk(p0[12], p0[13]), cvtpk(p0[14], p0[15])};
            pw2 = (u32x4){cvtpk(p1[0], p1[1]), cvtpk(p1[2], p1[3]), cvtpk(p1[4], p1[5]), cvtpk(p1[6], p1[7])}; pw3 = (u32x4){cvtpk(p1[8], p1[9]), cvtpk(p1[10], p1[11]), cvtpk(p1[12], p1[13]), cvtpk(p1[14], p1[15])};
            const LAS unsigned char* vb = vb0 + bufo;
#pragma unroll
            for (int d0 = 0; d0 < 2; ++d0) {
#pragma unroll
                for (int ks = 0; ks < 4; ++ks) { const s16x4_t vl = vtr(vb + d0 * 4096 + ks * 1024), vh = vtr(vb + d0 * 4096 + ks * 1024 + 512);
                    const bf16x8_t vf = (bf16x8_t){vl[0], vl[1], vl[2], vl[3], vh[0], vh[1], vh[2], vh[3]};
                    const bf16x8_t pa = __builtin_bit_cast(bf16x8_t, ks == 0 ? pw0 : (ks == 1 ? pw1 : (ks == 2 ? pw2 : pw3)));
                    o[d0] = __builtin_amdgcn_mfma_f32_32x32x16_bf16(pa, vf, o[d0], 0, 0, 0); } }
        }
        cvt_finish(a, cs, (LAS float*)(lds + 73728) + wid * 2112, lane, cstride);
        if (t + 1 < NT) { const int nb = ((t + 1) & 1) * 8192; *(LAS u32x4*)(lds + kdst + nb) = gkw; *(LAS u32x4*)(lds + vdst + nb) = gvw; }
        __syncthreads();
    };
    for (int t = 0; t < NT; t += 2) { step(t, gk1, gv1, gk0, gv0); if (t + 1 < NT) step(t + 1, gk0, gv0, gk1, gv1); }
#undef AT_LOAD
    { auto rr = __builtin_amdgcn_permlane32_swap(__float_as_uint(l_reg), __float_as_uint(l_reg), false, false); l_reg = __uint_as_float(rr[0]) + __uint_as_float(rr[1]); }
    if (sink) l_reg += __builtin_amdgcn_exp2f(a.in[I_SINK][l * 4 + hsink] * LOG2E - mhat * (0.125f * LOG2E));
    if (hi == 0) wsf[32 + r32] = 1.0f / l_reg;
    LDS_WAIT();
    LAS bf16_t* stg = (LAS bf16_t*)(lds + AT_OST) + wid * 2048;
#pragma unroll
    for (int r = 0; r < 16; ++r) { const int orow = crow(r, hi); const float il = wsf[32 + orow];
        stg[orow * 64 + r32] = (bf16_t)f2bf(o[0][r] * il); stg[orow * 64 + 32 + r32] = (bf16_t)f2bf(o[1][r] * il); }
    LDS_WAIT();
#pragma unroll
    for (int i = 0; i < 4; ++i) { const int row = i * 8 + (lane >> 3), ch = lane & 7; const u32x4 v = *(const LAS u32x4*)(stg + row * 64 + ch * 8);
        *(u32x4*)(Y + (size_t)(qrow0 + row) * D + ycol + ch * 8) = v; }
    __syncthreads();
}


template <int HW>
__device__ __forceinline__ void pool_tile(const bf16_t* PX, bf16_t* Y, const float* pscale, int tile, int g, int lane, const bf16x8_t (&wf)[4][2]) {
    const int tk = lane & 15, oc = lane >> 4; const int row = tile * 16 + tk; const bool lat = row < TX; const int tpos = lat ? (row & 4095) : ((row - TX) & 255); const int Ls = lat ? 4096 : 256;
    const bf16_t* pr = PX + (size_t)row * INW + 768 + g * 64 + 8 * oc;
    u32x4 w0[2 * HW], w1[2 * HW];
#pragma unroll
    for (int i = 0; i < 2 * HW; ++i) { const int off = i - HW; const int tp = tpos + off; const bool inr = (tp >= 0) && (tp < Ls); const bf16_t* p = pr + (ptrdiff_t)(inr ? off : 0) * INW; w0[i] = *(const u32x4*)p; w1[i] = *(const u32x4*)(p + 32); }
    float s0[8], s1[8]; int cnt = 0;
#pragma unroll
    for (int j = 0; j < 8; ++j) { s0[j] = 0.f; s1[j] = 0.f; }
#pragma unroll
    for (int i = 0; i < 2 * HW; ++i) { const int tp = tpos + i - HW; const bool in = (tp >= 0) && (tp < Ls); const float m = in ? 1.0f : 0.0f; cnt += in ? 1 : 0;
        s0[0] += m * bflo(w0[i].x); s0[1] += m * bfhi(w0[i].x); s0[2] += m * bflo(w0[i].y); s0[3] += m * bfhi(w0[i].y); s0[4] += m * bflo(w0[i].z); s0[5] += m * bfhi(w0[i].z); s0[6] += m * bflo(w0[i].w); s0[7] += m * bfhi(w0[i].w);
        s1[0] += m * bflo(w1[i].x); s1[1] += m * bfhi(w1[i].x); s1[2] += m * bflo(w1[i].y); s1[3] += m * bfhi(w1[i].y); s1[4] += m * bflo(w1[i].z); s1[5] += m * bfhi(w1[i].z); s1[6] += m * bflo(w1[i].w); s1[7] += m * bfhi(w1[i].w); }
    const float ic = 1.0f / (float)cnt; const u32x4 c0 = w0[HW], c1 = w1[HW];
    const float u0[8] = {bflo(c0.x), bfhi(c0.x), bflo(c0.y), bfhi(c0.y), bflo(c0.z), bfhi(c0.z), bflo(c0.w), bfhi(c0.w)}, u1[8] = {bflo(c1.x), bfhi(c1.x), bflo(c1.y), bfhi(c1.y), bflo(c1.z), bfhi(c1.z), bflo(c1.w), bfhi(c1.w)};
    u32x4 d0, d1;
    d0.x = cvtpk(s0[0] * ic - u0[0], s0[1] * ic - u0[1]); d0.y = cvtpk(s0[2] * ic - u0[2], s0[3] * ic - u0[3]); d0.z = cvtpk(s0[4] * ic - u0[4], s0[5] * ic - u0[5]); d0.w = cvtpk(s0[6] * ic - u0[6], s0[7] * ic - u0[7]);
    d1.x = cvtpk(s1[0] * ic - u1[0], s1[1] * ic - u1[1]); d1.y = cvtpk(s1[2] * ic - u1[2], s1[3] * ic - u1[3]); d1.z = cvtpk(s1[4] * ic - u1[4], s1[5] * ic - u1[5]); d1.w = cvtpk(s1[6] * ic - u1[6], s1[7] * ic - u1[7]);
    const bf16x8_t b0 = __builtin_bit_cast(bf16x8_t, d0), b1 = __builtin_bit_cast(bf16x8_t, d1);
    bf16_t* yr = Y + (size_t)row * D + 512 + g * 64 + 4 * oc;
#pragma unroll
    for (int nt = 0; nt < 4; ++nt) { f32x4 acc = {0.f, 0.f, 0.f, 0.f};
        acc = __builtin_amdgcn_mfma_f32_16x16x32_bf16(wf[nt][0], b0, acc, 0, 0, 0); acc = __builtin_amdgcn_mfma_f32_16x16x32_bf16(wf[nt][1], b1, acc, 0, 0, 0);
        const f32x4 sc = *(const f32x4*)(pscale + g * 64 + 16 * nt + 4 * oc); acc *= sc;
        u32x2 ov; ov.x = cvtpk(acc[0], acc[1]); ov.y = cvtpk(acc[2], acc[3]); *(u32x2*)(yr + 16 * nt) = ov; }
}
__device__ __forceinline__ void phase_mix1(const Args& a, unsigned char* ldsg, int vcu, int G, int l) {
    LAS unsigned char* lds = (LAS unsigned char*)ldsg;
    int tid_ = threadIdx.x; asm volatile("" : "+v"(tid_));
    const int tid = tid_, lane = tid & 63, wave = __builtin_amdgcn_readfirstlane(tid >> 6);
    unsigned char* ws = a.ws; asm volatile("" : "+s"(ws)); const bf16_t* PX = (const bf16_t*)(ws + WS_PX); bf16_t* Y = (bf16_t*)(ws + WS_Y);
    const bool upd = (l == 0); const int nrows = upd ? TT : TX;
    const int gw = vcu * NWAVES + wave, NGW = G * NWAVES;
    { AMP_BEGIN(31) load_tw(a, lds, tid);
    for (int it = vcu; it < 1024; it += G) hyena_item(a, lds, l, it >> 2, it & 3, tid);
    if (upd) for (int it = vcu; it < 32; it += G) ctx_hyena_item(a, lds, l, it, tid);
    event_arrive((unsigned*)(ws + WS_CTL) + 8192 + 64 * l); AMP_END(31) }
    { AMP_BEGIN(32)
    { const int g = gw & 3; const float* pwg = a.in[I_POOLW] + (size_t)(l * 4 + g) * 4096; const float* pscale = a.in[I_POOLS] + (size_t)l * 256;
      bf16x8_t wf[4][2];
#pragma unroll
      for (int nt = 0; nt < 4; ++nt)
#pragma unroll
          for (int ks = 0; ks < 2; ++ks) { const float* wp = pwg + (size_t)(32 * ks + 8 * (lane >> 4)) * 64 + 16 * nt + (lane & 15); u32x4 w;
              w.x = cvtpk(wp[0], wp[64]); w.y = cvtpk(wp[128], wp[192]); w.z = cvtpk(wp[256], wp[320]); w.w = cvtpk(wp[384], wp[448]); wf[nt][ks] = __builtin_bit_cast(bf16x8_t, w); }
      const int ntiles = nrows / 16;
      for (int it = gw; it < ntiles * 4; it += NGW) { const int tile = it >> 2;
          if (g == 0) pool_tile<1>(PX, Y, pscale, tile, g, lane, wf); else if (g == 1) pool_tile<2>(PX, Y, pscale, tile, g, lane, wf); else if (g == 2) pool_tile<4>(PX, Y, pscale, tile, g, lane, wf); else pool_tile<8>(PX, Y, pscale, tile, g, lane, wf); } }
    __syncthreads(); AMP_END(32) }
    { AMP_BEGIN(33)
    CvtStream cs; cs.it = upd ? gw : CVT_ITEMS; cs.end = CVT_ITEMS; cs.live = 0;
    for (int u = vcu; u < 512; u += G) attn_unit<0>(a, lds, l, u, wave, cs, NGW);
    for (int u = vcu; u < 512; u += G) attn_unit<1>(a, lds, l, u, wave, cs, NGW);
    if (upd) for (int u = vcu; u < 64; u += G) attn_unit<2>(a, lds, l, u, wave, cs, NGW);
    int lane2 = (int)__builtin_amdgcn_mbcnt_hi(~0u, __builtin_amdgcn_mbcnt_lo(~0u, 0u)); asm volatile("" : "+v"(lane2));
    while (cs.it < cs.end) { cvt_issue(a, cs, lane2); cvt_finish(a, cs, (LAS float*)(lds + 73728) + wave * 2112, lane2, NGW); }
    AMP_END(33) }
    { AMP_BEGIN(34) event_wait((unsigned*)(ws + WS_CTL) + 8192 + 64 * l, (unsigned)G);
      int lane3 = (int)__builtin_amdgcn_mbcnt_hi(~0u, __builtin_amdgcn_mbcnt_lo(~0u, 0u)); asm volatile("" : "+v"(lane3));
      for (int it = gw; it < 2048; it += NGW) ytr_item(a, lds + wave * 9216, it, lane3); AMP_END(34) }
}

__device__ __forceinline__ void phase_select(const Args& a, unsigned char* ldsg, int vcu, int G, bool with_ctx) {
    LAS unsigned* keys = (LAS unsigned*)(LAS unsigned char*)ldsg;
    LAS unsigned* hist = keys + 4096;
    LAS unsigned* ctl = hist + 256 + 64;
    int tid_ = threadIdx.x; asm volatile("" : "+v"(tid_));
    const int tid = tid_, lane = tid & 63; unsigned char* ws = a.ws; asm volatile("" : "+s"(ws));
    const float* AFFT = (const float*)(ws + WS_AFFT); int* ROWMAP = (int*)(ws + WS_ROWMAP); float* GATE = (float*)(ws + WS_GATE); int* INV = (int*)(ws + WS_INV);
    const int nitems = 128 + (with_ctx ? 128 : 0);
    for (int item = vcu; item < nitems; item += G) {
        int e, base, Ls, cap, slot0;
        if (item < 128) { const int b = item >> 4; e = item & 15; base = b * 4096; Ls = 4096; cap = CAPX; slot0 = b * CAPX; }
        else { const int it = item - 128; const int b = it >> 4; e = it & 15; base = TX + b * 256; Ls = 256; cap = CAPC; slot0 = NB * CAPX + b * CAPC; }
        unsigned k[8];
#pragma unroll
        for (int i = 0; i < 8; ++i) { const int idx = tid + NTHR * i; k[i] = (idx < Ls) ? __float_as_uint(AFFT[(size_t)e * TT + base + idx]) : 0u; if (idx < Ls) keys[idx] = k[i]; }
        if (tid == 0) { ctl[0] = 0u; ctl[1] = (unsigned)cap; ctl[2] = 0u; ctl[3] = 0u; }
        unsigned prefix = 0u;
#pragma unroll 1
        for (int p = 0; p < 4; ++p) { const int shift = 24 - 8 * p;
            if (tid < 256) hist[tid] = 0u;
            __syncthreads();
#pragma unroll
            for (int i = 0; i < 8; ++i) { const int idx = tid + NTHR * i; const bool cand = (idx < Ls) && (p == 0 || (k[i] >> (shift + 8)) == prefix);
                if (cand) atomicAdd((unsigned*)&hist[(k[i] >> shift) & 255u], 1u); }
            __syncthreads();
            if (tid < 64) {
                const unsigned need = ctl[1];
                const unsigned c0 = hist[255 - 4 * lane], c1 = hist[254 - 4 * lane], c2 = hist[253 - 4 * lane], c3 = hist[252 - 4 * lane];
                const unsigned s = c0 + c1 + c2 + c3;
                hist[256 + lane] = s; LDS_WAIT();
                unsigned inc = 0u;
                for (int q = 0; q < 64; ++q) { const unsigned v = hist[256 + q]; inc += (q <= lane) ? v : 0u; }
                const unsigned exc = inc - s;
                if (exc < need && inc >= need) { unsigned above = exc; int d;
                    if (above + c0 >= need) d = 255 - 4 * lane; else { above += c0; if (above + c1 >= need) d = 254 - 4 * lane; else { above += c1; if (above + c2 >= need) d = 253 - 4 * lane; else { above += c2; d = 252 - 4 * lane; } } }
                    ctl[0] = (prefix << 8) | (unsigned)d; ctl[1] = need - above; } }
            __syncthreads();
            prefix = ctl[0]; }
        const unsigned T = prefix; const unsigned need = ctl[1];
        int eqc = 0;
#pragma unroll
        for (int i = 0; i < 8; ++i) { const int idx = tid + NTHR * i; eqc += ((idx < Ls) && k[i] == T) ? 1 : 0; }
        if (eqc) atomicAdd((unsigned*)&ctl[3], (unsigned)eqc);
        __syncthreads();
        const bool all_eq = (ctl[3] == need);
#pragma unroll
        for (int i = 0; i < 8; ++i) { const int idx = tid + NTHR * i;
            if (idx < Ls && (k[i] > T || (all_eq && k[i] == T))) { const int s = (int)atomicAdd((unsigned*)&ctl[2], 1u); const int slot = e * SLOTS + slot0 + s;
                ROWMAP[slot] = base + idx; GATE[slot] = __uint_as_float(k[i]); INV[(size_t)(base + idx) * 16 + e] = slot; } }
        __syncthreads();
        if (!all_eq && tid == 0) {
            int s = (int)ctl[2]; unsigned left = need;
            for (int idx = 0; idx < Ls && left; ++idx) if (keys[idx] == T) { const int slot = e * SLOTS + slot0 + s; ROWMAP[slot] = base + idx; GATE[slot] = __uint_as_float(T); INV[(size_t)(base + idx) * 16 + e] = slot; ++s; --left; } }
        __syncthreads();
    }
}
__device__ __forceinline__ void phase_gather(const Args& a, int vcu, int G, bool with_ctx) {
    int tid_ = threadIdx.x; asm volatile("" : "+v"(tid_));
    const int tid = tid_, lane = tid & 63, wave = __builtin_amdgcn_readfirstlane(tid >> 6); unsigned char* ws = a.ws; asm volatile("" : "+s"(ws));
    const int* ROWMAP = (const int*)(ws + WS_ROWMAP); const bf16_t* HX = (const bf16_t*)(ws + WS_HX); bf16_t* XG = (bf16_t*)(ws + WS_XG);
    const int per = with_ctx ? SLOTS : NB * CAPX; const int gw = vcu * NWAVES + wave, NGW = G * NWAVES;
    for (int it = gw; it < NE * per; it += NGW) { const int e = it / per, s = it % per; const int slot = e * SLOTS + s; const int src = ROWMAP[slot];
        const u32x4* sp = (const u32x4*)(HX + (size_t)src * D) + 2 * lane; u32x4* dp = (u32x4*)(XG + (size_t)slot * D) + 2 * lane;
        const u32x4 v0 = sp[0], v1 = sp[1]; dp[0] = v0; dp[1] = v1; }
}
__device__ __forceinline__ void phase_combine(const Args& a, int vcu, int G, int l, bool with_ctx, bool final_norm, bool next_norm) {
    int tid_ = threadIdx.x; asm volatile("" : "+v"(tid_));
    const int tid = tid_, lane = tid & 63, wave = __builtin_amdgcn_readfirstlane(tid >> 6); unsigned char* ws = a.ws; asm volatile("" : "+s"(ws));
    const int* INV = (const int*)(ws + WS_INV); const bf16_t* OB = (const bf16_t*)(ws + WS_XG); const float* MOD = (const float*)(ws + WS_MOD) + (size_t)l * 9 * 6144;
    const float* MODN = (const float*)(ws + WS_MOD) + (size_t)(l + 1) * 9 * 6144; const float* gainn = a.in[I_N1G] + (l + 1) * D; bf16_t* HX = (bf16_t*)(ws + WS_HX);
    bf16_t* XB = (bf16_t*)(ws + WS_XB); const float* fng = a.in[I_FNG];
    const int nrows = with_ctx ? TT : TX; const int gw = vcu * NWAVES + wave, NGW = G * NWAVES;
    const float pz = (final_norm && __hip_atomic_load((unsigned*)(ws + WS_CTL) + 12288, __ATOMIC_RELAXED, __HIP_MEMORY_SCOPE_AGENT) != 0u) ? __builtin_nanf("") : 0.f;
    for (int rowa = gw; rowa < nrows; rowa += 2 * NGW) {
        int myinv[2]; f32x4 xv[2][4]; f32x4 acc[2][4];
#pragma unroll
        for (int u = 0; u < 2; ++u) { const int row = rowa + u * NGW; const bool ok = row < nrows; const int rr = ok ? row : rowa;
            myinv[u] = (lane < 16 && ok) ? INV[(size_t)rr * 16 + lane] : -1;
            const bf16_t* xr = XB + (size_t)rr * D;
#pragma unroll
            for (int j = 0; j < 4; ++j) { const u32x2 w = *(const u32x2*)(xr + 256 * j + 4 * lane); xv[u][j] = (f32x4){bflo(w.x), bfhi(w.x), bflo(w.y), bfhi(w.y)}; acc[u][j] = (f32x4){0.f, 0.f, 0.f, 0.f}; } }
#pragma unroll
        for (int u = 0; u < 2; ++u) {
            unsigned long long mask = __ballot(myinv[u] >= 0) & 0xffffull;
            while (mask) { int sl[4];
#pragma unroll
                for (int q = 0; q < 4; ++q) { if (mask) { const int e = __builtin_ctzll(mask); mask &= mask - 1; sl[q] = __builtin_amdgcn_readlane(myinv[u], e); } else sl[q] = -1; }
                u32x2 w[4][4];
#pragma unroll
                for (int q = 0; q < 4; ++q) { const bf16_t* orow = OB + (size_t)(sl[q] >= 0 ? sl[q] : 0) * D;
#pragma unroll
                    for (int j = 0; j < 4; ++j) w[q][j] = *(const u32x2*)(orow + 256 * j + 4 * lane); }
#pragma unroll
                for (int q = 0; q < 4; ++q) { const float m = (sl[q] >= 0) ? 1.0f : 0.0f;
#pragma unroll
                    for (int j = 0; j < 4; ++j) { acc[u][j][0] += m * bflo(w[q][j].x); acc[u][j][1] += m * bfhi(w[q][j].x); acc[u][j][2] += m * bflo(w[q][j].y); acc[u][j][3] += m * bfhi(w[q][j].y); } } } }
#pragma unroll
        for (int u = 0; u < 2; ++u) { const int row = rowa + u * NGW; if (row < nrows) {
            const bool lat = row < TX; float* xr = a.out + (size_t)row * D; bf16_t* xbr = XB + (size_t)row * D; const int mrow = lat ? (row >> 12) : 8;
            const float* gp = MOD + mrow * 6144 + 5 * 1024; f32x4 v[4]; float ss = 0.f;
#pragma unroll
            for (int j = 0; j < 4; ++j) { const f32x4 g = *(const f32x4*)(gp + 256 * j + 4 * lane); v[j] = xv[u][j] + g * acc[u][j];
                ss += (v[j][0] * v[j][0] + v[j][1] * v[j][1]) + (v[j][2] * v[j][2] + v[j][3] * v[j][3]); }
            if (final_norm) { const float rstd = 1.0f / sqrtf(wave_sum(ss) * (1.0f / D) + 1e-6f);
#pragma unroll
                for (int j = 0; j < 4; ++j) { const f32x4 g = *(const f32x4*)(fng + 256 * j + 4 * lane); *(f32x4*)(xr + 256 * j + 4 * lane) = v[j] * rstd * g + pz; } }
            else {
#pragma unroll
                for (int j = 0; j < 4; ++j) { u32x2 o; o.x = pk2(v[j][0], v[j][1]); o.y = pk2(v[j][2], v[j][3]); *(u32x2*)(xbr + 256 * j + 4 * lane) = o; }
                if (next_norm) { const float rstd = 1.0f / sqrtf(wave_sum(ss) * (1.0f / D) + 1e-6f); const float* shp = MODN + mrow * 6144; const float* scp = shp + 1024;
#pragma unroll
                    for (int j = 0; j < 4; ++j) { const f32x4 gg = *(const f32x4*)(gainn + 256 * j + 4 * lane), sh = *(const f32x4*)(shp + 256 * j + 4 * lane), sc = *(const f32x4*)(scp + 256 * j + 4 * lane);
                        const f32x4 hv = (v[j] * rstd * gg) * (1.0f + sc) + sh; u32x2 o; o.x = pk2(hv[0], hv[1]); o.y = pk2(hv[2], hv[3]); *(u32x2*)(HX + (size_t)row * D + 256 * j + 4 * lane) = o; } } } } }
    }
}

#define XBAR() do { XcdBarrier b_; b_.bar = (unsigned*)(a.ws + WS_CTL); b_.x = __builtin_amdgcn_readfirstlane(bar.x); b_.st = (volatile LAS unsigned*)((LAS unsigned char*)lds + LDS_BYTES - 16); xcd_barrier(b_); if (AMP_PHASE == 99) xcd_barrier(b_); } while (0)

__global__ void __launch_bounds__(NTHR, 2) fwd_kernel(Args a) {
    extern __shared__ __attribute__((aligned(16))) unsigned char lds[];
    cg::grid_group grid = cg::this_grid();
    const int G = gridDim.x, bx = blockIdx.x; const int vcu = (G % 8 == 0) ? (bx % 8) * (G / 8) + bx / 8 : bx;
    unsigned char* ws = a.ws;
    PG8_LAS unsigned char* glds = (PG8_LAS unsigned char*)lds;
    volatile LAS unsigned* bst = (volatile LAS unsigned*)((LAS unsigned char*)lds + LDS_BYTES - 16);
    if (threadIdx.x < 4) bst[threadIdx.x] = 0u;
    __syncthreads();
    XcdBarrier bar = xcd_barrier_post((unsigned*)(ws + WS_CTL), bst);
    { AMP_BEGIN(0) phase_prologue(a, lds, vcu, G); AMP_END(0) }
    if (a.ws == nullptr) grid.sync();
    XBAR();
    for (int l = 0; l < 2; ++l) {
        const bool upd = (l == 0);
        asm volatile("" : "+s"(ws));
        const float* srcx = a.in[I_X]; const float* srcc = a.in[I_CTX];
        if (upd) {
            { AMP_BEGIN(1) phase_norm(a, lds, vcu, G, l, srcx, srcc, nullptr, a.in[I_N1G] + l * D, 0, TT, false); AMP_END(1) }
            { AMP_BEGIN(11) load_tw(a, (LAS unsigned char*)lds, threadIdx.x); for (int it = vcu; it < 1024; it += G) spectrum_item(a, (LAS unsigned char*)lds, it, threadIdx.x); AMP_END(11) }
            XBAR();
        }
        { AMP_BEGIN(2) pg8::Gemm g{(const pg8::bf16_t*)(ws + WS_HX), (const pg8::bf16_t*)(ws + WS_WIN_T) + (size_t)l * INW * D, TT, INW, D};
          pg8::GroupOrder S; S.init(1, TT / 256, INW / 256, 0, G, bx);
          { PG8_LAS float* rl = (PG8_LAS float*)(glds + 131072 + 20480); const float* rs = (const float*)(ws + WS_ROPE); int tx = threadIdx.x; asm volatile("" : "+v"(tx)); for (int i = tx; i < 2048; i += NTHR) rl[i] = rs[i]; __syncthreads(); }
          pg8::EpiIn E{(pg8::bf16_t*)(ws + WS_PX), (const PG8_LAS float*)(glds + 131072 + 20480), (pg8::bf16_t*)(ws + WS_UT), glds + 131072, 1.0f};
          pg8::gemm_phase<pg8::EpiIn, pg8::GroupOrder, true, true>(glds, g, S, E); AMP_END(2) }
        XBAR();
        { AMP_BEGIN(3) phase_mix1(a, lds, vcu, G, l); AMP_END(3) }
        XBAR();
        { AMP_BEGIN(4) pg8::Gemm g{(const pg8::bf16_t*)(ws + WS_Y), (const pg8::bf16_t*)(ws + WS_WOUT_T) + (size_t)l * D * D, TT, D, D};
          pg8::GroupOrder S; S.init(1, (upd ? TT : TX) / 256, D / 256, 0, G, bx);
          pg8::EpiOut E{a.in[I_X], a.in[I_CTX], (pg8::bf16_t*)(ws + WS_XB), (const float*)(ws + WS_MOD) + (size_t)l * 9 * 6144, upd ? 1 : 0};
          pg8::gemm_phase<pg8::EpiOut, pg8::GroupOrder, true, true>(glds, g, S, E); AMP_END(4) }
        XBAR();
        { AMP_BEGIN(5) phase_norm(a, lds, vcu, G, l, nullptr, nullptr, (const bf16_t*)(ws + WS_XB), a.in[I_N2G] + l * D, 3, upd ? TT : TX, true); AMP_END(5) }
        XBAR();
        { AMP_BEGIN(6) phase_select(a, lds, vcu, G, upd); AMP_END(6) }
        XBAR();
        { AMP_BEGIN(8) pg8::Gemm g{(const pg8::bf16_t*)(ws + WS_HX), (const pg8::bf16_t*)(ws + WS_WGU_T + (size_t)l * NE * 4096 * D), NE * SLOTS, NE * 4096, D};
          pg8::GroupOrder S; S.init(NE, upd ? 17 : 16, 16, 17, G, bx);
          { PG8_LAS float* sl = (PG8_LAS float*)(glds + 131072 + 17408); const float* ss = (const float*)(ws + WS_WSC) + l * 48; int tx = threadIdx.x; asm volatile("" : "+v"(tx)); if (tx < 32) sl[tx] = ss[tx]; __syncthreads(); }
          pg8::EpiGU E{(unsigned char*)(ws + WS_ACT), (const PG8_LAS float*)(glds + 131072 + 17408)};
          pg8::gemm_phase_gather<pg8::EpiGU, pg8::GroupOrder, true>(glds, g, (const int*)(ws + WS_ROWMAP), (PG8_LAS int*)(glds + 131072), S, E); AMP_END(8) }
        XBAR();
        { AMP_BEGIN(9) pg8::Gemm g{(const pg8::bf16_t*)(ws + WS_ACT), (const pg8::bf16_t*)(ws + WS_WD_T + (size_t)l * NE * D * FF), NE * SLOTS, NE * D, FF};
          pg8::GroupOrder S; S.init(NE, upd ? 17 : 16, 4, 17, G, bx);
          { PG8_LAS float* gl = (PG8_LAS float*)(glds + 131072); const float* gs = (const float*)(ws + WS_GATE); const float* ss = (const float*)(ws + WS_WSC) + l * 48 + 32; pg8::Unit uu; int tx = threadIdx.x; asm volatile("" : "+v"(tx));
            for (int i = 0; S.next(i, uu); ++i) if (tx < 256) gl[i * 256 + tx] = gs[uu.pm * 256 + tx] * ss[uu.pn >> 2];
            __syncthreads(); }
          pg8::EpiDown E{(pg8::bf16_t*)(ws + WS_XG), (const PG8_LAS float*)(glds + 131072)};
          pg8::gemm_phase<pg8::EpiDown, pg8::GroupOrder, true, true, true>(glds, g, S, E); AMP_END(9) }
        XBAR();
        { AMP_BEGIN(10) phase_combine(a, vcu, G, l, upd, !upd, upd); AMP_END(10) }
        if (upd) XBAR();
    }
}

extern "C" void kernel_launch(void* const* d_in, const int* in_sizes, int n_in, void* d_out, int out_size, void* d_ws, size_t ws_size, hipStream_t stream) {
    static int grid = 0;
    if (grid == 0) {
        int dev = 0, cus = 0, per_cu = 0;
        hipGetDevice(&dev); hipDeviceGetAttribute(&cus, hipDeviceAttributeMultiprocessorCount, dev);
        if (hipFuncSetAttribute((const void*)fwd_kernel, hipFuncAttributeMaxDynamicSharedMemorySize, LDS_BYTES) != hipSuccess) { fprintf(stderr, "kernel_launch: hipFuncSetAttribute failed\n"); grid = -1; return; }
        if (hipOccupancyMaxActiveBlocksPerMultiprocessor(&per_cu, (const void*)fwd_kernel, NTHR, LDS_BYTES) != hipSuccess || per_cu < 1) { fprintf(stderr, "kernel_launch: occupancy query failed (%d)\n", per_cu); grid = -1; return; }
        grid = cus * 1;
        if (n_in != N_IN || ws_size < WS_END) { fprintf(stderr, "kernel_launch: unexpected n_in %d / ws %zu\n", n_in, ws_size); grid = -1; return; }
    }
    if (grid < 0) return;
    if (hipMemsetAsync((char*)d_ws + WS_CTL, 0, 65536, stream) != hipSuccess) { fprintf(stderr, "kernel_launch: memset failed\n"); return; }
    Args a{};
    for (int i = 0; i < N_IN; ++i) a.in[i] = (const float*)d_in[i];
    a.out = (float*)d_out; a.ws = (unsigned char*)d_ws;
    void* args[] = {&a};
    hipError_t e = hipLaunchCooperativeKernel((const void*)fwd_kernel, dim3(grid), dim3(NTHR), args, LDS_BYTES, stream);
    if (e != hipSuccess) fprintf(stderr, "cooperative launch failed: %s (grid %d)\n", hipGetErrorString(e), grid);
}
```

```cpp
#define AMP_PHASE -1
#include <hip/hip_runtime.h>
#include <hip/hip_cooperative_groups.h>
#include <cstdio>
#include <cstdint>
#ifndef AMP_PHASE
#define AMP_PHASE -1
#endif
namespace cg = cooperative_groups;
namespace pg8 {
#define PG8_LAS __attribute__((address_space(3)))
typedef unsigned short bf16_t;
typedef short bf16x8 __attribute__((ext_vector_type(8)));
typedef float f32x4 __attribute__((ext_vector_type(4)));
typedef unsigned u32x4 __attribute__((ext_vector_type(4)));
typedef int v4i_t __attribute__((ext_vector_type(4)));
typedef int v8i_t __attribute__((ext_vector_type(8)));
constexpr int BM = 256, BK = 64, HALF = 128, HTB = HALF * BK * 2  , STAGE_BYTES = 8 * HTB, NXCD = 8, WGM = 8;

__host__ __device__ __forceinline__ int lds_byte(int r, int c) { const int st = (r >> 4) * 2 + (c >> 5), rr = r & 15, cc = c & 31, ob = rr * 64 + cc * 2; return st * 1024 + (ob ^ (((ob >> 9) & 1) << 5)); }
__host__ __device__ __forceinline__ void stage_rc(int b, int& R, int& C) { const int st = b / 1024, sb = b % 1024, swz = sb ^ (((sb >> 9) & 1) << 5); R = (st >> 1) * 16 + swz / 64; C = (st & 1) * 32 + (swz % 64) / 2; }
__host__ __device__ __forceinline__ int perm32(int rho) { const int n = rho >> 4, i = rho & 15; return 8 * (i >> 2) + 4 * n + (i & 3); }

struct Unit { int pm, pn; };
struct Gemm { const bf16_t* A; const bf16_t* Bt; int M, N, K; };

struct StaticOrder {
    int nM, nN, nwg, G, c;
    __host__ __device__ void init(int M, int N, int G_, int c_) { nM = M / BM; nN = N / BM; nwg = nM * nN; G = G_; c = c_; }
    __host__ __device__ bool next(int i, Unit& u) const {
        const long L = (long)i * G + c; if (L >= nwg) return false;
        int wgid = (int)L; { const int q = nwg / NXCD, r = nwg % NXCD, xcd = wgid % NXCD, off = wgid / NXCD; wgid = (xcd < r ? xcd * (q + 1) : r * (q + 1) + (xcd - r) * q) + off; }
        const int nig = WGM * nN, gid = wgid / nig, fm = gid * WGM, gsz = (nM - fm) < WGM ? (nM - fm) : WGM;
        u.pm = fm + ((wgid % nig) % gsz); u.pn = (wgid % nig) / gsz; return true;
    }
    __device__ __forceinline__ void a_ready(const Unit&) const {}
    __device__ __forceinline__ void done(const Unit&) const {}
};

__device__ __forceinline__ unsigned cvt_pk_bf16(float lo, float hi) { unsigned r; asm volatile("v_cvt_pk_bf16_f32 %0, %1, %2" : "=v"(r) : "v"(lo), "v"(hi)); return r; }
typedef float f32x2 __attribute__((ext_vector_type(2)));
__device__ __forceinline__ f32x2 gelu_pk(f32x2 v) {
    const f32x2 av = __builtin_elementwise_abs(v), d = av * 0.2316418882f + 1.0f;
    f32x2 t; t.x = __builtin_amdgcn_rcpf(d.x); t.y = __builtin_amdgcn_rcpf(d.y);
    f32x2 q = t * 0.5307027145f + (-0.7265760135f); q = q * t + 0.7107068705f; q = q * t + (-0.142248368f); q = q * t + 0.127414796f; q = q * t;
    const f32x2 s = (v * v) * (-0.72134752044f);
    f32x2 e; e.x = __builtin_amdgcn_exp2f(s.x); e.y = __builtin_amdgcn_exp2f(s.y);
    const f32x2 m = v * (q * e), r = v - m;
    f32x2 o; o.x = v.x < 0.f ? m.x : r.x; o.y = v.y < 0.f ? m.y : r.y; return o;
}


struct GroupOrder {
    int nMl, nNl, strideM, nper, nwg, G, c;
    __device__ __forceinline__ void init(int ng, int nMl_, int nNl_, int strideM_, int G_, int c_) { nMl = nMl_; nNl = nNl_; strideM = strideM_; nper = nMl_ * nNl_; nwg = ng * nper; G = G_; c = c_; }
    __device__ __forceinline__ bool next(int i, Unit& u) const {
        const long L = (long)i * G + c; if (L >= nwg) return false;
        int wgid = (int)L; { const int q = nwg / NXCD, r = nwg % NXCD, xcd = wgid % NXCD, off = wgid / NXCD; wgid = (xcd < r ? xcd * (q + 1) : r * (q + 1) + (xcd - r) * q) + off; }
        const int e = wgid / nper, id = wgid % nper;
        const int nig = WGM * nNl, gid = id / nig, fm = gid * WGM, gsz = (nMl - fm) < WGM ? (nMl - fm) : WGM;
        u.pm = e * strideM + fm + ((id % nig) % gsz); u.pn = e * nNl + (id % nig) / gsz; return true;
    }
    __device__ __forceinline__ void a_ready(const Unit&) const {}
    __device__ __forceinline__ void done(const Unit&) const {}
};

constexpr int TXR = 32768;
struct EpiIn {
    static constexpr bool PERM = true, AFTER_DRAIN = false;
    bf16_t* PX; const PG8_LAS float* rope; bf16_t* UT; PG8_LAS unsigned char* stgbase; float wsc;
    __device__ __forceinline__ void operator()(const f32x4 (&acc)[2][2][4][2], const Unit& u, int ui, int wr, int wc, int fr, int fq) const {
        const int row0 = u.pm * BM + wr * 64 + fr; const int col0 = u.pn * BM + wc * 32 + 8 * fq;
        const bool latent = u.pm < (TXR / BM);
        if (latent && u.pn < 3) {
            PG8_LAS unsigned char* stg = stgbase + (wr * 4 + wc) * 2304; const int lane = fq * 16 + fr;
            const int b = u.pm >> 4, trow0 = (u.pm & 15) * BM; const int col = lane >> 1, half = lane & 1;
#pragma unroll
            for (int ai = 0; ai < 2; ++ai)
#pragma unroll
                for (int bj = 0; bj < 2; ++bj)
#pragma unroll
                    for (int mh = 0; mh < 2; ++mh) {
#pragma unroll
                        for (int mm = 0; mm < 2; ++mm)
#pragma unroll
                            for (int n = 0; n < 2; ++n) { const f32x4 v = acc[ai][bj][2 * mh + mm][n] * wsc; const unsigned w0 = cvt_pk_bf16(v[0], v[1]), w1 = cvt_pk_bf16(v[2], v[3]);
                                PG8_LAS unsigned char* p = stg + (8 * fq + 4 * n) * 72 + (16 * mm + fr) * 2;
                                *(PG8_LAS unsigned short*)(p) = (unsigned short)w0; *(PG8_LAS unsigned short*)(p + 72) = (unsigned short)(w0 >> 16);
                                *(PG8_LAS unsigned short*)(p + 144) = (unsigned short)w1; *(PG8_LAS unsigned short*)(p + 216) = (unsigned short)(w1 >> 16); }
                        asm volatile("s_waitcnt lgkmcnt(0)" ::: "memory");
                        typedef unsigned u32x2v __attribute__((ext_vector_type(2)));
                        const PG8_LAS unsigned char* rp = stg + col * 72 + half * 32;
                        const u32x2v a0 = *(const PG8_LAS u32x2v*)(rp), a1 = *(const PG8_LAS u32x2v*)(rp + 8), a2 = *(const PG8_LAS u32x2v*)(rp + 16), a3 = *(const PG8_LAS u32x2v*)(rp + 24);
                        const int ch = u.pn * BM + bj * HALF + wc * 32 + col; const int t0 = trow0 + ai * HALF + wr * 64 + mh * 32 + half * 16;
                        u32x4* gp = (u32x4*)(UT + ((size_t)(b * 768 + ch)) * 4096 + t0);
                        gp[0] = (u32x4){a0.x, a0.y, a1.x, a1.y}; gp[1] = (u32x4){a2.x, a2.y, a3.x, a3.y};
                        asm volatile("s_waitcnt lgkmcnt(0)" ::: "memory"); }
            return;
        }
#pragma unroll
        for (int ai = 0; ai < 2; ++ai)
#pragma unroll
            for (int m = 0; m < 4; ++m) { const int row = row0 + ai * HALF + m * 16; bf16_t* rowp = PX + (size_t)row * 2304 + col0;
#pragma unroll
                for (int bj = 0; bj < 2; ++bj) { f32x4 v0 = acc[ai][bj][m][0] * wsc, v1 = acc[ai][bj][m][1] * wsc;
                    const bool dorope = latent && (u.pn == 4 || (u.pn == 6 && bj == 0));
                    if (dorope) {
                        const int t = row & 4095; const int pos = (wc & 1) ? (t & 63) : (t >> 6);
                        const PG8_LAS f32x4* rp = (const PG8_LAS f32x4*)(rope + (pos * 16 + 8 * (fq & 1)) * 2);
                        const f32x4 r0 = rp[0], r1 = rp[1], r2 = rp[2], r3 = rp[3];
                        f32x4 p0, p1;
#pragma unroll
                        for (int j = 0; j < 4; ++j) { auto r0_ = __builtin_amdgcn_permlane32_swap(__float_as_uint(v0[j]), __float_as_uint(v0[j]), false, false); auto r1_ = __builtin_amdgcn_permlane32_swap(__float_as_uint(v1[j]), __float_as_uint(v1[j]), false, false);
                            p0[j] = __uint_as_float(fq < 2 ? r0_[1] : r0_[0]); p1[j] = __uint_as_float(fq < 2 ? r1_[1] : r1_[0]); }
                        const float c0[4] = {r0[0], r0[2], r1[0], r1[2]}, s0[4] = {r0[1], r0[3], r1[1], r1[3]};
                        const float c1[4] = {r2[0], r2[2], r3[0], r3[2]}, s1[4] = {r2[1], r2[3], r3[1], r3[3]};
                        const bool lo = fq < 2;
#pragma unroll
                        for (int j = 0; j < 4; ++j) {
                            v0[j] = lo ? (v0[j] * c0[j] - p0[j] * s0[j]) : (p0[j] * s0[j] + v0[j] * c0[j]);
                            v1[j] = lo ? (v1[j] * c1[j] - p1[j] * s1[j]) : (p1[j] * s1[j] + v1[j] * c1[j]); }
                    }
                    u32x4 w; w.x = cvt_pk_bf16(v0[0], v0[1]); w.y = cvt_pk_bf16(v0[2], v0[3]); w.z = cvt_pk_bf16(v1[0], v1[1]); w.w = cvt_pk_bf16(v1[2], v1[3]);
                    *(u32x4*)(rowp + bj * HALF) = w; } }
    }
};
struct EpiOut {
    static constexpr bool PERM = true, AFTER_DRAIN = false;
    const float* xf_x; const float* xf_c; bf16_t* XB; const float* mod; int from_f32;
    __device__ __forceinline__ void operator()(const f32x4 (&acc)[2][2][4][2], const Unit& u, int ui, int wr, int wc, int fr, int fq) const {
        const int row0 = u.pm * BM + wr * 64 + fr, col0 = u.pn * BM + wc * 32 + 8 * fq;
        const bool latent = u.pm < (TXR / BM);
#pragma unroll
        for (int ai = 0; ai < 2; ++ai)
#pragma unroll
            for (int m = 0; m < 4; ++m) { const int row = row0 + ai * HALF + m * 16;
                const int mrow = latent ? (row >> 12) : 8; const float* gp = mod + mrow * 6144 + 2 * 1024 + col0;
                bf16_t* xb = XB + (size_t)row * 1024 + col0;
#pragma unroll
                for (int bj = 0; bj < 2; ++bj) { const f32x4 g0 = *(const f32x4*)(gp + bj * HALF), g1 = *(const f32x4*)(gp + bj * HALF + 4); f32x4 x0, x1;
                    if (from_f32) { const float* xo = (latent ? xf_x + (size_t)row * 1024 : xf_c + (size_t)(row - TXR) * 1024) + col0 + bj * HALF; x0 = *(const f32x4*)xo; x1 = *(const f32x4*)(xo + 4); }
                    else { const u32x4 w = *(const u32x4*)(xb + bj * HALF); x0 = (f32x4){__uint_as_float(w.x << 16), __uint_as_float(w.x & 0xffff0000u), __uint_as_float(w.y << 16), __uint_as_float(w.y & 0xffff0000u)};
                        x1 = (f32x4){__uint_as_float(w.z << 16), __uint_as_float(w.z & 0xffff0000u), __uint_as_float(w.w << 16), __uint_as_float(w.w & 0xffff0000u)}; }
                    const f32x4 v0 = x0 + g0 * acc[ai][bj][m][0], v1 = x1 + g1 * acc[ai][bj][m][1];
                    u32x4 o; o.x = cvt_pk_bf16(v0[0], v0[1]); o.y = cvt_pk_bf16(v0[2], v0[3]); o.z = cvt_pk_bf16(v1[0], v1[1]); o.w = cvt_pk_bf16(v1[2], v1[3]);
                    *(u32x4*)(xb + bj * HALF) = o; } }
    }
};
struct EpiGU {
    static constexpr bool PERM = true, AFTER_DRAIN = false;
    unsigned char* ACT; const PG8_LAS float* wsc;
    __device__ __forceinline__ void operator()(const f32x4 (&acc)[2][2][4][2], const Unit& u, int ui, int wr, int wc, int fr, int fq) const {
        const int row0 = u.pm * BM + wr * 64 + fr; const int col0 = (u.pn & 15) * 128 + wc * 32 + 8 * fq; const int e = u.pn >> 4; const float sg = wsc[e], su = wsc[16 + e]; const float nsl = -1.4426950408889634f * sg, sgu = sg * su;
#pragma unroll
        for (int ai = 0; ai < 2; ++ai)
#pragma unroll
            for (int m = 0; m < 4; ++m) { unsigned char* rowp = ACT + (size_t)(row0 + ai * HALF + m * 16) * 2048 + col0;
                float h[8];
#pragma unroll
                for (int n = 0; n < 2; ++n)
#pragma unroll
                    for (int j = 0; j < 4; ++j) { const float ag = acc[ai][0][m][n][j], au = acc[ai][1][m][n][j]; const float r = __builtin_amdgcn_rcpf(1.0f + __builtin_amdgcn_exp2f(ag * nsl)); h[4 * n + j] = __builtin_amdgcn_fmed3f((ag * au) * sgu * r, -448.0f, 448.0f); }
                int p0 = 0, p1 = 0;
                p0 = __builtin_amdgcn_cvt_pk_fp8_f32(h[0], h[1], p0, false); p0 = __builtin_amdgcn_cvt_pk_fp8_f32(h[2], h[3], p0, true);
                p1 = __builtin_amdgcn_cvt_pk_fp8_f32(h[4], h[5], p1, false); p1 = __builtin_amdgcn_cvt_pk_fp8_f32(h[6], h[7], p1, true);
                typedef int i32x2v __attribute__((ext_vector_type(2)));
                *(i32x2v*)rowp = (i32x2v){p0, p1}; }
    }
};
struct EpiDown {
    static constexpr bool PERM = true, AFTER_DRAIN = false;
    bf16_t* OB; const PG8_LAS float* gl;
    __device__ __forceinline__ void operator()(const f32x4 (&acc)[2][2][4][2], const Unit& u, int ui, int wr, int wc, int fr, int fq) const {
        const int row0 = u.pm * BM + wr * 64 + fr; const int col0 = (u.pn & 3) * BM + wc * 32 + 8 * fq;
#pragma unroll
        for (int ai = 0; ai < 2; ++ai)
#pragma unroll
            for (int m = 0; m < 4; ++m) { const int row = row0 + ai * HALF + m * 16; const float g = gl[ui * BM + ai * HALF + wr * 64 + m * 16 + fr]; bf16_t* rowp = OB + (size_t)row * 1024 + col0;
#pragma unroll
                for (int bj = 0; bj < 2; ++bj) { const f32x4 v0 = acc[ai][bj][m][0] * g, v1 = acc[ai][bj][m][1] * g;
                    u32x4 w; w.x = cvt_pk_bf16(v0[0], v0[1]); w.y = cvt_pk_bf16(v0[2], v0[3]); w.z = cvt_pk_bf16(v1[0], v1[1]); w.w = cvt_pk_bf16(v1[2], v1[3]);
                    *(u32x4*)(rowp + bj * HALF) = w; } }
    }
};

template <class Epi, class Sched, bool ALIGN_EPI = false, bool SP2 = false, bool FP8 = false>
__device__ __forceinline__ void gemm_phase(PG8_LAS unsigned char* lds, const Gemm g, const Sched& S, const Epi& E) {
    int tid_ = threadIdx.x; asm volatile("" : "+v"(tid_));
    const int tid = tid_, wid = __builtin_amdgcn_readfirstlane(tid >> 6), lane = tid & 63, wr = wid >> 2, wc = wid & 3, fr = lane & 15, fq = lane >> 4;
    const int K = g.K, KB = FP8 ? K : 2 * K  , nt = KB / (BK * 2);
    unsigned voffA[2], voffB[2];
#pragma unroll
    for (int i = 0; i < 2; ++i) { int R, C; stage_rc(tid * 16 + i * 8192, R, C); const int Rb = Epi::PERM ? ((R & ~31) + perm32(R & 31)) : R;
        voffA[i] = (unsigned)(R * KB + C * 2); voffB[i] = (unsigned)(Rb * KB + C * 2); }
    const size_t kstep = (size_t)(BK * 2);
    const size_t hstep = (size_t)HALF * KB;
    const size_t tstep = 2 * hstep;
    const unsigned ldsw = (unsigned)wid * 1024u;
    const int aoff = lds_byte(wr * 64 + fr, fq * 8), boff = lds_byte(wc * 32 + fr, fq * 8);
#define PG8_SA(b, h) (((b) * 2 + (h)) * HTB)
#define PG8_SB(b, h) ((4 + (b) * 2 + (h)) * HTB)
#define PG8_STAGE(bufoff, gbase, voff) do { _Pragma("unroll") for (int _i = 0; _i < 2; ++_i) \
        __builtin_amdgcn_global_load_lds((const unsigned*)((const char*)(gbase) + (voff)[_i]), (PG8_LAS unsigned*)(lds + (bufoff) + ldsw + _i * 8192), 16, 0, 0); } while (0)
#define PG8_LDA(dst, b, h) do { _Pragma("unroll") for (int m = 0; m < 4; ++m) { if constexpr (FP8) { dst##8[m].lo = *(const PG8_LAS v4i_t*)(lds + PG8_SA(b, h) + aoff + m * 2048); dst##8[m].hi = *(const PG8_LAS v4i_t*)(lds + PG8_SA(b, h) + aoff + m * 2048 + 1024); } \
        else { _Pragma("unroll") for (int k = 0; k < 2; ++k) dst[m][k] = *(const PG8_LAS bf16x8*)(lds + PG8_SA(b, h) + aoff + m * 2048 + k * 1024); } } } while (0)
#define PG8_LDB(dst, b, h) do { _Pragma("unroll") for (int n = 0; n < 2; ++n) { if constexpr (FP8) { dst##8[n].lo = *(const PG8_LAS v4i_t*)(lds + PG8_SB(b, h) + boff + n * 2048); dst##8[n].hi = *(const PG8_LAS v4i_t*)(lds + PG8_SB(b, h) + boff + n * 2048 + 1024); } \
        else { _Pragma("unroll") for (int k = 0; k < 2; ++k) dst[n][k] = *(const PG8_LAS bf16x8*)(lds + PG8_SB(b, h) + boff + n * 2048 + k * 1024); } } } while (0)
#define PG8_CAT8(x0, x1) __builtin_shufflevector(__builtin_bit_cast(v4i_t, x0), __builtin_bit_cast(v4i_t, x1), 0, 1, 2, 3, 4, 5, 6, 7)
#define PG8_MMA(ai, bj, At, Bt) do { __builtin_amdgcn_s_setprio(1); if constexpr (FP8) asm volatile("s_nop 1" ::: "memory"); _Pragma("unroll") for (int m = 0; m < 4; ++m) _Pragma("unroll") for (int n = 0; n < 2; ++n) { \
        if constexpr (FP8) { asm volatile("v_mfma_scale_f32_16x16x128_f8f6f4 %0, %1, %2, %0, %3, %3 op_sel_hi:[0,0,0]" : "+v"(acc[ai][bj][m][n]) : "v"(Bt##8[n]), "v"(At##8[m]), "v"(one_scale)); } \
        else { _Pragma("unroll") for (int k = 0; k < 2; ++k) acc[ai][bj][m][n] = __builtin_amdgcn_mfma_f32_16x16x32_bf16(Bt[n][k], At[m][k], acc[ai][bj][m][n], 0, 0, 0); } } if constexpr (FP8) asm volatile("s_nop 15\n\ts_nop 3" ::: "memory"); __builtin_amdgcn_s_setprio(0); } while (0)
#define PG8_WAIT_V(n) asm volatile("s_waitcnt vmcnt(" #n ")" ::: "memory")
#define PG8_WAIT_L(n) asm volatile("s_waitcnt lgkmcnt(" #n ")" ::: "memory")
#define PG8_BAR __builtin_amdgcn_s_barrier()
#define PG8_SCHED __builtin_amdgcn_sched_barrier(0)
    Unit cur, nxt; int ui = 0;
    if (!S.next(0, cur)) return;
    f32x4 acc[2][2][4][2];
#pragma unroll
    for (int a = 0; a < 2; ++a)
#pragma unroll
        for (int b = 0; b < 2; ++b)
#pragma unroll
            for (int m = 0; m < 4; ++m)
#pragma unroll
                for (int n = 0; n < 2; ++n) acc[a][b][m][n] = (f32x4){0.f, 0.f, 0.f, 0.f};
    bf16x8 At[4][2], B0[2][2], B1[2][2];
    v8i_t At8[4], B08[2], B18[2];
    int one_scale = 0x7f7f7f7f; asm volatile("" : "+v"(one_scale));
    const char* cA = (const char*)g.A + (size_t)cur.pm * tstep; const char* cB = (const char*)g.Bt + (size_t)cur.pn * tstep;
    S.a_ready(cur);
    if constexpr (SP2) {
        PG8_STAGE(PG8_SB(0, 0), cB, voffB); PG8_STAGE(PG8_SB(0, 1), cB + hstep, voffB); PG8_STAGE(PG8_SA(0, 0), cA, voffA); PG8_STAGE(PG8_SA(0, 1), cA + hstep, voffA);
        if (wr == 1) PG8_BAR;
        PG8_WAIT_V(2); PG8_BAR;
        PG8_STAGE(PG8_SB(1, 0), cB + kstep, voffB); PG8_STAGE(PG8_SA(1, 0), cA + kstep, voffA); PG8_STAGE(PG8_SB(1, 1), cB + hstep + kstep, voffB);
        PG8_WAIT_V(6); PG8_BAR;
    } else {
        PG8_STAGE(PG8_SB(0, 0), cB, voffB); PG8_STAGE(PG8_SA(0, 0), cA, voffA); PG8_STAGE(PG8_SB(0, 1), cB + hstep, voffB); PG8_STAGE(PG8_SA(0, 1), cA + hstep, voffA);
        if (wr == 1) PG8_BAR;
        PG8_WAIT_V(4); PG8_BAR;
        PG8_STAGE(PG8_SB(1, 0), cB + kstep, voffB); PG8_STAGE(PG8_SA(1, 0), cA + kstep, voffA); PG8_STAGE(PG8_SB(1, 1), cB + hstep + kstep, voffB);
        PG8_WAIT_V(6); PG8_BAR;
    }
    for (;;) {
        const bool has_next = S.next(ui + 1, nxt);
        const char* nA = has_next ? (const char*)g.A + (size_t)nxt.pm * tstep : cA; const char* nB = has_next ? (const char*)g.Bt + (size_t)nxt.pn * tstep : cB;
#pragma nounroll
        for (int t = 0; t < nt; t += 2) {
            const bool last = (t == nt - 2);
            const char* a1 = cA + (size_t)(t + 1) * kstep;
            const char* a2 = last ? nA : cA + (size_t)(t + 2) * kstep; const char* b2 = last ? nB : cB + (size_t)(t + 2) * kstep;
            const char* a3 = a2 + kstep; const char* b3 = b2 + kstep;
            if (last && has_next) S.a_ready(nxt);
            if constexpr (SP2) {
            PG8_LDB(B0, 0, 0); PG8_LDB(B1, 0, 1); PG8_SCHED; PG8_LDA(At, 0, 0); PG8_STAGE(PG8_SA(1, 1), a1 + hstep, voffA);
            PG8_WAIT_V(8); PG8_WAIT_L(0); PG8_BAR; PG8_MMA(0, 0, At, B0); PG8_MMA(0, 1, At, B1); PG8_BAR; PG8_SCHED;
            PG8_LDA(At, 0, 1); PG8_STAGE(PG8_SB(0, 0), b2, voffB); PG8_STAGE(PG8_SB(0, 1), b2 + hstep, voffB); PG8_STAGE(PG8_SA(0, 0), a2, voffA);
            PG8_WAIT_V(8); PG8_WAIT_L(0); PG8_BAR; PG8_MMA(1, 0, At, B0); PG8_MMA(1, 1, At, B1); PG8_BAR; PG8_SCHED;
            PG8_LDB(B0, 1, 0); PG8_LDB(B1, 1, 1); PG8_SCHED; PG8_LDA(At, 1, 0); PG8_STAGE(PG8_SA(0, 1), a2 + hstep, voffA);
            PG8_WAIT_V(8); PG8_WAIT_L(0); PG8_BAR; PG8_MMA(0, 0, At, B0); PG8_MMA(0, 1, At, B1); PG8_BAR; PG8_SCHED;
            PG8_LDA(At, 1, 1); PG8_STAGE(PG8_SB(1, 0), b3, voffB); PG8_STAGE(PG8_SB(1, 1), b3 + hstep, voffB); PG8_STAGE(PG8_SA(1, 0), a3, voffA);
            PG8_WAIT_V(8); PG8_WAIT_L(0); PG8_BAR; PG8_MMA(1, 0, At, B0); PG8_MMA(1, 1, At, B1); PG8_BAR; PG8_SCHED;
            } else {
            PG8_LDB(B0, 0, 0); PG8_SCHED; PG8_LDA(At, 0, 0); PG8_STAGE(PG8_SA(1, 1), a1 + hstep, voffA);
            PG8_WAIT_L(8); PG8_BAR; PG8_WAIT_L(0); PG8_MMA(0, 0, At, B0); PG8_BAR; PG8_SCHED;
            PG8_LDB(B1, 0, 1); PG8_STAGE(PG8_SB(0, 0), b2, voffB);
            PG8_BAR; PG8_WAIT_L(0); PG8_MMA(0, 1, At, B1); PG8_BAR;
            PG8_LDA(At, 0, 1); PG8_STAGE(PG8_SA(0, 0), a2, voffA);
            PG8_BAR; PG8_WAIT_L(0); PG8_MMA(1, 0, At, B0); PG8_BAR; PG8_SCHED;
            PG8_STAGE(PG8_SB(0, 1), b2 + hstep, voffB);
            PG8_WAIT_V(6); PG8_BAR; PG8_MMA(1, 1, At, B1); PG8_BAR;
            PG8_LDB(B0, 1, 0); PG8_SCHED; PG8_LDA(At, 1, 0); PG8_STAGE(PG8_SA(0, 1), a2 + hstep, voffA);
            PG8_WAIT_L(8); PG8_BAR; PG8_WAIT_L(0); PG8_MMA(0, 0, At, B0); PG8_BAR; PG8_SCHED;
            PG8_LDB(B1, 1, 1); PG8_STAGE(PG8_SB(1, 0), b3, voffB);
            PG8_BAR; PG8_WAIT_L(0); PG8_MMA(0, 1, At, B1); PG8_BAR;
            PG8_LDA(At, 1, 1); PG8_STAGE(PG8_SA(1, 0), a3, voffA);
            PG8_BAR; PG8_WAIT_L(0); PG8_MMA(1, 0, At, B0); PG8_BAR; PG8_SCHED;
            PG8_STAGE(PG8_SB(1, 1), b3 + hstep, voffB);
            PG8_WAIT_V(6); PG8_BAR; PG8_MMA(1, 1, At, B1); PG8_BAR;
            }
        }
        if constexpr (ALIGN_EPI) { if (wr == 0) PG8_BAR; }
        if constexpr (!Epi::AFTER_DRAIN) { E(acc, cur, ui, wr, wc, fr, fq); S.done(cur); }
        if (!has_next) break;
#pragma unroll
        for (int a = 0; a < 2; ++a)
#pragma unroll
            for (int b = 0; b < 2; ++b)
#pragma unroll
                for (int m = 0; m < 4; ++m)
#pragma unroll
                    for (int n = 0; n < 2; ++n) acc[a][b][m][n] = (f32x4){0.f, 0.f, 0.f, 0.f};
        cur = nxt; cA = nA; cB = nB; ++ui;
        if constexpr (ALIGN_EPI) { if (wr == 1) PG8_BAR; }
    }
    PG8_WAIT_V(0);
    if constexpr (!ALIGN_EPI) { if (wr == 0) PG8_BAR; }
    PG8_BAR;
    if constexpr (Epi::AFTER_DRAIN) { E.fused(acc, cur, wr, wc, fr, fq, lds, wid, lane); S.done(cur); }
#undef PG8_SA
#undef PG8_SB
#undef PG8_STAGE
#undef PG8_LDA
#undef PG8_LDB
#undef PG8_MMA
#undef PG8_CAT8
#undef PG8_WAIT_V
#undef PG8_WAIT_L
#undef PG8_BAR
#undef PG8_SCHED
}
template <class Epi, class Sched, bool FP8 = false>
__device__ __forceinline__ void gemm_phase_gather(PG8_LAS unsigned char* lds, const Gemm g, const int* rowmap, PG8_LAS int* idxs, const Sched& S, const Epi& E) {
    constexpr bool ALIGN_EPI = true, SP2 = true;
    int tid_ = threadIdx.x; asm volatile("" : "+v"(tid_));
    const int tid = tid_, wid = __builtin_amdgcn_readfirstlane(tid >> 6), lane = tid & 63, wr = wid >> 2, wc = wid & 3, fr = lane & 15, fq = lane >> 4;
    const int K = g.K, KB = FP8 ? K : 2 * K  , nt = KB / (BK * 2);
    unsigned voffB[2]; int RA[2], CA[2];
#pragma unroll
    for (int i = 0; i < 2; ++i) { int R, C; stage_rc(tid * 16 + i * 8192, R, C); const int Rb = Epi::PERM ? ((R & ~31) + perm32(R & 31)) : R;
        RA[i] = R; CA[i] = C * 2; voffB[i] = (unsigned)(Rb * KB + C * 2); }
    const size_t kstep = (size_t)(BK * 2);
    const size_t hstep = (size_t)HALF * KB;
    const size_t tstep = 2 * hstep;
    const unsigned ldsw = (unsigned)wid * 1024u;
    const int aoff = lds_byte(wr * 64 + fr, fq * 8), boff = lds_byte(wc * 32 + fr, fq * 8);
#define PG8_SA(b, h) (((b) * 2 + (h)) * HTB)
#define PG8_SB(b, h) ((4 + (b) * 2 + (h)) * HTB)
#define PG8_STAGE(bufoff, gbase, voff) do { _Pragma("unroll") for (int _i = 0; _i < 2; ++_i) \
        __builtin_amdgcn_global_load_lds((const unsigned*)((const char*)(gbase) + (voff)[_i]), (PG8_LAS unsigned*)(lds + (bufoff) + ldsw + _i * 8192), 16, 0, 0); } while (0)
#define PG8_STAGE_AG(bufoff, P, h, koff) do { _Pragma("unroll") for (int _i = 0; _i < 2; ++_i) \
        __builtin_amdgcn_global_load_lds((const unsigned*)((const char*)g.A + (size_t)((P)[h][_i] + (unsigned)(koff))), (PG8_LAS unsigned*)(lds + (bufoff) + ldsw + _i * 8192), 16, 0, 0); } while (0)
#define PG8_ROWPTR(P, u) do { _Pragma("unroll") for (int _h = 0; _h < 2; ++_h) _Pragma("unroll") for (int _i = 0; _i < 2; ++_i) \
        (P)[_h][_i] = (unsigned)idxs[(u) * BM + _h * HALF + RA[_i]] * (unsigned)KB + (unsigned)CA[_i]; } while (0)
#define PG8_LDA(dst, b, h) do { _Pragma("unroll") for (int m = 0; m < 4; ++m) { if constexpr (FP8) { dst##8[m].lo = *(const PG8_LAS v4i_t*)(lds + PG8_SA(b, h) + aoff + m * 2048); dst##8[m].hi = *(const PG8_LAS v4i_t*)(lds + PG8_SA(b, h) + aoff + m * 2048 + 1024); } \
        else { _Pragma("unroll") for (int k = 0; k < 2; ++k) dst[m][k] = *(const PG8_LAS bf16x8*)(lds + PG8_SA(b, h) + aoff + m * 2048 + k * 1024); } } } while (0)
#define PG8_LDB(dst, b, h) do { _Pragma("unroll") for (int n = 0; n < 2; ++n) { if constexpr (FP8) { dst##8[n].lo = *(const PG8_LAS v4i_t*)(lds + PG8_SB(b, h) + boff + n * 2048); dst##8[n].hi = *(const PG8_LAS v4i_t*)(lds + PG8_SB(b, h) + boff + n * 2048 + 1024); } \
        else { _Pragma("unroll") for (int k = 0; k < 2; ++k) dst[n][k] = *(const PG8_LAS bf16x8*)(lds + PG8_SB(b, h) + boff + n * 2048 + k * 1024); } } } while (0)
#define PG8_CAT8(x0, x1) __builtin_shufflevector(__builtin_bit_cast(v4i_t, x0), __builtin_bit_cast(v4i_t, x1), 0, 1, 2, 3, 4, 5, 6, 7)
#define PG8_MMA(ai, bj, At, Bt) do { __builtin_amdgcn_s_setprio(1); if constexpr (FP8) asm volatile("s_nop 1" ::: "memory"); _Pragma("unroll") for (int m = 0; m < 4; ++m) _Pragma("unroll") for (int n = 0; n < 2; ++n) { \
        if constexpr (FP8) { asm volatile("v_mfma_scale_f32_16x16x128_f8f6f4 %0, %1, %2, %0, %3, %3 op_sel_hi:[0,0,0]" : "+v"(acc[ai][bj][m][n]) : "v"(Bt##8[n]), "v"(At##8[m]), "v"(one_scale)); } \
        else { _Pragma("unroll") for (int k = 0; k < 2; ++k) acc[ai][bj][m][n] = __builtin_amdgcn_mfma_f32_16x16x32_bf16(Bt[n][k], At[m][k], acc[ai][bj][m][n], 0, 0, 0); } } if constexpr (FP8) asm volatile("s_nop 15\n\ts_nop 3" ::: "memory"); __builtin_amdgcn_s_setprio(0); } while (0)
#define PG8_WAIT_V(n) asm volatile("s_waitcnt vmcnt(" #n ")" ::: "memory")
#define PG8_WAIT_L(n) asm volatile("s_waitcnt lgkmcnt(" #n ")" ::: "memory")
#define PG8_BAR __builtin_amdgcn_s_barrier()
#define PG8_SCHED __builtin_amdgcn_sched_barrier(0)
    Unit cur, nxt; int ui = 0;
    if (!S.next(0, cur)) return;
    f32x4 acc[2][2][4][2];
#pragma unroll
    for (int a = 0; a < 2; ++a)
#pragma unroll
        for (int b = 0; b < 2; ++b)
#pragma unroll
            for (int m = 0; m < 4; ++m)
#pragma unroll
                for (int n = 0; n < 2; ++n) acc[a][b][m][n] = (f32x4){0.f, 0.f, 0.f, 0.f};
    bf16x8 At[4][2], B0[2][2], B1[2][2];
    v8i_t At8[4], B08[2], B18[2];
    int one_scale = 0x7f7f7f7f; asm volatile("" : "+v"(one_scale));
    const char* cB = (const char*)g.Bt + (size_t)cur.pn * tstep;
    unsigned cP[2][2], nP[2][2];
    { Unit uu; for (int i = 0; S.next(i, uu); ++i) if (tid < BM) idxs[i * BM + tid] = rowmap[uu.pm * BM + tid]; }
    asm volatile("s_waitcnt vmcnt(0) lgkmcnt(0)" ::: "memory"); __builtin_amdgcn_s_barrier(); asm volatile("" ::: "memory");
    PG8_ROWPTR(cP, 0);
    S.a_ready(cur);
    if constexpr (SP2) {
        PG8_STAGE(PG8_SB(0, 0), cB, voffB); PG8_STAGE(PG8_SB(0, 1), cB + hstep, voffB); PG8_STAGE_AG(PG8_SA(0, 0), cP, 0, 0); PG8_STAGE_AG(PG8_SA(0, 1), cP, 1, 0);
        if (wr == 1) PG8_BAR;
        PG8_WAIT_V(2); PG8_BAR;
        PG8_STAGE(PG8_SB(1, 0), cB + kstep, voffB); PG8_STAGE_AG(PG8_SA(1, 0), cP, 0, kstep); PG8_STAGE(PG8_SB(1, 1), cB + hstep + kstep, voffB);
        PG8_WAIT_V(6); PG8_BAR;
    }
    for (;;) {
        const bool has_next = S.next(ui + 1, nxt);
        const char* nB = has_next ? (const char*)g.Bt + (size_t)nxt.pn * tstep : cB;
        if (has_next) { PG8_ROWPTR(nP, ui + 1); } else { _Pragma("unroll") for (int _h = 0; _h < 2; ++_h) _Pragma("unroll") for (int _i = 0; _i < 2; ++_i) nP[_h][_i] = cP[_h][_i]; }
#pragma nounroll
        for (int t = 0; t < nt; t += 2) {
            const bool last = (t == nt - 2);
            const size_t k1 = (size_t)(t + 1) * kstep, k2 = last ? 0 : (size_t)(t + 2) * kstep, k3 = k2 + kstep;
            unsigned sP[2][2];
            _Pragma("unroll") for (int _h = 0; _h < 2; ++_h) _Pragma("unroll") for (int _i = 0; _i < 2; ++_i) sP[_h][_i] = last ? nP[_h][_i] : cP[_h][_i];
            const char* b2 = last ? nB : cB + (size_t)(t + 2) * kstep; const char* b3 = b2 + kstep;
            if (last && has_next) S.a_ready(nxt);
            if constexpr (SP2) {
            PG8_LDB(B0, 0, 0); PG8_LDB(B1, 0, 1); PG8_SCHED; PG8_LDA(At, 0, 0); PG8_STAGE_AG(PG8_SA(1, 1), cP, 1, k1);
            PG8_WAIT_V(8); PG8_WAIT_L(0); PG8_BAR; PG8_MMA(0, 0, At, B0); PG8_MMA(0, 1, At, B1); PG8_BAR; PG8_SCHED;
            PG8_LDA(At, 0, 1); PG8_STAGE(PG8_SB(0, 0), b2, voffB); PG8_STAGE(PG8_SB(0, 1), b2 + hstep, voffB); PG8_STAGE_AG(PG8_SA(0, 0), sP, 0, k2);
            PG8_WAIT_V(8); PG8_WAIT_L(0); PG8_BAR; PG8_MMA(1, 0, At, B0); PG8_MMA(1, 1, At, B1); PG8_BAR; PG8_SCHED;
            PG8_LDB(B0, 1, 0); PG8_LDB(B1, 1, 1); PG8_SCHED; PG8_LDA(At, 1, 0); PG8_STAGE_AG(PG8_SA(0, 1), sP, 1, k2);
            PG8_WAIT_V(8); PG8_WAIT_L(0); PG8_BAR; PG8_MMA(0, 0, At, B0); PG8_MMA(0, 1, At, B1); PG8_BAR; PG8_SCHED;
            PG8_LDA(At, 1, 1); PG8_STAGE(PG8_SB(1, 0), b3, voffB); PG8_STAGE(PG8_SB(1, 1), b3 + hstep, voffB); PG8_STAGE_AG(PG8_SA(1, 0), sP, 0, k3);
            PG8_WAIT_V(8); PG8_WAIT_L(0); PG8_BAR; PG8_MMA(1, 0, At, B0); PG8_MMA(1, 1, At, B1); PG8_BAR; PG8_SCHED;
            }
        }
        if constexpr (ALIGN_EPI) { if (wr == 0) PG8_BAR; }
        if constexpr (!Epi::AFTER_DRAIN) { E(acc, cur, ui, wr, wc, fr, fq); if (AMP_PHASE == 81) { asm volatile("" ::: "memory"); E(acc, cur, ui, wr, wc, fr, fq); } S.done(cur); }
        if (!has_next) break;
#pragma unroll
        for (int a = 0; a < 2; ++a)
#pragma unroll
            for (int b = 0; b < 2; ++b)
#pragma unroll
                for (int m = 0; m < 4; ++m)
#pragma unroll
                    for (int n = 0; n < 2; ++n) acc[a][b][m][n] = (f32x4){0.f, 0.f, 0.f, 0.f};
        cur = nxt; cB = nB; ++ui;
        _Pragma("unroll") for (int _h = 0; _h < 2; ++_h) _Pragma("unroll") for (int _i = 0; _i < 2; ++_i) cP[_h][_i] = nP[_h][_i];
        if constexpr (ALIGN_EPI) { if (wr == 1) PG8_BAR; }
    }
    PG8_WAIT_V(0);
    if constexpr (!ALIGN_EPI) { if (wr == 0) PG8_BAR; }
    PG8_BAR;
    if constexpr (Epi::AFTER_DRAIN) { E.fused(acc, cur, wr, wc, fr, fq, lds, wid, lane); S.done(cur); }
#undef PG8_SA
#undef PG8_SB
#undef PG8_STAGE
#undef PG8_STAGE_AG
#undef PG8_ROWPTR
#undef PG8_LDA
#undef PG8_LDB
#undef PG8_MMA
#undef PG8_CAT8
#undef PG8_WAIT_V
#undef PG8_WAIT_L
#undef PG8_BAR
#undef PG8_SCHED
}

}

#define LAS __attribute__((address_space(3)))
typedef unsigned short bf16_t;
typedef float f32x4 __attribute__((ext_vector_type(4)));
typedef unsigned u32x4 __attribute__((ext_vector_type(4)));
typedef unsigned u32x2 __attribute__((ext_vector_type(2)));
typedef __bf16 bf16x2_t __attribute__((ext_vector_type(2)));
constexpr int NWAVES = 8, NTHR = 512;
constexpr int D = 1024, NB = 8, SEQ = 4096, LCTX = 256, TX = NB * SEQ, TC = NB * LCTX, TT = TX + TC, INW = 2304, NE = 16, FF = 2048;
constexpr int CAPX = 512, CAPC = 32, SLOTS = NB * CAPX + NB * CAPC;
constexpr float LOG2E = 1.4426950408889634f;
constexpr int LDS_BYTES = 163840;
enum { I_X = 0, I_C, I_CTX, I_CCTX, I_ADAW, I_ADAB, I_N1G, I_N2G, I_WIN, I_HCW, I_HCB, I_HW1, I_HB1, I_HW2, I_HB2, I_HW3, I_HFREQ, I_HSKIP, I_SINK, I_POOLW, I_POOLS, I_RPB, I_WOUT, I_ROUTER, I_WG, I_WU, I_WD, I_FNG, N_IN };
constexpr size_t MiB = 1u << 20;
constexpr size_t WS_CTL = 0;
constexpr size_t WS_MOD = 1 * MiB;
constexpr size_t WS_WSC = 1 * MiB + 512 * 1024;
constexpr size_t WS_ROPE = 2 * MiB;
constexpr size_t WS_TW8 = 2 * MiB + 65536;
constexpr size_t WS_WIN_T = 3 * MiB;
constexpr size_t WS_WOUT_T = 13 * MiB;
constexpr size_t WS_HC = 17 * MiB;
constexpr size_t WS_HCC = 51 * MiB;
constexpr size_t WS_AFFT = 53 * MiB;
constexpr size_t WS_ROWMAP = 56 * MiB;
constexpr size_t WS_GATE = 57 * MiB;
constexpr size_t WS_INV = 58 * MiB;
constexpr size_t WS_CRES = 61 * MiB;
constexpr size_t WS_HX = 69 * MiB;
constexpr size_t WS_WGU_T = 137 * MiB;
constexpr size_t WS_XB = 265 * MiB;
constexpr size_t WS_WD_T = 393 * MiB;
constexpr size_t WS_R = 521 * MiB;
constexpr size_t WS_ACT = WS_R;
constexpr size_t WS_XG = WS_R + 272 * MiB;
constexpr size_t WS_PX = WS_R;
constexpr size_t WS_Y = WS_R + 153 * MiB;
constexpr size_t WS_YT = WS_XG + 48 * MiB;
constexpr size_t WS_UT = WS_XG;
constexpr size_t WS_HS = WS_R + 408 * MiB;
constexpr size_t WS_END = WS_HS + 64 * MiB;
static_assert(WS_END <= 1024 * MiB, "workspace map");

struct Args { const float* in[N_IN]; float* out; unsigned char* ws; };

__device__ __forceinline__ float bf2f(unsigned short v) { return __uint_as_float(((unsigned)v) << 16); }
__device__ __forceinline__ unsigned f2bf(float f) { unsigned u = __float_as_uint(f); return (u + 0x7fffu + ((u >> 16) & 1u)) >> 16; }
__device__ __forceinline__ unsigned pk2(float lo, float hi) { return f2bf(lo) | (f2bf(hi) << 16); }
__device__ __forceinline__ float bflo(unsigned w) { return __uint_as_float(w << 16); }
__device__ __forceinline__ float bfhi(unsigned w) { return __uint_as_float(w & 0xffff0000u); }
__device__ __forceinline__ float dot2bf(unsigned a, unsigned b, float acc) { return __builtin_amdgcn_fdot2_f32_bf16(__builtin_bit_cast(bf16x2_t, a), __builtin_bit_cast(bf16x2_t, b), acc, false); }
template <int O> __device__ __forceinline__ float xshfl(float v) {
    if constexpr (O == 32) { auto rr = __builtin_amdgcn_permlane32_swap(__float_as_uint(v), __float_as_uint(v), false, false);
        const bool lowhalf = __builtin_amdgcn_mbcnt_lo(~0u, 0u) == __builtin_amdgcn_mbcnt_hi(~0u, __builtin_amdgcn_mbcnt_lo(~0u, 0u));
        return lowhalf ? __uint_as_float(rr[1]) : __uint_as_float(rr[0]); }
    else return __builtin_bit_cast(float, __builtin_amdgcn_ds_swizzle(__builtin_bit_cast(int, v), (O << 10) | 0x1f));
}
__device__ __forceinline__ float xsum32(float v) { auto rr = __builtin_amdgcn_permlane32_swap(__float_as_uint(v), __float_as_uint(v), false, false); return __uint_as_float(rr[0]) + __uint_as_float(rr[1]); }
__device__ __forceinline__ float xmax32(float v) { auto rr = __builtin_amdgcn_permlane32_swap(__float_as_uint(v), __float_as_uint(v), false, false); return fmaxf(__uint_as_float(rr[0]), __uint_as_float(rr[1])); }
__device__ __forceinline__ float wave_sum(float v) { v += xshfl<1>(v); v += xshfl<2>(v); v += xshfl<4>(v); v += xshfl<8>(v); v += xshfl<16>(v); return xsum32(v); }
__device__ __forceinline__ float wave_max_(float v) { v = fmaxf(v, xshfl<1>(v)); v = fmaxf(v, xshfl<2>(v)); v = fmaxf(v, xshfl<4>(v)); v = fmaxf(v, xshfl<8>(v)); v = fmaxf(v, xshfl<16>(v)); return xmax32(v); }
#define LDS_WAIT() asm volatile("s_waitcnt lgkmcnt(0)" ::: "memory")

#ifndef AMP_PHASE
#define AMP_PHASE -1
#endif
__device__ __forceinline__ unsigned long long amp_now() { asm volatile("s_waitcnt vmcnt(0) lgkmcnt(0)" ::: "memory"); __builtin_amdgcn_sched_barrier(0); const unsigned long long t = __builtin_amdgcn_s_memrealtime(); asm volatile("s_waitcnt lgkmcnt(0)" ::: "memory"); __builtin_amdgcn_sched_barrier(0); return t; }
#define AMP_BEGIN(id) unsigned long long amp_t0_ = 0; if ((id) == AMP_PHASE) { __syncthreads(); amp_t0_ = amp_now(); }
#define AMP_END(id) if ((id) == AMP_PHASE) { __syncthreads(); const unsigned long long t1_ = amp_now(); const unsigned long long d_ = t1_ - amp_t0_; while (amp_now() - t1_ < d_) __builtin_amdgcn_s_sleep(8); __syncthreads(); }
__device__ __forceinline__ void tr_item(const float* W, int K, int N, bf16_t* WT, int Kt, int item, int mode, LAS float* scr, int lane) {
    const int nblk = N / 32, kb = item / nblk, nb = item % nblk, k0 = 64 * kb, n0 = 32 * nb;
    const int r8 = lane >> 3, c4 = lane & 7; f32x4 v[8];
    const float* wp = W + (size_t)(k0 + r8) * N + n0 + 4 * c4;
#pragma unroll
    for (int i = 0; i < 8; ++i) v[i] = *(const f32x4*)(wp + (size_t)(8 * i) * N);
#pragma unroll
    for (int i = 0; i < 8; ++i) { LAS float* d = scr + (r8 + 8 * i) * 33 + 4 * c4; d[0] = v[i][0]; d[1] = v[i][1]; d[2] = v[i][2]; d[3] = v[i][3]; }
    LDS_WAIT();
    const int c = lane & 7;
    const int drow0 = (mode == 0) ? n0 : ((n0 >> 7) * 256 + (n0 & 127) + (mode == 2 ? 128 : 0));
#pragma unroll
    for (int j = 0; j < 4; ++j) { const int n = (lane >> 3) + 8 * j; const LAS float* sp = scr + (8 * c) * 33 + n;
        u32x4 o; o.x = pk2(sp[0 * 33], sp[1 * 33]); o.y = pk2(sp[2 * 33], sp[3 * 33]); o.z = pk2(sp[4 * 33], sp[5 * 33]); o.w = pk2(sp[6 * 33], sp[7 * 33]);
        *(u32x4*)(WT + (size_t)(drow0 + n) * Kt + k0 + 8 * c) = o; }
    LDS_WAIT();
}

struct CvtStream { int it, end, live; f32x4 v0, v1, v2, v3, v4, v5, v6, v7; };
constexpr int CVT_ITEMS = 2 * 3 * 16 * 1024;
__device__ __forceinline__ void cvt_decode(const Args& a, int r, const float*& W, int& K, int& N, unsigned char*& WT, int& Kt, int& mode, int& ri, float*& wsc) {
    const int l = r / 49152, rr = r % 49152, which = rr >> 14, e = (rr >> 10) & 15; ri = rr & 1023; const size_t le = (size_t)l * 16 + e;
    wsc = (float*)(a.ws + WS_WSC) + (l * 3 + which) * 16 + e;
    if (which == 0) { W = a.in[I_WG] + le * 1024 * 2048; K = 1024; N = 2048; WT = (unsigned char*)(a.ws + WS_WGU_T) + le * 4096 * 1024; Kt = 1024; mode = 1; }
    else if (which == 1) { W = a.in[I_WU] + le * 1024 * 2048; K = 1024; N = 2048; WT = (unsigned char*)(a.ws + WS_WGU_T) + le * 4096 * 1024; Kt = 1024; mode = 2; }
    else { W = a.in[I_WD] + le * 2048 * 1024; K = 2048; N = 1024; WT = (unsigned char*)(a.ws + WS_WD_T) + le * 1024 * 2048; Kt = 2048; mode = 0; }
}
__device__ __forceinline__ void cvt_issue(const Args& a, CvtStream& c, int lane) {
    c.live = 0; if (c.it >= c.end) return;
    const float* W; int K, N, Kt, mode, ri; unsigned char* WT; float* wsc; cvt_decode(a, c.it, W, K, N, WT, Kt, mode, ri, wsc);
    const int nblk = N / 32, kb = ri / nblk, nb = ri % nblk, k0 = 64 * kb, n0 = 32 * nb; const int r8 = lane >> 3, c4 = lane & 7;
    const float* wp = W + (size_t)(k0 + r8) * N + n0 + 4 * c4; const size_t st = (size_t)8 * N;
    c.v0 = *(const f32x4*)(wp); c.v1 = *(const f32x4*)(wp + st); c.v2 = *(const f32x4*)(wp + 2 * st); c.v3 = *(const f32x4*)(wp + 3 * st);
    c.v4 = *(const f32x4*)(wp + 4 * st); c.v5 = *(const f32x4*)(wp + 5 * st); c.v6 = *(const f32x4*)(wp + 6 * st); c.v7 = *(const f32x4*)(wp + 7 * st);
    c.live = 1;
}
__device__ __forceinline__ void cvt_finish(const Args& a, CvtStream& c, LAS float* scr, int lane, int stride) {
    if (!c.live) return;
    const float* W; int K, N, Kt, mode, ri; unsigned char* WT; float* wsc; cvt_decode(a, c.it, W, K, N, WT, Kt, mode, ri, wsc);
    const int nblk = N / 32, kb = ri / nblk, nb = ri % nblk, k0 = 64 * kb, n0 = 32 * nb; const int r8 = lane >> 3, c4 = lane & 7;
    const float mul = 1.0f / *wsc;
    LAS float* d = scr + r8 * 33 + 4 * c4;
#define CVT_PUT(i, v) { d[(8 * (i)) * 33 + 0] = v[0] * mul; d[(8 * (i)) * 33 + 1] = v[1] * mul; d[(8 * (i)) * 33 + 2] = v[2] * mul; d[(8 * (i)) * 33 + 3] = v[3] * mul; }
    CVT_PUT(0, c.v0) CVT_PUT(1, c.v1) CVT_PUT(2, c.v2) CVT_PUT(3, c.v3) CVT_PUT(4, c.v4) CVT_PUT(5, c.v5) CVT_PUT(6, c.v6) CVT_PUT(7, c.v7)
#undef CVT_PUT
    LDS_WAIT();
    const int cc = lane & 7;
    const int drow0 = (mode == 0) ? n0 : ((n0 >> 7) * 256 + (n0 & 127) + (mode == 2 ? 128 : 0));
#pragma unroll
    for (int j = 0; j < 4; ++j) { const int n = (lane >> 3) + 8 * j; const LAS float* sp = scr + (8 * cc) * 33 + n;
        int p0 = 0, p1 = 0;
        p0 = __builtin_amdgcn_cvt_pk_fp8_f32(sp[0 * 33], sp[1 * 33], p0, false); p0 = __builtin_amdgcn_cvt_pk_fp8_f32(sp[2 * 33], sp[3 * 33], p0, true);
        p1 = __builtin_amdgcn_cvt_pk_fp8_f32(sp[4 * 33], sp[5 * 33], p1, false); p1 = __builtin_amdgcn_cvt_pk_fp8_f32(sp[6 * 33], sp[7 * 33], p1, true);
        typedef int i32x2v __attribute__((ext_vector_type(2)));
        *(i32x2v*)(WT + (size_t)(drow0 + n) * Kt + k0 + 8 * cc) = (i32x2v){p0, p1}; }
    LDS_WAIT();
    c.it += stride; c.live = 0;
}

__device__ __forceinline__ void filter_item(const Args& a, LAS unsigned char* lds, int item, int tid) {
    asm volatile("" : "+v"(tid));
    const int lane = tid & 63, wave = tid >> 6;
    int l, L, p0; float* HCdst;
    if (item < 128) { l = 0; L = 4096; p0 = item * 32; HCdst = (float*)(a.ws + WS_HC); }
    else if (item < 256) { l = 1; L = 4096; p0 = (item - 128) * 32; HCdst = (float*)(a.ws + WS_HC) + (size_t)2 * 256 * 8192; }
    else { l = 0; L = 256; p0 = (item - 256) * 32; HCdst = (float*)(a.ws + WS_HCC) + 256; }
    LAS float* w1s = (LAS float*)lds; LAS float* w2s = w1s + 33 * 64; LAS float* b1s = w2s + 64 * 64; LAS float* b2s = b1s + 64; LAS float* frs = b2s + 64; LAS float* h2s = frs + 64; LAS float* ex = h2s + 32 * 64;
    { const float* w1 = a.in[I_HW1] + l * 33 * 64; const float* w2 = a.in[I_HW2] + l * 64 * 64;
      for (int i = tid; i < 33 * 64; i += NTHR) w1s[i] = w1[i];
      for (int i = tid; i < 64 * 64; i += NTHR) w2s[i] = w2[i];
      if (tid < 64) { b1s[tid] = a.in[I_HB1][l * 64 + tid]; b2s[tid] = a.in[I_HB2][l * 64 + tid]; frs[tid] = a.in[I_HFREQ][l * 64 + tid]; } }
    __syncthreads();
    const float frq = frs[lane];
#pragma unroll 1
    for (int q = 0; q < 4; ++q) { const int pp = wave * 4 + q, p = p0 + pp; const float tn = (float)p / (float)(L - 1);
        float fv = 0.f;
        if (lane == 0) fv = tn;
        else if (lane <= 32) { const int bi = (lane - 1) & 15; const float band = 1e-4f + (float)bi * ((15.0f - 1e-4f) / 15.0f);
            const float ang = ((float)(6.283185307179586 / (double)L) * (float)p) * band; fv = (lane <= 16) ? cosf(ang) : -sinf(ang); }
        float a1 = b1s[lane];
#pragma unroll
        for (int i = 0; i < 33; ++i) a1 += __builtin_bit_cast(float, __builtin_amdgcn_readlane(__builtin_bit_cast(int, fv), i)) * w1s[i * 64 + lane];
        const float h1 = sinf(frq * a1);
        float a2 = b2s[lane];
#pragma unroll 16
        for (int i = 0; i < 64; ++i) a2 += __builtin_bit_cast(float, __builtin_amdgcn_readlane(__builtin_bit_cast(int, h1), i)) * w2s[i * 64 + lane];
        h2s[lane * 32 + pp] = sinf(frq * a2); }
    __syncthreads();
    const float* w3 = a.in[I_HW3] + (size_t)l * 64 * 1024 + tid;
    float acc0[32], acc1[32];
#pragma unroll
    for (int pp = 0; pp < 32; ++pp) { acc0[pp] = 0.f; acc1[pp] = 0.f; }
#pragma unroll 4
    for (int i = 0; i < 64; ++i) { const float wa = w3[i * 1024], wb = w3[i * 1024 + 512];
#pragma unroll
        for (int q = 0; q < 8; ++q) { const f32x4 h = *(const LAS f32x4*)(h2s + i * 32 + 4 * q);
#pragma unroll
            for (int r = 0; r < 4; ++r) { acc0[4 * q + r] += h[r] * wa; acc1[4 * q + r] += h[r] * wb; } } }
    const int c = tid & 255, dir = tid >> 8; const float dmin = 3.0701134573253945f, dmax = 15.350567286626972f; const float delta = dmin + (float)c * ((dmax - dmin) / 255.0f);
    float* base0 = HCdst; float* base1 = HCdst + (size_t)(2 * L - 1) * 256;
    const bool tr = (L == 4096);
#pragma unroll
    for (int pp = 0; pp < 32; ++pp) { const int p = p0 + pp; const float tn = (float)p / (float)(L - 1); const float win = expf(-tn * delta); const float v0 = acc0[pp] * win, v1 = acc1[pp] * win;
        if (p == 0) { ex[tid] = v0; ex[512 + tid] = v1; }
        else { const int li = dir == 0 ? (L - 1 + p) : (L - 1 - p); const size_t idx = tr ? ((size_t)c * 8192 + li) : ((size_t)li * 256 + c); const size_t o1 = tr ? (size_t)256 * 8192 : (size_t)(2 * L - 1) * 256; base0[idx] = v0; base0[idx + o1] = v1; } }
    __syncthreads();
    if (p0 == 0 && tid < 256) { const size_t idx = tr ? ((size_t)tid * 8192 + (L - 1)) : ((size_t)(L - 1) * 256 + tid); const size_t o1 = tr ? (size_t)256 * 8192 : (size_t)(2 * L - 1) * 256; base0[idx] = ex[tid] + ex[tid + 256]; base0[idx + o1] = ex[512 + tid] + ex[512 + tid + 256]; }
    __syncthreads();
}


typedef int v8i_t __attribute__((ext_vector_type(8)));
__device__ __forceinline__ float st_A(int i, int k) { return (float)(((i * 7 + k * 3) % 5) - 2); }
__device__ __forceinline__ float st_B(int k, int j) { return (float)(((k * 5 + j * 11 + (k >> 4)) % 5) - 2); }
__device__ __forceinline__ void fp8_selftest(unsigned* poison, int lane) {
    const int fr = lane & 15, fq = lane >> 4; v8i_t av, bv;
#pragma unroll
    for (int w = 0; w < 8; ++w) { int pa = 0, pb = 0;
#pragma unroll
        for (int q = 0; q < 4; ++q) { }
        const int kb = (w < 4) ? (16 * fq + 4 * w) : (64 + 16 * fq + 4 * (w - 4));
        pa = __builtin_amdgcn_cvt_pk_fp8_f32(st_A(fr, kb), st_A(fr, kb + 1), pa, false); pa = __builtin_amdgcn_cvt_pk_fp8_f32(st_A(fr, kb + 2), st_A(fr, kb + 3), pa, true);
        pb = __builtin_amdgcn_cvt_pk_fp8_f32(st_B(kb, fr), st_B(kb + 1, fr), pb, false); pb = __builtin_amdgcn_cvt_pk_fp8_f32(st_B(kb + 2, fr), st_B(kb + 3, fr), pb, true);
        av[w] = pa; bv[w] = pb; }
    f32x4 acc = {0.f, 0.f, 0.f, 0.f};
    acc = __builtin_amdgcn_mfma_scale_f32_16x16x128_f8f6f4(av, bv, acc, 0, 0, 0, 0x7f7f7f7f, 0, 0x7f7f7f7f);
    bool bad = false;
#pragma unroll
    for (int r = 0; r < 4; ++r) { float ref = 0.f; for (int k = 0; k < 128; ++k) ref += st_A(4 * fq + r, k) * st_B(k, fr); bad |= (acc[r] != ref); }
    { const float v = (float)(lane * 3 + 1);
      const float r5 = __builtin_bit_cast(float, __builtin_amdgcn_update_dpp(0, __builtin_bit_cast(int, v), 0x150 + 5, 0xf, 0xf, false));
      const float r12 = __builtin_bit_cast(float, __builtin_amdgcn_update_dpp(0, __builtin_bit_cast(int, v), 0x150 + 12, 0xf, 0xf, false));
      bad |= (r5 != (float)(((lane & 48) + 5) * 3 + 1)) || (r12 != (float)(((lane & 48) + 12) * 3 + 1)); }
    if (__any(bad) && lane == 0) __hip_atomic_store(poison, 1u, __ATOMIC_RELAXED, __HIP_MEMORY_SCOPE_AGENT);
}

__device__ __forceinline__ void phase_prologue(const Args& a, unsigned char* ldsg, int vcu, int G) {
    LAS unsigned char* lds = (LAS unsigned char*)ldsg;
    int tid_ = threadIdx.x; asm volatile("" : "+v"(tid_));
    const int tid = tid_, lane = tid & 63, wave = __builtin_amdgcn_readfirstlane(tid >> 6);
    unsigned char* ws = a.ws;
    if (vcu == 2 % G && wave == 0) fp8_selftest((unsigned*)(ws + WS_CTL) + 12288, lane);
    LAS float* sc = (LAS float*)lds; LAS float* red = (LAS float*)(lds + 36864);
    for (int i = tid; i < 9 * 1024; i += NTHR) { const float v = (i < 8192) ? a.in[I_C][i] : a.in[I_CCTX][i - 8192]; sc[i] = v / (1.0f + expf(-v)); }
    __syncthreads();
    { AMP_BEGIN(41)
    float* MOD = (float*)(ws + WS_MOD);
    for (int item = vcu; item < 2 * 96; item += G) {
        const int l = item / 96, n0 = (item % 96) * 64, col = tid & 63, kg = tid >> 6;
        float acc[9];
#pragma unroll
        for (int r = 0; r < 9; ++r) acc[r] = 0.f;
        const float* w = a.in[I_ADAW] + (size_t)l * 1024 * 6144 + n0 + col;
#pragma unroll 4
        for (int k = kg * 128; k < kg * 128 + 128; ++k) { const float wv = w[(size_t)k * 6144];
#pragma unroll
            for (int r = 0; r < 9; ++r) acc[r] += sc[r * 1024 + k] * wv; }
#pragma unroll
        for (int r = 0; r < 9; ++r) red[(kg * 9 + r) * 64 + col] = acc[r];
        __syncthreads();
        for (int o = tid; o < 9 * 64; o += NTHR) { const int r = o >> 6, cc = o & 63; float s = 0.f;
#pragma unroll
            for (int g2 = 0; g2 < 8; ++g2) s += red[(g2 * 9 + r) * 64 + cc];
            MOD[(size_t)(l * 9 + r) * 6144 + n0 + cc] = s + a.in[I_ADAB][l * 6144 + n0 + cc]; }
        __syncthreads();
    }
    AMP_END(41) }
    if (vcu == 0) { float* ROPE = (float*)(ws + WS_ROPE);
        for (int i = tid; i < 1024; i += NTHR) { const int pos = i >> 4, fi = i & 15; const float inv = powf(10000.0f, -(float)fi / 16.0f); const float ang = (float)pos * inv;
            ROPE[2 * i] = cosf(ang); ROPE[2 * i + 1] = sinf(ang); } }
    if (vcu == 1 % G) { float* TW8 = (float*)(ws + WS_TW8);
        for (int i = tid; i < 8192; i += NTHR) { float sn, cs; sincospif(-(float)i * (1.0f / 4096.0f), &sn, &cs); TW8[2 * i] = cs; TW8[2 * i + 1] = sn; } }
    const int gw = vcu * NWAVES + wave, NGW = G * NWAVES;
    { AMP_BEGIN(42)
    for (int it = vcu; it < 264; it += G) filter_item(a, lds, it, tid);
    AMP_END(42) }
    { AMP_BEGIN(43)
    LAS float* scr = (LAS float*)(lds + 65536 + wave * 8448);
    for (int m = gw; m < 96; m += NGW) { const int l = m / 48, which = (m % 48) / 16, e = m & 15; const size_t le = (size_t)l * 16 + e; int lane_ = lane; asm volatile("" : "+v"(lane_));
        const float* W = (which == 0) ? a.in[I_WG] + le * 1024 * 2048 : ((which == 1) ? a.in[I_WU] + le * 1024 * 2048 : a.in[I_WD] + le * 2048 * 1024);
        const f32x4 sv = *(const f32x4*)(W + 4 * lane_); float sm = fmaxf(fmaxf(fabsf(sv[0]), fabsf(sv[1])), fmaxf(fabsf(sv[2]), fabsf(sv[3])));
        sm = wave_max_(sm);
        int E = 0; (void)frexpf(fmaxf(sm, 1e-30f), &E); if (lane_ == 0) ((float*)(ws + WS_WSC))[m] = ldexpf(1.0f, E - 5); }
    constexpr int IT_IN = 16 * 72, IT_OUT = 16 * 32, IT_LAYER = IT_IN + IT_OUT;
    for (int it = gw; it < 2 * IT_LAYER; it += NGW) {
        const int l = it / IT_LAYER; int r = it % IT_LAYER;
        if (r < IT_IN) { tr_item(a.in[I_WIN] + (size_t)l * 1024 * 2304, 1024, 2304, (bf16_t*)(ws + WS_WIN_T) + (size_t)l * 2304 * 1024, 1024, r, 0, scr, lane); continue; } r -= IT_IN;
        tr_item(a.in[I_WOUT] + (size_t)l * 1024 * 1024, 1024, 1024, (bf16_t*)(ws + WS_WOUT_T) + (size_t)l * 1024 * 1024, 1024, r, 0, scr, lane);
    }
    AMP_END(43) }
}

__device__ __forceinline__ void phase_norm(const Args& a, unsigned char* ldsg, int vcu, int G, int l, const float* srcx, const float* srcc, const bf16_t* srcb, const float* gain, int shift_idx, int nrows, bool router) {
    int tid_ = threadIdx.x; asm volatile("" : "+v"(tid_));
    const int tid = tid_, lane = tid & 63, wave = __builtin_amdgcn_readfirstlane(tid >> 6);
    unsigned char* ws = a.ws; asm volatile("" : "+s"(ws)); const float* MOD = (const float*)(ws + WS_MOD) + (size_t)l * 9 * 6144; bf16_t* HX = (bf16_t*)(ws + WS_HX);
    LAS float* rw = (LAS float*)(LAS unsigned char*)ldsg;
    if (router) { const float* rsrc = a.in[I_ROUTER] + (size_t)l * 1024 * 16; for (int i = tid; i < 1024 * 16; i += NTHR) rw[(i & 15) * 1024 + (i >> 4)] = rsrc[i]; __syncthreads(); }
    const int gw = vcu * NWAVES + wave, NGW = G * NWAVES;
    for (int rowa = gw; rowa < nrows; rowa += 2 * NGW) {
        f32x4 vv[2][4];
#pragma unroll
        for (int u = 0; u < 2; ++u) { const int rr = (rowa + u * NGW < nrows) ? rowa + u * NGW : rowa;
            if (srcb) { const bf16_t* xr = srcb + (size_t)rr * D;
#pragma unroll
                for (int j = 0; j < 4; ++j) { const u32x2 w = *(const u32x2*)(xr + 256 * j + 4 * lane); vv[u][j] = (f32x4){bflo(w.x), bfhi(w.x), bflo(w.y), bfhi(w.y)}; } }
            else { const float* xr = (rr < TX) ? srcx + (size_t)rr * D : srcc + (size_t)(rr - TX) * D;
#pragma unroll
                for (int j = 0; j < 4; ++j) vv[u][j] = *(const f32x4*)(xr + 256 * j + 4 * lane); } }
        f32x4 hv[2][4];
#pragma unroll
        for (int u = 0; u < 2; ++u) { const int row = rowa + u * NGW; if (row < nrows) {
        const bool lat = row < TX; const int mrow = lat ? (row >> 12) : 8;
        const float* shp = MOD + mrow * 6144 + shift_idx * 1024; const float* scp = shp + 1024;
        f32x4 v[4]; float ss = 0.f;
#pragma unroll
        for (int j = 0; j < 4; ++j) { v[j] = vv[u][j]; ss += (v[j][0] * v[j][0] + v[j][1] * v[j][1]) + (v[j][2] * v[j][2] + v[j][3] * v[j][3]); }
        const float rstd = 1.0f / sqrtf(wave_sum(ss) * (1.0f / D) + 1e-6f);
#pragma unroll
        for (int j = 0; j < 4; ++j) { const f32x4 gg = *(const f32x4*)(gain + 256 * j + 4 * lane), sh = *(const f32x4*)(shp + 256 * j + 4 * lane), sc = *(const f32x4*)(scp + 256 * j + 4 * lane);
            v[j] = (v[j] * rstd * gg) * (1.0f + sc) + sh;
            if (router) { int p = 0; p = __builtin_amdgcn_cvt_pk_fp8_f32(fminf(fmaxf(v[j][0], -448.f), 448.f), fminf(fmaxf(v[j][1], -448.f), 448.f), p, false); p = __builtin_amdgcn_cvt_pk_fp8_f32(fminf(fmaxf(v[j][2], -448.f), 448.f), fminf(fmaxf(v[j][3], -448.f), 448.f), p, true);
                *(int*)((unsigned char*)HX + (size_t)row * D + 256 * j + 4 * lane) = p; }
            else { u32x2 o; o.x = pk2(v[j][0], v[j][1]); o.y = pk2(v[j][2], v[j][3]); *(u32x2*)(HX + (size_t)row * D + 256 * j + 4 * lane) = o; } }
#pragma unroll
        for (int j = 0; j < 4; ++j) hv[u][j] = v[j];
        } }
        float plr[2][16];
        if (router) {
#pragma unroll
            for (int e = 0; e < 16; ++e) { float p0 = 0.f, p1 = 0.f;
#pragma unroll
                for (int j = 0; j < 4; ++j) { const f32x4 wv = *(const LAS f32x4*)(rw + e * 1024 + 256 * j + 4 * lane);
                    p0 += (hv[0][j][0] * wv[0] + hv[0][j][1] * wv[1]) + (hv[0][j][2] * wv[2] + hv[0][j][3] * wv[3]);
                    p1 += (hv[1][j][0] * wv[0] + hv[1][j][1] * wv[1]) + (hv[1][j][2] * wv[2] + hv[1][j][3] * wv[3]); }
                plr[0][e] = p0; plr[1][e] = p1; asm volatile("" : "+v"(plr[0][e]), "+v"(plr[1][e])); } }
#pragma unroll
        for (int u = 0; u < 2; ++u) { const int row = rowa + u * NGW; if (row < nrows) {
        if (router) {
            float pl[16];
#pragma unroll
            for (int e = 0; e < 16; ++e) pl[e] = plr[u][e];
            float q8[8], q4[4], q2[2], q1;
            { const bool up = (lane & 8) != 0;
#pragma unroll
              for (int e = 0; e < 8; ++e) { const float keep = up ? pl[e + 8] : pl[e], give = up ? pl[e] : pl[e + 8]; q8[e] = keep + xshfl<8>(give); } }
            { const bool up = (lane & 4) != 0;
#pragma unroll
              for (int e = 0; e < 4; ++e) { const float keep = up ? q8[e + 4] : q8[e], give = up ? q8[e] : q8[e + 4]; q4[e] = keep + xshfl<4>(give); } }
            { const bool up = (lane & 2) != 0;
#pragma unroll
              for (int e = 0; e < 2; ++e) { const float keep = up ? q4[e + 2] : q4[e], give = up ? q4[e] : q4[e + 2]; q2[e] = keep + xshfl<2>(give); } }
            { const bool up = (lane & 1) != 0; const float keep = up ? q2[1] : q2[0], give = up ? q2[0] : q2[1]; q1 = keep + xshfl<1>(give); }
            q1 += xshfl<16>(q1); q1 = xsum32(q1);
            const float mylog = (lane < 16) ? q1 : -1e30f;
            float mx = mylog;
            mx = fmaxf(mx, xshfl<1>(mx)); mx = fmaxf(mx, xshfl<2>(mx)); mx = fmaxf(mx, xshfl<4>(mx)); mx = fmaxf(mx, xshfl<8>(mx));
            const float mine = (lane < 16) ? expf(mylog - mx) : 0.f; float den = mine;
            den += xshfl<1>(den); den += xshfl<2>(den); den += xshfl<4>(den); den += xshfl<8>(den);
            if (lane < 16) { ((float*)(ws + WS_AFFT))[(size_t)lane * TT + row] = mine / den; ((int*)(ws + WS_INV))[(size_t)row * 16 + lane] = -1; }
        }
    } }
    }
}

#define XB_TMO      128
#define XB_XCNT(j)  (256  + 64 * (j))
#define XB_XSUB(j)  (1280 + 64 * (j))
#define XB_XGEN(j)  (2304 + 64 * (j))
#define XB_TOP      3328
#define XB_TOPGEN   3392
#define XCD_BAR_WORDS 3456
#define XB_SPIN_CAP (1u << 18)

__device__ __forceinline__ unsigned xb_ld(unsigned* p)              { return __hip_atomic_load(p, __ATOMIC_RELAXED, __HIP_MEMORY_SCOPE_AGENT); }
__device__ __forceinline__ unsigned xb_add(unsigned* p, unsigned v) { return __hip_atomic_fetch_add(p, v, __ATOMIC_RELAXED, __HIP_MEMORY_SCOPE_AGENT); }
__device__ __forceinline__ unsigned xb_xcc_id() { return (unsigned)__builtin_amdgcn_s_getreg((3 << 11) | 20) & 0xFu; }
#define XB_SPIN(cond, bar) do { unsigned _sp = 0; while (cond) { __builtin_amdgcn_s_sleep(1); \
    if ((++_sp & 255u) == 0u) { if (xb_ld(&(bar)[XB_TMO])) break; if (_sp > XB_SPIN_CAP) { atomicAdd(&(bar)[XB_TMO], 1u); break; } } } } while (0)

struct XcdBarrier {
    unsigned* bar; unsigned x;
    volatile LAS unsigned* st;
};

__device__ __forceinline__ XcdBarrier xcd_barrier_post(unsigned* bar, volatile LAS unsigned* st) {
    XcdBarrier b; b.bar = bar; b.x = xb_xcc_id(); b.st = st;
    if (threadIdx.x == 0) (void)xb_add(&bar[XB_XCNT(b.x)], 1u);
    return b;
}
__device__ __forceinline__ void xcd_barrier_complete(unsigned* bar, unsigned x, unsigned& nloc, unsigned& nx) {
    const unsigned G = gridDim.x * gridDim.y * gridDim.z;
    unsigned sum, cnt, mine, sp = 0u;
    for (;;) {
        sum = 0u; cnt = 0u; mine = 0u;
#pragma unroll
        for (unsigned j = 0; j < 16; ++j) { const unsigned c = xb_ld(&bar[XB_XCNT(j)]); sum += c; cnt += (c > 0u) ? 1u : 0u; mine = (j == x) ? c : mine; }
        if (sum == G) break;
        __builtin_amdgcn_s_sleep(1);
        if ((++sp & 255u) == 0u) { if (xb_ld(&bar[XB_TMO])) break; if (sp > XB_SPIN_CAP) { atomicAdd(&bar[XB_TMO], 1u); break; } }
    }
    nloc = mine > 0u ? mine : 1u; nx = cnt > 0u ? cnt : 1u;
}

__device__ __forceinline__ void xcd_barrier(const XcdBarrier& b) {
    asm volatile("s_waitcnt vmcnt(0)" ::: "memory");
    __syncthreads();
    if (threadIdx.x == 0) {
        unsigned* bar = b.bar;
        __builtin_amdgcn_s_waitcnt(0);
        unsigned nloc = b.st[0], nx = b.st[1];
        if (nloc == 0u) { xcd_barrier_complete(bar, b.x, nloc, nx); b.st[0] = nloc; b.st[1] = nx; }
        const unsigned old = xb_add(&bar[XB_XSUB(b.x)], 1u);
        const unsigned gen = old / nloc;
        if (old + 1u == (gen + 1u) * nloc) {
            __builtin_amdgcn_fence(__ATOMIC_RELEASE, "agent");
            asm volatile("s_waitcnt vmcnt(0)" ::: "memory");
            const unsigned og = xb_add(&bar[XB_TOP], 1u);
            const unsigned tg = og / nx;
            if (og + 1u == (tg + 1u) * nx) xb_add(&bar[XB_TOPGEN], 1u);
            else XB_SPIN(xb_ld(&bar[XB_TOPGEN]) == tg, bar);
            __builtin_amdgcn_fence(__ATOMIC_ACQUIRE, "agent");
            xb_add(&bar[XB_XGEN(b.x)], 1u);
            asm volatile("s_waitcnt vmcnt(0)" ::: "memory");
        } else {
            XB_SPIN(xb_ld(&bar[XB_XGEN(b.x)]) == gen, bar);
            __builtin_amdgcn_fence(__ATOMIC_ACQUIRE, "agent");
            asm volatile("s_waitcnt vmcnt(0)" ::: "memory");
        }
    }
    __syncthreads();
}


typedef float f32x2 __attribute__((ext_vector_type(2)));
__device__ __forceinline__ f32x2 cmul(f32x2 a, f32x2 b) { return (f32x2){a.x * b.x - a.y * b.y, a.x * b.y + a.y * b.x}; }
__device__ __forceinline__ void dft16(f32x2 (&v)[16]) {
    constexpr float WC[8] = {1.0f, 0.92387953251128674f, 0.70710678118654752f, 0.38268343236508977f, 0.0f, -0.38268343236508977f, -0.70710678118654752f, -0.92387953251128674f};
    constexpr float WS[8] = {0.0f, -0.38268343236508977f, -0.70710678118654752f, -0.92387953251128674f, -1.0f, -0.92387953251128674f, -0.70710678118654752f, -0.38268343236508977f};
#pragma unroll
    for (int s = 8; s >= 1; s >>= 1)
#pragma unroll
        for (int i = 0; i < 16; ++i) if ((i & s) == 0) { const int k = (i & (s - 1)) * (8 / s); const f32x2 u = v[i], t = v[i + s]; v[i] = u + t; const f32x2 d = u - t;
            v[i + s] = (k == 0) ? d : ((k == 4) ? (f32x2){d.y, -d.x} : (f32x2){d.x * WC[k] - d.y * WS[k], d.x * WS[k] + d.y * WC[k]}); }
}
__device__ __forceinline__ constexpr int bitrev4(int i) { return ((i & 1) << 3) | ((i & 2) << 1) | ((i & 4) >> 1) | ((i & 8) >> 3); }
template <int NS, int MODE>
__device__ __forceinline__ void fft_pass(LAS f32x2* Z, const LAS f32x2* TW, int tid, const f32x2* H) {
    const int f = tid >> 8, j = tid & 255, base = f * 4096, k = j & (NS - 1);
    f32x2 v[16];
#pragma unroll
    for (int r = 0; r < 16; ++r) { const int idx = base + j + 256 * r; v[r] = Z[idx + (idx >> 4)]; }
    if (MODE == 1) {
#pragma unroll
        for (int r = 0; r < 16; ++r) { const f32x2 p = cmul(v[r], H[r]); v[r] = (f32x2){p.y, p.x}; } }
    if (NS > 1) { const LAS f32x2* tp = (NS == 16) ? (TW + 8192 + k) : (TW + 4096 + k);
#pragma unroll
        for (int r = 1; r < 16; ++r) v[r] = cmul(v[r], tp[r * NS]); }
    dft16(v);
    if (NS != 256) __syncthreads();
    const int j0 = base + (j / NS) * NS * 16 + k;
#pragma unroll
    for (int rr = 0; rr < 16; ++rr) { const int idx = j0 + rr * NS; Z[idx + (idx >> 4)] = v[bitrev4(rr)]; }
    __syncthreads();
}
__device__ __forceinline__ void load_uc(const bf16_t* UT, const float* cw, const float* cb, int ch, int b, int tid, float (&out)[8]) {
    const bf16_t* p = UT + ((size_t)(b * 768 + ch)) * 4096 + 8 * tid;
    const u32x4 w = *(const u32x4*)p; float u[10];
    u[1] = bflo(w.x); u[2] = bfhi(w.x); u[3] = bflo(w.y); u[4] = bfhi(w.y); u[5] = bflo(w.z); u[6] = bfhi(w.z); u[7] = bflo(w.w); u[8] = bfhi(w.w);
    u[0] = (tid > 0) ? bf2f(p[-1]) : 0.f; u[9] = (tid < 511) ? bf2f(p[8]) : 0.f;
    const float w0 = cw[ch], w1 = cw[768 + ch], w2 = cw[1536 + ch], bb = cb[ch];
#pragma unroll
    for (int i = 0; i < 8; ++i) out[i] = u[i] * w0 + u[i + 1] * w1 + u[i + 2] * w2 + bb;
}
__device__ __forceinline__ void hy_fill(LAS f32x2* Z, const LAS f32x2* TW, int tid, const float (&va)[8], const float (&vb)[8]) {
#pragma unroll
    for (int i = 0; i < 8; ++i) { const int t = 8 * tid + i; const f32x2 z = {va[i], vb[i]}; Z[t + (t >> 4)] = z; const int t2 = 4096 + t; Z[t2 + (t2 >> 4)] = cmul(z, TW[t]); }
    __syncthreads();
}
__device__ __forceinline__ void hy_conv(LAS f32x2* Z, const LAS f32x2* TW, int tid, const f32x2* Hg) {
    f32x2 H[16];
    { const int f = tid >> 8, j = tid & 255, base = f * 4096;
#pragma unroll
      for (int r = 0; r < 16; ++r) H[r] = Hg[base + j + 256 * r]; }
    fft_pass<1, 0>(Z, TW, tid, nullptr); fft_pass<16, 0>(Z, TW, tid, nullptr); fft_pass<256, 0>(Z, TW, tid, nullptr);
    fft_pass<1, 1>(Z, TW, tid, H); fft_pass<16, 0>(Z, TW, tid, nullptr); fft_pass<256, 0>(Z, TW, tid, nullptr);
}
__device__ __forceinline__ f32x2 hy_out(const LAS f32x2* Z, const LAS f32x2* TW, int t) {
    const f32x2 se = Z[t + (t >> 4)]; const int t2 = 4096 + t; const f32x2 so = Z[t2 + (t2 >> 4)]; const f32x2 tw = TW[t];
    const f32x2 So = {so.y, so.x};
    return (f32x2){se.y + (So.x * tw.x + So.y * tw.y), se.x + (So.y * tw.x - So.x * tw.y)};
}
__device__ __forceinline__ void hyena_item(const Args& a, LAS unsigned char* lds, int l, int c, int bp, int tid) {
    asm volatile("" : "+v"(tid));
    LAS f32x2* Z = (LAS f32x2*)lds; const LAS f32x2* TW = (const LAS f32x2*)(lds + 69632);
    const bf16_t* UT = (const bf16_t*)(a.ws + WS_UT); bf16_t* YT = (bf16_t*)(a.ws + WS_YT);
    const float* cw = a.in[I_HCW] + (size_t)l * 3 * 768; const float* cb = a.in[I_HCB] + (size_t)l * 768; const float* skip = a.in[I_HSKIP] + (size_t)l * 2 * 256;
    const f32x2* HS = (const f32x2*)(a.ws + WS_HS) + ((size_t)(l * 2) * 256 + c) * 8192;
    const int b0 = 2 * bp, b1 = 2 * bp + 1;
    float va[8], vb[8], xa[8], xb[8];
    load_uc(UT, cw, cb, c, b0, tid, va); load_uc(UT, cw, cb, c, b1, tid, vb);
    hy_fill(Z, TW, tid, va, vb);
    hy_conv(Z, TW, tid, HS);
    load_uc(UT, cw, cb, 256 + c, b0, tid, xa); load_uc(UT, cw, cb, 256 + c, b1, tid, xb);
    { const float sk = skip[c];
#pragma unroll
      for (int i = 0; i < 8; ++i) { const f32x2 y = hy_out(Z, TW, 8 * tid + i); va[i] = xa[i] * (y.x + va[i] * sk); vb[i] = xb[i] * (y.y + vb[i] * sk); } }
    __syncthreads();
    hy_fill(Z, TW, tid, va, vb);
    hy_conv(Z, TW, tid, HS + (size_t)256 * 8192);
    load_uc(UT, cw, cb, 512 + c, b0, tid, xa); load_uc(UT, cw, cb, 512 + c, b1, tid, xb);
    { const float sk = skip[256 + c];
      float oa[8], ob[8];
#pragma unroll
      for (int i = 0; i < 8; ++i) { const f32x2 y = hy_out(Z, TW, 8 * tid + i); oa[i] = xa[i] * (y.x + va[i] * sk); ob[i] = xb[i] * (y.y + vb[i] * sk); }
      u32x4 wa, wb; wa.x = pk2(oa[0], oa[1]); wa.y = pk2(oa[2], oa[3]); wa.z = pk2(oa[4], oa[5]); wa.w = pk2(oa[6], oa[7]); wb.x = pk2(ob[0], ob[1]); wb.y = pk2(ob[2], ob[3]); wb.z = pk2(ob[4], ob[5]); wb.w = pk2(ob[6], ob[7]);
      *(u32x4*)(YT + ((size_t)(b0 * 256 + c)) * 4096 + 8 * tid) = wa; *(u32x4*)(YT + ((size_t)(b1 * 256 + c)) * 4096 + 8 * tid) = wb; }
    __syncthreads();
}
__device__ __forceinline__ void spectrum_item(const Args& a, LAS unsigned char* lds, int item, int tid) {
    asm volatile("" : "+v"(tid));
    LAS f32x2* Z = (LAS f32x2*)lds; const LAS f32x2* TW = (const LAS f32x2*)(lds + 69632);
    const int c = item & 255, lo = item >> 8;
    const float* HC = (const float*)(a.ws + WS_HC) + ((size_t)lo * 256 + c) * 8192;
    { const f32x4 hl0 = *(const f32x4*)(HC + 4095 + 8 * tid), hl1 = *(const f32x4*)(HC + 4095 + 8 * tid + 4);
      float hlv[8] = {hl0[0], hl0[1], hl0[2], hl0[3], hl1[0], hl1[1], hl1[2], hl1[3]}; float hhv[8];
#pragma unroll
      for (int i = 0; i < 8; ++i) { const int t = 8 * tid + i; hhv[i] = (t == 0) ? 0.f : HC[t - 1]; }
#pragma unroll
      for (int i = 0; i < 8; ++i) { const int t = 8 * tid + i; const float hl = hlv[i], hh = hhv[i];
        Z[t + (t >> 4)] = (f32x2){hl + hh, 0.f}; const int t2 = 4096 + t; const f32x2 tw = TW[t]; const float dd = hl - hh; Z[t2 + (t2 >> 4)] = (f32x2){dd * tw.x, dd * tw.y}; } }
    __syncthreads();
    fft_pass<1, 0>(Z, TW, tid, nullptr); fft_pass<16, 0>(Z, TW, tid, nullptr); fft_pass<256, 0>(Z, TW, tid, nullptr);
    f32x2* HS = (f32x2*)(a.ws + WS_HS) + (size_t)item * 8192;
#pragma unroll
    for (int i = 0; i < 16; ++i) { const int idx = tid + 512 * i; HS[idx] = Z[idx + (idx >> 4)] * (1.0f / 8192.0f); }
    __syncthreads();
}
__device__ __forceinline__ void load_tw(const Args& a, LAS unsigned char* lds, int tid) {
    asm volatile("" : "+v"(tid));
    LAS f32x2* TW = (LAS f32x2*)(lds + 69632); const f32x2* src = (const f32x2*)(a.ws + WS_TW8);
    for (int i = tid; i < 4096; i += NTHR) { TW[i] = src[i]; const int r = i >> 8, k = i & 255; TW[4096 + i] = src[r * k * 2]; }
    if (tid < 256) { const int r = tid >> 4, k = tid & 15; TW[8192 + tid] = src[r * k * 32]; }
    __syncthreads();
}
__device__ __forceinline__ float ctx_uc(const bf16_t* PXc, const float* cw, const float* cb, int ch, int t) {
    const float u1 = bf2f(PXc[(size_t)t * INW + ch]); const float u0 = (t > 0) ? bf2f(PXc[(size_t)(t - 1) * INW + ch]) : 0.f; const float u2 = (t < 255) ? bf2f(PXc[(size_t)(t + 1) * INW + ch]) : 0.f;
    return u0 * cw[ch] + u1 * cw[768 + ch] + u2 * cw[1536 + ch] + cb[ch];
}
__device__ __forceinline__ void ctx_conv16(const LAS float* IN, const float* H, int c, int lane, int t0, float (&acc)[16]) {
    float w[16];
    const float* hp = H + (size_t)(t0 + 255) * 256 + c;
#pragma unroll
    for (int i = 0; i < 16; ++i) { acc[i] = 0.f; w[i] = hp[i * 256]; }
    const LAS float* ip = IN + lane;
#pragma unroll 1
    for (int s0 = 0; s0 < 256; s0 += 16) {
#pragma unroll
        for (int u = 0; u < 16; ++u) { const float v = ip[u * 64];
#pragma unroll
            for (int i = 0; i < 16; ++i) acc[i] += v * w[(i - u + 16) & 15];
            w[(15 - u) & 15] = hp[-(u + 1) * 256]; }
        hp -= 16 * 256; ip += 16 * 64; }
}
__device__ __forceinline__ void ctx_hyena_item(const Args& a, LAS unsigned char* lds, int l, int item, int tid) {
    asm volatile("" : "+v"(tid));
    const int lane = tid & 63, wave = tid >> 6, b = item >> 2, c = (item & 3) * 64 + lane;
    LAS float* V = (LAS float*)lds; LAS float* Z1 = (LAS float*)(lds + 65536);
    const bf16_t* PXc = (const bf16_t*)(a.ws + WS_PX) + (size_t)(TX + b * 256) * INW; bf16_t* Y = (bf16_t*)(a.ws + WS_Y) + (size_t)(TX + b * 256) * D;
    const float* cw = a.in[I_HCW] + (size_t)l * 3 * 768; const float* cb = a.in[I_HCB] + (size_t)l * 768; const float* skip = a.in[I_HSKIP] + (size_t)l * 2 * 256;
    const float* H0 = (const float*)(a.ws + WS_HCC) + 256, *H1 = H0 + (size_t)511 * 256;
#pragma unroll 2
    for (int i = 0; i < 32; ++i) { const int t = wave * 32 + i; V[t * 64 + lane] = ctx_uc(PXc, cw, cb, c, t); }
    __syncthreads();
    float acc[16];
#pragma unroll 1
    for (int g = 0; g < 2; ++g) { const int t0 = wave * 32 + g * 16; ctx_conv16(V, H0, c, lane, t0, acc); const float sk = skip[c];
#pragma unroll
        for (int i = 0; i < 16; ++i) { const int t = t0 + i; Z1[t * 64 + lane] = ctx_uc(PXc, cw, cb, 256 + c, t) * (acc[i] + V[t * 64 + lane] * sk); } }
    __syncthreads();
#pragma unroll 1
    for (int g = 0; g < 2; ++g) { const int t0 = wave * 32 + g * 16; ctx_conv16(Z1, H1, c, lane, t0, acc); const float sk = skip[256 + c];
#pragma unroll
        for (int i = 0; i < 16; ++i) { const int t = t0 + i; Y[(size_t)t * D + c] = (bf16_t)f2bf(ctx_uc(PXc, cw, cb, 512 + c, t) * (acc[i] + Z1[t * 64 + lane] * sk)); } }
    __syncthreads();
}

__device__ __forceinline__ void ytr_item(const Args& a, LAS unsigned char* tile, int item, int lane) {
    const int b = item >> 8, tt = (item >> 2) & 63, ct = item & 3;
    const bf16_t* src = (const bf16_t*)(a.ws + WS_YT) + ((size_t)(b * 256 + ct * 64)) * 4096 + tt * 64; bf16_t* Y = (bf16_t*)(a.ws + WS_Y) + ((size_t)b * 4096 + tt * 64) * D + ct * 64;
    u32x4 v[8];
#pragma unroll
    for (int i = 0; i < 8; ++i) v[i] = *(const u32x4*)(src + (size_t)((lane >> 3) + 8 * i) * 4096 + (lane & 7) * 8);
#pragma unroll
    for (int i = 0; i < 8; ++i) *(LAS u32x4*)(tile + ((lane >> 3) + 8 * i) * 144 + (lane & 7) * 16) = v[i];
    LDS_WAIT();
    const LAS unsigned short* tp = (const LAS unsigned short*)(tile + lane * 2);
#pragma unroll
    for (int q = 0; q < 8; ++q) { u32x4 o;
        o.x = (unsigned)tp[(8 * q + 0) * 72] | ((unsigned)tp[(8 * q + 1) * 72] << 16); o.y = (unsigned)tp[(8 * q + 2) * 72] | ((unsigned)tp[(8 * q + 3) * 72] << 16);
        o.z = (unsigned)tp[(8 * q + 4) * 72] | ((unsigned)tp[(8 * q + 5) * 72] << 16); o.w = (unsigned)tp[(8 * q + 6) * 72] | ((unsigned)tp[(8 * q + 7) * 72] << 16);
        *(u32x4*)(Y + (size_t)lane * D + 8 * q) = o; }
    LDS_WAIT();
}
__device__ __forceinline__ void event_arrive(unsigned* ctr) {
    asm volatile("s_waitcnt vmcnt(0)" ::: "memory"); __syncthreads();
    if (threadIdx.x == 0) { __builtin_amdgcn_fence(__ATOMIC_RELEASE, "agent"); asm volatile("s_waitcnt vmcnt(0)" ::: "memory"); __hip_atomic_fetch_add(ctr, 1u, __ATOMIC_RELAXED, __HIP_MEMORY_SCOPE_AGENT); }
}
__device__ __forceinline__ void event_wait(unsigned* ctr, unsigned want) {
    if (threadIdx.x == 0) { unsigned sp = 0;
        while (__hip_atomic_load(ctr, __ATOMIC_RELAXED, __HIP_MEMORY_SCOPE_AGENT) < want) { __builtin_amdgcn_s_sleep(2); if (++sp > (1u << 22)) break; }
        __builtin_amdgcn_fence(__ATOMIC_ACQUIRE, "agent"); asm volatile("s_waitcnt vmcnt(0)" ::: "memory"); }
    __syncthreads();
}

typedef short bf16x8_t __attribute__((ext_vector_type(8)));
typedef short s16x4_t __attribute__((ext_vector_type(4)));
typedef float f32x16 __attribute__((ext_vector_type(16)));
__device__ __forceinline__ int crow(int r, int hi) { return (r & 3) + 8 * (r >> 2) + 4 * hi; }
__device__ __forceinline__ unsigned cvtpk(float lo, float hi) { f32x2 v = {lo, hi}; bf16x2_t b = __builtin_convertvector(v, bf16x2_t); return __builtin_bit_cast(unsigned, b); }
__device__ __forceinline__ s16x4_t vtr(const LAS unsigned char* p) { return __builtin_bit_cast(s16x4_t, __builtin_amdgcn_ds_read_tr16_b64_v4i16((LAS s16x4_t*)p)); }
constexpr int AT_K = 0, AT_V = 16384, AT_WSF = 32768, AT_OST = 34816, AT_RPB = 67584, AT_END = 69632;
template <int KIND>
__device__ __forceinline__ void attn_unit(const Args& a, LAS unsigned char* lds, int l, int u, int wave_, CvtStream& cs, int cstride) {
    int lane = (int)__builtin_amdgcn_mbcnt_hi(~0u, __builtin_amdgcn_mbcnt_lo(~0u, 0u)); asm volatile("" : "+v"(lane));
    const int wid = wave_, tid = wave_ * 64 + lane, r32 = lane & 31, hi = lane >> 5;
    const bf16_t* PX = (const bf16_t*)(a.ws + WS_PX); bf16_t* Y = (bf16_t*)(a.ws + WS_Y);
    int b, qcol, kcol, vcol, ycol, qrow0, nloc = 0, lo = 0; bool sink = false; int hsink = 0;
    int qpos0 = 0, blk = 0, rq = 0, cbase = 0, rq4 = 0;
    if (KIND == 0) { b = u >> 6; const int kvh = (u >> 5) & 1; blk = u & 31; const int h = 2 * kvh + (wid >> 2); qpos0 = blk * 128 + 32 * (wid & 3); qrow0 = b * 4096 + qpos0;
        qcol = 1024 + h * 64; kcol = 1536 + kvh * 64; vcol = 1664 + kvh * 64; ycol = 256 + h * 64; lo = (blk == 0) ? 2 : 0; nloc = ((blk == 31) ? 3 : 5) - lo + 1; sink = true; hsink = h; }
    else if (KIND == 1) { b = u >> 6; const int h = (u >> 4) & 3; rq4 = u & 15; rq = 4 * rq4 + (wid >> 1); cbase = 32 * (wid & 1); qrow0 = b * 4096 + rq * 64 + cbase;
        qcol = 1280 + h * 64; kcol = 1792 + h * 64; vcol = 2048 + h * 64; ycol = 768 + h * 64;
        const int ra = 4 * rq4 - 4, rb = 4 * rq4 + 3 - 4; lo = ra < 0 ? 0 : (ra > 56 ? 56 : ra); const int hi_r = (rb < 0 ? 0 : (rb > 56 ? 56 : rb)) + 7; nloc = hi_r - lo + 1;
        LAS float* rpbL = (LAS float*)(lds + AT_RPB); const float* src = a.in[I_RPB] + (size_t)(l * 4 + h) * 465;
        for (int i = tid; i < 465; i += NTHR) rpbL[i] = src[i] * 8.0f; }
    else { b = u >> 3; const int h = (u >> 1) & 3; qrow0 = TX + b * 256 + 32 * wid;
        if ((u & 1) == 0) { qcol = 1024 + h * 64; kcol = 1536 + (h >> 1) * 64; vcol = 1664 + (h >> 1) * 64; ycol = 256 + h * 64; sink = true; hsink = h; }
        else { qcol = 1280 + h * 64; kcol = 1792 + h * 64; vcol = 2048 + h * 64; ycol = 768 + h * 64; } }
    const int NT = nloc + 4;
    bf16x8_t qr[4];
    { const bf16_t* qp = PX + (size_t)(qrow0 + r32) * INW + qcol + hi * 8;
#pragma unroll
      for (int d0 = 0; d0 < 4; ++d0) qr[d0] = *(const bf16x8_t*)(qp + d0 * 16); }
    const int krow = 8 * wid + (lane & 7), kchunk = lane >> 3; const int vrow = 16 * (wid & 3) + (lane >> 2), vcoff = (wid >> 2) * 32 + (lane & 3) * 8;
    const int kdst = AT_K + kchunk * 1024 + krow * 16, vdst = AT_V + wid * 1024 + lane * 16;
    auto tile_row0 = [&](int t) -> int { if (t < nloc) { if (KIND == 0) return b * 4096 + blk * 128 - 128 + 64 * (lo + t); else return b * 4096 + (lo + t) * 64; } return TX + b * 256 + 64 * (t - nloc); };
    u32x4 gk0, gv0, gk1, gv1;
#define AT_LOAD(GK, GV, t_) do { const int R0_ = tile_row0(t_); GK = *(const u32x4*)(PX + (size_t)(R0_ + krow) * INW + kcol + kchunk * 8); GV = *(const u32x4*)(PX + (size_t)(R0_ + vrow) * INW + vcol + vcoff); } while (0)
    AT_LOAD(gk0, gv0, 0);
    if (NT > 1) AT_LOAD(gk1, gv1, 1); else { gk1 = gk0; gv1 = gv0; }
    *(LAS u32x4*)(lds + kdst) = gk0; *(LAS u32x4*)(lds + vdst) = gv0;
    float mhat = -1e30f, l_reg = 0.f; f32x16 o[2];
#pragma unroll
    for (int r = 0; r < 16; ++r) { o[0][r] = 0.f; o[1][r] = 0.f; }
    LAS float* wsf = (LAS float*)(lds + AT_WSF) + wid * 64;
    const LAS unsigned char* vb0 = lds + AT_V + ((lane >> 4) & 1) * 32 + (lane & 3) * 8 + (4 * hi + ((lane & 15) >> 2)) * 64;
    const LAS unsigned char* kb0 = lds + AT_K + hi * 1024 + r32 * 16;
    __syncthreads();
    auto step = [&](int t, u32x4& gkw, u32x4& gvw, u32x4& gkl, u32x4& gvl) __attribute__((always_inline)) {
        const int bufo = (t & 1) * 8192;
        cvt_issue(a, cs, lane);
        if (t + 2 < NT) AT_LOAD(gkl, gvl, t + 2);
        bool need = true; bool full = true; int ts = 0, rk = 0;
        if (t < nloc) {
            if (KIND == 0) { ts = blk * 128 - 128 + 64 * (lo + t); need = (ts + 63 >= qpos0 - 128) && (ts <= qpos0 + 31 + 128); full = (qpos0 + 31 - ts <= 128) && (ts + 63 - qpos0 <= 128); }
            if (KIND == 1) { rk = lo + t; const int r0 = (rq - 4) < 0 ? 0 : ((rq - 4) > 56 ? 56 : (rq - 4)); need = (rk >= r0) && (rk <= r0 + 7); full = false; }
        }
        if (need) {
            f32x16 p0, p1;
#pragma unroll
            for (int r = 0; r < 16; ++r) { p0[r] = 0.f; p1[r] = 0.f; }
            const LAS unsigned char* kb = kb0 + bufo;
#pragma unroll
            for (int d0 = 0; d0 < 4; ++d0) { const bf16x8_t k0 = *(const LAS bf16x8_t*)(kb + d0 * 2048), k1 = *(const LAS bf16x8_t*)(kb + d0 * 2048 + 512);
                p0 = __builtin_amdgcn_mfma_f32_32x32x16_bf16(k0, qr[d0], p0, 0, 0, 0); p1 = __builtin_amdgcn_mfma_f32_32x32x16_bf16(k1, qr[d0], p1, 0, 0, 0); }
            constexpr float C2 = 0.125f * LOG2E;
            if (!full) {
                if (KIND == 0) { const int tq = qpos0 + r32;
#pragma unroll
                    for (int r = 0; r < 16; ++r) { const int k0 = ts + crow(r, hi), d0 = tq - k0, d1 = d0 - 32; p0[r] = (d0 > 128 || d0 < -128) ? -INFINITY : p0[r]; p1[r] = (d1 > 128 || d1 < -128) ? -INFINITY : p1[r]; } }
                if (KIND == 1) { const int c = cbase + r32; const int wsc = (c - 8) < 0 ? 0 : ((c - 8) > 48 ? 48 : (c - 8)); const LAS float* rp = (const LAS float*)(lds + AT_RPB) + (rk - rq + 7) * 31 + 15 - c;
                    { float b0[16];
#pragma unroll
                      for (int r = 0; r < 16; ++r) { const int c0 = crow(r, hi); const int i0 = c0 < wsc ? wsc : (c0 > wsc + 15 ? wsc + 15 : c0); b0[r] = rp[i0]; }
#pragma unroll
                      for (int r = 0; r < 16; ++r) { const int c0 = crow(r, hi); const bool ok0 = (c0 >= wsc) && (c0 < wsc + 16); p0[r] = ok0 ? p0[r] + b0[r] : -INFINITY; } }
                    asm volatile("" : "+v"(p0) :: "memory");
                    { float b1[16];
#pragma unroll
                      for (int r = 0; r < 16; ++r) { const int c1 = crow(r, hi) + 32; const int i1 = c1 < wsc ? wsc : (c1 > wsc + 15 ? wsc + 15 : c1); b1[r] = rp[i1]; }
#pragma unroll
                      for (int r = 0; r < 16; ++r) { const int c1 = crow(r, hi) + 32; const bool ok1 = (c1 >= wsc) && (c1 < wsc + 16); p1[r] = ok1 ? p1[r] + b1[r] : -INFINITY; } } }
            }
            float rm = fmaxf(p0[0], p1[0]);
#pragma unroll
            for (int r = 1; r < 16; ++r) rm = fmaxf(rm, fmaxf(p0[r], p1[r]));
            { auto rr = __builtin_amdgcn_permlane32_swap(__float_as_uint(rm), __float_as_uint(rm), false, false); rm = fmaxf(__uint_as_float(rr[0]), __uint_as_float(rr[1])); }
            const float mnew = fmaxf(mhat, rm); const float f = __builtin_amdgcn_exp2f((mhat - mnew) * C2); const bool grew = mnew > mhat; mhat = mnew;
            const float nm = -mnew * C2; float sacc = 0.f;
#pragma unroll
            for (int r = 0; r < 16; ++r) { p0[r] = __builtin_amdgcn_exp2f(fmaf(p0[r], C2, nm)); p1[r] = __builtin_amdgcn_exp2f(fmaf(p1[r], C2, nm)); sacc += p0[r] + p1[r]; }
            l_reg = l_reg * f + sacc;
            if (__any(grew)) { if (hi == 0) wsf[r32] = f; LDS_WAIT();
#pragma unroll
                for (int r = 0; r < 16; ++r) { const float fr_ = wsf[crow(r, hi)]; o[0][r] *= fr_; o[1][r] *= fr_; }
                LDS_WAIT(); }
            u32x4 pw0, pw1, pw2, pw3;
            pw0 = (u32x4){cvtpk(p0[0], p0[1]), cvtpk(p0[2], p0[3]), cvtpk(p0[4], p0[5]), cvtpk(p0[6], p0[7])}; pw1 = (u32x4){cvtpk(p0[8], p0[9]), cvtpk(p0[10], p0[11]), cvtpk(p0[12], p0[13]), cvtpk(p0[14], p0[15])};
            pw2 = (u32x4){cvtpk(p1[0], p1[1]), cvtpk(p1[2], p1[3]), cvtpk(p1[4], p1[5]), cvtpk(p1[6], p1[7])}; pw3 = (u32x4){cvtpk(p1[8], p1[9]), cvtpk(p1[10], p1[11]), cvtpk(p1[12], p1[13]), cvtpk(p1[14], p1[15])};
            const LAS unsigned char* vb = vb0 + bufo;
#pragma unroll
            for (int d0 = 0; d0 < 2; ++d0) {
#pragma unroll
                for (int ks = 0; ks < 4; ++ks) { const s16x4_t vl = vtr(vb + d0 * 4096 + ks * 1024), vh = vtr(vb + d0 * 4096 + ks * 1024 + 512);
                    const bf16x8_t vf = (bf16x8_t){vl[0], vl[1], vl[2], vl[3], vh[0], vh[1], vh[2], vh[3]};
                    const bf16x8_t pa = __builtin_bit_cast(bf16x8_t, ks == 0 ? pw0 : (ks == 1 ? pw1 : (ks == 2 ? pw2 : pw3)));
                    o[d0] = __builtin_amdgcn_mfma_f32_32x32x16_bf16(pa, vf, o[d0], 0, 0, 0); } }
        }
        cvt_finish(a, cs, (LAS float*)(lds + 73728) + wid * 2112, lane, cstride);
        if (t + 1 < NT) { const int nb = ((t + 1) & 1) * 8192; *(LAS u32x4*)(lds + kdst + nb) = gkw; *(LAS u32x4*)(lds + vdst + nb) = gvw; }
        __syncthreads();
    };
    for (int t = 0; t < NT; t += 2) { step(t, gk1, gv1, gk0, gv0); if (t + 1 < NT) step(t + 1, gk0, gv0, gk1, gv1); }
#undef AT_LOAD
    { auto rr = __builtin_amdgcn_permlane32_swap(__float_as_uint(l_reg), __float_as_uint(l_reg), false, false); l_reg = __uint_as_float(rr[0]) + __uint_as_float(rr[1]); }
    if (sink) l_reg += __builtin_amdgcn_exp2f(a.in[I_SINK][l * 4 + hsink] * LOG2E - mhat * (0.125f * LOG2E));
    if (hi == 0) wsf[32 + r32] = 1.0f / l_reg;
    LDS_WAIT();
    LAS bf16_t* stg = (LAS bf16_t*)(lds + AT_OST) + wid * 2048;
#pragma unroll
    for (int r = 0; r < 16; ++r) { const int orow = crow(r, hi); const float il = wsf[32 + orow];
        stg[orow * 64 + r32] = (bf16_t)f2bf(o[0][r] * il); stg[orow * 64 + 32 + r32] = (bf16_t)f2bf(o[1][r] * il); }
    LDS_WAIT();
#pragma unroll
    for (int i = 0; i < 4; ++i) { const int row = i * 8 + (lane >> 3), ch = lane & 7; const u32x4 v = *(const LAS u32x4*)(stg + row * 64 + ch * 8);
        *(u32x4*)(Y + (size_t)(qrow0 + row) * D + ycol + ch * 8) = v; }
    __syncthreads();
}


template <int HW>
__device__ __forceinline__ void pool_tile(const bf16_t* PX, bf16_t* Y, const float* pscale, int tile, int g, int lane, const bf16x8_t (&wf)[4][2]) {
    const int tk = lane & 15, oc = lane >> 4; const int row = tile * 16 + tk; const bool lat = row < TX; const int tpos = lat ? (row & 4095) : ((row - TX) & 255); const int Ls = lat ? 4096 : 256;
    const bf16_t* pr = PX + (size_t)row * INW + 768 + g * 64 + 8 * oc;
    u32x4 w0[2 * HW], w1[2 * HW];
#pragma unroll
    for (int i = 0; i < 2 * HW; ++i) { const int off = i - HW; const int tp = tpos + off; const bool inr = (tp >= 0) && (tp < Ls); const bf16_t* p = pr + (ptrdiff_t)(inr ? off : 0) * INW; w0[i] = *(const u32x4*)p; w1[i] = *(const u32x4*)(p + 32); }
    float s0[8], s1[8]; int cnt = 0;
#pragma unroll
    for (int j = 0; j < 8; ++j) { s0[j] = 0.f; s1[j] = 0.f; }
#pragma unroll
    for (int i = 0; i < 2 * HW; ++i) { const int tp = tpos + i - HW; const bool in = (tp >= 0) && (tp < Ls); const float m = in ? 1.0f : 0.0f; cnt += in ? 1 : 0;
        s0[0] += m * bflo(w0[i].x); s0[1] += m * bfhi(w0[i].x); s0[2] += m * bflo(w0[i].y); s0[3] += m * bfhi(w0[i].y); s0[4] += m * bflo(w0[i].z); s0[5] += m * bfhi(w0[i].z); s0[6] += m * bflo(w0[i].w); s0[7] += m * bfhi(w0[i].w);
        s1[0] += m * bflo(w1[i].x); s1[1] += m * bfhi(w1[i].x); s1[2] += m * bflo(w1[i].y); s1[3] += m * bfhi(w1[i].y); s1[4] += m * bflo(w1[i].z); s1[5] += m * bfhi(w1[i].z); s1[6] += m * bflo(w1[i].w); s1[7] += m * bfhi(w1[i].w); }
    const float ic = 1.0f / (float)cnt; const u32x4 c0 = w0[HW], c1 = w1[HW];
    const float u0[8] = {bflo(c0.x), bfhi(c0.x), bflo(c0.y), bfhi(c0.y), bflo(c0.z), bfhi(c0.z), bflo(c0.w), bfhi(c0.w)}, u1[8] = {bflo(c1.x), bfhi(c1.x), bflo(c1.y), bfhi(c1.y), bflo(c1.z), bfhi(c1.z), bflo(c1.w), bfhi(c1.w)};
    u32x4 d0, d1;
    d0.x = cvtpk(s0[0] * ic - u0[0], s0[1] * ic - u0[1]); d0.y = cvtpk(s0[2] * ic - u0[2], s0[3] * ic - u0[3]); d0.z = cvtpk(s0[4] * ic - u0[4], s0[5] * ic - u0[5]); d0.w = cvtpk(s0[6] * ic - u0[6], s0[7] * ic - u0[7]);
    d1.x = cvtpk(s1[0] * ic - u1[0], s1[1] * ic - u1[1]); d1.y = cvtpk(s1[2] * ic - u1[2], s1[3] * ic - u1[3]); d1.z = cvtpk(s1[4] * ic - u1[4], s1[5] * ic - u1[5]); d1.w = cvtpk(s1[6] * ic - u1[6], s1[7] * ic - u1[7]);
    const bf16x8_t b0 = __builtin_bit_cast(bf16x8_t, d0), b1 = __builtin_bit_cast(bf16x8_t, d1);
    bf16_t* yr = Y + (size_t)row * D + 512 + g * 64 + 4 * oc;
#pragma unroll
    for (int nt = 0; nt < 4; ++nt) { f32x4 acc = {0.f, 0.f, 0.f, 0.f};
        acc = __builtin_amdgcn_mfma_f32_16x16x32_bf16(wf[nt][0], b0, acc, 0, 0, 0); acc = __builtin_amdgcn_mfma_f32_16x16x32_bf16(wf[nt][1], b1, acc, 0, 0, 0);
        const f32x4 sc = *(const f32x4*)(pscale + g * 64 + 16 * nt + 4 * oc); acc *= sc;
        u32x2 ov; ov.x = cvtpk(acc[0], acc[1]); ov.y = cvtpk(acc[2], acc[3]); *(u32x2*)(yr + 16 * nt) = ov; }
}
__device__ __forceinline__ void phase_mix1(const Args& a, unsigned char* ldsg, int vcu, int G, int l) {
    LAS unsigned char* lds = (LAS unsigned char*)ldsg;
    int tid_ = threadIdx.x; asm volatile("" : "+v"(tid_));
    const int tid = tid_, lane = tid & 63, wave = __builtin_amdgcn_readfirstlane(tid >> 6);
    unsigned char* ws = a.ws; asm volatile("" : "+s"(ws)); const bf16_t* PX = (const bf16_t*)(ws + WS_PX); bf16_t* Y = (bf16_t*)(ws + WS_Y);
    const bool upd = (l == 0); const int nrows = upd ? TT : TX;
    const int gw = vcu * NWAVES + wave, NGW = G * NWAVES;
    { AMP_BEGIN(31) load_tw(a, lds, tid);
    for (int it = vcu; it < 1024; it += G) hyena_item(a, lds, l, it >> 2, it & 3, tid);
    if (upd) for (int it = vcu; it < 32; it += G) ctx_hyena_item(a, lds, l, it, tid);
    event_arrive((unsigned*)(ws + WS_CTL) + 8192 + 64 * l); AMP_END(31) }
    { AMP_BEGIN(32)
    { const int g = gw & 3; const float* pwg = a.in[I_POOLW] + (size_t)(l * 4 + g) * 4096; const float* pscale = a.in[I_POOLS] + (size_t)l * 256;
      bf16x8_t wf[4][2];
#pragma unroll
      for (int nt = 0; nt < 4; ++nt)
#pragma unroll
          for (int ks = 0; ks < 2; ++ks) { const float* wp = pwg + (size_t)(32 * ks + 8 * (lane >> 4)) * 64 + 16 * nt + (lane & 15); u32x4 w;
              w.x = cvtpk(wp[0], wp[64]); w.y = cvtpk(wp[128], wp[192]); w.z = cvtpk(wp[256], wp[320]); w.w = cvtpk(wp[384], wp[448]); wf[nt][ks] = __builtin_bit_cast(bf16x8_t, w); }
      const int ntiles = nrows / 16;
      for (int it = gw; it < ntiles * 4; it += NGW) { const int tile = it >> 2;
          if (g == 0) pool_tile<1>(PX, Y, pscale, tile, g, lane, wf); else if (g == 1) pool_tile<2>(PX, Y, pscale, tile, g, lane, wf); else if (g == 2) pool_tile<4>(PX, Y, pscale, tile, g, lane, wf); else pool_tile<8>(PX, Y, pscale, tile, g, lane, wf); } }
    __syncthreads(); AMP_END(32) }
    { AMP_BEGIN(33)
    CvtStream cs; cs.it = upd ? gw : CVT_ITEMS; cs.end = CVT_ITEMS; cs.live = 0;
    for (int u = vcu; u < 512; u += G) attn_unit<0>(a, lds, l, u, wave, cs, NGW);
    for (int u = vcu; u < 512; u += G) attn_unit<1>(a, lds, l, u, wave, cs, NGW);
    if (upd) for (int u = vcu; u < 64; u += G) attn_unit<2>(a, lds, l, u, wave, cs, NGW);
    int lane2 = (int)__builtin_amdgcn_mbcnt_hi(~0u, __builtin_amdgcn_mbcnt_lo(~0u, 0u)); asm volatile("" : "+v"(lane2));
    while (cs.it < cs.end) { cvt_issue(a, cs, lane2); cvt_finish(a, cs, (LAS float*)(lds + 73728) + wave * 2112, lane2, NGW); }
    AMP_END(33) }
    { AMP_BEGIN(34) event_wait((unsigned*)(ws + WS_CTL) + 8192 + 64 * l, (unsigned)G);
      int lane3 = (int)__builtin_amdgcn_mbcnt_hi(~0u, __builtin_amdgcn_mbcnt_lo(~0u, 0u)); asm volatile("" : "+v"(lane3));
      for (int it = gw; it < 2048; it += NGW) ytr_item(a, lds + wave * 9216, it, lane3); AMP_END(34) }
}

__device__ __forceinline__ void phase_select(const Args& a, unsigned char* ldsg, int vcu, int G, bool with_ctx) {
    LAS unsigned* keys = (LAS unsigned*)(LAS unsigned char*)ldsg;
    LAS unsigned* hist = keys + 4096;
    LAS unsigned* ctl = hist + 256 + 64;
    int tid_ = threadIdx.x; asm volatile("" : "+v"(tid_));
    const int tid = tid_, lane = tid & 63; unsigned char* ws = a.ws; asm volatile("" : "+s"(ws));
    const float* AFFT = (const float*)(ws + WS_AFFT); int* ROWMAP = (int*)(ws + WS_ROWMAP); float* GATE = (float*)(ws + WS_GATE); int* INV = (int*)(ws + WS_INV);
    const int nitems = 128 + (with_ctx ? 128 : 0);
    for (int item = vcu; item < nitems; item += G) {
        int e, base, Ls, cap, slot0;
        if (item < 128) { const int b = item >> 4; e = item & 15; base = b * 4096; Ls = 4096; cap = CAPX; slot0 = b * CAPX; }
        else { const int it = item - 128; const int b = it >> 4; e = it & 15; base = TX + b * 256; Ls = 256; cap = CAPC; slot0 = NB * CAPX + b * CAPC; }
        unsigned k[8];
#pragma unroll
        for (int i = 0; i < 8; ++i) { const int idx = tid + NTHR * i; k[i] = (idx < Ls) ? __float_as_uint(AFFT[(size_t)e * TT + base + idx]) : 0u; if (idx < Ls) keys[idx] = k[i]; }
        if (tid == 0) { ctl[0] = 0u; ctl[1] = (unsigned)cap; ctl[2] = 0u; ctl[3] = 0u; }
        unsigned prefix = 0u;
#pragma unroll 1
        for (int p = 0; p < 4; ++p) { const int shift = 24 - 8 * p;
            if (tid < 256) hist[tid] = 0u;
            __syncthreads();
#pragma unroll
            for (int i = 0; i < 8; ++i) { const int idx = tid + NTHR * i; const bool cand = (idx < Ls) && (p == 0 || (k[i] >> (shift + 8)) == prefix);
                if (cand) atomicAdd((unsigned*)&hist[(k[i] >> shift) & 255u], 1u); }
            __syncthreads();
            if (tid < 64) {
                const unsigned need = ctl[1];
                const unsigned c0 = hist[255 - 4 * lane], c1 = hist[254 - 4 * lane], c2 = hist[253 - 4 * lane], c3 = hist[252 - 4 * lane];
                const unsigned s = c0 + c1 + c2 + c3;
                hist[256 + lane] = s; LDS_WAIT();
                unsigned inc = 0u;
                for (int q = 0; q < 64; ++q) { const unsigned v = hist[256 + q]; inc += (q <= lane) ? v : 0u; }
                const unsigned exc = inc - s;
                if (exc < need && inc >= need) { unsigned above = exc; int d;
                    if (above + c0 >= need) d = 255 - 4 * lane; else { above += c0; if (above + c1 >= need) d = 254 - 4 * lane; else { above += c1; if (above + c2 >= need) d = 253 - 4 * lane; else { above += c2; d = 252 - 4 * lane; } } }
                    ctl[0] = (prefix << 8) | (unsigned)d; ctl[1] = need - above; } }
            __syncthreads();
            prefix = ctl[0]; }
        const unsigned T = prefix; const unsigned need = ctl[1];
        int eqc = 0;
#pragma unroll
        for (int i = 0; i < 8; ++i) { const int idx = tid + NTHR * i; eqc += ((idx < Ls) && k[i] == T) ? 1 : 0; }
        if (eqc) atomicAdd((unsigned*)&ctl[3], (unsigned)eqc);
        __syncthreads();
        const bool all_eq = (ctl[3] == need);
#pragma unroll
        for (int i = 0; i < 8; ++i) { const int idx = tid + NTHR * i;
            if (idx < Ls && (k[i] > T || (all_eq && k[i] == T))) { const int s = (int)atomicAdd((unsigned*)&ctl[2], 1u); const int slot = e * SLOTS + slot0 + s;
                ROWMAP[slot] = base + idx; GATE[slot] = __uint_as_float(k[i]); INV[(size_t)(base + idx) * 16 + e] = slot; } }
        __syncthreads();
        if (!all_eq && tid == 0) {
            int s = (int)ctl[2]; unsigned left = need;
            for (int idx = 0; idx < Ls && left; ++idx) if (keys[idx] == T) { const int slot = e * SLOTS + slot0 + s; ROWMAP[slot] = base + idx; GATE[slot] = __uint_as_float(T); INV[(size_t)(base + idx) * 16 + e] = slot; ++s; --left; } }
        __syncthreads();
    }
}
__device__ __forceinline__ void phase_combine(const Args& a, int vcu, int G, int l, bool with_ctx, bool final_norm, bool next_norm) {
    int tid_ = threadIdx.x; asm volatile("" : "+v"(tid_));
    const int tid = tid_, lane = tid & 63, wave = __builtin_amdgcn_readfirstlane(tid >> 6); unsigned char* ws = a.ws; asm volatile("" : "+s"(ws));
    const int* INV = (const int*)(ws + WS_INV); const bf16_t* OB = (const bf16_t*)(ws + WS_XG); const float* MOD = (const float*)(ws + WS_MOD) + (size_t)l * 9 * 6144;
    const float* MODN = (const float*)(ws + WS_MOD) + (size_t)(l + 1) * 9 * 6144; const float* gainn = a.in[I_N1G] + (l + 1) * D; bf16_t* HX = (bf16_t*)(ws + WS_HX);
    bf16_t* XB = (bf16_t*)(ws + WS_XB); const float* fng = a.in[I_FNG];
    const int nrows = with_ctx ? TT : TX; const int gw = vcu * NWAVES + wave, NGW = G * NWAVES;
    const float pz = (final_norm && __hip_atomic_load((unsigned*)(ws + WS_CTL) + 12288, __ATOMIC_RELAXED, __HIP_MEMORY_SCOPE_AGENT) != 0u) ? __builtin_nanf("") : 0.f;
    for (int rowa = gw; rowa < nrows; rowa += 2 * NGW) {
        int myinv[2]; f32x4 xv[2][4]; f32x4 acc[2][4];
#pragma unroll
        for (int u = 0; u < 2; ++u) { const int row = rowa + u * NGW; const bool ok = row < nrows; const int rr = ok ? row : rowa;
            myinv[u] = (lane < 16 && ok) ? INV[(size_t)rr * 16 + lane] : -1;
            const bf16_t* xr = XB + (size_t)rr * D;
#pragma unroll
            for (int j = 0; j < 4; ++j) { const u32x2 w = *(const u32x2*)(xr + 256 * j + 4 * lane); xv[u][j] = (f32x4){bflo(w.x), bfhi(w.x), bflo(w.y), bfhi(w.y)}; acc[u][j] = (f32x4){0.f, 0.f, 0.f, 0.f}; } }
#pragma unroll
        for (int u = 0; u < 2; ++u) {
            unsigned long long mask = __ballot(myinv[u] >= 0) & 0xffffull;
            while (mask) { int sl[4];
#pragma unroll
                for (int q = 0; q < 4; ++q) { if (mask) { const int e = __builtin_ctzll(mask); mask &= mask - 1; sl[q] = __builtin_amdgcn_readlane(myinv[u], e); } else sl[q] = -1; }
                u32x2 w[4][4];
#pragma unroll
                for (int q = 0; q < 4; ++q) { const bf16_t* orow = OB + (size_t)(sl[q] >= 0 ? sl[q] : 0) * D;
#pragma unroll
                    for (int j = 0; j < 4; ++j) w[q][j] = *(const u32x2*)(orow + 256 * j + 4 * lane); }
#pragma unroll
                for (int q = 0; q < 4; ++q) { const float m = (sl[q] >= 0) ? 1.0f : 0.0f;
#pragma unroll
                    for (int j = 0; j < 4; ++j) { acc[u][j][0] += m * bflo(w[q][j].x); acc[u][j][1] += m * bfhi(w[q][j].x); acc[u][j][2] += m * bflo(w[q][j].y); acc[u][j][3] += m * bfhi(w[q][j].y); } } } }
#pragma unroll
        for (int u = 0; u < 2; ++u) { const int row = rowa + u * NGW; if (row < nrows) {
            const bool lat = row < TX; float* xr = a.out + (size_t)row * D; bf16_t* xbr = XB + (size_t)row * D; const int mrow = lat ? (row >> 12) : 8;
            const float* gp = MOD + mrow * 6144 + 5 * 1024; f32x4 v[4]; float ss = 0.f;
#pragma unroll
            for (int j = 0; j < 4; ++j) { const f32x4 g = *(const f32x4*)(gp + 256 * j + 4 * lane); v[j] = xv[u][j] + g * acc[u][j];
                ss += (v[j][0] * v[j][0] + v[j][1] * v[j][1]) + (v[j][2] * v[j][2] + v[j][3] * v[j][3]); }
            if (final_norm) { const float rstd = 1.0f / sqrtf(wave_sum(ss) * (1.0f / D) + 1e-6f);
#pragma unroll
                for (int j = 0; j < 4; ++j) { const f32x4 g = *(const f32x4*)(fng + 256 * j + 4 * lane); *(f32x4*)(xr + 256 * j + 4 * lane) = v[j] * rstd * g + pz; } }
            else {
#pragma unroll
                for (int j = 0; j < 4; ++j) { u32x2 o; o.x = pk2(v[j][0], v[j][1]); o.y = pk2(v[j][2], v[j][3]); *(u32x2*)(xbr + 256 * j + 4 * lane) = o; }
                if (next_norm) { const float rstd = 1.0f / sqrtf(wave_sum(ss) * (1.0f / D) + 1e-6f); const float* shp = MODN + mrow * 6144; const float* scp = shp + 1024;
#pragma unroll
                    for (int j = 0; j < 4; ++j) { const f32x4 gg = *(const f32x4*)(gainn + 256 * j + 4 * lane), sh = *(const f32x4*)(shp + 256 * j + 4 * lane), sc = *(const f32x4*)(scp + 256 * j + 4 * lane);
                        const f32x4 hv = (v[j] * rstd * gg) * (1.0f + sc) + sh; u32x2 o; o.x = pk2(hv[0], hv[1]); o.y = pk2(hv[2], hv[3]); *(u32x2*)(HX + (size_t)row * D + 256 * j + 4 * lane) = o; } } } } }
    }
}

#define XBAR() do { XcdBarrier b_; b_.bar = (unsigned*)(a.ws + WS_CTL); b_.x = __builtin_amdgcn_readfirstlane(bar.x); b_.st = (volatile LAS unsigned*)((LAS unsigned char*)lds + LDS_BYTES - 16); xcd_barrier(b_); if (AMP_PHASE == 99) xcd_barrier(b_); } while (0)

__global__ void __launch_bounds__(NTHR, 2) fwd_kernel(Args a) {
    extern __shared__ __attribute__((aligned(16))) unsigned char lds[];
    cg::grid_group grid = cg::this_grid();
    const int G = gridDim.x, bx = blockIdx.x; const int vcu = (G % 8 == 0) ? (bx % 8) * (G / 8) + bx / 8 : bx;
    unsigned char* ws = a.ws;
    PG8_LAS unsigned char* glds = (PG8_LAS unsigned char*)lds;
    volatile LAS unsigned* bst = (volatile LAS unsigned*)((LAS unsigned char*)lds + LDS_BYTES - 16);
    if (threadIdx.x < 4) bst[threadIdx.x] = 0u;
    __syncthreads();
    XcdBarrier bar = xcd_barrier_post((unsigned*)(ws + WS_CTL), bst);
    { AMP_BEGIN(0) phase_prologue(a, lds, vcu, G); AMP_END(0) }
    if (a.ws == nullptr) grid.sync();
    XBAR();
    for (int l = 0; l < 2; ++l) {
        const bool upd = (l == 0);
        asm volatile("" : "+s"(ws));
        const float* srcx = a.in[I_X]; const float* srcc = a.in[I_CTX];
        if (upd) {
            { AMP_BEGIN(1) phase_norm(a, lds, vcu, G, l, srcx, srcc, nullptr, a.in[I_N1G] + l * D, 0, TT, false); AMP_END(1) }
            { AMP_BEGIN(11) load_tw(a, (LAS unsigned char*)lds, threadIdx.x); for (int it = vcu; it < 1024; it += G) spectrum_item(a, (LAS unsigned char*)lds, it, threadIdx.x); AMP_END(11) }
            XBAR();
        }
        { AMP_BEGIN(2) pg8::Gemm g{(const pg8::bf16_t*)(ws + WS_HX), (const pg8::bf16_t*)(ws + WS_WIN_T) + (size_t)l * INW * D, TT, INW, D};
          pg8::GroupOrder S; S.init(1, TT / 256, INW / 256, 0, G, bx);
          { PG8_LAS float* rl = (PG8_LAS float*)(glds + 131072 + 20480); const float* rs = (const float*)(ws + WS_ROPE); int tx = threadIdx.x; asm volatile("" : "+v"(tx)); for (int i = tx; i < 2048; i += NTHR) rl[i] = rs[i]; __syncthreads(); }
          pg8::EpiIn E{(pg8::bf16_t*)(ws + WS_PX), (const PG8_LAS float*)(glds + 131072 + 20480), (pg8::bf16_t*)(ws + WS_UT), glds + 131072, 1.0f};
          pg8::gemm_phase<pg8::EpiIn, pg8::GroupOrder, true, true>(glds, g, S, E); AMP_END(2) }
        XBAR();
        { AMP_BEGIN(3) phase_mix1(a, lds, vcu, G, l); AMP_END(3) }
        XBAR();
        { AMP_BEGIN(4) pg8::Gemm g{(const pg8::bf16_t*)(ws + WS_Y), (const pg8::bf16_t*)(ws + WS_WOUT_T) + (size_t)l * D * D, TT, D, D};
          pg8::GroupOrder S; S.init(1, (upd ? TT : TX) / 256, D / 256, 0, G, bx);
          pg8::EpiOut E{a.in[I_X], a.in[I_CTX], (pg8::bf16_t*)(ws + WS_XB), (const float*)(ws + WS_MOD) + (size_t)l * 9 * 6144, upd ? 1 : 0};
          pg8::gemm_phase<pg8::EpiOut, pg8::GroupOrder, true, true>(glds, g, S, E); AMP_END(4) }
        XBAR();
        { AMP_BEGIN(5) phase_norm(a, lds, vcu, G, l, nullptr, nullptr, (const bf16_t*)(ws + WS_XB), a.in[I_N2G] + l * D, 3, upd ? TT : TX, true); AMP_END(5) }
        XBAR();
        { AMP_BEGIN(6) phase_select(a, lds, vcu, G, upd); AMP_END(6) }
        XBAR();
        { AMP_BEGIN(8) pg8::Gemm g{(const pg8::bf16_t*)(ws + WS_HX), (const pg8::bf16_t*)(ws + WS_WGU_T + (size_t)l * NE * 4096 * D), NE * SLOTS, NE * 4096, D};
          pg8::GroupOrder S; S.init(NE, upd ? 17 : 16, 16, 17, G, bx);
          { PG8_LAS float* sl = (PG8_LAS float*)(glds + 131072 + 17408); const float* ss = (const float*)(ws + WS_WSC) + l * 48; int tx = threadIdx.x; asm volatile("" : "+v"(tx)); if (tx < 32) sl[tx] = ss[tx]; __syncthreads(); }
          pg8::EpiGU E{(unsigned char*)(ws + WS_ACT), (const PG8_LAS float*)(glds + 131072 + 17408)};
          pg8::gemm_phase_gather<pg8::EpiGU, pg8::GroupOrder, true>(glds, g, (const int*)(ws + WS_ROWMAP), (PG8_LAS int*)(glds + 131072), S, E); AMP_END(8) }
        XBAR();
        { AMP_BEGIN(9) pg8::Gemm g{(const pg8::bf16_t*)(ws + WS_ACT), (const pg8::bf16_t*)(ws + WS_WD_T + (size_t)l * NE * D * FF), NE * SLOTS, NE * D, FF};
          pg8::GroupOrder S; S.init(NE, upd ? 17 : 16, 4, 17, G, bx);
          { PG8_LAS float* gl = (PG8_LAS float*)(glds + 131072); const float* gs = (const float*)(ws + WS_GATE); const float* ss = (const float*)(ws + WS_WSC) + l * 48 + 32; pg8::Unit uu; int tx = threadIdx.x; asm volatile("" : "+v"(tx));
            for (int i = 0; S.next(i, uu); ++i) if (tx < 256) gl[i * 256 + tx] = gs[uu.pm * 256 + tx] * ss[uu.pn >> 2];
            __syncthreads(); }
          pg8::EpiDown E{(pg8::bf16_t*)(ws + WS_XG), (const PG8_LAS float*)(glds + 131072)};
          pg8::gemm_phase<pg8::EpiDown, pg8::GroupOrder, true, true, true>(glds, g, S, E); AMP_END(9) }
        XBAR();
        { AMP_BEGIN(10) phase_combine(a, vcu, G, l, upd, !upd, upd); AMP_END(10) }
        if (upd) XBAR();
    }
}

extern "C" void kernel_launch(void* const* d_in, const int* in_sizes, int n_in, void* d_out, int out_size, void* d_ws, size_t ws_size, hipStream_t stream) {
    static int grid = 0;
    if (grid == 0) {
        int dev = 0, cus = 0, per_cu = 0;
        hipGetDevice(&dev); hipDeviceGetAttribute(&cus, hipDeviceAttributeMultiprocessorCount, dev);
        if (hipFuncSetAttribute((const void*)fwd_kernel, hipFuncAttributeMaxDynamicSharedMemorySize, LDS_BYTES) != hipSuccess) { fprintf(stderr, "kernel_launch: hipFuncSetAttribute failed\n"); grid = -1; return; }
        if (hipOccupancyMaxActiveBlocksPerMultiprocessor(&per_cu, (const void*)fwd_kernel, NTHR, LDS_BYTES) != hipSuccess || per_cu < 1) { fprintf(stderr, "kernel_launch: occupancy query failed (%d)\n", per_cu); grid = -1; return; }
        grid = cus * 1;
        if (n_in != N_IN || ws_size < WS_END) { fprintf(stderr, "kernel_launch: unexpected n_in %d / ws %zu\n", n_in, ws_size); grid = -1; return; }
    }
    if (grid < 0) return;
    if (hipMemsetAsync((char*)d_ws + WS_CTL, 0, 65536, stream) != hipSuccess) { fprintf(stderr, "kernel_launch: memset failed\n"); return; }
    Args a{};
    for (int i = 0; i < N_IN; ++i) a.in[i] = (const float*)d_in[i];
    a.out = (float*)d_out; a.ws = (unsigned char*)d_ws;
    void* args[] = {&a};
    hipError_t e = hipLaunchCooperativeKernel((const void*)fwd_kernel, dim3(grid), dim3(NTHR), args, LDS_BYTES, stream);
    if (e != hipSuccess) fprintf(stderr, "cooperative launch failed: %s (grid %d)\n", hipGetErrorString(e), grid);
}
```

```cpp
#define AMP_PHASE -1
#include <hip/hip_runtime.h>
#include <hip/hip_cooperative_groups.h>
#include <cstdio>
#include <cstdint>
#ifndef AMP_PHASE
#define AMP_PHASE -1
#endif
namespace cg = cooperative_groups;
namespace pg8 {
#define PG8_LAS __attribute__((address_space(3)))
typedef unsigned short bf16_t;
typedef short bf16x8 __attribute__((ext_vector_type(8)));
typedef float f32x4 __attribute__((ext_vector_type(4)));
typedef unsigned u32x4 __attribute__((ext_vector_type(4)));
typedef int v4i_t __attribute__((ext_vector_type(4)));
typedef int v8i_t __attribute__((ext_vector_type(8)));
constexpr int BM = 256, BK = 64, HALF = 128, HTB = HALF * BK * 2  , STAGE_BYTES = 8 * HTB, NXCD = 8, WGM = 8;

__host__ __device__ __forceinline__ int lds_byte(int r, int c) { const int st = (r >> 4) * 2 + (c >> 5), rr = r & 15, cc = c & 31, ob = rr * 64 + cc * 2; return st * 1024 + (ob ^ (((ob >> 9) & 1) << 5)); }
__host__ __device__ __forceinline__ void stage_rc(int b, int& R, int& C) { const int st = b / 1024, sb = b % 1024, swz = sb ^ (((sb >> 9) & 1) << 5); R = (st >> 1) * 16 + swz / 64; C = (st & 1) * 32 + (swz % 64) / 2; }
__host__ __device__ __forceinline__ int perm32(int rho) { const int n = rho >> 4, i = rho & 15; return 8 * (i >> 2) + 4 * n + (i & 3); }

struct Unit { int pm, pn; };
struct Gemm { const bf16_t* A; const bf16_t* Bt; int M, N, K; };

struct StaticOrder {
    int nM, nN, nwg, G, c;
    __host__ __device__ void init(int M, int N, int G_, int c_) { nM = M / BM; nN = N / BM; nwg = nM * nN; G = G_; c = c_; }
    __host__ __device__ bool next(int i, Unit& u) const {
        const long L = (long)i * G + c; if (L >= nwg) return false;
        int wgid = (int)L; { const int q = nwg / NXCD, r = nwg % NXCD, xcd = wgid % NXCD, off = wgid / NXCD; wgid = (xcd < r ? xcd * (q + 1) : r * (q + 1) + (xcd - r) * q) + off; }
        const int nig = WGM * nN, gid = wgid / nig, fm = gid * WGM, gsz = (nM - fm) < WGM ? (nM - fm) : WGM;
        u.pm = fm + ((wgid % nig) % gsz); u.pn = (wgid % nig) / gsz; return true;
    }
    __device__ __forceinline__ void a_ready(const Unit&) const {}
    __device__ __forceinline__ void done(const Unit&) const {}
};

__device__ __forceinline__ unsigned cvt_pk_bf16(float lo, float hi) { unsigned r; asm volatile("v_cvt_pk_bf16_f32 %0, %1, %2" : "=v"(r) : "v"(lo), "v"(hi)); return r; }
typedef float f32x2 __attribute__((ext_vector_type(2)));
__device__ __forceinline__ f32x2 gelu_pk(f32x2 v) {
    const f32x2 av = __builtin_elementwise_abs(v), d = av * 0.2316418882f + 1.0f;
    f32x2 t; t.x = __builtin_amdgcn_rcpf(d.x); t.y = __builtin_amdgcn_rcpf(d.y);
    f32x2 q = t * 0.5307027145f + (-0.7265760135f); q = q * t + 0.7107068705f; q = q * t + (-0.142248368f); q = q * t + 0.127414796f; q = q * t;
    const f32x2 s = (v * v) * (-0.72134752044f);
    f32x2 e; e.x = __builtin_amdgcn_exp2f(s.x); e.y = __builtin_amdgcn_exp2f(s.y);
    const f32x2 m = v * (q * e), r = v - m;
    f32x2 o; o.x = v.x < 0.f ? m.x : r.x; o.y = v.y < 0.f ? m.y : r.y; return o;
}


struct GroupOrder {
    int nMl, nNl, strideM, nper, nwg, G, c;
    __device__ __forceinline__ void init(int ng, int nMl_, int nNl_, int strideM_, int G_, int c_) { nMl = nMl_; nNl = nNl_; strideM = strideM_; nper = nMl_ * nNl_; nwg = ng * nper; G = G_; c = c_; }
    __device__ __forceinline__ bool next(int i, Unit& u) const {
        const long L = (long)i * G + c; if (L >= nwg) return false;
        int wgid = (int)L; { const int q = nwg / NXCD, r = nwg % NXCD, xcd = wgid % NXCD, off = wgid / NXCD; wgid = (xcd < r ? xcd * (q + 1) : r * (q + 1) + (xcd - r) * q) + off; }
        const int e = wgid / nper, id = wgid % nper;
        const int nig = WGM * nNl, gid = id / nig, fm = gid * WGM, gsz = (nMl - fm) < WGM ? (nMl - fm) : WGM;
        u.pm = e * strideM + fm + ((id % nig) % gsz); u.pn = e * nNl + (id % nig) / gsz; return true;
    }
    __device__ __forceinline__ void a_ready(const Unit&) const {}
    __device__ __forceinline__ void done(const Unit&) const {}
};

constexpr int TXR = 32768;
struct EpiIn {
    static constexpr bool PERM = true, AFTER_DRAIN = false;
    bf16_t* PX; const PG8_LAS float* rope; bf16_t* UT; PG8_LAS unsigned char* stgbase; float wsc;
    __device__ __forceinline__ void operator()(const f32x4 (&acc)[2][2][4][2], const Unit& u, int ui, int wr, int wc, int fr, int fq) const {
        const int row0 = u.pm * BM + wr * 64 + fr; const int col0 = u.pn * BM + wc * 32 + 8 * fq;
        const bool latent = u.pm < (TXR / BM);
        if (latent && u.pn < 3) {
            PG8_LAS unsigned char* stg = stgbase + (wr * 4 + wc) * 2304; const int lane = fq * 16 + fr;
            const int b = u.pm >> 4, trow0 = (u.pm & 15) * BM; const int col = lane >> 1, half = lane & 1;
#pragma unroll
            for (int ai = 0; ai < 2; ++ai)
#pragma unroll
                for (int bj = 0; bj < 2; ++bj)
#pragma unroll
                    for (int mh = 0; mh < 2; ++mh) {
#pragma unroll
                        for (int mm = 0; mm < 2; ++mm)
#pragma unroll
                            for (int n = 0; n < 2; ++n) { const f32x4 v = acc[ai][bj][2 * mh + mm][n] * wsc; const unsigned w0 = cvt_pk_bf16(v[0], v[1]), w1 = cvt_pk_bf16(v[2], v[3]);
                                PG8_LAS unsigned char* p = stg + (8 * fq + 4 * n) * 72 + (16 * mm + fr) * 2;
                                *(PG8_LAS unsigned short*)(p) = (unsigned short)w0; *(PG8_LAS unsigned short*)(p + 72) = (unsigned short)(w0 >> 16);
                                *(PG8_LAS unsigned short*)(p + 144) = (unsigned short)w1; *(PG8_LAS unsigned short*)(p + 216) = (unsigned short)(w1 >> 16); }
                        asm volatile("s_waitcnt lgkmcnt(0)" ::: "memory");
                        typedef unsigned u32x2v __attribute__((ext_vector_type(2)));
                        const PG8_LAS unsigned char* rp = stg + col * 72 + half * 32;
                        const u32x2v a0 = *(const PG8_LAS u32x2v*)(rp), a1 = *(const PG8_LAS u32x2v*)(rp + 8), a2 = *(const PG8_LAS u32x2v*)(rp + 16), a3 = *(const PG8_LAS u32x2v*)(rp + 24);
                        const int ch = u.pn * BM + bj * HALF + wc * 32 + col; const int t0 = trow0 + ai * HALF + wr * 64 + mh * 32 + half * 16;
                        u32x4* gp = (u32x4*)(UT + ((size_t)(b * 768 + ch)) * 4096 + t0);
                        gp[0] = (u32x4){a0.x, a0.y, a1.x, a1.y}; gp[1] = (u32x4){a2.x, a2.y, a3.x, a3.y};
                        asm volatile("s_waitcnt lgkmcnt(0)" ::: "memory"); }
            return;
        }
#pragma unroll
        for (int ai = 0; ai < 2; ++ai)
#pragma unroll
            for (int m = 0; m < 4; ++m) { const int row = row0 + ai * HALF + m * 16; bf16_t* rowp = PX + (size_t)row * 2304 + col0;
#pragma unroll
                for (int bj = 0; bj < 2; ++bj) { f32x4 v0 = acc[ai][bj][m][0] * wsc, v1 = acc[ai][bj][m][1] * wsc;
                    const bool dorope = latent && (u.pn == 4 || (u.pn == 6 && bj == 0));
                    if (dorope) {
                        const int t = row & 4095; const int pos = (wc & 1) ? (t & 63) : (t >> 6);
                        const PG8_LAS f32x4* rp = (const PG8_LAS f32x4*)(rope + (pos * 16 + 8 * (fq & 1)) * 2);
                        const f32x4 r0 = rp[0], r1 = rp[1], r2 = rp[2], r3 = rp[3];
                        f32x4 p0, p1;
#pragma unroll
                        for (int j = 0; j < 4; ++j) { auto r0_ = __builtin_amdgcn_permlane32_swap(__float_as_uint(v0[j]), __float_as_uint(v0[j]), false, false); auto r1_ = __builtin_amdgcn_permlane32_swap(__float_as_uint(v1[j]), __float_as_uint(v1[j]), false, false);
                            p0[j] = __uint_as_float(fq < 2 ? r0_[1] : r0_[0]); p1[j] = __uint_as_float(fq < 2 ? r1_[1] : r1_[0]); }
                        const float c0[4] = {r0[0], r0[2], r1[0], r1[2]}, s0[4] = {r0[1], r0[3], r1[1], r1[3]};
                        const float c1[4] = {r2[0], r2[2], r3[0], r3[2]}, s1[4] = {r2[1], r2[3], r3[1], r3[3]};
                        const bool lo = fq < 2;
#pragma unroll
                        for (int j = 0; j < 4; ++j) {
                            v0[j] = lo ? (v0[j] * c0[j] - p0[j] * s0[j]) : (p0[j] * s0[j] + v0[j] * c0[j]);
                            v1[j] = lo ? (v1[j] * c1[j] - p1[j] * s1[j]) : (p1[j] * s1[j] + v1[j] * c1[j]); }
                    }
                    u32x4 w; w.x = cvt_pk_bf16(v0[0], v0[1]); w.y = cvt_pk_bf16(v0[2], v0[3]); w.z = cvt_pk_bf16(v1[0], v1[1]); w.w = cvt_pk_bf16(v1[2], v1[3]);
                    *(u32x4*)(rowp + bj * HALF) = w; } }
    }
};
struct EpiOut {
    static constexpr bool PERM = true, AFTER_DRAIN = false;
    const float* xf_x; const float* xf_c; bf16_t* XB; const float* mod; int from_f32;
    __device__ __forceinline__ void operator()(const f32x4 (&acc)[2][2][4][2], const Unit& u, int ui, int wr, int wc, int fr, int fq) const {
        const int row0 = u.pm * BM + wr * 64 + fr, col0 = u.pn * BM + wc * 32 + 8 * fq;
        const bool latent = u.pm < (TXR / BM);
#pragma unroll
        for (int ai = 0; ai < 2; ++ai)
#pragma unroll
            for (int m = 0; m < 4; ++m) { const int row = row0 + ai * HALF + m * 16;
                const int mrow = latent ? (row >> 12) : 8; const float* gp = mod + mrow * 6144 + 2 * 1024 + col0;
                bf16_t* xb = XB + (size_t)row * 1024 + col0;
#pragma unroll
                for (int bj = 0; bj < 2; ++bj) { const f32x4 g0 = *(const f32x4*)(gp + bj * HALF), g1 = *(const f32x4*)(gp + bj * HALF + 4); f32x4 x0, x1;
                    if (from_f32) { const float* xo = (latent ? xf_x + (size_t)row * 1024 : xf_c + (size_t)(row - TXR) * 1024) + col0 + bj * HALF; x0 = *(const f32x4*)xo; x1 = *(const f32x4*)(xo + 4); }
                    else { const u32x4 w = *(const u32x4*)(xb + bj * HALF); x0 = (f32x4){__uint_as_float(w.x << 16), __uint_as_float(w.x & 0xffff0000u), __uint_as_float(w.y << 16), __uint_as_float(w.y & 0xffff0000u)};
                        x1 = (f32x4){__uint_as_float(w.z << 16), __uint_as_float(w.z & 0xffff0000u), __uint_as_float(w.w << 16), __uint_as_float(w.w & 0xffff0000u)}; }
                    const f32x4 v0 = x0 + g0 * acc[ai][bj][m][0], v1 = x1 + g1 * acc[ai][bj][m][1];
                    u32x4 o; o.x = cvt_pk_bf16(v0[0], v0[1]); o.y = cvt_pk_bf16(v0[2], v0[3]); o.z = cvt_pk_bf16(v1[0], v1[1]); o.w = cvt_pk_bf16(v1[2], v1[3]);
                    *(u32x4*)(xb + bj * HALF) = o; } }
    }
};
struct EpiGU {
    static constexpr bool PERM = true, AFTER_DRAIN = false;
    unsigned char* ACT; const PG8_LAS float* wsc;
    __device__ __forceinline__ void operator()(const f32x4 (&acc)[2][2][4][2], const Unit& u, int ui, int wr, int wc, int fr, int fq) const {
        const int row0 = u.pm * BM + wr * 64 + fr; const int col0 = (u.pn & 15) * 128 + wc * 32 + 8 * fq; const int e = u.pn >> 4; const float sg = wsc[e], su = wsc[16 + e]; const float nsl = -1.4426950408889634f * sg, sgu = sg * su;
#pragma unroll
        for (int ai = 0; ai < 2; ++ai)
#pragma unroll
            for (int m = 0; m < 4; ++m) { unsigned char* rowp = ACT + (size_t)(row0 + ai * HALF + m * 16) * 2048 + col0;
                float h[8];
#pragma unroll
                for (int n = 0; n < 2; ++n)
#pragma unroll
                    for (int j = 0; j < 4; ++j) { const float ag = acc[ai][0][m][n][j], au = acc[ai][1][m][n][j]; const float r = __builtin_amdgcn_rcpf(1.0f + __builtin_amdgcn_exp2f(ag * nsl)); h[4 * n + j] = __builtin_amdgcn_fmed3f((ag * au) * sgu * r, -448.0f, 448.0f); }
                int p0 = 0, p1 = 0;
                p0 = __builtin_amdgcn_cvt_pk_fp8_f32(h[0], h[1], p0, false); p0 = __builtin_amdgcn_cvt_pk_fp8_f32(h[2], h[3], p0, true);
                p1 = __builtin_amdgcn_cvt_pk_fp8_f32(h[4], h[5], p1, false); p1 = __builtin_amdgcn_cvt_pk_fp8_f32(h[6], h[7], p1, true);
                typedef int i32x2v __attribute__((ext_vector_type(2)));
                *(i32x2v*)rowp = (i32x2v){p0, p1}; }
    }
};
struct EpiDown {
    static constexpr bool PERM = true, AFTER_DRAIN = false;
    unsigned char* OB; const PG8_LAS float* gl;
    __device__ __forceinline__ void operator()(const f32x4 (&acc)[2][2][4][2], const Unit& u, int ui, int wr, int wc, int fr, int fq) const {
        const int row0 = u.pm * BM + wr * 64 + fr; const int col0 = (u.pn & 3) * BM + wc * 32 + 8 * fq;
#pragma unroll
        for (int ai = 0; ai < 2; ++ai)
#pragma unroll
            for (int m = 0; m < 4; ++m) { const int row = row0 + ai * HALF + m * 16; const float g = gl[ui * BM + ai * HALF + wr * 64 + m * 16 + fr]; unsigned char* rowp = OB + (size_t)row * 1024 + col0;
#pragma unroll
                for (int bj = 0; bj < 2; ++bj) { const f32x4 v0 = acc[ai][bj][m][0] * g, v1 = acc[ai][bj][m][1] * g; int p0 = 0, p1 = 0;
                    p0 = __builtin_amdgcn_cvt_pk_fp8_f32(__builtin_amdgcn_fmed3f(v0[0], -448.f, 448.f), __builtin_amdgcn_fmed3f(v0[1], -448.f, 448.f), p0, false); p0 = __builtin_amdgcn_cvt_pk_fp8_f32(__builtin_amdgcn_fmed3f(v0[2], -448.f, 448.f), __builtin_amdgcn_fmed3f(v0[3], -448.f, 448.f), p0, true);
                    p1 = __builtin_amdgcn_cvt_pk_fp8_f32(__builtin_amdgcn_fmed3f(v1[0], -448.f, 448.f), __builtin_amdgcn_fmed3f(v1[1], -448.f, 448.f), p1, false); p1 = __builtin_amdgcn_cvt_pk_fp8_f32(__builtin_amdgcn_fmed3f(v1[2], -448.f, 448.f), __builtin_amdgcn_fmed3f(v1[3], -448.f, 448.f), p1, true);
                    typedef int i32x2v __attribute__((ext_vector_type(2)));
                    *(i32x2v*)(rowp + bj * HALF) = (i32x2v){p0, p1}; } }
    }
};

template <class Epi, class Sched, bool ALIGN_EPI = false, bool SP2 = false, bool FP8 = false>
__device__ __forceinline__ void gemm_phase(PG8_LAS unsigned char* lds, const Gemm g, const Sched& S, const Epi& E) {
    int tid_ = threadIdx.x; asm volatile("" : "+v"(tid_));
    const int tid = tid_, wid = __builtin_amdgcn_readfirstlane(tid >> 6), lane = tid & 63, wr = wid >> 2, wc = wid & 3, fr = lane & 15, fq = lane >> 4;
    const int K = g.K, KB = FP8 ? K : 2 * K  , nt = KB / (BK * 2);
    unsigned voffA[2], voffB[2];
#pragma unroll
    for (int i = 0; i < 2; ++i) { int R, C; stage_rc(tid * 16 + i * 8192, R, C); const int Rb = Epi::PERM ? ((R & ~31) + perm32(R & 31)) : R;
        voffA[i] = (unsigned)(R * KB + C * 2); voffB[i] = (unsigned)(Rb * KB + C * 2); }
    const size_t kstep = (size_t)(BK * 2);
    const size_t hstep = (size_t)HALF * KB;
    const size_t tstep = 2 * hstep;
    const unsigned ldsw = (unsigned)wid * 1024u;
    const int aoff = lds_byte(wr * 64 + fr, fq * 8), boff = lds_byte(wc * 32 + fr, fq * 8);
#define PG8_SA(b, h) (((b) * 2 + (h)) * HTB)
#define PG8_SB(b, h) ((4 + (b) * 2 + (h)) * HTB)
#define PG8_STAGE(bufoff, gbase, voff) do { _Pragma("unroll") for (int _i = 0; _i < 2; ++_i) \
        __builtin_amdgcn_global_load_lds((const unsigned*)((const char*)(gbase) + (voff)[_i]), (PG8_LAS unsigned*)(lds + (bufoff) + ldsw + _i * 8192), 16, 0, 0); } while (0)
#define PG8_LDA(dst, b, h) do { _Pragma("unroll") for (int m = 0; m < 4; ++m) { if constexpr (FP8) { dst##8[m].lo = *(const PG8_LAS v4i_t*)(lds + PG8_SA(b, h) + aoff + m * 2048); dst##8[m].hi = *(const PG8_LAS v4i_t*)(lds + PG8_SA(b, h) + aoff + m * 2048 + 1024); } \
        else { _Pragma("unroll") for (int k = 0; k < 2; ++k) dst[m][k] = *(const PG8_LAS bf16x8*)(lds + PG8_SA(b, h) + aoff + m * 2048 + k * 1024); } } } while (0)
#define PG8_LDB(dst, b, h) do { _Pragma("unroll") for (int n = 0; n < 2; ++n) { if constexpr (FP8) { dst##8[n].lo = *(const PG8_LAS v4i_t*)(lds + PG8_SB(b, h) + boff + n * 2048); dst##8[n].hi = *(const PG8_LAS v4i_t*)(lds + PG8_SB(b, h) + boff + n * 2048 + 1024); } \
        else { _Pragma("unroll") for (int k = 0; k < 2; ++k) dst[n][k] = *(const PG8_LAS bf16x8*)(lds + PG8_SB(b, h) + boff + n * 2048 + k * 1024); } } } while (0)
#define PG8_CAT8(x0, x1) __builtin_shufflevector(__builtin_bit_cast(v4i_t, x0), __builtin_bit_cast(v4i_t, x1), 0, 1, 2, 3, 4, 5, 6, 7)
#define PG8_MMA(ai, bj, At, Bt) do { __builtin_amdgcn_s_setprio(1); if constexpr (FP8) asm volatile("s_nop 1" ::: "memory"); _Pragma("unroll") for (int m = 0; m < 4; ++m) _Pragma("unroll") for (int n = 0; n < 2; ++n) { \
        if constexpr (FP8) { asm volatile("v_mfma_scale_f32_16x16x128_f8f6f4 %0, %1, %2, %0, %3, %3 op_sel_hi:[0,0,0]" : "+v"(acc[ai][bj][m][n]) : "v"(Bt##8[n]), "v"(At##8[m]), "v"(one_scale)); } \
        else { _Pragma("unroll") for (int k = 0; k < 2; ++k) acc[ai][bj][m][n] = __builtin_amdgcn_mfma_f32_16x16x32_bf16(Bt[n][k], At[m][k], acc[ai][bj][m][n], 0, 0, 0); } } if constexpr (FP8) asm volatile("s_nop 15\n\ts_nop 3" ::: "memory"); __builtin_amdgcn_s_setprio(0); } while (0)
#define PG8_WAIT_V(n) asm volatile("s_waitcnt vmcnt(" #n ")" ::: "memory")
#define PG8_WAIT_L(n) asm volatile("s_waitcnt lgkmcnt(" #n ")" ::: "memory")
#define PG8_BAR __builtin_amdgcn_s_barrier()
#define PG8_SCHED __builtin_amdgcn_sched_barrier(0)
    Unit cur, nxt; int ui = 0;
    if (!S.next(0, cur)) return;
    f32x4 acc[2][2][4][2];
#pragma unroll
    for (int a = 0; a < 2; ++a)
#pragma unroll
        for (int b = 0; b < 2; ++b)
#pragma unroll
            for (int m = 0; m < 4; ++m)
#pragma unroll
                for (int n = 0; n < 2; ++n) acc[a][b][m][n] = (f32x4){0.f, 0.f, 0.f, 0.f};
    bf16x8 At[4][2], B0[2][2], B1[2][2];
    v8i_t At8[4], B08[2], B18[2];
    int one_scale = 0x7f7f7f7f; asm volatile("" : "+v"(one_scale));
    const char* cA = (const char*)g.A + (size_t)cur.pm * tstep; const char* cB = (const char*)g.Bt + (size_t)cur.pn * tstep;
    S.a_ready(cur);
    if constexpr (SP2) {
        PG8_STAGE(PG8_SB(0, 0), cB, voffB); PG8_STAGE(PG8_SB(0, 1), cB + hstep, voffB); PG8_STAGE(PG8_SA(0, 0), cA, voffA); PG8_STAGE(PG8_SA(0, 1), cA + hstep, voffA);
        if (wr == 1) PG8_BAR;
        PG8_WAIT_V(2); PG8_BAR;
        PG8_STAGE(PG8_SB(1, 0), cB + kstep, voffB); PG8_STAGE(PG8_SA(1, 0), cA + kstep, voffA); PG8_STAGE(PG8_SB(1, 1), cB + hstep + kstep, voffB);
        PG8_WAIT_V(6); PG8_BAR;
    } else {
        PG8_STAGE(PG8_SB(0, 0), cB, voffB); PG8_STAGE(PG8_SA(0, 0), cA, voffA); PG8_STAGE(PG8_SB(0, 1), cB + hstep, voffB); PG8_STAGE(PG8_SA(0, 1), cA + hstep, voffA);
        if (wr == 1) PG8_BAR;
        PG8_WAIT_V(4); PG8_BAR;
        PG8_STAGE(PG8_SB(1, 0), cB + kstep, voffB); PG8_STAGE(PG8_SA(1, 0), cA + kstep, voffA); PG8_STAGE(PG8_SB(1, 1), cB + hstep + kstep, voffB);
        PG8_WAIT_V(6); PG8_BAR;
    }
    for (;;) {
        const bool has_next = S.next(ui + 1, nxt);
        const char* nA = has_next ? (const char*)g.A + (size_t)nxt.pm * tstep : cA; const char* nB = has_next ? (const char*)g.Bt + (size_t)nxt.pn * tstep : cB;
#pragma nounroll
        for (int t = 0; t < nt; t += 2) {
            const bool last = (t == nt - 2);
            const char* a1 = cA + (size_t)(t + 1) * kstep;
            const char* a2 = last ? nA : cA + (size_t)(t + 2) * kstep; const char* b2 = last ? nB : cB + (size_t)(t + 2) * kstep;
            const char* a3 = a2 + kstep; const char* b3 = b2 + kstep;
            if (last && has_next) S.a_ready(nxt);
            if constexpr (SP2) {
            PG8_LDB(B0, 0, 0); PG8_LDB(B1, 0, 1); PG8_SCHED; PG8_LDA(At, 0, 0); PG8_STAGE(PG8_SA(1, 1), a1 + hstep, voffA);
            PG8_WAIT_V(8); PG8_WAIT_L(0); PG8_BAR; PG8_MMA(0, 0, At, B0); PG8_MMA(0, 1, At, B1); PG8_BAR; PG8_SCHED;
            PG8_LDA(At, 0, 1); PG8_STAGE(PG8_SB(0, 0), b2, voffB); PG8_STAGE(PG8_SB(0, 1), b2 + hstep, voffB); PG8_STAGE(PG8_SA(0, 0), a2, voffA);
            PG8_WAIT_V(8); PG8_WAIT_L(0); PG8_BAR; PG8_MMA(1, 0, At, B0); PG8_MMA(1, 1, At, B1); PG8_BAR; PG8_SCHED;
            PG8_LDB(B0, 1, 0); PG8_LDB(B1, 1, 1); PG8_SCHED; PG8_LDA(At, 1, 0); PG8_STAGE(PG8_SA(0, 1), a2 + hstep, voffA);
            PG8_WAIT_V(8); PG8_WAIT_L(0); PG8_BAR; PG8_MMA(0, 0, At, B0); PG8_MMA(0, 1, At, B1); PG8_BAR; PG8_SCHED;
            PG8_LDA(At, 1, 1); PG8_STAGE(PG8_SB(1, 0), b3, voffB); PG8_STAGE(PG8_SB(1, 1), b3 + hstep, voffB); PG8_STAGE(PG8_SA(1, 0), a3, voffA);
            PG8_WAIT_V(8); PG8_WAIT_L(0); PG8_BAR; PG8_MMA(1, 0, At, B0); PG8_MMA(1, 1, At, B1); PG8_BAR; PG8_SCHED;
            } else {
            PG8_LDB(B0, 0, 0); PG8_SCHED; PG8_LDA(At, 0, 0); PG8_STAGE(PG8_SA(1, 1), a1 + hstep, voffA);
            PG8_WAIT_L(8); PG8_BAR; PG8_WAIT_L(0); PG8_MMA(0, 0, At, B0); PG8_BAR; PG8_SCHED;
            PG8_LDB(B1, 0, 1); PG8_STAGE(PG8_SB(0, 0), b2, voffB);
            PG8_BAR; PG8_WAIT_L(0); PG8_MMA(0, 1, At, B1); PG8_BAR;
            PG8_LDA(At, 0, 1); PG8_STAGE(PG8_SA(0, 0), a2, voffA);
            PG8_BAR; PG8_WAIT_L(0); PG8_MMA(1, 0, At, B0); PG8_BAR; PG8_SCHED;
            PG8_STAGE(PG8_SB(0, 1), b2 + hstep, voffB);
            PG8_WAIT_V(6); PG8_BAR; PG8_MMA(1, 1, At, B1); PG8_BAR;
            PG8_LDB(B0, 1, 0); PG8_SCHED; PG8_LDA(At, 1, 0); PG8_STAGE(PG8_SA(0, 1), a2 + hstep, voffA);
            PG8_WAIT_L(8); PG8_BAR; PG8_WAIT_L(0); PG8_MMA(0, 0, At, B0); PG8_BAR; PG8_SCHED;
            PG8_LDB(B1, 1, 1); PG8_STAGE(PG8_SB(1, 0), b3, voffB);
            PG8_BAR; PG8_WAIT_L(0); PG8_MMA(0, 1, At, B1); PG8_BAR;
            PG8_LDA(At, 1, 1); PG8_STAGE(PG8_SA(1, 0), a3, voffA);
            PG8_BAR; PG8_WAIT_L(0); PG8_MMA(1, 0, At, B0); PG8_BAR; PG8_SCHED;
            PG8_STAGE(PG8_SB(1, 1), b3 + hstep, voffB);
            PG8_WAIT_V(6); PG8_BAR; PG8_MMA(1, 1, At, B1); PG8_BAR;
            }
        }
        if constexpr (ALIGN_EPI) { if (wr == 0) PG8_BAR; }
        if constexpr (!Epi::AFTER_DRAIN) { E(acc, cur, ui, wr, wc, fr, fq); S.done(cur); }
        if (!has_next) break;
#pragma unroll
        for (int a = 0; a < 2; ++a)
#pragma unroll
            for (int b = 0; b < 2; ++b)
#pragma unroll
                for (int m = 0; m < 4; ++m)
#pragma unroll
                    for (int n = 0; n < 2; ++n) acc[a][b][m][n] = (f32x4){0.f, 0.f, 0.f, 0.f};
        cur = nxt; cA = nA; cB = nB; ++ui;
        if constexpr (ALIGN_EPI) { if (wr == 1) PG8_BAR; }
    }
    PG8_WAIT_V(0);
    if constexpr (!ALIGN_EPI) { if (wr == 0) PG8_BAR; }
    PG8_BAR;
    if constexpr (Epi::AFTER_DRAIN) { E.fused(acc, cur, wr, wc, fr, fq, lds, wid, lane); S.done(cur); }
#undef PG8_SA
#undef PG8_SB
#undef PG8_STAGE
#undef PG8_LDA
#undef PG8_LDB
#undef PG8_MMA
#undef PG8_CAT8
#undef PG8_WAIT_V
#undef PG8_WAIT_L
#undef PG8_BAR
#undef PG8_SCHED
}
template <class Epi, class Sched, bool FP8 = false>
__device__ __forceinline__ void gemm_phase_gather(PG8_LAS unsigned char* lds, const Gemm g, const int* rowmap, PG8_LAS int* idxs, const Sched& S, const Epi& E) {
    constexpr bool ALIGN_EPI = true, SP2 = true;
    int tid_ = threadIdx.x; asm volatile("" : "+v"(tid_));
    const int tid = tid_, wid = __builtin_amdgcn_readfirstlane(tid >> 6), lane = tid & 63, wr = wid >> 2, wc = wid & 3, fr = lane & 15, fq = lane >> 4;
    const int K = g.K, KB = FP8 ? K : 2 * K  , nt = KB / (BK * 2);
    unsigned voffB[2]; int RA[2], CA[2];
#pragma unroll
    for (int i = 0; i < 2; ++i) { int R, C; stage_rc(tid * 16 + i * 8192, R, C); const int Rb = Epi::PERM ? ((R & ~31) + perm32(R & 31)) : R;
        RA[i] = R; CA[i] = C * 2; voffB[i] = (unsigned)(Rb * KB + C * 2); }
    const size_t kstep = (size_t)(BK * 2);
    const size_t hstep = (size_t)HALF * KB;
    const size_t tstep = 2 * hstep;
    const unsigned ldsw = (unsigned)wid * 1024u;
    const int aoff = lds_byte(wr * 64 + fr, fq * 8), boff = lds_byte(wc * 32 + fr, fq * 8);
#define PG8_SA(b, h) (((b) * 2 + (h)) * HTB)
#define PG8_SB(b, h) ((4 + (b) * 2 + (h)) * HTB)
#define PG8_STAGE(bufoff, gbase, voff) do { _Pragma("unroll") for (int _i = 0; _i < 2; ++_i) \
        __builtin_amdgcn_global_load_lds((const unsigned*)((const char*)(gbase) + (voff)[_i]), (PG8_LAS unsigned*)(lds + (bufoff) + ldsw + _i * 8192), 16, 0, 0); } while (0)
#define PG8_STAGE_AG(bufoff, P, h, koff) do { _Pragma("unroll") for (int _i = 0; _i < 2; ++_i) \
        __builtin_amdgcn_global_load_lds((const unsigned*)((const char*)g.A + (size_t)((P)[h][_i] + (unsigned)(koff))), (PG8_LAS unsigned*)(lds + (bufoff) + ldsw + _i * 8192), 16, 0, 0); } while (0)
#define PG8_ROWPTR(P, u) do { _Pragma("unroll") for (int _h = 0; _h < 2; ++_h) _Pragma("unroll") for (int _i = 0; _i < 2; ++_i) \
        (P)[_h][_i] = (unsigned)idxs[(u) * BM + _h * HALF + RA[_i]] * (unsigned)KB + (unsigned)CA[_i]; } while (0)
#define PG8_LDA(dst, b, h) do { _Pragma("unroll") for (int m = 0; m < 4; ++m) { if constexpr (FP8) { dst##8[m].lo = *(const PG8_LAS v4i_t*)(lds + PG8_SA(b, h) + aoff + m * 2048); dst##8[m].hi = *(const PG8_LAS v4i_t*)(lds + PG8_SA(b, h) + aoff + m * 2048 + 1024); } \
        else { _Pragma("unroll") for (int k = 0; k < 2; ++k) dst[m][k] = *(const PG8_LAS bf16x8*)(lds + PG8_SA(b, h) + aoff + m * 2048 + k * 1024); } } } while (0)
#define PG8_LDB(dst, b, h) do { _Pragma("unroll") for (int n = 0; n < 2; ++n) { if constexpr (FP8) { dst##8[n].lo = *(const PG8_LAS v4i_t*)(lds + PG8_SB(b, h) + boff + n * 2048); dst##8[n].hi = *(const PG8_LAS v4i_t*)(lds + PG8_SB(b, h) + boff + n * 2048 + 1024); } \
        else { _Pragma("unroll") for (int k = 0; k < 2; ++k) dst[n][k] = *(const PG8_LAS bf16x8*)(lds + PG8_SB(b, h) + boff + n * 2048 + k * 1024); } } } while (0)
#define PG8_CAT8(x0, x1) __builtin_shufflevector(__builtin_bit_cast(v4i_t, x0), __builtin_bit_cast(v4i_t, x1), 0, 1, 2, 3, 4, 5, 6, 7)
#define PG8_MMA(ai, bj, At, Bt) do { __builtin_amdgcn_s_setprio(1); if constexpr (FP8) asm volatile("s_nop 1" ::: "memory"); _Pragma("unroll") for (int m = 0; m < 4; ++m) _Pragma("unroll") for (int n = 0; n < 2; ++n) { \
        if constexpr (FP8) { asm volatile("v_mfma_scale_f32_16x16x128_f8f6f4 %0, %1, %2, %0, %3, %3 op_sel_hi:[0,0,0]" : "+v"(acc[ai][bj][m][n]) : "v"(Bt##8[n]), "v"(At##8[m]), "v"(one_scale)); } \
        else { _Pragma("unroll") for (int k = 0; k < 2; ++k) acc[ai][bj][m][n] = __builtin_amdgcn_mfma_f32_16x16x32_bf16(Bt[n][k], At[m][k], acc[ai][bj][m][n], 0, 0, 0); } } if constexpr (FP8) asm volatile("s_nop 15\n\ts_nop 3" ::: "memory"); __builtin_amdgcn_s_setprio(0); } while (0)
#define PG8_WAIT_V(n) asm volatile("s_waitcnt vmcnt(" #n ")" ::: "memory")
#define PG8_WAIT_L(n) asm volatile("s_waitcnt lgkmcnt(" #n ")" ::: "memory")
#define PG8_BAR __builtin_amdgcn_s_barrier()
#define PG8_SCHED __builtin_amdgcn_sched_barrier(0)
    Unit cur, nxt; int ui = 0;
    if (!S.next(0, cur)) return;
    f32x4 acc[2][2][4][2];
#pragma unroll
    for (int a = 0; a < 2; ++a)
#pragma unroll
        for (int b = 0; b < 2; ++b)
#pragma unroll
            for (int m = 0; m < 4; ++m)
#pragma unroll
                for (int n = 0; n < 2; ++n) acc[a][b][m][n] = (f32x4){0.f, 0.f, 0.f, 0.f};
    bf16x8 At[4][2], B0[2][2], B1[2][2];
    v8i_t At8[4], B08[2], B18[2];
    int one_scale = 0x7f7f7f7f; asm volatile("" : "+v"(one_scale));
    const char* cB = (const char*)g.Bt + (size_t)cur.pn * tstep;
    unsigned cP[2][2], nP[2][2];
    { Unit uu; for (int i = 0; S.next(i, uu); ++i) if (tid < BM) idxs[i * BM + tid] = rowmap[uu.pm * BM + tid]; }
    asm volatile("s_waitcnt vmcnt(0) lgkmcnt(0)" ::: "memory"); __builtin_amdgcn_s_barrier(); asm volatile("" ::: "memory");
    PG8_ROWPTR(cP, 0);
    S.a_ready(cur);
    if constexpr (SP2) {
        PG8_STAGE(PG8_SB(0, 0), cB, voffB); PG8_STAGE(PG8_SB(0, 1), cB + hstep, voffB); PG8_STAGE_AG(PG8_SA(0, 0), cP, 0, 0); PG8_STAGE_AG(PG8_SA(0, 1), cP, 1, 0);
        if (wr == 1) PG8_BAR;
        PG8_WAIT_V(2); PG8_BAR;
        PG8_STAGE(PG8_SB(1, 0), cB + kstep, voffB); PG8_STAGE_AG(PG8_SA(1, 0), cP, 0, kstep); PG8_STAGE(PG8_SB(1, 1), cB + hstep + kstep, voffB);
        PG8_WAIT_V(6); PG8_BAR;
    }
    for (;;) {
        const bool has_next = S.next(ui + 1, nxt);
        const char* nB = has_next ? (const char*)g.Bt + (size_t)nxt.pn * tstep : cB;
        if (has_next) { PG8_ROWPTR(nP, ui + 1); } else { _Pragma("unroll") for (int _h = 0; _h < 2; ++_h) _Pragma("unroll") for (int _i = 0; _i < 2; ++_i) nP[_h][_i] = cP[_h][_i]; }
#pragma nounroll
        for (int t = 0; t < nt; t += 2) {
            const bool last = (t == nt - 2);
            const size_t k1 = (size_t)(t + 1) * kstep, k2 = last ? 0 : (size_t)(t + 2) * kstep, k3 = k2 + kstep;
            unsigned sP[2][2];
            _Pragma("unroll") for (int _h = 0; _h < 2; ++_h) _Pragma("unroll") for (int _i = 0; _i < 2; ++_i) sP[_h][_i] = last ? nP[_h][_i] : cP[_h][_i];
            const char* b2 = last ? nB : cB + (size_t)(t + 2) * kstep; const char* b3 = b2 + kstep;
            if (last && has_next) S.a_ready(nxt);
            if constexpr (SP2) {
            PG8_LDB(B0, 0, 0); PG8_LDB(B1, 0, 1); PG8_SCHED; PG8_LDA(At, 0, 0); PG8_STAGE_AG(PG8_SA(1, 1), cP, 1, k1);
            PG8_WAIT_V(8); PG8_WAIT_L(0); PG8_BAR; PG8_MMA(0, 0, At, B0); PG8_MMA(0, 1, At, B1); PG8_BAR; PG8_SCHED;
            PG8_LDA(At, 0, 1); PG8_STAGE(PG8_SB(0, 0), b2, voffB); PG8_STAGE(PG8_SB(0, 1), b2 + hstep, voffB); PG8_STAGE_AG(PG8_SA(0, 0), sP, 0, k2);
            PG8_WAIT_V(8); PG8_WAIT_L(0); PG8_BAR; PG8_MMA(1, 0, At, B0); PG8_MMA(1, 1, At, B1); PG8_BAR; PG8_SCHED;
            PG8_LDB(B0, 1, 0); PG8_LDB(B1, 1, 1); PG8_SCHED; PG8_LDA(At, 1, 0); PG8_STAGE_AG(PG8_SA(0, 1), sP, 1, k2);
            PG8_WAIT_V(8); PG8_WAIT_L(0); PG8_BAR; PG8_MMA(0, 0, At, B0); PG8_MMA(0, 1, At, B1); PG8_BAR; PG8_SCHED;
            PG8_LDA(At, 1, 1); PG8_STAGE(PG8_SB(1, 0), b3, voffB); PG8_STAGE(PG8_SB(1, 1), b3 + hstep, voffB); PG8_STAGE_AG(PG8_SA(1, 0), sP, 0, k3);
            PG8_WAIT_V(8); PG8_WAIT_L(0); PG8_BAR; PG8_MMA(1, 0, At, B0); PG8_MMA(1, 1, At, B1); PG8_BAR; PG8_SCHED;
            }
        }
        if constexpr (ALIGN_EPI) { if (wr == 0) PG8_BAR; }
        if constexpr (!Epi::AFTER_DRAIN) { E(acc, cur, ui, wr, wc, fr, fq); if (AMP_PHASE == 81) { asm volatile("" ::: "memory"); E(acc, cur, ui, wr, wc, fr, fq); } S.done(cur); }
        if (!has_next) break;
#pragma unroll
        for (int a = 0; a < 2; ++a)
#pragma unroll
            for (int b = 0; b < 2; ++b)
#pragma unroll
                for (int m = 0; m < 4; ++m)
#pragma unroll
                    for (int n = 0; n < 2; ++n) acc[a][b][m][n] = (f32x4){0.f, 0.f, 0.f, 0.f};
        cur = nxt; cB = nB; ++ui;
        _Pragma("unroll") for (int _h = 0; _h < 2; ++_h) _Pragma("unroll") for (int _i = 0; _i < 2; ++_i) cP[_h][_i] = nP[_h][_i];
        if constexpr (ALIGN_EPI) { if (wr == 1) PG8_BAR; }
    }
    PG8_WAIT_V(0);
    if constexpr (!ALIGN_EPI) { if (wr == 0) PG8_BAR; }
    PG8_BAR;
    if constexpr (Epi::AFTER_DRAIN) { E.fused(acc, cur, wr, wc, fr, fq, lds, wid, lane); S.done(cur); }
#undef PG8_SA
#undef PG8_SB
#undef PG8_STAGE
#undef PG8_STAGE_AG
#undef PG8_ROWPTR
#undef PG8_LDA
#undef PG8_LDB
#undef PG8_MMA
#undef PG8_CAT8
#undef PG8_WAIT_V
#undef PG8_WAIT_L
#undef PG8_BAR
#undef PG8_SCHED
}

}

#define LAS __attribute__((address_space(3)))
typedef unsigned short bf16_t;
typedef float f32x4 __attribute__((ext_vector_type(4)));
typedef unsigned u32x4 __attribute__((ext_vector_type(4)));
typedef unsigned u32x2 __attribute__((ext_vector_type(2)));
typedef __bf16 bf16x2_t __attribute__((ext_vector_type(2)));
constexpr int NWAVES = 8, NTHR = 512;
constexpr int D = 1024, NB = 8, SEQ = 4096, LCTX = 256, TX = NB * SEQ, TC = NB * LCTX, TT = TX + TC, INW = 2304, NE = 16, FF = 2048;
constexpr int CAPX = 512, CAPC = 32, SLOTS = NB * CAPX + NB * CAPC;
constexpr float LOG2E = 1.4426950408889634f;
constexpr int LDS_BYTES = 163840;
enum { I_X = 0, I_C, I_CTX, I_CCTX, I_ADAW, I_ADAB, I_N1G, I_N2G, I_WIN, I_HCW, I_HCB, I_HW1, I_HB1, I_HW2, I_HB2, I_HW3, I_HFREQ, I_HSKIP, I_SINK, I_POOLW, I_POOLS, I_RPB, I_WOUT, I_ROUTER, I_WG, I_WU, I_WD, I_FNG, N_IN };
constexpr size_t MiB = 1u << 20;
constexpr size_t WS_CTL = 0;
constexpr size_t WS_MOD = 1 * MiB;
constexpr size_t WS_WSC = 1 * MiB + 512 * 1024;
constexpr size_t WS_ROPE = 2 * MiB;
constexpr size_t WS_TW8 = 2 * MiB + 65536;
constexpr size_t WS_WIN_T = 3 * MiB;
constexpr size_t WS_WOUT_T = 13 * MiB;
constexpr size_t WS_HC = 17 * MiB;
constexpr size_t WS_HCC = 51 * MiB;
constexpr size_t WS_AFFT = 53 * MiB;
constexpr size_t WS_ROWMAP = 56 * MiB;
constexpr size_t WS_GATE = 57 * MiB;
constexpr size_t WS_INV = 58 * MiB;
constexpr size_t WS_CRES = 61 * MiB;
constexpr size_t WS_HX = 69 * MiB;
constexpr size_t WS_WGU_T = 137 * MiB;
constexpr size_t WS_XB = 265 * MiB;
constexpr size_t WS_WD_T = 393 * MiB;
constexpr size_t WS_R = 521 * MiB;
constexpr size_t WS_ACT = WS_R;
constexpr size_t WS_XG = WS_R + 272 * MiB;
constexpr size_t WS_PX = WS_R;
constexpr size_t WS_Y = WS_R + 153 * MiB;
constexpr size_t WS_YT = WS_XG + 48 * MiB;
constexpr size_t WS_UT = WS_XG;
constexpr size_t WS_HS = WS_R + 408 * MiB;
constexpr size_t WS_END = WS_HS + 64 * MiB;
static_assert(WS_END <= 1024 * MiB, "workspace map");

struct Args { const float* in[N_IN]; float* out; unsigned char* ws; };

__device__ __forceinline__ float bf2f(unsigned short v) { return __uint_as_float(((unsigned)v) << 16); }
__device__ __forceinline__ unsigned f2bf(float f) { unsigned u = __float_as_uint(f); return (u + 0x7fffu + ((u >> 16) & 1u)) >> 16; }
__device__ __forceinline__ unsigned pk2(float lo, float hi) { return f2bf(lo) | (f2bf(hi) << 16); }
__device__ __forceinline__ float bflo(unsigned w) { return __uint_as_float(w << 16); }
__device__ __forceinline__ float bfhi(unsigned w) { return __uint_as_float(w & 0xffff0000u); }
__device__ __forceinline__ float dot2bf(unsigned a, unsigned b, float acc) { return __builtin_amdgcn_fdot2_f32_bf16(__builtin_bit_cast(bf16x2_t, a), __builtin_bit_cast(bf16x2_t, b), acc, false); }
template <int O> __device__ __forceinline__ float xshfl(float v) {
    if constexpr (O == 32) { auto rr = __builtin_amdgcn_permlane32_swap(__float_as_uint(v), __float_as_uint(v), false, false);
        const bool lowhalf = __builtin_amdgcn_mbcnt_lo(~0u, 0u) == __builtin_amdgcn_mbcnt_hi(~0u, __builtin_amdgcn_mbcnt_lo(~0u, 0u));
        return lowhalf ? __uint_as_float(rr[1]) : __uint_as_float(rr[0]); }
    else return __builtin_bit_cast(float, __builtin_amdgcn_ds_swizzle(__builtin_bit_cast(int, v), (O << 10) | 0x1f));
}
__device__ __forceinline__ float xsum32(float v) { auto rr = __builtin_amdgcn_permlane32_swap(__float_as_uint(v), __float_as_uint(v), false, false); return __uint_as_float(rr[0]) + __uint_as_float(rr[1]); }
__device__ __forceinline__ float xmax32(float v) { auto rr = __builtin_amdgcn_permlane32_swap(__float_as_uint(v), __float_as_uint(v), false, false); return fmaxf(__uint_as_float(rr[0]), __uint_as_float(rr[1])); }
__device__ __forceinline__ float wave_sum(float v) { v += xshfl<1>(v); v += xshfl<2>(v); v += xshfl<4>(v); v += xshfl<8>(v); v += xshfl<16>(v); return xsum32(v); }
__device__ __forceinline__ float wave_max_(float v) { v = fmaxf(v, xshfl<1>(v)); v = fmaxf(v, xshfl<2>(v)); v = fmaxf(v, xshfl<4>(v)); v = fmaxf(v, xshfl<8>(v)); v = fmaxf(v, xshfl<16>(v)); return xmax32(v); }
#define LDS_WAIT() asm volatile("s_waitcnt lgkmcnt(0)" ::: "memory")

#ifndef AMP_PHASE
#define AMP_PHASE -1
#endif
__device__ __forceinline__ unsigned long long amp_now() { asm volatile("s_waitcnt vmcnt(0) lgkmcnt(0)" ::: "memory"); __builtin_amdgcn_sched_barrier(0); const unsigned long long t = __builtin_amdgcn_s_memrealtime(); asm volatile("s_waitcnt lgkmcnt(0)" ::: "memory"); __builtin_amdgcn_sched_barrier(0); return t; }
#define AMP_BEGIN(id) unsigned long long amp_t0_ = 0; if ((id) == AMP_PHASE) { __syncthreads(); amp_t0_ = amp_now(); }
#define AMP_END(id) if ((id) == AMP_PHASE) { __syncthreads(); const unsigned long long t1_ = amp_now(); const unsigned long long d_ = t1_ - amp_t0_; while (amp_now() - t1_ < d_) __builtin_amdgcn_s_sleep(8); __syncthreads(); }
__device__ __forceinline__ void tr_item(const float* W, int K, int N, bf16_t* WT, int Kt, int item, int mode, LAS float* scr, int lane) {
    const int nblk = N / 32, kb = item / nblk, nb = item % nblk, k0 = 64 * kb, n0 = 32 * nb;
    const int r8 = lane >> 3, c4 = lane & 7; f32x4 v[8];
    const float* wp = W + (size_t)(k0 + r8) * N + n0 + 4 * c4;
#pragma unroll
    for (int i = 0; i < 8; ++i) v[i] = *(const f32x4*)(wp + (size_t)(8 * i) * N);
#pragma unroll
    for (int i = 0; i < 8; ++i) { LAS float* d = scr + (r8 + 8 * i) * 33 + 4 * c4; d[0] = v[i][0]; d[1] = v[i][1]; d[2] = v[i][2]; d[3] = v[i][3]; }
    LDS_WAIT();
    const int c = lane & 7;
    const int drow0 = (mode == 0) ? n0 : ((n0 >> 7) * 256 + (n0 & 127) + (mode == 2 ? 128 : 0));
#pragma unroll
    for (int j = 0; j < 4; ++j) { const int n = (lane >> 3) + 8 * j; const LAS float* sp = scr + (8 * c) * 33 + n;
        u32x4 o; o.x = pk2(sp[0 * 33], sp[1 * 33]); o.y = pk2(sp[2 * 33], sp[3 * 33]); o.z = pk2(sp[4 * 33], sp[5 * 33]); o.w = pk2(sp[6 * 33], sp[7 * 33]);
        *(u32x4*)(WT + (size_t)(drow0 + n) * Kt + k0 + 8 * c) = o; }
    LDS_WAIT();
}

struct CvtStream { int it, end, live; f32x4 v0, v1, v2, v3, v4, v5, v6, v7; };
constexpr int CVT_ITEMS = 2 * 3 * 16 * 1024;
__device__ __forceinline__ void cvt_decode(const Args& a, int r, const float*& W, int& K, int& N, unsigned char*& WT, int& Kt, int& mode, int& ri, float*& wsc) {
    const int l = r / 49152, rr = r % 49152, which = rr >> 14, e = (rr >> 10) & 15; ri = rr & 1023; const size_t le = (size_t)l * 16 + e;
    wsc = (float*)(a.ws + WS_WSC) + (l * 3 + which) * 16 + e;
    if (which == 0) { W = a.in[I_WG] + le * 1024 * 2048; K = 1024; N = 2048; WT = (unsigned char*)(a.ws + WS_WGU_T) + le * 4096 * 1024; Kt = 1024; mode = 1; }
    else if (which == 1) { W = a.in[I_WU] + le * 1024 * 2048; K = 1024; N = 2048; WT = (unsigned char*)(a.ws + WS_WGU_T) + le * 4096 * 1024; Kt = 1024; mode = 2; }
    else { W = a.in[I_WD] + le * 2048 * 1024; K = 2048; N = 1024; WT = (unsigned char*)(a.ws + WS_WD_T) + le * 1024 * 2048; Kt = 2048; mode = 0; }
}
__device__ __forceinline__ void cvt_issue(const Args& a, CvtStream& c, int lane) {
    c.live = 0; if (c.it >= c.end) return;
    const float* W; int K, N, Kt, mode, ri; unsigned char* WT; float* wsc; cvt_decode(a, c.it, W, K, N, WT, Kt, mode, ri, wsc);
    const int nblk = N / 32, kb = ri / nblk, nb = ri % nblk, k0 = 64 * kb, n0 = 32 * nb; const int r8 = lane >> 3, c4 = lane & 7;
    const float* wp = W + (size_t)(k0 + r8) * N + n0 + 4 * c4; const size_t st = (size_t)8 * N;
    c.v0 = *(const f32x4*)(wp); c.v1 = *(const f32x4*)(wp + st); c.v2 = *(const f32x4*)(wp + 2 * st); c.v3 = *(const f32x4*)(wp + 3 * st);
    c.v4 = *(const f32x4*)(wp + 4 * st); c.v5 = *(const f32x4*)(wp + 5 * st); c.v6 = *(const f32x4*)(wp + 6 * st); c.v7 = *(const f32x4*)(wp + 7 * st);
    c.live = 1;
}
__device__ __forceinline__ void cvt_finish(const Args& a, CvtStream& c, LAS float* scr, int lane, int stride) {
    if (!c.live) return;
    const float* W; int K, N, Kt, mode, ri; unsigned char* WT; float* wsc; cvt_decode(a, c.it, W, K, N, WT, Kt, mode, ri, wsc);
    const int nblk = N / 32, kb = ri / nblk, nb = ri % nblk, k0 = 64 * kb, n0 = 32 * nb; const int r8 = lane >> 3, c4 = lane & 7;
    const float mul = 1.0f / *wsc;
    LAS float* d = scr + r8 * 33 + 4 * c4;
#define CVT_PUT(i, v) { d[(8 * (i)) * 33 + 0] = v[0] * mul; d[(8 * (i)) * 33 + 1] = v[1] * mul; d[(8 * (i)) * 33 + 2] = v[2] * mul; d[(8 * (i)) * 33 + 3] = v[3] * mul; }
    CVT_PUT(0, c.v0) CVT_PUT(1, c.v1) CVT_PUT(2, c.v2) CVT_PUT(3, c.v3) CVT_PUT(4, c.v4) CVT_PUT(5, c.v5) CVT_PUT(6, c.v6) CVT_PUT(7, c.v7)
#undef CVT_PUT
    LDS_WAIT();
    const int cc = lane & 7;
    const int drow0 = (mode == 0) ? n0 : ((n0 >> 7) * 256 + (n0 & 127) + (mode == 2 ? 128 : 0));
#pragma unroll
    for (int j = 0; j < 4; ++j) { const int n = (lane >> 3) + 8 * j; const LAS float* sp = scr + (8 * cc) * 33 + n;
        int p0 = 0, p1 = 0;
        p0 = __builtin_amdgcn_cvt_pk_fp8_f32(sp[0 * 33], sp[1 * 33], p0, false); p0 = __builtin_amdgcn_cvt_pk_fp8_f32(sp[2 * 33], sp[3 * 33], p0, true);
        p1 = __builtin_amdgcn_cvt_pk_fp8_f32(sp[4 * 33], sp[5 * 33], p1, false); p1 = __builtin_amdgcn_cvt_pk_fp8_f32(sp[6 * 33], sp[7 * 33], p1, true);
        typedef int i32x2v __attribute__((ext_vector_type(2)));
        *(i32x2v*)(WT + (size_t)(drow0 + n) * Kt + k0 + 8 * cc) = (i32x2v){p0, p1}; }
    LDS_WAIT();
    c.it += stride; c.live = 0;
}

__device__ __forceinline__ void filter_item(const Args& a, LAS unsigned char* lds, int item, int tid) {
    asm volatile("" : "+v"(tid));
    const int lane = tid & 63, wave = tid >> 6;
    int l, L, p0; float* HCdst;
    if (item < 128) { l = 0; L = 4096; p0 = item * 32; HCdst = (float*)(a.ws + WS_HC); }
    else if (item < 256) { l = 1; L = 4096; p0 = (item - 128) * 32; HCdst = (float*)(a.ws + WS_HC) + (size_t)2 * 256 * 8192; }
    else { l = 0; L = 256; p0 = (item - 256) * 32; HCdst = (float*)(a.ws + WS_HCC) + 256; }
    LAS float* w1s = (LAS float*)lds; LAS float* w2s = w1s + 33 * 64; LAS float* b1s = w2s + 64 * 64; LAS float* b2s = b1s + 64; LAS float* frs = b2s + 64; LAS float* h2s = frs + 64; LAS float* ex = h2s + 32 * 64;
    { const float* w1 = a.in[I_HW1] + l * 33 * 64; const float* w2 = a.in[I_HW2] + l * 64 * 64;
      for (int i = tid; i < 33 * 64; i += NTHR) w1s[i] = w1[i];
      for (int i = tid; i < 64 * 64; i += NTHR) w2s[i] = w2[i];
      if (tid < 64) { b1s[tid] = a.in[I_HB1][l * 64 + tid]; b2s[tid] = a.in[I_HB2][l * 64 + tid]; frs[tid] = a.in[I_HFREQ][l * 64 + tid]; } }
    __syncthreads();
    const float frq = frs[lane];
#pragma unroll 1
    for (int q = 0; q < 4; ++q) { const int pp = wave * 4 + q, p = p0 + pp; const float tn = (float)p / (float)(L - 1);
        float fv = 0.f;
        if (lane == 0) fv = tn;
        else if (lane <= 32) { const int bi = (lane - 1) & 15; const float band = 1e-4f + (float)bi * ((15.0f - 1e-4f) / 15.0f);
            const float ang = ((float)(6.283185307179586 / (double)L) * (float)p) * band; fv = (lane <= 16) ? cosf(ang) : -sinf(ang); }
        float a1 = b1s[lane];
#pragma unroll
        for (int i = 0; i < 33; ++i) a1 += __builtin_bit_cast(float, __builtin_amdgcn_readlane(__builtin_bit_cast(int, fv), i)) * w1s[i * 64 + lane];
        const float h1 = sinf(frq * a1);
        float a2 = b2s[lane];
#pragma unroll 16
        for (int i = 0; i < 64; ++i) a2 += __builtin_bit_cast(float, __builtin_amdgcn_readlane(__builtin_bit_cast(int, h1), i)) * w2s[i * 64 + lane];
        h2s[lane * 32 + pp] = sinf(frq * a2); }
    __syncthreads();
    const float* w3 = a.in[I_HW3] + (size_t)l * 64 * 1024 + tid;
    float acc0[32], acc1[32];
#pragma unroll
    for (int pp = 0; pp < 32; ++pp) { acc0[pp] = 0.f; acc1[pp] = 0.f; }
#pragma unroll 4
    for (int i = 0; i < 64; ++i) { const float wa = w3[i * 1024], wb = w3[i * 1024 + 512];
#pragma unroll
        for (int q = 0; q < 8; ++q) { const f32x4 h = *(const LAS f32x4*)(h2s + i * 32 + 4 * q);
#pragma unroll
            for (int r = 0; r < 4; ++r) { acc0[4 * q + r] += h[r] * wa; acc1[4 * q + r] += h[r] * wb; } } }
    const int c = tid & 255, dir = tid >> 8; const float dmin = 3.0701134573253945f, dmax = 15.350567286626972f; const float delta = dmin + (float)c * ((dmax - dmin) / 255.0f);
    float* base0 = HCdst; float* base1 = HCdst + (size_t)(2 * L - 1) * 256;
    const bool tr = (L == 4096);
#pragma unroll
    for (int pp = 0; pp < 32; ++pp) { const int p = p0 + pp; const float tn = (float)p / (float)(L - 1); const float win = expf(-tn * delta); const float v0 = acc0[pp] * win, v1 = acc1[pp] * win;
        if (p == 0) { ex[tid] = v0; ex[512 + tid] = v1; }
        else { const int li = dir == 0 ? (L - 1 + p) : (L - 1 - p); const size_t idx = tr ? ((size_t)c * 8192 + li) : ((size_t)li * 256 + c); const size_t o1 = tr ? (size_t)256 * 8192 : (size_t)(2 * L - 1) * 256; base0[idx] = v0; base0[idx + o1] = v1; } }
    __syncthreads();
    if (p0 == 0 && tid < 256) { const size_t idx = tr ? ((size_t)tid * 8192 + (L - 1)) : ((size_t)(L - 1) * 256 + tid); const size_t o1 = tr ? (size_t)256 * 8192 : (size_t)(2 * L - 1) * 256; base0[idx] = ex[tid] + ex[tid + 256]; base0[idx + o1] = ex[512 + tid] + ex[512 + tid + 256]; }
    __syncthreads();
}


typedef int v8i_t __attribute__((ext_vector_type(8)));
__device__ __forceinline__ float st_A(int i, int k) { return (float)(((i * 7 + k * 3) % 5) - 2); }
__device__ __forceinline__ float st_B(int k, int j) { return (float)(((k * 5 + j * 11 + (k >> 4)) % 5) - 2); }
__device__ __forceinline__ void fp8_selftest(unsigned* poison, int lane) {
    const int fr = lane & 15, fq = lane >> 4; v8i_t av, bv;
#pragma unroll
    for (int w = 0; w < 8; ++w) { int pa = 0, pb = 0;
#pragma unroll
        for (int q = 0; q < 4; ++q) { }
        const int kb = (w < 4) ? (16 * fq + 4 * w) : (64 + 16 * fq + 4 * (w - 4));
        pa = __builtin_amdgcn_cvt_pk_fp8_f32(st_A(fr, kb), st_A(fr, kb + 1), pa, false); pa = __builtin_amdgcn_cvt_pk_fp8_f32(st_A(fr, kb + 2), st_A(fr, kb + 3), pa, true);
        pb = __builtin_amdgcn_cvt_pk_fp8_f32(st_B(kb, fr), st_B(kb + 1, fr), pb, false); pb = __builtin_amdgcn_cvt_pk_fp8_f32(st_B(kb + 2, fr), st_B(kb + 3, fr), pb, true);
        av[w] = pa; bv[w] = pb; }
    f32x4 acc = {0.f, 0.f, 0.f, 0.f};
    acc = __builtin_amdgcn_mfma_scale_f32_16x16x128_f8f6f4(av, bv, acc, 0, 0, 0, 0x7f7f7f7f, 0, 0x7f7f7f7f);
    bool bad = false;
#pragma unroll
    for (int r = 0; r < 4; ++r) { float ref = 0.f; for (int k = 0; k < 128; ++k) ref += st_A(4 * fq + r, k) * st_B(k, fr); bad |= (acc[r] != ref); }
    { const float v = (float)(lane * 3 + 1);
      const float r5 = __builtin_bit_cast(float, __builtin_amdgcn_update_dpp(0, __builtin_bit_cast(int, v), 0x150 + 5, 0xf, 0xf, false));
      const float r12 = __builtin_bit_cast(float, __builtin_amdgcn_update_dpp(0, __builtin_bit_cast(int, v), 0x150 + 12, 0xf, 0xf, false));
      bad |= (r5 != (float)(((lane & 48) + 5) * 3 + 1)) || (r12 != (float)(((lane & 48) + 12) * 3 + 1)); }
    if (__any(bad) && lane == 0) __hip_atomic_store(poison, 1u, __ATOMIC_RELAXED, __HIP_MEMORY_SCOPE_AGENT);
}

__device__ __forceinline__ void phase_prologue(const Args& a, unsigned char* ldsg, int vcu, int G) {
    LAS unsigned char* lds = (LAS unsigned char*)ldsg;
    int tid_ = threadIdx.x; asm volatile("" : "+v"(tid_));
    const int tid = tid_, lane = tid & 63, wave = __builtin_amdgcn_readfirstlane(tid >> 6);
    unsigned char* ws = a.ws;
    if (vcu == 2 % G && wave == 0) fp8_selftest((unsigned*)(ws + WS_CTL) + 12288, lane);
    LAS float* sc = (LAS float*)lds; LAS float* red = (LAS float*)(lds + 36864);
    for (int i = tid; i < 9 * 1024; i += NTHR) { const float v = (i < 8192) ? a.in[I_C][i] : a.in[I_CCTX][i - 8192]; sc[i] = v / (1.0f + expf(-v)); }
    __syncthreads();
    { AMP_BEGIN(41)
    float* MOD = (float*)(ws + WS_MOD);
    for (int item = vcu; item < 2 * 96; item += G) {
        const int l = item / 96, n0 = (item % 96) * 64, col = tid & 63, kg = tid >> 6;
        float acc[9];
#pragma unroll
        for (int r = 0; r < 9; ++r) acc[r] = 0.f;
        const float* w = a.in[I_ADAW] + (size_t)l * 1024 * 6144 + n0 + col;
#pragma unroll 4
        for (int k = kg * 128; k < kg * 128 + 128; ++k) { const float wv = w[(size_t)k * 6144];
#pragma unroll
            for (int r = 0; r < 9; ++r) acc[r] += sc[r * 1024 + k] * wv; }
#pragma unroll
        for (int r = 0; r < 9; ++r) red[(kg * 9 + r) * 64 + col] = acc[r];
        __syncthreads();
        for (int o = tid; o < 9 * 64; o += NTHR) { const int r = o >> 6, cc = o & 63; float s = 0.f;
#pragma unroll
            for (int g2 = 0; g2 < 8; ++g2) s += red[(g2 * 9 + r) * 64 + cc];
            MOD[(size_t)(l * 9 + r) * 6144 + n0 + cc] = s + a.in[I_ADAB][l * 6144 + n0 + cc]; }
        __syncthreads();
    }
    AMP_END(41) }
    if (vcu == 0) { float* ROPE = (float*)(ws + WS_ROPE);
        for (int i = tid; i < 1024; i += NTHR) { const int pos = i >> 4, fi = i & 15; const float inv = powf(10000.0f, -(float)fi / 16.0f); const float ang = (float)pos * inv;
            ROPE[2 * i] = cosf(ang); ROPE[2 * i + 1] = sinf(ang); } }
    if (vcu == 1 % G) { float* TW8 = (float*)(ws + WS_TW8);
        for (int i = tid; i < 8192; i += NTHR) { float sn, cs; sincospif(-(float)i * (1.0f / 4096.0f), &sn, &cs); TW8[2 * i] = cs; TW8[2 * i + 1] = sn; } }
    const int gw = vcu * NWAVES + wave, NGW = G * NWAVES;
    { AMP_BEGIN(42)
    for (int it = vcu; it < 264; it += G) filter_item(a, lds, it, tid);
    AMP_END(42) }
    { AMP_BEGIN(43)
    LAS float* scr = (LAS float*)(lds + 65536 + wave * 8448);
    for (int m = gw; m < 96; m += NGW) { const int l = m / 48, which = (m % 48) / 16, e = m & 15; const size_t le = (size_t)l * 16 + e; int lane_ = lane; asm volatile("" : "+v"(lane_));
        const float* W = (which == 0) ? a.in[I_WG] + le * 1024 * 2048 : ((which == 1) ? a.in[I_WU] + le * 1024 * 2048 : a.in[I_WD] + le * 2048 * 1024);
        const f32x4 sv = *(const f32x4*)(W + 4 * lane_); float sm = fmaxf(fmaxf(fabsf(sv[0]), fabsf(sv[1])), fmaxf(fabsf(sv[2]), fabsf(sv[3])));
        sm = wave_max_(sm);
        int E = 0; (void)frexpf(fmaxf(sm, 1e-30f), &E); if (lane_ == 0) ((float*)(ws + WS_WSC))[m] = ldexpf(1.0f, E - 5); }
    constexpr int IT_IN = 16 * 72, IT_OUT = 16 * 32, IT_LAYER = IT_IN + IT_OUT;
    for (int it = gw; it < 2 * IT_LAYER; it += NGW) {
        const int l = it / IT_LAYER; int r = it % IT_LAYER;
        if (r < IT_IN) { tr_item(a.in[I_WIN] + (size_t)l * 1024 * 2304, 1024, 2304, (bf16_t*)(ws + WS_WIN_T) + (size_t)l * 2304 * 1024, 1024, r, 0, scr, lane); continue; } r -= IT_IN;
        tr_item(a.in[I_WOUT] + (size_t)l * 1024 * 1024, 1024, 1024, (bf16_t*)(ws + WS_WOUT_T) + (size_t)l * 1024 * 1024, 1024, r, 0, scr, lane);
    }
    AMP_END(43) }
}

__device__ __forceinline__ void phase_norm_router(const Args& a, unsigned char* ldsg, int vcu, int G, int l, const bf16_t* XB, const float* gain, int nrows) {
    int tid_ = threadIdx.x; asm volatile("" : "+v"(tid_));
    const int tid = tid_, lane = tid & 63, wave = __builtin_amdgcn_readfirstlane(tid >> 6);
    unsigned char* ws = a.ws; asm volatile("" : "+s"(ws)); const float* MOD = (const float*)(ws + WS_MOD) + (size_t)l * 9 * 6144; unsigned char* HX8 = (unsigned char*)(ws + WS_HX);
    LAS unsigned short* rwb = (LAS unsigned short*)(LAS unsigned char*)ldsg;
    { const float* rsrc = a.in[I_ROUTER] + (size_t)l * 1024 * 16; f32x4 rv[8];
#pragma unroll
      for (int k = 0; k < 8; ++k) rv[k] = *(const f32x4*)(rsrc + 4 * (tid + NTHR * k));
#pragma unroll
      for (int k = 0; k < 8; ++k) { const int i4 = tid + NTHR * k, col = i4 >> 2, e0 = (4 * i4) & 15;
#pragma unroll
          for (int q = 0; q < 4; ++q) rwb[(e0 + q) * 1064 + col] = (unsigned short)f2bf(rv[k][q]); }
      __syncthreads(); }
    const int r = lane & 15, kq = lane >> 4; const int gw = vcu * NWAVES + wave, NGW = G * NWAVES; const int ntiles = nrows / 16;
    for (int tile = gw; tile < ntiles; tile += NGW) {
        const int row = tile * 16 + r; const bool lat = row < TX; const int mrow = lat ? (row >> 12) : 8;
        const bf16_t* xr = XB + (size_t)row * D + 8 * kq; const float* shp = MOD + mrow * 6144 + 3 * 1024 + 8 * kq; const float* scp = shp + 1024; const float* gp = gain + 8 * kq;
        float ss = 0.f;
#pragma unroll 1
        for (int s0 = 0; s0 < 32; s0 += 8) { u32x4 w[8];
#pragma unroll
            for (int s = 0; s < 8; ++s) w[s] = *(const u32x4*)(xr + 32 * (s0 + s));
#pragma unroll
            for (int s = 0; s < 8; ++s) { const float v0 = bflo(w[s].x), v1 = bfhi(w[s].x), v2 = bflo(w[s].y), v3 = bfhi(w[s].y), v4 = bflo(w[s].z), v5 = bfhi(w[s].z), v6 = bflo(w[s].w), v7 = bfhi(w[s].w);
                ss += ((v0 * v0 + v1 * v1) + (v2 * v2 + v3 * v3)) + ((v4 * v4 + v5 * v5) + (v6 * v6 + v7 * v7)); } }
        ss += xshfl<16>(ss); ss = xsum32(ss);
        const float rstd = 1.0f / sqrtf(ss * (1.0f / D) + 1e-6f);
        f32x4 acc = {0.f, 0.f, 0.f, 0.f};
        const LAS unsigned short* wb = rwb + r * 1064 + 8 * kq;
#pragma unroll 4
        for (int s = 0; s < 32; ++s) { const u32x4 w = *(const u32x4*)(xr + 32 * s);
            const f32x4 g0 = *(const f32x4*)(gp + 32 * s), g1 = *(const f32x4*)(gp + 32 * s + 4), h0 = *(const f32x4*)(shp + 32 * s), h1 = *(const f32x4*)(shp + 32 * s + 4), c0 = *(const f32x4*)(scp + 32 * s), c1 = *(const f32x4*)(scp + 32 * s + 4);
            float hv[8];
            hv[0] = (bflo(w.x) * rstd * g0[0]) * (1.0f + c0[0]) + h0[0]; hv[1] = (bfhi(w.x) * rstd * g0[1]) * (1.0f + c0[1]) + h0[1]; hv[2] = (bflo(w.y) * rstd * g0[2]) * (1.0f + c0[2]) + h0[2]; hv[3] = (bfhi(w.y) * rstd * g0[3]) * (1.0f + c0[3]) + h0[3];
            hv[4] = (bflo(w.z) * rstd * g1[0]) * (1.0f + c1[0]) + h1[0]; hv[5] = (bfhi(w.z) * rstd * g1[1]) * (1.0f + c1[1]) + h1[1]; hv[6] = (bflo(w.w) * rstd * g1[2]) * (1.0f + c1[2]) + h1[2]; hv[7] = (bfhi(w.w) * rstd * g1[3]) * (1.0f + c1[3]) + h1[3];
            int p0 = 0, p1 = 0;
            p0 = __builtin_amdgcn_cvt_pk_fp8_f32(__builtin_amdgcn_fmed3f(hv[0], -448.f, 448.f), __builtin_amdgcn_fmed3f(hv[1], -448.f, 448.f), p0, false); p0 = __builtin_amdgcn_cvt_pk_fp8_f32(__builtin_amdgcn_fmed3f(hv[2], -448.f, 448.f), __builtin_amdgcn_fmed3f(hv[3], -448.f, 448.f), p0, true);
            p1 = __builtin_amdgcn_cvt_pk_fp8_f32(__builtin_amdgcn_fmed3f(hv[4], -448.f, 448.f), __builtin_amdgcn_fmed3f(hv[5], -448.f, 448.f), p1, false); p1 = __builtin_amdgcn_cvt_pk_fp8_f32(__builtin_amdgcn_fmed3f(hv[6], -448.f, 448.f), __builtin_amdgcn_fmed3f(hv[7], -448.f, 448.f), p1, true);
            typedef int i32x2v __attribute__((ext_vector_type(2)));
            *(i32x2v*)(HX8 + (size_t)row * D + 32 * s + 8 * kq) = (i32x2v){p0, p1};
            u32x4 af; af.x = pk2(hv[0], hv[1]); af.y = pk2(hv[2], hv[3]); af.z = pk2(hv[4], hv[5]); af.w = pk2(hv[6], hv[7]);
            typedef short bf16x8r __attribute__((ext_vector_type(8)));
            const bf16x8r bfr = *(const LAS bf16x8r*)(wb + 32 * s);
            acc = __builtin_amdgcn_mfma_f32_16x16x32_bf16(__builtin_bit_cast(bf16x8r, af), bfr, acc, 0, 0, 0); }
#pragma unroll
        for (int q = 0; q < 4; ++q) { float mx = acc[q]; mx = fmaxf(mx, xshfl<1>(mx)); mx = fmaxf(mx, xshfl<2>(mx)); mx = fmaxf(mx, xshfl<4>(mx)); mx = fmaxf(mx, xshfl<8>(mx));
            const float pe = expf(acc[q] - mx); float den = pe; den += xshfl<1>(den); den += xshfl<2>(den); den += xshfl<4>(den); den += xshfl<8>(den);
            const int orow = tile * 16 + 4 * kq + q;
            ((float*)(ws + WS_AFFT))[(size_t)r * TT + orow] = pe / den; ((int*)(ws + WS_INV))[(size_t)orow * 16 + r] = -1; }
    }
}

__device__ __forceinline__ void phase_norm(const Args& a, unsigned char* ldsg, int vcu, int G, int l, const float* srcx, const float* srcc, const bf16_t* srcb, const float* gain, int shift_idx, int nrows, bool router) {
    int tid_ = threadIdx.x; asm volatile("" : "+v"(tid_));
    const int tid = tid_, lane = tid & 63, wave = __builtin_amdgcn_readfirstlane(tid >> 6);
    unsigned char* ws = a.ws; asm volatile("" : "+s"(ws)); const float* MOD = (const float*)(ws + WS_MOD) + (size_t)l * 9 * 6144; bf16_t* HX = (bf16_t*)(ws + WS_HX);
    LAS float* rw = (LAS float*)(LAS unsigned char*)ldsg;
    if (router) { const float* rsrc = a.in[I_ROUTER] + (size_t)l * 1024 * 16; f32x4 rv[8];
#pragma unroll
        for (int k = 0; k < 8; ++k) rv[k] = *(const f32x4*)(rsrc + 4 * (tid + NTHR * k));
#pragma unroll
        for (int k = 0; k < 8; ++k) { const int i4 = tid + NTHR * k, col = i4 >> 2, e0 = (4 * i4) & 15;
#pragma unroll
            for (int q = 0; q < 4; ++q) rw[(e0 + q) * 1024 + col] = rv[k][q]; }
        __syncthreads(); }
    const int gw = vcu * NWAVES + wave, NGW = G * NWAVES;
    f32x4 nv[2][4];
#define NRM_PRELOAD(ra) do { _Pragma("unroll") for (int u = 0; u < 2; ++u) { const int rr = ((ra) + u * NGW < nrows) ? (ra) + u * NGW : gw; \
            if (srcb) { const bf16_t* xr = srcb + (size_t)rr * D; _Pragma("unroll") for (int j = 0; j < 4; ++j) { const u32x2 w = *(const u32x2*)(xr + 256 * j + 4 * lane); nv[u][j] = (f32x4){bflo(w.x), bfhi(w.x), bflo(w.y), bfhi(w.y)}; } } \
            else { const float* xr = (rr < TX) ? srcx + (size_t)rr * D : srcc + (size_t)(rr - TX) * D; _Pragma("unroll") for (int j = 0; j < 4; ++j) nv[u][j] = *(const f32x4*)(xr + 256 * j + 4 * lane); } } } while (0)
    NRM_PRELOAD(gw);
    for (int rowa = gw; rowa < nrows; rowa += 2 * NGW) {
        f32x4 vv[2][4];
#pragma unroll
        for (int u = 0; u < 2; ++u)
#pragma unroll
            for (int j = 0; j < 4; ++j) vv[u][j] = nv[u][j];
        if (rowa + 2 * NGW < nrows) NRM_PRELOAD(rowa + 2 * NGW);
        f32x4 hv[2][4];
#pragma unroll
        for (int u = 0; u < 2; ++u) { const int row = rowa + u * NGW; if (row < nrows) {
        const bool lat = row < TX; const int mrow = lat ? (row >> 12) : 8;
        const float* shp = MOD + mrow * 6144 + shift_idx * 1024; const float* scp = shp + 1024;
        f32x4 v[4]; float ss = 0.f;
#pragma unroll
        for (int j = 0; j < 4; ++j) { v[j] = vv[u][j]; ss += (v[j][0] * v[j][0] + v[j][1] * v[j][1]) + (v[j][2] * v[j][2] + v[j][3] * v[j][3]); }
        const float rstd = 1.0f / sqrtf(wave_sum(ss) * (1.0f / D) + 1e-6f);
#pragma unroll
        for (int j = 0; j < 4; ++j) { const f32x4 gg = *(const f32x4*)(gain + 256 * j + 4 * lane), sh = *(const f32x4*)(shp + 256 * j + 4 * lane), sc = *(const f32x4*)(scp + 256 * j + 4 * lane);
            v[j] = (v[j] * rstd * gg) * (1.0f + sc) + sh;
            if (router) { int p = 0; p = __builtin_amdgcn_cvt_pk_fp8_f32(fminf(fmaxf(v[j][0], -448.f), 448.f), fminf(fmaxf(v[j][1], -448.f), 448.f), p, false); p = __builtin_amdgcn_cvt_pk_fp8_f32(fminf(fmaxf(v[j][2], -448.f), 448.f), fminf(fmaxf(v[j][3], -448.f), 448.f), p, true);
                *(int*)((unsigned char*)HX + (size_t)row * D + 256 * j + 4 * lane) = p; }
            else { u32x2 o; o.x = pk2(v[j][0], v[j][1]); o.y = pk2(v[j][2], v[j][3]); *(u32x2*)(HX + (size_t)row * D + 256 * j + 4 * lane) = o; } }
#pragma unroll
        for (int j = 0; j < 4; ++j) hv[u][j] = v[j];
        } }
        float plr[2][16];
        if (router) {
#pragma unroll
            for (int e = 0; e < 16; ++e) { float p0 = 0.f, p1 = 0.f;
#pragma unroll
                for (int j = 0; j < 4; ++j) { const f32x4 wv = *(const LAS f32x4*)(rw + e * 1024 + 256 * j + 4 * lane);
                    p0 += (hv[0][j][0] * wv[0] + hv[0][j][1] * wv[1]) + (hv[0][j][2] * wv[2] + hv[0][j][3] * wv[3]);
                    p1 += (hv[1][j][0] * wv[0] + hv[1][j][1] * wv[1]) + (hv[1][j][2] * wv[2] + hv[1][j][3] * wv[3]); }
                plr[0][e] = p0; plr[1][e] = p1; if ((e & 3) == 3) asm volatile("" : "+v"(plr[0][e]), "+v"(plr[1][e]), "+v"(plr[0][e - 1]), "+v"(plr[1][e - 1]), "+v"(plr[0][e - 2]), "+v"(plr[1][e - 2]), "+v"(plr[0][e - 3]), "+v"(plr[1][e - 3]) :: "memory"); } }
#pragma unroll
        for (int u = 0; u < 2; ++u) { const int row = rowa + u * NGW; if (row < nrows) {
        if (router) {
            float pl[16];
#pragma unroll
            for (int e = 0; e < 16; ++e) pl[e] = plr[u][e];
            float q8[8], q4[4], q2[2], q1;
            { const bool up = (lane & 8) != 0;
#pragma unroll
              for (int e = 0; e < 8; ++e) { const float keep = up ? pl[e + 8] : pl[e], give = up ? pl[e] : pl[e + 8]; q8[e] = keep + xshfl<8>(give); } }
            { const bool up = (lane & 4) != 0;
#pragma unroll
              for (int e = 0; e < 4; ++e) { const float keep = up ? q8[e + 4] : q8[e], give = up ? q8[e] : q8[e + 4]; q4[e] = keep + xshfl<4>(give); } }
            { const bool up = (lane & 2) != 0;
#pragma unroll
              for (int e = 0; e < 2; ++e) { const float keep = up ? q4[e + 2] : q4[e], give = up ? q4[e] : q4[e + 2]; q2[e] = keep + xshfl<2>(give); } }
            { const bool up = (lane & 1) != 0; const float keep = up ? q2[1] : q2[0], give = up ? q2[0] : q2[1]; q1 = keep + xshfl<1>(give); }
            q1 += xshfl<16>(q1); q1 = xsum32(q1);
            const float mylog = (lane < 16) ? q1 : -1e30f;
            float mx = mylog;
            mx = fmaxf(mx, xshfl<1>(mx)); mx = fmaxf(mx, xshfl<2>(mx)); mx = fmaxf(mx, xshfl<4>(mx)); mx = fmaxf(mx, xshfl<8>(mx));
            const float mine = (lane < 16) ? expf(mylog - mx) : 0.f; float den = mine;
            den += xshfl<1>(den); den += xshfl<2>(den); den += xshfl<4>(den); den += xshfl<8>(den);
            if (lane < 16) { ((float*)(ws + WS_AFFT))[(size_t)lane * TT + row] = mine / den; ((int*)(ws + WS_INV))[(size_t)row * 16 + lane] = -1; }
        }
    } }
    }
}
#undef NRM_PRELOAD

#define XB_TMO      128
#define XB_XCNT(j)  (256  + 64 * (j))
#define XB_XSUB(j)  (1280 + 64 * (j))
#define XB_XGEN(j)  (2304 + 64 * (j))
#define XB_TOP      3328
#define XB_TOPGEN   3392
#define XCD_BAR_WORDS 3456
#define XB_SPIN_CAP (1u << 18)

__device__ __forceinline__ unsigned xb_ld(unsigned* p)              { return __hip_atomic_load(p, __ATOMIC_RELAXED, __HIP_MEMORY_SCOPE_AGENT); }
__device__ __forceinline__ unsigned xb_add(unsigned* p, unsigned v) { return __hip_atomic_fetch_add(p, v, __ATOMIC_RELAXED, __HIP_MEMORY_SCOPE_AGENT); }
__device__ __forceinline__ unsigned xb_xcc_id() { return (unsigned)__builtin_amdgcn_s_getreg((3 << 11) | 20) & 0xFu; }
#define XB_SPIN(cond, bar) do { unsigned _sp = 0; while (cond) { __builtin_amdgcn_s_sleep(1); \
    if ((++_sp & 255u) == 0u) { if (xb_ld(&(bar)[XB_TMO])) break; if (_sp > XB_SPIN_CAP) { atomicAdd(&(bar)[XB_TMO], 1u); break; } } } } while (0)

struct XcdBarrier {
    unsigned* bar; unsigned x;
    volatile LAS unsigned* st;
};

__device__ __forceinline__ XcdBarrier xcd_barrier_post(unsigned* bar, volatile LAS unsigned* st) {
    XcdBarrier b; b.bar = bar; b.x = xb_xcc_id(); b.st = st;
    if (threadIdx.x == 0) (void)xb_add(&bar[XB_XCNT(b.x)], 1u);
    return b;
}
__device__ __forceinline__ void xcd_barrier_complete(unsigned* bar, unsigned x, unsigned& nloc, unsigned& nx) {
    const unsigned G = gridDim.x * gridDim.y * gridDim.z;
    unsigned sum, cnt, mine, sp = 0u;
    for (;;) {
        sum = 0u; cnt = 0u; mine = 0u;
#pragma unroll
        for (unsigned j = 0; j < 16; ++j) { const unsigned c = xb_ld(&bar[XB_XCNT(j)]); sum += c; cnt += (c > 0u) ? 1u : 0u; mine = (j == x) ? c : mine; }
        if (sum == G) break;
        __builtin_amdgcn_s_sleep(1);
        if ((++sp & 255u) == 0u) { if (xb_ld(&bar[XB_TMO])) break; if (sp > XB_SPIN_CAP) { atomicAdd(&bar[XB_TMO], 1u); break; } }
    }
    nloc = mine > 0u ? mine : 1u; nx = cnt > 0u ? cnt : 1u;
}

__device__ __forceinline__ void xcd_barrier(const XcdBarrier& b) {
    asm volatile("s_waitcnt vmcnt(0)" ::: "memory");
    __syncthreads();
    if (threadIdx.x == 0) {
        unsigned* bar = b.bar;
        __builtin_amdgcn_s_waitcnt(0);
        unsigned nloc = b.st[0], nx = b.st[1];
        if (nloc == 0u) { xcd_barrier_complete(bar, b.x, nloc, nx); b.st[0] = nloc; b.st[1] = nx; }
        const unsigned old = xb_add(&bar[XB_XSUB(b.x)], 1u);
        const unsigned gen = old / nloc;
        if (old + 1u == (gen + 1u) * nloc) {
            __builtin_amdgcn_fence(__ATOMIC_RELEASE, "agent");
            asm volatile("s_waitcnt vmcnt(0)" ::: "memory");
            const unsigned og = xb_add(&bar[XB_TOP], 1u);
            const unsigned tg = og / nx;
            if (og + 1u == (tg + 1u) * nx) xb_add(&bar[XB_TOPGEN], 1u);
            else XB_SPIN(xb_ld(&bar[XB_TOPGEN]) == tg, bar);
            __builtin_amdgcn_fence(__ATOMIC_ACQUIRE, "agent");
            xb_add(&bar[XB_XGEN(b.x)], 1u);
            asm volatile("s_waitcnt vmcnt(0)" ::: "memory");
        } else {
            XB_SPIN(xb_ld(&bar[XB_XGEN(b.x)]) == gen, bar);
            __builtin_amdgcn_fence(__ATOMIC_ACQUIRE, "agent");
            asm volatile("s_waitcnt vmcnt(0)" ::: "memory");
        }
    }
    __syncthreads();
}


typedef float f32x2 __attribute__((ext_vector_type(2)));
__device__ __forceinline__ f32x2 cmul(f32x2 a, f32x2 b) { return (f32x2){a.x * b.x - a.y * b.y, a.x * b.y + a.y * b.x}; }
__device__ __forceinline__ void dft16(f32x2 (&v)[16]) {
    constexpr float WC[8] = {1.0f, 0.92387953251128674f, 0.70710678118654752f, 0.38268343236508977f, 0.0f, -0.38268343236508977f, -0.70710678118654752f, -0.92387953251128674f};
    constexpr float WS[8] = {0.0f, -0.38268343236508977f, -0.70710678118654752f, -0.92387953251128674f, -1.0f, -0.92387953251128674f, -0.70710678118654752f, -0.38268343236508977f};
#pragma unroll
    for (int s = 8; s >= 1; s >>= 1)
#pragma unroll
        for (int i = 0; i < 16; ++i) if ((i & s) == 0) { const int k = (i & (s - 1)) * (8 / s); const f32x2 u = v[i], t = v[i + s]; v[i] = u + t; const f32x2 d = u - t;
            v[i + s] = (k == 0) ? d : ((k == 4) ? (f32x2){d.y, -d.x} : (f32x2){d.x * WC[k] - d.y * WS[k], d.x * WS[k] + d.y * WC[k]}); }
}
__device__ __forceinline__ constexpr int bitrev4(int i) { return ((i & 1) << 3) | ((i & 2) << 1) | ((i & 4) >> 1) | ((i & 8) >> 3); }
template <int NS, int MODE>
__device__ __forceinline__ void fft_pass(LAS f32x2* Z, const LAS f32x2* TW, int tid, const f32x2* H) {
    const int f = tid >> 8, j = tid & 255, base = f * 4096, k = j & (NS - 1);
    f32x2 v[16];
#pragma unroll
    for (int r = 0; r < 16; ++r) { const int idx = base + j + 256 * r; v[r] = Z[idx + (idx >> 4)]; }
    if (MODE == 1) {
#pragma unroll
        for (int r = 0; r < 16; ++r) { const f32x2 p = cmul(v[r], H[r]); v[r] = (f32x2){p.y, p.x}; } }
    if (NS > 1) { const LAS f32x2* tp = (NS == 16) ? (TW + 8192 + k) : (TW + 4096 + k);
#pragma unroll
        for (int r = 1; r < 16; ++r) v[r] = cmul(v[r], tp[r * NS]); }
    dft16(v);
    if (NS != 256) __syncthreads();
    const int j0 = base + (j / NS) * NS * 16 + k;
#pragma unroll
    for (int rr = 0; rr < 16; ++rr) { const int idx = j0 + rr * NS; Z[idx + (idx >> 4)] = v[bitrev4(rr)]; }
    __syncthreads();
}
__device__ __forceinline__ void load_uc(const bf16_t* UT, const float* cw, const float* cb, int ch, int b, int tid, float (&out)[8]) {
    const bf16_t* p = UT + ((size_t)(b * 768 + ch)) * 4096 + 8 * tid;
    const u32x4 w = *(const u32x4*)p; float u[10];
    u[1] = bflo(w.x); u[2] = bfhi(w.x); u[3] = bflo(w.y); u[4] = bfhi(w.y); u[5] = bflo(w.z); u[6] = bfhi(w.z); u[7] = bflo(w.w); u[8] = bfhi(w.w);
    u[0] = (tid > 0) ? bf2f(p[-1]) : 0.f; u[9] = (tid < 511) ? bf2f(p[8]) : 0.f;
    const float w0 = cw[ch], w1 = cw[768 + ch], w2 = cw[1536 + ch], bb = cb[ch];
#pragma unroll
    for (int i = 0; i < 8; ++i) out[i] = u[i] * w0 + u[i + 1] * w1 + u[i + 2] * w2 + bb;
}
__device__ __forceinline__ void hy_fill(LAS f32x2* Z, const LAS f32x2* TW, int tid, const float (&va)[8], const float (&vb)[8]) {
#pragma unroll
    for (int i = 0; i < 8; ++i) { const int t = 8 * tid + i; const f32x2 z = {va[i], vb[i]}; Z[t + (t >> 4)] = z; const int t2 = 4096 + t; Z[t2 + (t2 >> 4)] = cmul(z, TW[t]); }
    __syncthreads();
}
__device__ __forceinline__ void hy_conv(LAS f32x2* Z, const LAS f32x2* TW, int tid, const f32x2* Hg) {
    f32x2 H[16];
    { const int f = tid >> 8, j = tid & 255, base = f * 4096;
#pragma unroll
      for (int r = 0; r < 16; ++r) H[r] = Hg[base + j + 256 * r]; }
    fft_pass<1, 0>(Z, TW, tid, nullptr); fft_pass<16, 0>(Z, TW, tid, nullptr); fft_pass<256, 0>(Z, TW, tid, nullptr);
    fft_pass<1, 1>(Z, TW, tid, H); fft_pass<16, 0>(Z, TW, tid, nullptr); fft_pass<256, 0>(Z, TW, tid, nullptr);
}
__device__ __forceinline__ f32x2 hy_out(const LAS f32x2* Z, const LAS f32x2* TW, int t) {
    const f32x2 se = Z[t + (t >> 4)]; const int t2 = 4096 + t; const f32x2 so = Z[t2 + (t2 >> 4)]; const f32x2 tw = TW[t];
    const f32x2 So = {so.y, so.x};
    return (f32x2){se.y + (So.x * tw.x + So.y * tw.y), se.x + (So.y * tw.x - So.x * tw.y)};
}
__device__ __forceinline__ void hyena_item(const Args& a, LAS unsigned char* lds, int l, int c, int bp, int tid) {
    asm volatile("" : "+v"(tid));
    LAS f32x2* Z = (LAS f32x2*)lds; const LAS f32x2* TW = (const LAS f32x2*)(lds + 69632);
    const bf16_t* UT = (const bf16_t*)(a.ws + WS_UT); bf16_t* YT = (bf16_t*)(a.ws + WS_YT);
    const float* cw = a.in[I_HCW] + (size_t)l * 3 * 768; const float* cb = a.in[I_HCB] + (size_t)l * 768; const float* skip = a.in[I_HSKIP] + (size_t)l * 2 * 256;
    const f32x2* HS = (const f32x2*)(a.ws + WS_HS) + ((size_t)(l * 2) * 256 + c) * 8192;
    const int b0 = 2 * bp, b1 = 2 * bp + 1;
    float va[8], vb[8], xa[8], xb[8];
    load_uc(UT, cw, cb, c, b0, tid, va); load_uc(UT, cw, cb, c, b1, tid, vb);
    hy_fill(Z, TW, tid, va, vb);
    hy_conv(Z, TW, tid, HS);
    load_uc(UT, cw, cb, 256 + c, b0, tid, xa); load_uc(UT, cw, cb, 256 + c, b1, tid, xb);
    { const float sk = skip[c];
#pragma unroll
      for (int i = 0; i < 8; ++i) { const f32x2 y = hy_out(Z, TW, 8 * tid + i); va[i] = xa[i] * (y.x + va[i] * sk); vb[i] = xb[i] * (y.y + vb[i] * sk); } }
    __syncthreads();
    hy_fill(Z, TW, tid, va, vb);
    hy_conv(Z, TW, tid, HS + (size_t)256 * 8192);
    load_uc(UT, cw, cb, 512 + c, b0, tid, xa); load_uc(UT, cw, cb, 512 + c, b1, tid, xb);
    { const float sk = skip[256 + c];
      float oa[8], ob[8];
#pragma unroll
      for (int i = 0; i < 8; ++i) { const f32x2 y = hy_out(Z, TW, 8 * tid + i); oa[i] = xa[i] * (y.x + va[i] * sk); ob[i] = xb[i] * (y.y + vb[i] * sk); }
      u32x4 wa, wb; wa.x = pk2(oa[0], oa[1]); wa.y = pk2(oa[2], oa[3]); wa.z = pk2(oa[4], oa[5]); wa.w = pk2(oa[6], oa[7]); wb.x = pk2(ob[0], ob[1]); wb.y = pk2(ob[2], ob[3]); wb.z = pk2(ob[4], ob[5]); wb.w = pk2(ob[6], ob[7]);
      *(u32x4*)(YT + ((size_t)(b0 * 256 + c)) * 4096 + 8 * tid) = wa; *(u32x4*)(YT + ((size_t)(b1 * 256 + c)) * 4096 + 8 * tid) = wb; }
    __syncthreads();
}
__device__ __forceinline__ void spectrum_item(const Args& a, LAS unsigned char* lds, int item, int tid) {
    asm volatile("" : "+v"(tid));
    LAS f32x2* Z = (LAS f32x2*)lds; const LAS f32x2* TW = (const LAS f32x2*)(lds + 69632);
    const int c = item & 255, lo = item >> 8;
    const float* HC = (const float*)(a.ws + WS_HC) + ((size_t)lo * 256 + c) * 8192;
    { const f32x4 hl0 = *(const f32x4*)(HC + 4095 + 8 * tid), hl1 = *(const f32x4*)(HC + 4095 + 8 * tid + 4);
      float hlv[8] = {hl0[0], hl0[1], hl0[2], hl0[3], hl1[0], hl1[1], hl1[2], hl1[3]}; float hhv[8];
#pragma unroll
      for (int i = 0; i < 8; ++i) { const int t = 8 * tid + i; hhv[i] = (t == 0) ? 0.f : HC[t - 1]; }
#pragma unroll
      for (int i = 0; i < 8; ++i) { const int t = 8 * tid + i; const float hl = hlv[i], hh = hhv[i];
        Z[t + (t >> 4)] = (f32x2){hl + hh, 0.f}; const int t2 = 4096 + t; const f32x2 tw = TW[t]; const float dd = hl - hh; Z[t2 + (t2 >> 4)] = (f32x2){dd * tw.x, dd * tw.y}; } }
    __syncthreads();
    fft_pass<1, 0>(Z, TW, tid, nullptr); fft_pass<16, 0>(Z, TW, tid, nullptr); fft_pass<256, 0>(Z, TW, tid, nullptr);
    f32x2* HS = (f32x2*)(a.ws + WS_HS) + (size_t)item * 8192;
#pragma unroll
    for (int i = 0; i < 16; ++i) { const int idx = tid + 512 * i; HS[idx] = Z[idx + (idx >> 4)] * (1.0f / 8192.0f); }
    __syncthreads();
}
__device__ __forceinline__ void load_tw(const Args& a, LAS unsigned char* lds, int tid) {
    asm volatile("" : "+v"(tid));
    LAS f32x2* TW = (LAS f32x2*)(lds + 69632); const f32x2* src = (const f32x2*)(a.ws + WS_TW8);
    for (int i = tid; i < 4096; i += NTHR) { TW[i] = src[i]; const int r = i >> 8, k = i & 255; TW[4096 + i] = src[r * k * 2]; }
    if (tid < 256) { const int r = tid >> 4, k = tid & 15; TW[8192 + tid] = src[r * k * 32]; }
    __syncthreads();
}
__device__ __forceinline__ float ctx_uc(const bf16_t* PXc, const float* cw, const float* cb, int ch, int t) {
    const float u1 = bf2f(PXc[(size_t)t * INW + ch]); const float u0 = (t > 0) ? bf2f(PXc[(size_t)(t - 1) * INW + ch]) : 0.f; const float u2 = (t < 255) ? bf2f(PXc[(size_t)(t + 1) * INW + ch]) : 0.f;
    return u0 * cw[ch] + u1 * cw[768 + ch] + u2 * cw[1536 + ch] + cb[ch];
}
__device__ __forceinline__ void ctx_conv16(const LAS float* IN, const float* H, int c, int lane, int t0, float (&acc)[16]) {
    float w[16];
    const float* hp = H + (size_t)(t0 + 255) * 256 + c;
#pragma unroll
    for (int i = 0; i < 16; ++i) { acc[i] = 0.f; w[i] = hp[i * 256]; }
    const LAS float* ip = IN + lane;
#pragma unroll 1
    for (int s0 = 0; s0 < 256; s0 += 16) {
#pragma unroll
        for (int u = 0; u < 16; ++u) { const float v = ip[u * 64];
#pragma unroll
            for (int i = 0; i < 16; ++i) acc[i] += v * w[(i - u + 16) & 15];
            w[(15 - u) & 15] = hp[-(u + 1) * 256]; }
        hp -= 16 * 256; ip += 16 * 64; }
}
__device__ __forceinline__ void ctx_hyena_item(const Args& a, LAS unsigned char* lds, int l, int item, int tid) {
    asm volatile("" : "+v"(tid));
    const int lane = tid & 63, wave = tid >> 6, b = item >> 2, c = (item & 3) * 64 + lane;
    LAS float* V = (LAS float*)lds; LAS float* Z1 = (LAS float*)(lds + 65536);
    const bf16_t* PXc = (const bf16_t*)(a.ws + WS_PX) + (size_t)(TX + b * 256) * INW; bf16_t* Y = (bf16_t*)(a.ws + WS_Y) + (size_t)(TX + b * 256) * D;
    const float* cw = a.in[I_HCW] + (size_t)l * 3 * 768; const float* cb = a.in[I_HCB] + (size_t)l * 768; const float* skip = a.in[I_HSKIP] + (size_t)l * 2 * 256;
    const float* H0 = (const float*)(a.ws + WS_HCC) + 256, *H1 = H0 + (size_t)511 * 256;
#pragma unroll 2
    for (int i = 0; i < 32; ++i) { const int t = wave * 32 + i; V[t * 64 + lane] = ctx_uc(PXc, cw, cb, c, t); }
    __syncthreads();
    float acc[16];
#pragma unroll 1
    for (int g = 0; g < 2; ++g) { const int t0 = wave * 32 + g * 16; ctx_conv16(V, H0, c, lane, t0, acc); const float sk = skip[c];
#pragma unroll
        for (int i = 0; i < 16; ++i) { const int t = t0 + i; Z1[t * 64 + lane] = ctx_uc(PXc, cw, cb, 256 + c, t) * (acc[i] + V[t * 64 + lane] * sk); } }
    __syncthreads();
#pragma unroll 1
    for (int g = 0; g < 2; ++g) { const int t0 = wave * 32 + g * 16; ctx_conv16(Z1, H1, c, lane, t0, acc); const float sk = skip[256 + c];
#pragma unroll
        for (int i = 0; i < 16; ++i) { const int t = t0 + i; Y[(size_t)t * D + c] = (bf16_t)f2bf(ctx_uc(PXc, cw, cb, 512 + c, t) * (acc[i] + Z1[t * 64 + lane] * sk)); } }
    __syncthreads();
}

__device__ __forceinline__ void ytr_item(const Args& a, LAS unsigned char* tile, int item, int lane) {
    const int b = item >> 8, tt = (item >> 2) & 63, ct = item & 3;
    const bf16_t* src = (const bf16_t*)(a.ws + WS_YT) + ((size_t)(b * 256 + ct * 64)) * 4096 + tt * 64; bf16_t* Y = (bf16_t*)(a.ws + WS_Y) + ((size_t)b * 4096 + tt * 64) * D + ct * 64;
    u32x4 v[8];
#pragma unroll
    for (int i = 0; i < 8; ++i) v[i] = *(const u32x4*)(src + (size_t)((lane >> 3) + 8 * i) * 4096 + (lane & 7) * 8);
#pragma unroll
    for (int i = 0; i < 8; ++i) *(LAS u32x4*)(tile + ((lane >> 3) + 8 * i) * 144 + (lane & 7) * 16) = v[i];
    LDS_WAIT();
    const LAS unsigned short* tp = (const LAS unsigned short*)(tile + lane * 2);
#pragma unroll
    for (int q = 0; q < 8; ++q) { u32x4 o;
        o.x = (unsigned)tp[(8 * q + 0) * 72] | ((unsigned)tp[(8 * q + 1) * 72] << 16); o.y = (unsigned)tp[(8 * q + 2) * 72] | ((unsigned)tp[(8 * q + 3) * 72] << 16);
        o.z = (unsigned)tp[(8 * q + 4) * 72] | ((unsigned)tp[(8 * q + 5) * 72] << 16); o.w = (unsigned)tp[(8 * q + 6) * 72] | ((unsigned)tp[(8 * q + 7) * 72] << 16);
        *(u32x4*)(Y + (size_t)lane * D + 8 * q) = o; }
    LDS_WAIT();
}
__device__ __forceinline__ void event_arrive(unsigned* ctr) {
    asm volatile("s_waitcnt vmcnt(0)" ::: "memory"); __syncthreads();
    if (threadIdx.x == 0) { __builtin_amdgcn_fence(__ATOMIC_RELEASE, "agent"); asm volatile("s_waitcnt vmcnt(0)" ::: "memory"); __hip_atomic_fetch_add(ctr, 1u, __ATOMIC_RELAXED, __HIP_MEMORY_SCOPE_AGENT); }
}
__device__ __forceinline__ void event_wait(unsigned* ctr, unsigned want) {
    if (threadIdx.x == 0) { unsigned sp = 0;
        while (__hip_atomic_load(ctr, __ATOMIC_RELAXED, __HIP_MEMORY_SCOPE_AGENT) < want) { __builtin_amdgcn_s_sleep(2); if (++sp > (1u << 22)) break; }
        __builtin_amdgcn_fence(__ATOMIC_ACQUIRE, "agent"); asm volatile("s_waitcnt vmcnt(0)" ::: "memory"); }
    __syncthreads();
}

typedef short bf16x8_t __attribute__((ext_vector_type(8)));
typedef short s16x4_t __attribute__((ext_vector_type(4)));
typedef float f32x16 __attribute__((ext_vector_type(16)));
__device__ __forceinline__ int crow(int r, int hi) { return (r & 3) + 8 * (r >> 2) + 4 * hi; }
__device__ __forceinline__ unsigned cvtpk(float lo, float hi) { f32x2 v = {lo, hi}; bf16x2_t b = __builtin_convertvector(v, bf16x2_t); return __builtin_bit_cast(unsigned, b); }
__device__ __forceinline__ s16x4_t vtr(const LAS unsigned char* p) { return __builtin_bit_cast(s16x4_t, __builtin_amdgcn_ds_read_tr16_b64_v4i16((LAS s16x4_t*)p)); }
constexpr int AT_K = 0, AT_V = 16384, AT_WSF = 32768, AT_OST = 34816, AT_RPB = 67584, AT_END = 69632;
template <int KIND>
__device__ __forceinline__ void attn_unit(const Args& a, LAS unsigned char* lds, int l, int u, int wave_, CvtStream& cs, int cstride) {
    int lane = (int)__builtin_amdgcn_mbcnt_hi(~0u, __builtin_amdgcn_mbcnt_lo(~0u, 0u)); asm volatile("" : "+v"(lane));
    const int wid = wave_, tid = wave_ * 64 + lane, r32 = lane & 31, hi = lane >> 5;
    const bf16_t* PX = (const bf16_t*)(a.ws + WS_PX); bf16_t* Y = (bf16_t*)(a.ws + WS_Y);
    int b, qcol, kcol, vcol, ycol, qrow0, nloc = 0, lo = 0; bool sink = false; int hsink = 0;
    int qpos0 = 0, blk = 0, rq = 0, cbase = 0, rq4 = 0;
    if (KIND == 0) { b = u >> 6; const int kvh = (u >> 5) & 1; blk = u & 31; const int h = 2 * kvh + (wid >> 2); qpos0 = blk * 128 + 32 * (wid & 3); qrow0 = b * 4096 + qpos0;
        qcol = 1024 + h * 64; kcol = 1536 + kvh * 64; vcol = 1664 + kvh * 64; ycol = 256 + h * 64; lo = (blk == 0) ? 2 : 0; nloc = ((blk == 31) ? 3 : 5) - lo + 1; sink = true; hsink = h; }
    else if (KIND == 1) { b = u >> 6; const int h = (u >> 4) & 3; rq4 = u & 15; rq = 4 * rq4 + (wid >> 1); cbase = 32 * (wid & 1); qrow0 = b * 4096 + rq * 64 + cbase;
        qcol = 1280 + h * 64; kcol = 1792 + h * 64; vcol = 2048 + h * 64; ycol = 768 + h * 64;
        const int ra = 4 * rq4 - 4, rb = 4 * rq4 + 3 - 4; lo = ra < 0 ? 0 : (ra > 56 ? 56 : ra); const int hi_r = (rb < 0 ? 0 : (rb > 56 ? 56 : rb)) + 7; nloc = hi_r - lo + 1;
        LAS float* rpbL = (LAS float*)(lds + AT_RPB); const float* src = a.in[I_RPB] + (size_t)(l * 4 + h) * 465;
        for (int i = tid; i < 465; i += NTHR) rpbL[i] = src[i] * 8.0f; }
    else { b = u >> 3; const int h = (u >> 1) & 3; qrow0 = TX + b * 256 + 32 * wid;
        if ((u & 1) == 0) { qcol = 1024 + h * 64; kcol = 1536 + (h >> 1) * 64; vcol = 1664 + (h >> 1) * 64; ycol = 256 + h * 64; sink = true; hsink = h; }
        else { qcol = 1280 + h * 64; kcol = 1792 + h * 64; vcol = 2048 + h * 64; ycol = 768 + h * 64; } }
    const int NT = nloc + 4;
    bf16x8_t qr[4];
    { const bf16_t* qp = PX + (size_t)(qrow0 + r32) * INW + qcol + hi * 8;
#pragma unroll
      for (int d0 = 0; d0 < 4; ++d0) qr[d0] = *(const bf16x8_t*)(qp + d0 * 16); }
    const int krow = 8 * wid + (lane & 7), kchunk = lane >> 3; const int vrow = 16 * (wid & 3) + (lane >> 2), vcoff = (wid >> 2) * 32 + (lane & 3) * 8;
    const int kdst = AT_K + kchunk * 1024 + krow * 16, vdst = AT_V + wid * 1024 + lane * 16;
    auto tile_row0 = [&](int t) -> int { if (t < nloc) { if (KIND == 0) return b * 4096 + blk * 128 - 128 + 64 * (lo + t); else return b * 4096 + (lo + t) * 64; } return TX + b * 256 + 64 * (t - nloc); };
    u32x4 gk0, gv0, gk1, gv1;
#define AT_LOAD(GK, GV, t_) do { const int R0_ = tile_row0(t_); GK = *(const u32x4*)(PX + (size_t)(R0_ + krow) * INW + kcol + kchunk * 8); GV = *(const u32x4*)(PX + (size_t)(R0_ + vrow) * INW + vcol + vcoff); } while (0)
    AT_LOAD(gk0, gv0, 0);
    if (NT > 1) AT_LOAD(gk1, gv1, 1); else { gk1 = gk0; gv1 = gv0; }
    *(LAS u32x4*)(lds + kdst) = gk0; *(LAS u32x4*)(lds + vdst) = gv0;
    float mhat = -1e30f, l_reg = 0.f; f32x16 o[2];
#pragma unroll
    for (int r = 0; r < 16; ++r) { o[0][r] = 0.f; o[1][r] = 0.f; }
    LAS float* wsf = (LAS float*)(lds + AT_WSF) + wid * 64;
    const LAS unsigned char* vb0 = lds + AT_V + ((lane >> 4) & 1) * 32 + (lane & 3) * 8 + (4 * hi + ((lane & 15) >> 2)) * 64;
    const LAS unsigned char* kb0 = lds + AT_K + hi * 1024 + r32 * 16;
    __syncthreads();
    auto step = [&](int t, u32x4& gkw, u32x4& gvw, u32x4& gkl, u32x4& gvl) __attribute__((always_inline)) {
        const int bufo = (t & 1) * 8192;
        cvt_issue(a, cs, lane);
        if (t + 2 < NT) AT_LOAD(gkl, gvl, t + 2);
        bool need = true; bool full = true; int ts = 0, rk = 0;
        if (t < nloc) {
            if (KIND == 0) { ts = blk * 128 - 128 + 64 * (lo + t); need = (ts + 63 >= qpos0 - 128) && (ts <= qpos0 + 31 + 128); full = (qpos0 + 31 - ts <= 128) && (ts + 63 - qpos0 <= 128); }
            if (KIND == 1) { rk = lo + t; const int r0 = (rq - 4) < 0 ? 0 : ((rq - 4) > 56 ? 56 : (rq - 4)); need = (rk >= r0) && (rk <= r0 + 7); full = false; }
        }
        if (need) {
            f32x16 p0, p1;
#pragma unroll
            for (int r = 0; r < 16; ++r) { p0[r] = 0.f; p1[r] = 0.f; }
            const LAS unsigned char* kb = kb0 + bufo;
#pragma unroll
            for (int d0 = 0; d0 < 4; ++d0) { const bf16x8_t k0 = *(const LAS bf16x8_t*)(kb + d0 * 2048), k1 = *(const LAS bf16x8_t*)(kb + d0 * 2048 + 512);
                p0 = __builtin_amdgcn_mfma_f32_32x32x16_bf16(k0, qr[d0], p0, 0, 0, 0); p1 = __builtin_amdgcn_mfma_f32_32x32x16_bf16(k1, qr[d0], p1, 0, 0, 0); }
            constexpr float C2 = 0.125f * LOG2E;
            if (!full) {
                if (KIND == 0) { const int tq = qpos0 + r32;
#pragma unroll
                    for (int r = 0; r < 16; ++r) { const int k0 = ts + crow(r, hi), d0 = tq - k0, d1 = d0 - 32; p0[r] = (d0 > 128 || d0 < -128) ? -INFINITY : p0[r]; p1[r] = (d1 > 128 || d1 < -128) ? -INFINITY : p1[r]; } }
                if (KIND == 1) { const int c = cbase + r32; const int wsc = (c - 8) < 0 ? 0 : ((c - 8) > 48 ? 48 : (c - 8)); const LAS float* rp = (const LAS float*)(lds + AT_RPB) + (rk - rq + 7) * 31 + 15 - c;
                    { float b0[16];
#pragma unroll
                      for (int r = 0; r < 16; ++r) { const int c0 = crow(r, hi); const int i0 = c0 < wsc ? wsc : (c0 > wsc + 15 ? wsc + 15 : c0); b0[r] = rp[i0]; }
#pragma unroll
                      for (int r = 0; r < 16; ++r) { const int c0 = crow(r, hi); const bool ok0 = (c0 >= wsc) && (c0 < wsc + 16); p0[r] = ok0 ? p0[r] + b0[r] : -INFINITY; } }
                    asm volatile("" : "+v"(p0) :: "memory");
                    { float b1[16];
#pragma unroll
                      for (int r = 0; r < 16; ++r) { const int c1 = crow(r, hi) + 32; const int i1 = c1 < wsc ? wsc : (c1 > wsc + 15 ? wsc + 15 : c1); b1[r] = rp[i1]; }
#pragma unroll
                      for (int r = 0; r < 16; ++r) { const int c1 = crow(r, hi) + 32; const bool ok1 = (c1 >= wsc) && (c1 < wsc + 16); p1[r] = ok1 ? p1[r] + b1[r] : -INFINITY; } } }
            }
            float rm = fmaxf(p0[0], p1[0]);
#pragma unroll
            for (int r = 1; r < 16; ++r) rm = fmaxf(rm, fmaxf(p0[r], p1[r]));
            { auto rr = __builtin_amdgcn_permlane32_swap(__float_as_uint(rm), __float_as_uint(rm), false, false); rm = fmaxf(__uint_as_float(rr[0]), __uint_as_float(rr[1])); }
            const float mnew = fmaxf(mhat, rm); const float f = __builtin_amdgcn_exp2f((mhat - mnew) * C2); const bool grew = mnew > mhat; mhat = mnew;
            const float nm = -mnew * C2; float sacc = 0.f;
#pragma unroll
            for (int r = 0; r < 16; ++r) { p0[r] = __builtin_amdgcn_exp2f(fmaf(p0[r], C2, nm)); p1[r] = __builtin_amdgcn_exp2f(fmaf(p1[r], C2, nm)); sacc += p0[r] + p1[r]; }
            l_reg = l_reg * f + sacc;
            if (__any(grew)) { if (hi == 0) wsf[r32] = f; LDS_WAIT();
#pragma unroll
                for (int r = 0; r < 16; ++r) { const float fr_ = wsf[crow(r, hi)]; o[0][r] *= fr_; o[1][r] *= fr_; }
                LDS_WAIT(); }
            u32x4 pw0, pw1, pw2, pw3;
            pw0 = (u32x4){cvtpk(p0[0], p0[1]), cvtpk(p0[2], p0[3]), cvtpk(p0[4], p0[5]), cvtpk(p0[6], p0[7])}; pw1 = (u32x4){cvtpk(p0[8], p0[9]), cvtpk(p0[10], p0[11]), cvtpk(p0[12], p0[13]), cvtpk(p0[14], p0[15])};
            pw2 = (u32x4){cvtpk(p1[0], p1[1]), cvtpk(p1[2], p1[3]), cvtpk(p1[4], p1[5]), cvtpk(p1[6], p1[7])}; pw3 = (u32x4){cvtpk(p1[8], p1[9]), cvtpk(p1[10], p1[11]), cvtpk(p1[12], p1[13]), cvtpk(p1[14], p1[15])};
            const LAS unsigned char* vb = vb0 + bufo;
#pragma unroll
            for (int d0 = 0; d0 < 2; ++d0) {
#pragma unroll
                for (int ks = 0; ks < 4; ++ks) { const s16x4_t vl = vtr(vb + d0 * 4096 + ks * 1024), vh = vtr(vb + d0 * 4096 + ks * 1024 + 512);
                    const bf16x8_t vf = (bf16x8_t){vl[0], vl[1], vl[2], vl[3], vh[0], vh[1], vh[2], vh[3]};
                    const bf16x8_t pa = __builtin_bit_cast(bf16x8_t, ks == 0 ? pw0 : (ks == 1 ? pw1 : (ks == 2 ? pw2 : pw3)));
                    o[d0] = __builtin_amdgcn_mfma_f32_32x32x16_bf16(pa, vf, o[d0], 0, 0, 0); } }
        }
        cvt_finish(a, cs, (LAS float*)(lds + 73728) + wid * 2112, lane, cstride);
        if (t + 1 < NT) { const int nb = ((t + 1) & 1) * 8192; *(LAS u32x4*)(lds + kdst + nb) = gkw; *(LAS u32x4*)(lds + vdst + nb) = gvw; }
        __syncthreads();
    };
    for (int t = 0; t < NT; t += 2) { step(t, gk1, gv1, gk0, gv0); if (t + 1 < NT) step(t + 1, gk0, gv0, gk1, gv1); }
#undef AT_LOAD
    { auto rr = __builtin_amdgcn_permlane32_swap(__float_as_uint(l_reg), __float_as_uint(l_reg), false, false); l_reg = __uint_as_float(rr[0]) + __uint_as_float(rr[1]); }
    if (sink) l_reg += __builtin_amdgcn_exp2f(a.in[I_SINK][l * 4 + hsink] * LOG2E - mhat * (0.125f * LOG2E));
    if (hi == 0) wsf[32 + r32] = 1.0f / l_reg;
    LDS_WAIT();
    LAS bf16_t* stg = (LAS bf16_t*)(lds + AT_OST) + wid * 2048;
#pragma unroll
    for (int r = 0; r < 16; ++r) { const int orow = crow(r, hi); const float il = wsf[32 + orow];
        stg[orow * 64 + r32] = (bf16_t)f2bf(o[0][r] * il); stg[orow * 64 + 32 + r32] = (bf16_t)f2bf(o[1][r] * il); }
    LDS_WAIT();
#pragma unroll
    for (int i = 0; i < 4; ++i) { const int row = i * 8 + (lane >> 3), ch = lane & 7; const u32x4 v = *(const LAS u32x4*)(stg + row * 64 + ch * 8);
        *(u32x4*)(Y + (size_t)(qrow0 + row) * D + ycol + ch * 8) = v; }
    __syncthreads();
}


template <int HW>
__device__ __forceinline__ void pool_tile(const bf16_t* PX, bf16_t* Y, const float* pscale, int tile, int g, int lane, const bf16x8_t (&wf)[4][2]) {
    const int tk = lane & 15, oc = lane >> 4; const int row = tile * 16 + tk; const bool lat = row < TX; const int tpos = lat ? (row & 4095) : ((row - TX) & 255); const int Ls = lat ? 4096 : 256;
    const bf16_t* pr = PX + (size_t)row * INW + 768 + g * 64 + 8 * oc;
    u32x4 w0[2 * HW], w1[2 * HW];
#pragma unroll
    for (int i = 0; i < 2 * HW; ++i) { const int off = i - HW; const int tp = tpos + off; const bool inr = (tp >= 0) && (tp < Ls); const bf16_t* p = pr + (ptrdiff_t)(inr ? off : 0) * INW; w0[i] = *(const u32x4*)p; w1[i] = *(const u32x4*)(p + 32); }
    float s0[8], s1[8]; int cnt = 0;
#pragma unroll
    for (int j = 0; j < 8; ++j) { s0[j] = 0.f; s1[j] = 0.f; }
#pragma unroll
    for (int i = 0; i < 2 * HW; ++i) { const int tp = tpos + i - HW; const bool in = (tp >= 0) && (tp < Ls); const float m = in ? 1.0f : 0.0f; cnt += in ? 1 : 0;
        s0[0] += m * bflo(w0[i].x); s0[1] += m * bfhi(w0[i].x); s0[2] += m * bflo(w0[i].y); s0[3] += m * bfhi(w0[i].y); s0[4] += m * bflo(w0[i].z); s0[5] += m * bfhi(w0[i].z); s0[6] += m * bflo(w0[i].w); s0[7] += m * bfhi(w0[i].w);
        s1[0] += m * bflo(w1[i].x); s1[1] += m * bfhi(w1[i].x); s1[2] += m * bflo(w1[i].y); s1[3] += m * bfhi(w1[i].y); s1[4] += m * bflo(w1[i].z); s1[5] += m * bfhi(w1[i].z); s1[6] += m * bflo(w1[i].w); s1[7] += m * bfhi(w1[i].w); }
    const float ic = 1.0f / (float)cnt; const u32x4 c0 = w0[HW], c1 = w1[HW];
    const float u0[8] = {bflo(c0.x), bfhi(c0.x), bflo(c0.y), bfhi(c0.y), bflo(c0.z), bfhi(c0.z), bflo(c0.w), bfhi(c0.w)}, u1[8] = {bflo(c1.x), bfhi(c1.x), bflo(c1.y), bfhi(c1.y), bflo(c1.z), bfhi(c1.z), bflo(c1.w), bfhi(c1.w)};
    u32x4 d0, d1;
    d0.x = cvtpk(s0[0] * ic - u0[0], s0[1] * ic - u0[1]); d0.y = cvtpk(s0[2] * ic - u0[2], s0[3] * ic - u0[3]); d0.z = cvtpk(s0[4] * ic - u0[4], s0[5] * ic - u0[5]); d0.w = cvtpk(s0[6] * ic - u0[6], s0[7] * ic - u0[7]);
    d1.x = cvtpk(s1[0] * ic - u1[0], s1[1] * ic - u1[1]); d1.y = cvtpk(s1[2] * ic - u1[2], s1[3] * ic - u1[3]); d1.z = cvtpk(s1[4] * ic - u1[4], s1[5] * ic - u1[5]); d1.w = cvtpk(s1[6] * ic - u1[6], s1[7] * ic - u1[7]);
    const bf16x8_t b0 = __builtin_bit_cast(bf16x8_t, d0), b1 = __builtin_bit_cast(bf16x8_t, d1);
    bf16_t* yr = Y + (size_t)row * D + 512 + g * 64 + 4 * oc;
#pragma unroll
    for (int nt = 0; nt < 4; ++nt) { f32x4 acc = {0.f, 0.f, 0.f, 0.f};
        acc = __builtin_amdgcn_mfma_f32_16x16x32_bf16(wf[nt][0], b0, acc, 0, 0, 0); acc = __builtin_amdgcn_mfma_f32_16x16x32_bf16(wf[nt][1], b1, acc, 0, 0, 0);
        const f32x4 sc = *(const f32x4*)(pscale + g * 64 + 16 * nt + 4 * oc); acc *= sc;
        u32x2 ov; ov.x = cvtpk(acc[0], acc[1]); ov.y = cvtpk(acc[2], acc[3]); *(u32x2*)(yr + 16 * nt) = ov; }
}
__device__ __forceinline__ void phase_mix1(const Args& a, unsigned char* ldsg, int vcu, int G, int l) {
    LAS unsigned char* lds = (LAS unsigned char*)ldsg;
    int tid_ = threadIdx.x; asm volatile("" : "+v"(tid_));
    const int tid = tid_, lane = tid & 63, wave = __builtin_amdgcn_readfirstlane(tid >> 6);
    unsigned char* ws = a.ws; asm volatile("" : "+s"(ws)); const bf16_t* PX = (const bf16_t*)(ws + WS_PX); bf16_t* Y = (bf16_t*)(ws + WS_Y);
    const bool upd = (l == 0); const int nrows = upd ? TT : TX;
    const int gw = vcu * NWAVES + wave, NGW = G * NWAVES;
    { AMP_BEGIN(31) load_tw(a, lds, tid);
    for (int it = vcu; it < 1024; it += G) hyena_item(a, lds, l, it >> 2, it & 3, tid);
    if (upd) for (int it = vcu; it < 32; it += G) ctx_hyena_item(a, lds, l, it, tid);
    event_arrive((unsigned*)(ws + WS_CTL) + 8192 + 64 * l); AMP_END(31) }
    { AMP_BEGIN(32)
    { const int g = gw & 3; const float* pwg = a.in[I_POOLW] + (size_t)(l * 4 + g) * 4096; const float* pscale = a.in[I_POOLS] + (size_t)l * 256;
      bf16x8_t wf[4][2];
#pragma unroll
      for (int nt = 0; nt < 4; ++nt)
#pragma unroll
          for (int ks = 0; ks < 2; ++ks) { const float* wp = pwg + (size_t)(32 * ks + 8 * (lane >> 4)) * 64 + 16 * nt + (lane & 15); u32x4 w;
              w.x = cvtpk(wp[0], wp[64]); w.y = cvtpk(wp[128], wp[192]); w.z = cvtpk(wp[256], wp[320]); w.w = cvtpk(wp[384], wp[448]); wf[nt][ks] = __builtin_bit_cast(bf16x8_t, w); }
      const int ntiles = nrows / 16;
      for (int it = gw; it < ntiles * 4; it += NGW) { const int tile = it >> 2;
          if (g == 0) pool_tile<1>(PX, Y, pscale, tile, g, lane, wf); else if (g == 1) pool_tile<2>(PX, Y, pscale, tile, g, lane, wf); else if (g == 2) pool_tile<4>(PX, Y, pscale, tile, g, lane, wf); else pool_tile<8>(PX, Y, pscale, tile, g, lane, wf); } }
    __syncthreads(); AMP_END(32) }
    { AMP_BEGIN(33)
    CvtStream cs; cs.it = upd ? gw : CVT_ITEMS; cs.end = CVT_ITEMS; cs.live = 0;
    for (int u = vcu; u < 512; u += G) attn_unit<0>(a, lds, l, u, wave, cs, NGW);
    for (int u = vcu; u < 512; u += G) attn_unit<1>(a, lds, l, u, wave, cs, NGW);
    if (upd) for (int u = vcu; u < 64; u += G) attn_unit<2>(a, lds, l, u, wave, cs, NGW);
    int lane2 = (int)__builtin_amdgcn_mbcnt_hi(~0u, __builtin_amdgcn_mbcnt_lo(~0u, 0u)); asm volatile("" : "+v"(lane2));
    while (cs.it < cs.end) { cvt_issue(a, cs, lane2); cvt_finish(a, cs, (LAS float*)(lds + 73728) + wave * 2112, lane2, NGW); }
    AMP_END(33) }
    { AMP_BEGIN(34) event_wait((unsigned*)(ws + WS_CTL) + 8192 + 64 * l, (unsigned)G);
      int lane3 = (int)__builtin_amdgcn_mbcnt_hi(~0u, __builtin_amdgcn_mbcnt_lo(~0u, 0u)); asm volatile("" : "+v"(lane3));
      for (int it = gw; it < 2048; it += NGW) ytr_item(a, lds + wave * 9216, it, lane3); AMP_END(34) }
}

__device__ __forceinline__ void phase_select(const Args& a, unsigned char* ldsg, int vcu, int G, bool with_ctx) {
    LAS unsigned* keys = (LAS unsigned*)(LAS unsigned char*)ldsg;
    LAS unsigned* hist = keys + 4096;
    LAS unsigned* ctl = hist + 256 + 64;
    int tid_ = threadIdx.x; asm volatile("" : "+v"(tid_));
    const int tid = tid_, lane = tid & 63; unsigned char* ws = a.ws; asm volatile("" : "+s"(ws));
    const float* AFFT = (const float*)(ws + WS_AFFT); int* ROWMAP = (int*)(ws + WS_ROWMAP); float* GATE = (float*)(ws + WS_GATE); int* INV = (int*)(ws + WS_INV);
    const int nitems = 128 + (with_ctx ? 128 : 0);
    for (int item = vcu; item < nitems; item += G) {
        int e, base, Ls, cap, slot0;
        if (item < 128) { const int b = item >> 4; e = item & 15; base = b * 4096; Ls = 4096; cap = CAPX; slot0 = b * CAPX; }
        else { const int it = item - 128; const int b = it >> 4; e = it & 15; base = TX + b * 256; Ls = 256; cap = CAPC; slot0 = NB * CAPX + b * CAPC; }
        unsigned k[8];
#pragma unroll
        for (int i = 0; i < 8; ++i) { const int idx = tid + NTHR * i; k[i] = (idx < Ls) ? __float_as_uint(AFFT[(size_t)e * TT + base + idx]) : 0u; if (idx < Ls) keys[idx] = k[i]; }
        if (tid == 0) { ctl[0] = 0u; ctl[1] = (unsigned)cap; ctl[2] = 0u; ctl[3] = 0u; }
        unsigned prefix = 0u;
#pragma unroll 1
        for (int p = 0; p < 4; ++p) { const int shift = 24 - 8 * p;
            if (tid < 256) hist[tid] = 0u;
            __syncthreads();
#pragma unroll
            for (int i = 0; i < 8; ++i) { const int idx = tid + NTHR * i; const bool cand = (idx < Ls) && (p == 0 || (k[i] >> (shift + 8)) == prefix);
                if (cand) atomicAdd((unsigned*)&hist[(k[i] >> shift) & 255u], 1u); }
            __syncthreads();
            if (tid < 64) {
                const unsigned need = ctl[1];
                const unsigned c0 = hist[255 - 4 * lane], c1 = hist[254 - 4 * lane], c2 = hist[253 - 4 * lane], c3 = hist[252 - 4 * lane];
                const unsigned s = c0 + c1 + c2 + c3;
                hist[256 + lane] = s; LDS_WAIT();
                unsigned inc = 0u;
                for (int q = 0; q < 64; ++q) { const unsigned v = hist[256 + q]; inc += (q <= lane) ? v : 0u; }
                const unsigned exc = inc - s;
                if (exc < need && inc >= need) { unsigned above = exc; int d;
                    if (above + c0 >= need) d = 255 - 4 * lane; else { above += c0; if (above + c1 >= need) d = 254 - 4 * lane; else { above += c1; if (above + c2 >= need) d = 253 - 4 * lane; else { above += c2; d = 252 - 4 * lane; } } }
                    ctl[0] = (prefix << 8) | (unsigned)d; ctl[1] = need - above; } }
            __syncthreads();
            prefix = ctl[0]; }
        const unsigned T = prefix; const unsigned need = ctl[1];
        int eqc = 0;
#pragma unroll
        for (int i = 0; i < 8; ++i) { const int idx = tid + NTHR * i; eqc += ((idx < Ls) && k[i] == T) ? 1 : 0; }
        if (eqc) atomicAdd((unsigned*)&ctl[3], (unsigned)eqc);
        __syncthreads();
        const bool all_eq = (ctl[3] == need);
#pragma unroll
        for (int i = 0; i < 8; ++i) { const int idx = tid + NTHR * i;
            if (idx < Ls && (k[i] > T || (all_eq && k[i] == T))) { const int s = (int)atomicAdd((unsigned*)&ctl[2], 1u); const int slot = e * SLOTS + slot0 + s;
                ROWMAP[slot] = base + idx; GATE[slot] = __uint_as_float(k[i]); INV[(size_t)(base + idx) * 16 + e] = slot; } }
        __syncthreads();
        if (!all_eq && tid == 0) {
            int s = (int)ctl[2]; unsigned left = need;
            for (int idx = 0; idx < Ls && left; ++idx) if (keys[idx] == T) { const int slot = e * SLOTS + slot0 + s; ROWMAP[slot] = base + idx; GATE[slot] = __uint_as_float(T); INV[(size_t)(base + idx) * 16 + e] = slot; ++s; --left; } }
        __syncthreads();
    }
}
__device__ __forceinline__ void phase_combine(const Args& a, int vcu, int G, int l, bool with_ctx, bool final_norm, bool next_norm) {
    int tid_ = threadIdx.x; asm volatile("" : "+v"(tid_));
    const int tid = tid_, lane = tid & 63, wave = __builtin_amdgcn_readfirstlane(tid >> 6); unsigned char* ws = a.ws; asm volatile("" : "+s"(ws));
    const int* INV = (const int*)(ws + WS_INV); const unsigned char* OB = (const unsigned char*)(ws + WS_XG);   const float* MOD = (const float*)(ws + WS_MOD) + (size_t)l * 9 * 6144;
    const float* MODN = (const float*)(ws + WS_MOD) + (size_t)(l + 1) * 9 * 6144; const float* gainn = a.in[I_N1G] + (l + 1) * D; bf16_t* HX = (bf16_t*)(ws + WS_HX);
    bf16_t* XB = (bf16_t*)(ws + WS_XB); const float* fng = a.in[I_FNG];
    const int nrows = with_ctx ? TT : TX; const int gw = vcu * NWAVES + wave, NGW = G * NWAVES;
    const float pz = (final_norm && __hip_atomic_load((unsigned*)(ws + WS_CTL) + 12288, __ATOMIC_RELAXED, __HIP_MEMORY_SCOPE_AGENT) != 0u) ? __builtin_nanf("") : 0.f;
    int ninv[2]; u32x2 nx[2][4];
#define CMB_PRELOAD(ra) do { _Pragma("unroll") for (int u = 0; u < 2; ++u) { const int row_ = (ra) + u * NGW; const bool ok_ = row_ < nrows; const int rr_ = ok_ ? row_ : gw; \
            ninv[u] = (lane < 16 && ok_) ? INV[(size_t)rr_ * 16 + lane] : -1; const bf16_t* xr_ = XB + (size_t)rr_ * D; \
            _Pragma("unroll") for (int j = 0; j < 4; ++j) nx[u][j] = *(const u32x2*)(xr_ + 256 * j + 4 * lane); } } while (0)
    CMB_PRELOAD(gw);
    for (int rowa = gw; rowa < nrows; rowa += 2 * NGW) {
        int myinv[2]; f32x4 xv[2][4]; f32x4 acc[2][4];
#pragma unroll
        for (int u = 0; u < 2; ++u) { myinv[u] = ninv[u];
#pragma unroll
            for (int j = 0; j < 4; ++j) { const u32x2 w = nx[u][j]; xv[u][j] = (f32x4){bflo(w.x), bfhi(w.x), bflo(w.y), bfhi(w.y)}; acc[u][j] = (f32x4){0.f, 0.f, 0.f, 0.f}; } }
        if (rowa + 2 * NGW < nrows) CMB_PRELOAD(rowa + 2 * NGW);
#pragma unroll
        for (int u = 0; u < 2; ++u) {
            unsigned long long mask = __ballot(myinv[u] >= 0) & 0xffffull;
            while (mask) { int sl[4];
#pragma unroll
                for (int q = 0; q < 4; ++q) { if (mask) { const int e = __builtin_ctzll(mask); mask &= mask - 1; sl[q] = __builtin_amdgcn_readlane(myinv[u], e); } else sl[q] = -1; }
                int w[4][4];
#pragma unroll
                for (int q = 0; q < 4; ++q) { const unsigned char* orow = OB + (size_t)(sl[q] >= 0 ? sl[q] : 0) * D;
#pragma unroll
                    for (int j = 0; j < 4; ++j) w[q][j] = *(const int*)(orow + 256 * j + 4 * lane); }
#pragma unroll
                for (int q = 0; q < 4; ++q) { const float m = (sl[q] >= 0) ? 1.0f : 0.0f;
#pragma unroll
                    for (int j = 0; j < 4; ++j) { acc[u][j][0] += m * __builtin_amdgcn_cvt_f32_fp8(w[q][j], 0); acc[u][j][1] += m * __builtin_amdgcn_cvt_f32_fp8(w[q][j], 1); acc[u][j][2] += m * __builtin_amdgcn_cvt_f32_fp8(w[q][j], 2); acc[u][j][3] += m * __builtin_amdgcn_cvt_f32_fp8(w[q][j], 3); } } } }
#pragma unroll
        for (int u = 0; u < 2; ++u) { const int row = rowa + u * NGW; if (row < nrows) {
            const bool lat = row < TX; float* xr = a.out + (size_t)row * D; bf16_t* xbr = XB + (size_t)row * D; const int mrow = lat ? (row >> 12) : 8;
            const float* gp = MOD + mrow * 6144 + 5 * 1024; f32x4 v[4]; float ss = 0.f;
#pragma unroll
            for (int j = 0; j < 4; ++j) { const f32x4 g = *(const f32x4*)(gp + 256 * j + 4 * lane); v[j] = xv[u][j] + g * acc[u][j];
                ss += (v[j][0] * v[j][0] + v[j][1] * v[j][1]) + (v[j][2] * v[j][2] + v[j][3] * v[j][3]); }
            if (final_norm) { const float rstd = 1.0f / sqrtf(wave_sum(ss) * (1.0f / D) + 1e-6f);
#pragma unroll
                for (int j = 0; j < 4; ++j) { const f32x4 g = *(const f32x4*)(fng + 256 * j + 4 * lane); *(f32x4*)(xr + 256 * j + 4 * lane) = v[j] * rstd * g + pz; } }
            else {
#pragma unroll
                for (int j = 0; j < 4; ++j) { u32x2 o; o.x = pk2(v[j][0], v[j][1]); o.y = pk2(v[j][2], v[j][3]); *(u32x2*)(xbr + 256 * j + 4 * lane) = o; }
                if (next_norm) { const float rstd = 1.0f / sqrtf(wave_sum(ss) * (1.0f / D) + 1e-6f); const float* shp = MODN + mrow * 6144; const float* scp = shp + 1024;
#pragma unroll
                    for (int j = 0; j < 4; ++j) { const f32x4 gg = *(const f32x4*)(gainn + 256 * j + 4 * lane), sh = *(const f32x4*)(shp + 256 * j + 4 * lane), sc = *(const f32x4*)(scp + 256 * j + 4 * lane);
                        const f32x4 hv = (v[j] * rstd * gg) * (1.0f + sc) + sh; u32x2 o; o.x = pk2(hv[0], hv[1]); o.y = pk2(hv[2], hv[3]); *(u32x2*)(HX + (size_t)row * D + 256 * j + 4 * lane) = o; } } } } }
    }
}
#undef CMB_PRELOAD

#define XBAR() do { XcdBarrier b_; b_.bar = (unsigned*)(a.ws + WS_CTL); b_.x = __builtin_amdgcn_readfirstlane(bar.x); b_.st = (volatile LAS unsigned*)((LAS unsigned char*)lds + LDS_BYTES - 16); xcd_barrier(b_); if (AMP_PHASE == 99) xcd_barrier(b_); } while (0)

__global__ void __launch_bounds__(NTHR, 2) fwd_kernel(Args a) {
    extern __shared__ __attribute__((aligned(16))) unsigned char lds[];
    cg::grid_group grid = cg::this_grid();
    const int G = gridDim.x, bx = blockIdx.x; const int vcu = (G % 8 == 0) ? (bx % 8) * (G / 8) + bx / 8 : bx;
    unsigned char* ws = a.ws;
    PG8_LAS unsigned char* glds = (PG8_LAS unsigned char*)lds;
    volatile LAS unsigned* bst = (volatile LAS unsigned*)((LAS unsigned char*)lds + LDS_BYTES - 16);
    if (threadIdx.x < 4) bst[threadIdx.x] = 0u;
    __syncthreads();
    XcdBarrier bar = xcd_barrier_post((unsigned*)(ws + WS_CTL), bst);
    { AMP_BEGIN(0) phase_prologue(a, lds, vcu, G); AMP_END(0) }
    if (a.ws == nullptr) grid.sync();
    XBAR();
    for (int l = 0; l < 2; ++l) {
        const bool upd = (l == 0);
        asm volatile("" : "+s"(ws));
        const float* srcx = a.in[I_X]; const float* srcc = a.in[I_CTX];
        if (upd) {
            { AMP_BEGIN(1) phase_norm(a, lds, vcu, G, l, srcx, srcc, nullptr, a.in[I_N1G] + l * D, 0, TT, false); AMP_END(1) }
            { AMP_BEGIN(11) load_tw(a, (LAS unsigned char*)lds, threadIdx.x); for (int it = vcu; it < 1024; it += G) spectrum_item(a, (LAS unsigned char*)lds, it, threadIdx.x); AMP_END(11) }
            XBAR();
        }
        { AMP_BEGIN(2) pg8::Gemm g{(const pg8::bf16_t*)(ws + WS_HX), (const pg8::bf16_t*)(ws + WS_WIN_T) + (size_t)l * INW * D, TT, INW, D};
          pg8::GroupOrder S; S.init(1, TT / 256, INW / 256, 0, G, bx);
          { PG8_LAS float* rl = (PG8_LAS float*)(glds + 131072 + 20480); const float* rs = (const float*)(ws + WS_ROPE); int tx = threadIdx.x; asm volatile("" : "+v"(tx)); for (int i = tx; i < 2048; i += NTHR) rl[i] = rs[i]; __syncthreads(); }
          pg8::EpiIn E{(pg8::bf16_t*)(ws + WS_PX), (const PG8_LAS float*)(glds + 131072 + 20480), (pg8::bf16_t*)(ws + WS_UT), glds + 131072, 1.0f};
          pg8::gemm_phase<pg8::EpiIn, pg8::GroupOrder, true, true>(glds, g, S, E); AMP_END(2) }
        XBAR();
        { AMP_BEGIN(3) phase_mix1(a, lds, vcu, G, l); AMP_END(3) }
        XBAR();
        { AMP_BEGIN(4) pg8::Gemm g{(const pg8::bf16_t*)(ws + WS_Y), (const pg8::bf16_t*)(ws + WS_WOUT_T) + (size_t)l * D * D, TT, D, D};
          pg8::GroupOrder S; S.init(1, (upd ? TT : TX) / 256, D / 256, 0, G, bx);
          pg8::EpiOut E{a.in[I_X], a.in[I_CTX], (pg8::bf16_t*)(ws + WS_XB), (const float*)(ws + WS_MOD) + (size_t)l * 9 * 6144, upd ? 1 : 0};
          pg8::gemm_phase<pg8::EpiOut, pg8::GroupOrder, true, true>(glds, g, S, E); AMP_END(4) }
        XBAR();
        { AMP_BEGIN(5) phase_norm_router(a, lds, vcu, G, l, (const bf16_t*)(ws + WS_XB), a.in[I_N2G] + l * D, upd ? TT : TX); AMP_END(5) }
        XBAR();
        { AMP_BEGIN(6) phase_select(a, lds, vcu, G, upd); AMP_END(6) }
        XBAR();
        { AMP_BEGIN(8) pg8::Gemm g{(const pg8::bf16_t*)(ws + WS_HX), (const pg8::bf16_t*)(ws + WS_WGU_T + (size_t)l * NE * 4096 * D), NE * SLOTS, NE * 4096, D};
          pg8::GroupOrder S; S.init(NE, upd ? 17 : 16, 16, 17, G, bx);
          { PG8_LAS float* sl = (PG8_LAS float*)(glds + 131072 + 17408); const float* ss = (const float*)(ws + WS_WSC) + l * 48; int tx = threadIdx.x; asm volatile("" : "+v"(tx)); if (tx < 32) sl[tx] = ss[tx]; __syncthreads(); }
          pg8::EpiGU E{(unsigned char*)(ws + WS_ACT), (const PG8_LAS float*)(glds + 131072 + 17408)};
          pg8::gemm_phase_gather<pg8::EpiGU, pg8::GroupOrder, true>(glds, g, (const int*)(ws + WS_ROWMAP), (PG8_LAS int*)(glds + 131072), S, E); AMP_END(8) }
        XBAR();
        { AMP_BEGIN(9) pg8::Gemm g{(const pg8::bf16_t*)(ws + WS_ACT), (const pg8::bf16_t*)(ws + WS_WD_T + (size_t)l * NE * D * FF), NE * SLOTS, NE * D, FF};
          pg8::GroupOrder S; S.init(NE, upd ? 17 : 16, 4, 17, G, bx);
          { PG8_LAS float* gl = (PG8_LAS float*)(glds + 131072); const float* gs = (const float*)(ws + WS_GATE); const float* ss = (const float*)(ws + WS_WSC) + l * 48 + 32; pg8::Unit uu; int tx = threadIdx.x; asm volatile("" : "+v"(tx));
            for (int i = 0; S.next(i, uu); ++i) if (tx < 256) gl[i * 256 + tx] = gs[uu.pm * 256 + tx] * ss[uu.pn >> 2];
            __syncthreads(); }
          pg8::EpiDown E{(unsigned char*)(ws + WS_XG), (const PG8_LAS float*)(glds + 131072)};
          pg8::gemm_phase<pg8::EpiDown, pg8::GroupOrder, true, true, true>(glds, g, S, E); AMP_END(9) }
        XBAR();
        { AMP_BEGIN(10) phase_combine(a, vcu, G, l, upd, !upd, upd); AMP_END(10) }
        if (upd) XBAR();
    }
}

extern "C" void kernel_launch(void* const* d_in, const int* in_sizes, int n_in, void* d_out, int out_size, void* d_ws, size_t ws_size, hipStream_t stream) {
    static int grid = 0;
    if (grid == 0) {
        int dev = 0, cus = 0, per_cu = 0;
        hipGetDevice(&dev); hipDeviceGetAttribute(&cus, hipDeviceAttributeMultiprocessorCount, dev);
        if (hipFuncSetAttribute((const void*)fwd_kernel, hipFuncAttributeMaxDynamicSharedMemorySize, LDS_BYTES) != hipSuccess) { fprintf(stderr, "kernel_launch: hipFuncSetAttribute failed\n"); grid = -1; return; }
        if (hipOccupancyMaxActiveBlocksPerMultiprocessor(&per_cu, (const void*)fwd_kernel, NTHR, LDS_BYTES) != hipSuccess || per_cu < 1) { fprintf(stderr, "kernel_launch: occupancy query failed (%d)\n", per_cu); grid = -1; return; }
        grid = cus * 1;
        if (n_in != N_IN || ws_size < WS_END) { fprintf(stderr, "kernel_launch: unexpected n_in %d / ws %zu\n", n_in, ws_size); grid = -1; return; }
    }
    if (grid < 0) return;
    if (hipMemsetAsync((char*)d_ws + WS_CTL, 0, 65536, stream) != hipSuccess) { fprintf(stderr, "kernel_launch: memset failed\n"); return; }
    Args a{};
    for (int i = 0; i < N_IN; ++i) a.in[i] = (const float*)d_in[i];
    a.out = (float*)d_out; a.ws = (unsigned char*)d_ws;
    void* args[] = {&a};
    hipError_t e = hipLaunchCooperativeKernel((const void*)fwd_kernel, dim3(grid), dim3(NTHR), args, LDS_BYTES, stream);
    if (e != hipSuccess) fprintf(stderr, "cooperative launch failed: %s (grid %d)\n", hipGetErrorString(e), grid);
}
```

```cpp
#define AMP_PHASE -1
#include <hip/hip_runtime.h>
#include <hip/hip_cooperative_groups.h>
#include <cstdio>
#include <cstdint>
#ifndef AMP_PHASE
#define AMP_PHASE -1
#endif
namespace cg = cooperative_groups;
namespace pg8 {
#define PG8_LAS __attribute__((address_space(3)))
typedef unsigned short bf16_t;
typedef short bf16x8 __attribute__((ext_vector_type(8)));
typedef float f32x4 __attribute__((ext_vector_type(4)));
typedef unsigned u32x4 __attribute__((ext_vector_type(4)));
typedef int v4i_t __attribute__((ext_vector_type(4)));
typedef int v8i_t __attribute__((ext_vector_type(8)));
constexpr int BM = 256, BK = 64, HALF = 128, HTB = HALF * BK * 2  , STAGE_BYTES = 8 * HTB, NXCD = 8, WGM = 8;

__host__ __device__ __forceinline__ int lds_byte(int r, int c) { const int st = (r >> 4) * 2 + (c >> 5), rr = r & 15, cc = c & 31, ob = rr * 64 + cc * 2; return st * 1024 + (ob ^ (((ob >> 9) & 1) << 5)); }
__host__ __device__ __forceinline__ void stage_rc(int b, int& R, int& C) { const int st = b / 1024, sb = b % 1024, swz = sb ^ (((sb >> 9) & 1) << 5); R = (st >> 1) * 16 + swz / 64; C = (st & 1) * 32 + (swz % 64) / 2; }
__host__ __device__ __forceinline__ int perm32(int rho) { const int n = rho >> 4, i = rho & 15; return 8 * (i >> 2) + 4 * n + (i & 3); }

struct Unit { int pm, pn; };
struct Gemm { const bf16_t* A; const bf16_t* Bt; int M, N, K; };

struct StaticOrder {
    int nM, nN, nwg, G, c;
    __host__ __device__ void init(int M, int N, int G_, int c_) { nM = M / BM; nN = N / BM; nwg = nM * nN; G = G_; c = c_; }
    __host__ __device__ bool next(int i, Unit& u) const {
        const long L = (long)i * G + c; if (L >= nwg) return false;
        int wgid = (int)L; { const int q = nwg / NXCD, r = nwg % NXCD, xcd = wgid % NXCD, off = wgid / NXCD; wgid = (xcd < r ? xcd * (q + 1) : r * (q + 1) + (xcd - r) * q) + off; }
        const int nig = WGM * nN, gid = wgid / nig, fm = gid * WGM, gsz = (nM - fm) < WGM ? (nM - fm) : WGM;
        u.pm = fm + ((wgid % nig) % gsz); u.pn = (wgid % nig) / gsz; return true;
    }
    __device__ __forceinline__ void a_ready(const Unit&) const {}
    __device__ __forceinline__ void done(const Unit&) const {}
};

__device__ __forceinline__ unsigned cvt_pk_bf16(float lo, float hi) { unsigned r; asm volatile("v_cvt_pk_bf16_f32 %0, %1, %2" : "=v"(r) : "v"(lo), "v"(hi)); return r; }
typedef float f32x2 __attribute__((ext_vector_type(2)));
__device__ __forceinline__ f32x2 gelu_pk(f32x2 v) {
    const f32x2 av = __builtin_elementwise_abs(v), d = av * 0.2316418882f + 1.0f;
    f32x2 t; t.x = __builtin_amdgcn_rcpf(d.x); t.y = __builtin_amdgcn_rcpf(d.y);
    f32x2 q = t * 0.5307027145f + (-0.7265760135f); q = q * t + 0.7107068705f; q = q * t + (-0.142248368f); q = q * t + 0.127414796f; q = q * t;
    const f32x2 s = (v * v) * (-0.72134752044f);
    f32x2 e; e.x = __builtin_amdgcn_exp2f(s.x); e.y = __builtin_amdgcn_exp2f(s.y);
    const f32x2 m = v * (q * e), r = v - m;
    f32x2 o; o.x = v.x < 0.f ? m.x : r.x; o.y = v.y < 0.f ? m.y : r.y; return o;
}


struct GroupOrder {
    int nMl, nNl, strideM, nper, nwg, G, c;
    __device__ __forceinline__ void init(int ng, int nMl_, int nNl_, int strideM_, int G_, int c_) { nMl = nMl_; nNl = nNl_; strideM = strideM_; nper = nMl_ * nNl_; nwg = ng * nper; G = G_; c = c_; }
    __device__ __forceinline__ bool next(int i, Unit& u) const {
        const long L = (long)i * G + c; if (L >= nwg) return false;
        int wgid = (int)L; { const int q = nwg / NXCD, r = nwg % NXCD, xcd = wgid % NXCD, off = wgid / NXCD; wgid = (xcd < r ? xcd * (q + 1) : r * (q + 1) + (xcd - r) * q) + off; }
        const int e = wgid / nper, id = wgid % nper;
        const int nig = WGM * nNl, gid = id / nig, fm = gid * WGM, gsz = (nMl - fm) < WGM ? (nMl - fm) : WGM;
        u.pm = e * strideM + fm + ((id % nig) % gsz); u.pn = e * nNl + (id % nig) / gsz; return true;
    }
    __device__ __forceinline__ void a_ready(const Unit&) const {}
    __device__ __forceinline__ void done(const Unit&) const {}
};

constexpr int TXR = 32768;
struct EpiIn {
    static constexpr bool PERM = true, AFTER_DRAIN = false;
    bf16_t* PX; const PG8_LAS float* rope; bf16_t* UT; PG8_LAS unsigned char* stgbase; float wsc;
    __device__ __forceinline__ void operator()(const f32x4 (&acc)[2][2][4][2], const Unit& u, int ui, int wr, int wc, int fr, int fq) const {
        const int row0 = u.pm * BM + wr * 64 + fr; const int col0 = u.pn * BM + wc * 32 + 8 * fq;
        const bool latent = u.pm < (TXR / BM);
        if (latent && u.pn < 3) {
            PG8_LAS unsigned char* stg = stgbase + (wr * 4 + wc) * 2304; const int lane = fq * 16 + fr;
            const int b = u.pm >> 4, trow0 = (u.pm & 15) * BM; const int col = lane >> 1, half = lane & 1;
#pragma unroll
            for (int ai = 0; ai < 2; ++ai)
#pragma unroll
                for (int bj = 0; bj < 2; ++bj)
#pragma unroll
                    for (int mh = 0; mh < 2; ++mh) {
#pragma unroll
                        for (int mm = 0; mm < 2; ++mm)
#pragma unroll
                            for (int n = 0; n < 2; ++n) { const f32x4 v = acc[ai][bj][2 * mh + mm][n] * wsc; const unsigned w0 = cvt_pk_bf16(v[0], v[1]), w1 = cvt_pk_bf16(v[2], v[3]);
                                PG8_LAS unsigned char* p = stg + (8 * fq + 4 * n) * 72 + (16 * mm + fr) * 2;
                                *(PG8_LAS unsigned short*)(p) = (unsigned short)w0; *(PG8_LAS unsigned short*)(p + 72) = (unsigned short)(w0 >> 16);
                                *(PG8_LAS unsigned short*)(p + 144) = (unsigned short)w1; *(PG8_LAS unsigned short*)(p + 216) = (unsigned short)(w1 >> 16); }
                        asm volatile("s_waitcnt lgkmcnt(0)" ::: "memory");
                        typedef unsigned u32x2v __attribute__((ext_vector_type(2)));
                        const PG8_LAS unsigned char* rp = stg + col * 72 + half * 32;
                        const u32x2v a0 = *(const PG8_LAS u32x2v*)(rp), a1 = *(const PG8_LAS u32x2v*)(rp + 8), a2 = *(const PG8_LAS u32x2v*)(rp + 16), a3 = *(const PG8_LAS u32x2v*)(rp + 24);
                        const int ch = u.pn * BM + bj * HALF + wc * 32 + col; const int t0 = trow0 + ai * HALF + wr * 64 + mh * 32 + half * 16;
                        u32x4* gp = (u32x4*)(UT + ((size_t)(b * 768 + ch)) * 4096 + t0);
                        gp[0] = (u32x4){a0.x, a0.y, a1.x, a1.y}; gp[1] = (u32x4){a2.x, a2.y, a3.x, a3.y};
                        asm volatile("s_waitcnt lgkmcnt(0)" ::: "memory"); }
            return;
        }
#pragma unroll
        for (int ai = 0; ai < 2; ++ai)
#pragma unroll
            for (int m = 0; m < 4; ++m) { const int row = row0 + ai * HALF + m * 16; bf16_t* rowp = PX + (size_t)row * 2304 + col0;
#pragma unroll
                for (int bj = 0; bj < 2; ++bj) { f32x4 v0 = acc[ai][bj][m][0] * wsc, v1 = acc[ai][bj][m][1] * wsc;
                    const bool dorope = latent && (u.pn == 4 || (u.pn == 6 && bj == 0));
                    if (dorope) {
                        const int t = row & 4095; const int pos = (wc & 1) ? (t & 63) : (t >> 6);
                        const PG8_LAS f32x4* rp = (const PG8_LAS f32x4*)(rope + (pos * 16 + 8 * (fq & 1)) * 2);
                        const f32x4 r0 = rp[0], r1 = rp[1], r2 = rp[2], r3 = rp[3];
                        f32x4 p0, p1;
#pragma unroll
                        for (int j = 0; j < 4; ++j) { auto r0_ = __builtin_amdgcn_permlane32_swap(__float_as_uint(v0[j]), __float_as_uint(v0[j]), false, false); auto r1_ = __builtin_amdgcn_permlane32_swap(__float_as_uint(v1[j]), __float_as_uint(v1[j]), false, false);
                            p0[j] = __uint_as_float(fq < 2 ? r0_[1] : r0_[0]); p1[j] = __uint_as_float(fq < 2 ? r1_[1] : r1_[0]); }
                        const float c0[4] = {r0[0], r0[2], r1[0], r1[2]}, s0[4] = {r0[1], r0[3], r1[1], r1[3]};
                        const float c1[4] = {r2[0], r2[2], r3[0], r3[2]}, s1[4] = {r2[1], r2[3], r3[1], r3[3]};
                        const bool lo = fq < 2;
#pragma unroll
                        for (int j = 0; j < 4; ++j) {
                            v0[j] = lo ? (v0[j] * c0[j] - p0[j] * s0[j]) : (p0[j] * s0[j] + v0[j] * c0[j]);
                            v1[j] = lo ? (v1[j] * c1[j] - p1[j] * s1[j]) : (p1[j] * s1[j] + v1[j] * c1[j]); }
                    }
                    u32x4 w; w.x = cvt_pk_bf16(v0[0], v0[1]); w.y = cvt_pk_bf16(v0[2], v0[3]); w.z = cvt_pk_bf16(v1[0], v1[1]); w.w = cvt_pk_bf16(v1[2], v1[3]);
                    *(u32x4*)(rowp + bj * HALF) = w; } }
    }
};
struct EpiOut {
    static constexpr bool PERM = true, AFTER_DRAIN = false;
    const float* xf_x; const float* xf_c; bf16_t* XB; const float* mod; int from_f32;
    __device__ __forceinline__ void operator()(const f32x4 (&acc)[2][2][4][2], const Unit& u, int ui, int wr, int wc, int fr, int fq) const {
        const int row0 = u.pm * BM + wr * 64 + fr, col0 = u.pn * BM + wc * 32 + 8 * fq;
        const bool latent = u.pm < (TXR / BM);
#pragma unroll
        for (int ai = 0; ai < 2; ++ai)
#pragma unroll
            for (int m = 0; m < 4; ++m) { const int row = row0 + ai * HALF + m * 16;
                const int mrow = latent ? (row >> 12) : 8; const float* gp = mod + mrow * 6144 + 2 * 1024 + col0;
                bf16_t* xb = XB + (size_t)row * 1024 + col0;
#pragma unroll
                for (int bj = 0; bj < 2; ++bj) { const f32x4 g0 = *(const f32x4*)(gp + bj * HALF), g1 = *(const f32x4*)(gp + bj * HALF + 4); f32x4 x0, x1;
                    if (from_f32) { const float* xo = (latent ? xf_x + (size_t)row * 1024 : xf_c + (size_t)(row - TXR) * 1024) + col0 + bj * HALF; x0 = *(const f32x4*)xo; x1 = *(const f32x4*)(xo + 4); }
                    else { const u32x4 w = *(const u32x4*)(xb + bj * HALF); x0 = (f32x4){__uint_as_float(w.x << 16), __uint_as_float(w.x & 0xffff0000u), __uint_as_float(w.y << 16), __uint_as_float(w.y & 0xffff0000u)};
                        x1 = (f32x4){__uint_as_float(w.z << 16), __uint_as_float(w.z & 0xffff0000u), __uint_as_float(w.w << 16), __uint_as_float(w.w & 0xffff0000u)}; }
                    const f32x4 v0 = x0 + g0 * acc[ai][bj][m][0], v1 = x1 + g1 * acc[ai][bj][m][1];
                    u32x4 o; o.x = cvt_pk_bf16(v0[0], v0[1]); o.y = cvt_pk_bf16(v0[2], v0[3]); o.z = cvt_pk_bf16(v1[0], v1[1]); o.w = cvt_pk_bf16(v1[2], v1[3]);
                    *(u32x4*)(xb + bj * HALF) = o; } }
    }
};
struct EpiGU {
    static constexpr bool PERM = true, AFTER_DRAIN = false;
    unsigned char* ACT; const PG8_LAS float* wsc;
    __device__ __forceinline__ void operator()(const f32x4 (&acc)[2][2][4][2], const Unit& u, int ui, int wr, int wc, int fr, int fq) const {
        const int row0 = u.pm * BM + wr * 64 + fr; const int col0 = (u.pn & 15) * 128 + wc * 32 + 8 * fq; const int e = u.pn >> 4; const float sg = wsc[e], su = wsc[16 + e]; const float nsl = -1.4426950408889634f * sg, sgu = sg * su;
#pragma unroll
        for (int ai = 0; ai < 2; ++ai)
#pragma unroll
            for (int m = 0; m < 4; ++m) { unsigned char* rowp = ACT + (size_t)(row0 + ai * HALF + m * 16) * 2048 + col0;
                float h[8];
#pragma unroll
                for (int n = 0; n < 2; ++n)
#pragma unroll
                    for (int j = 0; j < 4; ++j) { const float ag = acc[ai][0][m][n][j], au = acc[ai][1][m][n][j]; const float r = __builtin_amdgcn_rcpf(1.0f + __builtin_amdgcn_exp2f(ag * nsl)); h[4 * n + j] = __builtin_amdgcn_fmed3f((ag * au) * sgu * r, -448.0f, 448.0f); }
                int p0 = 0, p1 = 0;
                p0 = __builtin_amdgcn_cvt_pk_fp8_f32(h[0], h[1], p0, false); p0 = __builtin_amdgcn_cvt_pk_fp8_f32(h[2], h[3], p0, true);
                p1 = __builtin_amdgcn_cvt_pk_fp8_f32(h[4], h[5], p1, false); p1 = __builtin_amdgcn_cvt_pk_fp8_f32(h[6], h[7], p1, true);
                typedef int i32x2v __attribute__((ext_vector_type(2)));
                *(i32x2v*)rowp = (i32x2v){p0, p1}; }
    }
};
struct EpiDown {
    static constexpr bool PERM = true, AFTER_DRAIN = false;
    unsigned char* OB; const PG8_LAS float* gl;
    __device__ __forceinline__ void operator()(const f32x4 (&acc)[2][2][4][2], const Unit& u, int ui, int wr, int wc, int fr, int fq) const {
        const int row0 = u.pm * BM + wr * 64 + fr; const int col0 = (u.pn & 3) * BM + wc * 32 + 8 * fq;
#pragma unroll
        for (int ai = 0; ai < 2; ++ai)
#pragma unroll
            for (int m = 0; m < 4; ++m) { const int row = row0 + ai * HALF + m * 16; const float g = gl[ui * BM + ai * HALF + wr * 64 + m * 16 + fr]; unsigned char* rowp = OB + (size_t)row * 1024 + col0;
#pragma unroll
                for (int bj = 0; bj < 2; ++bj) { const f32x4 v0 = acc[ai][bj][m][0] * g, v1 = acc[ai][bj][m][1] * g; int p0 = 0, p1 = 0;
                    p0 = __builtin_amdgcn_cvt_pk_fp8_f32(__builtin_amdgcn_fmed3f(v0[0], -448.f, 448.f), __builtin_amdgcn_fmed3f(v0[1], -448.f, 448.f), p0, false); p0 = __builtin_amdgcn_cvt_pk_fp8_f32(__builtin_amdgcn_fmed3f(v0[2], -448.f, 448.f), __builtin_amdgcn_fmed3f(v0[3], -448.f, 448.f), p0, true);
                    p1 = __builtin_amdgcn_cvt_pk_fp8_f32(__builtin_amdgcn_fmed3f(v1[0], -448.f, 448.f), __builtin_amdgcn_fmed3f(v1[1], -448.f, 448.f), p1, false); p1 = __builtin_amdgcn_cvt_pk_fp8_f32(__builtin_amdgcn_fmed3f(v1[2], -448.f, 448.f), __builtin_amdgcn_fmed3f(v1[3], -448.f, 448.f), p1, true);
                    typedef int i32x2v __attribute__((ext_vector_type(2)));
                    *(i32x2v*)(rowp + bj * HALF) = (i32x2v){p0, p1}; } }
    }
};

template <class Epi, class Sched, bool ALIGN_EPI = false, bool SP2 = false, bool FP8 = false>
__device__ __forceinline__ void gemm_phase(PG8_LAS unsigned char* lds, const Gemm g, const Sched& S, const Epi& E) {
    int tid_ = threadIdx.x; asm volatile("" : "+v"(tid_));
    const int tid = tid_, wid = __builtin_amdgcn_readfirstlane(tid >> 6), lane = tid & 63, wr = wid >> 2, wc = wid & 3, fr = lane & 15, fq = lane >> 4;
    const int K = g.K, KB = FP8 ? K : 2 * K  , nt = KB / (BK * 2);
    unsigned voffA[2], voffB[2];
#pragma unroll
    for (int i = 0; i < 2; ++i) { int R, C; stage_rc(tid * 16 + i * 8192, R, C); const int Rb = Epi::PERM ? ((R & ~31) + perm32(R & 31)) : R;
        voffA[i] = (unsigned)(R * KB + C * 2); voffB[i] = (unsigned)(Rb * KB + C * 2); }
    const size_t kstep = (size_t)(BK * 2);
    const size_t hstep = (size_t)HALF * KB;
    const size_t tstep = 2 * hstep;
    const unsigned ldsw = (unsigned)wid * 1024u;
    const int aoff = lds_byte(wr * 64 + fr, fq * 8), boff = lds_byte(wc * 32 + fr, fq * 8);
#define PG8_SA(b, h) (((b) * 2 + (h)) * HTB)
#define PG8_SB(b, h) ((4 + (b) * 2 + (h)) * HTB)
#define PG8_STAGE(bufoff, gbase, voff) do { _Pragma("unroll") for (int _i = 0; _i < 2; ++_i) \
        __builtin_amdgcn_global_load_lds((const unsigned*)((const char*)(gbase) + (voff)[_i]), (PG8_LAS unsigned*)(lds + (bufoff) + ldsw + _i * 8192), 16, 0, 0); } while (0)
#define PG8_LDA(dst, b, h) do { _Pragma("unroll") for (int m = 0; m < 4; ++m) { if constexpr (FP8) { dst##8[m].lo = *(const PG8_LAS v4i_t*)(lds + PG8_SA(b, h) + aoff + m * 2048); dst##8[m].hi = *(const PG8_LAS v4i_t*)(lds + PG8_SA(b, h) + aoff + m * 2048 + 1024); } \
        else { _Pragma("unroll") for (int k = 0; k < 2; ++k) dst[m][k] = *(const PG8_LAS bf16x8*)(lds + PG8_SA(b, h) + aoff + m * 2048 + k * 1024); } } } while (0)
#define PG8_LDB(dst, b, h) do { _Pragma("unroll") for (int n = 0; n < 2; ++n) { if constexpr (FP8) { dst##8[n].lo = *(const PG8_LAS v4i_t*)(lds + PG8_SB(b, h) + boff + n * 2048); dst##8[n].hi = *(const PG8_LAS v4i_t*)(lds + PG8_SB(b, h) + boff + n * 2048 + 1024); } \
        else { _Pragma("unroll") for (int k = 0; k < 2; ++k) dst[n][k] = *(const PG8_LAS bf16x8*)(lds + PG8_SB(b, h) + boff + n * 2048 + k * 1024); } } } while (0)
#define PG8_CAT8(x0, x1) __builtin_shufflevector(__builtin_bit_cast(v4i_t, x0), __builtin_bit_cast(v4i_t, x1), 0, 1, 2, 3, 4, 5, 6, 7)
#define PG8_MMA(ai, bj, At, Bt) do { __builtin_amdgcn_s_setprio(1); if constexpr (FP8) asm volatile("s_nop 1" ::: "memory"); _Pragma("unroll") for (int m = 0; m < 4; ++m) _Pragma("unroll") for (int n = 0; n < 2; ++n) { \
        if constexpr (FP8) { asm volatile("v_mfma_scale_f32_16x16x128_f8f6f4 %0, %1, %2, %0, %3, %3 op_sel_hi:[0,0,0]" : "+v"(acc[ai][bj][m][n]) : "v"(Bt##8[n]), "v"(At##8[m]), "v"(one_scale)); } \
        else { _Pragma("unroll") for (int k = 0; k < 2; ++k) acc[ai][bj][m][n] = __builtin_amdgcn_mfma_f32_16x16x32_bf16(Bt[n][k], At[m][k], acc[ai][bj][m][n], 0, 0, 0); } } if constexpr (FP8) asm volatile("s_nop 15\n\ts_nop 3" ::: "memory"); __builtin_amdgcn_s_setprio(0); } while (0)
#define PG8_WAIT_V(n) asm volatile("s_waitcnt vmcnt(" #n ")" ::: "memory")
#define PG8_WAIT_L(n) asm volatile("s_waitcnt lgkmcnt(" #n ")" ::: "memory")
#define PG8_BAR __builtin_amdgcn_s_barrier()
#define PG8_SCHED __builtin_amdgcn_sched_barrier(0)
    Unit cur, nxt; int ui = 0;
    if (!S.next(0, cur)) return;
    f32x4 acc[2][2][4][2];
#pragma unroll
    for (int a = 0; a < 2; ++a)
#pragma unroll
        for (int b = 0; b < 2; ++b)
#pragma unroll
            for (int m = 0; m < 4; ++m)
#pragma unroll
                for (int n = 0; n < 2; ++n) acc[a][b][m][n] = (f32x4){0.f, 0.f, 0.f, 0.f};
    bf16x8 At[4][2], B0[2][2], B1[2][2];
    v8i_t At8[4], B08[2], B18[2];
    int one_scale = 0x7f7f7f7f; asm volatile("" : "+v"(one_scale));
    const char* cA = (const char*)g.A + (size_t)cur.pm * tstep; const char* cB = (const char*)g.Bt + (size_t)cur.pn * tstep;
    S.a_ready(cur);
    if constexpr (SP2) {
        PG8_STAGE(PG8_SB(0, 0), cB, voffB); PG8_STAGE(PG8_SB(0, 1), cB + hstep, voffB); PG8_STAGE(PG8_SA(0, 0), cA, voffA); PG8_STAGE(PG8_SA(0, 1), cA + hstep, voffA);
        if (wr == 1) PG8_BAR;
        PG8_WAIT_V(2); PG8_BAR;
        PG8_STAGE(PG8_SB(1, 0), cB + kstep, voffB); PG8_STAGE(PG8_SA(1, 0), cA + kstep, voffA); PG8_STAGE(PG8_SB(1, 1), cB + hstep + kstep, voffB);
        PG8_WAIT_V(6); PG8_BAR;
    } else {
        PG8_STAGE(PG8_SB(0, 0), cB, voffB); PG8_STAGE(PG8_SA(0, 0), cA, voffA); PG8_STAGE(PG8_SB(0, 1), cB + hstep, voffB); PG8_STAGE(PG8_SA(0, 1), cA + hstep, voffA);
        if (wr == 1) PG8_BAR;
        PG8_WAIT_V(4); PG8_BAR;
        PG8_STAGE(PG8_SB(1, 0), cB + kstep, voffB); PG8_STAGE(PG8_SA(1, 0), cA + kstep, voffA); PG8_STAGE(PG8_SB(1, 1), cB + hstep + kstep, voffB);
        PG8_WAIT_V(6); PG8_BAR;
    }
    for (;;) {
        const bool has_next = S.next(ui + 1, nxt);
        const char* nA = has_next ? (const char*)g.A + (size_t)nxt.pm * tstep : cA; const char* nB = has_next ? (const char*)g.Bt + (size_t)nxt.pn * tstep : cB;
#pragma nounroll
        for (int t = 0; t < nt; t += 2) {
            const bool last = (t == nt - 2);
            const char* a1 = cA + (size_t)(t + 1) * kstep;
            const char* a2 = last ? nA : cA + (size_t)(t + 2) * kstep; const char* b2 = last ? nB : cB + (size_t)(t + 2) * kstep;
            const char* a3 = a2 + kstep; const char* b3 = b2 + kstep;
            if (last && has_next) S.a_ready(nxt);
            if constexpr (SP2) {
            PG8_LDB(B0, 0, 0); PG8_LDB(B1, 0, 1); PG8_SCHED; PG8_LDA(At, 0, 0); PG8_STAGE(PG8_SA(1, 1), a1 + hstep, voffA);
            PG8_WAIT_V(8); PG8_WAIT_L(0); PG8_BAR; PG8_MMA(0, 0, At, B0); PG8_MMA(0, 1, At, B1); PG8_BAR; PG8_SCHED;
            PG8_LDA(At, 0, 1); PG8_STAGE(PG8_SB(0, 0), b2, voffB); PG8_STAGE(PG8_SB(0, 1), b2 + hstep, voffB); PG8_STAGE(PG8_SA(0, 0), a2, voffA);
            PG8_WAIT_V(8); PG8_WAIT_L(0); PG8_BAR; PG8_MMA(1, 0, At, B0); PG8_MMA(1, 1, At, B1); PG8_BAR; PG8_SCHED;
            PG8_LDB(B0, 1, 0); PG8_LDB(B1, 1, 1); PG8_SCHED; PG8_LDA(At, 1, 0); PG8_STAGE(PG8_SA(0, 1), a2 + hstep, voffA);
            PG8_WAIT_V(8); PG8_WAIT_L(0); PG8_BAR; PG8_MMA(0, 0, At, B0); PG8_MMA(0, 1, At, B1); PG8_BAR; PG8_SCHED;
            PG8_LDA(At, 1, 1); PG8_STAGE(PG8_SB(1, 0), b3, voffB); PG8_STAGE(PG8_SB(1, 1), b3 + hstep, voffB); PG8_STAGE(PG8_SA(1, 0), a3, voffA);
            PG8_WAIT_V(8); PG8_WAIT_L(0); PG8_BAR; PG8_MMA(1, 0, At, B0); PG8_MMA(1, 1, At, B1); PG8_BAR; PG8_SCHED;
            } else {
            PG8_LDB(B0, 0, 0); PG8_SCHED; PG8_LDA(At, 0, 0); PG8_STAGE(PG8_SA(1, 1), a1 + hstep, voffA);
            PG8_WAIT_L(8); PG8_BAR; PG8_WAIT_L(0); PG8_MMA(0, 0, At, B0); PG8_BAR; PG8_SCHED;
            PG8_LDB(B1, 0, 1); PG8_STAGE(PG8_SB(0, 0), b2, voffB);
            PG8_BAR; PG8_WAIT_L(0); PG8_MMA(0, 1, At, B1); PG8_BAR;
            PG8_LDA(At, 0, 1); PG8_STAGE(PG8_SA(0, 0), a2, voffA);
            PG8_BAR; PG8_WAIT_L(0); PG8_MMA(1, 0, At, B0); PG8_BAR; PG8_SCHED;
            PG8_STAGE(PG8_SB(0, 1), b2 + hstep, voffB);
            PG8_WAIT_V(6); PG8_BAR; PG8_MMA(1, 1, At, B1); PG8_BAR;
            PG8_LDB(B0, 1, 0); PG8_SCHED; PG8_LDA(At, 1, 0); PG8_STAGE(PG8_SA(0, 1), a2 + hstep, voffA);
            PG8_WAIT_L(8); PG8_BAR; PG8_WAIT_L(0); PG8_MMA(0, 0, At, B0); PG8_BAR; PG8_SCHED;
            PG8_LDB(B1, 1, 1); PG8_STAGE(PG8_SB(1, 0), b3, voffB);
            PG8_BAR; PG8_WAIT_L(0); PG8_MMA(0, 1, At, B1); PG8_BAR;
            PG8_LDA(At, 1, 1); PG8_STAGE(PG8_SA(1, 0), a3, voffA);
            PG8_BAR; PG8_WAIT_L(0); PG8_MMA(1, 0, At, B0); PG8_BAR; PG8_SCHED;
            PG8_STAGE(PG8_SB(1, 1), b3 + hstep, voffB);
            PG8_WAIT_V(6); PG8_BAR; PG8_MMA(1, 1, At, B1); PG8_BAR;
            }
        }
        if constexpr (ALIGN_EPI) { if (wr == 0) PG8_BAR; }
        if constexpr (!Epi::AFTER_DRAIN) { E(acc, cur, ui, wr, wc, fr, fq); S.done(cur); }
        if (!has_next) break;
#pragma unroll
        for (int a = 0; a < 2; ++a)
#pragma unroll
            for (int b = 0; b < 2; ++b)
#pragma unroll
                for (int m = 0; m < 4; ++m)
#pragma unroll
                    for (int n = 0; n < 2; ++n) acc[a][b][m][n] = (f32x4){0.f, 0.f, 0.f, 0.f};
        cur = nxt; cA = nA; cB = nB; ++ui;
        if constexpr (ALIGN_EPI) { if (wr == 1) PG8_BAR; }
    }
    PG8_WAIT_V(0);
    if constexpr (!ALIGN_EPI) { if (wr == 0) PG8_BAR; }
    PG8_BAR;
    if constexpr (Epi::AFTER_DRAIN) { E.fused(acc, cur, wr, wc, fr, fq, lds, wid, lane); S.done(cur); }
#undef PG8_SA
#undef PG8_SB
#undef PG8_STAGE
#undef PG8_LDA
#undef PG8_LDB
#undef PG8_MMA
#undef PG8_CAT8
#undef PG8_WAIT_V
#undef PG8_WAIT_L
#undef PG8_BAR
#undef PG8_SCHED
}
template <class Epi, class Sched, bool FP8 = false>
__device__ __forceinline__ void gemm_phase_gather(PG8_LAS unsigned char* lds, const Gemm g, const int* rowmap, PG8_LAS int* idxs, const Sched& S, const Epi& E) {
    constexpr bool ALIGN_EPI = true, SP2 = true;
    int tid_ = threadIdx.x; asm volatile("" : "+v"(tid_));
    const int tid = tid_, wid = __builtin_amdgcn_readfirstlane(tid >> 6), lane = tid & 63, wr = wid >> 2, wc = wid & 3, fr = lane & 15, fq = lane >> 4;
    const int K = g.K, KB = FP8 ? K : 2 * K  , nt = KB / (BK * 2);
    unsigned voffB[2]; int RA[2], CA[2];
#pragma unroll
    for (int i = 0; i < 2; ++i) { int R, C; stage_rc(tid * 16 + i * 8192, R, C); const int Rb = Epi::PERM ? ((R & ~31) + perm32(R & 31)) : R;
        RA[i] = R; CA[i] = C * 2; voffB[i] = (unsigned)(Rb * KB + C * 2); }
    const size_t kstep = (size_t)(BK * 2);
    const size_t hstep = (size_t)HALF * KB;
    const size_t tstep = 2 * hstep;
    const unsigned ldsw = (unsigned)wid * 1024u;
    const int aoff = lds_byte(wr * 64 + fr, fq * 8), boff = lds_byte(wc * 32 + fr, fq * 8);
#define PG8_SA(b, h) (((b) * 2 + (h)) * HTB)
#define PG8_SB(b, h) ((4 + (b) * 2 + (h)) * HTB)
#define PG8_STAGE(bufoff, gbase, voff) do { _Pragma("unroll") for (int _i = 0; _i < 2; ++_i) \
        __builtin_amdgcn_global_load_lds((const unsigned*)((const char*)(gbase) + (voff)[_i]), (PG8_LAS unsigned*)(lds + (bufoff) + ldsw + _i * 8192), 16, 0, 0); } while (0)
#define PG8_STAGE_AG(bufoff, P, h, koff) do { _Pragma("unroll") for (int _i = 0; _i < 2; ++_i) \
        __builtin_amdgcn_global_load_lds((const unsigned*)((const char*)g.A + (size_t)((P)[h][_i] + (unsigned)(koff))), (PG8_LAS unsigned*)(lds + (bufoff) + ldsw + _i * 8192), 16, 0, 0); } while (0)
#define PG8_ROWPTR(P, u) do { _Pragma("unroll") for (int _h = 0; _h < 2; ++_h) _Pragma("unroll") for (int _i = 0; _i < 2; ++_i) \
        (P)[_h][_i] = (unsigned)idxs[(u) * BM + _h * HALF + RA[_i]] * (unsigned)KB + (unsigned)CA[_i]; } while (0)
#define PG8_LDA(dst, b, h) do { _Pragma("unroll") for (int m = 0; m < 4; ++m) { if constexpr (FP8) { dst##8[m].lo = *(const PG8_LAS v4i_t*)(lds + PG8_SA(b, h) + aoff + m * 2048); dst##8[m].hi = *(const PG8_LAS v4i_t*)(lds + PG8_SA(b, h) + aoff + m * 2048 + 1024); } \
        else { _Pragma("unroll") for (int k = 0; k < 2; ++k) dst[m][k] = *(const PG8_LAS bf16x8*)(lds + PG8_SA(b, h) + aoff + m * 2048 + k * 1024); } } } while (0)
#define PG8_LDB(dst, b, h) do { _Pragma("unroll") for (int n = 0; n < 2; ++n) { if constexpr (FP8) { dst##8[n].lo = *(const PG8_LAS v4i_t*)(lds + PG8_SB(b, h) + boff + n * 2048); dst##8[n].hi = *(const PG8_LAS v4i_t*)(lds + PG8_SB(b, h) + boff + n * 2048 + 1024); } \
        else { _Pragma("unroll") for (int k = 0; k < 2; ++k) dst[n][k] = *(const PG8_LAS bf16x8*)(lds + PG8_SB(b, h) + boff + n * 2048 + k * 1024); } } } while (0)
#define PG8_CAT8(x0, x1) __builtin_shufflevector(__builtin_bit_cast(v4i_t, x0), __builtin_bit_cast(v4i_t, x1), 0, 1, 2, 3, 4, 5, 6, 7)
#define PG8_MMA(ai, bj, At, Bt) do { __builtin_amdgcn_s_setprio(1); if constexpr (FP8) asm volatile("s_nop 1" ::: "memory"); _Pragma("unroll") for (int m = 0; m < 4; ++m) _Pragma("unroll") for (int n = 0; n < 2; ++n) { \
        if constexpr (FP8) { asm volatile("v_mfma_scale_f32_16x16x128_f8f6f4 %0, %1, %2, %0, %3, %3 op_sel_hi:[0,0,0]" : "+v"(acc[ai][bj][m][n]) : "v"(Bt##8[n]), "v"(At##8[m]), "v"(one_scale)); } \
        else { _Pragma("unroll") for (int k = 0; k < 2; ++k) acc[ai][bj][m][n] = __builtin_amdgcn_mfma_f32_16x16x32_bf16(Bt[n][k], At[m][k], acc[ai][bj][m][n], 0, 0, 0); } } if constexpr (FP8) asm volatile("s_nop 15\n\ts_nop 3" ::: "memory"); __builtin_amdgcn_s_setprio(0); } while (0)
#define PG8_WAIT_V(n) asm volatile("s_waitcnt vmcnt(" #n ")" ::: "memory")
#define PG8_WAIT_L(n) asm volatile("s_waitcnt lgkmcnt(" #n ")" ::: "memory")
#define PG8_BAR __builtin_amdgcn_s_barrier()
#define PG8_SCHED __builtin_amdgcn_sched_barrier(0)
    Unit cur, nxt; int ui = 0;
    if (!S.next(0, cur)) return;
    f32x4 acc[2][2][4][2];
#pragma unroll
    for (int a = 0; a < 2; ++a)
#pragma unroll
        for (int b = 0; b < 2; ++b)
#pragma unroll
            for (int m = 0; m < 4; ++m)
#pragma unroll
                for (int n = 0; n < 2; ++n) acc[a][b][m][n] = (f32x4){0.f, 0.f, 0.f, 0.f};
    bf16x8 At[4][2], B0[2][2], B1[2][2];
    v8i_t At8[4], B08[2], B18[2];
    int one_scale = 0x7f7f7f7f; asm volatile("" : "+v"(one_scale));
    const char* cB = (const char*)g.Bt + (size_t)cur.pn * tstep;
    unsigned cP[2][2], nP[2][2];
    { Unit uu; for (int i = 0; S.next(i, uu); ++i) if (tid < BM) idxs[i * BM + tid] = rowmap[uu.pm * BM + tid]; }
    asm volatile("s_waitcnt vmcnt(0) lgkmcnt(0)" ::: "memory"); __builtin_amdgcn_s_barrier(); asm volatile("" ::: "memory");
    PG8_ROWPTR(cP, 0);
    S.a_ready(cur);
    if constexpr (SP2) {
        PG8_STAGE(PG8_SB(0, 0), cB, voffB); PG8_STAGE(PG8_SB(0, 1), cB + hstep, voffB); PG8_STAGE_AG(PG8_SA(0, 0), cP, 0, 0); PG8_STAGE_AG(PG8_SA(0, 1), cP, 1, 0);
        if (wr == 1) PG8_BAR;
        PG8_WAIT_V(2); PG8_BAR;
        PG8_STAGE(PG8_SB(1, 0), cB + kstep, voffB); PG8_STAGE_AG(PG8_SA(1, 0), cP, 0, kstep); PG8_STAGE(PG8_SB(1, 1), cB + hstep + kstep, voffB);
        PG8_WAIT_V(6); PG8_BAR;
    }
    for (;;) {
        const bool has_next = S.next(ui + 1, nxt);
        const char* nB = has_next ? (const char*)g.Bt + (size_t)nxt.pn * tstep : cB;
        if (has_next) { PG8_ROWPTR(nP, ui + 1); } else { _Pragma("unroll") for (int _h = 0; _h < 2; ++_h) _Pragma("unroll") for (int _i = 0; _i < 2; ++_i) nP[_h][_i] = cP[_h][_i]; }
#pragma nounroll
        for (int t = 0; t < nt; t += 2) {
            const bool last = (t == nt - 2);
            const size_t k1 = (size_t)(t + 1) * kstep, k2 = last ? 0 : (size_t)(t + 2) * kstep, k3 = k2 + kstep;
            unsigned sP[2][2];
            _Pragma("unroll") for (int _h = 0; _h < 2; ++_h) _Pragma("unroll") for (int _i = 0; _i < 2; ++_i) sP[_h][_i] = last ? nP[_h][_i] : cP[_h][_i];
            const char* b2 = last ? nB : cB + (size_t)(t + 2) * kstep; const char* b3 = b2 + kstep;
            if (last && has_next) S.a_ready(nxt);
            if constexpr (SP2) {
            PG8_LDB(B0, 0, 0); PG8_LDB(B1, 0, 1); PG8_SCHED; PG8_LDA(At, 0, 0); PG8_STAGE_AG(PG8_SA(1, 1), cP, 1, k1);
            PG8_WAIT_V(8); PG8_WAIT_L(0); PG8_BAR; PG8_MMA(0, 0, At, B0); PG8_MMA(0, 1, At, B1); PG8_BAR; PG8_SCHED;
            PG8_LDA(At, 0, 1); PG8_STAGE(PG8_SB(0, 0), b2, voffB); PG8_STAGE(PG8_SB(0, 1), b2 + hstep, voffB); PG8_STAGE_AG(PG8_SA(0, 0), sP, 0, k2);
            PG8_WAIT_V(8); PG8_WAIT_L(0); PG8_BAR; PG8_MMA(1, 0, At, B0); PG8_MMA(1, 1, At, B1); PG8_BAR; PG8_SCHED;
            PG8_LDB(B0, 1, 0); PG8_LDB(B1, 1, 1); PG8_SCHED; PG8_LDA(At, 1, 0); PG8_STAGE_AG(PG8_SA(0, 1), sP, 1, k2);
            PG8_WAIT_V(8); PG8_WAIT_L(0); PG8_BAR; PG8_MMA(0, 0, At, B0); PG8_MMA(0, 1, At, B1); PG8_BAR; PG8_SCHED;
            PG8_LDA(At, 1, 1); PG8_STAGE(PG8_SB(1, 0), b3, voffB); PG8_STAGE(PG8_SB(1, 1), b3 + hstep, voffB); PG8_STAGE_AG(PG8_SA(1, 0), sP, 0, k3);
            PG8_WAIT_V(8); PG8_WAIT_L(0); PG8_BAR; PG8_MMA(1, 0, At, B0); PG8_MMA(1, 1, At, B1); PG8_BAR; PG8_SCHED;
            }
        }
        if constexpr (ALIGN_EPI) { if (wr == 0) PG8_BAR; }
        if constexpr (!Epi::AFTER_DRAIN) { E(acc, cur, ui, wr, wc, fr, fq); if (AMP_PHASE == 81) { asm volatile("" ::: "memory"); E(acc, cur, ui, wr, wc, fr, fq); } S.done(cur); }
        if (!has_next) break;
#pragma unroll
        for (int a = 0; a < 2; ++a)
#pragma unroll
            for (int b = 0; b < 2; ++b)
#pragma unroll
                for (int m = 0; m < 4; ++m)
#pragma unroll
                    for (int n = 0; n < 2; ++n) acc[a][b][m][n] = (f32x4){0.f, 0.f, 0.f, 0.f};
        cur = nxt; cB = nB; ++ui;
        _Pragma("unroll") for (int _h = 0; _h < 2; ++_h) _Pragma("unroll") for (int _i = 0; _i < 2; ++_i) cP[_h][_i] = nP[_h][_i];
        if constexpr (ALIGN_EPI) { if (wr == 1) PG8_BAR; }
    }
    PG8_WAIT_V(0);
    if constexpr (!ALIGN_EPI) { if (wr == 0) PG8_BAR; }
    PG8_BAR;
    if constexpr (Epi::AFTER_DRAIN) { E.fused(acc, cur, wr, wc, fr, fq, lds, wid, lane); S.done(cur); }
#undef PG8_SA
#undef PG8_SB
#undef PG8_STAGE
#undef PG8_STAGE_AG
#undef PG8_ROWPTR
#undef PG8_LDA
#undef PG8_LDB
#undef PG8_MMA
#undef PG8_CAT8
#undef PG8_WAIT_V
#undef PG8_WAIT_L
#undef PG8_BAR
#undef PG8_SCHED
}

}

#define LAS __attribute__((address_space(3)))
typedef unsigned short bf16_t;
typedef float f32x4 __attribute__((ext_vector_type(4)));
typedef unsigned u32x4 __attribute__((ext_vector_type(4)));
typedef unsigned u32x2 __attribute__((ext_vector_type(2)));
typedef __bf16 bf16x2_t __attribute__((ext_vector_type(2)));
constexpr int NWAVES = 8, NTHR = 512;
constexpr int D = 1024, NB = 8, SEQ = 4096, LCTX = 256, TX = NB * SEQ, TC = NB * LCTX, TT = TX + TC, INW = 2304, NE = 16, FF = 2048;
constexpr int CAPX = 512, CAPC = 32, SLOTS = NB * CAPX + NB * CAPC;
constexpr float LOG2E = 1.4426950408889634f;
constexpr int LDS_BYTES = 163840;
enum { I_X = 0, I_C, I_CTX, I_CCTX, I_ADAW, I_ADAB, I_N1G, I_N2G, I_WIN, I_HCW, I_HCB, I_HW1, I_HB1, I_HW2, I_HB2, I_HW3, I_HFREQ, I_HSKIP, I_SINK, I_POOLW, I_POOLS, I_RPB, I_WOUT, I_ROUTER, I_WG, I_WU, I_WD, I_FNG, N_IN };
constexpr size_t MiB = 1u << 20;
constexpr size_t WS_CTL = 0;
constexpr size_t WS_MOD = 1 * MiB;
constexpr size_t WS_WSC = 1 * MiB + 512 * 1024;
constexpr size_t WS_ROPE = 2 * MiB;
constexpr size_t WS_TW8 = 2 * MiB + 65536;
constexpr size_t WS_WIN_T = 3 * MiB;
constexpr size_t WS_WOUT_T = 13 * MiB;
constexpr size_t WS_HC = 17 * MiB;
constexpr size_t WS_HCC = 51 * MiB;
constexpr size_t WS_AFFT = 53 * MiB;
constexpr size_t WS_ROWMAP = 56 * MiB;
constexpr size_t WS_GATE = 57 * MiB;
constexpr size_t WS_INV = 58 * MiB;
constexpr size_t WS_CRES = 61 * MiB;
constexpr size_t WS_HX = 69 * MiB;
constexpr size_t WS_WGU_T = 137 * MiB;
constexpr size_t WS_XB = 265 * MiB;
constexpr size_t WS_WD_T = 393 * MiB;
constexpr size_t WS_R = 521 * MiB;
constexpr size_t WS_ACT = WS_R;
constexpr size_t WS_XG = WS_R + 272 * MiB;
constexpr size_t WS_PX = WS_R;
constexpr size_t WS_Y = WS_R + 153 * MiB;
constexpr size_t WS_YT = WS_XG + 48 * MiB;
constexpr size_t WS_UT = WS_XG;
constexpr size_t WS_HS = WS_R + 408 * MiB;
constexpr size_t WS_END = WS_HS + 64 * MiB;
static_assert(WS_END <= 1024 * MiB, "workspace map");

struct Args { const float* in[N_IN]; float* out; unsigned char* ws; };

__device__ __forceinline__ float bf2f(unsigned short v) { return __uint_as_float(((unsigned)v) << 16); }
__device__ __forceinline__ unsigned f2bf(float f) { unsigned u = __float_as_uint(f); return (u + 0x7fffu + ((u >> 16) & 1u)) >> 16; }
__device__ __forceinline__ unsigned pk2(float lo, float hi) { return f2bf(lo) | (f2bf(hi) << 16); }
__device__ __forceinline__ float bflo(unsigned w) { return __uint_as_float(w << 16); }
__device__ __forceinline__ float bfhi(unsigned w) { return __uint_as_float(w & 0xffff0000u); }
__device__ __forceinline__ float dot2bf(unsigned a, unsigned b, float acc) { return __builtin_amdgcn_fdot2_f32_bf16(__builtin_bit_cast(bf16x2_t, a), __builtin_bit_cast(bf16x2_t, b), acc, false); }
template <int O> __device__ __forceinline__ float xshfl(float v) {
    if constexpr (O == 32) { auto rr = __builtin_amdgcn_permlane32_swap(__float_as_uint(v), __float_as_uint(v), false, false);
        const bool lowhalf = __builtin_amdgcn_mbcnt_lo(~0u, 0u) == __builtin_amdgcn_mbcnt_hi(~0u, __builtin_amdgcn_mbcnt_lo(~0u, 0u));
        return lowhalf ? __uint_as_float(rr[1]) : __uint_as_float(rr[0]); }
    else return __builtin_bit_cast(float, __builtin_amdgcn_ds_swizzle(__builtin_bit_cast(int, v), (O << 10) | 0x1f));
}
__device__ __forceinline__ float xsum32(float v) { auto rr = __builtin_amdgcn_permlane32_swap(__float_as_uint(v), __float_as_uint(v), false, false); return __uint_as_float(rr[0]) + __uint_as_float(rr[1]); }
__device__ __forceinline__ float xmax32(float v) { auto rr = __builtin_amdgcn_permlane32_swap(__float_as_uint(v), __float_as_uint(v), false, false); return fmaxf(__uint_as_float(rr[0]), __uint_as_float(rr[1])); }
__device__ __forceinline__ float wave_sum(float v) { v += xshfl<1>(v); v += xshfl<2>(v); v += xshfl<4>(v); v += xshfl<8>(v); v += xshfl<16>(v); return xsum32(v); }
__device__ __forceinline__ float wave_max_(float v) { v = fmaxf(v, xshfl<1>(v)); v = fmaxf(v, xshfl<2>(v)); v = fmaxf(v, xshfl<4>(v)); v = fmaxf(v, xshfl<8>(v)); v = fmaxf(v, xshfl<16>(v)); return xmax32(v); }
#define LDS_WAIT() asm volatile("s_waitcnt lgkmcnt(0)" ::: "memory")

#ifndef AMP_PHASE
#define AMP_PHASE -1
#endif
__device__ __forceinline__ unsigned long long amp_now() { asm volatile("s_waitcnt vmcnt(0) lgkmcnt(0)" ::: "memory"); __builtin_amdgcn_sched_barrier(0); const unsigned long long t = __builtin_amdgcn_s_memrealtime(); asm volatile("s_waitcnt lgkmcnt(0)" ::: "memory"); __builtin_amdgcn_sched_barrier(0); return t; }
#define AMP_BEGIN(id) unsigned long long amp_t0_ = 0; if ((id) == AMP_PHASE) { __syncthreads(); amp_t0_ = amp_now(); }
#define AMP_END(id) if ((id) == AMP_PHASE) { __syncthreads(); const unsigned long long t1_ = amp_now(); const unsigned long long d_ = t1_ - amp_t0_; while (amp_now() - t1_ < d_) __builtin_amdgcn_s_sleep(8); __syncthreads(); }
__device__ __forceinline__ void tr_item(const float* W, int K, int N, bf16_t* WT, int Kt, int item, int mode, LAS float* scr, int lane) {
    const int nblk = N / 32, kb = item / nblk, nb = item % nblk, k0 = 64 * kb, n0 = 32 * nb;
    const int r8 = lane >> 3, c4 = lane & 7; f32x4 v[8];
    const float* wp = W + (size_t)(k0 + r8) * N + n0 + 4 * c4;
#pragma unroll
    for (int i = 0; i < 8; ++i) v[i] = *(const f32x4*)(wp + (size_t)(8 * i) * N);
#pragma unroll
    for (int i = 0; i < 8; ++i) { LAS float* d = scr + (r8 + 8 * i) * 33 + 4 * c4; d[0] = v[i][0]; d[1] = v[i][1]; d[2] = v[i][2]; d[3] = v[i][3]; }
    LDS_WAIT();
    const int c = lane & 7;
    const int drow0 = (mode == 0) ? n0 : ((n0 >> 7) * 256 + (n0 & 127) + (mode == 2 ? 128 : 0));
#pragma unroll
    for (int j = 0; j < 4; ++j) { const int n = (lane >> 3) + 8 * j; const LAS float* sp = scr + (8 * c) * 33 + n;
        u32x4 o; o.x = pk2(sp[0 * 33], sp[1 * 33]); o.y = pk2(sp[2 * 33], sp[3 * 33]); o.z = pk2(sp[4 * 33], sp[5 * 33]); o.w = pk2(sp[6 * 33], sp[7 * 33]);
        *(u32x4*)(WT + (size_t)(drow0 + n) * Kt + k0 + 8 * c) = o; }
    LDS_WAIT();
}

struct CvtStream { int it, end, live; f32x4 v0, v1, v2, v3, v4, v5, v6, v7; };
constexpr int CVT_ITEMS = 2 * 3 * 16 * 1024;
__device__ __forceinline__ void cvt_decode(const Args& a, int r, const float*& W, int& K, int& N, unsigned char*& WT, int& Kt, int& mode, int& ri, float*& wsc) {
    const int l = r / 49152, rr = r % 49152, which = rr >> 14, e = (rr >> 10) & 15; ri = rr & 1023; const size_t le = (size_t)l * 16 + e;
    wsc = (float*)(a.ws + WS_WSC) + (l * 3 + which) * 16 + e;
    if (which == 0) { W = a.in[I_WG] + le * 1024 * 2048; K = 1024; N = 2048; WT = (unsigned char*)(a.ws + WS_WGU_T) + le * 4096 * 1024; Kt = 1024; mode = 1; }
    else if (which == 1) { W = a.in[I_WU] + le * 1024 * 2048; K = 1024; N = 2048; WT = (unsigned char*)(a.ws + WS_WGU_T) + le * 4096 * 1024; Kt = 1024; mode = 2; }
    else { W = a.in[I_WD] + le * 2048 * 1024; K = 2048; N = 1024; WT = (unsigned char*)(a.ws + WS_WD_T) + le * 1024 * 2048; Kt = 2048; mode = 0; }
}
__device__ __forceinline__ void cvt_issue(const Args& a, CvtStream& c, int lane) {
    c.live = 0; if (c.it >= c.end) return;
    const float* W; int K, N, Kt, mode, ri; unsigned char* WT; float* wsc; cvt_decode(a, c.it, W, K, N, WT, Kt, mode, ri, wsc);
    const int nblk = N / 32, kb = ri / nblk, nb = ri % nblk, k0 = 64 * kb, n0 = 32 * nb; const int r8 = lane >> 3, c4 = lane & 7;
    const float* wp = W + (size_t)(k0 + r8) * N + n0 + 4 * c4; const size_t st = (size_t)8 * N;
    c.v0 = *(const f32x4*)(wp); c.v1 = *(const f32x4*)(wp + st); c.v2 = *(const f32x4*)(wp + 2 * st); c.v3 = *(const f32x4*)(wp + 3 * st);
    c.v4 = *(const f32x4*)(wp + 4 * st); c.v5 = *(const f32x4*)(wp + 5 * st); c.v6 = *(const f32x4*)(wp + 6 * st); c.v7 = *(const f32x4*)(wp + 7 * st);
    c.live = 1;
}
__device__ __forceinline__ void cvt_finish(const Args& a, CvtStream& c, LAS float* scr, int lane, int stride) {
    if (!c.live) return;
    const float* W; int K, N, Kt, mode, ri; unsigned char* WT; float* wsc; cvt_decode(a, c.it, W, K, N, WT, Kt, mode, ri, wsc);
    const int nblk = N / 32, kb = ri / nblk, nb = ri % nblk, k0 = 64 * kb, n0 = 32 * nb; const int r8 = lane >> 3, c4 = lane & 7;
    const float mul = 1.0f / *wsc;
    LAS float* d = scr + r8 * 33 + 4 * c4;
#define CVT_PUT(i, v) { d[(8 * (i)) * 33 + 0] = v[0] * mul; d[(8 * (i)) * 33 + 1] = v[1] * mul; d[(8 * (i)) * 33 + 2] = v[2] * mul; d[(8 * (i)) * 33 + 3] = v[3] * mul; }
    CVT_PUT(0, c.v0) CVT_PUT(1, c.v1) CVT_PUT(2, c.v2) CVT_PUT(3, c.v3) CVT_PUT(4, c.v4) CVT_PUT(5, c.v5) CVT_PUT(6, c.v6) CVT_PUT(7, c.v7)
#undef CVT_PUT
    LDS_WAIT();
    const int cc = lane & 7;
    const int drow0 = (mode == 0) ? n0 : ((n0 >> 7) * 256 + (n0 & 127) + (mode == 2 ? 128 : 0));
#pragma unroll
    for (int j = 0; j < 4; ++j) { const int n = (lane >> 3) + 8 * j; const LAS float* sp = scr + (8 * cc) * 33 + n;
        int p0 = 0, p1 = 0;
        p0 = __builtin_amdgcn_cvt_pk_fp8_f32(sp[0 * 33], sp[1 * 33], p0, false); p0 = __builtin_amdgcn_cvt_pk_fp8_f32(sp[2 * 33], sp[3 * 33], p0, true);
        p1 = __builtin_amdgcn_cvt_pk_fp8_f32(sp[4 * 33], sp[5 * 33], p1, false); p1 = __builtin_amdgcn_cvt_pk_fp8_f32(sp[6 * 33], sp[7 * 33], p1, true);
        typedef int i32x2v __attribute__((ext_vector_type(2)));
        *(i32x2v*)(WT + (size_t)(drow0 + n) * Kt + k0 + 8 * cc) = (i32x2v){p0, p1}; }
    LDS_WAIT();
    c.it += stride; c.live = 0;
}

__device__ __forceinline__ void filter_item(const Args& a, LAS unsigned char* lds, int item, int tid) {
    asm volatile("" : "+v"(tid));
    const int lane = tid & 63, wave = tid >> 6;
    int l, L, p0; float* HCdst;
    if (item < 128) { l = 0; L = 4096; p0 = item * 32; HCdst = (float*)(a.ws + WS_HC); }
    else if (item < 256) { l = 1; L = 4096; p0 = (item - 128) * 32; HCdst = (float*)(a.ws + WS_HC) + (size_t)2 * 256 * 8192; }
    else { l = 0; L = 256; p0 = (item - 256) * 32; HCdst = (float*)(a.ws + WS_HCC) + 256; }
    LAS float* w1s = (LAS float*)lds; LAS float* w2s = w1s + 33 * 64; LAS float* b1s = w2s + 64 * 64; LAS float* b2s = b1s + 64; LAS float* frs = b2s + 64; LAS float* h2s = frs + 64; LAS float* ex = h2s + 32 * 64;
    { const float* w1 = a.in[I_HW1] + l * 33 * 64; const float* w2 = a.in[I_HW2] + l * 64 * 64;
      for (int i = tid; i < 33 * 64; i += NTHR) w1s[i] = w1[i];
      for (int i = tid; i < 64 * 64; i += NTHR) w2s[i] = w2[i];
      if (tid < 64) { b1s[tid] = a.in[I_HB1][l * 64 + tid]; b2s[tid] = a.in[I_HB2][l * 64 + tid]; frs[tid] = a.in[I_HFREQ][l * 64 + tid]; } }
    __syncthreads();
    const float frq = frs[lane];
#pragma unroll 1
    for (int q = 0; q < 4; ++q) { const int pp = wave * 4 + q, p = p0 + pp; const float tn = (float)p / (float)(L - 1);
        float fv = 0.f;
        if (lane == 0) fv = tn;
        else if (lane <= 32) { const int bi = (lane - 1) & 15; const float band = 1e-4f + (float)bi * ((15.0f - 1e-4f) / 15.0f);
            const float ang = ((float)(6.283185307179586 / (double)L) * (float)p) * band; fv = (lane <= 16) ? cosf(ang) : -sinf(ang); }
        float a1 = b1s[lane];
#pragma unroll
        for (int i = 0; i < 33; ++i) a1 += __builtin_bit_cast(float, __builtin_amdgcn_readlane(__builtin_bit_cast(int, fv), i)) * w1s[i * 64 + lane];
        const float h1 = sinf(frq * a1);
        float a2 = b2s[lane];
#pragma unroll 16
        for (int i = 0; i < 64; ++i) a2 += __builtin_bit_cast(float, __builtin_amdgcn_readlane(__builtin_bit_cast(int, h1), i)) * w2s[i * 64 + lane];
        h2s[lane * 32 + pp] = sinf(frq * a2); }
    __syncthreads();
    const float* w3 = a.in[I_HW3] + (size_t)l * 64 * 1024 + tid;
    float acc0[32], acc1[32];
#pragma unroll
    for (int pp = 0; pp < 32; ++pp) { acc0[pp] = 0.f; acc1[pp] = 0.f; }
#pragma unroll 4
    for (int i = 0; i < 64; ++i) { const float wa = w3[i * 1024], wb = w3[i * 1024 + 512];
#pragma unroll
        for (int q = 0; q < 8; ++q) { const f32x4 h = *(const LAS f32x4*)(h2s + i * 32 + 4 * q);
#pragma unroll
            for (int r = 0; r < 4; ++r) { acc0[4 * q + r] += h[r] * wa; acc1[4 * q + r] += h[r] * wb; } } }
    const int c = tid & 255, dir = tid >> 8; const float dmin = 3.0701134573253945f, dmax = 15.350567286626972f; const float delta = dmin + (float)c * ((dmax - dmin) / 255.0f);
    float* base0 = HCdst; float* base1 = HCdst + (size_t)(2 * L - 1) * 256;
    const bool tr = (L == 4096);
#pragma unroll
    for (int pp = 0; pp < 32; ++pp) { const int p = p0 + pp; const float tn = (float)p / (float)(L - 1); const float win = expf(-tn * delta); const float v0 = acc0[pp] * win, v1 = acc1[pp] * win;
        if (p == 0) { ex[tid] = v0; ex[512 + tid] = v1; }
        else { const int li = dir == 0 ? (L - 1 + p) : (L - 1 - p); const size_t idx = tr ? ((size_t)c * 8192 + li) : ((size_t)li * 256 + c); const size_t o1 = tr ? (size_t)256 * 8192 : (size_t)(2 * L - 1) * 256; base0[idx] = v0; base0[idx + o1] = v1; } }
    __syncthreads();
    if (p0 == 0 && tid < 256) { const size_t idx = tr ? ((size_t)tid * 8192 + (L - 1)) : ((size_t)(L - 1) * 256 + tid); const size_t o1 = tr ? (size_t)256 * 8192 : (size_t)(2 * L - 1) * 256; base0[idx] = ex[tid] + ex[tid + 256]; base0[idx + o1] = ex[512 + tid] + ex[512 + tid + 256]; }
    __syncthreads();
}


typedef int v8i_t __attribute__((ext_vector_type(8)));
__device__ __forceinline__ float st_A(int i, int k) { return (float)(((i * 7 + k * 3) % 5) - 2); }
__device__ __forceinline__ float st_B(int k, int j) { return (float)(((k * 5 + j * 11 + (k >> 4)) % 5) - 2); }
__device__ __forceinline__ void fp8_selftest(unsigned* poison, int lane) {
    const int fr = lane & 15, fq = lane >> 4; v8i_t av, bv;
#pragma unroll
    for (int w = 0; w < 8; ++w) { int pa = 0, pb = 0;
#pragma unroll
        for (int q = 0; q < 4; ++q) { }
        const int kb = (w < 4) ? (16 * fq + 4 * w) : (64 + 16 * fq + 4 * (w - 4));
        pa = __builtin_amdgcn_cvt_pk_fp8_f32(st_A(fr, kb), st_A(fr, kb + 1), pa, false); pa = __builtin_amdgcn_cvt_pk_fp8_f32(st_A(fr, kb + 2), st_A(fr, kb + 3), pa, true);
        pb = __builtin_amdgcn_cvt_pk_fp8_f32(st_B(kb, fr), st_B(kb + 1, fr), pb, false); pb = __builtin_amdgcn_cvt_pk_fp8_f32(st_B(kb + 2, fr), st_B(kb + 3, fr), pb, true);
        av[w] = pa; bv[w] = pb; }
    f32x4 acc = {0.f, 0.f, 0.f, 0.f};
    acc = __builtin_amdgcn_mfma_scale_f32_16x16x128_f8f6f4(av, bv, acc, 0, 0, 0, 0x7f7f7f7f, 0, 0x7f7f7f7f);
    bool bad = false;
#pragma unroll
    for (int r = 0; r < 4; ++r) { float ref = 0.f; for (int k = 0; k < 128; ++k) ref += st_A(4 * fq + r, k) * st_B(k, fr); bad |= (acc[r] != ref); }
    { const float v = (float)(lane * 3 + 1);
      const float r5 = __builtin_bit_cast(float, __builtin_amdgcn_update_dpp(0, __builtin_bit_cast(int, v), 0x150 + 5, 0xf, 0xf, false));
      const float r12 = __builtin_bit_cast(float, __builtin_amdgcn_update_dpp(0, __builtin_bit_cast(int, v), 0x150 + 12, 0xf, 0xf, false));
      bad |= (r5 != (float)(((lane & 48) + 5) * 3 + 1)) || (r12 != (float)(((lane & 48) + 12) * 3 + 1)); }
    if (__any(bad) && lane == 0) __hip_atomic_store(poison, 1u, __ATOMIC_RELAXED, __HIP_MEMORY_SCOPE_AGENT);
}

__device__ __forceinline__ void phase_prologue(const Args& a, unsigned char* ldsg, int vcu, int G) {
    LAS unsigned char* lds = (LAS unsigned char*)ldsg;
    int tid_ = threadIdx.x; asm volatile("" : "+v"(tid_));
    const int tid = tid_, lane = tid & 63, wave = __builtin_amdgcn_readfirstlane(tid >> 6);
    unsigned char* ws = a.ws;
    if (vcu == 2 % G && wave == 0) fp8_selftest((unsigned*)(ws + WS_CTL) + 12288, lane);
    LAS float* sc = (LAS float*)lds; LAS float* red = (LAS float*)(lds + 36864);
    for (int i = tid; i < 9 * 1024; i += NTHR) { const float v = (i < 8192) ? a.in[I_C][i] : a.in[I_CCTX][i - 8192]; sc[i] = v / (1.0f + expf(-v)); }
    __syncthreads();
    { AMP_BEGIN(41)
    float* MOD = (float*)(ws + WS_MOD);
    for (int item = vcu; item < 2 * 96; item += G) {
        const int l = item / 96, n0 = (item % 96) * 64, col = tid & 63, kg = tid >> 6;
        float acc[9];
#pragma unroll
        for (int r = 0; r < 9; ++r) acc[r] = 0.f;
        const float* w = a.in[I_ADAW] + (size_t)l * 1024 * 6144 + n0 + col;
#pragma unroll 4
        for (int k = kg * 128; k < kg * 128 + 128; ++k) { const float wv = w[(size_t)k * 6144];
#pragma unroll
            for (int r = 0; r < 9; ++r) acc[r] += sc[r * 1024 + k] * wv; }
#pragma unroll
        for (int r = 0; r < 9; ++r) red[(kg * 9 + r) * 64 + col] = acc[r];
        __syncthreads();
        for (int o = tid; o < 9 * 64; o += NTHR) { const int r = o >> 6, cc = o & 63; float s = 0.f;
#pragma unroll
            for (int g2 = 0; g2 < 8; ++g2) s += red[(g2 * 9 + r) * 64 + cc];
            MOD[(size_t)(l * 9 + r) * 6144 + n0 + cc] = s + a.in[I_ADAB][l * 6144 + n0 + cc]; }
        __syncthreads();
    }
    AMP_END(41) }
    if (vcu == 0) { float* ROPE = (float*)(ws + WS_ROPE);
        for (int i = tid; i < 1024; i += NTHR) { const int pos = i >> 4, fi = i & 15; const float inv = powf(10000.0f, -(float)fi / 16.0f); const float ang = (float)pos * inv;
            ROPE[2 * i] = cosf(ang); ROPE[2 * i + 1] = sinf(ang); } }
    if (vcu == 1 % G) { float* TW8 = (float*)(ws + WS_TW8);
        for (int i = tid; i < 8192; i += NTHR) { float sn, cs; sincospif(-(float)i * (1.0f / 4096.0f), &sn, &cs); TW8[2 * i] = cs; TW8[2 * i + 1] = sn; } }
    const int gw = vcu * NWAVES + wave, NGW = G * NWAVES;
    { AMP_BEGIN(42)
    for (int it = G - 1 - vcu; it < 264; it += G) filter_item(a, lds, it, tid);
    AMP_END(42) }
    { AMP_BEGIN(43)
    LAS float* scr = (LAS float*)(lds + 65536 + wave * 8448);
    for (int m = gw; m < 96; m += NGW) { const int l = m / 48, which = (m % 48) / 16, e = m & 15; const size_t le = (size_t)l * 16 + e; int lane_ = lane; asm volatile("" : "+v"(lane_));
        const float* W = (which == 0) ? a.in[I_WG] + le * 1024 * 2048 : ((which == 1) ? a.in[I_WU] + le * 1024 * 2048 : a.in[I_WD] + le * 2048 * 1024);
        const f32x4 sv = *(const f32x4*)(W + 4 * lane_); float sm = fmaxf(fmaxf(fabsf(sv[0]), fabsf(sv[1])), fmaxf(fabsf(sv[2]), fabsf(sv[3])));
        sm = wave_max_(sm);
        int E = 0; (void)frexpf(fmaxf(sm, 1e-30f), &E); if (lane_ == 0) ((float*)(ws + WS_WSC))[m] = ldexpf(1.0f, E - 5); }
    constexpr int IT_IN = 16 * 72, IT_OUT = 16 * 32, IT_LAYER = IT_IN + IT_OUT;
    for (int it = gw; it < 2 * IT_LAYER; it += NGW) {
        const int l = it / IT_LAYER; int r = it % IT_LAYER;
        if (r < IT_IN) { tr_item(a.in[I_WIN] + (size_t)l * 1024 * 2304, 1024, 2304, (bf16_t*)(ws + WS_WIN_T) + (size_t)l * 2304 * 1024, 1024, r, 0, scr, lane); continue; } r -= IT_IN;
        tr_item(a.in[I_WOUT] + (size_t)l * 1024 * 1024, 1024, 1024, (bf16_t*)(ws + WS_WOUT_T) + (size_t)l * 1024 * 1024, 1024, r, 0, scr, lane);
    }
    AMP_END(43) }
}

__device__ __forceinline__ void phase_norm_router(const Args& a, unsigned char* ldsg, int vcu, int G, int l, const bf16_t* XB, const float* gain, int nrows) {
    int tid_ = threadIdx.x; asm volatile("" : "+v"(tid_));
    const int tid = tid_, lane = tid & 63, wave = __builtin_amdgcn_readfirstlane(tid >> 6);
    unsigned char* ws = a.ws; asm volatile("" : "+s"(ws)); const float* MOD = (const float*)(ws + WS_MOD) + (size_t)l * 9 * 6144; unsigned char* HX8 = (unsigned char*)(ws + WS_HX);
    LAS unsigned short* rwb = (LAS unsigned short*)(LAS unsigned char*)ldsg;
    { const float* rsrc = a.in[I_ROUTER] + (size_t)l * 1024 * 16; f32x4 rv[8];
#pragma unroll
      for (int k = 0; k < 8; ++k) rv[k] = *(const f32x4*)(rsrc + 4 * (tid + NTHR * k));
#pragma unroll
      for (int k = 0; k < 8; ++k) { const int i4 = tid + NTHR * k, col = i4 >> 2, e0 = (4 * i4) & 15;
#pragma unroll
          for (int q = 0; q < 4; ++q) rwb[(e0 + q) * 1064 + col] = (unsigned short)f2bf(rv[k][q]); }
      __syncthreads(); }
    const int r = lane & 15, kq = lane >> 4; const int gw = vcu * NWAVES + wave, NGW = G * NWAVES; const int ntiles = nrows / 16;
    for (int tile = gw; tile < ntiles; tile += NGW) {
        const int row = tile * 16 + r; const bool lat = row < TX; const int mrow = lat ? (row >> 12) : 8;
        const bf16_t* xr = XB + (size_t)row * D + 8 * kq; const float* shp = MOD + mrow * 6144 + 3 * 1024 + 8 * kq; const float* scp = shp + 1024; const float* gp = gain + 8 * kq;
        float ss = 0.f;
#pragma unroll 1
        for (int s0 = 0; s0 < 32; s0 += 8) { u32x4 w[8];
#pragma unroll
            for (int s = 0; s < 8; ++s) w[s] = *(const u32x4*)(xr + 32 * (s0 + s));
#pragma unroll
            for (int s = 0; s < 8; ++s) { const float v0 = bflo(w[s].x), v1 = bfhi(w[s].x), v2 = bflo(w[s].y), v3 = bfhi(w[s].y), v4 = bflo(w[s].z), v5 = bfhi(w[s].z), v6 = bflo(w[s].w), v7 = bfhi(w[s].w);
                ss += ((v0 * v0 + v1 * v1) + (v2 * v2 + v3 * v3)) + ((v4 * v4 + v5 * v5) + (v6 * v6 + v7 * v7)); } }
        ss += xshfl<16>(ss); ss = xsum32(ss);
        const float rstd = 1.0f / sqrtf(ss * (1.0f / D) + 1e-6f);
        f32x4 acc = {0.f, 0.f, 0.f, 0.f};
        const LAS unsigned short* wb = rwb + r * 1064 + 8 * kq;
#pragma unroll 4
        for (int s = 0; s < 32; ++s) { const u32x4 w = *(const u32x4*)(xr + 32 * s);
            const f32x4 g0 = *(const f32x4*)(gp + 32 * s), g1 = *(const f32x4*)(gp + 32 * s + 4), h0 = *(const f32x4*)(shp + 32 * s), h1 = *(const f32x4*)(shp + 32 * s + 4), c0 = *(const f32x4*)(scp + 32 * s), c1 = *(const f32x4*)(scp + 32 * s + 4);
            float hv[8];
            hv[0] = (bflo(w.x) * rstd * g0[0]) * (1.0f + c0[0]) + h0[0]; hv[1] = (bfhi(w.x) * rstd * g0[1]) * (1.0f + c0[1]) + h0[1]; hv[2] = (bflo(w.y) * rstd * g0[2]) * (1.0f + c0[2]) + h0[2]; hv[3] = (bfhi(w.y) * rstd * g0[3]) * (1.0f + c0[3]) + h0[3];
            hv[4] = (bflo(w.z) * rstd * g1[0]) * (1.0f + c1[0]) + h1[0]; hv[5] = (bfhi(w.z) * rstd * g1[1]) * (1.0f + c1[1]) + h1[1]; hv[6] = (bflo(w.w) * rstd * g1[2]) * (1.0f + c1[2]) + h1[2]; hv[7] = (bfhi(w.w) * rstd * g1[3]) * (1.0f + c1[3]) + h1[3];
            int p0 = 0, p1 = 0;
            p0 = __builtin_amdgcn_cvt_pk_fp8_f32(__builtin_amdgcn_fmed3f(hv[0], -448.f, 448.f), __builtin_amdgcn_fmed3f(hv[1], -448.f, 448.f), p0, false); p0 = __builtin_amdgcn_cvt_pk_fp8_f32(__builtin_amdgcn_fmed3f(hv[2], -448.f, 448.f), __builtin_amdgcn_fmed3f(hv[3], -448.f, 448.f), p0, true);
            p1 = __builtin_amdgcn_cvt_pk_fp8_f32(__builtin_amdgcn_fmed3f(hv[4], -448.f, 448.f), __builtin_amdgcn_fmed3f(hv[5], -448.f, 448.f), p1, false); p1 = __builtin_amdgcn_cvt_pk_fp8_f32(__builtin_amdgcn_fmed3f(hv[6], -448.f, 448.f), __builtin_amdgcn_fmed3f(hv[7], -448.f, 448.f), p1, true);
            typedef int i32x2v __attribute__((ext_vector_type(2)));
            *(i32x2v*)(HX8 + (size_t)row * D + 32 * s + 8 * kq) = (i32x2v){p0, p1};
            u32x4 af; af.x = pk2(hv[0], hv[1]); af.y = pk2(hv[2], hv[3]); af.z = pk2(hv[4], hv[5]); af.w = pk2(hv[6], hv[7]);
            typedef short bf16x8r __attribute__((ext_vector_type(8)));
            const bf16x8r bfr = *(const LAS bf16x8r*)(wb + 32 * s);
            acc = __builtin_amdgcn_mfma_f32_16x16x32_bf16(__builtin_bit_cast(bf16x8r, af), bfr, acc, 0, 0, 0); }
#pragma unroll
        for (int q = 0; q < 4; ++q) { float mx = acc[q]; mx = fmaxf(mx, xshfl<1>(mx)); mx = fmaxf(mx, xshfl<2>(mx)); mx = fmaxf(mx, xshfl<4>(mx)); mx = fmaxf(mx, xshfl<8>(mx));
            const float pe = expf(acc[q] - mx); float den = pe; den += xshfl<1>(den); den += xshfl<2>(den); den += xshfl<4>(den); den += xshfl<8>(den);
            const int orow = tile * 16 + 4 * kq + q;
            ((float*)(ws + WS_AFFT))[(size_t)r * TT + orow] = pe / den; ((int*)(ws + WS_INV))[(size_t)orow * 16 + r] = -1; }
    }
}

__device__ __forceinline__ void phase_norm(const Args& a, unsigned char* ldsg, int vcu, int G, int l, const float* srcx, const float* srcc, const bf16_t* srcb, const float* gain, int shift_idx, int nrows, bool router) {
    int tid_ = threadIdx.x; asm volatile("" : "+v"(tid_));
    const int tid = tid_, lane = tid & 63, wave = __builtin_amdgcn_readfirstlane(tid >> 6);
    unsigned char* ws = a.ws; asm volatile("" : "+s"(ws)); const float* MOD = (const float*)(ws + WS_MOD) + (size_t)l * 9 * 6144; bf16_t* HX = (bf16_t*)(ws + WS_HX);
    LAS float* rw = (LAS float*)(LAS unsigned char*)ldsg;
    if (router) { const float* rsrc = a.in[I_ROUTER] + (size_t)l * 1024 * 16; f32x4 rv[8];
#pragma unroll
        for (int k = 0; k < 8; ++k) rv[k] = *(const f32x4*)(rsrc + 4 * (tid + NTHR * k));
#pragma unroll
        for (int k = 0; k < 8; ++k) { const int i4 = tid + NTHR * k, col = i4 >> 2, e0 = (4 * i4) & 15;
#pragma unroll
            for (int q = 0; q < 4; ++q) rw[(e0 + q) * 1024 + col] = rv[k][q]; }
        __syncthreads(); }
    const int gw = vcu * NWAVES + wave, NGW = G * NWAVES;
    f32x4 nv[2][4];
#define NRM_PRELOAD(ra) do { _Pragma("unroll") for (int u = 0; u < 2; ++u) { const int rr = ((ra) + u * NGW < nrows) ? (ra) + u * NGW : gw; \
            if (srcb) { const bf16_t* xr = srcb + (size_t)rr * D; _Pragma("unroll") for (int j = 0; j < 4; ++j) { const u32x2 w = *(const u32x2*)(xr + 256 * j + 4 * lane); nv[u][j] = (f32x4){bflo(w.x), bfhi(w.x), bflo(w.y), bfhi(w.y)}; } } \
            else { const float* xr = (rr < TX) ? srcx + (size_t)rr * D : srcc + (size_t)(rr - TX) * D; _Pragma("unroll") for (int j = 0; j < 4; ++j) nv[u][j] = *(const f32x4*)(xr + 256 * j + 4 * lane); } } } while (0)
    NRM_PRELOAD(gw);
    for (int rowa = gw; rowa < nrows; rowa += 2 * NGW) {
        f32x4 vv[2][4];
#pragma unroll
        for (int u = 0; u < 2; ++u)
#pragma unroll
            for (int j = 0; j < 4; ++j) vv[u][j] = nv[u][j];
        if (rowa + 2 * NGW < nrows) NRM_PRELOAD(rowa + 2 * NGW);
        f32x4 hv[2][4];
#pragma unroll
        for (int u = 0; u < 2; ++u) { const int row = rowa + u * NGW; if (row < nrows) {
        const bool lat = row < TX; const int mrow = lat ? (row >> 12) : 8;
        const float* shp = MOD + mrow * 6144 + shift_idx * 1024; const float* scp = shp + 1024;
        f32x4 v[4]; float ss = 0.f;
#pragma unroll
        for (int j = 0; j < 4; ++j) { v[j] = vv[u][j]; ss += (v[j][0] * v[j][0] + v[j][1] * v[j][1]) + (v[j][2] * v[j][2] + v[j][3] * v[j][3]); }
        const float rstd = 1.0f / sqrtf(wave_sum(ss) * (1.0f / D) + 1e-6f);
#pragma unroll
        for (int j = 0; j < 4; ++j) { const f32x4 gg = *(const f32x4*)(gain + 256 * j + 4 * lane), sh = *(const f32x4*)(shp + 256 * j + 4 * lane), sc = *(const f32x4*)(scp + 256 * j + 4 * lane);
            v[j] = (v[j] * rstd * gg) * (1.0f + sc) + sh;
            if (router) { int p = 0; p = __builtin_amdgcn_cvt_pk_fp8_f32(fminf(fmaxf(v[j][0], -448.f), 448.f), fminf(fmaxf(v[j][1], -448.f), 448.f), p, false); p = __builtin_amdgcn_cvt_pk_fp8_f32(fminf(fmaxf(v[j][2], -448.f), 448.f), fminf(fmaxf(v[j][3], -448.f), 448.f), p, true);
                *(int*)((unsigned char*)HX + (size_t)row * D + 256 * j + 4 * lane) = p; }
            else { u32x2 o; o.x = pk2(v[j][0], v[j][1]); o.y = pk2(v[j][2], v[j][3]); *(u32x2*)(HX + (size_t)row * D + 256 * j + 4 * lane) = o; } }
#pragma unroll
        for (int j = 0; j < 4; ++j) hv[u][j] = v[j];
        } }
        float plr[2][16];
        if (router) {
#pragma unroll
            for (int e = 0; e < 16; ++e) { float p0 = 0.f, p1 = 0.f;
#pragma unroll
                for (int j = 0; j < 4; ++j) { const f32x4 wv = *(const LAS f32x4*)(rw + e * 1024 + 256 * j + 4 * lane);
                    p0 += (hv[0][j][0] * wv[0] + hv[0][j][1] * wv[1]) + (hv[0][j][2] * wv[2] + hv[0][j][3] * wv[3]);
                    p1 += (hv[1][j][0] * wv[0] + hv[1][j][1] * wv[1]) + (hv[1][j][2] * wv[2] + hv[1][j][3] * wv[3]); }
                plr[0][e] = p0; plr[1][e] = p1; if ((e & 3) == 3) asm volatile("" : "+v"(plr[0][e]), "+v"(plr[1][e]), "+v"(plr[0][e - 1]), "+v"(plr[1][e - 1]), "+v"(plr[0][e - 2]), "+v"(plr[1][e - 2]), "+v"(plr[0][e - 3]), "+v"(plr[1][e - 3]) :: "memory"); } }
#pragma unroll
        for (int u = 0; u < 2; ++u) { const int row = rowa + u * NGW; if (row < nrows) {
        if (router) {
            float pl[16];
#pragma unroll
            for (int e = 0; e < 16; ++e) pl[e] = plr[u][e];
            float q8[8], q4[4], q2[2], q1;
            { const bool up = (lane & 8) != 0;
#pragma unroll
              for (int e = 0; e < 8; ++e) { const float keep = up ? pl[e + 8] : pl[e], give = up ? pl[e] : pl[e + 8]; q8[e] = keep + xshfl<8>(give); } }
            { const bool up = (lane & 4) != 0;
#pragma unroll
              for (int e = 0; e < 4; ++e) { const float keep = up ? q8[e + 4] : q8[e], give = up ? q8[e] : q8[e + 4]; q4[e] = keep + xshfl<4>(give); } }
            { const bool up = (lane & 2) != 0;
#pragma unroll
              for (int e = 0; e < 2; ++e) { const float keep = up ? q4[e + 2] : q4[e], give = up ? q4[e] : q4[e + 2]; q2[e] = keep + xshfl<2>(give); } }
            { const bool up = (lane & 1) != 0; const float keep = up ? q2[1] : q2[0], give = up ? q2[0] : q2[1]; q1 = keep + xshfl<1>(give); }
            q1 += xshfl<16>(q1); q1 = xsum32(q1);
            const float mylog = (lane < 16) ? q1 : -1e30f;
            float mx = mylog;
            mx = fmaxf(mx, xshfl<1>(mx)); mx = fmaxf(mx, xshfl<2>(mx)); mx = fmaxf(mx, xshfl<4>(mx)); mx = fmaxf(mx, xshfl<8>(mx));
            const float mine = (lane < 16) ? expf(mylog - mx) : 0.f; float den = mine;
            den += xshfl<1>(den); den += xshfl<2>(den); den += xshfl<4>(den); den += xshfl<8>(den);
            if (lane < 16) { ((float*)(ws + WS_AFFT))[(size_t)lane * TT + row] = mine / den; ((int*)(ws + WS_INV))[(size_t)row * 16 + lane] = -1; }
        }
    } }
    }
}
#undef NRM_PRELOAD

#define XB_TMO      128
#define XB_XCNT(j)  (256  + 64 * (j))
#define XB_XSUB(j)  (1280 + 64 * (j))
#define XB_XGEN(j)  (2304 + 64 * (j))
#define XB_TOP      3328
#define XB_TOPGEN   3392
#define XCD_BAR_WORDS 3456
#define XB_SPIN_CAP (1u << 18)

__device__ __forceinline__ unsigned xb_ld(unsigned* p)              { return __hip_atomic_load(p, __ATOMIC_RELAXED, __HIP_MEMORY_SCOPE_AGENT); }
__device__ __forceinline__ unsigned xb_add(unsigned* p, unsigned v) { return __hip_atomic_fetch_add(p, v, __ATOMIC_RELAXED, __HIP_MEMORY_SCOPE_AGENT); }
__device__ __forceinline__ unsigned xb_xcc_id() { return (unsigned)__builtin_amdgcn_s_getreg((3 << 11) | 20) & 0xFu; }
#define XB_SPIN(cond, bar) do { unsigned _sp = 0; while (cond) { __builtin_amdgcn_s_sleep(1); \
    if ((++_sp & 255u) == 0u) { if (xb_ld(&(bar)[XB_TMO])) break; if (_sp > XB_SPIN_CAP) { atomicAdd(&(bar)[XB_TMO], 1u); break; } } } } while (0)

struct XcdBarrier {
    unsigned* bar; unsigned x;
    volatile LAS unsigned* st;
};

__device__ __forceinline__ XcdBarrier xcd_barrier_post(unsigned* bar, volatile LAS unsigned* st) {
    XcdBarrier b; b.bar = bar; b.x = xb_xcc_id(); b.st = st;
    if (threadIdx.x == 0) (void)xb_add(&bar[XB_XCNT(b.x)], 1u);
    return b;
}
__device__ __forceinline__ void xcd_barrier_complete(unsigned* bar, unsigned x, unsigned& nloc, unsigned& nx) {
    const unsigned G = gridDim.x * gridDim.y * gridDim.z;
    unsigned sum, cnt, mine, sp = 0u;
    for (;;) {
        sum = 0u; cnt = 0u; mine = 0u;
#pragma unroll
        for (unsigned j = 0; j < 16; ++j) { const unsigned c = xb_ld(&bar[XB_XCNT(j)]); sum += c; cnt += (c > 0u) ? 1u : 0u; mine = (j == x) ? c : mine; }
        if (sum == G) break;
        __builtin_amdgcn_s_sleep(1);
        if ((++sp & 255u) == 0u) { if (xb_ld(&bar[XB_TMO])) break; if (sp > XB_SPIN_CAP) { atomicAdd(&bar[XB_TMO], 1u); break; } }
    }
    nloc = mine > 0u ? mine : 1u; nx = cnt > 0u ? cnt : 1u;
}

__device__ __forceinline__ void xcd_barrier(const XcdBarrier& b) {
    asm volatile("s_waitcnt vmcnt(0)" ::: "memory");
    __syncthreads();
    if (threadIdx.x == 0) {
        unsigned* bar = b.bar;
        __builtin_amdgcn_s_waitcnt(0);
        unsigned nloc = b.st[0], nx = b.st[1];
        if (nloc == 0u) { xcd_barrier_complete(bar, b.x, nloc, nx); b.st[0] = nloc; b.st[1] = nx; }
        const unsigned old = xb_add(&bar[XB_XSUB(b.x)], 1u);
        const unsigned gen = old / nloc;
        if (old + 1u == (gen + 1u) * nloc) {
            __builtin_amdgcn_fence(__ATOMIC_RELEASE, "agent");
            asm volatile("s_waitcnt vmcnt(0)" ::: "memory");
            const unsigned og = xb_add(&bar[XB_TOP], 1u);
            const unsigned tg = og / nx;
            if (og + 1u == (tg + 1u) * nx) xb_add(&bar[XB_TOPGEN], 1u);
            else XB_SPIN(xb_ld(&bar[XB_TOPGEN]) == tg, bar);
            __builtin_amdgcn_fence(__ATOMIC_ACQUIRE, "agent");
            xb_add(&bar[XB_XGEN(b.x)], 1u);
            asm volatile("s_waitcnt vmcnt(0)" ::: "memory");
        } else {
            XB_SPIN(xb_ld(&bar[XB_XGEN(b.x)]) == gen, bar);
            __builtin_amdgcn_fence(__ATOMIC_ACQUIRE, "agent");
            asm volatile("s_waitcnt vmcnt(0)" ::: "memory");
        }
    }
    __syncthreads();
}


typedef float f32x2 __attribute__((ext_vector_type(2)));
__device__ __forceinline__ f32x2 cmul(f32x2 a, f32x2 b) { return (f32x2){a.x * b.x - a.y * b.y, a.x * b.y + a.y * b.x}; }
__device__ __forceinline__ void dft16(f32x2 (&v)[16]) {
    constexpr float WC[8] = {1.0f, 0.92387953251128674f, 0.70710678118654752f, 0.38268343236508977f, 0.0f, -0.38268343236508977f, -0.70710678118654752f, -0.92387953251128674f};
    constexpr float WS[8] = {0.0f, -0.38268343236508977f, -0.70710678118654752f, -0.92387953251128674f, -1.0f, -0.92387953251128674f, -0.70710678118654752f, -0.38268343236508977f};
#pragma unroll
    for (int s = 8; s >= 1; s >>= 1)
#pragma unroll
        for (int i = 0; i < 16; ++i) if ((i & s) == 0) { const int k = (i & (s - 1)) * (8 / s); const f32x2 u = v[i], t = v[i + s]; v[i] = u + t; const f32x2 d = u - t;
            v[i + s] = (k == 0) ? d : ((k == 4) ? (f32x2){d.y, -d.x} : (f32x2){d.x * WC[k] - d.y * WS[k], d.x * WS[k] + d.y * WC[k]}); }
}
__device__ __forceinline__ constexpr int bitrev4(int i) { return ((i & 1) << 3) | ((i & 2) << 1) | ((i & 4) >> 1) | ((i & 8) >> 3); }
template <int NS, int MODE>
__device__ __forceinline__ void fft_pass(LAS f32x2* Z, const LAS f32x2* TW, int tid, const f32x2* H) {
    const int f = tid >> 8, j = tid & 255, base = f * 4096, k = j & (NS - 1);
    f32x2 v[16];
#pragma unroll
    for (int r = 0; r < 16; ++r) { const int idx = base + j + 256 * r; v[r] = Z[idx + (idx >> 4)]; }
    if (MODE == 1) {
#pragma unroll
        for (int r = 0; r < 16; ++r) { const f32x2 p = cmul(v[r], H[r]); v[r] = (f32x2){p.y, p.x}; } }
    if (NS > 1) { const LAS f32x2* tp = (NS == 16) ? (TW + 8192 + k) : (TW + 4096 + k);
#pragma unroll
        for (int r = 1; r < 16; ++r) v[r] = cmul(v[r], tp[r * NS]); }
    dft16(v);
    if (NS != 256) __syncthreads();
    const int j0 = base + (j / NS) * NS * 16 + k;
#pragma unroll
    for (int rr = 0; rr < 16; ++rr) { const int idx = j0 + rr * NS; Z[idx + (idx >> 4)] = v[bitrev4(rr)]; }
    __syncthreads();
}
__device__ __forceinline__ void load_uc(const bf16_t* UT, const float* cw, const float* cb, int ch, int b, int tid, float (&out)[8]) {
    const bf16_t* p = UT + ((size_t)(b * 768 + ch)) * 4096 + 8 * tid;
    const u32x4 w = *(const u32x4*)p; float u[10];
    u[1] = bflo(w.x); u[2] = bfhi(w.x); u[3] = bflo(w.y); u[4] = bfhi(w.y); u[5] = bflo(w.z); u[6] = bfhi(w.z); u[7] = bflo(w.w); u[8] = bfhi(w.w);
    u[0] = (tid > 0) ? bf2f(p[-1]) : 0.f; u[9] = (tid < 511) ? bf2f(p[8]) : 0.f;
    const float w0 = cw[ch], w1 = cw[768 + ch], w2 = cw[1536 + ch], bb = cb[ch];
#pragma unroll
    for (int i = 0; i < 8; ++i) out[i] = u[i] * w0 + u[i + 1] * w1 + u[i + 2] * w2 + bb;
}
__device__ __forceinline__ void hy_fill(LAS f32x2* Z, const LAS f32x2* TW, int tid, const float (&va)[8], const float (&vb)[8]) {
#pragma unroll
    for (int i = 0; i < 8; ++i) { const int t = 8 * tid + i; const f32x2 z = {va[i], vb[i]}; Z[t + (t >> 4)] = z; const int t2 = 4096 + t; Z[t2 + (t2 >> 4)] = cmul(z, TW[t]); }
    __syncthreads();
}
__device__ __forceinline__ void hy_conv(LAS f32x2* Z, const LAS f32x2* TW, int tid, const f32x2* Hg) {
    f32x2 H[16];
    { const int f = tid >> 8, j = tid & 255, base = f * 4096;
#pragma unroll
      for (int r = 0; r < 16; ++r) H[r] = Hg[base + j + 256 * r]; }
    fft_pass<1, 0>(Z, TW, tid, nullptr); fft_pass<16, 0>(Z, TW, tid, nullptr); fft_pass<256, 0>(Z, TW, tid, nullptr);
    fft_pass<1, 1>(Z, TW, tid, H); fft_pass<16, 0>(Z, TW, tid, nullptr); fft_pass<256, 0>(Z, TW, tid, nullptr);
}
__device__ __forceinline__ f32x2 hy_out(const LAS f32x2* Z, const LAS f32x2* TW, int t) {
    const f32x2 se = Z[t + (t >> 4)]; const int t2 = 4096 + t; const f32x2 so = Z[t2 + (t2 >> 4)]; const f32x2 tw = TW[t];
    const f32x2 So = {so.y, so.x};
    return (f32x2){se.y + (So.x * tw.x + So.y * tw.y), se.x + (So.y * tw.x - So.x * tw.y)};
}
__device__ __forceinline__ void hyena_item(const Args& a, LAS unsigned char* lds, int l, int c, int bp, int tid) {
    asm volatile("" : "+v"(tid));
    LAS f32x2* Z = (LAS f32x2*)lds; const LAS f32x2* TW = (const LAS f32x2*)(lds + 69632);
    const bf16_t* UT = (const bf16_t*)(a.ws + WS_UT); bf16_t* YT = (bf16_t*)(a.ws + WS_YT);
    const float* cw = a.in[I_HCW] + (size_t)l * 3 * 768; const float* cb = a.in[I_HCB] + (size_t)l * 768; const float* skip = a.in[I_HSKIP] + (size_t)l * 2 * 256;
    const f32x2* HS = (const f32x2*)(a.ws + WS_HS) + ((size_t)(l * 2) * 256 + c) * 8192;
    const int b0 = 2 * bp, b1 = 2 * bp + 1;
    float va[8], vb[8], xa[8], xb[8];
    load_uc(UT, cw, cb, c, b0, tid, va); load_uc(UT, cw, cb, c, b1, tid, vb);
    hy_fill(Z, TW, tid, va, vb);
    hy_conv(Z, TW, tid, HS);
    load_uc(UT, cw, cb, 256 + c, b0, tid, xa); load_uc(UT, cw, cb, 256 + c, b1, tid, xb);
    { const float sk = skip[c];
#pragma unroll
      for (int i = 0; i < 8; ++i) { const f32x2 y = hy_out(Z, TW, 8 * tid + i); va[i] = xa[i] * (y.x + va[i] * sk); vb[i] = xb[i] * (y.y + vb[i] * sk); } }
    __syncthreads();
    hy_fill(Z, TW, tid, va, vb);
    hy_conv(Z, TW, tid, HS + (size_t)256 * 8192);
    load_uc(UT, cw, cb, 512 + c, b0, tid, xa); load_uc(UT, cw, cb, 512 + c, b1, tid, xb);
    { const float sk = skip[256 + c];
      float oa[8], ob[8];
#pragma unroll
      for (int i = 0; i < 8; ++i) { const f32x2 y = hy_out(Z, TW, 8 * tid + i); oa[i] = xa[i] * (y.x + va[i] * sk); ob[i] = xb[i] * (y.y + vb[i] * sk); }
      u32x4 wa, wb; wa.x = pk2(oa[0], oa[1]); wa.y = pk2(oa[2], oa[3]); wa.z = pk2(oa[4], oa[5]); wa.w = pk2(oa[6], oa[7]); wb.x = pk2(ob[0], ob[1]); wb.y = pk2(ob[2], ob[3]); wb.z = pk2(ob[4], ob[5]); wb.w = pk2(ob[6], ob[7]);
      *(u32x4*)(YT + ((size_t)(b0 * 256 + c)) * 4096 + 8 * tid) = wa; *(u32x4*)(YT + ((size_t)(b1 * 256 + c)) * 4096 + 8 * tid) = wb; }
    __syncthreads();
}
__device__ __forceinline__ void spectrum_item(const Args& a, LAS unsigned char* lds, int item, int tid) {
    asm volatile("" : "+v"(tid));
    LAS f32x2* Z = (LAS f32x2*)lds; const LAS f32x2* TW = (const LAS f32x2*)(lds + 69632);
    const int c = item & 255, lo = item >> 8;
    const float* HC = (const float*)(a.ws + WS_HC) + ((size_t)lo * 256 + c) * 8192;
    { const f32x4 hl0 = *(const f32x4*)(HC + 4095 + 8 * tid), hl1 = *(const f32x4*)(HC + 4095 + 8 * tid + 4);
      float hlv[8] = {hl0[0], hl0[1], hl0[2], hl0[3], hl1[0], hl1[1], hl1[2], hl1[3]}; float hhv[8];
#pragma unroll
      for (int i = 0; i < 8; ++i) { const int t = 8 * tid + i; hhv[i] = (t == 0) ? 0.f : HC[t - 1]; }
#pragma unroll
      for (int i = 0; i < 8; ++i) { const int t = 8 * tid + i; const float hl = hlv[i], hh = hhv[i];
        Z[t + (t >> 4)] = (f32x2){hl + hh, 0.f}; const int t2 = 4096 + t; const f32x2 tw = TW[t]; const float dd = hl - hh; Z[t2 + (t2 >> 4)] = (f32x2){dd * tw.x, dd * tw.y}; } }
    __syncthreads();
    fft_pass<1, 0>(Z, TW, tid, nullptr); fft_pass<16, 0>(Z, TW, tid, nullptr); fft_pass<256, 0>(Z, TW, tid, nullptr);
    f32x2* HS = (f32x2*)(a.ws + WS_HS) + (size_t)item * 8192;
#pragma unroll
    for (int i = 0; i < 16; ++i) { const int idx = tid + 512 * i; HS[idx] = Z[idx + (idx >> 4)] * (1.0f / 8192.0f); }
    __syncthreads();
}
__device__ __forceinline__ void load_tw(const Args& a, LAS unsigned char* lds, int tid) {
    asm volatile("" : "+v"(tid));
    LAS f32x2* TW = (LAS f32x2*)(lds + 69632); const f32x2* src = (const f32x2*)(a.ws + WS_TW8);
    for (int i = tid; i < 4096; i += NTHR) { TW[i] = src[i]; const int r = i >> 8, k = i & 255; TW[4096 + i] = src[r * k * 2]; }
    if (tid < 256) { const int r = tid >> 4, k = tid & 15; TW[8192 + tid] = src[r * k * 32]; }
    __syncthreads();
}
__device__ __forceinline__ float ctx_uc(const bf16_t* PXc, const float* cw, const float* cb, int ch, int t) {
    const float u1 = bf2f(PXc[(size_t)t * INW + ch]); const float u0 = (t > 0) ? bf2f(PXc[(size_t)(t - 1) * INW + ch]) : 0.f; const float u2 = (t < 255) ? bf2f(PXc[(size_t)(t + 1) * INW + ch]) : 0.f;
    return u0 * cw[ch] + u1 * cw[768 + ch] + u2 * cw[1536 + ch] + cb[ch];
}
__device__ __forceinline__ void ctx_conv16(const LAS float* IN, const float* H, int c, int lane, int t0, float (&acc)[16]) {
    float w[16];
    const float* hp = H + (size_t)(t0 + 255) * 256 + c;
#pragma unroll
    for (int i = 0; i < 16; ++i) { acc[i] = 0.f; w[i] = hp[i * 256]; }
    const LAS float* ip = IN + lane;
#pragma unroll 1
    for (int s0 = 0; s0 < 256; s0 += 16) {
#pragma unroll
        for (int u = 0; u < 16; ++u) { const float v = ip[u * 64];
#pragma unroll
            for (int i = 0; i < 16; ++i) acc[i] += v * w[(i - u + 16) & 15];
            w[(15 - u) & 15] = hp[-(u + 1) * 256]; }
        hp -= 16 * 256; ip += 16 * 64; }
}
__device__ __forceinline__ void ctx_hyena_item(const Args& a, LAS unsigned char* lds, int l, int item, int tid) {
    asm volatile("" : "+v"(tid));
    const int lane = tid & 63, wave = tid >> 6, b = item >> 2, c = (item & 3) * 64 + lane;
    LAS float* V = (LAS float*)lds; LAS float* Z1 = (LAS float*)(lds + 65536);
    const bf16_t* PXc = (const bf16_t*)(a.ws + WS_PX) + (size_t)(TX + b * 256) * INW; bf16_t* Y = (bf16_t*)(a.ws + WS_Y) + (size_t)(TX + b * 256) * D;
    const float* cw = a.in[I_HCW] + (size_t)l * 3 * 768; const float* cb = a.in[I_HCB] + (size_t)l * 768; const float* skip = a.in[I_HSKIP] + (size_t)l * 2 * 256;
    const float* H0 = (const float*)(a.ws + WS_HCC) + 256, *H1 = H0 + (size_t)511 * 256;
#pragma unroll 2
    for (int i = 0; i < 32; ++i) { const int t = wave * 32 + i; V[t * 64 + lane] = ctx_uc(PXc, cw, cb, c, t); }
    __syncthreads();
    float acc[16];
#pragma unroll 1
    for (int g = 0; g < 2; ++g) { const int t0 = wave * 32 + g * 16; ctx_conv16(V, H0, c, lane, t0, acc); const float sk = skip[c];
#pragma unroll
        for (int i = 0; i < 16; ++i) { const int t = t0 + i; Z1[t * 64 + lane] = ctx_uc(PXc, cw, cb, 256 + c, t) * (acc[i] + V[t * 64 + lane] * sk); } }
    __syncthreads();
#pragma unroll 1
    for (int g = 0; g < 2; ++g) { const int t0 = wave * 32 + g * 16; ctx_conv16(Z1, H1, c, lane, t0, acc); const float sk = skip[256 + c];
#pragma unroll
        for (int i = 0; i < 16; ++i) { const int t = t0 + i; Y[(size_t)t * D + c] = (bf16_t)f2bf(ctx_uc(PXc, cw, cb, 512 + c, t) * (acc[i] + Z1[t * 64 + lane] * sk)); } }
    __syncthreads();
}

__device__ __forceinline__ void ytr_item(const Args& a, LAS unsigned char* tile, int item, int lane) {
    const int b = item >> 8, tt = (item >> 2) & 63, ct = item & 3;
    const bf16_t* src = (const bf16_t*)(a.ws + WS_YT) + ((size_t)(b * 256 + ct * 64)) * 4096 + tt * 64; bf16_t* Y = (bf16_t*)(a.ws + WS_Y) + ((size_t)b * 4096 + tt * 64) * D + ct * 64;
    u32x4 v[8];
#pragma unroll
    for (int i = 0; i < 8; ++i) v[i] = *(const u32x4*)(src + (size_t)((lane >> 3) + 8 * i) * 4096 + (lane & 7) * 8);
#pragma unroll
    for (int i = 0; i < 8; ++i) *(LAS u32x4*)(tile + ((lane >> 3) + 8 * i) * 144 + (lane & 7) * 16) = v[i];
    LDS_WAIT();
    const LAS unsigned short* tp = (const LAS unsigned short*)(tile + lane * 2);
#pragma unroll
    for (int q = 0; q < 8; ++q) { u32x4 o;
        o.x = (unsigned)tp[(8 * q + 0) * 72] | ((unsigned)tp[(8 * q + 1) * 72] << 16); o.y = (unsigned)tp[(8 * q + 2) * 72] | ((unsigned)tp[(8 * q + 3) * 72] << 16);
        o.z = (unsigned)tp[(8 * q + 4) * 72] | ((unsigned)tp[(8 * q + 5) * 72] << 16); o.w = (unsigned)tp[(8 * q + 6) * 72] | ((unsigned)tp[(8 * q + 7) * 72] << 16);
        *(u32x4*)(Y + (size_t)lane * D + 8 * q) = o; }
    LDS_WAIT();
}
__device__ __forceinline__ void event_arrive(unsigned* ctr) {
    asm volatile("s_waitcnt vmcnt(0)" ::: "memory"); __syncthreads();
    if (threadIdx.x == 0) { __builtin_amdgcn_fence(__ATOMIC_RELEASE, "agent"); asm volatile("s_waitcnt vmcnt(0)" ::: "memory"); __hip_atomic_fetch_add(ctr, 1u, __ATOMIC_RELAXED, __HIP_MEMORY_SCOPE_AGENT); }
}
__device__ __forceinline__ void event_wait(unsigned* ctr, unsigned want) {
    if (threadIdx.x == 0) { unsigned sp = 0;
        while (__hip_atomic_load(ctr, __ATOMIC_RELAXED, __HIP_MEMORY_SCOPE_AGENT) < want) { __builtin_amdgcn_s_sleep(2); if (++sp > (1u << 22)) break; }
        __builtin_amdgcn_fence(__ATOMIC_ACQUIRE, "agent"); asm volatile("s_waitcnt vmcnt(0)" ::: "memory"); }
    __syncthreads();
}

typedef short bf16x8_t __attribute__((ext_vector_type(8)));
typedef short s16x4_t __attribute__((ext_vector_type(4)));
typedef float f32x16 __attribute__((ext_vector_type(16)));
__device__ __forceinline__ int crow(int r, int hi) { return (r & 3) + 8 * (r >> 2) + 4 * hi; }
__device__ __forceinline__ unsigned cvtpk(float lo, float hi) { f32x2 v = {lo, hi}; bf16x2_t b = __builtin_convertvector(v, bf16x2_t); return __builtin_bit_cast(unsigned, b); }
__device__ __forceinline__ s16x4_t vtr(const LAS unsigned char* p) { return __builtin_bit_cast(s16x4_t, __builtin_amdgcn_ds_read_tr16_b64_v4i16((LAS s16x4_t*)p)); }
constexpr int AT_K = 0, AT_V = 16384, AT_WSF = 32768, AT_OST = 34816, AT_RPB = 67584, AT_END = 69632;
template <int KIND>
__device__ __forceinline__ void attn_unit(const Args& a, LAS unsigned char* lds, int l, int u, int wave_, CvtStream& cs, int cstride) {
    int lane = (int)__builtin_amdgcn_mbcnt_hi(~0u, __builtin_amdgcn_mbcnt_lo(~0u, 0u)); asm volatile("" : "+v"(lane));
    const int wid = wave_, tid = wave_ * 64 + lane, r32 = lane & 31, hi = lane >> 5;
    const bf16_t* PX = (const bf16_t*)(a.ws + WS_PX); bf16_t* Y = (bf16_t*)(a.ws + WS_Y);
    int b, qcol, kcol, vcol, ycol, qrow0, nloc = 0, lo = 0; bool sink = false; int hsink = 0;
    int qpos0 = 0, blk = 0, rq = 0, cbase = 0, rq4 = 0;
    if (KIND == 0) { b = u >> 6; const int kvh = (u >> 5) & 1; blk = u & 31; const int h = 2 * kvh + (wid >> 2); qpos0 = blk * 128 + 32 * (wid & 3); qrow0 = b * 4096 + qpos0;
        qcol = 1024 + h * 64; kcol = 1536 + kvh * 64; vcol = 1664 + kvh * 64; ycol = 256 + h * 64; lo = (blk == 0) ? 2 : 0; nloc = ((blk == 31) ? 3 : 5) - lo + 1; sink = true; hsink = h; }
    else if (KIND == 1) { b = u >> 6; const int h = (u >> 4) & 3; rq4 = u & 15; rq = 4 * rq4 + (wid >> 1); cbase = 32 * (wid & 1); qrow0 = b * 4096 + rq * 64 + cbase;
        qcol = 1280 + h * 64; kcol = 1792 + h * 64; vcol = 2048 + h * 64; ycol = 768 + h * 64;
        const int ra = 4 * rq4 - 4, rb = 4 * rq4 + 3 - 4; lo = ra < 0 ? 0 : (ra > 56 ? 56 : ra); const int hi_r = (rb < 0 ? 0 : (rb > 56 ? 56 : rb)) + 7; nloc = hi_r - lo + 1;
        LAS float* rpbL = (LAS float*)(lds + AT_RPB); const float* src = a.in[I_RPB] + (size_t)(l * 4 + h) * 465;
        for (int i = tid; i < 465; i += NTHR) rpbL[i] = src[i] * 8.0f; }
    else { b = u >> 3; const int h = (u >> 1) & 3; qrow0 = TX + b * 256 + 32 * wid;
        if ((u & 1) == 0) { qcol = 1024 + h * 64; kcol = 1536 + (h >> 1) * 64; vcol = 1664 + (h >> 1) * 64; ycol = 256 + h * 64; sink = true; hsink = h; }
        else { qcol = 1280 + h * 64; kcol = 1792 + h * 64; vcol = 2048 + h * 64; ycol = 768 + h * 64; } }
    const int NT = nloc + 4;
    bf16x8_t qr[4];
    { const bf16_t* qp = PX + (size_t)(qrow0 + r32) * INW + qcol + hi * 8;
#pragma unroll
      for (int d0 = 0; d0 < 4; ++d0) qr[d0] = *(const bf16x8_t*)(qp + d0 * 16); }
    const int krow = 8 * wid + (lane & 7), kchunk = lane >> 3; const int vrow = 16 * (wid & 3) + (lane >> 2), vcoff = (wid >> 2) * 32 + (lane & 3) * 8;
    const int kdst = AT_K + kchunk * 1024 + krow * 16, vdst = AT_V + wid * 1024 + lane * 16;
    auto tile_row0 = [&](int t) -> int { if (t < nloc) { if (KIND == 0) return b * 4096 + blk * 128 - 128 + 64 * (lo + t); else return b * 4096 + (lo + t) * 64; } return TX + b * 256 + 64 * (t - nloc); };
    u32x4 gk0, gv0, gk1, gv1;
#define AT_LOAD(GK, GV, t_) do { const int R0_ = tile_row0(t_); GK = *(const u32x4*)(PX + (size_t)(R0_ + krow) * INW + kcol + kchunk * 8); GV = *(const u32x4*)(PX + (size_t)(R0_ + vrow) * INW + vcol + vcoff); } while (0)
    AT_LOAD(gk0, gv0, 0);
    if (NT > 1) AT_LOAD(gk1, gv1, 1); else { gk1 = gk0; gv1 = gv0; }
    *(LAS u32x4*)(lds + kdst) = gk0; *(LAS u32x4*)(lds + vdst) = gv0;
    float mhat = -1e30f, l_reg = 0.f; f32x16 o[2];
#pragma unroll
    for (int r = 0; r < 16; ++r) { o[0][r] = 0.f; o[1][r] = 0.f; }
    LAS float* wsf = (LAS float*)(lds + AT_WSF) + wid * 64;
    const LAS unsigned char* vb0 = lds + AT_V + ((lane >> 4) & 1) * 32 + (lane & 3) * 8 + (4 * hi + ((lane & 15) >> 2)) * 64;
    const LAS unsigned char* kb0 = lds + AT_K + hi * 1024 + r32 * 16;
    __syncthreads();
    auto step = [&](int t, u32x4& gkw, u32x4& gvw, u32x4& gkl, u32x4& gvl) __attribute__((always_inline)) {
        const int bufo = (t & 1) * 8192;
        cvt_issue(a, cs, lane);
        if (t + 2 < NT) AT_LOAD(gkl, gvl, t + 2);
        bool need = true; bool full = true; int ts = 0, rk = 0;
        if (t < nloc) {
            if (KIND == 0) { ts = blk * 128 - 128 + 64 * (lo + t); need = (ts + 63 >= qpos0 - 128) && (ts <= qpos0 + 31 + 128); full = (qpos0 + 31 - ts <= 128) && (ts + 63 - qpos0 <= 128); }
            if (KIND == 1) { rk = lo + t; const int r0 = (rq - 4) < 0 ? 0 : ((rq - 4) > 56 ? 56 : (rq - 4)); need = (rk >= r0) && (rk <= r0 + 7); full = false; }
        }
        if (need) {
            f32x16 p0, p1;
#pragma unroll
            for (int r = 0; r < 16; ++r) { p0[r] = 0.f; p1[r] = 0.f; }
            const LAS unsigned char* kb = kb0 + bufo;
#pragma unroll
            for (int d0 = 0; d0 < 4; ++d0) { const bf16x8_t k0 = *(const LAS bf16x8_t*)(kb + d0 * 2048), k1 = *(const LAS bf16x8_t*)(kb + d0 * 2048 + 512);
                p0 = __builtin_amdgcn_mfma_f32_32x32x16_bf16(k0, qr[d0], p0, 0, 0, 0); p1 = __builtin_amdgcn_mfma_f32_32x32x16_bf16(k1, qr[d0], p1, 0, 0, 0); }
            constexpr float C2 = 0.125f * LOG2E;
            if (!full) {
                if (KIND == 0) { const int tq = qpos0 + r32;
#pragma unroll
                    for (int r = 0; r < 16; ++r) { const int k0 = ts + crow(r, hi), d0 = tq - k0, d1 = d0 - 32; p0[r] = (d0 > 128 || d0 < -128) ? -INFINITY : p0[r]; p1[r] = (d1 > 128 || d1 < -128) ? -INFINITY : p1[r]; } }
                if (KIND == 1) { const int c = cbase + r32; const int wsc = (c - 8) < 0 ? 0 : ((c - 8) > 48 ? 48 : (c - 8)); const LAS float* rp = (const LAS float*)(lds + AT_RPB) + (rk - rq + 7) * 31 + 15 - c;
                    { float b0[16];
#pragma unroll
                      for (int r = 0; r < 16; ++r) { const int c0 = crow(r, hi); const int i0 = c0 < wsc ? wsc : (c0 > wsc + 15 ? wsc + 15 : c0); b0[r] = rp[i0]; }
#pragma unroll
                      for (int r = 0; r < 16; ++r) { const int c0 = crow(r, hi); const bool ok0 = (c0 >= wsc) && (c0 < wsc + 16); p0[r] = ok0 ? p0[r] + b0[r] : -INFINITY; } }
                    asm volatile("" : "+v"(p0) :: "memory");
                    { float b1[16];
#pragma unroll
                      for (int r = 0; r < 16; ++r) { const int c1 = crow(r, hi) + 32; const int i1 = c1 < wsc ? wsc : (c1 > wsc + 15 ? wsc + 15 : c1); b1[r] = rp[i1]; }
#pragma unroll
                      for (int r = 0; r < 16; ++r) { const int c1 = crow(r, hi) + 32; const bool ok1 = (c1 >= wsc) && (c1 < wsc + 16); p1[r] = ok1 ? p1[r] + b1[r] : -INFINITY; } } }
            }
            float rm = fmaxf(p0[0], p1[0]);
#pragma unroll
            for (int r = 1; r < 16; ++r) rm = fmaxf(rm, fmaxf(p0[r], p1[r]));
            { auto rr = __builtin_amdgcn_permlane32_swap(__float_as_uint(rm), __float_as_uint(rm), false, false); rm = fmaxf(__uint_as_float(rr[0]), __uint_as_float(rr[1])); }
            const float mnew = fmaxf(mhat, rm); const float f = __builtin_amdgcn_exp2f((mhat - mnew) * C2); const bool grew = mnew > mhat; mhat = mnew;
            const float nm = -mnew * C2; float sacc = 0.f;
#pragma unroll
            for (int r = 0; r < 16; ++r) { p0[r] = __builtin_amdgcn_exp2f(fmaf(p0[r], C2, nm)); p1[r] = __builtin_amdgcn_exp2f(fmaf(p1[r], C2, nm)); sacc += p0[r] + p1[r]; }
            l_reg = l_reg * f + sacc;
            if (__any(grew)) { if (hi == 0) wsf[r32] = f; LDS_WAIT();
#pragma unroll
                for (int r = 0; r < 16; ++r) { const float fr_ = wsf[crow(r, hi)]; o[0][r] *= fr_; o[1][r] *= fr_; }
                LDS_WAIT(); }
            u32x4 pw0, pw1, pw2, pw3;
            pw0 = (u32x4){cvtpk(p0[0], p0[1]), cvtpk(p0[2], p0[3]), cvtpk(p0[4], p0[5]), cvtpk(p0[6], p0[7])}; pw1 = (u32x4){cvtpk(p0[8], p0[9]), cvtpk(p0[10], p0[11]), cvtpk(p0[12], p0[13]), cvtpk(p0[14], p0[15])};
            pw2 = (u32x4){cvtpk(p1[0], p1[1]), cvtpk(p1[2], p1[3]), cvtpk(p1[4], p1[5]), cvtpk(p1[6], p1[7])}; pw3 = (u32x4){cvtpk(p1[8], p1[9]), cvtpk(p1[10], p1[11]), cvtpk(p1[12], p1[13]), cvtpk(p1[14], p1[15])};
            const LAS unsigned char* vb = vb0 + bufo;
#pragma unroll
            for (int d0 = 0; d0 < 2; ++d0) {
#pragma unroll
                for (int ks = 0; ks < 4; ++ks) { const s16x4_t vl = vtr(vb + d0 * 4096 + ks * 1024), vh = vtr(vb + d0 * 4096 + ks * 1024 + 512);
                    const bf16x8_t vf = (bf16x8_t){vl[0], vl[1], vl[2], vl[3], vh[0], vh[1], vh[2], vh[3]};
                    const bf16x8_t pa = __builtin_bit_cast(bf16x8_t, ks == 0 ? pw0 : (ks == 1 ? pw1 : (ks == 2 ? pw2 : pw3)));
                    o[d0] = __builtin_amdgcn_mfma_f32_32x32x16_bf16(pa, vf, o[d0], 0, 0, 0); } }
        }
        cvt_finish(a, cs, (LAS float*)(lds + 73728) + wid * 2112, lane, cstride);
        if (t + 1 < NT) { const int nb = ((t + 1) & 1) * 8192; *(LAS u32x4*)(lds + kdst + nb) = gkw; *(LAS u32x4*)(lds + vdst + nb) = gvw; }
        __syncthreads();
    };
    for (int t = 0; t < NT; t += 2) { step(t, gk1, gv1, gk0, gv0); if (t + 1 < NT) step(t + 1, gk0, gv0, gk1, gv1); }
#undef AT_LOAD
    { auto rr = __builtin_amdgcn_permlane32_swap(__float_as_uint(l_reg), __float_as_uint(l_reg), false, false); l_reg = __uint_as_float(rr[0]) + __uint_as_float(rr[1]); }
    if (sink) l_reg += __builtin_amdgcn_exp2f(a.in[I_SINK][l * 4 + hsink] * LOG2E - mhat * (0.125f * LOG2E));
    if (hi == 0) wsf[32 + r32] = 1.0f / l_reg;
    LDS_WAIT();
    LAS bf16_t* stg = (LAS bf16_t*)(lds + AT_OST) + wid * 2048;
#pragma unroll
    for (int r = 0; r < 16; ++r) { const int orow = crow(r, hi); const float il = wsf[32 + orow];
        stg[orow * 64 + r32] = (bf16_t)f2bf(o[0][r] * il); stg[orow * 64 + 32 + r32] = (bf16_t)f2bf(o[1][r] * il); }
    LDS_WAIT();
#pragma unroll
    for (int i = 0; i < 4; ++i) { const int row = i * 8 + (lane >> 3), ch = lane & 7; const u32x4 v = *(const LAS u32x4*)(stg + row * 64 + ch * 8);
        *(u32x4*)(Y + (size_t)(qrow0 + row) * D + ycol + ch * 8) = v; }
    __syncthreads();
}


template <int HW>
__device__ __forceinline__ void pool_tile(const bf16_t* PX, bf16_t* Y, const float* pscale, int tile, int g, int lane, const bf16x8_t (&wf)[4][2]) {
    const int tk = lane & 15, oc = lane >> 4; const int row = tile * 16 + tk; const bool lat = row < TX; const int tpos = lat ? (row & 4095) : ((row - TX) & 255); const int Ls = lat ? 4096 : 256;
    const bf16_t* pr = PX + (size_t)row * INW + 768 + g * 64 + 8 * oc;
    u32x4 w0[2 * HW], w1[2 * HW];
#pragma unroll
    for (int i = 0; i < 2 * HW; ++i) { const int off = i - HW; const int tp = tpos + off; const bool inr = (tp >= 0) && (tp < Ls); const bf16_t* p = pr + (ptrdiff_t)(inr ? off : 0) * INW; w0[i] = *(const u32x4*)p; w1[i] = *(const u32x4*)(p + 32); }
    float s0[8], s1[8]; int cnt = 0;
#pragma unroll
    for (int j = 0; j < 8; ++j) { s0[j] = 0.f; s1[j] = 0.f; }
#pragma unroll
    for (int i = 0; i < 2 * HW; ++i) { const int tp = tpos + i - HW; const bool in = (tp >= 0) && (tp < Ls); const float m = in ? 1.0f : 0.0f; cnt += in ? 1 : 0;
        s0[0] += m * bflo(w0[i].x); s0[1] += m * bfhi(w0[i].x); s0[2] += m * bflo(w0[i].y); s0[3] += m * bfhi(w0[i].y); s0[4] += m * bflo(w0[i].z); s0[5] += m * bfhi(w0[i].z); s0[6] += m * bflo(w0[i].w); s0[7] += m * bfhi(w0[i].w);
        s1[0] += m * bflo(w1[i].x); s1[1] += m * bfhi(w1[i].x); s1[2] += m * bflo(w1[i].y); s1[3] += m * bfhi(w1[i].y); s1[4] += m * bflo(w1[i].z); s1[5] += m * bfhi(w1[i].z); s1[6] += m * bflo(w1[i].w); s1[7] += m * bfhi(w1[i].w); }
    const float ic = 1.0f / (float)cnt; const u32x4 c0 = w0[HW], c1 = w1[HW];
    const float u0[8] = {bflo(c0.x), bfhi(c0.x), bflo(c0.y), bfhi(c0.y), bflo(c0.z), bfhi(c0.z), bflo(c0.w), bfhi(c0.w)}, u1[8] = {bflo(c1.x), bfhi(c1.x), bflo(c1.y), bfhi(c1.y), bflo(c1.z), bfhi(c1.z), bflo(c1.w), bfhi(c1.w)};
    u32x4 d0, d1;
    d0.x = cvtpk(s0[0] * ic - u0[0], s0[1] * ic - u0[1]); d0.y = cvtpk(s0[2] * ic - u0[2], s0[3] * ic - u0[3]); d0.z = cvtpk(s0[4] * ic - u0[4], s0[5] * ic - u0[5]); d0.w = cvtpk(s0[6] * ic - u0[6], s0[7] * ic - u0[7]);
    d1.x = cvtpk(s1[0] * ic - u1[0], s1[1] * ic - u1[1]); d1.y = cvtpk(s1[2] * ic - u1[2], s1[3] * ic - u1[3]); d1.z = cvtpk(s1[4] * ic - u1[4], s1[5] * ic - u1[5]); d1.w = cvtpk(s1[6] * ic - u1[6], s1[7] * ic - u1[7]);
    const bf16x8_t b0 = __builtin_bit_cast(bf16x8_t, d0), b1 = __builtin_bit_cast(bf16x8_t, d1);
    bf16_t* yr = Y + (size_t)row * D + 512 + g * 64 + 4 * oc;
#pragma unroll
    for (int nt = 0; nt < 4; ++nt) { f32x4 acc = {0.f, 0.f, 0.f, 0.f};
        acc = __builtin_amdgcn_mfma_f32_16x16x32_bf16(wf[nt][0], b0, acc, 0, 0, 0); acc = __builtin_amdgcn_mfma_f32_16x16x32_bf16(wf[nt][1], b1, acc, 0, 0, 0);
        const f32x4 sc = *(const f32x4*)(pscale + g * 64 + 16 * nt + 4 * oc); acc *= sc;
        u32x2 ov; ov.x = cvtpk(acc[0], acc[1]); ov.y = cvtpk(acc[2], acc[3]); *(u32x2*)(yr + 16 * nt) = ov; }
}
__device__ __forceinline__ void phase_mix1(const Args& a, unsigned char* ldsg, int vcu, int G, int l) {
    LAS unsigned char* lds = (LAS unsigned char*)ldsg;
    int tid_ = threadIdx.x; asm volatile("" : "+v"(tid_));
    const int tid = tid_, lane = tid & 63, wave = __builtin_amdgcn_readfirstlane(tid >> 6);
    unsigned char* ws = a.ws; asm volatile("" : "+s"(ws)); const bf16_t* PX = (const bf16_t*)(ws + WS_PX); bf16_t* Y = (bf16_t*)(ws + WS_Y);
    const bool upd = (l == 0); const int nrows = upd ? TT : TX;
    const int gw = vcu * NWAVES + wave, NGW = G * NWAVES;
    { AMP_BEGIN(31) load_tw(a, lds, tid);
    for (int it = vcu; it < 1024; it += G) hyena_item(a, lds, l, it >> 2, it & 3, tid);
    if (upd) for (int it = vcu; it < 32; it += G) ctx_hyena_item(a, lds, l, it, tid);
    event_arrive((unsigned*)(ws + WS_CTL) + 8192 + 64 * l); AMP_END(31) }
    { AMP_BEGIN(32)
    { const int g = gw & 3; const float* pwg = a.in[I_POOLW] + (size_t)(l * 4 + g) * 4096; const float* pscale = a.in[I_POOLS] + (size_t)l * 256;
      bf16x8_t wf[4][2];
#pragma unroll
      for (int nt = 0; nt < 4; ++nt)
#pragma unroll
          for (int ks = 0; ks < 2; ++ks) { const float* wp = pwg + (size_t)(32 * ks + 8 * (lane >> 4)) * 64 + 16 * nt + (lane & 15); u32x4 w;
              w.x = cvtpk(wp[0], wp[64]); w.y = cvtpk(wp[128], wp[192]); w.z = cvtpk(wp[256], wp[320]); w.w = cvtpk(wp[384], wp[448]); wf[nt][ks] = __builtin_bit_cast(bf16x8_t, w); }
      const int ntiles = nrows / 16;
      for (int it = gw; it < ntiles * 4; it += NGW) { const int tile = it >> 2;
          if (g == 0) pool_tile<1>(PX, Y, pscale, tile, g, lane, wf); else if (g == 1) pool_tile<2>(PX, Y, pscale, tile, g, lane, wf); else if (g == 2) pool_tile<4>(PX, Y, pscale, tile, g, lane, wf); else pool_tile<8>(PX, Y, pscale, tile, g, lane, wf); } }
    __syncthreads(); AMP_END(32) }
    { AMP_BEGIN(33)
    CvtStream cs; cs.it = upd ? gw : CVT_ITEMS; cs.end = CVT_ITEMS; cs.live = 0;
    for (int u = vcu; u < 512; u += G) attn_unit<0>(a, lds, l, u, wave, cs, NGW);
    for (int u = vcu; u < 512; u += G) attn_unit<1>(a, lds, l, u, wave, cs, NGW);
    if (upd) for (int u = (vcu + G - 64 % G) % G; u < 64; u += G) attn_unit<2>(a, lds, l, u, wave, cs, NGW);
    int lane2 = (int)__builtin_amdgcn_mbcnt_hi(~0u, __builtin_amdgcn_mbcnt_lo(~0u, 0u)); asm volatile("" : "+v"(lane2));
    while (cs.it < cs.end) { cvt_issue(a, cs, lane2); cvt_finish(a, cs, (LAS float*)(lds + 73728) + wave * 2112, lane2, NGW); }
    AMP_END(33) }
    { AMP_BEGIN(34) event_wait((unsigned*)(ws + WS_CTL) + 8192 + 64 * l, (unsigned)G);
      int lane3 = (int)__builtin_amdgcn_mbcnt_hi(~0u, __builtin_amdgcn_mbcnt_lo(~0u, 0u)); asm volatile("" : "+v"(lane3));
      for (int it = gw; it < 2048; it += NGW) ytr_item(a, lds + wave * 9216, it, lane3); AMP_END(34) }
}

__device__ __forceinline__ void phase_select(const Args& a, unsigned char* ldsg, int vcu, int G, bool with_ctx) {
    LAS unsigned* keys = (LAS unsigned*)(LAS unsigned char*)ldsg;
    LAS unsigned* hist = keys + 4096;
    LAS unsigned* ctl = hist + 256 + 64;
    int tid_ = threadIdx.x; asm volatile("" : "+v"(tid_));
    const int tid = tid_, lane = tid & 63; unsigned char* ws = a.ws; asm volatile("" : "+s"(ws));
    const float* AFFT = (const float*)(ws + WS_AFFT); int* ROWMAP = (int*)(ws + WS_ROWMAP); float* GATE = (float*)(ws + WS_GATE); int* INV = (int*)(ws + WS_INV);
    const int nitems = 128 + (with_ctx ? 128 : 0);
    for (int item = vcu; item < nitems; item += G) {
        int e, base, Ls, cap, slot0;
        if (item < 128) { const int b = item >> 4; e = item & 15; base = b * 4096; Ls = 4096; cap = CAPX; slot0 = b * CAPX; }
        else { const int it = item - 128; const int b = it >> 4; e = it & 15; base = TX + b * 256; Ls = 256; cap = CAPC; slot0 = NB * CAPX + b * CAPC; }
        unsigned k[8];
#pragma unroll
        for (int i = 0; i < 8; ++i) { const int idx = tid + NTHR * i; k[i] = (idx < Ls) ? __float_as_uint(AFFT[(size_t)e * TT + base + idx]) : 0u; if (idx < Ls) keys[idx] = k[i]; }
        if (tid == 0) { ctl[0] = 0u; ctl[1] = (unsigned)cap; ctl[2] = 0u; ctl[3] = 0u; }
        unsigned prefix = 0u;
#pragma unroll 1
        for (int p = 0; p < 4; ++p) { const int shift = 24 - 8 * p;
            if (tid < 256) hist[tid] = 0u;
            __syncthreads();
#pragma unroll
            for (int i = 0; i < 8; ++i) { const int idx = tid + NTHR * i; const bool cand = (idx < Ls) && (p == 0 || (k[i] >> (shift + 8)) == prefix);
                if (cand) atomicAdd((unsigned*)&hist[(k[i] >> shift) & 255u], 1u); }
            __syncthreads();
            if (tid < 64) {
                const unsigned need = ctl[1];
                const unsigned c0 = hist[255 - 4 * lane], c1 = hist[254 - 4 * lane], c2 = hist[253 - 4 * lane], c3 = hist[252 - 4 * lane];
                const unsigned s = c0 + c1 + c2 + c3;
                hist[256 + lane] = s; LDS_WAIT();
                unsigned inc = 0u;
                for (int q = 0; q < 64; ++q) { const unsigned v = hist[256 + q]; inc += (q <= lane) ? v : 0u; }
                const unsigned exc = inc - s;
                if (exc < need && inc >= need) { unsigned above = exc; int d;
                    if (above + c0 >= need) d = 255 - 4 * lane; else { above += c0; if (above + c1 >= need) d = 254 - 4 * lane; else { above += c1; if (above + c2 >= need) d = 253 - 4 * lane; else { above += c2; d = 252 - 4 * lane; } } }
                    ctl[0] = (prefix << 8) | (unsigned)d; ctl[1] = need - above; } }
            __syncthreads();
            prefix = ctl[0]; }
        const unsigned T = prefix; const unsigned need = ctl[1];
        int eqc = 0;
#pragma unroll
        for (int i = 0; i < 8; ++i) { const int idx = tid + NTHR * i; eqc += ((idx < Ls) && k[i] == T) ? 1 : 0; }
        if (eqc) atomicAdd((unsigned*)&ctl[3], (unsigned)eqc);
        __syncthreads();
        const bool all_eq = (ctl[3] == need);
#pragma unroll
        for (int i = 0; i < 8; ++i) { const int idx = tid + NTHR * i;
            if (idx < Ls && (k[i] > T || (all_eq && k[i] == T))) { const int s = (int)atomicAdd((unsigned*)&ctl[2], 1u); const int slot = e * SLOTS + slot0 + s;
                ROWMAP[slot] = base + idx; GATE[slot] = __uint_as_float(k[i]); INV[(size_t)(base + idx) * 16 + e] = slot; } }
        __syncthreads();
        if (!all_eq && tid == 0) {
            int s = (int)ctl[2]; unsigned left = need;
            for (int idx = 0; idx < Ls && left; ++idx) if (keys[idx] == T) { const int slot = e * SLOTS + slot0 + s; ROWMAP[slot] = base + idx; GATE[slot] = __uint_as_float(T); INV[(size_t)(base + idx) * 16 + e] = slot; ++s; --left; } }
        __syncthreads();
    }
}
__device__ __forceinline__ void phase_combine(const Args& a, int vcu, int G, int l, bool with_ctx, bool final_norm, bool next_norm) {
    int tid_ = threadIdx.x; asm volatile("" : "+v"(tid_));
    const int tid = tid_, lane = tid & 63, wave = __builtin_amdgcn_readfirstlane(tid >> 6); unsigned char* ws = a.ws; asm volatile("" : "+s"(ws));
    const int* INV = (const int*)(ws + WS_INV); const unsigned char* OB = (const unsigned char*)(ws + WS_XG);   const float* MOD = (const float*)(ws + WS_MOD) + (size_t)l * 9 * 6144;
    const float* MODN = (const float*)(ws + WS_MOD) + (size_t)(l + 1) * 9 * 6144; const float* gainn = a.in[I_N1G] + (l + 1) * D; bf16_t* HX = (bf16_t*)(ws + WS_HX);
    bf16_t* XB = (bf16_t*)(ws + WS_XB); const float* fng = a.in[I_FNG];
    const int nrows = with_ctx ? TT : TX; const int gw = vcu * NWAVES + wave, NGW = G * NWAVES;
    const float pz = (final_norm && __hip_atomic_load((unsigned*)(ws + WS_CTL) + 12288, __ATOMIC_RELAXED, __HIP_MEMORY_SCOPE_AGENT) != 0u) ? __builtin_nanf("") : 0.f;
    int ninv[2]; u32x2 nx[2][4];
#define CMB_PRELOAD(ra) do { _Pragma("unroll") for (int u = 0; u < 2; ++u) { const int row_ = (ra) + u * NGW; const bool ok_ = row_ < nrows; const int rr_ = ok_ ? row_ : gw; \
            ninv[u] = (lane < 16 && ok_) ? INV[(size_t)rr_ * 16 + lane] : -1; const bf16_t* xr_ = XB + (size_t)rr_ * D; \
            _Pragma("unroll") for (int j = 0; j < 4; ++j) nx[u][j] = *(const u32x2*)(xr_ + 256 * j + 4 * lane); } } while (0)
    CMB_PRELOAD(gw);
    for (int rowa = gw; rowa < nrows; rowa += 2 * NGW) {
        int myinv[2]; f32x4 xv[2][4]; f32x4 acc[2][4];
#pragma unroll
        for (int u = 0; u < 2; ++u) { myinv[u] = ninv[u];
#pragma unroll
            for (int j = 0; j < 4; ++j) { const u32x2 w = nx[u][j]; xv[u][j] = (f32x4){bflo(w.x), bfhi(w.x), bflo(w.y), bfhi(w.y)}; acc[u][j] = (f32x4){0.f, 0.f, 0.f, 0.f}; } }
        if (rowa + 2 * NGW < nrows) CMB_PRELOAD(rowa + 2 * NGW);
#pragma unroll
        for (int u = 0; u < 2; ++u) {
            unsigned long long mask = __ballot(myinv[u] >= 0) & 0xffffull;
            while (mask) { int sl[4];
#pragma unroll
                for (int q = 0; q < 4; ++q) { if (mask) { const int e = __builtin_ctzll(mask); mask &= mask - 1; sl[q] = __builtin_amdgcn_readlane(myinv[u], e); } else sl[q] = -1; }
                int w[4][4];
#pragma unroll
                for (int q = 0; q < 4; ++q) { const unsigned char* orow = OB + (size_t)(sl[q] >= 0 ? sl[q] : 0) * D;
#pragma unroll
                    for (int j = 0; j < 4; ++j) w[q][j] = *(const int*)(orow + 256 * j + 4 * lane); }
#pragma unroll
                for (int q = 0; q < 4; ++q) { const float m = (sl[q] >= 0) ? 1.0f : 0.0f;
#pragma unroll
                    for (int j = 0; j < 4; ++j) { acc[u][j][0] += m * __builtin_amdgcn_cvt_f32_fp8(w[q][j], 0); acc[u][j][1] += m * __builtin_amdgcn_cvt_f32_fp8(w[q][j], 1); acc[u][j][2] += m * __builtin_amdgcn_cvt_f32_fp8(w[q][j], 2); acc[u][j][3] += m * __builtin_amdgcn_cvt_f32_fp8(w[q][j], 3); } } } }
#pragma unroll
        for (int u = 0; u < 2; ++u) { const int row = rowa + u * NGW; if (row < nrows) {
            const bool lat = row < TX; float* xr = a.out + (size_t)row * D; bf16_t* xbr = XB + (size_t)row * D; const int mrow = lat ? (row >> 12) : 8;
            const float* gp = MOD + mrow * 6144 + 5 * 1024; f32x4 v[4]; float ss = 0.f;
#pragma unroll
            for (int j = 0; j < 4; ++j) { const f32x4 g = *(const f32x4*)(gp + 256 * j + 4 * lane); v[j] = xv[u][j] + g * acc[u][j];
                ss += (v[j][0] * v[j][0] + v[j][1] * v[j][1]) + (v[j][2] * v[j][2] + v[j][3] * v[j][3]); }
            if (final_norm) { const float rstd = 1.0f / sqrtf(wave_sum(ss) * (1.0f / D) + 1e-6f);
#pragma unroll
                for (int j = 0; j < 4; ++j) { const f32x4 g = *(const f32x4*)(fng + 256 * j + 4 * lane); *(f32x4*)(xr + 256 * j + 4 * lane) = v[j] * rstd * g + pz; } }
            else {
#pragma unroll
                for (int j = 0; j < 4; ++j) { u32x2 o; o.x = pk2(v[j][0], v[j][1]); o.y = pk2(v[j][2], v[j][3]); *(u32x2*)(xbr + 256 * j + 4 * lane) = o; }
                if (next_norm) { const float rstd = 1.0f / sqrtf(wave_sum(ss) * (1.0f / D) + 1e-6f); const float* shp = MODN + mrow * 6144; const float* scp = shp + 1024;
#pragma unroll
                    for (int j = 0; j < 4; ++j) { const f32x4 gg = *(const f32x4*)(gainn + 256 * j + 4 * lane), sh = *(const f32x4*)(shp + 256 * j + 4 * lane), sc = *(const f32x4*)(scp + 256 * j + 4 * lane);
                        const f32x4 hv = (v[j] * rstd * gg) * (1.0f + sc) + sh; u32x2 o; o.x = pk2(hv[0], hv[1]); o.y = pk2(hv[2], hv[3]); *(u32x2*)(HX + (size_t)row * D + 256 * j + 4 * lane) = o; } } } } }
    }
}
#undef CMB_PRELOAD

#define XBAR() do { XcdBarrier b_; b_.bar = (unsigned*)(a.ws + WS_CTL); b_.x = __builtin_amdgcn_readfirstlane(bar.x); b_.st = (volatile LAS unsigned*)((LAS unsigned char*)lds + LDS_BYTES - 16); xcd_barrier(b_); if (AMP_PHASE == 99) xcd_barrier(b_); } while (0)

__global__ void __launch_bounds__(NTHR, 2) fwd_kernel(Args a) {
    extern __shared__ __attribute__((aligned(16))) unsigned char lds[];
    cg::grid_group grid = cg::this_grid();
    const int G = gridDim.x, bx = blockIdx.x; const int vcu = (G % 8 == 0) ? (bx % 8) * (G / 8) + bx / 8 : bx;
    unsigned char* ws = a.ws;
    PG8_LAS unsigned char* glds = (PG8_LAS unsigned char*)lds;
    volatile LAS unsigned* bst = (volatile LAS unsigned*)((LAS unsigned char*)lds + LDS_BYTES - 16);
    if (threadIdx.x < 4) bst[threadIdx.x] = 0u;
    __syncthreads();
    XcdBarrier bar = xcd_barrier_post((unsigned*)(ws + WS_CTL), bst);
    { AMP_BEGIN(0) phase_prologue(a, lds, vcu, G); AMP_END(0) }
    if (a.ws == nullptr) grid.sync();
    XBAR();
    for (int l = 0; l < 2; ++l) {
        const bool upd = (l == 0);
        asm volatile("" : "+s"(ws));
        const float* srcx = a.in[I_X]; const float* srcc = a.in[I_CTX];
        if (upd) {
            { AMP_BEGIN(1) phase_norm(a, lds, vcu, G, l, srcx, srcc, nullptr, a.in[I_N1G] + l * D, 0, TT, false); AMP_END(1) }
            { AMP_BEGIN(11) load_tw(a, (LAS unsigned char*)lds, threadIdx.x); for (int it = vcu; it < 1024; it += G) spectrum_item(a, (LAS unsigned char*)lds, it, threadIdx.x); AMP_END(11) }
            XBAR();
        }
        { AMP_BEGIN(2) pg8::Gemm g{(const pg8::bf16_t*)(ws + WS_HX), (const pg8::bf16_t*)(ws + WS_WIN_T) + (size_t)l * INW * D, TT, INW, D};
          pg8::GroupOrder S; S.init(1, TT / 256, INW / 256, 0, G, bx);
          { PG8_LAS float* rl = (PG8_LAS float*)(glds + 131072 + 20480); const float* rs = (const float*)(ws + WS_ROPE); int tx = threadIdx.x; asm volatile("" : "+v"(tx)); for (int i = tx; i < 2048; i += NTHR) rl[i] = rs[i]; __syncthreads(); }
          pg8::EpiIn E{(pg8::bf16_t*)(ws + WS_PX), (const PG8_LAS float*)(glds + 131072 + 20480), (pg8::bf16_t*)(ws + WS_UT), glds + 131072, 1.0f};
          pg8::gemm_phase<pg8::EpiIn, pg8::GroupOrder, true, true>(glds, g, S, E); AMP_END(2) }
        XBAR();
        { AMP_BEGIN(3) phase_mix1(a, lds, vcu, G, l); AMP_END(3) }
        XBAR();
        { AMP_BEGIN(4) pg8::Gemm g{(const pg8::bf16_t*)(ws + WS_Y), (const pg8::bf16_t*)(ws + WS_WOUT_T) + (size_t)l * D * D, TT, D, D};
          pg8::GroupOrder S; S.init(1, (upd ? TT : TX) / 256, D / 256, 0, G, bx);
          pg8::EpiOut E{a.in[I_X], a.in[I_CTX], (pg8::bf16_t*)(ws + WS_XB), (const float*)(ws + WS_MOD) + (size_t)l * 9 * 6144, upd ? 1 : 0};
          pg8::gemm_phase<pg8::EpiOut, pg8::GroupOrder, true, true>(glds, g, S, E); AMP_END(4) }
        XBAR();
        { AMP_BEGIN(5) phase_norm_router(a, lds, vcu, G, l, (const bf16_t*)(ws + WS_XB), a.in[I_N2G] + l * D, upd ? TT : TX); AMP_END(5) }
        XBAR();
        { AMP_BEGIN(6) phase_select(a, lds, vcu, G, upd); AMP_END(6) }
        XBAR();
        { AMP_BEGIN(8) pg8::Gemm g{(const pg8::bf16_t*)(ws + WS_HX), (const pg8::bf16_t*)(ws + WS_WGU_T + (size_t)l * NE * 4096 * D), NE * SLOTS, NE * 4096, D};
          pg8::GroupOrder S; S.init(NE, upd ? 17 : 16, 16, 17, G, bx);
          { PG8_LAS float* sl = (PG8_LAS float*)(glds + 131072 + 17408); const float* ss = (const float*)(ws + WS_WSC) + l * 48; int tx = threadIdx.x; asm volatile("" : "+v"(tx)); if (tx < 32) sl[tx] = ss[tx]; __syncthreads(); }
          pg8::EpiGU E{(unsigned char*)(ws + WS_ACT), (const PG8_LAS float*)(glds + 131072 + 17408)};
          pg8::gemm_phase_gather<pg8::EpiGU, pg8::GroupOrder, true>(glds, g, (const int*)(ws + WS_ROWMAP), (PG8_LAS int*)(glds + 131072), S, E); AMP_END(8) }
        XBAR();
        { AMP_BEGIN(9) pg8::Gemm g{(const pg8::bf16_t*)(ws + WS_ACT), (const pg8::bf16_t*)(ws + WS_WD_T + (size_t)l * NE * D * FF), NE * SLOTS, NE * D, FF};
          pg8::GroupOrder S; S.init(NE, upd ? 17 : 16, 4, 17, G, bx);
          { PG8_LAS float* gl = (PG8_LAS float*)(glds + 131072); const float* gs = (const float*)(ws + WS_GATE); const float* ss = (const float*)(ws + WS_WSC) + l * 48 + 32; pg8::Unit uu; int tx = threadIdx.x; asm volatile("" : "+v"(tx));
            for (int i = 0; S.next(i, uu); ++i) if (tx < 256) gl[i * 256 + tx] = gs[uu.pm * 256 + tx] * ss[uu.pn >> 2];
            __syncthreads(); }
          pg8::EpiDown E{(unsigned char*)(ws + WS_XG), (const PG8_LAS float*)(glds + 131072)};
          pg8::gemm_phase<pg8::EpiDown, pg8::GroupOrder, true, true, true>(glds, g, S, E); AMP_END(9) }
        XBAR();
        { AMP_BEGIN(10) phase_combine(a, vcu, G, l, upd, !upd, upd); AMP_END(10) }
        if (upd) XBAR();
    }
}

extern "C" void kernel_launch(void* const* d_in, const int* in_sizes, int n_in, void* d_out, int out_size, void* d_ws, size_t ws_size, hipStream_t stream) {
    static int grid = 0;
    if (grid == 0) {
        int dev = 0, cus = 0, per_cu = 0;
        hipGetDevice(&dev); hipDeviceGetAttribute(&cus, hipDeviceAttributeMultiprocessorCount, dev);
        if (hipFuncSetAttribute((const void*)fwd_kernel, hipFuncAttributeMaxDynamicSharedMemorySize, LDS_BYTES) != hipSuccess) { fprintf(stderr, "kernel_launch: hipFuncSetAttribute failed\n"); grid = -1; return; }
        if (hipOccupancyMaxActiveBlocksPerMultiprocessor(&per_cu, (const void*)fwd_kernel, NTHR, LDS_BYTES) != hipSuccess || per_cu < 1) { fprintf(stderr, "kernel_launch: occupancy query failed (%d)\n", per_cu); grid = -1; return; }
        grid = cus * 1;
        if (n_in != N_IN || ws_size < WS_END) { fprintf(stderr, "kernel_launch: unexpected n_in %d / ws %zu\n", n_in, ws_size); grid = -1; return; }
    }
    if (grid < 0) return;
    if (hipMemsetAsync((char*)d_ws + WS_CTL, 0, 65536, stream) != hipSuccess) { fprintf(stderr, "kernel_launch: memset failed\n"); return; }
    Args a{};
    for (int i = 0; i < N_IN; ++i) a.in[i] = (const float*)d_in[i];
    a.out = (float*)d_out; a.ws = (unsigned char*)d_ws;
    void* args[] = {&a};
    hipError_t e = hipLaunchCooperativeKernel((const void*)fwd_kernel, dim3(grid), dim3(NTHR), args, LDS_BYTES, stream);
    if (e != hipSuccess) fprintf(stderr, "cooperative launch failed: %s (grid %d)\n", hipGetErrorString(e), grid);
}
```

```cpp
#define AMP_PHASE -1
#include <hip/hip_runtime.h>
#include <hip/hip_cooperative_groups.h>
#include <cstdio>
#include <cstdint>
#ifndef AMP_PHASE
#define AMP_PHASE -1
#endif
namespace cg = cooperative_groups;
namespace pg8 {
#define PG8_LAS __attribute__((address_space(3)))
typedef unsigned short bf16_t;
typedef short bf16x8 __attribute__((ext_vector_type(8)));
typedef float f32x4 __attribute__((ext_vector_type(4)));
typedef unsigned u32x4 __attribute__((ext_vector_type(4)));
typedef int v4i_t __attribute__((ext_vector_type(4)));
typedef int v8i_t __attribute__((ext_vector_type(8)));
constexpr int BM = 256, BK = 64, HALF = 128, HTB = HALF * BK * 2  , STAGE_BYTES = 8 * HTB, NXCD = 8, WGM = 8;

__host__ __device__ __forceinline__ int lds_byte(int r, int c) { const int st = (r >> 4) * 2 + (c >> 5), rr = r & 15, cc = c & 31, ob = rr * 64 + cc * 2; return st * 1024 + (ob ^ (((ob >> 9) & 1) << 5)); }
__host__ __device__ __forceinline__ void stage_rc(int b, int& R, int& C) { const int st = b / 1024, sb = b % 1024, swz = sb ^ (((sb >> 9) & 1) << 5); R = (st >> 1) * 16 + swz / 64; C = (st & 1) * 32 + (swz % 64) / 2; }
__host__ __device__ __forceinline__ int perm32(int rho) { const int n = rho >> 4, i = rho & 15; return 8 * (i >> 2) + 4 * n + (i & 3); }

struct Unit { int pm, pn; };
__device__ __forceinline__ int tid_of(int wv) { int l_; asm volatile("v_mbcnt_lo_u32_b32 %0, -1, 0\n\tv_mbcnt_hi_u32_b32 %0, -1, %0" : "=v"(l_)); return wv * 64 + l_; }
struct Gemm { const bf16_t* A; const bf16_t* Bt; int M, N, K, wv; };

struct StaticOrder {
    int nM, nN, nwg, G, c;
    __host__ __device__ void init(int M, int N, int G_, int c_) { nM = M / BM; nN = N / BM; nwg = nM * nN; G = G_; c = c_; }
    __host__ __device__ bool next(int i, Unit& u) const {
        const long L = (long)i * G + c; if (L >= nwg) return false;
        int wgid = (int)L; { const int q = nwg / NXCD, r = nwg % NXCD, xcd = wgid % NXCD, off = wgid / NXCD; wgid = (xcd < r ? xcd * (q + 1) : r * (q + 1) + (xcd - r) * q) + off; }
        const int nig = WGM * nN, gid = wgid / nig, fm = gid * WGM, gsz = (nM - fm) < WGM ? (nM - fm) : WGM;
        u.pm = fm + ((wgid % nig) % gsz); u.pn = (wgid % nig) / gsz; return true;
    }
    __device__ __forceinline__ void a_ready(const Unit&) const {}
    __device__ __forceinline__ void done(const Unit&) const {}
};

__device__ __forceinline__ unsigned cvt_pk_bf16(float lo, float hi) { unsigned r; asm volatile("v_cvt_pk_bf16_f32 %0, %1, %2" : "=v"(r) : "v"(lo), "v"(hi)); return r; }
typedef float f32x2 __attribute__((ext_vector_type(2)));
__device__ __forceinline__ f32x2 gelu_pk(f32x2 v) {
    const f32x2 av = __builtin_elementwise_abs(v), d = av * 0.2316418882f + 1.0f;
    f32x2 t; t.x = __builtin_amdgcn_rcpf(d.x); t.y = __builtin_amdgcn_rcpf(d.y);
    f32x2 q = t * 0.5307027145f + (-0.7265760135f); q = q * t + 0.7107068705f; q = q * t + (-0.142248368f); q = q * t + 0.127414796f; q = q * t;
    const f32x2 s = (v * v) * (-0.72134752044f);
    f32x2 e; e.x = __builtin_amdgcn_exp2f(s.x); e.y = __builtin_amdgcn_exp2f(s.y);
    const f32x2 m = v * (q * e), r = v - m;
    f32x2 o; o.x = v.x < 0.f ? m.x : r.x; o.y = v.y < 0.f ? m.y : r.y; return o;
}


struct GroupOrder {
    int nMl, nNl, strideM, nper, nwg, G, c, pm0;
    __device__ __forceinline__ void init(int ng, int nMl_, int nNl_, int strideM_, int G_, int c_, int pm0_ = 0) { nMl = nMl_; nNl = nNl_; strideM = strideM_; nper = nMl_ * nNl_; nwg = ng * nper; G = G_; c = c_; pm0 = pm0_; }
    __device__ __forceinline__ bool next(int i, Unit& u) const {
        const long L = (long)i * G + c; if (L >= nwg) return false;
        int wgid = (int)L; { const int q = nwg / NXCD, r = nwg % NXCD, xcd = wgid % NXCD, off = wgid / NXCD; wgid = (xcd < r ? xcd * (q + 1) : r * (q + 1) + (xcd - r) * q) + off; }
        const int e = wgid / nper, id = wgid % nper;
        const int nig = WGM * nNl, gid = id / nig, fm = gid * WGM, gsz = (nMl - fm) < WGM ? (nMl - fm) : WGM;
        u.pm = pm0 + e * strideM + fm + ((id % nig) % gsz); u.pn = e * nNl + (id % nig) / gsz; return true;
    }
    __device__ __forceinline__ void a_ready(const Unit&) const {}
    __device__ __forceinline__ void done(const Unit&) const {}
};

constexpr int TXR = 32768;
struct EpiIn {
    static constexpr bool PERM = true, AFTER_DRAIN = false;
    bf16_t* PX; const PG8_LAS float* rope; bf16_t* UT; PG8_LAS unsigned char* stgbase; float wsc;
    __device__ __forceinline__ void operator()(const f32x4 (&acc)[2][2][4][2], const Unit& u, int ui, int wr, int wc, int fr, int fq) const {
        const int row0 = u.pm * BM + wr * 64 + fr; const int col0 = u.pn * BM + wc * 32 + 8 * fq;
        const bool latent = u.pm < (TXR / BM);
        if (latent && u.pn < 3) {
            PG8_LAS unsigned char* stg = stgbase + (wr * 4 + wc) * 2304; const int lane = fq * 16 + fr;
            const int b = u.pm >> 4, trow0 = (u.pm & 15) * BM; const int col = lane >> 1, half = lane & 1;
#pragma unroll
            for (int ai = 0; ai < 2; ++ai)
#pragma unroll
                for (int bj = 0; bj < 2; ++bj)
#pragma unroll
                    for (int mh = 0; mh < 2; ++mh) {
#pragma unroll
                        for (int mm = 0; mm < 2; ++mm)
#pragma unroll
                            for (int n = 0; n < 2; ++n) { const f32x4 v = acc[ai][bj][2 * mh + mm][n]; const unsigned w0 = cvt_pk_bf16(v[0], v[1]), w1 = cvt_pk_bf16(v[2], v[3]);
                                PG8_LAS unsigned char* p = stg + (8 * fq + 4 * n) * 72 + (16 * mm + fr) * 2;
                                *(PG8_LAS unsigned short*)(p) = (unsigned short)w0; *(PG8_LAS unsigned short*)(p + 72) = (unsigned short)(w0 >> 16);
                                *(PG8_LAS unsigned short*)(p + 144) = (unsigned short)w1; *(PG8_LAS unsigned short*)(p + 216) = (unsigned short)(w1 >> 16); }
                        asm volatile("s_waitcnt lgkmcnt(0)" ::: "memory");
                        typedef unsigned u32x2v __attribute__((ext_vector_type(2)));
                        const PG8_LAS unsigned char* rp = stg + col * 72 + half * 32;
                        const u32x2v a0 = *(const PG8_LAS u32x2v*)(rp), a1 = *(const PG8_LAS u32x2v*)(rp + 8), a2 = *(const PG8_LAS u32x2v*)(rp + 16), a3 = *(const PG8_LAS u32x2v*)(rp + 24);
                        const int ch = u.pn * BM + bj * HALF + wc * 32 + col; const int t0 = trow0 + ai * HALF + wr * 64 + mh * 32 + half * 16;
                        u32x4* gp = (u32x4*)(UT + ((size_t)(b * 768 + ch)) * 4096 + t0);
                        gp[0] = (u32x4){a0.x, a0.y, a1.x, a1.y}; gp[1] = (u32x4){a2.x, a2.y, a3.x, a3.y};
                        asm volatile("s_waitcnt lgkmcnt(0)" ::: "memory"); }
            return;
        }
#pragma unroll
        for (int ai = 0; ai < 2; ++ai)
#pragma unroll
            for (int m = 0; m < 4; ++m) { const int row = row0 + ai * HALF + m * 16; bf16_t* rowp = PX + (size_t)row * 2304 + col0;
#pragma unroll
                for (int bj = 0; bj < 2; ++bj) { f32x4 v0 = acc[ai][bj][m][0], v1 = acc[ai][bj][m][1];
                    const bool dorope = latent && (u.pn == 4 || (u.pn == 6 && bj == 0));
                    if (dorope) {
                        const int t = row & 4095; const int pos = (wc & 1) ? (t & 63) : (t >> 6);
                        const PG8_LAS f32x4* rp = (const PG8_LAS f32x4*)(rope + (pos * 16 + 8 * (fq & 1)) * 2);
                        const f32x4 r0 = rp[0], r1 = rp[1], r2 = rp[2], r3 = rp[3];
                        f32x4 p0, p1;
#pragma unroll
                        for (int j = 0; j < 4; ++j) { auto r0_ = __builtin_amdgcn_permlane32_swap(__float_as_uint(v0[j]), __float_as_uint(v0[j]), false, false); auto r1_ = __builtin_amdgcn_permlane32_swap(__float_as_uint(v1[j]), __float_as_uint(v1[j]), false, false);
                            p0[j] = __uint_as_float(fq < 2 ? r0_[1] : r0_[0]); p1[j] = __uint_as_float(fq < 2 ? r1_[1] : r1_[0]); }
                        const float c0[4] = {r0[0], r0[2], r1[0], r1[2]}, s0[4] = {r0[1], r0[3], r1[1], r1[3]};
                        const float c1[4] = {r2[0], r2[2], r3[0], r3[2]}, s1[4] = {r2[1], r2[3], r3[1], r3[3]};
                        const bool lo = fq < 2;
#pragma unroll
                        for (int j = 0; j < 4; ++j) {
                            v0[j] = lo ? (v0[j] * c0[j] - p0[j] * s0[j]) : (p0[j] * s0[j] + v0[j] * c0[j]);
                            v1[j] = lo ? (v1[j] * c1[j] - p1[j] * s1[j]) : (p1[j] * s1[j] + v1[j] * c1[j]); }
                    }
                    u32x4 w; w.x = cvt_pk_bf16(v0[0], v0[1]); w.y = cvt_pk_bf16(v0[2], v0[3]); w.z = cvt_pk_bf16(v1[0], v1[1]); w.w = cvt_pk_bf16(v1[2], v1[3]);
                    *(u32x4*)(rowp + bj * HALF) = w; } }
    }
};
struct EpiOut {
    static constexpr bool PERM = true, AFTER_DRAIN = false;
    const float* xf_x; const float* xf_c; bf16_t* XB; const float* mod; int from_f32;
    __device__ __forceinline__ void operator()(const f32x4 (&acc)[2][2][4][2], const Unit& u, int ui, int wr, int wc, int fr, int fq) const {
        const int row0 = u.pm * BM + wr * 64 + fr, col0 = u.pn * BM + wc * 32 + 8 * fq;
        const bool latent = u.pm < (TXR / BM);
#pragma unroll
        for (int ai = 0; ai < 2; ++ai)
#pragma unroll
            for (int m = 0; m < 4; ++m) { const int row = row0 + ai * HALF + m * 16;
                const int mrow = latent ? (row >> 12) : 8; const float* gp = mod + mrow * 6144 + 2 * 1024 + col0;
                bf16_t* xb = XB + (size_t)row * 1024 + col0;
#pragma unroll
                for (int bj = 0; bj < 2; ++bj) { const f32x4 g0 = *(const f32x4*)(gp + bj * HALF), g1 = *(const f32x4*)(gp + bj * HALF + 4); f32x4 x0, x1;
                    if (from_f32) { const float* xo = (latent ? xf_x + (size_t)row * 1024 : xf_c + (size_t)(row - TXR) * 1024) + col0 + bj * HALF; x0 = *(const f32x4*)xo; x1 = *(const f32x4*)(xo + 4); }
                    else { const u32x4 w = *(const u32x4*)(xb + bj * HALF); x0 = (f32x4){__uint_as_float(w.x << 16), __uint_as_float(w.x & 0xffff0000u), __uint_as_float(w.y << 16), __uint_as_float(w.y & 0xffff0000u)};
                        x1 = (f32x4){__uint_as_float(w.z << 16), __uint_as_float(w.z & 0xffff0000u), __uint_as_float(w.w << 16), __uint_as_float(w.w & 0xffff0000u)}; }
                    const f32x4 v0 = x0 + g0 * acc[ai][bj][m][0], v1 = x1 + g1 * acc[ai][bj][m][1];
                    u32x4 o; o.x = cvt_pk_bf16(v0[0], v0[1]); o.y = cvt_pk_bf16(v0[2], v0[3]); o.z = cvt_pk_bf16(v1[0], v1[1]); o.w = cvt_pk_bf16(v1[2], v1[3]);
                    *(u32x4*)(xb + bj * HALF) = o; } }
    }
};
struct EpiGU {
    static constexpr bool PERM = true, AFTER_DRAIN = false;
    unsigned char* ACT; const PG8_LAS float* wsc;
    __device__ __forceinline__ void operator()(const f32x4 (&acc)[2][2][4][2], const Unit& u, int ui, int wr, int wc, int fr, int fq) const {
        const int row0 = u.pm * BM + wr * 64 + fr; const int col0 = (u.pn & 15) * 128 + wc * 32 + 8 * fq; const int e = u.pn >> 4; const float sg = wsc[e], su = wsc[16 + e]; const float nsl = -1.4426950408889634f * sg, isgu = 1.0f / (sg * su);
#pragma unroll
        for (int ai = 0; ai < 2; ++ai)
#pragma unroll
            for (int m = 0; m < 4; ++m) { unsigned char* rowp = ACT + (size_t)(row0 + ai * HALF + m * 16) * 2048 + col0;
                float h[8];
#pragma unroll
                for (int n = 0; n < 2; ++n) { const f32x4 ag = acc[ai][0][m][n], au = acc[ai][1][m][n]; const f32x4 ex = ag * nsl, gu = ag * au;
#pragma unroll
                    for (int j = 0; j < 4; ++j) { const float r = __builtin_amdgcn_rcpf(__builtin_fmaf(__builtin_amdgcn_exp2f(ex[j]), isgu, isgu)); h[4 * n + j] = __builtin_amdgcn_fmed3f(gu[j] * r, -448.0f, 448.0f); } }
                int p0 = 0, p1 = 0;
                p0 = __builtin_amdgcn_cvt_pk_fp8_f32(h[0], h[1], p0, false); p0 = __builtin_amdgcn_cvt_pk_fp8_f32(h[2], h[3], p0, true);
                p1 = __builtin_amdgcn_cvt_pk_fp8_f32(h[4], h[5], p1, false); p1 = __builtin_amdgcn_cvt_pk_fp8_f32(h[6], h[7], p1, true);
                typedef int i32x2v __attribute__((ext_vector_type(2)));
                *(i32x2v*)rowp = (i32x2v){p0, p1}; }
    }
};
struct EpiDown {
    static constexpr bool PERM = true, AFTER_DRAIN = false;
    unsigned char* OB; const PG8_LAS float* gl;
    __device__ __forceinline__ void operator()(const f32x4 (&acc)[2][2][4][2], const Unit& u, int ui, int wr, int wc, int fr, int fq) const {
        const int row0 = u.pm * BM + wr * 64 + fr; const int col0 = (u.pn & 3) * BM + wc * 32 + 8 * fq;
#pragma unroll
        for (int ai = 0; ai < 2; ++ai)
#pragma unroll
            for (int m = 0; m < 4; ++m) { const int row = row0 + ai * HALF + m * 16; const float g = gl[ui * BM + ai * HALF + wr * 64 + m * 16 + fr]; unsigned char* rowp = OB + (size_t)row * 1024 + col0;
#pragma unroll
                for (int bj = 0; bj < 2; ++bj) { const f32x4 v0 = acc[ai][bj][m][0] * g, v1 = acc[ai][bj][m][1] * g; int p0 = 0, p1 = 0;
                    p0 = __builtin_amdgcn_cvt_pk_fp8_f32(__builtin_amdgcn_fmed3f(v0[0], -448.f, 448.f), __builtin_amdgcn_fmed3f(v0[1], -448.f, 448.f), p0, false); p0 = __builtin_amdgcn_cvt_pk_fp8_f32(__builtin_amdgcn_fmed3f(v0[2], -448.f, 448.f), __builtin_amdgcn_fmed3f(v0[3], -448.f, 448.f), p0, true);
                    p1 = __builtin_amdgcn_cvt_pk_fp8_f32(__builtin_amdgcn_fmed3f(v1[0], -448.f, 448.f), __builtin_amdgcn_fmed3f(v1[1], -448.f, 448.f), p1, false); p1 = __builtin_amdgcn_cvt_pk_fp8_f32(__builtin_amdgcn_fmed3f(v1[2], -448.f, 448.f), __builtin_amdgcn_fmed3f(v1[3], -448.f, 448.f), p1, true);
                    typedef int i32x2v __attribute__((ext_vector_type(2)));
                    *(i32x2v*)(rowp + bj * HALF) = (i32x2v){p0, p1}; } }
    }
};

template <class Epi, class Sched, bool ALIGN_EPI = false, bool SP2 = false, bool FP8 = false>
__device__ __forceinline__ void gemm_phase(PG8_LAS unsigned char* lds, const Gemm g, const Sched& S, const Epi& E) {
    int tid_ = tid_of(g.wv); asm volatile("" : "+v"(tid_));
    const int tid = tid_, wid = __builtin_amdgcn_readfirstlane(tid >> 6), lane = tid & 63, wr = wid >> 2, wc = wid & 3, fr = lane & 15, fq = lane >> 4;
    const int K = g.K, KB = FP8 ? K : 2 * K  , nt = KB / (BK * 2);
    unsigned voffA[2], voffB[2];
#pragma unroll
    for (int i = 0; i < 2; ++i) { int R, C; stage_rc(tid * 16 + i * 8192, R, C); const int Rb = Epi::PERM ? ((R & ~31) + perm32(R & 31)) : R;
        voffA[i] = (unsigned)(R * KB + C * 2); voffB[i] = (unsigned)(Rb * KB + C * 2); }
    const size_t kstep = (size_t)(BK * 2);
    const size_t hstep = (size_t)HALF * KB;
    const size_t tstep = 2 * hstep;
    const unsigned ldsw = (unsigned)wid * 1024u;
    const int aoff = lds_byte(wr * 64 + fr, fq * 8), boff = lds_byte(wc * 32 + fr, fq * 8);
#define PG8_SA(b, h) (((b) * 2 + (h)) * HTB)
#define PG8_SB(b, h) ((4 + (b) * 2 + (h)) * HTB)
#define PG8_STAGE(bufoff, gbase, voff) do { _Pragma("unroll") for (int _i = 0; _i < 2; ++_i) \
        __builtin_amdgcn_global_load_lds((const unsigned*)((const char*)(gbase) + (voff)[_i]), (PG8_LAS unsigned*)(lds + (bufoff) + ldsw + _i * 8192), 16, 0, 0); } while (0)
#define PG8_LDA(dst, b, h) do { _Pragma("unroll") for (int m = 0; m < 4; ++m) { if constexpr (FP8) { dst##8[m].lo = *(const PG8_LAS v4i_t*)(lds + PG8_SA(b, h) + aoff + m * 2048); dst##8[m].hi = *(const PG8_LAS v4i_t*)(lds + PG8_SA(b, h) + aoff + m * 2048 + 1024); } \
        else { _Pragma("unroll") for (int k = 0; k < 2; ++k) dst[m][k] = *(const PG8_LAS bf16x8*)(lds + PG8_SA(b, h) + aoff + m * 2048 + k * 1024); } } } while (0)
#define PG8_LDB(dst, b, h) do { _Pragma("unroll") for (int n = 0; n < 2; ++n) { if constexpr (FP8) { dst##8[n].lo = *(const PG8_LAS v4i_t*)(lds + PG8_SB(b, h) + boff + n * 2048); dst##8[n].hi = *(const PG8_LAS v4i_t*)(lds + PG8_SB(b, h) + boff + n * 2048 + 1024); } \
        else { _Pragma("unroll") for (int k = 0; k < 2; ++k) dst[n][k] = *(const PG8_LAS bf16x8*)(lds + PG8_SB(b, h) + boff + n * 2048 + k * 1024); } } } while (0)
#define PG8_CAT8(x0, x1) __builtin_shufflevector(__builtin_bit_cast(v4i_t, x0), __builtin_bit_cast(v4i_t, x1), 0, 1, 2, 3, 4, 5, 6, 7)
#define PG8_MMA(ai, bj, At, Bt) do { __builtin_amdgcn_s_setprio(1); if constexpr (FP8) asm volatile("s_nop 1" ::: "memory"); _Pragma("unroll") for (int m = 0; m < 4; ++m) _Pragma("unroll") for (int n = 0; n < 2; ++n) { \
        if constexpr (FP8) { asm volatile("v_mfma_scale_f32_16x16x128_f8f6f4 %0, %1, %2, %0, %3, %3 op_sel_hi:[0,0,0]" : "+v"(acc[ai][bj][m][n]) : "v"(Bt##8[n]), "v"(At##8[m]), "v"(one_scale)); } \
        else { _Pragma("unroll") for (int k = 0; k < 2; ++k) acc[ai][bj][m][n] = __builtin_amdgcn_mfma_f32_16x16x32_bf16(Bt[n][k], At[m][k], acc[ai][bj][m][n], 0, 0, 0); } } if constexpr (FP8) asm volatile("s_nop 15\n\ts_nop 3" ::: "memory"); __builtin_amdgcn_s_setprio(0); } while (0)
#define PG8_WAIT_V(n) asm volatile("s_waitcnt vmcnt(" #n ")" ::: "memory")
#define PG8_WAIT_L(n) asm volatile("s_waitcnt lgkmcnt(" #n ")" ::: "memory")
#define PG8_BAR __builtin_amdgcn_s_barrier()
#define PG8_SCHED __builtin_amdgcn_sched_barrier(0)
    Unit cur, nxt; int ui = 0;
    if (!S.next(0, cur)) return;
    f32x4 acc[2][2][4][2];
#pragma unroll
    for (int a = 0; a < 2; ++a)
#pragma unroll
        for (int b = 0; b < 2; ++b)
#pragma unroll
            for (int m = 0; m < 4; ++m)
#pragma unroll
                for (int n = 0; n < 2; ++n) acc[a][b][m][n] = (f32x4){0.f, 0.f, 0.f, 0.f};
    bf16x8 At[4][2], B0[2][2], B1[2][2];
    v8i_t At8[4], B08[2], B18[2];
    int one_scale = 0x7f7f7f7f; asm volatile("" : "+v"(one_scale));
    const char* cA = (const char*)g.A + (size_t)cur.pm * tstep; const char* cB = (const char*)g.Bt + (size_t)cur.pn * tstep;
    S.a_ready(cur);
    if constexpr (SP2) {
        PG8_STAGE(PG8_SB(0, 0), cB, voffB); PG8_STAGE(PG8_SB(0, 1), cB + hstep, voffB); PG8_STAGE(PG8_SA(0, 0), cA, voffA); PG8_STAGE(PG8_SA(0, 1), cA + hstep, voffA);
        if (wr == 1) PG8_BAR;
        PG8_WAIT_V(2); PG8_BAR;
        PG8_STAGE(PG8_SB(1, 0), cB + kstep, voffB); PG8_STAGE(PG8_SA(1, 0), cA + kstep, voffA); PG8_STAGE(PG8_SB(1, 1), cB + hstep + kstep, voffB);
        PG8_WAIT_V(6); PG8_BAR;
    } else {
        PG8_STAGE(PG8_SB(0, 0), cB, voffB); PG8_STAGE(PG8_SA(0, 0), cA, voffA); PG8_STAGE(PG8_SB(0, 1), cB + hstep, voffB); PG8_STAGE(PG8_SA(0, 1), cA + hstep, voffA);
        if (wr == 1) PG8_BAR;
        PG8_WAIT_V(4); PG8_BAR;
        PG8_STAGE(PG8_SB(1, 0), cB + kstep, voffB); PG8_STAGE(PG8_SA(1, 0), cA + kstep, voffA); PG8_STAGE(PG8_SB(1, 1), cB + hstep + kstep, voffB);
        PG8_WAIT_V(6); PG8_BAR;
    }
    for (;;) {
        const bool has_next = S.next(ui + 1, nxt);
        const char* nA = has_next ? (const char*)g.A + (size_t)nxt.pm * tstep : cA; const char* nB = has_next ? (const char*)g.Bt + (size_t)nxt.pn * tstep : cB;
#pragma nounroll
        for (int t = 0; t < nt; t += 2) {
            const bool last = (t == nt - 2);
            const char* a1 = cA + (size_t)(t + 1) * kstep;
            const char* a2 = last ? nA : cA + (size_t)(t + 2) * kstep; const char* b2 = last ? nB : cB + (size_t)(t + 2) * kstep;
            const char* a3 = a2 + kstep; const char* b3 = b2 + kstep;
            if (last && has_next) S.a_ready(nxt);
            if constexpr (SP2) {
            PG8_LDB(B0, 0, 0); PG8_LDB(B1, 0, 1); PG8_SCHED; PG8_LDA(At, 0, 0); PG8_STAGE(PG8_SA(1, 1), a1 + hstep, voffA);
            PG8_WAIT_V(8); PG8_WAIT_L(0); PG8_BAR; PG8_MMA(0, 0, At, B0); PG8_MMA(0, 1, At, B1); PG8_BAR; PG8_SCHED;
            PG8_LDA(At, 0, 1); PG8_STAGE(PG8_SB(0, 0), b2, voffB); PG8_STAGE(PG8_SB(0, 1), b2 + hstep, voffB); PG8_STAGE(PG8_SA(0, 0), a2, voffA);
            PG8_WAIT_V(8); PG8_WAIT_L(0); PG8_BAR; PG8_MMA(1, 0, At, B0); PG8_MMA(1, 1, At, B1); PG8_BAR; PG8_SCHED;
            PG8_LDB(B0, 1, 0); PG8_LDB(B1, 1, 1); PG8_SCHED; PG8_LDA(At, 1, 0); PG8_STAGE(PG8_SA(0, 1), a2 + hstep, voffA);
            PG8_WAIT_V(8); PG8_WAIT_L(0); PG8_BAR; PG8_MMA(0, 0, At, B0); PG8_MMA(0, 1, At, B1); PG8_BAR; PG8_SCHED;
            PG8_LDA(At, 1, 1); PG8_STAGE(PG8_SB(1, 0), b3, voffB); PG8_STAGE(PG8_SB(1, 1), b3 + hstep, voffB); PG8_STAGE(PG8_SA(1, 0), a3, voffA);
            PG8_WAIT_V(8); PG8_WAIT_L(0); PG8_BAR; PG8_MMA(1, 0, At, B0); PG8_MMA(1, 1, At, B1); PG8_BAR; PG8_SCHED;
            } else {
            PG8_LDB(B0, 0, 0); PG8_SCHED; PG8_LDA(At, 0, 0); PG8_STAGE(PG8_SA(1, 1), a1 + hstep, voffA);
            PG8_WAIT_L(8); PG8_BAR; PG8_WAIT_L(0); PG8_MMA(0, 0, At, B0); PG8_BAR; PG8_SCHED;
            PG8_LDB(B1, 0, 1); PG8_STAGE(PG8_SB(0, 0), b2, voffB);
            PG8_BAR; PG8_WAIT_L(0); PG8_MMA(0, 1, At, B1); PG8_BAR;
            PG8_LDA(At, 0, 1); PG8_STAGE(PG8_SA(0, 0), a2, voffA);
            PG8_BAR; PG8_WAIT_L(0); PG8_MMA(1, 0, At, B0); PG8_BAR; PG8_SCHED;
            PG8_STAGE(PG8_SB(0, 1), b2 + hstep, voffB);
            PG8_WAIT_V(6); PG8_BAR; PG8_MMA(1, 1, At, B1); PG8_BAR;
            PG8_LDB(B0, 1, 0); PG8_SCHED; PG8_LDA(At, 1, 0); PG8_STAGE(PG8_SA(0, 1), a2 + hstep, voffA);
            PG8_WAIT_L(8); PG8_BAR; PG8_WAIT_L(0); PG8_MMA(0, 0, At, B0); PG8_BAR; PG8_SCHED;
            PG8_LDB(B1, 1, 1); PG8_STAGE(PG8_SB(1, 0), b3, voffB);
            PG8_BAR; PG8_WAIT_L(0); PG8_MMA(0, 1, At, B1); PG8_BAR;
            PG8_LDA(At, 1, 1); PG8_STAGE(PG8_SA(1, 0), a3, voffA);
            PG8_BAR; PG8_WAIT_L(0); PG8_MMA(1, 0, At, B0); PG8_BAR; PG8_SCHED;
            PG8_STAGE(PG8_SB(1, 1), b3 + hstep, voffB);
            PG8_WAIT_V(6); PG8_BAR; PG8_MMA(1, 1, At, B1); PG8_BAR;
            }
        }
        if constexpr (ALIGN_EPI) { if (wr == 0) PG8_BAR; }
        if constexpr (!Epi::AFTER_DRAIN) { E(acc, cur, ui, wr, wc, fr, fq); S.done(cur); }
        if (!has_next) break;
#pragma unroll
        for (int a = 0; a < 2; ++a)
#pragma unroll
            for (int b = 0; b < 2; ++b)
#pragma unroll
                for (int m = 0; m < 4; ++m)
#pragma unroll
                    for (int n = 0; n < 2; ++n) acc[a][b][m][n] = (f32x4){0.f, 0.f, 0.f, 0.f};
        cur = nxt; cA = nA; cB = nB; ++ui;
        if constexpr (ALIGN_EPI) { if (wr == 1) PG8_BAR; }
    }
    PG8_WAIT_V(0);
    if constexpr (!ALIGN_EPI) { if (wr == 0) PG8_BAR; }
    PG8_BAR;
    if constexpr (Epi::AFTER_DRAIN) { E.fused(acc, cur, wr, wc, fr, fq, lds, wid, lane); S.done(cur); }
#undef PG8_SA
#undef PG8_SB
#undef PG8_STAGE
#undef PG8_LDA
#undef PG8_LDB
#undef PG8_MMA
#undef PG8_CAT8
#undef PG8_WAIT_V
#undef PG8_WAIT_L
#undef PG8_BAR
#undef PG8_SCHED
}
template <class Epi, class Sched, bool FP8 = false>
__device__ __forceinline__ void gemm_phase_gather(PG8_LAS unsigned char* lds, const Gemm g, const int* rowmap, PG8_LAS int* idxs, const Sched& S, const Epi& E) {
    constexpr bool ALIGN_EPI = true, SP2 = true;
    int tid_ = tid_of(g.wv); asm volatile("" : "+v"(tid_));
    const int tid = tid_, wid = __builtin_amdgcn_readfirstlane(tid >> 6), lane = tid & 63, wr = wid >> 2, wc = wid & 3, fr = lane & 15, fq = lane >> 4;
    const int K = g.K, KB = FP8 ? K : 2 * K  , nt = KB / (BK * 2);
    unsigned voffB[2]; int RA[2], CA[2];
#pragma unroll
    for (int i = 0; i < 2; ++i) { int R, C; stage_rc(tid * 16 + i * 8192, R, C); const int Rb = Epi::PERM ? ((R & ~31) + perm32(R & 31)) : R;
        RA[i] = R; CA[i] = C * 2; voffB[i] = (unsigned)(Rb * KB + C * 2); }
    const size_t kstep = (size_t)(BK * 2);
    const size_t hstep = (size_t)HALF * KB;
    const size_t tstep = 2 * hstep;
    const unsigned ldsw = (unsigned)wid * 1024u;
    const int aoff = lds_byte(wr * 64 + fr, fq * 8), boff = lds_byte(wc * 32 + fr, fq * 8);
#define PG8_SA(b, h) (((b) * 2 + (h)) * HTB)
#define PG8_SB(b, h) ((4 + (b) * 2 + (h)) * HTB)
#define PG8_STAGE(bufoff, gbase, voff) do { _Pragma("unroll") for (int _i = 0; _i < 2; ++_i) \
        __builtin_amdgcn_global_load_lds((const unsigned*)((const char*)(gbase) + (voff)[_i]), (PG8_LAS unsigned*)(lds + (bufoff) + ldsw + _i * 8192), 16, 0, 0); } while (0)
#define PG8_STAGE_AG(bufoff, P, h, koff) do { _Pragma("unroll") for (int _i = 0; _i < 2; ++_i) \
        __builtin_amdgcn_global_load_lds((const unsigned*)((const char*)g.A + (size_t)((P)[h][_i] + (unsigned)(koff))), (PG8_LAS unsigned*)(lds + (bufoff) + ldsw + _i * 8192), 16, 0, 0); } while (0)
#define PG8_ROWPTR(P, u) do { _Pragma("unroll") for (int _h = 0; _h < 2; ++_h) _Pragma("unroll") for (int _i = 0; _i < 2; ++_i) \
        (P)[_h][_i] = (unsigned)idxs[(u) * BM + _h * HALF + RA[_i]] * (unsigned)KB + (unsigned)CA[_i]; } while (0)
#define PG8_LDA(dst, b, h) do { _Pragma("unroll") for (int m = 0; m < 4; ++m) { if constexpr (FP8) { dst##8[m].lo = *(const PG8_LAS v4i_t*)(lds + PG8_SA(b, h) + aoff + m * 2048); dst##8[m].hi = *(const PG8_LAS v4i_t*)(lds + PG8_SA(b, h) + aoff + m * 2048 + 1024); } \
        else { _Pragma("unroll") for (int k = 0; k < 2; ++k) dst[m][k] = *(const PG8_LAS bf16x8*)(lds + PG8_SA(b, h) + aoff + m * 2048 + k * 1024); } } } while (0)
#define PG8_LDB(dst, b, h) do { _Pragma("unroll") for (int n = 0; n < 2; ++n) { if constexpr (FP8) { dst##8[n].lo = *(const PG8_LAS v4i_t*)(lds + PG8_SB(b, h) + boff + n * 2048); dst##8[n].hi = *(const PG8_LAS v4i_t*)(lds + PG8_SB(b, h) + boff + n * 2048 + 1024); } \
        else { _Pragma("unroll") for (int k = 0; k < 2; ++k) dst[n][k] = *(const PG8_LAS bf16x8*)(lds + PG8_SB(b, h) + boff + n * 2048 + k * 1024); } } } while (0)
#define PG8_CAT8(x0, x1) __builtin_shufflevector(__builtin_bit_cast(v4i_t, x0), __builtin_bit_cast(v4i_t, x1), 0, 1, 2, 3, 4, 5, 6, 7)
#define PG8_MMA(ai, bj, At, Bt) do { __builtin_amdgcn_s_setprio(1); if constexpr (FP8) asm volatile("s_nop 1" ::: "memory"); _Pragma("unroll") for (int m = 0; m < 4; ++m) _Pragma("unroll") for (int n = 0; n < 2; ++n) { \
        if constexpr (FP8) { asm volatile("v_mfma_scale_f32_16x16x128_f8f6f4 %0, %1, %2, %0, %3, %3 op_sel_hi:[0,0,0]" : "+v"(acc[ai][bj][m][n]) : "v"(Bt##8[n]), "v"(At##8[m]), "v"(one_scale)); } \
        else { _Pragma("unroll") for (int k = 0; k < 2; ++k) acc[ai][bj][m][n] = __builtin_amdgcn_mfma_f32_16x16x32_bf16(Bt[n][k], At[m][k], acc[ai][bj][m][n], 0, 0, 0); } } if constexpr (FP8) asm volatile("s_nop 15\n\ts_nop 3" ::: "memory"); __builtin_amdgcn_s_setprio(0); } while (0)
#define PG8_WAIT_V(n) asm volatile("s_waitcnt vmcnt(" #n ")" ::: "memory")
#define PG8_WAIT_L(n) asm volatile("s_waitcnt lgkmcnt(" #n ")" ::: "memory")
#define PG8_BAR __builtin_amdgcn_s_barrier()
#define PG8_SCHED __builtin_amdgcn_sched_barrier(0)
    Unit cur, nxt; int ui = 0;
    if (!S.next(0, cur)) return;
    f32x4 acc[2][2][4][2];
#pragma unroll
    for (int a = 0; a < 2; ++a)
#pragma unroll
        for (int b = 0; b < 2; ++b)
#pragma unroll
            for (int m = 0; m < 4; ++m)
#pragma unroll
                for (int n = 0; n < 2; ++n) acc[a][b][m][n] = (f32x4){0.f, 0.f, 0.f, 0.f};
    bf16x8 At[4][2], B0[2][2], B1[2][2];
    v8i_t At8[4], B08[2], B18[2];
    int one_scale = 0x7f7f7f7f; asm volatile("" : "+v"(one_scale));
    const char* cB = (const char*)g.Bt + (size_t)cur.pn * tstep;
    unsigned cP[2][2], nP[2][2];
    { Unit uu; for (int i = 0; S.next(i, uu); ++i) if (tid < BM) idxs[i * BM + tid] = rowmap[uu.pm * BM + tid]; }
    asm volatile("s_waitcnt vmcnt(0) lgkmcnt(0)" ::: "memory"); __builtin_amdgcn_s_barrier(); asm volatile("" ::: "memory");
    PG8_ROWPTR(cP, 0);
    S.a_ready(cur);
    if constexpr (SP2) {
        PG8_STAGE(PG8_SB(0, 0), cB, voffB); PG8_STAGE(PG8_SB(0, 1), cB + hstep, voffB); PG8_STAGE_AG(PG8_SA(0, 0), cP, 0, 0); PG8_STAGE_AG(PG8_SA(0, 1), cP, 1, 0);
        if (wr == 1) PG8_BAR;
        PG8_WAIT_V(2); PG8_BAR;
        PG8_STAGE(PG8_SB(1, 0), cB + kstep, voffB); PG8_STAGE_AG(PG8_SA(1, 0), cP, 0, kstep); PG8_STAGE(PG8_SB(1, 1), cB + hstep + kstep, voffB);
        PG8_WAIT_V(6); PG8_BAR;
    }
    for (;;) {
        const bool has_next = S.next(ui + 1, nxt);
        const char* nB = has_next ? (const char*)g.Bt + (size_t)nxt.pn * tstep : cB;
        if (has_next) { PG8_ROWPTR(nP, ui + 1); } else { _Pragma("unroll") for (int _h = 0; _h < 2; ++_h) _Pragma("unroll") for (int _i = 0; _i < 2; ++_i) nP[_h][_i] = cP[_h][_i]; }
#pragma nounroll
        for (int t = 0; t < nt; t += 2) {
            const bool last = (t == nt - 2);
            const size_t k1 = (size_t)(t + 1) * kstep, k2 = last ? 0 : (size_t)(t + 2) * kstep, k3 = k2 + kstep;
            unsigned sP[2][2];
            _Pragma("unroll") for (int _h = 0; _h < 2; ++_h) _Pragma("unroll") for (int _i = 0; _i < 2; ++_i) sP[_h][_i] = last ? nP[_h][_i] : cP[_h][_i];
            const char* b2 = last ? nB : cB + (size_t)(t + 2) * kstep; const char* b3 = b2 + kstep;
            if (last && has_next) S.a_ready(nxt);
            if constexpr (SP2) {
            PG8_LDB(B0, 0, 0); PG8_LDB(B1, 0, 1); PG8_SCHED; PG8_LDA(At, 0, 0); PG8_STAGE_AG(PG8_SA(1, 1), cP, 1, k1);
            PG8_WAIT_V(8); PG8_WAIT_L(0); PG8_BAR; PG8_MMA(0, 0, At, B0); PG8_MMA(0, 1, At, B1); PG8_BAR; PG8_SCHED;
            PG8_LDA(At, 0, 1); PG8_STAGE(PG8_SB(0, 0), b2, voffB); PG8_STAGE(PG8_SB(0, 1), b2 + hstep, voffB); PG8_STAGE_AG(PG8_SA(0, 0), sP, 0, k2);
            PG8_WAIT_V(8); PG8_WAIT_L(0); PG8_BAR; PG8_MMA(1, 0, At, B0); PG8_MMA(1, 1, At, B1); PG8_BAR; PG8_SCHED;
            PG8_LDB(B0, 1, 0); PG8_LDB(B1, 1, 1); PG8_SCHED; PG8_LDA(At, 1, 0); PG8_STAGE_AG(PG8_SA(0, 1), sP, 1, k2);
            PG8_WAIT_V(8); PG8_WAIT_L(0); PG8_BAR; PG8_MMA(0, 0, At, B0); PG8_MMA(0, 1, At, B1); PG8_BAR; PG8_SCHED;
            PG8_LDA(At, 1, 1); PG8_STAGE(PG8_SB(1, 0), b3, voffB); PG8_STAGE(PG8_SB(1, 1), b3 + hstep, voffB); PG8_STAGE_AG(PG8_SA(1, 0), sP, 0, k3);
            PG8_WAIT_V(8); PG8_WAIT_L(0); PG8_BAR; PG8_MMA(1, 0, At, B0); PG8_MMA(1, 1, At, B1); PG8_BAR; PG8_SCHED;
            }
        }
        if constexpr (ALIGN_EPI) { if (wr == 0) PG8_BAR; }
        if constexpr (!Epi::AFTER_DRAIN) { E(acc, cur, ui, wr, wc, fr, fq); if (AMP_PHASE == 81) { asm volatile("" ::: "memory"); E(acc, cur, ui, wr, wc, fr, fq); } S.done(cur); }
        if (!has_next) break;
#pragma unroll
        for (int a = 0; a < 2; ++a)
#pragma unroll
            for (int b = 0; b < 2; ++b)
#pragma unroll
                for (int m = 0; m < 4; ++m)
#pragma unroll
                    for (int n = 0; n < 2; ++n) acc[a][b][m][n] = (f32x4){0.f, 0.f, 0.f, 0.f};
        cur = nxt; cB = nB; ++ui;
        _Pragma("unroll") for (int _h = 0; _h < 2; ++_h) _Pragma("unroll") for (int _i = 0; _i < 2; ++_i) cP[_h][_i] = nP[_h][_i];
        if constexpr (ALIGN_EPI) { if (wr == 1) PG8_BAR; }
    }
    PG8_WAIT_V(0);
    if constexpr (!ALIGN_EPI) { if (wr == 0) PG8_BAR; }
    PG8_BAR;
    if constexpr (Epi::AFTER_DRAIN) { E.fused(acc, cur, wr, wc, fr, fq, lds, wid, lane); S.done(cur); }
#undef PG8_SA
#undef PG8_SB
#undef PG8_STAGE
#undef PG8_STAGE_AG
#undef PG8_ROWPTR
#undef PG8_LDA
#undef PG8_LDB
#undef PG8_MMA
#undef PG8_CAT8
#undef PG8_WAIT_V
#undef PG8_WAIT_L
#undef PG8_BAR
#undef PG8_SCHED
}

}

#define LAS __attribute__((address_space(3)))
typedef unsigned short bf16_t;
typedef float f32x4 __attribute__((ext_vector_type(4)));
typedef unsigned u32x4 __attribute__((ext_vector_type(4)));
typedef unsigned u32x2 __attribute__((ext_vector_type(2)));
typedef __bf16 bf16x2_t __attribute__((ext_vector_type(2)));
constexpr int NWAVES = 8, NTHR = 512;
constexpr int D = 1024, NB = 8, SEQ = 4096, LCTX = 256, TX = NB * SEQ, TC = NB * LCTX, TT = TX + TC, INW = 2304, NE = 16, FF = 2048;
constexpr int CAPX = 512, CAPC = 32, SLOTS = NB * CAPX + NB * CAPC;
constexpr float LOG2E = 1.4426950408889634f;
constexpr int LDS_BYTES = 163840;
enum { I_X = 0, I_C, I_CTX, I_CCTX, I_ADAW, I_ADAB, I_N1G, I_N2G, I_WIN, I_HCW, I_HCB, I_HW1, I_HB1, I_HW2, I_HB2, I_HW3, I_HFREQ, I_HSKIP, I_SINK, I_POOLW, I_POOLS, I_RPB, I_WOUT, I_ROUTER, I_WG, I_WU, I_WD, I_FNG, N_IN };
constexpr size_t MiB = 1u << 20;
constexpr size_t WS_CTL = 0;
constexpr size_t WS_MOD = 1 * MiB;
constexpr size_t WS_WSC = 1 * MiB + 512 * 1024;
constexpr size_t WS_ROPE = 2 * MiB;
constexpr size_t WS_TW8 = 2 * MiB + 65536;
constexpr size_t WS_WIN_T = 3 * MiB;
constexpr size_t WS_WOUT_T = 13 * MiB;
constexpr size_t WS_HC = 17 * MiB;
constexpr size_t WS_HCC = 51 * MiB;
constexpr size_t WS_AFFT = 53 * MiB;
constexpr size_t WS_ROWMAP = 56 * MiB;
constexpr size_t WS_GATE = 57 * MiB;
constexpr size_t WS_INV = 58 * MiB;
constexpr size_t WS_CRES = 61 * MiB;
constexpr size_t WS_HX = 69 * MiB;
constexpr size_t WS_WGU_T = 137 * MiB;
constexpr size_t WS_XB = 265 * MiB;
constexpr size_t WS_WD_T = 393 * MiB;
constexpr size_t WS_R = 521 * MiB;
constexpr size_t WS_ACT = WS_R;
constexpr size_t WS_XG = WS_R + 272 * MiB;
constexpr size_t WS_PX = WS_R;
constexpr size_t WS_Y = WS_R + 153 * MiB;
constexpr size_t WS_YT = WS_XG + 48 * MiB;
constexpr size_t WS_UT = WS_XG;
constexpr size_t WS_HS = WS_R + 408 * MiB;
constexpr size_t WS_END = WS_HS + 64 * MiB;
static_assert(WS_END <= 1024 * MiB, "workspace map");

struct Args { const float* in[N_IN]; float* out; unsigned char* ws; };

__device__ __forceinline__ float bf2f(unsigned short v) { return __uint_as_float(((unsigned)v) << 16); }
__device__ __forceinline__ unsigned pk2(float lo, float hi) { typedef float f32x2c __attribute__((ext_vector_type(2))); f32x2c v = {lo, hi}; bf16x2_t b = __builtin_convertvector(v, bf16x2_t); return __builtin_bit_cast(unsigned, b); }
__device__ __forceinline__ unsigned f2bf(float f) { return pk2(f, 0.f) & 0xffffu; }
__device__ __forceinline__ float bflo(unsigned w) { return __uint_as_float(w << 16); }
__device__ __forceinline__ float bfhi(unsigned w) { return __uint_as_float(w & 0xffff0000u); }
__device__ __forceinline__ float dot2bf(unsigned a, unsigned b, float acc) { return __builtin_amdgcn_fdot2_f32_bf16(__builtin_bit_cast(bf16x2_t, a), __builtin_bit_cast(bf16x2_t, b), acc, false); }
template <int O> __device__ __forceinline__ float xshfl(float v) {
    if constexpr (O == 32) { auto rr = __builtin_amdgcn_permlane32_swap(__float_as_uint(v), __float_as_uint(v), false, false);
        const bool lowhalf = __builtin_amdgcn_mbcnt_lo(~0u, 0u) == __builtin_amdgcn_mbcnt_hi(~0u, __builtin_amdgcn_mbcnt_lo(~0u, 0u));
        return lowhalf ? __uint_as_float(rr[1]) : __uint_as_float(rr[0]); }
    else return __builtin_bit_cast(float, __builtin_amdgcn_ds_swizzle(__builtin_bit_cast(int, v), (O << 10) | 0x1f));
}
__device__ __forceinline__ float xsum32(float v) { auto rr = __builtin_amdgcn_permlane32_swap(__float_as_uint(v), __float_as_uint(v), false, false); return __uint_as_float(rr[0]) + __uint_as_float(rr[1]); }
__device__ __forceinline__ float xmax32(float v) { auto rr = __builtin_amdgcn_permlane32_swap(__float_as_uint(v), __float_as_uint(v), false, false); return fmaxf(__uint_as_float(rr[0]), __uint_as_float(rr[1])); }
__device__ __forceinline__ float wave_sum(float v) { v += xshfl<1>(v); v += xshfl<2>(v); v += xshfl<4>(v); v += xshfl<8>(v); v += xshfl<16>(v); return xsum32(v); }
__device__ __forceinline__ float wave_max_(float v) { v = fmaxf(v, xshfl<1>(v)); v = fmaxf(v, xshfl<2>(v)); v = fmaxf(v, xshfl<4>(v)); v = fmaxf(v, xshfl<8>(v)); v = fmaxf(v, xshfl<16>(v)); return xmax32(v); }
#define LDS_WAIT() asm volatile("s_waitcnt lgkmcnt(0)" ::: "memory")

#ifndef AMP_PHASE
#define AMP_PHASE -1
#endif
__device__ __forceinline__ unsigned long long amp_now() { asm volatile("s_waitcnt vmcnt(0) lgkmcnt(0)" ::: "memory"); __builtin_amdgcn_sched_barrier(0); const unsigned long long t = __builtin_amdgcn_s_memrealtime(); asm volatile("s_waitcnt lgkmcnt(0)" ::: "memory"); __builtin_amdgcn_sched_barrier(0); return t; }
#define AMP_BEGIN(id) unsigned long long amp_t0_ = 0; if ((id) == AMP_PHASE) { __syncthreads(); amp_t0_ = amp_now(); }
#define AMP_END(id) if ((id) == AMP_PHASE) { __syncthreads(); const unsigned long long t1_ = amp_now(); const unsigned long long d_ = t1_ - amp_t0_; while (amp_now() - t1_ < d_) __builtin_amdgcn_s_sleep(8); __syncthreads(); }
__device__ __forceinline__ void tr_item(const float* W, int K, int N, bf16_t* WT, int Kt, int item, int mode, LAS float* scr, int lane) {
    const int nblk = N / 32, kb = item / nblk, nb = item % nblk, k0 = 64 * kb, n0 = 32 * nb;
    const int r8 = lane >> 3, c4 = lane & 7; f32x4 v[8];
    const float* wp = W + (size_t)(k0 + r8) * N + n0 + 4 * c4;
#pragma unroll
    for (int i = 0; i < 8; ++i) v[i] = *(const f32x4*)(wp + (size_t)(8 * i) * N);
#pragma unroll
    for (int i = 0; i < 8; ++i) { LAS float* d = scr + (r8 + 8 * i) * 33 + 4 * c4; d[0] = v[i][0]; d[1] = v[i][1]; d[2] = v[i][2]; d[3] = v[i][3]; }
    LDS_WAIT();
    const int c = lane & 7;
    const int drow0 = (mode == 0) ? n0 : ((n0 >> 7) * 256 + (n0 & 127) + (mode == 2 ? 128 : 0));
#pragma unroll
    for (int j = 0; j < 4; ++j) { const int n = (lane >> 3) + 8 * j; const LAS float* sp = scr + (8 * c) * 33 + n;
        u32x4 o; o.x = pk2(sp[0 * 33], sp[1 * 33]); o.y = pk2(sp[2 * 33], sp[3 * 33]); o.z = pk2(sp[4 * 33], sp[5 * 33]); o.w = pk2(sp[6 * 33], sp[7 * 33]);
        *(u32x4*)(WT + (size_t)(drow0 + n) * Kt + k0 + 8 * c) = o; }
    LDS_WAIT();
}

struct CvtStream { int it, end, live; f32x4 v0, v1, v2, v3, v4, v5, v6, v7; };
constexpr int CVT_ITEMS = 2 * 3 * 16 * 1024;
__device__ __forceinline__ void cvt_decode(const Args& a, int r, const float*& W, int& K, int& N, unsigned char*& WT, int& Kt, int& mode, int& ri, float*& wsc) {
    const int l = r / 49152, rr = r % 49152, which = rr >> 14, e = (rr >> 10) & 15; ri = rr & 1023; const size_t le = (size_t)l * 16 + e;
    wsc = (float*)(a.ws + WS_WSC) + (l * 3 + which) * 16 + e;
    if (which == 0) { W = a.in[I_WG] + le * 1024 * 2048; K = 1024; N = 2048; WT = (unsigned char*)(a.ws + WS_WGU_T) + le * 4096 * 1024; Kt = 1024; mode = 1; }
    else if (which == 1) { W = a.in[I_WU] + le * 1024 * 2048; K = 1024; N = 2048; WT = (unsigned char*)(a.ws + WS_WGU_T) + le * 4096 * 1024; Kt = 1024; mode = 2; }
    else { W = a.in[I_WD] + le * 2048 * 1024; K = 2048; N = 1024; WT = (unsigned char*)(a.ws + WS_WD_T) + le * 1024 * 2048; Kt = 2048; mode = 0; }
}
__device__ __forceinline__ void cvt_issue(const Args& a, CvtStream& c, int lane) {
    c.live = 0; if (c.it >= c.end) return;
    const float* W; int K, N, Kt, mode, ri; unsigned char* WT; float* wsc; cvt_decode(a, c.it, W, K, N, WT, Kt, mode, ri, wsc);
    const int nblk = N / 32, kb = ri / nblk, nb = ri % nblk, k0 = 64 * kb, n0 = 32 * nb; const int r8 = lane >> 3, c4 = lane & 7;
    const float* wp = W + (size_t)(k0 + r8) * N + n0 + 4 * c4; const size_t st = (size_t)8 * N;
    c.v0 = __builtin_nontemporal_load((const f32x4*)(wp)); c.v1 = __builtin_nontemporal_load((const f32x4*)(wp + st)); c.v2 = __builtin_nontemporal_load((const f32x4*)(wp + 2 * st)); c.v3 = __builtin_nontemporal_load((const f32x4*)(wp + 3 * st));
    c.v4 = __builtin_nontemporal_load((const f32x4*)(wp + 4 * st)); c.v5 = __builtin_nontemporal_load((const f32x4*)(wp + 5 * st)); c.v6 = __builtin_nontemporal_load((const f32x4*)(wp + 6 * st)); c.v7 = __builtin_nontemporal_load((const f32x4*)(wp + 7 * st));
    c.live = 1;
}
__device__ __forceinline__ void cvt_finish(const Args& a, CvtStream& c, LAS float* scr, int lane, int stride) {
    if (!c.live) return;
    const float* W; int K, N, Kt, mode, ri; unsigned char* WT; float* wsc; cvt_decode(a, c.it, W, K, N, WT, Kt, mode, ri, wsc);
    const int nblk = N / 32, kb = ri / nblk, nb = ri % nblk, k0 = 64 * kb, n0 = 32 * nb; const int r8 = lane >> 3, c4 = lane & 7;
    const float mul = 1.0f / *wsc;
    LAS float* d = scr + r8 * 33 + 4 * c4;
#define CVT_PUT(i, v) { d[(8 * (i)) * 33 + 0] = v[0] * mul; d[(8 * (i)) * 33 + 1] = v[1] * mul; d[(8 * (i)) * 33 + 2] = v[2] * mul; d[(8 * (i)) * 33 + 3] = v[3] * mul; }
    CVT_PUT(0, c.v0) CVT_PUT(1, c.v1) CVT_PUT(2, c.v2) CVT_PUT(3, c.v3) CVT_PUT(4, c.v4) CVT_PUT(5, c.v5) CVT_PUT(6, c.v6) CVT_PUT(7, c.v7)
#undef CVT_PUT
    LDS_WAIT();
    const int cc = lane & 7;
    const int drow0 = (mode == 0) ? n0 : ((n0 >> 7) * 256 + (n0 & 127) + (mode == 2 ? 128 : 0));
#pragma unroll
    for (int j = 0; j < 4; ++j) { const int n = (lane >> 3) + 8 * j; const LAS float* sp = scr + (8 * cc) * 33 + n;
        int p0 = 0, p1 = 0;
        p0 = __builtin_amdgcn_cvt_pk_fp8_f32(sp[0 * 33], sp[1 * 33], p0, false); p0 = __builtin_amdgcn_cvt_pk_fp8_f32(sp[2 * 33], sp[3 * 33], p0, true);
        p1 = __builtin_amdgcn_cvt_pk_fp8_f32(sp[4 * 33], sp[5 * 33], p1, false); p1 = __builtin_amdgcn_cvt_pk_fp8_f32(sp[6 * 33], sp[7 * 33], p1, true);
        typedef int i32x2v __attribute__((ext_vector_type(2)));
        *(i32x2v*)(WT + (size_t)(drow0 + n) * Kt + k0 + 8 * cc) = (i32x2v){p0, p1}; }
    LDS_WAIT();
    c.it += stride; c.live = 0;
}

template <int NL>
__device__ __forceinline__ void filter_item(const Args& a, LAS unsigned char* lds, int item, int tid) {
    asm volatile("" : "+v"(tid));
    const int lane = tid & 63, wave = tid >> 6;
    int l, L, p0; float* HCdst;
    if (NL == 8) { l = 0; L = 256; p0 = item * 8; HCdst = (float*)(a.ws + WS_HCC) + 256; }
    else if (item < 128) { l = 0; L = 4096; p0 = item * 32; HCdst = (float*)(a.ws + WS_HC); }
    else { l = 1; L = 4096; p0 = (item - 128) * 32; HCdst = (float*)(a.ws + WS_HC) + (size_t)2 * 256 * 8192; }
    LAS float* w1s = (LAS float*)lds; LAS float* w2s = w1s + 33 * 64; LAS float* b1s = w2s + 64 * 64; LAS float* b2s = b1s + 64; LAS float* frs = b2s + 64; LAS float* h2s = frs + 64; LAS float* ex = h2s + 32 * 64;
    { const float* w1 = a.in[I_HW1] + l * 33 * 64; const float* w2 = a.in[I_HW2] + l * 64 * 64;
      for (int i = tid; i < 33 * 64; i += NTHR) w1s[i] = w1[i];
      for (int i = tid; i < 64 * 64; i += NTHR) w2s[i] = w2[i];
      if (tid < 64) { b1s[tid] = a.in[I_HB1][l * 64 + tid]; b2s[tid] = a.in[I_HB2][l * 64 + tid]; frs[tid] = a.in[I_HFREQ][l * 64 + tid]; } }
    __syncthreads();
    const float frq = frs[lane];
    constexpr int NQ = NL / 8;
    float fv[NQ], a1[NQ], h1[NQ], a2[NQ];
#pragma unroll
    for (int q = 0; q < NQ; ++q) { const int p = p0 + wave * NQ + q; const float tn = (float)p / (float)(L - 1);
        fv[q] = 0.f;
        if (lane == 0) fv[q] = tn;
        else if (lane <= 32) { const int bi = (lane - 1) & 15; const float band = 1e-4f + (float)bi * ((15.0f - 1e-4f) / 15.0f);
            const float ang = ((float)(6.283185307179586 / (double)L) * (float)p) * band; fv[q] = (lane <= 16) ? cosf(ang) : -sinf(ang); }
        a1[q] = b1s[lane]; }
#pragma unroll
    for (int i = 0; i < 33; ++i) { const float w = w1s[i * 64 + lane];
#pragma unroll
        for (int q = 0; q < NQ; ++q) a1[q] += __builtin_bit_cast(float, __builtin_amdgcn_readlane(__builtin_bit_cast(int, fv[q]), i)) * w; }
#pragma unroll
    for (int q = 0; q < NQ; ++q) { h1[q] = sinf(frq * a1[q]); a2[q] = b2s[lane]; }
#pragma unroll 16
    for (int i = 0; i < 64; ++i) { const float w = w2s[i * 64 + lane];
#pragma unroll
        for (int q = 0; q < NQ; ++q) a2[q] += __builtin_bit_cast(float, __builtin_amdgcn_readlane(__builtin_bit_cast(int, h1[q]), i)) * w; }
#pragma unroll
    for (int q = 0; q < NQ; ++q) h2s[lane * NL + wave * NQ + q] = sinf(frq * a2[q]);
    __syncthreads();
    constexpr int LPT = NL / 4;
    typedef float f32x2q __attribute__((ext_vector_type(2)));
    const int cgp = tid & 127, lg = __builtin_amdgcn_readfirstlane(tid >> 7);
    const float* w3 = a.in[I_HW3] + (size_t)l * 64 * 1024 + 8 * cgp;
    f32x2q acc[8][LPT / 2];
#pragma unroll
    for (int k = 0; k < 8; ++k)
#pragma unroll
        for (int j = 0; j < LPT / 2; ++j) acc[k][j] = (f32x2q){0.f, 0.f};
#pragma unroll 4
    for (int i = 0; i < 64; ++i) { const f32x4 wa = *(const f32x4*)(w3 + i * 1024), wb = *(const f32x4*)(w3 + i * 1024 + 4);
        const float wv_[8] = {wa[0], wa[1], wa[2], wa[3], wb[0], wb[1], wb[2], wb[3]};
        f32x2q hp[LPT / 2];
        if constexpr (LPT == 8) { const f32x4 h0 = *(const LAS f32x4*)(h2s + i * NL + lg * LPT), h1 = *(const LAS f32x4*)(h2s + i * NL + lg * LPT + 4);
            hp[0] = (f32x2q){h0[0], h0[1]}; hp[1] = (f32x2q){h0[2], h0[3]}; hp[2] = (f32x2q){h1[0], h1[1]}; hp[3] = (f32x2q){h1[2], h1[3]}; }
        else { hp[0] = *(const LAS f32x2q*)(h2s + i * NL + lg * LPT); }
#pragma unroll
        for (int k = 0; k < 8; ++k) { const f32x2q ww = (f32x2q){wv_[k], wv_[k]};
#pragma unroll
            for (int j = 0; j < LPT / 2; ++j) acc[k][j] = hp[j] * ww + acc[k][j]; } }
    __syncthreads();
    LAS float* S = (LAS float*)lds;
    { const float dmin = 3.0701134573253945f, dmax = 15.350567286626972f;
#pragma unroll
      for (int k = 0; k < 8; ++k) { const int col = 8 * cgp + k; const float delta = dmin + (float)(col & 255) * ((dmax - dmin) / 255.0f);
#pragma unroll
          for (int j = 0; j < LPT; ++j) { const int lagl = lg * LPT + j; const float tn = (float)(p0 + lagl) / (float)(L - 1); const float win = expf(-tn * delta);
              S[(k * 128 + cgp) * 33 + lagl] = acc[k][j >> 1][j & 1] * win; } } }
    __syncthreads();
    const bool tr = (L == 4096);
    const size_t o1 = tr ? (size_t)256 * 8192 : (size_t)(2 * L - 1) * 256;
#pragma unroll 4
    for (int kk = 0; kk < 2 * NL; ++kk) { const int e = kk * NTHR + tid; const int col = e / NL, lagl = e % NL; const int p = p0 + lagl; const int order = col >> 9, dir = (col >> 8) & 1, c = col & 255;
        float v = S[((col & 7) * 128 + (col >> 3)) * 33 + lagl];
        if (p == 0) { if (dir == 1) continue; const int col2 = col + 256; v += S[((col2 & 7) * 128 + (col2 >> 3)) * 33]; }
        const int li = dir == 0 ? (L - 1 + p) : (L - 1 - p); const size_t idx = tr ? ((size_t)c * 8192 + li) : ((size_t)li * 256 + c);
        HCdst[idx + (size_t)order * o1] = v; }
    __syncthreads();
}


typedef int v8i_t __attribute__((ext_vector_type(8)));
__device__ __forceinline__ float st_A(int i, int k) { return (float)(((i * 7 + k * 3) % 5) - 2); }
__device__ __forceinline__ float st_B(int k, int j) { return (float)(((k * 5 + j * 11 + (k >> 4)) % 5) - 2); }
__device__ __forceinline__ void fp8_selftest(unsigned* poison, int lane, int wave, LAS float* part) {
    const int fr = lane & 15, fq = lane >> 4; v8i_t av, bv;
    { f32x4 p = {0.f, 0.f, 0.f, 0.f};
      for (int k = 16 * wave; k < 16 * wave + 16; ++k) { const float bk = st_B(k, fr);
#pragma unroll
          for (int r = 0; r < 4; ++r) p[r] += st_A(4 * fq + r, k) * bk; }
      *(LAS f32x4*)(part + (wave * 64 + lane) * 4) = p; }
    __syncthreads();
    if (wave != 0) return;
#pragma unroll
    for (int w = 0; w < 8; ++w) { int pa = 0, pb = 0;
#pragma unroll
        for (int q = 0; q < 4; ++q) { }
        const int kb = (w < 4) ? (16 * fq + 4 * w) : (64 + 16 * fq + 4 * (w - 4));
        pa = __builtin_amdgcn_cvt_pk_fp8_f32(st_A(fr, kb), st_A(fr, kb + 1), pa, false); pa = __builtin_amdgcn_cvt_pk_fp8_f32(st_A(fr, kb + 2), st_A(fr, kb + 3), pa, true);
        pb = __builtin_amdgcn_cvt_pk_fp8_f32(st_B(kb, fr), st_B(kb + 1, fr), pb, false); pb = __builtin_amdgcn_cvt_pk_fp8_f32(st_B(kb + 2, fr), st_B(kb + 3, fr), pb, true);
        av[w] = pa; bv[w] = pb; }
    f32x4 acc = {0.f, 0.f, 0.f, 0.f};
    acc = __builtin_amdgcn_mfma_scale_f32_16x16x128_f8f6f4(av, bv, acc, 0, 0, 0, 0x7f7f7f7f, 0, 0x7f7f7f7f);
    bool bad = false;
#pragma unroll
    for (int r = 0; r < 4; ++r) { float ref = 0.f;
#pragma unroll
        for (int w = 0; w < 8; ++w) ref += part[(w * 64 + lane) * 4 + r];
        bad |= (acc[r] != ref); }
    { const float v = (float)(lane * 3 + 1);
      const float r5 = __builtin_bit_cast(float, __builtin_amdgcn_update_dpp(0, __builtin_bit_cast(int, v), 0x150 + 5, 0xf, 0xf, false));
      const float r12 = __builtin_bit_cast(float, __builtin_amdgcn_update_dpp(0, __builtin_bit_cast(int, v), 0x150 + 12, 0xf, 0xf, false));
      bad |= (r5 != (float)(((lane & 48) + 5) * 3 + 1)) || (r12 != (float)(((lane & 48) + 12) * 3 + 1)); }
    if (__any(bad) && lane == 0) __hip_atomic_store(poison, 1u, __ATOMIC_RELAXED, __HIP_MEMORY_SCOPE_AGENT);
}

__device__ __forceinline__ void phase_prologue(const Args& a, unsigned char* ldsg, int vcu, int G, int wv) {
    LAS unsigned char* lds = (LAS unsigned char*)ldsg;
    int tid_ = pg8::tid_of(wv); asm volatile("" : "+v"(tid_));
    const int tid = tid_, lane = tid & 63, wave = __builtin_amdgcn_readfirstlane(tid >> 6);
    unsigned char* ws = a.ws;
    if (vcu == 2 % G) fp8_selftest((unsigned*)(ws + WS_CTL) + 12288, lane, wave, (LAS float*)(lds + 36864));
    LAS float* sc = (LAS float*)lds; LAS float* red = (LAS float*)(lds + 36864);
    for (int i = tid; i < 9 * 1024; i += NTHR) { const float v = (i < 8192) ? a.in[I_C][i] : a.in[I_CCTX][i - 8192]; sc[i] = v / (1.0f + expf(-v)); }
    __syncthreads();
    { AMP_BEGIN(41)
    float* MOD = (float*)(ws + WS_MOD);
    for (int item = vcu; item < 2 * 96; item += G) {
        const int l = item / 96, n0 = (item % 96) * 64, col = tid & 63, kg = tid >> 6;
        float acc[9];
#pragma unroll
        for (int r = 0; r < 9; ++r) acc[r] = 0.f;
        const float* w = a.in[I_ADAW] + (size_t)l * 1024 * 6144 + n0 + col;
#pragma unroll 4
        for (int k = kg * 128; k < kg * 128 + 128; ++k) { const float wv = w[(size_t)k * 6144];
#pragma unroll
            for (int r = 0; r < 9; ++r) acc[r] += sc[r * 1024 + k] * wv; }
#pragma unroll
        for (int r = 0; r < 9; ++r) red[(kg * 9 + r) * 64 + col] = acc[r];
        __syncthreads();
        for (int o = tid; o < 9 * 64; o += NTHR) { const int r = o >> 6, cc = o & 63; float s = 0.f;
#pragma unroll
            for (int g2 = 0; g2 < 8; ++g2) s += red[(g2 * 9 + r) * 64 + cc];
            MOD[(size_t)(l * 9 + r) * 6144 + n0 + cc] = s + a.in[I_ADAB][l * 6144 + n0 + cc]; }
        __syncthreads();
    }
    AMP_END(41) }
    if (vcu == 0) { float* ROPE = (float*)(ws + WS_ROPE);
        for (int i = tid; i < 1024; i += NTHR) { const int pos = i >> 4, fi = i & 15; const float inv = powf(10000.0f, -(float)fi / 16.0f); const float ang = (float)pos * inv;
            ROPE[2 * i] = cosf(ang); ROPE[2 * i + 1] = sinf(ang); } }
    if (vcu == 1 % G) { float* TW8 = (float*)(ws + WS_TW8);
        for (int i = tid; i < 8192; i += NTHR) { float sn, cs; sincospif(-(float)i * (1.0f / 4096.0f), &sn, &cs); TW8[2 * i] = cs; TW8[2 * i + 1] = sn; } }
    const int gw = vcu * NWAVES + wave, NGW = G * NWAVES;
    { AMP_BEGIN(42)
    for (int it = vcu; it < 256; it += G) filter_item<32>(a, lds, it, tid);
    for (int it = (vcu + G - 192 % G) % G; it < 32; it += G) filter_item<8>(a, lds, it, tid);
    AMP_END(42) }
    { AMP_BEGIN(43)
    LAS float* scr = (LAS float*)(lds + 65536 + wave * 8448);
    for (int m = gw; m < 96; m += NGW) { const int l = m / 48, which = (m % 48) / 16, e = m & 15; const size_t le = (size_t)l * 16 + e; int lane_ = lane; asm volatile("" : "+v"(lane_));
        const float* W = (which == 0) ? a.in[I_WG] + le * 1024 * 2048 : ((which == 1) ? a.in[I_WU] + le * 1024 * 2048 : a.in[I_WD] + le * 2048 * 1024);
        const f32x4 sv = *(const f32x4*)(W + 4 * lane_); float sm = fmaxf(fmaxf(fabsf(sv[0]), fabsf(sv[1])), fmaxf(fabsf(sv[2]), fabsf(sv[3])));
        sm = wave_max_(sm);
        int E = 0; (void)frexpf(fmaxf(sm, 1e-30f), &E); if (lane_ == 0) ((float*)(ws + WS_WSC))[m] = ldexpf(1.0f, E - 5); }
    constexpr int IT_IN = 16 * 72, IT_OUT = 16 * 32, IT_LAYER = IT_IN + IT_OUT;
    for (int it = gw; it < 2 * IT_LAYER; it += NGW) {
        const int l = it / IT_LAYER; int r = it % IT_LAYER;
        if (r < IT_IN) { tr_item(a.in[I_WIN] + (size_t)l * 1024 * 2304, 1024, 2304, (bf16_t*)(ws + WS_WIN_T) + (size_t)l * 2304 * 1024, 1024, r, 0, scr, lane); continue; } r -= IT_IN;
        tr_item(a.in[I_WOUT] + (size_t)l * 1024 * 1024, 1024, 1024, (bf16_t*)(ws + WS_WOUT_T) + (size_t)l * 1024 * 1024, 1024, r, 0, scr, lane);
    }
    AMP_END(43) }
}

__device__ __forceinline__ void phase_norm_router(const Args& a, unsigned char* ldsg, int vrank, int nblk, int l, const bf16_t* XB, const float* gain, int bt_begin, int bt_end, int wv) {
    int tid_ = pg8::tid_of(wv); asm volatile("" : "+v"(tid_));
    const int tid = tid_, lane = tid & 63, wave = __builtin_amdgcn_readfirstlane(tid >> 6);
    unsigned char* ws = a.ws; asm volatile("" : "+s"(ws)); const float* MOD = (const float*)(ws + WS_MOD) + (size_t)l * 9 * 6144; unsigned char* HX8 = (unsigned char*)(ws + WS_HX);
    LAS unsigned short* rwb = (LAS unsigned short*)(LAS unsigned char*)ldsg;
    { const float* rsrc = a.in[I_ROUTER] + (size_t)l * 1024 * 16; f32x4 rv[8];
#pragma unroll
      for (int k = 0; k < 8; ++k) rv[k] = *(const f32x4*)(rsrc + 4 * (tid + NTHR * k));
#pragma unroll
      for (int k = 0; k < 8; ++k) { const int i4 = tid + NTHR * k, col = i4 >> 2, e0 = (4 * i4) & 15;
#pragma unroll
          for (int q = 0; q < 4; ++q) rwb[(e0 + q) * 1064 + col] = (unsigned short)f2bf(rv[k][q]); }
      __syncthreads(); }
    const int r = lane & 15, kq = lane >> 4;
    LAS float* gmod = (LAS float*)((LAS unsigned char*)ldsg + 36864); LAS float* smod = gmod + 1024;
    for (int bt = bt_begin + vrank; bt < bt_end; bt += nblk) {
        const int tile = bt * 8 + wave; const int row = tile * 16 + r; const int mrow = (bt * 128 < TX) ? ((bt * 128) >> 12) : 8;
        __syncthreads();
        { const float* shp = MOD + mrow * 6144 + 3 * 1024; typedef float f32x2v __attribute__((ext_vector_type(2))); const f32x2v gg = *(const f32x2v*)(gain + 2 * tid), hh = *(const f32x2v*)(shp + 2 * tid), cc = *(const f32x2v*)(shp + 1024 + 2 * tid);
          *(LAS f32x2v*)(gmod + 2 * tid) = gg * (1.0f + cc); *(LAS f32x2v*)(smod + 2 * tid) = hh; }
        const bf16_t* xr = XB + (size_t)row * D + 16 * kq;
        u32x4 w[32];
#pragma unroll
        for (int s = 0; s < 32; ++s) w[s] = *(const u32x4*)(xr + 64 * (s >> 1) + 8 * (s & 1));
        __syncthreads();
        float ss = 0.f;
#pragma unroll
        for (int s = 0; s < 32; ++s) { const float v0 = bflo(w[s].x), v1 = bfhi(w[s].x), v2 = bflo(w[s].y), v3 = bfhi(w[s].y), v4 = bflo(w[s].z), v5 = bfhi(w[s].z), v6 = bflo(w[s].w), v7 = bfhi(w[s].w);
            ss += ((v0 * v0 + v1 * v1) + (v2 * v2 + v3 * v3)) + ((v4 * v4 + v5 * v5) + (v6 * v6 + v7 * v7)); }
        ss += xshfl<16>(ss); ss = xsum32(ss);
        const float rstd = 1.0f / sqrtf(ss * (1.0f / D) + 1e-6f);
#pragma unroll
        for (int s = 0; s < 32; ++s) asm volatile("" : "+v"(w[s]));
        f32x4 acc = {0.f, 0.f, 0.f, 0.f};
        const LAS unsigned short* wb = rwb + r * 1064 + 16 * kq;
        const LAS float* gq = gmod + 16 * kq; const LAS float* sq = smod + 16 * kq; int pq0 = 0, pq1 = 0;
#pragma unroll
        for (int s = 0; s < 32; ++s) { const int co = 64 * (s >> 1) + 8 * (s & 1);
            const f32x4 g0 = *(const LAS f32x4*)(gq + co), g1 = *(const LAS f32x4*)(gq + co + 4), h0 = *(const LAS f32x4*)(sq + co), h1 = *(const LAS f32x4*)(sq + co + 4);
            float hv[8];
            hv[0] = (bflo(w[s].x) * rstd) * g0[0] + h0[0]; hv[1] = (bfhi(w[s].x) * rstd) * g0[1] + h0[1]; hv[2] = (bflo(w[s].y) * rstd) * g0[2] + h0[2]; hv[3] = (bfhi(w[s].y) * rstd) * g0[3] + h0[3];
            hv[4] = (bflo(w[s].z) * rstd) * g1[0] + h1[0]; hv[5] = (bfhi(w[s].z) * rstd) * g1[1] + h1[1]; hv[6] = (bflo(w[s].w) * rstd) * g1[2] + h1[2]; hv[7] = (bfhi(w[s].w) * rstd) * g1[3] + h1[3];
            int p0 = 0, p1 = 0;
            p0 = __builtin_amdgcn_cvt_pk_fp8_f32(__builtin_amdgcn_fmed3f(hv[0], -448.f, 448.f), __builtin_amdgcn_fmed3f(hv[1], -448.f, 448.f), p0, false); p0 = __builtin_amdgcn_cvt_pk_fp8_f32(__builtin_amdgcn_fmed3f(hv[2], -448.f, 448.f), __builtin_amdgcn_fmed3f(hv[3], -448.f, 448.f), p0, true);
            p1 = __builtin_amdgcn_cvt_pk_fp8_f32(__builtin_amdgcn_fmed3f(hv[4], -448.f, 448.f), __builtin_amdgcn_fmed3f(hv[5], -448.f, 448.f), p1, false); p1 = __builtin_amdgcn_cvt_pk_fp8_f32(__builtin_amdgcn_fmed3f(hv[6], -448.f, 448.f), __builtin_amdgcn_fmed3f(hv[7], -448.f, 448.f), p1, true);
            typedef int i32x4v __attribute__((ext_vector_type(4)));
            if (s & 1) *(i32x4v*)(HX8 + (size_t)row * D + 64 * (s >> 1) + 16 * kq) = (i32x4v){pq0, pq1, p0, p1}; else { pq0 = p0; pq1 = p1; }
            u32x4 af; af.x = pk2(hv[0], hv[1]); af.y = pk2(hv[2], hv[3]); af.z = pk2(hv[4], hv[5]); af.w = pk2(hv[6], hv[7]);
            typedef short bf16x8r __attribute__((ext_vector_type(8)));
            const bf16x8r bfr = *(const LAS bf16x8r*)(wb + co);
            acc = __builtin_amdgcn_mfma_f32_16x16x32_bf16(__builtin_bit_cast(bf16x8r, af), bfr, acc, 0, 0, 0);
            __builtin_amdgcn_sched_barrier(0); }
#pragma unroll
        for (int q = 0; q < 4; ++q) { float mx = acc[q]; mx = fmaxf(mx, xshfl<1>(mx)); mx = fmaxf(mx, xshfl<2>(mx)); mx = fmaxf(mx, xshfl<4>(mx)); mx = fmaxf(mx, xshfl<8>(mx));
            const float pe = expf(acc[q] - mx); float den = pe; den += xshfl<1>(den); den += xshfl<2>(den); den += xshfl<4>(den); den += xshfl<8>(den);
            const int orow = tile * 16 + 4 * kq + q;
            ((float*)(ws + WS_AFFT))[(size_t)r * TT + orow] = pe / den; ((int*)(ws + WS_INV))[(size_t)orow * 16 + r] = -1; }
    }
}

__device__ __forceinline__ void phase_norm(const Args& a, unsigned char* ldsg, int vcu, int G, int l, const float* srcx, const float* srcc, const bf16_t* srcb, const float* gain, int shift_idx, int nrows, bool router, int wv) {
    int tid_ = pg8::tid_of(wv); asm volatile("" : "+v"(tid_));
    const int tid = tid_, lane = tid & 63, wave = __builtin_amdgcn_readfirstlane(tid >> 6);
    unsigned char* ws = a.ws; asm volatile("" : "+s"(ws)); const float* MOD = (const float*)(ws + WS_MOD) + (size_t)l * 9 * 6144; bf16_t* HX = (bf16_t*)(ws + WS_HX);
    LAS float* rw = (LAS float*)(LAS unsigned char*)ldsg;
    if (router) { const float* rsrc = a.in[I_ROUTER] + (size_t)l * 1024 * 16; f32x4 rv[8];
#pragma unroll
        for (int k = 0; k < 8; ++k) rv[k] = *(const f32x4*)(rsrc + 4 * (tid + NTHR * k));
#pragma unroll
        for (int k = 0; k < 8; ++k) { const int i4 = tid + NTHR * k, col = i4 >> 2, e0 = (4 * i4) & 15;
#pragma unroll
            for (int q = 0; q < 4; ++q) rw[(e0 + q) * 1024 + col] = rv[k][q]; }
        __syncthreads(); }
    const int gw = vcu * NWAVES + wave, NGW = G * NWAVES;
    f32x4 nv[2][4];
#define NRM_PRELOAD(ra) do { _Pragma("unroll") for (int u = 0; u < 2; ++u) { const int rr = ((ra) + u * NGW < nrows) ? (ra) + u * NGW : gw; \
            if (srcb) { const bf16_t* xr = srcb + (size_t)rr * D; _Pragma("unroll") for (int j = 0; j < 4; ++j) { const u32x2 w = *(const u32x2*)(xr + 256 * j + 4 * lane); nv[u][j] = (f32x4){bflo(w.x), bfhi(w.x), bflo(w.y), bfhi(w.y)}; } } \
            else { const float* xr = (rr < TX) ? srcx + (size_t)rr * D : srcc + (size_t)(rr - TX) * D; _Pragma("unroll") for (int j = 0; j < 4; ++j) nv[u][j] = *(const f32x4*)(xr + 256 * j + 4 * lane); } } } while (0)
    NRM_PRELOAD(gw);
    for (int rowa = gw; rowa < nrows; rowa += 2 * NGW) {
        f32x4 vv[2][4];
#pragma unroll
        for (int u = 0; u < 2; ++u)
#pragma unroll
            for (int j = 0; j < 4; ++j) vv[u][j] = nv[u][j];
        if (rowa + 2 * NGW < nrows) NRM_PRELOAD(rowa + 2 * NGW);
        f32x4 hv[2][4];
#pragma unroll
        for (int u = 0; u < 2; ++u) { const int row = rowa + u * NGW; if (row < nrows) {
        const bool lat = row < TX; const int mrow = lat ? (row >> 12) : 8;
        const float* shp = MOD + mrow * 6144 + shift_idx * 1024; const float* scp = shp + 1024;
        f32x4 v[4]; float ss = 0.f;
#pragma unroll
        for (int j = 0; j < 4; ++j) { v[j] = vv[u][j]; ss += (v[j][0] * v[j][0] + v[j][1] * v[j][1]) + (v[j][2] * v[j][2] + v[j][3] * v[j][3]); }
        const float rstd = 1.0f / sqrtf(wave_sum(ss) * (1.0f / D) + 1e-6f);
#pragma unroll
        for (int j = 0; j < 4; ++j) { const f32x4 gg = *(const f32x4*)(gain + 256 * j + 4 * lane), sh = *(const f32x4*)(shp + 256 * j + 4 * lane), sc = *(const f32x4*)(scp + 256 * j + 4 * lane);
            v[j] = (v[j] * rstd * gg) * (1.0f + sc) + sh;
            if (router) { int p = 0; p = __builtin_amdgcn_cvt_pk_fp8_f32(fminf(fmaxf(v[j][0], -448.f), 448.f), fminf(fmaxf(v[j][1], -448.f), 448.f), p, false); p = __builtin_amdgcn_cvt_pk_fp8_f32(fminf(fmaxf(v[j][2], -448.f), 448.f), fminf(fmaxf(v[j][3], -448.f), 448.f), p, true);
                *(int*)((unsigned char*)HX + (size_t)row * D + 256 * j + 4 * lane) = p; }
            else { u32x2 o; o.x = pk2(v[j][0], v[j][1]); o.y = pk2(v[j][2], v[j][3]); *(u32x2*)(HX + (size_t)row * D + 256 * j + 4 * lane) = o; } }
#pragma unroll
        for (int j = 0; j < 4; ++j) hv[u][j] = v[j];
        } }
        float plr[2][16];
        if (router) {
#pragma unroll
            for (int e = 0; e < 16; ++e) { float p0 = 0.f, p1 = 0.f;
#pragma unroll
                for (int j = 0; j < 4; ++j) { const f32x4 wv = *(const LAS f32x4*)(rw + e * 1024 + 256 * j + 4 * lane);
                    p0 += (hv[0][j][0] * wv[0] + hv[0][j][1] * wv[1]) + (hv[0][j][2] * wv[2] + hv[0][j][3] * wv[3]);
                    p1 += (hv[1][j][0] * wv[0] + hv[1][j][1] * wv[1]) + (hv[1][j][2] * wv[2] + hv[1][j][3] * wv[3]); }
                plr[0][e] = p0; plr[1][e] = p1; if ((e & 3) == 3) asm volatile("" : "+v"(plr[0][e]), "+v"(plr[1][e]), "+v"(plr[0][e - 1]), "+v"(plr[1][e - 1]), "+v"(plr[0][e - 2]), "+v"(plr[1][e - 2]), "+v"(plr[0][e - 3]), "+v"(plr[1][e - 3]) :: "memory"); } }
#pragma unroll
        for (int u = 0; u < 2; ++u) { const int row = rowa + u * NGW; if (row < nrows) {
        if (router) {
            float pl[16];
#pragma unroll
            for (int e = 0; e < 16; ++e) pl[e] = plr[u][e];
            float q8[8], q4[4], q2[2], q1;
            { const bool up = (lane & 8) != 0;
#pragma unroll
              for (int e = 0; e < 8; ++e) { const float keep = up ? pl[e + 8] : pl[e], give = up ? pl[e] : pl[e + 8]; q8[e] = keep + xshfl<8>(give); } }
            { const bool up = (lane & 4) != 0;
#pragma unroll
              for (int e = 0; e < 4; ++e) { const float keep = up ? q8[e + 4] : q8[e], give = up ? q8[e] : q8[e + 4]; q4[e] = keep + xshfl<4>(give); } }
            { const bool up = (lane & 2) != 0;
#pragma unroll
              for (int e = 0; e < 2; ++e) { const float keep = up ? q4[e + 2] : q4[e], give = up ? q4[e] : q4[e + 2]; q2[e] = keep + xshfl<2>(give); } }
            { const bool up = (lane & 1) != 0; const float keep = up ? q2[1] : q2[0], give = up ? q2[0] : q2[1]; q1 = keep + xshfl<1>(give); }
            q1 += xshfl<16>(q1); q1 = xsum32(q1);
            const float mylog = (lane < 16) ? q1 : -1e30f;
            float mx = mylog;
            mx = fmaxf(mx, xshfl<1>(mx)); mx = fmaxf(mx, xshfl<2>(mx)); mx = fmaxf(mx, xshfl<4>(mx)); mx = fmaxf(mx, xshfl<8>(mx));
            const float mine = (lane < 16) ? expf(mylog - mx) : 0.f; float den = mine;
            den += xshfl<1>(den); den += xshfl<2>(den); den += xshfl<4>(den); den += xshfl<8>(den);
            if (lane < 16) { ((float*)(ws + WS_AFFT))[(size_t)lane * TT + row] = mine / den; ((int*)(ws + WS_INV))[(size_t)row * 16 + lane] = -1; }
        }
    } }
    }
}
#undef NRM_PRELOAD

#define XB_TMO      128
#define XB_XCNT(j)  (256  + 64 * (j))
#define XB_XSUB(j)  (1280 + 64 * (j))
#define XB_XGEN(j)  (2304 + 64 * (j))
#define XB_TOP      3328
#define XB_TOPGEN   3392
#define XCD_BAR_WORDS 3456
#define XB_SPIN_CAP (1u << 18)

__device__ __forceinline__ unsigned xb_ld(unsigned* p)              { return __hip_atomic_load(p, __ATOMIC_RELAXED, __HIP_MEMORY_SCOPE_AGENT); }
__device__ __forceinline__ unsigned xb_add(unsigned* p, unsigned v) { return __hip_atomic_fetch_add(p, v, __ATOMIC_RELAXED, __HIP_MEMORY_SCOPE_AGENT); }
__device__ __forceinline__ unsigned xb_xcc_id() { return (unsigned)__builtin_amdgcn_s_getreg((3 << 11) | 20) & 0xFu; }
#define XB_SPIN(cond, bar) do { unsigned _sp = 0; while (cond) { __builtin_amdgcn_s_sleep(1); \
    if ((++_sp & 255u) == 0u) { if (xb_ld(&(bar)[XB_TMO])) break; if (_sp > XB_SPIN_CAP) { atomicAdd(&(bar)[XB_TMO], 1u); break; } } } } while (0)

struct XcdBarrier {
    unsigned* bar; unsigned x; int wv;
    volatile LAS unsigned* st;
};

__device__ __forceinline__ XcdBarrier xcd_barrier_post(unsigned* bar, volatile LAS unsigned* st, int wv) {
    XcdBarrier b; b.bar = bar; b.x = xb_xcc_id(); b.st = st; b.wv = wv;
    if (pg8::tid_of(wv) == 0) (void)xb_add(&bar[XB_XCNT(b.x)], 1u);
    return b;
}
__device__ __forceinline__ void xcd_barrier_complete(unsigned* bar, unsigned x, unsigned& nloc, unsigned& nx) {
    const unsigned G = gridDim.x * gridDim.y * gridDim.z;
    unsigned sum, cnt, mine, sp = 0u;
    for (;;) {
        sum = 0u; cnt = 0u; mine = 0u;
#pragma unroll
        for (unsigned j = 0; j < 16; ++j) { const unsigned c = xb_ld(&bar[XB_XCNT(j)]); sum += c; cnt += (c > 0u) ? 1u : 0u; mine = (j == x) ? c : mine; }
        if (sum == G) break;
        __builtin_amdgcn_s_sleep(1);
        if ((++sp & 255u) == 0u) { if (xb_ld(&bar[XB_TMO])) break; if (sp > XB_SPIN_CAP) { atomicAdd(&bar[XB_TMO], 1u); break; } }
    }
    nloc = mine > 0u ? mine : 1u; nx = cnt > 0u ? cnt : 1u;
}

__device__ __forceinline__ void xcd_barrier(const XcdBarrier& b) {
    asm volatile("s_waitcnt vmcnt(0)" ::: "memory");
    __syncthreads();
    if (pg8::tid_of(b.wv) == 0) {
        unsigned* bar = b.bar;
        __builtin_amdgcn_s_waitcnt(0);
        unsigned nloc = b.st[0], nx = b.st[1];
        if (nloc == 0u) { xcd_barrier_complete(bar, b.x, nloc, nx); b.st[0] = nloc; b.st[1] = nx; }
        const unsigned old = xb_add(&bar[XB_XSUB(b.x)], 1u);
        const unsigned gen = old / nloc;
        if (old + 1u == (gen + 1u) * nloc) {
            __builtin_amdgcn_fence(__ATOMIC_RELEASE, "agent");
            asm volatile("s_waitcnt vmcnt(0)" ::: "memory");
            const unsigned og = xb_add(&bar[XB_TOP], 1u);
            const unsigned tg = og / nx;
            if (og + 1u == (tg + 1u) * nx) xb_add(&bar[XB_TOPGEN], 1u);
            else XB_SPIN(xb_ld(&bar[XB_TOPGEN]) == tg, bar);
            __builtin_amdgcn_fence(__ATOMIC_ACQUIRE, "agent");
            xb_add(&bar[XB_XGEN(b.x)], 1u);
            asm volatile("s_waitcnt vmcnt(0)" ::: "memory");
        } else {
            XB_SPIN(xb_ld(&bar[XB_XGEN(b.x)]) == gen, bar);
            __builtin_amdgcn_fence(__ATOMIC_ACQUIRE, "agent");
            asm volatile("s_waitcnt vmcnt(0)" ::: "memory");
        }
    }
    __syncthreads();
}


typedef float f32x2 __attribute__((ext_vector_type(2)));
__device__ __forceinline__ f32x2 cmul(f32x2 a, f32x2 b) { return (f32x2){a.x * b.x - a.y * b.y, a.x * b.y + a.y * b.x}; }
__device__ __forceinline__ void dft16(f32x2 (&v)[16]) {
    constexpr float WC[8] = {1.0f, 0.92387953251128674f, 0.70710678118654752f, 0.38268343236508977f, 0.0f, -0.38268343236508977f, -0.70710678118654752f, -0.92387953251128674f};
    constexpr float WS[8] = {0.0f, -0.38268343236508977f, -0.70710678118654752f, -0.92387953251128674f, -1.0f, -0.92387953251128674f, -0.70710678118654752f, -0.38268343236508977f};
#pragma unroll
    for (int s = 8; s >= 1; s >>= 1)
#pragma unroll
        for (int i = 0; i < 16; ++i) if ((i & s) == 0) { const int k = (i & (s - 1)) * (8 / s); const f32x2 u = v[i], t = v[i + s]; v[i] = u + t; const f32x2 d = u - t;
            v[i + s] = (k == 0) ? d : ((k == 4) ? (f32x2){d.y, -d.x} : (f32x2){d.x * WC[k] - d.y * WS[k], d.x * WS[k] + d.y * WC[k]}); }
}
__device__ __forceinline__ constexpr int bitrev4(int i) { return ((i & 1) << 3) | ((i & 2) << 1) | ((i & 4) >> 1) | ((i & 8) >> 3); }
template <int NS, int MODE>
__device__ __forceinline__ void fft_pass(LAS f32x2* Z, const LAS f32x2* TW, int tid, const f32x2* H) {
    const int f = tid >> 8, j = tid & 255, base = f * 4096, k = j & (NS - 1);
    f32x2 v[16];
#pragma unroll
    for (int r = 0; r < 16; ++r) { const int idx = base + j + 256 * r; v[r] = Z[idx + (idx >> 4)]; }
    if (MODE == 1) {
#pragma unroll
        for (int r = 0; r < 16; ++r) { const f32x2 p = cmul(v[r], H[r]); v[r] = (f32x2){p.y, p.x}; } }
    if (NS > 1) { const LAS f32x2* tp = (NS == 16) ? (TW + 8192 + k) : (TW + 4096 + k);
#pragma unroll
        for (int r = 1; r < 16; ++r) v[r] = cmul(v[r], tp[r * NS]); }
    dft16(v);
    if (NS != 256) __syncthreads();
    const int j0 = base + (j / NS) * NS * 16 + k;
#pragma unroll
    for (int rr = 0; rr < 16; ++rr) { const int idx = j0 + rr * NS; Z[idx + (idx >> 4)] = v[bitrev4(rr)]; }
    __syncthreads();
}
__device__ __forceinline__ void load_uc(const bf16_t* UT, const float* cw, const float* cb, int ch, int b, int tid, float (&out)[8]) {
    const bf16_t* p = UT + ((size_t)(b * 768 + ch)) * 4096 + 8 * tid;
    const u32x4 w = *(const u32x4*)p; float u[10];
    u[1] = bflo(w.x); u[2] = bfhi(w.x); u[3] = bflo(w.y); u[4] = bfhi(w.y); u[5] = bflo(w.z); u[6] = bfhi(w.z); u[7] = bflo(w.w); u[8] = bfhi(w.w);
    u[0] = (tid > 0) ? bf2f(p[-1]) : 0.f; u[9] = (tid < 511) ? bf2f(p[8]) : 0.f;
    const float w0 = cw[ch], w1 = cw[768 + ch], w2 = cw[1536 + ch], bb = cb[ch];
#pragma unroll
    for (int i = 0; i < 8; ++i) out[i] = u[i] * w0 + u[i + 1] * w1 + u[i + 2] * w2 + bb;
}
__device__ __forceinline__ void hy_fill(LAS f32x2* Z, const LAS f32x2* TW, int tid, const float (&va)[8], const float (&vb)[8]) {
#pragma unroll
    for (int i = 0; i < 8; ++i) { const int t = 8 * tid + i; const f32x2 z = {va[i], vb[i]}; Z[t + (t >> 4)] = z; const int t2 = 4096 + t; Z[t2 + (t2 >> 4)] = cmul(z, TW[t]); }
    __syncthreads();
}
__device__ __forceinline__ void hy_conv(LAS f32x2* Z, const LAS f32x2* TW, int tid, const f32x2* Hg) {
    f32x2 H[16];
    { const int f = tid >> 8, j = tid & 255, base = f * 4096;
#pragma unroll
      for (int r = 0; r < 16; ++r) H[r] = Hg[base + j + 256 * r]; }
    fft_pass<1, 0>(Z, TW, tid, nullptr); fft_pass<16, 0>(Z, TW, tid, nullptr); fft_pass<256, 0>(Z, TW, tid, nullptr);
    fft_pass<1, 1>(Z, TW, tid, H); fft_pass<16, 0>(Z, TW, tid, nullptr); fft_pass<256, 0>(Z, TW, tid, nullptr);
}
__device__ __forceinline__ f32x2 hy_out(const LAS f32x2* Z, const LAS f32x2* TW, int t) {
    const f32x2 se = Z[t + (t >> 4)]; const int t2 = 4096 + t; const f32x2 so = Z[t2 + (t2 >> 4)]; const f32x2 tw = TW[t];
    const f32x2 So = {so.y, so.x};
    return (f32x2){se.y + (So.x * tw.x + So.y * tw.y), se.x + (So.y * tw.x - So.x * tw.y)};
}
__device__ __forceinline__ void hyena_item(const Args& a, LAS unsigned char* lds, int l, int c, int bp, int tid) {
    asm volatile("" : "+v"(tid));
    LAS f32x2* Z = (LAS f32x2*)lds; const LAS f32x2* TW = (const LAS f32x2*)(lds + 69632);
    const bf16_t* UT = (const bf16_t*)(a.ws + WS_UT); bf16_t* YT = (bf16_t*)(a.ws + WS_YT);
    const float* cw = a.in[I_HCW] + (size_t)l * 3 * 768; const float* cb = a.in[I_HCB] + (size_t)l * 768; const float* skip = a.in[I_HSKIP] + (size_t)l * 2 * 256;
    const f32x2* HS = (const f32x2*)(a.ws + WS_HS) + ((size_t)(l * 2) * 256 + c) * 8192;
    const int b0 = 2 * bp, b1 = 2 * bp + 1;
    float va[8], vb[8], xa[8], xb[8];
    load_uc(UT, cw, cb, c, b0, tid, va); load_uc(UT, cw, cb, c, b1, tid, vb);
    hy_fill(Z, TW, tid, va, vb);
    hy_conv(Z, TW, tid, HS);
    load_uc(UT, cw, cb, 256 + c, b0, tid, xa); load_uc(UT, cw, cb, 256 + c, b1, tid, xb);
    { const float sk = skip[c];
#pragma unroll
      for (int i = 0; i < 8; ++i) { const f32x2 y = hy_out(Z, TW, 8 * tid + i); va[i] = xa[i] * (y.x + va[i] * sk); vb[i] = xb[i] * (y.y + vb[i] * sk); } }
    __syncthreads();
    hy_fill(Z, TW, tid, va, vb);
    hy_conv(Z, TW, tid, HS + (size_t)256 * 8192);
    load_uc(UT, cw, cb, 512 + c, b0, tid, xa); load_uc(UT, cw, cb, 512 + c, b1, tid, xb);
    { const float sk = skip[256 + c];
      float oa[8], ob[8];
#pragma unroll
      for (int i = 0; i < 8; ++i) { const f32x2 y = hy_out(Z, TW, 8 * tid + i); oa[i] = xa[i] * (y.x + va[i] * sk); ob[i] = xb[i] * (y.y + vb[i] * sk); }
      u32x4 wa, wb; wa.x = pk2(oa[0], oa[1]); wa.y = pk2(oa[2], oa[3]); wa.z = pk2(oa[4], oa[5]); wa.w = pk2(oa[6], oa[7]); wb.x = pk2(ob[0], ob[1]); wb.y = pk2(ob[2], ob[3]); wb.z = pk2(ob[4], ob[5]); wb.w = pk2(ob[6], ob[7]);
      *(u32x4*)(YT + ((size_t)(b0 * 256 + c)) * 4096 + 8 * tid) = wa; *(u32x4*)(YT + ((size_t)(b1 * 256 + c)) * 4096 + 8 * tid) = wb; }
    __syncthreads();
}
__device__ __forceinline__ void spectrum_item(const Args& a, LAS unsigned char* lds, int item, int tid) {
    asm volatile("" : "+v"(tid));
    LAS f32x2* Z = (LAS f32x2*)lds; const LAS f32x2* TW = (const LAS f32x2*)(lds + 69632);
    const int c = item & 255, lo = item >> 8;
    const float* HC = (const float*)(a.ws + WS_HC) + ((size_t)lo * 256 + c) * 8192;
    { const f32x4 hl0 = *(const f32x4*)(HC + 4095 + 8 * tid), hl1 = *(const f32x4*)(HC + 4095 + 8 * tid + 4);
      float hlv[8] = {hl0[0], hl0[1], hl0[2], hl0[3], hl1[0], hl1[1], hl1[2], hl1[3]}; float hhv[8];
#pragma unroll
      for (int i = 0; i < 8; ++i) { const int t = 8 * tid + i; hhv[i] = (t == 0) ? 0.f : HC[t - 1]; }
#pragma unroll
      for (int i = 0; i < 8; ++i) { const int t = 8 * tid + i; const float hl = hlv[i], hh = hhv[i];
        Z[t + (t >> 4)] = (f32x2){hl + hh, 0.f}; const int t2 = 4096 + t; const f32x2 tw = TW[t]; const float dd = hl - hh; Z[t2 + (t2 >> 4)] = (f32x2){dd * tw.x, dd * tw.y}; } }
    __syncthreads();
    fft_pass<1, 0>(Z, TW, tid, nullptr); fft_pass<16, 0>(Z, TW, tid, nullptr); fft_pass<256, 0>(Z, TW, tid, nullptr);
    f32x2* HS = (f32x2*)(a.ws + WS_HS) + (size_t)item * 8192;
#pragma unroll
    for (int i = 0; i < 16; ++i) { const int idx = tid + 512 * i; HS[idx] = Z[idx + (idx >> 4)] * (1.0f / 8192.0f); }
    __syncthreads();
}
__device__ __forceinline__ void load_tw(const Args& a, LAS unsigned char* lds, int tid) {
    asm volatile("" : "+v"(tid));
    LAS f32x2* TW = (LAS f32x2*)(lds + 69632); const f32x2* src = (const f32x2*)(a.ws + WS_TW8);
    for (int i = tid; i < 4096; i += NTHR) { TW[i] = src[i]; const int r = i >> 8, k = i & 255; TW[4096 + i] = src[r * k * 2]; }
    if (tid < 256) { const int r = tid >> 4, k = tid & 15; TW[8192 + tid] = src[r * k * 32]; }
    __syncthreads();
}
__device__ __forceinline__ float ctx_uc(const bf16_t* PXc, const float* cw, const float* cb, int ch, int t) {
    const float u1 = bf2f(PXc[(size_t)t * INW + ch]); const float u0 = (t > 0) ? bf2f(PXc[(size_t)(t - 1) * INW + ch]) : 0.f; const float u2 = (t < 255) ? bf2f(PXc[(size_t)(t + 1) * INW + ch]) : 0.f;
    return u0 * cw[ch] + u1 * cw[768 + ch] + u2 * cw[1536 + ch] + cb[ch];
}
__device__ __forceinline__ void ctx_conv4(const LAS float* ip, const LAS float* hp, float (&acc)[4]) {
#pragma unroll
    for (int i = 0; i < 4; ++i) acc[i] = 0.f;
    f32x4 hB = *(const LAS f32x4*)(hp + 4);
#pragma unroll 4
    for (int s0 = 0; s0 < 256; s0 += 4) { const f32x4 hA = *(const LAS f32x4*)(hp - s0); const f32x4 v = *(const LAS f32x4*)(ip + s0);
        const float hw[8] = {hA[0], hA[1], hA[2], hA[3], hB[0], hB[1], hB[2], hB[3]};
#pragma unroll
        for (int u = 0; u < 4; ++u)
#pragma unroll
            for (int i = 0; i < 4; ++i) acc[i] += v[u] * hw[3 + i - u];
        hB = hA; }
}
__device__ __forceinline__ void ctx_hyena_item(const Args& a, LAS unsigned char* lds, int l, int item, int tid) {
    asm volatile("" : "+v"(tid));
    const int lane = tid & 63, wave = tid >> 6, b = item >> 5, cg = item & 31;
    constexpr int VP = 260, HP = 520;
    LAS float* Vt = (LAS float*)lds; LAS float* X1t = Vt + 8 * VP; LAS float* X2t = X1t + 8 * VP; LAS float* Z1t = X2t + 8 * VP; LAS float* H0t = Z1t + 8 * VP; LAS float* H1t = H0t + 8 * HP;
    const bf16_t* PXc = (const bf16_t*)(a.ws + WS_PX) + (size_t)(TX + b * 256) * INW; bf16_t* Y = (bf16_t*)(a.ws + WS_Y) + (size_t)(TX + b * 256) * D;
    const float* cw = a.in[I_HCW] + (size_t)l * 3 * 768; const float* cb = a.in[I_HCB] + (size_t)l * 768; const float* skip = a.in[I_HSKIP] + (size_t)l * 2 * 256;
    const float* H0 = (const float*)(a.ws + WS_HCC) + 256, *H1 = H0 + (size_t)511 * 256;
    for (int idx = tid; idx < 511 * 8; idx += NTHR) { const int j = idx >> 3, c = idx & 7; H0t[c * HP + j] = H0[(size_t)j * 256 + cg * 8 + c]; H1t[c * HP + j] = H1[(size_t)j * 256 + cg * 8 + c]; }
    { const int t = tid >> 1, c4 = (tid & 1) * 4;
#pragma unroll
      for (int k3 = 0; k3 < 3; ++k3) { LAS float* dst = (k3 == 0) ? Vt : ((k3 == 1) ? X1t : X2t); const int ch0 = 256 * k3 + cg * 8 + c4;
          const u32x2 z2 = {0u, 0u};
          const u32x2 r1 = *(const u32x2*)(PXc + (size_t)t * INW + ch0); const u32x2 r0 = (t > 0) ? *(const u32x2*)(PXc + (size_t)(t - 1) * INW + ch0) : z2; const u32x2 r2 = (t < 255) ? *(const u32x2*)(PXc + (size_t)(t + 1) * INW + ch0) : z2;
          const f32x4 w0 = *(const f32x4*)(cw + ch0), w1 = *(const f32x4*)(cw + 768 + ch0), w2 = *(const f32x4*)(cw + 1536 + ch0), bb = *(const f32x4*)(cb + ch0);
          const float u0[4] = {bflo(r0.x), bfhi(r0.x), bflo(r0.y), bfhi(r0.y)}, u1[4] = {bflo(r1.x), bfhi(r1.x), bflo(r1.y), bfhi(r1.y)}, u2[4] = {bflo(r2.x), bfhi(r2.x), bflo(r2.y), bfhi(r2.y)};
#pragma unroll
          for (int k = 0; k < 4; ++k) dst[(c4 + k) * VP + t] = u0[k] * w0[k] + u1[k] * w1[k] + u2[k] * w2[k] + bb[k]; } }
    __syncthreads();
    const int c = lane & 7, t0 = (wave * 8 + (lane >> 3)) * 4; float acc[4];
    { ctx_conv4(Vt + c * VP, H0t + c * HP + t0 + 252, acc); const float sk = skip[cg * 8 + c];
      const f32x4 x1 = *(const LAS f32x4*)(X1t + c * VP + t0), vv = *(const LAS f32x4*)(Vt + c * VP + t0);
      f32x4 z; z[0] = x1[0] * (acc[0] + vv[0] * sk); z[1] = x1[1] * (acc[1] + vv[1] * sk); z[2] = x1[2] * (acc[2] + vv[2] * sk); z[3] = x1[3] * (acc[3] + vv[3] * sk);
      *(LAS f32x4*)(Z1t + c * VP + t0) = z; }
    __syncthreads();
    { ctx_conv4(Z1t + c * VP, H1t + c * HP + t0 + 252, acc); const float sk = skip[256 + cg * 8 + c];
      const f32x4 x2 = *(const LAS f32x4*)(X2t + c * VP + t0), zz = *(const LAS f32x4*)(Z1t + c * VP + t0);
#pragma unroll
      for (int i = 0; i < 4; ++i) Y[(size_t)(t0 + i) * D + cg * 8 + c] = (bf16_t)f2bf(x2[i] * (acc[i] + zz[i] * sk)); }
    __syncthreads();
}

__device__ __forceinline__ void ytr_item(const Args& a, LAS unsigned char* tile, int item, int lane) {
    const int b = item >> 8, tt = (item >> 2) & 63, ct = item & 3;
    const bf16_t* src = (const bf16_t*)(a.ws + WS_YT) + ((size_t)(b * 256 + ct * 64)) * 4096 + tt * 64; bf16_t* Y = (bf16_t*)(a.ws + WS_Y) + ((size_t)b * 4096 + tt * 64) * D + ct * 64;
    u32x4 v[8];
#pragma unroll
    for (int i = 0; i < 8; ++i) v[i] = *(const u32x4*)(src + (size_t)((lane >> 3) + 8 * i) * 4096 + (lane & 7) * 8);
#pragma unroll
    for (int i = 0; i < 8; ++i) *(LAS u32x4*)(tile + ((lane >> 3) + 8 * i) * 144 + (lane & 7) * 16) = v[i];
    LDS_WAIT();
    const LAS unsigned short* tp = (const LAS unsigned short*)(tile + lane * 2);
#pragma unroll
    for (int q = 0; q < 8; ++q) { u32x4 o;
        o.x = (unsigned)tp[(8 * q + 0) * 72] | ((unsigned)tp[(8 * q + 1) * 72] << 16); o.y = (unsigned)tp[(8 * q + 2) * 72] | ((unsigned)tp[(8 * q + 3) * 72] << 16);
        o.z = (unsigned)tp[(8 * q + 4) * 72] | ((unsigned)tp[(8 * q + 5) * 72] << 16); o.w = (unsigned)tp[(8 * q + 6) * 72] | ((unsigned)tp[(8 * q + 7) * 72] << 16);
        *(u32x4*)(Y + (size_t)lane * D + 8 * q) = o; }
    LDS_WAIT();
}
__device__ __forceinline__ void event_arrive(unsigned* ctr, int wv) {
    asm volatile("s_waitcnt vmcnt(0)" ::: "memory"); __syncthreads();
    if (pg8::tid_of(wv) == 0) { __builtin_amdgcn_fence(__ATOMIC_RELEASE, "agent"); asm volatile("s_waitcnt vmcnt(0)" ::: "memory"); __hip_atomic_fetch_add(ctr, 1u, __ATOMIC_RELAXED, __HIP_MEMORY_SCOPE_AGENT); }
}
__device__ __forceinline__ void event_wait(unsigned* ctr, unsigned want, int wv) {
    if (pg8::tid_of(wv) == 0) { unsigned sp = 0;
        while (__hip_atomic_load(ctr, __ATOMIC_RELAXED, __HIP_MEMORY_SCOPE_AGENT) < want) { __builtin_amdgcn_s_sleep(2); if (++sp > (1u << 22)) break; }
        __builtin_amdgcn_fence(__ATOMIC_ACQUIRE, "agent"); asm volatile("s_waitcnt vmcnt(0)" ::: "memory"); }
    __syncthreads();
}

typedef short bf16x8_t __attribute__((ext_vector_type(8)));
typedef short s16x4_t __attribute__((ext_vector_type(4)));
typedef float f32x16 __attribute__((ext_vector_type(16)));
__device__ __forceinline__ int crow(int r, int hi) { return (r & 3) + 8 * (r >> 2) + 4 * hi; }
__device__ __forceinline__ unsigned cvtpk(float lo, float hi) { f32x2 v = {lo, hi}; bf16x2_t b = __builtin_convertvector(v, bf16x2_t); return __builtin_bit_cast(unsigned, b); }
__device__ __forceinline__ s16x4_t vtr(const LAS unsigned char* p) { return __builtin_bit_cast(s16x4_t, __builtin_amdgcn_ds_read_tr16_b64_v4i16((LAS s16x4_t*)p)); }
constexpr int AT_K = 0, AT_V = 16384, AT_WSF = 32768, AT_OST = 34816, AT_RPB = 67584, AT_END = 69632;
template <int KIND>
__device__ __forceinline__ void attn_unit(const Args& a, LAS unsigned char* lds, int l, int u, int wave_, CvtStream& cs, int cstride) {
    int lane = pg8::tid_of(0); asm volatile("" : "+v"(lane));
    const int wid = wave_, tid = wave_ * 64 + lane, r32 = lane & 31, hi = lane >> 5;
    const bf16_t* PX = (const bf16_t*)(a.ws + WS_PX); bf16_t* Y = (bf16_t*)(a.ws + WS_Y);
    int b, qcol, kcol, vcol, ycol, qrow0, nloc = 0, lo = 0; bool sink = false; int hsink = 0;
    int qpos0 = 0, blk = 0, rq = 0, cbase = 0, rq4 = 0;
    if (KIND == 0) { b = u >> 6; const int kvh = (u >> 5) & 1; blk = u & 31; const int h = 2 * kvh + (wid >> 2); qpos0 = blk * 128 + 32 * (wid & 3); qrow0 = b * 4096 + qpos0;
        qcol = 1024 + h * 64; kcol = 1536 + kvh * 64; vcol = 1664 + kvh * 64; ycol = 256 + h * 64; lo = (blk == 0) ? 2 : 0; nloc = ((blk == 31) ? 3 : 5) - lo + 1; sink = true; hsink = h; }
    else if (KIND == 1) { b = u >> 6; const int h = (u >> 4) & 3; rq4 = u & 15; rq = 4 * rq4 + (wid >> 1); cbase = 32 * (wid & 1); qrow0 = b * 4096 + rq * 64 + cbase;
        qcol = 1280 + h * 64; kcol = 1792 + h * 64; vcol = 2048 + h * 64; ycol = 768 + h * 64;
        const int ra = 4 * rq4 - 4, rb = 4 * rq4 + 3 - 4; lo = ra < 0 ? 0 : (ra > 56 ? 56 : ra); const int hi_r = (rb < 0 ? 0 : (rb > 56 ? 56 : rb)) + 7; nloc = hi_r - lo + 1;
        LAS float* rpbL = (LAS float*)(lds + AT_RPB); const float* src = a.in[I_RPB] + (size_t)(l * 4 + h) * 465;
        for (int i = tid; i < 465; i += NTHR) rpbL[i] = src[i] * 8.0f; }
    else { b = u >> 3; const int h = (u >> 1) & 3; qrow0 = TX + b * 256 + 32 * wid;
        if ((u & 1) == 0) { qcol = 1024 + h * 64; kcol = 1536 + (h >> 1) * 64; vcol = 1664 + (h >> 1) * 64; ycol = 256 + h * 64; sink = true; hsink = h; }
        else { qcol = 1280 + h * 64; kcol = 1792 + h * 64; vcol = 2048 + h * 64; ycol = 768 + h * 64; } }
    const int NT = nloc + 4;
    bf16x8_t qr[4];
    { const bf16_t* qp = PX + (size_t)(qrow0 + r32) * INW + qcol + hi * 8;
#pragma unroll
      for (int d0 = 0; d0 < 4; ++d0) qr[d0] = *(const bf16x8_t*)(qp + d0 * 16); }
    const int krow = 8 * wid + (lane & 7), kchunk = lane >> 3; const int vrow = 16 * (wid & 3) + (lane >> 2), vcoff = (wid >> 2) * 32 + (lane & 3) * 8;
    const int kdst = AT_K + kchunk * 1024 + krow * 16, vdst = AT_V + wid * 1024 + lane * 16;
    auto tile_row0 = [&](int t) -> int { if (t < nloc) { if (KIND == 0) return b * 4096 + blk * 128 - 128 + 64 * (lo + t); else return b * 4096 + (lo + t) * 64; } return TX + b * 256 + 64 * (t - nloc); };
    u32x4 gk0, gv0, gk1, gv1;
#define AT_LOAD(GK, GV, t_) do { const int R0_ = tile_row0(t_); GK = *(const u32x4*)(PX + (size_t)(R0_ + krow) * INW + kcol + kchunk * 8); GV = *(const u32x4*)(PX + (size_t)(R0_ + vrow) * INW + vcol + vcoff); } while (0)
    AT_LOAD(gk0, gv0, 0);
    if (NT > 1) AT_LOAD(gk1, gv1, 1); else { gk1 = gk0; gv1 = gv0; }
    *(LAS u32x4*)(lds + kdst) = gk0; *(LAS u32x4*)(lds + vdst) = gv0;
    float mhat = -1e30f, l_reg = 0.f; f32x16 o[2];
#pragma unroll
    for (int r = 0; r < 16; ++r) { o[0][r] = 0.f; o[1][r] = 0.f; }
    LAS float* wsf = (LAS float*)(lds + AT_WSF) + wid * 64;
    const LAS unsigned char* vb0 = lds + AT_V + ((lane >> 4) & 1) * 32 + (lane & 3) * 8 + (4 * hi + ((lane & 15) >> 2)) * 64;
    const LAS unsigned char* kb0 = lds + AT_K + hi * 1024 + r32 * 16;
    __syncthreads();
    auto step = [&](int t, u32x4& gkw, u32x4& gvw, u32x4& gkl, u32x4& gvl) __attribute__((always_inline)) {
        const int bufo = (t & 1) * 8192;
        cvt_issue(a, cs, lane);
        if (t + 2 < NT) AT_LOAD(gkl, gvl, t + 2);
        bool need = true; bool full = true; int ts = 0, rk = 0;
        if (t < nloc) {
            if (KIND == 0) { ts = blk * 128 - 128 + 64 * (lo + t); need = (ts + 63 >= qpos0 - 128) && (ts <= qpos0 + 31 + 128); full = (qpos0 + 31 - ts <= 128) && (ts + 63 - qpos0 <= 128); }
            if (KIND == 1) { rk = lo + t; const int r0 = (rq - 4) < 0 ? 0 : ((rq - 4) > 56 ? 56 : (rq - 4)); need = (rk >= r0) && (rk <= r0 + 7); full = false; }
        }
        if (need) {
            f32x16 p0, p1;
#pragma unroll
            for (int r = 0; r < 16; ++r) { p0[r] = 0.f; p1[r] = 0.f; }
            const LAS unsigned char* kb = kb0 + bufo;
#pragma unroll
            for (int d0 = 0; d0 < 4; ++d0) { const bf16x8_t k0 = *(const LAS bf16x8_t*)(kb + d0 * 2048), k1 = *(const LAS bf16x8_t*)(kb + d0 * 2048 + 512);
                p0 = __builtin_amdgcn_mfma_f32_32x32x16_bf16(k0, qr[d0], p0, 0, 0, 0); p1 = __builtin_amdgcn_mfma_f32_32x32x16_bf16(k1, qr[d0], p1, 0, 0, 0); }
            constexpr float C2 = 0.125f * LOG2E;
            if (!full) {
                if (KIND == 0) { const int tq = qpos0 + r32;
#pragma unroll
                    for (int r = 0; r < 16; ++r) { const int k0 = ts + crow(r, hi), d0 = tq - k0, d1 = d0 - 32; p0[r] = (d0 > 128 || d0 < -128) ? -INFINITY : p0[r]; p1[r] = (d1 > 128 || d1 < -128) ? -INFINITY : p1[r]; } }
                if (KIND == 1) { const int c = cbase + r32; const int wsc = (c - 8) < 0 ? 0 : ((c - 8) > 48 ? 48 : (c - 8));
                    const LAS float* rp = (const LAS float*)(lds + AT_RPB) + (rk - rq + 7) * 31 + 15 - c + 4 * hi;
                    const unsigned long long wm = (0xFFFFull << wsc) >> (4 * hi); const unsigned wlo = (unsigned)wm, whi = (unsigned)(wm >> 32);
                    { float b0[16];
#pragma unroll
                      for (int r = 0; r < 16; ++r) b0[r] = rp[(r & 3) + 8 * (r >> 2)];
#pragma unroll
                      for (int r = 0; r < 16; ++r) { const int cr = (r & 3) + 8 * (r >> 2); p0[r] = (wlo & (1u << cr)) ? p0[r] + b0[r] : -INFINITY; } }
                    asm volatile("" : "+v"(p0) :: "memory");
                    { float b1[16];
#pragma unroll
                      for (int r = 0; r < 16; ++r) b1[r] = rp[32 + (r & 3) + 8 * (r >> 2)];
#pragma unroll
                      for (int r = 0; r < 16; ++r) { const int cr = (r & 3) + 8 * (r >> 2); p1[r] = (whi & (1u << cr)) ? p1[r] + b1[r] : -INFINITY; } } }
            }
            float rm = fmaxf(p0[0], p1[0]);
#pragma unroll
            for (int r = 1; r < 16; ++r) asm("v_max3_f32 %0, %0, %1, %2" : "+v"(rm) : "v"(p0[r]), "v"(p1[r]));
            { auto rr = __builtin_amdgcn_permlane32_swap(__float_as_uint(rm), __float_as_uint(rm), false, false); rm = fmaxf(__uint_as_float(rr[0]), __uint_as_float(rr[1])); }
            constexpr float TAU = 24.0f;
            const bool grew = rm > mhat + TAU; const float mnew = grew ? rm : mhat; const float f = __builtin_amdgcn_exp2f((mhat - mnew) * C2); mhat = mnew;
            const float nm = -mnew * C2; float sacc = 0.f; f32x2 sacc2 = {0.f, 0.f};
#pragma unroll
            for (int r = 0; r < 16; r += 2) {
                f32x2 t0 = (f32x2){p0[r], p0[r + 1]} * (f32x2){C2, C2} + (f32x2){nm, nm}, t1 = (f32x2){p1[r], p1[r + 1]} * (f32x2){C2, C2} + (f32x2){nm, nm};
                t0.x = __builtin_amdgcn_exp2f(t0.x); t0.y = __builtin_amdgcn_exp2f(t0.y); t1.x = __builtin_amdgcn_exp2f(t1.x); t1.y = __builtin_amdgcn_exp2f(t1.y);
                p0[r] = t0.x; p0[r + 1] = t0.y; p1[r] = t1.x; p1[r + 1] = t1.y; sacc2 += t0 + t1; }
            sacc = sacc2.x + sacc2.y;
            l_reg = l_reg * f + sacc;
            if (__any(grew)) { if (hi == 0) wsf[r32] = f; LDS_WAIT();
#pragma unroll
                for (int r = 0; r < 16; ++r) { const float fr_ = wsf[crow(r, hi)]; o[0][r] *= fr_; o[1][r] *= fr_; }
                LDS_WAIT(); }
            u32x4 pw0, pw1, pw2, pw3;
            pw0 = (u32x4){cvtpk(p0[0], p0[1]), cvtpk(p0[2], p0[3]), cvtpk(p0[4], p0[5]), cvtpk(p0[6], p0[7])}; pw1 = (u32x4){cvtpk(p0[8], p0[9]), cvtpk(p0[10], p0[11]), cvtpk(p0[12], p0[13]), cvtpk(p0[14], p0[15])};
            pw2 = (u32x4){cvtpk(p1[0], p1[1]), cvtpk(p1[2], p1[3]), cvtpk(p1[4], p1[5]), cvtpk(p1[6], p1[7])}; pw3 = (u32x4){cvtpk(p1[8], p1[9]), cvtpk(p1[10], p1[11]), cvtpk(p1[12], p1[13]), cvtpk(p1[14], p1[15])};
            const LAS unsigned char* vb = vb0 + bufo;
#pragma unroll
            for (int d0 = 0; d0 < 2; ++d0) {
#pragma unroll
                for (int ks = 0; ks < 4; ++ks) { const s16x4_t vl = vtr(vb + d0 * 4096 + ks * 1024), vh = vtr(vb + d0 * 4096 + ks * 1024 + 512);
                    const bf16x8_t vf = (bf16x8_t){vl[0], vl[1], vl[2], vl[3], vh[0], vh[1], vh[2], vh[3]};
                    const bf16x8_t pa = __builtin_bit_cast(bf16x8_t, ks == 0 ? pw0 : (ks == 1 ? pw1 : (ks == 2 ? pw2 : pw3)));
                    o[d0] = __builtin_amdgcn_mfma_f32_32x32x16_bf16(pa, vf, o[d0], 0, 0, 0); } }
        }
        cvt_finish(a, cs, (LAS float*)(lds + 73728) + wid * 2112, lane, cstride);
        if (t + 1 < NT) { const int nb = ((t + 1) & 1) * 8192; *(LAS u32x4*)(lds + kdst + nb) = gkw; *(LAS u32x4*)(lds + vdst + nb) = gvw; }
        __syncthreads();
    };
    for (int t = 0; t < NT; t += 2) { step(t, gk1, gv1, gk0, gv0); if (t + 1 < NT) step(t + 1, gk0, gv0, gk1, gv1); }
#undef AT_LOAD
    { auto rr = __builtin_amdgcn_permlane32_swap(__float_as_uint(l_reg), __float_as_uint(l_reg), false, false); l_reg = __uint_as_float(rr[0]) + __uint_as_float(rr[1]); }
    if (sink) l_reg += __builtin_amdgcn_exp2f(a.in[I_SINK][l * 4 + hsink] * LOG2E - mhat * (0.125f * LOG2E));
    if (hi == 0) wsf[32 + r32] = 1.0f / l_reg;
    LDS_WAIT();
    LAS bf16_t* stg = (LAS bf16_t*)(lds + AT_OST) + wid * 2048;
#pragma unroll
    for (int r = 0; r < 16; ++r) { const int orow = crow(r, hi); const float il = wsf[32 + orow];
        const unsigned pk = pk2(o[0][r] * il, o[1][r] * il); stg[orow * 64 + r32] = (bf16_t)(pk & 0xffffu); stg[orow * 64 + 32 + r32] = (bf16_t)(pk >> 16); }
    LDS_WAIT();
#pragma unroll
    for (int i = 0; i < 4; ++i) { const int row = i * 8 + (lane >> 3), ch = lane & 7; const u32x4 v = *(const LAS u32x4*)(stg + row * 64 + ch * 8);
        *(u32x4*)(Y + (size_t)(qrow0 + row) * D + ycol + ch * 8) = v; }
    __syncthreads();
}


template <int HW>
__device__ __forceinline__ void pool_tile(const bf16_t* PX, bf16_t* Y, const float* pscale, int tile, int g, int lane, const LAS u32x4* wfl) {
    const int tk = lane & 15, oc = lane >> 4; const int row = tile * 16 + tk; const bool lat = row < TX; const int tpos = lat ? (row & 4095) : ((row - TX) & 255); const int Ls = lat ? 4096 : 256;
    const bf16_t* pr = PX + (size_t)row * INW + 768 + g * 64 + 8 * oc;
    u32x4 w0[2 * HW], w1[2 * HW];
#pragma unroll
    for (int i = 0; i < 2 * HW; ++i) { const int off = i - HW; const int tp = tpos + off; const bool inr = (tp >= 0) && (tp < Ls); const bf16_t* p = pr + (ptrdiff_t)(inr ? off : 0) * INW; w0[i] = *(const u32x4*)p; w1[i] = *(const u32x4*)(p + 32); }
    float s0[8], s1[8]; int cnt = 0;
#pragma unroll
    for (int j = 0; j < 8; ++j) { s0[j] = 0.f; s1[j] = 0.f; }
#pragma unroll
    for (int i = 0; i < 2 * HW; ++i) { const int tp = tpos + i - HW; const bool in = (tp >= 0) && (tp < Ls); const float m = in ? 1.0f : 0.0f; cnt += in ? 1 : 0;
        s0[0] += m * bflo(w0[i].x); s0[1] += m * bfhi(w0[i].x); s0[2] += m * bflo(w0[i].y); s0[3] += m * bfhi(w0[i].y); s0[4] += m * bflo(w0[i].z); s0[5] += m * bfhi(w0[i].z); s0[6] += m * bflo(w0[i].w); s0[7] += m * bfhi(w0[i].w);
        s1[0] += m * bflo(w1[i].x); s1[1] += m * bfhi(w1[i].x); s1[2] += m * bflo(w1[i].y); s1[3] += m * bfhi(w1[i].y); s1[4] += m * bflo(w1[i].z); s1[5] += m * bfhi(w1[i].z); s1[6] += m * bflo(w1[i].w); s1[7] += m * bfhi(w1[i].w); }
    const float ic = 1.0f / (float)cnt; const u32x4 c0 = w0[HW], c1 = w1[HW];
    const float u0[8] = {bflo(c0.x), bfhi(c0.x), bflo(c0.y), bfhi(c0.y), bflo(c0.z), bfhi(c0.z), bflo(c0.w), bfhi(c0.w)}, u1[8] = {bflo(c1.x), bfhi(c1.x), bflo(c1.y), bfhi(c1.y), bflo(c1.z), bfhi(c1.z), bflo(c1.w), bfhi(c1.w)};
    u32x4 d0, d1;
    d0.x = cvtpk(s0[0] * ic - u0[0], s0[1] * ic - u0[1]); d0.y = cvtpk(s0[2] * ic - u0[2], s0[3] * ic - u0[3]); d0.z = cvtpk(s0[4] * ic - u0[4], s0[5] * ic - u0[5]); d0.w = cvtpk(s0[6] * ic - u0[6], s0[7] * ic - u0[7]);
    d1.x = cvtpk(s1[0] * ic - u1[0], s1[1] * ic - u1[1]); d1.y = cvtpk(s1[2] * ic - u1[2], s1[3] * ic - u1[3]); d1.z = cvtpk(s1[4] * ic - u1[4], s1[5] * ic - u1[5]); d1.w = cvtpk(s1[6] * ic - u1[6], s1[7] * ic - u1[7]);
    const bf16x8_t b0 = __builtin_bit_cast(bf16x8_t, d0), b1 = __builtin_bit_cast(bf16x8_t, d1);
    bf16_t* yr = Y + (size_t)row * D + 512 + g * 64 + 4 * oc;
#pragma unroll
    for (int nt = 0; nt < 4; ++nt) { f32x4 acc = {0.f, 0.f, 0.f, 0.f};
        const bf16x8_t wa = __builtin_bit_cast(bf16x8_t, wfl[((g * 4 + nt) * 2 + 0) * 64 + lane]), wb = __builtin_bit_cast(bf16x8_t, wfl[((g * 4 + nt) * 2 + 1) * 64 + lane]);
        acc = __builtin_amdgcn_mfma_f32_16x16x32_bf16(wa, b0, acc, 0, 0, 0); acc = __builtin_amdgcn_mfma_f32_16x16x32_bf16(wb, b1, acc, 0, 0, 0);
        const f32x4 sc = *(const f32x4*)(pscale + g * 64 + 16 * nt + 4 * oc); acc *= sc;
        u32x2 ov; ov.x = cvtpk(acc[0], acc[1]); ov.y = cvtpk(acc[2], acc[3]); *(u32x2*)(yr + 16 * nt) = ov; }
}
__device__ __forceinline__ void phase_mix1(const Args& a, unsigned char* ldsg, int vcu, int G, int l, int wv) {
    LAS unsigned char* lds = (LAS unsigned char*)ldsg;
    int tid_ = pg8::tid_of(wv); asm volatile("" : "+v"(tid_));
    const int tid = tid_, lane = tid & 63, wave = __builtin_amdgcn_readfirstlane(tid >> 6);
    unsigned char* ws = a.ws; asm volatile("" : "+s"(ws)); const bf16_t* PX = (const bf16_t*)(ws + WS_PX); bf16_t* Y = (bf16_t*)(ws + WS_Y);
    const bool upd = (l == 0); const int nrows = upd ? TT : TX;
    const int gw = vcu * NWAVES + wave, NGW = G * NWAVES;
    { AMP_BEGIN(31) load_tw(a, lds, tid);
    for (int it = vcu; it < 1024; it += G) hyena_item(a, lds, l, it >> 2, it & 3, tid);
    if (upd) for (int it = vcu; it < 256; it += G) ctx_hyena_item(a, lds, l, it, tid);
    event_arrive((unsigned*)(ws + WS_CTL) + 8192 + 64 * l, wv); AMP_END(31) }
    { AMP_BEGIN(32)
    { const float* pscale = a.in[I_POOLS] + (size_t)l * 256; LAS u32x4* wfl = (LAS u32x4*)lds;
      { const int g = wave & 3, nt0 = (wave >> 2) * 2; const float* pwg = a.in[I_POOLW] + (size_t)(l * 4 + g) * 4096;
#pragma unroll
        for (int nt = nt0; nt < nt0 + 2; ++nt)
#pragma unroll
            for (int ks = 0; ks < 2; ++ks) { const float* wp = pwg + (size_t)(32 * ks + 8 * (lane >> 4)) * 64 + 16 * nt + (lane & 15); u32x4 w;
                w.x = cvtpk(wp[0], wp[64]); w.y = cvtpk(wp[128], wp[192]); w.z = cvtpk(wp[256], wp[320]); w.w = cvtpk(wp[384], wp[448]); wfl[((g * 4 + nt) * 2 + ks) * 64 + lane] = w; } }
      __syncthreads();
      const int ntiles = nrows / 16, nmain = (ntiles / NGW) * NGW;
      for (int tile = gw; tile < nmain; tile += NGW) { pool_tile<1>(PX, Y, pscale, tile, 0, lane, wfl); pool_tile<2>(PX, Y, pscale, tile, 1, lane, wfl); pool_tile<4>(PX, Y, pscale, tile, 2, lane, wfl); pool_tile<8>(PX, Y, pscale, tile, 3, lane, wfl); }
      for (int it = (gw + NGW - 1024 % NGW) % NGW; it < (ntiles - nmain) * 4; it += NGW) { const int tile = nmain + (it >> 2), g = __builtin_amdgcn_readfirstlane(it & 3);
          if (g == 0) pool_tile<1>(PX, Y, pscale, tile, g, lane, wfl); else if (g == 1) pool_tile<2>(PX, Y, pscale, tile, g, lane, wfl); else if (g == 2) pool_tile<4>(PX, Y, pscale, tile, g, lane, wfl); else pool_tile<8>(PX, Y, pscale, tile, g, lane, wfl); } }
    __syncthreads(); AMP_END(32) }
    { AMP_BEGIN(33)
    const bool relieve = upd && (G == 256); const bool desig = relieve && vcu >= 192 && vcu < 224;
    const int CNGW = relieve ? (G - 32) * NWAVES : NGW; const int cgw = relieve ? ((vcu < 192 ? vcu : vcu - 32) * NWAVES + wave) : gw;
    CvtStream cs; cs.end = (l + 1) * (CVT_ITEMS / 2); cs.it = desig ? cs.end : l * (CVT_ITEMS / 2) + cgw; cs.live = 0;
    if (upd) { for (int u = (vcu + G - 64 % G) % G; u < 64; u += G) attn_unit<2>(a, lds, l, u, wave, cs, CNGW);
        event_arrive((unsigned*)(ws + WS_CTL) + 8192 + 64 * 2, wv); }
    for (int u = vcu; u < 512; u += G) attn_unit<0>(a, lds, l, u, wave, cs, CNGW);
    for (int u = vcu; u < 512; u += G) attn_unit<1>(a, lds, l, u, wave, cs, CNGW);
    int lane2 = pg8::tid_of(0); asm volatile("" : "+v"(lane2));
    while (cs.it < cs.end) { cvt_issue(a, cs, lane2); cvt_finish(a, cs, (LAS float*)(lds + 73728) + wave * 2112, lane2, CNGW); }
    AMP_END(33) }
    if (upd) { const int j0 = (vcu + G - 192 % G) % G;
        if (j0 < 32) { event_wait((unsigned*)(ws + WS_CTL) + 8192 + 64 * 2, (unsigned)G, wv);
            pg8::Gemm g{(const pg8::bf16_t*)(ws + WS_Y), (const pg8::bf16_t*)(ws + WS_WOUT_T) + (size_t)l * D * D, TT, D, D, wv};
            pg8::GroupOrder S; S.init(1, (TT - TX) / 256, D / 256, 0, G, j0, TX / 256);
            pg8::EpiOut E{a.in[I_X], a.in[I_CTX], (pg8::bf16_t*)(ws + WS_XB), (const float*)(ws + WS_MOD) + (size_t)l * 9 * 6144, 1};
            pg8::gemm_phase<pg8::EpiOut, pg8::GroupOrder, true, true>((PG8_LAS unsigned char*)ldsg, g, S, E); __syncthreads();
            if (G == 256) {
                event_arrive((unsigned*)(ws + WS_CTL) + 8192 + 64 * 4, wv);
                if (j0 < 16) { event_wait((unsigned*)(ws + WS_CTL) + 8192 + 64 * 4, 32u, wv);
                    phase_norm_router(a, ldsg, j0, 16, l, (const bf16_t*)(ws + WS_XB), a.in[I_N2G] + l * D, TX / 128, TT / 128, wv); __syncthreads(); } } } }
    { AMP_BEGIN(34) event_wait((unsigned*)(ws + WS_CTL) + 8192 + 64 * l, (unsigned)G, wv);
      int lane3 = pg8::tid_of(0); asm volatile("" : "+v"(lane3));
      for (int it = gw; it < 2048; it += NGW) ytr_item(a, lds + wave * 9216, it, lane3); AMP_END(34) }
}

__device__ __forceinline__ void phase_select(const Args& a, unsigned char* ldsg, int vcu, int G, bool with_ctx, int wv) {
    LAS unsigned* keys = (LAS unsigned*)(LAS unsigned char*)ldsg;
    LAS unsigned* hist = keys + 4096;
    LAS unsigned* ctl = hist + 256 + 64;
    int tid_ = pg8::tid_of(wv); asm volatile("" : "+v"(tid_));
    const int tid = tid_, lane = tid & 63; unsigned char* ws = a.ws; asm volatile("" : "+s"(ws));
    const float* AFFT = (const float*)(ws + WS_AFFT); int* ROWMAP = (int*)(ws + WS_ROWMAP); float* GATE = (float*)(ws + WS_GATE); int* INV = (int*)(ws + WS_INV);
    const int nitems = 128 + (with_ctx ? 128 : 0);
    for (int item = vcu; item < nitems; item += G) {
        int e, base, Ls, cap, slot0;
        if (item < 128) { const int b = item >> 4; e = item & 15; base = b * 4096; Ls = 4096; cap = CAPX; slot0 = b * CAPX; }
        else { const int it = item - 128; const int b = it >> 4; e = it & 15; base = TX + b * 256; Ls = 256; cap = CAPC; slot0 = NB * CAPX + b * CAPC; }
        unsigned k[8];
#pragma unroll
        for (int i = 0; i < 8; ++i) { const int idx = tid + NTHR * i; k[i] = (idx < Ls) ? __float_as_uint(AFFT[(size_t)e * TT + base + idx]) : 0u; if (idx < Ls) keys[idx] = k[i]; }
        if (tid == 0) { ctl[0] = 0u; ctl[1] = (unsigned)cap; ctl[2] = 0u; ctl[3] = 0u; }
        unsigned prefix = 0u;
#pragma unroll 1
        for (int p = 0; p < 4; ++p) { const int shift = 24 - 8 * p;
            if (tid < 256) hist[tid] = 0u;
            __syncthreads();
#pragma unroll
            for (int i = 0; i < 8; ++i) { const int idx = tid + NTHR * i; const bool cand = (idx < Ls) && (p == 0 || (k[i] >> (shift + 8)) == prefix);
                if (cand) atomicAdd((unsigned*)&hist[(k[i] >> shift) & 255u], 1u); }
            __syncthreads();
            if (tid < 64) {
                const unsigned need = ctl[1];
                const unsigned c0 = hist[255 - 4 * lane], c1 = hist[254 - 4 * lane], c2 = hist[253 - 4 * lane], c3 = hist[252 - 4 * lane];
                const unsigned s = c0 + c1 + c2 + c3;
                hist[256 + lane] = s; LDS_WAIT();
                unsigned inc = 0u;
                for (int q = 0; q < 64; ++q) { const unsigned v = hist[256 + q]; inc += (q <= lane) ? v : 0u; }
                const unsigned exc = inc - s;
                if (exc < need && inc >= need) { unsigned above = exc; int d;
                    if (above + c0 >= need) d = 255 - 4 * lane; else { above += c0; if (above + c1 >= need) d = 254 - 4 * lane; else { above += c1; if (above + c2 >= need) d = 253 - 4 * lane; else { above += c2; d = 252 - 4 * lane; } } }
                    ctl[0] = (prefix << 8) | (unsigned)d; ctl[1] = need - above; } }
            __syncthreads();
            prefix = ctl[0]; }
        const unsigned T = prefix; const unsigned need = ctl[1];
        int eqc = 0;
#pragma unroll
        for (int i = 0; i < 8; ++i) { const int idx = tid + NTHR * i; eqc += ((idx < Ls) && k[i] == T) ? 1 : 0; }
        if (eqc) atomicAdd((unsigned*)&ctl[3], (unsigned)eqc);
        __syncthreads();
        const bool all_eq = (ctl[3] == need);
#pragma unroll
        for (int i = 0; i < 8; ++i) { const int idx = tid + NTHR * i;
            if (idx < Ls && (k[i] > T || (all_eq && k[i] == T))) { const int s = (int)atomicAdd((unsigned*)&ctl[2], 1u); const int slot = e * SLOTS + slot0 + s;
                ROWMAP[slot] = base + idx; GATE[slot] = __uint_as_float(k[i]); INV[(size_t)(base + idx) * 16 + e] = slot; } }
        __syncthreads();
        if (!all_eq && tid == 0) {
            int s = (int)ctl[2]; unsigned left = need;
            for (int idx = 0; idx < Ls && left; ++idx) if (keys[idx] == T) { const int slot = e * SLOTS + slot0 + s; ROWMAP[slot] = base + idx; GATE[slot] = __uint_as_float(T); INV[(size_t)(base + idx) * 16 + e] = slot; ++s; --left; } }
        __syncthreads();
    }
}
__device__ __forceinline__ void phase_combine(const Args& a, int vrank, int nblk, int row_begin, int row_end, int l, bool final_norm, bool next_norm, int wv) {
    int tid_ = pg8::tid_of(wv); asm volatile("" : "+v"(tid_));
    const int tid = tid_, lane = tid & 63, wave = __builtin_amdgcn_readfirstlane(tid >> 6); unsigned char* ws = a.ws; asm volatile("" : "+s"(ws));
    const int* INV = (const int*)(ws + WS_INV); const unsigned char* OB = (const unsigned char*)(ws + WS_XG);   const float* MOD = (const float*)(ws + WS_MOD) + (size_t)l * 9 * 6144;
    const float* MODN = (const float*)(ws + WS_MOD) + (size_t)(l + 1) * 9 * 6144; const float* gainn = a.in[I_N1G] + (l + 1) * D; bf16_t* HX = (bf16_t*)(ws + WS_HX);
    bf16_t* XB = (bf16_t*)(ws + WS_XB); const float* fng = a.in[I_FNG];
    const int nrows = row_end; const int gw = row_begin + vrank * NWAVES + wave, NGW = nblk * NWAVES;
    const float pz = (final_norm && __hip_atomic_load((unsigned*)(ws + WS_CTL) + 12288, __ATOMIC_RELAXED, __HIP_MEMORY_SCOPE_AGENT) != 0u) ? __builtin_nanf("") : 0.f;
    int cinv[2], ninv[2]; u32x2 cx[2][4], nx[2][4]; int pw[2][4][4];
#define CMB_PRELOAD(ra) do { _Pragma("unroll") for (int u = 0; u < 2; ++u) { const int row_ = (ra) + u * NGW; const bool ok_ = row_ < nrows; const int rr_ = ok_ ? row_ : gw; \
            ninv[u] = (lane < 16 && ok_) ? INV[(size_t)rr_ * 16 + lane] : -1; const bf16_t* xr_ = XB + (size_t)rr_ * D; \
            _Pragma("unroll") for (int j = 0; j < 4; ++j) nx[u][j] = *(const u32x2*)(xr_ + 256 * j + 4 * lane); } } while (0)
#define CMB_OBLOAD() do { _Pragma("unroll") for (int u = 0; u < 2; ++u) { unsigned long long mk_ = __ballot(cinv[u] >= 0) & 0xffffull; \
            _Pragma("unroll") for (int q = 0; q < 4; ++q) { int s_ = 0; if (mk_) { const int e_ = __builtin_ctzll(mk_); mk_ &= mk_ - 1; s_ = __builtin_amdgcn_readlane(cinv[u], e_); } \
                const unsigned char* orow_ = OB + (size_t)s_ * D; _Pragma("unroll") for (int j = 0; j < 4; ++j) pw[u][q][j] = *(const int*)(orow_ + 256 * j + 4 * lane); } } } while (0)
    CMB_PRELOAD(gw);
#pragma unroll
    for (int u = 0; u < 2; ++u) { cinv[u] = ninv[u];
#pragma unroll
        for (int j = 0; j < 4; ++j) cx[u][j] = nx[u][j]; }
    CMB_OBLOAD();
    CMB_PRELOAD(gw + 2 * NGW);
    for (int rowa = gw; rowa < nrows; rowa += 2 * NGW) {
        int myinv[2]; u32x2 px[2][4]; f32x4 acc[2][4]; unsigned long long rest[2];
#pragma unroll
        for (int u = 0; u < 2; ++u) { myinv[u] = cinv[u];
#pragma unroll
            for (int j = 0; j < 4; ++j) { px[u][j] = cx[u][j]; acc[u][j] = (f32x4){0.f, 0.f, 0.f, 0.f}; } }
#pragma unroll
        for (int u = 0; u < 2; ++u) { unsigned long long mask = __ballot(myinv[u] >= 0) & 0xffffull;
#pragma unroll
            for (int q = 0; q < 4; ++q) { const float m = mask ? 1.0f : 0.0f; mask &= mask - 1;
#pragma unroll
                for (int j = 0; j < 4; ++j) { acc[u][j][0] += m * __builtin_amdgcn_cvt_f32_fp8(pw[u][q][j], 0); acc[u][j][1] += m * __builtin_amdgcn_cvt_f32_fp8(pw[u][q][j], 1); acc[u][j][2] += m * __builtin_amdgcn_cvt_f32_fp8(pw[u][q][j], 2); acc[u][j][3] += m * __builtin_amdgcn_cvt_f32_fp8(pw[u][q][j], 3); } }
            rest[u] = mask; }
#pragma unroll
        for (int u = 0; u < 2; ++u) { cinv[u] = ninv[u];
#pragma unroll
            for (int j = 0; j < 4; ++j) cx[u][j] = nx[u][j]; }
        CMB_OBLOAD();
        CMB_PRELOAD(rowa + 4 * NGW);
#pragma unroll
        for (int u = 0; u < 2; ++u) {
            unsigned long long mask = rest[u];
            while (mask) { int sl[4];
#pragma unroll
                for (int q = 0; q < 4; ++q) { if (mask) { const int e = __builtin_ctzll(mask); mask &= mask - 1; sl[q] = __builtin_amdgcn_readlane(myinv[u], e); } else sl[q] = -1; }
                int w[4][4];
#pragma unroll
                for (int q = 0; q < 4; ++q) { const unsigned char* orow = OB + (size_t)(sl[q] >= 0 ? sl[q] : 0) * D;
#pragma unroll
                    for (int j = 0; j < 4; ++j) w[q][j] = *(const int*)(orow + 256 * j + 4 * lane); }
#pragma unroll
                for (int q = 0; q < 4; ++q) { const float m = (sl[q] >= 0) ? 1.0f : 0.0f;
#pragma unroll
                    for (int j = 0; j < 4; ++j) { acc[u][j][0] += m * __builtin_amdgcn_cvt_f32_fp8(w[q][j], 0); acc[u][j][1] += m * __builtin_amdgcn_cvt_f32_fp8(w[q][j], 1); acc[u][j][2] += m * __builtin_amdgcn_cvt_f32_fp8(w[q][j], 2); acc[u][j][3] += m * __builtin_amdgcn_cvt_f32_fp8(w[q][j], 3); } } } }
#pragma unroll
        for (int u = 0; u < 2; ++u) { const int row = rowa + u * NGW; if (row < nrows) {
            const bool lat = row < TX; float* xr = a.out + (size_t)row * D; bf16_t* xbr = XB + (size_t)row * D; const int mrow = lat ? (row >> 12) : 8;
            const float* gp = MOD + mrow * 6144 + 5 * 1024; f32x4 v[4]; float ss = 0.f;
#pragma unroll
            for (int j = 0; j < 4; ++j) { const f32x4 g = *(const f32x4*)(gp + 256 * j + 4 * lane); const u32x2 w = px[u][j]; v[j] = (f32x4){bflo(w.x), bfhi(w.x), bflo(w.y), bfhi(w.y)} + g * acc[u][j];
                ss += (v[j][0] * v[j][0] + v[j][1] * v[j][1]) + (v[j][2] * v[j][2] + v[j][3] * v[j][3]); }
            if (final_norm) { const float rstd = 1.0f / sqrtf(wave_sum(ss) * (1.0f / D) + 1e-6f);
#pragma unroll
                for (int j = 0; j < 4; ++j) { const f32x4 g = *(const f32x4*)(fng + 256 * j + 4 * lane); __builtin_nontemporal_store(v[j] * rstd * g + pz, (f32x4*)(xr + 256 * j + 4 * lane)); } }
            else {
#pragma unroll
                for (int j = 0; j < 4; ++j) { u32x2 o; o.x = pk2(v[j][0], v[j][1]); o.y = pk2(v[j][2], v[j][3]); *(u32x2*)(xbr + 256 * j + 4 * lane) = o; }
                if (next_norm) { const float rstd = 1.0f / sqrtf(wave_sum(ss) * (1.0f / D) + 1e-6f); const float* shp = MODN + mrow * 6144; const float* scp = shp + 1024;
#pragma unroll
                    for (int j = 0; j < 4; ++j) { const f32x4 gg = *(const f32x4*)(gainn + 256 * j + 4 * lane), sh = *(const f32x4*)(shp + 256 * j + 4 * lane), sc = *(const f32x4*)(scp + 256 * j + 4 * lane);
                        const f32x4 hv = (v[j] * rstd * gg) * (1.0f + sc) + sh; u32x2 o; o.x = pk2(hv[0], hv[1]); o.y = pk2(hv[2], hv[3]); *(u32x2*)(HX + (size_t)row * D + 256 * j + 4 * lane) = o; } } } } }
    }
}
#undef CMB_PRELOAD
#undef CMB_OBLOAD

#define XBAR() do { XcdBarrier b_; b_.bar = (unsigned*)(a.ws + WS_CTL); b_.x = __builtin_amdgcn_readfirstlane(bar.x); b_.wv = wv; b_.st = (volatile LAS unsigned*)((LAS unsigned char*)lds + LDS_BYTES - 16); xcd_barrier(b_); if (AMP_PHASE == 99) xcd_barrier(b_); } while (0)

__global__ void __launch_bounds__(NTHR, 2) fwd_kernel(Args a) {
    extern __shared__ __attribute__((aligned(16))) unsigned char lds[];
    cg::grid_group grid = cg::this_grid();
    const int wv = __builtin_amdgcn_readfirstlane((int)threadIdx.x >> 6);
    const int G = gridDim.x, bx = blockIdx.x; const int vcu = (G % 8 == 0) ? (bx % 8) * (G / 8) + bx / 8 : bx;
    unsigned char* ws = a.ws;
    PG8_LAS unsigned char* glds = (PG8_LAS unsigned char*)lds;
    volatile LAS unsigned* bst = (volatile LAS unsigned*)((LAS unsigned char*)lds + LDS_BYTES - 16);
    { const int t0 = pg8::tid_of(wv); if (t0 < 4) bst[t0] = 0u; }
    __syncthreads();
    XcdBarrier bar = xcd_barrier_post((unsigned*)(ws + WS_CTL), bst, wv);
    { AMP_BEGIN(0) phase_prologue(a, lds, vcu, G, wv); AMP_END(0) }
    if (a.ws == nullptr) grid.sync();
    XBAR();
    for (int l = 0; l < 2; ++l) {
        const bool upd = (l == 0);
        asm volatile("" : "+s"(ws));
        const float* srcx = a.in[I_X]; const float* srcc = a.in[I_CTX];
        if (upd) {
            { AMP_BEGIN(1) phase_norm(a, lds, vcu, G, l, srcx, srcc, nullptr, a.in[I_N1G] + l * D, 0, TT, false, wv); AMP_END(1) }
            { AMP_BEGIN(11) { const int t1 = pg8::tid_of(wv); load_tw(a, (LAS unsigned char*)lds, t1); for (int it = vcu; it < 1024; it += G) spectrum_item(a, (LAS unsigned char*)lds, it, t1); } AMP_END(11) }
            XBAR();
        }
        { AMP_BEGIN(2) pg8::Gemm g{(const pg8::bf16_t*)(ws + WS_HX), (const pg8::bf16_t*)(ws + WS_WIN_T) + (size_t)l * INW * D, TT, INW, D, wv};
          pg8::GroupOrder S; S.init(1, TT / 256, INW / 256, 0, G, bx);
          { PG8_LAS float* rl = (PG8_LAS float*)(glds + 131072 + 20480); const float* rs = (const float*)(ws + WS_ROPE); int tx = pg8::tid_of(wv); asm volatile("" : "+v"(tx)); for (int i = tx; i < 2048; i += NTHR) rl[i] = rs[i]; __syncthreads(); }
          pg8::EpiIn E{(pg8::bf16_t*)(ws + WS_PX), (const PG8_LAS float*)(glds + 131072 + 20480), (pg8::bf16_t*)(ws + WS_UT), glds + 131072, 1.0f};
          pg8::gemm_phase<pg8::EpiIn, pg8::GroupOrder, true, true>(glds, g, S, E); AMP_END(2) }
        XBAR();
        { AMP_BEGIN(3) phase_mix1(a, lds, vcu, G, l, wv); AMP_END(3) }
        XBAR();
        { AMP_BEGIN(4) pg8::Gemm g{(const pg8::bf16_t*)(ws + WS_Y), (const pg8::bf16_t*)(ws + WS_WOUT_T) + (size_t)l * D * D, TT, D, D, wv};
          pg8::GroupOrder S; S.init(1, TX / 256, D / 256, 0, G, bx);
          pg8::EpiOut E{a.in[I_X], a.in[I_CTX], (pg8::bf16_t*)(ws + WS_XB), (const float*)(ws + WS_MOD) + (size_t)l * 9 * 6144, upd ? 1 : 0};
          pg8::gemm_phase<pg8::EpiOut, pg8::GroupOrder, true, true>(glds, g, S, E); AMP_END(4) }
        XBAR();
        { AMP_BEGIN(5) phase_norm_router(a, lds, vcu, G, l, (const bf16_t*)(ws + WS_XB), a.in[I_N2G] + l * D, 0, (upd && G != 256) ? TT / 128 : TX / 128, wv); AMP_END(5) }
        XBAR();
        { AMP_BEGIN(6) phase_select(a, lds, vcu, G, upd, wv); AMP_END(6) }
        XBAR();
        { AMP_BEGIN(8) pg8::Gemm g{(const pg8::bf16_t*)(ws + WS_HX), (const pg8::bf16_t*)(ws + WS_WGU_T + (size_t)l * NE * 4096 * D), NE * SLOTS, NE * 4096, D, wv};
          pg8::GroupOrder S; S.init(NE, upd ? 17 : 16, 16, 17, G, bx);
          { PG8_LAS float* sl = (PG8_LAS float*)(glds + 131072 + 17408); const float* ss = (const float*)(ws + WS_WSC) + l * 48; int tx = pg8::tid_of(wv); asm volatile("" : "+v"(tx)); if (tx < 32) sl[tx] = ss[tx]; __syncthreads(); }
          pg8::EpiGU E{(unsigned char*)(ws + WS_ACT), (const PG8_LAS float*)(glds + 131072 + 17408)};
          pg8::gemm_phase_gather<pg8::EpiGU, pg8::GroupOrder, true>(glds, g, (const int*)(ws + WS_ROWMAP), (PG8_LAS int*)(glds + 131072), S, E); AMP_END(8) }
        XBAR();
        { AMP_BEGIN(9) pg8::Gemm g{(const pg8::bf16_t*)(ws + WS_ACT), (const pg8::bf16_t*)(ws + WS_WD_T + (size_t)l * NE * D * FF), NE * SLOTS, NE * D, FF, wv};
          pg8::GroupOrder S; S.init(NE, 16, 4, 17, G, bx);
          { PG8_LAS float* gl = (PG8_LAS float*)(glds + 131072); const float* gs = (const float*)(ws + WS_GATE); const float* ss = (const float*)(ws + WS_WSC) + l * 48 + 32; pg8::Unit uu; int tx = pg8::tid_of(wv); asm volatile("" : "+v"(tx));
            for (int i = 0; S.next(i, uu); ++i) if (tx < 256) gl[i * 256 + tx] = gs[uu.pm * 256 + tx] * ss[uu.pn >> 2];
            __syncthreads(); }
          pg8::EpiDown E{(unsigned char*)(ws + WS_XG), (const PG8_LAS float*)(glds + 131072)};
          pg8::gemm_phase<pg8::EpiDown, pg8::GroupOrder, true, true, true>(glds, g, S, E); AMP_END(9) }
        XBAR();
        { AMP_BEGIN(10)
        if (!upd) phase_combine(a, vcu, G, 0, TX, l, true, false, wv);
        else {
            const bool split = (G == 256); constexpr int R1 = 10752;
            if (vcu < 64 || !split) {
                pg8::Gemm g{(const pg8::bf16_t*)(ws + WS_ACT), (const pg8::bf16_t*)(ws + WS_WD_T + (size_t)l * NE * D * FF), NE * SLOTS, NE * D, FF, wv};
                pg8::GroupOrder S; S.init(NE, 1, 4, 17, G, vcu, 16);
                pg8::Unit uu;
                if (S.next(0, uu)) {
                    { PG8_LAS float* gl = (PG8_LAS float*)(glds + 131072); const float* gs = (const float*)(ws + WS_GATE); const float* ss = (const float*)(ws + WS_WSC) + l * 48 + 32; int tx = pg8::tid_of(wv); asm volatile("" : "+v"(tx));
                      for (int i = 0; S.next(i, uu); ++i) if (tx < 256) gl[i * 256 + tx] = gs[uu.pm * 256 + tx] * ss[uu.pn >> 2];
                      __syncthreads(); }
                    pg8::EpiDown E{(unsigned char*)(ws + WS_XG), (const PG8_LAS float*)(glds + 131072)};
                    pg8::gemm_phase<pg8::EpiDown, pg8::GroupOrder, true, true, true>(glds, g, S, E);
                    event_arrive((unsigned*)(ws + WS_CTL) + 8192 + 64 * 3, wv); } }
            if (split) { if (vcu >= 64) phase_combine(a, vcu - 64, G - 64, 0, R1, l, false, true, wv);
                         phase_combine(a, vcu, G, R1, TX, l, false, true, wv); }
            else phase_combine(a, vcu, G, 0, TX, l, false, true, wv);
            event_wait((unsigned*)(ws + WS_CTL) + 8192 + 64 * 3, (unsigned)(G < 64 ? G : 64), wv);
            phase_combine(a, vcu, G, TX, TT, l, false, true, wv);
        }
        AMP_END(10) }
        if (upd) XBAR();
    }
}

extern "C" void kernel_launch(void* const* d_in, const int* in_sizes, int n_in, void* d_out, int out_size, void* d_ws, size_t ws_size, hipStream_t stream) {
    static int grid = 0;
    if (grid == 0) {
        int dev = 0, cus = 0, per_cu = 0;
        hipGetDevice(&dev); hipDeviceGetAttribute(&cus, hipDeviceAttributeMultiprocessorCount, dev);
        if (hipFuncSetAttribute((const void*)fwd_kernel, hipFuncAttributeMaxDynamicSharedMemorySize, LDS_BYTES) != hipSuccess) { fprintf(stderr, "kernel_launch: hipFuncSetAttribute failed\n"); grid = -1; return; }
        if (hipOccupancyMaxActiveBlocksPerMultiprocessor(&per_cu, (const void*)fwd_kernel, NTHR, LDS_BYTES) != hipSuccess || per_cu < 1) { fprintf(stderr, "kernel_launch: occupancy query failed (%d)\n", per_cu); grid = -1; return; }
        grid = cus * 1;
        if (n_in != N_IN || ws_size < WS_END) { fprintf(stderr, "kernel_launch: unexpected n_in %d / ws %zu\n", n_in, ws_size); grid = -1; return; }
    }
    if (grid < 0) return;
    if (hipMemsetAsync((char*)d_ws + WS_CTL, 0, 65536, stream) != hipSuccess) { fprintf(stderr, "kernel_launch: memset failed\n"); return; }
    Args a{};
    for (int i = 0; i < N_IN; ++i) a.in[i] = (const float*)d_in[i];
    a.out = (float*)d_out; a.ws = (unsigned char*)d_ws;
    void* args[] = {&a};
    hipError_t e = hipLaunchCooperativeKernel((const void*)fwd_kernel, dim3(grid), dim3(NTHR), args, LDS_BYTES, stream);
    if (e != hipSuccess) fprintf(stderr, "cooperative launch failed: %s (grid %d)\n", hipGetErrorString(e), grid);
}
```
